# Optimizing an MI355X kernel written in HIP

```python
import jax, jax.numpy as jnp
from jax import lax
import numpy as np

D_MODEL = 1024
BATCH = 2
SEQ = 16384
DEPTH = 4

GRID_W = 64
CTX_LEN = 256
N_MIXERS = 3
N_LRU = (DEPTH + 2) // 3
N_MLSTM = (DEPTH + 1) // 3
N_RWKV = DEPTH // 3

LRU_WIDTH = 1280
LRU_BLOCKS = 10
LRU_BS = LRU_WIDTH // LRU_BLOCKS
LRU_C = 8.0
CONV_W = 4

MLSTM_HEADS = 8
MLSTM_DK = 128
MLSTM_DV = 256
MLSTM_QK = MLSTM_HEADS * MLSTM_DK
MLSTM_WIDTH = MLSTM_HEADS * MLSTM_DV
MLSTM_CHUNK = 64

RWKV_HEAD = 64
RWKV_WIDTH = D_MODEL
RWKV_HEADS = RWKV_WIDTH // RWKV_HEAD
DECAY_RANK = 64
ICL_RANK = 64
GN_EPS = 64e-5
NORM_EPS = 1e-6

kernel_name = 'hybrid_rglru_mlstm_rwkv7_prefix_trunk'


def rmsnorm(x, g):
    xf = x.astype(jnp.float32)
    y = xf * lax.rsqrt(jnp.mean(xf * xf, axis=-1, keepdims=True) + NORM_EPS)
    return (y * g.astype(jnp.float32)).astype(x.dtype)


def ada_params(cond, w, b):
    m = jax.nn.silu(cond) @ w + b
    return jnp.split(m, 3, axis=-1)


def centred_dwconv(u, w, b):
    k = w.shape[0]
    left = k // 2
    t = u.shape[1]
    up = jnp.pad(u, ((0, 0), (left, k - 1 - left), (0, 0)))
    out = b
    for j in range(k):
        out = out + up[:, j:j + t] * w[j]
    return out


def rglru_coeffs(u, gate_w, gate_b, lam):
    bsz, t, e = u.shape
    uf = u.astype(jnp.float32)
    ub = uf.reshape(bsz, t, LRU_BLOCKS, LRU_BS)
    gates = jnp.einsum('btnj,dgnjk->dgbtnk', ub, gate_w.astype(jnp.float32)).reshape(2, 2, bsz, t, e)
    gates = jax.nn.sigmoid(gates + gate_b[:, :, None, None, :].astype(jnp.float32))
    r, i = gates[:, 0], gates[:, 1]
    log_a = -LRU_C * jax.nn.softplus(-lam.astype(jnp.float32))[:, None, None, :] * r
    a = jnp.exp(log_a)
    b = jnp.sqrt(-jnp.expm1(2.0 * log_a)) * (i * uf[None])
    return a, b


def linear_scan(a, b, h0, reverse):
    def step(h, ab):
        h = ab[0] * h + ab[1]
        return h, h
    h_last, hs = lax.scan(step, h0, (jnp.moveaxis(a, 1, 0), jnp.moveaxis(b, 1, 0)), reverse=reverse)
    return jnp.moveaxis(hs, 0, 1), h_last


def rglru_bidir(a, b, h0):
    hf, lf = linear_scan(a[0], b[0], h0[0], False)
    hb, lb = linear_scan(a[1], b[1], h0[1], True)
    return hf + hb, jnp.stack([lf, lb])


def lru_mixer(hc, hx, w_in, conv_w, conv_b, gate_w, gate_b, lam, w_out, with_ctx):
    def coeffs(h):
        u, z = jnp.split(h @ w_in, 2, axis=-1)
        a, b = rglru_coeffs(centred_dwconv(u, conv_w, conv_b), gate_w, gate_b, lam)
        return a, b, z
    ac, bc, zc = coeffs(hc)
    h0 = jnp.zeros((2, hc.shape[0], LRU_WIDTH), jnp.float32)
    yc, state_c = rglru_bidir(ac, bc, h0)
    ax, bx, zx = coeffs(hx)
    yx, _ = rglru_bidir(ax, bx, state_c)
    out_x = (yx.astype(hx.dtype) * jax.nn.silu(zx)) @ w_out
    out_c = ((yc.astype(hc.dtype) * jax.nn.silu(zc)) @ w_out) if with_ctx else None
    return out_c, out_x


def mlstm_proj(h, w_in, gate_b):
    bsz, t, _ = h.shape
    splits = [MLSTM_QK, 2 * MLSTM_QK, 2 * MLSTM_QK + MLSTM_WIDTH, 2 * MLSTM_QK + 2 * MLSTM_WIDTH]
    q, k, v, z, g = jnp.split(h @ w_in, splits, axis=-1)
    heads = lambda y, d: y.reshape(bsz, t, MLSTM_HEADS, d).transpose(0, 2, 1, 3).astype(jnp.float32)
    q = heads(q, MLSTM_DK)
    k = heads(k, MLSTM_DK) * (MLSTM_DK ** -0.5)
    v = heads(v, MLSTM_DV)
    g = g.reshape(bsz, t, 2, 2, MLSTM_HEADS).astype(jnp.float32) + gate_b.astype(jnp.float32)
    g = g.transpose(2, 3, 0, 4, 1)
    log_i = g[:, 0]
    log_f = jax.nn.log_sigmoid(g[:, 1])
    return q, k, v, z, log_i, log_f


def mlstm_chunk_scan(q, k, v, log_i, log_f, state):
    bsz, nh, t, _ = q.shape
    L = MLSTM_CHUNK
    nc = t // L
    chunks = lambda y: jnp.moveaxis(y.reshape(bsz, nh, nc, L, *y.shape[3:]), 2, 0)
    causal = jnp.tril(jnp.ones((L, L), dtype=bool))

    def step(carry, inp):
        C, n, m = carry
        qc, kc, vc, ic, fc = inp
        bcum = jnp.cumsum(fc, axis=-1)
        logw = jnp.where(causal, bcum[..., :, None] - bcum[..., None, :] + ic[..., None, :], -jnp.inf)
        g = bcum + m[..., None]
        m_t = jnp.maximum(g, jnp.max(logw, axis=-1))
        s = jnp.einsum('bhtd,bhsd->bhts', qc, kc) * jnp.exp(logw - m_t[..., None])
        inter = jnp.exp(g - m_t)
        num = jnp.einsum('bhts,bhsv->bhtv', s, vc) + inter[..., None] * jnp.einsum('bhtd,bhdv->bhtv', qc, C)
        den = jnp.sum(s, axis=-1) + inter * jnp.einsum('bhtd,bhd->bht', qc, n)
        h = num / jnp.maximum(jnp.abs(den), jnp.exp(-m_t))[..., None]
        m_new = m_t[..., -1]
        wgt = jnp.exp(bcum[..., -1:] - bcum + ic - m_new[..., None])
        decay = jnp.exp(bcum[..., -1] + m - m_new)
        C = decay[..., None, None] * C + jnp.einsum('bhs,bhsd,bhsv->bhdv', wgt, kc, vc)
        n = decay[..., None] * n + jnp.einsum('bhs,bhsd->bhd', wgt, kc)
        return (C, n, m_new), h

    state, hs = lax.scan(step, state, (chunks(q), chunks(k), chunks(v), chunks(log_i), chunks(log_f)))
    return jnp.moveaxis(hs, 0, 2).reshape(bsz, nh, t, -1), state


def mlstm_bidir(q, k, v, log_i, log_f, states):
    flip = lambda y: jnp.flip(y, axis=2)
    hf, sf = mlstm_chunk_scan(q, k, v, log_i[0], log_f[0], states[0])
    hb, sb = mlstm_chunk_scan(flip(q), flip(k), flip(v), flip(log_i[1]), flip(log_f[1]), states[1])
    return hf + flip(hb), (sf, sb)


def mlstm_zero_state(bsz):
    return (jnp.zeros((bsz, MLSTM_HEADS, MLSTM_DK, MLSTM_DV), jnp.float32),
            jnp.zeros((bsz, MLSTM_HEADS, MLSTM_DK), jnp.float32),
            jnp.zeros((bsz, MLSTM_HEADS), jnp.float32))


def mlstm_mixer(hc, hx, w_in, gate_b, norm_g, w_out, with_ctx):
    def finish(hsum, z):
        bsz, _, t, _ = hsum.shape
        hn = hsum * lax.rsqrt(jnp.mean(hsum * hsum, axis=-1, keepdims=True) + NORM_EPS)
        hn = hn.transpose(0, 2, 1, 3).reshape(bsz, t, MLSTM_WIDTH) * norm_g
        return (hn.astype(z.dtype) * jax.nn.silu(z)) @ w_out
    qc, kc, vc, zc, ic, fc = mlstm_proj(hc, w_in, gate_b)
    zero = mlstm_zero_state(hc.shape[0])
    hcs, states_c = mlstm_bidir(qc, kc, vc, ic, fc, (zero, zero))
    qx, kx, vx, zx, ix, fx = mlstm_proj(hx, w_in, gate_b)
    hxs, _ = mlstm_bidir(qx, kx, vx, ix, fx, states_c)
    return (finish(hcs, zc) if with_ctx else None), finish(hxs, zx)


def shift_grid(h, rows):
    bsz, t, d = h.shape
    q = d // 4
    g = h.reshape(bsz, rows, GRID_W, d)
    left = jnp.pad(g[:, :, :-1, :q], ((0, 0), (0, 0), (1, 0), (0, 0)))
    right = jnp.pad(g[:, :, 1:, q:2 * q], ((0, 0), (0, 0), (0, 1), (0, 0)))
    up = jnp.pad(g[:, :-1, :, 2 * q:3 * q], ((0, 0), (1, 0), (0, 0), (0, 0)))
    down = jnp.pad(g[:, 1:, :, 3 * q:], ((0, 0), (0, 1), (0, 0), (0, 0)))
    return jnp.concatenate([left, right, up, down], axis=-1).reshape(bsz, t, d)


def shift_seq(h):
    half = h.shape[-1] // 2
    prev = jnp.pad(h[:, :-1, :half], ((0, 0), (1, 0), (0, 0)))
    nxt = jnp.pad(h[:, 1:, half:], ((0, 0), (0, 1), (0, 0)))
    return jnp.concatenate([prev, nxt], axis=-1)


def rwkv7_prep(h, shifted, mu, w_rkvz, w0, w1, w2, a0, a1, a2, k_k, k_a):
    hd = lambda y: y.reshape(*y.shape[:-1], RWKV_HEADS, RWKV_HEAD).astype(jnp.float32)
    xs = h[None] + (shifted - h)[None] * mu[:, None, None, :]
    r, k, v, z = jnp.einsum('gbtd,gde->gbte', xs[:4], w_rkvz)
    w_pre = w0[:, None, None, :] + jnp.einsum('xbtr,xre->xbte', jnp.tanh(jnp.einsum('btd,xdr->xbtr', xs[4], w1)), w2)
    decay = jnp.exp(-jnp.exp(-jax.nn.softplus(-w_pre.astype(jnp.float32)) - 0.5))
    a = jax.nn.sigmoid(a0[:, None, None, :] + jnp.einsum('xbtr,xre->xbte', jnp.einsum('btd,xdr->xbtr', xs[5], a1), a2))
    kk = hd(k * k_k)
    kk = kk / jnp.maximum(jnp.sqrt(jnp.sum(kk * kk, axis=-1, keepdims=True)), 1e-12)
    k_dir = k[None] * (1.0 + (a - 1.0) * k_a)
    return hd(r), hd(decay), kk, hd(a), hd(k_dir), hd(v), z


def rwkv7_scan(r, w, kk, a, k, v, s0, reverse):
    tm = lambda y: jnp.moveaxis(y, 1, 0)
    def step(s, inp):
        r_t, w_t, kk_t, a_t, k_t, v_t = inp
        s = (s * w_t[..., None, :]
             - jnp.einsum('bhvk,bhk->bhv', s, kk_t)[..., None] * (kk_t * a_t)[..., None, :]
             + v_t[..., :, None] * k_t[..., None, :])
        return s, jnp.einsum('bhvk,bhk->bhv', s, r_t)
    s_last, ys = lax.scan(step, s0, tuple(tm(y) for y in (r, w, kk, a, k, v)), reverse=reverse)
    return jnp.moveaxis(ys, 0, 1), s_last


def rwkv7_mixer(hc, hx, rows, mu, w_rkvz, w0, w1, w2, a0, a1, a2, k_k, k_a, r_k, ln_g, ln_b, w_out, with_ctx):
    def run(h, shifted, states):
        r, w, kk, a, k, v, z = rwkv7_prep(h, shifted, mu, w_rkvz, w0, w1, w2, a0, a1, a2, k_k, k_a)
        yf, sf = rwkv7_scan(r, w[0], kk, a[0], k[0], v, states[0], False)
        yb, sb = rwkv7_scan(r, w[1], kk, a[1], k[1], v, states[1], True)
        return (yf + yb, r, k, v, z), jnp.stack([sf, sb])

    def finish(y, r, k, v, z):
        mean = jnp.mean(y, axis=-1, keepdims=True)
        var = jnp.mean(jnp.square(y - mean), axis=-1, keepdims=True)
        y = ((y - mean) * lax.rsqrt(var + GN_EPS) * ln_g.reshape(RWKV_HEADS, RWKV_HEAD)
             + ln_b.reshape(RWKV_HEADS, RWKV_HEAD))
        bonus = jnp.sum(r[None] * k * r_k.reshape(RWKV_HEADS, RWKV_HEAD), axis=(0, -1))[..., None] * v
        y = (y + bonus).reshape(z.shape)
        return (y.astype(z.dtype) * jax.nn.silu(z)) @ w_out

    s0 = jnp.zeros((2, hc.shape[0], RWKV_HEADS, RWKV_HEAD, RWKV_HEAD), jnp.float32)
    parts_c, states_c = run(hc, shift_seq(hc), s0)
    parts_x, _ = run(hx, shift_grid(hx, rows), states_c)
    return (finish(*parts_c) if with_ctx else None), finish(*parts_x)


def setup_inputs(seed: int = 0) -> dict:
    key = jax.random.key(seed)
    ks = iter(jax.random.split(key, 40))
    nrm = lambda shape, scale: scale * jax.random.normal(next(ks), shape, jnp.float32)
    unif = lambda shape, lo, hi: jax.random.uniform(next(ks), shape, jnp.float32, lo, hi)
    D = D_MODEL
    lam_p = unif((N_LRU, 2, LRU_WIDTH), 0.9, 0.999) ** (1.0 / LRU_C)
    mlstm_gate_b = jnp.stack([nrm((N_MLSTM, 2, MLSTM_HEADS), 0.1),
                              unif((N_MLSTM, 2, MLSTM_HEADS), 3.0, 6.0)], axis=2)
    return {
        'x': nrm((BATCH, SEQ, D), 1.0),
        'c': nrm((BATCH, D), 1.0),
        'ctx': nrm((BATCH, CTX_LEN, D), 1.0),
        'c_ctx': nrm((D,), 1.0),
        'norm_g': 1.0 + nrm((DEPTH, D), 0.1),
        'mod_w': nrm((DEPTH, D, 3 * D), D ** -0.5),
        'mod_b': nrm((DEPTH, 3 * D), 0.02),
        'final_g': 1.0 + nrm((D,), 0.1),
        'lru_w_in': nrm((N_LRU, D, 2 * LRU_WIDTH), D ** -0.5),
        'lru_conv_w': nrm((N_LRU, CONV_W, LRU_WIDTH), CONV_W ** -0.5),
        'lru_conv_b': nrm((N_LRU, LRU_WIDTH), 0.02),
        'lru_gate_w': nrm((N_LRU, 2, 2, LRU_BLOCKS, LRU_BS, LRU_BS), LRU_BS ** -0.5),
        'lru_gate_b': nrm((N_LRU, 2, 2, LRU_WIDTH), 0.1),
        'lru_lam': jnp.log(lam_p) - jnp.log1p(-lam_p),
        'lru_w_out': nrm((N_LRU, LRU_WIDTH, D), LRU_WIDTH ** -0.5),
        'mlstm_w_in': nrm((N_MLSTM, D, 2 * MLSTM_QK + 2 * MLSTM_WIDTH + 4 * MLSTM_HEADS), D ** -0.5),
        'mlstm_gate_b': mlstm_gate_b,
        'mlstm_norm_g': 1.0 + nrm((N_MLSTM, MLSTM_WIDTH), 0.1),
        'mlstm_w_out': nrm((N_MLSTM, MLSTM_WIDTH, D), MLSTM_WIDTH ** -0.5),
        'r7_mu': unif((N_RWKV, 6, D), 0.0, 1.0),
        'r7_w_rkvz': nrm((N_RWKV, 4, D, RWKV_WIDTH), D ** -0.5),
        'r7_w0': unif((N_RWKV, 2, RWKV_WIDTH), -6.0, -1.0),
        'r7_w1': nrm((N_RWKV, 2, D, DECAY_RANK), D ** -0.5),
        'r7_w2': nrm((N_RWKV, 2, DECAY_RANK, RWKV_WIDTH), 0.1 * DECAY_RANK ** -0.5),
        'r7_a0': nrm((N_RWKV, 2, RWKV_WIDTH), 0.1),
        'r7_a1': nrm((N_RWKV, 2, D, ICL_RANK), D ** -0.5),
        'r7_a2': nrm((N_RWKV, 2, ICL_RANK, RWKV_WIDTH), 0.1 * ICL_RANK ** -0.5),
        'r7_k_k': 0.85 + nrm((N_RWKV, RWKV_WIDTH), 0.1),
        'r7_k_a': 1.0 + nrm((N_RWKV, RWKV_WIDTH), 0.1),
        'r7_r_k': nrm((N_RWKV, RWKV_WIDTH), 0.1),
        'r7_ln_g': 1.0 + nrm((N_RWKV, RWKV_WIDTH), 0.1),
        'r7_ln_b': nrm((N_RWKV, RWKV_WIDTH), 0.02),
        'r7_w_out': nrm((N_RWKV, RWKV_WIDTH, D), RWKV_WIDTH ** -0.5),
    }


def reference(x, c, ctx, c_ctx, norm_g, mod_w, mod_b, final_g,
              lru_w_in, lru_conv_w, lru_conv_b, lru_gate_w, lru_gate_b, lru_lam, lru_w_out,
              mlstm_w_in, mlstm_gate_b, mlstm_norm_g, mlstm_w_out,
              r7_mu, r7_w_rkvz, r7_w0, r7_w1, r7_w2, r7_a0, r7_a1, r7_a2,
              r7_k_k, r7_k_a, r7_r_k, r7_ln_g, r7_ln_b, r7_w_out):
    rows = x.shape[1] // GRID_W
    xc = ctx
    for i in range(DEPTH):
        kind, j = i % N_MIXERS, i // N_MIXERS
        with_ctx = i < DEPTH - 1
        shift_x, scale_x, gate_x = ada_params(c, mod_w[i], mod_b[i])
        shift_c, scale_c, gate_c = ada_params(c_ctx, mod_w[i], mod_b[i])
        hx = rmsnorm(x, norm_g[i]) * (1.0 + scale_x[:, None]) + shift_x[:, None]
        hc = rmsnorm(xc, norm_g[i]) * (1.0 + scale_c) + shift_c
        if kind == 0:
            yc, yx = lru_mixer(hc, hx, lru_w_in[j], lru_conv_w[j], lru_conv_b[j], lru_gate_w[j],
                               lru_gate_b[j], lru_lam[j], lru_w_out[j], with_ctx)
        elif kind == 1:
            yc, yx = mlstm_mixer(hc, hx, mlstm_w_in[j], mlstm_gate_b[j], mlstm_norm_g[j], mlstm_w_out[j], with_ctx)
        else:
            yc, yx = rwkv7_mixer(hc, hx, rows, r7_mu[j], r7_w_rkvz[j], r7_w0[j], r7_w1[j], r7_w2[j],
                                 r7_a0[j], r7_a1[j], r7_a2[j], r7_k_k[j], r7_k_a[j], r7_r_k[j],
                                 r7_ln_g[j], r7_ln_b[j], r7_w_out[j], with_ctx)
        x = x + gate_x[:, None] * yx
        if with_ctx:
            xc = xc + gate_c * yc
    return rmsnorm(x, final_g)
```

```cpp
#include <hip/hip_runtime.h>
#include <hip/hip_bf16.h>
#include <hip/hip_cooperative_groups.h>
#include <cstdio>
#include <cstring>
#include <type_traits>
namespace cg = cooperative_groups;

#ifndef MEGA
#define MEGA 0
#endif

typedef unsigned short bfr;
using bf16x8 = __attribute__((ext_vector_type(8))) short;
using f32x4 = __attribute__((ext_vector_type(4))) float;

#define R_ 33280
#define BT_ 16640
#define NCH_ 260

#define OFF_XC 0ull
#define OFF_MOD 2097152ull
#define OFF_W 2244608ull
#define OFF_H 24264704ull
#define OFF_ACT 92422144ull
#define A_Z 0ull
#define A_UC 85196800ull
#define A_AB 170393600ull
#define A_U 170393600ull
#define A_HF 340787200ull
#define A_AGG 425984000ull
#define A_CAR 431308800ull
#define A_QKV 0ull
#define A_GATE 272629760ull
#define A_HS 276889600ull
#define A_RSTD 413204480ull
#define A_RKVZ 0ull
#define A_WM 272629760ull
#define A_AM 281149440ull
#define A_SW 289669120ull
#define A_AA 357826560ull
#define A_BON 425984000ull
#define WS_NEED (OFF_ACT + 434000000ull)

#define WL_GATE (2560 * 1024)
#define WL_OUT (WL_GATE + 1310720)
#define WM_Z (4224 * 1024)
#define WM_OUT (WM_Z + 2048 * 1024)
#define WR_UP (4352 * 2048)
#define WR_OUT (WR_UP + 262144)

enum { PH_PRE = 0, PH_NORM, PH_LRU_IN, PH_LRU_CONV, PH_LRU_GATE, PH_LRU_S1, PH_LRU_S2, PH_LRU_S3, PH_LRU_OUT,
       PH_ML_IN, PH_ML_SCAN, PH_ML_STAT, PH_ML_Z, PH_ML_OUT,
       PH_R7_IN, PH_R7_UP, PH_R7_SCAN, PH_R7_FIN, PH_R7_OUT, PH_FINAL };

struct P {
  const float *x, *c, *ctx, *c_ctx, *norm_g, *mod_w, *mod_b, *final_g;
  const float *lru_w_in, *lru_conv_w, *lru_conv_b, *lru_gate_w, *lru_gate_b, *lru_lam, *lru_w_out;
  const float *ml_w_in, *ml_gate_b, *ml_norm_g, *ml_w_out;
  const float *r7_mu, *r7_w_rkvz, *r7_w0, *r7_w1, *r7_w2, *r7_a0, *r7_a1, *r7_a2, *r7_k_k, *r7_k_a, *r7_r_k, *r7_ln_g, *r7_ln_b, *r7_w_out;
  float* Xx; float* Xc; float* MOD; bfr* W; bfr* H; char* ACT;
  int nsched; int pad_;
  int sched[64 * 3];
};
struct Ctx { int layer, j, d, wc; };

__device__ __forceinline__ bfr f2b(float f) { unsigned u = __float_as_uint(f); u += 0x7fffu + ((u >> 16) & 1u); return (bfr)(u >> 16); }
__device__ __forceinline__ float b2f(bfr b) { return __uint_as_float(((unsigned)b) << 16); }
__device__ __forceinline__ unsigned pk2(float a, float b) { return (unsigned)f2b(a) | (((unsigned)f2b(b)) << 16); }
__device__ __forceinline__ float blo(unsigned u) { return __uint_as_float(u << 16); }
__device__ __forceinline__ float bhi(unsigned u) { return __uint_as_float(u & 0xffff0000u); }
__device__ __forceinline__ void store4b(bfr* dst, f32x4 v) { uint2 u; u.x = pk2(v[0], v[1]); u.y = pk2(v[2], v[3]); *(uint2*)dst = u; }
__device__ __forceinline__ float sigm(float x) { return 1.f / (1.f + __expf(-x)); }
__device__ __forceinline__ float siluf(float x) { return x * sigm(x); }
__device__ __forceinline__ float softplusf(float x) { return x > 20.f ? x : log1pf(expf(x)); }
__device__ __forceinline__ int rowmap(int d, int b, int pp) { int o = d == 0 ? pp : (pp < 256 ? 255 - pp : 16895 - pp); return b * BT_ + o; }
__device__ __forceinline__ float* xrowp(const P& p, int row, int& mi) {
  int b = row / BT_, o = row - b * BT_;
  if (o < 256) { mi = 2; return p.Xc + (size_t)(b * 256 + o) * 1024; }
  mi = b; return p.Xx + (size_t)(b * 16384 + o - 256) * 1024;
}
__device__ __forceinline__ float wsum(float v) { for (int o = 32; o; o >>= 1) v += __shfl_xor(v, o); return v; }
template <int CTRL> __device__ __forceinline__ float dppf(float x) {
  return __int_as_float(__builtin_amdgcn_update_dpp(0, __float_as_int(x), CTRL, 0xf, 0xf, true));
}
__device__ __forceinline__ float red16(float x) {
  x += dppf<0xB1>(x); x += dppf<0x4E>(x); x += dppf<0x141>(x); x += dppf<0x140>(x); return x;
}

template <class F> __device__ __forceinline__ void prep_tile(bfr* dst, int K, int tn, int tk, F get, float* sm) {
  int tid = threadIdx.x;
  for (int i = 0; i < 16; i++) { int kk = (tid >> 6) + 4 * i, nn = tid & 63; sm[kk * 65 + nn] = get(tk * 64 + kk, tn * 64 + nn); }
  __syncthreads();
  for (int i = 0; i < 16; i++) { int nn = (tid >> 6) + 4 * i, kk = tid & 63; dst[(size_t)(tn * 64 + nn) * K + tk * 64 + kk] = f2b(sm[kk * 65 + nn]); }
  __syncthreads();
}
__device__ __forceinline__ int prep_count(int layer) { int kind = layer % 3; return kind == 0 ? (640 + 320 + 320) : kind == 1 ? (1056 + 512 + 512) : (2176 + 64 + 256); }
__device__ __forceinline__ void prep_item(const P& p, int layer, int it, float* sm) {
  int kind = layer % 3, j = layer / 3;
  if (kind == 0) {
    if (it < 640) { int tn = it / 16, tk = it % 16; const float* s = p.lru_w_in + (size_t)j * 1024 * 2560;
      prep_tile(p.W, 1024, tn, tk, [=](int k, int n) { return s[(size_t)k * 2560 + n]; }, sm); return; }
    it -= 640;
    if (it < 320) { int d = it / 160, r = it % 160, tn = r / 2, tk = r % 2; const float* s = p.lru_gate_w + (size_t)(j * 2 + d) * 2 * 10 * 16384;
      prep_tile(p.W + WL_GATE + d * 655360, 128, tn, tk, [=](int k, int n) {
        int nt = n >> 7, blk = nt >> 1, sub = nt & 1, jj = n & 127, wn = jj >> 6, rr = jj & 63, g = rr >> 5, c = rr & 31;
        int kch = sub * 64 + wn * 32 + c; return s[((size_t)(g * 10 + blk) * 128 + k) * 128 + kch]; }, sm); return; }
    it -= 320;
    { int tn = it / 20, tk = it % 20; const float* s = p.lru_w_out + (size_t)j * 1280 * 1024;
      prep_tile(p.W + WL_OUT, 1280, tn, tk, [=](int k, int n) { return s[(size_t)k * 1024 + n]; }, sm); return; }
  } else if (kind == 1) {
    const float* s = p.ml_w_in + (size_t)j * 1024 * 6176;
    if (it < 1056) { int tn = it / 16, tk = it % 16;
      prep_tile(p.W, 1024, tn, tk, [=](int k, int n) {
        if (n < 4096) { float v = s[(size_t)k * 6176 + n]; return (n >= 1024 && n < 2048) ? v * 0.08838834764831845f : v; }
        if (n < 4128) return s[(size_t)k * 6176 + 6144 + (n - 4096)];
        return 0.f; }, sm); return; }
    it -= 1056;
    if (it < 512) { int tn = it / 16, tk = it % 16;
      prep_tile(p.W + WM_Z, 1024, tn, tk, [=](int k, int n) { return s[(size_t)k * 6176 + 4096 + n]; }, sm); return; }
    it -= 512;
    { int tn = it / 32, tk = it % 32; const float* so = p.ml_w_out + (size_t)j * 2048 * 1024;
      prep_tile(p.W + WM_OUT, 2048, tn, tk, [=](int k, int n) { return so[(size_t)k * 1024 + n]; }, sm); return; }
  } else {
    if (it < 2176) { int tn = it / 32, tk = it % 32;
      const float* mu = p.r7_mu + (size_t)j * 6 * 1024; const float* wr = p.r7_w_rkvz + (size_t)j * 4 * 1024 * 1024;
      const float* w1 = p.r7_w1 + (size_t)j * 2 * 1024 * 64; const float* a1 = p.r7_a1 + (size_t)j * 2 * 1024 * 64;
      prep_tile(p.W, 2048, tn, tk, [=](int k, int n) {
        int kk = k & 1023; float v, m;
        if (n < 4096) { int g = n >> 10, e = n & 1023; m = mu[g * 1024 + kk]; v = wr[((size_t)g * 1024 + kk) * 1024 + e]; }
        else if (n < 4224) { int xx = (n - 4096) >> 6, rr = (n - 4096) & 63; m = mu[4 * 1024 + kk]; v = w1[((size_t)xx * 1024 + kk) * 64 + rr]; }
        else { int xx = (n - 4224) >> 6, rr = (n - 4224) & 63; m = mu[5 * 1024 + kk]; v = a1[((size_t)xx * 1024 + kk) * 64 + rr]; }
        return (k < 1024 ? (1.f - m) : m) * v; }, sm); return; }
    it -= 2176;
    if (it < 64) { int u = it / 16, tn = it % 16; const float* s = (u < 2 ? p.r7_w2 : p.r7_a2) + (size_t)(j * 2 + (u & 1)) * 64 * 1024;
      prep_tile(p.W + WR_UP + u * 65536, 64, tn, 0, [=](int k, int n) { return s[(size_t)k * 1024 + n]; }, sm); return; }
    it -= 64;
    { int tn = it / 16, tk = it % 16; const float* s = p.r7_w_out + (size_t)j * 1024 * 1024;
      prep_tile(p.W + WR_OUT, 1024, tn, tk, [=](int k, int n) { return s[(size_t)k * 1024 + n]; }, sm); return; }
  }
}

#define LDSS 72
template <class G> __device__ __forceinline__ void gemm_tile(const P& p, const Ctx& c, int mt, int nt, char* smem) {
  const int tid = threadIdx.x, lane = tid & 63, wid = tid >> 6, wm = wid & 1, wn = wid >> 1;
  bfr* sA = (bfr*)smem; bfr* sB = sA + 2 * 128 * LDSS;
  f32x4 acc[4][4];
  for (int a = 0; a < 4; a++) for (int b = 0; b < 4; b++) acc[a][b] = f32x4{0.f, 0.f, 0.f, 0.f};
  const int lr = tid >> 3, lc = tid & 7;
  uint4 ra[4], rb[4];
  auto gload = [&](int kt) __attribute__((always_inline)) {
#pragma unroll
    for (int i = 0; i < 4; i++) {
      const bfr* pa = G::aptr(p, c, mt * 128 + lr + 32 * i, kt, nt);
      ra[i] = pa ? *(const uint4*)(pa + lc * 8) : uint4{0u, 0u, 0u, 0u};
      rb[i] = *(const uint4*)(G::bptr(p, c, nt * 128 + lr + 32 * i, kt) + lc * 8);
    }
  };
  auto sstore = [&](int buf) __attribute__((always_inline)) {
#pragma unroll
    for (int i = 0; i < 4; i++) {
      *(uint4*)(sA + (buf * 128 + lr + 32 * i) * LDSS + lc * 8) = ra[i];
      *(uint4*)(sB + (buf * 128 + lr + 32 * i) * LDSS + lc * 8) = rb[i];
    }
  };
  gload(0); sstore(0); __syncthreads();
  for (int kt = 0; kt < G::KT; kt++) {
    const int buf = kt & 1;
    if (kt + 1 < G::KT) gload(kt + 1);
#pragma unroll
    for (int ks = 0; ks < 2; ks++) {
      bf16x8 af[4], bf[4];
#pragma unroll
      for (int i = 0; i < 4; i++) {
        af[i] = *(const bf16x8*)(sA + (buf * 128 + wm * 64 + i * 16 + (lane & 15)) * LDSS + ks * 32 + (lane >> 4) * 8);
        bf[i] = *(const bf16x8*)(sB + (buf * 128 + wn * 64 + i * 16 + (lane & 15)) * LDSS + ks * 32 + (lane >> 4) * 8);
      }
#pragma unroll
      for (int n = 0; n < 4; n++)
#pragma unroll
        for (int m = 0; m < 4; m++) acc[n][m] = __builtin_amdgcn_mfma_f32_16x16x32_bf16(bf[n], af[m], acc[n][m], 0, 0, 0);
    }
    if (kt + 1 < G::KT) sstore(buf ^ 1);
    __syncthreads();
  }
  G::epi(p, c, acc, mt * 128 + wm * 64, nt * 128 + wn * 64, lane);
}

__device__ __forceinline__ void epi_resid(const P& p, const Ctx& c, f32x4 (&acc)[4][4], int m0, int n0, int lane) {
#pragma unroll
  for (int mi = 0; mi < 4; mi++) {
    int row = m0 + mi * 16 + (lane & 15); int mo; float* xr = xrowp(p, row, mo);
    if (mo == 2 && !c.wc) continue;
    const float* g = p.MOD + (size_t)(c.layer * 3 + mo) * 3072 + 2048;
#pragma unroll
    for (int ni = 0; ni < 4; ni++) {
      int n = n0 + ni * 16 + (lane >> 4) * 4;
      float4 xv = *(float4*)(xr + n); float4 gg = *(const float4*)(g + n);
      xv.x += gg.x * acc[ni][mi][0]; xv.y += gg.y * acc[ni][mi][1]; xv.z += gg.z * acc[ni][mi][2]; xv.w += gg.w * acc[ni][mi][3];
      *(float4*)(xr + n) = xv;
    }
  }
}

struct G_LruIn { static constexpr int KT = 16, NT = 20;
  static __device__ __forceinline__ const bfr* aptr(const P& p, const Ctx& c, int row, int kt, int nt) { return p.H + (size_t)row * 1024 + kt * 64; }
  static __device__ __forceinline__ const bfr* bptr(const P& p, const Ctx& c, int n, int kt) { return p.W + (size_t)n * 1024 + kt * 64; }
  static __device__ __forceinline__ void epi(const P& p, const Ctx& c, f32x4 (&acc)[4][4], int m0, int n0, int lane) {
    bfr* U = (bfr*)(p.ACT + A_U); bfr* Z = (bfr*)(p.ACT + A_Z);
#pragma unroll
    for (int ni = 0; ni < 4; ni++)
#pragma unroll
      for (int mi = 0; mi < 4; mi++) {
        int row = m0 + mi * 16 + (lane & 15), n = n0 + ni * 16 + (lane >> 4) * 4;
        bfr* dst = n < 1280 ? U + (size_t)row * 1280 + n : Z + (size_t)row * 1280 + (n - 1280);
        store4b(dst, acc[ni][mi]);
      }
  } };
struct G_LruGate { static constexpr int KT = 2, NT = 20;
  static __device__ __forceinline__ const bfr* aptr(const P& p, const Ctx& c, int row, int kt, int nt) { return (const bfr*)(p.ACT + A_UC) + (size_t)row * 1280 + (nt >> 1) * 128 + kt * 64; }
  static __device__ __forceinline__ const bfr* bptr(const P& p, const Ctx& c, int n, int kt) { return p.W + WL_GATE + c.d * 655360 + (size_t)n * 128 + kt * 64; }
  static __device__ __forceinline__ void epi(const P& p, const Ctx& c, f32x4 (&acc)[4][4], int m0, int n0, int lane) {
    const bfr* UC = (const bfr*)(p.ACT + A_UC); unsigned* AB = (unsigned*)(p.ACT + A_AB);
    const float* gb = p.lru_gate_b + (size_t)(c.j * 2 + c.d) * 2 * 1280; const float* lam = p.lru_lam + (size_t)(c.j * 2 + c.d) * 1280;
    int chb = (n0 >> 6) * 32;
#pragma unroll
    for (int ni = 0; ni < 2; ni++) {
      int ch = chb + ni * 16 + (lane >> 4) * 4;
      float cl[4], br[4], bi[4];
#pragma unroll
      for (int q = 0; q < 4; q++) { cl[q] = 8.f * softplusf(-lam[ch + q]); br[q] = gb[ch + q]; bi[q] = gb[1280 + ch + q]; }
#pragma unroll
      for (int mi = 0; mi < 4; mi++) {
        int row = m0 + mi * 16 + (lane & 15);
        uint2 u = *(const uint2*)(UC + (size_t)row * 1280 + ch);
        float uc[4] = {blo(u.x), bhi(u.x), blo(u.y), bhi(u.y)};
        unsigned o[4];
#pragma unroll
        for (int q = 0; q < 4; q++) {
          float r = sigm(acc[ni][mi][q] + br[q]), ig = sigm(acc[ni + 2][mi][q] + bi[q]);
          float la = -cl[q] * r; float oma = -expm1f(la); float bb = sqrtf(-expm1f(2.f * la)) * ig * uc[q];
          o[q] = (((unsigned)f2b(oma)) << 16) | (unsigned)f2b(bb);
        }
        *(uint4*)(AB + (size_t)row * 1280 + ch) = uint4{o[0], o[1], o[2], o[3]};
      }
    }
  } };
struct G_LruOut { static constexpr int KT = 20, NT = 8;
  static __device__ __forceinline__ const bfr* aptr(const P& p, const Ctx& c, int row, int kt, int nt) { return (const bfr*)(p.ACT + A_Z) + (size_t)row * 1280 + kt * 64; }
  static __device__ __forceinline__ const bfr* bptr(const P& p, const Ctx& c, int n, int kt) { return p.W + WL_OUT + (size_t)n * 1280 + kt * 64; }
  static __device__ __forceinline__ void epi(const P& p, const Ctx& c, f32x4 (&acc)[4][4], int m0, int n0, int lane) { epi_resid(p, c, acc, m0, n0, lane); } };
struct G_MlIn { static constexpr int KT = 16, NT = 33;
  static __device__ __forceinline__ const bfr* aptr(const P& p, const Ctx& c, int row, int kt, int nt) { return p.H + (size_t)row * 1024 + kt * 64; }
  static __device__ __forceinline__ const bfr* bptr(const P& p, const Ctx& c, int n, int kt) { return p.W + (size_t)n * 1024 + kt * 64; }
  static __device__ __forceinline__ void epi(const P& p, const Ctx& c, f32x4 (&acc)[4][4], int m0, int n0, int lane) {
    bfr* QKV = (bfr*)(p.ACT + A_QKV); float* GT = (float*)(p.ACT + A_GATE);
#pragma unroll
    for (int ni = 0; ni < 4; ni++)
#pragma unroll
      for (int mi = 0; mi < 4; mi++) {
        int row = m0 + mi * 16 + (lane & 15), n = n0 + ni * 16 + (lane >> 4) * 4;
        if (n < 4096) store4b(QKV + (size_t)row * 4096 + n, acc[ni][mi]);
        else if (n < 4128) *(float4*)(GT + (size_t)row * 32 + (n - 4096)) = float4{acc[ni][mi][0], acc[ni][mi][1], acc[ni][mi][2], acc[ni][mi][3]};
      }
  } };
struct G_MlZ { static constexpr int KT = 16, NT = 16;
  static __device__ __forceinline__ const bfr* aptr(const P& p, const Ctx& c, int row, int kt, int nt) { return p.H + (size_t)row * 1024 + kt * 64; }
  static __device__ __forceinline__ const bfr* bptr(const P& p, const Ctx& c, int n, int kt) { return p.W + WM_Z + (size_t)n * 1024 + kt * 64; }
  static __device__ __forceinline__ void epi(const P& p, const Ctx& c, f32x4 (&acc)[4][4], int m0, int n0, int lane) {
    bfr* HS = (bfr*)(p.ACT + A_HS); const float* RS = (const float*)(p.ACT + A_RSTD); const float* ng = p.ml_norm_g + (size_t)c.j * 2048;
#pragma unroll
    for (int ni = 0; ni < 4; ni++)
#pragma unroll
      for (int mi = 0; mi < 4; mi++) {
        int row = m0 + mi * 16 + (lane & 15), n = n0 + ni * 16 + (lane >> 4) * 4;
        bfr* hp = HS + (size_t)row * 2048 + n; uint2 u = *(const uint2*)hp; float rs = RS[(size_t)row * 8 + (n >> 8)];
        float4 g4 = *(const float4*)(ng + n);
        f32x4 o;
        o[0] = blo(u.x) * rs * g4.x * siluf(acc[ni][mi][0]); o[1] = bhi(u.x) * rs * g4.y * siluf(acc[ni][mi][1]);
        o[2] = blo(u.y) * rs * g4.z * siluf(acc[ni][mi][2]); o[3] = bhi(u.y) * rs * g4.w * siluf(acc[ni][mi][3]);
        store4b(hp, o);
      }
  } };
struct G_MlOut { static constexpr int KT = 32, NT = 8;
  static __device__ __forceinline__ const bfr* aptr(const P& p, const Ctx& c, int row, int kt, int nt) { return (const bfr*)(p.ACT + A_HS) + (size_t)row * 2048 + kt * 64; }
  static __device__ __forceinline__ const bfr* bptr(const P& p, const Ctx& c, int n, int kt) { return p.W + WM_OUT + (size_t)n * 2048 + kt * 64; }
  static __device__ __forceinline__ void epi(const P& p, const Ctx& c, f32x4 (&acc)[4][4], int m0, int n0, int lane) { epi_resid(p, c, acc, m0, n0, lane); } };
struct G_R7In { static constexpr int KT = 32, NT = 34;
  static __device__ __forceinline__ const bfr* aptr(const P& p, const Ctx& c, int row, int kt, int nt) {
    if (kt < 16) return p.H + (size_t)row * 1024 + kt * 64;
    int q = (kt - 16) >> 2; int b = row / BT_, o = row - b * BT_; int nr;
    if (o < 256) { if (q < 2) { if (o < 1) return nullptr; nr = row - 1; } else { if (o >= 255) return nullptr; nr = row + 1; } }
    else { int t = o - 256, col = t & 63, gr = t >> 6;
      if (q == 0) { if (col == 0) return nullptr; nr = row - 1; }
      else if (q == 1) { if (col == 63) return nullptr; nr = row + 1; }
      else if (q == 2) { if (gr == 0) return nullptr; nr = row - 64; }
      else { if (gr == 255) return nullptr; nr = row + 64; } }
    return p.H + (size_t)nr * 1024 + (kt - 16) * 64; }
  static __device__ __forceinline__ const bfr* bptr(const P& p, const Ctx& c, int n, int kt) { return p.W + (size_t)n * 2048 + kt * 64; }
  static __device__ __forceinline__ void epi(const P& p, const Ctx& c, f32x4 (&acc)[4][4], int m0, int n0, int lane) {
    bfr* RK = (bfr*)(p.ACT + A_RKVZ); bfr* WMb = (bfr*)(p.ACT + A_WM); bfr* AMb = (bfr*)(p.ACT + A_AM);
#pragma unroll
    for (int ni = 0; ni < 4; ni++)
#pragma unroll
      for (int mi = 0; mi < 4; mi++) {
        int row = m0 + mi * 16 + (lane & 15), n = n0 + ni * 16 + (lane >> 4) * 4;
        if (n < 4096) store4b(RK + (size_t)row * 4096 + n, acc[ni][mi]);
        else if (n < 4224) { f32x4 t;
#pragma unroll
          for (int q = 0; q < 4; q++) t[q] = tanhf(acc[ni][mi][q]); store4b(WMb + (size_t)row * 128 + (n - 4096), t); }
        else store4b(AMb + (size_t)row * 128 + (n - 4224), acc[ni][mi]);
      }
  } };
struct G_R7Up { static constexpr int KT = 1, NT = 16;
  static __device__ __forceinline__ const bfr* aptr(const P& p, const Ctx& c, int row, int kt, int nt) { return (const bfr*)(p.ACT + (nt < 8 ? A_WM : A_AM)) + (size_t)row * 128 + c.d * 64; }
  static __device__ __forceinline__ const bfr* bptr(const P& p, const Ctx& c, int n, int kt) { return n < 1024 ? p.W + WR_UP + c.d * 65536 + (size_t)n * 64 : p.W + WR_UP + (2 + c.d) * 65536 + (size_t)(n - 1024) * 64; }
  static __device__ __forceinline__ void epi(const P& p, const Ctx& c, f32x4 (&acc)[4][4], int m0, int n0, int lane) {
    bfr* SW = (bfr*)(p.ACT + A_SW); bfr* AA = (bfr*)(p.ACT + A_AA);
    const float* w0 = p.r7_w0 + (size_t)(c.j * 2 + c.d) * 1024; const float* a0 = p.r7_a0 + (size_t)(c.j * 2 + c.d) * 1024;
#pragma unroll
    for (int ni = 0; ni < 4; ni++)
#pragma unroll
      for (int mi = 0; mi < 4; mi++) {
        int row = m0 + mi * 16 + (lane & 15), n = n0 + ni * 16 + (lane >> 4) * 4; f32x4 t;
        if (n < 1024) {
#pragma unroll
          for (int q = 0; q < 4; q++) t[q] = 0.6065306597126334f * sigm(w0[n + q] + acc[ni][mi][q]); store4b(SW + (size_t)row * 1024 + n, t); }
        else { int e = n - 1024;
#pragma unroll
          for (int q = 0; q < 4; q++) t[q] = sigm(a0[e + q] + acc[ni][mi][q]); store4b(AA + (size_t)row * 1024 + e, t); }
      }
  } };
struct G_R7Out { static constexpr int KT = 16, NT = 8;
  static __device__ __forceinline__ const bfr* aptr(const P& p, const Ctx& c, int row, int kt, int nt) { return p.H + (size_t)row * 1024 + kt * 64; }
  static __device__ __forceinline__ const bfr* bptr(const P& p, const Ctx& c, int n, int kt) { return p.W + WR_OUT + (size_t)n * 1024 + kt * 64; }
  static __device__ __forceinline__ void epi(const P& p, const Ctx& c, f32x4 (&acc)[4][4], int m0, int n0, int lane) { epi_resid(p, c, acc, m0, n0, lane); } };

template <class G> __device__ __forceinline__ void gemm_phase(const P& p, const Ctx& c, char* smem) {
  const int total = 260 * G::NT;
  for (int it = blockIdx.x; it < total; it += gridDim.x) gemm_tile<G>(p, c, it / G::NT, it % G::NT, smem);
}

__device__ __forceinline__ void ph_pre(const P& p, char* smem) {
  float* sm = (float*)smem; const int tid = threadIdx.x;
  const int nprep = prep_count(0), ngemv = 192, ncopy = 8320;
  for (int it = blockIdx.x; it < nprep + ngemv + ncopy; it += gridDim.x) {
    if (it < nprep) { prep_item(p, 0, it, sm); continue; }
    int i2 = it - nprep;
    if (i2 < ngemv) {
      int l = i2 / 48, cgp = i2 % 48;
      for (int i = tid; i < 3072; i += 256) { int cnd = i >> 10, k = i & 1023; float v = cnd == 0 ? p.c[k] : cnd == 1 ? p.c[1024 + k] : p.c_ctx[k]; sm[i] = siluf(v); }
      __syncthreads();
      int kq = tid >> 6, col = cgp * 64 + (tid & 63); const float* w = p.mod_w + (size_t)l * 1024 * 3072 + col;
      float a0 = 0.f, a1 = 0.f, a2 = 0.f;
      for (int k = kq * 256; k < kq * 256 + 256; k++) { float wv = w[(size_t)k * 3072]; a0 += sm[k] * wv; a1 += sm[1024 + k] * wv; a2 += sm[2048 + k] * wv; }
      float* red = sm + 3072; red[tid * 3] = a0; red[tid * 3 + 1] = a1; red[tid * 3 + 2] = a2;
      __syncthreads();
      if (tid < 64) { float bias = p.mod_b[(size_t)l * 3072 + col];
        for (int cnd = 0; cnd < 3; cnd++) { float s = bias; for (int q = 0; q < 4; q++) s += red[(q * 64 + tid) * 3 + cnd]; p.MOD[(size_t)(l * 3 + cnd) * 3072 + col] = s; } }
      __syncthreads();
      continue;
    }
    i2 -= ngemv;
    for (int q = 0; q < 4; q++) { int idx = i2 * 1024 + q * 256 + tid; int row = idx >> 8, c4 = idx & 255; int b = row / BT_, o = row - b * BT_;
      if (o < 256) ((float4*)p.Xc)[(size_t)(b * 256 + o) * 256 + c4] = ((const float4*)p.ctx)[(size_t)(b * 256 + o) * 256 + c4];
      else ((float4*)p.Xx)[(size_t)(b * 16384 + o - 256) * 256 + c4] = ((const float4*)p.x)[(size_t)(b * 16384 + o - 256) * 256 + c4]; }
  }
}
__device__ __forceinline__ void ph_norm(const P& p, int layer, char* smem) {
  const int tid = threadIdx.x, lane = tid & 63, wid = tid >> 6;
  const int nprep = layer > 0 ? prep_count(layer) : 0; const int kind = layer % 3;
  const int nzero = kind == 1 ? 8320 : 0;
  (void)nzero;
  for (int it = blockIdx.x; it < nprep + 8320; it += gridDim.x) {
    if (it < nprep) { prep_item(p, layer, it, (float*)smem); continue; }
    int row = (it - nprep) * 4 + wid; int mo; const float* xr = xrowp(p, row, mo);
    float4 v[4]; float ss = 0.f;
#pragma unroll
    for (int i = 0; i < 4; i++) { v[i] = *(const float4*)(xr + lane * 4 + 256 * i); ss += v[i].x * v[i].x + v[i].y * v[i].y + v[i].z * v[i].z + v[i].w * v[i].w; }
    ss = wsum(ss); float rs = rsqrtf(ss * (1.f / 1024.f) + 1e-6f);
    const float* g = p.norm_g + (size_t)layer * 1024; const float* md = p.MOD + (size_t)(layer * 3 + mo) * 3072;
#pragma unroll
    for (int i = 0; i < 4; i++) { int cidx = lane * 4 + 256 * i; float4 gg = *(const float4*)(g + cidx), sh = *(const float4*)(md + cidx), sc = *(const float4*)(md + 1024 + cidx);
      f32x4 o; o[0] = v[i].x * rs * gg.x * (1.f + sc.x) + sh.x; o[1] = v[i].y * rs * gg.y * (1.f + sc.y) + sh.y; o[2] = v[i].z * rs * gg.z * (1.f + sc.z) + sh.z; o[3] = v[i].w * rs * gg.w * (1.f + sc.w) + sh.w;
      store4b(p.H + (size_t)row * 1024 + cidx, o); }
  }
}
__device__ __forceinline__ void ph_final(const P& p) {
  const int lane = threadIdx.x & 63, wid = threadIdx.x >> 6;
  for (int it = blockIdx.x; it < 8192; it += gridDim.x) {
    float* xr = p.Xx + (size_t)(it * 4 + wid) * 1024; float4 v[4]; float ss = 0.f;
#pragma unroll
    for (int i = 0; i < 4; i++) { v[i] = *(const float4*)(xr + lane * 4 + 256 * i); ss += v[i].x * v[i].x + v[i].y * v[i].y + v[i].z * v[i].z + v[i].w * v[i].w; }
    ss = wsum(ss); float rs = rsqrtf(ss * (1.f / 1024.f) + 1e-6f);
#pragma unroll
    for (int i = 0; i < 4; i++) { int cidx = lane * 4 + 256 * i; float4 gg = *(const float4*)(p.final_g + cidx);
      *(float4*)(xr + cidx) = float4{v[i].x * rs * gg.x, v[i].y * rs * gg.y, v[i].z * rs * gg.z, v[i].w * rs * gg.w}; }
  }
}
__device__ __forceinline__ void ph_lru_conv(const P& p, int j) {
  const bfr* U = (const bfr*)(p.ACT + A_U); bfr* UC = (bfr*)(p.ACT + A_UC);
  const float* cw = p.lru_conv_w + (size_t)j * 4 * 1280; const float* cb = p.lru_conv_b + (size_t)j * 1280;
  for (int it = blockIdx.x; it < 20800; it += gridDim.x) {
    int idx = it * 256 + threadIdx.x; int row = idx / 160, cgp = idx % 160, ch = cgp * 8;
    int b = row / BT_, o = row - b * BT_; int s0 = o < 256 ? 0 : 256, e0 = o < 256 ? 256 : BT_;
    float acc[8];
#pragma unroll
    for (int e = 0; e < 8; e++) acc[e] = cb[ch + e];
#pragma unroll
    for (int t = 0; t < 4; t++) { int oo = o + t - 2; if (oo < s0 || oo >= e0) continue;
      uint4 u = *(const uint4*)(U + (size_t)(row + t - 2) * 1280 + ch); const float* w = cw + t * 1280 + ch;
      acc[0] += w[0] * blo(u.x); acc[1] += w[1] * bhi(u.x); acc[2] += w[2] * blo(u.y); acc[3] += w[3] * bhi(u.y);
      acc[4] += w[4] * blo(u.z); acc[5] += w[5] * bhi(u.z); acc[6] += w[6] * blo(u.w); acc[7] += w[7] * bhi(u.w); }
    *(uint4*)(UC + (size_t)row * 1280 + ch) = uint4{pk2(acc[0], acc[1]), pk2(acc[2], acc[3]), pk2(acc[4], acc[5]), pk2(acc[6], acc[7])};
  }
}
__device__ __forceinline__ void ph_lru_s1(const P& p, int d) {
  const unsigned* AB = (const unsigned*)(p.ACT + A_AB); float2* AGG = (float2*)(p.ACT + A_AGG);
  for (int it = blockIdx.x; it < 2600; it += gridDim.x) {
    int b = it / 1300, r = it % 1300, cc = r / 5, ch = (r % 5) * 256 + threadIdx.x;
    float Pp = 1.f, Q = 0.f;
#pragma unroll 8
    for (int t = 0; t < 64; t++) { unsigned u = AB[(size_t)rowmap(d, b, cc * 64 + t) * 1280 + ch]; float a = 1.f - bhi(u), bb = blo(u); Pp *= a; Q = a * Q + bb; }
    AGG[(size_t)(b * NCH_ + cc) * 1280 + ch] = float2{Pp, Q};
  }
}
__device__ __forceinline__ void ph_lru_s2(const P& p) {
  const float2* AGG = (const float2*)(p.ACT + A_AGG); float* CAR = (float*)(p.ACT + A_CAR);
  for (int it = blockIdx.x; it < 10; it += gridDim.x) {
    int idx = it * 256 + threadIdx.x, b = idx / 1280, ch = idx % 1280; float h = 0.f;
#pragma unroll 4
    for (int cc = 0; cc < NCH_; cc++) { size_t o = (size_t)(b * NCH_ + cc) * 1280 + ch; float2 a = AGG[o]; CAR[o] = h; h = a.x * h + a.y; }
  }
}
__device__ __forceinline__ void ph_lru_s3(const P& p, int d) {
  const unsigned* AB = (const unsigned*)(p.ACT + A_AB); const float* CAR = (const float*)(p.ACT + A_CAR);
  bfr* HF = (bfr*)(p.ACT + A_HF); bfr* Z = (bfr*)(p.ACT + A_Z);
  for (int it = blockIdx.x; it < 2600; it += gridDim.x) {
    int b = it / 1300, r = it % 1300, cc = r / 5, ch = (r % 5) * 256 + threadIdx.x;
    float h = CAR[(size_t)(b * NCH_ + cc) * 1280 + ch];
#pragma unroll 8
    for (int t = 0; t < 64; t++) { size_t o = (size_t)rowmap(d, b, cc * 64 + t) * 1280 + ch; unsigned u = AB[o]; h = (1.f - bhi(u)) * h + blo(u);
      if (d == 0) HF[o] = f2b(h); else { float y = b2f(HF[o]) + h; Z[o] = f2b(y * siluf(b2f(Z[o]))); } }
  }
}
__device__ __forceinline__ void ph_ml_stat(const P& p) {
  const bfr* HS = (const bfr*)(p.ACT + A_HS); float* RS = (float*)(p.ACT + A_RSTD);
  const int lane = threadIdx.x & 63, wid = threadIdx.x >> 6;
  for (int it = blockIdx.x; it < 8320; it += gridDim.x) {
    int row = it * 4 + wid; const bfr* hp = HS + (size_t)row * 2048 + lane * 32; float ss = 0.f;
#pragma unroll
    for (int i = 0; i < 4; i++) { uint4 u = *(const uint4*)(hp + i * 8); float a;
      a = blo(u.x); ss += a * a; a = bhi(u.x); ss += a * a; a = blo(u.y); ss += a * a; a = bhi(u.y); ss += a * a;
      a = blo(u.z); ss += a * a; a = bhi(u.z); ss += a * a; a = blo(u.w); ss += a * a; a = bhi(u.w); ss += a * a; }
    ss += __shfl_xor(ss, 1); ss += __shfl_xor(ss, 2); ss += __shfl_xor(ss, 4);
    if ((lane & 7) == 0) RS[(size_t)row * 8 + (lane >> 3)] = rsqrtf(ss * (1.f / 256.f) + 1e-6f);
  }
}
__device__ __forceinline__ void ph_r7_fin(const P& p, int j) {
  bfr* Y = p.H; const bfr* RK = (const bfr*)(p.ACT + A_RKVZ); const float* BON = (const float*)(p.ACT + A_BON);
  const float* lg = p.r7_ln_g + (size_t)j * 1024; const float* lb = p.r7_ln_b + (size_t)j * 1024;
  const int lane = threadIdx.x & 63, wid = threadIdx.x >> 6;
  for (int it = blockIdx.x; it < 8320; it += gridDim.x) {
    int row = it * 4 + wid, ch = lane * 16, hd = lane >> 2;
    float y[16], v[16], z[16];
#pragma unroll
    for (int i = 0; i < 2; i++) {
      uint4 u = *(const uint4*)(Y + (size_t)row * 1024 + ch + i * 8);
      y[i * 8 + 0] = blo(u.x); y[i * 8 + 1] = bhi(u.x); y[i * 8 + 2] = blo(u.y); y[i * 8 + 3] = bhi(u.y); y[i * 8 + 4] = blo(u.z); y[i * 8 + 5] = bhi(u.z); y[i * 8 + 6] = blo(u.w); y[i * 8 + 7] = bhi(u.w);
      u = *(const uint4*)(RK + (size_t)row * 4096 + 2048 + ch + i * 8);
      v[i * 8 + 0] = blo(u.x); v[i * 8 + 1] = bhi(u.x); v[i * 8 + 2] = blo(u.y); v[i * 8 + 3] = bhi(u.y); v[i * 8 + 4] = blo(u.z); v[i * 8 + 5] = bhi(u.z); v[i * 8 + 6] = blo(u.w); v[i * 8 + 7] = bhi(u.w);
      u = *(const uint4*)(RK + (size_t)row * 4096 + 3072 + ch + i * 8);
      z[i * 8 + 0] = blo(u.x); z[i * 8 + 1] = bhi(u.x); z[i * 8 + 2] = blo(u.y); z[i * 8 + 3] = bhi(u.y); z[i * 8 + 4] = blo(u.z); z[i * 8 + 5] = bhi(u.z); z[i * 8 + 6] = blo(u.w); z[i * 8 + 7] = bhi(u.w);
    }
    float s = 0.f;
#pragma unroll
    for (int e = 0; e < 16; e++) s += y[e];
    s += __shfl_xor(s, 1); s += __shfl_xor(s, 2); float mean = s * (1.f / 64.f);
    float q = 0.f;
#pragma unroll
    for (int e = 0; e < 16; e++) { float dlt = y[e] - mean; q += dlt * dlt; }
    q += __shfl_xor(q, 1); q += __shfl_xor(q, 2); float rs = rsqrtf(q * (1.f / 64.f) + 64e-5f);
    float bon = BON[(size_t)row * 16 + hd] + BON[(size_t)(R_ + row) * 16 + hd];
    float o[16];
#pragma unroll
    for (int e = 0; e < 16; e++) { float yn = (y[e] - mean) * rs * lg[ch + e] + lb[ch + e]; o[e] = (yn + bon * v[e]) * siluf(z[e]); }
#pragma unroll
    for (int i = 0; i < 2; i++)
      *(uint4*)(Y + (size_t)row * 1024 + ch + i * 8) = uint4{pk2(o[i * 8], o[i * 8 + 1]), pk2(o[i * 8 + 2], o[i * 8 + 3]), pk2(o[i * 8 + 4], o[i * 8 + 5]), pk2(o[i * 8 + 6], o[i * 8 + 7])};
  }
}

#define QS 136
#define VS 72
__device__ __forceinline__ void ph_ml_scan(const P& p, int j, char* smem) {
  bfr* sQ = (bfr*)smem; bfr* sK = sQ + 64 * QS; bfr* sVT = sK + 64 * QS; bfr* sCT = sVT + 16 * VS;
  float* sN = (float*)(sCT + 2 * 16 * QS);
  float* sEs = sN + 256; float* sCt = sEs + 64; float* sBc = sCt + 64; float* sWg = sBc + 64; float* sNr = sWg + 64;
  const bfr* QKV = (const bfr*)(p.ACT + A_QKV); const float* GT = (const float*)(p.ACT + A_GATE); bfr* HS = (bfr*)(p.ACT + A_HS);
  const float* gbias = p.ml_gate_b + (size_t)j * 32;
  const int tid = threadIdx.x, lane = tid & 63, w = tid >> 6, l15 = lane & 15, q4 = lane >> 4;
  for (int it = blockIdx.x; it < 256; it += gridDim.x) {
    const int b = it >> 7, hh = (it >> 4) & 7, sl = it & 15;
    f32x4 Cacc[2][2];
#pragma unroll
    for (int a = 0; a < 2; a++) {
#pragma unroll
      for (int c = 0; c < 2; c++) Cacc[a][c] = f32x4{0.f, 0.f, 0.f, 0.f}; }
    float mst0 = 0.f, mst1 = 0.f;
    for (int i = tid; i < 2 * 16 * QS; i += 256) sCT[i] = 0;
    sN[tid] = 0.f;
    uint4 pq0, pq1, pq2, pq3, pk0, pk1, pk2, pk3, pv = uint4{0u, 0u, 0u, 0u};
#define ML_ROW0(d_, s_) ((d_) == 0 ? b * BT_ + 64 * (s_) : rowmap(1, b, 64 * (s_) + 63))
#define ML_LD(i_, PQ, PK) { int idx = tid + 256 * (i_), rho = idx >> 4, c8 = idx & 15; const bfr* src = QKV + (size_t)(r0n + rho) * 4096 + hh * 128 + c8 * 8; PQ = *(const uint4*)src; PK = *(const uint4*)(src + 1024); }
#define ML_ISSUE(d_, s_) { const int r0n = ML_ROW0(d_, s_); ML_LD(0, pq0, pk0) ML_LD(1, pq1, pk1) ML_LD(2, pq2, pk2) ML_LD(3, pq3, pk3) \
      if (tid < 128) pv = *(const uint4*)(QKV + (size_t)(r0n + (tid >> 1)) * 4096 + 2048 + hh * 256 + sl * 16 + (tid & 1) * 8); }
#define ML_ST(i_, PQ, PK) { int idx = tid + 256 * (i_), rho = idx >> 4, c8 = idx & 15; *(uint4*)(sQ + rho * QS + c8 * 8) = PQ; *(uint4*)(sK + rho * QS + c8 * 8) = PK; }
#define ML_COMMIT() { ML_ST(0, pq0, pk0) ML_ST(1, pq1, pk1) ML_ST(2, pq2, pk2) ML_ST(3, pq3, pk3) \
      if (tid < 128) { int rho = tid >> 1, vb = (tid & 1) * 8; \
        sVT[(vb + 0) * VS + rho] = (bfr)(pv.x & 0xffff); sVT[(vb + 1) * VS + rho] = (bfr)(pv.x >> 16); \
        sVT[(vb + 2) * VS + rho] = (bfr)(pv.y & 0xffff); sVT[(vb + 3) * VS + rho] = (bfr)(pv.y >> 16); \
        sVT[(vb + 4) * VS + rho] = (bfr)(pv.z & 0xffff); sVT[(vb + 5) * VS + rho] = (bfr)(pv.z >> 16); \
        sVT[(vb + 6) * VS + rho] = (bfr)(pv.w & 0xffff); sVT[(vb + 7) * VS + rho] = (bfr)(pv.w >> 16); } }
    ML_ISSUE(0, 0)
    __syncthreads();
    for (int s = 0; s < NCH_; s++) {
#pragma unroll
    for (int d = 0; d < 2; d++) {
      const int st = 2 * s + d;
      const int r0 = ML_ROW0(d, s);
      ML_COMMIT()
      float mcur = d ? mst1 : mst0, mxl, decay;
      {
        int rho = d ? 63 - lane : lane; const float* gp = GT + (size_t)(r0 + rho) * 32 + d * 16 + hh;
        float gi = gp[0] + gbias[(d * 2 + 0) * 8 + hh], gf = gp[8] + gbias[(d * 2 + 1) * 8 + hh];
        float fc = fminf(gf, 0.f) - log1pf(__expf(-fabsf(gf)));
        float bc = fc;
        for (int o = 1; o < 64; o <<= 1) { float t = __shfl_up(bc, o); if (lane >= o) bc += t; }
        float e = gi - bc, pm = e;
        for (int o = 1; o < 64; o <<= 1) { float t = __shfl_up(pm, o); if (lane >= o) pm = fmaxf(pm, t); }
        float pml = __shfl(pm, 63), bcl = __shfl(bc, 63);
        mxl = fmaxf(mcur, pml); decay = __expf(mcur - mxl);
        if (w == 0) { sEs[rho] = e; sCt[rho] = -fmaxf(mcur, pm); sBc[rho] = bc; sWg[rho] = __expf(e - mxl); }
        if (d) mst1 = bcl + mxl; else mst0 = bcl + mxl;
      }
      __syncthreads();
      if (st + 1 < 2 * NCH_) ML_ISSUE((st + 1) & 1, (st + 1) >> 1)
      bf16x8 qf[4];
#pragma unroll
      for (int ks = 0; ks < 4; ks++) qf[ks] = *(const bf16x8*)(sQ + (16 * w + l15) * QS + ks * 32 + q4 * 8);
      f32x4 sacc[4];
#pragma unroll
      for (int a = 0; a < 4; a++) { sacc[a] = f32x4{0.f, 0.f, 0.f, 0.f};
#pragma unroll
        for (int ks = 0; ks < 4; ks++) { bf16x8 kf = *(const bf16x8*)(sK + (16 * a + l15) * QS + ks * 32 + q4 * 8); sacc[a] = __builtin_amdgcn_mfma_f32_16x16x32_bf16(kf, qf[ks], sacc[a], 0, 0, 0); } }
      const int rt = 16 * w + l15; const float ctt = sCt[rt]; float densum = 0.f;
#pragma unroll
      for (int a = 0; a < 4; a++)
#pragma unroll
        for (int jj = 0; jj < 4; jj++) { int rs_ = 16 * a + 4 * q4 + jj; bool valid = d == 0 ? rs_ <= rt : rs_ >= rt;
          float wv = valid ? __expf(ctt + sEs[rs_]) : 0.f; float sv = sacc[a][jj] * wv; sacc[a][jj] = sv; densum += sv; }
      densum += __shfl_xor(densum, 16); densum += __shfl_xor(densum, 32);
      bf16x8 sf[2], vf[2];
#pragma unroll
      for (int ks = 0; ks < 2; ks++) {
#pragma unroll
        for (int jj = 0; jj < 4; jj++) { sf[ks][jj] = (short)f2b(sacc[2 * ks][jj]); sf[ks][4 + jj] = (short)f2b(sacc[2 * ks + 1][jj]); }
        uint2 v0 = *(const uint2*)(sVT + l15 * VS + 32 * ks + 4 * q4), v1 = *(const uint2*)(sVT + l15 * VS + 32 * ks + 16 + 4 * q4);
        uint4 vv = uint4{v0.x, v0.y, v1.x, v1.y}; vf[ks] = *(bf16x8*)&vv;
      }
      f32x4 num = f32x4{0.f, 0.f, 0.f, 0.f}, numC = f32x4{0.f, 0.f, 0.f, 0.f};
#pragma unroll
      for (int ks = 0; ks < 2; ks++) num = __builtin_amdgcn_mfma_f32_16x16x32_bf16(vf[ks], sf[ks], num, 0, 0, 0);
#pragma unroll
      for (int ks = 0; ks < 4; ks++) { bf16x8 cf = *(const bf16x8*)(sCT + (d * 16 + l15) * QS + ks * 32 + q4 * 8); numC = __builtin_amdgcn_mfma_f32_16x16x32_bf16(cf, qf[ks], numC, 0, 0, 0); }
      float qn = 0.f;
#pragma unroll
      for (int i = 0; i < 4; i++) { uint4 u = *(const uint4*)(sQ + rt * QS + 32 * q4 + i * 8); const float* nn = sN + d * 128 + 32 * q4 + i * 8;
        qn += blo(u.x) * nn[0] + bhi(u.x) * nn[1] + blo(u.y) * nn[2] + bhi(u.y) * nn[3] + blo(u.z) * nn[4] + bhi(u.z) * nn[5] + blo(u.w) * nn[6] + bhi(u.w) * nn[7]; }
      qn += __shfl_xor(qn, 16); qn += __shfl_xor(qn, 32);
      {
        float inter = __expf(mcur + ctt); float den = densum + inter * qn; float dn = fmaxf(fabsf(den), __expf(ctt - sBc[rt])); float inv = 1.f / dn;
        f32x4 hv;
#pragma unroll
        for (int jj = 0; jj < 4; jj++) hv[jj] = (num[jj] + inter * numC[jj]) * inv;
        int rc = (r0 - b * BT_) >> 6; bool first;
        if (d == 0) { int sp = rc < 4 ? 3 - rc : 263 - rc; first = s < sp; } else first = s < rc;
        bfr* hp = HS + (size_t)(r0 + rt) * 2048 + hh * 256 + sl * 16 + 4 * q4;
        if (!first) { uint2 u = *(const uint2*)hp; hv[0] += blo(u.x); hv[1] += bhi(u.x); hv[2] += blo(u.y); hv[3] += bhi(u.y); }
        store4b(hp, hv);
      }
      __syncthreads();
      {
        bf16x8 vw[2];
#pragma unroll
        for (int ks = 0; ks < 2; ks++)
#pragma unroll
          for (int e = 0; e < 8; e++) { int rs_ = 32 * ks + (e < 4 ? 4 * q4 + e : 16 + 4 * q4 + e - 4); vw[ks][e] = (short)f2b(b2f((bfr)vf[ks][e]) * sWg[rs_]); }
#pragma unroll
        for (int a = 0; a < 2; a++) {
          int dk = 32 * w + 16 * a + l15;
#pragma unroll
          for (int jj = 0; jj < 4; jj++) Cacc[d][a][jj] *= decay;
#pragma unroll
          for (int ks = 0; ks < 2; ks++) { bf16x8 kt;
#pragma unroll
            for (int e = 0; e < 8; e++) { int rs_ = 32 * ks + (e < 4 ? 4 * q4 + e : 16 + 4 * q4 + e - 4); kt[e] = (short)sK[rs_ * QS + dk]; }
            Cacc[d][a] = __builtin_amdgcn_mfma_f32_16x16x32_bf16(vw[ks], kt, Cacc[d][a], 0, 0, 0); }
#pragma unroll
          for (int jj = 0; jj < 4; jj++) sCT[(d * 16 + 4 * q4 + jj) * QS + dk] = f2b(Cacc[d][a][jj]);
        }
        int dk = tid & 127, hf = tid >> 7; float part = 0.f;
#pragma unroll 8
        for (int r = 0; r < 32; r++) part += sWg[32 * hf + r] * b2f(sK[(32 * hf + r) * QS + dk]);
        sNr[tid] = part;
      }
      __syncthreads();
      if (tid < 128) sN[d * 128 + tid] = decay * sN[d * 128 + tid] + sNr[tid] + sNr[128 + tid];
    }
    }
    __syncthreads();
  }
}

__device__ __forceinline__ void ph_r7_scan(const P& p, int j, int d, char* smem) {
  float* sW = (float*)smem; float* sKa = sW + 2048; float* sBe = sKa + 2048; float* sKd = sBe + 2048; float* sR = sKd + 2048; float* sV = sR + 2048; float* sY = sV + 256;
  const bfr* RK = (const bfr*)(p.ACT + A_RKVZ); const bfr* SW = (const bfr*)(p.ACT + A_SW); const bfr* AA = (const bfr*)(p.ACT + A_AA);
  float* BON = (float*)(p.ACT + A_BON); bfr* Y = p.H;
  const float* kkp = p.r7_k_k + (size_t)j * 1024; const float* kap = p.r7_k_a + (size_t)j * 1024; const float* rkp = p.r7_r_k + (size_t)j * 1024;
  const int tid = threadIdx.x, lane = tid & 63, w = tid >> 6, kp = lane & 15, rr = lane >> 4;
  const int si = tid >> 3, sc = tid & 7;
  for (int it = blockIdx.x; it < 256; it += gridDim.x) {
    const int b = it >> 7, hh = (it >> 3) & 15, rg = it & 7;
    const int col = hh * 64 + sc * 8;
    float kkc[8], kac[8], rkc[8];
#pragma unroll
    for (int e = 0; e < 8; e++) { kkc[e] = kkp[col + e]; kac[e] = kap[col + e]; rkc[e] = rkp[col + e]; }
    float s0 = 0.f, s1 = 0.f, s2 = 0.f, s3 = 0.f;
    uint4 pr, pk, pv, pw, pa;
    auto issue = [&](int blk) __attribute__((always_inline)) { int row = rowmap(d, b, blk * 32 + si); const bfr* rp = RK + (size_t)row * 4096 + col;
      pr = *(const uint4*)rp; pk = *(const uint4*)(rp + 1024); pv = *(const uint4*)(rp + 2048);
      pw = *(const uint4*)(SW + (size_t)row * 1024 + col); pa = *(const uint4*)(AA + (size_t)row * 1024 + col); };
    issue(0);
    for (int blk = 0; blk < BT_ / 32; blk++) {
      __syncthreads();
      {
        const int row = rowmap(d, b, blk * 32 + si);
        unsigned ur[4] = {pr.x, pr.y, pr.z, pr.w}, uk[4] = {pk.x, pk.y, pk.z, pk.w}, uv[4] = {pv.x, pv.y, pv.z, pv.w}, uw[4] = {pw.x, pw.y, pw.z, pw.w}, ua[4] = {pa.x, pa.y, pa.z, pa.w};
        float r8[8], k8[8], v8[8], w8[8], a8[8], kr[8];
#pragma unroll
        for (int e = 0; e < 4; e++) { r8[2 * e] = blo(ur[e]); r8[2 * e + 1] = bhi(ur[e]); k8[2 * e] = blo(uk[e]); k8[2 * e + 1] = bhi(uk[e]); v8[2 * e] = blo(uv[e]); v8[2 * e + 1] = bhi(uv[e]);
          w8[2 * e] = blo(uw[e]); w8[2 * e + 1] = bhi(uw[e]); a8[2 * e] = blo(ua[e]); a8[2 * e + 1] = bhi(ua[e]); }
        float ss = 0.f;
#pragma unroll
        for (int e = 0; e < 8; e++) { kr[e] = k8[e] * kkc[e]; ss += kr[e] * kr[e]; }
        ss += __shfl_xor(ss, 1); ss += __shfl_xor(ss, 2); ss += __shfl_xor(ss, 4);
        float inv = 1.f / fmaxf(sqrtf(ss), 1e-12f);
        float bon = 0.f; float ow[8], oka[8], obe[8], okd[8];
#pragma unroll
        for (int e = 0; e < 8; e++) { float ka = kr[e] * inv; oka[e] = ka; obe[e] = a8[e] * ka; float kd = k8[e] * (1.f + (a8[e] - 1.f) * kac[e]); okd[e] = kd; ow[e] = __expf(-w8[e]); bon += r8[e] * kd * rkc[e]; }
        bon += __shfl_xor(bon, 1); bon += __shfl_xor(bon, 2); bon += __shfl_xor(bon, 4);
        if (rg == 0 && sc == 0) BON[((size_t)d * R_ + row) * 16 + hh] = bon;
        int o = si * 64 + sc * 8;
        *(float4*)(sW + o) = float4{ow[0], ow[1], ow[2], ow[3]}; *(float4*)(sW + o + 4) = float4{ow[4], ow[5], ow[6], ow[7]};
        *(float4*)(sKa + o) = float4{oka[0], oka[1], oka[2], oka[3]}; *(float4*)(sKa + o + 4) = float4{oka[4], oka[5], oka[6], oka[7]};
        *(float4*)(sBe + o) = float4{obe[0], obe[1], obe[2], obe[3]}; *(float4*)(sBe + o + 4) = float4{obe[4], obe[5], obe[6], obe[7]};
        *(float4*)(sKd + o) = float4{okd[0], okd[1], okd[2], okd[3]}; *(float4*)(sKd + o + 4) = float4{okd[4], okd[5], okd[6], okd[7]};
        *(float4*)(sR + o) = float4{r8[0], r8[1], r8[2], r8[3]}; *(float4*)(sR + o + 4) = float4{r8[4], r8[5], r8[6], r8[7]};
        if (sc == rg) { *(float4*)(sV + si * 8) = float4{v8[0], v8[1], v8[2], v8[3]}; *(float4*)(sV + si * 8 + 4) = float4{v8[4], v8[5], v8[6], v8[7]}; }
      }
      __syncthreads();
      if (blk + 1 < BT_ / 32) issue(blk + 1);
      if (w < 2) {
#pragma unroll 8
        for (int i = 0; i < 32; i++) {
          float4 w4 = *(const float4*)(sW + i * 64 + kp * 4), ka4 = *(const float4*)(sKa + i * 64 + kp * 4), be4 = *(const float4*)(sBe + i * 64 + kp * 4);
          float4 kd4 = *(const float4*)(sKd + i * 64 + kp * 4), r4 = *(const float4*)(sR + i * 64 + kp * 4); float vv = sV[i * 8 + w * 4 + rr];
          float sa = red16((s0 * ka4.x + s1 * ka4.y) + (s2 * ka4.z + s3 * ka4.w));
          s0 = s0 * w4.x + (kd4.x * vv - sa * be4.x); s1 = s1 * w4.y + (kd4.y * vv - sa * be4.y);
          s2 = s2 * w4.z + (kd4.z * vv - sa * be4.z); s3 = s3 * w4.w + (kd4.w * vv - sa * be4.w);
          float y = red16((s0 * r4.x + s1 * r4.y) + (s2 * r4.z + s3 * r4.w));
          if (kp == 0) sY[i * 8 + w * 4 + rr] = y;
        }
      }
      __syncthreads();
      if (tid < 32) {
        int row = rowmap(d, b, blk * 32 + tid); bfr* yp = Y + (size_t)row * 1024 + hh * 64 + rg * 8; float yy[8];
#pragma unroll
        for (int e = 0; e < 8; e++) yy[e] = sY[tid * 8 + e];
        if (d == 1) { uint4 u = *(const uint4*)yp; yy[0] += blo(u.x); yy[1] += bhi(u.x); yy[2] += blo(u.y); yy[3] += bhi(u.y); yy[4] += blo(u.z); yy[5] += bhi(u.z); yy[6] += blo(u.w); yy[7] += bhi(u.w); }
        *(uint4*)yp = uint4{pk2(yy[0], yy[1]), pk2(yy[2], yy[3]), pk2(yy[4], yy[5]), pk2(yy[6], yy[7])};
      }
    }
    __syncthreads();
  }
}

__device__ __forceinline__ void run_phase(const P& p, int ph, int layer, int d, char* smem) {
  Ctx c; c.layer = layer; c.j = layer / 3; c.d = d; c.wc = layer < 3 ? 1 : 0;
  switch (ph) {
    case PH_PRE: ph_pre(p, smem); break;
    case PH_NORM: ph_norm(p, layer, smem); break;
    case PH_LRU_IN: gemm_phase<G_LruIn>(p, c, smem); break;
    case PH_LRU_CONV: ph_lru_conv(p, c.j); break;
    case PH_LRU_GATE: gemm_phase<G_LruGate>(p, c, smem); break;
    case PH_LRU_S1: ph_lru_s1(p, d); break;
    case PH_LRU_S2: ph_lru_s2(p); break;
    case PH_LRU_S3: ph_lru_s3(p, d); break;
    case PH_LRU_OUT: gemm_phase<G_LruOut>(p, c, smem); break;
    case PH_ML_IN: gemm_phase<G_MlIn>(p, c, smem); break;
    case PH_ML_SCAN: ph_ml_scan(p, c.j, smem); break;
    case PH_ML_STAT: ph_ml_stat(p); break;
    case PH_ML_Z: gemm_phase<G_MlZ>(p, c, smem); break;
    case PH_ML_OUT: gemm_phase<G_MlOut>(p, c, smem); break;
    case PH_R7_IN: gemm_phase<G_R7In>(p, c, smem); break;
    case PH_R7_UP: gemm_phase<G_R7Up>(p, c, smem); break;
    case PH_R7_SCAN: ph_r7_scan(p, c.j, d, smem); break;
    case PH_R7_FIN: ph_r7_fin(p, c.j); break;
    case PH_R7_OUT: gemm_phase<G_R7Out>(p, c, smem); break;
    case PH_FINAL: ph_final(p); break;
  }
}

#define SMEM_BYTES 73728
#if !MEGA
__global__ void __launch_bounds__(256) phase_kernel(P p, int si) {
  __shared__ __attribute__((aligned(16))) char smem[SMEM_BYTES];
  run_phase(p, p.sched[si * 3], p.sched[si * 3 + 1], p.sched[si * 3 + 2], smem);
}
#else
__global__ void __launch_bounds__(256) mega_kernel(P p) {
  __shared__ __attribute__((aligned(16))) char smem[SMEM_BYTES];
  cg::grid_group grid = cg::this_grid();
  for (int si = 0; si < p.nsched; si++) {
    run_phase(p, p.sched[si * 3], p.sched[si * 3 + 1], p.sched[si * 3 + 2], smem);
    if (si + 1 < p.nsched) grid.sync();
  }
}
#endif

extern "C" void kernel_launch(void* const* d_in, const int* in_sizes, int n_in, void* d_out, int out_size, void* d_ws, size_t ws_size, hipStream_t stream) {
  P p; memset(&p, 0, sizeof(p));
  const float** f = (const float**)&p;
  for (int i = 0; i < 33; i++) f[i] = (const float*)d_in[i];
  char* ws = (char*)d_ws;
  p.Xx = (float*)d_out; p.Xc = (float*)(ws + OFF_XC); p.MOD = (float*)(ws + OFF_MOD); p.W = (bfr*)(ws + OFF_W); p.H = (bfr*)(ws + OFF_H); p.ACT = ws + OFF_ACT;
  int n = 0;
  auto add = [&](int ph, int layer, int d) { p.sched[n * 3] = ph; p.sched[n * 3 + 1] = layer; p.sched[n * 3 + 2] = d; n++; };
  add(PH_PRE, 0, 0);
  for (int l = 0; l < 4; l++) {
    add(PH_NORM, l, 0);
    int kind = l % 3;
    if (kind == 0) { add(PH_LRU_IN, l, 0); add(PH_LRU_CONV, l, 0);
      for (int d = 0; d < 2; d++) { add(PH_LRU_GATE, l, d); add(PH_LRU_S1, l, d); add(PH_LRU_S2, l, d); add(PH_LRU_S3, l, d); }
      add(PH_LRU_OUT, l, 0); }
    else if (kind == 1) { add(PH_ML_IN, l, 0); add(PH_ML_SCAN, l, 0); add(PH_ML_STAT, l, 0); add(PH_ML_Z, l, 0); add(PH_ML_OUT, l, 0); }
    else { add(PH_R7_IN, l, 0); for (int d = 0; d < 2; d++) { add(PH_R7_UP, l, d); add(PH_R7_SCAN, l, d); } add(PH_R7_FIN, l, 0); add(PH_R7_OUT, l, 0); }
  }
  add(PH_FINAL, 0, 0);
  p.nsched = n;
  if (ws_size < WS_NEED) fprintf(stderr, "workspace too small: %zu < %llu\n", ws_size, (unsigned long long)WS_NEED);
#if MEGA
  static int grid_blocks = 0;
  if (!grid_blocks) { int dev = 0, cus = 0, per = 0; hipGetDevice(&dev); hipDeviceGetAttribute(&cus, hipDeviceAttributeMultiprocessorCount, dev);
    hipOccupancyMaxActiveBlocksPerMultiprocessor(&per, mega_kernel, 256, 0); if (per > 2) per = 2; grid_blocks = cus * per; }
  void* args[] = {&p};
  hipError_t e = hipLaunchCooperativeKernel((void*)mega_kernel, dim3(grid_blocks), dim3(256), args, 0, stream);
  if (e != hipSuccess) fprintf(stderr, "cooperative launch failed: %s (grid %d)\n", hipGetErrorString(e), grid_blocks);
#else
  for (int si = 0; si < n; si++) phase_kernel<<<512, 256, 0, stream>>>(p, si);
#endif
}
```

```cpp
#include <hip/hip_runtime.h>
#include <hip/hip_bf16.h>
#include <hip/hip_cooperative_groups.h>
#include <cstdio>
#include <cstring>
#include <type_traits>
namespace cg = cooperative_groups;

#ifndef MEGA
#define MEGA 1
#endif

typedef unsigned short bfr;
using bf16x8 = __attribute__((ext_vector_type(8))) short;
using f32x4 = __attribute__((ext_vector_type(4))) float;

#define R_ 33280
#define BT_ 16640
#define NCH_ 260

#define OFF_XC 0ull
#define OFF_MOD 2097152ull
#define OFF_W 2244608ull
#define OFF_H 24264704ull
#define OFF_ACT 92422144ull
#define A_Z 0ull
#define A_UC 85196800ull
#define A_AB 170393600ull
#define A_U 170393600ull
#define A_HF 340787200ull
#define A_AGG 425984000ull
#define A_CAR 431308800ull
#define A_QKV 0ull
#define A_GATE 272629760ull
#define A_HS 276889600ull
#define A_RSTD 413204480ull
#define A_RKVZ 0ull
#define A_WM 272629760ull
#define A_AM 281149440ull
#define A_SW 289669120ull
#define A_AA 357826560ull
#define A_BON 425984000ull
#define WS_NEED (OFF_ACT + 434000000ull)

#define WL_GATE (2560 * 1024)
#define WL_OUT (WL_GATE + 1310720)
#define WM_Z (4224 * 1024)
#define WM_OUT (WM_Z + 2048 * 1024)
#define WR_UP (4352 * 2048)
#define WR_OUT (WR_UP + 262144)

enum { PH_PRE = 0, PH_NORM, PH_LRU_IN, PH_LRU_CONV, PH_LRU_GATE, PH_LRU_S1, PH_LRU_S2, PH_LRU_S3, PH_LRU_OUT,
       PH_ML_IN, PH_ML_SCAN, PH_ML_STAT, PH_ML_Z, PH_ML_OUT,
       PH_R7_IN, PH_R7_UP, PH_R7_SCAN, PH_R7_FIN, PH_R7_OUT, PH_FINAL };

struct P {
  const float *x, *c, *ctx, *c_ctx, *norm_g, *mod_w, *mod_b, *final_g;
  const float *lru_w_in, *lru_conv_w, *lru_conv_b, *lru_gate_w, *lru_gate_b, *lru_lam, *lru_w_out;
  const float *ml_w_in, *ml_gate_b, *ml_norm_g, *ml_w_out;
  const float *r7_mu, *r7_w_rkvz, *r7_w0, *r7_w1, *r7_w2, *r7_a0, *r7_a1, *r7_a2, *r7_k_k, *r7_k_a, *r7_r_k, *r7_ln_g, *r7_ln_b, *r7_w_out;
  float* Xx; float* Xc; float* MOD; bfr* W; bfr* H; char* ACT;
  int nsched; int pad_;
  int sched[64 * 3];
};
struct Ctx { int layer, j, d, wc; };

__device__ __forceinline__ bfr f2b(float f) { unsigned u = __float_as_uint(f); u += 0x7fffu + ((u >> 16) & 1u); return (bfr)(u >> 16); }
__device__ __forceinline__ float b2f(bfr b) { return __uint_as_float(((unsigned)b) << 16); }
__device__ __forceinline__ unsigned pk2(float a, float b) { return (unsigned)f2b(a) | (((unsigned)f2b(b)) << 16); }
__device__ __forceinline__ float blo(unsigned u) { return __uint_as_float(u << 16); }
__device__ __forceinline__ float bhi(unsigned u) { return __uint_as_float(u & 0xffff0000u); }
__device__ __forceinline__ void store4b(bfr* dst, f32x4 v) { uint2 u; u.x = pk2(v[0], v[1]); u.y = pk2(v[2], v[3]); *(uint2*)dst = u; }
__device__ __forceinline__ float sigm(float x) { return 1.f / (1.f + __expf(-x)); }
__device__ __forceinline__ float siluf(float x) { return x * sigm(x); }
__device__ __forceinline__ float softplusf(float x) { return x > 20.f ? x : log1pf(expf(x)); }
__device__ __forceinline__ int rowmap(int d, int b, int pp) { int o = d == 0 ? pp : (pp < 256 ? 255 - pp : 16895 - pp); return b * BT_ + o; }
__device__ __forceinline__ float* xrowp(const P& p, int row, int& mi) {
  int b = row / BT_, o = row - b * BT_;
  if (o < 256) { mi = 2; return p.Xc + (size_t)(b * 256 + o) * 1024; }
  mi = b; return p.Xx + (size_t)(b * 16384 + o - 256) * 1024;
}
__device__ __forceinline__ float wsum(float v) { for (int o = 32; o; o >>= 1) v += __shfl_xor(v, o); return v; }
template <int CTRL> __device__ __forceinline__ float dppf(float x) {
  return __int_as_float(__builtin_amdgcn_update_dpp(0, __float_as_int(x), CTRL, 0xf, 0xf, true));
}
__device__ __forceinline__ float red16(float x) {
  x += dppf<0xB1>(x); x += dppf<0x4E>(x); x += dppf<0x141>(x); x += dppf<0x140>(x); return x;
}

template <class F> __device__ __forceinline__ void prep_tile(bfr* dst, int K, int tn, int tk, F get, float* sm) {
  int tid = threadIdx.x;
  for (int i = 0; i < 16; i++) { int kk = (tid >> 6) + 4 * i, nn = tid & 63; sm[kk * 65 + nn] = get(tk * 64 + kk, tn * 64 + nn); }
  __syncthreads();
  for (int i = 0; i < 16; i++) { int nn = (tid >> 6) + 4 * i, kk = tid & 63; dst[(size_t)(tn * 64 + nn) * K + tk * 64 + kk] = f2b(sm[kk * 65 + nn]); }
  __syncthreads();
}
__device__ __forceinline__ int prep_count(int layer) { int kind = layer % 3; return kind == 0 ? (640 + 320 + 320) : kind == 1 ? (1056 + 512 + 512) : (2176 + 64 + 256); }
__device__ __forceinline__ void prep_item(const P& p, int layer, int it, float* sm) {
  int kind = layer % 3, j = layer / 3;
  if (kind == 0) {
    if (it < 640) { int tn = it / 16, tk = it % 16; const float* s = p.lru_w_in + (size_t)j * 1024 * 2560;
      prep_tile(p.W, 1024, tn, tk, [=](int k, int n) { return s[(size_t)k * 2560 + n]; }, sm); return; }
    it -= 640;
    if (it < 320) { int d = it / 160, r = it % 160, tn = r / 2, tk = r % 2; const float* s = p.lru_gate_w + (size_t)(j * 2 + d) * 2 * 10 * 16384;
      prep_tile(p.W + WL_GATE + d * 655360, 128, tn, tk, [=](int k, int n) {
        int nt = n >> 7, blk = nt >> 1, sub = nt & 1, jj = n & 127, wn = jj >> 6, rr = jj & 63, g = rr >> 5, c = rr & 31;
        int kch = sub * 64 + wn * 32 + c; return s[((size_t)(g * 10 + blk) * 128 + k) * 128 + kch]; }, sm); return; }
    it -= 320;
    { int tn = it / 20, tk = it % 20; const float* s = p.lru_w_out + (size_t)j * 1280 * 1024;
      prep_tile(p.W + WL_OUT, 1280, tn, tk, [=](int k, int n) { return s[(size_t)k * 1024 + n]; }, sm); return; }
  } else if (kind == 1) {
    const float* s = p.ml_w_in + (size_t)j * 1024 * 6176;
    if (it < 1056) { int tn = it / 16, tk = it % 16;
      prep_tile(p.W, 1024, tn, tk, [=](int k, int n) {
        if (n < 4096) { float v = s[(size_t)k * 6176 + n]; return (n >= 1024 && n < 2048) ? v * 0.08838834764831845f : v; }
        if (n < 4128) return s[(size_t)k * 6176 + 6144 + (n - 4096)];
        return 0.f; }, sm); return; }
    it -= 1056;
    if (it < 512) { int tn = it / 16, tk = it % 16;
      prep_tile(p.W + WM_Z, 1024, tn, tk, [=](int k, int n) { return s[(size_t)k * 6176 + 4096 + n]; }, sm); return; }
    it -= 512;
    { int tn = it / 32, tk = it % 32; const float* so = p.ml_w_out + (size_t)j * 2048 * 1024;
      prep_tile(p.W + WM_OUT, 2048, tn, tk, [=](int k, int n) { return so[(size_t)k * 1024 + n]; }, sm); return; }
  } else {
    if (it < 2176) { int tn = it / 32, tk = it % 32;
      const float* mu = p.r7_mu + (size_t)j * 6 * 1024; const float* wr = p.r7_w_rkvz + (size_t)j * 4 * 1024 * 1024;
      const float* w1 = p.r7_w1 + (size_t)j * 2 * 1024 * 64; const float* a1 = p.r7_a1 + (size_t)j * 2 * 1024 * 64;
      prep_tile(p.W, 2048, tn, tk, [=](int k, int n) {
        int kk = k & 1023; float v, m;
        if (n < 4096) { int g = n >> 10, e = n & 1023; m = mu[g * 1024 + kk]; v = wr[((size_t)g * 1024 + kk) * 1024 + e]; }
        else if (n < 4224) { int xx = (n - 4096) >> 6, rr = (n - 4096) & 63; m = mu[4 * 1024 + kk]; v = w1[((size_t)xx * 1024 + kk) * 64 + rr]; }
        else { int xx = (n - 4224) >> 6, rr = (n - 4224) & 63; m = mu[5 * 1024 + kk]; v = a1[((size_t)xx * 1024 + kk) * 64 + rr]; }
        return (k < 1024 ? (1.f - m) : m) * v; }, sm); return; }
    it -= 2176;
    if (it < 64) { int u = it / 16, tn = it % 16; const float* s = (u < 2 ? p.r7_w2 : p.r7_a2) + (size_t)(j * 2 + (u & 1)) * 64 * 1024;
      prep_tile(p.W + WR_UP + u * 65536, 64, tn, 0, [=](int k, int n) { return s[(size_t)k * 1024 + n]; }, sm); return; }
    it -= 64;
    { int tn = it / 16, tk = it % 16; const float* s = p.r7_w_out + (size_t)j * 1024 * 1024;
      prep_tile(p.W + WR_OUT, 1024, tn, tk, [=](int k, int n) { return s[(size_t)k * 1024 + n]; }, sm); return; }
  }
}

#define LDSS 72
template <class G> __device__ __forceinline__ void gemm_tile(const P& p, const Ctx& c, int mt, int nt, char* smem) {
  const int tid = threadIdx.x, lane = tid & 63, wid = tid >> 6, wm = wid & 1, wn = wid >> 1;
  bfr* sA = (bfr*)smem; bfr* sB = sA + 2 * 128 * LDSS;
  f32x4 acc[4][4];
  for (int a = 0; a < 4; a++) for (int b = 0; b < 4; b++) acc[a][b] = f32x4{0.f, 0.f, 0.f, 0.f};
  const int lr = tid >> 3, lc = tid & 7;
  uint4 ra[4], rb[4];
  auto gload = [&](int kt) __attribute__((always_inline)) {
#pragma unroll
    for (int i = 0; i < 4; i++) {
      const bfr* pa = G::aptr(p, c, mt * 128 + lr + 32 * i, kt, nt);
      ra[i] = pa ? *(const uint4*)(pa + lc * 8) : uint4{0u, 0u, 0u, 0u};
      rb[i] = *(const uint4*)(G::bptr(p, c, nt * 128 + lr + 32 * i, kt) + lc * 8);
    }
  };
  auto sstore = [&](int buf) __attribute__((always_inline)) {
#pragma unroll
    for (int i = 0; i < 4; i++) {
      *(uint4*)(sA + (buf * 128 + lr + 32 * i) * LDSS + lc * 8) = ra[i];
      *(uint4*)(sB + (buf * 128 + lr + 32 * i) * LDSS + lc * 8) = rb[i];
    }
  };
  gload(0); sstore(0); __syncthreads();
  for (int kt = 0; kt < G::KT; kt++) {
    const int buf = kt & 1;
    if (kt + 1 < G::KT) gload(kt + 1);
#pragma unroll
    for (int ks = 0; ks < 2; ks++) {
      bf16x8 af[4], bf[4];
#pragma unroll
      for (int i = 0; i < 4; i++) {
        af[i] = *(const bf16x8*)(sA + (buf * 128 + wm * 64 + i * 16 + (lane & 15)) * LDSS + ks * 32 + (lane >> 4) * 8);
        bf[i] = *(const bf16x8*)(sB + (buf * 128 + wn * 64 + i * 16 + (lane & 15)) * LDSS + ks * 32 + (lane >> 4) * 8);
      }
#pragma unroll
      for (int n = 0; n < 4; n++)
#pragma unroll
        for (int m = 0; m < 4; m++) acc[n][m] = __builtin_amdgcn_mfma_f32_16x16x32_bf16(bf[n], af[m], acc[n][m], 0, 0, 0);
    }
    if (kt + 1 < G::KT) sstore(buf ^ 1);
    __syncthreads();
  }
  G::epi(p, c, acc, mt * 128 + wm * 64, nt * 128 + wn * 64, lane);
}

__device__ __forceinline__ void epi_resid(const P& p, const Ctx& c, f32x4 (&acc)[4][4], int m0, int n0, int lane) {
#pragma unroll
  for (int mi = 0; mi < 4; mi++) {
    int row = m0 + mi * 16 + (lane & 15); int mo; float* xr = xrowp(p, row, mo);
    if (mo == 2 && !c.wc) continue;
    const float* g = p.MOD + (size_t)(c.layer * 3 + mo) * 3072 + 2048;
#pragma unroll
    for (int ni = 0; ni < 4; ni++) {
      int n = n0 + ni * 16 + (lane >> 4) * 4;
      float4 xv = *(float4*)(xr + n); float4 gg = *(const float4*)(g + n);
      xv.x += gg.x * acc[ni][mi][0]; xv.y += gg.y * acc[ni][mi][1]; xv.z += gg.z * acc[ni][mi][2]; xv.w += gg.w * acc[ni][mi][3];
      *(float4*)(xr + n) = xv;
    }
  }
}

struct G_LruIn { static constexpr int KT = 16, NT = 20;
  static __device__ __forceinline__ const bfr* aptr(const P& p, const Ctx& c, int row, int kt, int nt) { return p.H + (size_t)row * 1024 + kt * 64; }
  static __device__ __forceinline__ const bfr* bptr(const P& p, const Ctx& c, int n, int kt) { return p.W + (size_t)n * 1024 + kt * 64; }
  static __device__ __forceinline__ void epi(const P& p, const Ctx& c, f32x4 (&acc)[4][4], int m0, int n0, int lane) {
    bfr* U = (bfr*)(p.ACT + A_U); bfr* Z = (bfr*)(p.ACT + A_Z);
#pragma unroll
    for (int ni = 0; ni < 4; ni++)
#pragma unroll
      for (int mi = 0; mi < 4; mi++) {
        int row = m0 + mi * 16 + (lane & 15), n = n0 + ni * 16 + (lane >> 4) * 4;
        bfr* dst = n < 1280 ? U + (size_t)row * 1280 + n : Z + (size_t)row * 1280 + (n - 1280);
        store4b(dst, acc[ni][mi]);
      }
  } };
struct G_LruGate { static constexpr int KT = 2, NT = 20;
  static __device__ __forceinline__ const bfr* aptr(const P& p, const Ctx& c, int row, int kt, int nt) { return (const bfr*)(p.ACT + A_UC) + (size_t)row * 1280 + (nt >> 1) * 128 + kt * 64; }
  static __device__ __forceinline__ const bfr* bptr(const P& p, const Ctx& c, int n, int kt) { return p.W + WL_GATE + c.d * 655360 + (size_t)n * 128 + kt * 64; }
  static __device__ __forceinline__ void epi(const P& p, const Ctx& c, f32x4 (&acc)[4][4], int m0, int n0, int lane) {
    const bfr* UC = (const bfr*)(p.ACT + A_UC); unsigned* AB = (unsigned*)(p.ACT + A_AB);
    const float* gb = p.lru_gate_b + (size_t)(c.j * 2 + c.d) * 2 * 1280; const float* lam = p.lru_lam + (size_t)(c.j * 2 + c.d) * 1280;
    int chb = (n0 >> 6) * 32;
#pragma unroll
    for (int ni = 0; ni < 2; ni++) {
      int ch = chb + ni * 16 + (lane >> 4) * 4;
      float cl[4], br[4], bi[4];
#pragma unroll
      for (int q = 0; q < 4; q++) { cl[q] = 8.f * softplusf(-lam[ch + q]); br[q] = gb[ch + q]; bi[q] = gb[1280 + ch + q]; }
#pragma unroll
      for (int mi = 0; mi < 4; mi++) {
        int row = m0 + mi * 16 + (lane & 15);
        uint2 u = *(const uint2*)(UC + (size_t)row * 1280 + ch);
        float uc[4] = {blo(u.x), bhi(u.x), blo(u.y), bhi(u.y)};
        unsigned o[4];
#pragma unroll
        for (int q = 0; q < 4; q++) {
          float r = sigm(acc[ni][mi][q] + br[q]), ig = sigm(acc[ni + 2][mi][q] + bi[q]);
          float la = -cl[q] * r; float oma = -expm1f(la); float bb = sqrtf(-expm1f(2.f * la)) * ig * uc[q];
          o[q] = (((unsigned)f2b(oma)) << 16) | (unsigned)f2b(bb);
        }
        *(uint4*)(AB + (size_t)row * 1280 + ch) = uint4{o[0], o[1], o[2], o[3]};
      }
    }
  } };
struct G_LruOut { static constexpr int KT = 20, NT = 8;
  static __device__ __forceinline__ const bfr* aptr(const P& p, const Ctx& c, int row, int kt, int nt) { return (const bfr*)(p.ACT + A_Z) + (size_t)row * 1280 + kt * 64; }
  static __device__ __forceinline__ const bfr* bptr(const P& p, const Ctx& c, int n, int kt) { return p.W + WL_OUT + (size_t)n * 1280 + kt * 64; }
  static __device__ __forceinline__ void epi(const P& p, const Ctx& c, f32x4 (&acc)[4][4], int m0, int n0, int lane) { epi_resid(p, c, acc, m0, n0, lane); } };
struct G_MlIn { static constexpr int KT = 16, NT = 33;
  static __device__ __forceinline__ const bfr* aptr(const P& p, const Ctx& c, int row, int kt, int nt) { return p.H + (size_t)row * 1024 + kt * 64; }
  static __device__ __forceinline__ const bfr* bptr(const P& p, const Ctx& c, int n, int kt) { return p.W + (size_t)n * 1024 + kt * 64; }
  static __device__ __forceinline__ void epi(const P& p, const Ctx& c, f32x4 (&acc)[4][4], int m0, int n0, int lane) {
    bfr* QKV = (bfr*)(p.ACT + A_QKV); float* GT = (float*)(p.ACT + A_GATE);
#pragma unroll
    for (int ni = 0; ni < 4; ni++)
#pragma unroll
      for (int mi = 0; mi < 4; mi++) {
        int row = m0 + mi * 16 + (lane & 15), n = n0 + ni * 16 + (lane >> 4) * 4;
        if (n < 4096) store4b(QKV + (size_t)row * 4096 + n, acc[ni][mi]);
        else if (n < 4128) *(float4*)(GT + (size_t)row * 32 + (n - 4096)) = float4{acc[ni][mi][0], acc[ni][mi][1], acc[ni][mi][2], acc[ni][mi][3]};
      }
  } };
struct G_MlZ { static constexpr int KT = 16, NT = 16;
  static __device__ __forceinline__ const bfr* aptr(const P& p, const Ctx& c, int row, int kt, int nt) { return p.H + (size_t)row * 1024 + kt * 64; }
  static __device__ __forceinline__ const bfr* bptr(const P& p, const Ctx& c, int n, int kt) { return p.W + WM_Z + (size_t)n * 1024 + kt * 64; }
  static __device__ __forceinline__ void epi(const P& p, const Ctx& c, f32x4 (&acc)[4][4], int m0, int n0, int lane) {
    bfr* HS = (bfr*)(p.ACT + A_HS); const float* RS = (const float*)(p.ACT + A_RSTD); const float* ng = p.ml_norm_g + (size_t)c.j * 2048;
#pragma unroll
    for (int ni = 0; ni < 4; ni++)
#pragma unroll
      for (int mi = 0; mi < 4; mi++) {
        int row = m0 + mi * 16 + (lane & 15), n = n0 + ni * 16 + (lane >> 4) * 4;
        bfr* hp = HS + (size_t)row * 2048 + n; uint2 u = *(const uint2*)hp; float rs = RS[(size_t)row * 8 + (n >> 8)];
        float4 g4 = *(const float4*)(ng + n);
        f32x4 o;
        o[0] = blo(u.x) * rs * g4.x * siluf(acc[ni][mi][0]); o[1] = bhi(u.x) * rs * g4.y * siluf(acc[ni][mi][1]);
        o[2] = blo(u.y) * rs * g4.z * siluf(acc[ni][mi][2]); o[3] = bhi(u.y) * rs * g4.w * siluf(acc[ni][mi][3]);
        store4b(hp, o);
      }
  } };
struct G_MlOut { static constexpr int KT = 32, NT = 8;
  static __device__ __forceinline__ const bfr* aptr(const P& p, const Ctx& c, int row, int kt, int nt) { return (const bfr*)(p.ACT + A_HS) + (size_t)row * 2048 + kt * 64; }
  static __device__ __forceinline__ const bfr* bptr(const P& p, const Ctx& c, int n, int kt) { return p.W + WM_OUT + (size_t)n * 2048 + kt * 64; }
  static __device__ __forceinline__ void epi(const P& p, const Ctx& c, f32x4 (&acc)[4][4], int m0, int n0, int lane) { epi_resid(p, c, acc, m0, n0, lane); } };
struct G_R7In { static constexpr int KT = 32, NT = 34;
  static __device__ __forceinline__ const bfr* aptr(const P& p, const Ctx& c, int row, int kt, int nt) {
    if (kt < 16) return p.H + (size_t)row * 1024 + kt * 64;
    int q = (kt - 16) >> 2; int b = row / BT_, o = row - b * BT_; int nr;
    if (o < 256) { if (q < 2) { if (o < 1) return nullptr; nr = row - 1; } else { if (o >= 255) return nullptr; nr = row + 1; } }
    else { int t = o - 256, col = t & 63, gr = t >> 6;
      if (q == 0) { if (col == 0) return nullptr; nr = row - 1; }
      else if (q == 1) { if (col == 63) return nullptr; nr = row + 1; }
      else if (q == 2) { if (gr == 0) return nullptr; nr = row - 64; }
      else { if (gr == 255) return nullptr; nr = row + 64; } }
    return p.H + (size_t)nr * 1024 + (kt - 16) * 64; }
  static __device__ __forceinline__ const bfr* bptr(const P& p, const Ctx& c, int n, int kt) { return p.W + (size_t)n * 2048 + kt * 64; }
  static __device__ __forceinline__ void epi(const P& p, const Ctx& c, f32x4 (&acc)[4][4], int m0, int n0, int lane) {
    bfr* RK = (bfr*)(p.ACT + A_RKVZ); bfr* WMb = (bfr*)(p.ACT + A_WM); bfr* AMb = (bfr*)(p.ACT + A_AM);
#pragma unroll
    for (int ni = 0; ni < 4; ni++)
#pragma unroll
      for (int mi = 0; mi < 4; mi++) {
        int row = m0 + mi * 16 + (lane & 15), n = n0 + ni * 16 + (lane >> 4) * 4;
        if (n < 4096) store4b(RK + (size_t)row * 4096 + n, acc[ni][mi]);
        else if (n < 4224) { f32x4 t;
#pragma unroll
          for (int q = 0; q < 4; q++) t[q] = tanhf(acc[ni][mi][q]); store4b(WMb + (size_t)row * 128 + (n - 4096), t); }
        else store4b(AMb + (size_t)row * 128 + (n - 4224), acc[ni][mi]);
      }
  } };
struct G_R7Up { static constexpr int KT = 1, NT = 16;
  static __device__ __forceinline__ const bfr* aptr(const P& p, const Ctx& c, int row, int kt, int nt) { return (const bfr*)(p.ACT + (nt < 8 ? A_WM : A_AM)) + (size_t)row * 128 + c.d * 64; }
  static __device__ __forceinline__ const bfr* bptr(const P& p, const Ctx& c, int n, int kt) { return n < 1024 ? p.W + WR_UP + c.d * 65536 + (size_t)n * 64 : p.W + WR_UP + (2 + c.d) * 65536 + (size_t)(n - 1024) * 64; }
  static __device__ __forceinline__ void epi(const P& p, const Ctx& c, f32x4 (&acc)[4][4], int m0, int n0, int lane) {
    bfr* SW = (bfr*)(p.ACT + A_SW); bfr* AA = (bfr*)(p.ACT + A_AA);
    const float* w0 = p.r7_w0 + (size_t)(c.j * 2 + c.d) * 1024; const float* a0 = p.r7_a0 + (size_t)(c.j * 2 + c.d) * 1024;
#pragma unroll
    for (int ni = 0; ni < 4; ni++)
#pragma unroll
      for (int mi = 0; mi < 4; mi++) {
        int row = m0 + mi * 16 + (lane & 15), n = n0 + ni * 16 + (lane >> 4) * 4; f32x4 t;
        if (n < 1024) {
#pragma unroll
          for (int q = 0; q < 4; q++) t[q] = 0.6065306597126334f * sigm(w0[n + q] + acc[ni][mi][q]); store4b(SW + (size_t)row * 1024 + n, t); }
        else { int e = n - 1024;
#pragma unroll
          for (int q = 0; q < 4; q++) t[q] = sigm(a0[e + q] + acc[ni][mi][q]); store4b(AA + (size_t)row * 1024 + e, t); }
      }
  } };
struct G_R7Out { static constexpr int KT = 16, NT = 8;
  static __device__ __forceinline__ const bfr* aptr(const P& p, const Ctx& c, int row, int kt, int nt) { return p.H + (size_t)row * 1024 + kt * 64; }
  static __device__ __forceinline__ const bfr* bptr(const P& p, const Ctx& c, int n, int kt) { return p.W + WR_OUT + (size_t)n * 1024 + kt * 64; }
  static __device__ __forceinline__ void epi(const P& p, const Ctx& c, f32x4 (&acc)[4][4], int m0, int n0, int lane) { epi_resid(p, c, acc, m0, n0, lane); } };

template <class G> __device__ __forceinline__ void gemm_phase(const P& p, const Ctx& c, char* smem) {
  const int total = 260 * G::NT;
  for (int it = blockIdx.x; it < total; it += gridDim.x) gemm_tile<G>(p, c, it / G::NT, it % G::NT, smem);
}

__device__ __forceinline__ void ph_pre(const P& p, char* smem) {
  float* sm = (float*)smem; const int tid = threadIdx.x;
  const int nprep = prep_count(0), ngemv = 192, ncopy = 8320;
  for (int it = blockIdx.x; it < nprep + ngemv + ncopy; it += gridDim.x) {
    if (it < nprep) { prep_item(p, 0, it, sm); continue; }
    int i2 = it - nprep;
    if (i2 < ngemv) {
      int l = i2 / 48, cgp = i2 % 48;
      for (int i = tid; i < 3072; i += 256) { int cnd = i >> 10, k = i & 1023; float v = cnd == 0 ? p.c[k] : cnd == 1 ? p.c[1024 + k] : p.c_ctx[k]; sm[i] = siluf(v); }
      __syncthreads();
      int kq = tid >> 6, col = cgp * 64 + (tid & 63); const float* w = p.mod_w + (size_t)l * 1024 * 3072 + col;
      float a0 = 0.f, a1 = 0.f, a2 = 0.f;
      for (int k = kq * 256; k < kq * 256 + 256; k++) { float wv = w[(size_t)k * 3072]; a0 += sm[k] * wv; a1 += sm[1024 + k] * wv; a2 += sm[2048 + k] * wv; }
      float* red = sm + 3072; red[tid * 3] = a0; red[tid * 3 + 1] = a1; red[tid * 3 + 2] = a2;
      __syncthreads();
      if (tid < 64) { float bias = p.mod_b[(size_t)l * 3072 + col];
        for (int cnd = 0; cnd < 3; cnd++) { float s = bias; for (int q = 0; q < 4; q++) s += red[(q * 64 + tid) * 3 + cnd]; p.MOD[(size_t)(l * 3 + cnd) * 3072 + col] = s; } }
      __syncthreads();
      continue;
    }
    i2 -= ngemv;
    for (int q = 0; q < 4; q++) { int idx = i2 * 1024 + q * 256 + tid; int row = idx >> 8, c4 = idx & 255; int b = row / BT_, o = row - b * BT_;
      if (o < 256) ((float4*)p.Xc)[(size_t)(b * 256 + o) * 256 + c4] = ((const float4*)p.ctx)[(size_t)(b * 256 + o) * 256 + c4];
      else ((float4*)p.Xx)[(size_t)(b * 16384 + o - 256) * 256 + c4] = ((const float4*)p.x)[(size_t)(b * 16384 + o - 256) * 256 + c4]; }
  }
}
__device__ __forceinline__ void ph_norm(const P& p, int layer, char* smem) {
  const int tid = threadIdx.x, lane = tid & 63, wid = tid >> 6;
  const int nprep = layer > 0 ? prep_count(layer) : 0; const int kind = layer % 3;
  const int nzero = kind == 1 ? 8320 : 0;
  (void)nzero;
  for (int it = blockIdx.x; it < nprep + 8320; it += gridDim.x) {
    if (it < nprep) { prep_item(p, layer, it, (float*)smem); continue; }
    int row = (it - nprep) * 4 + wid; int mo; const float* xr = xrowp(p, row, mo);
    float4 v[4]; float ss = 0.f;
#pragma unroll
    for (int i = 0; i < 4; i++) { v[i] = *(const float4*)(xr + lane * 4 + 256 * i); ss += v[i].x * v[i].x + v[i].y * v[i].y + v[i].z * v[i].z + v[i].w * v[i].w; }
    ss = wsum(ss); float rs = rsqrtf(ss * (1.f / 1024.f) + 1e-6f);
    const float* g = p.norm_g + (size_t)layer * 1024; const float* md = p.MOD + (size_t)(layer * 3 + mo) * 3072;
#pragma unroll
    for (int i = 0; i < 4; i++) { int cidx = lane * 4 + 256 * i; float4 gg = *(const float4*)(g + cidx), sh = *(const float4*)(md + cidx), sc = *(const float4*)(md + 1024 + cidx);
      f32x4 o; o[0] = v[i].x * rs * gg.x * (1.f + sc.x) + sh.x; o[1] = v[i].y * rs * gg.y * (1.f + sc.y) + sh.y; o[2] = v[i].z * rs * gg.z * (1.f + sc.z) + sh.z; o[3] = v[i].w * rs * gg.w * (1.f + sc.w) + sh.w;
      store4b(p.H + (size_t)row * 1024 + cidx, o); }
  }
}
__device__ __forceinline__ void ph_final(const P& p) {
  const int lane = threadIdx.x & 63, wid = threadIdx.x >> 6;
  for (int it = blockIdx.x; it < 8192; it += gridDim.x) {
    float* xr = p.Xx + (size_t)(it * 4 + wid) * 1024; float4 v[4]; float ss = 0.f;
#pragma unroll
    for (int i = 0; i < 4; i++) { v[i] = *(const float4*)(xr + lane * 4 + 256 * i); ss += v[i].x * v[i].x + v[i].y * v[i].y + v[i].z * v[i].z + v[i].w * v[i].w; }
    ss = wsum(ss); float rs = rsqrtf(ss * (1.f / 1024.f) + 1e-6f);
#pragma unroll
    for (int i = 0; i < 4; i++) { int cidx = lane * 4 + 256 * i; float4 gg = *(const float4*)(p.final_g + cidx);
      *(float4*)(xr + cidx) = float4{v[i].x * rs * gg.x, v[i].y * rs * gg.y, v[i].z * rs * gg.z, v[i].w * rs * gg.w}; }
  }
}
__device__ __forceinline__ void ph_lru_conv(const P& p, int j) {
  const bfr* U = (const bfr*)(p.ACT + A_U); bfr* UC = (bfr*)(p.ACT + A_UC);
  const float* cw = p.lru_conv_w + (size_t)j * 4 * 1280; const float* cb = p.lru_conv_b + (size_t)j * 1280;
  for (int it = blockIdx.x; it < 20800; it += gridDim.x) {
    int idx = it * 256 + threadIdx.x; int row = idx / 160, cgp = idx % 160, ch = cgp * 8;
    int b = row / BT_, o = row - b * BT_; int s0 = o < 256 ? 0 : 256, e0 = o < 256 ? 256 : BT_;
    float acc[8];
#pragma unroll
    for (int e = 0; e < 8; e++) acc[e] = cb[ch + e];
#pragma unroll
    for (int t = 0; t < 4; t++) { int oo = o + t - 2; if (oo < s0 || oo >= e0) continue;
      uint4 u = *(const uint4*)(U + (size_t)(row + t - 2) * 1280 + ch); const float* w = cw + t * 1280 + ch;
      acc[0] += w[0] * blo(u.x); acc[1] += w[1] * bhi(u.x); acc[2] += w[2] * blo(u.y); acc[3] += w[3] * bhi(u.y);
      acc[4] += w[4] * blo(u.z); acc[5] += w[5] * bhi(u.z); acc[6] += w[6] * blo(u.w); acc[7] += w[7] * bhi(u.w); }
    *(uint4*)(UC + (size_t)row * 1280 + ch) = uint4{pk2(acc[0], acc[1]), pk2(acc[2], acc[3]), pk2(acc[4], acc[5]), pk2(acc[6], acc[7])};
  }
}
__device__ __forceinline__ void ph_lru_s1(const P& p, int d) {
  const unsigned* AB = (const unsigned*)(p.ACT + A_AB); float2* AGG = (float2*)(p.ACT + A_AGG);
  for (int it = blockIdx.x; it < 2600; it += gridDim.x) {
    int b = it / 1300, r = it % 1300, cc = r / 5, ch = (r % 5) * 256 + threadIdx.x;
    float Pp = 1.f, Q = 0.f;
#pragma unroll 8
    for (int t = 0; t < 64; t++) { unsigned u = AB[(size_t)rowmap(d, b, cc * 64 + t) * 1280 + ch]; float a = 1.f - bhi(u), bb = blo(u); Pp *= a; Q = a * Q + bb; }
    AGG[(size_t)(b * NCH_ + cc) * 1280 + ch] = float2{Pp, Q};
  }
}
__device__ __forceinline__ void ph_lru_s2(const P& p) {
  const float2* AGG = (const float2*)(p.ACT + A_AGG); float* CAR = (float*)(p.ACT + A_CAR);
  for (int it = blockIdx.x; it < 10; it += gridDim.x) {
    int idx = it * 256 + threadIdx.x, b = idx / 1280, ch = idx % 1280; float h = 0.f;
#pragma unroll 4
    for (int cc = 0; cc < NCH_; cc++) { size_t o = (size_t)(b * NCH_ + cc) * 1280 + ch; float2 a = AGG[o]; CAR[o] = h; h = a.x * h + a.y; }
  }
}
__device__ __forceinline__ void ph_lru_s3(const P& p, int d) {
  const unsigned* AB = (const unsigned*)(p.ACT + A_AB); const float* CAR = (const float*)(p.ACT + A_CAR);
  bfr* HF = (bfr*)(p.ACT + A_HF); bfr* Z = (bfr*)(p.ACT + A_Z);
  for (int it = blockIdx.x; it < 2600; it += gridDim.x) {
    int b = it / 1300, r = it % 1300, cc = r / 5, ch = (r % 5) * 256 + threadIdx.x;
    float h = CAR[(size_t)(b * NCH_ + cc) * 1280 + ch];
#pragma unroll 8
    for (int t = 0; t < 64; t++) { size_t o = (size_t)rowmap(d, b, cc * 64 + t) * 1280 + ch; unsigned u = AB[o]; h = (1.f - bhi(u)) * h + blo(u);
      if (d == 0) HF[o] = f2b(h); else { float y = b2f(HF[o]) + h; Z[o] = f2b(y * siluf(b2f(Z[o]))); } }
  }
}
__device__ __forceinline__ void ph_ml_stat(const P& p) {
  const bfr* HS = (const bfr*)(p.ACT + A_HS); float* RS = (float*)(p.ACT + A_RSTD);
  const int lane = threadIdx.x & 63, wid = threadIdx.x >> 6;
  for (int it = blockIdx.x; it < 8320; it += gridDim.x) {
    int row = it * 4 + wid; const bfr* hp = HS + (size_t)row * 2048 + lane * 32; float ss = 0.f;
#pragma unroll
    for (int i = 0; i < 4; i++) { uint4 u = *(const uint4*)(hp + i * 8); float a;
      a = blo(u.x); ss += a * a; a = bhi(u.x); ss += a * a; a = blo(u.y); ss += a * a; a = bhi(u.y); ss += a * a;
      a = blo(u.z); ss += a * a; a = bhi(u.z); ss += a * a; a = blo(u.w); ss += a * a; a = bhi(u.w); ss += a * a; }
    ss += __shfl_xor(ss, 1); ss += __shfl_xor(ss, 2); ss += __shfl_xor(ss, 4);
    if ((lane & 7) == 0) RS[(size_t)row * 8 + (lane >> 3)] = rsqrtf(ss * (1.f / 256.f) + 1e-6f);
  }
}
__device__ __forceinline__ void ph_r7_fin(const P& p, int j) {
  bfr* Y = p.H; const bfr* RK = (const bfr*)(p.ACT + A_RKVZ); const float* BON = (const float*)(p.ACT + A_BON);
  const float* lg = p.r7_ln_g + (size_t)j * 1024; const float* lb = p.r7_ln_b + (size_t)j * 1024;
  const int lane = threadIdx.x & 63, wid = threadIdx.x >> 6;
  for (int it = blockIdx.x; it < 8320; it += gridDim.x) {
    int row = it * 4 + wid, ch = lane * 16, hd = lane >> 2;
    float y[16], v[16], z[16];
#pragma unroll
    for (int i = 0; i < 2; i++) {
      uint4 u = *(const uint4*)(Y + (size_t)row * 1024 + ch + i * 8);
      y[i * 8 + 0] = blo(u.x); y[i * 8 + 1] = bhi(u.x); y[i * 8 + 2] = blo(u.y); y[i * 8 + 3] = bhi(u.y); y[i * 8 + 4] = blo(u.z); y[i * 8 + 5] = bhi(u.z); y[i * 8 + 6] = blo(u.w); y[i * 8 + 7] = bhi(u.w);
      u = *(const uint4*)(RK + (size_t)row * 4096 + 2048 + ch + i * 8);
      v[i * 8 + 0] = blo(u.x); v[i * 8 + 1] = bhi(u.x); v[i * 8 + 2] = blo(u.y); v[i * 8 + 3] = bhi(u.y); v[i * 8 + 4] = blo(u.z); v[i * 8 + 5] = bhi(u.z); v[i * 8 + 6] = blo(u.w); v[i * 8 + 7] = bhi(u.w);
      u = *(const uint4*)(RK + (size_t)row * 4096 + 3072 + ch + i * 8);
      z[i * 8 + 0] = blo(u.x); z[i * 8 + 1] = bhi(u.x); z[i * 8 + 2] = blo(u.y); z[i * 8 + 3] = bhi(u.y); z[i * 8 + 4] = blo(u.z); z[i * 8 + 5] = bhi(u.z); z[i * 8 + 6] = blo(u.w); z[i * 8 + 7] = bhi(u.w);
    }
    float s = 0.f;
#pragma unroll
    for (int e = 0; e < 16; e++) s += y[e];
    s += __shfl_xor(s, 1); s += __shfl_xor(s, 2); float mean = s * (1.f / 64.f);
    float q = 0.f;
#pragma unroll
    for (int e = 0; e < 16; e++) { float dlt = y[e] - mean; q += dlt * dlt; }
    q += __shfl_xor(q, 1); q += __shfl_xor(q, 2); float rs = rsqrtf(q * (1.f / 64.f) + 64e-5f);
    float bon = BON[(size_t)row * 16 + hd] + BON[(size_t)(R_ + row) * 16 + hd];
    float o[16];
#pragma unroll
    for (int e = 0; e < 16; e++) { float yn = (y[e] - mean) * rs * lg[ch + e] + lb[ch + e]; o[e] = (yn + bon * v[e]) * siluf(z[e]); }
#pragma unroll
    for (int i = 0; i < 2; i++)
      *(uint4*)(Y + (size_t)row * 1024 + ch + i * 8) = uint4{pk2(o[i * 8], o[i * 8 + 1]), pk2(o[i * 8 + 2], o[i * 8 + 3]), pk2(o[i * 8 + 4], o[i * 8 + 5]), pk2(o[i * 8 + 6], o[i * 8 + 7])};
  }
}

#define QS 136
#define VS 72
__device__ __forceinline__ void ph_ml_scan(const P& p, int j, char* smem) {
  bfr* sQ = (bfr*)smem; bfr* sK = sQ + 64 * QS; bfr* sVT = sK + 64 * QS; bfr* sCT = sVT + 16 * VS;
  float* sN = (float*)(sCT + 2 * 16 * QS);
  float* sEs = sN + 256; float* sCt = sEs + 64; float* sBc = sCt + 64; float* sWg = sBc + 64; float* sNr = sWg + 64;
  const bfr* QKV = (const bfr*)(p.ACT + A_QKV); const float* GT = (const float*)(p.ACT + A_GATE); bfr* HS = (bfr*)(p.ACT + A_HS);
  const float* gbias = p.ml_gate_b + (size_t)j * 32;
  const int tid = threadIdx.x, lane = tid & 63, w = tid >> 6, l15 = lane & 15, q4 = lane >> 4;
  for (int it = blockIdx.x; it < 256; it += gridDim.x) {
    const int b = it >> 7, hh = (it >> 4) & 7, sl = it & 15;
    f32x4 Cacc[2][2];
#pragma unroll
    for (int a = 0; a < 2; a++) {
#pragma unroll
      for (int c = 0; c < 2; c++) Cacc[a][c] = f32x4{0.f, 0.f, 0.f, 0.f}; }
    float mst0 = 0.f, mst1 = 0.f;
    for (int i = tid; i < 2 * 16 * QS; i += 256) sCT[i] = 0;
    sN[tid] = 0.f;
    uint4 pq0, pq1, pq2, pq3, pk0, pk1, pk2, pk3, pv = uint4{0u, 0u, 0u, 0u};
#define ML_ROW0(d_, s_) ((d_) == 0 ? b * BT_ + 64 * (s_) : rowmap(1, b, 64 * (s_) + 63))
#define ML_LD(i_, PQ, PK) { int idx = tid + 256 * (i_), rho = idx >> 4, c8 = idx & 15; const bfr* src = QKV + (size_t)(r0n + rho) * 4096 + hh * 128 + c8 * 8; PQ = *(const uint4*)src; PK = *(const uint4*)(src + 1024); }
#define ML_ISSUE(d_, s_) { const int r0n = ML_ROW0(d_, s_); ML_LD(0, pq0, pk0) ML_LD(1, pq1, pk1) ML_LD(2, pq2, pk2) ML_LD(3, pq3, pk3) \
      if (tid < 128) pv = *(const uint4*)(QKV + (size_t)(r0n + (tid >> 1)) * 4096 + 2048 + hh * 256 + sl * 16 + (tid & 1) * 8); }
#define ML_ST(i_, PQ, PK) { int idx = tid + 256 * (i_), rho = idx >> 4, c8 = idx & 15; *(uint4*)(sQ + rho * QS + c8 * 8) = PQ; *(uint4*)(sK + rho * QS + c8 * 8) = PK; }
#define ML_COMMIT() { ML_ST(0, pq0, pk0) ML_ST(1, pq1, pk1) ML_ST(2, pq2, pk2) ML_ST(3, pq3, pk3) \
      if (tid < 128) { int rho = tid >> 1, vb = (tid & 1) * 8; \
        sVT[(vb + 0) * VS + rho] = (bfr)(pv.x & 0xffff); sVT[(vb + 1) * VS + rho] = (bfr)(pv.x >> 16); \
        sVT[(vb + 2) * VS + rho] = (bfr)(pv.y & 0xffff); sVT[(vb + 3) * VS + rho] = (bfr)(pv.y >> 16); \
        sVT[(vb + 4) * VS + rho] = (bfr)(pv.z & 0xffff); sVT[(vb + 5) * VS + rho] = (bfr)(pv.z >> 16); \
        sVT[(vb + 6) * VS + rho] = (bfr)(pv.w & 0xffff); sVT[(vb + 7) * VS + rho] = (bfr)(pv.w >> 16); } }
    ML_ISSUE(0, 0)
    __syncthreads();
    for (int s = 0; s < NCH_; s++) {
#pragma unroll
    for (int d = 0; d < 2; d++) {
      const int st = 2 * s + d;
      const int r0 = ML_ROW0(d, s);
      ML_COMMIT()
      float mcur = d ? mst1 : mst0, mxl, decay;
      {
        int rho = d ? 63 - lane : lane; const float* gp = GT + (size_t)(r0 + rho) * 32 + d * 16 + hh;
        float gi = gp[0] + gbias[(d * 2 + 0) * 8 + hh], gf = gp[8] + gbias[(d * 2 + 1) * 8 + hh];
        float fc = fminf(gf, 0.f) - log1pf(__expf(-fabsf(gf)));
        float bc = fc;
        for (int o = 1; o < 64; o <<= 1) { float t = __shfl_up(bc, o); if (lane >= o) bc += t; }
        float e = gi - bc, pm = e;
        for (int o = 1; o < 64; o <<= 1) { float t = __shfl_up(pm, o); if (lane >= o) pm = fmaxf(pm, t); }
        float pml = __shfl(pm, 63), bcl = __shfl(bc, 63);
        mxl = fmaxf(mcur, pml); decay = __expf(mcur - mxl);
        if (w == 0) { sEs[rho] = e; sCt[rho] = -fmaxf(mcur, pm); sBc[rho] = bc; sWg[rho] = __expf(e - mxl); }
        if (d) mst1 = bcl + mxl; else mst0 = bcl + mxl;
      }
      __syncthreads();
      if (st + 1 < 2 * NCH_) ML_ISSUE((st + 1) & 1, (st + 1) >> 1)
      bf16x8 qf[4];
#pragma unroll
      for (int ks = 0; ks < 4; ks++) qf[ks] = *(const bf16x8*)(sQ + (16 * w + l15) * QS + ks * 32 + q4 * 8);
      f32x4 sacc[4];
#pragma unroll
      for (int a = 0; a < 4; a++) { sacc[a] = f32x4{0.f, 0.f, 0.f, 0.f};
#pragma unroll
        for (int ks = 0; ks < 4; ks++) { bf16x8 kf = *(const bf16x8*)(sK + (16 * a + l15) * QS + ks * 32 + q4 * 8); sacc[a] = __builtin_amdgcn_mfma_f32_16x16x32_bf16(kf, qf[ks], sacc[a], 0, 0, 0); } }
      const int rt = 16 * w + l15; const float ctt = sCt[rt]; float densum = 0.f;
#pragma unroll
      for (int a = 0; a < 4; a++)
#pragma unroll
        for (int jj = 0; jj < 4; jj++) { int rs_ = 16 * a + 4 * q4 + jj; bool valid = d == 0 ? rs_ <= rt : rs_ >= rt;
          float wv = valid ? __expf(ctt + sEs[rs_]) : 0.f; float sv = sacc[a][jj] * wv; sacc[a][jj] = sv; densum += sv; }
      densum += __shfl_xor(densum, 16); densum += __shfl_xor(densum, 32);
      bf16x8 sf[2], vf[2];
#pragma unroll
      for (int ks = 0; ks < 2; ks++) {
#pragma unroll
        for (int jj = 0; jj < 4; jj++) { sf[ks][jj] = (short)f2b(sacc[2 * ks][jj]); sf[ks][4 + jj] = (short)f2b(sacc[2 * ks + 1][jj]); }
        uint2 v0 = *(const uint2*)(sVT + l15 * VS + 32 * ks + 4 * q4), v1 = *(const uint2*)(sVT + l15 * VS + 32 * ks + 16 + 4 * q4);
        uint4 vv = uint4{v0.x, v0.y, v1.x, v1.y}; vf[ks] = *(bf16x8*)&vv;
      }
      f32x4 num = f32x4{0.f, 0.f, 0.f, 0.f}, numC = f32x4{0.f, 0.f, 0.f, 0.f};
#pragma unroll
      for (int ks = 0; ks < 2; ks++) num = __builtin_amdgcn_mfma_f32_16x16x32_bf16(vf[ks], sf[ks], num, 0, 0, 0);
#pragma unroll
      for (int ks = 0; ks < 4; ks++) { bf16x8 cf = *(const bf16x8*)(sCT + (d * 16 + l15) * QS + ks * 32 + q4 * 8); numC = __builtin_amdgcn_mfma_f32_16x16x32_bf16(cf, qf[ks], numC, 0, 0, 0); }
      float qn = 0.f;
#pragma unroll
      for (int i = 0; i < 4; i++) { uint4 u = *(const uint4*)(sQ + rt * QS + 32 * q4 + i * 8); const float* nn = sN + d * 128 + 32 * q4 + i * 8;
        qn += blo(u.x) * nn[0] + bhi(u.x) * nn[1] + blo(u.y) * nn[2] + bhi(u.y) * nn[3] + blo(u.z) * nn[4] + bhi(u.z) * nn[5] + blo(u.w) * nn[6] + bhi(u.w) * nn[7]; }
      qn += __shfl_xor(qn, 16); qn += __shfl_xor(qn, 32);
      {
        float inter = __expf(mcur + ctt); float den = densum + inter * qn; float dn = fmaxf(fabsf(den), __expf(ctt - sBc[rt])); float inv = 1.f / dn;
        f32x4 hv;
#pragma unroll
        for (int jj = 0; jj < 4; jj++) hv[jj] = (num[jj] + inter * numC[jj]) * inv;
        int rc = (r0 - b * BT_) >> 6; bool first;
        if (d == 0) { int sp = rc < 4 ? 3 - rc : 263 - rc; first = s < sp; } else first = s < rc;
        bfr* hp = HS + (size_t)(r0 + rt) * 2048 + hh * 256 + sl * 16 + 4 * q4;
        if (!first) { uint2 u = *(const uint2*)hp; hv[0] += blo(u.x); hv[1] += bhi(u.x); hv[2] += blo(u.y); hv[3] += bhi(u.y); }
        store4b(hp, hv);
      }
      __syncthreads();
      {
        bf16x8 vw[2];
#pragma unroll
        for (int ks = 0; ks < 2; ks++)
#pragma unroll
          for (int e = 0; e < 8; e++) { int rs_ = 32 * ks + (e < 4 ? 4 * q4 + e : 16 + 4 * q4 + e - 4); vw[ks][e] = (short)f2b(b2f((bfr)vf[ks][e]) * sWg[rs_]); }
#pragma unroll
        for (int a = 0; a < 2; a++) {
          int dk = 32 * w + 16 * a + l15;
#pragma unroll
          for (int jj = 0; jj < 4; jj++) Cacc[d][a][jj] *= decay;
#pragma unroll
          for (int ks = 0; ks < 2; ks++) { bf16x8 kt;
#pragma unroll
            for (int e = 0; e < 8; e++) { int rs_ = 32 * ks + (e < 4 ? 4 * q4 + e : 16 + 4 * q4 + e - 4); kt[e] = (short)sK[rs_ * QS + dk]; }
            Cacc[d][a] = __builtin_amdgcn_mfma_f32_16x16x32_bf16(vw[ks], kt, Cacc[d][a], 0, 0, 0); }
#pragma unroll
          for (int jj = 0; jj < 4; jj++) sCT[(d * 16 + 4 * q4 + jj) * QS + dk] = f2b(Cacc[d][a][jj]);
        }
        int dk = tid & 127, hf = tid >> 7; float part = 0.f;
#pragma unroll 8
        for (int r = 0; r < 32; r++) part += sWg[32 * hf + r] * b2f(sK[(32 * hf + r) * QS + dk]);
        sNr[tid] = part;
      }
      __syncthreads();
      if (tid < 128) sN[d * 128 + tid] = decay * sN[d * 128 + tid] + sNr[tid] + sNr[128 + tid];
    }
    }
    __syncthreads();
  }
}

__device__ __forceinline__ void ph_r7_scan(const P& p, int j, int d, char* smem) {
  float* sW = (float*)smem; float* sKa = sW + 2048; float* sBe = sKa + 2048; float* sKd = sBe + 2048; float* sR = sKd + 2048; float* sV = sR + 2048; float* sY = sV + 256;
  const bfr* RK = (const bfr*)(p.ACT + A_RKVZ); const bfr* SW = (const bfr*)(p.ACT + A_SW); const bfr* AA = (const bfr*)(p.ACT + A_AA);
  float* BON = (float*)(p.ACT + A_BON); bfr* Y = p.H;
  const float* kkp = p.r7_k_k + (size_t)j * 1024; const float* kap = p.r7_k_a + (size_t)j * 1024; const float* rkp = p.r7_r_k + (size_t)j * 1024;
  const int tid = threadIdx.x, lane = tid & 63, w = tid >> 6, kp = lane & 15, rr = lane >> 4;
  const int si = tid >> 3, sc = tid & 7;
  for (int it = blockIdx.x; it < 256; it += gridDim.x) {
    const int b = it >> 7, hh = (it >> 3) & 15, rg = it & 7;
    const int col = hh * 64 + sc * 8;
    float kkc[8], kac[8], rkc[8];
#pragma unroll
    for (int e = 0; e < 8; e++) { kkc[e] = kkp[col + e]; kac[e] = kap[col + e]; rkc[e] = rkp[col + e]; }
    float s0 = 0.f, s1 = 0.f, s2 = 0.f, s3 = 0.f;
    uint4 pr, pk, pv, pw, pa;
    auto issue = [&](int blk) __attribute__((always_inline)) { int row = rowmap(d, b, blk * 32 + si); const bfr* rp = RK + (size_t)row * 4096 + col;
      pr = *(const uint4*)rp; pk = *(const uint4*)(rp + 1024); pv = *(const uint4*)(rp + 2048);
      pw = *(const uint4*)(SW + (size_t)row * 1024 + col); pa = *(const uint4*)(AA + (size_t)row * 1024 + col); };
    issue(0);
    for (int blk = 0; blk < BT_ / 32; blk++) {
      __syncthreads();
      {
        const int row = rowmap(d, b, blk * 32 + si);
        unsigned ur[4] = {pr.x, pr.y, pr.z, pr.w}, uk[4] = {pk.x, pk.y, pk.z, pk.w}, uv[4] = {pv.x, pv.y, pv.z, pv.w}, uw[4] = {pw.x, pw.y, pw.z, pw.w}, ua[4] = {pa.x, pa.y, pa.z, pa.w};
        float r8[8], k8[8], v8[8], w8[8], a8[8], kr[8];
#pragma unroll
        for (int e = 0; e < 4; e++) { r8[2 * e] = blo(ur[e]); r8[2 * e + 1] = bhi(ur[e]); k8[2 * e] = blo(uk[e]); k8[2 * e + 1] = bhi(uk[e]); v8[2 * e] = blo(uv[e]); v8[2 * e + 1] = bhi(uv[e]);
          w8[2 * e] = blo(uw[e]); w8[2 * e + 1] = bhi(uw[e]); a8[2 * e] = blo(ua[e]); a8[2 * e + 1] = bhi(ua[e]); }
        float ss = 0.f;
#pragma unroll
        for (int e = 0; e < 8; e++) { kr[e] = k8[e] * kkc[e]; ss += kr[e] * kr[e]; }
        ss += __shfl_xor(ss, 1); ss += __shfl_xor(ss, 2); ss += __shfl_xor(ss, 4);
        float inv = 1.f / fmaxf(sqrtf(ss), 1e-12f);
        float bon = 0.f; float ow[8], oka[8], obe[8], okd[8];
#pragma unroll
        for (int e = 0; e < 8; e++) { float ka = kr[e] * inv; oka[e] = ka; obe[e] = a8[e] * ka; float kd = k8[e] * (1.f + (a8[e] - 1.f) * kac[e]); okd[e] = kd; ow[e] = __expf(-w8[e]); bon += r8[e] * kd * rkc[e]; }
        bon += __shfl_xor(bon, 1); bon += __shfl_xor(bon, 2); bon += __shfl_xor(bon, 4);
        if (rg == 0 && sc == 0) BON[((size_t)d * R_ + row) * 16 + hh] = bon;
        int o = si * 64 + sc * 8;
        *(float4*)(sW + o) = float4{ow[0], ow[1], ow[2], ow[3]}; *(float4*)(sW + o + 4) = float4{ow[4], ow[5], ow[6], ow[7]};
        *(float4*)(sKa + o) = float4{oka[0], oka[1], oka[2], oka[3]}; *(float4*)(sKa + o + 4) = float4{oka[4], oka[5], oka[6], oka[7]};
        *(float4*)(sBe + o) = float4{obe[0], obe[1], obe[2], obe[3]}; *(float4*)(sBe + o + 4) = float4{obe[4], obe[5], obe[6], obe[7]};
        *(float4*)(sKd + o) = float4{okd[0], okd[1], okd[2], okd[3]}; *(float4*)(sKd + o + 4) = float4{okd[4], okd[5], okd[6], okd[7]};
        *(float4*)(sR + o) = float4{r8[0], r8[1], r8[2], r8[3]}; *(float4*)(sR + o + 4) = float4{r8[4], r8[5], r8[6], r8[7]};
        if (sc == rg) { *(float4*)(sV + si * 8) = float4{v8[0], v8[1], v8[2], v8[3]}; *(float4*)(sV + si * 8 + 4) = float4{v8[4], v8[5], v8[6], v8[7]}; }
      }
      __syncthreads();
      if (blk + 1 < BT_ / 32) issue(blk + 1);
      if (w < 2) {
#pragma unroll 8
        for (int i = 0; i < 32; i++) {
          float4 w4 = *(const float4*)(sW + i * 64 + kp * 4), ka4 = *(const float4*)(sKa + i * 64 + kp * 4), be4 = *(const float4*)(sBe + i * 64 + kp * 4);
          float4 kd4 = *(const float4*)(sKd + i * 64 + kp * 4), r4 = *(const float4*)(sR + i * 64 + kp * 4); float vv = sV[i * 8 + w * 4 + rr];
          float sa = red16((s0 * ka4.x + s1 * ka4.y) + (s2 * ka4.z + s3 * ka4.w));
          s0 = s0 * w4.x + (kd4.x * vv - sa * be4.x); s1 = s1 * w4.y + (kd4.y * vv - sa * be4.y);
          s2 = s2 * w4.z + (kd4.z * vv - sa * be4.z); s3 = s3 * w4.w + (kd4.w * vv - sa * be4.w);
          float y = red16((s0 * r4.x + s1 * r4.y) + (s2 * r4.z + s3 * r4.w));
          if (kp == 0) sY[i * 8 + w * 4 + rr] = y;
        }
      }
      __syncthreads();
      if (tid < 32) {
        int row = rowmap(d, b, blk * 32 + tid); bfr* yp = Y + (size_t)row * 1024 + hh * 64 + rg * 8; float yy[8];
#pragma unroll
        for (int e = 0; e < 8; e++) yy[e] = sY[tid * 8 + e];
        if (d == 1) { uint4 u = *(const uint4*)yp; yy[0] += blo(u.x); yy[1] += bhi(u.x); yy[2] += blo(u.y); yy[3] += bhi(u.y); yy[4] += blo(u.z); yy[5] += bhi(u.z); yy[6] += blo(u.w); yy[7] += bhi(u.w); }
        *(uint4*)yp = uint4{pk2(yy[0], yy[1]), pk2(yy[2], yy[3]), pk2(yy[4], yy[5]), pk2(yy[6], yy[7])};
      }
    }
    __syncthreads();
  }
}

__device__ __forceinline__ void run_phase(const P& p, int ph, int layer, int d, char* smem) {
  Ctx c; c.layer = layer; c.j = layer / 3; c.d = d; c.wc = layer < 3 ? 1 : 0;
  switch (ph) {
    case PH_PRE: ph_pre(p, smem); break;
    case PH_NORM: ph_norm(p, layer, smem); break;
    case PH_LRU_IN: gemm_phase<G_LruIn>(p, c, smem); break;
    case PH_LRU_CONV: ph_lru_conv(p, c.j); break;
    case PH_LRU_GATE: gemm_phase<G_LruGate>(p, c, smem); break;
    case PH_LRU_S1: ph_lru_s1(p, d); break;
    case PH_LRU_S2: ph_lru_s2(p); break;
    case PH_LRU_S3: ph_lru_s3(p, d); break;
    case PH_LRU_OUT: gemm_phase<G_LruOut>(p, c, smem); break;
    case PH_ML_IN: gemm_phase<G_MlIn>(p, c, smem); break;
    case PH_ML_SCAN: ph_ml_scan(p, c.j, smem); break;
    case PH_ML_STAT: ph_ml_stat(p); break;
    case PH_ML_Z: gemm_phase<G_MlZ>(p, c, smem); break;
    case PH_ML_OUT: gemm_phase<G_MlOut>(p, c, smem); break;
    case PH_R7_IN: gemm_phase<G_R7In>(p, c, smem); break;
    case PH_R7_UP: gemm_phase<G_R7Up>(p, c, smem); break;
    case PH_R7_SCAN: ph_r7_scan(p, c.j, d, smem); break;
    case PH_R7_FIN: ph_r7_fin(p, c.j); break;
    case PH_R7_OUT: gemm_phase<G_R7Out>(p, c, smem); break;
    case PH_FINAL: ph_final(p); break;
  }
}

#define SMEM_BYTES 73728
#if !MEGA
__global__ void __launch_bounds__(256) phase_kernel(P p, int si) {
  __shared__ __attribute__((aligned(16))) char smem[SMEM_BYTES];
  run_phase(p, p.sched[si * 3], p.sched[si * 3 + 1], p.sched[si * 3 + 2], smem);
}
#else
__global__ void __launch_bounds__(256) mega_kernel(P p) {
  __shared__ __attribute__((aligned(16))) char smem[SMEM_BYTES];
  cg::grid_group grid = cg::this_grid();
  for (int si = 0; si < p.nsched; si++) {
    run_phase(p, p.sched[si * 3], p.sched[si * 3 + 1], p.sched[si * 3 + 2], smem);
    if (si + 1 < p.nsched) grid.sync();
  }
}
#endif

extern "C" void kernel_launch(void* const* d_in, const int* in_sizes, int n_in, void* d_out, int out_size, void* d_ws, size_t ws_size, hipStream_t stream) {
  P p; memset(&p, 0, sizeof(p));
  const float** f = (const float**)&p;
  for (int i = 0; i < 33; i++) f[i] = (const float*)d_in[i];
  char* ws = (char*)d_ws;
  p.Xx = (float*)d_out; p.Xc = (float*)(ws + OFF_XC); p.MOD = (float*)(ws + OFF_MOD); p.W = (bfr*)(ws + OFF_W); p.H = (bfr*)(ws + OFF_H); p.ACT = ws + OFF_ACT;
  int n = 0;
  auto add = [&](int ph, int layer, int d) { p.sched[n * 3] = ph; p.sched[n * 3 + 1] = layer; p.sched[n * 3 + 2] = d; n++; };
  add(PH_PRE, 0, 0);
  for (int l = 0; l < 4; l++) {
    add(PH_NORM, l, 0);
    int kind = l % 3;
    if (kind == 0) { add(PH_LRU_IN, l, 0); add(PH_LRU_CONV, l, 0);
      for (int d = 0; d < 2; d++) { add(PH_LRU_GATE, l, d); add(PH_LRU_S1, l, d); add(PH_LRU_S2, l, d); add(PH_LRU_S3, l, d); }
      add(PH_LRU_OUT, l, 0); }
    else if (kind == 1) { add(PH_ML_IN, l, 0); add(PH_ML_SCAN, l, 0); add(PH_ML_STAT, l, 0); add(PH_ML_Z, l, 0); add(PH_ML_OUT, l, 0); }
    else { add(PH_R7_IN, l, 0); for (int d = 0; d < 2; d++) { add(PH_R7_UP, l, d); add(PH_R7_SCAN, l, d); } add(PH_R7_FIN, l, 0); add(PH_R7_OUT, l, 0); }
  }
  add(PH_FINAL, 0, 0);
  p.nsched = n;
  if (ws_size < WS_NEED) fprintf(stderr, "workspace too small: %zu < %llu\n", ws_size, (unsigned long long)WS_NEED);
#if MEGA
  static int grid_blocks = 0;
  if (!grid_blocks) { int dev = 0, cus = 0, per = 0; hipGetDevice(&dev); hipDeviceGetAttribute(&cus, hipDeviceAttributeMultiprocessorCount, dev);
    hipOccupancyMaxActiveBlocksPerMultiprocessor(&per, mega_kernel, 256, 0); if (per > 2) per = 2; grid_blocks = cus * per; }
  void* args[] = {&p};
  hipError_t e = hipLaunchCooperativeKernel((void*)mega_kernel, dim3(grid_blocks), dim3(256), args, 0, stream);
  if (e != hipSuccess) fprintf(stderr, "cooperative launch failed: %s (grid %d)\n", hipGetErrorString(e), grid_blocks);
#else
  for (int si = 0; si < n; si++) phase_kernel<<<512, 256, 0, stream>>>(p, si);
#endif
}
```

```cpp
#include <hip/hip_runtime.h>
#include <hip/hip_bf16.h>
#include <hip/hip_cooperative_groups.h>
#include <cstdio>
#include <cstring>
#include <type_traits>
namespace cg = cooperative_groups;

#ifndef DUP
#define DUP 0
#endif
#ifndef MEGA
#define MEGA 1
#endif

typedef unsigned short bfr;
using bf16x8 = __attribute__((ext_vector_type(8))) short;
using f32x4 = __attribute__((ext_vector_type(4))) float;

#define R_ 33280
#define BT_ 16640
#define NCH_ 260

#define OFF_XC 0ull
#define OFF_MOD 2097152ull
#define OFF_W 2244608ull
#define OFF_H 24264704ull
#define OFF_ACT 92422144ull
#define A_Z 0ull
#define A_UC 85196800ull
#define A_AB 170393600ull
#define A_U 170393600ull
#define A_HF 340787200ull
#define A_AGG 425984000ull
#define A_CAR 431308800ull
#define A_QKV 0ull
#define A_GATE 272629760ull
#define A_HS 276889600ull
#define A_RSTD 413204480ull
#define A_RKVZ 0ull
#define A_WM 272629760ull
#define A_AM 281149440ull
#define A_SW 289669120ull
#define A_AA 357826560ull
#define A_BON 425984000ull
#define WS_NEED (OFF_ACT + 434000000ull)

#define WL_GATE (2560 * 1024)
#define WL_OUT (WL_GATE + 1310720)
#define WM_Z (4224 * 1024)
#define WM_OUT (WM_Z + 2048 * 1024)
#define WR_UP (4352 * 2048)
#define WR_OUT (WR_UP + 262144)

enum { PH_PRE = 0, PH_NORM, PH_LRU_IN, PH_LRU_CONV, PH_LRU_GATE, PH_LRU_S1, PH_LRU_S2, PH_LRU_S3, PH_LRU_OUT,
       PH_ML_IN, PH_ML_SCAN, PH_ML_STAT, PH_ML_Z, PH_ML_OUT,
       PH_R7_IN, PH_R7_UP, PH_R7_SCAN, PH_R7_FIN, PH_R7_OUT, PH_FINAL };

struct P {
  const float *x, *c, *ctx, *c_ctx, *norm_g, *mod_w, *mod_b, *final_g;
  const float *lru_w_in, *lru_conv_w, *lru_conv_b, *lru_gate_w, *lru_gate_b, *lru_lam, *lru_w_out;
  const float *ml_w_in, *ml_gate_b, *ml_norm_g, *ml_w_out;
  const float *r7_mu, *r7_w_rkvz, *r7_w0, *r7_w1, *r7_w2, *r7_a0, *r7_a1, *r7_a2, *r7_k_k, *r7_k_a, *r7_r_k, *r7_ln_g, *r7_ln_b, *r7_w_out;
  float* Xx; float* Xc; float* MOD; bfr* W; bfr* H; char* ACT;
  int nsched; int pad_;
  int sched[64 * 3];
};
struct Ctx { int layer, j, d, wc; };

__device__ __forceinline__ int ltid() { int t = threadIdx.x; asm volatile("" : "+v"(t)); return t; }
__device__ __forceinline__ bfr f2b(float f) { unsigned u = __float_as_uint(f); u += 0x7fffu + ((u >> 16) & 1u); return (bfr)(u >> 16); }
__device__ __forceinline__ float b2f(bfr b) { return __uint_as_float(((unsigned)b) << 16); }
__device__ __forceinline__ unsigned pk2(float a, float b) { return (unsigned)f2b(a) | (((unsigned)f2b(b)) << 16); }
__device__ __forceinline__ float blo(unsigned u) { return __uint_as_float(u << 16); }
__device__ __forceinline__ float bhi(unsigned u) { return __uint_as_float(u & 0xffff0000u); }
__device__ __forceinline__ void store4b(bfr* dst, f32x4 v) { uint2 u; u.x = pk2(v[0], v[1]); u.y = pk2(v[2], v[3]); *(uint2*)dst = u; }
__device__ __forceinline__ float sigm(float x) { return 1.f / (1.f + __expf(-x)); }
__device__ __forceinline__ float siluf(float x) { return x * sigm(x); }
__device__ __forceinline__ float softplusf(float x) { return x > 20.f ? x : log1pf(expf(x)); }
__device__ __forceinline__ int rowmap(int d, int b, int pp) { int o = d == 0 ? pp : (pp < 256 ? 255 - pp : 16895 - pp); return b * BT_ + o; }
__device__ __forceinline__ float* xrowp(const P& p, int row, int& mi) {
  int b = row / BT_, o = row - b * BT_;
  if (o < 256) { mi = 2; return p.Xc + (size_t)(b * 256 + o) * 1024; }
  mi = b; return p.Xx + (size_t)(b * 16384 + o - 256) * 1024;
}
__device__ __forceinline__ float wsum(float v) { for (int o = 32; o; o >>= 1) v += __shfl_xor(v, o); return v; }
template <int CTRL> __device__ __forceinline__ float dppf(float x) {
  return __int_as_float(__builtin_amdgcn_update_dpp(0, __float_as_int(x), CTRL, 0xf, 0xf, true));
}
__device__ __forceinline__ float red16(float x) {
  x += dppf<0xB1>(x); x += dppf<0x4E>(x); x += dppf<0x141>(x); x += dppf<0x140>(x); return x;
}

template <class F> __device__ __forceinline__ void prep_tile(bfr* dst, int K, int tn, int tk, F get, float* sm) {
  int tid = ltid();
  for (int i = 0; i < 8; i++) { int kk = (tid >> 6) + 8 * i, nn = tid & 63; sm[kk * 65 + nn] = get(tk * 64 + kk, tn * 64 + nn); }
  __syncthreads();
  for (int i = 0; i < 8; i++) { int nn = (tid >> 6) + 8 * i, kk = tid & 63; dst[(size_t)(tn * 64 + nn) * K + tk * 64 + kk] = f2b(sm[kk * 65 + nn]); }
  __syncthreads();
}
__device__ __forceinline__ int prep_count(int layer) { int kind = layer % 3; return kind == 0 ? (640 + 320 + 320) : kind == 1 ? (1056 + 512 + 512) : (2176 + 64 + 256); }
__device__ __forceinline__ void prep_item(const P& p, int layer, int it, float* sm) {
  int kind = layer % 3, j = layer / 3;
  if (kind == 0) {
    if (it < 640) { int tn = it / 16, tk = it % 16; const float* s = p.lru_w_in + (size_t)j * 1024 * 2560;
      prep_tile(p.W, 1024, tn, tk, [=](int k, int n) { return s[(size_t)k * 2560 + n]; }, sm); return; }
    it -= 640;
    if (it < 320) { int d = it / 160, r = it % 160, tn = r / 2, tk = r % 2; const float* s = p.lru_gate_w + (size_t)(j * 2 + d) * 2 * 10 * 16384;
      prep_tile(p.W + WL_GATE + d * 655360, 128, tn, tk, [=](int k, int n) {
        int nt = n >> 7, blk = nt >> 1, sub = nt & 1, jj = n & 127, wn = jj >> 6, rr = jj & 63, g = rr >> 5, c = rr & 31;
        int kch = sub * 64 + wn * 32 + c; return s[((size_t)(g * 10 + blk) * 128 + k) * 128 + kch]; }, sm); return; }
    it -= 320;
    { int tn = it / 20, tk = it % 20; const float* s = p.lru_w_out + (size_t)j * 1280 * 1024;
      prep_tile(p.W + WL_OUT, 1280, tn, tk, [=](int k, int n) { return s[(size_t)k * 1024 + n]; }, sm); return; }
  } else if (kind == 1) {
    const float* s = p.ml_w_in + (size_t)j * 1024 * 6176;
    if (it < 1056) { int tn = it / 16, tk = it % 16;
      prep_tile(p.W, 1024, tn, tk, [=](int k, int n) {
        if (n < 4096) { float v = s[(size_t)k * 6176 + n]; return (n >= 1024 && n < 2048) ? v * 0.08838834764831845f : v; }
        if (n < 4128) return s[(size_t)k * 6176 + 6144 + (n - 4096)];
        return 0.f; }, sm); return; }
    it -= 1056;
    if (it < 512) { int tn = it / 16, tk = it % 16;
      prep_tile(p.W + WM_Z, 1024, tn, tk, [=](int k, int n) { return s[(size_t)k * 6176 + 4096 + n]; }, sm); return; }
    it -= 512;
    { int tn = it / 32, tk = it % 32; const float* so = p.ml_w_out + (size_t)j * 2048 * 1024;
      prep_tile(p.W + WM_OUT, 2048, tn, tk, [=](int k, int n) { return so[(size_t)k * 1024 + n]; }, sm); return; }
  } else {
    if (it < 2176) { int tn = it / 32, tk = it % 32;
      const float* mu = p.r7_mu + (size_t)j * 6 * 1024; const float* wr = p.r7_w_rkvz + (size_t)j * 4 * 1024 * 1024;
      const float* w1 = p.r7_w1 + (size_t)j * 2 * 1024 * 64; const float* a1 = p.r7_a1 + (size_t)j * 2 * 1024 * 64;
      prep_tile(p.W, 2048, tn, tk, [=](int k, int n) {
        int kk = k & 1023; float v, m;
        if (n < 4096) { int g = n >> 10, e = n & 1023; m = mu[g * 1024 + kk]; v = wr[((size_t)g * 1024 + kk) * 1024 + e]; }
        else if (n < 4224) { int xx = (n - 4096) >> 6, rr = (n - 4096) & 63; m = mu[4 * 1024 + kk]; v = w1[((size_t)xx * 1024 + kk) * 64 + rr]; }
        else { int xx = (n - 4224) >> 6, rr = (n - 4224) & 63; m = mu[5 * 1024 + kk]; v = a1[((size_t)xx * 1024 + kk) * 64 + rr]; }
        return (k < 1024 ? (1.f - m) : m) * v; }, sm); return; }
    it -= 2176;
    if (it < 64) { int u = it / 16, tn = it % 16; const float* s = (u < 2 ? p.r7_w2 : p.r7_a2) + (size_t)(j * 2 + (u & 1)) * 64 * 1024;
      prep_tile(p.W + WR_UP + u * 65536, 64, tn, 0, [=](int k, int n) { return s[(size_t)k * 1024 + n]; }, sm); return; }
    it -= 64;
    { int tn = it / 16, tk = it % 16; const float* s = p.r7_w_out + (size_t)j * 1024 * 1024;
      prep_tile(p.W + WR_OUT, 1024, tn, tk, [=](int k, int n) { return s[(size_t)k * 1024 + n]; }, sm); return; }
  }
}

#define LDSS 72
template <class G> __device__ __forceinline__ void gemm_tile(const P& p, const Ctx& c, int mt, int nt, char* smem) {
  const int tid = ltid(), lane = tid & 63, wid = tid >> 6, wm = wid & 3, wn = wid >> 2;
  bfr* sA = (bfr*)smem; bfr* sB = sA + 2 * 256 * LDSS;
  f32x4 acc[4][4];
  for (int a = 0; a < 4; a++) for (int b = 0; b < 4; b++) acc[a][b] = f32x4{0.f, 0.f, 0.f, 0.f};
  const int lr = tid >> 3, lc = tid & 7;
  uint4 ra[4], rb[2];
  auto gload = [&](int kt) __attribute__((always_inline)) {
#pragma unroll
    for (int i = 0; i < 4; i++) {
      const bfr* pa = G::aptr(p, c, mt * 256 + lr + 64 * i, kt, nt);
      ra[i] = pa ? *(const uint4*)(pa + lc * 8) : uint4{0u, 0u, 0u, 0u};
      if (i < 2) rb[i] = *(const uint4*)(G::bptr(p, c, nt * 128 + lr + 64 * i, kt) + lc * 8);
    }
  };
  auto sstore = [&](int buf) __attribute__((always_inline)) {
#pragma unroll
    for (int i = 0; i < 4; i++) {
      *(uint4*)(sA + (buf * 256 + lr + 64 * i) * LDSS + lc * 8) = ra[i];
      if (i < 2) *(uint4*)(sB + (buf * 128 + lr + 64 * i) * LDSS + lc * 8) = rb[i];
    }
  };
  gload(0); sstore(0); __syncthreads();
  for (int kt = 0; kt < G::KT; kt++) {
    const int buf = kt & 1;
    if (kt + 1 < G::KT) gload(kt + 1);
#pragma unroll
    for (int ks = 0; ks < 2; ks++) {
      bf16x8 af[4], bf[4];
#pragma unroll
      for (int i = 0; i < 4; i++) {
        af[i] = *(const bf16x8*)(sA + (buf * 256 + wm * 64 + i * 16 + (lane & 15)) * LDSS + ks * 32 + (lane >> 4) * 8);
        bf[i] = *(const bf16x8*)(sB + (buf * 128 + wn * 64 + i * 16 + (lane & 15)) * LDSS + ks * 32 + (lane >> 4) * 8);
      }
#pragma unroll
      for (int n = 0; n < 4; n++)
#pragma unroll
        for (int m = 0; m < 4; m++) acc[n][m] = __builtin_amdgcn_mfma_f32_16x16x32_bf16(bf[n], af[m], acc[n][m], 0, 0, 0);
    }
    if (kt + 1 < G::KT) sstore(buf ^ 1);
    __syncthreads();
  }
  G::epi(p, c, acc, mt * 256 + wm * 64, nt * 128 + wn * 64, lane);
}

__device__ __forceinline__ void epi_resid(const P& p, const Ctx& c, f32x4 (&acc)[4][4], int m0, int n0, int lane) {
#pragma unroll
  for (int mi = 0; mi < 4; mi++) {
    int row = m0 + mi * 16 + (lane & 15); int mo; float* xr = xrowp(p, row, mo);
    if (mo == 2 && !c.wc) continue;
    const float* g = p.MOD + (size_t)(c.layer * 3 + mo) * 3072 + 2048;
#pragma unroll
    for (int ni = 0; ni < 4; ni++) {
      int n = n0 + ni * 16 + (lane >> 4) * 4;
      float4 xv = *(float4*)(xr + n); float4 gg = *(const float4*)(g + n);
      xv.x += gg.x * acc[ni][mi][0]; xv.y += gg.y * acc[ni][mi][1]; xv.z += gg.z * acc[ni][mi][2]; xv.w += gg.w * acc[ni][mi][3];
      *(float4*)(xr + n) = xv;
    }
  }
}

struct G_LruIn { static constexpr int KT = 16, NT = 20;
  static __device__ __forceinline__ const bfr* aptr(const P& p, const Ctx& c, int row, int kt, int nt) { return p.H + (size_t)row * 1024 + kt * 64; }
  static __device__ __forceinline__ const bfr* bptr(const P& p, const Ctx& c, int n, int kt) { return p.W + (size_t)n * 1024 + kt * 64; }
  static __device__ __forceinline__ void epi(const P& p, const Ctx& c, f32x4 (&acc)[4][4], int m0, int n0, int lane) {
    bfr* U = (bfr*)(p.ACT + A_U); bfr* Z = (bfr*)(p.ACT + A_Z);
#pragma unroll
    for (int ni = 0; ni < 4; ni++)
#pragma unroll
      for (int mi = 0; mi < 4; mi++) {
        int row = m0 + mi * 16 + (lane & 15), n = n0 + ni * 16 + (lane >> 4) * 4;
        bfr* dst = n < 1280 ? U + (size_t)row * 1280 + n : Z + (size_t)row * 1280 + (n - 1280);
        store4b(dst, acc[ni][mi]);
      }
  } };
struct G_LruGate { static constexpr int KT = 2, NT = 20;
  static __device__ __forceinline__ const bfr* aptr(const P& p, const Ctx& c, int row, int kt, int nt) { return (const bfr*)(p.ACT + A_UC) + (size_t)row * 1280 + (nt >> 1) * 128 + kt * 64; }
  static __device__ __forceinline__ const bfr* bptr(const P& p, const Ctx& c, int n, int kt) { return p.W + WL_GATE + c.d * 655360 + (size_t)n * 128 + kt * 64; }
  static __device__ __forceinline__ void epi(const P& p, const Ctx& c, f32x4 (&acc)[4][4], int m0, int n0, int lane) {
    const bfr* UC = (const bfr*)(p.ACT + A_UC); unsigned* AB = (unsigned*)(p.ACT + A_AB);
    const float* gb = p.lru_gate_b + (size_t)(c.j * 2 + c.d) * 2 * 1280; const float* lam = p.lru_lam + (size_t)(c.j * 2 + c.d) * 1280;
    int chb = (n0 >> 6) * 32;
#pragma unroll
    for (int ni = 0; ni < 2; ni++) {
      int ch = chb + ni * 16 + (lane >> 4) * 4;
      float cl[4], br[4], bi[4];
#pragma unroll
      for (int q = 0; q < 4; q++) { cl[q] = 8.f * softplusf(-lam[ch + q]); br[q] = gb[ch + q]; bi[q] = gb[1280 + ch + q]; }
#pragma unroll
      for (int mi = 0; mi < 4; mi++) {
        int row = m0 + mi * 16 + (lane & 15);
        uint2 u = *(const uint2*)(UC + (size_t)row * 1280 + ch);
        float uc[4] = {blo(u.x), bhi(u.x), blo(u.y), bhi(u.y)};
        unsigned o[4];
#pragma unroll
        for (int q = 0; q < 4; q++) {
          float r = sigm(acc[ni][mi][q] + br[q]), ig = sigm(acc[ni + 2][mi][q] + bi[q]);
          float la = -cl[q] * r; float oma = -expm1f(la); float bb = sqrtf(-expm1f(2.f * la)) * ig * uc[q];
          o[q] = (((unsigned)f2b(oma)) << 16) | (unsigned)f2b(bb);
        }
        *(uint4*)(AB + (size_t)row * 1280 + ch) = uint4{o[0], o[1], o[2], o[3]};
      }
    }
  } };
struct G_LruOut { static constexpr int KT = 20, NT = 8;
  static __device__ __forceinline__ const bfr* aptr(const P& p, const Ctx& c, int row, int kt, int nt) { return (const bfr*)(p.ACT + A_Z) + (size_t)row * 1280 + kt * 64; }
  static __device__ __forceinline__ const bfr* bptr(const P& p, const Ctx& c, int n, int kt) { return p.W + WL_OUT + (size_t)n * 1280 + kt * 64; }
  static __device__ __forceinline__ void epi(const P& p, const Ctx& c, f32x4 (&acc)[4][4], int m0, int n0, int lane) { epi_resid(p, c, acc, m0, n0, lane); } };
struct G_MlIn { static constexpr int KT = 16, NT = 33;
  static __device__ __forceinline__ const bfr* aptr(const P& p, const Ctx& c, int row, int kt, int nt) { return p.H + (size_t)row * 1024 + kt * 64; }
  static __device__ __forceinline__ const bfr* bptr(const P& p, const Ctx& c, int n, int kt) { return p.W + (size_t)n * 1024 + kt * 64; }
  static __device__ __forceinline__ void epi(const P& p, const Ctx& c, f32x4 (&acc)[4][4], int m0, int n0, int lane) {
    bfr* QKV = (bfr*)(p.ACT + A_QKV); float* GT = (float*)(p.ACT + A_GATE);
#pragma unroll
    for (int ni = 0; ni < 4; ni++)
#pragma unroll
      for (int mi = 0; mi < 4; mi++) {
        int row = m0 + mi * 16 + (lane & 15), n = n0 + ni * 16 + (lane >> 4) * 4;
        if (n < 4096) store4b(QKV + (size_t)row * 4096 + n, acc[ni][mi]);
        else if (n < 4128) *(float4*)(GT + (size_t)row * 32 + (n - 4096)) = float4{acc[ni][mi][0], acc[ni][mi][1], acc[ni][mi][2], acc[ni][mi][3]};
      }
  } };
struct G_MlZ { static constexpr int KT = 16, NT = 16;
  static __device__ __forceinline__ const bfr* aptr(const P& p, const Ctx& c, int row, int kt, int nt) { return p.H + (size_t)row * 1024 + kt * 64; }
  static __device__ __forceinline__ const bfr* bptr(const P& p, const Ctx& c, int n, int kt) { return p.W + WM_Z + (size_t)n * 1024 + kt * 64; }
  static __device__ __forceinline__ void epi(const P& p, const Ctx& c, f32x4 (&acc)[4][4], int m0, int n0, int lane) {
    bfr* HS = (bfr*)(p.ACT + A_HS); const float* RS = (const float*)(p.ACT + A_RSTD); const float* ng = p.ml_norm_g + (size_t)c.j * 2048;
#pragma unroll
    for (int ni = 0; ni < 4; ni++)
#pragma unroll
      for (int mi = 0; mi < 4; mi++) {
        int row = m0 + mi * 16 + (lane & 15), n = n0 + ni * 16 + (lane >> 4) * 4;
        bfr* hp = HS + (size_t)row * 2048 + n; uint2 u = *(const uint2*)hp; float rs = RS[(size_t)row * 8 + (n >> 8)];
        float4 g4 = *(const float4*)(ng + n);
        f32x4 o;
        o[0] = blo(u.x) * rs * g4.x * siluf(acc[ni][mi][0]); o[1] = bhi(u.x) * rs * g4.y * siluf(acc[ni][mi][1]);
        o[2] = blo(u.y) * rs * g4.z * siluf(acc[ni][mi][2]); o[3] = bhi(u.y) * rs * g4.w * siluf(acc[ni][mi][3]);
        store4b(hp, o);
      }
  } };
struct G_MlOut { static constexpr int KT = 32, NT = 8;
  static __device__ __forceinline__ const bfr* aptr(const P& p, const Ctx& c, int row, int kt, int nt) { return (const bfr*)(p.ACT + A_HS) + (size_t)row * 2048 + kt * 64; }
  static __device__ __forceinline__ const bfr* bptr(const P& p, const Ctx& c, int n, int kt) { return p.W + WM_OUT + (size_t)n * 2048 + kt * 64; }
  static __device__ __forceinline__ void epi(const P& p, const Ctx& c, f32x4 (&acc)[4][4], int m0, int n0, int lane) { epi_resid(p, c, acc, m0, n0, lane); } };
struct G_R7In { static constexpr int KT = 32, NT = 34;
  static __device__ __forceinline__ const bfr* aptr(const P& p, const Ctx& c, int row, int kt, int nt) {
    if (kt < 16) return p.H + (size_t)row * 1024 + kt * 64;
    int q = (kt - 16) >> 2; int b = row / BT_, o = row - b * BT_; int nr;
    if (o < 256) { if (q < 2) { if (o < 1) return nullptr; nr = row - 1; } else { if (o >= 255) return nullptr; nr = row + 1; } }
    else { int t = o - 256, col = t & 63, gr = t >> 6;
      if (q == 0) { if (col == 0) return nullptr; nr = row - 1; }
      else if (q == 1) { if (col == 63) return nullptr; nr = row + 1; }
      else if (q == 2) { if (gr == 0) return nullptr; nr = row - 64; }
      else { if (gr == 255) return nullptr; nr = row + 64; } }
    return p.H + (size_t)nr * 1024 + (kt - 16) * 64; }
  static __device__ __forceinline__ const bfr* bptr(const P& p, const Ctx& c, int n, int kt) { return p.W + (size_t)n * 2048 + kt * 64; }
  static __device__ __forceinline__ void epi(const P& p, const Ctx& c, f32x4 (&acc)[4][4], int m0, int n0, int lane) {
    bfr* RK = (bfr*)(p.ACT + A_RKVZ); bfr* WMb = (bfr*)(p.ACT + A_WM); bfr* AMb = (bfr*)(p.ACT + A_AM);
#pragma unroll
    for (int ni = 0; ni < 4; ni++)
#pragma unroll
      for (int mi = 0; mi < 4; mi++) {
        int row = m0 + mi * 16 + (lane & 15), n = n0 + ni * 16 + (lane >> 4) * 4;
        if (n < 4096) store4b(RK + (size_t)row * 4096 + n, acc[ni][mi]);
        else if (n < 4224) { f32x4 t;
#pragma unroll
          for (int q = 0; q < 4; q++) t[q] = tanhf(acc[ni][mi][q]); store4b(WMb + (size_t)row * 128 + (n - 4096), t); }
        else store4b(AMb + (size_t)row * 128 + (n - 4224), acc[ni][mi]);
      }
  } };
struct G_R7Up { static constexpr int KT = 1, NT = 16;
  static __device__ __forceinline__ const bfr* aptr(const P& p, const Ctx& c, int row, int kt, int nt) { return (const bfr*)(p.ACT + (nt < 8 ? A_WM : A_AM)) + (size_t)row * 128 + c.d * 64; }
  static __device__ __forceinline__ const bfr* bptr(const P& p, const Ctx& c, int n, int kt) { return n < 1024 ? p.W + WR_UP + c.d * 65536 + (size_t)n * 64 : p.W + WR_UP + (2 + c.d) * 65536 + (size_t)(n - 1024) * 64; }
  static __device__ __forceinline__ void epi(const P& p, const Ctx& c, f32x4 (&acc)[4][4], int m0, int n0, int lane) {
    bfr* SW = (bfr*)(p.ACT + A_SW); bfr* AA = (bfr*)(p.ACT + A_AA);
    const float* w0 = p.r7_w0 + (size_t)(c.j * 2 + c.d) * 1024; const float* a0 = p.r7_a0 + (size_t)(c.j * 2 + c.d) * 1024;
#pragma unroll
    for (int ni = 0; ni < 4; ni++)
#pragma unroll
      for (int mi = 0; mi < 4; mi++) {
        int row = m0 + mi * 16 + (lane & 15), n = n0 + ni * 16 + (lane >> 4) * 4; f32x4 t;
        if (n < 1024) {
#pragma unroll
          for (int q = 0; q < 4; q++) t[q] = 0.6065306597126334f * sigm(w0[n + q] + acc[ni][mi][q]); store4b(SW + (size_t)row * 1024 + n, t); }
        else { int e = n - 1024;
#pragma unroll
          for (int q = 0; q < 4; q++) t[q] = sigm(a0[e + q] + acc[ni][mi][q]); store4b(AA + (size_t)row * 1024 + e, t); }
      }
  } };
struct G_R7Out { static constexpr int KT = 16, NT = 8;
  static __device__ __forceinline__ const bfr* aptr(const P& p, const Ctx& c, int row, int kt, int nt) { return p.H + (size_t)row * 1024 + kt * 64; }
  static __device__ __forceinline__ const bfr* bptr(const P& p, const Ctx& c, int n, int kt) { return p.W + WR_OUT + (size_t)n * 1024 + kt * 64; }
  static __device__ __forceinline__ void epi(const P& p, const Ctx& c, f32x4 (&acc)[4][4], int m0, int n0, int lane) { epi_resid(p, c, acc, m0, n0, lane); } };

template <class G> __device__ __forceinline__ void gemm_phase(const P& p, const Ctx& c, char* smem) {
  const int total = 130 * G::NT;
  for (int it = blockIdx.x; it < total; it += gridDim.x) gemm_tile<G>(p, c, it / G::NT, it % G::NT, smem);
}

__device__ __forceinline__ void ph_pre(const P& p, char* smem) {
  float* sm = (float*)smem; const int tid = ltid();
  const int nprep = prep_count(0), ngemv = 192, ncopy = 4160;
  for (int it = blockIdx.x; it < nprep + ngemv + ncopy; it += gridDim.x) {
    if (it < nprep) { prep_item(p, 0, it, sm); continue; }
    int i2 = it - nprep;
    if (i2 < ngemv) {
      int l = i2 / 48, cgp = i2 % 48;
      for (int i = tid; i < 3072; i += 512) { int cnd = i >> 10, k = i & 1023; float v = cnd == 0 ? p.c[k] : cnd == 1 ? p.c[1024 + k] : p.c_ctx[k]; sm[i] = siluf(v); }
      __syncthreads();
      int kq = tid >> 6, col = cgp * 64 + (tid & 63); const float* w = p.mod_w + (size_t)l * 1024 * 3072 + col;
      float a0 = 0.f, a1 = 0.f, a2 = 0.f;
      for (int k = kq * 128; k < kq * 128 + 128; k++) { float wv = w[(size_t)k * 3072]; a0 += sm[k] * wv; a1 += sm[1024 + k] * wv; a2 += sm[2048 + k] * wv; }
      float* red = sm + 3072; red[tid * 3] = a0; red[tid * 3 + 1] = a1; red[tid * 3 + 2] = a2;
      __syncthreads();
      if (tid < 64) { float bias = p.mod_b[(size_t)l * 3072 + col];
        for (int cnd = 0; cnd < 3; cnd++) { float s = bias; for (int q = 0; q < 8; q++) s += red[(q * 64 + tid) * 3 + cnd]; p.MOD[(size_t)(l * 3 + cnd) * 3072 + col] = s; } }
      __syncthreads();
      continue;
    }
    i2 -= ngemv;
    for (int q = 0; q < 4; q++) { int idx = i2 * 2048 + q * 512 + tid; int row = idx >> 8, c4 = idx & 255; int b = row / BT_, o = row - b * BT_;
      if (o < 256) ((float4*)p.Xc)[(size_t)(b * 256 + o) * 256 + c4] = ((const float4*)p.ctx)[(size_t)(b * 256 + o) * 256 + c4];
      else ((float4*)p.Xx)[(size_t)(b * 16384 + o - 256) * 256 + c4] = ((const float4*)p.x)[(size_t)(b * 16384 + o - 256) * 256 + c4]; }
  }
}
__device__ __forceinline__ void ph_norm(const P& p, int layer, char* smem) {
  const int tid = ltid(), lane = tid & 63, wid = tid >> 6;
  const int nprep = layer > 0 ? prep_count(layer) : 0; const int kind = layer % 3;
  const int nzero = kind == 1 ? 8320 : 0;
  (void)nzero;
  for (int it = blockIdx.x; it < nprep + 4160; it += gridDim.x) {
    if (it < nprep) { prep_item(p, layer, it, (float*)smem); continue; }
    int row = (it - nprep) * 8 + wid; int mo; const float* xr = xrowp(p, row, mo);
    float4 v[4]; float ss = 0.f;
#pragma unroll
    for (int i = 0; i < 4; i++) { v[i] = *(const float4*)(xr + lane * 4 + 256 * i); ss += v[i].x * v[i].x + v[i].y * v[i].y + v[i].z * v[i].z + v[i].w * v[i].w; }
    ss = wsum(ss); float rs = rsqrtf(ss * (1.f / 1024.f) + 1e-6f);
    const float* g = p.norm_g + (size_t)layer * 1024; const float* md = p.MOD + (size_t)(layer * 3 + mo) * 3072;
#pragma unroll
    for (int i = 0; i < 4; i++) { int cidx = lane * 4 + 256 * i; float4 gg = *(const float4*)(g + cidx), sh = *(const float4*)(md + cidx), sc = *(const float4*)(md + 1024 + cidx);
      f32x4 o; o[0] = v[i].x * rs * gg.x * (1.f + sc.x) + sh.x; o[1] = v[i].y * rs * gg.y * (1.f + sc.y) + sh.y; o[2] = v[i].z * rs * gg.z * (1.f + sc.z) + sh.z; o[3] = v[i].w * rs * gg.w * (1.f + sc.w) + sh.w;
      store4b(p.H + (size_t)row * 1024 + cidx, o); }
  }
}
__device__ __forceinline__ void ph_final(const P& p) {
  const int lane = ltid() & 63, wid = ltid() >> 6;
  for (int it = blockIdx.x; it < 4096; it += gridDim.x) {
    float* xr = p.Xx + (size_t)(it * 8 + wid) * 1024; float4 v[4]; float ss = 0.f;
#pragma unroll
    for (int i = 0; i < 4; i++) { v[i] = *(const float4*)(xr + lane * 4 + 256 * i); ss += v[i].x * v[i].x + v[i].y * v[i].y + v[i].z * v[i].z + v[i].w * v[i].w; }
    ss = wsum(ss); float rs = rsqrtf(ss * (1.f / 1024.f) + 1e-6f);
#pragma unroll
    for (int i = 0; i < 4; i++) { int cidx = lane * 4 + 256 * i; float4 gg = *(const float4*)(p.final_g + cidx);
      *(float4*)(xr + cidx) = float4{v[i].x * rs * gg.x, v[i].y * rs * gg.y, v[i].z * rs * gg.z, v[i].w * rs * gg.w}; }
  }
}
__device__ __forceinline__ void ph_lru_conv(const P& p, int j) {
  const bfr* U = (const bfr*)(p.ACT + A_U); bfr* UC = (bfr*)(p.ACT + A_UC);
  const float* cw = p.lru_conv_w + (size_t)j * 4 * 1280; const float* cb = p.lru_conv_b + (size_t)j * 1280;
  for (int it = blockIdx.x; it < 10400; it += gridDim.x) {
    int idx = it * 512 + ltid(); int row = idx / 160, cgp = idx % 160, ch = cgp * 8;
    int b = row / BT_, o = row - b * BT_; int s0 = o < 256 ? 0 : 256, e0 = o < 256 ? 256 : BT_;
    float acc[8];
#pragma unroll
    for (int e = 0; e < 8; e++) acc[e] = cb[ch + e];
#pragma unroll
    for (int t = 0; t < 4; t++) { int oo = o + t - 2; if (oo < s0 || oo >= e0) continue;
      uint4 u = *(const uint4*)(U + (size_t)(row + t - 2) * 1280 + ch); const float* w = cw + t * 1280 + ch;
      acc[0] += w[0] * blo(u.x); acc[1] += w[1] * bhi(u.x); acc[2] += w[2] * blo(u.y); acc[3] += w[3] * bhi(u.y);
      acc[4] += w[4] * blo(u.z); acc[5] += w[5] * bhi(u.z); acc[6] += w[6] * blo(u.w); acc[7] += w[7] * bhi(u.w); }
    *(uint4*)(UC + (size_t)row * 1280 + ch) = uint4{pk2(acc[0], acc[1]), pk2(acc[2], acc[3]), pk2(acc[4], acc[5]), pk2(acc[6], acc[7])};
  }
}
__device__ __forceinline__ void ph_lru_s1(const P& p, int d) {
  const unsigned* AB = (const unsigned*)(p.ACT + A_AB); float2* AGG = (float2*)(p.ACT + A_AGG);
  for (int it = blockIdx.x * 2 + (ltid() >> 8); it < 2600; it += gridDim.x * 2) {
    int b = it / 1300, r = it % 1300, cc = r / 5, ch = (r % 5) * 256 + (ltid() & 255);
    float Pp = 1.f, Q = 0.f;
#pragma unroll 8
    for (int t = 0; t < 64; t++) { unsigned u = AB[(size_t)rowmap(d, b, cc * 64 + t) * 1280 + ch]; float a = 1.f - bhi(u), bb = blo(u); Pp *= a; Q = a * Q + bb; }
    AGG[(size_t)(b * NCH_ + cc) * 1280 + ch] = float2{Pp, Q};
  }
}
__device__ __forceinline__ void ph_lru_s2(const P& p) {
  const float2* AGG = (const float2*)(p.ACT + A_AGG); float* CAR = (float*)(p.ACT + A_CAR);
  for (int it = blockIdx.x; it < 5; it += gridDim.x) {
    int idx = it * 512 + ltid(), b = idx / 1280, ch = idx % 1280; float h = 0.f;
#pragma unroll 4
    for (int cc = 0; cc < NCH_; cc++) { size_t o = (size_t)(b * NCH_ + cc) * 1280 + ch; float2 a = AGG[o]; CAR[o] = h; h = a.x * h + a.y; }
  }
}
__device__ __forceinline__ void ph_lru_s3(const P& p, int d) {
  const unsigned* AB = (const unsigned*)(p.ACT + A_AB); const float* CAR = (const float*)(p.ACT + A_CAR);
  bfr* HF = (bfr*)(p.ACT + A_HF); bfr* Z = (bfr*)(p.ACT + A_Z);
  for (int it = blockIdx.x * 2 + (ltid() >> 8); it < 2600; it += gridDim.x * 2) {
    int b = it / 1300, r = it % 1300, cc = r / 5, ch = (r % 5) * 256 + (ltid() & 255);
    float h = CAR[(size_t)(b * NCH_ + cc) * 1280 + ch];
#pragma unroll 8
    for (int t = 0; t < 64; t++) { size_t o = (size_t)rowmap(d, b, cc * 64 + t) * 1280 + ch; unsigned u = AB[o]; h = (1.f - bhi(u)) * h + blo(u);
      if (d == 0) HF[o] = f2b(h); else { float y = b2f(HF[o]) + h; Z[o] = f2b(y * siluf(b2f(Z[o]))); } }
  }
}
__device__ __forceinline__ void ph_ml_stat(const P& p) {
  const bfr* HS = (const bfr*)(p.ACT + A_HS); float* RS = (float*)(p.ACT + A_RSTD);
  const int lane = ltid() & 63, wid = ltid() >> 6;
  for (int it = blockIdx.x; it < 4160; it += gridDim.x) {
    int row = it * 8 + wid; const bfr* hp = HS + (size_t)row * 2048 + lane * 32; float ss = 0.f;
#pragma unroll
    for (int i = 0; i < 4; i++) { uint4 u = *(const uint4*)(hp + i * 8); float a;
      a = blo(u.x); ss += a * a; a = bhi(u.x); ss += a * a; a = blo(u.y); ss += a * a; a = bhi(u.y); ss += a * a;
      a = blo(u.z); ss += a * a; a = bhi(u.z); ss += a * a; a = blo(u.w); ss += a * a; a = bhi(u.w); ss += a * a; }
    ss += __shfl_xor(ss, 1); ss += __shfl_xor(ss, 2); ss += __shfl_xor(ss, 4);
    if ((lane & 7) == 0) RS[(size_t)row * 8 + (lane >> 3)] = rsqrtf(ss * (1.f / 256.f) + 1e-6f);
  }
}
__device__ __forceinline__ void ph_r7_fin(const P& p, int j) {
  bfr* Y = p.H; const bfr* RK = (const bfr*)(p.ACT + A_RKVZ); const float* BON = (const float*)(p.ACT + A_BON);
  const float* lg = p.r7_ln_g + (size_t)j * 1024; const float* lb = p.r7_ln_b + (size_t)j * 1024;
  const int lane = ltid() & 63, wid = ltid() >> 6;
  for (int it = blockIdx.x; it < 4160; it += gridDim.x) {
    int row = it * 8 + wid, ch = lane * 16, hd = lane >> 2;
    float y[16], v[16], z[16];
#pragma unroll
    for (int i = 0; i < 2; i++) {
      uint4 u = *(const uint4*)(Y + (size_t)row * 1024 + ch + i * 8);
      y[i * 8 + 0] = blo(u.x); y[i * 8 + 1] = bhi(u.x); y[i * 8 + 2] = blo(u.y); y[i * 8 + 3] = bhi(u.y); y[i * 8 + 4] = blo(u.z); y[i * 8 + 5] = bhi(u.z); y[i * 8 + 6] = blo(u.w); y[i * 8 + 7] = bhi(u.w);
      u = *(const uint4*)(RK + (size_t)row * 4096 + 2048 + ch + i * 8);
      v[i * 8 + 0] = blo(u.x); v[i * 8 + 1] = bhi(u.x); v[i * 8 + 2] = blo(u.y); v[i * 8 + 3] = bhi(u.y); v[i * 8 + 4] = blo(u.z); v[i * 8 + 5] = bhi(u.z); v[i * 8 + 6] = blo(u.w); v[i * 8 + 7] = bhi(u.w);
      u = *(const uint4*)(RK + (size_t)row * 4096 + 3072 + ch + i * 8);
      z[i * 8 + 0] = blo(u.x); z[i * 8 + 1] = bhi(u.x); z[i * 8 + 2] = blo(u.y); z[i * 8 + 3] = bhi(u.y); z[i * 8 + 4] = blo(u.z); z[i * 8 + 5] = bhi(u.z); z[i * 8 + 6] = blo(u.w); z[i * 8 + 7] = bhi(u.w);
    }
    float s = 0.f;
#pragma unroll
    for (int e = 0; e < 16; e++) s += y[e];
    s += __shfl_xor(s, 1); s += __shfl_xor(s, 2); float mean = s * (1.f / 64.f);
    float q = 0.f;
#pragma unroll
    for (int e = 0; e < 16; e++) { float dlt = y[e] - mean; q += dlt * dlt; }
    q += __shfl_xor(q, 1); q += __shfl_xor(q, 2); float rs = rsqrtf(q * (1.f / 64.f) + 64e-5f);
    float bon = BON[(size_t)row * 16 + hd] + BON[(size_t)(R_ + row) * 16 + hd];
    float o[16];
#pragma unroll
    for (int e = 0; e < 16; e++) { float yn = (y[e] - mean) * rs * lg[ch + e] + lb[ch + e]; o[e] = (yn + bon * v[e]) * siluf(z[e]); }
#pragma unroll
    for (int i = 0; i < 2; i++)
      *(uint4*)(Y + (size_t)row * 1024 + ch + i * 8) = uint4{pk2(o[i * 8], o[i * 8 + 1]), pk2(o[i * 8 + 2], o[i * 8 + 3]), pk2(o[i * 8 + 4], o[i * 8 + 5]), pk2(o[i * 8 + 6], o[i * 8 + 7])};
  }
}

#define QS 136
#define VS 72
#define MLG_BYTES 45056
__device__ __forceinline__ void ph_ml_scan(const P& p, int j, char* smem0) {
  const int d = ltid() >> 8;
  char* smem = smem0 + d * MLG_BYTES;
  bfr* sQ = (bfr*)smem; bfr* sK = sQ + 64 * QS; bfr* sVT = sK + 64 * QS; bfr* sCT = sVT + 16 * VS;
  float* sN = (float*)(sCT + 16 * QS);
  float* sEs = sN + 128; float* sCt = sEs + 64; float* sBc = sCt + 64; float* sWg = sBc + 64; float* sNr = sWg + 64;
  const bfr* QKV = (const bfr*)(p.ACT + A_QKV); const float* GT = (const float*)(p.ACT + A_GATE); bfr* HS = (bfr*)(p.ACT + A_HS);
  const float* gbias = p.ml_gate_b + (size_t)j * 32;
  const int tid = ltid() & 255, lane = tid & 63, w = tid >> 6, l15 = lane & 15, q4 = lane >> 4;
  for (int it = blockIdx.x; it < 256; it += gridDim.x) {
    const int b = it >> 7, hh = (it >> 4) & 7, sl = it & 15;
    f32x4 Cacc[2];
    Cacc[0] = f32x4{0.f, 0.f, 0.f, 0.f}; Cacc[1] = f32x4{0.f, 0.f, 0.f, 0.f};
    float mcur = 0.f;
    for (int i = tid; i < 16 * QS; i += 256) sCT[i] = 0;
    if (tid < 128) sN[tid] = 0.f;
    uint4 pq0, pq1, pq2, pq3, pk0, pk1, pk2, pk3, pv = uint4{0u, 0u, 0u, 0u};
#define ML_ROW0(s_) (d == 0 ? b * BT_ + 64 * (s_) : rowmap(1, b, 64 * (s_) + 63))
#define ML_LD(i_, PQ, PK) { int idx = tid + 256 * (i_), rho = idx >> 4, c8 = idx & 15; const bfr* src = QKV + (size_t)(r0n + rho) * 4096 + hh * 128 + c8 * 8; PQ = *(const uint4*)src; PK = *(const uint4*)(src + 1024); }
#define ML_ISSUE(s_) { const int r0n = ML_ROW0(s_); ML_LD(0, pq0, pk0) ML_LD(1, pq1, pk1) ML_LD(2, pq2, pk2) ML_LD(3, pq3, pk3) \
      if (tid < 128) pv = *(const uint4*)(QKV + (size_t)(r0n + (tid >> 1)) * 4096 + 2048 + hh * 256 + sl * 16 + (tid & 1) * 8); }
#define ML_ST(i_, PQ, PK) { int idx = tid + 256 * (i_), rho = idx >> 4, c8 = idx & 15; *(uint4*)(sQ + rho * QS + c8 * 8) = PQ; *(uint4*)(sK + rho * QS + c8 * 8) = PK; }
#define ML_COMMIT() { ML_ST(0, pq0, pk0) ML_ST(1, pq1, pk1) ML_ST(2, pq2, pk2) ML_ST(3, pq3, pk3) \
      if (tid < 128) { int rho = tid >> 1, vb = (tid & 1) * 8; \
        sVT[(vb + 0) * VS + rho] = (bfr)(pv.x & 0xffff); sVT[(vb + 1) * VS + rho] = (bfr)(pv.x >> 16); \
        sVT[(vb + 2) * VS + rho] = (bfr)(pv.y & 0xffff); sVT[(vb + 3) * VS + rho] = (bfr)(pv.y >> 16); \
        sVT[(vb + 4) * VS + rho] = (bfr)(pv.z & 0xffff); sVT[(vb + 5) * VS + rho] = (bfr)(pv.z >> 16); \
        sVT[(vb + 6) * VS + rho] = (bfr)(pv.w & 0xffff); sVT[(vb + 7) * VS + rho] = (bfr)(pv.w >> 16); } }
    ML_ISSUE(0)
    __syncthreads();
    for (int s = 0; s < NCH_; s++) {
      const int r0 = ML_ROW0(s);
      ML_COMMIT()
      float mxl, decay;
      {
        int rho = d ? 63 - lane : lane; const float* gp = GT + (size_t)(r0 + rho) * 32 + d * 16 + hh;
        float gi = gp[0] + gbias[(d * 2 + 0) * 8 + hh], gf = gp[8] + gbias[(d * 2 + 1) * 8 + hh];
        float fc = fminf(gf, 0.f) - log1pf(__expf(-fabsf(gf)));
        float bc = fc;
        for (int o = 1; o < 64; o <<= 1) { float t = __shfl_up(bc, o); if (lane >= o) bc += t; }
        float e = gi - bc, pm = e;
        for (int o = 1; o < 64; o <<= 1) { float t = __shfl_up(pm, o); if (lane >= o) pm = fmaxf(pm, t); }
        float pml = __shfl(pm, 63), bcl = __shfl(bc, 63);
        mxl = fmaxf(mcur, pml); decay = __expf(mcur - mxl);
        if (w == 0) { sEs[rho] = e; sCt[rho] = -fmaxf(mcur, pm); sBc[rho] = bc; sWg[rho] = __expf(e - mxl); }
        pml = bcl + mxl;
        bcl = mcur; mcur = pml; pml = bcl;
        mxl = pml;
      }
      const float mold = mxl;
      __syncthreads();
      if (s + 1 < NCH_) ML_ISSUE(s + 1)
      bf16x8 qf[4];
#pragma unroll
      for (int ks = 0; ks < 4; ks++) qf[ks] = *(const bf16x8*)(sQ + (16 * w + l15) * QS + ks * 32 + q4 * 8);
      f32x4 sacc[4];
#pragma unroll
      for (int a = 0; a < 4; a++) { sacc[a] = f32x4{0.f, 0.f, 0.f, 0.f};
#pragma unroll
        for (int ks = 0; ks < 4; ks++) { bf16x8 kf = *(const bf16x8*)(sK + (16 * a + l15) * QS + ks * 32 + q4 * 8); sacc[a] = __builtin_amdgcn_mfma_f32_16x16x32_bf16(kf, qf[ks], sacc[a], 0, 0, 0); } }
      const int rt = 16 * w + l15; const float ctt = sCt[rt]; float densum = 0.f;
#pragma unroll
      for (int a = 0; a < 4; a++)
#pragma unroll
        for (int jj = 0; jj < 4; jj++) { int rs_ = 16 * a + 4 * q4 + jj; bool valid = d == 0 ? rs_ <= rt : rs_ >= rt;
          float wv = valid ? __expf(ctt + sEs[rs_]) : 0.f; float sv = sacc[a][jj] * wv; sacc[a][jj] = sv; densum += sv; }
      densum += __shfl_xor(densum, 16); densum += __shfl_xor(densum, 32);
      bf16x8 sf[2], vf[2];
#pragma unroll
      for (int ks = 0; ks < 2; ks++) {
#pragma unroll
        for (int jj = 0; jj < 4; jj++) { sf[ks][jj] = (short)f2b(sacc[2 * ks][jj]); sf[ks][4 + jj] = (short)f2b(sacc[2 * ks + 1][jj]); }
        uint2 v0 = *(const uint2*)(sVT + l15 * VS + 32 * ks + 4 * q4), v1 = *(const uint2*)(sVT + l15 * VS + 32 * ks + 16 + 4 * q4);
        uint4 vv = uint4{v0.x, v0.y, v1.x, v1.y}; vf[ks] = *(bf16x8*)&vv;
      }
      f32x4 num = f32x4{0.f, 0.f, 0.f, 0.f}, numC = f32x4{0.f, 0.f, 0.f, 0.f};
#pragma unroll
      for (int ks = 0; ks < 2; ks++) num = __builtin_amdgcn_mfma_f32_16x16x32_bf16(vf[ks], sf[ks], num, 0, 0, 0);
#pragma unroll
      for (int ks = 0; ks < 4; ks++) { bf16x8 cf = *(const bf16x8*)(sCT + l15 * QS + ks * 32 + q4 * 8); numC = __builtin_amdgcn_mfma_f32_16x16x32_bf16(cf, qf[ks], numC, 0, 0, 0); }
      float qn = 0.f;
#pragma unroll
      for (int i = 0; i < 4; i++) { uint4 u = *(const uint4*)(sQ + rt * QS + 32 * q4 + i * 8); const float* nn = sN + 32 * q4 + i * 8;
        qn += blo(u.x) * nn[0] + bhi(u.x) * nn[1] + blo(u.y) * nn[2] + bhi(u.y) * nn[3] + blo(u.z) * nn[4] + bhi(u.z) * nn[5] + blo(u.w) * nn[6] + bhi(u.w) * nn[7]; }
      qn += __shfl_xor(qn, 16); qn += __shfl_xor(qn, 32);
      {
        float inter = __expf(mold + ctt); float den = densum + inter * qn; float dn = fmaxf(fabsf(den), __expf(ctt - sBc[rt])); float inv = 1.f / dn;
        f32x4 hv;
#pragma unroll
        for (int jj = 0; jj < 4; jj++) hv[jj] = (num[jj] + inter * numC[jj]) * inv;
        int rc = (r0 - b * BT_) >> 6; bool first;
        if (d == 0) { int sp = rc < 4 ? 3 - rc : 263 - rc; first = s < sp; } else first = s < rc;
        bfr* hp = HS + (size_t)(r0 + rt) * 2048 + hh * 256 + sl * 16 + 4 * q4;
        if (!first) { unsigned long long uu = __hip_atomic_load((unsigned long long*)hp, __ATOMIC_RELAXED, __HIP_MEMORY_SCOPE_AGENT); unsigned ux = (unsigned)uu, uy = (unsigned)(uu >> 32);
          hv[0] += blo(ux); hv[1] += bhi(ux); hv[2] += blo(uy); hv[3] += bhi(uy); }
        store4b(hp, hv);
      }
      __syncthreads();
      {
        bf16x8 vw[2];
#pragma unroll
        for (int ks = 0; ks < 2; ks++)
#pragma unroll
          for (int e = 0; e < 8; e++) { int rs_ = 32 * ks + (e < 4 ? 4 * q4 + e : 16 + 4 * q4 + e - 4); vw[ks][e] = (short)f2b(b2f((bfr)vf[ks][e]) * sWg[rs_]); }
#pragma unroll
        for (int a = 0; a < 2; a++) {
          int dk = 32 * w + 16 * a + l15;
#pragma unroll
          for (int jj = 0; jj < 4; jj++) Cacc[a][jj] *= decay;
#pragma unroll
          for (int ks = 0; ks < 2; ks++) { bf16x8 kt;
#pragma unroll
            for (int e = 0; e < 8; e++) { int rs_ = 32 * ks + (e < 4 ? 4 * q4 + e : 16 + 4 * q4 + e - 4); kt[e] = (short)sK[rs_ * QS + dk]; }
            Cacc[a] = __builtin_amdgcn_mfma_f32_16x16x32_bf16(vw[ks], kt, Cacc[a], 0, 0, 0); }
#pragma unroll
          for (int jj = 0; jj < 4; jj++) sCT[(4 * q4 + jj) * QS + dk] = f2b(Cacc[a][jj]);
        }
        int dk = tid & 127, hf = tid >> 7; float part = 0.f;
#pragma unroll 8
        for (int r = 0; r < 32; r++) part += sWg[32 * hf + r] * b2f(sK[(32 * hf + r) * QS + dk]);
        sNr[tid] = part;
      }
      __syncthreads();
      if (tid < 128) sN[tid] = decay * sN[tid] + sNr[tid] + sNr[128 + tid];
    }
    __syncthreads();
  }
}

__device__ __forceinline__ void ph_r7_scan(const P& p, int j, int d, char* smem) {
  float* sW = (float*)smem; float* sKa = sW + 4096; float* sBe = sKa + 4096; float* sKd = sBe + 4096; float* sR = sKd + 4096; float* sV = sR + 4096; float* sY = sV + 512;
  const bfr* RK = (const bfr*)(p.ACT + A_RKVZ); const bfr* SW = (const bfr*)(p.ACT + A_SW); const bfr* AA = (const bfr*)(p.ACT + A_AA);
  float* BON = (float*)(p.ACT + A_BON); bfr* Y = p.H;
  const float* kkp = p.r7_k_k + (size_t)j * 1024; const float* kap = p.r7_k_a + (size_t)j * 1024; const float* rkp = p.r7_r_k + (size_t)j * 1024;
  const int tid = ltid(), lane = tid & 63, w = tid >> 6, kp = lane & 15, rr = lane >> 4;
  const int si = tid >> 3, sc = tid & 7;
  for (int it = blockIdx.x; it < 256; it += gridDim.x) {
    const int b = it >> 7, hh = (it >> 3) & 15, rg = it & 7;
    const int col = hh * 64 + sc * 8;
    float kkc[8], kac[8], rkc[8];
#pragma unroll
    for (int e = 0; e < 8; e++) { kkc[e] = kkp[col + e]; kac[e] = kap[col + e]; rkc[e] = rkp[col + e]; }
    float s0 = 0.f, s1 = 0.f, s2 = 0.f, s3 = 0.f;
    uint4 pr, pk, pv, pw, pa;
#define R7_ISSUE(blk_) { int row = rowmap(d, b, (blk_) * 64 + si); const bfr* rp = RK + (size_t)row * 4096 + col; \
      pr = *(const uint4*)rp; pk = *(const uint4*)(rp + 1024); pv = *(const uint4*)(rp + 2048); \
      pw = *(const uint4*)(SW + (size_t)row * 1024 + col); pa = *(const uint4*)(AA + (size_t)row * 1024 + col); }
    R7_ISSUE(0)
    for (int blk = 0; blk < BT_ / 64; blk++) {
      __syncthreads();
      {
        const int row = rowmap(d, b, blk * 64 + si);
        unsigned ur[4] = {pr.x, pr.y, pr.z, pr.w}, uk[4] = {pk.x, pk.y, pk.z, pk.w}, uv[4] = {pv.x, pv.y, pv.z, pv.w}, uw[4] = {pw.x, pw.y, pw.z, pw.w}, ua[4] = {pa.x, pa.y, pa.z, pa.w};
        float r8[8], k8[8], v8[8], w8[8], a8[8], kr[8];
#pragma unroll
        for (int e = 0; e < 4; e++) { r8[2 * e] = blo(ur[e]); r8[2 * e + 1] = bhi(ur[e]); k8[2 * e] = blo(uk[e]); k8[2 * e + 1] = bhi(uk[e]); v8[2 * e] = blo(uv[e]); v8[2 * e + 1] = bhi(uv[e]);
          w8[2 * e] = blo(uw[e]); w8[2 * e + 1] = bhi(uw[e]); a8[2 * e] = blo(ua[e]); a8[2 * e + 1] = bhi(ua[e]); }
        float ss = 0.f;
#pragma unroll
        for (int e = 0; e < 8; e++) { kr[e] = k8[e] * kkc[e]; ss += kr[e] * kr[e]; }
        ss += __shfl_xor(ss, 1); ss += __shfl_xor(ss, 2); ss += __shfl_xor(ss, 4);
        float inv = 1.f / fmaxf(sqrtf(ss), 1e-12f);
        float bon = 0.f; float ow[8], oka[8], obe[8], okd[8];
#pragma unroll
        for (int e = 0; e < 8; e++) { float ka = kr[e] * inv; oka[e] = ka; obe[e] = a8[e] * ka; float kd = k8[e] * (1.f + (a8[e] - 1.f) * kac[e]); okd[e] = kd; ow[e] = __expf(-w8[e]); bon += r8[e] * kd * rkc[e]; }
        bon += __shfl_xor(bon, 1); bon += __shfl_xor(bon, 2); bon += __shfl_xor(bon, 4);
        if (rg == 0 && sc == 0) BON[((size_t)d * R_ + row) * 16 + hh] = bon;
        int o = si * 64 + sc * 8;
        *(float4*)(sW + o) = float4{ow[0], ow[1], ow[2], ow[3]}; *(float4*)(sW + o + 4) = float4{ow[4], ow[5], ow[6], ow[7]};
        *(float4*)(sKa + o) = float4{oka[0], oka[1], oka[2], oka[3]}; *(float4*)(sKa + o + 4) = float4{oka[4], oka[5], oka[6], oka[7]};
        *(float4*)(sBe + o) = float4{obe[0], obe[1], obe[2], obe[3]}; *(float4*)(sBe + o + 4) = float4{obe[4], obe[5], obe[6], obe[7]};
        *(float4*)(sKd + o) = float4{okd[0], okd[1], okd[2], okd[3]}; *(float4*)(sKd + o + 4) = float4{okd[4], okd[5], okd[6], okd[7]};
        *(float4*)(sR + o) = float4{r8[0], r8[1], r8[2], r8[3]}; *(float4*)(sR + o + 4) = float4{r8[4], r8[5], r8[6], r8[7]};
        if (sc == rg) { *(float4*)(sV + si * 8) = float4{v8[0], v8[1], v8[2], v8[3]}; *(float4*)(sV + si * 8 + 4) = float4{v8[4], v8[5], v8[6], v8[7]}; }
      }
      __syncthreads();
      if (blk + 1 < BT_ / 64) R7_ISSUE(blk + 1)
      if (w < 2) {
        float4 w4 = *(const float4*)(sW + kp * 4), ka4 = *(const float4*)(sKa + kp * 4), be4 = *(const float4*)(sBe + kp * 4);
        float4 kd4 = *(const float4*)(sKd + kp * 4), r4 = *(const float4*)(sR + kp * 4); float vv = sV[w * 4 + rr];
#pragma unroll 4
        for (int i = 0; i < 64; i++) {
          const int in = (i + 1) & 63;
          float4 nw4 = *(const float4*)(sW + in * 64 + kp * 4), nka4 = *(const float4*)(sKa + in * 64 + kp * 4), nbe4 = *(const float4*)(sBe + in * 64 + kp * 4);
          float4 nkd4 = *(const float4*)(sKd + in * 64 + kp * 4), nr4 = *(const float4*)(sR + in * 64 + kp * 4); float nvv = sV[in * 8 + w * 4 + rr];
          float sa = red16((s0 * ka4.x + s1 * ka4.y) + (s2 * ka4.z + s3 * ka4.w));
          s0 = s0 * w4.x + (kd4.x * vv - sa * be4.x); s1 = s1 * w4.y + (kd4.y * vv - sa * be4.y);
          s2 = s2 * w4.z + (kd4.z * vv - sa * be4.z); s3 = s3 * w4.w + (kd4.w * vv - sa * be4.w);
          float y = red16((s0 * r4.x + s1 * r4.y) + (s2 * r4.z + s3 * r4.w));
          if (kp == 0) sY[i * 8 + w * 4 + rr] = y;
          w4 = nw4; ka4 = nka4; be4 = nbe4; kd4 = nkd4; r4 = nr4; vv = nvv;
        }
      }
      __syncthreads();
      if (tid < 64) {
        int row = rowmap(d, b, blk * 64 + tid); bfr* yp = Y + (size_t)row * 1024 + hh * 64 + rg * 8; float yy[8];
#pragma unroll
        for (int e = 0; e < 8; e++) yy[e] = sY[tid * 8 + e];
        if (d == 1) { uint4 u = *(const uint4*)yp; yy[0] += blo(u.x); yy[1] += bhi(u.x); yy[2] += blo(u.y); yy[3] += bhi(u.y); yy[4] += blo(u.z); yy[5] += bhi(u.z); yy[6] += blo(u.w); yy[7] += bhi(u.w); }
        *(uint4*)yp = uint4{pk2(yy[0], yy[1]), pk2(yy[2], yy[3]), pk2(yy[4], yy[5]), pk2(yy[6], yy[7])};
      }
    }
    __syncthreads();
  }
}

__device__ __forceinline__ void run_phase(const P& p, int ph, int layer, int d, char* smem) {
  Ctx c; c.layer = layer; c.j = layer / 3; c.d = d; c.wc = layer < 3 ? 1 : 0;
  switch (ph) {
    case PH_PRE: ph_pre(p, smem); break;
    case PH_NORM: ph_norm(p, layer, smem); break;
    case PH_LRU_IN: gemm_phase<G_LruIn>(p, c, smem); break;
    case PH_LRU_CONV: ph_lru_conv(p, c.j); break;
    case PH_LRU_GATE: gemm_phase<G_LruGate>(p, c, smem); break;
    case PH_LRU_S1: ph_lru_s1(p, d); break;
    case PH_LRU_S2: ph_lru_s2(p); break;
    case PH_LRU_S3: ph_lru_s3(p, d); break;
    case PH_LRU_OUT: gemm_phase<G_LruOut>(p, c, smem); break;
    case PH_ML_IN: gemm_phase<G_MlIn>(p, c, smem); break;
    case PH_ML_SCAN: ph_ml_scan(p, c.j, smem); break;
    case PH_ML_STAT: ph_ml_stat(p); break;
    case PH_ML_Z: gemm_phase<G_MlZ>(p, c, smem); break;
    case PH_ML_OUT: gemm_phase<G_MlOut>(p, c, smem); break;
    case PH_R7_IN: gemm_phase<G_R7In>(p, c, smem); break;
    case PH_R7_UP: gemm_phase<G_R7Up>(p, c, smem); break;
    case PH_R7_SCAN: ph_r7_scan(p, c.j, d, smem); break;
    case PH_R7_FIN: ph_r7_fin(p, c.j); break;
    case PH_R7_OUT: gemm_phase<G_R7Out>(p, c, smem); break;
    case PH_FINAL: ph_final(p); break;
  }
}

#define SMEM_BYTES 131072
extern __shared__ __attribute__((aligned(16))) char dyn_smem[];
#if !MEGA
__global__ void __launch_bounds__(512, 2) phase_kernel(P p, int si) {
  run_phase(p, p.sched[si * 3], p.sched[si * 3 + 1], p.sched[si * 3 + 2], dyn_smem);
}
#else
__global__ void __launch_bounds__(512, 2) mega_kernel(P p) {
  cg::grid_group grid = cg::this_grid();
  for (int si = 0; si < p.nsched; si++) {
    run_phase(p, p.sched[si * 3], p.sched[si * 3 + 1], p.sched[si * 3 + 2], dyn_smem);
    if (si + 1 < p.nsched) grid.sync();
  }
}
#endif

extern "C" void kernel_launch(void* const* d_in, const int* in_sizes, int n_in, void* d_out, int out_size, void* d_ws, size_t ws_size, hipStream_t stream) {
  P p; memset(&p, 0, sizeof(p));
  const float** f = (const float**)&p;
  for (int i = 0; i < 33; i++) f[i] = (const float*)d_in[i];
  char* ws = (char*)d_ws;
  p.Xx = (float*)d_out; p.Xc = (float*)(ws + OFF_XC); p.MOD = (float*)(ws + OFF_MOD); p.W = (bfr*)(ws + OFF_W); p.H = (bfr*)(ws + OFF_H); p.ACT = ws + OFF_ACT;
  int n = 0;
  auto add = [&](int ph, int layer, int d) { p.sched[n * 3] = ph; p.sched[n * 3 + 1] = layer; p.sched[n * 3 + 2] = d; n++; };
  add(PH_PRE, 0, 0);
  if (DUP & 4) add(PH_PRE, 0, 0);
  for (int l = 0; l < 4; l++) {
    add(PH_NORM, l, 0); if (DUP & 4) add(PH_NORM, l, 0);
    int kind = l % 3;
    const bool dg = DUP & 1, ds = DUP & 2;
    if (kind == 0) { add(PH_LRU_IN, l, 0); if (dg) add(PH_LRU_IN, l, 0); add(PH_LRU_CONV, l, 0); if (DUP & 4) add(PH_LRU_CONV, l, 0);
      for (int d = 0; d < 2; d++) { add(PH_LRU_GATE, l, d); if (dg) add(PH_LRU_GATE, l, d); add(PH_LRU_S1, l, d); if (DUP & 8) add(PH_LRU_S1, l, d); add(PH_LRU_S2, l, d); if (DUP & 16) add(PH_LRU_S2, l, d); add(PH_LRU_S3, l, d); }
      add(PH_LRU_OUT, l, 0); }
    else if (kind == 1) { add(PH_ML_IN, l, 0); if (dg) add(PH_ML_IN, l, 0); add(PH_ML_SCAN, l, 0); if (ds) add(PH_ML_SCAN, l, 0); add(PH_ML_STAT, l, 0); if (DUP & 4) add(PH_ML_STAT, l, 0); add(PH_ML_Z, l, 0); add(PH_ML_OUT, l, 0); }
    else { add(PH_R7_IN, l, 0); if (dg) add(PH_R7_IN, l, 0); for (int d = 0; d < 2; d++) { add(PH_R7_UP, l, d); if (dg) add(PH_R7_UP, l, d); add(PH_R7_SCAN, l, d); if (ds && d == 0) add(PH_R7_SCAN, l, d); } add(PH_R7_FIN, l, 0); add(PH_R7_OUT, l, 0); }
  }
  add(PH_FINAL, 0, 0);
  p.nsched = n;
  if (ws_size < WS_NEED) fprintf(stderr, "workspace too small: %zu < %llu\n", ws_size, (unsigned long long)WS_NEED);
#if MEGA
  static int grid_blocks = 0;
  if (!grid_blocks) { int dev = 0, cus = 0, per = 0; hipGetDevice(&dev); hipDeviceGetAttribute(&cus, hipDeviceAttributeMultiprocessorCount, dev);
    hipFuncSetAttribute((const void*)mega_kernel, hipFuncAttributeMaxDynamicSharedMemorySize, SMEM_BYTES);
    hipOccupancyMaxActiveBlocksPerMultiprocessor(&per, mega_kernel, 512, SMEM_BYTES); if (per > 1) per = 1; if (per < 1) per = 1; grid_blocks = cus * per; }
  void* args[] = {&p};
  hipError_t e = hipLaunchCooperativeKernel((void*)mega_kernel, dim3(grid_blocks), dim3(512), args, SMEM_BYTES, stream);
  if (e != hipSuccess) fprintf(stderr, "cooperative launch failed: %s (grid %d)\n", hipGetErrorString(e), grid_blocks);
#else
  static int once = 0; if (!once) { once = 1; hipFuncSetAttribute((const void*)phase_kernel, hipFuncAttributeMaxDynamicSharedMemorySize, SMEM_BYTES); }
  for (int si = 0; si < n; si++) phase_kernel<<<256, 512, SMEM_BYTES, stream>>>(p, si);
#endif
}
```

```cpp
#include <hip/hip_runtime.h>
#include <hip/hip_bf16.h>
#include <hip/hip_cooperative_groups.h>
#include <cstdio>
#include <cstring>
#include <type_traits>
namespace cg = cooperative_groups;

#ifndef DUP
#define DUP 0
#endif
#ifndef MEGA
#define MEGA 1
#endif

typedef unsigned short bfr;
using bf16x8 = __attribute__((ext_vector_type(8))) short;
using f32x4 = __attribute__((ext_vector_type(4))) float;

#define R_ 33280
#define BT_ 16640
#define NCH_ 260

#define OFF_XC 0ull
#define OFF_MOD 2097152ull
#define OFF_W 2244608ull
#define OFF_H 24264704ull
#define OFF_ACT 92422144ull
#define A_Z 0ull
#define A_UC 85196800ull
#define A_AB 170393600ull
#define A_U 170393600ull
#define A_HF 340787200ull
#define A_AGG 425984000ull
#define A_CAR 431308800ull
#define A_QKV 0ull
#define A_GATE 272629760ull
#define A_HS 276889600ull
#define A_RSTD 413204480ull
#define A_R7B 68157440ull
#define A_RKVZ (A_R7B + 0ull)
#define A_WM (A_R7B + 272629760ull)
#define A_AM (A_R7B + 281149440ull)
#define A_BON (A_R7B + 289669120ull)
#define A_Y (A_R7B + 293928960ull)
#define WS_NEED (OFF_ACT + 434000000ull)

#define WL_GATE (2560 * 1024)
#define WL_OUT (WL_GATE + 1310720)
#define WM_Z (4352 * 1024)
#define WM_OUT (WM_Z + 2048 * 1024)
#define WR_UP (4352 * 2048)
#define WR_OUT (WR_UP + 262144)

enum { PH_PRE = 0, PH_NORM, PH_LRU_IN, PH_LRU_CONV, PH_LRU_GATE, PH_LRU_S1, PH_LRU_S2, PH_LRU_S3, PH_LRU_OUT,
       PH_ML_IN, PH_ML_SCAN, PH_ML_STAT, PH_ML_Z, PH_ML_OUT,
       PH_R7_IN, PH_R7_UP, PH_R7_SCAN, PH_R7_FIN, PH_R7_OUT, PH_FINAL, PH_R7_SHIFT };

struct P {
  const float *x, *c, *ctx, *c_ctx, *norm_g, *mod_w, *mod_b, *final_g;
  const float *lru_w_in, *lru_conv_w, *lru_conv_b, *lru_gate_w, *lru_gate_b, *lru_lam, *lru_w_out;
  const float *ml_w_in, *ml_gate_b, *ml_norm_g, *ml_w_out;
  const float *r7_mu, *r7_w_rkvz, *r7_w0, *r7_w1, *r7_w2, *r7_a0, *r7_a1, *r7_a2, *r7_k_k, *r7_k_a, *r7_r_k, *r7_ln_g, *r7_ln_b, *r7_w_out;
  float* Xx; float* Xc; float* MOD; bfr* W; bfr* H; char* ACT;
  int nsched; int pad_;
  int sched[64 * 3];
};
struct Ctx { int layer, j, d, wc; };

__device__ __forceinline__ int ltid() { int t = threadIdx.x; asm volatile("" : "+v"(t)); return t; }
__device__ __forceinline__ bfr f2b(float f) { unsigned u = __float_as_uint(f); u += 0x7fffu + ((u >> 16) & 1u); return (bfr)(u >> 16); }
__device__ __forceinline__ float b2f(bfr b) { return __uint_as_float(((unsigned)b) << 16); }
__device__ __forceinline__ unsigned pk2(float a, float b) { return (unsigned)f2b(a) | (((unsigned)f2b(b)) << 16); }
__device__ __forceinline__ float blo(unsigned u) { return __uint_as_float(u << 16); }
__device__ __forceinline__ float bhi(unsigned u) { return __uint_as_float(u & 0xffff0000u); }
__device__ __forceinline__ void store4b(bfr* dst, f32x4 v) { uint2 u; u.x = pk2(v[0], v[1]); u.y = pk2(v[2], v[3]); *(uint2*)dst = u; }
__device__ __forceinline__ float sigm(float x) { return 1.f / (1.f + __expf(-x)); }
__device__ __forceinline__ float siluf(float x) { return x * sigm(x); }
__device__ __forceinline__ float softplusf(float x) { return x > 20.f ? x : log1pf(expf(x)); }
__device__ __forceinline__ int rowmap(int d, int b, int pp) { int o = d == 0 ? pp : (pp < 256 ? 255 - pp : 16895 - pp); return b * BT_ + o; }
__device__ __forceinline__ float* xrowp(const P& p, int row, int& mi) {
  int b = row / BT_, o = row - b * BT_;
  if (o < 256) { mi = 2; return p.Xc + (size_t)(b * 256 + o) * 1024; }
  mi = b; return p.Xx + (size_t)(b * 16384 + o - 256) * 1024;
}
__device__ __forceinline__ float wsum(float v) { for (int o = 32; o; o >>= 1) v += __shfl_xor(v, o); return v; }
template <int CTRL> __device__ __forceinline__ float dppf(float x) {
  return __int_as_float(__builtin_amdgcn_update_dpp(0, __float_as_int(x), CTRL, 0xf, 0xf, true));
}
__device__ __forceinline__ float red16(float x) {
  x += dppf<0xB1>(x); x += dppf<0x4E>(x); x += dppf<0x141>(x); x += dppf<0x140>(x); return x;
}

template <class F> __device__ __forceinline__ void prep_tile(bfr* dst, int K, int tn, int tk, F get, float* sm) {
  int tid = ltid();
  for (int i = 0; i < 8; i++) { int kk = (tid >> 6) + 8 * i, nn = tid & 63; sm[kk * 65 + nn] = get(tk * 64 + kk, tn * 64 + nn); }
  __syncthreads();
  for (int i = 0; i < 8; i++) { int nn = (tid >> 6) + 8 * i, kk = tid & 63; dst[(size_t)(tn * 64 + nn) * K + tk * 64 + kk] = f2b(sm[kk * 65 + nn]); }
  __syncthreads();
}
__device__ __forceinline__ int prep_count(int layer) { int kind = layer % 3; return kind == 0 ? (640 + 320 + 320) : kind == 1 ? (1088 + 512 + 512) : (2176 + 64 + 256); }
__device__ __forceinline__ void prep_item(const P& p, int layer, int it, float* sm) {
  int kind = layer % 3, j = layer / 3;
  if (kind == 0) {
    if (it < 640) { int tn = it / 16, tk = it % 16; const float* s = p.lru_w_in + (size_t)j * 1024 * 2560;
      prep_tile(p.W, 1024, tn, tk, [=](int k, int n) { return s[(size_t)k * 2560 + n]; }, sm); return; }
    it -= 640;
    if (it < 320) { int d = it / 160, r = it % 160, tn = r / 2, tk = r % 2; const float* s = p.lru_gate_w + (size_t)(j * 2 + d) * 2 * 10 * 16384;
      prep_tile(p.W + WL_GATE + d * 655360, 128, tn, tk, [=](int k, int n) {
        int nt = n >> 7, blk = nt >> 1, sub = nt & 1, jj = n & 127, wn = jj >> 6, rr = jj & 63, g = rr >> 5, c = rr & 31;
        int kch = sub * 64 + wn * 32 + c; return s[((size_t)(g * 10 + blk) * 128 + k) * 128 + kch]; }, sm); return; }
    it -= 320;
    { int tn = it / 20, tk = it % 20; const float* s = p.lru_w_out + (size_t)j * 1280 * 1024;
      prep_tile(p.W + WL_OUT, 1280, tn, tk, [=](int k, int n) { return s[(size_t)k * 1024 + n]; }, sm); return; }
  } else if (kind == 1) {
    const float* s = p.ml_w_in + (size_t)j * 1024 * 6176;
    if (it < 1088) { int tn = it / 16, tk = it % 16;
      prep_tile(p.W, 1024, tn, tk, [=](int k, int n) {
        if (n < 4096) { float v = s[(size_t)k * 6176 + n]; return (n >= 1024 && n < 2048) ? v * 0.08838834764831845f : v; }
        if (n < 4128) return s[(size_t)k * 6176 + 6144 + (n - 4096)];
        return 0.f; }, sm); return; }
    it -= 1088;
    if (it < 512) { int tn = it / 16, tk = it % 16;
      prep_tile(p.W + WM_Z, 1024, tn, tk, [=](int k, int n) { return s[(size_t)k * 6176 + 4096 + n]; }, sm); return; }
    it -= 512;
    { int tn = it / 32, tk = it % 32; const float* so = p.ml_w_out + (size_t)j * 2048 * 1024;
      prep_tile(p.W + WM_OUT, 2048, tn, tk, [=](int k, int n) { return so[(size_t)k * 1024 + n]; }, sm); return; }
  } else {
    if (it < 2176) { int tn = it / 32, tk = it % 32;
      const float* mu = p.r7_mu + (size_t)j * 6 * 1024; const float* wr = p.r7_w_rkvz + (size_t)j * 4 * 1024 * 1024;
      const float* w1 = p.r7_w1 + (size_t)j * 2 * 1024 * 64; const float* a1 = p.r7_a1 + (size_t)j * 2 * 1024 * 64;
      prep_tile(p.W, 2048, tn, tk, [=](int k, int n) {
        int kk = k & 1023; float v, m;
        if (n < 4096) { int g = n >> 10, e = n & 1023; m = mu[g * 1024 + kk]; v = wr[((size_t)g * 1024 + kk) * 1024 + e]; }
        else if (n < 4224) { int xx = (n - 4096) >> 6, rr = (n - 4096) & 63; m = mu[4 * 1024 + kk]; v = w1[((size_t)xx * 1024 + kk) * 64 + rr]; }
        else { int xx = (n - 4224) >> 6, rr = (n - 4224) & 63; m = mu[5 * 1024 + kk]; v = a1[((size_t)xx * 1024 + kk) * 64 + rr]; }
        return (k < 1024 ? (1.f - m) : m) * v; }, sm); return; }
    it -= 2176;
    if (it < 64) { int u = it / 16, tn = it % 16; const float* s = (u < 2 ? p.r7_w2 : p.r7_a2) + (size_t)(j * 2 + (u & 1)) * 64 * 1024;
      prep_tile(p.W + WR_UP + u * 65536, 64, tn, 0, [=](int k, int n) { return s[(size_t)k * 1024 + n]; }, sm); return; }
    it -= 64;
    { int tn = it / 16, tk = it % 16; const float* s = p.r7_w_out + (size_t)j * 1024 * 1024;
      prep_tile(p.W + WR_OUT, 1024, tn, tk, [=](int k, int n) { return s[(size_t)k * 1024 + n]; }, sm); return; }
  }
}

#define LDSS 72
template <class G> __device__ __forceinline__ void gemm_tile(const P& p, const Ctx& c, int mt, int nt, char* smem) {
  const int tid = ltid(), lane = tid & 63, wid = tid >> 6, wm = wid & 3, wn = wid >> 2;
  bfr* sA = (bfr*)smem; bfr* sB = sA + 2 * 256 * LDSS;
  f32x4 acc[4][4];
  for (int a = 0; a < 4; a++) for (int b = 0; b < 4; b++) acc[a][b] = f32x4{0.f, 0.f, 0.f, 0.f};
  const int lr = tid >> 3, lc = tid & 7;
  uint4 ra[4], rb[2];
  auto gload = [&](int kt) __attribute__((always_inline)) {
#pragma unroll
    for (int i = 0; i < 4; i++) {
      const bfr* pa = G::aptr(p, c, mt * 256 + lr + 64 * i, kt, nt);
      ra[i] = pa ? *(const uint4*)(pa + lc * 8) : uint4{0u, 0u, 0u, 0u};
      if (i < 2) rb[i] = *(const uint4*)(G::bptr(p, c, nt * 128 + lr + 64 * i, kt) + lc * 8);
    }
  };
  auto sstore = [&](int buf) __attribute__((always_inline)) {
#pragma unroll
    for (int i = 0; i < 4; i++) {
      *(uint4*)(sA + (buf * 256 + lr + 64 * i) * LDSS + lc * 8) = ra[i];
      if (i < 2) *(uint4*)(sB + (buf * 128 + lr + 64 * i) * LDSS + lc * 8) = rb[i];
    }
  };
  gload(0); sstore(0); __syncthreads();
  for (int kt = 0; kt < G::KT; kt++) {
    const int buf = kt & 1;
    if (kt + 1 < G::KT) gload(kt + 1);
#pragma unroll
    for (int ks = 0; ks < 2; ks++) {
      bf16x8 af[4], bf[4];
#pragma unroll
      for (int i = 0; i < 4; i++) {
        af[i] = *(const bf16x8*)(sA + (buf * 256 + wm * 64 + i * 16 + (lane & 15)) * LDSS + ks * 32 + (lane >> 4) * 8);
        bf[i] = *(const bf16x8*)(sB + (buf * 128 + wn * 64 + i * 16 + (lane & 15)) * LDSS + ks * 32 + (lane >> 4) * 8);
      }
#pragma unroll
      for (int n = 0; n < 4; n++)
#pragma unroll
        for (int m = 0; m < 4; m++) acc[n][m] = __builtin_amdgcn_mfma_f32_16x16x32_bf16(bf[n], af[m], acc[n][m], 0, 0, 0);
    }
    if (kt + 1 < G::KT) sstore(buf ^ 1);
    __syncthreads();
  }
  G::epi(p, c, acc, mt * 256 + wm * 64, nt * 128 + wn * 64, lane);
}

__device__ __forceinline__ void epi_resid(const P& p, const Ctx& c, f32x4 (&acc)[4][4], int m0, int n0, int lane) {
#pragma unroll
  for (int mi = 0; mi < 4; mi++) {
    int row = m0 + mi * 16 + (lane & 15); int mo; float* xr = xrowp(p, row, mo);
    if (mo == 2 && !c.wc) continue;
    const float* g = p.MOD + (size_t)(c.layer * 3 + mo) * 3072 + 2048;
#pragma unroll
    for (int ni = 0; ni < 4; ni++) {
      int n = n0 + ni * 16 + (lane >> 4) * 4;
      float4 xv = *(float4*)(xr + n); float4 gg = *(const float4*)(g + n);
      xv.x += gg.x * acc[ni][mi][0]; xv.y += gg.y * acc[ni][mi][1]; xv.z += gg.z * acc[ni][mi][2]; xv.w += gg.w * acc[ni][mi][3];
      *(float4*)(xr + n) = xv;
    }
  }
}

struct G_LruIn { static constexpr int KT = 16, NT = 20;
  static __device__ __forceinline__ const bfr* aptr(const P& p, const Ctx& c, int row, int kt, int nt) { return p.H + (size_t)row * 1024 + kt * 64; }
  static __device__ __forceinline__ const bfr* bptr(const P& p, const Ctx& c, int n, int kt) { return p.W + (size_t)n * 1024 + kt * 64; }
  static __device__ __forceinline__ void epi(const P& p, const Ctx& c, f32x4 (&acc)[4][4], int m0, int n0, int lane) {
    bfr* U = (bfr*)(p.ACT + A_U); bfr* Z = (bfr*)(p.ACT + A_Z);
#pragma unroll
    for (int ni = 0; ni < 4; ni++)
#pragma unroll
      for (int mi = 0; mi < 4; mi++) {
        int row = m0 + mi * 16 + (lane & 15), n = n0 + ni * 16 + (lane >> 4) * 4;
        bfr* dst = n < 1280 ? U + (size_t)row * 1280 + n : Z + (size_t)row * 1280 + (n - 1280);
        store4b(dst, acc[ni][mi]);
      }
  } };
struct G_LruGate { static constexpr int KT = 2, NT = 20;
  static __device__ __forceinline__ const bfr* aptr(const P& p, const Ctx& c, int row, int kt, int nt) { return (const bfr*)(p.ACT + A_UC) + (size_t)row * 1280 + (nt >> 1) * 128 + kt * 64; }
  static __device__ __forceinline__ const bfr* bptr(const P& p, const Ctx& c, int n, int kt) { return p.W + WL_GATE + c.d * 655360 + (size_t)n * 128 + kt * 64; }
  static __device__ __forceinline__ void epi(const P& p, const Ctx& c, f32x4 (&acc)[4][4], int m0, int n0, int lane) {
    const bfr* UC = (const bfr*)(p.ACT + A_UC); unsigned* AB = (unsigned*)(p.ACT + A_AB);
    const float* gb = p.lru_gate_b + (size_t)(c.j * 2 + c.d) * 2 * 1280; const float* lam = p.lru_lam + (size_t)(c.j * 2 + c.d) * 1280;
    int chb = (n0 >> 6) * 32;
#pragma unroll
    for (int ni = 0; ni < 2; ni++) {
      int ch = chb + ni * 16 + (lane >> 4) * 4;
      float cl[4], br[4], bi[4];
#pragma unroll
      for (int q = 0; q < 4; q++) { cl[q] = 8.f * softplusf(-lam[ch + q]); br[q] = gb[ch + q]; bi[q] = gb[1280 + ch + q]; }
#pragma unroll
      for (int mi = 0; mi < 4; mi++) {
        int row = m0 + mi * 16 + (lane & 15);
        uint2 u = *(const uint2*)(UC + (size_t)row * 1280 + ch);
        float uc[4] = {blo(u.x), bhi(u.x), blo(u.y), bhi(u.y)};
        unsigned o[4];
#pragma unroll
        for (int q = 0; q < 4; q++) {
          float r = sigm(acc[ni][mi][q] + br[q]), ig = sigm(acc[ni + 2][mi][q] + bi[q]);
          float la = -cl[q] * r; float oma = -expm1f(la); float bb = sqrtf(-expm1f(2.f * la)) * ig * uc[q];
          o[q] = (((unsigned)f2b(oma)) << 16) | (unsigned)f2b(bb);
        }
        *(uint4*)(AB + (size_t)row * 1280 + ch) = uint4{o[0], o[1], o[2], o[3]};
      }
    }
  } };
struct G_LruOut { static constexpr int KT = 20, NT = 8;
  static __device__ __forceinline__ const bfr* aptr(const P& p, const Ctx& c, int row, int kt, int nt) { return (const bfr*)(p.ACT + A_Z) + (size_t)row * 1280 + kt * 64; }
  static __device__ __forceinline__ const bfr* bptr(const P& p, const Ctx& c, int n, int kt) { return p.W + WL_OUT + (size_t)n * 1280 + kt * 64; }
  static __device__ __forceinline__ void epi(const P& p, const Ctx& c, f32x4 (&acc)[4][4], int m0, int n0, int lane) { epi_resid(p, c, acc, m0, n0, lane); } };
struct G_MlIn { static constexpr int KT = 16, NT = 33;
  static __device__ __forceinline__ const bfr* aptr(const P& p, const Ctx& c, int row, int kt, int nt) { return p.H + (size_t)row * 1024 + kt * 64; }
  static __device__ __forceinline__ const bfr* bptr(const P& p, const Ctx& c, int n, int kt) { return p.W + (size_t)n * 1024 + kt * 64; }
  static __device__ __forceinline__ void epi(const P& p, const Ctx& c, f32x4 (&acc)[4][4], int m0, int n0, int lane) {
    bfr* QKV = (bfr*)(p.ACT + A_QKV); float* GT = (float*)(p.ACT + A_GATE);
#pragma unroll
    for (int ni = 0; ni < 4; ni++)
#pragma unroll
      for (int mi = 0; mi < 4; mi++) {
        int row = m0 + mi * 16 + (lane & 15), n = n0 + ni * 16 + (lane >> 4) * 4;
        if (n < 4096) store4b(QKV + (size_t)row * 4096 + n, acc[ni][mi]);
        else if (n < 4128) *(float4*)(GT + (size_t)row * 32 + (n - 4096)) = float4{acc[ni][mi][0], acc[ni][mi][1], acc[ni][mi][2], acc[ni][mi][3]};
      }
  } };
struct G_MlZ { static constexpr int KT = 16, NT = 16;
  static __device__ __forceinline__ const bfr* aptr(const P& p, const Ctx& c, int row, int kt, int nt) { return p.H + (size_t)row * 1024 + kt * 64; }
  static __device__ __forceinline__ const bfr* bptr(const P& p, const Ctx& c, int n, int kt) { return p.W + WM_Z + (size_t)n * 1024 + kt * 64; }
  static __device__ __forceinline__ void epi(const P& p, const Ctx& c, f32x4 (&acc)[4][4], int m0, int n0, int lane) {
    bfr* HS = (bfr*)(p.ACT + A_HS); const float* RS = (const float*)(p.ACT + A_RSTD); const float* ng = p.ml_norm_g + (size_t)c.j * 2048;
#pragma unroll
    for (int ni = 0; ni < 4; ni++)
#pragma unroll
      for (int mi = 0; mi < 4; mi++) {
        int row = m0 + mi * 16 + (lane & 15), n = n0 + ni * 16 + (lane >> 4) * 4;
        bfr* hp = HS + (size_t)row * 2048 + n; uint2 u = *(const uint2*)hp; float rs = RS[(size_t)row * 8 + (n >> 8)];
        float4 g4 = *(const float4*)(ng + n);
        f32x4 o;
        o[0] = blo(u.x) * rs * g4.x * siluf(acc[ni][mi][0]); o[1] = bhi(u.x) * rs * g4.y * siluf(acc[ni][mi][1]);
        o[2] = blo(u.y) * rs * g4.z * siluf(acc[ni][mi][2]); o[3] = bhi(u.y) * rs * g4.w * siluf(acc[ni][mi][3]);
        store4b(hp, o);
      }
  } };
struct G_MlOut { static constexpr int KT = 32, NT = 8;
  static __device__ __forceinline__ const bfr* aptr(const P& p, const Ctx& c, int row, int kt, int nt) { return (const bfr*)(p.ACT + A_HS) + (size_t)row * 2048 + kt * 64; }
  static __device__ __forceinline__ const bfr* bptr(const P& p, const Ctx& c, int n, int kt) { return p.W + WM_OUT + (size_t)n * 2048 + kt * 64; }
  static __device__ __forceinline__ void epi(const P& p, const Ctx& c, f32x4 (&acc)[4][4], int m0, int n0, int lane) { epi_resid(p, c, acc, m0, n0, lane); } };
struct G_R7In { static constexpr int KT = 32, NT = 34;
  static __device__ __forceinline__ const bfr* aptr(const P& p, const Ctx& c, int row, int kt, int nt) {
    if (kt < 16) return p.H + (size_t)row * 1024 + kt * 64;
    int q = (kt - 16) >> 2; int b = row / BT_, o = row - b * BT_; int nr;
    if (o < 256) { if (q < 2) { if (o < 1) return nullptr; nr = row - 1; } else { if (o >= 255) return nullptr; nr = row + 1; } }
    else { int t = o - 256, col = t & 63, gr = t >> 6;
      if (q == 0) { if (col == 0) return nullptr; nr = row - 1; }
      else if (q == 1) { if (col == 63) return nullptr; nr = row + 1; }
      else if (q == 2) { if (gr == 0) return nullptr; nr = row - 64; }
      else { if (gr == 255) return nullptr; nr = row + 64; } }
    return p.H + (size_t)nr * 1024 + (kt - 16) * 64; }
  static __device__ __forceinline__ const bfr* bptr(const P& p, const Ctx& c, int n, int kt) { return p.W + (size_t)n * 2048 + kt * 64; }
  static __device__ __forceinline__ void epi(const P& p, const Ctx& c, f32x4 (&acc)[4][4], int m0, int n0, int lane) {
    bfr* RK = (bfr*)(p.ACT + A_RKVZ); bfr* WMb = (bfr*)(p.ACT + A_WM); bfr* AMb = (bfr*)(p.ACT + A_AM);
#pragma unroll
    for (int ni = 0; ni < 4; ni++)
#pragma unroll
      for (int mi = 0; mi < 4; mi++) {
        int row = m0 + mi * 16 + (lane & 15), n = n0 + ni * 16 + (lane >> 4) * 4;
        if (n < 4096) store4b(RK + (size_t)row * 4096 + n, acc[ni][mi]);
        else if (n < 4224) { f32x4 t;
#pragma unroll
          for (int q = 0; q < 4; q++) t[q] = tanhf(acc[ni][mi][q]); store4b(WMb + (size_t)row * 128 + (n - 4096), t); }
        else store4b(AMb + (size_t)row * 128 + (n - 4224), acc[ni][mi]);
      }
  } };
struct G_R7Up { static constexpr int KT = 1, NT = 32;
  static __device__ __forceinline__ const bfr* aptr(const P& p, const Ctx& c, int row, int kt, int nt) { return (const bfr*)(p.ACT + ((nt & 15) < 8 ? A_WM : A_AM)) + (size_t)row * 128 + (nt >> 4) * 64; }
  static __device__ __forceinline__ const bfr* bptr(const P& p, const Ctx& c, int n, int kt) { int ds = n >> 11, m = n & 2047; return p.W + WR_UP + ((m < 1024 ? 0 : 2) + ds) * 65536 + (size_t)(m & 1023) * 64; }
  static __device__ __forceinline__ void epi(const P& p, const Ctx& c, f32x4 (&acc)[4][4], int m0, int n0, int lane) {
    unsigned char* Q8 = (unsigned char*)p.H;
#pragma unroll
    for (int ni = 0; ni < 4; ni++)
#pragma unroll
      for (int mi = 0; mi < 4; mi++) {
        int row = m0 + mi * 16 + (lane & 15), n = n0 + ni * 16 + (lane >> 4) * 4; int ds = n >> 11, m = n & 2047, e = m & 1023; unsigned pkd = 0;
        if (m < 1024) { const float* w0 = p.r7_w0 + (size_t)(c.j * 2 + ds) * 1024;
#pragma unroll
          for (int q = 0; q < 4; q++) { float sw = 0.6065306597126334f * sigm(w0[e + q] + acc[ni][mi][q]); float lq = (log2f(sw) + 13.f) * 20.f + 0.5f; int qi = (int)fminf(fmaxf(lq, 0.f), 255.f); pkd |= (unsigned)qi << (8 * q); }
          *(unsigned*)(Q8 + ((size_t)ds * R_ + row) * 1024 + e) = pkd; }
        else { const float* a0 = p.r7_a0 + (size_t)(c.j * 2 + ds) * 1024;
#pragma unroll
          for (int q = 0; q < 4; q++) { float a = sigm(a0[e + q] + acc[ni][mi][q]); int qi = (int)(a * 255.f + 0.5f); pkd |= (unsigned)qi << (8 * q); }
          *(unsigned*)(Q8 + ((size_t)(2 + ds) * R_ + row) * 1024 + e) = pkd; }
      }
  } };
struct G_R7Out { static constexpr int KT = 16, NT = 8;
  static __device__ __forceinline__ const bfr* aptr(const P& p, const Ctx& c, int row, int kt, int nt) { return p.H + (size_t)row * 1024 + kt * 64; }
  static __device__ __forceinline__ const bfr* bptr(const P& p, const Ctx& c, int n, int kt) { return p.W + WR_OUT + (size_t)n * 1024 + kt * 64; }
  static __device__ __forceinline__ void epi(const P& p, const Ctx& c, f32x4 (&acc)[4][4], int m0, int n0, int lane) { epi_resid(p, c, acc, m0, n0, lane); } };


namespace pg8 {
#define PG8_LAS __attribute__((address_space(3)))
constexpr int BM = 256, BK = 64, HALF = 128, HTB = HALF * BK * 2, NXCD = 8, WGM = 8;
__device__ __forceinline__ int lds_byte(int r, int c) { const int st = (r >> 4) * 2 + (c >> 5), rr = r & 15, cc = c & 31, ob = rr * 64 + cc * 2; return st * 1024 + (ob ^ (((ob >> 9) & 1) << 5)); }
__device__ __forceinline__ void stage_rc(int b, int& R, int& C) { const int st = b / 1024, sb = b % 1024, swz = sb ^ (((sb >> 9) & 1) << 5); R = (st >> 1) * 16 + swz / 64; C = (st & 1) * 32 + (swz % 64) / 2; }
struct Unit { int pm, pn; };
struct Gemm { const bfr* A; const bfr* Bt; int M, N, K; };
struct StaticOrder {
  int nM, nN, nwg, G, c;
  __device__ void init(int M, int N, int G_, int c_) { nM = M / BM; nN = N / BM; nwg = nM * nN; G = G_; c = c_; }
  __device__ bool next(int i, Unit& u) const {
    const long L = (long)i * G + c; if (L >= nwg) return false;
    int wgid = (int)L; { const int q = nwg / NXCD, r = nwg % NXCD, xcd = wgid % NXCD, off = wgid / NXCD; wgid = (xcd < r ? xcd * (q + 1) : r * (q + 1) + (xcd - r) * q) + off; }
    const int nig = WGM * nN, gid = wgid / nig, fm = gid * WGM, gsz = (nM - fm) < WGM ? (nM - fm) : WGM;
    u.pm = fm + ((wgid % nig) % gsz); u.pn = (wgid % nig) / gsz; return true;
  }
};
template <class Epi>
__device__ __forceinline__ void gemm_phase(PG8_LAS unsigned char* lds, const Gemm g, const StaticOrder& S, const Epi& E) {
  const int tid = ltid(), wid = __builtin_amdgcn_readfirstlane(tid >> 6), lane = tid & 63, wr = wid >> 2, wc = wid & 3, fr = lane & 15, fq = lane >> 4;
  const int K = g.K, nt = K / BK;
  unsigned voffA[2], voffB[2];
#pragma unroll
  for (int i = 0; i < 2; ++i) { int R, C; stage_rc(tid * 16 + i * 8192, R, C); voffA[i] = (unsigned)(R * K + C) * 2u; voffB[i] = voffA[i]; }
  const size_t kstep = (size_t)(BK * 2);
  const size_t hstep = (size_t)HALF * K * 2;
  const size_t tstep = 2 * hstep;
  const unsigned ldsw = (unsigned)wid * 1024u;
  const int aoff = lds_byte(wr * 64 + fr, fq * 8), boff = lds_byte(wc * 32 + fr, fq * 8);
#define PG8_SA(b, h) (((b) * 2 + (h)) * HTB)
#define PG8_SB(b, h) ((4 + (b) * 2 + (h)) * HTB)
#define PG8_STAGE(bufoff, gbase, voff) do { _Pragma("unroll") for (int _i = 0; _i < 2; ++_i) \
    __builtin_amdgcn_global_load_lds((const unsigned*)((const char*)(gbase) + (voff)[_i]), (PG8_LAS unsigned*)(lds + (bufoff) + ldsw + _i * 8192), 16, 0, 0); } while (0)
#define PG8_LDA(dst, b, h) do { _Pragma("unroll") for (int m = 0; m < 4; ++m) _Pragma("unroll") for (int k = 0; k < 2; ++k) dst[m][k] = *(const PG8_LAS bf16x8*)(lds + PG8_SA(b, h) + aoff + m * 2048 + k * 1024); } while (0)
#define PG8_LDB(dst, b, h) do { _Pragma("unroll") for (int n = 0; n < 2; ++n) _Pragma("unroll") for (int k = 0; k < 2; ++k) dst[n][k] = *(const PG8_LAS bf16x8*)(lds + PG8_SB(b, h) + boff + n * 2048 + k * 1024); } while (0)
#define PG8_MMA(ai, bj, At, Bt) do { __builtin_amdgcn_s_setprio(1); _Pragma("unroll") for (int m = 0; m < 4; ++m) _Pragma("unroll") for (int n = 0; n < 2; ++n) _Pragma("unroll") for (int k = 0; k < 2; ++k) \
    acc[ai][bj][m][n] = __builtin_amdgcn_mfma_f32_16x16x32_bf16(Bt[n][k], At[m][k], acc[ai][bj][m][n], 0, 0, 0); __builtin_amdgcn_s_setprio(0); } while (0)
#define PG8_WAIT_V(n) asm volatile("s_waitcnt vmcnt(" #n ")" ::: "memory")
#define PG8_WAIT_L(n) asm volatile("s_waitcnt lgkmcnt(" #n ")" ::: "memory")
#define PG8_BAR __builtin_amdgcn_s_barrier()
#define PG8_SCHED __builtin_amdgcn_sched_barrier(0)
  Unit cur, nxt; int ui = 0;
  if (!S.next(0, cur)) return;
  f32x4 acc[2][2][4][2];
#pragma unroll
  for (int a = 0; a < 2; ++a)
#pragma unroll
    for (int b = 0; b < 2; ++b)
#pragma unroll
      for (int m = 0; m < 4; ++m)
#pragma unroll
        for (int n = 0; n < 2; ++n) acc[a][b][m][n] = (f32x4){0.f, 0.f, 0.f, 0.f};
  bf16x8 At[4][2], B0[2][2], B1[2][2];
  const char* cA = (const char*)g.A + (size_t)cur.pm * tstep; const char* cB = (const char*)g.Bt + (size_t)cur.pn * tstep;
  PG8_STAGE(PG8_SB(0, 0), cB, voffB); PG8_STAGE(PG8_SA(0, 0), cA, voffA); PG8_STAGE(PG8_SB(0, 1), cB + hstep, voffB); PG8_STAGE(PG8_SA(0, 1), cA + hstep, voffA);
  if (wr == 1) PG8_BAR;
  PG8_WAIT_V(4); PG8_BAR;
  PG8_STAGE(PG8_SB(1, 0), cB + kstep, voffB); PG8_STAGE(PG8_SA(1, 0), cA + kstep, voffA); PG8_STAGE(PG8_SB(1, 1), cB + hstep + kstep, voffB);
  PG8_WAIT_V(6); PG8_BAR;
  for (;;) {
    const bool has_next = S.next(ui + 1, nxt);
    const char* nA = has_next ? (const char*)g.A + (size_t)nxt.pm * tstep : cA; const char* nB = has_next ? (const char*)g.Bt + (size_t)nxt.pn * tstep : cB;
    for (int t = 0; t < nt; t += 2) {
      const bool last = (t == nt - 2);
      const char* a1 = cA + (size_t)(t + 1) * kstep;
      const char* a2 = last ? nA : cA + (size_t)(t + 2) * kstep; const char* b2 = last ? nB : cB + (size_t)(t + 2) * kstep;
      const char* a3 = a2 + kstep; const char* b3 = b2 + kstep;
      PG8_LDB(B0, 0, 0); PG8_SCHED; PG8_LDA(At, 0, 0); PG8_STAGE(PG8_SA(1, 1), a1 + hstep, voffA);
      PG8_WAIT_L(8); PG8_BAR; PG8_WAIT_L(0); PG8_MMA(0, 0, At, B0); PG8_BAR; PG8_SCHED;
      PG8_LDB(B1, 0, 1); PG8_STAGE(PG8_SB(0, 0), b2, voffB);
      PG8_BAR; PG8_WAIT_L(0); PG8_MMA(0, 1, At, B1); PG8_BAR;
      PG8_LDA(At, 0, 1); PG8_STAGE(PG8_SA(0, 0), a2, voffA);
      PG8_BAR; PG8_WAIT_L(0); PG8_MMA(1, 0, At, B0); PG8_BAR; PG8_SCHED;
      PG8_STAGE(PG8_SB(0, 1), b2 + hstep, voffB);
      PG8_WAIT_V(6); PG8_BAR; PG8_MMA(1, 1, At, B1); PG8_BAR;
      PG8_LDB(B0, 1, 0); PG8_SCHED; PG8_LDA(At, 1, 0); PG8_STAGE(PG8_SA(0, 1), a2 + hstep, voffA);
      PG8_WAIT_L(8); PG8_BAR; PG8_WAIT_L(0); PG8_MMA(0, 0, At, B0); PG8_BAR; PG8_SCHED;
      PG8_LDB(B1, 1, 1); PG8_STAGE(PG8_SB(1, 0), b3, voffB);
      PG8_BAR; PG8_WAIT_L(0); PG8_MMA(0, 1, At, B1); PG8_BAR;
      PG8_LDA(At, 1, 1); PG8_STAGE(PG8_SA(1, 0), a3, voffA);
      PG8_BAR; PG8_WAIT_L(0); PG8_MMA(1, 0, At, B0); PG8_BAR; PG8_SCHED;
      PG8_STAGE(PG8_SB(1, 1), b3 + hstep, voffB);
      PG8_WAIT_V(6); PG8_BAR; PG8_MMA(1, 1, At, B1); PG8_BAR;
    }
    E(acc, cur, wr, wc, fr, fq);
    if (!has_next) break;
#pragma unroll
    for (int a = 0; a < 2; ++a)
#pragma unroll
      for (int b = 0; b < 2; ++b)
#pragma unroll
        for (int m = 0; m < 4; ++m)
#pragma unroll
          for (int n = 0; n < 2; ++n) acc[a][b][m][n] = (f32x4){0.f, 0.f, 0.f, 0.f};
    cur = nxt; cA = nA; cB = nB; ++ui;
  }
  PG8_WAIT_V(0);
  if (wr == 0) PG8_BAR;
  PG8_BAR;
#undef PG8_SA
#undef PG8_SB
#undef PG8_STAGE
#undef PG8_LDA
#undef PG8_LDB
#undef PG8_MMA
#undef PG8_WAIT_V
#undef PG8_WAIT_L
#undef PG8_BAR
#undef PG8_SCHED
}
}

template <class F> struct EpiAd {
  F f;
  __device__ __forceinline__ void operator()(const f32x4 (&acc)[2][2][4][2], const pg8::Unit& u, int wr, int wc, int fr, int fq) const {
#pragma unroll
    for (int ai = 0; ai < 2; ++ai)
#pragma unroll
      for (int m = 0; m < 4; ++m) { const int row = u.pm * 256 + ai * 128 + wr * 64 + m * 16 + fr;
#pragma unroll
        for (int bj = 0; bj < 2; ++bj)
#pragma unroll
          for (int n = 0; n < 2; ++n) f(row, u.pn * 256 + bj * 128 + wc * 32 + n * 16 + 4 * fq, acc[ai][bj][m][n]); }
  }
};
template <class F> __device__ __forceinline__ void big_gemm(char* smem, const bfr* A, const bfr* Bt, int N, int K, F f) {
  pg8::Gemm g; g.A = A; g.Bt = Bt; g.M = R_; g.N = N; g.K = K;
  pg8::StaticOrder S; S.init(R_, N, (int)gridDim.x, (int)blockIdx.x);
  EpiAd<F> E{f};
  pg8::gemm_phase(( __attribute__((address_space(3))) unsigned char*)smem, g, S, E);
}
struct F_LruIn { char* ACT; __device__ __forceinline__ void operator()(int row, int n, f32x4 v) const {
  bfr* dst = n < 1280 ? (bfr*)(ACT + A_U) + (size_t)row * 1280 + n : (bfr*)(ACT + A_Z) + (size_t)row * 1280 + (n - 1280); store4b(dst, v); } };
struct F_Resid { float* Xx; float* Xc; const float* MODg; int wc; __device__ __forceinline__ void operator()(int row, int n, f32x4 v) const {
  int b = row / BT_, o = row - b * BT_; bool isc = o < 256; if (isc && !wc) return;
  float* xr = isc ? Xc + (size_t)(b * 256 + o) * 1024 : Xx + (size_t)(b * 16384 + o - 256) * 1024; const float* g = MODg + (size_t)(isc ? 2 : b) * 3072 + 2048;
  float4 xv = *(float4*)(xr + n); float4 gg = *(const float4*)(g + n);
  xv.x += gg.x * v[0]; xv.y += gg.y * v[1]; xv.z += gg.z * v[2]; xv.w += gg.w * v[3]; *(float4*)(xr + n) = xv; } };
struct F_MlIn { char* ACT; __device__ __forceinline__ void operator()(int row, int n, f32x4 v) const {
  if (n < 4096) store4b((bfr*)(ACT + A_QKV) + (size_t)row * 4096 + n, v);
  else if (n < 4128) *(float4*)((float*)(ACT + A_GATE) + (size_t)row * 32 + (n - 4096)) = float4{v[0], v[1], v[2], v[3]}; } };
struct F_MlZ { char* ACT; const float* ng; __device__ __forceinline__ void operator()(int row, int n, f32x4 v) const {
  bfr* hp = (bfr*)(ACT + A_HS) + (size_t)row * 2048 + n; uint2 u = *(const uint2*)hp; float rs = ((const float*)(ACT + A_RSTD))[(size_t)row * 8 + (n >> 8)];
  float4 g4 = *(const float4*)(ng + n); f32x4 o;
  o[0] = blo(u.x) * rs * g4.x * siluf(v[0]); o[1] = bhi(u.x) * rs * g4.y * siluf(v[1]); o[2] = blo(u.y) * rs * g4.z * siluf(v[2]); o[3] = bhi(u.y) * rs * g4.w * siluf(v[3]);
  store4b(hp, o); } };
struct F_R7In { char* ACT; __device__ __forceinline__ void operator()(int row, int n, f32x4 v) const {
  if (n < 4096) store4b((bfr*)(ACT + A_RKVZ) + (size_t)row * 4096 + n, v);
  else if (n < 4224) { f32x4 t;
#pragma unroll
    for (int q = 0; q < 4; q++) t[q] = tanhf(v[q]);
    store4b((bfr*)(ACT + A_WM) + (size_t)row * 128 + (n - 4096), t); }
  else store4b((bfr*)(ACT + A_AM) + (size_t)row * 128 + (n - 4224), v); } };

template <class G> __device__ __forceinline__ void gemm_phase(const P& p, const Ctx& c, char* smem) {
  const int total = 130 * G::NT;
  for (int it = blockIdx.x; it < total; it += gridDim.x) gemm_tile<G>(p, c, it / G::NT, it % G::NT, smem);
}

__device__ __forceinline__ void ph_pre(const P& p, char* smem) {
  float* sm = (float*)smem; const int tid = ltid();
  const int nprep = prep_count(0), ngemv = 192, ncopy = 4160;
  for (int it = blockIdx.x; it < nprep + ngemv + ncopy; it += gridDim.x) {
    if (it < nprep) { prep_item(p, 0, it, sm); continue; }
    int i2 = it - nprep;
    if (i2 < ngemv) {
      int l = i2 / 48, cgp = i2 % 48;
      for (int i = tid; i < 3072; i += 512) { int cnd = i >> 10, k = i & 1023; float v = cnd == 0 ? p.c[k] : cnd == 1 ? p.c[1024 + k] : p.c_ctx[k]; sm[i] = siluf(v); }
      __syncthreads();
      int kq = tid >> 6, col = cgp * 64 + (tid & 63); const float* w = p.mod_w + (size_t)l * 1024 * 3072 + col;
      float a0 = 0.f, a1 = 0.f, a2 = 0.f;
      for (int k = kq * 128; k < kq * 128 + 128; k++) { float wv = w[(size_t)k * 3072]; a0 += sm[k] * wv; a1 += sm[1024 + k] * wv; a2 += sm[2048 + k] * wv; }
      float* red = sm + 3072; red[tid * 3] = a0; red[tid * 3 + 1] = a1; red[tid * 3 + 2] = a2;
      __syncthreads();
      if (tid < 64) { float bias = p.mod_b[(size_t)l * 3072 + col];
        for (int cnd = 0; cnd < 3; cnd++) { float s = bias; for (int q = 0; q < 8; q++) s += red[(q * 64 + tid) * 3 + cnd]; p.MOD[(size_t)(l * 3 + cnd) * 3072 + col] = s; } }
      __syncthreads();
      continue;
    }
    i2 -= ngemv;
    for (int q = 0; q < 4; q++) { int idx = i2 * 2048 + q * 512 + tid; int row = idx >> 8, c4 = idx & 255; int b = row / BT_, o = row - b * BT_;
      if (o < 256) ((float4*)p.Xc)[(size_t)(b * 256 + o) * 256 + c4] = ((const float4*)p.ctx)[(size_t)(b * 256 + o) * 256 + c4];
      else ((float4*)p.Xx)[(size_t)(b * 16384 + o - 256) * 256 + c4] = ((const float4*)p.x)[(size_t)(b * 16384 + o - 256) * 256 + c4]; }
  }
}
__device__ __forceinline__ void ph_norm(const P& p, int layer, char* smem) {
  const int tid = ltid(), lane = tid & 63, wid = tid >> 6;
  const int nprep = layer > 0 ? prep_count(layer) : 0; const int kind = layer % 3;
  const int nzero = kind == 1 ? 8320 : 0;
  (void)nzero;
  for (int it = blockIdx.x; it < nprep + 4160; it += gridDim.x) {
    if (it < nprep) { prep_item(p, layer, it, (float*)smem); continue; }
    int row = (it - nprep) * 8 + wid; int mo; const float* xr = xrowp(p, row, mo);
    float4 v[4]; float ss = 0.f;
#pragma unroll
    for (int i = 0; i < 4; i++) { v[i] = *(const float4*)(xr + lane * 4 + 256 * i); ss += v[i].x * v[i].x + v[i].y * v[i].y + v[i].z * v[i].z + v[i].w * v[i].w; }
    ss = wsum(ss); float rs = rsqrtf(ss * (1.f / 1024.f) + 1e-6f);
    const float* g = p.norm_g + (size_t)layer * 1024; const float* md = p.MOD + (size_t)(layer * 3 + mo) * 3072;
#pragma unroll
    for (int i = 0; i < 4; i++) { int cidx = lane * 4 + 256 * i; float4 gg = *(const float4*)(g + cidx), sh = *(const float4*)(md + cidx), sc = *(const float4*)(md + 1024 + cidx);
      f32x4 o; o[0] = v[i].x * rs * gg.x * (1.f + sc.x) + sh.x; o[1] = v[i].y * rs * gg.y * (1.f + sc.y) + sh.y; o[2] = v[i].z * rs * gg.z * (1.f + sc.z) + sh.z; o[3] = v[i].w * rs * gg.w * (1.f + sc.w) + sh.w;
      store4b(p.H + (size_t)row * (kind == 2 ? 2048 : 1024) + cidx, o); }
  }
}
__device__ __forceinline__ void ph_r7_shift(const P& p) {
  for (int it = blockIdx.x; it < 8320; it += gridDim.x) {
    int idx = it * 512 + ltid(); int row = idx >> 7, c8 = idx & 127, q = c8 >> 5;
    int b = row / BT_, o = row - b * BT_; int nr = -1;
    if (o < 256) { if (q < 2) { if (o >= 1) nr = row - 1; } else { if (o < 255) nr = row + 1; } }
    else { int t = o - 256, col = t & 63, gr = t >> 6;
      if (q == 0) { if (col != 0) nr = row - 1; } else if (q == 1) { if (col != 63) nr = row + 1; }
      else if (q == 2) { if (gr != 0) nr = row - 64; } else { if (gr != 255) nr = row + 64; } }
    uint4 v = nr >= 0 ? *(const uint4*)(p.H + (size_t)nr * 2048 + c8 * 8) : uint4{0u, 0u, 0u, 0u};
    *(uint4*)(p.H + (size_t)row * 2048 + 1024 + c8 * 8) = v;
  }
}
__device__ __forceinline__ void ph_final(const P& p) {
  const int lane = ltid() & 63, wid = ltid() >> 6;
  for (int it = blockIdx.x; it < 4096; it += gridDim.x) {
    float* xr = p.Xx + (size_t)(it * 8 + wid) * 1024; float4 v[4]; float ss = 0.f;
#pragma unroll
    for (int i = 0; i < 4; i++) { v[i] = *(const float4*)(xr + lane * 4 + 256 * i); ss += v[i].x * v[i].x + v[i].y * v[i].y + v[i].z * v[i].z + v[i].w * v[i].w; }
    ss = wsum(ss); float rs = rsqrtf(ss * (1.f / 1024.f) + 1e-6f);
#pragma unroll
    for (int i = 0; i < 4; i++) { int cidx = lane * 4 + 256 * i; float4 gg = *(const float4*)(p.final_g + cidx);
      *(float4*)(xr + cidx) = float4{v[i].x * rs * gg.x, v[i].y * rs * gg.y, v[i].z * rs * gg.z, v[i].w * rs * gg.w}; }
  }
}
__device__ __forceinline__ void ph_lru_conv(const P& p, int j) {
  const bfr* U = (const bfr*)(p.ACT + A_U); bfr* UC = (bfr*)(p.ACT + A_UC);
  const float* cw = p.lru_conv_w + (size_t)j * 4 * 1280; const float* cb = p.lru_conv_b + (size_t)j * 1280;
  for (int it = blockIdx.x; it < 10400; it += gridDim.x) {
    int idx = it * 512 + ltid(); int row = idx / 160, cgp = idx % 160, ch = cgp * 8;
    int b = row / BT_, o = row - b * BT_; int s0 = o < 256 ? 0 : 256, e0 = o < 256 ? 256 : BT_;
    float acc[8];
#pragma unroll
    for (int e = 0; e < 8; e++) acc[e] = cb[ch + e];
#pragma unroll
    for (int t = 0; t < 4; t++) { int oo = o + t - 2; if (oo < s0 || oo >= e0) continue;
      uint4 u = *(const uint4*)(U + (size_t)(row + t - 2) * 1280 + ch); const float* w = cw + t * 1280 + ch;
      acc[0] += w[0] * blo(u.x); acc[1] += w[1] * bhi(u.x); acc[2] += w[2] * blo(u.y); acc[3] += w[3] * bhi(u.y);
      acc[4] += w[4] * blo(u.z); acc[5] += w[5] * bhi(u.z); acc[6] += w[6] * blo(u.w); acc[7] += w[7] * bhi(u.w); }
    *(uint4*)(UC + (size_t)row * 1280 + ch) = uint4{pk2(acc[0], acc[1]), pk2(acc[2], acc[3]), pk2(acc[4], acc[5]), pk2(acc[6], acc[7])};
  }
}
__device__ __forceinline__ void ph_lru_s1(const P& p, int d) {
  const unsigned* AB = (const unsigned*)(p.ACT + A_AB); float2* AGG = (float2*)(p.ACT + A_AGG);
  for (int it = blockIdx.x * 2 + (ltid() >> 8); it < 2600; it += gridDim.x * 2) {
    int b = it / 1300, r = it % 1300, cc = r / 5, ch = (r % 5) * 256 + (ltid() & 255);
    float Pp = 1.f, Q = 0.f;
#pragma unroll 8
    for (int t = 0; t < 64; t++) { unsigned u = AB[(size_t)rowmap(d, b, cc * 64 + t) * 1280 + ch]; float a = 1.f - bhi(u), bb = blo(u); Pp *= a; Q = a * Q + bb; }
    AGG[(size_t)(b * NCH_ + cc) * 1280 + ch] = float2{Pp, Q};
  }
}
__device__ __forceinline__ void ph_lru_s2(const P& p) {
  const float2* AGG = (const float2*)(p.ACT + A_AGG); float* CAR = (float*)(p.ACT + A_CAR);
  for (int it = blockIdx.x; it < 5; it += gridDim.x) {
    int idx = it * 512 + ltid(), b = idx / 1280, ch = idx % 1280; float h = 0.f;
#pragma unroll 4
    for (int cc = 0; cc < NCH_; cc++) { size_t o = (size_t)(b * NCH_ + cc) * 1280 + ch; float2 a = AGG[o]; CAR[o] = h; h = a.x * h + a.y; }
  }
}
__device__ __forceinline__ void ph_lru_s3(const P& p, int d) {
  const unsigned* AB = (const unsigned*)(p.ACT + A_AB); const float* CAR = (const float*)(p.ACT + A_CAR);
  bfr* HF = (bfr*)(p.ACT + A_HF); bfr* Z = (bfr*)(p.ACT + A_Z);
  for (int it = blockIdx.x * 2 + (ltid() >> 8); it < 2600; it += gridDim.x * 2) {
    int b = it / 1300, r = it % 1300, cc = r / 5, ch = (r % 5) * 256 + (ltid() & 255);
    float h = CAR[(size_t)(b * NCH_ + cc) * 1280 + ch];
#pragma unroll 8
    for (int t = 0; t < 64; t++) { size_t o = (size_t)rowmap(d, b, cc * 64 + t) * 1280 + ch; unsigned u = AB[o]; h = (1.f - bhi(u)) * h + blo(u);
      if (d == 0) HF[o] = f2b(h); else { float y = b2f(HF[o]) + h; Z[o] = f2b(y * siluf(b2f(Z[o]))); } }
  }
}
__device__ __forceinline__ void ph_ml_stat(const P& p) {
  const bfr* HS = (const bfr*)(p.ACT + A_HS); float* RS = (float*)(p.ACT + A_RSTD);
  const int lane = ltid() & 63, wid = ltid() >> 6;
  for (int it = blockIdx.x; it < 4160; it += gridDim.x) {
    int row = it * 8 + wid; const bfr* hp = HS + (size_t)row * 2048 + lane * 32; float ss = 0.f;
#pragma unroll
    for (int i = 0; i < 4; i++) { uint4 u = *(const uint4*)(hp + i * 8); float a;
      a = blo(u.x); ss += a * a; a = bhi(u.x); ss += a * a; a = blo(u.y); ss += a * a; a = bhi(u.y); ss += a * a;
      a = blo(u.z); ss += a * a; a = bhi(u.z); ss += a * a; a = blo(u.w); ss += a * a; a = bhi(u.w); ss += a * a; }
    ss += __shfl_xor(ss, 1); ss += __shfl_xor(ss, 2); ss += __shfl_xor(ss, 4);
    if ((lane & 7) == 0) RS[(size_t)row * 8 + (lane >> 3)] = rsqrtf(ss * (1.f / 256.f) + 1e-6f);
  }
}
__device__ __forceinline__ void ph_r7_fin(const P& p, int j) {
  bfr* Y = (bfr*)(p.ACT + A_Y); const bfr* RK = (const bfr*)(p.ACT + A_RKVZ); const float* BON = (const float*)(p.ACT + A_BON);
  const float* lg = p.r7_ln_g + (size_t)j * 1024; const float* lb = p.r7_ln_b + (size_t)j * 1024;
  const int lane = ltid() & 63, wid = ltid() >> 6;
  for (int it = blockIdx.x; it < 4160; it += gridDim.x) {
    int row = it * 8 + wid, ch = lane * 16, hd = lane >> 2;
    float y[16], v[16], z[16];
#pragma unroll
    for (int i = 0; i < 2; i++) {
      uint4 u = *(const uint4*)(Y + (size_t)row * 1024 + ch + i * 8);
      y[i * 8 + 0] = blo(u.x); y[i * 8 + 1] = bhi(u.x); y[i * 8 + 2] = blo(u.y); y[i * 8 + 3] = bhi(u.y); y[i * 8 + 4] = blo(u.z); y[i * 8 + 5] = bhi(u.z); y[i * 8 + 6] = blo(u.w); y[i * 8 + 7] = bhi(u.w);
      u = *(const uint4*)(RK + (size_t)row * 4096 + 2048 + ch + i * 8);
      v[i * 8 + 0] = blo(u.x); v[i * 8 + 1] = bhi(u.x); v[i * 8 + 2] = blo(u.y); v[i * 8 + 3] = bhi(u.y); v[i * 8 + 4] = blo(u.z); v[i * 8 + 5] = bhi(u.z); v[i * 8 + 6] = blo(u.w); v[i * 8 + 7] = bhi(u.w);
      u = *(const uint4*)(RK + (size_t)row * 4096 + 3072 + ch + i * 8);
      z[i * 8 + 0] = blo(u.x); z[i * 8 + 1] = bhi(u.x); z[i * 8 + 2] = blo(u.y); z[i * 8 + 3] = bhi(u.y); z[i * 8 + 4] = blo(u.z); z[i * 8 + 5] = bhi(u.z); z[i * 8 + 6] = blo(u.w); z[i * 8 + 7] = bhi(u.w);
    }
    float s = 0.f;
#pragma unroll
    for (int e = 0; e < 16; e++) s += y[e];
    s += __shfl_xor(s, 1); s += __shfl_xor(s, 2); float mean = s * (1.f / 64.f);
    float q = 0.f;
#pragma unroll
    for (int e = 0; e < 16; e++) { float dlt = y[e] - mean; q += dlt * dlt; }
    q += __shfl_xor(q, 1); q += __shfl_xor(q, 2); float rs = rsqrtf(q * (1.f / 64.f) + 64e-5f);
    float bon = BON[(size_t)row * 16 + hd] + BON[(size_t)(R_ + row) * 16 + hd];
    float o[16];
#pragma unroll
    for (int e = 0; e < 16; e++) { float yn = (y[e] - mean) * rs * lg[ch + e] + lb[ch + e]; o[e] = (yn + bon * v[e]) * siluf(z[e]); }
#pragma unroll
    for (int i = 0; i < 2; i++)
      *(uint4*)(Y + (size_t)row * 1024 + ch + i * 8) = uint4{pk2(o[i * 8], o[i * 8 + 1]), pk2(o[i * 8 + 2], o[i * 8 + 3]), pk2(o[i * 8 + 4], o[i * 8 + 5]), pk2(o[i * 8 + 6], o[i * 8 + 7])};
  }
}

#define QS 136
#define VS 72
#define MLG_BYTES 45056
__device__ __forceinline__ void ph_ml_scan(const P& p, int j, char* smem0) {
  const int d = ltid() >> 8;
  char* smem = smem0 + d * MLG_BYTES;
  bfr* sQ = (bfr*)smem; bfr* sK = sQ + 64 * QS; bfr* sVT = sK + 64 * QS; bfr* sCT = sVT + 16 * VS;
  float* sN = (float*)(sCT + 16 * QS);
  float* sEs = sN + 128; float* sCt = sEs + 64; float* sBc = sCt + 64; float* sWg = sBc + 64; float* sNr = sWg + 64;
  const bfr* QKV = (const bfr*)(p.ACT + A_QKV); const float* GT = (const float*)(p.ACT + A_GATE); bfr* HS = (bfr*)(p.ACT + A_HS);
  const float* gbias = p.ml_gate_b + (size_t)j * 32;
  const int tid = ltid() & 255, lane = tid & 63, w = tid >> 6, l15 = lane & 15, q4 = lane >> 4;
  for (int it = blockIdx.x; it < 256; it += gridDim.x) {
    const int b = it >> 7, hh = (it >> 4) & 7, sl = it & 15;
    f32x4 Cacc[2];
    Cacc[0] = f32x4{0.f, 0.f, 0.f, 0.f}; Cacc[1] = f32x4{0.f, 0.f, 0.f, 0.f};
    float mcur = 0.f;
    for (int i = tid; i < 16 * QS; i += 256) sCT[i] = 0;
    if (tid < 128) sN[tid] = 0.f;
    uint4 pq0, pq1, pq2, pq3, pk0, pk1, pk2, pk3, pv = uint4{0u, 0u, 0u, 0u};
#define ML_ROW0(s_) (d == 0 ? b * BT_ + 64 * (s_) : rowmap(1, b, 64 * (s_) + 63))
#define ML_LD(i_, PQ, PK) { int idx = tid + 256 * (i_), rho = idx >> 4, c8 = idx & 15; const bfr* src = QKV + (size_t)(r0n + rho) * 4096 + hh * 128 + c8 * 8; PQ = *(const uint4*)src; PK = *(const uint4*)(src + 1024); }
#define ML_ISSUE(s_) { const int r0n = ML_ROW0(s_); ML_LD(0, pq0, pk0) ML_LD(1, pq1, pk1) ML_LD(2, pq2, pk2) ML_LD(3, pq3, pk3) \
      if (tid < 128) pv = *(const uint4*)(QKV + (size_t)(r0n + (tid >> 1)) * 4096 + 2048 + hh * 256 + sl * 16 + (tid & 1) * 8); }
#define ML_ST(i_, PQ, PK) { int idx = tid + 256 * (i_), rho = idx >> 4, c8 = idx & 15; *(uint4*)(sQ + rho * QS + c8 * 8) = PQ; *(uint4*)(sK + rho * QS + c8 * 8) = PK; }
#define ML_COMMIT() { ML_ST(0, pq0, pk0) ML_ST(1, pq1, pk1) ML_ST(2, pq2, pk2) ML_ST(3, pq3, pk3) \
      if (tid < 128) { int rho = tid >> 1, vb = (tid & 1) * 8; \
        sVT[(vb + 0) * VS + rho] = (bfr)(pv.x & 0xffff); sVT[(vb + 1) * VS + rho] = (bfr)(pv.x >> 16); \
        sVT[(vb + 2) * VS + rho] = (bfr)(pv.y & 0xffff); sVT[(vb + 3) * VS + rho] = (bfr)(pv.y >> 16); \
        sVT[(vb + 4) * VS + rho] = (bfr)(pv.z & 0xffff); sVT[(vb + 5) * VS + rho] = (bfr)(pv.z >> 16); \
        sVT[(vb + 6) * VS + rho] = (bfr)(pv.w & 0xffff); sVT[(vb + 7) * VS + rho] = (bfr)(pv.w >> 16); } }
    ML_ISSUE(0)
    __syncthreads();
    for (int s = 0; s < NCH_; s++) {
      const int r0 = ML_ROW0(s);
      ML_COMMIT()
      float mxl, decay;
      {
        int rho = d ? 63 - lane : lane; const float* gp = GT + (size_t)(r0 + rho) * 32 + d * 16 + hh;
        float gi = gp[0] + gbias[(d * 2 + 0) * 8 + hh], gf = gp[8] + gbias[(d * 2 + 1) * 8 + hh];
        float fc = fminf(gf, 0.f) - log1pf(__expf(-fabsf(gf)));
        float bc = fc;
        for (int o = 1; o < 64; o <<= 1) { float t = __shfl_up(bc, o); if (lane >= o) bc += t; }
        float e = gi - bc, pm = e;
        for (int o = 1; o < 64; o <<= 1) { float t = __shfl_up(pm, o); if (lane >= o) pm = fmaxf(pm, t); }
        float pml = __shfl(pm, 63), bcl = __shfl(bc, 63);
        mxl = fmaxf(mcur, pml); decay = __expf(mcur - mxl);
        if (w == 0) { sEs[rho] = e; sCt[rho] = -fmaxf(mcur, pm); sBc[rho] = bc; sWg[rho] = __expf(e - mxl); }
        pml = bcl + mxl;
        bcl = mcur; mcur = pml; pml = bcl;
        mxl = pml;
      }
      const float mold = mxl;
      __syncthreads();
      if (s + 1 < NCH_) ML_ISSUE(s + 1)
      bf16x8 qf[4];
#pragma unroll
      for (int ks = 0; ks < 4; ks++) qf[ks] = *(const bf16x8*)(sQ + (16 * w + l15) * QS + ks * 32 + q4 * 8);
      f32x4 sacc[4];
#pragma unroll
      for (int a = 0; a < 4; a++) { sacc[a] = f32x4{0.f, 0.f, 0.f, 0.f};
#pragma unroll
        for (int ks = 0; ks < 4; ks++) { bf16x8 kf = *(const bf16x8*)(sK + (16 * a + l15) * QS + ks * 32 + q4 * 8); sacc[a] = __builtin_amdgcn_mfma_f32_16x16x32_bf16(kf, qf[ks], sacc[a], 0, 0, 0); } }
      const int rt = 16 * w + l15; const float ctt = sCt[rt]; float densum = 0.f;
#pragma unroll
      for (int a = 0; a < 4; a++)
#pragma unroll
        for (int jj = 0; jj < 4; jj++) { int rs_ = 16 * a + 4 * q4 + jj; bool valid = d == 0 ? rs_ <= rt : rs_ >= rt;
          float wv = valid ? __expf(ctt + sEs[rs_]) : 0.f; float sv = sacc[a][jj] * wv; sacc[a][jj] = sv; densum += sv; }
      densum += __shfl_xor(densum, 16); densum += __shfl_xor(densum, 32);
      bf16x8 sf[2], vf[2];
#pragma unroll
      for (int ks = 0; ks < 2; ks++) {
#pragma unroll
        for (int jj = 0; jj < 4; jj++) { sf[ks][jj] = (short)f2b(sacc[2 * ks][jj]); sf[ks][4 + jj] = (short)f2b(sacc[2 * ks + 1][jj]); }
        uint2 v0 = *(const uint2*)(sVT + l15 * VS + 32 * ks + 4 * q4), v1 = *(const uint2*)(sVT + l15 * VS + 32 * ks + 16 + 4 * q4);
        uint4 vv = uint4{v0.x, v0.y, v1.x, v1.y}; vf[ks] = *(bf16x8*)&vv;
      }
      f32x4 num = f32x4{0.f, 0.f, 0.f, 0.f}, numC = f32x4{0.f, 0.f, 0.f, 0.f};
#pragma unroll
      for (int ks = 0; ks < 2; ks++) num = __builtin_amdgcn_mfma_f32_16x16x32_bf16(vf[ks], sf[ks], num, 0, 0, 0);
#pragma unroll
      for (int ks = 0; ks < 4; ks++) { bf16x8 cf = *(const bf16x8*)(sCT + l15 * QS + ks * 32 + q4 * 8); numC = __builtin_amdgcn_mfma_f32_16x16x32_bf16(cf, qf[ks], numC, 0, 0, 0); }
      float qn = 0.f;
#pragma unroll
      for (int i = 0; i < 4; i++) { uint4 u = *(const uint4*)(sQ + rt * QS + 32 * q4 + i * 8); const float* nn = sN + 32 * q4 + i * 8;
        qn += blo(u.x) * nn[0] + bhi(u.x) * nn[1] + blo(u.y) * nn[2] + bhi(u.y) * nn[3] + blo(u.z) * nn[4] + bhi(u.z) * nn[5] + blo(u.w) * nn[6] + bhi(u.w) * nn[7]; }
      qn += __shfl_xor(qn, 16); qn += __shfl_xor(qn, 32);
      {
        float inter = __expf(mold + ctt); float den = densum + inter * qn; float dn = fmaxf(fabsf(den), __expf(ctt - sBc[rt])); float inv = 1.f / dn;
        f32x4 hv;
#pragma unroll
        for (int jj = 0; jj < 4; jj++) hv[jj] = (num[jj] + inter * numC[jj]) * inv;
        int rc = (r0 - b * BT_) >> 6; bool first;
        if (d == 0) { int sp = rc < 4 ? 3 - rc : 263 - rc; first = s < sp; } else first = s < rc;
        bfr* hp = HS + (size_t)(r0 + rt) * 2048 + hh * 256 + sl * 16 + 4 * q4;
        if (!first) { unsigned long long uu = __hip_atomic_load((unsigned long long*)hp, __ATOMIC_RELAXED, __HIP_MEMORY_SCOPE_AGENT); unsigned ux = (unsigned)uu, uy = (unsigned)(uu >> 32);
          hv[0] += blo(ux); hv[1] += bhi(ux); hv[2] += blo(uy); hv[3] += bhi(uy); }
        store4b(hp, hv);
      }
      __syncthreads();
      {
        bf16x8 vw[2];
#pragma unroll
        for (int ks = 0; ks < 2; ks++)
#pragma unroll
          for (int e = 0; e < 8; e++) { int rs_ = 32 * ks + (e < 4 ? 4 * q4 + e : 16 + 4 * q4 + e - 4); vw[ks][e] = (short)f2b(b2f((bfr)vf[ks][e]) * sWg[rs_]); }
#pragma unroll
        for (int a = 0; a < 2; a++) {
          int dk = 32 * w + 16 * a + l15;
#pragma unroll
          for (int jj = 0; jj < 4; jj++) Cacc[a][jj] *= decay;
#pragma unroll
          for (int ks = 0; ks < 2; ks++) { bf16x8 kt;
#pragma unroll
            for (int e = 0; e < 8; e++) { int rs_ = 32 * ks + (e < 4 ? 4 * q4 + e : 16 + 4 * q4 + e - 4); kt[e] = (short)sK[rs_ * QS + dk]; }
            Cacc[a] = __builtin_amdgcn_mfma_f32_16x16x32_bf16(vw[ks], kt, Cacc[a], 0, 0, 0); }
#pragma unroll
          for (int jj = 0; jj < 4; jj++) sCT[(4 * q4 + jj) * QS + dk] = f2b(Cacc[a][jj]);
        }
        int dk = tid & 127, hf = tid >> 7; float part = 0.f;
#pragma unroll 8
        for (int r = 0; r < 32; r++) part += sWg[32 * hf + r] * b2f(sK[(32 * hf + r) * QS + dk]);
        sNr[tid] = part;
      }
      __syncthreads();
      if (tid < 128) sN[tid] = decay * sN[tid] + sNr[tid] + sNr[128 + tid];
    }
    __syncthreads();
  }
}

#define R7G_BYTES 43008
__device__ __forceinline__ void ph_r7_scan(const P& p, int j, char* smem) {
  const unsigned char* Q8 = (const unsigned char*)p.H;
  const bfr* RK = (const bfr*)(p.ACT + A_RKVZ); float* BON = (float*)(p.ACT + A_BON); bfr* Y = (bfr*)(p.ACT + A_Y);
  const float* kkp = p.r7_k_k + (size_t)j * 1024; const float* kap = p.r7_k_a + (size_t)j * 1024; const float* rkp = p.r7_r_k + (size_t)j * 1024;
  const int tid = ltid(), lane = tid & 63, w = tid >> 6, kp = lane & 15, rr = lane >> 4;
  const int g = tid >> 8, t8 = tid & 255, si = t8 >> 3, sc = t8 & 7;
  const int rd = (w >> 1) & 1, rw = w & 1;
  float* gs = (float*)(smem + g * R7G_BYTES);
  float* gW = gs; float* gKa = gW + 2048; float* gBe = gKa + 2048; float* gKd = gBe + 2048; float* gR = gKd + 2048; float* gV = gR + 2048;
  const float* rs = (const float*)(smem + rd * R7G_BYTES);
  const float* sW = rs; const float* sKa = sW + 2048; const float* sBe = sKa + 2048; const float* sKd = sBe + 2048; const float* sR = sKd + 2048; const float* sV = sR + 2048;
  float* sYr = (float*)(smem + rd * R7G_BYTES) + 2048 * 5 + 256;
  for (int it = blockIdx.x; it < 256; it += gridDim.x) {
    const int b = it >> 7, hh = (it >> 3) & 15, rg = it & 7;
    const int col = hh * 64 + sc * 8;
    float kkc[8], kac[8], rkc[8];
#pragma unroll
    for (int e = 0; e < 8; e++) { kkc[e] = kkp[col + e]; kac[e] = kap[col + e]; rkc[e] = rkp[col + e]; }
    float s0 = 0.f, s1 = 0.f, s2 = 0.f, s3 = 0.f;
    uint4 pr, pk, pv; uint2 pw, pa;
#define R7_ISSUE(blk_) { int row = rowmap(g, b, (blk_) * 32 + si); const bfr* rp = RK + (size_t)row * 4096 + col; \
      pr = *(const uint4*)rp; pk = *(const uint4*)(rp + 1024); pv = *(const uint4*)(rp + 2048); \
      pw = *(const uint2*)(Q8 + ((size_t)g * R_ + row) * 1024 + col); pa = *(const uint2*)(Q8 + ((size_t)(2 + g) * R_ + row) * 1024 + col); }
    R7_ISSUE(0)
    for (int blk = 0; blk < BT_ / 32; blk++) {
      __syncthreads();
      {
        const int row = rowmap(g, b, blk * 32 + si);
        unsigned ur[4] = {pr.x, pr.y, pr.z, pr.w}, uk[4] = {pk.x, pk.y, pk.z, pk.w}, uv[4] = {pv.x, pv.y, pv.z, pv.w};
        float r8[8], k8[8], v8[8], w8[8], a8[8], kr[8];
#pragma unroll
        for (int e = 0; e < 4; e++) { r8[2 * e] = blo(ur[e]); r8[2 * e + 1] = bhi(ur[e]); k8[2 * e] = blo(uk[e]); k8[2 * e + 1] = bhi(uk[e]); v8[2 * e] = blo(uv[e]); v8[2 * e + 1] = bhi(uv[e]); }
#pragma unroll
        for (int e = 0; e < 4; e++) { w8[e] = (float)((pw.x >> (8 * e)) & 255u); w8[4 + e] = (float)((pw.y >> (8 * e)) & 255u); a8[e] = (float)((pa.x >> (8 * e)) & 255u) * (1.f / 255.f); a8[4 + e] = (float)((pa.y >> (8 * e)) & 255u) * (1.f / 255.f); }
        float ss = 0.f;
#pragma unroll
        for (int e = 0; e < 8; e++) { kr[e] = k8[e] * kkc[e]; ss += kr[e] * kr[e]; }
        ss += __shfl_xor(ss, 1); ss += __shfl_xor(ss, 2); ss += __shfl_xor(ss, 4);
        float inv = 1.f / fmaxf(sqrtf(ss), 1e-12f);
        float bon = 0.f; float ow[8], oka[8], obe[8], okd[8];
#pragma unroll
        for (int e = 0; e < 8; e++) { float ka = kr[e] * inv; oka[e] = ka; obe[e] = a8[e] * ka; float kd = k8[e] * (1.f + (a8[e] - 1.f) * kac[e]); okd[e] = kd;
          ow[e] = __expf(-exp2f(w8[e] * 0.05f - 13.f)); bon += r8[e] * kd * rkc[e]; }
        bon += __shfl_xor(bon, 1); bon += __shfl_xor(bon, 2); bon += __shfl_xor(bon, 4);
        if (rg == 0 && sc == 0) BON[((size_t)g * R_ + row) * 16 + hh] = bon;
        int o = si * 64 + sc * 8;
        *(float4*)(gW + o) = float4{ow[0], ow[1], ow[2], ow[3]}; *(float4*)(gW + o + 4) = float4{ow[4], ow[5], ow[6], ow[7]};
        *(float4*)(gKa + o) = float4{oka[0], oka[1], oka[2], oka[3]}; *(float4*)(gKa + o + 4) = float4{oka[4], oka[5], oka[6], oka[7]};
        *(float4*)(gBe + o) = float4{obe[0], obe[1], obe[2], obe[3]}; *(float4*)(gBe + o + 4) = float4{obe[4], obe[5], obe[6], obe[7]};
        *(float4*)(gKd + o) = float4{okd[0], okd[1], okd[2], okd[3]}; *(float4*)(gKd + o + 4) = float4{okd[4], okd[5], okd[6], okd[7]};
        *(float4*)(gR + o) = float4{r8[0], r8[1], r8[2], r8[3]}; *(float4*)(gR + o + 4) = float4{r8[4], r8[5], r8[6], r8[7]};
        if (sc == rg) { *(float4*)(gV + si * 8) = float4{v8[0], v8[1], v8[2], v8[3]}; *(float4*)(gV + si * 8 + 4) = float4{v8[4], v8[5], v8[6], v8[7]}; }
      }
      __syncthreads();
      if (blk + 1 < BT_ / 32) R7_ISSUE(blk + 1)
      if (w < 4) {
        float4 w4 = *(const float4*)(sW + kp * 4), ka4 = *(const float4*)(sKa + kp * 4), be4 = *(const float4*)(sBe + kp * 4);
        float4 kd4 = *(const float4*)(sKd + kp * 4), r4 = *(const float4*)(sR + kp * 4); float vv = sV[rw * 4 + rr];
#pragma unroll 4
        for (int i = 0; i < 32; i++) {
          const int in = (i + 1) & 31;
          float4 nw4 = *(const float4*)(sW + in * 64 + kp * 4), nka4 = *(const float4*)(sKa + in * 64 + kp * 4), nbe4 = *(const float4*)(sBe + in * 64 + kp * 4);
          float4 nkd4 = *(const float4*)(sKd + in * 64 + kp * 4), nr4 = *(const float4*)(sR + in * 64 + kp * 4); float nvv = sV[in * 8 + rw * 4 + rr];
          float sa = red16((s0 * ka4.x + s1 * ka4.y) + (s2 * ka4.z + s3 * ka4.w));
          s0 = s0 * w4.x + (kd4.x * vv - sa * be4.x); s1 = s1 * w4.y + (kd4.y * vv - sa * be4.y);
          s2 = s2 * w4.z + (kd4.z * vv - sa * be4.z); s3 = s3 * w4.w + (kd4.w * vv - sa * be4.w);
          float y = red16((s0 * r4.x + s1 * r4.y) + (s2 * r4.z + s3 * r4.w));
          if (kp == 0) sYr[i * 8 + rw * 4 + rr] = y;
          w4 = nw4; ka4 = nka4; be4 = nbe4; kd4 = nkd4; r4 = nr4; vv = nvv;
        }
      }
      __syncthreads();
      if (tid < 64) {
        const int og = tid >> 5, i = tid & 31, pp = blk * 32 + i;
        const int row = rowmap(og, b, pp), o = row - b * BT_;
        const bool first = og == 0 ? (pp < (o < 256 ? 255 - o : 16895 - o)) : (pp < o);
        bfr* yp = Y + (size_t)row * 1024 + hh * 64 + rg * 8; const float* sy = (const float*)(smem + og * R7G_BYTES) + 2048 * 5 + 256 + i * 8; float yy[8];
#pragma unroll
        for (int e = 0; e < 8; e++) yy[e] = sy[e];
        if (!first) { unsigned long long u0 = __hip_atomic_load((unsigned long long*)yp, __ATOMIC_RELAXED, __HIP_MEMORY_SCOPE_AGENT), u1 = __hip_atomic_load((unsigned long long*)yp + 1, __ATOMIC_RELAXED, __HIP_MEMORY_SCOPE_AGENT);
          unsigned ux = (unsigned)u0, uy = (unsigned)(u0 >> 32), uz = (unsigned)u1, uw = (unsigned)(u1 >> 32);
          yy[0] += blo(ux); yy[1] += bhi(ux); yy[2] += blo(uy); yy[3] += bhi(uy); yy[4] += blo(uz); yy[5] += bhi(uz); yy[6] += blo(uw); yy[7] += bhi(uw); }
        *(uint4*)yp = uint4{pk2(yy[0], yy[1]), pk2(yy[2], yy[3]), pk2(yy[4], yy[5]), pk2(yy[6], yy[7])};
      }
    }
    __syncthreads();
  }
}

__device__ __forceinline__ void run_phase(const P& p, int ph, int layer, int d, char* smem) {
  Ctx c; c.layer = layer; c.j = layer / 3; c.d = d; c.wc = layer < 3 ? 1 : 0;
  switch (ph) {
    case PH_PRE: ph_pre(p, smem); break;
    case PH_NORM: ph_norm(p, layer, smem); break;
    case PH_LRU_IN: big_gemm(smem, p.H, p.W, 2560, 1024, F_LruIn{p.ACT}); break;
    case PH_LRU_CONV: ph_lru_conv(p, c.j); break;
    case PH_LRU_GATE: gemm_phase<G_LruGate>(p, c, smem); break;
    case PH_LRU_S1: ph_lru_s1(p, d); break;
    case PH_LRU_S2: ph_lru_s2(p); break;
    case PH_LRU_S3: ph_lru_s3(p, d); break;
    case PH_LRU_OUT: big_gemm(smem, (const bfr*)(p.ACT + A_Z), p.W + WL_OUT, 1024, 1280, F_Resid{p.Xx, p.Xc, p.MOD + (size_t)layer * 3 * 3072, c.wc}); break;
    case PH_ML_IN: big_gemm(smem, p.H, p.W, 4352, 1024, F_MlIn{p.ACT}); break;
    case PH_ML_SCAN: ph_ml_scan(p, c.j, smem); break;
    case PH_ML_STAT: ph_ml_stat(p); break;
    case PH_ML_Z: big_gemm(smem, p.H, p.W + WM_Z, 2048, 1024, F_MlZ{p.ACT, p.ml_norm_g + (size_t)c.j * 2048}); break;
    case PH_ML_OUT: big_gemm(smem, (const bfr*)(p.ACT + A_HS), p.W + WM_OUT, 1024, 2048, F_Resid{p.Xx, p.Xc, p.MOD + (size_t)layer * 3 * 3072, c.wc}); break;
    case PH_R7_IN: big_gemm(smem, p.H, p.W, 4352, 2048, F_R7In{p.ACT}); break;
    case PH_R7_SHIFT: ph_r7_shift(p); break;
    case PH_R7_UP: gemm_phase<G_R7Up>(p, c, smem); break;
    case PH_R7_SCAN: ph_r7_scan(p, c.j, smem); break;
    case PH_R7_FIN: ph_r7_fin(p, c.j); break;
    case PH_R7_OUT: big_gemm(smem, (const bfr*)(p.ACT + A_Y), p.W + WR_OUT, 1024, 1024, F_Resid{p.Xx, p.Xc, p.MOD + (size_t)layer * 3 * 3072, c.wc}); break;
    case PH_FINAL: ph_final(p); break;
  }
}

#define SMEM_BYTES 131072
extern __shared__ __attribute__((aligned(16))) char dyn_smem[];
#if !MEGA
__global__ void __launch_bounds__(512, 2) phase_kernel(P p, int si) {
  run_phase(p, p.sched[si * 3], p.sched[si * 3 + 1], p.sched[si * 3 + 2], dyn_smem);
}
#else
__global__ void __launch_bounds__(512, 2) mega_kernel(P p) {
  cg::grid_group grid = cg::this_grid();
  for (int si = 0; si < p.nsched; si++) {
    run_phase(p, p.sched[si * 3], p.sched[si * 3 + 1], p.sched[si * 3 + 2], dyn_smem);
    if (si + 1 < p.nsched) grid.sync();
  }
}
#endif

extern "C" void kernel_launch(void* const* d_in, const int* in_sizes, int n_in, void* d_out, int out_size, void* d_ws, size_t ws_size, hipStream_t stream) {
  P p; memset(&p, 0, sizeof(p));
  const float** f = (const float**)&p;
  for (int i = 0; i < 33; i++) f[i] = (const float*)d_in[i];
  char* ws = (char*)d_ws;
  p.Xx = (float*)d_out; p.Xc = (float*)(ws + OFF_XC); p.MOD = (float*)(ws + OFF_MOD); p.W = (bfr*)(ws + OFF_W); p.H = (bfr*)(ws + OFF_H); p.ACT = ws + OFF_ACT;
  int n = 0;
  auto add = [&](int ph, int layer, int d) { p.sched[n * 3] = ph; p.sched[n * 3 + 1] = layer; p.sched[n * 3 + 2] = d; n++; };
  add(PH_PRE, 0, 0);
  if (DUP & 4) add(PH_PRE, 0, 0);
  for (int l = 0; l < 4; l++) {
    add(PH_NORM, l, 0); if (DUP & 4) add(PH_NORM, l, 0);
    int kind = l % 3;
    const bool dg = DUP & 1, ds = DUP & 2;
    if (kind == 0) { add(PH_LRU_IN, l, 0); if (dg) add(PH_LRU_IN, l, 0); add(PH_LRU_CONV, l, 0); if (DUP & 4) add(PH_LRU_CONV, l, 0);
      for (int d = 0; d < 2; d++) { add(PH_LRU_GATE, l, d); if (dg) add(PH_LRU_GATE, l, d); add(PH_LRU_S1, l, d); if (DUP & 8) add(PH_LRU_S1, l, d); add(PH_LRU_S2, l, d); if (DUP & 16) add(PH_LRU_S2, l, d); add(PH_LRU_S3, l, d); }
      add(PH_LRU_OUT, l, 0); }
    else if (kind == 1) { add(PH_ML_IN, l, 0); if (dg) add(PH_ML_IN, l, 0); add(PH_ML_SCAN, l, 0); if (ds) add(PH_ML_SCAN, l, 0); add(PH_ML_STAT, l, 0); if (DUP & 4) add(PH_ML_STAT, l, 0); add(PH_ML_Z, l, 0); add(PH_ML_OUT, l, 0); }
    else { add(PH_R7_SHIFT, l, 0); add(PH_R7_IN, l, 0); if (dg) add(PH_R7_IN, l, 0); add(PH_R7_UP, l, 0); if (dg) add(PH_R7_UP, l, 0); add(PH_R7_SCAN, l, 0); if (ds) add(PH_R7_SCAN, l, 0); add(PH_R7_FIN, l, 0); add(PH_R7_OUT, l, 0); }
  }
  add(PH_FINAL, 0, 0);
  p.nsched = n;
  if (ws_size < WS_NEED) fprintf(stderr, "workspace too small: %zu < %llu\n", ws_size, (unsigned long long)WS_NEED);
#if MEGA
  static int grid_blocks = 0;
  if (!grid_blocks) { int dev = 0, cus = 0, per = 0; hipGetDevice(&dev); hipDeviceGetAttribute(&cus, hipDeviceAttributeMultiprocessorCount, dev);
    hipFuncSetAttribute((const void*)mega_kernel, hipFuncAttributeMaxDynamicSharedMemorySize, SMEM_BYTES);
    hipOccupancyMaxActiveBlocksPerMultiprocessor(&per, mega_kernel, 512, SMEM_BYTES); if (per > 1) per = 1; if (per < 1) per = 1; grid_blocks = cus * per; }
  void* args[] = {&p};
  hipError_t e = hipLaunchCooperativeKernel((void*)mega_kernel, dim3(grid_blocks), dim3(512), args, SMEM_BYTES, stream);
  if (e != hipSuccess) fprintf(stderr, "cooperative launch failed: %s (grid %d)\n", hipGetErrorString(e), grid_blocks);
#else
  static int once = 0; if (!once) { once = 1; hipFuncSetAttribute((const void*)phase_kernel, hipFuncAttributeMaxDynamicSharedMemorySize, SMEM_BYTES); }
  for (int si = 0; si < n; si++) phase_kernel<<<256, 512, SMEM_BYTES, stream>>>(p, si);
#endif
}
```

```cpp
#include <hip/hip_runtime.h>
#include <hip/hip_bf16.h>
#include <hip/hip_cooperative_groups.h>
#include <cstdio>
#include <cstring>
#include <type_traits>
namespace cg = cooperative_groups;

#ifndef DUP
#define DUP 0
#endif
#ifndef MEGA
#define MEGA 1
#endif

typedef unsigned short bfr;
using bf16x8 = __attribute__((ext_vector_type(8))) short;
using f32x4 = __attribute__((ext_vector_type(4))) float;

#define R_ 33280
#define BT_ 16640
#define NCH_ 260

#define OFF_XC 0ull
#define OFF_MOD 2097152ull
#define OFF_W 2244608ull
#define OFF_H 24264704ull
#define OFF_ACT 92422144ull
#define A_Z 0ull
#define A_UC 85196800ull
#define A_AB 170393600ull
#define A_U 170393600ull
#define A_HF 340787200ull
#define A_AGG 425984000ull
#define A_CAR 431308800ull
#define A_QKV 0ull
#define A_GATE 272629760ull
#define A_HS 276889600ull
#define A_RSTD 413204480ull
#define A_R7B 68157440ull
#define A_RKVZ (A_R7B + 0ull)
#define A_WM (A_R7B + 272629760ull)
#define A_AM (A_R7B + 281149440ull)
#define A_BON (A_R7B + 289669120ull)
#define A_Y (A_R7B + 293928960ull)
#define WS_NEED (OFF_ACT + 434000000ull)

#define WL_GATE (2560 * 1024)
#define WL_OUT (WL_GATE + 1310720)
#define WM_Z (4352 * 1024)
#define WM_OUT (WM_Z + 2048 * 1024)
#define WR_UP (4352 * 2048)
#define WR_OUT (WR_UP + 262144)

enum { PH_PRE = 0, PH_NORM, PH_LRU_IN, PH_LRU_CONV, PH_LRU_GATE, PH_LRU_S1, PH_LRU_S2, PH_LRU_S3, PH_LRU_OUT,
       PH_ML_IN, PH_ML_SCAN, PH_ML_STAT, PH_ML_Z, PH_ML_OUT,
       PH_R7_IN, PH_R7_UP, PH_R7_SCAN, PH_R7_FIN, PH_R7_OUT, PH_FINAL, PH_R7_SHIFT };

struct P {
  const float *x, *c, *ctx, *c_ctx, *norm_g, *mod_w, *mod_b, *final_g;
  const float *lru_w_in, *lru_conv_w, *lru_conv_b, *lru_gate_w, *lru_gate_b, *lru_lam, *lru_w_out;
  const float *ml_w_in, *ml_gate_b, *ml_norm_g, *ml_w_out;
  const float *r7_mu, *r7_w_rkvz, *r7_w0, *r7_w1, *r7_w2, *r7_a0, *r7_a1, *r7_a2, *r7_k_k, *r7_k_a, *r7_r_k, *r7_ln_g, *r7_ln_b, *r7_w_out;
  float* Xx; float* Xc; float* MOD; bfr* W; bfr* H; char* ACT;
  int nsched; int pad_;
  int sched[64 * 3];
};
struct Ctx { int layer, j, d, wc; };

__device__ __forceinline__ int ltid() { int t = threadIdx.x; asm volatile("" : "+v"(t)); return t; }
__device__ __forceinline__ bfr f2b(float f) { unsigned u = __float_as_uint(f); u += 0x7fffu + ((u >> 16) & 1u); return (bfr)(u >> 16); }
__device__ __forceinline__ float b2f(bfr b) { return __uint_as_float(((unsigned)b) << 16); }
__device__ __forceinline__ unsigned pk2(float a, float b) { return (unsigned)f2b(a) | (((unsigned)f2b(b)) << 16); }
__device__ __forceinline__ float blo(unsigned u) { return __uint_as_float(u << 16); }
__device__ __forceinline__ float bhi(unsigned u) { return __uint_as_float(u & 0xffff0000u); }
__device__ __forceinline__ void store4b(bfr* dst, f32x4 v) { uint2 u; u.x = pk2(v[0], v[1]); u.y = pk2(v[2], v[3]); *(uint2*)dst = u; }
__device__ __forceinline__ float sigm(float x) { return 1.f / (1.f + __expf(-x)); }
__device__ __forceinline__ float siluf(float x) { return x * sigm(x); }
__device__ __forceinline__ float softplusf(float x) { return x > 20.f ? x : log1pf(expf(x)); }
__device__ __forceinline__ int rowmap(int d, int b, int pp) { int o = d == 0 ? pp : (pp < 256 ? 255 - pp : 16895 - pp); return b * BT_ + o; }
__device__ __forceinline__ float* xrowp(const P& p, int row, int& mi) {
  int b = row / BT_, o = row - b * BT_;
  if (o < 256) { mi = 2; return p.Xc + (size_t)(b * 256 + o) * 1024; }
  mi = b; return p.Xx + (size_t)(b * 16384 + o - 256) * 1024;
}
__device__ __forceinline__ float wsum(float v) { for (int o = 32; o; o >>= 1) v += __shfl_xor(v, o); return v; }
template <int CTRL> __device__ __forceinline__ float dppf(float x) {
  return __int_as_float(__builtin_amdgcn_update_dpp(0, __float_as_int(x), CTRL, 0xf, 0xf, true));
}
__device__ __forceinline__ float red16(float x) {
  x += dppf<0xB1>(x); x += dppf<0x4E>(x); x += dppf<0x141>(x); x += dppf<0x140>(x); return x;
}

template <class F> __device__ __forceinline__ void prep_tile(bfr* dst, int K, int tn, int tk, F get, float* sm) {
  int tid = ltid();
  for (int i = 0; i < 8; i++) { int kk = (tid >> 6) + 8 * i, nn = tid & 63; sm[kk * 65 + nn] = get(tk * 64 + kk, tn * 64 + nn); }
  __syncthreads();
  for (int i = 0; i < 8; i++) { int nn = (tid >> 6) + 8 * i, kk = tid & 63; dst[(size_t)(tn * 64 + nn) * K + tk * 64 + kk] = f2b(sm[kk * 65 + nn]); }
  __syncthreads();
}
__device__ __forceinline__ int prep_count(int layer) { int kind = layer % 3; return kind == 0 ? (640 + 320 + 320) : kind == 1 ? (1088 + 512 + 512) : (2176 + 64 + 256); }
__device__ __forceinline__ void prep_item(const P& p, int layer, int it, float* sm) {
  int kind = layer % 3, j = layer / 3;
  if (kind == 0) {
    if (it < 640) { int tn = it / 16, tk = it % 16; const float* s = p.lru_w_in + (size_t)j * 1024 * 2560;
      prep_tile(p.W, 1024, tn, tk, [=](int k, int n) { return s[(size_t)k * 2560 + n]; }, sm); return; }
    it -= 640;
    if (it < 320) { int d = it / 160, r = it % 160, tn = r / 2, tk = r % 2; const float* s = p.lru_gate_w + (size_t)(j * 2 + d) * 2 * 10 * 16384;
      prep_tile(p.W + WL_GATE + d * 655360, 128, tn, tk, [=](int k, int n) {
        int nt = n >> 7, blk = nt >> 1, sub = nt & 1, jj = n & 127, wn = jj >> 6, rr = jj & 63, g = rr >> 5, c = rr & 31;
        int kch = sub * 64 + wn * 32 + c; return s[((size_t)(g * 10 + blk) * 128 + k) * 128 + kch]; }, sm); return; }
    it -= 320;
    { int tn = it / 20, tk = it % 20; const float* s = p.lru_w_out + (size_t)j * 1280 * 1024;
      prep_tile(p.W + WL_OUT, 1280, tn, tk, [=](int k, int n) { return s[(size_t)k * 1024 + n]; }, sm); return; }
  } else if (kind == 1) {
    const float* s = p.ml_w_in + (size_t)j * 1024 * 6176;
    if (it < 1088) { int tn = it / 16, tk = it % 16;
      prep_tile(p.W, 1024, tn, tk, [=](int k, int n) {
        if (n < 4096) { float v = s[(size_t)k * 6176 + n]; return (n >= 1024 && n < 2048) ? v * 0.08838834764831845f : v; }
        if (n < 4128) return s[(size_t)k * 6176 + 6144 + (n - 4096)];
        return 0.f; }, sm); return; }
    it -= 1088;
    if (it < 512) { int tn = it / 16, tk = it % 16;
      prep_tile(p.W + WM_Z, 1024, tn, tk, [=](int k, int n) { return s[(size_t)k * 6176 + 4096 + n]; }, sm); return; }
    it -= 512;
    { int tn = it / 32, tk = it % 32; const float* so = p.ml_w_out + (size_t)j * 2048 * 1024;
      prep_tile(p.W + WM_OUT, 2048, tn, tk, [=](int k, int n) { return so[(size_t)k * 1024 + n]; }, sm); return; }
  } else {
    if (it < 2176) { int tn = it / 32, tk = it % 32;
      const float* mu = p.r7_mu + (size_t)j * 6 * 1024; const float* wr = p.r7_w_rkvz + (size_t)j * 4 * 1024 * 1024;
      const float* w1 = p.r7_w1 + (size_t)j * 2 * 1024 * 64; const float* a1 = p.r7_a1 + (size_t)j * 2 * 1024 * 64;
      prep_tile(p.W, 2048, tn, tk, [=](int k, int n) {
        int kk = k & 1023; float v, m;
        if (n < 4096) { int g = n >> 10, e = n & 1023; m = mu[g * 1024 + kk]; v = wr[((size_t)g * 1024 + kk) * 1024 + e]; }
        else if (n < 4224) { int xx = (n - 4096) >> 6, rr = (n - 4096) & 63; m = mu[4 * 1024 + kk]; v = w1[((size_t)xx * 1024 + kk) * 64 + rr]; }
        else { int xx = (n - 4224) >> 6, rr = (n - 4224) & 63; m = mu[5 * 1024 + kk]; v = a1[((size_t)xx * 1024 + kk) * 64 + rr]; }
        return (k < 1024 ? (1.f - m) : m) * v; }, sm); return; }
    it -= 2176;
    if (it < 64) { int u = it / 16, tn = it % 16; const float* s = (u < 2 ? p.r7_w2 : p.r7_a2) + (size_t)(j * 2 + (u & 1)) * 64 * 1024;
      prep_tile(p.W + WR_UP + u * 65536, 64, tn, 0, [=](int k, int n) { return s[(size_t)k * 1024 + n]; }, sm); return; }
    it -= 64;
    { int tn = it / 16, tk = it % 16; const float* s = p.r7_w_out + (size_t)j * 1024 * 1024;
      prep_tile(p.W + WR_OUT, 1024, tn, tk, [=](int k, int n) { return s[(size_t)k * 1024 + n]; }, sm); return; }
  }
}

#define LDSS 72
template <class G> __device__ __forceinline__ void gemm_tile(const P& p, const Ctx& c, int mt, int nt, char* smem) {
  const int tid = ltid(), lane = tid & 63, wid = tid >> 6, wm = wid & 3, wn = wid >> 2;
  bfr* sA = (bfr*)smem; bfr* sB = sA + 2 * 256 * LDSS;
  f32x4 acc[4][4];
  for (int a = 0; a < 4; a++) for (int b = 0; b < 4; b++) acc[a][b] = f32x4{0.f, 0.f, 0.f, 0.f};
  const int lr = tid >> 3, lc = tid & 7;
  uint4 ra[4], rb[2];
  auto gload = [&](int kt) __attribute__((always_inline)) {
#pragma unroll
    for (int i = 0; i < 4; i++) {
      const bfr* pa = G::aptr(p, c, mt * 256 + lr + 64 * i, kt, nt);
      ra[i] = pa ? *(const uint4*)(pa + lc * 8) : uint4{0u, 0u, 0u, 0u};
      if (i < 2) rb[i] = *(const uint4*)(G::bptr(p, c, nt * 128 + lr + 64 * i, kt) + lc * 8);
    }
  };
  auto sstore = [&](int buf) __attribute__((always_inline)) {
#pragma unroll
    for (int i = 0; i < 4; i++) {
      *(uint4*)(sA + (buf * 256 + lr + 64 * i) * LDSS + lc * 8) = ra[i];
      if (i < 2) *(uint4*)(sB + (buf * 128 + lr + 64 * i) * LDSS + lc * 8) = rb[i];
    }
  };
  gload(0); sstore(0); __syncthreads();
  for (int kt = 0; kt < G::KT; kt++) {
    const int buf = kt & 1;
    if (kt + 1 < G::KT) gload(kt + 1);
#pragma unroll
    for (int ks = 0; ks < 2; ks++) {
      bf16x8 af[4], bf[4];
#pragma unroll
      for (int i = 0; i < 4; i++) {
        af[i] = *(const bf16x8*)(sA + (buf * 256 + wm * 64 + i * 16 + (lane & 15)) * LDSS + ks * 32 + (lane >> 4) * 8);
        bf[i] = *(const bf16x8*)(sB + (buf * 128 + wn * 64 + i * 16 + (lane & 15)) * LDSS + ks * 32 + (lane >> 4) * 8);
      }
#pragma unroll
      for (int n = 0; n < 4; n++)
#pragma unroll
        for (int m = 0; m < 4; m++) acc[n][m] = __builtin_amdgcn_mfma_f32_16x16x32_bf16(bf[n], af[m], acc[n][m], 0, 0, 0);
    }
    if (kt + 1 < G::KT) sstore(buf ^ 1);
    __syncthreads();
  }
  G::epi(p, c, acc, mt * 256 + wm * 64, nt * 128 + wn * 64, lane);
}

__device__ __forceinline__ void epi_resid(const P& p, const Ctx& c, f32x4 (&acc)[4][4], int m0, int n0, int lane) {
#pragma unroll
  for (int mi = 0; mi < 4; mi++) {
    int row = m0 + mi * 16 + (lane & 15); int mo; float* xr = xrowp(p, row, mo);
    if (mo == 2 && !c.wc) continue;
    const float* g = p.MOD + (size_t)(c.layer * 3 + mo) * 3072 + 2048;
#pragma unroll
    for (int ni = 0; ni < 4; ni++) {
      int n = n0 + ni * 16 + (lane >> 4) * 4;
      float4 xv = *(float4*)(xr + n); float4 gg = *(const float4*)(g + n);
      xv.x += gg.x * acc[ni][mi][0]; xv.y += gg.y * acc[ni][mi][1]; xv.z += gg.z * acc[ni][mi][2]; xv.w += gg.w * acc[ni][mi][3];
      *(float4*)(xr + n) = xv;
    }
  }
}

struct G_LruIn { static constexpr int KT = 16, NT = 20;
  static __device__ __forceinline__ const bfr* aptr(const P& p, const Ctx& c, int row, int kt, int nt) { return p.H + (size_t)row * 1024 + kt * 64; }
  static __device__ __forceinline__ const bfr* bptr(const P& p, const Ctx& c, int n, int kt) { return p.W + (size_t)n * 1024 + kt * 64; }
  static __device__ __forceinline__ void epi(const P& p, const Ctx& c, f32x4 (&acc)[4][4], int m0, int n0, int lane) {
    bfr* U = (bfr*)(p.ACT + A_U); bfr* Z = (bfr*)(p.ACT + A_Z);
#pragma unroll
    for (int ni = 0; ni < 4; ni++)
#pragma unroll
      for (int mi = 0; mi < 4; mi++) {
        int row = m0 + mi * 16 + (lane & 15), n = n0 + ni * 16 + (lane >> 4) * 4;
        bfr* dst = n < 1280 ? U + (size_t)row * 1280 + n : Z + (size_t)row * 1280 + (n - 1280);
        store4b(dst, acc[ni][mi]);
      }
  } };
struct G_LruGate { static constexpr int KT = 2, NT = 20;
  static __device__ __forceinline__ const bfr* aptr(const P& p, const Ctx& c, int row, int kt, int nt) { return (const bfr*)(p.ACT + A_UC) + (size_t)row * 1280 + (nt >> 1) * 128 + kt * 64; }
  static __device__ __forceinline__ const bfr* bptr(const P& p, const Ctx& c, int n, int kt) { return p.W + WL_GATE + c.d * 655360 + (size_t)n * 128 + kt * 64; }
  static __device__ __forceinline__ void epi(const P& p, const Ctx& c, f32x4 (&acc)[4][4], int m0, int n0, int lane) {
    const bfr* UC = (const bfr*)(p.ACT + A_UC); unsigned* AB = (unsigned*)(p.ACT + A_AB);
    const float* gb = p.lru_gate_b + (size_t)(c.j * 2 + c.d) * 2 * 1280; const float* lam = p.lru_lam + (size_t)(c.j * 2 + c.d) * 1280;
    int chb = (n0 >> 6) * 32;
#pragma unroll
    for (int ni = 0; ni < 2; ni++) {
      int ch = chb + ni * 16 + (lane >> 4) * 4;
      float cl[4], br[4], bi[4];
#pragma unroll
      for (int q = 0; q < 4; q++) { cl[q] = 8.f * softplusf(-lam[ch + q]); br[q] = gb[ch + q]; bi[q] = gb[1280 + ch + q]; }
#pragma unroll
      for (int mi = 0; mi < 4; mi++) {
        int row = m0 + mi * 16 + (lane & 15);
        uint2 u = *(const uint2*)(UC + (size_t)row * 1280 + ch);
        float uc[4] = {blo(u.x), bhi(u.x), blo(u.y), bhi(u.y)};
        unsigned o[4];
#pragma unroll
        for (int q = 0; q < 4; q++) {
          float r = sigm(acc[ni][mi][q] + br[q]), ig = sigm(acc[ni + 2][mi][q] + bi[q]);
          float la = -cl[q] * r; float oma = 1.f - __expf(la); float bb = sqrtf(oma * (2.f - oma)) * ig * uc[q];
          o[q] = (((unsigned)f2b(oma)) << 16) | (unsigned)f2b(bb);
        }
        *(uint4*)(AB + (size_t)row * 1280 + ch) = uint4{o[0], o[1], o[2], o[3]};
      }
    }
  } };
struct G_LruOut { static constexpr int KT = 20, NT = 8;
  static __device__ __forceinline__ const bfr* aptr(const P& p, const Ctx& c, int row, int kt, int nt) { return (const bfr*)(p.ACT + A_Z) + (size_t)row * 1280 + kt * 64; }
  static __device__ __forceinline__ const bfr* bptr(const P& p, const Ctx& c, int n, int kt) { return p.W + WL_OUT + (size_t)n * 1280 + kt * 64; }
  static __device__ __forceinline__ void epi(const P& p, const Ctx& c, f32x4 (&acc)[4][4], int m0, int n0, int lane) { epi_resid(p, c, acc, m0, n0, lane); } };
struct G_MlIn { static constexpr int KT = 16, NT = 33;
  static __device__ __forceinline__ const bfr* aptr(const P& p, const Ctx& c, int row, int kt, int nt) { return p.H + (size_t)row * 1024 + kt * 64; }
  static __device__ __forceinline__ const bfr* bptr(const P& p, const Ctx& c, int n, int kt) { return p.W + (size_t)n * 1024 + kt * 64; }
  static __device__ __forceinline__ void epi(const P& p, const Ctx& c, f32x4 (&acc)[4][4], int m0, int n0, int lane) {
    bfr* QKV = (bfr*)(p.ACT + A_QKV); float* GT = (float*)(p.ACT + A_GATE);
#pragma unroll
    for (int ni = 0; ni < 4; ni++)
#pragma unroll
      for (int mi = 0; mi < 4; mi++) {
        int row = m0 + mi * 16 + (lane & 15), n = n0 + ni * 16 + (lane >> 4) * 4;
        if (n < 4096) store4b(QKV + (size_t)row * 4096 + n, acc[ni][mi]);
        else if (n < 4128) *(float4*)(GT + (size_t)row * 32 + (n - 4096)) = float4{acc[ni][mi][0], acc[ni][mi][1], acc[ni][mi][2], acc[ni][mi][3]};
      }
  } };
struct G_MlZ { static constexpr int KT = 16, NT = 16;
  static __device__ __forceinline__ const bfr* aptr(const P& p, const Ctx& c, int row, int kt, int nt) { return p.H + (size_t)row * 1024 + kt * 64; }
  static __device__ __forceinline__ const bfr* bptr(const P& p, const Ctx& c, int n, int kt) { return p.W + WM_Z + (size_t)n * 1024 + kt * 64; }
  static __device__ __forceinline__ void epi(const P& p, const Ctx& c, f32x4 (&acc)[4][4], int m0, int n0, int lane) {
    bfr* HS = (bfr*)(p.ACT + A_HS); const float* RS = (const float*)(p.ACT + A_RSTD); const float* ng = p.ml_norm_g + (size_t)c.j * 2048;
#pragma unroll
    for (int ni = 0; ni < 4; ni++)
#pragma unroll
      for (int mi = 0; mi < 4; mi++) {
        int row = m0 + mi * 16 + (lane & 15), n = n0 + ni * 16 + (lane >> 4) * 4;
        bfr* hp = HS + (size_t)row * 2048 + n; uint2 u = *(const uint2*)hp; float rs = RS[(size_t)row * 8 + (n >> 8)];
        float4 g4 = *(const float4*)(ng + n);
        f32x4 o;
        o[0] = blo(u.x) * rs * g4.x * siluf(acc[ni][mi][0]); o[1] = bhi(u.x) * rs * g4.y * siluf(acc[ni][mi][1]);
        o[2] = blo(u.y) * rs * g4.z * siluf(acc[ni][mi][2]); o[3] = bhi(u.y) * rs * g4.w * siluf(acc[ni][mi][3]);
        store4b(hp, o);
      }
  } };
struct G_MlOut { static constexpr int KT = 32, NT = 8;
  static __device__ __forceinline__ const bfr* aptr(const P& p, const Ctx& c, int row, int kt, int nt) { return (const bfr*)(p.ACT + A_HS) + (size_t)row * 2048 + kt * 64; }
  static __device__ __forceinline__ const bfr* bptr(const P& p, const Ctx& c, int n, int kt) { return p.W + WM_OUT + (size_t)n * 2048 + kt * 64; }
  static __device__ __forceinline__ void epi(const P& p, const Ctx& c, f32x4 (&acc)[4][4], int m0, int n0, int lane) { epi_resid(p, c, acc, m0, n0, lane); } };
struct G_R7In { static constexpr int KT = 32, NT = 34;
  static __device__ __forceinline__ const bfr* aptr(const P& p, const Ctx& c, int row, int kt, int nt) {
    if (kt < 16) return p.H + (size_t)row * 1024 + kt * 64;
    int q = (kt - 16) >> 2; int b = row / BT_, o = row - b * BT_; int nr;
    if (o < 256) { if (q < 2) { if (o < 1) return nullptr; nr = row - 1; } else { if (o >= 255) return nullptr; nr = row + 1; } }
    else { int t = o - 256, col = t & 63, gr = t >> 6;
      if (q == 0) { if (col == 0) return nullptr; nr = row - 1; }
      else if (q == 1) { if (col == 63) return nullptr; nr = row + 1; }
      else if (q == 2) { if (gr == 0) return nullptr; nr = row - 64; }
      else { if (gr == 255) return nullptr; nr = row + 64; } }
    return p.H + (size_t)nr * 1024 + (kt - 16) * 64; }
  static __device__ __forceinline__ const bfr* bptr(const P& p, const Ctx& c, int n, int kt) { return p.W + (size_t)n * 2048 + kt * 64; }
  static __device__ __forceinline__ void epi(const P& p, const Ctx& c, f32x4 (&acc)[4][4], int m0, int n0, int lane) {
    bfr* RK = (bfr*)(p.ACT + A_RKVZ); bfr* WMb = (bfr*)(p.ACT + A_WM); bfr* AMb = (bfr*)(p.ACT + A_AM);
#pragma unroll
    for (int ni = 0; ni < 4; ni++)
#pragma unroll
      for (int mi = 0; mi < 4; mi++) {
        int row = m0 + mi * 16 + (lane & 15), n = n0 + ni * 16 + (lane >> 4) * 4;
        if (n < 4096) store4b(RK + (size_t)row * 4096 + n, acc[ni][mi]);
        else if (n < 4224) { f32x4 t;
#pragma unroll
          for (int q = 0; q < 4; q++) t[q] = tanhf(acc[ni][mi][q]); store4b(WMb + (size_t)row * 128 + (n - 4096), t); }
        else store4b(AMb + (size_t)row * 128 + (n - 4224), acc[ni][mi]);
      }
  } };
struct G_R7Up { static constexpr int KT = 1, NT = 32;
  static __device__ __forceinline__ const bfr* aptr(const P& p, const Ctx& c, int row, int kt, int nt) { return (const bfr*)(p.ACT + ((nt & 15) < 8 ? A_WM : A_AM)) + (size_t)row * 128 + (nt >> 4) * 64; }
  static __device__ __forceinline__ const bfr* bptr(const P& p, const Ctx& c, int n, int kt) { int ds = n >> 11, m = n & 2047; return p.W + WR_UP + ((m < 1024 ? 0 : 2) + ds) * 65536 + (size_t)(m & 1023) * 64; }
  static __device__ __forceinline__ void epi(const P& p, const Ctx& c, f32x4 (&acc)[4][4], int m0, int n0, int lane) {
    unsigned char* Q8 = (unsigned char*)p.H;
#pragma unroll
    for (int ni = 0; ni < 4; ni++)
#pragma unroll
      for (int mi = 0; mi < 4; mi++) {
        int row = m0 + mi * 16 + (lane & 15), n = n0 + ni * 16 + (lane >> 4) * 4; int ds = n >> 11, m = n & 2047, e = m & 1023; unsigned pkd = 0;
        if (m < 1024) { const float* w0 = p.r7_w0 + (size_t)(c.j * 2 + ds) * 1024;
#pragma unroll
          for (int q = 0; q < 4; q++) { float sw = 0.6065306597126334f * sigm(w0[e + q] + acc[ni][mi][q]); float lq = (log2f(sw) + 13.f) * 20.f + 0.5f; int qi = (int)fminf(fmaxf(lq, 0.f), 255.f); pkd |= (unsigned)qi << (8 * q); }
          *(unsigned*)(Q8 + ((size_t)ds * R_ + row) * 1024 + e) = pkd; }
        else { const float* a0 = p.r7_a0 + (size_t)(c.j * 2 + ds) * 1024;
#pragma unroll
          for (int q = 0; q < 4; q++) { float a = sigm(a0[e + q] + acc[ni][mi][q]); int qi = (int)(a * 255.f + 0.5f); pkd |= (unsigned)qi << (8 * q); }
          *(unsigned*)(Q8 + ((size_t)(2 + ds) * R_ + row) * 1024 + e) = pkd; }
      }
  } };
struct G_R7Out { static constexpr int KT = 16, NT = 8;
  static __device__ __forceinline__ const bfr* aptr(const P& p, const Ctx& c, int row, int kt, int nt) { return p.H + (size_t)row * 1024 + kt * 64; }
  static __device__ __forceinline__ const bfr* bptr(const P& p, const Ctx& c, int n, int kt) { return p.W + WR_OUT + (size_t)n * 1024 + kt * 64; }
  static __device__ __forceinline__ void epi(const P& p, const Ctx& c, f32x4 (&acc)[4][4], int m0, int n0, int lane) { epi_resid(p, c, acc, m0, n0, lane); } };


namespace pg8 {
#define PG8_LAS __attribute__((address_space(3)))
constexpr int BM = 256, BK = 64, HALF = 128, HTB = HALF * BK * 2, NXCD = 8, WGM = 8;
__device__ __forceinline__ int lds_byte(int r, int c) { const int st = (r >> 4) * 2 + (c >> 5), rr = r & 15, cc = c & 31, ob = rr * 64 + cc * 2; return st * 1024 + (ob ^ (((ob >> 9) & 1) << 5)); }
__device__ __forceinline__ void stage_rc(int b, int& R, int& C) { const int st = b / 1024, sb = b % 1024, swz = sb ^ (((sb >> 9) & 1) << 5); R = (st >> 1) * 16 + swz / 64; C = (st & 1) * 32 + (swz % 64) / 2; }
struct Unit { int pm, pn; };
struct Gemm { const bfr* A; const bfr* Bt; int M, N, K; };
struct StaticOrder {
  int nM, nN, nwg, G, c;
  __device__ void init(int M, int N, int G_, int c_) { nM = M / BM; nN = N / BM; nwg = nM * nN; G = G_; c = c_; }
  __device__ bool next(int i, Unit& u) const {
    const long L = (long)i * G + c; if (L >= nwg) return false;
    int wgid = (int)L; { const int q = nwg / NXCD, r = nwg % NXCD, xcd = wgid % NXCD, off = wgid / NXCD; wgid = (xcd < r ? xcd * (q + 1) : r * (q + 1) + (xcd - r) * q) + off; }
    const int nig = WGM * nN, gid = wgid / nig, fm = gid * WGM, gsz = (nM - fm) < WGM ? (nM - fm) : WGM;
    u.pm = fm + ((wgid % nig) % gsz); u.pn = (wgid % nig) / gsz; return true;
  }
};
template <class Epi>
__device__ __forceinline__ void gemm_phase(PG8_LAS unsigned char* lds, const Gemm g, const StaticOrder& S, const Epi& E) {
  const int tid = ltid(), wid = __builtin_amdgcn_readfirstlane(tid >> 6), lane = tid & 63, wr = wid >> 2, wc = wid & 3, fr = lane & 15, fq = lane >> 4;
  const int K = g.K, nt = K / BK;
  unsigned voffA[2], voffB[2];
#pragma unroll
  for (int i = 0; i < 2; ++i) { int R, C; stage_rc(tid * 16 + i * 8192, R, C); voffA[i] = (unsigned)(R * K + C) * 2u; voffB[i] = voffA[i]; }
  const size_t kstep = (size_t)(BK * 2);
  const size_t hstep = (size_t)HALF * K * 2;
  const size_t tstep = 2 * hstep;
  const unsigned ldsw = (unsigned)wid * 1024u;
  const int aoff = lds_byte(wr * 64 + fr, fq * 8), boff = lds_byte(wc * 32 + fr, fq * 8);
#define PG8_SA(b, h) (((b) * 2 + (h)) * HTB)
#define PG8_SB(b, h) ((4 + (b) * 2 + (h)) * HTB)
#define PG8_STAGE(bufoff, gbase, voff) do { _Pragma("unroll") for (int _i = 0; _i < 2; ++_i) \
    __builtin_amdgcn_global_load_lds((const unsigned*)((const char*)(gbase) + (voff)[_i]), (PG8_LAS unsigned*)(lds + (bufoff) + ldsw + _i * 8192), 16, 0, 0); } while (0)
#define PG8_LDA(dst, b, h) do { _Pragma("unroll") for (int m = 0; m < 4; ++m) _Pragma("unroll") for (int k = 0; k < 2; ++k) dst[m][k] = *(const PG8_LAS bf16x8*)(lds + PG8_SA(b, h) + aoff + m * 2048 + k * 1024); } while (0)
#define PG8_LDB(dst, b, h) do { _Pragma("unroll") for (int n = 0; n < 2; ++n) _Pragma("unroll") for (int k = 0; k < 2; ++k) dst[n][k] = *(const PG8_LAS bf16x8*)(lds + PG8_SB(b, h) + boff + n * 2048 + k * 1024); } while (0)
#define PG8_MMA(ai, bj, At, Bt) do { __builtin_amdgcn_s_setprio(1); _Pragma("unroll") for (int m = 0; m < 4; ++m) _Pragma("unroll") for (int n = 0; n < 2; ++n) _Pragma("unroll") for (int k = 0; k < 2; ++k) \
    acc[ai][bj][m][n] = __builtin_amdgcn_mfma_f32_16x16x32_bf16(Bt[n][k], At[m][k], acc[ai][bj][m][n], 0, 0, 0); __builtin_amdgcn_s_setprio(0); } while (0)
#define PG8_WAIT_V(n) asm volatile("s_waitcnt vmcnt(" #n ")" ::: "memory")
#define PG8_WAIT_L(n) asm volatile("s_waitcnt lgkmcnt(" #n ")" ::: "memory")
#define PG8_BAR __builtin_amdgcn_s_barrier()
#define PG8_SCHED __builtin_amdgcn_sched_barrier(0)
  Unit cur, nxt; int ui = 0;
  if (!S.next(0, cur)) return;
  f32x4 acc[2][2][4][2];
#pragma unroll
  for (int a = 0; a < 2; ++a)
#pragma unroll
    for (int b = 0; b < 2; ++b)
#pragma unroll
      for (int m = 0; m < 4; ++m)
#pragma unroll
        for (int n = 0; n < 2; ++n) acc[a][b][m][n] = (f32x4){0.f, 0.f, 0.f, 0.f};
  bf16x8 At[4][2], B0[2][2], B1[2][2];
  const char* cA = (const char*)g.A + (size_t)cur.pm * tstep; const char* cB = (const char*)g.Bt + (size_t)cur.pn * tstep;
  PG8_STAGE(PG8_SB(0, 0), cB, voffB); PG8_STAGE(PG8_SA(0, 0), cA, voffA); PG8_STAGE(PG8_SB(0, 1), cB + hstep, voffB); PG8_STAGE(PG8_SA(0, 1), cA + hstep, voffA);
  if (wr == 1) PG8_BAR;
  PG8_WAIT_V(4); PG8_BAR;
  PG8_STAGE(PG8_SB(1, 0), cB + kstep, voffB); PG8_STAGE(PG8_SA(1, 0), cA + kstep, voffA); PG8_STAGE(PG8_SB(1, 1), cB + hstep + kstep, voffB);
  PG8_WAIT_V(6); PG8_BAR;
  for (;;) {
    const bool has_next = S.next(ui + 1, nxt);
    const char* nA = has_next ? (const char*)g.A + (size_t)nxt.pm * tstep : cA; const char* nB = has_next ? (const char*)g.Bt + (size_t)nxt.pn * tstep : cB;
    for (int t = 0; t < nt; t += 2) {
      const bool last = (t == nt - 2);
      const char* a1 = cA + (size_t)(t + 1) * kstep;
      const char* a2 = last ? nA : cA + (size_t)(t + 2) * kstep; const char* b2 = last ? nB : cB + (size_t)(t + 2) * kstep;
      const char* a3 = a2 + kstep; const char* b3 = b2 + kstep;
      PG8_LDB(B0, 0, 0); PG8_SCHED; PG8_LDA(At, 0, 0); PG8_STAGE(PG8_SA(1, 1), a1 + hstep, voffA);
      PG8_WAIT_L(8); PG8_BAR; PG8_WAIT_L(0); PG8_MMA(0, 0, At, B0); PG8_BAR; PG8_SCHED;
      PG8_LDB(B1, 0, 1); PG8_STAGE(PG8_SB(0, 0), b2, voffB);
      PG8_BAR; PG8_WAIT_L(0); PG8_MMA(0, 1, At, B1); PG8_BAR;
      PG8_LDA(At, 0, 1); PG8_STAGE(PG8_SA(0, 0), a2, voffA);
      PG8_BAR; PG8_WAIT_L(0); PG8_MMA(1, 0, At, B0); PG8_BAR; PG8_SCHED;
      PG8_STAGE(PG8_SB(0, 1), b2 + hstep, voffB);
      PG8_WAIT_V(6); PG8_BAR; PG8_MMA(1, 1, At, B1); PG8_BAR;
      PG8_LDB(B0, 1, 0); PG8_SCHED; PG8_LDA(At, 1, 0); PG8_STAGE(PG8_SA(0, 1), a2 + hstep, voffA);
      PG8_WAIT_L(8); PG8_BAR; PG8_WAIT_L(0); PG8_MMA(0, 0, At, B0); PG8_BAR; PG8_SCHED;
      PG8_LDB(B1, 1, 1); PG8_STAGE(PG8_SB(1, 0), b3, voffB);
      PG8_BAR; PG8_WAIT_L(0); PG8_MMA(0, 1, At, B1); PG8_BAR;
      PG8_LDA(At, 1, 1); PG8_STAGE(PG8_SA(1, 0), a3, voffA);
      PG8_BAR; PG8_WAIT_L(0); PG8_MMA(1, 0, At, B0); PG8_BAR; PG8_SCHED;
      PG8_STAGE(PG8_SB(1, 1), b3 + hstep, voffB);
      PG8_WAIT_V(6); PG8_BAR; PG8_MMA(1, 1, At, B1); PG8_BAR;
    }
    E(acc, cur, wr, wc, fr, fq);
    if (!has_next) break;
#pragma unroll
    for (int a = 0; a < 2; ++a)
#pragma unroll
      for (int b = 0; b < 2; ++b)
#pragma unroll
        for (int m = 0; m < 4; ++m)
#pragma unroll
          for (int n = 0; n < 2; ++n) acc[a][b][m][n] = (f32x4){0.f, 0.f, 0.f, 0.f};
    cur = nxt; cA = nA; cB = nB; ++ui;
  }
  PG8_WAIT_V(0);
  if (wr == 0) PG8_BAR;
  PG8_BAR;
#undef PG8_SA
#undef PG8_SB
#undef PG8_STAGE
#undef PG8_LDA
#undef PG8_LDB
#undef PG8_MMA
#undef PG8_WAIT_V
#undef PG8_WAIT_L
#undef PG8_BAR
#undef PG8_SCHED
}
}

template <class F> struct EpiAd {
  F f;
  __device__ __forceinline__ void operator()(const f32x4 (&acc)[2][2][4][2], const pg8::Unit& u, int wr, int wc, int fr, int fq) const {
#pragma unroll
    for (int ai = 0; ai < 2; ++ai)
#pragma unroll
      for (int m = 0; m < 4; ++m) { const int row = u.pm * 256 + ai * 128 + wr * 64 + m * 16 + fr;
#pragma unroll
        for (int bj = 0; bj < 2; ++bj)
#pragma unroll
          for (int n = 0; n < 2; ++n) f(row, u.pn * 256 + bj * 128 + wc * 32 + n * 16 + 4 * fq, acc[ai][bj][m][n]); }
  }
};
template <class F> __device__ __forceinline__ void big_gemm(char* smem, const bfr* A, const bfr* Bt, int N, int K, F f) {
  pg8::Gemm g; g.A = A; g.Bt = Bt; g.M = R_; g.N = N; g.K = K;
  pg8::StaticOrder S; S.init(R_, N, (int)gridDim.x, (int)blockIdx.x);
  EpiAd<F> E{f};
  pg8::gemm_phase(( __attribute__((address_space(3))) unsigned char*)smem, g, S, E);
}
struct F_LruIn { char* ACT; __device__ __forceinline__ void operator()(int row, int n, f32x4 v) const {
  bfr* dst = n < 1280 ? (bfr*)(ACT + A_U) + (size_t)row * 1280 + n : (bfr*)(ACT + A_Z) + (size_t)row * 1280 + (n - 1280); store4b(dst, v); } };
struct F_Resid { float* Xx; float* Xc; const float* MODg; int wc; __device__ __forceinline__ void operator()(int row, int n, f32x4 v) const {
  int b = row / BT_, o = row - b * BT_; bool isc = o < 256; if (isc && !wc) return;
  float* xr = isc ? Xc + (size_t)(b * 256 + o) * 1024 : Xx + (size_t)(b * 16384 + o - 256) * 1024; const float* g = MODg + (size_t)(isc ? 2 : b) * 3072 + 2048;
  float4 xv = *(float4*)(xr + n); float4 gg = *(const float4*)(g + n);
  xv.x += gg.x * v[0]; xv.y += gg.y * v[1]; xv.z += gg.z * v[2]; xv.w += gg.w * v[3]; *(float4*)(xr + n) = xv; } };
struct F_MlIn { char* ACT; __device__ __forceinline__ void operator()(int row, int n, f32x4 v) const {
  if (n < 4096) store4b((bfr*)(ACT + A_QKV) + (size_t)row * 4096 + n, v);
  else if (n < 4128) *(float4*)((float*)(ACT + A_GATE) + (size_t)row * 32 + (n - 4096)) = float4{v[0], v[1], v[2], v[3]}; } };
struct F_MlZ { char* ACT; const float* ng; __device__ __forceinline__ void operator()(int row, int n, f32x4 v) const {
  bfr* hp = (bfr*)(ACT + A_HS) + (size_t)row * 2048 + n; uint2 u = *(const uint2*)hp; float rs = ((const float*)(ACT + A_RSTD))[(size_t)row * 8 + (n >> 8)];
  float4 g4 = *(const float4*)(ng + n); f32x4 o;
  o[0] = blo(u.x) * rs * g4.x * siluf(v[0]); o[1] = bhi(u.x) * rs * g4.y * siluf(v[1]); o[2] = blo(u.y) * rs * g4.z * siluf(v[2]); o[3] = bhi(u.y) * rs * g4.w * siluf(v[3]);
  store4b(hp, o); } };
struct F_R7In { char* ACT; __device__ __forceinline__ void operator()(int row, int n, f32x4 v) const {
  if (n < 4096) store4b((bfr*)(ACT + A_RKVZ) + (size_t)row * 4096 + n, v);
  else if (n < 4224) { f32x4 t;
#pragma unroll
    for (int q = 0; q < 4; q++) t[q] = tanhf(v[q]);
    store4b((bfr*)(ACT + A_WM) + (size_t)row * 128 + (n - 4096), t); }
  else store4b((bfr*)(ACT + A_AM) + (size_t)row * 128 + (n - 4224), v); } };

template <class G> __device__ __forceinline__ void gemm_phase(const P& p, const Ctx& c, char* smem) {
  const int total = 130 * G::NT;
  for (int it = blockIdx.x; it < total; it += gridDim.x) gemm_tile<G>(p, c, it / G::NT, it % G::NT, smem);
}

__device__ __forceinline__ void ph_pre(const P& p, char* smem) {
  float* sm = (float*)smem; const int tid = ltid();
  const int nprep = prep_count(0), ngemv = 192, ncopy = 4160;
  for (int it = blockIdx.x; it < nprep + ngemv + ncopy; it += gridDim.x) {
    if (it < nprep) { prep_item(p, 0, it, sm); continue; }
    int i2 = it - nprep;
    if (i2 < ngemv) {
      int l = i2 / 48, cgp = i2 % 48;
      for (int i = tid; i < 3072; i += 512) { int cnd = i >> 10, k = i & 1023; float v = cnd == 0 ? p.c[k] : cnd == 1 ? p.c[1024 + k] : p.c_ctx[k]; sm[i] = siluf(v); }
      __syncthreads();
      int kq = tid >> 6, col = cgp * 64 + (tid & 63); const float* w = p.mod_w + (size_t)l * 1024 * 3072 + col;
      float a0 = 0.f, a1 = 0.f, a2 = 0.f;
      for (int k = kq * 128; k < kq * 128 + 128; k++) { float wv = w[(size_t)k * 3072]; a0 += sm[k] * wv; a1 += sm[1024 + k] * wv; a2 += sm[2048 + k] * wv; }
      float* red = sm + 3072; red[tid * 3] = a0; red[tid * 3 + 1] = a1; red[tid * 3 + 2] = a2;
      __syncthreads();
      if (tid < 64) { float bias = p.mod_b[(size_t)l * 3072 + col];
        for (int cnd = 0; cnd < 3; cnd++) { float s = bias; for (int q = 0; q < 8; q++) s += red[(q * 64 + tid) * 3 + cnd]; p.MOD[(size_t)(l * 3 + cnd) * 3072 + col] = s; } }
      __syncthreads();
      continue;
    }
    i2 -= ngemv;
    for (int q = 0; q < 4; q++) { int idx = i2 * 2048 + q * 512 + tid; int row = idx >> 8, c4 = idx & 255; int b = row / BT_, o = row - b * BT_;
      if (o < 256) ((float4*)p.Xc)[(size_t)(b * 256 + o) * 256 + c4] = ((const float4*)p.ctx)[(size_t)(b * 256 + o) * 256 + c4];
      else ((float4*)p.Xx)[(size_t)(b * 16384 + o - 256) * 256 + c4] = ((const float4*)p.x)[(size_t)(b * 16384 + o - 256) * 256 + c4]; }
  }
}
__device__ __forceinline__ void ph_norm(const P& p, int layer, char* smem) {
  const int tid = ltid(), lane = tid & 63, wid = tid >> 6;
  const int nprep = layer > 0 ? prep_count(layer) : 0; const int kind = layer % 3;
  const int nzero = kind == 1 ? 8320 : 0;
  (void)nzero;
  for (int it = blockIdx.x; it < nprep + 4160; it += gridDim.x) {
    if (it < nprep) { prep_item(p, layer, it, (float*)smem); continue; }
    int row = (it - nprep) * 8 + wid; int mo; const float* xr = xrowp(p, row, mo);
    float4 v[4]; float ss = 0.f;
#pragma unroll
    for (int i = 0; i < 4; i++) { v[i] = *(const float4*)(xr + lane * 4 + 256 * i); ss += v[i].x * v[i].x + v[i].y * v[i].y + v[i].z * v[i].z + v[i].w * v[i].w; }
    ss = wsum(ss); float rs = rsqrtf(ss * (1.f / 1024.f) + 1e-6f);
    const float* g = p.norm_g + (size_t)layer * 1024; const float* md = p.MOD + (size_t)(layer * 3 + mo) * 3072;
#pragma unroll
    for (int i = 0; i < 4; i++) { int cidx = lane * 4 + 256 * i; float4 gg = *(const float4*)(g + cidx), sh = *(const float4*)(md + cidx), sc = *(const float4*)(md + 1024 + cidx);
      f32x4 o; o[0] = v[i].x * rs * gg.x * (1.f + sc.x) + sh.x; o[1] = v[i].y * rs * gg.y * (1.f + sc.y) + sh.y; o[2] = v[i].z * rs * gg.z * (1.f + sc.z) + sh.z; o[3] = v[i].w * rs * gg.w * (1.f + sc.w) + sh.w;
      store4b(p.H + (size_t)row * (kind == 2 ? 2048 : 1024) + cidx, o); }
  }
}
__device__ __forceinline__ void ph_r7_shift(const P& p) {
  for (int it = blockIdx.x; it < 8320; it += gridDim.x) {
    int idx = it * 512 + ltid(); int row = idx >> 7, c8 = idx & 127, q = c8 >> 5;
    int b = row / BT_, o = row - b * BT_; int nr = -1;
    if (o < 256) { if (q < 2) { if (o >= 1) nr = row - 1; } else { if (o < 255) nr = row + 1; } }
    else { int t = o - 256, col = t & 63, gr = t >> 6;
      if (q == 0) { if (col != 0) nr = row - 1; } else if (q == 1) { if (col != 63) nr = row + 1; }
      else if (q == 2) { if (gr != 0) nr = row - 64; } else { if (gr != 255) nr = row + 64; } }
    uint4 v = nr >= 0 ? *(const uint4*)(p.H + (size_t)nr * 2048 + c8 * 8) : uint4{0u, 0u, 0u, 0u};
    *(uint4*)(p.H + (size_t)row * 2048 + 1024 + c8 * 8) = v;
  }
}
__device__ __forceinline__ void ph_final(const P& p) {
  const int lane = ltid() & 63, wid = ltid() >> 6;
  for (int it = blockIdx.x; it < 4096; it += gridDim.x) {
    float* xr = p.Xx + (size_t)(it * 8 + wid) * 1024; float4 v[4]; float ss = 0.f;
#pragma unroll
    for (int i = 0; i < 4; i++) { v[i] = *(const float4*)(xr + lane * 4 + 256 * i); ss += v[i].x * v[i].x + v[i].y * v[i].y + v[i].z * v[i].z + v[i].w * v[i].w; }
    ss = wsum(ss); float rs = rsqrtf(ss * (1.f / 1024.f) + 1e-6f);
#pragma unroll
    for (int i = 0; i < 4; i++) { int cidx = lane * 4 + 256 * i; float4 gg = *(const float4*)(p.final_g + cidx);
      *(float4*)(xr + cidx) = float4{v[i].x * rs * gg.x, v[i].y * rs * gg.y, v[i].z * rs * gg.z, v[i].w * rs * gg.w}; }
  }
}
__device__ __forceinline__ void ph_lru_conv(const P& p, int j) {
  const bfr* U = (const bfr*)(p.ACT + A_U); bfr* UC = (bfr*)(p.ACT + A_UC);
  const float* cw = p.lru_conv_w + (size_t)j * 4 * 1280; const float* cb = p.lru_conv_b + (size_t)j * 1280;
  for (int it = blockIdx.x; it < 10400; it += gridDim.x) {
    int idx = it * 512 + ltid(); int row = idx / 160, cgp = idx % 160, ch = cgp * 8;
    int b = row / BT_, o = row - b * BT_; int s0 = o < 256 ? 0 : 256, e0 = o < 256 ? 256 : BT_;
    float acc[8];
#pragma unroll
    for (int e = 0; e < 8; e++) acc[e] = cb[ch + e];
#pragma unroll
    for (int t = 0; t < 4; t++) { int oo = o + t - 2; if (oo < s0 || oo >= e0) continue;
      uint4 u = *(const uint4*)(U + (size_t)(row + t - 2) * 1280 + ch); const float* w = cw + t * 1280 + ch;
      acc[0] += w[0] * blo(u.x); acc[1] += w[1] * bhi(u.x); acc[2] += w[2] * blo(u.y); acc[3] += w[3] * bhi(u.y);
      acc[4] += w[4] * blo(u.z); acc[5] += w[5] * bhi(u.z); acc[6] += w[6] * blo(u.w); acc[7] += w[7] * bhi(u.w); }
    *(uint4*)(UC + (size_t)row * 1280 + ch) = uint4{pk2(acc[0], acc[1]), pk2(acc[2], acc[3]), pk2(acc[4], acc[5]), pk2(acc[6], acc[7])};
  }
}
__device__ __forceinline__ void ph_lru_s1(const P& p, int d) {
  const unsigned* AB = (const unsigned*)(p.ACT + A_AB); float2* AGG = (float2*)(p.ACT + A_AGG);
  const int t = ltid();
  for (int it = blockIdx.x * 8 + (t >> 6); it < 2600; it += gridDim.x * 8) {
    int b = it / 1300, r = it % 1300, cc = r / 5, ch = (r % 5) * 256 + (t & 63) * 4;
    float P0 = 1.f, Q0 = 0.f, P1 = 1.f, Q1 = 0.f, P2 = 1.f, Q2 = 0.f, P3 = 1.f, Q3 = 0.f;
#pragma unroll 8
    for (int q = 0; q < 64; q++) { uint4 u = *(const uint4*)(AB + (size_t)rowmap(d, b, cc * 64 + q) * 1280 + ch);
      float a0 = 1.f - bhi(u.x), a1 = 1.f - bhi(u.y), a2 = 1.f - bhi(u.z), a3 = 1.f - bhi(u.w);
      P0 *= a0; Q0 = a0 * Q0 + blo(u.x); P1 *= a1; Q1 = a1 * Q1 + blo(u.y); P2 *= a2; Q2 = a2 * Q2 + blo(u.z); P3 *= a3; Q3 = a3 * Q3 + blo(u.w); }
    float4* ag = (float4*)(AGG + (size_t)(b * NCH_ + cc) * 1280 + ch); ag[0] = float4{P0, Q0, P1, Q1}; ag[1] = float4{P2, Q2, P3, Q3};
  }
}
__device__ __forceinline__ void ph_lru_s2(const P& p) {
  const float2* AGG = (const float2*)(p.ACT + A_AGG); float* CAR = (float*)(p.ACT + A_CAR);
  for (int it = blockIdx.x; it < 5; it += gridDim.x) {
    int idx = it * 512 + ltid(), b = idx / 1280, ch = idx % 1280; float h = 0.f;
#pragma unroll 20
    for (int cc = 0; cc < NCH_; cc++) { size_t o = (size_t)(b * NCH_ + cc) * 1280 + ch; float2 a = AGG[o]; CAR[o] = h; h = a.x * h + a.y; }
  }
}
__device__ __forceinline__ void ph_lru_s3(const P& p, int d) {
  const unsigned* AB = (const unsigned*)(p.ACT + A_AB); const float* CAR = (const float*)(p.ACT + A_CAR);
  bfr* HF = (bfr*)(p.ACT + A_HF); bfr* Z = (bfr*)(p.ACT + A_Z);
  const int t = ltid();
  for (int it = blockIdx.x * 8 + (t >> 6); it < 2600; it += gridDim.x * 8) {
    int b = it / 1300, r = it % 1300, cc = r / 5, ch = (r % 5) * 256 + (t & 63) * 4;
    float4 h = *(const float4*)(CAR + (size_t)(b * NCH_ + cc) * 1280 + ch);
#pragma unroll 8
    for (int q = 0; q < 64; q++) { size_t o = (size_t)rowmap(d, b, cc * 64 + q) * 1280 + ch; uint4 u = *(const uint4*)(AB + o);
      h.x = (1.f - bhi(u.x)) * h.x + blo(u.x); h.y = (1.f - bhi(u.y)) * h.y + blo(u.y); h.z = (1.f - bhi(u.z)) * h.z + blo(u.z); h.w = (1.f - bhi(u.w)) * h.w + blo(u.w);
      if (d == 0) *(uint2*)(HF + o) = uint2{pk2(h.x, h.y), pk2(h.z, h.w)};
      else { uint2 hf = *(const uint2*)(HF + o), zz = *(const uint2*)(Z + o);
        *(uint2*)(Z + o) = uint2{pk2((blo(hf.x) + h.x) * siluf(blo(zz.x)), (bhi(hf.x) + h.y) * siluf(bhi(zz.x))), pk2((blo(hf.y) + h.z) * siluf(blo(zz.y)), (bhi(hf.y) + h.w) * siluf(bhi(zz.y)))}; } }
  }
}
__device__ __forceinline__ void ph_ml_stat(const P& p) {
  const bfr* HS = (const bfr*)(p.ACT + A_HS); float* RS = (float*)(p.ACT + A_RSTD);
  const int lane = ltid() & 63, wid = ltid() >> 6;
  for (int it = blockIdx.x; it < 4160; it += gridDim.x) {
    int row = it * 8 + wid; const bfr* hp = HS + (size_t)row * 2048 + lane * 32; float ss = 0.f;
#pragma unroll
    for (int i = 0; i < 4; i++) { uint4 u = *(const uint4*)(hp + i * 8); float a;
      a = blo(u.x); ss += a * a; a = bhi(u.x); ss += a * a; a = blo(u.y); ss += a * a; a = bhi(u.y); ss += a * a;
      a = blo(u.z); ss += a * a; a = bhi(u.z); ss += a * a; a = blo(u.w); ss += a * a; a = bhi(u.w); ss += a * a; }
    ss += __shfl_xor(ss, 1); ss += __shfl_xor(ss, 2); ss += __shfl_xor(ss, 4);
    if ((lane & 7) == 0) RS[(size_t)row * 8 + (lane >> 3)] = rsqrtf(ss * (1.f / 256.f) + 1e-6f);
  }
}
__device__ __forceinline__ void ph_r7_fin(const P& p, int j) {
  bfr* Y = (bfr*)(p.ACT + A_Y); const bfr* RK = (const bfr*)(p.ACT + A_RKVZ); const float* BON = (const float*)(p.ACT + A_BON);
  const float* lg = p.r7_ln_g + (size_t)j * 1024; const float* lb = p.r7_ln_b + (size_t)j * 1024;
  const int lane = ltid() & 63, wid = ltid() >> 6;
  for (int it = blockIdx.x; it < 4160; it += gridDim.x) {
    int row = it * 8 + wid, ch = lane * 16, hd = lane >> 2;
    float y[16], v[16], z[16];
#pragma unroll
    for (int i = 0; i < 2; i++) {
      uint4 u = *(const uint4*)(Y + (size_t)row * 1024 + ch + i * 8);
      y[i * 8 + 0] = blo(u.x); y[i * 8 + 1] = bhi(u.x); y[i * 8 + 2] = blo(u.y); y[i * 8 + 3] = bhi(u.y); y[i * 8 + 4] = blo(u.z); y[i * 8 + 5] = bhi(u.z); y[i * 8 + 6] = blo(u.w); y[i * 8 + 7] = bhi(u.w);
      u = *(const uint4*)(RK + (size_t)row * 4096 + 2048 + ch + i * 8);
      v[i * 8 + 0] = blo(u.x); v[i * 8 + 1] = bhi(u.x); v[i * 8 + 2] = blo(u.y); v[i * 8 + 3] = bhi(u.y); v[i * 8 + 4] = blo(u.z); v[i * 8 + 5] = bhi(u.z); v[i * 8 + 6] = blo(u.w); v[i * 8 + 7] = bhi(u.w);
      u = *(const uint4*)(RK + (size_t)row * 4096 + 3072 + ch + i * 8);
      z[i * 8 + 0] = blo(u.x); z[i * 8 + 1] = bhi(u.x); z[i * 8 + 2] = blo(u.y); z[i * 8 + 3] = bhi(u.y); z[i * 8 + 4] = blo(u.z); z[i * 8 + 5] = bhi(u.z); z[i * 8 + 6] = blo(u.w); z[i * 8 + 7] = bhi(u.w);
    }
    float s = 0.f;
#pragma unroll
    for (int e = 0; e < 16; e++) s += y[e];
    s += __shfl_xor(s, 1); s += __shfl_xor(s, 2); float mean = s * (1.f / 64.f);
    float q = 0.f;
#pragma unroll
    for (int e = 0; e < 16; e++) { float dlt = y[e] - mean; q += dlt * dlt; }
    q += __shfl_xor(q, 1); q += __shfl_xor(q, 2); float rs = rsqrtf(q * (1.f / 64.f) + 64e-5f);
    float bon = BON[(size_t)row * 16 + hd] + BON[(size_t)(R_ + row) * 16 + hd];
    float o[16];
#pragma unroll
    for (int e = 0; e < 16; e++) { float yn = (y[e] - mean) * rs * lg[ch + e] + lb[ch + e]; o[e] = (yn + bon * v[e]) * siluf(z[e]); }
#pragma unroll
    for (int i = 0; i < 2; i++)
      *(uint4*)(Y + (size_t)row * 1024 + ch + i * 8) = uint4{pk2(o[i * 8], o[i * 8 + 1]), pk2(o[i * 8 + 2], o[i * 8 + 3]), pk2(o[i * 8 + 4], o[i * 8 + 5]), pk2(o[i * 8 + 6], o[i * 8 + 7])};
  }
}

#define QS 136
#define VS 72
#define MLG_BYTES 45056
__device__ __forceinline__ void ph_ml_scan(const P& p, int j, char* smem0) {
  const int d = ltid() >> 8;
  char* smem = smem0 + d * MLG_BYTES;
  bfr* sQ = (bfr*)smem; bfr* sK = sQ + 64 * QS; bfr* sVT = sK + 64 * QS; bfr* sCT = sVT + 16 * VS;
  float* sN = (float*)(sCT + 16 * QS);
  float* sEs = sN + 128; float* sCt = sEs + 64; float* sBc = sCt + 64; float* sWg = sBc + 64; float* sNr = sWg + 64;
  const bfr* QKV = (const bfr*)(p.ACT + A_QKV); const float* GT = (const float*)(p.ACT + A_GATE); bfr* HS = (bfr*)(p.ACT + A_HS);
  const float* gbias = p.ml_gate_b + (size_t)j * 32;
  const int tid = ltid() & 255, lane = tid & 63, w = tid >> 6, l15 = lane & 15, q4 = lane >> 4;
  for (int it = blockIdx.x; it < 256; it += gridDim.x) {
    const int b = it >> 7, hh = (it >> 4) & 7, sl = it & 15;
    f32x4 Cacc[2];
    Cacc[0] = f32x4{0.f, 0.f, 0.f, 0.f}; Cacc[1] = f32x4{0.f, 0.f, 0.f, 0.f};
    float mcur = 0.f;
    for (int i = tid; i < 16 * QS; i += 256) sCT[i] = 0;
    if (tid < 128) sN[tid] = 0.f;
    uint4 pq0, pq1, pq2, pq3, pk0, pk1, pk2, pk3, pv = uint4{0u, 0u, 0u, 0u}; float pgi, pgf;
#define ML_ROW0(s_) (d == 0 ? b * BT_ + 64 * (s_) : rowmap(1, b, 64 * (s_) + 63))
#define ML_LD(i_, PQ, PK) { int idx = tid + 256 * (i_), rho = idx >> 4, c8 = idx & 15; const bfr* src = QKV + (size_t)(r0n + rho) * 4096 + hh * 128 + c8 * 8; PQ = *(const uint4*)src; PK = *(const uint4*)(src + 1024); }
#define ML_ISSUE(s_) { const int r0n = ML_ROW0(s_); ML_LD(0, pq0, pk0) ML_LD(1, pq1, pk1) ML_LD(2, pq2, pk2) ML_LD(3, pq3, pk3) \
      if (tid < 128) pv = *(const uint4*)(QKV + (size_t)(r0n + (tid >> 1)) * 4096 + 2048 + hh * 256 + sl * 16 + (tid & 1) * 8); \
      { const float* gp_ = GT + (size_t)(r0n + (d ? 63 - lane : lane)) * 32 + d * 16 + hh; pgi = gp_[0]; pgf = gp_[8]; } }
#define ML_ST(i_, PQ, PK) { int idx = tid + 256 * (i_), rho = idx >> 4, c8 = idx & 15; *(uint4*)(sQ + rho * QS + c8 * 8) = PQ; *(uint4*)(sK + rho * QS + c8 * 8) = PK; }
#define ML_COMMIT() { ML_ST(0, pq0, pk0) ML_ST(1, pq1, pk1) ML_ST(2, pq2, pk2) ML_ST(3, pq3, pk3) \
      if (tid < 128) { int rho = tid >> 1, vb = (tid & 1) * 8; \
        sVT[(vb + 0) * VS + rho] = (bfr)(pv.x & 0xffff); sVT[(vb + 1) * VS + rho] = (bfr)(pv.x >> 16); \
        sVT[(vb + 2) * VS + rho] = (bfr)(pv.y & 0xffff); sVT[(vb + 3) * VS + rho] = (bfr)(pv.y >> 16); \
        sVT[(vb + 4) * VS + rho] = (bfr)(pv.z & 0xffff); sVT[(vb + 5) * VS + rho] = (bfr)(pv.z >> 16); \
        sVT[(vb + 6) * VS + rho] = (bfr)(pv.w & 0xffff); sVT[(vb + 7) * VS + rho] = (bfr)(pv.w >> 16); } }
    ML_ISSUE(0)
    __syncthreads();
    for (int s = 0; s < NCH_; s++) {
      const int r0 = ML_ROW0(s);
      ML_COMMIT()
      float mxl, decay;
      {
        int rho = d ? 63 - lane : lane;
        float gi = pgi + gbias[(d * 2 + 0) * 8 + hh], gf = pgf + gbias[(d * 2 + 1) * 8 + hh];
        float fc = fminf(gf, 0.f) - log1pf(__expf(-fabsf(gf)));
        float bc = fc;
        for (int o = 1; o < 64; o <<= 1) { float t = __shfl_up(bc, o); if (lane >= o) bc += t; }
        float e = gi - bc, pm = e;
        for (int o = 1; o < 64; o <<= 1) { float t = __shfl_up(pm, o); if (lane >= o) pm = fmaxf(pm, t); }
        float pml = __shfl(pm, 63), bcl = __shfl(bc, 63);
        mxl = fmaxf(mcur, pml); decay = __expf(mcur - mxl);
        if (w == 0) { sEs[rho] = e; sCt[rho] = -fmaxf(mcur, pm); sBc[rho] = bc; sWg[rho] = __expf(e - mxl); }
        pml = bcl + mxl;
        bcl = mcur; mcur = pml; pml = bcl;
        mxl = pml;
      }
      const float mold = mxl;
      __syncthreads();
      const int rt = 16 * w + l15;
      bfr* hp = HS + (size_t)(r0 + rt) * 2048 + hh * 256 + sl * 16 + 4 * q4;
      bool first; { int rc = (r0 - b * BT_) >> 6; if (d == 0) { int sp = rc < 4 ? 3 - rc : 263 - rc; first = s < sp; } else first = s < rc; }
      unsigned long long uu = 0ull;
      if (!first) uu = __hip_atomic_load((unsigned long long*)hp, __ATOMIC_RELAXED, __HIP_MEMORY_SCOPE_AGENT);
      if (s + 1 < NCH_) ML_ISSUE(s + 1)
      bf16x8 qf[4];
#pragma unroll
      for (int ks = 0; ks < 4; ks++) qf[ks] = *(const bf16x8*)(sQ + (16 * w + l15) * QS + ks * 32 + q4 * 8);
      f32x4 sacc[4];
#pragma unroll
      for (int a = 0; a < 4; a++) { sacc[a] = f32x4{0.f, 0.f, 0.f, 0.f};
#pragma unroll
        for (int ks = 0; ks < 4; ks++) { bf16x8 kf = *(const bf16x8*)(sK + (16 * a + l15) * QS + ks * 32 + q4 * 8); sacc[a] = __builtin_amdgcn_mfma_f32_16x16x32_bf16(kf, qf[ks], sacc[a], 0, 0, 0); } }
      const float ctt = sCt[rt]; float densum = 0.f;
#pragma unroll
      for (int a = 0; a < 4; a++)
#pragma unroll
        for (int jj = 0; jj < 4; jj++) { int rs_ = 16 * a + 4 * q4 + jj; bool valid = d == 0 ? rs_ <= rt : rs_ >= rt;
          float wv = valid ? __expf(ctt + sEs[rs_]) : 0.f; float sv = sacc[a][jj] * wv; sacc[a][jj] = sv; densum += sv; }
      densum += __shfl_xor(densum, 16); densum += __shfl_xor(densum, 32);
      bf16x8 sf[2], vf[2];
#pragma unroll
      for (int ks = 0; ks < 2; ks++) {
#pragma unroll
        for (int jj = 0; jj < 4; jj++) { sf[ks][jj] = (short)f2b(sacc[2 * ks][jj]); sf[ks][4 + jj] = (short)f2b(sacc[2 * ks + 1][jj]); }
        uint2 v0 = *(const uint2*)(sVT + l15 * VS + 32 * ks + 4 * q4), v1 = *(const uint2*)(sVT + l15 * VS + 32 * ks + 16 + 4 * q4);
        uint4 vv = uint4{v0.x, v0.y, v1.x, v1.y}; vf[ks] = *(bf16x8*)&vv;
      }
      f32x4 num = f32x4{0.f, 0.f, 0.f, 0.f}, numC = f32x4{0.f, 0.f, 0.f, 0.f};
#pragma unroll
      for (int ks = 0; ks < 2; ks++) num = __builtin_amdgcn_mfma_f32_16x16x32_bf16(vf[ks], sf[ks], num, 0, 0, 0);
#pragma unroll
      for (int ks = 0; ks < 4; ks++) { bf16x8 cf = *(const bf16x8*)(sCT + l15 * QS + ks * 32 + q4 * 8); numC = __builtin_amdgcn_mfma_f32_16x16x32_bf16(cf, qf[ks], numC, 0, 0, 0); }
      float qn = 0.f;
#pragma unroll
      for (int i = 0; i < 4; i++) { uint4 u = *(const uint4*)(sQ + rt * QS + 32 * q4 + i * 8); const float* nn = sN + 32 * q4 + i * 8;
        qn += blo(u.x) * nn[0] + bhi(u.x) * nn[1] + blo(u.y) * nn[2] + bhi(u.y) * nn[3] + blo(u.z) * nn[4] + bhi(u.z) * nn[5] + blo(u.w) * nn[6] + bhi(u.w) * nn[7]; }
      qn += __shfl_xor(qn, 16); qn += __shfl_xor(qn, 32);
      {
        float inter = __expf(mold + ctt); float den = densum + inter * qn; float dn = fmaxf(fabsf(den), __expf(ctt - sBc[rt])); float inv = 1.f / dn;
        f32x4 hv;
#pragma unroll
        for (int jj = 0; jj < 4; jj++) hv[jj] = (num[jj] + inter * numC[jj]) * inv;
        if (!first) { unsigned ux = (unsigned)uu, uy = (unsigned)(uu >> 32);
          hv[0] += blo(ux); hv[1] += bhi(ux); hv[2] += blo(uy); hv[3] += bhi(uy); }
        store4b(hp, hv);
      }
      __syncthreads();
      {
        bf16x8 vw[2];
#pragma unroll
        for (int ks = 0; ks < 2; ks++)
#pragma unroll
          for (int e = 0; e < 8; e++) { int rs_ = 32 * ks + (e < 4 ? 4 * q4 + e : 16 + 4 * q4 + e - 4); vw[ks][e] = (short)f2b(b2f((bfr)vf[ks][e]) * sWg[rs_]); }
#pragma unroll
        for (int a = 0; a < 2; a++) {
          int dk = 32 * w + 16 * a + l15;
#pragma unroll
          for (int jj = 0; jj < 4; jj++) Cacc[a][jj] *= decay;
#pragma unroll
          for (int ks = 0; ks < 2; ks++) { bf16x8 kt;
#pragma unroll
            for (int e = 0; e < 8; e++) { int rs_ = 32 * ks + (e < 4 ? 4 * q4 + e : 16 + 4 * q4 + e - 4); kt[e] = (short)sK[rs_ * QS + dk]; }
            Cacc[a] = __builtin_amdgcn_mfma_f32_16x16x32_bf16(vw[ks], kt, Cacc[a], 0, 0, 0); }
#pragma unroll
          for (int jj = 0; jj < 4; jj++) sCT[(4 * q4 + jj) * QS + dk] = f2b(Cacc[a][jj]);
        }
        int dk = tid & 127, hf = tid >> 7; float part = 0.f;
#pragma unroll 8
        for (int r = 0; r < 32; r++) part += sWg[32 * hf + r] * b2f(sK[(32 * hf + r) * QS + dk]);
        sNr[tid] = part;
      }
      __syncthreads();
      if (tid < 128) sN[tid] = decay * sN[tid] + sNr[tid] + sNr[128 + tid];
    }
    __syncthreads();
  }
}

#define R7G_BYTES 58368
__device__ __forceinline__ void ph_r7_scan(const P& p, int j, char* smem) {
  const unsigned char* Q8 = (const unsigned char*)p.H;
  const bfr* RK = (const bfr*)(p.ACT + A_RKVZ); float* BON = (float*)(p.ACT + A_BON); bfr* Y = (bfr*)(p.ACT + A_Y);
  const float* kkp = p.r7_k_k + (size_t)j * 1024; const float* kap = p.r7_k_a + (size_t)j * 1024; const float* rkp = p.r7_r_k + (size_t)j * 1024;
  const int tid = ltid(), lane = tid & 63, w = tid >> 6, kp = lane & 15, rr = lane >> 4;
  const int g = tid >> 8, t8 = tid & 255, si = t8 >> 3, sc = t8 & 7;
  const int rd = (w >> 1) & 1, rw = w & 1;
  float* gs = (float*)(smem + g * R7G_BYTES);
  float* gW = gs; float* gKa = gW + 2048; float* gBe = gKa + 2048; float* gKd = gBe + 2048; float* gR = gKd + 2048; float* gV = gR + 2048;
  const float* rs = (const float*)(smem + rd * R7G_BYTES);
  const float* sW = rs; const float* sKa = sW + 2048; const float* sBe = sKa + 2048; const float* sKd = sBe + 2048; const float* sR = sKd + 2048; const float* sV = sR + 2048;
  float* sYr = (float*)(smem + rd * R7G_BYTES) + 2048 * 5 + 256;
  for (int it = blockIdx.x; it < 256; it += gridDim.x) {
    const int b = it >> 7, hh = (it >> 3) & 15, rg = it & 7;
    const int col = hh * 64 + sc * 8;
    float kkc[8], kac[8], rkc[8];
#pragma unroll
    for (int e = 0; e < 8; e++) { kkc[e] = kkp[col + e]; kac[e] = kap[col + e]; rkc[e] = rkp[col + e]; }
    float s0 = 0.f, s1 = 0.f, s2 = 0.f, s3 = 0.f;
    uint4 pr, pk, pv; uint2 pw, pa;
#define R7_ISSUE(blk_) { int row = rowmap(g, b, (blk_) * 32 + si); const bfr* rp = RK + (size_t)row * 4096 + col; \
      pr = *(const uint4*)rp; pk = *(const uint4*)(rp + 1024); pv = *(const uint4*)(rp + 2048); \
      pw = *(const uint2*)(Q8 + ((size_t)g * R_ + row) * 1024 + col); pa = *(const uint2*)(Q8 + ((size_t)(2 + g) * R_ + row) * 1024 + col); }
    R7_ISSUE(0)
    for (int blk = 0; blk < BT_ / 32; blk++) {
      __syncthreads();
      {
        const int row = rowmap(g, b, blk * 32 + si);
        unsigned ur[4] = {pr.x, pr.y, pr.z, pr.w}, uk[4] = {pk.x, pk.y, pk.z, pk.w}, uv[4] = {pv.x, pv.y, pv.z, pv.w};
        float r8[8], k8[8], v8[8], w8[8], a8[8], kr[8];
#pragma unroll
        for (int e = 0; e < 4; e++) { r8[2 * e] = blo(ur[e]); r8[2 * e + 1] = bhi(ur[e]); k8[2 * e] = blo(uk[e]); k8[2 * e + 1] = bhi(uk[e]); v8[2 * e] = blo(uv[e]); v8[2 * e + 1] = bhi(uv[e]); }
#pragma unroll
        for (int e = 0; e < 4; e++) { w8[e] = (float)((pw.x >> (8 * e)) & 255u); w8[4 + e] = (float)((pw.y >> (8 * e)) & 255u); a8[e] = (float)((pa.x >> (8 * e)) & 255u) * (1.f / 255.f); a8[4 + e] = (float)((pa.y >> (8 * e)) & 255u) * (1.f / 255.f); }
        float ss = 0.f;
#pragma unroll
        for (int e = 0; e < 8; e++) { kr[e] = k8[e] * kkc[e]; ss += kr[e] * kr[e]; }
        ss += __shfl_xor(ss, 1); ss += __shfl_xor(ss, 2); ss += __shfl_xor(ss, 4);
        float inv = 1.f / fmaxf(sqrtf(ss), 1e-12f);
        float bon = 0.f; float ow[8], oka[8], obe[8], okd[8];
#pragma unroll
        for (int e = 0; e < 8; e++) { float ka = kr[e] * inv; oka[e] = ka; obe[e] = a8[e] * ka; float kd = k8[e] * (1.f + (a8[e] - 1.f) * kac[e]); okd[e] = kd;
          ow[e] = __expf(-exp2f(w8[e] * 0.05f - 13.f)); bon += r8[e] * kd * rkc[e]; }
        bon += __shfl_xor(bon, 1); bon += __shfl_xor(bon, 2); bon += __shfl_xor(bon, 4);
        if (rg == 0 && sc == 0) BON[((size_t)g * R_ + row) * 16 + hh] = bon;
        int o = si * 64 + sc * 8;
        *(float4*)(gW + o) = float4{ow[0], ow[1], ow[2], ow[3]}; *(float4*)(gW + o + 4) = float4{ow[4], ow[5], ow[6], ow[7]};
        *(float4*)(gKa + o) = float4{oka[0], oka[1], oka[2], oka[3]}; *(float4*)(gKa + o + 4) = float4{oka[4], oka[5], oka[6], oka[7]};
        *(float4*)(gBe + o) = float4{obe[0], obe[1], obe[2], obe[3]}; *(float4*)(gBe + o + 4) = float4{obe[4], obe[5], obe[6], obe[7]};
        *(float4*)(gKd + o) = float4{okd[0], okd[1], okd[2], okd[3]}; *(float4*)(gKd + o + 4) = float4{okd[4], okd[5], okd[6], okd[7]};
        *(float4*)(gR + o) = float4{r8[0], r8[1], r8[2], r8[3]}; *(float4*)(gR + o + 4) = float4{r8[4], r8[5], r8[6], r8[7]};
        if (sc == rg) { *(float4*)(gV + si * 8) = float4{v8[0], v8[1], v8[2], v8[3]}; *(float4*)(gV + si * 8 + 4) = float4{v8[4], v8[5], v8[6], v8[7]}; }
      }
      __syncthreads();
      unsigned long long yu0 = 0ull, yu1 = 0ull; bool yfirst = true; bfr* yp = Y;
      if (tid < 64) {
        const int og = tid >> 5, pp = blk * 32 + (tid & 31); const int row = rowmap(og, b, pp), o = row - b * BT_;
        yfirst = og == 0 ? (pp < (o < 256 ? 255 - o : 16895 - o)) : (pp < o);
        yp = Y + (size_t)row * 1024 + hh * 64 + rg * 8;
        if (!yfirst) { yu0 = __hip_atomic_load((unsigned long long*)yp, __ATOMIC_RELAXED, __HIP_MEMORY_SCOPE_AGENT); yu1 = __hip_atomic_load((unsigned long long*)yp + 1, __ATOMIC_RELAXED, __HIP_MEMORY_SCOPE_AGENT); }
      }
      if (blk + 1 < BT_ / 32) R7_ISSUE(blk + 1)
      if (w < 4) {
        float4 w4 = *(const float4*)(sW + kp * 4), ka4 = *(const float4*)(sKa + kp * 4), be4 = *(const float4*)(sBe + kp * 4);
        float4 kd4 = *(const float4*)(sKd + kp * 4), r4 = *(const float4*)(sR + kp * 4); float vv = sV[rw * 4 + rr];
#pragma unroll 4
        for (int i = 0; i < 32; i++) {
          const int in = (i + 1) & 31;
          float4 nw4 = *(const float4*)(sW + in * 64 + kp * 4), nka4 = *(const float4*)(sKa + in * 64 + kp * 4), nbe4 = *(const float4*)(sBe + in * 64 + kp * 4);
          float4 nkd4 = *(const float4*)(sKd + in * 64 + kp * 4), nr4 = *(const float4*)(sR + in * 64 + kp * 4); float nvv = sV[in * 8 + rw * 4 + rr];
          float sa = red16((s0 * ka4.x + s1 * ka4.y) + (s2 * ka4.z + s3 * ka4.w));
          s0 = s0 * w4.x + (kd4.x * vv - sa * be4.x); s1 = s1 * w4.y + (kd4.y * vv - sa * be4.y);
          s2 = s2 * w4.z + (kd4.z * vv - sa * be4.z); s3 = s3 * w4.w + (kd4.w * vv - sa * be4.w);
          float y = red16((s0 * r4.x + s1 * r4.y) + (s2 * r4.z + s3 * r4.w));
          sYr[(i * 8 + rw * 4 + rr) * 16 + kp] = y;
          w4 = nw4; ka4 = nka4; be4 = nbe4; kd4 = nkd4; r4 = nr4; vv = nvv;
        }
      }
      __syncthreads();
      if (tid < 64) {
        const int og = tid >> 5, i = tid & 31;
        const float* sy = (const float*)(smem + og * R7G_BYTES) + 2048 * 5 + 256 + i * 128; float yy[8];
#pragma unroll
        for (int e = 0; e < 8; e++) yy[e] = sy[e * 16];
        if (!yfirst) { const unsigned long long u0 = yu0, u1 = yu1;
          unsigned ux = (unsigned)u0, uy = (unsigned)(u0 >> 32), uz = (unsigned)u1, uw = (unsigned)(u1 >> 32);
          yy[0] += blo(ux); yy[1] += bhi(ux); yy[2] += blo(uy); yy[3] += bhi(uy); yy[4] += blo(uz); yy[5] += bhi(uz); yy[6] += blo(uw); yy[7] += bhi(uw); }
        *(uint4*)yp = uint4{pk2(yy[0], yy[1]), pk2(yy[2], yy[3]), pk2(yy[4], yy[5]), pk2(yy[6], yy[7])};
      }
    }
    __syncthreads();
  }
}

__device__ __forceinline__ void run_phase(const P& p, int ph, int layer, int d, char* smem) {
  Ctx c; c.layer = layer; c.j = layer / 3; c.d = d; c.wc = layer < 3 ? 1 : 0;
  switch (ph) {
    case PH_PRE: ph_pre(p, smem); break;
    case PH_NORM: ph_norm(p, layer, smem); break;
    case PH_LRU_IN: big_gemm(smem, p.H, p.W, 2560, 1024, F_LruIn{p.ACT}); break;
    case PH_LRU_CONV: ph_lru_conv(p, c.j); break;
    case PH_LRU_GATE: gemm_phase<G_LruGate>(p, c, smem); break;
    case PH_LRU_S1: ph_lru_s1(p, d); break;
    case PH_LRU_S2: ph_lru_s2(p); break;
    case PH_LRU_S3: ph_lru_s3(p, d); break;
    case PH_LRU_OUT: big_gemm(smem, (const bfr*)(p.ACT + A_Z), p.W + WL_OUT, 1024, 1280, F_Resid{p.Xx, p.Xc, p.MOD + (size_t)layer * 3 * 3072, c.wc}); break;
    case PH_ML_IN: big_gemm(smem, p.H, p.W, 4352, 1024, F_MlIn{p.ACT}); break;
    case PH_ML_SCAN: ph_ml_scan(p, c.j, smem); break;
    case PH_ML_STAT: ph_ml_stat(p); break;
    case PH_ML_Z: big_gemm(smem, p.H, p.W + WM_Z, 2048, 1024, F_MlZ{p.ACT, p.ml_norm_g + (size_t)c.j * 2048}); break;
    case PH_ML_OUT: big_gemm(smem, (const bfr*)(p.ACT + A_HS), p.W + WM_OUT, 1024, 2048, F_Resid{p.Xx, p.Xc, p.MOD + (size_t)layer * 3 * 3072, c.wc}); break;
    case PH_R7_IN: big_gemm(smem, p.H, p.W, 4352, 2048, F_R7In{p.ACT}); break;
    case PH_R7_SHIFT: ph_r7_shift(p); break;
    case PH_R7_UP: gemm_phase<G_R7Up>(p, c, smem); break;
    case PH_R7_SCAN: ph_r7_scan(p, c.j, smem); break;
    case PH_R7_FIN: ph_r7_fin(p, c.j); break;
    case PH_R7_OUT: big_gemm(smem, (const bfr*)(p.ACT + A_Y), p.W + WR_OUT, 1024, 1024, F_Resid{p.Xx, p.Xc, p.MOD + (size_t)layer * 3 * 3072, c.wc}); break;
    case PH_FINAL: ph_final(p); break;
  }
}

#define SMEM_BYTES 131072
extern __shared__ __attribute__((aligned(16))) char dyn_smem[];
#if !MEGA
__global__ void __launch_bounds__(512, 2) phase_kernel(P p, int si) {
  run_phase(p, p.sched[si * 3], p.sched[si * 3 + 1], p.sched[si * 3 + 2], dyn_smem);
}
#else
__global__ void __launch_bounds__(512, 2) mega_kernel(P p) {
  cg::grid_group grid = cg::this_grid();
  for (int si = 0; si < p.nsched; si++) {
    run_phase(p, p.sched[si * 3], p.sched[si * 3 + 1], p.sched[si * 3 + 2], dyn_smem);
    if (si + 1 < p.nsched) grid.sync();
  }
}
#endif

extern "C" void kernel_launch(void* const* d_in, const int* in_sizes, int n_in, void* d_out, int out_size, void* d_ws, size_t ws_size, hipStream_t stream) {
  P p; memset(&p, 0, sizeof(p));
  const float** f = (const float**)&p;
  for (int i = 0; i < 33; i++) f[i] = (const float*)d_in[i];
  char* ws = (char*)d_ws;
  p.Xx = (float*)d_out; p.Xc = (float*)(ws + OFF_XC); p.MOD = (float*)(ws + OFF_MOD); p.W = (bfr*)(ws + OFF_W); p.H = (bfr*)(ws + OFF_H); p.ACT = ws + OFF_ACT;
  int n = 0;
  auto add = [&](int ph, int layer, int d) { p.sched[n * 3] = ph; p.sched[n * 3 + 1] = layer; p.sched[n * 3 + 2] = d; n++; };
  add(PH_PRE, 0, 0);
  if (DUP & 4) add(PH_PRE, 0, 0);
  for (int l = 0; l < 4; l++) {
    add(PH_NORM, l, 0); if (DUP & 4) add(PH_NORM, l, 0);
    int kind = l % 3;
    const bool dg = DUP & 1, ds = DUP & 2;
    if (kind == 0) { add(PH_LRU_IN, l, 0); if (dg) add(PH_LRU_IN, l, 0); add(PH_LRU_CONV, l, 0); if (DUP & 4) add(PH_LRU_CONV, l, 0);
      for (int d = 0; d < 2; d++) { add(PH_LRU_GATE, l, d); if (dg) add(PH_LRU_GATE, l, d); add(PH_LRU_S1, l, d); if (DUP & 8) add(PH_LRU_S1, l, d); add(PH_LRU_S2, l, d); if (DUP & 16) add(PH_LRU_S2, l, d); add(PH_LRU_S3, l, d); }
      add(PH_LRU_OUT, l, 0); }
    else if (kind == 1) { add(PH_ML_IN, l, 0); if (dg) add(PH_ML_IN, l, 0); add(PH_ML_SCAN, l, 0); if (ds) add(PH_ML_SCAN, l, 0); add(PH_ML_STAT, l, 0); if (DUP & 4) add(PH_ML_STAT, l, 0); add(PH_ML_Z, l, 0); add(PH_ML_OUT, l, 0); }
    else { add(PH_R7_SHIFT, l, 0); add(PH_R7_IN, l, 0); if (dg) add(PH_R7_IN, l, 0); add(PH_R7_UP, l, 0); if (dg) add(PH_R7_UP, l, 0); add(PH_R7_SCAN, l, 0); if (ds) add(PH_R7_SCAN, l, 0); add(PH_R7_FIN, l, 0); add(PH_R7_OUT, l, 0); }
  }
  add(PH_FINAL, 0, 0);
  p.nsched = n;
  if (ws_size < WS_NEED) fprintf(stderr, "workspace too small: %zu < %llu\n", ws_size, (unsigned long long)WS_NEED);
#if MEGA
  static int grid_blocks = 0;
  if (!grid_blocks) { int dev = 0, cus = 0, per = 0; hipGetDevice(&dev); hipDeviceGetAttribute(&cus, hipDeviceAttributeMultiprocessorCount, dev);
    hipFuncSetAttribute((const void*)mega_kernel, hipFuncAttributeMaxDynamicSharedMemorySize, SMEM_BYTES);
    hipOccupancyMaxActiveBlocksPerMultiprocessor(&per, mega_kernel, 512, SMEM_BYTES); if (per > 1) per = 1; if (per < 1) per = 1; grid_blocks = cus * per; }
  void* args[] = {&p};
  hipError_t e = hipLaunchCooperativeKernel((void*)mega_kernel, dim3(grid_blocks), dim3(512), args, SMEM_BYTES, stream);
  if (e != hipSuccess) fprintf(stderr, "cooperative launch failed: %s (grid %d)\n", hipGetErrorString(e), grid_blocks);
#else
  static int once = 0; if (!once) { once = 1; hipFuncSetAttribute((const void*)phase_kernel, hipFuncAttributeMaxDynamicSharedMemorySize, SMEM_BYTES); }
  for (int si = 0; si < n; si++) phase_kernel<<<256, 512, SMEM_BYTES, stream>>>(p, si);
#endif
}
```

```cpp
#include <hip/hip_runtime.h>
#include <hip/hip_bf16.h>
#include <hip/hip_cooperative_groups.h>
#include <cstdio>
#include <cstring>
#include <type_traits>
namespace cg = cooperative_groups;

#ifndef DUP
#define DUP 0
#endif
#ifndef MEGA
#define MEGA 1
#endif

typedef unsigned short bfr;
using bf16x8 = __attribute__((ext_vector_type(8))) short;
using f32x4 = __attribute__((ext_vector_type(4))) float;

#define R_ 33280
#define BT_ 16640
#define NCH_ 260

#define OFF_XC 0ull
#define OFF_MOD 2097152ull
#define OFF_W 2244608ull
#define OFF_H 24264704ull
#define OFF_ACT 92422144ull
#define A_Z 0ull
#define A_UC 85196800ull
#define A_AB 170393600ull
#define A_U 170393600ull
#define A_HF 340787200ull
#define A_AGG 425984000ull
#define A_CAR 431308800ull
#define A_QKV 0ull
#define A_GATE 272629760ull
#define A_HS 276889600ull
#define A_RSTD 413204480ull
#define A_R7B 68157440ull
#define A_RKVZ (A_R7B + 0ull)
#define A_WM (A_R7B + 272629760ull)
#define A_AM (A_R7B + 281149440ull)
#define A_BON (A_R7B + 289669120ull)
#define A_Y (A_R7B + 293928960ull)
#define WS_NEED (OFF_ACT + 434000000ull)

#define WL_GATE (2560 * 1024)
#define WL_OUT (WL_GATE + 1310720)
#define WM_Z (4352 * 1024)
#define WM_OUT (WM_Z + 2048 * 1024)
#define WR_UP (4352 * 2048)
#define WR_OUT (WR_UP + 262144)

enum { PH_PRE = 0, PH_NORM, PH_LRU_IN, PH_LRU_CONV, PH_LRU_GATE, PH_LRU_S1, PH_LRU_S2, PH_LRU_S3, PH_LRU_OUT,
       PH_ML_IN, PH_ML_SCAN, PH_ML_STAT, PH_ML_Z, PH_ML_OUT,
       PH_R7_IN, PH_R7_CA, PH_R7_CB, PH_R7_FIN, PH_R7_OUT, PH_FINAL, PH_R7_SHIFT };

struct P {
  const float *x, *c, *ctx, *c_ctx, *norm_g, *mod_w, *mod_b, *final_g;
  const float *lru_w_in, *lru_conv_w, *lru_conv_b, *lru_gate_w, *lru_gate_b, *lru_lam, *lru_w_out;
  const float *ml_w_in, *ml_gate_b, *ml_norm_g, *ml_w_out;
  const float *r7_mu, *r7_w_rkvz, *r7_w0, *r7_w1, *r7_w2, *r7_a0, *r7_a1, *r7_a2, *r7_k_k, *r7_k_a, *r7_r_k, *r7_ln_g, *r7_ln_b, *r7_w_out;
  float* Xx; float* Xc; float* MOD; bfr* W; bfr* H; char* ACT;
  int nsched; int pad_;
  int sched[64 * 3];
};
struct Ctx { int layer, j, d, wc; };

__device__ __forceinline__ int ltid() { int t = threadIdx.x; asm volatile("" : "+v"(t)); return t; }
__device__ __forceinline__ bfr f2b(float f) { unsigned u = __float_as_uint(f); u += 0x7fffu + ((u >> 16) & 1u); return (bfr)(u >> 16); }
__device__ __forceinline__ float b2f(bfr b) { return __uint_as_float(((unsigned)b) << 16); }
__device__ __forceinline__ unsigned pk2(float a, float b) { return (unsigned)f2b(a) | (((unsigned)f2b(b)) << 16); }
__device__ __forceinline__ float blo(unsigned u) { return __uint_as_float(u << 16); }
__device__ __forceinline__ float bhi(unsigned u) { return __uint_as_float(u & 0xffff0000u); }
__device__ __forceinline__ void store4b(bfr* dst, f32x4 v) { uint2 u; u.x = pk2(v[0], v[1]); u.y = pk2(v[2], v[3]); *(uint2*)dst = u; }
__device__ __forceinline__ float sigm(float x) { return 1.f / (1.f + __expf(-x)); }
__device__ __forceinline__ float siluf(float x) { return x * sigm(x); }
__device__ __forceinline__ float softplusf(float x) { return x > 20.f ? x : log1pf(expf(x)); }
__device__ __forceinline__ int rowmap(int d, int b, int pp) { int o = d == 0 ? pp : (pp < 256 ? 255 - pp : 16895 - pp); return b * BT_ + o; }
__device__ __forceinline__ float* xrowp(const P& p, int row, int& mi) {
  int b = row / BT_, o = row - b * BT_;
  if (o < 256) { mi = 2; return p.Xc + (size_t)(b * 256 + o) * 1024; }
  mi = b; return p.Xx + (size_t)(b * 16384 + o - 256) * 1024;
}
__device__ __forceinline__ float wsum(float v) { for (int o = 32; o; o >>= 1) v += __shfl_xor(v, o); return v; }
template <int CTRL> __device__ __forceinline__ float dppf(float x) {
  return __int_as_float(__builtin_amdgcn_update_dpp(0, __float_as_int(x), CTRL, 0xf, 0xf, true));
}
__device__ __forceinline__ float red16(float x) {
  x += dppf<0xB1>(x); x += dppf<0x4E>(x); x += dppf<0x141>(x); x += dppf<0x140>(x); return x;
}

template <class F> __device__ __forceinline__ void prep_tile(bfr* dst, int K, int tn, int tk, F get, float* sm) {
  int tid = ltid();
  for (int i = 0; i < 8; i++) { int kk = (tid >> 6) + 8 * i, nn = tid & 63; sm[kk * 65 + nn] = get(tk * 64 + kk, tn * 64 + nn); }
  __syncthreads();
  for (int i = 0; i < 8; i++) { int nn = (tid >> 6) + 8 * i, kk = tid & 63; dst[(size_t)(tn * 64 + nn) * K + tk * 64 + kk] = f2b(sm[kk * 65 + nn]); }
  __syncthreads();
}
__device__ __forceinline__ int prep_count(int layer) { int kind = layer % 3; return kind == 0 ? (640 + 320 + 320) : kind == 1 ? (1088 + 512 + 512) : (2176 + 64 + 256); }
__device__ __forceinline__ void prep_item(const P& p, int layer, int it, float* sm) {
  int kind = layer % 3, j = layer / 3;
  if (kind == 0) {
    if (it < 640) { int tn = it / 16, tk = it % 16; const float* s = p.lru_w_in + (size_t)j * 1024 * 2560;
      prep_tile(p.W, 1024, tn, tk, [=](int k, int n) { return s[(size_t)k * 2560 + n]; }, sm); return; }
    it -= 640;
    if (it < 320) { int d = it / 160, r = it % 160, tn = r / 2, tk = r % 2; const float* s = p.lru_gate_w + (size_t)(j * 2 + d) * 2 * 10 * 16384;
      prep_tile(p.W + WL_GATE + d * 655360, 128, tn, tk, [=](int k, int n) {
        int nt = n >> 7, blk = nt >> 1, sub = nt & 1, jj = n & 127, wn = jj >> 6, rr = jj & 63, g = rr >> 5, c = rr & 31;
        int kch = sub * 64 + wn * 32 + c; return s[((size_t)(g * 10 + blk) * 128 + k) * 128 + kch]; }, sm); return; }
    it -= 320;
    { int tn = it / 20, tk = it % 20; const float* s = p.lru_w_out + (size_t)j * 1280 * 1024;
      prep_tile(p.W + WL_OUT, 1280, tn, tk, [=](int k, int n) { return s[(size_t)k * 1024 + n]; }, sm); return; }
  } else if (kind == 1) {
    const float* s = p.ml_w_in + (size_t)j * 1024 * 6176;
    if (it < 1088) { int tn = it / 16, tk = it % 16;
      prep_tile(p.W, 1024, tn, tk, [=](int k, int n) {
        if (n < 4096) { float v = s[(size_t)k * 6176 + n]; return (n >= 1024 && n < 2048) ? v * 0.08838834764831845f : v; }
        if (n < 4128) return s[(size_t)k * 6176 + 6144 + (n - 4096)];
        return 0.f; }, sm); return; }
    it -= 1088;
    if (it < 512) { int tn = it / 16, tk = it % 16;
      prep_tile(p.W + WM_Z, 1024, tn, tk, [=](int k, int n) { return s[(size_t)k * 6176 + 4096 + n]; }, sm); return; }
    it -= 512;
    { int tn = it / 32, tk = it % 32; const float* so = p.ml_w_out + (size_t)j * 2048 * 1024;
      prep_tile(p.W + WM_OUT, 2048, tn, tk, [=](int k, int n) { return so[(size_t)k * 1024 + n]; }, sm); return; }
  } else {
    if (it < 2176) { int tn = it / 32, tk = it % 32;
      const float* mu = p.r7_mu + (size_t)j * 6 * 1024; const float* wr = p.r7_w_rkvz + (size_t)j * 4 * 1024 * 1024;
      const float* w1 = p.r7_w1 + (size_t)j * 2 * 1024 * 64; const float* a1 = p.r7_a1 + (size_t)j * 2 * 1024 * 64;
      prep_tile(p.W, 2048, tn, tk, [=](int k, int n) {
        int kk = k & 1023; float v, m;
        if (n < 4096) { int g = n >> 10, e = n & 1023; m = mu[g * 1024 + kk]; v = wr[((size_t)g * 1024 + kk) * 1024 + e]; }
        else if (n < 4224) { int xx = (n - 4096) >> 6, rr = (n - 4096) & 63; m = mu[4 * 1024 + kk]; v = w1[((size_t)xx * 1024 + kk) * 64 + rr]; }
        else { int xx = (n - 4224) >> 6, rr = (n - 4224) & 63; m = mu[5 * 1024 + kk]; v = a1[((size_t)xx * 1024 + kk) * 64 + rr]; }
        return (k < 1024 ? (1.f - m) : m) * v; }, sm); return; }
    it -= 2176;
    if (it < 64) { int u = it / 16, tn = it % 16; const float* s = (u < 2 ? p.r7_w2 : p.r7_a2) + (size_t)(j * 2 + (u & 1)) * 64 * 1024;
      prep_tile(p.W + WR_UP + u * 65536, 64, tn, 0, [=](int k, int n) { return s[(size_t)k * 1024 + n]; }, sm); return; }
    it -= 64;
    { int tn = it / 16, tk = it % 16; const float* s = p.r7_w_out + (size_t)j * 1024 * 1024;
      prep_tile(p.W + WR_OUT, 1024, tn, tk, [=](int k, int n) { return s[(size_t)k * 1024 + n]; }, sm); return; }
  }
}

#define LDSS 72
template <class G> __device__ __forceinline__ void gemm_tile(const P& p, const Ctx& c, int mt, int nt, char* smem) {
  const int tid = ltid(), lane = tid & 63, wid = tid >> 6, wm = wid & 3, wn = wid >> 2;
  bfr* sA = (bfr*)smem; bfr* sB = sA + 2 * 256 * LDSS;
  f32x4 acc[4][4];
  for (int a = 0; a < 4; a++) for (int b = 0; b < 4; b++) acc[a][b] = f32x4{0.f, 0.f, 0.f, 0.f};
  const int lr = tid >> 3, lc = tid & 7;
  uint4 ra[4], rb[2];
  auto gload = [&](int kt) __attribute__((always_inline)) {
#pragma unroll
    for (int i = 0; i < 4; i++) {
      const bfr* pa = G::aptr(p, c, mt * 256 + lr + 64 * i, kt, nt);
      ra[i] = pa ? *(const uint4*)(pa + lc * 8) : uint4{0u, 0u, 0u, 0u};
      if (i < 2) rb[i] = *(const uint4*)(G::bptr(p, c, nt * 128 + lr + 64 * i, kt) + lc * 8);
    }
  };
  auto sstore = [&](int buf) __attribute__((always_inline)) {
#pragma unroll
    for (int i = 0; i < 4; i++) {
      *(uint4*)(sA + (buf * 256 + lr + 64 * i) * LDSS + lc * 8) = ra[i];
      if (i < 2) *(uint4*)(sB + (buf * 128 + lr + 64 * i) * LDSS + lc * 8) = rb[i];
    }
  };
  gload(0); sstore(0); __syncthreads();
  for (int kt = 0; kt < G::KT; kt++) {
    const int buf = kt & 1;
    if (kt + 1 < G::KT) gload(kt + 1);
#pragma unroll
    for (int ks = 0; ks < 2; ks++) {
      bf16x8 af[4], bf[4];
#pragma unroll
      for (int i = 0; i < 4; i++) {
        af[i] = *(const bf16x8*)(sA + (buf * 256 + wm * 64 + i * 16 + (lane & 15)) * LDSS + ks * 32 + (lane >> 4) * 8);
        bf[i] = *(const bf16x8*)(sB + (buf * 128 + wn * 64 + i * 16 + (lane & 15)) * LDSS + ks * 32 + (lane >> 4) * 8);
      }
#pragma unroll
      for (int n = 0; n < 4; n++)
#pragma unroll
        for (int m = 0; m < 4; m++) acc[n][m] = __builtin_amdgcn_mfma_f32_16x16x32_bf16(bf[n], af[m], acc[n][m], 0, 0, 0);
    }
    if (kt + 1 < G::KT) sstore(buf ^ 1);
    __syncthreads();
  }
  G::epi(p, c, acc, mt * 256 + wm * 64, nt * 128 + wn * 64, lane);
}

__device__ __forceinline__ void epi_resid(const P& p, const Ctx& c, f32x4 (&acc)[4][4], int m0, int n0, int lane) {
#pragma unroll
  for (int mi = 0; mi < 4; mi++) {
    int row = m0 + mi * 16 + (lane & 15); int mo; float* xr = xrowp(p, row, mo);
    if (mo == 2 && !c.wc) continue;
    const float* g = p.MOD + (size_t)(c.layer * 3 + mo) * 3072 + 2048;
#pragma unroll
    for (int ni = 0; ni < 4; ni++) {
      int n = n0 + ni * 16 + (lane >> 4) * 4;
      float4 xv = *(float4*)(xr + n); float4 gg = *(const float4*)(g + n);
      xv.x += gg.x * acc[ni][mi][0]; xv.y += gg.y * acc[ni][mi][1]; xv.z += gg.z * acc[ni][mi][2]; xv.w += gg.w * acc[ni][mi][3];
      *(float4*)(xr + n) = xv;
    }
  }
}

struct G_LruIn { static constexpr int KT = 16, NT = 20;
  static __device__ __forceinline__ const bfr* aptr(const P& p, const Ctx& c, int row, int kt, int nt) { return p.H + (size_t)row * 1024 + kt * 64; }
  static __device__ __forceinline__ const bfr* bptr(const P& p, const Ctx& c, int n, int kt) { return p.W + (size_t)n * 1024 + kt * 64; }
  static __device__ __forceinline__ void epi(const P& p, const Ctx& c, f32x4 (&acc)[4][4], int m0, int n0, int lane) {
    bfr* U = (bfr*)(p.ACT + A_U); bfr* Z = (bfr*)(p.ACT + A_Z);
#pragma unroll
    for (int ni = 0; ni < 4; ni++)
#pragma unroll
      for (int mi = 0; mi < 4; mi++) {
        int row = m0 + mi * 16 + (lane & 15), n = n0 + ni * 16 + (lane >> 4) * 4;
        bfr* dst = n < 1280 ? U + (size_t)row * 1280 + n : Z + (size_t)row * 1280 + (n - 1280);
        store4b(dst, acc[ni][mi]);
      }
  } };
struct G_LruGate { static constexpr int KT = 2, NT = 20;
  static __device__ __forceinline__ const bfr* aptr(const P& p, const Ctx& c, int row, int kt, int nt) { return (const bfr*)(p.ACT + A_UC) + (size_t)row * 1280 + (nt >> 1) * 128 + kt * 64; }
  static __device__ __forceinline__ const bfr* bptr(const P& p, const Ctx& c, int n, int kt) { return p.W + WL_GATE + c.d * 655360 + (size_t)n * 128 + kt * 64; }
  static __device__ __forceinline__ void epi(const P& p, const Ctx& c, f32x4 (&acc)[4][4], int m0, int n0, int lane) {
    const bfr* UC = (const bfr*)(p.ACT + A_UC); unsigned* AB = (unsigned*)(p.ACT + A_AB);
    const float* gb = p.lru_gate_b + (size_t)(c.j * 2 + c.d) * 2 * 1280; const float* lam = p.lru_lam + (size_t)(c.j * 2 + c.d) * 1280;
    int chb = (n0 >> 6) * 32;
#pragma unroll
    for (int ni = 0; ni < 2; ni++) {
      int ch = chb + ni * 16 + (lane >> 4) * 4;
      float cl[4], br[4], bi[4];
#pragma unroll
      for (int q = 0; q < 4; q++) { cl[q] = 8.f * softplusf(-lam[ch + q]); br[q] = gb[ch + q]; bi[q] = gb[1280 + ch + q]; }
#pragma unroll
      for (int mi = 0; mi < 4; mi++) {
        int row = m0 + mi * 16 + (lane & 15);
        uint2 u = *(const uint2*)(UC + (size_t)row * 1280 + ch);
        float uc[4] = {blo(u.x), bhi(u.x), blo(u.y), bhi(u.y)};
        unsigned o[4];
#pragma unroll
        for (int q = 0; q < 4; q++) {
          float r = sigm(acc[ni][mi][q] + br[q]), ig = sigm(acc[ni + 2][mi][q] + bi[q]);
          float la = -cl[q] * r; float oma = 1.f - __expf(la); float bb = sqrtf(oma * (2.f - oma)) * ig * uc[q];
          o[q] = (((unsigned)f2b(oma)) << 16) | (unsigned)f2b(bb);
        }
        *(uint4*)(AB + (size_t)row * 1280 + ch) = uint4{o[0], o[1], o[2], o[3]};
      }
    }
  } };
struct G_LruOut { static constexpr int KT = 20, NT = 8;
  static __device__ __forceinline__ const bfr* aptr(const P& p, const Ctx& c, int row, int kt, int nt) { return (const bfr*)(p.ACT + A_Z) + (size_t)row * 1280 + kt * 64; }
  static __device__ __forceinline__ const bfr* bptr(const P& p, const Ctx& c, int n, int kt) { return p.W + WL_OUT + (size_t)n * 1280 + kt * 64; }
  static __device__ __forceinline__ void epi(const P& p, const Ctx& c, f32x4 (&acc)[4][4], int m0, int n0, int lane) { epi_resid(p, c, acc, m0, n0, lane); } };
struct G_MlIn { static constexpr int KT = 16, NT = 33;
  static __device__ __forceinline__ const bfr* aptr(const P& p, const Ctx& c, int row, int kt, int nt) { return p.H + (size_t)row * 1024 + kt * 64; }
  static __device__ __forceinline__ const bfr* bptr(const P& p, const Ctx& c, int n, int kt) { return p.W + (size_t)n * 1024 + kt * 64; }
  static __device__ __forceinline__ void epi(const P& p, const Ctx& c, f32x4 (&acc)[4][4], int m0, int n0, int lane) {
    bfr* QKV = (bfr*)(p.ACT + A_QKV); float* GT = (float*)(p.ACT + A_GATE);
#pragma unroll
    for (int ni = 0; ni < 4; ni++)
#pragma unroll
      for (int mi = 0; mi < 4; mi++) {
        int row = m0 + mi * 16 + (lane & 15), n = n0 + ni * 16 + (lane >> 4) * 4;
        if (n < 4096) store4b(QKV + (size_t)row * 4096 + n, acc[ni][mi]);
        else if (n < 4128) *(float4*)(GT + (size_t)row * 32 + (n - 4096)) = float4{acc[ni][mi][0], acc[ni][mi][1], acc[ni][mi][2], acc[ni][mi][3]};
      }
  } };
struct G_MlZ { static constexpr int KT = 16, NT = 16;
  static __device__ __forceinline__ const bfr* aptr(const P& p, const Ctx& c, int row, int kt, int nt) { return p.H + (size_t)row * 1024 + kt * 64; }
  static __device__ __forceinline__ const bfr* bptr(const P& p, const Ctx& c, int n, int kt) { return p.W + WM_Z + (size_t)n * 1024 + kt * 64; }
  static __device__ __forceinline__ void epi(const P& p, const Ctx& c, f32x4 (&acc)[4][4], int m0, int n0, int lane) {
    bfr* HS = (bfr*)(p.ACT + A_HS); const float* RS = (const float*)(p.ACT + A_RSTD); const float* ng = p.ml_norm_g + (size_t)c.j * 2048;
#pragma unroll
    for (int ni = 0; ni < 4; ni++)
#pragma unroll
      for (int mi = 0; mi < 4; mi++) {
        int row = m0 + mi * 16 + (lane & 15), n = n0 + ni * 16 + (lane >> 4) * 4;
        bfr* hp = HS + (size_t)row * 2048 + n; uint2 u = *(const uint2*)hp; float rs = RS[(size_t)row * 8 + (n >> 8)];
        float4 g4 = *(const float4*)(ng + n);
        f32x4 o;
        o[0] = blo(u.x) * rs * g4.x * siluf(acc[ni][mi][0]); o[1] = bhi(u.x) * rs * g4.y * siluf(acc[ni][mi][1]);
        o[2] = blo(u.y) * rs * g4.z * siluf(acc[ni][mi][2]); o[3] = bhi(u.y) * rs * g4.w * siluf(acc[ni][mi][3]);
        store4b(hp, o);
      }
  } };
struct G_MlOut { static constexpr int KT = 32, NT = 8;
  static __device__ __forceinline__ const bfr* aptr(const P& p, const Ctx& c, int row, int kt, int nt) { return (const bfr*)(p.ACT + A_HS) + (size_t)row * 2048 + kt * 64; }
  static __device__ __forceinline__ const bfr* bptr(const P& p, const Ctx& c, int n, int kt) { return p.W + WM_OUT + (size_t)n * 2048 + kt * 64; }
  static __device__ __forceinline__ void epi(const P& p, const Ctx& c, f32x4 (&acc)[4][4], int m0, int n0, int lane) { epi_resid(p, c, acc, m0, n0, lane); } };
struct G_R7In { static constexpr int KT = 32, NT = 34;
  static __device__ __forceinline__ const bfr* aptr(const P& p, const Ctx& c, int row, int kt, int nt) {
    if (kt < 16) return p.H + (size_t)row * 1024 + kt * 64;
    int q = (kt - 16) >> 2; int b = row / BT_, o = row - b * BT_; int nr;
    if (o < 256) { if (q < 2) { if (o < 1) return nullptr; nr = row - 1; } else { if (o >= 255) return nullptr; nr = row + 1; } }
    else { int t = o - 256, col = t & 63, gr = t >> 6;
      if (q == 0) { if (col == 0) return nullptr; nr = row - 1; }
      else if (q == 1) { if (col == 63) return nullptr; nr = row + 1; }
      else if (q == 2) { if (gr == 0) return nullptr; nr = row - 64; }
      else { if (gr == 255) return nullptr; nr = row + 64; } }
    return p.H + (size_t)nr * 1024 + (kt - 16) * 64; }
  static __device__ __forceinline__ const bfr* bptr(const P& p, const Ctx& c, int n, int kt) { return p.W + (size_t)n * 2048 + kt * 64; }
  static __device__ __forceinline__ void epi(const P& p, const Ctx& c, f32x4 (&acc)[4][4], int m0, int n0, int lane) {
    bfr* RK = (bfr*)(p.ACT + A_RKVZ); bfr* WMb = (bfr*)(p.ACT + A_WM); bfr* AMb = (bfr*)(p.ACT + A_AM);
#pragma unroll
    for (int ni = 0; ni < 4; ni++)
#pragma unroll
      for (int mi = 0; mi < 4; mi++) {
        int row = m0 + mi * 16 + (lane & 15), n = n0 + ni * 16 + (lane >> 4) * 4;
        if (n < 4096) store4b(RK + (size_t)row * 4096 + n, acc[ni][mi]);
        else if (n < 4224) { f32x4 t;
#pragma unroll
          for (int q = 0; q < 4; q++) t[q] = tanhf(acc[ni][mi][q]); store4b(WMb + (size_t)row * 128 + (n - 4096), t); }
        else store4b(AMb + (size_t)row * 128 + (n - 4224), acc[ni][mi]);
      }
  } };
struct G_R7Out { static constexpr int KT = 16, NT = 8;
  static __device__ __forceinline__ const bfr* aptr(const P& p, const Ctx& c, int row, int kt, int nt) { return p.H + (size_t)row * 1024 + kt * 64; }
  static __device__ __forceinline__ const bfr* bptr(const P& p, const Ctx& c, int n, int kt) { return p.W + WR_OUT + (size_t)n * 1024 + kt * 64; }
  static __device__ __forceinline__ void epi(const P& p, const Ctx& c, f32x4 (&acc)[4][4], int m0, int n0, int lane) { epi_resid(p, c, acc, m0, n0, lane); } };


namespace pg8 {
#define PG8_LAS __attribute__((address_space(3)))
constexpr int BM = 256, BK = 64, HALF = 128, HTB = HALF * BK * 2, NXCD = 8, WGM = 8;
__device__ __forceinline__ int lds_byte(int r, int c) { const int st = (r >> 4) * 2 + (c >> 5), rr = r & 15, cc = c & 31, ob = rr * 64 + cc * 2; return st * 1024 + (ob ^ (((ob >> 9) & 1) << 5)); }
__device__ __forceinline__ void stage_rc(int b, int& R, int& C) { const int st = b / 1024, sb = b % 1024, swz = sb ^ (((sb >> 9) & 1) << 5); R = (st >> 1) * 16 + swz / 64; C = (st & 1) * 32 + (swz % 64) / 2; }
struct Unit { int pm, pn; };
struct Gemm { const bfr* A; const bfr* Bt; int M, N, K; };
struct StaticOrder {
  int nM, nN, nwg, G, c;
  __device__ void init(int M, int N, int G_, int c_) { nM = M / BM; nN = N / BM; nwg = nM * nN; G = G_; c = c_; }
  __device__ bool next(int i, Unit& u) const {
    const long L = (long)i * G + c; if (L >= nwg) return false;
    int wgid = (int)L; { const int q = nwg / NXCD, r = nwg % NXCD, xcd = wgid % NXCD, off = wgid / NXCD; wgid = (xcd < r ? xcd * (q + 1) : r * (q + 1) + (xcd - r) * q) + off; }
    const int nig = WGM * nN, gid = wgid / nig, fm = gid * WGM, gsz = (nM - fm) < WGM ? (nM - fm) : WGM;
    u.pm = fm + ((wgid % nig) % gsz); u.pn = (wgid % nig) / gsz; return true;
  }
};
template <class Epi>
__device__ __forceinline__ void gemm_phase(PG8_LAS unsigned char* lds, const Gemm g, const StaticOrder& S, const Epi& E) {
  const int tid = ltid(), wid = __builtin_amdgcn_readfirstlane(tid >> 6), lane = tid & 63, wr = wid >> 2, wc = wid & 3, fr = lane & 15, fq = lane >> 4;
  const int K = g.K, nt = K / BK;
  unsigned voffA[2], voffB[2];
#pragma unroll
  for (int i = 0; i < 2; ++i) { int R, C; stage_rc(tid * 16 + i * 8192, R, C); voffA[i] = (unsigned)(R * K + C) * 2u; voffB[i] = voffA[i]; }
  const size_t kstep = (size_t)(BK * 2);
  const size_t hstep = (size_t)HALF * K * 2;
  const size_t tstep = 2 * hstep;
  const unsigned ldsw = (unsigned)wid * 1024u;
  const int aoff = lds_byte(wr * 64 + fr, fq * 8), boff = lds_byte(wc * 32 + fr, fq * 8);
#define PG8_SA(b, h) (((b) * 2 + (h)) * HTB)
#define PG8_SB(b, h) ((4 + (b) * 2 + (h)) * HTB)
#define PG8_STAGE(bufoff, gbase, voff) do { _Pragma("unroll") for (int _i = 0; _i < 2; ++_i) \
    __builtin_amdgcn_global_load_lds((const unsigned*)((const char*)(gbase) + (voff)[_i]), (PG8_LAS unsigned*)(lds + (bufoff) + ldsw + _i * 8192), 16, 0, 0); } while (0)
#define PG8_LDA(dst, b, h) do { _Pragma("unroll") for (int m = 0; m < 4; ++m) _Pragma("unroll") for (int k = 0; k < 2; ++k) dst[m][k] = *(const PG8_LAS bf16x8*)(lds + PG8_SA(b, h) + aoff + m * 2048 + k * 1024); } while (0)
#define PG8_LDB(dst, b, h) do { _Pragma("unroll") for (int n = 0; n < 2; ++n) _Pragma("unroll") for (int k = 0; k < 2; ++k) dst[n][k] = *(const PG8_LAS bf16x8*)(lds + PG8_SB(b, h) + boff + n * 2048 + k * 1024); } while (0)
#define PG8_MMA(ai, bj, At, Bt) do { __builtin_amdgcn_s_setprio(1); _Pragma("unroll") for (int m = 0; m < 4; ++m) _Pragma("unroll") for (int n = 0; n < 2; ++n) _Pragma("unroll") for (int k = 0; k < 2; ++k) \
    acc[ai][bj][m][n] = __builtin_amdgcn_mfma_f32_16x16x32_bf16(Bt[n][k], At[m][k], acc[ai][bj][m][n], 0, 0, 0); __builtin_amdgcn_s_setprio(0); } while (0)
#define PG8_WAIT_V(n) asm volatile("s_waitcnt vmcnt(" #n ")" ::: "memory")
#define PG8_WAIT_L(n) asm volatile("s_waitcnt lgkmcnt(" #n ")" ::: "memory")
#define PG8_BAR __builtin_amdgcn_s_barrier()
#define PG8_SCHED __builtin_amdgcn_sched_barrier(0)
  Unit cur, nxt; int ui = 0;
  if (!S.next(0, cur)) return;
  f32x4 acc[2][2][4][2];
#pragma unroll
  for (int a = 0; a < 2; ++a)
#pragma unroll
    for (int b = 0; b < 2; ++b)
#pragma unroll
      for (int m = 0; m < 4; ++m)
#pragma unroll
        for (int n = 0; n < 2; ++n) acc[a][b][m][n] = (f32x4){0.f, 0.f, 0.f, 0.f};
  bf16x8 At[4][2], B0[2][2], B1[2][2];
  const char* cA = (const char*)g.A + (size_t)cur.pm * tstep; const char* cB = (const char*)g.Bt + (size_t)cur.pn * tstep;
  PG8_STAGE(PG8_SB(0, 0), cB, voffB); PG8_STAGE(PG8_SA(0, 0), cA, voffA); PG8_STAGE(PG8_SB(0, 1), cB + hstep, voffB); PG8_STAGE(PG8_SA(0, 1), cA + hstep, voffA);
  if (wr == 1) PG8_BAR;
  PG8_WAIT_V(4); PG8_BAR;
  PG8_STAGE(PG8_SB(1, 0), cB + kstep, voffB); PG8_STAGE(PG8_SA(1, 0), cA + kstep, voffA); PG8_STAGE(PG8_SB(1, 1), cB + hstep + kstep, voffB);
  PG8_WAIT_V(6); PG8_BAR;
  for (;;) {
    const bool has_next = S.next(ui + 1, nxt);
    const char* nA = has_next ? (const char*)g.A + (size_t)nxt.pm * tstep : cA; const char* nB = has_next ? (const char*)g.Bt + (size_t)nxt.pn * tstep : cB;
    for (int t = 0; t < nt; t += 2) {
      const bool last = (t == nt - 2);
      const char* a1 = cA + (size_t)(t + 1) * kstep;
      const char* a2 = last ? nA : cA + (size_t)(t + 2) * kstep; const char* b2 = last ? nB : cB + (size_t)(t + 2) * kstep;
      const char* a3 = a2 + kstep; const char* b3 = b2 + kstep;
      PG8_LDB(B0, 0, 0); PG8_SCHED; PG8_LDA(At, 0, 0); PG8_STAGE(PG8_SA(1, 1), a1 + hstep, voffA);
      PG8_WAIT_L(8); PG8_BAR; PG8_WAIT_L(0); PG8_MMA(0, 0, At, B0); PG8_BAR; PG8_SCHED;
      PG8_LDB(B1, 0, 1); PG8_STAGE(PG8_SB(0, 0), b2, voffB);
      PG8_BAR; PG8_WAIT_L(0); PG8_MMA(0, 1, At, B1); PG8_BAR;
      PG8_LDA(At, 0, 1); PG8_STAGE(PG8_SA(0, 0), a2, voffA);
      PG8_BAR; PG8_WAIT_L(0); PG8_MMA(1, 0, At, B0); PG8_BAR; PG8_SCHED;
      PG8_STAGE(PG8_SB(0, 1), b2 + hstep, voffB);
      PG8_WAIT_V(6); PG8_BAR; PG8_MMA(1, 1, At, B1); PG8_BAR;
      PG8_LDB(B0, 1, 0); PG8_SCHED; PG8_LDA(At, 1, 0); PG8_STAGE(PG8_SA(0, 1), a2 + hstep, voffA);
      PG8_WAIT_L(8); PG8_BAR; PG8_WAIT_L(0); PG8_MMA(0, 0, At, B0); PG8_BAR; PG8_SCHED;
      PG8_LDB(B1, 1, 1); PG8_STAGE(PG8_SB(1, 0), b3, voffB);
      PG8_BAR; PG8_WAIT_L(0); PG8_MMA(0, 1, At, B1); PG8_BAR;
      PG8_LDA(At, 1, 1); PG8_STAGE(PG8_SA(1, 0), a3, voffA);
      PG8_BAR; PG8_WAIT_L(0); PG8_MMA(1, 0, At, B0); PG8_BAR; PG8_SCHED;
      PG8_STAGE(PG8_SB(1, 1), b3 + hstep, voffB);
      PG8_WAIT_V(6); PG8_BAR; PG8_MMA(1, 1, At, B1); PG8_BAR;
    }
    E(acc, cur, wr, wc, fr, fq);
    if (!has_next) break;
#pragma unroll
    for (int a = 0; a < 2; ++a)
#pragma unroll
      for (int b = 0; b < 2; ++b)
#pragma unroll
        for (int m = 0; m < 4; ++m)
#pragma unroll
          for (int n = 0; n < 2; ++n) acc[a][b][m][n] = (f32x4){0.f, 0.f, 0.f, 0.f};
    cur = nxt; cA = nA; cB = nB; ++ui;
  }
  PG8_WAIT_V(0);
  if (wr == 0) PG8_BAR;
  PG8_BAR;
#undef PG8_SA
#undef PG8_SB
#undef PG8_STAGE
#undef PG8_LDA
#undef PG8_LDB
#undef PG8_MMA
#undef PG8_WAIT_V
#undef PG8_WAIT_L
#undef PG8_BAR
#undef PG8_SCHED
}
}

template <class F> struct EpiAd {
  F f;
  __device__ __forceinline__ void operator()(const f32x4 (&acc)[2][2][4][2], const pg8::Unit& u, int wr, int wc, int fr, int fq) const {
#pragma unroll
    for (int ai = 0; ai < 2; ++ai)
#pragma unroll
      for (int m = 0; m < 4; ++m) { const int row = u.pm * 256 + ai * 128 + wr * 64 + m * 16 + fr;
#pragma unroll
        for (int bj = 0; bj < 2; ++bj)
#pragma unroll
          for (int n = 0; n < 2; ++n) f(row, u.pn * 256 + bj * 128 + wc * 32 + n * 16 + 4 * fq, acc[ai][bj][m][n]); }
  }
};
template <class F> __device__ __forceinline__ void big_gemm(char* smem, const bfr* A, const bfr* Bt, int N, int K, F f) {
  pg8::Gemm g; g.A = A; g.Bt = Bt; g.M = R_; g.N = N; g.K = K;
  pg8::StaticOrder S; S.init(R_, N, (int)gridDim.x, (int)blockIdx.x);
  EpiAd<F> E{f};
  pg8::gemm_phase(( __attribute__((address_space(3))) unsigned char*)smem, g, S, E);
}
struct F_LruIn { char* ACT; __device__ __forceinline__ void operator()(int row, int n, f32x4 v) const {
  bfr* dst = n < 1280 ? (bfr*)(ACT + A_U) + (size_t)row * 1280 + n : (bfr*)(ACT + A_Z) + (size_t)row * 1280 + (n - 1280); store4b(dst, v); } };
struct F_Resid { float* Xx; float* Xc; const float* MODg; int wc; __device__ __forceinline__ void operator()(int row, int n, f32x4 v) const {
  int b = row / BT_, o = row - b * BT_; bool isc = o < 256; if (isc && !wc) return;
  float* xr = isc ? Xc + (size_t)(b * 256 + o) * 1024 : Xx + (size_t)(b * 16384 + o - 256) * 1024; const float* g = MODg + (size_t)(isc ? 2 : b) * 3072 + 2048;
  float4 xv = *(float4*)(xr + n); float4 gg = *(const float4*)(g + n);
  xv.x += gg.x * v[0]; xv.y += gg.y * v[1]; xv.z += gg.z * v[2]; xv.w += gg.w * v[3]; *(float4*)(xr + n) = xv; } };
struct F_MlIn { char* ACT; __device__ __forceinline__ void operator()(int row, int n, f32x4 v) const {
  if (n < 4096) store4b((bfr*)(ACT + A_QKV) + (size_t)row * 4096 + n, v);
  else if (n < 4128) *(float4*)((float*)(ACT + A_GATE) + (size_t)row * 32 + (n - 4096)) = float4{v[0], v[1], v[2], v[3]}; } };
struct F_MlZ { char* ACT; const float* ng; __device__ __forceinline__ void operator()(int row, int n, f32x4 v) const {
  bfr* hp = (bfr*)(ACT + A_HS) + (size_t)row * 2048 + n; uint2 u = *(const uint2*)hp; float rs = ((const float*)(ACT + A_RSTD))[(size_t)row * 8 + (n >> 8)];
  float4 g4 = *(const float4*)(ng + n); f32x4 o;
  o[0] = blo(u.x) * rs * g4.x * siluf(v[0]); o[1] = bhi(u.x) * rs * g4.y * siluf(v[1]); o[2] = blo(u.y) * rs * g4.z * siluf(v[2]); o[3] = bhi(u.y) * rs * g4.w * siluf(v[3]);
  store4b(hp, o); } };
struct F_R7In { char* ACT; __device__ __forceinline__ void operator()(int row, int n, f32x4 v) const {
  if (n < 4096) store4b((bfr*)(ACT + A_RKVZ) + (size_t)row * 4096 + n, v);
  else if (n < 4224) { f32x4 t;
#pragma unroll
    for (int q = 0; q < 4; q++) t[q] = tanhf(v[q]);
    store4b((bfr*)(ACT + A_WM) + (size_t)row * 128 + (n - 4096), t); }
  else store4b((bfr*)(ACT + A_AM) + (size_t)row * 128 + (n - 4224), v); } };

template <class G> __device__ __forceinline__ void gemm_phase(const P& p, const Ctx& c, char* smem) {
  const int total = 130 * G::NT;
  for (int it = blockIdx.x; it < total; it += gridDim.x) gemm_tile<G>(p, c, it / G::NT, it % G::NT, smem);
}

__device__ __forceinline__ void ph_pre(const P& p, char* smem) {
  float* sm = (float*)smem; const int tid = ltid();
  const int nprep = prep_count(0), ngemv = 192, ncopy = 4160;
  for (int it = blockIdx.x; it < nprep + ngemv + ncopy; it += gridDim.x) {
    if (it < nprep) { prep_item(p, 0, it, sm); continue; }
    int i2 = it - nprep;
    if (i2 < ngemv) {
      int l = i2 / 48, cgp = i2 % 48;
      for (int i = tid; i < 3072; i += 512) { int cnd = i >> 10, k = i & 1023; float v = cnd == 0 ? p.c[k] : cnd == 1 ? p.c[1024 + k] : p.c_ctx[k]; sm[i] = siluf(v); }
      __syncthreads();
      int kq = tid >> 6, col = cgp * 64 + (tid & 63); const float* w = p.mod_w + (size_t)l * 1024 * 3072 + col;
      float a0 = 0.f, a1 = 0.f, a2 = 0.f;
      for (int k = kq * 128; k < kq * 128 + 128; k++) { float wv = w[(size_t)k * 3072]; a0 += sm[k] * wv; a1 += sm[1024 + k] * wv; a2 += sm[2048 + k] * wv; }
      float* red = sm + 3072; red[tid * 3] = a0; red[tid * 3 + 1] = a1; red[tid * 3 + 2] = a2;
      __syncthreads();
      if (tid < 64) { float bias = p.mod_b[(size_t)l * 3072 + col];
        for (int cnd = 0; cnd < 3; cnd++) { float s = bias; for (int q = 0; q < 8; q++) s += red[(q * 64 + tid) * 3 + cnd]; p.MOD[(size_t)(l * 3 + cnd) * 3072 + col] = s; } }
      __syncthreads();
      continue;
    }
    i2 -= ngemv;
    for (int q = 0; q < 4; q++) { int idx = i2 * 2048 + q * 512 + tid; int row = idx >> 8, c4 = idx & 255; int b = row / BT_, o = row - b * BT_;
      if (o < 256) ((float4*)p.Xc)[(size_t)(b * 256 + o) * 256 + c4] = ((const float4*)p.ctx)[(size_t)(b * 256 + o) * 256 + c4];
      else ((float4*)p.Xx)[(size_t)(b * 16384 + o - 256) * 256 + c4] = ((const float4*)p.x)[(size_t)(b * 16384 + o - 256) * 256 + c4]; }
  }
}
__device__ __forceinline__ void ph_norm(const P& p, int layer, char* smem) {
  const int tid = ltid(), lane = tid & 63, wid = tid >> 6;
  const int nprep = layer > 0 ? prep_count(layer) : 0; const int kind = layer % 3;
  const int nzero = kind == 1 ? 8320 : 0;
  (void)nzero;
  for (int it = blockIdx.x; it < nprep + 4160; it += gridDim.x) {
    if (it < nprep) { prep_item(p, layer, it, (float*)smem); continue; }
    int row = (it - nprep) * 8 + wid; int mo; const float* xr = xrowp(p, row, mo);
    float4 v[4]; float ss = 0.f;
#pragma unroll
    for (int i = 0; i < 4; i++) { v[i] = *(const float4*)(xr + lane * 4 + 256 * i); ss += v[i].x * v[i].x + v[i].y * v[i].y + v[i].z * v[i].z + v[i].w * v[i].w; }
    ss = wsum(ss); float rs = rsqrtf(ss * (1.f / 1024.f) + 1e-6f);
    const float* g = p.norm_g + (size_t)layer * 1024; const float* md = p.MOD + (size_t)(layer * 3 + mo) * 3072;
#pragma unroll
    for (int i = 0; i < 4; i++) { int cidx = lane * 4 + 256 * i; float4 gg = *(const float4*)(g + cidx), sh = *(const float4*)(md + cidx), sc = *(const float4*)(md + 1024 + cidx);
      f32x4 o; o[0] = v[i].x * rs * gg.x * (1.f + sc.x) + sh.x; o[1] = v[i].y * rs * gg.y * (1.f + sc.y) + sh.y; o[2] = v[i].z * rs * gg.z * (1.f + sc.z) + sh.z; o[3] = v[i].w * rs * gg.w * (1.f + sc.w) + sh.w;
      store4b(p.H + (size_t)row * (kind == 2 ? 2048 : 1024) + cidx, o); }
  }
}
__device__ __forceinline__ void ph_r7_shift(const P& p) {
  for (int it = blockIdx.x; it < 8320; it += gridDim.x) {
    int idx = it * 512 + ltid(); int row = idx >> 7, c8 = idx & 127, q = c8 >> 5;
    int b = row / BT_, o = row - b * BT_; int nr = -1;
    if (o < 256) { if (q < 2) { if (o >= 1) nr = row - 1; } else { if (o < 255) nr = row + 1; } }
    else { int t = o - 256, col = t & 63, gr = t >> 6;
      if (q == 0) { if (col != 0) nr = row - 1; } else if (q == 1) { if (col != 63) nr = row + 1; }
      else if (q == 2) { if (gr != 0) nr = row - 64; } else { if (gr != 255) nr = row + 64; } }
    uint4 v = nr >= 0 ? *(const uint4*)(p.H + (size_t)nr * 2048 + c8 * 8) : uint4{0u, 0u, 0u, 0u};
    *(uint4*)(p.H + (size_t)row * 2048 + 1024 + c8 * 8) = v;
  }
}
__device__ __forceinline__ void ph_final(const P& p) {
  const int lane = ltid() & 63, wid = ltid() >> 6;
  for (int it = blockIdx.x; it < 4096; it += gridDim.x) {
    float* xr = p.Xx + (size_t)(it * 8 + wid) * 1024; float4 v[4]; float ss = 0.f;
#pragma unroll
    for (int i = 0; i < 4; i++) { v[i] = *(const float4*)(xr + lane * 4 + 256 * i); ss += v[i].x * v[i].x + v[i].y * v[i].y + v[i].z * v[i].z + v[i].w * v[i].w; }
    ss = wsum(ss); float rs = rsqrtf(ss * (1.f / 1024.f) + 1e-6f);
#pragma unroll
    for (int i = 0; i < 4; i++) { int cidx = lane * 4 + 256 * i; float4 gg = *(const float4*)(p.final_g + cidx);
      *(float4*)(xr + cidx) = float4{v[i].x * rs * gg.x, v[i].y * rs * gg.y, v[i].z * rs * gg.z, v[i].w * rs * gg.w}; }
  }
}
__device__ __forceinline__ void ph_lru_conv(const P& p, int j) {
  const bfr* U = (const bfr*)(p.ACT + A_U); bfr* UC = (bfr*)(p.ACT + A_UC);
  const float* cw = p.lru_conv_w + (size_t)j * 4 * 1280; const float* cb = p.lru_conv_b + (size_t)j * 1280;
  for (int it = blockIdx.x; it < 10400; it += gridDim.x) {
    int idx = it * 512 + ltid(); int row = idx / 160, cgp = idx % 160, ch = cgp * 8;
    int b = row / BT_, o = row - b * BT_; int s0 = o < 256 ? 0 : 256, e0 = o < 256 ? 256 : BT_;
    float acc[8];
#pragma unroll
    for (int e = 0; e < 8; e++) acc[e] = cb[ch + e];
#pragma unroll
    for (int t = 0; t < 4; t++) { int oo = o + t - 2; if (oo < s0 || oo >= e0) continue;
      uint4 u = *(const uint4*)(U + (size_t)(row + t - 2) * 1280 + ch); const float* w = cw + t * 1280 + ch;
      acc[0] += w[0] * blo(u.x); acc[1] += w[1] * bhi(u.x); acc[2] += w[2] * blo(u.y); acc[3] += w[3] * bhi(u.y);
      acc[4] += w[4] * blo(u.z); acc[5] += w[5] * bhi(u.z); acc[6] += w[6] * blo(u.w); acc[7] += w[7] * bhi(u.w); }
    *(uint4*)(UC + (size_t)row * 1280 + ch) = uint4{pk2(acc[0], acc[1]), pk2(acc[2], acc[3]), pk2(acc[4], acc[5]), pk2(acc[6], acc[7])};
  }
}
__device__ __forceinline__ void ph_lru_s1(const P& p, int d) {
  const unsigned* AB = (const unsigned*)(p.ACT + A_AB); float2* AGG = (float2*)(p.ACT + A_AGG);
  const int t = ltid();
  for (int it = blockIdx.x * 8 + (t >> 6); it < 2600; it += gridDim.x * 8) {
    int b = it / 1300, r = it % 1300, cc = r / 5, ch = (r % 5) * 256 + (t & 63) * 4;
    float P0 = 1.f, Q0 = 0.f, P1 = 1.f, Q1 = 0.f, P2 = 1.f, Q2 = 0.f, P3 = 1.f, Q3 = 0.f;
#pragma unroll 8
    for (int q = 0; q < 64; q++) { uint4 u = *(const uint4*)(AB + (size_t)rowmap(d, b, cc * 64 + q) * 1280 + ch);
      float a0 = 1.f - bhi(u.x), a1 = 1.f - bhi(u.y), a2 = 1.f - bhi(u.z), a3 = 1.f - bhi(u.w);
      P0 *= a0; Q0 = a0 * Q0 + blo(u.x); P1 *= a1; Q1 = a1 * Q1 + blo(u.y); P2 *= a2; Q2 = a2 * Q2 + blo(u.z); P3 *= a3; Q3 = a3 * Q3 + blo(u.w); }
    float4* ag = (float4*)(AGG + (size_t)(b * NCH_ + cc) * 1280 + ch); ag[0] = float4{P0, Q0, P1, Q1}; ag[1] = float4{P2, Q2, P3, Q3};
  }
}
__device__ __forceinline__ void ph_lru_s2(const P& p) {
  const float2* AGG = (const float2*)(p.ACT + A_AGG); float* CAR = (float*)(p.ACT + A_CAR);
  for (int it = blockIdx.x; it < 5; it += gridDim.x) {
    int idx = it * 512 + ltid(), b = idx / 1280, ch = idx % 1280; float h = 0.f;
#pragma unroll 20
    for (int cc = 0; cc < NCH_; cc++) { size_t o = (size_t)(b * NCH_ + cc) * 1280 + ch; float2 a = AGG[o]; CAR[o] = h; h = a.x * h + a.y; }
  }
}
__device__ __forceinline__ void ph_lru_s3(const P& p, int d) {
  const unsigned* AB = (const unsigned*)(p.ACT + A_AB); const float* CAR = (const float*)(p.ACT + A_CAR);
  bfr* HF = (bfr*)(p.ACT + A_HF); bfr* Z = (bfr*)(p.ACT + A_Z);
  const int t = ltid();
  for (int it = blockIdx.x * 8 + (t >> 6); it < 2600; it += gridDim.x * 8) {
    int b = it / 1300, r = it % 1300, cc = r / 5, ch = (r % 5) * 256 + (t & 63) * 4;
    float4 h = *(const float4*)(CAR + (size_t)(b * NCH_ + cc) * 1280 + ch);
#pragma unroll 8
    for (int q = 0; q < 64; q++) { size_t o = (size_t)rowmap(d, b, cc * 64 + q) * 1280 + ch; uint4 u = *(const uint4*)(AB + o);
      h.x = (1.f - bhi(u.x)) * h.x + blo(u.x); h.y = (1.f - bhi(u.y)) * h.y + blo(u.y); h.z = (1.f - bhi(u.z)) * h.z + blo(u.z); h.w = (1.f - bhi(u.w)) * h.w + blo(u.w);
      if (d == 0) *(uint2*)(HF + o) = uint2{pk2(h.x, h.y), pk2(h.z, h.w)};
      else { uint2 hf = *(const uint2*)(HF + o), zz = *(const uint2*)(Z + o);
        *(uint2*)(Z + o) = uint2{pk2((blo(hf.x) + h.x) * siluf(blo(zz.x)), (bhi(hf.x) + h.y) * siluf(bhi(zz.x))), pk2((blo(hf.y) + h.z) * siluf(blo(zz.y)), (bhi(hf.y) + h.w) * siluf(bhi(zz.y)))}; } }
  }
}
__device__ __forceinline__ void ph_ml_stat(const P& p) {
  const bfr* HS = (const bfr*)(p.ACT + A_HS); float* RS = (float*)(p.ACT + A_RSTD);
  const int lane = ltid() & 63, wid = ltid() >> 6;
  for (int it = blockIdx.x; it < 4160; it += gridDim.x) {
    int row = it * 8 + wid; const bfr* hp = HS + (size_t)row * 2048 + lane * 32; float ss = 0.f;
#pragma unroll
    for (int i = 0; i < 4; i++) { uint4 u = *(const uint4*)(hp + i * 8); float a;
      a = blo(u.x); ss += a * a; a = bhi(u.x); ss += a * a; a = blo(u.y); ss += a * a; a = bhi(u.y); ss += a * a;
      a = blo(u.z); ss += a * a; a = bhi(u.z); ss += a * a; a = blo(u.w); ss += a * a; a = bhi(u.w); ss += a * a; }
    ss += __shfl_xor(ss, 1); ss += __shfl_xor(ss, 2); ss += __shfl_xor(ss, 4);
    if ((lane & 7) == 0) RS[(size_t)row * 8 + (lane >> 3)] = rsqrtf(ss * (1.f / 256.f) + 1e-6f);
  }
}
__device__ __forceinline__ void ph_r7_fin(const P& p, int j) {
  bfr* Y = (bfr*)(p.ACT + A_Y); const bfr* RK = (const bfr*)(p.ACT + A_RKVZ); const float* BON = (const float*)(p.ACT + A_BON);
  const float* lg = p.r7_ln_g + (size_t)j * 1024; const float* lb = p.r7_ln_b + (size_t)j * 1024;
  const int lane = ltid() & 63, wid = ltid() >> 6;
  for (int it = blockIdx.x; it < 4160; it += gridDim.x) {
    int row = it * 8 + wid, ch = lane * 16, hd = lane >> 2;
    float y[16], v[16], z[16];
#pragma unroll
    for (int i = 0; i < 2; i++) {
      uint4 u = *(const uint4*)(Y + (size_t)row * 1024 + ch + i * 8);
      y[i * 8 + 0] = blo(u.x); y[i * 8 + 1] = bhi(u.x); y[i * 8 + 2] = blo(u.y); y[i * 8 + 3] = bhi(u.y); y[i * 8 + 4] = blo(u.z); y[i * 8 + 5] = bhi(u.z); y[i * 8 + 6] = blo(u.w); y[i * 8 + 7] = bhi(u.w);
      u = *(const uint4*)(RK + (size_t)row * 4096 + 2048 + ch + i * 8);
      v[i * 8 + 0] = blo(u.x); v[i * 8 + 1] = bhi(u.x); v[i * 8 + 2] = blo(u.y); v[i * 8 + 3] = bhi(u.y); v[i * 8 + 4] = blo(u.z); v[i * 8 + 5] = bhi(u.z); v[i * 8 + 6] = blo(u.w); v[i * 8 + 7] = bhi(u.w);
      u = *(const uint4*)(RK + (size_t)row * 4096 + 3072 + ch + i * 8);
      z[i * 8 + 0] = blo(u.x); z[i * 8 + 1] = bhi(u.x); z[i * 8 + 2] = blo(u.y); z[i * 8 + 3] = bhi(u.y); z[i * 8 + 4] = blo(u.z); z[i * 8 + 5] = bhi(u.z); z[i * 8 + 6] = blo(u.w); z[i * 8 + 7] = bhi(u.w);
    }
    float s = 0.f;
#pragma unroll
    for (int e = 0; e < 16; e++) s += y[e];
    s += __shfl_xor(s, 1); s += __shfl_xor(s, 2); float mean = s * (1.f / 64.f);
    float q = 0.f;
#pragma unroll
    for (int e = 0; e < 16; e++) { float dlt = y[e] - mean; q += dlt * dlt; }
    q += __shfl_xor(q, 1); q += __shfl_xor(q, 2); float rs = rsqrtf(q * (1.f / 64.f) + 64e-5f);
    float bon = BON[(size_t)row * 16 + hd] + BON[(size_t)(R_ + row) * 16 + hd];
    float o[16];
#pragma unroll
    for (int e = 0; e < 16; e++) { float yn = (y[e] - mean) * rs * lg[ch + e] + lb[ch + e]; o[e] = (yn + bon * v[e]) * siluf(z[e]); }
#pragma unroll
    for (int i = 0; i < 2; i++)
      *(uint4*)(Y + (size_t)row * 1024 + ch + i * 8) = uint4{pk2(o[i * 8], o[i * 8 + 1]), pk2(o[i * 8 + 2], o[i * 8 + 3]), pk2(o[i * 8 + 4], o[i * 8 + 5]), pk2(o[i * 8 + 6], o[i * 8 + 7])};
  }
}

#define QS 136
#define VS 72
#define MLG_BYTES 45056
__device__ __forceinline__ void ph_ml_scan(const P& p, int j, char* smem0) {
  const int d = ltid() >> 8;
  char* smem = smem0 + d * MLG_BYTES;
  bfr* sQ = (bfr*)smem; bfr* sK = sQ + 64 * QS; bfr* sVT = sK + 64 * QS; bfr* sCT = sVT + 16 * VS;
  float* sN = (float*)(sCT + 16 * QS);
  float* sEs = sN + 128; float* sCt = sEs + 64; float* sBc = sCt + 64; float* sWg = sBc + 64; float* sNr = sWg + 64;
  const bfr* QKV = (const bfr*)(p.ACT + A_QKV); const float* GT = (const float*)(p.ACT + A_GATE); bfr* HS = (bfr*)(p.ACT + A_HS);
  const float* gbias = p.ml_gate_b + (size_t)j * 32;
  const int tid = ltid() & 255, lane = tid & 63, w = tid >> 6, l15 = lane & 15, q4 = lane >> 4;
  for (int it = blockIdx.x; it < 256; it += gridDim.x) {
    const int b = it >> 7, hh = (it >> 4) & 7, sl = it & 15;
    f32x4 Cacc[2];
    Cacc[0] = f32x4{0.f, 0.f, 0.f, 0.f}; Cacc[1] = f32x4{0.f, 0.f, 0.f, 0.f};
    float mcur = 0.f;
    for (int i = tid; i < 16 * QS; i += 256) sCT[i] = 0;
    if (tid < 128) sN[tid] = 0.f;
    uint4 pq0, pq1, pq2, pq3, pk0, pk1, pk2, pk3, pv = uint4{0u, 0u, 0u, 0u}; float pgi, pgf;
#define ML_ROW0(s_) (d == 0 ? b * BT_ + 64 * (s_) : rowmap(1, b, 64 * (s_) + 63))
#define ML_LD(i_, PQ, PK) { int idx = tid + 256 * (i_), rho = idx >> 4, c8 = idx & 15; const bfr* src = QKV + (size_t)(r0n + rho) * 4096 + hh * 128 + c8 * 8; PQ = *(const uint4*)src; PK = *(const uint4*)(src + 1024); }
#define ML_ISSUE(s_) { const int r0n = ML_ROW0(s_); ML_LD(0, pq0, pk0) ML_LD(1, pq1, pk1) ML_LD(2, pq2, pk2) ML_LD(3, pq3, pk3) \
      if (tid < 128) pv = *(const uint4*)(QKV + (size_t)(r0n + (tid >> 1)) * 4096 + 2048 + hh * 256 + sl * 16 + (tid & 1) * 8); \
      { const float* gp_ = GT + (size_t)(r0n + (d ? 63 - lane : lane)) * 32 + d * 16 + hh; pgi = gp_[0]; pgf = gp_[8]; } }
#define ML_ST(i_, PQ, PK) { int idx = tid + 256 * (i_), rho = idx >> 4, c8 = idx & 15; *(uint4*)(sQ + rho * QS + c8 * 8) = PQ; *(uint4*)(sK + rho * QS + c8 * 8) = PK; }
#define ML_COMMIT() { ML_ST(0, pq0, pk0) ML_ST(1, pq1, pk1) ML_ST(2, pq2, pk2) ML_ST(3, pq3, pk3) \
      if (tid < 128) { int rho = tid >> 1, vb = (tid & 1) * 8; \
        sVT[(vb + 0) * VS + rho] = (bfr)(pv.x & 0xffff); sVT[(vb + 1) * VS + rho] = (bfr)(pv.x >> 16); \
        sVT[(vb + 2) * VS + rho] = (bfr)(pv.y & 0xffff); sVT[(vb + 3) * VS + rho] = (bfr)(pv.y >> 16); \
        sVT[(vb + 4) * VS + rho] = (bfr)(pv.z & 0xffff); sVT[(vb + 5) * VS + rho] = (bfr)(pv.z >> 16); \
        sVT[(vb + 6) * VS + rho] = (bfr)(pv.w & 0xffff); sVT[(vb + 7) * VS + rho] = (bfr)(pv.w >> 16); } }
    ML_ISSUE(0)
    __syncthreads();
    for (int s = 0; s < NCH_; s++) {
      const int r0 = ML_ROW0(s);
      ML_COMMIT()
      float mxl, decay;
      {
        int rho = d ? 63 - lane : lane;
        float gi = pgi + gbias[(d * 2 + 0) * 8 + hh], gf = pgf + gbias[(d * 2 + 1) * 8 + hh];
        float fc = fminf(gf, 0.f) - log1pf(__expf(-fabsf(gf)));
        float bc = fc;
        for (int o = 1; o < 64; o <<= 1) { float t = __shfl_up(bc, o); if (lane >= o) bc += t; }
        float e = gi - bc, pm = e;
        for (int o = 1; o < 64; o <<= 1) { float t = __shfl_up(pm, o); if (lane >= o) pm = fmaxf(pm, t); }
        float pml = __shfl(pm, 63), bcl = __shfl(bc, 63);
        mxl = fmaxf(mcur, pml); decay = __expf(mcur - mxl);
        if (w == 0) { sEs[rho] = e; sCt[rho] = -fmaxf(mcur, pm); sBc[rho] = bc; sWg[rho] = __expf(e - mxl); }
        pml = bcl + mxl;
        bcl = mcur; mcur = pml; pml = bcl;
        mxl = pml;
      }
      const float mold = mxl;
      __syncthreads();
      const int rt = 16 * w + l15;
      bfr* hp = HS + (size_t)(r0 + rt) * 2048 + hh * 256 + sl * 16 + 4 * q4;
      bool first; { int rc = (r0 - b * BT_) >> 6; if (d == 0) { int sp = rc < 4 ? 3 - rc : 263 - rc; first = s < sp; } else first = s < rc; }
      unsigned long long uu = 0ull;
      if (!first) uu = __hip_atomic_load((unsigned long long*)hp, __ATOMIC_RELAXED, __HIP_MEMORY_SCOPE_AGENT);
      if (s + 1 < NCH_) ML_ISSUE(s + 1)
      bf16x8 qf[4];
#pragma unroll
      for (int ks = 0; ks < 4; ks++) qf[ks] = *(const bf16x8*)(sQ + (16 * w + l15) * QS + ks * 32 + q4 * 8);
      f32x4 sacc[4];
#pragma unroll
      for (int a = 0; a < 4; a++) { sacc[a] = f32x4{0.f, 0.f, 0.f, 0.f};
#pragma unroll
        for (int ks = 0; ks < 4; ks++) { bf16x8 kf = *(const bf16x8*)(sK + (16 * a + l15) * QS + ks * 32 + q4 * 8); sacc[a] = __builtin_amdgcn_mfma_f32_16x16x32_bf16(kf, qf[ks], sacc[a], 0, 0, 0); } }
      const float ctt = sCt[rt]; float densum = 0.f;
#pragma unroll
      for (int a = 0; a < 4; a++)
#pragma unroll
        for (int jj = 0; jj < 4; jj++) { int rs_ = 16 * a + 4 * q4 + jj; bool valid = d == 0 ? rs_ <= rt : rs_ >= rt;
          float wv = valid ? __expf(ctt + sEs[rs_]) : 0.f; float sv = sacc[a][jj] * wv; sacc[a][jj] = sv; densum += sv; }
      densum += __shfl_xor(densum, 16); densum += __shfl_xor(densum, 32);
      bf16x8 sf[2], vf[2];
#pragma unroll
      for (int ks = 0; ks < 2; ks++) {
#pragma unroll
        for (int jj = 0; jj < 4; jj++) { sf[ks][jj] = (short)f2b(sacc[2 * ks][jj]); sf[ks][4 + jj] = (short)f2b(sacc[2 * ks + 1][jj]); }
        uint2 v0 = *(const uint2*)(sVT + l15 * VS + 32 * ks + 4 * q4), v1 = *(const uint2*)(sVT + l15 * VS + 32 * ks + 16 + 4 * q4);
        uint4 vv = uint4{v0.x, v0.y, v1.x, v1.y}; vf[ks] = *(bf16x8*)&vv;
      }
      f32x4 num = f32x4{0.f, 0.f, 0.f, 0.f}, numC = f32x4{0.f, 0.f, 0.f, 0.f};
#pragma unroll
      for (int ks = 0; ks < 2; ks++) num = __builtin_amdgcn_mfma_f32_16x16x32_bf16(vf[ks], sf[ks], num, 0, 0, 0);
#pragma unroll
      for (int ks = 0; ks < 4; ks++) { bf16x8 cf = *(const bf16x8*)(sCT + l15 * QS + ks * 32 + q4 * 8); numC = __builtin_amdgcn_mfma_f32_16x16x32_bf16(cf, qf[ks], numC, 0, 0, 0); }
      float qn = 0.f;
#pragma unroll
      for (int i = 0; i < 4; i++) { uint4 u = *(const uint4*)(sQ + rt * QS + 32 * q4 + i * 8); const float* nn = sN + 32 * q4 + i * 8;
        qn += blo(u.x) * nn[0] + bhi(u.x) * nn[1] + blo(u.y) * nn[2] + bhi(u.y) * nn[3] + blo(u.z) * nn[4] + bhi(u.z) * nn[5] + blo(u.w) * nn[6] + bhi(u.w) * nn[7]; }
      qn += __shfl_xor(qn, 16); qn += __shfl_xor(qn, 32);
      {
        float inter = __expf(mold + ctt); float den = densum + inter * qn; float dn = fmaxf(fabsf(den), __expf(ctt - sBc[rt])); float inv = 1.f / dn;
        f32x4 hv;
#pragma unroll
        for (int jj = 0; jj < 4; jj++) hv[jj] = (num[jj] + inter * numC[jj]) * inv;
        if (!first) { unsigned ux = (unsigned)uu, uy = (unsigned)(uu >> 32);
          hv[0] += blo(ux); hv[1] += bhi(ux); hv[2] += blo(uy); hv[3] += bhi(uy); }
        store4b(hp, hv);
      }
      __syncthreads();
      {
        bf16x8 vw[2];
#pragma unroll
        for (int ks = 0; ks < 2; ks++)
#pragma unroll
          for (int e = 0; e < 8; e++) { int rs_ = 32 * ks + (e < 4 ? 4 * q4 + e : 16 + 4 * q4 + e - 4); vw[ks][e] = (short)f2b(b2f((bfr)vf[ks][e]) * sWg[rs_]); }
#pragma unroll
        for (int a = 0; a < 2; a++) {
          int dk = 32 * w + 16 * a + l15;
#pragma unroll
          for (int jj = 0; jj < 4; jj++) Cacc[a][jj] *= decay;
#pragma unroll
          for (int ks = 0; ks < 2; ks++) { bf16x8 kt;
#pragma unroll
            for (int e = 0; e < 8; e++) { int rs_ = 32 * ks + (e < 4 ? 4 * q4 + e : 16 + 4 * q4 + e - 4); kt[e] = (short)sK[rs_ * QS + dk]; }
            Cacc[a] = __builtin_amdgcn_mfma_f32_16x16x32_bf16(vw[ks], kt, Cacc[a], 0, 0, 0); }
#pragma unroll
          for (int jj = 0; jj < 4; jj++) sCT[(4 * q4 + jj) * QS + dk] = f2b(Cacc[a][jj]);
        }
        int dk = tid & 127, hf = tid >> 7; float part = 0.f;
#pragma unroll 8
        for (int r = 0; r < 32; r++) part += sWg[32 * hf + r] * b2f(sK[(32 * hf + r) * QS + dk]);
        sNr[tid] = part;
      }
      __syncthreads();
      if (tid < 128) sN[tid] = decay * sN[tid] + sNr[tid] + sNr[128 + tid];
    }
    __syncthreads();
  }
}

#define CS 72
#define CSLOT(i_) ((bfr*)smem + (i_) * (64 * CS))
#define A_SST (A_R7B + 362086400ull)
__device__ __forceinline__ f32x4 cmm(const bfr* X, const bfr* YT, int ti, int tj, int l15, int q4) {
  f32x4 acc = f32x4{0.f, 0.f, 0.f, 0.f};
#pragma unroll
  for (int ks = 0; ks < 2; ks++) { bf16x8 a = *(const bf16x8*)(X + (16 * ti + l15) * CS + 32 * ks + 8 * q4); bf16x8 b = *(const bf16x8*)(YT + (16 * tj + l15) * CS + 32 * ks + 8 * q4);
    acc = __builtin_amdgcn_mfma_f32_16x16x32_bf16(a, b, acc, 0, 0, 0); }
  return acc;
}
template <int MODE> __device__ __forceinline__ f32x4 cmm_mask(const bfr* X, const bfr* YT, int ti, int tj, int l15, int q4) {
  f32x4 acc = f32x4{0.f, 0.f, 0.f, 0.f};
#pragma unroll
  for (int ks = 0; ks < 2; ks++) { const int kb = 2 * ks + (q4 >> 1);
    const bool ok = MODE == 1 ? ((kb == 0 && tj == 1) || (kb == 2 && tj == 3)) : (kb < 2 && tj >= 2);
    bf16x8 a = *(const bf16x8*)(X + (16 * ti + l15) * CS + 32 * ks + 8 * q4); bf16x8 bz = bf16x8{0, 0, 0, 0, 0, 0, 0, 0};
    if (ok) bz = *(const bf16x8*)(YT + (16 * tj + l15) * CS + 32 * ks + 8 * q4);
    acc = __builtin_amdgcn_mfma_f32_16x16x32_bf16(a, bz, acc, 0, 0, 0); }
  return acc;
}
__device__ __forceinline__ void st_row(bfr* dst, int r0, int c, f32x4 v) {
#pragma unroll
  for (int jj = 0; jj < 4; jj++) dst[(r0 + jj) * CS + c] = f2b(v[jj]); }
__device__ __forceinline__ void st_tr(bfr* dst, int r0, int c, f32x4 v) { store4b(dst + c * CS + r0, v); }
__device__ __forceinline__ f32x4 ld_row(const bfr* src, int r0, int c) { f32x4 v;
#pragma unroll
  for (int jj = 0; jj < 4; jj++) v[jj] = b2f(src[(r0 + jj) * CS + c]);
  return v; }
__device__ __forceinline__ f32x4 ld_tr(const bfr* src, int r0, int c) { uint2 u = *(const uint2*)(src + c * CS + r0); return f32x4{blo(u.x), bhi(u.x), blo(u.y), bhi(u.y)}; }

__device__ __forceinline__ void ph_r7_ca(const P& p, int j, int win, char* smem) {
  float* LW = (float*)(smem + 7 * 9216); float* AT = (float*)(smem + 9 * 9216); float* WL = (float*)(smem + 14 * 9216);
  const bfr* RK = (const bfr*)(p.ACT + A_RKVZ); const bfr* WMb = (const bfr*)(p.ACT + A_WM); const bfr* AMb = (const bfr*)(p.ACT + A_AM);
  float* BON = (float*)(p.ACT + A_BON); bfr* WB = p.H;
  const float* kkp = p.r7_k_k + (size_t)j * 1024; const float* kap = p.r7_k_a + (size_t)j * 1024; const float* rkp = p.r7_r_k + (size_t)j * 1024;
  const int tid = ltid(), lane = tid & 63, w = tid >> 6, l15 = lane & 15, q4 = lane >> 4, ti = w >> 1, tj0 = (w & 1) * 2;
  const int c0 = win * 65;
  for (int it = blockIdx.x; it < 4160; it += gridDim.x) {
    const int chain = it / 65, cl = it - chain * 65, c = c0 + cl, d = chain & 1, b = chain >> 5, h = (chain >> 1) & 15;
    {
      const int rowA = rowmap(d, b, 64 * c + 16 * ti + l15);
      const float* w0 = p.r7_w0 + (size_t)(j * 2 + d) * 1024 + h * 64; const float* a0 = p.r7_a0 + (size_t)(j * 2 + d) * 1024 + h * 64;
#pragma unroll
      for (int tt = 0; tt < 2; tt++) { const int tj = tj0 + tt; f32x4 aw = f32x4{0.f, 0.f, 0.f, 0.f}, aa = aw;
#pragma unroll
        for (int ks = 0; ks < 2; ks++) {
          bf16x8 xw = *(const bf16x8*)(WMb + (size_t)rowA * 128 + d * 64 + 32 * ks + 8 * q4), xa = *(const bf16x8*)(AMb + (size_t)rowA * 128 + d * 64 + 32 * ks + 8 * q4);
          bf16x8 yw = *(const bf16x8*)(p.W + WR_UP + d * 65536 + (size_t)(h * 64 + 16 * tj + l15) * 64 + 32 * ks + 8 * q4);
          bf16x8 ya = *(const bf16x8*)(p.W + WR_UP + (2 + d) * 65536 + (size_t)(h * 64 + 16 * tj + l15) * 64 + 32 * ks + 8 * q4);
          aw = __builtin_amdgcn_mfma_f32_16x16x32_bf16(xw, yw, aw, 0, 0, 0); aa = __builtin_amdgcn_mfma_f32_16x16x32_bf16(xa, ya, aa, 0, 0, 0); }
        const int ch = 16 * tj + l15; const float w0v = w0[ch], a0v = a0[ch];
#pragma unroll
        for (int jj = 0; jj < 4; jj++) { const int tau = 16 * ti + 4 * q4 + jj; LW[tau * 64 + ch] = -0.6065306597126334f * sigm(w0v + aw[jj]); AT[tau * 64 + ch] = sigm(a0v + aa[jj]); }
      }
    }
    __syncthreads();
    if (tid < 64) { float acc = 0.f;
#pragma unroll 8
      for (int t = 0; t < 64; t++) { acc += LW[t * 64 + tid]; LW[t * 64 + tid] = acc; } }
    __syncthreads();
    {
      const int tau = tid >> 3, sc = tid & 7, col = h * 64 + sc * 8; const int row = rowmap(d, b, 64 * c + tau);
      const bfr* rp = RK + (size_t)row * 4096 + col; uint4 pr = *(const uint4*)rp, pk = *(const uint4*)(rp + 1024);
      unsigned ur[4] = {pr.x, pr.y, pr.z, pr.w}, uk[4] = {pk.x, pk.y, pk.z, pk.w};
      float r8[8], k8[8], kr[8];
#pragma unroll
      for (int e = 0; e < 4; e++) { r8[2 * e] = blo(ur[e]); r8[2 * e + 1] = bhi(ur[e]); k8[2 * e] = blo(uk[e]); k8[2 * e + 1] = bhi(uk[e]); }
      float ss = 0.f;
#pragma unroll
      for (int e = 0; e < 8; e++) { kr[e] = k8[e] * kkp[col + e]; ss += kr[e] * kr[e]; }
      ss += __shfl_xor(ss, 1); ss += __shfl_xor(ss, 2); ss += __shfl_xor(ss, 4);
      const float inv = 1.f / fmaxf(sqrtf(ss), 1e-12f);
      float bon = 0.f, o0[8], o1[8], o2[8], o3[8], o4[8], o5[8];
#pragma unroll
      for (int e = 0; e < 8; e++) {
        const float cw = LW[tau * 64 + sc * 8 + e], cwm = tau > 0 ? LW[(tau - 1) * 64 + sc * 8 + e] : 0.f, cwl = LW[63 * 64 + sc * 8 + e], a = AT[tau * 64 + sc * 8 + e];
        const float ka = kr[e] * inv, be = a * ka, kd = k8[e] * (1.f + (a - 1.f) * kap[col + e]); bon += r8[e] * kd * rkp[col + e];
        const float e2 = __expf(-cw), e4 = __expf(cwl - cw);
        o0[e] = ka * __expf(cwm); o1[e] = be * e2; o2[e] = kd * e2; o3[e] = r8[e] * __expf(cw); o4[e] = be * e4; o5[e] = kd * e4;
        if (tau == 63) WL[sc * 8 + e] = __expf(cwl);
      }
      bon += __shfl_xor(bon, 1); bon += __shfl_xor(bon, 2); bon += __shfl_xor(bon, 4);
      if (sc == 0) BON[((size_t)d * R_ + row) * 16 + h] = bon;
      *(uint4*)(CSLOT(0) + tau * CS + sc * 8) = uint4{pk2(o0[0], o0[1]), pk2(o0[2], o0[3]), pk2(o0[4], o0[5]), pk2(o0[6], o0[7])};
      *(uint4*)(CSLOT(1) + tau * CS + sc * 8) = uint4{pk2(o1[0], o1[1]), pk2(o1[2], o1[3]), pk2(o1[4], o1[5]), pk2(o1[6], o1[7])};
      *(uint4*)(CSLOT(2) + tau * CS + sc * 8) = uint4{pk2(o2[0], o2[1]), pk2(o2[2], o2[3]), pk2(o2[4], o2[5]), pk2(o2[6], o2[7])};
      *(uint4*)(CSLOT(3) + tau * CS + sc * 8) = uint4{pk2(o3[0], o3[1]), pk2(o3[2], o3[3]), pk2(o3[4], o3[5]), pk2(o3[6], o3[7])};
#pragma unroll
      for (int e = 0; e < 8; e++) { CSLOT(4)[(sc * 8 + e) * CS + tau] = f2b(o0[e]); CSLOT(5)[(sc * 8 + e) * CS + tau] = f2b(o4[e]); CSLOT(6)[(sc * 8 + e) * CS + tau] = f2b(o5[e]); }
    }
    __syncthreads();
#pragma unroll
    for (int tt = 0; tt < 2; tt++) { const int tj = tj0 + tt, r0 = 16 * ti + 4 * q4, cc = 16 * tj + l15;
      f32x4 v = cmm(CSLOT(1), CSLOT(0), ti, tj, l15, q4);
#pragma unroll
      for (int jj = 0; jj < 4; jj++) if (!(r0 + jj < cc)) v[jj] = 0.f;
      st_row(CSLOT(7), r0, cc, v); st_tr(CSLOT(8), r0, cc, v);
      v = cmm(CSLOT(2), CSLOT(0), ti, tj, l15, q4);
#pragma unroll
      for (int jj = 0; jj < 4; jj++) if (!(r0 + jj < cc)) v[jj] = 0.f;
      st_row(CSLOT(9), r0, cc, v);
      v = cmm(CSLOT(3), CSLOT(1), ti, tj, l15, q4);
#pragma unroll
      for (int jj = 0; jj < 4; jj++) if (!(cc <= r0 + jj)) v[jj] = 0.f;
      st_row(CSLOT(10), r0, cc, v);
      v = cmm(CSLOT(3), CSLOT(2), ti, tj, l15, q4);
#pragma unroll
      for (int jj = 0; jj < 4; jj++) if (!(cc <= r0 + jj)) v[jj] = 0.f;
      st_row(CSLOT(11), r0, cc, v);
    }
    __syncthreads();
    {
      float* X = (float*)CSLOT(0);
      const bfr* Ab = CSLOT(7);
      const int cl = lane >> 3, pp = lane & 7, cx = 8 * w + cl, blk0 = (w >> 1) * 16;
#pragma unroll 1
      for (int il = 15; il >= 0; il--) { const int i = blk0 + il;
        float sum = 0.f;
#pragma unroll 1
        for (int jx = i + 1 + pp; jx < blk0 + 16; jx += 8) sum += b2f(Ab[i * CS + jx]) * X[jx * 72 + cx];
        sum += dppf<0xB1>(sum); sum += dppf<0x4E>(sum); sum += dppf<0x141>(sum);
        const float xv = (i == cx ? 1.f : 0.f) - sum;
        if (pp == 0) X[i * 72 + cx] = xv;
      }
      __syncthreads();
#pragma unroll 1
      for (int e = tid; e < 4096; e += 512) { const int i = e >> 6, c2 = e & 63; const bfr tv = ((i >> 4) == (c2 >> 4)) ? f2b(X[i * 72 + c2]) : (bfr)0; CSLOT(2)[i * CS + c2] = tv; CSLOT(12)[c2 * CS + i] = tv; }
      __syncthreads();
#pragma unroll
      for (int tt = 0; tt < 2; tt++) { const int tj = tj0 + tt, r0 = 16 * ti + 4 * q4, cc = 16 * tj + l15; st_row(CSLOT(13), r0, cc, cmm_mask<1>(CSLOT(2), CSLOT(8), ti, tj, l15, q4)); }
      __syncthreads();
#pragma unroll
      for (int tt = 0; tt < 2; tt++) { const int tj = tj0 + tt, r0 = 16 * ti + 4 * q4, cc = 16 * tj + l15;
        f32x4 v = ld_row(CSLOT(2), r0, cc) - cmm(CSLOT(13), CSLOT(12), ti, tj, l15, q4); st_row(CSLOT(0), r0, cc, v); st_tr(CSLOT(1), r0, cc, v); }
      __syncthreads();
#pragma unroll
      for (int tt = 0; tt < 2; tt++) { const int tj = tj0 + tt, r0 = 16 * ti + 4 * q4, cc = 16 * tj + l15; st_row(CSLOT(13), r0, cc, cmm_mask<2>(CSLOT(0), CSLOT(8), ti, tj, l15, q4)); }
      __syncthreads();
#pragma unroll
      for (int tt = 0; tt < 2; tt++) { const int tj = tj0 + tt, r0 = 16 * ti + 4 * q4, cc = 16 * tj + l15;
        f32x4 v = ld_row(CSLOT(0), r0, cc) - cmm(CSLOT(13), CSLOT(1), ti, tj, l15, q4);
#pragma unroll
        for (int jj = 0; jj < 4; jj++) if (r0 + jj == cc) v[jj] -= 1.f;
        st_row(CSLOT(2), r0, cc, v); }
      __syncthreads();
    }
#pragma unroll
    for (int tt = 0; tt < 2; tt++) { const int tj = tj0 + tt, r0 = 16 * ti + 4 * q4, cc = 16 * tj + l15;
      f32x4 g = cmm(CSLOT(10), CSLOT(2), ti, tj, l15, q4) + ld_row(CSLOT(10), r0, cc); st_row(CSLOT(12), r0, cc, g);
      f32x4 hh = cmm(CSLOT(5), CSLOT(2), ti, tj, l15, q4) + ld_row(CSLOT(5), r0, cc); st_row(CSLOT(13), r0, cc, hh); }
    __syncthreads();
    {
      bfr* out = WB + (size_t)(chain * 65 + cl) * 16384;
#pragma unroll
      for (int tt = 0; tt < 2; tt++) { const int tj = tj0 + tt, r0 = 16 * ti + 4 * q4, cc = 16 * tj + l15;
        f32x4 v = ld_tr(CSLOT(3), r0, cc) - cmm(CSLOT(4), CSLOT(12), ti, tj, l15, q4);
        store4b(out + cc * 64 + r0, v);
        v = ld_tr(CSLOT(11), r0, cc) - cmm(CSLOT(9), CSLOT(12), ti, tj, l15, q4);
        store4b(out + 4096 + cc * 64 + r0, v);
        v = -cmm(CSLOT(4), CSLOT(13), ti, tj, l15, q4);
#pragma unroll
        for (int jj = 0; jj < 4; jj++) if (r0 + jj == cc) v[jj] += WL[cc];
        store4b(out + 8192 + cc * 64 + r0, v);
        v = ld_tr(CSLOT(6), r0, cc) - cmm(CSLOT(9), CSLOT(13), ti, tj, l15, q4);
        store4b(out + 12288 + cc * 64 + r0, v);
      }
    }
    __syncthreads();
  }
}

__device__ __forceinline__ void ph_r7_cb(const P& p, int win, int d, char* smem) {
  bfr* Sh = (bfr*)smem; bfr* Sl = Sh + 2 * 16 * CS; bfr* VT = Sl + 2 * 16 * CS;
  const bfr* WB = p.H; const bfr* RK = (const bfr*)(p.ACT + A_RKVZ); bfr* Y = (bfr*)(p.ACT + A_Y); bfr* SST = (bfr*)(p.ACT + A_SST);
  const int tid = ltid(), lane = tid & 63, w = tid >> 6, l15 = lane & 15, q4 = lane >> 4;
  const int c0 = win * 65;
  for (int it = blockIdx.x; it < 128; it += gridDim.x) {
    const int b = it >> 6, h = (it >> 2) & 15, rg = it & 3, chain = (b * 16 + h) * 2 + d;
    bfr* sst = SST + (size_t)(chain * 4 + rg) * 2048;
    __syncthreads();
    if (tid < 256) { const int hl = tid >> 7, e = tid & 127, rr = e >> 3, c8 = e & 7; uint4 v = uint4{0u, 0u, 0u, 0u};
      if (win > 0) v = *(const uint4*)(sst + hl * 1024 + rr * 64 + c8 * 8);
      *(uint4*)((hl ? Sl : Sh) + rr * CS + c8 * 8) = v; }
    const int vtau = tid >> 3, vp = tid & 7;
    { const int row = rowmap(d, b, 64 * c0 + vtau); unsigned vv = *(const unsigned*)(RK + (size_t)row * 4096 + 2048 + h * 64 + rg * 16 + 2 * vp);
      VT[(2 * vp) * CS + vtau] = (bfr)(vv & 0xffff); VT[(2 * vp + 1) * CS + vtau] = (bfr)(vv >> 16); }
    const bfr* bbase = WB + (size_t)(chain * 65) * 16384 + (w < 4 ? 8192 + (16 * w + l15) * 64 : (16 * (w - 4) + l15) * 64) + 8 * q4;
    bf16x8 rb1[4][2], rb2[4][2]; unsigned rv[4]; uint2 ry[4];
#define CB_FIRST(c_) ({ const int rc_ = d == 0 ? (c_) : ((c_) < 4 ? 3 - (c_) : 263 - (c_)); const int cb_ = rc_ < 4 ? 3 - rc_ : 263 - rc_; d == 0 ? (win <= cb_ / 65) : (win < rc_ / 65); })
#define CB_LOAD(u_, s_) { const int ss_ = (s_) < 65 ? (s_) : 64; const bfr* bp_ = bbase + (size_t)ss_ * 16384; \
      rb1[u_][0] = *(const bf16x8*)bp_; rb1[u_][1] = *(const bf16x8*)(bp_ + 32); rb2[u_][0] = *(const bf16x8*)(bp_ + 4096); rb2[u_][1] = *(const bf16x8*)(bp_ + 4096 + 32); \
      const int sv_ = ss_ + 1 < 65 ? ss_ + 1 : 64; const int rowv_ = rowmap(d, b, 64 * (c0 + sv_) + vtau); \
      rv[u_] = *(const unsigned*)(RK + (size_t)rowv_ * 4096 + 2048 + h * 64 + rg * 16 + 2 * vp); \
      ry[u_] = uint2{0u, 0u}; if (w >= 4 && !CB_FIRST(c0 + ss_)) { const int rowy_ = rowmap(d, b, 64 * (c0 + ss_) + 16 * (w - 4) + l15); ry[u_] = *(const uint2*)(Y + (size_t)rowy_ * 1024 + h * 64 + rg * 16 + 4 * q4); } }
    CB_LOAD(0, 0) CB_LOAD(1, 1) CB_LOAD(2, 2) CB_LOAD(3, 3)
    __syncthreads();
    for (int g = 0; g < 17; g++) {
#pragma unroll
      for (int u = 0; u < 4; u++) {
        const int s = 4 * g + u;
        if (s < 65) {
          const int cur = s & 1, nxt = cur ^ 1, c = c0 + s;
          bf16x8 sh[2], sl[2], vt[2];
#pragma unroll
          for (int ks = 0; ks < 2; ks++) { sh[ks] = *(const bf16x8*)(Sh + (cur * 16 + l15) * CS + 32 * ks + 8 * q4); sl[ks] = *(const bf16x8*)(Sl + (cur * 16 + l15) * CS + 32 * ks + 8 * q4);
            vt[ks] = *(const bf16x8*)(VT + (cur * 16 + l15) * CS + 32 * ks + 8 * q4); }
          f32x4 a1 = f32x4{0.f, 0.f, 0.f, 0.f}, a2 = a1;
#pragma unroll
          for (int ks = 0; ks < 2; ks++) { a1 = __builtin_amdgcn_mfma_f32_16x16x32_bf16(sh[ks], rb1[u][ks], a1, 0, 0, 0); a2 = __builtin_amdgcn_mfma_f32_16x16x32_bf16(vt[ks], rb2[u][ks], a2, 0, 0, 0); }
#pragma unroll
          for (int ks = 0; ks < 2; ks++) a1 = __builtin_amdgcn_mfma_f32_16x16x32_bf16(sl[ks], rb1[u][ks], a1, 0, 0, 0);
          a1 = a1 + a2;
          if (w < 4) {
#pragma unroll
            for (int jj = 0; jj < 4; jj++) { const bfr hi = f2b(a1[jj]); Sh[(nxt * 16 + 4 * q4 + jj) * CS + 16 * w + l15] = hi; Sl[(nxt * 16 + 4 * q4 + jj) * CS + 16 * w + l15] = f2b(a1[jj] - b2f(hi)); }
          } else {
            const int rowy = rowmap(d, b, 64 * c + 16 * (w - 4) + l15);
            a1[0] += blo(ry[u].x); a1[1] += bhi(ry[u].x); a1[2] += blo(ry[u].y); a1[3] += bhi(ry[u].y);
            store4b(Y + (size_t)rowy * 1024 + h * 64 + rg * 16 + 4 * q4, a1);
          }
          if (s + 1 < 65) { VT[(nxt * 16 + 2 * vp) * CS + vtau] = (bfr)(rv[u] & 0xffff); VT[(nxt * 16 + 2 * vp + 1) * CS + vtau] = (bfr)(rv[u] >> 16); }
          if (s + 4 < 65) CB_LOAD(u, s + 4)
          __syncthreads();
        }
      }
    }
    if (tid < 256) { const int hl = tid >> 7, e = tid & 127, rr = e >> 3, c8 = e & 7; *(uint4*)(sst + hl * 1024 + rr * 64 + c8 * 8) = *(const uint4*)((hl ? Sl : Sh) + (16 + rr) * CS + c8 * 8); }
  }
}

__device__ __forceinline__ void run_phase(const P& p, int ph, int layer, int d, char* smem) {
  Ctx c; c.layer = layer; c.j = layer / 3; c.d = d; c.wc = layer < 3 ? 1 : 0;
  switch (ph) {
    case PH_PRE: ph_pre(p, smem); break;
    case PH_NORM: ph_norm(p, layer, smem); break;
    case PH_LRU_IN: big_gemm(smem, p.H, p.W, 2560, 1024, F_LruIn{p.ACT}); break;
    case PH_LRU_CONV: ph_lru_conv(p, c.j); break;
    case PH_LRU_GATE: gemm_phase<G_LruGate>(p, c, smem); break;
    case PH_LRU_S1: ph_lru_s1(p, d); break;
    case PH_LRU_S2: ph_lru_s2(p); break;
    case PH_LRU_S3: ph_lru_s3(p, d); break;
    case PH_LRU_OUT: big_gemm(smem, (const bfr*)(p.ACT + A_Z), p.W + WL_OUT, 1024, 1280, F_Resid{p.Xx, p.Xc, p.MOD + (size_t)layer * 3 * 3072, c.wc}); break;
    case PH_ML_IN: big_gemm(smem, p.H, p.W, 4352, 1024, F_MlIn{p.ACT}); break;
    case PH_ML_SCAN: ph_ml_scan(p, c.j, smem); break;
    case PH_ML_STAT: ph_ml_stat(p); break;
    case PH_ML_Z: big_gemm(smem, p.H, p.W + WM_Z, 2048, 1024, F_MlZ{p.ACT, p.ml_norm_g + (size_t)c.j * 2048}); break;
    case PH_ML_OUT: big_gemm(smem, (const bfr*)(p.ACT + A_HS), p.W + WM_OUT, 1024, 2048, F_Resid{p.Xx, p.Xc, p.MOD + (size_t)layer * 3 * 3072, c.wc}); break;
    case PH_R7_IN: big_gemm(smem, p.H, p.W, 4352, 2048, F_R7In{p.ACT}); break;
    case PH_R7_SHIFT: ph_r7_shift(p); break;
    case PH_R7_CA: ph_r7_ca(p, c.j, d, smem); break;
    case PH_R7_CB: ph_r7_cb(p, d >> 1, d & 1, smem); break;
    case PH_R7_FIN: ph_r7_fin(p, c.j); break;
    case PH_R7_OUT: big_gemm(smem, (const bfr*)(p.ACT + A_Y), p.W + WR_OUT, 1024, 1024, F_Resid{p.Xx, p.Xc, p.MOD + (size_t)layer * 3 * 3072, c.wc}); break;
    case PH_FINAL: ph_final(p); break;
  }
}

#define SMEM_BYTES 131072
extern __shared__ __attribute__((aligned(16))) char dyn_smem[];
#if !MEGA
__global__ void __launch_bounds__(512, 2) phase_kernel(P p, int si) {
  run_phase(p, p.sched[si * 3], p.sched[si * 3 + 1], p.sched[si * 3 + 2], dyn_smem);
}
#else
__global__ void __launch_bounds__(512, 2) mega_kernel(P p) {
  cg::grid_group grid = cg::this_grid();
  for (int si = 0; si < p.nsched; si++) {
    run_phase(p, p.sched[si * 3], p.sched[si * 3 + 1], p.sched[si * 3 + 2], dyn_smem);
    if (si + 1 < p.nsched) grid.sync();
  }
}
#endif

extern "C" void kernel_launch(void* const* d_in, const int* in_sizes, int n_in, void* d_out, int out_size, void* d_ws, size_t ws_size, hipStream_t stream) {
  P p; memset(&p, 0, sizeof(p));
  const float** f = (const float**)&p;
  for (int i = 0; i < 33; i++) f[i] = (const float*)d_in[i];
  char* ws = (char*)d_ws;
  p.Xx = (float*)d_out; p.Xc = (float*)(ws + OFF_XC); p.MOD = (float*)(ws + OFF_MOD); p.W = (bfr*)(ws + OFF_W); p.H = (bfr*)(ws + OFF_H); p.ACT = ws + OFF_ACT;
  int n = 0;
  auto add = [&](int ph, int layer, int d) { p.sched[n * 3] = ph; p.sched[n * 3 + 1] = layer; p.sched[n * 3 + 2] = d; n++; };
  add(PH_PRE, 0, 0);
  if (DUP & 4) add(PH_PRE, 0, 0);
  for (int l = 0; l < 4; l++) {
    add(PH_NORM, l, 0); if (DUP & 4) add(PH_NORM, l, 0);
    int kind = l % 3;
    const bool dg = DUP & 1, ds = DUP & 2;
    if (kind == 0) { add(PH_LRU_IN, l, 0); if (dg) add(PH_LRU_IN, l, 0); add(PH_LRU_CONV, l, 0); if (DUP & 4) add(PH_LRU_CONV, l, 0);
      for (int d = 0; d < 2; d++) { add(PH_LRU_GATE, l, d); if (dg) add(PH_LRU_GATE, l, d); add(PH_LRU_S1, l, d); if (DUP & 8) add(PH_LRU_S1, l, d); add(PH_LRU_S2, l, d); if (DUP & 16) add(PH_LRU_S2, l, d); add(PH_LRU_S3, l, d); }
      add(PH_LRU_OUT, l, 0); }
    else if (kind == 1) { add(PH_ML_IN, l, 0); if (dg) add(PH_ML_IN, l, 0); add(PH_ML_SCAN, l, 0); if (ds) add(PH_ML_SCAN, l, 0); add(PH_ML_STAT, l, 0); if (DUP & 4) add(PH_ML_STAT, l, 0); add(PH_ML_Z, l, 0); add(PH_ML_OUT, l, 0); }
    else { add(PH_R7_SHIFT, l, 0); add(PH_R7_IN, l, 0); if (dg) add(PH_R7_IN, l, 0); for (int wi = 0; wi < 4; wi++) { add(PH_R7_CA, l, wi); if (ds) add(PH_R7_CA, l, wi); add(PH_R7_CB, l, wi * 2); add(PH_R7_CB, l, wi * 2 + 1); } add(PH_R7_FIN, l, 0); add(PH_R7_OUT, l, 0); }
  }
  add(PH_FINAL, 0, 0);
  p.nsched = n;
  if (ws_size < WS_NEED) fprintf(stderr, "workspace too small: %zu < %llu\n", ws_size, (unsigned long long)WS_NEED);
#if MEGA
  static int grid_blocks = 0;
  if (!grid_blocks) { int dev = 0, cus = 0, per = 0; hipGetDevice(&dev); hipDeviceGetAttribute(&cus, hipDeviceAttributeMultiprocessorCount, dev);
    hipFuncSetAttribute((const void*)mega_kernel, hipFuncAttributeMaxDynamicSharedMemorySize, SMEM_BYTES);
    hipOccupancyMaxActiveBlocksPerMultiprocessor(&per, mega_kernel, 512, SMEM_BYTES); if (per > 1) per = 1; if (per < 1) per = 1; grid_blocks = cus * per; }
  void* args[] = {&p};
  hipError_t e = hipLaunchCooperativeKernel((void*)mega_kernel, dim3(grid_blocks), dim3(512), args, SMEM_BYTES, stream);
  if (e != hipSuccess) fprintf(stderr, "cooperative launch failed: %s (grid %d)\n", hipGetErrorString(e), grid_blocks);
#else
  static int once = 0; if (!once) { once = 1; hipFuncSetAttribute((const void*)phase_kernel, hipFuncAttributeMaxDynamicSharedMemorySize, SMEM_BYTES); }
  for (int si = 0; si < n; si++) phase_kernel<<<256, 512, SMEM_BYTES, stream>>>(p, si);
#endif
}
```

```cpp
#include <hip/hip_runtime.h>
#include <hip/hip_bf16.h>
#include <hip/hip_cooperative_groups.h>
#include <cstdio>
#include <cstring>
#include <type_traits>
namespace cg = cooperative_groups;

#ifndef DUP
#define DUP 0
#endif
#ifndef MEGA
#define MEGA 1
#endif

typedef unsigned short bfr;
using bf16x8 = __attribute__((ext_vector_type(8))) short;
using f32x4 = __attribute__((ext_vector_type(4))) float;

#define R_ 33280
#define BT_ 16640
#define NCH_ 260

#define OFF_XC 0ull
#define OFF_MOD 2097152ull
#define OFF_W 2244608ull
#define OFF_H 24264704ull
#define OFF_ACT 92422144ull
#define A_Z 0ull
#define A_UC 85196800ull
#define A_AB 170393600ull
#define A_U 170393600ull
#define A_HF 340787200ull
#define A_AGG 425984000ull
#define A_CAR 431308800ull
#define A_QKV 0ull
#define A_GATE 272629760ull
#define A_HS 276889600ull
#define A_RSTD 413204480ull
#define A_R7B 68157440ull
#define A_RKVZ (A_R7B + 0ull)
#define A_WM (A_R7B + 272629760ull)
#define A_AM (A_R7B + 281149440ull)
#define A_BON (A_R7B + 289669120ull)
#define A_Y (A_R7B + 293928960ull)
#define WS_NEED (527000064ull + 16384ull)

#define WL_GATE (2560 * 1024)
#define WL_OUT (WL_GATE + 1310720)
#define WM_Z (4352 * 1024)
#define WM_OUT (WM_Z + 2048 * 1024)
#define WR_UP (4352 * 2048)
#define WR_OUT (WR_UP + 262144)

enum { PH_PRE = 0, PH_NORM, PH_LRU_IN, PH_LRU_CONV, PH_LRU_GATE, PH_LRU_S1, PH_LRU_S2, PH_LRU_S3, PH_LRU_OUT,
       PH_ML_IN, PH_ML_SCAN, PH_ML_STAT, PH_ML_Z, PH_ML_OUT,
       PH_R7_IN, PH_R7_CA, PH_R7_CB, PH_R7_FIN, PH_R7_OUT, PH_FINAL, PH_R7_SHIFT };

struct P {
  const float *x, *c, *ctx, *c_ctx, *norm_g, *mod_w, *mod_b, *final_g;
  const float *lru_w_in, *lru_conv_w, *lru_conv_b, *lru_gate_w, *lru_gate_b, *lru_lam, *lru_w_out;
  const float *ml_w_in, *ml_gate_b, *ml_norm_g, *ml_w_out;
  const float *r7_mu, *r7_w_rkvz, *r7_w0, *r7_w1, *r7_w2, *r7_a0, *r7_a1, *r7_a2, *r7_k_k, *r7_k_a, *r7_r_k, *r7_ln_g, *r7_ln_b, *r7_w_out;
  float* Xx; float* Xc; float* MOD; bfr* W; bfr* H; char* ACT; unsigned* bar;
  int nsched; int pad_;
  int sched[64 * 3];
};
struct Ctx { int layer, j, d, wc; };

__device__ __forceinline__ int ltid() { int t = threadIdx.x; asm volatile("" : "+v"(t)); return t; }
__device__ __forceinline__ bfr f2b(float f) { unsigned u = __float_as_uint(f); u += 0x7fffu + ((u >> 16) & 1u); return (bfr)(u >> 16); }
__device__ __forceinline__ float b2f(bfr b) { return __uint_as_float(((unsigned)b) << 16); }
__device__ __forceinline__ unsigned pk2(float a, float b) { return (unsigned)f2b(a) | (((unsigned)f2b(b)) << 16); }
__device__ __forceinline__ float blo(unsigned u) { return __uint_as_float(u << 16); }
__device__ __forceinline__ float bhi(unsigned u) { return __uint_as_float(u & 0xffff0000u); }
__device__ __forceinline__ void store4b(bfr* dst, f32x4 v) { uint2 u; u.x = pk2(v[0], v[1]); u.y = pk2(v[2], v[3]); *(uint2*)dst = u; }
__device__ __forceinline__ float sigm(float x) { return 1.f / (1.f + __expf(-x)); }
__device__ __forceinline__ float siluf(float x) { return x * sigm(x); }
__device__ __forceinline__ float softplusf(float x) { return x > 20.f ? x : log1pf(expf(x)); }
__device__ __forceinline__ int rowmap(int d, int b, int pp) { int o = d == 0 ? pp : (pp < 256 ? 255 - pp : 16895 - pp); return b * BT_ + o; }
__device__ __forceinline__ float* xrowp(const P& p, int row, int& mi) {
  int b = row / BT_, o = row - b * BT_;
  if (o < 256) { mi = 2; return p.Xc + (size_t)(b * 256 + o) * 1024; }
  mi = b; return p.Xx + (size_t)(b * 16384 + o - 256) * 1024;
}
__device__ __forceinline__ float wsum(float v) { for (int o = 32; o; o >>= 1) v += __shfl_xor(v, o); return v; }
template <int CTRL> __device__ __forceinline__ float dppf(float x) {
  return __int_as_float(__builtin_amdgcn_update_dpp(0, __float_as_int(x), CTRL, 0xf, 0xf, true));
}
__device__ __forceinline__ float red16(float x) {
  x += dppf<0xB1>(x); x += dppf<0x4E>(x); x += dppf<0x141>(x); x += dppf<0x140>(x); return x;
}

template <class F> __device__ __forceinline__ void prep_tile(bfr* dst, int K, int tn, int tk, F get, float* sm) {
  int tid = ltid();
  for (int i = 0; i < 8; i++) { int kk = (tid >> 6) + 8 * i, nn = tid & 63; sm[kk * 65 + nn] = get(tk * 64 + kk, tn * 64 + nn); }
  __syncthreads();
  for (int i = 0; i < 8; i++) { int nn = (tid >> 6) + 8 * i, kk = tid & 63; dst[(size_t)(tn * 64 + nn) * K + tk * 64 + kk] = f2b(sm[kk * 65 + nn]); }
  __syncthreads();
}
__device__ __forceinline__ int prep_count(int layer) { int kind = layer % 3; return kind == 0 ? (640 + 320 + 320) : kind == 1 ? (1088 + 512 + 512) : (2176 + 64 + 256); }
__device__ __forceinline__ void prep_item(const P& p, int layer, int it, float* sm) {
  int kind = layer % 3, j = layer / 3;
  if (kind == 0) {
    if (it < 640) { int tn = it / 16, tk = it % 16; const float* s = p.lru_w_in + (size_t)j * 1024 * 2560;
      prep_tile(p.W, 1024, tn, tk, [=](int k, int n) { return s[(size_t)k * 2560 + n]; }, sm); return; }
    it -= 640;
    if (it < 320) { int d = it / 160, r = it % 160, tn = r / 2, tk = r % 2; const float* s = p.lru_gate_w + (size_t)(j * 2 + d) * 2 * 10 * 16384;
      prep_tile(p.W + WL_GATE + d * 655360, 128, tn, tk, [=](int k, int n) {
        int nt = n >> 7, blk = nt >> 1, sub = nt & 1, jj = n & 127, wn = jj >> 6, rr = jj & 63, g = rr >> 5, c = rr & 31;
        int kch = sub * 64 + wn * 32 + c; return s[((size_t)(g * 10 + blk) * 128 + k) * 128 + kch]; }, sm); return; }
    it -= 320;
    { int tn = it / 20, tk = it % 20; const float* s = p.lru_w_out + (size_t)j * 1280 * 1024;
      prep_tile(p.W + WL_OUT, 1280, tn, tk, [=](int k, int n) { return s[(size_t)k * 1024 + n]; }, sm); return; }
  } else if (kind == 1) {
    const float* s = p.ml_w_in + (size_t)j * 1024 * 6176;
    if (it < 1088) { int tn = it / 16, tk = it % 16;
      prep_tile(p.W, 1024, tn, tk, [=](int k, int n) {
        if (n < 4096) { float v = s[(size_t)k * 6176 + n]; return (n >= 1024 && n < 2048) ? v * 0.08838834764831845f : v; }
        if (n < 4128) return s[(size_t)k * 6176 + 6144 + (n - 4096)];
        return 0.f; }, sm); return; }
    it -= 1088;
    if (it < 512) { int tn = it / 16, tk = it % 16;
      prep_tile(p.W + WM_Z, 1024, tn, tk, [=](int k, int n) { return s[(size_t)k * 6176 + 4096 + n]; }, sm); return; }
    it -= 512;
    { int tn = it / 32, tk = it % 32; const float* so = p.ml_w_out + (size_t)j * 2048 * 1024;
      prep_tile(p.W + WM_OUT, 2048, tn, tk, [=](int k, int n) { return so[(size_t)k * 1024 + n]; }, sm); return; }
  } else {
    if (it < 2176) { int tn = it / 32, tk = it % 32;
      const float* mu = p.r7_mu + (size_t)j * 6 * 1024; const float* wr = p.r7_w_rkvz + (size_t)j * 4 * 1024 * 1024;
      const float* w1 = p.r7_w1 + (size_t)j * 2 * 1024 * 64; const float* a1 = p.r7_a1 + (size_t)j * 2 * 1024 * 64;
      prep_tile(p.W, 2048, tn, tk, [=](int k, int n) {
        int kk = k & 1023; float v, m;
        if (n < 4096) { int g = n >> 10, e = n & 1023; m = mu[g * 1024 + kk]; v = wr[((size_t)g * 1024 + kk) * 1024 + e]; }
        else if (n < 4224) { int xx = (n - 4096) >> 6, rr = (n - 4096) & 63; m = mu[4 * 1024 + kk]; v = w1[((size_t)xx * 1024 + kk) * 64 + rr]; }
        else { int xx = (n - 4224) >> 6, rr = (n - 4224) & 63; m = mu[5 * 1024 + kk]; v = a1[((size_t)xx * 1024 + kk) * 64 + rr]; }
        return (k < 1024 ? (1.f - m) : m) * v; }, sm); return; }
    it -= 2176;
    if (it < 64) { int u = it / 16, tn = it % 16; const float* s = (u < 2 ? p.r7_w2 : p.r7_a2) + (size_t)(j * 2 + (u & 1)) * 64 * 1024;
      prep_tile(p.W + WR_UP + u * 65536, 64, tn, 0, [=](int k, int n) { return s[(size_t)k * 1024 + n]; }, sm); return; }
    it -= 64;
    { int tn = it / 16, tk = it % 16; const float* s = p.r7_w_out + (size_t)j * 1024 * 1024;
      prep_tile(p.W + WR_OUT, 1024, tn, tk, [=](int k, int n) { return s[(size_t)k * 1024 + n]; }, sm); return; }
  }
}

#define LDSS 72
template <class G> __device__ __forceinline__ void gemm_tile(const P& p, const Ctx& c, int mt, int nt, char* smem) {
  const int tid = ltid(), lane = tid & 63, wid = tid >> 6, wm = wid & 3, wn = wid >> 2;
  bfr* sA = (bfr*)smem; bfr* sB = sA + 2 * 256 * LDSS;
  f32x4 acc[4][4];
  for (int a = 0; a < 4; a++) for (int b = 0; b < 4; b++) acc[a][b] = f32x4{0.f, 0.f, 0.f, 0.f};
  const int lr = tid >> 3, lc = tid & 7;
  uint4 ra[4], rb[2];
  auto gload = [&](int kt) __attribute__((always_inline)) {
#pragma unroll
    for (int i = 0; i < 4; i++) {
      const bfr* pa = G::aptr(p, c, mt * 256 + lr + 64 * i, kt, nt);
      ra[i] = pa ? *(const uint4*)(pa + lc * 8) : uint4{0u, 0u, 0u, 0u};
      if (i < 2) rb[i] = *(const uint4*)(G::bptr(p, c, nt * 128 + lr + 64 * i, kt) + lc * 8);
    }
  };
  auto sstore = [&](int buf) __attribute__((always_inline)) {
#pragma unroll
    for (int i = 0; i < 4; i++) {
      *(uint4*)(sA + (buf * 256 + lr + 64 * i) * LDSS + lc * 8) = ra[i];
      if (i < 2) *(uint4*)(sB + (buf * 128 + lr + 64 * i) * LDSS + lc * 8) = rb[i];
    }
  };
  gload(0); sstore(0); __syncthreads();
  for (int kt = 0; kt < G::KT; kt++) {
    const int buf = kt & 1;
    if (kt + 1 < G::KT) gload(kt + 1);
#pragma unroll
    for (int ks = 0; ks < 2; ks++) {
      bf16x8 af[4], bf[4];
#pragma unroll
      for (int i = 0; i < 4; i++) {
        af[i] = *(const bf16x8*)(sA + (buf * 256 + wm * 64 + i * 16 + (lane & 15)) * LDSS + ks * 32 + (lane >> 4) * 8);
        bf[i] = *(const bf16x8*)(sB + (buf * 128 + wn * 64 + i * 16 + (lane & 15)) * LDSS + ks * 32 + (lane >> 4) * 8);
      }
#pragma unroll
      for (int n = 0; n < 4; n++)
#pragma unroll
        for (int m = 0; m < 4; m++) acc[n][m] = __builtin_amdgcn_mfma_f32_16x16x32_bf16(bf[n], af[m], acc[n][m], 0, 0, 0);
    }
    if (kt + 1 < G::KT) sstore(buf ^ 1);
    __syncthreads();
  }
  G::epi(p, c, acc, mt * 256 + wm * 64, nt * 128 + wn * 64, lane);
}

__device__ __forceinline__ void epi_resid(const P& p, const Ctx& c, f32x4 (&acc)[4][4], int m0, int n0, int lane) {
#pragma unroll
  for (int mi = 0; mi < 4; mi++) {
    int row = m0 + mi * 16 + (lane & 15); int mo; float* xr = xrowp(p, row, mo);
    if (mo == 2 && !c.wc) continue;
    const float* g = p.MOD + (size_t)(c.layer * 3 + mo) * 3072 + 2048;
#pragma unroll
    for (int ni = 0; ni < 4; ni++) {
      int n = n0 + ni * 16 + (lane >> 4) * 4;
      float4 xv = *(float4*)(xr + n); float4 gg = *(const float4*)(g + n);
      xv.x += gg.x * acc[ni][mi][0]; xv.y += gg.y * acc[ni][mi][1]; xv.z += gg.z * acc[ni][mi][2]; xv.w += gg.w * acc[ni][mi][3];
      *(float4*)(xr + n) = xv;
    }
  }
}

struct G_LruIn { static constexpr int KT = 16, NT = 20;
  static __device__ __forceinline__ const bfr* aptr(const P& p, const Ctx& c, int row, int kt, int nt) { return p.H + (size_t)row * 1024 + kt * 64; }
  static __device__ __forceinline__ const bfr* bptr(const P& p, const Ctx& c, int n, int kt) { return p.W + (size_t)n * 1024 + kt * 64; }
  static __device__ __forceinline__ void epi(const P& p, const Ctx& c, f32x4 (&acc)[4][4], int m0, int n0, int lane) {
    bfr* U = (bfr*)(p.ACT + A_U); bfr* Z = (bfr*)(p.ACT + A_Z);
#pragma unroll
    for (int ni = 0; ni < 4; ni++)
#pragma unroll
      for (int mi = 0; mi < 4; mi++) {
        int row = m0 + mi * 16 + (lane & 15), n = n0 + ni * 16 + (lane >> 4) * 4;
        bfr* dst = n < 1280 ? U + (size_t)row * 1280 + n : Z + (size_t)row * 1280 + (n - 1280);
        store4b(dst, acc[ni][mi]);
      }
  } };
struct G_LruGate { static constexpr int KT = 2, NT = 20;
  static __device__ __forceinline__ const bfr* aptr(const P& p, const Ctx& c, int row, int kt, int nt) { return (const bfr*)(p.ACT + A_UC) + (size_t)row * 1280 + (nt >> 1) * 128 + kt * 64; }
  static __device__ __forceinline__ const bfr* bptr(const P& p, const Ctx& c, int n, int kt) { return p.W + WL_GATE + c.d * 655360 + (size_t)n * 128 + kt * 64; }
  static __device__ __forceinline__ void epi(const P& p, const Ctx& c, f32x4 (&acc)[4][4], int m0, int n0, int lane) {
    const bfr* UC = (const bfr*)(p.ACT + A_UC); unsigned* AB = (unsigned*)(p.ACT + A_AB);
    const float* gb = p.lru_gate_b + (size_t)(c.j * 2 + c.d) * 2 * 1280; const float* lam = p.lru_lam + (size_t)(c.j * 2 + c.d) * 1280;
    int chb = (n0 >> 6) * 32;
#pragma unroll
    for (int ni = 0; ni < 2; ni++) {
      int ch = chb + ni * 16 + (lane >> 4) * 4;
      float cl[4], br[4], bi[4];
#pragma unroll
      for (int q = 0; q < 4; q++) { cl[q] = 8.f * softplusf(-lam[ch + q]); br[q] = gb[ch + q]; bi[q] = gb[1280 + ch + q]; }
#pragma unroll
      for (int mi = 0; mi < 4; mi++) {
        int row = m0 + mi * 16 + (lane & 15);
        uint2 u = *(const uint2*)(UC + (size_t)row * 1280 + ch);
        float uc[4] = {blo(u.x), bhi(u.x), blo(u.y), bhi(u.y)};
        unsigned o[4];
#pragma unroll
        for (int q = 0; q < 4; q++) {
          float r = sigm(acc[ni][mi][q] + br[q]), ig = sigm(acc[ni + 2][mi][q] + bi[q]);
          float la = -cl[q] * r; float oma = 1.f - __expf(la); float bb = sqrtf(oma * (2.f - oma)) * ig * uc[q];
          o[q] = (((unsigned)f2b(oma)) << 16) | (unsigned)f2b(bb);
        }
        *(uint4*)(AB + (size_t)row * 1280 + ch) = uint4{o[0], o[1], o[2], o[3]};
      }
    }
  } };
struct G_LruOut { static constexpr int KT = 20, NT = 8;
  static __device__ __forceinline__ const bfr* aptr(const P& p, const Ctx& c, int row, int kt, int nt) { return (const bfr*)(p.ACT + A_Z) + (size_t)row * 1280 + kt * 64; }
  static __device__ __forceinline__ const bfr* bptr(const P& p, const Ctx& c, int n, int kt) { return p.W + WL_OUT + (size_t)n * 1280 + kt * 64; }
  static __device__ __forceinline__ void epi(const P& p, const Ctx& c, f32x4 (&acc)[4][4], int m0, int n0, int lane) { epi_resid(p, c, acc, m0, n0, lane); } };
struct G_MlIn { static constexpr int KT = 16, NT = 33;
  static __device__ __forceinline__ const bfr* aptr(const P& p, const Ctx& c, int row, int kt, int nt) { return p.H + (size_t)row * 1024 + kt * 64; }
  static __device__ __forceinline__ const bfr* bptr(const P& p, const Ctx& c, int n, int kt) { return p.W + (size_t)n * 1024 + kt * 64; }
  static __device__ __forceinline__ void epi(const P& p, const Ctx& c, f32x4 (&acc)[4][4], int m0, int n0, int lane) {
    bfr* QKV = (bfr*)(p.ACT + A_QKV); float* GT = (float*)(p.ACT + A_GATE);
#pragma unroll
    for (int ni = 0; ni < 4; ni++)
#pragma unroll
      for (int mi = 0; mi < 4; mi++) {
        int row = m0 + mi * 16 + (lane & 15), n = n0 + ni * 16 + (lane >> 4) * 4;
        if (n < 4096) store4b(QKV + (size_t)row * 4096 + n, acc[ni][mi]);
        else if (n < 4128) *(float4*)(GT + (size_t)row * 32 + (n - 4096)) = float4{acc[ni][mi][0], acc[ni][mi][1], acc[ni][mi][2], acc[ni][mi][3]};
      }
  } };
struct G_MlZ { static constexpr int KT = 16, NT = 16;
  static __device__ __forceinline__ const bfr* aptr(const P& p, const Ctx& c, int row, int kt, int nt) { return p.H + (size_t)row * 1024 + kt * 64; }
  static __device__ __forceinline__ const bfr* bptr(const P& p, const Ctx& c, int n, int kt) { return p.W + WM_Z + (size_t)n * 1024 + kt * 64; }
  static __device__ __forceinline__ void epi(const P& p, const Ctx& c, f32x4 (&acc)[4][4], int m0, int n0, int lane) {
    bfr* HS = (bfr*)(p.ACT + A_HS); const float* RS = (const float*)(p.ACT + A_RSTD); const float* ng = p.ml_norm_g + (size_t)c.j * 2048;
#pragma unroll
    for (int ni = 0; ni < 4; ni++)
#pragma unroll
      for (int mi = 0; mi < 4; mi++) {
        int row = m0 + mi * 16 + (lane & 15), n = n0 + ni * 16 + (lane >> 4) * 4;
        bfr* hp = HS + (size_t)row * 2048 + n; uint2 u = *(const uint2*)hp; float rs = RS[(size_t)row * 8 + (n >> 8)];
        float4 g4 = *(const float4*)(ng + n);
        f32x4 o;
        o[0] = blo(u.x) * rs * g4.x * siluf(acc[ni][mi][0]); o[1] = bhi(u.x) * rs * g4.y * siluf(acc[ni][mi][1]);
        o[2] = blo(u.y) * rs * g4.z * siluf(acc[ni][mi][2]); o[3] = bhi(u.y) * rs * g4.w * siluf(acc[ni][mi][3]);
        store4b(hp, o);
      }
  } };
struct G_MlOut { static constexpr int KT = 32, NT = 8;
  static __device__ __forceinline__ const bfr* aptr(const P& p, const Ctx& c, int row, int kt, int nt) { return (const bfr*)(p.ACT + A_HS) + (size_t)row * 2048 + kt * 64; }
  static __device__ __forceinline__ const bfr* bptr(const P& p, const Ctx& c, int n, int kt) { return p.W + WM_OUT + (size_t)n * 2048 + kt * 64; }
  static __device__ __forceinline__ void epi(const P& p, const Ctx& c, f32x4 (&acc)[4][4], int m0, int n0, int lane) { epi_resid(p, c, acc, m0, n0, lane); } };
struct G_R7In { static constexpr int KT = 32, NT = 34;
  static __device__ __forceinline__ const bfr* aptr(const P& p, const Ctx& c, int row, int kt, int nt) {
    if (kt < 16) return p.H + (size_t)row * 1024 + kt * 64;
    int q = (kt - 16) >> 2; int b = row / BT_, o = row - b * BT_; int nr;
    if (o < 256) { if (q < 2) { if (o < 1) return nullptr; nr = row - 1; } else { if (o >= 255) return nullptr; nr = row + 1; } }
    else { int t = o - 256, col = t & 63, gr = t >> 6;
      if (q == 0) { if (col == 0) return nullptr; nr = row - 1; }
      else if (q == 1) { if (col == 63) return nullptr; nr = row + 1; }
      else if (q == 2) { if (gr == 0) return nullptr; nr = row - 64; }
      else { if (gr == 255) return nullptr; nr = row + 64; } }
    return p.H + (size_t)nr * 1024 + (kt - 16) * 64; }
  static __device__ __forceinline__ const bfr* bptr(const P& p, const Ctx& c, int n, int kt) { return p.W + (size_t)n * 2048 + kt * 64; }
  static __device__ __forceinline__ void epi(const P& p, const Ctx& c, f32x4 (&acc)[4][4], int m0, int n0, int lane) {
    bfr* RK = (bfr*)(p.ACT + A_RKVZ); bfr* WMb = (bfr*)(p.ACT + A_WM); bfr* AMb = (bfr*)(p.ACT + A_AM);
#pragma unroll
    for (int ni = 0; ni < 4; ni++)
#pragma unroll
      for (int mi = 0; mi < 4; mi++) {
        int row = m0 + mi * 16 + (lane & 15), n = n0 + ni * 16 + (lane >> 4) * 4;
        if (n < 4096) store4b(RK + (size_t)row * 4096 + n, acc[ni][mi]);
        else if (n < 4224) { f32x4 t;
#pragma unroll
          for (int q = 0; q < 4; q++) t[q] = tanhf(acc[ni][mi][q]); store4b(WMb + (size_t)row * 128 + (n - 4096), t); }
        else store4b(AMb + (size_t)row * 128 + (n - 4224), acc[ni][mi]);
      }
  } };
struct G_R7Out { static constexpr int KT = 16, NT = 8;
  static __device__ __forceinline__ const bfr* aptr(const P& p, const Ctx& c, int row, int kt, int nt) { return p.H + (size_t)row * 1024 + kt * 64; }
  static __device__ __forceinline__ const bfr* bptr(const P& p, const Ctx& c, int n, int kt) { return p.W + WR_OUT + (size_t)n * 1024 + kt * 64; }
  static __device__ __forceinline__ void epi(const P& p, const Ctx& c, f32x4 (&acc)[4][4], int m0, int n0, int lane) { epi_resid(p, c, acc, m0, n0, lane); } };


namespace pg8 {
#define PG8_LAS __attribute__((address_space(3)))
constexpr int BM = 256, BK = 64, HALF = 128, HTB = HALF * BK * 2, NXCD = 8, WGM = 8;
__device__ __forceinline__ int lds_byte(int r, int c) { const int st = (r >> 4) * 2 + (c >> 5), rr = r & 15, cc = c & 31, ob = rr * 64 + cc * 2; return st * 1024 + (ob ^ (((ob >> 9) & 1) << 5)); }
__device__ __forceinline__ void stage_rc(int b, int& R, int& C) { const int st = b / 1024, sb = b % 1024, swz = sb ^ (((sb >> 9) & 1) << 5); R = (st >> 1) * 16 + swz / 64; C = (st & 1) * 32 + (swz % 64) / 2; }
struct Unit { int pm, pn; };
struct Gemm { const bfr* A; const bfr* Bt; int M, N, K; };
struct StaticOrder {
  int nM, nN, nwg, G, c;
  __device__ void init(int M, int N, int G_, int c_) { nM = M / BM; nN = N / BM; nwg = nM * nN; G = G_; c = c_; }
  __device__ bool next(int i, Unit& u) const {
    const long L = (long)i * G + c; if (L >= nwg) return false;
    int wgid = (int)L; { const int q = nwg / NXCD, r = nwg % NXCD, xcd = wgid % NXCD, off = wgid / NXCD; wgid = (xcd < r ? xcd * (q + 1) : r * (q + 1) + (xcd - r) * q) + off; }
    const int nig = WGM * nN, gid = wgid / nig, fm = gid * WGM, gsz = (nM - fm) < WGM ? (nM - fm) : WGM;
    u.pm = fm + ((wgid % nig) % gsz); u.pn = (wgid % nig) / gsz; return true;
  }
};
template <class Epi>
__device__ __forceinline__ void gemm_phase(PG8_LAS unsigned char* lds, const Gemm g, const StaticOrder& S, const Epi& E) {
  const int tid = ltid(), wid = __builtin_amdgcn_readfirstlane(tid >> 6), lane = tid & 63, wr = wid >> 2, wc = wid & 3, fr = lane & 15, fq = lane >> 4;
  const int K = g.K, nt = K / BK;
  unsigned voffA[2], voffB[2];
#pragma unroll
  for (int i = 0; i < 2; ++i) { int R, C; stage_rc(tid * 16 + i * 8192, R, C); voffA[i] = (unsigned)(R * K + C) * 2u; voffB[i] = voffA[i]; }
  const size_t kstep = (size_t)(BK * 2);
  const size_t hstep = (size_t)HALF * K * 2;
  const size_t tstep = 2 * hstep;
  const unsigned ldsw = (unsigned)wid * 1024u;
  const int aoff = lds_byte(wr * 64 + fr, fq * 8), boff = lds_byte(wc * 32 + fr, fq * 8);
#define PG8_SA(b, h) (((b) * 2 + (h)) * HTB)
#define PG8_SB(b, h) ((4 + (b) * 2 + (h)) * HTB)
#define PG8_STAGE(bufoff, gbase, voff) do { _Pragma("unroll") for (int _i = 0; _i < 2; ++_i) \
    __builtin_amdgcn_global_load_lds((const unsigned*)((const char*)(gbase) + (voff)[_i]), (PG8_LAS unsigned*)(lds + (bufoff) + ldsw + _i * 8192), 16, 0, 0); } while (0)
#define PG8_LDA(dst, b, h) do { _Pragma("unroll") for (int m = 0; m < 4; ++m) _Pragma("unroll") for (int k = 0; k < 2; ++k) dst[m][k] = *(const PG8_LAS bf16x8*)(lds + PG8_SA(b, h) + aoff + m * 2048 + k * 1024); } while (0)
#define PG8_LDB(dst, b, h) do { _Pragma("unroll") for (int n = 0; n < 2; ++n) _Pragma("unroll") for (int k = 0; k < 2; ++k) dst[n][k] = *(const PG8_LAS bf16x8*)(lds + PG8_SB(b, h) + boff + n * 2048 + k * 1024); } while (0)
#define PG8_MMA(ai, bj, At, Bt) do { __builtin_amdgcn_s_setprio(1); _Pragma("unroll") for (int m = 0; m < 4; ++m) _Pragma("unroll") for (int n = 0; n < 2; ++n) _Pragma("unroll") for (int k = 0; k < 2; ++k) \
    acc[ai][bj][m][n] = __builtin_amdgcn_mfma_f32_16x16x32_bf16(Bt[n][k], At[m][k], acc[ai][bj][m][n], 0, 0, 0); __builtin_amdgcn_s_setprio(0); } while (0)
#define PG8_WAIT_V(n) asm volatile("s_waitcnt vmcnt(" #n ")" ::: "memory")
#define PG8_WAIT_L(n) asm volatile("s_waitcnt lgkmcnt(" #n ")" ::: "memory")
#define PG8_BAR __builtin_amdgcn_s_barrier()
#define PG8_SCHED __builtin_amdgcn_sched_barrier(0)
  Unit cur, nxt; int ui = 0;
  if (!S.next(0, cur)) return;
  f32x4 acc[2][2][4][2];
#pragma unroll
  for (int a = 0; a < 2; ++a)
#pragma unroll
    for (int b = 0; b < 2; ++b)
#pragma unroll
      for (int m = 0; m < 4; ++m)
#pragma unroll
        for (int n = 0; n < 2; ++n) acc[a][b][m][n] = (f32x4){0.f, 0.f, 0.f, 0.f};
  bf16x8 At[4][2], B0[2][2], B1[2][2];
  const char* cA = (const char*)g.A + (size_t)cur.pm * tstep; const char* cB = (const char*)g.Bt + (size_t)cur.pn * tstep;
  PG8_STAGE(PG8_SB(0, 0), cB, voffB); PG8_STAGE(PG8_SA(0, 0), cA, voffA); PG8_STAGE(PG8_SB(0, 1), cB + hstep, voffB); PG8_STAGE(PG8_SA(0, 1), cA + hstep, voffA);
  if (wr == 1) PG8_BAR;
  PG8_WAIT_V(4); PG8_BAR;
  PG8_STAGE(PG8_SB(1, 0), cB + kstep, voffB); PG8_STAGE(PG8_SA(1, 0), cA + kstep, voffA); PG8_STAGE(PG8_SB(1, 1), cB + hstep + kstep, voffB);
  PG8_WAIT_V(6); PG8_BAR;
  for (;;) {
    const bool has_next = S.next(ui + 1, nxt);
    const char* nA = has_next ? (const char*)g.A + (size_t)nxt.pm * tstep : cA; const char* nB = has_next ? (const char*)g.Bt + (size_t)nxt.pn * tstep : cB;
    for (int t = 0; t < nt; t += 2) {
      const bool last = (t == nt - 2);
      const char* a1 = cA + (size_t)(t + 1) * kstep;
      const char* a2 = last ? nA : cA + (size_t)(t + 2) * kstep; const char* b2 = last ? nB : cB + (size_t)(t + 2) * kstep;
      const char* a3 = a2 + kstep; const char* b3 = b2 + kstep;
      PG8_LDB(B0, 0, 0); PG8_SCHED; PG8_LDA(At, 0, 0); PG8_STAGE(PG8_SA(1, 1), a1 + hstep, voffA);
      PG8_WAIT_L(8); PG8_BAR; PG8_WAIT_L(0); PG8_MMA(0, 0, At, B0); PG8_BAR; PG8_SCHED;
      PG8_LDB(B1, 0, 1); PG8_STAGE(PG8_SB(0, 0), b2, voffB);
      PG8_BAR; PG8_WAIT_L(0); PG8_MMA(0, 1, At, B1); PG8_BAR;
      PG8_LDA(At, 0, 1); PG8_STAGE(PG8_SA(0, 0), a2, voffA);
      PG8_BAR; PG8_WAIT_L(0); PG8_MMA(1, 0, At, B0); PG8_BAR; PG8_SCHED;
      PG8_STAGE(PG8_SB(0, 1), b2 + hstep, voffB);
      PG8_WAIT_V(6); PG8_BAR; PG8_MMA(1, 1, At, B1); PG8_BAR;
      PG8_LDB(B0, 1, 0); PG8_SCHED; PG8_LDA(At, 1, 0); PG8_STAGE(PG8_SA(0, 1), a2 + hstep, voffA);
      PG8_WAIT_L(8); PG8_BAR; PG8_WAIT_L(0); PG8_MMA(0, 0, At, B0); PG8_BAR; PG8_SCHED;
      PG8_LDB(B1, 1, 1); PG8_STAGE(PG8_SB(1, 0), b3, voffB);
      PG8_BAR; PG8_WAIT_L(0); PG8_MMA(0, 1, At, B1); PG8_BAR;
      PG8_LDA(At, 1, 1); PG8_STAGE(PG8_SA(1, 0), a3, voffA);
      PG8_BAR; PG8_WAIT_L(0); PG8_MMA(1, 0, At, B0); PG8_BAR; PG8_SCHED;
      PG8_STAGE(PG8_SB(1, 1), b3 + hstep, voffB);
      PG8_WAIT_V(6); PG8_BAR; PG8_MMA(1, 1, At, B1); PG8_BAR;
    }
    E(acc, cur, wr, wc, fr, fq);
    if (!has_next) break;
#pragma unroll
    for (int a = 0; a < 2; ++a)
#pragma unroll
      for (int b = 0; b < 2; ++b)
#pragma unroll
        for (int m = 0; m < 4; ++m)
#pragma unroll
          for (int n = 0; n < 2; ++n) acc[a][b][m][n] = (f32x4){0.f, 0.f, 0.f, 0.f};
    cur = nxt; cA = nA; cB = nB; ++ui;
  }
  PG8_WAIT_V(0);
  if (wr == 0) PG8_BAR;
  PG8_BAR;
#undef PG8_SA
#undef PG8_SB
#undef PG8_STAGE
#undef PG8_LDA
#undef PG8_LDB
#undef PG8_MMA
#undef PG8_WAIT_V
#undef PG8_WAIT_L
#undef PG8_BAR
#undef PG8_SCHED
}
}

template <class F> struct EpiAd {
  F f;
  __device__ __forceinline__ void operator()(const f32x4 (&acc)[2][2][4][2], const pg8::Unit& u, int wr, int wc, int fr, int fq) const {
#pragma unroll
    for (int ai = 0; ai < 2; ++ai)
#pragma unroll
      for (int m = 0; m < 4; ++m) { const int row = u.pm * 256 + ai * 128 + wr * 64 + m * 16 + fr;
#pragma unroll
        for (int bj = 0; bj < 2; ++bj)
#pragma unroll
          for (int n = 0; n < 2; ++n) f(row, u.pn * 256 + bj * 128 + wc * 32 + n * 16 + 4 * fq, acc[ai][bj][m][n]); }
  }
};
template <class F> __device__ __forceinline__ void big_gemm(char* smem, const bfr* A, const bfr* Bt, int N, int K, F f) {
  pg8::Gemm g; g.A = A; g.Bt = Bt; g.M = R_; g.N = N; g.K = K;
  pg8::StaticOrder S; S.init(R_, N, (int)gridDim.x, (int)blockIdx.x);
  EpiAd<F> E{f};
  pg8::gemm_phase(( __attribute__((address_space(3))) unsigned char*)smem, g, S, E);
}
struct F_LruIn { char* ACT; __device__ __forceinline__ void operator()(int row, int n, f32x4 v) const {
  bfr* dst = n < 1280 ? (bfr*)(ACT + A_U) + (size_t)row * 1280 + n : (bfr*)(ACT + A_Z) + (size_t)row * 1280 + (n - 1280); store4b(dst, v); } };
struct F_Resid { float* Xx; float* Xc; const float* MODg; int wc; __device__ __forceinline__ void operator()(int row, int n, f32x4 v) const {
  int b = row / BT_, o = row - b * BT_; bool isc = o < 256; if (isc && !wc) return;
  float* xr = isc ? Xc + (size_t)(b * 256 + o) * 1024 : Xx + (size_t)(b * 16384 + o - 256) * 1024; const float* g = MODg + (size_t)(isc ? 2 : b) * 3072 + 2048;
  float4 xv = *(float4*)(xr + n); float4 gg = *(const float4*)(g + n);
  xv.x += gg.x * v[0]; xv.y += gg.y * v[1]; xv.z += gg.z * v[2]; xv.w += gg.w * v[3]; *(float4*)(xr + n) = xv; } };
struct F_MlIn { char* ACT; __device__ __forceinline__ void operator()(int row, int n, f32x4 v) const {
  if (n < 4096) store4b((bfr*)(ACT + A_QKV) + (size_t)row * 4096 + n, v);
  else if (n < 4128) *(float4*)((float*)(ACT + A_GATE) + (size_t)row * 32 + (n - 4096)) = float4{v[0], v[1], v[2], v[3]}; } };
struct F_MlZ { char* ACT; const float* ng; __device__ __forceinline__ void operator()(int row, int n, f32x4 v) const {
  bfr* hp = (bfr*)(ACT + A_HS) + (size_t)row * 2048 + n; uint2 u = *(const uint2*)hp; float rs = ((const float*)(ACT + A_RSTD))[(size_t)row * 8 + (n >> 8)];
  float4 g4 = *(const float4*)(ng + n); f32x4 o;
  o[0] = blo(u.x) * rs * g4.x * siluf(v[0]); o[1] = bhi(u.x) * rs * g4.y * siluf(v[1]); o[2] = blo(u.y) * rs * g4.z * siluf(v[2]); o[3] = bhi(u.y) * rs * g4.w * siluf(v[3]);
  store4b(hp, o); } };
struct F_R7In { char* ACT; __device__ __forceinline__ void operator()(int row, int n, f32x4 v) const {
  if (n < 4096) store4b((bfr*)(ACT + A_RKVZ) + (size_t)row * 4096 + n, v);
  else if (n < 4224) { f32x4 t;
#pragma unroll
    for (int q = 0; q < 4; q++) t[q] = tanhf(v[q]);
    store4b((bfr*)(ACT + A_WM) + (size_t)row * 128 + (n - 4096), t); }
  else store4b((bfr*)(ACT + A_AM) + (size_t)row * 128 + (n - 4224), v); } };

template <class G> __device__ __forceinline__ void gemm_phase(const P& p, const Ctx& c, char* smem) {
  const int total = 130 * G::NT;
  for (int it = blockIdx.x; it < total; it += gridDim.x) gemm_tile<G>(p, c, it / G::NT, it % G::NT, smem);
}

__device__ __forceinline__ void ph_pre(const P& p, char* smem) {
  float* sm = (float*)smem; const int tid = ltid();
  const int nprep = prep_count(0), ngemv = 192, ncopy = 4160;
  for (int it = blockIdx.x; it < nprep + ngemv + ncopy; it += gridDim.x) {
    if (it < nprep) { prep_item(p, 0, it, sm); continue; }
    int i2 = it - nprep;
    if (i2 < ngemv) {
      int l = i2 / 48, cgp = i2 % 48;
      for (int i = tid; i < 3072; i += 512) { int cnd = i >> 10, k = i & 1023; float v = cnd == 0 ? p.c[k] : cnd == 1 ? p.c[1024 + k] : p.c_ctx[k]; sm[i] = siluf(v); }
      __syncthreads();
      int kq = tid >> 6, col = cgp * 64 + (tid & 63); const float* w = p.mod_w + (size_t)l * 1024 * 3072 + col;
      float a0 = 0.f, a1 = 0.f, a2 = 0.f;
      for (int k = kq * 128; k < kq * 128 + 128; k++) { float wv = w[(size_t)k * 3072]; a0 += sm[k] * wv; a1 += sm[1024 + k] * wv; a2 += sm[2048 + k] * wv; }
      float* red = sm + 3072; red[tid * 3] = a0; red[tid * 3 + 1] = a1; red[tid * 3 + 2] = a2;
      __syncthreads();
      if (tid < 64) { float bias = p.mod_b[(size_t)l * 3072 + col];
        for (int cnd = 0; cnd < 3; cnd++) { float s = bias; for (int q = 0; q < 8; q++) s += red[(q * 64 + tid) * 3 + cnd]; p.MOD[(size_t)(l * 3 + cnd) * 3072 + col] = s; } }
      __syncthreads();
      continue;
    }
    i2 -= ngemv;
    for (int q = 0; q < 4; q++) { int idx = i2 * 2048 + q * 512 + tid; int row = idx >> 8, c4 = idx & 255; int b = row / BT_, o = row - b * BT_;
      if (o < 256) ((float4*)p.Xc)[(size_t)(b * 256 + o) * 256 + c4] = ((const float4*)p.ctx)[(size_t)(b * 256 + o) * 256 + c4];
      else ((float4*)p.Xx)[(size_t)(b * 16384 + o - 256) * 256 + c4] = ((const float4*)p.x)[(size_t)(b * 16384 + o - 256) * 256 + c4]; }
  }
}
__device__ __forceinline__ void ph_norm(const P& p, int layer, char* smem) {
  const int tid = ltid(), lane = tid & 63, wid = tid >> 6;
  const int nprep = layer > 0 ? prep_count(layer) : 0; const int kind = layer % 3;
  const int nzero = kind == 1 ? 8320 : 0;
  (void)nzero;
  for (int it = blockIdx.x; it < nprep + 4160; it += gridDim.x) {
    if (it < nprep) { prep_item(p, layer, it, (float*)smem); continue; }
    int row = (it - nprep) * 8 + wid; int mo; const float* xr = xrowp(p, row, mo);
    float4 v[4]; float ss = 0.f;
#pragma unroll
    for (int i = 0; i < 4; i++) { v[i] = *(const float4*)(xr + lane * 4 + 256 * i); ss += v[i].x * v[i].x + v[i].y * v[i].y + v[i].z * v[i].z + v[i].w * v[i].w; }
    ss = wsum(ss); float rs = rsqrtf(ss * (1.f / 1024.f) + 1e-6f);
    const float* g = p.norm_g + (size_t)layer * 1024; const float* md = p.MOD + (size_t)(layer * 3 + mo) * 3072;
#pragma unroll
    for (int i = 0; i < 4; i++) { int cidx = lane * 4 + 256 * i; float4 gg = *(const float4*)(g + cidx), sh = *(const float4*)(md + cidx), sc = *(const float4*)(md + 1024 + cidx);
      f32x4 o; o[0] = v[i].x * rs * gg.x * (1.f + sc.x) + sh.x; o[1] = v[i].y * rs * gg.y * (1.f + sc.y) + sh.y; o[2] = v[i].z * rs * gg.z * (1.f + sc.z) + sh.z; o[3] = v[i].w * rs * gg.w * (1.f + sc.w) + sh.w;
      store4b(p.H + (size_t)row * (kind == 2 ? 2048 : 1024) + cidx, o); }
  }
}
__device__ __forceinline__ void ph_r7_shift(const P& p) {
  for (int it = blockIdx.x; it < 8320; it += gridDim.x) {
    int idx = it * 512 + ltid(); int row = idx >> 7, c8 = idx & 127, q = c8 >> 5;
    int b = row / BT_, o = row - b * BT_; int nr = -1;
    if (o < 256) { if (q < 2) { if (o >= 1) nr = row - 1; } else { if (o < 255) nr = row + 1; } }
    else { int t = o - 256, col = t & 63, gr = t >> 6;
      if (q == 0) { if (col != 0) nr = row - 1; } else if (q == 1) { if (col != 63) nr = row + 1; }
      else if (q == 2) { if (gr != 0) nr = row - 64; } else { if (gr != 255) nr = row + 64; } }
    uint4 v = nr >= 0 ? *(const uint4*)(p.H + (size_t)nr * 2048 + c8 * 8) : uint4{0u, 0u, 0u, 0u};
    *(uint4*)(p.H + (size_t)row * 2048 + 1024 + c8 * 8) = v;
  }
}
__device__ __forceinline__ void ph_final(const P& p) {
  const int lane = ltid() & 63, wid = ltid() >> 6;
  for (int it = blockIdx.x; it < 4096; it += gridDim.x) {
    float* xr = p.Xx + (size_t)(it * 8 + wid) * 1024; float4 v[4]; float ss = 0.f;
#pragma unroll
    for (int i = 0; i < 4; i++) { v[i] = *(const float4*)(xr + lane * 4 + 256 * i); ss += v[i].x * v[i].x + v[i].y * v[i].y + v[i].z * v[i].z + v[i].w * v[i].w; }
    ss = wsum(ss); float rs = rsqrtf(ss * (1.f / 1024.f) + 1e-6f);
#pragma unroll
    for (int i = 0; i < 4; i++) { int cidx = lane * 4 + 256 * i; float4 gg = *(const float4*)(p.final_g + cidx);
      *(float4*)(xr + cidx) = float4{v[i].x * rs * gg.x, v[i].y * rs * gg.y, v[i].z * rs * gg.z, v[i].w * rs * gg.w}; }
  }
}
__device__ __forceinline__ void ph_lru_conv(const P& p, int j) {
  const bfr* U = (const bfr*)(p.ACT + A_U); bfr* UC = (bfr*)(p.ACT + A_UC);
  const float* cw = p.lru_conv_w + (size_t)j * 4 * 1280; const float* cb = p.lru_conv_b + (size_t)j * 1280;
  for (int it = blockIdx.x; it < 10400; it += gridDim.x) {
    int idx = it * 512 + ltid(); int row = idx / 160, cgp = idx % 160, ch = cgp * 8;
    int b = row / BT_, o = row - b * BT_; int s0 = o < 256 ? 0 : 256, e0 = o < 256 ? 256 : BT_;
    float acc[8];
#pragma unroll
    for (int e = 0; e < 8; e++) acc[e] = cb[ch + e];
#pragma unroll
    for (int t = 0; t < 4; t++) { int oo = o + t - 2; if (oo < s0 || oo >= e0) continue;
      uint4 u = *(const uint4*)(U + (size_t)(row + t - 2) * 1280 + ch); const float* w = cw + t * 1280 + ch;
      acc[0] += w[0] * blo(u.x); acc[1] += w[1] * bhi(u.x); acc[2] += w[2] * blo(u.y); acc[3] += w[3] * bhi(u.y);
      acc[4] += w[4] * blo(u.z); acc[5] += w[5] * bhi(u.z); acc[6] += w[6] * blo(u.w); acc[7] += w[7] * bhi(u.w); }
    *(uint4*)(UC + (size_t)row * 1280 + ch) = uint4{pk2(acc[0], acc[1]), pk2(acc[2], acc[3]), pk2(acc[4], acc[5]), pk2(acc[6], acc[7])};
  }
}
__device__ __forceinline__ void ph_lru_s1(const P& p, int d) {
  const unsigned* AB = (const unsigned*)(p.ACT + A_AB); float2* AGG = (float2*)(p.ACT + A_AGG);
  const int t = ltid();
  for (int it = blockIdx.x * 8 + (t >> 6); it < 2600; it += gridDim.x * 8) {
    int b = it / 1300, r = it % 1300, cc = r / 5, ch = (r % 5) * 256 + (t & 63) * 4;
    float P0 = 1.f, Q0 = 0.f, P1 = 1.f, Q1 = 0.f, P2 = 1.f, Q2 = 0.f, P3 = 1.f, Q3 = 0.f;
#pragma unroll 8
    for (int q = 0; q < 64; q++) { uint4 u = *(const uint4*)(AB + (size_t)rowmap(d, b, cc * 64 + q) * 1280 + ch);
      float a0 = 1.f - bhi(u.x), a1 = 1.f - bhi(u.y), a2 = 1.f - bhi(u.z), a3 = 1.f - bhi(u.w);
      P0 *= a0; Q0 = a0 * Q0 + blo(u.x); P1 *= a1; Q1 = a1 * Q1 + blo(u.y); P2 *= a2; Q2 = a2 * Q2 + blo(u.z); P3 *= a3; Q3 = a3 * Q3 + blo(u.w); }
    float4* ag = (float4*)(AGG + (size_t)(b * NCH_ + cc) * 1280 + ch); ag[0] = float4{P0, Q0, P1, Q1}; ag[1] = float4{P2, Q2, P3, Q3};
  }
}
__device__ __forceinline__ void ph_lru_s2(const P& p) {
  const float2* AGG = (const float2*)(p.ACT + A_AGG); float* CAR = (float*)(p.ACT + A_CAR);
  for (int it = blockIdx.x; it < 5; it += gridDim.x) {
    int idx = it * 512 + ltid(), b = idx / 1280, ch = idx % 1280; float h = 0.f;
#pragma unroll 20
    for (int cc = 0; cc < NCH_; cc++) { size_t o = (size_t)(b * NCH_ + cc) * 1280 + ch; float2 a = AGG[o]; CAR[o] = h; h = a.x * h + a.y; }
  }
}
__device__ __forceinline__ void ph_lru_s3(const P& p, int d) {
  const unsigned* AB = (const unsigned*)(p.ACT + A_AB); const float* CAR = (const float*)(p.ACT + A_CAR);
  bfr* HF = (bfr*)(p.ACT + A_HF); bfr* Z = (bfr*)(p.ACT + A_Z);
  const int t = ltid();
  for (int it = blockIdx.x * 8 + (t >> 6); it < 2600; it += gridDim.x * 8) {
    int b = it / 1300, r = it % 1300, cc = r / 5, ch = (r % 5) * 256 + (t & 63) * 4;
    float4 h = *(const float4*)(CAR + (size_t)(b * NCH_ + cc) * 1280 + ch);
#pragma unroll 8
    for (int q = 0; q < 64; q++) { size_t o = (size_t)rowmap(d, b, cc * 64 + q) * 1280 + ch; uint4 u = *(const uint4*)(AB + o);
      h.x = (1.f - bhi(u.x)) * h.x + blo(u.x); h.y = (1.f - bhi(u.y)) * h.y + blo(u.y); h.z = (1.f - bhi(u.z)) * h.z + blo(u.z); h.w = (1.f - bhi(u.w)) * h.w + blo(u.w);
      if (d == 0) *(uint2*)(HF + o) = uint2{pk2(h.x, h.y), pk2(h.z, h.w)};
      else { uint2 hf = *(const uint2*)(HF + o), zz = *(const uint2*)(Z + o);
        *(uint2*)(Z + o) = uint2{pk2((blo(hf.x) + h.x) * siluf(blo(zz.x)), (bhi(hf.x) + h.y) * siluf(bhi(zz.x))), pk2((blo(hf.y) + h.z) * siluf(blo(zz.y)), (bhi(hf.y) + h.w) * siluf(bhi(zz.y)))}; } }
  }
}
__device__ __forceinline__ void ph_ml_stat(const P& p) {
  const bfr* HS = (const bfr*)(p.ACT + A_HS); float* RS = (float*)(p.ACT + A_RSTD);
  const int lane = ltid() & 63, wid = ltid() >> 6;
  for (int it = blockIdx.x; it < 4160; it += gridDim.x) {
    int row = it * 8 + wid; const bfr* hp = HS + (size_t)row * 2048 + lane * 32; float ss = 0.f;
#pragma unroll
    for (int i = 0; i < 4; i++) { uint4 u = *(const uint4*)(hp + i * 8); float a;
      a = blo(u.x); ss += a * a; a = bhi(u.x); ss += a * a; a = blo(u.y); ss += a * a; a = bhi(u.y); ss += a * a;
      a = blo(u.z); ss += a * a; a = bhi(u.z); ss += a * a; a = blo(u.w); ss += a * a; a = bhi(u.w); ss += a * a; }
    ss += __shfl_xor(ss, 1); ss += __shfl_xor(ss, 2); ss += __shfl_xor(ss, 4);
    if ((lane & 7) == 0) RS[(size_t)row * 8 + (lane >> 3)] = rsqrtf(ss * (1.f / 256.f) + 1e-6f);
  }
}
__device__ __forceinline__ void ph_r7_fin(const P& p, int j) {
  bfr* Y = (bfr*)(p.ACT + A_Y); const bfr* RK = (const bfr*)(p.ACT + A_RKVZ); const float* BON = (const float*)(p.ACT + A_BON);
  const float* lg = p.r7_ln_g + (size_t)j * 1024; const float* lb = p.r7_ln_b + (size_t)j * 1024;
  const int lane = ltid() & 63, wid = ltid() >> 6;
  for (int it = blockIdx.x; it < 4160; it += gridDim.x) {
    int row = it * 8 + wid, ch = lane * 16, hd = lane >> 2;
    float y[16], v[16], z[16];
#pragma unroll
    for (int i = 0; i < 2; i++) {
      uint4 u = *(const uint4*)(Y + (size_t)row * 1024 + ch + i * 8);
      y[i * 8 + 0] = blo(u.x); y[i * 8 + 1] = bhi(u.x); y[i * 8 + 2] = blo(u.y); y[i * 8 + 3] = bhi(u.y); y[i * 8 + 4] = blo(u.z); y[i * 8 + 5] = bhi(u.z); y[i * 8 + 6] = blo(u.w); y[i * 8 + 7] = bhi(u.w);
      u = *(const uint4*)(RK + (size_t)row * 4096 + 2048 + ch + i * 8);
      v[i * 8 + 0] = blo(u.x); v[i * 8 + 1] = bhi(u.x); v[i * 8 + 2] = blo(u.y); v[i * 8 + 3] = bhi(u.y); v[i * 8 + 4] = blo(u.z); v[i * 8 + 5] = bhi(u.z); v[i * 8 + 6] = blo(u.w); v[i * 8 + 7] = bhi(u.w);
      u = *(const uint4*)(RK + (size_t)row * 4096 + 3072 + ch + i * 8);
      z[i * 8 + 0] = blo(u.x); z[i * 8 + 1] = bhi(u.x); z[i * 8 + 2] = blo(u.y); z[i * 8 + 3] = bhi(u.y); z[i * 8 + 4] = blo(u.z); z[i * 8 + 5] = bhi(u.z); z[i * 8 + 6] = blo(u.w); z[i * 8 + 7] = bhi(u.w);
    }
    float s = 0.f;
#pragma unroll
    for (int e = 0; e < 16; e++) s += y[e];
    s += __shfl_xor(s, 1); s += __shfl_xor(s, 2); float mean = s * (1.f / 64.f);
    float q = 0.f;
#pragma unroll
    for (int e = 0; e < 16; e++) { float dlt = y[e] - mean; q += dlt * dlt; }
    q += __shfl_xor(q, 1); q += __shfl_xor(q, 2); float rs = rsqrtf(q * (1.f / 64.f) + 64e-5f);
    float bon = BON[(size_t)row * 16 + hd] + BON[(size_t)(R_ + row) * 16 + hd];
    float o[16];
#pragma unroll
    for (int e = 0; e < 16; e++) { float yn = (y[e] - mean) * rs * lg[ch + e] + lb[ch + e]; o[e] = (yn + bon * v[e]) * siluf(z[e]); }
#pragma unroll
    for (int i = 0; i < 2; i++)
      *(uint4*)(Y + (size_t)row * 1024 + ch + i * 8) = uint4{pk2(o[i * 8], o[i * 8 + 1]), pk2(o[i * 8 + 2], o[i * 8 + 3]), pk2(o[i * 8 + 4], o[i * 8 + 5]), pk2(o[i * 8 + 6], o[i * 8 + 7])};
  }
}

#define QS 136
#define VS 72
#define MLG_BYTES 45056
__device__ __forceinline__ void ph_ml_scan(const P& p, int j, char* smem0) {
  const int d = ltid() >> 8;
  char* smem = smem0 + d * MLG_BYTES;
  bfr* sQ = (bfr*)smem; bfr* sK = sQ + 64 * QS; bfr* sVT = sK + 64 * QS; bfr* sCT = sVT + 16 * VS;
  float* sN = (float*)(sCT + 16 * QS);
  float* sEs = sN + 128; float* sCt = sEs + 64; float* sBc = sCt + 64; float* sWg = sBc + 64; float* sNr = sWg + 64;
  const bfr* QKV = (const bfr*)(p.ACT + A_QKV); const float* GT = (const float*)(p.ACT + A_GATE); bfr* HS = (bfr*)(p.ACT + A_HS);
  const float* gbias = p.ml_gate_b + (size_t)j * 32;
  const int tid = ltid() & 255, lane = tid & 63, w = tid >> 6, l15 = lane & 15, q4 = lane >> 4;
  for (int it = blockIdx.x; it < 256; it += gridDim.x) {
    const int b = it >> 7, hh = (it >> 4) & 7, sl = it & 15;
    f32x4 Cacc[2];
    Cacc[0] = f32x4{0.f, 0.f, 0.f, 0.f}; Cacc[1] = f32x4{0.f, 0.f, 0.f, 0.f};
    float mcur = 0.f;
    for (int i = tid; i < 16 * QS; i += 256) sCT[i] = 0;
    if (tid < 128) sN[tid] = 0.f;
    uint4 pq0, pq1, pq2, pq3, pk0, pk1, pk2, pk3, pv = uint4{0u, 0u, 0u, 0u}; float pgi, pgf;
#define ML_ROW0(s_) (d == 0 ? b * BT_ + 64 * (s_) : rowmap(1, b, 64 * (s_) + 63))
#define ML_LD(i_, PQ, PK) { int idx = tid + 256 * (i_), rho = idx >> 4, c8 = idx & 15; const bfr* src = QKV + (size_t)(r0n + rho) * 4096 + hh * 128 + c8 * 8; PQ = *(const uint4*)src; PK = *(const uint4*)(src + 1024); }
#define ML_ISSUE(s_) { const int r0n = ML_ROW0(s_); ML_LD(0, pq0, pk0) ML_LD(1, pq1, pk1) ML_LD(2, pq2, pk2) ML_LD(3, pq3, pk3) \
      if (tid < 128) pv = *(const uint4*)(QKV + (size_t)(r0n + (tid >> 1)) * 4096 + 2048 + hh * 256 + sl * 16 + (tid & 1) * 8); \
      { const float* gp_ = GT + (size_t)(r0n + (d ? 63 - lane : lane)) * 32 + d * 16 + hh; pgi = gp_[0]; pgf = gp_[8]; } }
#define ML_ST(i_, PQ, PK) { int idx = tid + 256 * (i_), rho = idx >> 4, c8 = idx & 15; *(uint4*)(sQ + rho * QS + c8 * 8) = PQ; *(uint4*)(sK + rho * QS + c8 * 8) = PK; }
#define ML_COMMIT() { ML_ST(0, pq0, pk0) ML_ST(1, pq1, pk1) ML_ST(2, pq2, pk2) ML_ST(3, pq3, pk3) \
      if (tid < 128) { int rho = tid >> 1, vb = (tid & 1) * 8; \
        sVT[(vb + 0) * VS + rho] = (bfr)(pv.x & 0xffff); sVT[(vb + 1) * VS + rho] = (bfr)(pv.x >> 16); \
        sVT[(vb + 2) * VS + rho] = (bfr)(pv.y & 0xffff); sVT[(vb + 3) * VS + rho] = (bfr)(pv.y >> 16); \
        sVT[(vb + 4) * VS + rho] = (bfr)(pv.z & 0xffff); sVT[(vb + 5) * VS + rho] = (bfr)(pv.z >> 16); \
        sVT[(vb + 6) * VS + rho] = (bfr)(pv.w & 0xffff); sVT[(vb + 7) * VS + rho] = (bfr)(pv.w >> 16); } }
    ML_ISSUE(0)
    __syncthreads();
    for (int s = 0; s < NCH_; s++) {
      const int r0 = ML_ROW0(s);
      ML_COMMIT()
      float mxl, decay;
      {
        int rho = d ? 63 - lane : lane;
        float gi = pgi + gbias[(d * 2 + 0) * 8 + hh], gf = pgf + gbias[(d * 2 + 1) * 8 + hh];
        float fc = fminf(gf, 0.f) - log1pf(__expf(-fabsf(gf)));
        float bc = fc;
        for (int o = 1; o < 64; o <<= 1) { float t = __shfl_up(bc, o); if (lane >= o) bc += t; }
        float e = gi - bc, pm = e;
        for (int o = 1; o < 64; o <<= 1) { float t = __shfl_up(pm, o); if (lane >= o) pm = fmaxf(pm, t); }
        float pml = __shfl(pm, 63), bcl = __shfl(bc, 63);
        mxl = fmaxf(mcur, pml); decay = __expf(mcur - mxl);
        if (w == 0) { sEs[rho] = e; sCt[rho] = -fmaxf(mcur, pm); sBc[rho] = bc; sWg[rho] = __expf(e - mxl); }
        pml = bcl + mxl;
        bcl = mcur; mcur = pml; pml = bcl;
        mxl = pml;
      }
      const float mold = mxl;
      __syncthreads();
      const int rt = 16 * w + l15;
      bfr* hp = HS + (size_t)(r0 + rt) * 2048 + hh * 256 + sl * 16 + 4 * q4;
      bool first; { int rc = (r0 - b * BT_) >> 6; if (d == 0) { int sp = rc < 4 ? 3 - rc : 263 - rc; first = s < sp; } else first = s < rc; }
      unsigned long long uu = 0ull;
      if (!first) uu = __hip_atomic_load((unsigned long long*)hp, __ATOMIC_RELAXED, __HIP_MEMORY_SCOPE_AGENT);
      if (s + 1 < NCH_) ML_ISSUE(s + 1)
      bf16x8 qf[4];
#pragma unroll
      for (int ks = 0; ks < 4; ks++) qf[ks] = *(const bf16x8*)(sQ + (16 * w + l15) * QS + ks * 32 + q4 * 8);
      f32x4 sacc[4];
#pragma unroll
      for (int a = 0; a < 4; a++) { sacc[a] = f32x4{0.f, 0.f, 0.f, 0.f};
#pragma unroll
        for (int ks = 0; ks < 4; ks++) { bf16x8 kf = *(const bf16x8*)(sK + (16 * a + l15) * QS + ks * 32 + q4 * 8); sacc[a] = __builtin_amdgcn_mfma_f32_16x16x32_bf16(kf, qf[ks], sacc[a], 0, 0, 0); } }
      const float ctt = sCt[rt]; float densum = 0.f;
#pragma unroll
      for (int a = 0; a < 4; a++)
#pragma unroll
        for (int jj = 0; jj < 4; jj++) { int rs_ = 16 * a + 4 * q4 + jj; bool valid = d == 0 ? rs_ <= rt : rs_ >= rt;
          float wv = valid ? __expf(ctt + sEs[rs_]) : 0.f; float sv = sacc[a][jj] * wv; sacc[a][jj] = sv; densum += sv; }
      densum += __shfl_xor(densum, 16); densum += __shfl_xor(densum, 32);
      bf16x8 sf[2], vf[2];
#pragma unroll
      for (int ks = 0; ks < 2; ks++) {
#pragma unroll
        for (int jj = 0; jj < 4; jj++) { sf[ks][jj] = (short)f2b(sacc[2 * ks][jj]); sf[ks][4 + jj] = (short)f2b(sacc[2 * ks + 1][jj]); }
        uint2 v0 = *(const uint2*)(sVT + l15 * VS + 32 * ks + 4 * q4), v1 = *(const uint2*)(sVT + l15 * VS + 32 * ks + 16 + 4 * q4);
        uint4 vv = uint4{v0.x, v0.y, v1.x, v1.y}; vf[ks] = *(bf16x8*)&vv;
      }
      f32x4 num = f32x4{0.f, 0.f, 0.f, 0.f}, numC = f32x4{0.f, 0.f, 0.f, 0.f};
#pragma unroll
      for (int ks = 0; ks < 2; ks++) num = __builtin_amdgcn_mfma_f32_16x16x32_bf16(vf[ks], sf[ks], num, 0, 0, 0);
#pragma unroll
      for (int ks = 0; ks < 4; ks++) { bf16x8 cf = *(const bf16x8*)(sCT + l15 * QS + ks * 32 + q4 * 8); numC = __builtin_amdgcn_mfma_f32_16x16x32_bf16(cf, qf[ks], numC, 0, 0, 0); }
      float qn = 0.f;
#pragma unroll
      for (int i = 0; i < 4; i++) { uint4 u = *(const uint4*)(sQ + rt * QS + 32 * q4 + i * 8); const float* nn = sN + 32 * q4 + i * 8;
        qn += blo(u.x) * nn[0] + bhi(u.x) * nn[1] + blo(u.y) * nn[2] + bhi(u.y) * nn[3] + blo(u.z) * nn[4] + bhi(u.z) * nn[5] + blo(u.w) * nn[6] + bhi(u.w) * nn[7]; }
      qn += __shfl_xor(qn, 16); qn += __shfl_xor(qn, 32);
      {
        float inter = __expf(mold + ctt); float den = densum + inter * qn; float dn = fmaxf(fabsf(den), __expf(ctt - sBc[rt])); float inv = 1.f / dn;
        f32x4 hv;
#pragma unroll
        for (int jj = 0; jj < 4; jj++) hv[jj] = (num[jj] + inter * numC[jj]) * inv;
        if (!first) { unsigned ux = (unsigned)uu, uy = (unsigned)(uu >> 32);
          hv[0] += blo(ux); hv[1] += bhi(ux); hv[2] += blo(uy); hv[3] += bhi(uy); }
        store4b(hp, hv);
      }
      __syncthreads();
      {
        bf16x8 vw[2];
#pragma unroll
        for (int ks = 0; ks < 2; ks++)
#pragma unroll
          for (int e = 0; e < 8; e++) { int rs_ = 32 * ks + (e < 4 ? 4 * q4 + e : 16 + 4 * q4 + e - 4); vw[ks][e] = (short)f2b(b2f((bfr)vf[ks][e]) * sWg[rs_]); }
#pragma unroll
        for (int a = 0; a < 2; a++) {
          int dk = 32 * w + 16 * a + l15;
#pragma unroll
          for (int jj = 0; jj < 4; jj++) Cacc[a][jj] *= decay;
#pragma unroll
          for (int ks = 0; ks < 2; ks++) { bf16x8 kt;
#pragma unroll
            for (int e = 0; e < 8; e++) { int rs_ = 32 * ks + (e < 4 ? 4 * q4 + e : 16 + 4 * q4 + e - 4); kt[e] = (short)sK[rs_ * QS + dk]; }
            Cacc[a] = __builtin_amdgcn_mfma_f32_16x16x32_bf16(vw[ks], kt, Cacc[a], 0, 0, 0); }
#pragma unroll
          for (int jj = 0; jj < 4; jj++) sCT[(4 * q4 + jj) * QS + dk] = f2b(Cacc[a][jj]);
        }
        int dk = tid & 127, hf = tid >> 7; float part = 0.f;
#pragma unroll 8
        for (int r = 0; r < 32; r++) part += sWg[32 * hf + r] * b2f(sK[(32 * hf + r) * QS + dk]);
        sNr[tid] = part;
      }
      __syncthreads();
      if (tid < 128) sN[tid] = decay * sN[tid] + sNr[tid] + sNr[128 + tid];
    }
    __syncthreads();
  }
}

#define CS 72
#define CSLOT(i_) ((bfr*)smem + (i_) * (64 * CS))
#define A_SST (A_R7B + 362086400ull)
__device__ __forceinline__ f32x4 cmm(const bfr* X, const bfr* YT, int ti, int tj, int l15, int q4) {
  f32x4 acc = f32x4{0.f, 0.f, 0.f, 0.f};
#pragma unroll
  for (int ks = 0; ks < 2; ks++) { bf16x8 a = *(const bf16x8*)(X + (16 * ti + l15) * CS + 32 * ks + 8 * q4); bf16x8 b = *(const bf16x8*)(YT + (16 * tj + l15) * CS + 32 * ks + 8 * q4);
    acc = __builtin_amdgcn_mfma_f32_16x16x32_bf16(a, b, acc, 0, 0, 0); }
  return acc;
}
template <int MODE> __device__ __forceinline__ f32x4 cmm_mask(const bfr* X, const bfr* YT, int ti, int tj, int l15, int q4) {
  f32x4 acc = f32x4{0.f, 0.f, 0.f, 0.f};
#pragma unroll
  for (int ks = 0; ks < 2; ks++) { const int kb = 2 * ks + (q4 >> 1);
    const bool ok = MODE == 1 ? ((kb == 0 && tj == 1) || (kb == 2 && tj == 3)) : (kb < 2 && tj >= 2);
    bf16x8 a = *(const bf16x8*)(X + (16 * ti + l15) * CS + 32 * ks + 8 * q4); bf16x8 bz = bf16x8{0, 0, 0, 0, 0, 0, 0, 0};
    if (ok) bz = *(const bf16x8*)(YT + (16 * tj + l15) * CS + 32 * ks + 8 * q4);
    acc = __builtin_amdgcn_mfma_f32_16x16x32_bf16(a, bz, acc, 0, 0, 0); }
  return acc;
}
__device__ __forceinline__ void st_row(bfr* dst, int r0, int c, f32x4 v) {
#pragma unroll
  for (int jj = 0; jj < 4; jj++) dst[(r0 + jj) * CS + c] = f2b(v[jj]); }
__device__ __forceinline__ void st_tr(bfr* dst, int r0, int c, f32x4 v) { store4b(dst + c * CS + r0, v); }
__device__ __forceinline__ f32x4 ld_row(const bfr* src, int r0, int c) { f32x4 v;
#pragma unroll
  for (int jj = 0; jj < 4; jj++) v[jj] = b2f(src[(r0 + jj) * CS + c]);
  return v; }
__device__ __forceinline__ f32x4 ld_tr(const bfr* src, int r0, int c) { uint2 u = *(const uint2*)(src + c * CS + r0); return f32x4{blo(u.x), bhi(u.x), blo(u.y), bhi(u.y)}; }

__device__ __forceinline__ void ph_r7_ca(const P& p, int j, int win, char* smem) {
  float* LW = (float*)(smem + 7 * 9216); float* AT = (float*)(smem + 9 * 9216); float* WL = (float*)(smem + 14 * 9216);
  const bfr* RK = (const bfr*)(p.ACT + A_RKVZ); const bfr* WMb = (const bfr*)(p.ACT + A_WM); const bfr* AMb = (const bfr*)(p.ACT + A_AM);
  float* BON = (float*)(p.ACT + A_BON); bfr* WB = p.H;
  const float* kkp = p.r7_k_k + (size_t)j * 1024; const float* kap = p.r7_k_a + (size_t)j * 1024; const float* rkp = p.r7_r_k + (size_t)j * 1024;
  const int tid = ltid(), lane = tid & 63, w = tid >> 6, l15 = lane & 15, q4 = lane >> 4, ti = w >> 1, tj0 = (w & 1) * 2;
  const int c0 = win * 65;
  for (int it = blockIdx.x; it < 4160; it += gridDim.x) {
    const int chain = it / 65, cl = it - chain * 65, c = c0 + cl, d = chain & 1, b = chain >> 5, h = (chain >> 1) & 15;
    {
      const int rowA = rowmap(d, b, 64 * c + 16 * ti + l15);
      const float* w0 = p.r7_w0 + (size_t)(j * 2 + d) * 1024 + h * 64; const float* a0 = p.r7_a0 + (size_t)(j * 2 + d) * 1024 + h * 64;
#pragma unroll
      for (int tt = 0; tt < 2; tt++) { const int tj = tj0 + tt; f32x4 aw = f32x4{0.f, 0.f, 0.f, 0.f}, aa = aw;
#pragma unroll
        for (int ks = 0; ks < 2; ks++) {
          bf16x8 xw = *(const bf16x8*)(WMb + (size_t)rowA * 128 + d * 64 + 32 * ks + 8 * q4), xa = *(const bf16x8*)(AMb + (size_t)rowA * 128 + d * 64 + 32 * ks + 8 * q4);
          bf16x8 yw = *(const bf16x8*)(p.W + WR_UP + d * 65536 + (size_t)(h * 64 + 16 * tj + l15) * 64 + 32 * ks + 8 * q4);
          bf16x8 ya = *(const bf16x8*)(p.W + WR_UP + (2 + d) * 65536 + (size_t)(h * 64 + 16 * tj + l15) * 64 + 32 * ks + 8 * q4);
          aw = __builtin_amdgcn_mfma_f32_16x16x32_bf16(xw, yw, aw, 0, 0, 0); aa = __builtin_amdgcn_mfma_f32_16x16x32_bf16(xa, ya, aa, 0, 0, 0); }
        const int ch = 16 * tj + l15; const float w0v = w0[ch], a0v = a0[ch];
#pragma unroll
        for (int jj = 0; jj < 4; jj++) { const int tau = 16 * ti + 4 * q4 + jj; LW[tau * 64 + ch] = -0.6065306597126334f * sigm(w0v + aw[jj]); AT[tau * 64 + ch] = sigm(a0v + aa[jj]); }
      }
    }
    __syncthreads();
    if (tid < 64) { float acc = 0.f;
#pragma unroll 8
      for (int t = 0; t < 64; t++) { acc += LW[t * 64 + tid]; LW[t * 64 + tid] = acc; } }
    __syncthreads();
    {
      const int tau = tid >> 3, sc = tid & 7, col = h * 64 + sc * 8; const int row = rowmap(d, b, 64 * c + tau);
      const bfr* rp = RK + (size_t)row * 4096 + col; uint4 pr = *(const uint4*)rp, pk = *(const uint4*)(rp + 1024);
      unsigned ur[4] = {pr.x, pr.y, pr.z, pr.w}, uk[4] = {pk.x, pk.y, pk.z, pk.w};
      float r8[8], k8[8], kr[8];
#pragma unroll
      for (int e = 0; e < 4; e++) { r8[2 * e] = blo(ur[e]); r8[2 * e + 1] = bhi(ur[e]); k8[2 * e] = blo(uk[e]); k8[2 * e + 1] = bhi(uk[e]); }
      float ss = 0.f;
#pragma unroll
      for (int e = 0; e < 8; e++) { kr[e] = k8[e] * kkp[col + e]; ss += kr[e] * kr[e]; }
      ss += __shfl_xor(ss, 1); ss += __shfl_xor(ss, 2); ss += __shfl_xor(ss, 4);
      const float inv = 1.f / fmaxf(sqrtf(ss), 1e-12f);
      float bon = 0.f, o0[8], o1[8], o2[8], o3[8], o4[8], o5[8];
#pragma unroll
      for (int e = 0; e < 8; e++) {
        const float cw = LW[tau * 64 + sc * 8 + e], cwm = tau > 0 ? LW[(tau - 1) * 64 + sc * 8 + e] : 0.f, cwl = LW[63 * 64 + sc * 8 + e], a = AT[tau * 64 + sc * 8 + e];
        const float ka = kr[e] * inv, be = a * ka, kd = k8[e] * (1.f + (a - 1.f) * kap[col + e]); bon += r8[e] * kd * rkp[col + e];
        const float e2 = __expf(-cw), e4 = __expf(cwl - cw);
        o0[e] = ka * __expf(cwm); o1[e] = be * e2; o2[e] = kd * e2; o3[e] = r8[e] * __expf(cw); o4[e] = be * e4; o5[e] = kd * e4;
        if (tau == 63) WL[sc * 8 + e] = __expf(cwl);
      }
      bon += __shfl_xor(bon, 1); bon += __shfl_xor(bon, 2); bon += __shfl_xor(bon, 4);
      if (sc == 0) BON[((size_t)d * R_ + row) * 16 + h] = bon;
      *(uint4*)(CSLOT(0) + tau * CS + sc * 8) = uint4{pk2(o0[0], o0[1]), pk2(o0[2], o0[3]), pk2(o0[4], o0[5]), pk2(o0[6], o0[7])};
      *(uint4*)(CSLOT(1) + tau * CS + sc * 8) = uint4{pk2(o1[0], o1[1]), pk2(o1[2], o1[3]), pk2(o1[4], o1[5]), pk2(o1[6], o1[7])};
      *(uint4*)(CSLOT(2) + tau * CS + sc * 8) = uint4{pk2(o2[0], o2[1]), pk2(o2[2], o2[3]), pk2(o2[4], o2[5]), pk2(o2[6], o2[7])};
      *(uint4*)(CSLOT(3) + tau * CS + sc * 8) = uint4{pk2(o3[0], o3[1]), pk2(o3[2], o3[3]), pk2(o3[4], o3[5]), pk2(o3[6], o3[7])};
#pragma unroll
      for (int e = 0; e < 8; e++) { CSLOT(4)[(sc * 8 + e) * CS + tau] = f2b(o0[e]); CSLOT(5)[(sc * 8 + e) * CS + tau] = f2b(o4[e]); CSLOT(6)[(sc * 8 + e) * CS + tau] = f2b(o5[e]); }
    }
    __syncthreads();
#pragma unroll
    for (int tt = 0; tt < 2; tt++) { const int tj = tj0 + tt, r0 = 16 * ti + 4 * q4, cc = 16 * tj + l15;
      f32x4 v = cmm(CSLOT(1), CSLOT(0), ti, tj, l15, q4);
#pragma unroll
      for (int jj = 0; jj < 4; jj++) if (!(r0 + jj < cc)) v[jj] = 0.f;
      st_row(CSLOT(7), r0, cc, v); st_tr(CSLOT(8), r0, cc, v);
      v = cmm(CSLOT(2), CSLOT(0), ti, tj, l15, q4);
#pragma unroll
      for (int jj = 0; jj < 4; jj++) if (!(r0 + jj < cc)) v[jj] = 0.f;
      st_row(CSLOT(9), r0, cc, v);
      v = cmm(CSLOT(3), CSLOT(1), ti, tj, l15, q4);
#pragma unroll
      for (int jj = 0; jj < 4; jj++) if (!(cc <= r0 + jj)) v[jj] = 0.f;
      st_row(CSLOT(10), r0, cc, v);
      v = cmm(CSLOT(3), CSLOT(2), ti, tj, l15, q4);
#pragma unroll
      for (int jj = 0; jj < 4; jj++) if (!(cc <= r0 + jj)) v[jj] = 0.f;
      st_row(CSLOT(11), r0, cc, v);
    }
    __syncthreads();
    {
      float* X = (float*)CSLOT(0);
      const bfr* Ab = CSLOT(7);
      const int cl = lane >> 3, pp = lane & 7, cx = 8 * w + cl, blk0 = (w >> 1) * 16;
#pragma unroll 1
      for (int il = 15; il >= 0; il--) { const int i = blk0 + il;
        float sum = 0.f;
#pragma unroll 1
        for (int jx = i + 1 + pp; jx < blk0 + 16; jx += 8) sum += b2f(Ab[i * CS + jx]) * X[jx * 72 + cx];
        sum += dppf<0xB1>(sum); sum += dppf<0x4E>(sum); sum += dppf<0x141>(sum);
        const float xv = (i == cx ? 1.f : 0.f) - sum;
        if (pp == 0) X[i * 72 + cx] = xv;
      }
      __syncthreads();
#pragma unroll 1
      for (int e = tid; e < 4096; e += 512) { const int i = e >> 6, c2 = e & 63; const bfr tv = ((i >> 4) == (c2 >> 4)) ? f2b(X[i * 72 + c2]) : (bfr)0; CSLOT(2)[i * CS + c2] = tv; CSLOT(12)[c2 * CS + i] = tv; }
      __syncthreads();
#pragma unroll
      for (int tt = 0; tt < 2; tt++) { const int tj = tj0 + tt, r0 = 16 * ti + 4 * q4, cc = 16 * tj + l15; st_row(CSLOT(13), r0, cc, cmm_mask<1>(CSLOT(2), CSLOT(8), ti, tj, l15, q4)); }
      __syncthreads();
#pragma unroll
      for (int tt = 0; tt < 2; tt++) { const int tj = tj0 + tt, r0 = 16 * ti + 4 * q4, cc = 16 * tj + l15;
        f32x4 v = ld_row(CSLOT(2), r0, cc) - cmm(CSLOT(13), CSLOT(12), ti, tj, l15, q4); st_row(CSLOT(0), r0, cc, v); st_tr(CSLOT(1), r0, cc, v); }
      __syncthreads();
#pragma unroll
      for (int tt = 0; tt < 2; tt++) { const int tj = tj0 + tt, r0 = 16 * ti + 4 * q4, cc = 16 * tj + l15; st_row(CSLOT(13), r0, cc, cmm_mask<2>(CSLOT(0), CSLOT(8), ti, tj, l15, q4)); }
      __syncthreads();
#pragma unroll
      for (int tt = 0; tt < 2; tt++) { const int tj = tj0 + tt, r0 = 16 * ti + 4 * q4, cc = 16 * tj + l15;
        f32x4 v = ld_row(CSLOT(0), r0, cc) - cmm(CSLOT(13), CSLOT(1), ti, tj, l15, q4);
#pragma unroll
        for (int jj = 0; jj < 4; jj++) if (r0 + jj == cc) v[jj] -= 1.f;
        st_row(CSLOT(2), r0, cc, v); }
      __syncthreads();
    }
#pragma unroll
    for (int tt = 0; tt < 2; tt++) { const int tj = tj0 + tt, r0 = 16 * ti + 4 * q4, cc = 16 * tj + l15;
      f32x4 g = cmm(CSLOT(10), CSLOT(2), ti, tj, l15, q4) + ld_row(CSLOT(10), r0, cc); st_row(CSLOT(12), r0, cc, g);
      f32x4 hh = cmm(CSLOT(5), CSLOT(2), ti, tj, l15, q4) + ld_row(CSLOT(5), r0, cc); st_row(CSLOT(13), r0, cc, hh); }
    __syncthreads();
    {
      bfr* out = WB + (size_t)(chain * 65 + cl) * 16384;
#pragma unroll
      for (int tt = 0; tt < 2; tt++) { const int tj = tj0 + tt, r0 = 16 * ti + 4 * q4, cc = 16 * tj + l15;
        f32x4 v = ld_tr(CSLOT(3), r0, cc) - cmm(CSLOT(4), CSLOT(12), ti, tj, l15, q4);
        store4b(out + cc * 64 + r0, v);
        v = ld_tr(CSLOT(11), r0, cc) - cmm(CSLOT(9), CSLOT(12), ti, tj, l15, q4);
        store4b(out + 4096 + cc * 64 + r0, v);
        v = -cmm(CSLOT(4), CSLOT(13), ti, tj, l15, q4);
#pragma unroll
        for (int jj = 0; jj < 4; jj++) if (r0 + jj == cc) v[jj] += WL[cc];
        store4b(out + 8192 + cc * 64 + r0, v);
        v = ld_tr(CSLOT(6), r0, cc) - cmm(CSLOT(9), CSLOT(13), ti, tj, l15, q4);
        store4b(out + 12288 + cc * 64 + r0, v);
      }
    }
    __syncthreads();
  }
}

__device__ __forceinline__ void ph_r7_cb(const P& p, int win, int d, char* smem) {
  bfr* Sh = (bfr*)smem; bfr* Sl = Sh + 2 * 16 * CS; bfr* VT = Sl + 2 * 16 * CS;
  const bfr* WB = p.H; const bfr* RK = (const bfr*)(p.ACT + A_RKVZ); bfr* Y = (bfr*)(p.ACT + A_Y); bfr* SST = (bfr*)(p.ACT + A_SST);
  const int tid = ltid(), lane = tid & 63, w = tid >> 6, l15 = lane & 15, q4 = lane >> 4;
  const int c0 = win * 65;
  for (int it = blockIdx.x; it < 128; it += gridDim.x) {
    const int b = it >> 6, h = (it >> 2) & 15, rg = it & 3, chain = (b * 16 + h) * 2 + d;
    bfr* sst = SST + (size_t)(chain * 4 + rg) * 2048;
    __syncthreads();
    if (tid < 256) { const int hl = tid >> 7, e = tid & 127, rr = e >> 3, c8 = e & 7; uint4 v = uint4{0u, 0u, 0u, 0u};
      if (win > 0) v = *(const uint4*)(sst + hl * 1024 + rr * 64 + c8 * 8);
      *(uint4*)((hl ? Sl : Sh) + rr * CS + c8 * 8) = v; }
    const int vtau = tid >> 3, vp = tid & 7;
    { const int row = rowmap(d, b, 64 * c0 + vtau); unsigned vv = *(const unsigned*)(RK + (size_t)row * 4096 + 2048 + h * 64 + rg * 16 + 2 * vp);
      VT[(2 * vp) * CS + vtau] = (bfr)(vv & 0xffff); VT[(2 * vp + 1) * CS + vtau] = (bfr)(vv >> 16); }
    const bfr* bbase = WB + (size_t)(chain * 65) * 16384 + (w < 4 ? 8192 + (16 * w + l15) * 64 : (16 * (w - 4) + l15) * 64) + 8 * q4;
    bf16x8 rb1[4][2], rb2[4][2]; unsigned rv[4]; uint2 ry[4];
#define CB_FIRST(c_) ({ const int rc_ = d == 0 ? (c_) : ((c_) < 4 ? 3 - (c_) : 263 - (c_)); const int cb_ = rc_ < 4 ? 3 - rc_ : 263 - rc_; d == 0 ? (win <= cb_ / 65) : (win < rc_ / 65); })
#define CB_LOAD(u_, s_) { const int ss_ = (s_) < 65 ? (s_) : 64; const bfr* bp_ = bbase + (size_t)ss_ * 16384; \
      rb1[u_][0] = *(const bf16x8*)bp_; rb1[u_][1] = *(const bf16x8*)(bp_ + 32); rb2[u_][0] = *(const bf16x8*)(bp_ + 4096); rb2[u_][1] = *(const bf16x8*)(bp_ + 4096 + 32); \
      const int sv_ = ss_ + 1 < 65 ? ss_ + 1 : 64; const int rowv_ = rowmap(d, b, 64 * (c0 + sv_) + vtau); \
      rv[u_] = *(const unsigned*)(RK + (size_t)rowv_ * 4096 + 2048 + h * 64 + rg * 16 + 2 * vp); \
      ry[u_] = uint2{0u, 0u}; if (w >= 4 && !CB_FIRST(c0 + ss_)) { const int rowy_ = rowmap(d, b, 64 * (c0 + ss_) + 16 * (w - 4) + l15); ry[u_] = *(const uint2*)(Y + (size_t)rowy_ * 1024 + h * 64 + rg * 16 + 4 * q4); } }
    CB_LOAD(0, 0) CB_LOAD(1, 1) CB_LOAD(2, 2) CB_LOAD(3, 3)
    __syncthreads();
    for (int g = 0; g < 17; g++) {
#pragma unroll
      for (int u = 0; u < 4; u++) {
        const int s = 4 * g + u;
        if (s < 65) {
          const int cur = s & 1, nxt = cur ^ 1, c = c0 + s;
          bf16x8 sh[2], sl[2], vt[2];
#pragma unroll
          for (int ks = 0; ks < 2; ks++) { sh[ks] = *(const bf16x8*)(Sh + (cur * 16 + l15) * CS + 32 * ks + 8 * q4); sl[ks] = *(const bf16x8*)(Sl + (cur * 16 + l15) * CS + 32 * ks + 8 * q4);
            vt[ks] = *(const bf16x8*)(VT + (cur * 16 + l15) * CS + 32 * ks + 8 * q4); }
          f32x4 a1 = f32x4{0.f, 0.f, 0.f, 0.f}, a2 = a1;
#pragma unroll
          for (int ks = 0; ks < 2; ks++) { a1 = __builtin_amdgcn_mfma_f32_16x16x32_bf16(sh[ks], rb1[u][ks], a1, 0, 0, 0); a2 = __builtin_amdgcn_mfma_f32_16x16x32_bf16(vt[ks], rb2[u][ks], a2, 0, 0, 0); }
#pragma unroll
          for (int ks = 0; ks < 2; ks++) a1 = __builtin_amdgcn_mfma_f32_16x16x32_bf16(sl[ks], rb1[u][ks], a1, 0, 0, 0);
          a1 = a1 + a2;
          if (w < 4) {
#pragma unroll
            for (int jj = 0; jj < 4; jj++) { const bfr hi = f2b(a1[jj]); Sh[(nxt * 16 + 4 * q4 + jj) * CS + 16 * w + l15] = hi; Sl[(nxt * 16 + 4 * q4 + jj) * CS + 16 * w + l15] = f2b(a1[jj] - b2f(hi)); }
          } else {
            const int rowy = rowmap(d, b, 64 * c + 16 * (w - 4) + l15);
            a1[0] += blo(ry[u].x); a1[1] += bhi(ry[u].x); a1[2] += blo(ry[u].y); a1[3] += bhi(ry[u].y);
            store4b(Y + (size_t)rowy * 1024 + h * 64 + rg * 16 + 4 * q4, a1);
          }
          if (s + 1 < 65) { VT[(nxt * 16 + 2 * vp) * CS + vtau] = (bfr)(rv[u] & 0xffff); VT[(nxt * 16 + 2 * vp + 1) * CS + vtau] = (bfr)(rv[u] >> 16); }
          if (s + 4 < 65) CB_LOAD(u, s + 4)
          __syncthreads();
        }
      }
    }
    if (tid < 256) { const int hl = tid >> 7, e = tid & 127, rr = e >> 3, c8 = e & 7; *(uint4*)(sst + hl * 1024 + rr * 64 + c8 * 8) = *(const uint4*)((hl ? Sl : Sh) + (16 + rr) * CS + c8 * 8); }
  }
}

__device__ __forceinline__ void run_phase(const P& p, int ph, int layer, int d, char* smem) {
  Ctx c; c.layer = layer; c.j = layer / 3; c.d = d; c.wc = layer < 3 ? 1 : 0;
  switch (ph) {
    case PH_PRE: ph_pre(p, smem); break;
    case PH_NORM: ph_norm(p, layer, smem); break;
    case PH_LRU_IN: big_gemm(smem, p.H, p.W, 2560, 1024, F_LruIn{p.ACT}); break;
    case PH_LRU_CONV: ph_lru_conv(p, c.j); break;
    case PH_LRU_GATE: gemm_phase<G_LruGate>(p, c, smem); break;
    case PH_LRU_S1: ph_lru_s1(p, d); break;
    case PH_LRU_S2: ph_lru_s2(p); break;
    case PH_LRU_S3: ph_lru_s3(p, d); break;
    case PH_LRU_OUT: big_gemm(smem, (const bfr*)(p.ACT + A_Z), p.W + WL_OUT, 1024, 1280, F_Resid{p.Xx, p.Xc, p.MOD + (size_t)layer * 3 * 3072, c.wc}); break;
    case PH_ML_IN: big_gemm(smem, p.H, p.W, 4352, 1024, F_MlIn{p.ACT}); break;
    case PH_ML_SCAN: ph_ml_scan(p, c.j, smem); break;
    case PH_ML_STAT: ph_ml_stat(p); break;
    case PH_ML_Z: big_gemm(smem, p.H, p.W + WM_Z, 2048, 1024, F_MlZ{p.ACT, p.ml_norm_g + (size_t)c.j * 2048}); break;
    case PH_ML_OUT: big_gemm(smem, (const bfr*)(p.ACT + A_HS), p.W + WM_OUT, 1024, 2048, F_Resid{p.Xx, p.Xc, p.MOD + (size_t)layer * 3 * 3072, c.wc}); break;
    case PH_R7_IN: big_gemm(smem, p.H, p.W, 4352, 2048, F_R7In{p.ACT}); break;
    case PH_R7_SHIFT: ph_r7_shift(p); break;
    case PH_R7_CA: ph_r7_ca(p, c.j, d, smem); break;
    case PH_R7_CB: ph_r7_cb(p, d >> 1, d & 1, smem); break;
    case PH_R7_FIN: ph_r7_fin(p, c.j); break;
    case PH_R7_OUT: big_gemm(smem, (const bfr*)(p.ACT + A_Y), p.W + WR_OUT, 1024, 1024, F_Resid{p.Xx, p.Xc, p.MOD + (size_t)layer * 3 * 3072, c.wc}); break;
    case PH_FINAL: ph_final(p); break;
  }
}


#define XB_TMO      128
#define XB_XCNT(j)  (256  + 64 * (j))
#define XB_XSUB(j)  (1280 + 64 * (j))
#define XB_XGEN(j)  (2304 + 64 * (j))
#define XB_TOP      3328
#define XB_TOPGEN   3392
#define XCD_BAR_WORDS 3456
#define XB_SPIN_CAP (1u << 18)
#define OFF_BAR 527000064ull
__device__ __forceinline__ unsigned xb_ld(unsigned* p)              { return __hip_atomic_load(p, __ATOMIC_RELAXED, __HIP_MEMORY_SCOPE_AGENT); }
__device__ __forceinline__ unsigned xb_add(unsigned* p, unsigned v) { return __hip_atomic_fetch_add(p, v, __ATOMIC_RELAXED, __HIP_MEMORY_SCOPE_AGENT); }
__device__ __forceinline__ unsigned xb_xcc_id() { return (unsigned)__builtin_amdgcn_s_getreg((3 << 11) | 20) & 0xFu; }
#define XB_SPIN(cond, bar) do { unsigned _sp = 0; while (cond) { __builtin_amdgcn_s_sleep(1); \
    if ((++_sp & 255u) == 0u) { if (xb_ld(&(bar)[XB_TMO])) break; if (_sp > XB_SPIN_CAP) { atomicAdd(&(bar)[XB_TMO], 1u); break; } } } } while (0)
struct XcdBarrier { unsigned* bar; unsigned x; volatile __attribute__((address_space(3))) unsigned* st; };
__device__ __forceinline__ XcdBarrier xcd_barrier_post(unsigned* bar, volatile __attribute__((address_space(3))) unsigned* st) {
  XcdBarrier b; b.bar = bar; b.x = xb_xcc_id(); b.st = st;
  if (threadIdx.x == 0) (void)xb_add(&bar[XB_XCNT(b.x)], 1u);
  return b;
}
__device__ __forceinline__ void xcd_barrier_complete(unsigned* bar, unsigned x, unsigned& nloc, unsigned& nx) {
  const unsigned G = gridDim.x * gridDim.y * gridDim.z;
  unsigned sum, cnt, mine, sp = 0u;
  for (;;) {
    sum = 0u; cnt = 0u; mine = 0u;
#pragma unroll
    for (unsigned j = 0; j < 16; ++j) { const unsigned c = xb_ld(&bar[XB_XCNT(j)]); sum += c; cnt += (c > 0u) ? 1u : 0u; mine = (j == x) ? c : mine; }
    if (sum == G) break;
    __builtin_amdgcn_s_sleep(1);
    if ((++sp & 255u) == 0u) { if (xb_ld(&bar[XB_TMO])) break; if (sp > XB_SPIN_CAP) { atomicAdd(&bar[XB_TMO], 1u); break; } }
  }
  nloc = mine > 0u ? mine : 1u; nx = cnt > 0u ? cnt : 1u;
}
__device__ __forceinline__ void xcd_barrier(const XcdBarrier& b) {
  asm volatile("s_waitcnt vmcnt(0)" ::: "memory");
  __syncthreads();
  if (threadIdx.x == 0) {
    unsigned* bar = b.bar;
    __builtin_amdgcn_s_waitcnt(0);
    unsigned nloc = b.st[0], nx = b.st[1];
    if (nloc == 0u) { xcd_barrier_complete(bar, b.x, nloc, nx); b.st[0] = nloc; b.st[1] = nx; }
    const unsigned old = xb_add(&bar[XB_XSUB(b.x)], 1u);
    const unsigned gen = old / nloc;
    if (old + 1u == (gen + 1u) * nloc) {
      __builtin_amdgcn_fence(__ATOMIC_RELEASE, "agent");
      asm volatile("s_waitcnt vmcnt(0)" ::: "memory");
      const unsigned og = xb_add(&bar[XB_TOP], 1u);
      const unsigned tg = og / nx;
      if (og + 1u == (tg + 1u) * nx) xb_add(&bar[XB_TOPGEN], 1u);
      else XB_SPIN(xb_ld(&bar[XB_TOPGEN]) == tg, bar);
      __builtin_amdgcn_fence(__ATOMIC_ACQUIRE, "agent");
      xb_add(&bar[XB_XGEN(b.x)], 1u);
      asm volatile("s_waitcnt vmcnt(0)" ::: "memory");
    } else {
      XB_SPIN(xb_ld(&bar[XB_XGEN(b.x)]) == gen, bar);
      __builtin_amdgcn_fence(__ATOMIC_ACQUIRE, "agent");
      asm volatile("s_waitcnt vmcnt(0)" ::: "memory");
    }
  }
  __syncthreads();
}

#define SMEM_BYTES (131072 + 64)
extern __shared__ __attribute__((aligned(16))) char dyn_smem[];
#if !MEGA
__global__ void __launch_bounds__(512, 2) phase_kernel(P p, int si) {
  run_phase(p, p.sched[si * 3], p.sched[si * 3 + 1], p.sched[si * 3 + 2], dyn_smem);
}
#else
__global__ void __launch_bounds__(512, 2) mega_kernel(P p) {
  cg::grid_group grid = cg::this_grid();
  volatile __attribute__((address_space(3))) unsigned* st = (volatile __attribute__((address_space(3))) unsigned*)(dyn_smem + 131072);
  if (threadIdx.x < 4) st[threadIdx.x] = 0u;
  __syncthreads();
  const XcdBarrier xb = xcd_barrier_post(p.bar, st);
  for (int si = 0; si < p.nsched; si++) {
    run_phase(p, p.sched[si * 3], p.sched[si * 3 + 1], p.sched[si * 3 + 2], dyn_smem);
    if (si + 1 < p.nsched) { if (si == 0) grid.sync(); else xcd_barrier(xb); }
  }
}
#endif

extern "C" void kernel_launch(void* const* d_in, const int* in_sizes, int n_in, void* d_out, int out_size, void* d_ws, size_t ws_size, hipStream_t stream) {
  P p; memset(&p, 0, sizeof(p));
  const float** f = (const float**)&p;
  for (int i = 0; i < 33; i++) f[i] = (const float*)d_in[i];
  char* ws = (char*)d_ws;
  p.Xx = (float*)d_out; p.Xc = (float*)(ws + OFF_XC); p.MOD = (float*)(ws + OFF_MOD); p.W = (bfr*)(ws + OFF_W); p.H = (bfr*)(ws + OFF_H); p.ACT = ws + OFF_ACT; p.bar = (unsigned*)(ws + OFF_BAR);
  int n = 0;
  auto add = [&](int ph, int layer, int d) { p.sched[n * 3] = ph; p.sched[n * 3 + 1] = layer; p.sched[n * 3 + 2] = d; n++; };
  add(PH_PRE, 0, 0);
  if (DUP & 4) add(PH_PRE, 0, 0);
  for (int l = 0; l < 4; l++) {
    add(PH_NORM, l, 0); if (DUP & 4) add(PH_NORM, l, 0);
    int kind = l % 3;
    const bool dg = DUP & 1, ds = DUP & 2;
    if (kind == 0) { add(PH_LRU_IN, l, 0); if (dg) add(PH_LRU_IN, l, 0); add(PH_LRU_CONV, l, 0); if (DUP & 4) add(PH_LRU_CONV, l, 0);
      for (int d = 0; d < 2; d++) { add(PH_LRU_GATE, l, d); if (dg) add(PH_LRU_GATE, l, d); add(PH_LRU_S1, l, d); if (DUP & 8) add(PH_LRU_S1, l, d); add(PH_LRU_S2, l, d); if (DUP & 16) add(PH_LRU_S2, l, d); add(PH_LRU_S3, l, d); }
      add(PH_LRU_OUT, l, 0); }
    else if (kind == 1) { add(PH_ML_IN, l, 0); if (dg) add(PH_ML_IN, l, 0); add(PH_ML_SCAN, l, 0); if (ds) add(PH_ML_SCAN, l, 0); add(PH_ML_STAT, l, 0); if (DUP & 4) add(PH_ML_STAT, l, 0); add(PH_ML_Z, l, 0); add(PH_ML_OUT, l, 0); }
    else { add(PH_R7_SHIFT, l, 0); add(PH_R7_IN, l, 0); if (dg) add(PH_R7_IN, l, 0); for (int wi = 0; wi < 4; wi++) { add(PH_R7_CA, l, wi); if (ds) add(PH_R7_CA, l, wi); add(PH_R7_CB, l, wi * 2); add(PH_R7_CB, l, wi * 2 + 1); } add(PH_R7_FIN, l, 0); add(PH_R7_OUT, l, 0); }
  }
  add(PH_FINAL, 0, 0);
  p.nsched = n;
  if (ws_size < WS_NEED) fprintf(stderr, "workspace too small: %zu < %llu\n", ws_size, (unsigned long long)WS_NEED);
#if MEGA
  static int grid_blocks = 0;
  if (!grid_blocks) { int dev = 0, cus = 0, per = 0; hipGetDevice(&dev); hipDeviceGetAttribute(&cus, hipDeviceAttributeMultiprocessorCount, dev);
    hipFuncSetAttribute((const void*)mega_kernel, hipFuncAttributeMaxDynamicSharedMemorySize, SMEM_BYTES);
    hipOccupancyMaxActiveBlocksPerMultiprocessor(&per, mega_kernel, 512, SMEM_BYTES); if (per > 1) per = 1; if (per < 1) per = 1; grid_blocks = cus * per; }
  hipMemsetAsync(ws + OFF_BAR, 0, XCD_BAR_WORDS * 4, stream);
  void* args[] = {&p};
  hipError_t e = hipLaunchCooperativeKernel((void*)mega_kernel, dim3(grid_blocks), dim3(512), args, SMEM_BYTES, stream);
  if (e != hipSuccess) fprintf(stderr, "cooperative launch failed: %s (grid %d)\n", hipGetErrorString(e), grid_blocks);
#else
  static int once = 0; if (!once) { once = 1; hipFuncSetAttribute((const void*)phase_kernel, hipFuncAttributeMaxDynamicSharedMemorySize, SMEM_BYTES); }
  for (int si = 0; si < n; si++) phase_kernel<<<256, 512, SMEM_BYTES, stream>>>(p, si);
#endif
}
```

```cpp
#include <hip/hip_runtime.h>
#include <hip/hip_bf16.h>
#include <hip/hip_cooperative_groups.h>
#include <cstdio>
#include <cstring>
#include <type_traits>
namespace cg = cooperative_groups;

#ifndef DUP
#define DUP 0
#endif
#ifndef MEGA
#define MEGA 1
#endif

typedef unsigned short bfr;
using bf16x8 = __attribute__((ext_vector_type(8))) short;
using f32x4 = __attribute__((ext_vector_type(4))) float;

#define R_ 33280
#define BT_ 16640
#define NCH_ 260

#define OFF_XC 0ull
#define OFF_MOD 2097152ull
#define OFF_W 2244608ull
#define OFF_H 24264704ull
#define OFF_ACT 92422144ull
#define A_Z 0ull
#define A_UC 85196800ull
#define A_AB 170393600ull
#define A_U 170393600ull
#define A_HF 340787200ull
#define A_AGG 425984000ull
#define A_CAR 431308800ull
#define A_QKV 0ull
#define A_GATE 272629760ull
#define A_HS 276889600ull
#define A_RSTD 413204480ull
#define A_R7B 68157440ull
#define A_RKVZ (A_R7B + 0ull)
#define A_WM (A_R7B + 272629760ull)
#define A_AM (A_R7B + 281149440ull)
#define A_BON (A_R7B + 289669120ull)
#define A_Y (A_R7B + 293928960ull)
#define WS_NEED (527000064ull + 16384ull)

#define WL_GATE (2560 * 1024)
#define WL_OUT (WL_GATE + 1310720)
#define WM_Z (4352 * 1024)
#define WM_OUT (WM_Z + 2048 * 1024)
#define WR_UP (4352 * 2048)
#define WR_OUT (WR_UP + 262144)

enum { PH_PRE = 0, PH_NORM, PH_LRU_IN, PH_LRU_CONV, PH_LRU_GATE, PH_LRU_S1, PH_LRU_S2, PH_LRU_S3, PH_LRU_OUT,
       PH_ML_IN, PH_ML_SCAN, PH_ML_STAT, PH_ML_Z, PH_ML_OUT,
       PH_R7_IN, PH_R7_CA, PH_R7_CB, PH_R7_FIN, PH_R7_OUT, PH_FINAL, PH_R7_SHIFT };

struct P {
  const float *x, *c, *ctx, *c_ctx, *norm_g, *mod_w, *mod_b, *final_g;
  const float *lru_w_in, *lru_conv_w, *lru_conv_b, *lru_gate_w, *lru_gate_b, *lru_lam, *lru_w_out;
  const float *ml_w_in, *ml_gate_b, *ml_norm_g, *ml_w_out;
  const float *r7_mu, *r7_w_rkvz, *r7_w0, *r7_w1, *r7_w2, *r7_a0, *r7_a1, *r7_a2, *r7_k_k, *r7_k_a, *r7_r_k, *r7_ln_g, *r7_ln_b, *r7_w_out;
  float* Xx; float* Xc; float* MOD; bfr* W; bfr* H; char* ACT; unsigned* bar;
  int nsched; int pad_;
  int sched[64 * 3];
};
struct Ctx { int layer, j, d, wc; };

__device__ __forceinline__ int ltid() { int t = threadIdx.x; asm volatile("" : "+v"(t)); return t; }
__device__ __forceinline__ bfr f2b(float f) { unsigned u = __float_as_uint(f); u += 0x7fffu + ((u >> 16) & 1u); return (bfr)(u >> 16); }
__device__ __forceinline__ float b2f(bfr b) { return __uint_as_float(((unsigned)b) << 16); }
__device__ __forceinline__ unsigned pk2(float a, float b) { return (unsigned)f2b(a) | (((unsigned)f2b(b)) << 16); }
__device__ __forceinline__ float blo(unsigned u) { return __uint_as_float(u << 16); }
__device__ __forceinline__ float bhi(unsigned u) { return __uint_as_float(u & 0xffff0000u); }
__device__ __forceinline__ void store4b(bfr* dst, f32x4 v) { uint2 u; u.x = pk2(v[0], v[1]); u.y = pk2(v[2], v[3]); *(uint2*)dst = u; }
__device__ __forceinline__ float sigm(float x) { return __builtin_amdgcn_rcpf(1.f + __expf(-x)); }
__device__ __forceinline__ float siluf(float x) { return x * sigm(x); }
__device__ __forceinline__ float softplusf(float x) { return x > 20.f ? x : log1pf(expf(x)); }
__device__ __forceinline__ int rowmap(int d, int b, int pp) { int o = d == 0 ? pp : (pp < 256 ? 255 - pp : 16895 - pp); return b * BT_ + o; }
__device__ __forceinline__ float* xrowp(const P& p, int row, int& mi) {
  int b = row / BT_, o = row - b * BT_;
  if (o < 256) { mi = 2; return p.Xc + (size_t)(b * 256 + o) * 1024; }
  mi = b; return p.Xx + (size_t)(b * 16384 + o - 256) * 1024;
}
__device__ __forceinline__ float wsum(float v) { for (int o = 32; o; o >>= 1) v += __shfl_xor(v, o); return v; }
template <int CTRL> __device__ __forceinline__ float dppf(float x) {
  return __int_as_float(__builtin_amdgcn_update_dpp(0, __float_as_int(x), CTRL, 0xf, 0xf, true));
}
__device__ __forceinline__ float red16(float x) {
  x += dppf<0xB1>(x); x += dppf<0x4E>(x); x += dppf<0x141>(x); x += dppf<0x140>(x); return x;
}

template <class F> __device__ __forceinline__ void prep_tile(bfr* dst, int K, int tn, int tk, F get, float* sm) {
  int tid = ltid();
  for (int i = 0; i < 8; i++) { int kk = (tid >> 6) + 8 * i, nn = tid & 63; sm[kk * 65 + nn] = get(tk * 64 + kk, tn * 64 + nn); }
  __syncthreads();
  for (int i = 0; i < 8; i++) { int nn = (tid >> 6) + 8 * i, kk = tid & 63; dst[(size_t)(tn * 64 + nn) * K + tk * 64 + kk] = f2b(sm[kk * 65 + nn]); }
  __syncthreads();
}
__device__ __forceinline__ int prep_count(int layer) { int kind = layer % 3; return kind == 0 ? (640 + 320 + 320) : kind == 1 ? (1088 + 512 + 512) : (2176 + 64 + 256); }
__device__ __forceinline__ void prep_item(const P& p, int layer, int it, float* sm) {
  int kind = layer % 3, j = layer / 3;
  if (kind == 0) {
    if (it < 640) { int tn = it / 16, tk = it % 16; const float* s = p.lru_w_in + (size_t)j * 1024 * 2560;
      prep_tile(p.W, 1024, tn, tk, [=](int k, int n) { return s[(size_t)k * 2560 + n]; }, sm); return; }
    it -= 640;
    if (it < 320) { int d = it / 160, r = it % 160, tn = r / 2, tk = r % 2; const float* s = p.lru_gate_w + (size_t)(j * 2 + d) * 2 * 10 * 16384;
      prep_tile(p.W + WL_GATE + d * 655360, 128, tn, tk, [=](int k, int n) {
        int nt = n >> 7, blk = nt >> 1, sub = nt & 1, jj = n & 127, wn = jj >> 6, rr = jj & 63, g = rr >> 5, c = rr & 31;
        int kch = sub * 64 + wn * 32 + c; return s[((size_t)(g * 10 + blk) * 128 + k) * 128 + kch]; }, sm); return; }
    it -= 320;
    { int tn = it / 20, tk = it % 20; const float* s = p.lru_w_out + (size_t)j * 1280 * 1024;
      prep_tile(p.W + WL_OUT, 1280, tn, tk, [=](int k, int n) { return s[(size_t)k * 1024 + n]; }, sm); return; }
  } else if (kind == 1) {
    const float* s = p.ml_w_in + (size_t)j * 1024 * 6176;
    if (it < 1088) { int tn = it / 16, tk = it % 16;
      prep_tile(p.W, 1024, tn, tk, [=](int k, int n) {
        if (n < 4096) { float v = s[(size_t)k * 6176 + n]; return (n >= 1024 && n < 2048) ? v * 0.08838834764831845f : v; }
        if (n < 4128) return s[(size_t)k * 6176 + 6144 + (n - 4096)];
        return 0.f; }, sm); return; }
    it -= 1088;
    if (it < 512) { int tn = it / 16, tk = it % 16;
      prep_tile(p.W + WM_Z, 1024, tn, tk, [=](int k, int n) { return s[(size_t)k * 6176 + 4096 + n]; }, sm); return; }
    it -= 512;
    { int tn = it / 32, tk = it % 32; const float* so = p.ml_w_out + (size_t)j * 2048 * 1024;
      prep_tile(p.W + WM_OUT, 2048, tn, tk, [=](int k, int n) { return so[(size_t)k * 1024 + n]; }, sm); return; }
  } else {
    if (it < 2176) { int tn = it / 32, tk = it % 32;
      const float* mu = p.r7_mu + (size_t)j * 6 * 1024; const float* wr = p.r7_w_rkvz + (size_t)j * 4 * 1024 * 1024;
      const float* w1 = p.r7_w1 + (size_t)j * 2 * 1024 * 64; const float* a1 = p.r7_a1 + (size_t)j * 2 * 1024 * 64;
      prep_tile(p.W, 2048, tn, tk, [=](int k, int n) {
        int kk = k & 1023; float v, m;
        if (n < 4096) { int g = n >> 10, e = n & 1023; m = mu[g * 1024 + kk]; v = wr[((size_t)g * 1024 + kk) * 1024 + e]; }
        else if (n < 4224) { int xx = (n - 4096) >> 6, rr = (n - 4096) & 63; m = mu[4 * 1024 + kk]; v = w1[((size_t)xx * 1024 + kk) * 64 + rr]; }
        else { int xx = (n - 4224) >> 6, rr = (n - 4224) & 63; m = mu[5 * 1024 + kk]; v = a1[((size_t)xx * 1024 + kk) * 64 + rr]; }
        return (k < 1024 ? (1.f - m) : m) * v; }, sm); return; }
    it -= 2176;
    if (it < 64) { int u = it / 16, tn = it % 16; const float* s = (u < 2 ? p.r7_w2 : p.r7_a2) + (size_t)(j * 2 + (u & 1)) * 64 * 1024;
      prep_tile(p.W + WR_UP + u * 65536, 64, tn, 0, [=](int k, int n) { return s[(size_t)k * 1024 + n]; }, sm); return; }
    it -= 64;
    { int tn = it / 16, tk = it % 16; const float* s = p.r7_w_out + (size_t)j * 1024 * 1024;
      prep_tile(p.W + WR_OUT, 1024, tn, tk, [=](int k, int n) { return s[(size_t)k * 1024 + n]; }, sm); return; }
  }
}

#define LDSS 72
template <class G> __device__ __forceinline__ void gemm_tile(const P& p, const Ctx& c, int mt, int nt, char* smem) {
  const int tid = ltid(), lane = tid & 63, wid = tid >> 6, wm = wid & 3, wn = wid >> 2;
  bfr* sA = (bfr*)smem; bfr* sB = sA + 2 * 256 * LDSS;
  f32x4 acc[4][4];
  for (int a = 0; a < 4; a++) for (int b = 0; b < 4; b++) acc[a][b] = f32x4{0.f, 0.f, 0.f, 0.f};
  const int lr = tid >> 3, lc = tid & 7;
  uint4 ra[4], rb[2];
  auto gload = [&](int kt) __attribute__((always_inline)) {
#pragma unroll
    for (int i = 0; i < 4; i++) {
      const bfr* pa = G::aptr(p, c, mt * 256 + lr + 64 * i, kt, nt);
      ra[i] = pa ? *(const uint4*)(pa + lc * 8) : uint4{0u, 0u, 0u, 0u};
      if (i < 2) rb[i] = *(const uint4*)(G::bptr(p, c, nt * 128 + lr + 64 * i, kt) + lc * 8);
    }
  };
  auto sstore = [&](int buf) __attribute__((always_inline)) {
#pragma unroll
    for (int i = 0; i < 4; i++) {
      *(uint4*)(sA + (buf * 256 + lr + 64 * i) * LDSS + lc * 8) = ra[i];
      if (i < 2) *(uint4*)(sB + (buf * 128 + lr + 64 * i) * LDSS + lc * 8) = rb[i];
    }
  };
  gload(0); sstore(0); __syncthreads();
  for (int kt = 0; kt < G::KT; kt++) {
    const int buf = kt & 1;
    if (kt + 1 < G::KT) gload(kt + 1);
#pragma unroll
    for (int ks = 0; ks < 2; ks++) {
      bf16x8 af[4], bf[4];
#pragma unroll
      for (int i = 0; i < 4; i++) {
        af[i] = *(const bf16x8*)(sA + (buf * 256 + wm * 64 + i * 16 + (lane & 15)) * LDSS + ks * 32 + (lane >> 4) * 8);
        bf[i] = *(const bf16x8*)(sB + (buf * 128 + wn * 64 + i * 16 + (lane & 15)) * LDSS + ks * 32 + (lane >> 4) * 8);
      }
#pragma unroll
      for (int n = 0; n < 4; n++)
#pragma unroll
        for (int m = 0; m < 4; m++) acc[n][m] = __builtin_amdgcn_mfma_f32_16x16x32_bf16(bf[n], af[m], acc[n][m], 0, 0, 0);
    }
    if (kt + 1 < G::KT) sstore(buf ^ 1);
    __syncthreads();
  }
  G::epi(p, c, acc, mt * 256 + wm * 64, nt * 128 + wn * 64, lane);
}

__device__ __forceinline__ void epi_resid(const P& p, const Ctx& c, f32x4 (&acc)[4][4], int m0, int n0, int lane) {
#pragma unroll
  for (int mi = 0; mi < 4; mi++) {
    int row = m0 + mi * 16 + (lane & 15); int mo; float* xr = xrowp(p, row, mo);
    if (mo == 2 && !c.wc) continue;
    const float* g = p.MOD + (size_t)(c.layer * 3 + mo) * 3072 + 2048;
#pragma unroll
    for (int ni = 0; ni < 4; ni++) {
      int n = n0 + ni * 16 + (lane >> 4) * 4;
      float4 xv = *(float4*)(xr + n); float4 gg = *(const float4*)(g + n);
      xv.x += gg.x * acc[ni][mi][0]; xv.y += gg.y * acc[ni][mi][1]; xv.z += gg.z * acc[ni][mi][2]; xv.w += gg.w * acc[ni][mi][3];
      *(float4*)(xr + n) = xv;
    }
  }
}

struct G_LruIn { static constexpr int KT = 16, NT = 20;
  static __device__ __forceinline__ const bfr* aptr(const P& p, const Ctx& c, int row, int kt, int nt) { return p.H + (size_t)row * 1024 + kt * 64; }
  static __device__ __forceinline__ const bfr* bptr(const P& p, const Ctx& c, int n, int kt) { return p.W + (size_t)n * 1024 + kt * 64; }
  static __device__ __forceinline__ void epi(const P& p, const Ctx& c, f32x4 (&acc)[4][4], int m0, int n0, int lane) {
    bfr* U = (bfr*)(p.ACT + A_U); bfr* Z = (bfr*)(p.ACT + A_Z);
#pragma unroll
    for (int ni = 0; ni < 4; ni++)
#pragma unroll
      for (int mi = 0; mi < 4; mi++) {
        int row = m0 + mi * 16 + (lane & 15), n = n0 + ni * 16 + (lane >> 4) * 4;
        bfr* dst = n < 1280 ? U + (size_t)row * 1280 + n : Z + (size_t)row * 1280 + (n - 1280);
        store4b(dst, acc[ni][mi]);
      }
  } };
struct G_LruGate { static constexpr int KT = 2, NT = 20;
  static __device__ __forceinline__ const bfr* aptr(const P& p, const Ctx& c, int row, int kt, int nt) { return (const bfr*)(p.ACT + A_UC) + (size_t)row * 1280 + (nt >> 1) * 128 + kt * 64; }
  static __device__ __forceinline__ const bfr* bptr(const P& p, const Ctx& c, int n, int kt) { return p.W + WL_GATE + c.d * 655360 + (size_t)n * 128 + kt * 64; }
  static __device__ __forceinline__ void epi(const P& p, const Ctx& c, f32x4 (&acc)[4][4], int m0, int n0, int lane) {
    const bfr* UC = (const bfr*)(p.ACT + A_UC); unsigned* AB = (unsigned*)(p.ACT + A_AB);
    const float* gb = p.lru_gate_b + (size_t)(c.j * 2 + c.d) * 2 * 1280; const float* lam = p.lru_lam + (size_t)(c.j * 2 + c.d) * 1280;
    int chb = (n0 >> 6) * 32;
#pragma unroll
    for (int ni = 0; ni < 2; ni++) {
      int ch = chb + ni * 16 + (lane >> 4) * 4;
      float cl[4], br[4], bi[4];
#pragma unroll
      for (int q = 0; q < 4; q++) { cl[q] = 8.f * softplusf(-lam[ch + q]); br[q] = gb[ch + q]; bi[q] = gb[1280 + ch + q]; }
#pragma unroll
      for (int mi = 0; mi < 4; mi++) {
        int row = m0 + mi * 16 + (lane & 15);
        uint2 u = *(const uint2*)(UC + (size_t)row * 1280 + ch);
        float uc[4] = {blo(u.x), bhi(u.x), blo(u.y), bhi(u.y)};
        unsigned o[4];
#pragma unroll
        for (int q = 0; q < 4; q++) {
          float r = sigm(acc[ni][mi][q] + br[q]), ig = sigm(acc[ni + 2][mi][q] + bi[q]);
          float la = -cl[q] * r; float oma = 1.f - __expf(la); float bb = __builtin_amdgcn_sqrtf(oma * (2.f - oma)) * ig * uc[q];
          o[q] = (((unsigned)f2b(oma)) << 16) | (unsigned)f2b(bb);
        }
        *(uint4*)(AB + (size_t)row * 1280 + ch) = uint4{o[0], o[1], o[2], o[3]};
      }
    }
  } };
struct G_LruOut { static constexpr int KT = 20, NT = 8;
  static __device__ __forceinline__ const bfr* aptr(const P& p, const Ctx& c, int row, int kt, int nt) { return (const bfr*)(p.ACT + A_Z) + (size_t)row * 1280 + kt * 64; }
  static __device__ __forceinline__ const bfr* bptr(const P& p, const Ctx& c, int n, int kt) { return p.W + WL_OUT + (size_t)n * 1280 + kt * 64; }
  static __device__ __forceinline__ void epi(const P& p, const Ctx& c, f32x4 (&acc)[4][4], int m0, int n0, int lane) { epi_resid(p, c, acc, m0, n0, lane); } };
struct G_MlIn { static constexpr int KT = 16, NT = 33;
  static __device__ __forceinline__ const bfr* aptr(const P& p, const Ctx& c, int row, int kt, int nt) { return p.H + (size_t)row * 1024 + kt * 64; }
  static __device__ __forceinline__ const bfr* bptr(const P& p, const Ctx& c, int n, int kt) { return p.W + (size_t)n * 1024 + kt * 64; }
  static __device__ __forceinline__ void epi(const P& p, const Ctx& c, f32x4 (&acc)[4][4], int m0, int n0, int lane) {
    bfr* QKV = (bfr*)(p.ACT + A_QKV); float* GT = (float*)(p.ACT + A_GATE);
#pragma unroll
    for (int ni = 0; ni < 4; ni++)
#pragma unroll
      for (int mi = 0; mi < 4; mi++) {
        int row = m0 + mi * 16 + (lane & 15), n = n0 + ni * 16 + (lane >> 4) * 4;
        if (n < 4096) store4b(QKV + (size_t)row * 4096 + n, acc[ni][mi]);
        else if (n < 4128) *(float4*)(GT + (size_t)row * 32 + (n - 4096)) = float4{acc[ni][mi][0], acc[ni][mi][1], acc[ni][mi][2], acc[ni][mi][3]};
      }
  } };
struct G_MlZ { static constexpr int KT = 16, NT = 16;
  static __device__ __forceinline__ const bfr* aptr(const P& p, const Ctx& c, int row, int kt, int nt) { return p.H + (size_t)row * 1024 + kt * 64; }
  static __device__ __forceinline__ const bfr* bptr(const P& p, const Ctx& c, int n, int kt) { return p.W + WM_Z + (size_t)n * 1024 + kt * 64; }
  static __device__ __forceinline__ void epi(const P& p, const Ctx& c, f32x4 (&acc)[4][4], int m0, int n0, int lane) {
    bfr* HS = (bfr*)(p.ACT + A_HS); const float* RS = (const float*)(p.ACT + A_RSTD); const float* ng = p.ml_norm_g + (size_t)c.j * 2048;
#pragma unroll
    for (int ni = 0; ni < 4; ni++)
#pragma unroll
      for (int mi = 0; mi < 4; mi++) {
        int row = m0 + mi * 16 + (lane & 15), n = n0 + ni * 16 + (lane >> 4) * 4;
        bfr* hp = HS + (size_t)row * 2048 + n; uint2 u = *(const uint2*)hp; float rs = RS[(size_t)row * 8 + (n >> 8)];
        float4 g4 = *(const float4*)(ng + n);
        f32x4 o;
        o[0] = blo(u.x) * rs * g4.x * siluf(acc[ni][mi][0]); o[1] = bhi(u.x) * rs * g4.y * siluf(acc[ni][mi][1]);
        o[2] = blo(u.y) * rs * g4.z * siluf(acc[ni][mi][2]); o[3] = bhi(u.y) * rs * g4.w * siluf(acc[ni][mi][3]);
        store4b(hp, o);
      }
  } };
struct G_MlOut { static constexpr int KT = 32, NT = 8;
  static __device__ __forceinline__ const bfr* aptr(const P& p, const Ctx& c, int row, int kt, int nt) { return (const bfr*)(p.ACT + A_HS) + (size_t)row * 2048 + kt * 64; }
  static __device__ __forceinline__ const bfr* bptr(const P& p, const Ctx& c, int n, int kt) { return p.W + WM_OUT + (size_t)n * 2048 + kt * 64; }
  static __device__ __forceinline__ void epi(const P& p, const Ctx& c, f32x4 (&acc)[4][4], int m0, int n0, int lane) { epi_resid(p, c, acc, m0, n0, lane); } };
struct G_R7In { static constexpr int KT = 32, NT = 34;
  static __device__ __forceinline__ const bfr* aptr(const P& p, const Ctx& c, int row, int kt, int nt) {
    if (kt < 16) return p.H + (size_t)row * 1024 + kt * 64;
    int q = (kt - 16) >> 2; int b = row / BT_, o = row - b * BT_; int nr;
    if (o < 256) { if (q < 2) { if (o < 1) return nullptr; nr = row - 1; } else { if (o >= 255) return nullptr; nr = row + 1; } }
    else { int t = o - 256, col = t & 63, gr = t >> 6;
      if (q == 0) { if (col == 0) return nullptr; nr = row - 1; }
      else if (q == 1) { if (col == 63) return nullptr; nr = row + 1; }
      else if (q == 2) { if (gr == 0) return nullptr; nr = row - 64; }
      else { if (gr == 255) return nullptr; nr = row + 64; } }
    return p.H + (size_t)nr * 1024 + (kt - 16) * 64; }
  static __device__ __forceinline__ const bfr* bptr(const P& p, const Ctx& c, int n, int kt) { return p.W + (size_t)n * 2048 + kt * 64; }
  static __device__ __forceinline__ void epi(const P& p, const Ctx& c, f32x4 (&acc)[4][4], int m0, int n0, int lane) {
    bfr* RK = (bfr*)(p.ACT + A_RKVZ); bfr* WMb = (bfr*)(p.ACT + A_WM); bfr* AMb = (bfr*)(p.ACT + A_AM);
#pragma unroll
    for (int ni = 0; ni < 4; ni++)
#pragma unroll
      for (int mi = 0; mi < 4; mi++) {
        int row = m0 + mi * 16 + (lane & 15), n = n0 + ni * 16 + (lane >> 4) * 4;
        if (n < 4096) store4b(RK + (size_t)row * 4096 + n, acc[ni][mi]);
        else if (n < 4224) { f32x4 t;
#pragma unroll
          for (int q = 0; q < 4; q++) t[q] = tanhf(acc[ni][mi][q]); store4b(WMb + (size_t)row * 128 + (n - 4096), t); }
        else store4b(AMb + (size_t)row * 128 + (n - 4224), acc[ni][mi]);
      }
  } };
struct G_R7Out { static constexpr int KT = 16, NT = 8;
  static __device__ __forceinline__ const bfr* aptr(const P& p, const Ctx& c, int row, int kt, int nt) { return p.H + (size_t)row * 1024 + kt * 64; }
  static __device__ __forceinline__ const bfr* bptr(const P& p, const Ctx& c, int n, int kt) { return p.W + WR_OUT + (size_t)n * 1024 + kt * 64; }
  static __device__ __forceinline__ void epi(const P& p, const Ctx& c, f32x4 (&acc)[4][4], int m0, int n0, int lane) { epi_resid(p, c, acc, m0, n0, lane); } };


namespace pg8 {
#define PG8_LAS __attribute__((address_space(3)))
constexpr int BM = 256, BK = 64, HALF = 128, HTB = HALF * BK * 2, NXCD = 8, WGM = 8;
__device__ __forceinline__ int lds_byte(int r, int c) { const int st = (r >> 4) * 2 + (c >> 5), rr = r & 15, cc = c & 31, ob = rr * 64 + cc * 2; return st * 1024 + (ob ^ (((ob >> 9) & 1) << 5)); }
__device__ __forceinline__ void stage_rc(int b, int& R, int& C) { const int st = b / 1024, sb = b % 1024, swz = sb ^ (((sb >> 9) & 1) << 5); R = (st >> 1) * 16 + swz / 64; C = (st & 1) * 32 + (swz % 64) / 2; }
struct Unit { int pm, pn; };
struct Gemm { const bfr* A; const bfr* Bt; int M, N, K; };
struct StaticOrder {
  int nM, nN, nwg, G, c;
  __device__ void init(int M, int N, int G_, int c_) { nM = M / BM; nN = N / BM; nwg = nM * nN; G = G_; c = c_; }
  __device__ bool next(int i, Unit& u) const {
    const long L = (long)i * G + c; if (L >= nwg) return false;
    int wgid = (int)L; { const int q = nwg / NXCD, r = nwg % NXCD, xcd = wgid % NXCD, off = wgid / NXCD; wgid = (xcd < r ? xcd * (q + 1) : r * (q + 1) + (xcd - r) * q) + off; }
    const int nig = WGM * nN, gid = wgid / nig, fm = gid * WGM, gsz = (nM - fm) < WGM ? (nM - fm) : WGM;
    u.pm = fm + ((wgid % nig) % gsz); u.pn = (wgid % nig) / gsz; return true;
  }
};
template <class Epi>
__device__ __forceinline__ void gemm_phase(PG8_LAS unsigned char* lds, const Gemm g, const StaticOrder& S, const Epi& E) {
  const int tid = ltid(), wid = __builtin_amdgcn_readfirstlane(tid >> 6), lane = tid & 63, wr = wid >> 2, wc = wid & 3, fr = lane & 15, fq = lane >> 4;
  const int K = g.K, nt = K / BK;
  unsigned voffA[2], voffB[2];
#pragma unroll
  for (int i = 0; i < 2; ++i) { int R, C; stage_rc(tid * 16 + i * 8192, R, C); voffA[i] = (unsigned)(R * K + C) * 2u; voffB[i] = voffA[i]; }
  const size_t kstep = (size_t)(BK * 2);
  const size_t hstep = (size_t)HALF * K * 2;
  const size_t tstep = 2 * hstep;
  const unsigned ldsw = (unsigned)wid * 1024u;
  const int aoff = lds_byte(wr * 64 + fr, fq * 8), boff = lds_byte(wc * 32 + fr, fq * 8);
#define PG8_SA(b, h) (((b) * 2 + (h)) * HTB)
#define PG8_SB(b, h) ((4 + (b) * 2 + (h)) * HTB)
#define PG8_STAGE(bufoff, gbase, voff) do { _Pragma("unroll") for (int _i = 0; _i < 2; ++_i) \
    __builtin_amdgcn_global_load_lds((const unsigned*)((const char*)(gbase) + (voff)[_i]), (PG8_LAS unsigned*)(lds + (bufoff) + ldsw + _i * 8192), 16, 0, 0); } while (0)
#define PG8_LDA(dst, b, h) do { _Pragma("unroll") for (int m = 0; m < 4; ++m) _Pragma("unroll") for (int k = 0; k < 2; ++k) dst[m][k] = *(const PG8_LAS bf16x8*)(lds + PG8_SA(b, h) + aoff + m * 2048 + k * 1024); } while (0)
#define PG8_LDB(dst, b, h) do { _Pragma("unroll") for (int n = 0; n < 2; ++n) _Pragma("unroll") for (int k = 0; k < 2; ++k) dst[n][k] = *(const PG8_LAS bf16x8*)(lds + PG8_SB(b, h) + boff + n * 2048 + k * 1024); } while (0)
#define PG8_MMA(ai, bj, At, Bt) do { __builtin_amdgcn_s_setprio(1); _Pragma("unroll") for (int m = 0; m < 4; ++m) _Pragma("unroll") for (int n = 0; n < 2; ++n) _Pragma("unroll") for (int k = 0; k < 2; ++k) \
    acc[ai][bj][m][n] = __builtin_amdgcn_mfma_f32_16x16x32_bf16(Bt[n][k], At[m][k], acc[ai][bj][m][n], 0, 0, 0); __builtin_amdgcn_s_setprio(0); } while (0)
#define PG8_WAIT_V(n) asm volatile("s_waitcnt vmcnt(" #n ")" ::: "memory")
#define PG8_WAIT_L(n) asm volatile("s_waitcnt lgkmcnt(" #n ")" ::: "memory")
#define PG8_BAR __builtin_amdgcn_s_barrier()
#define PG8_SCHED __builtin_amdgcn_sched_barrier(0)
  Unit cur, nxt; int ui = 0;
  if (!S.next(0, cur)) return;
  f32x4 acc[2][2][4][2];
#pragma unroll
  for (int a = 0; a < 2; ++a)
#pragma unroll
    for (int b = 0; b < 2; ++b)
#pragma unroll
      for (int m = 0; m < 4; ++m)
#pragma unroll
        for (int n = 0; n < 2; ++n) acc[a][b][m][n] = (f32x4){0.f, 0.f, 0.f, 0.f};
  bf16x8 At[4][2], B0[2][2], B1[2][2];
  const char* cA = (const char*)g.A + (size_t)cur.pm * tstep; const char* cB = (const char*)g.Bt + (size_t)cur.pn * tstep;
  PG8_STAGE(PG8_SB(0, 0), cB, voffB); PG8_STAGE(PG8_SA(0, 0), cA, voffA); PG8_STAGE(PG8_SB(0, 1), cB + hstep, voffB); PG8_STAGE(PG8_SA(0, 1), cA + hstep, voffA);
  if (wr == 1) PG8_BAR;
  PG8_WAIT_V(4); PG8_BAR;
  PG8_STAGE(PG8_SB(1, 0), cB + kstep, voffB); PG8_STAGE(PG8_SA(1, 0), cA + kstep, voffA); PG8_STAGE(PG8_SB(1, 1), cB + hstep + kstep, voffB);
  PG8_WAIT_V(6); PG8_BAR;
  for (;;) {
    const bool has_next = S.next(ui + 1, nxt);
    const char* nA = has_next ? (const char*)g.A + (size_t)nxt.pm * tstep : cA; const char* nB = has_next ? (const char*)g.Bt + (size_t)nxt.pn * tstep : cB;
    for (int t = 0; t < nt; t += 2) {
      const bool last = (t == nt - 2);
      const char* a1 = cA + (size_t)(t + 1) * kstep;
      const char* a2 = last ? nA : cA + (size_t)(t + 2) * kstep; const char* b2 = last ? nB : cB + (size_t)(t + 2) * kstep;
      const char* a3 = a2 + kstep; const char* b3 = b2 + kstep;
      PG8_LDB(B0, 0, 0); PG8_SCHED; PG8_LDA(At, 0, 0); PG8_STAGE(PG8_SA(1, 1), a1 + hstep, voffA);
      PG8_WAIT_L(8); PG8_BAR; PG8_WAIT_L(0); PG8_MMA(0, 0, At, B0); PG8_BAR; PG8_SCHED;
      PG8_LDB(B1, 0, 1); PG8_STAGE(PG8_SB(0, 0), b2, voffB);
      PG8_BAR; PG8_WAIT_L(0); PG8_MMA(0, 1, At, B1); PG8_BAR;
      PG8_LDA(At, 0, 1); PG8_STAGE(PG8_SA(0, 0), a2, voffA);
      PG8_BAR; PG8_WAIT_L(0); PG8_MMA(1, 0, At, B0); PG8_BAR; PG8_SCHED;
      PG8_STAGE(PG8_SB(0, 1), b2 + hstep, voffB);
      PG8_WAIT_V(6); PG8_BAR; PG8_MMA(1, 1, At, B1); PG8_BAR;
      PG8_LDB(B0, 1, 0); PG8_SCHED; PG8_LDA(At, 1, 0); PG8_STAGE(PG8_SA(0, 1), a2 + hstep, voffA);
      PG8_WAIT_L(8); PG8_BAR; PG8_WAIT_L(0); PG8_MMA(0, 0, At, B0); PG8_BAR; PG8_SCHED;
      PG8_LDB(B1, 1, 1); PG8_STAGE(PG8_SB(1, 0), b3, voffB);
      PG8_BAR; PG8_WAIT_L(0); PG8_MMA(0, 1, At, B1); PG8_BAR;
      PG8_LDA(At, 1, 1); PG8_STAGE(PG8_SA(1, 0), a3, voffA);
      PG8_BAR; PG8_WAIT_L(0); PG8_MMA(1, 0, At, B0); PG8_BAR; PG8_SCHED;
      PG8_STAGE(PG8_SB(1, 1), b3 + hstep, voffB);
      PG8_WAIT_V(6); PG8_BAR; PG8_MMA(1, 1, At, B1); PG8_BAR;
    }
    E(acc, cur, wr, wc, fr, fq);
    if (!has_next) break;
#pragma unroll
    for (int a = 0; a < 2; ++a)
#pragma unroll
      for (int b = 0; b < 2; ++b)
#pragma unroll
        for (int m = 0; m < 4; ++m)
#pragma unroll
          for (int n = 0; n < 2; ++n) acc[a][b][m][n] = (f32x4){0.f, 0.f, 0.f, 0.f};
    cur = nxt; cA = nA; cB = nB; ++ui;
  }
  PG8_WAIT_V(0);
  if (wr == 0) PG8_BAR;
  PG8_BAR;
#undef PG8_SA
#undef PG8_SB
#undef PG8_STAGE
#undef PG8_LDA
#undef PG8_LDB
#undef PG8_MMA
#undef PG8_WAIT_V
#undef PG8_WAIT_L
#undef PG8_BAR
#undef PG8_SCHED
}
}

template <class F> struct EpiAd {
  F f;
  __device__ __forceinline__ void operator()(const f32x4 (&acc)[2][2][4][2], const pg8::Unit& u, int wr, int wc, int fr, int fq) const {
#pragma unroll
    for (int ai = 0; ai < 2; ++ai)
#pragma unroll
      for (int m = 0; m < 4; ++m) { const int row = u.pm * 256 + ai * 128 + wr * 64 + m * 16 + fr;
#pragma unroll
        for (int bj = 0; bj < 2; ++bj)
#pragma unroll
          for (int n = 0; n < 2; ++n) f(row, u.pn * 256 + bj * 128 + wc * 32 + n * 16 + 4 * fq, acc[ai][bj][m][n]); }
  }
};
template <class F> __device__ __forceinline__ void big_gemm(char* smem, const bfr* A, const bfr* Bt, int N, int K, F f) {
  pg8::Gemm g; g.A = A; g.Bt = Bt; g.M = R_; g.N = N; g.K = K;
  pg8::StaticOrder S; S.init(R_, N, (int)gridDim.x, (int)blockIdx.x);
  EpiAd<F> E{f};
  pg8::gemm_phase(( __attribute__((address_space(3))) unsigned char*)smem, g, S, E);
}
struct F_LruIn { char* ACT; __device__ __forceinline__ void operator()(int row, int n, f32x4 v) const {
  bfr* dst = n < 1280 ? (bfr*)(ACT + A_U) + (size_t)row * 1280 + n : (bfr*)(ACT + A_Z) + (size_t)row * 1280 + (n - 1280); store4b(dst, v); } };
struct F_Resid { float* Xx; float* Xc; const float* MODg; int wc; __device__ __forceinline__ void operator()(int row, int n, f32x4 v) const {
  int b = row / BT_, o = row - b * BT_; bool isc = o < 256; if (isc && !wc) return;
  float* xr = isc ? Xc + (size_t)(b * 256 + o) * 1024 : Xx + (size_t)(b * 16384 + o - 256) * 1024; const float* g = MODg + (size_t)(isc ? 2 : b) * 3072 + 2048;
  float4 xv = *(float4*)(xr + n); float4 gg = *(const float4*)(g + n);
  xv.x += gg.x * v[0]; xv.y += gg.y * v[1]; xv.z += gg.z * v[2]; xv.w += gg.w * v[3]; *(float4*)(xr + n) = xv; } };
struct F_MlIn { char* ACT; __device__ __forceinline__ void operator()(int row, int n, f32x4 v) const {
  if (n < 4096) store4b((bfr*)(ACT + A_QKV) + (size_t)row * 4096 + n, v);
  else if (n < 4128) *(float4*)((float*)(ACT + A_GATE) + (size_t)row * 32 + (n - 4096)) = float4{v[0], v[1], v[2], v[3]}; } };
struct F_MlZ { char* ACT; const float* ng; __device__ __forceinline__ void operator()(int row, int n, f32x4 v) const {
  bfr* hp = (bfr*)(ACT + A_HS) + (size_t)row * 2048 + n; uint2 u = *(const uint2*)hp; float rs = ((const float*)(ACT + A_RSTD))[(size_t)row * 8 + (n >> 8)];
  float4 g4 = *(const float4*)(ng + n); f32x4 o;
  o[0] = blo(u.x) * rs * g4.x * siluf(v[0]); o[1] = bhi(u.x) * rs * g4.y * siluf(v[1]); o[2] = blo(u.y) * rs * g4.z * siluf(v[2]); o[3] = bhi(u.y) * rs * g4.w * siluf(v[3]);
  store4b(hp, o); } };
struct F_R7In { char* ACT; __device__ __forceinline__ void operator()(int row, int n, f32x4 v) const {
  if (n < 4096) store4b((bfr*)(ACT + A_RKVZ) + (size_t)row * 4096 + n, v);
  else if (n < 4224) { f32x4 t;
#pragma unroll
    for (int q = 0; q < 4; q++) t[q] = tanhf(v[q]);
    store4b((bfr*)(ACT + A_WM) + (size_t)row * 128 + (n - 4096), t); }
  else store4b((bfr*)(ACT + A_AM) + (size_t)row * 128 + (n - 4224), v); } };

template <class G> __device__ __forceinline__ void gemm_phase(const P& p, const Ctx& c, char* smem) {
  const int total = 130 * G::NT;
  for (int it = blockIdx.x; it < total; it += gridDim.x) gemm_tile<G>(p, c, it / G::NT, it % G::NT, smem);
}

__device__ __forceinline__ void ph_pre(const P& p, char* smem) {
  float* sm = (float*)smem; const int tid = ltid();
  const int nprep = prep_count(0), ngemv = 192, ncopy = 4160;
  for (int it = blockIdx.x; it < nprep + ngemv + ncopy; it += gridDim.x) {
    if (it < nprep) { prep_item(p, 0, it, sm); continue; }
    int i2 = it - nprep;
    if (i2 < ngemv) {
      int l = i2 / 48, cgp = i2 % 48;
      for (int i = tid; i < 3072; i += 512) { int cnd = i >> 10, k = i & 1023; float v = cnd == 0 ? p.c[k] : cnd == 1 ? p.c[1024 + k] : p.c_ctx[k]; sm[i] = siluf(v); }
      __syncthreads();
      int kq = tid >> 6, col = cgp * 64 + (tid & 63); const float* w = p.mod_w + (size_t)l * 1024 * 3072 + col;
      float a0 = 0.f, a1 = 0.f, a2 = 0.f;
      for (int k = kq * 128; k < kq * 128 + 128; k++) { float wv = w[(size_t)k * 3072]; a0 += sm[k] * wv; a1 += sm[1024 + k] * wv; a2 += sm[2048 + k] * wv; }
      float* red = sm + 3072; red[tid * 3] = a0; red[tid * 3 + 1] = a1; red[tid * 3 + 2] = a2;
      __syncthreads();
      if (tid < 64) { float bias = p.mod_b[(size_t)l * 3072 + col];
        for (int cnd = 0; cnd < 3; cnd++) { float s = bias; for (int q = 0; q < 8; q++) s += red[(q * 64 + tid) * 3 + cnd]; p.MOD[(size_t)(l * 3 + cnd) * 3072 + col] = s; } }
      __syncthreads();
      continue;
    }
    i2 -= ngemv;
    for (int q = 0; q < 4; q++) { int idx = i2 * 2048 + q * 512 + tid; int row = idx >> 8, c4 = idx & 255; int b = row / BT_, o = row - b * BT_;
      if (o < 256) ((float4*)p.Xc)[(size_t)(b * 256 + o) * 256 + c4] = ((const float4*)p.ctx)[(size_t)(b * 256 + o) * 256 + c4];
      else ((float4*)p.Xx)[(size_t)(b * 16384 + o - 256) * 256 + c4] = ((const float4*)p.x)[(size_t)(b * 16384 + o - 256) * 256 + c4]; }
  }
}
__device__ __forceinline__ void ph_norm(const P& p, int layer, char* smem) {
  const int tid = ltid(), lane = tid & 63, wid = tid >> 6;
  const int nprep = layer > 0 ? prep_count(layer) : 0; const int kind = layer % 3;
  const int nzero = kind == 1 ? 8320 : 0;
  (void)nzero;
  for (int it = blockIdx.x; it < nprep + 4160; it += gridDim.x) {
    if (it < nprep) { prep_item(p, layer, it, (float*)smem); continue; }
    int row = (it - nprep) * 8 + wid; int mo; const float* xr = xrowp(p, row, mo);
    float4 v[4]; float ss = 0.f;
#pragma unroll
    for (int i = 0; i < 4; i++) { v[i] = *(const float4*)(xr + lane * 4 + 256 * i); ss += v[i].x * v[i].x + v[i].y * v[i].y + v[i].z * v[i].z + v[i].w * v[i].w; }
    ss = wsum(ss); float rs = rsqrtf(ss * (1.f / 1024.f) + 1e-6f);
    const float* g = p.norm_g + (size_t)layer * 1024; const float* md = p.MOD + (size_t)(layer * 3 + mo) * 3072;
#pragma unroll
    for (int i = 0; i < 4; i++) { int cidx = lane * 4 + 256 * i; float4 gg = *(const float4*)(g + cidx), sh = *(const float4*)(md + cidx), sc = *(const float4*)(md + 1024 + cidx);
      f32x4 o; o[0] = v[i].x * rs * gg.x * (1.f + sc.x) + sh.x; o[1] = v[i].y * rs * gg.y * (1.f + sc.y) + sh.y; o[2] = v[i].z * rs * gg.z * (1.f + sc.z) + sh.z; o[3] = v[i].w * rs * gg.w * (1.f + sc.w) + sh.w;
      store4b(p.H + (size_t)row * (kind == 2 ? 2048 : 1024) + cidx, o); }
  }
}
__device__ __forceinline__ void ph_r7_shift(const P& p) {
  for (int it = blockIdx.x; it < 8320; it += gridDim.x) {
    int idx = it * 512 + ltid(); int row = idx >> 7, c8 = idx & 127, q = c8 >> 5;
    int b = row / BT_, o = row - b * BT_; int nr = -1;
    if (o < 256) { if (q < 2) { if (o >= 1) nr = row - 1; } else { if (o < 255) nr = row + 1; } }
    else { int t = o - 256, col = t & 63, gr = t >> 6;
      if (q == 0) { if (col != 0) nr = row - 1; } else if (q == 1) { if (col != 63) nr = row + 1; }
      else if (q == 2) { if (gr != 0) nr = row - 64; } else { if (gr != 255) nr = row + 64; } }
    uint4 v = nr >= 0 ? *(const uint4*)(p.H + (size_t)nr * 2048 + c8 * 8) : uint4{0u, 0u, 0u, 0u};
    *(uint4*)(p.H + (size_t)row * 2048 + 1024 + c8 * 8) = v;
  }
}
__device__ __forceinline__ void ph_final(const P& p) {
  const int lane = ltid() & 63, wid = ltid() >> 6;
  for (int it = blockIdx.x; it < 4096; it += gridDim.x) {
    float* xr = p.Xx + (size_t)(it * 8 + wid) * 1024; float4 v[4]; float ss = 0.f;
#pragma unroll
    for (int i = 0; i < 4; i++) { v[i] = *(const float4*)(xr + lane * 4 + 256 * i); ss += v[i].x * v[i].x + v[i].y * v[i].y + v[i].z * v[i].z + v[i].w * v[i].w; }
    ss = wsum(ss); float rs = rsqrtf(ss * (1.f / 1024.f) + 1e-6f);
#pragma unroll
    for (int i = 0; i < 4; i++) { int cidx = lane * 4 + 256 * i; float4 gg = *(const float4*)(p.final_g + cidx);
      *(float4*)(xr + cidx) = float4{v[i].x * rs * gg.x, v[i].y * rs * gg.y, v[i].z * rs * gg.z, v[i].w * rs * gg.w}; }
  }
}
__device__ __forceinline__ void ph_lru_conv(const P& p, int j) {
  const bfr* U = (const bfr*)(p.ACT + A_U); bfr* UC = (bfr*)(p.ACT + A_UC);
  const float* cw = p.lru_conv_w + (size_t)j * 4 * 1280; const float* cb = p.lru_conv_b + (size_t)j * 1280;
  for (int it = blockIdx.x; it < 10400; it += gridDim.x) {
    int idx = it * 512 + ltid(); int row = idx / 160, cgp = idx % 160, ch = cgp * 8;
    int b = row / BT_, o = row - b * BT_; int s0 = o < 256 ? 0 : 256, e0 = o < 256 ? 256 : BT_;
    float acc[8];
#pragma unroll
    for (int e = 0; e < 8; e++) acc[e] = cb[ch + e];
#pragma unroll
    for (int t = 0; t < 4; t++) { int oo = o + t - 2; if (oo < s0 || oo >= e0) continue;
      uint4 u = *(const uint4*)(U + (size_t)(row + t - 2) * 1280 + ch); const float* w = cw + t * 1280 + ch;
      acc[0] += w[0] * blo(u.x); acc[1] += w[1] * bhi(u.x); acc[2] += w[2] * blo(u.y); acc[3] += w[3] * bhi(u.y);
      acc[4] += w[4] * blo(u.z); acc[5] += w[5] * bhi(u.z); acc[6] += w[6] * blo(u.w); acc[7] += w[7] * bhi(u.w); }
    *(uint4*)(UC + (size_t)row * 1280 + ch) = uint4{pk2(acc[0], acc[1]), pk2(acc[2], acc[3]), pk2(acc[4], acc[5]), pk2(acc[6], acc[7])};
  }
}
__device__ __forceinline__ void ph_lru_s1(const P& p, int d) {
  const unsigned* AB = (const unsigned*)(p.ACT + A_AB); float2* AGG = (float2*)(p.ACT + A_AGG);
  const int t = ltid();
  for (int it = blockIdx.x * 8 + (t >> 6); it < 2600; it += gridDim.x * 8) {
    int b = it / 1300, r = it % 1300, cc = r / 5, ch = (r % 5) * 256 + (t & 63) * 4;
    float P0 = 1.f, Q0 = 0.f, P1 = 1.f, Q1 = 0.f, P2 = 1.f, Q2 = 0.f, P3 = 1.f, Q3 = 0.f;
#pragma unroll 8
    for (int q = 0; q < 64; q++) { uint4 u = *(const uint4*)(AB + (size_t)rowmap(d, b, cc * 64 + q) * 1280 + ch);
      float a0 = 1.f - bhi(u.x), a1 = 1.f - bhi(u.y), a2 = 1.f - bhi(u.z), a3 = 1.f - bhi(u.w);
      P0 *= a0; Q0 = a0 * Q0 + blo(u.x); P1 *= a1; Q1 = a1 * Q1 + blo(u.y); P2 *= a2; Q2 = a2 * Q2 + blo(u.z); P3 *= a3; Q3 = a3 * Q3 + blo(u.w); }
    float4* ag = (float4*)(AGG + (size_t)(b * NCH_ + cc) * 1280 + ch); ag[0] = float4{P0, Q0, P1, Q1}; ag[1] = float4{P2, Q2, P3, Q3};
  }
}
__device__ __forceinline__ void ph_lru_s2(const P& p) {
  const float2* AGG = (const float2*)(p.ACT + A_AGG); float* CAR = (float*)(p.ACT + A_CAR);
  for (int it = blockIdx.x; it < 5; it += gridDim.x) {
    int idx = it * 512 + ltid(), b = idx / 1280, ch = idx % 1280; float h = 0.f;
#pragma unroll 20
    for (int cc = 0; cc < NCH_; cc++) { size_t o = (size_t)(b * NCH_ + cc) * 1280 + ch; float2 a = AGG[o]; CAR[o] = h; h = a.x * h + a.y; }
  }
}
__device__ __forceinline__ void ph_lru_s3(const P& p, int d) {
  const unsigned* AB = (const unsigned*)(p.ACT + A_AB); const float* CAR = (const float*)(p.ACT + A_CAR);
  bfr* HF = (bfr*)(p.ACT + A_HF); bfr* Z = (bfr*)(p.ACT + A_Z);
  const int t = ltid();
  for (int it = blockIdx.x * 8 + (t >> 6); it < 2600; it += gridDim.x * 8) {
    int b = it / 1300, r = it % 1300, cc = r / 5, ch = (r % 5) * 256 + (t & 63) * 4;
    float4 h = *(const float4*)(CAR + (size_t)(b * NCH_ + cc) * 1280 + ch);
#pragma unroll 8
    for (int q = 0; q < 64; q++) { size_t o = (size_t)rowmap(d, b, cc * 64 + q) * 1280 + ch; uint4 u = *(const uint4*)(AB + o);
      h.x = (1.f - bhi(u.x)) * h.x + blo(u.x); h.y = (1.f - bhi(u.y)) * h.y + blo(u.y); h.z = (1.f - bhi(u.z)) * h.z + blo(u.z); h.w = (1.f - bhi(u.w)) * h.w + blo(u.w);
      if (d == 0) *(uint2*)(HF + o) = uint2{pk2(h.x, h.y), pk2(h.z, h.w)};
      else { uint2 hf = *(const uint2*)(HF + o), zz = *(const uint2*)(Z + o);
        *(uint2*)(Z + o) = uint2{pk2((blo(hf.x) + h.x) * siluf(blo(zz.x)), (bhi(hf.x) + h.y) * siluf(bhi(zz.x))), pk2((blo(hf.y) + h.z) * siluf(blo(zz.y)), (bhi(hf.y) + h.w) * siluf(bhi(zz.y)))}; } }
  }
}
__device__ __forceinline__ void ph_ml_stat(const P& p) {
  const bfr* HS = (const bfr*)(p.ACT + A_HS); float* RS = (float*)(p.ACT + A_RSTD);
  const int lane = ltid() & 63, wid = ltid() >> 6;
  for (int it = blockIdx.x; it < 4160; it += gridDim.x) {
    int row = it * 8 + wid; const bfr* hp = HS + (size_t)row * 2048 + lane * 32; float ss = 0.f;
#pragma unroll
    for (int i = 0; i < 4; i++) { uint4 u = *(const uint4*)(hp + i * 8); float a;
      a = blo(u.x); ss += a * a; a = bhi(u.x); ss += a * a; a = blo(u.y); ss += a * a; a = bhi(u.y); ss += a * a;
      a = blo(u.z); ss += a * a; a = bhi(u.z); ss += a * a; a = blo(u.w); ss += a * a; a = bhi(u.w); ss += a * a; }
    ss += __shfl_xor(ss, 1); ss += __shfl_xor(ss, 2); ss += __shfl_xor(ss, 4);
    if ((lane & 7) == 0) RS[(size_t)row * 8 + (lane >> 3)] = rsqrtf(ss * (1.f / 256.f) + 1e-6f);
  }
}
__device__ __forceinline__ void ph_r7_fin(const P& p, int j) {
  bfr* Y = (bfr*)(p.ACT + A_Y); const bfr* RK = (const bfr*)(p.ACT + A_RKVZ); const float* BON = (const float*)(p.ACT + A_BON);
  const float* lg = p.r7_ln_g + (size_t)j * 1024; const float* lb = p.r7_ln_b + (size_t)j * 1024;
  const int lane = ltid() & 63, wid = ltid() >> 6;
  for (int it = blockIdx.x; it < 4160; it += gridDim.x) {
    int row = it * 8 + wid, ch = lane * 16, hd = lane >> 2;
    float y[16], v[16], z[16];
#pragma unroll
    for (int i = 0; i < 2; i++) {
      uint4 u = *(const uint4*)(Y + (size_t)row * 1024 + ch + i * 8);
      y[i * 8 + 0] = blo(u.x); y[i * 8 + 1] = bhi(u.x); y[i * 8 + 2] = blo(u.y); y[i * 8 + 3] = bhi(u.y); y[i * 8 + 4] = blo(u.z); y[i * 8 + 5] = bhi(u.z); y[i * 8 + 6] = blo(u.w); y[i * 8 + 7] = bhi(u.w);
      u = *(const uint4*)(RK + (size_t)row * 4096 + 2048 + ch + i * 8);
      v[i * 8 + 0] = blo(u.x); v[i * 8 + 1] = bhi(u.x); v[i * 8 + 2] = blo(u.y); v[i * 8 + 3] = bhi(u.y); v[i * 8 + 4] = blo(u.z); v[i * 8 + 5] = bhi(u.z); v[i * 8 + 6] = blo(u.w); v[i * 8 + 7] = bhi(u.w);
      u = *(const uint4*)(RK + (size_t)row * 4096 + 3072 + ch + i * 8);
      z[i * 8 + 0] = blo(u.x); z[i * 8 + 1] = bhi(u.x); z[i * 8 + 2] = blo(u.y); z[i * 8 + 3] = bhi(u.y); z[i * 8 + 4] = blo(u.z); z[i * 8 + 5] = bhi(u.z); z[i * 8 + 6] = blo(u.w); z[i * 8 + 7] = bhi(u.w);
    }
    float s = 0.f;
#pragma unroll
    for (int e = 0; e < 16; e++) s += y[e];
    s += __shfl_xor(s, 1); s += __shfl_xor(s, 2); float mean = s * (1.f / 64.f);
    float q = 0.f;
#pragma unroll
    for (int e = 0; e < 16; e++) { float dlt = y[e] - mean; q += dlt * dlt; }
    q += __shfl_xor(q, 1); q += __shfl_xor(q, 2); float rs = rsqrtf(q * (1.f / 64.f) + 64e-5f);
    float bon = BON[(size_t)row * 16 + hd] + BON[(size_t)(R_ + row) * 16 + hd];
    float o[16];
#pragma unroll
    for (int e = 0; e < 16; e++) { float yn = (y[e] - mean) * rs * lg[ch + e] + lb[ch + e]; o[e] = (yn + bon * v[e]) * siluf(z[e]); }
#pragma unroll
    for (int i = 0; i < 2; i++)
      *(uint4*)(Y + (size_t)row * 1024 + ch + i * 8) = uint4{pk2(o[i * 8], o[i * 8 + 1]), pk2(o[i * 8 + 2], o[i * 8 + 3]), pk2(o[i * 8 + 4], o[i * 8 + 5]), pk2(o[i * 8 + 6], o[i * 8 + 7])};
  }
}

#define QS 136
#define VS 72
#define MLG_BYTES 45056
__device__ __forceinline__ void ph_ml_scan(const P& p, int j, char* smem0) {
  const int d = ltid() >> 8;
  char* smem = smem0 + d * MLG_BYTES;
  bfr* sQ = (bfr*)smem; bfr* sK = sQ + 64 * QS; bfr* sVT = sK + 64 * QS; bfr* sCT = sVT + 16 * VS;
  float* sN = (float*)(sCT + 16 * QS);
  float* sEs = sN + 128; float* sCt = sEs + 64; float* sBc = sCt + 64; float* sWg = sBc + 64; float* sNr = sWg + 64;
  const bfr* QKV = (const bfr*)(p.ACT + A_QKV); const float* GT = (const float*)(p.ACT + A_GATE); bfr* HS = (bfr*)(p.ACT + A_HS);
  const float* gbias = p.ml_gate_b + (size_t)j * 32;
  const int tid = ltid() & 255, lane = tid & 63, w = tid >> 6, l15 = lane & 15, q4 = lane >> 4;
  for (int it = blockIdx.x; it < 256; it += gridDim.x) {
    const int b = it >> 7, hh = (it >> 4) & 7, sl = it & 15;
    f32x4 Cacc[2];
    Cacc[0] = f32x4{0.f, 0.f, 0.f, 0.f}; Cacc[1] = f32x4{0.f, 0.f, 0.f, 0.f};
    float mcur = 0.f;
    for (int i = tid; i < 16 * QS; i += 256) sCT[i] = 0;
    if (tid < 128) sN[tid] = 0.f;
    uint4 pq0, pq1, pq2, pq3, pk0, pk1, pk2, pk3, pv = uint4{0u, 0u, 0u, 0u}; float pgi, pgf;
#define ML_ROW0(s_) (d == 0 ? b * BT_ + 64 * (s_) : rowmap(1, b, 64 * (s_) + 63))
#define ML_LD(i_, PQ, PK) { int idx = tid + 256 * (i_), rho = idx >> 4, c8 = idx & 15; const bfr* src = QKV + (size_t)(r0n + rho) * 4096 + hh * 128 + c8 * 8; PQ = *(const uint4*)src; PK = *(const uint4*)(src + 1024); }
#define ML_ISSUE(s_) { const int r0n = ML_ROW0(s_); ML_LD(0, pq0, pk0) ML_LD(1, pq1, pk1) ML_LD(2, pq2, pk2) ML_LD(3, pq3, pk3) \
      if (tid < 128) pv = *(const uint4*)(QKV + (size_t)(r0n + (tid >> 1)) * 4096 + 2048 + hh * 256 + sl * 16 + (tid & 1) * 8); \
      { const float* gp_ = GT + (size_t)(r0n + (d ? 63 - lane : lane)) * 32 + d * 16 + hh; pgi = gp_[0]; pgf = gp_[8]; } }
#define ML_ST(i_, PQ, PK) { int idx = tid + 256 * (i_), rho = idx >> 4, c8 = idx & 15; *(uint4*)(sQ + rho * QS + c8 * 8) = PQ; *(uint4*)(sK + rho * QS + c8 * 8) = PK; }
#define ML_COMMIT() { ML_ST(0, pq0, pk0) ML_ST(1, pq1, pk1) ML_ST(2, pq2, pk2) ML_ST(3, pq3, pk3) \
      if (tid < 128) { int rho = tid >> 1, vb = (tid & 1) * 8; \
        sVT[(vb + 0) * VS + rho] = (bfr)(pv.x & 0xffff); sVT[(vb + 1) * VS + rho] = (bfr)(pv.x >> 16); \
        sVT[(vb + 2) * VS + rho] = (bfr)(pv.y & 0xffff); sVT[(vb + 3) * VS + rho] = (bfr)(pv.y >> 16); \
        sVT[(vb + 4) * VS + rho] = (bfr)(pv.z & 0xffff); sVT[(vb + 5) * VS + rho] = (bfr)(pv.z >> 16); \
        sVT[(vb + 6) * VS + rho] = (bfr)(pv.w & 0xffff); sVT[(vb + 7) * VS + rho] = (bfr)(pv.w >> 16); } }
    ML_ISSUE(0)
    __syncthreads();
    for (int s = 0; s < NCH_; s++) {
      const int r0 = ML_ROW0(s);
      ML_COMMIT()
      float mxl, decay;
      {
        int rho = d ? 63 - lane : lane;
        float gi = pgi + gbias[(d * 2 + 0) * 8 + hh], gf = pgf + gbias[(d * 2 + 1) * 8 + hh];
        float fc = fminf(gf, 0.f) - __logf(1.f + __expf(-fabsf(gf)));
        float bc = fc;
        for (int o = 1; o < 64; o <<= 1) { float t = __shfl_up(bc, o); if (lane >= o) bc += t; }
        float e = gi - bc, pm = e;
        for (int o = 1; o < 64; o <<= 1) { float t = __shfl_up(pm, o); if (lane >= o) pm = fmaxf(pm, t); }
        float pml = __shfl(pm, 63), bcl = __shfl(bc, 63);
        mxl = fmaxf(mcur, pml); decay = __expf(mcur - mxl);
        if (w == 0) { sEs[rho] = e; sCt[rho] = -fmaxf(mcur, pm); sBc[rho] = bc; sWg[rho] = __expf(e - mxl); }
        pml = bcl + mxl;
        bcl = mcur; mcur = pml; pml = bcl;
        mxl = pml;
      }
      const float mold = mxl;
      __syncthreads();
      const int rt = 16 * w + l15;
      bfr* hp = HS + (size_t)(r0 + rt) * 2048 + hh * 256 + sl * 16 + 4 * q4;
      bool first; { int rc = (r0 - b * BT_) >> 6; if (d == 0) { int sp = rc < 4 ? 3 - rc : 263 - rc; first = s < sp; } else first = s < rc; }
      unsigned long long uu = 0ull;
      if (!first) uu = __hip_atomic_load((unsigned long long*)hp, __ATOMIC_RELAXED, __HIP_MEMORY_SCOPE_AGENT);
      if (s + 1 < NCH_) ML_ISSUE(s + 1)
      bf16x8 qf[4];
#pragma unroll
      for (int ks = 0; ks < 4; ks++) qf[ks] = *(const bf16x8*)(sQ + (16 * w + l15) * QS + ks * 32 + q4 * 8);
      f32x4 sacc[4];
#pragma unroll
      for (int a = 0; a < 4; a++) { sacc[a] = f32x4{0.f, 0.f, 0.f, 0.f};
#pragma unroll
        for (int ks = 0; ks < 4; ks++) { bf16x8 kf = *(const bf16x8*)(sK + (16 * a + l15) * QS + ks * 32 + q4 * 8); sacc[a] = __builtin_amdgcn_mfma_f32_16x16x32_bf16(kf, qf[ks], sacc[a], 0, 0, 0); } }
      const float ctt = sCt[rt]; float densum = 0.f;
#pragma unroll
      for (int a = 0; a < 4; a++)
#pragma unroll
        for (int jj = 0; jj < 4; jj++) { int rs_ = 16 * a + 4 * q4 + jj; bool valid = d == 0 ? rs_ <= rt : rs_ >= rt;
          float wv = valid ? __expf(ctt + sEs[rs_]) : 0.f; float sv = sacc[a][jj] * wv; sacc[a][jj] = sv; densum += sv; }
      densum += __shfl_xor(densum, 16); densum += __shfl_xor(densum, 32);
      bf16x8 sf[2], vf[2];
#pragma unroll
      for (int ks = 0; ks < 2; ks++) {
#pragma unroll
        for (int jj = 0; jj < 4; jj++) { sf[ks][jj] = (short)f2b(sacc[2 * ks][jj]); sf[ks][4 + jj] = (short)f2b(sacc[2 * ks + 1][jj]); }
        uint2 v0 = *(const uint2*)(sVT + l15 * VS + 32 * ks + 4 * q4), v1 = *(const uint2*)(sVT + l15 * VS + 32 * ks + 16 + 4 * q4);
        uint4 vv = uint4{v0.x, v0.y, v1.x, v1.y}; vf[ks] = *(bf16x8*)&vv;
      }
      f32x4 num = f32x4{0.f, 0.f, 0.f, 0.f}, numC = f32x4{0.f, 0.f, 0.f, 0.f};
#pragma unroll
      for (int ks = 0; ks < 2; ks++) num = __builtin_amdgcn_mfma_f32_16x16x32_bf16(vf[ks], sf[ks], num, 0, 0, 0);
#pragma unroll
      for (int ks = 0; ks < 4; ks++) { bf16x8 cf = *(const bf16x8*)(sCT + l15 * QS + ks * 32 + q4 * 8); numC = __builtin_amdgcn_mfma_f32_16x16x32_bf16(cf, qf[ks], numC, 0, 0, 0); }
      float qn = 0.f;
#pragma unroll
      for (int i = 0; i < 4; i++) { uint4 u = *(const uint4*)(sQ + rt * QS + 32 * q4 + i * 8); const float* nn = sN + 32 * q4 + i * 8;
        qn += blo(u.x) * nn[0] + bhi(u.x) * nn[1] + blo(u.y) * nn[2] + bhi(u.y) * nn[3] + blo(u.z) * nn[4] + bhi(u.z) * nn[5] + blo(u.w) * nn[6] + bhi(u.w) * nn[7]; }
      qn += __shfl_xor(qn, 16); qn += __shfl_xor(qn, 32);
      {
        float inter = __expf(mold + ctt); float den = densum + inter * qn; float dn = fmaxf(fabsf(den), __expf(ctt - sBc[rt])); float inv = __builtin_amdgcn_rcpf(dn);
        f32x4 hv;
#pragma unroll
        for (int jj = 0; jj < 4; jj++) hv[jj] = (num[jj] + inter * numC[jj]) * inv;
        if (!first) { unsigned ux = (unsigned)uu, uy = (unsigned)(uu >> 32);
          hv[0] += blo(ux); hv[1] += bhi(ux); hv[2] += blo(uy); hv[3] += bhi(uy); }
        store4b(hp, hv);
      }
      __syncthreads();
      {
        bf16x8 vw[2], wa[2];
#pragma unroll
        for (int ks = 0; ks < 2; ks++)
#pragma unroll
          for (int e = 0; e < 8; e++) { int rs_ = 32 * ks + (e < 4 ? 4 * q4 + e : 16 + 4 * q4 + e - 4); const float wg_ = sWg[rs_]; vw[ks][e] = (short)f2b(b2f((bfr)vf[ks][e]) * wg_); wa[ks][e] = l15 == 0 ? (short)f2b(wg_) : (short)0; }
#pragma unroll
        for (int a = 0; a < 2; a++) {
          int dk = 32 * w + 16 * a + l15;
#pragma unroll
          for (int jj = 0; jj < 4; jj++) Cacc[a][jj] *= decay;
          f32x4 nacc = f32x4{0.f, 0.f, 0.f, 0.f};
#pragma unroll
          for (int ks = 0; ks < 2; ks++) { bf16x8 kt;
#pragma unroll
            for (int e = 0; e < 8; e++) { int rs_ = 32 * ks + (e < 4 ? 4 * q4 + e : 16 + 4 * q4 + e - 4); kt[e] = (short)sK[rs_ * QS + dk]; }
            Cacc[a] = __builtin_amdgcn_mfma_f32_16x16x32_bf16(vw[ks], kt, Cacc[a], 0, 0, 0);
            nacc = __builtin_amdgcn_mfma_f32_16x16x32_bf16(wa[ks], kt, nacc, 0, 0, 0); }
          if (q4 == 0) sNr[dk] = nacc[0];
#pragma unroll
          for (int jj = 0; jj < 4; jj++) sCT[(4 * q4 + jj) * QS + dk] = f2b(Cacc[a][jj]);
        }
      }
      __syncthreads();
      if (tid < 128) sN[tid] = decay * sN[tid] + sNr[tid];
    }
    __syncthreads();
  }
}

#define CS 72
#define CSLOT(i_) ((bfr*)smem + (i_) * (64 * CS))
#define A_SST (A_R7B + 362086400ull)
__device__ __forceinline__ f32x4 cmm(const bfr* X, const bfr* YT, int ti, int tj, int l15, int q4) {
  f32x4 acc = f32x4{0.f, 0.f, 0.f, 0.f};
#pragma unroll
  for (int ks = 0; ks < 2; ks++) { bf16x8 a = *(const bf16x8*)(X + (16 * ti + l15) * CS + 32 * ks + 8 * q4); bf16x8 b = *(const bf16x8*)(YT + (16 * tj + l15) * CS + 32 * ks + 8 * q4);
    acc = __builtin_amdgcn_mfma_f32_16x16x32_bf16(a, b, acc, 0, 0, 0); }
  return acc;
}
template <int MODE> __device__ __forceinline__ f32x4 cmm_mask(const bfr* X, const bfr* YT, int ti, int tj, int l15, int q4) {
  f32x4 acc = f32x4{0.f, 0.f, 0.f, 0.f};
#pragma unroll
  for (int ks = 0; ks < 2; ks++) { const int kb = 2 * ks + (q4 >> 1);
    const bool ok = MODE == 1 ? ((kb == 0 && tj == 1) || (kb == 2 && tj == 3)) : (kb < 2 && tj >= 2);
    bf16x8 a = *(const bf16x8*)(X + (16 * ti + l15) * CS + 32 * ks + 8 * q4); bf16x8 bz = bf16x8{0, 0, 0, 0, 0, 0, 0, 0};
    if (ok) bz = *(const bf16x8*)(YT + (16 * tj + l15) * CS + 32 * ks + 8 * q4);
    acc = __builtin_amdgcn_mfma_f32_16x16x32_bf16(a, bz, acc, 0, 0, 0); }
  return acc;
}
__device__ __forceinline__ void st_row(bfr* dst, int r0, int c, f32x4 v) {
#pragma unroll
  for (int jj = 0; jj < 4; jj++) dst[(r0 + jj) * CS + c] = f2b(v[jj]); }
__device__ __forceinline__ void st_tr(bfr* dst, int r0, int c, f32x4 v) { store4b(dst + c * CS + r0, v); }
__device__ __forceinline__ f32x4 ld_row(const bfr* src, int r0, int c) { f32x4 v;
#pragma unroll
  for (int jj = 0; jj < 4; jj++) v[jj] = b2f(src[(r0 + jj) * CS + c]);
  return v; }
__device__ __forceinline__ f32x4 ld_tr(const bfr* src, int r0, int c) { uint2 u = *(const uint2*)(src + c * CS + r0); return f32x4{blo(u.x), bhi(u.x), blo(u.y), bhi(u.y)}; }

__device__ __forceinline__ void ph_r7_ca(const P& p, int j, int win, char* smem) {
  float* LW = (float*)(smem + 7 * 9216); float* AT = (float*)(smem + 9 * 9216); float* WL = (float*)(smem + 14 * 9216);
  const bfr* RK = (const bfr*)(p.ACT + A_RKVZ); const bfr* WMb = (const bfr*)(p.ACT + A_WM); const bfr* AMb = (const bfr*)(p.ACT + A_AM);
  float* BON = (float*)(p.ACT + A_BON); bfr* WB = p.H;
  const float* kkp = p.r7_k_k + (size_t)j * 1024; const float* kap = p.r7_k_a + (size_t)j * 1024; const float* rkp = p.r7_r_k + (size_t)j * 1024;
  const int tid = ltid(), lane = tid & 63, w = tid >> 6, l15 = lane & 15, q4 = lane >> 4, ti = w >> 1, tj0 = (w & 1) * 2;
  const int c0 = win * 65;
  for (int it = blockIdx.x; it < 4160; it += gridDim.x) {
    const int chain = it / 65, cl = it - chain * 65, c = c0 + cl, d = chain & 1, b = chain >> 5, h = (chain >> 1) & 15;
    {
      const int rowA = rowmap(d, b, 64 * c + 16 * ti + l15);
      const float* w0 = p.r7_w0 + (size_t)(j * 2 + d) * 1024 + h * 64; const float* a0 = p.r7_a0 + (size_t)(j * 2 + d) * 1024 + h * 64;
#pragma unroll
      for (int tt = 0; tt < 2; tt++) { const int tj = tj0 + tt; f32x4 aw = f32x4{0.f, 0.f, 0.f, 0.f}, aa = aw;
#pragma unroll
        for (int ks = 0; ks < 2; ks++) {
          bf16x8 xw = *(const bf16x8*)(WMb + (size_t)rowA * 128 + d * 64 + 32 * ks + 8 * q4), xa = *(const bf16x8*)(AMb + (size_t)rowA * 128 + d * 64 + 32 * ks + 8 * q4);
          bf16x8 yw = *(const bf16x8*)(p.W + WR_UP + d * 65536 + (size_t)(h * 64 + 16 * tj + l15) * 64 + 32 * ks + 8 * q4);
          bf16x8 ya = *(const bf16x8*)(p.W + WR_UP + (2 + d) * 65536 + (size_t)(h * 64 + 16 * tj + l15) * 64 + 32 * ks + 8 * q4);
          aw = __builtin_amdgcn_mfma_f32_16x16x32_bf16(xw, yw, aw, 0, 0, 0); aa = __builtin_amdgcn_mfma_f32_16x16x32_bf16(xa, ya, aa, 0, 0, 0); }
        const int ch = 16 * tj + l15; const float w0v = w0[ch], a0v = a0[ch];
#pragma unroll
        for (int jj = 0; jj < 4; jj++) { const int tau = 16 * ti + 4 * q4 + jj; LW[tau * 64 + ch] = -0.6065306597126334f * sigm(w0v + aw[jj]); AT[tau * 64 + ch] = sigm(a0v + aa[jj]); }
      }
    }
    __syncthreads();
    if (tid < 64) { float acc = 0.f;
#pragma unroll 8
      for (int t = 0; t < 64; t++) { acc += LW[t * 64 + tid]; LW[t * 64 + tid] = acc; } }
    __syncthreads();
    {
      const int tau = tid >> 3, sc = tid & 7, col = h * 64 + sc * 8; const int row = rowmap(d, b, 64 * c + tau);
      const bfr* rp = RK + (size_t)row * 4096 + col; uint4 pr = *(const uint4*)rp, pk = *(const uint4*)(rp + 1024);
      unsigned ur[4] = {pr.x, pr.y, pr.z, pr.w}, uk[4] = {pk.x, pk.y, pk.z, pk.w};
      float r8[8], k8[8], kr[8];
#pragma unroll
      for (int e = 0; e < 4; e++) { r8[2 * e] = blo(ur[e]); r8[2 * e + 1] = bhi(ur[e]); k8[2 * e] = blo(uk[e]); k8[2 * e + 1] = bhi(uk[e]); }
      float ss = 0.f;
#pragma unroll
      for (int e = 0; e < 8; e++) { kr[e] = k8[e] * kkp[col + e]; ss += kr[e] * kr[e]; }
      ss += __shfl_xor(ss, 1); ss += __shfl_xor(ss, 2); ss += __shfl_xor(ss, 4);
      const float inv = __builtin_amdgcn_rsqf(fmaxf(ss, 1e-24f));
      float bon = 0.f, o0[8], o1[8], o2[8], o3[8], o4[8], o5[8];
#pragma unroll
      for (int e = 0; e < 8; e++) {
        const float cw = LW[tau * 64 + sc * 8 + e], cwm = tau > 0 ? LW[(tau - 1) * 64 + sc * 8 + e] : 0.f, cwl = LW[63 * 64 + sc * 8 + e], a = AT[tau * 64 + sc * 8 + e];
        const float ka = kr[e] * inv, be = a * ka, kd = k8[e] * (1.f + (a - 1.f) * kap[col + e]); bon += r8[e] * kd * rkp[col + e];
        const float e2 = __expf(-cw), e4 = __expf(cwl - cw);
        o0[e] = ka * __expf(cwm); o1[e] = be * e2; o2[e] = kd * e2; o3[e] = r8[e] * __expf(cw); o4[e] = be * e4; o5[e] = kd * e4;
        if (tau == 63) WL[sc * 8 + e] = __expf(cwl);
      }
      bon += __shfl_xor(bon, 1); bon += __shfl_xor(bon, 2); bon += __shfl_xor(bon, 4);
      if (sc == 0) BON[((size_t)d * R_ + row) * 16 + h] = bon;
      *(uint4*)(CSLOT(0) + tau * CS + sc * 8) = uint4{pk2(o0[0], o0[1]), pk2(o0[2], o0[3]), pk2(o0[4], o0[5]), pk2(o0[6], o0[7])};
      *(uint4*)(CSLOT(1) + tau * CS + sc * 8) = uint4{pk2(o1[0], o1[1]), pk2(o1[2], o1[3]), pk2(o1[4], o1[5]), pk2(o1[6], o1[7])};
      *(uint4*)(CSLOT(2) + tau * CS + sc * 8) = uint4{pk2(o2[0], o2[1]), pk2(o2[2], o2[3]), pk2(o2[4], o2[5]), pk2(o2[6], o2[7])};
      *(uint4*)(CSLOT(3) + tau * CS + sc * 8) = uint4{pk2(o3[0], o3[1]), pk2(o3[2], o3[3]), pk2(o3[4], o3[5]), pk2(o3[6], o3[7])};
#pragma unroll
      for (int e = 0; e < 8; e++) { CSLOT(4)[(sc * 8 + e) * CS + tau] = f2b(o0[e]); CSLOT(5)[(sc * 8 + e) * CS + tau] = f2b(o4[e]); CSLOT(6)[(sc * 8 + e) * CS + tau] = f2b(o5[e]); }
    }
    __syncthreads();
#pragma unroll
    for (int tt = 0; tt < 2; tt++) { const int tj = tj0 + tt, r0 = 16 * ti + 4 * q4, cc = 16 * tj + l15;
      f32x4 v = cmm(CSLOT(1), CSLOT(0), ti, tj, l15, q4);
#pragma unroll
      for (int jj = 0; jj < 4; jj++) if (!(r0 + jj < cc)) v[jj] = 0.f;
      st_row(CSLOT(7), r0, cc, v); st_tr(CSLOT(8), r0, cc, v);
      v = cmm(CSLOT(2), CSLOT(0), ti, tj, l15, q4);
#pragma unroll
      for (int jj = 0; jj < 4; jj++) if (!(r0 + jj < cc)) v[jj] = 0.f;
      st_row(CSLOT(9), r0, cc, v);
      v = cmm(CSLOT(3), CSLOT(1), ti, tj, l15, q4);
#pragma unroll
      for (int jj = 0; jj < 4; jj++) if (!(cc <= r0 + jj)) v[jj] = 0.f;
      st_row(CSLOT(10), r0, cc, v);
      v = cmm(CSLOT(3), CSLOT(2), ti, tj, l15, q4);
#pragma unroll
      for (int jj = 0; jj < 4; jj++) if (!(cc <= r0 + jj)) v[jj] = 0.f;
      st_row(CSLOT(11), r0, cc, v);
    }
    __syncthreads();
    {
      float* X = (float*)CSLOT(0);
      const bfr* Ab = CSLOT(7);
      const int cl = lane >> 3, pp = lane & 7, cx = 8 * w + cl, blk0 = (w >> 1) * 16;
#pragma unroll 1
      for (int il = 15; il >= 0; il--) { const int i = blk0 + il;
        float sum = 0.f;
#pragma unroll 1
        for (int jx = i + 1 + pp; jx < blk0 + 16; jx += 8) sum += b2f(Ab[i * CS + jx]) * X[jx * 72 + cx];
        sum += dppf<0xB1>(sum); sum += dppf<0x4E>(sum); sum += dppf<0x141>(sum);
        const float xv = (i == cx ? 1.f : 0.f) - sum;
        if (pp == 0) X[i * 72 + cx] = xv;
      }
      __syncthreads();
#pragma unroll 1
      for (int e = tid; e < 4096; e += 512) { const int i = e >> 6, c2 = e & 63; const bfr tv = ((i >> 4) == (c2 >> 4)) ? f2b(X[i * 72 + c2]) : (bfr)0; CSLOT(2)[i * CS + c2] = tv; CSLOT(12)[c2 * CS + i] = tv; }
      __syncthreads();
#pragma unroll
      for (int tt = 0; tt < 2; tt++) { const int tj = tj0 + tt, r0 = 16 * ti + 4 * q4, cc = 16 * tj + l15; st_row(CSLOT(13), r0, cc, cmm_mask<1>(CSLOT(2), CSLOT(8), ti, tj, l15, q4)); }
      __syncthreads();
#pragma unroll
      for (int tt = 0; tt < 2; tt++) { const int tj = tj0 + tt, r0 = 16 * ti + 4 * q4, cc = 16 * tj + l15;
        f32x4 v = ld_row(CSLOT(2), r0, cc) - cmm(CSLOT(13), CSLOT(12), ti, tj, l15, q4); st_row(CSLOT(0), r0, cc, v); st_tr(CSLOT(1), r0, cc, v); }
      __syncthreads();
#pragma unroll
      for (int tt = 0; tt < 2; tt++) { const int tj = tj0 + tt, r0 = 16 * ti + 4 * q4, cc = 16 * tj + l15; st_row(CSLOT(13), r0, cc, cmm_mask<2>(CSLOT(0), CSLOT(8), ti, tj, l15, q4)); }
      __syncthreads();
#pragma unroll
      for (int tt = 0; tt < 2; tt++) { const int tj = tj0 + tt, r0 = 16 * ti + 4 * q4, cc = 16 * tj + l15;
        f32x4 v = ld_row(CSLOT(0), r0, cc) - cmm(CSLOT(13), CSLOT(1), ti, tj, l15, q4);
#pragma unroll
        for (int jj = 0; jj < 4; jj++) if (r0 + jj == cc) v[jj] -= 1.f;
        st_row(CSLOT(2), r0, cc, v); }
      __syncthreads();
    }
#pragma unroll
    for (int tt = 0; tt < 2; tt++) { const int tj = tj0 + tt, r0 = 16 * ti + 4 * q4, cc = 16 * tj + l15;
      f32x4 g = cmm(CSLOT(10), CSLOT(2), ti, tj, l15, q4) + ld_row(CSLOT(10), r0, cc); st_row(CSLOT(12), r0, cc, g);
      f32x4 hh = cmm(CSLOT(5), CSLOT(2), ti, tj, l15, q4) + ld_row(CSLOT(5), r0, cc); st_row(CSLOT(13), r0, cc, hh); }
    __syncthreads();
    {
      bfr* out = WB + (size_t)(chain * 65 + cl) * 16384;
#pragma unroll
      for (int tt = 0; tt < 2; tt++) { const int tj = tj0 + tt, r0 = 16 * ti + 4 * q4, cc = 16 * tj + l15;
        f32x4 v = ld_tr(CSLOT(3), r0, cc) - cmm(CSLOT(4), CSLOT(12), ti, tj, l15, q4);
        store4b(out + cc * 64 + r0, v);
        v = ld_tr(CSLOT(11), r0, cc) - cmm(CSLOT(9), CSLOT(12), ti, tj, l15, q4);
        store4b(out + 4096 + cc * 64 + r0, v);
        v = -cmm(CSLOT(4), CSLOT(13), ti, tj, l15, q4);
#pragma unroll
        for (int jj = 0; jj < 4; jj++) if (r0 + jj == cc) v[jj] += WL[cc];
        store4b(out + 8192 + cc * 64 + r0, v);
        v = ld_tr(CSLOT(6), r0, cc) - cmm(CSLOT(9), CSLOT(13), ti, tj, l15, q4);
        store4b(out + 12288 + cc * 64 + r0, v);
      }
    }
    __syncthreads();
  }
}

__device__ __forceinline__ void ph_r7_cb(const P& p, int win, int d, char* smem) {
  bfr* Sh = (bfr*)smem; bfr* Sl = Sh + 2 * 16 * CS; bfr* VT = Sl + 2 * 16 * CS;
  const bfr* WB = p.H; const bfr* RK = (const bfr*)(p.ACT + A_RKVZ); bfr* Y = (bfr*)(p.ACT + A_Y); bfr* SST = (bfr*)(p.ACT + A_SST);
  const int tid = ltid(), lane = tid & 63, w = tid >> 6, l15 = lane & 15, q4 = lane >> 4;
  const int c0 = win * 65;
  for (int it = blockIdx.x; it < 128; it += gridDim.x) {
    const int b = it >> 6, h = (it >> 2) & 15, rg = it & 3, chain = (b * 16 + h) * 2 + d;
    bfr* sst = SST + (size_t)(chain * 4 + rg) * 2048;
    __syncthreads();
    if (tid < 256) { const int hl = tid >> 7, e = tid & 127, rr = e >> 3, c8 = e & 7; uint4 v = uint4{0u, 0u, 0u, 0u};
      if (win > 0) v = *(const uint4*)(sst + hl * 1024 + rr * 64 + c8 * 8);
      *(uint4*)((hl ? Sl : Sh) + rr * CS + c8 * 8) = v; }
    const int vtau = tid >> 3, vp = tid & 7;
    { const int row = rowmap(d, b, 64 * c0 + vtau); unsigned vv = *(const unsigned*)(RK + (size_t)row * 4096 + 2048 + h * 64 + rg * 16 + 2 * vp);
      VT[(2 * vp) * CS + vtau] = (bfr)(vv & 0xffff); VT[(2 * vp + 1) * CS + vtau] = (bfr)(vv >> 16); }
    const bfr* bbase = WB + (size_t)(chain * 65) * 16384 + (w < 4 ? 8192 + (16 * w + l15) * 64 : (16 * (w - 4) + l15) * 64) + 8 * q4;
    bf16x8 rb1[4][2], rb2[4][2]; unsigned rv[4]; uint2 ry[4];
#define CB_FIRST(c_) ({ const int rc_ = d == 0 ? (c_) : ((c_) < 4 ? 3 - (c_) : 263 - (c_)); const int cb_ = rc_ < 4 ? 3 - rc_ : 263 - rc_; d == 0 ? (win <= cb_ / 65) : (win < rc_ / 65); })
#define CB_LOAD(u_, s_) { const int ss_ = (s_) < 65 ? (s_) : 64; const bfr* bp_ = bbase + (size_t)ss_ * 16384; \
      rb1[u_][0] = *(const bf16x8*)bp_; rb1[u_][1] = *(const bf16x8*)(bp_ + 32); rb2[u_][0] = *(const bf16x8*)(bp_ + 4096); rb2[u_][1] = *(const bf16x8*)(bp_ + 4096 + 32); \
      const int sv_ = ss_ + 1 < 65 ? ss_ + 1 : 64; const int rowv_ = rowmap(d, b, 64 * (c0 + sv_) + vtau); \
      rv[u_] = *(const unsigned*)(RK + (size_t)rowv_ * 4096 + 2048 + h * 64 + rg * 16 + 2 * vp); \
      ry[u_] = uint2{0u, 0u}; if (w >= 4 && !CB_FIRST(c0 + ss_)) { const int rowy_ = rowmap(d, b, 64 * (c0 + ss_) + 16 * (w - 4) + l15); ry[u_] = *(const uint2*)(Y + (size_t)rowy_ * 1024 + h * 64 + rg * 16 + 4 * q4); } }
    CB_LOAD(0, 0) CB_LOAD(1, 1) CB_LOAD(2, 2) CB_LOAD(3, 3)
    __syncthreads();
    for (int g = 0; g < 17; g++) {
#pragma unroll
      for (int u = 0; u < 4; u++) {
        const int s = 4 * g + u;
        if (s < 65) {
          const int cur = s & 1, nxt = cur ^ 1, c = c0 + s;
          bf16x8 sh[2], sl[2], vt[2];
#pragma unroll
          for (int ks = 0; ks < 2; ks++) { sh[ks] = *(const bf16x8*)(Sh + (cur * 16 + l15) * CS + 32 * ks + 8 * q4); sl[ks] = *(const bf16x8*)(Sl + (cur * 16 + l15) * CS + 32 * ks + 8 * q4);
            vt[ks] = *(const bf16x8*)(VT + (cur * 16 + l15) * CS + 32 * ks + 8 * q4); }
          f32x4 a1 = f32x4{0.f, 0.f, 0.f, 0.f}, a2 = a1;
#pragma unroll
          for (int ks = 0; ks < 2; ks++) { a1 = __builtin_amdgcn_mfma_f32_16x16x32_bf16(sh[ks], rb1[u][ks], a1, 0, 0, 0); a2 = __builtin_amdgcn_mfma_f32_16x16x32_bf16(vt[ks], rb2[u][ks], a2, 0, 0, 0); }
#pragma unroll
          for (int ks = 0; ks < 2; ks++) a1 = __builtin_amdgcn_mfma_f32_16x16x32_bf16(sl[ks], rb1[u][ks], a1, 0, 0, 0);
          a1 = a1 + a2;
          if (w < 4) {
#pragma unroll
            for (int jj = 0; jj < 4; jj++) { const bfr hi = f2b(a1[jj]); Sh[(nxt * 16 + 4 * q4 + jj) * CS + 16 * w + l15] = hi; Sl[(nxt * 16 + 4 * q4 + jj) * CS + 16 * w + l15] = f2b(a1[jj] - b2f(hi)); }
          } else {
            const int rowy = rowmap(d, b, 64 * c + 16 * (w - 4) + l15);
            a1[0] += blo(ry[u].x); a1[1] += bhi(ry[u].x); a1[2] += blo(ry[u].y); a1[3] += bhi(ry[u].y);
            store4b(Y + (size_t)rowy * 1024 + h * 64 + rg * 16 + 4 * q4, a1);
          }
          if (s + 1 < 65) { VT[(nxt * 16 + 2 * vp) * CS + vtau] = (bfr)(rv[u] & 0xffff); VT[(nxt * 16 + 2 * vp + 1) * CS + vtau] = (bfr)(rv[u] >> 16); }
          if (s + 4 < 65) CB_LOAD(u, s + 4)
          __syncthreads();
        }
      }
    }
    if (tid < 256) { const int hl = tid >> 7, e = tid & 127, rr = e >> 3, c8 = e & 7; *(uint4*)(sst + hl * 1024 + rr * 64 + c8 * 8) = *(const uint4*)((hl ? Sl : Sh) + (16 + rr) * CS + c8 * 8); }
  }
}

__device__ __forceinline__ void run_phase(const P& p, int ph, int layer, int d, char* smem) {
  Ctx c; c.layer = layer; c.j = layer / 3; c.d = d; c.wc = layer < 3 ? 1 : 0;
  switch (ph) {
    case PH_PRE: ph_pre(p, smem); break;
    case PH_NORM: ph_norm(p, layer, smem); break;
    case PH_LRU_IN: big_gemm(smem, p.H, p.W, 2560, 1024, F_LruIn{p.ACT}); break;
    case PH_LRU_CONV: ph_lru_conv(p, c.j); break;
    case PH_LRU_GATE: gemm_phase<G_LruGate>(p, c, smem); break;
    case PH_LRU_S1: ph_lru_s1(p, d); break;
    case PH_LRU_S2: ph_lru_s2(p); break;
    case PH_LRU_S3: ph_lru_s3(p, d); break;
    case PH_LRU_OUT: big_gemm(smem, (const bfr*)(p.ACT + A_Z), p.W + WL_OUT, 1024, 1280, F_Resid{p.Xx, p.Xc, p.MOD + (size_t)layer * 3 * 3072, c.wc}); break;
    case PH_ML_IN: big_gemm(smem, p.H, p.W, 4352, 1024, F_MlIn{p.ACT}); break;
    case PH_ML_SCAN: ph_ml_scan(p, c.j, smem); break;
    case PH_ML_STAT: ph_ml_stat(p); break;
    case PH_ML_Z: big_gemm(smem, p.H, p.W + WM_Z, 2048, 1024, F_MlZ{p.ACT, p.ml_norm_g + (size_t)c.j * 2048}); break;
    case PH_ML_OUT: big_gemm(smem, (const bfr*)(p.ACT + A_HS), p.W + WM_OUT, 1024, 2048, F_Resid{p.Xx, p.Xc, p.MOD + (size_t)layer * 3 * 3072, c.wc}); break;
    case PH_R7_IN: big_gemm(smem, p.H, p.W, 4352, 2048, F_R7In{p.ACT}); break;
    case PH_R7_SHIFT: ph_r7_shift(p); break;
    case PH_R7_CA: ph_r7_ca(p, c.j, d, smem); break;
    case PH_R7_CB: ph_r7_cb(p, d >> 1, d & 1, smem); break;
    case PH_R7_FIN: ph_r7_fin(p, c.j); break;
    case PH_R7_OUT: big_gemm(smem, (const bfr*)(p.ACT + A_Y), p.W + WR_OUT, 1024, 1024, F_Resid{p.Xx, p.Xc, p.MOD + (size_t)layer * 3 * 3072, c.wc}); break;
    case PH_FINAL: ph_final(p); break;
  }
}


#define XB_TMO      128
#define XB_XCNT(j)  (256  + 64 * (j))
#define XB_XSUB(j)  (1280 + 64 * (j))
#define XB_XGEN(j)  (2304 + 64 * (j))
#define XB_TOP      3328
#define XB_TOPGEN   3392
#define XCD_BAR_WORDS 3456
#define XB_SPIN_CAP (1u << 18)
#define OFF_BAR 527000064ull
__device__ __forceinline__ unsigned xb_ld(unsigned* p)              { return __hip_atomic_load(p, __ATOMIC_RELAXED, __HIP_MEMORY_SCOPE_AGENT); }
__device__ __forceinline__ unsigned xb_add(unsigned* p, unsigned v) { return __hip_atomic_fetch_add(p, v, __ATOMIC_RELAXED, __HIP_MEMORY_SCOPE_AGENT); }
__device__ __forceinline__ unsigned xb_xcc_id() { return (unsigned)__builtin_amdgcn_s_getreg((3 << 11) | 20) & 0xFu; }
#define XB_SPIN(cond, bar) do { unsigned _sp = 0; while (cond) { __builtin_amdgcn_s_sleep(1); \
    if ((++_sp & 255u) == 0u) { if (xb_ld(&(bar)[XB_TMO])) break; if (_sp > XB_SPIN_CAP) { atomicAdd(&(bar)[XB_TMO], 1u); break; } } } } while (0)
struct XcdBarrier { unsigned* bar; unsigned x; volatile __attribute__((address_space(3))) unsigned* st; };
__device__ __forceinline__ XcdBarrier xcd_barrier_post(unsigned* bar, volatile __attribute__((address_space(3))) unsigned* st) {
  XcdBarrier b; b.bar = bar; b.x = xb_xcc_id(); b.st = st;
  if (threadIdx.x == 0) (void)xb_add(&bar[XB_XCNT(b.x)], 1u);
  return b;
}
__device__ __forceinline__ void xcd_barrier_complete(unsigned* bar, unsigned x, unsigned& nloc, unsigned& nx) {
  const unsigned G = gridDim.x * gridDim.y * gridDim.z;
  unsigned sum, cnt, mine, sp = 0u;
  for (;;) {
    sum = 0u; cnt = 0u; mine = 0u;
#pragma unroll
    for (unsigned j = 0; j < 16; ++j) { const unsigned c = xb_ld(&bar[XB_XCNT(j)]); sum += c; cnt += (c > 0u) ? 1u : 0u; mine = (j == x) ? c : mine; }
    if (sum == G) break;
    __builtin_amdgcn_s_sleep(1);
    if ((++sp & 255u) == 0u) { if (xb_ld(&bar[XB_TMO])) break; if (sp > XB_SPIN_CAP) { atomicAdd(&bar[XB_TMO], 1u); break; } }
  }
  nloc = mine > 0u ? mine : 1u; nx = cnt > 0u ? cnt : 1u;
}
__device__ __forceinline__ void xcd_barrier(const XcdBarrier& b) {
  asm volatile("s_waitcnt vmcnt(0)" ::: "memory");
  __syncthreads();
  if (threadIdx.x == 0) {
    unsigned* bar = b.bar;
    __builtin_amdgcn_s_waitcnt(0);
    unsigned nloc = b.st[0], nx = b.st[1];
    if (nloc == 0u) { xcd_barrier_complete(bar, b.x, nloc, nx); b.st[0] = nloc; b.st[1] = nx; }
    const unsigned old = xb_add(&bar[XB_XSUB(b.x)], 1u);
    const unsigned gen = old / nloc;
    if (old + 1u == (gen + 1u) * nloc) {
      __builtin_amdgcn_fence(__ATOMIC_RELEASE, "agent");
      asm volatile("s_waitcnt vmcnt(0)" ::: "memory");
      const unsigned og = xb_add(&bar[XB_TOP], 1u);
      const unsigned tg = og / nx;
      if (og + 1u == (tg + 1u) * nx) xb_add(&bar[XB_TOPGEN], 1u);
      else XB_SPIN(xb_ld(&bar[XB_TOPGEN]) == tg, bar);
      __builtin_amdgcn_fence(__ATOMIC_ACQUIRE, "agent");
      xb_add(&bar[XB_XGEN(b.x)], 1u);
      asm volatile("s_waitcnt vmcnt(0)" ::: "memory");
    } else {
      XB_SPIN(xb_ld(&bar[XB_XGEN(b.x)]) == gen, bar);
      __builtin_amdgcn_fence(__ATOMIC_ACQUIRE, "agent");
      asm volatile("s_waitcnt vmcnt(0)" ::: "memory");
    }
  }
  __syncthreads();
}

#define SMEM_BYTES (131072 + 64)
extern __shared__ __attribute__((aligned(16))) char dyn_smem[];
#if !MEGA
__global__ void __launch_bounds__(512, 2) phase_kernel(P p, int si) {
  run_phase(p, p.sched[si * 3], p.sched[si * 3 + 1], p.sched[si * 3 + 2], dyn_smem);
}
#else
__global__ void __launch_bounds__(512, 2) mega_kernel(P p) {
  cg::grid_group grid = cg::this_grid();
  volatile __attribute__((address_space(3))) unsigned* st = (volatile __attribute__((address_space(3))) unsigned*)(dyn_smem + 131072);
  if (threadIdx.x < 4) st[threadIdx.x] = 0u;
  __syncthreads();
  const XcdBarrier xb = xcd_barrier_post(p.bar, st);
  for (int si = 0; si < p.nsched; si++) {
    run_phase(p, p.sched[si * 3], p.sched[si * 3 + 1], p.sched[si * 3 + 2], dyn_smem);
    if (si + 1 < p.nsched) { if (si == 0) grid.sync(); else xcd_barrier(xb); }
  }
}
#endif

extern "C" void kernel_launch(void* const* d_in, const int* in_sizes, int n_in, void* d_out, int out_size, void* d_ws, size_t ws_size, hipStream_t stream) {
  P p; memset(&p, 0, sizeof(p));
  const float** f = (const float**)&p;
  for (int i = 0; i < 33; i++) f[i] = (const float*)d_in[i];
  char* ws = (char*)d_ws;
  p.Xx = (float*)d_out; p.Xc = (float*)(ws + OFF_XC); p.MOD = (float*)(ws + OFF_MOD); p.W = (bfr*)(ws + OFF_W); p.H = (bfr*)(ws + OFF_H); p.ACT = ws + OFF_ACT; p.bar = (unsigned*)(ws + OFF_BAR);
  int n = 0;
  auto add = [&](int ph, int layer, int d) { p.sched[n * 3] = ph; p.sched[n * 3 + 1] = layer; p.sched[n * 3 + 2] = d; n++; };
  add(PH_PRE, 0, 0);
  if (DUP & 4) add(PH_PRE, 0, 0);
  for (int l = 0; l < 4; l++) {
    add(PH_NORM, l, 0); if (DUP & 4) add(PH_NORM, l, 0);
    int kind = l % 3;
    const bool dg = DUP & 1, ds = DUP & 2;
    if (kind == 0) { add(PH_LRU_IN, l, 0); if (dg) add(PH_LRU_IN, l, 0); add(PH_LRU_CONV, l, 0); if (DUP & 4) add(PH_LRU_CONV, l, 0);
      for (int d = 0; d < 2; d++) { add(PH_LRU_GATE, l, d); if (dg) add(PH_LRU_GATE, l, d); add(PH_LRU_S1, l, d); if (DUP & 8) add(PH_LRU_S1, l, d); add(PH_LRU_S2, l, d); if (DUP & 16) add(PH_LRU_S2, l, d); add(PH_LRU_S3, l, d); }
      add(PH_LRU_OUT, l, 0); }
    else if (kind == 1) { add(PH_ML_IN, l, 0); if (dg) add(PH_ML_IN, l, 0); add(PH_ML_SCAN, l, 0); if (ds) add(PH_ML_SCAN, l, 0); add(PH_ML_STAT, l, 0); if (DUP & 4) add(PH_ML_STAT, l, 0); add(PH_ML_Z, l, 0); add(PH_ML_OUT, l, 0); }
    else { add(PH_R7_SHIFT, l, 0); add(PH_R7_IN, l, 0); if (dg) add(PH_R7_IN, l, 0); for (int wi = 0; wi < 4; wi++) { add(PH_R7_CA, l, wi); if (ds) add(PH_R7_CA, l, wi); add(PH_R7_CB, l, wi * 2); add(PH_R7_CB, l, wi * 2 + 1); } add(PH_R7_FIN, l, 0); add(PH_R7_OUT, l, 0); }
  }
  add(PH_FINAL, 0, 0);
  p.nsched = n;
  if (ws_size < WS_NEED) fprintf(stderr, "workspace too small: %zu < %llu\n", ws_size, (unsigned long long)WS_NEED);
#if MEGA
  static int grid_blocks = 0;
  if (!grid_blocks) { int dev = 0, cus = 0, per = 0; hipGetDevice(&dev); hipDeviceGetAttribute(&cus, hipDeviceAttributeMultiprocessorCount, dev);
    hipFuncSetAttribute((const void*)mega_kernel, hipFuncAttributeMaxDynamicSharedMemorySize, SMEM_BYTES);
    hipOccupancyMaxActiveBlocksPerMultiprocessor(&per, mega_kernel, 512, SMEM_BYTES); if (per > 1) per = 1; if (per < 1) per = 1; grid_blocks = cus * per; }
  hipMemsetAsync(ws + OFF_BAR, 0, XCD_BAR_WORDS * 4, stream);
  void* args[] = {&p};
  hipError_t e = hipLaunchCooperativeKernel((void*)mega_kernel, dim3(grid_blocks), dim3(512), args, SMEM_BYTES, stream);
  if (e != hipSuccess) fprintf(stderr, "cooperative launch failed: %s (grid %d)\n", hipGetErrorString(e), grid_blocks);
#else
  static int once = 0; if (!once) { once = 1; hipFuncSetAttribute((const void*)phase_kernel, hipFuncAttributeMaxDynamicSharedMemorySize, SMEM_BYTES); }
  for (int si = 0; si < n; si++) phase_kernel<<<256, 512, SMEM_BYTES, stream>>>(p, si);
#endif
}
```

```cpp
#include <hip/hip_runtime.h>
#include <hip/hip_bf16.h>
#include <hip/hip_cooperative_groups.h>
#include <cstdio>
#include <cstring>
#include <type_traits>
namespace cg = cooperative_groups;

#ifndef DUP
#define DUP 0
#endif
#ifndef MEGA
#define MEGA 1
#endif

typedef unsigned short bfr;
using bf16x8 = __attribute__((ext_vector_type(8))) short;
using f32x4 = __attribute__((ext_vector_type(4))) float;

#define R_ 33280
#define BT_ 16640
#define NCH_ 260

#define OFF_XC 0ull
#define OFF_MOD 2097152ull
#define OFF_W 2244608ull
#define OFF_H 24264704ull
#define OFF_ACT 92422144ull
#define A_Z 0ull
#define A_UC 85196800ull
#define A_AB 170393600ull
#define A_U 170393600ull
#define A_HF 340787200ull
#define A_AGG 425984000ull
#define A_CAR 431308800ull
#define A_QKV 0ull
#define A_GATE 272629760ull
#define A_HS 276889600ull
#define A_RSTD 413204480ull
#define A_R7B 68157440ull
#define A_RKVZ (A_R7B + 0ull)
#define A_WM (A_R7B + 272629760ull)
#define A_AM (A_R7B + 281149440ull)
#define A_BON (A_R7B + 289669120ull)
#define A_Y (A_R7B + 293928960ull)
#define WS_NEED (527000064ull + 16384ull)

#define WL_GATE (2560 * 1024)
#define WL_OUT (WL_GATE + 1310720)
#define WM_Z (4352 * 1024)
#define WM_OUT (WM_Z + 2048 * 1024)
#define WR_UP (4352 * 2048)
#define WR_OUT (WR_UP + 262144)

enum { PH_PRE = 0, PH_NORM, PH_LRU_IN, PH_LRU_CONV, PH_LRU_GATE, PH_LRU_S1, PH_LRU_S2, PH_LRU_S3, PH_LRU_OUT,
       PH_ML_IN, PH_ML_SCAN, PH_ML_STAT, PH_ML_Z, PH_ML_OUT,
       PH_R7_IN, PH_R7_CA, PH_R7_CB, PH_R7_FIN, PH_R7_OUT, PH_FINAL, PH_R7_SHIFT };

struct P {
  const float *x, *c, *ctx, *c_ctx, *norm_g, *mod_w, *mod_b, *final_g;
  const float *lru_w_in, *lru_conv_w, *lru_conv_b, *lru_gate_w, *lru_gate_b, *lru_lam, *lru_w_out;
  const float *ml_w_in, *ml_gate_b, *ml_norm_g, *ml_w_out;
  const float *r7_mu, *r7_w_rkvz, *r7_w0, *r7_w1, *r7_w2, *r7_a0, *r7_a1, *r7_a2, *r7_k_k, *r7_k_a, *r7_r_k, *r7_ln_g, *r7_ln_b, *r7_w_out;
  float* Xx; float* Xc; float* MOD; bfr* W; bfr* H; char* ACT; unsigned* bar; float* CL;
  int nsched; int pad_;
  int sched[64 * 3];
};
struct Ctx { int layer, j, d, wc; };

__device__ __forceinline__ int ltid() { int t = threadIdx.x; asm volatile("" : "+v"(t)); return t; }
typedef float f32v2_ __attribute__((ext_vector_type(2))); typedef __bf16 bf16v2_ __attribute__((ext_vector_type(2)));
__device__ __forceinline__ unsigned cvtpk(float lo, float hi) { f32v2_ f = {lo, hi}; bf16v2_ h = __builtin_convertvector(f, bf16v2_); return __builtin_bit_cast(unsigned, h); }
__device__ __forceinline__ bfr f2b(float f) { return (bfr)(cvtpk(f, f) & 0xffffu); }
__device__ __forceinline__ float b2f(bfr b) { return __uint_as_float(((unsigned)b) << 16); }
__device__ __forceinline__ unsigned pk2(float a, float b) { return cvtpk(a, b); }
__device__ __forceinline__ float blo(unsigned u) { return __uint_as_float(u << 16); }
__device__ __forceinline__ float bhi(unsigned u) { return __uint_as_float(u & 0xffff0000u); }
__device__ __forceinline__ void store4b(bfr* dst, f32x4 v) { uint2 u; u.x = pk2(v[0], v[1]); u.y = pk2(v[2], v[3]); *(uint2*)dst = u; }
__device__ __forceinline__ float sigm(float x) { return __builtin_amdgcn_rcpf(1.f + __expf(-x)); }
__device__ __forceinline__ float siluf(float x) { return x * sigm(x); }
__device__ __forceinline__ float softplusf(float x) { return x > 20.f ? x : log1pf(expf(x)); }
__device__ __forceinline__ int rowmap(int d, int b, int pp) { int o = d == 0 ? pp : (pp < 256 ? 255 - pp : 16895 - pp); return b * BT_ + o; }
__device__ __forceinline__ float* xrowp(const P& p, int row, int& mi) {
  int b = row / BT_, o = row - b * BT_;
  if (o < 256) { mi = 2; return p.Xc + (size_t)(b * 256 + o) * 1024; }
  mi = b; return p.Xx + (size_t)(b * 16384 + o - 256) * 1024;
}
__device__ __forceinline__ float wsum(float v) { for (int o = 32; o; o >>= 1) v += __shfl_xor(v, o); return v; }
template <int CTRL> __device__ __forceinline__ float dppf(float x) {
  return __int_as_float(__builtin_amdgcn_update_dpp(0, __float_as_int(x), CTRL, 0xf, 0xf, true));
}
__device__ __forceinline__ float red16(float x) {
  x += dppf<0xB1>(x); x += dppf<0x4E>(x); x += dppf<0x141>(x); x += dppf<0x140>(x); return x;
}

template <class F> __device__ __forceinline__ void prep_tile(bfr* dst, int K, int tn, int tk, F get, float* sm) {
  int tid = ltid();
  for (int i = 0; i < 8; i++) { int kk = (tid >> 6) + 8 * i, nn = tid & 63; sm[kk * 65 + nn] = get(tk * 64 + kk, tn * 64 + nn); }
  __syncthreads();
  for (int i = 0; i < 8; i++) { int nn = (tid >> 6) + 8 * i, kk = tid & 63; dst[(size_t)(tn * 64 + nn) * K + tk * 64 + kk] = f2b(sm[kk * 65 + nn]); }
  __syncthreads();
}
__device__ __forceinline__ int prep_count(int layer) { int kind = layer % 3; return kind == 0 ? (640 + 320 + 320) : kind == 1 ? (1088 + 512 + 512) : (2176 + 64 + 256); }
__device__ __forceinline__ void prep_item(const P& p, int layer, int it, float* sm) {
  int kind = layer % 3, j = layer / 3;
  if (kind == 0) {
    if (it < 640) { int tn = it / 16, tk = it % 16; const float* s = p.lru_w_in + (size_t)j * 1024 * 2560;
      prep_tile(p.W, 1024, tn, tk, [=](int k, int n) { return s[(size_t)k * 2560 + n]; }, sm); return; }
    it -= 640;
    if (it < 320) { int d = it / 160, r = it % 160, tn = r / 2, tk = r % 2; const float* s = p.lru_gate_w + (size_t)(j * 2 + d) * 2 * 10 * 16384;
      prep_tile(p.W + WL_GATE + d * 655360, 128, tn, tk, [=](int k, int n) {
        int nt = n >> 7, blk = nt >> 1, sub = nt & 1, jj = n & 127, wn = jj >> 6, rr = jj & 63, g = rr >> 5, c = rr & 31;
        int kch = sub * 64 + wn * 32 + c; return s[((size_t)(g * 10 + blk) * 128 + k) * 128 + kch]; }, sm); return; }
    it -= 320;
    { int tn = it / 20, tk = it % 20; const float* s = p.lru_w_out + (size_t)j * 1280 * 1024;
      prep_tile(p.W + WL_OUT, 1280, tn, tk, [=](int k, int n) { return s[(size_t)k * 1024 + n]; }, sm); return; }
  } else if (kind == 1) {
    const float* s = p.ml_w_in + (size_t)j * 1024 * 6176;
    if (it < 1088) { int tn = it / 16, tk = it % 16;
      prep_tile(p.W, 1024, tn, tk, [=](int k, int n) {
        if (n < 4096) { float v = s[(size_t)k * 6176 + n]; return (n >= 1024 && n < 2048) ? v * 0.08838834764831845f : v; }
        if (n < 4128) return s[(size_t)k * 6176 + 6144 + (n - 4096)];
        return 0.f; }, sm); return; }
    it -= 1088;
    if (it < 512) { int tn = it / 16, tk = it % 16;
      prep_tile(p.W + WM_Z, 1024, tn, tk, [=](int k, int n) { return s[(size_t)k * 6176 + 4096 + n]; }, sm); return; }
    it -= 512;
    { int tn = it / 32, tk = it % 32; const float* so = p.ml_w_out + (size_t)j * 2048 * 1024;
      prep_tile(p.W + WM_OUT, 2048, tn, tk, [=](int k, int n) { return so[(size_t)k * 1024 + n]; }, sm); return; }
  } else {
    if (it < 2176) { int tn = it / 32, tk = it % 32;
      const float* mu = p.r7_mu + (size_t)j * 6 * 1024; const float* wr = p.r7_w_rkvz + (size_t)j * 4 * 1024 * 1024;
      const float* w1 = p.r7_w1 + (size_t)j * 2 * 1024 * 64; const float* a1 = p.r7_a1 + (size_t)j * 2 * 1024 * 64;
      prep_tile(p.W, 2048, tn, tk, [=](int k, int n) {
        int kk = k & 1023; float v, m;
        if (n < 4096) { int g = n >> 10, e = n & 1023; m = mu[g * 1024 + kk]; v = wr[((size_t)g * 1024 + kk) * 1024 + e]; }
        else if (n < 4224) { int xx = (n - 4096) >> 6, rr = (n - 4096) & 63; m = mu[4 * 1024 + kk]; v = w1[((size_t)xx * 1024 + kk) * 64 + rr]; }
        else { int xx = (n - 4224) >> 6, rr = (n - 4224) & 63; m = mu[5 * 1024 + kk]; v = a1[((size_t)xx * 1024 + kk) * 64 + rr]; }
        return (k < 1024 ? (1.f - m) : m) * v; }, sm); return; }
    it -= 2176;
    if (it < 64) { int u = it / 16, tn = it % 16; const float* s = (u < 2 ? p.r7_w2 : p.r7_a2) + (size_t)(j * 2 + (u & 1)) * 64 * 1024;
      prep_tile(p.W + WR_UP + u * 65536, 64, tn, 0, [=](int k, int n) { return s[(size_t)k * 1024 + n]; }, sm); return; }
    it -= 64;
    { int tn = it / 16, tk = it % 16; const float* s = p.r7_w_out + (size_t)j * 1024 * 1024;
      prep_tile(p.W + WR_OUT, 1024, tn, tk, [=](int k, int n) { return s[(size_t)k * 1024 + n]; }, sm); return; }
  }
}

#define LDSS 72
template <class G> __device__ __forceinline__ void gemm_tile(const P& p, const Ctx& c, int mt, int nt, char* smem) {
  const int tid = ltid(), lane = tid & 63, wid = tid >> 6, wm = wid & 3, wn = wid >> 2;
  bfr* sA = (bfr*)smem; bfr* sB = sA + 2 * 256 * LDSS;
  f32x4 acc[4][4];
  for (int a = 0; a < 4; a++) for (int b = 0; b < 4; b++) acc[a][b] = f32x4{0.f, 0.f, 0.f, 0.f};
  const int lr = tid >> 3, lc = tid & 7;
  uint4 ra[4], rb[2];
  auto gload = [&](int kt) __attribute__((always_inline)) {
#pragma unroll
    for (int i = 0; i < 4; i++) {
      const bfr* pa = G::aptr(p, c, mt * 256 + lr + 64 * i, kt, nt);
      ra[i] = pa ? *(const uint4*)(pa + lc * 8) : uint4{0u, 0u, 0u, 0u};
      if (i < 2) rb[i] = *(const uint4*)(G::bptr(p, c, nt * 128 + lr + 64 * i, kt) + lc * 8);
    }
  };
  auto sstore = [&](int buf) __attribute__((always_inline)) {
#pragma unroll
    for (int i = 0; i < 4; i++) {
      *(uint4*)(sA + (buf * 256 + lr + 64 * i) * LDSS + lc * 8) = ra[i];
      if (i < 2) *(uint4*)(sB + (buf * 128 + lr + 64 * i) * LDSS + lc * 8) = rb[i];
    }
  };
  gload(0); sstore(0); __syncthreads();
  for (int kt = 0; kt < G::KT; kt++) {
    const int buf = kt & 1;
    if (kt + 1 < G::KT) gload(kt + 1);
#pragma unroll
    for (int ks = 0; ks < 2; ks++) {
      bf16x8 af[4], bf[4];
#pragma unroll
      for (int i = 0; i < 4; i++) {
        af[i] = *(const bf16x8*)(sA + (buf * 256 + wm * 64 + i * 16 + (lane & 15)) * LDSS + ks * 32 + (lane >> 4) * 8);
        bf[i] = *(const bf16x8*)(sB + (buf * 128 + wn * 64 + i * 16 + (lane & 15)) * LDSS + ks * 32 + (lane >> 4) * 8);
      }
#pragma unroll
      for (int n = 0; n < 4; n++)
#pragma unroll
        for (int m = 0; m < 4; m++) acc[n][m] = __builtin_amdgcn_mfma_f32_16x16x32_bf16(bf[n], af[m], acc[n][m], 0, 0, 0);
    }
    if (kt + 1 < G::KT) sstore(buf ^ 1);
    __syncthreads();
  }
  G::epi(p, c, acc, mt * 256 + wm * 64, nt * 128 + wn * 64, lane);
}

__device__ __forceinline__ void epi_resid(const P& p, const Ctx& c, f32x4 (&acc)[4][4], int m0, int n0, int lane) {
#pragma unroll
  for (int mi = 0; mi < 4; mi++) {
    int row = m0 + mi * 16 + (lane & 15); int mo; float* xr = xrowp(p, row, mo);
    if (mo == 2 && !c.wc) continue;
    const float* g = p.MOD + (size_t)(c.layer * 3 + mo) * 3072 + 2048;
#pragma unroll
    for (int ni = 0; ni < 4; ni++) {
      int n = n0 + ni * 16 + (lane >> 4) * 4;
      float4 xv = *(float4*)(xr + n); float4 gg = *(const float4*)(g + n);
      xv.x += gg.x * acc[ni][mi][0]; xv.y += gg.y * acc[ni][mi][1]; xv.z += gg.z * acc[ni][mi][2]; xv.w += gg.w * acc[ni][mi][3];
      *(float4*)(xr + n) = xv;
    }
  }
}

struct G_LruIn { static constexpr int KT = 16, NT = 20;
  static __device__ __forceinline__ const bfr* aptr(const P& p, const Ctx& c, int row, int kt, int nt) { return p.H + (size_t)row * 1024 + kt * 64; }
  static __device__ __forceinline__ const bfr* bptr(const P& p, const Ctx& c, int n, int kt) { return p.W + (size_t)n * 1024 + kt * 64; }
  static __device__ __forceinline__ void epi(const P& p, const Ctx& c, f32x4 (&acc)[4][4], int m0, int n0, int lane) {
    bfr* U = (bfr*)(p.ACT + A_U); bfr* Z = (bfr*)(p.ACT + A_Z);
#pragma unroll
    for (int ni = 0; ni < 4; ni++)
#pragma unroll
      for (int mi = 0; mi < 4; mi++) {
        int row = m0 + mi * 16 + (lane & 15), n = n0 + ni * 16 + (lane >> 4) * 4;
        bfr* dst = n < 1280 ? U + (size_t)row * 1280 + n : Z + (size_t)row * 1280 + (n - 1280);
        store4b(dst, acc[ni][mi]);
      }
  } };
struct G_LruGate { static constexpr int KT = 2, NT = 20;
  static __device__ __forceinline__ const bfr* aptr(const P& p, const Ctx& c, int row, int kt, int nt) { return (const bfr*)(p.ACT + A_UC) + (size_t)row * 1280 + (nt >> 1) * 128 + kt * 64; }
  static __device__ __forceinline__ const bfr* bptr(const P& p, const Ctx& c, int n, int kt) { return p.W + WL_GATE + c.d * 655360 + (size_t)n * 128 + kt * 64; }
  static __device__ __forceinline__ void epi(const P& p, const Ctx& c, f32x4 (&acc)[4][4], int m0, int n0, int lane) {
    const bfr* UC = (const bfr*)(p.ACT + A_UC); unsigned* AB = (unsigned*)(p.ACT + A_AB);
    const float* gb = p.lru_gate_b + (size_t)(c.j * 2 + c.d) * 2 * 1280; const float* lam = p.lru_lam + (size_t)(c.j * 2 + c.d) * 1280;
    int chb = (n0 >> 6) * 32;
#pragma unroll
    for (int ni = 0; ni < 2; ni++) {
      int ch = chb + ni * 16 + (lane >> 4) * 4;
      float cl[4], br[4], bi[4];
#pragma unroll
      for (int q = 0; q < 4; q++) { cl[q] = p.CL[(size_t)(c.j * 2 + c.d) * 1280 + ch + q]; br[q] = gb[ch + q]; bi[q] = gb[1280 + ch + q]; }
#pragma unroll
      for (int mi = 0; mi < 4; mi++) {
        int row = m0 + mi * 16 + (lane & 15);
        uint2 u = *(const uint2*)(UC + (size_t)row * 1280 + ch);
        float uc[4] = {blo(u.x), bhi(u.x), blo(u.y), bhi(u.y)};
        unsigned o[4];
#pragma unroll
        for (int q = 0; q < 4; q++) {
          float r = sigm(acc[ni][mi][q] + br[q]), ig = sigm(acc[ni + 2][mi][q] + bi[q]);
          float la = -cl[q] * r; float oma = 1.f - __expf(la); float bb = __builtin_amdgcn_sqrtf(oma * (2.f - oma)) * ig * uc[q];
          o[q] = (((unsigned)f2b(oma)) << 16) | (unsigned)f2b(bb);
        }
        *(uint4*)(AB + (size_t)row * 1280 + ch) = uint4{o[0], o[1], o[2], o[3]};
      }
    }
  } };
struct G_LruOut { static constexpr int KT = 20, NT = 8;
  static __device__ __forceinline__ const bfr* aptr(const P& p, const Ctx& c, int row, int kt, int nt) { return (const bfr*)(p.ACT + A_Z) + (size_t)row * 1280 + kt * 64; }
  static __device__ __forceinline__ const bfr* bptr(const P& p, const Ctx& c, int n, int kt) { return p.W + WL_OUT + (size_t)n * 1280 + kt * 64; }
  static __device__ __forceinline__ void epi(const P& p, const Ctx& c, f32x4 (&acc)[4][4], int m0, int n0, int lane) { epi_resid(p, c, acc, m0, n0, lane); } };
struct G_MlIn { static constexpr int KT = 16, NT = 33;
  static __device__ __forceinline__ const bfr* aptr(const P& p, const Ctx& c, int row, int kt, int nt) { return p.H + (size_t)row * 1024 + kt * 64; }
  static __device__ __forceinline__ const bfr* bptr(const P& p, const Ctx& c, int n, int kt) { return p.W + (size_t)n * 1024 + kt * 64; }
  static __device__ __forceinline__ void epi(const P& p, const Ctx& c, f32x4 (&acc)[4][4], int m0, int n0, int lane) {
    bfr* QKV = (bfr*)(p.ACT + A_QKV); float* GT = (float*)(p.ACT + A_GATE);
#pragma unroll
    for (int ni = 0; ni < 4; ni++)
#pragma unroll
      for (int mi = 0; mi < 4; mi++) {
        int row = m0 + mi * 16 + (lane & 15), n = n0 + ni * 16 + (lane >> 4) * 4;
        if (n < 4096) store4b(QKV + (size_t)row * 4096 + n, acc[ni][mi]);
        else if (n < 4128) *(float4*)(GT + (size_t)row * 32 + (n - 4096)) = float4{acc[ni][mi][0], acc[ni][mi][1], acc[ni][mi][2], acc[ni][mi][3]};
      }
  } };
struct G_MlZ { static constexpr int KT = 16, NT = 16;
  static __device__ __forceinline__ const bfr* aptr(const P& p, const Ctx& c, int row, int kt, int nt) { return p.H + (size_t)row * 1024 + kt * 64; }
  static __device__ __forceinline__ const bfr* bptr(const P& p, const Ctx& c, int n, int kt) { return p.W + WM_Z + (size_t)n * 1024 + kt * 64; }
  static __device__ __forceinline__ void epi(const P& p, const Ctx& c, f32x4 (&acc)[4][4], int m0, int n0, int lane) {
    bfr* HS = (bfr*)(p.ACT + A_HS); const float* RS = (const float*)(p.ACT + A_RSTD); const float* ng = p.ml_norm_g + (size_t)c.j * 2048;
#pragma unroll
    for (int ni = 0; ni < 4; ni++)
#pragma unroll
      for (int mi = 0; mi < 4; mi++) {
        int row = m0 + mi * 16 + (lane & 15), n = n0 + ni * 16 + (lane >> 4) * 4;
        bfr* hp = HS + (size_t)row * 2048 + n; uint2 u = *(const uint2*)hp; float rs = RS[(size_t)row * 8 + (n >> 8)];
        float4 g4 = *(const float4*)(ng + n);
        f32x4 o;
        o[0] = blo(u.x) * rs * g4.x * siluf(acc[ni][mi][0]); o[1] = bhi(u.x) * rs * g4.y * siluf(acc[ni][mi][1]);
        o[2] = blo(u.y) * rs * g4.z * siluf(acc[ni][mi][2]); o[3] = bhi(u.y) * rs * g4.w * siluf(acc[ni][mi][3]);
        store4b(hp, o);
      }
  } };
struct G_MlOut { static constexpr int KT = 32, NT = 8;
  static __device__ __forceinline__ const bfr* aptr(const P& p, const Ctx& c, int row, int kt, int nt) { return (const bfr*)(p.ACT + A_HS) + (size_t)row * 2048 + kt * 64; }
  static __device__ __forceinline__ const bfr* bptr(const P& p, const Ctx& c, int n, int kt) { return p.W + WM_OUT + (size_t)n * 2048 + kt * 64; }
  static __device__ __forceinline__ void epi(const P& p, const Ctx& c, f32x4 (&acc)[4][4], int m0, int n0, int lane) { epi_resid(p, c, acc, m0, n0, lane); } };
struct G_R7In { static constexpr int KT = 32, NT = 34;
  static __device__ __forceinline__ const bfr* aptr(const P& p, const Ctx& c, int row, int kt, int nt) {
    if (kt < 16) return p.H + (size_t)row * 1024 + kt * 64;
    int q = (kt - 16) >> 2; int b = row / BT_, o = row - b * BT_; int nr;
    if (o < 256) { if (q < 2) { if (o < 1) return nullptr; nr = row - 1; } else { if (o >= 255) return nullptr; nr = row + 1; } }
    else { int t = o - 256, col = t & 63, gr = t >> 6;
      if (q == 0) { if (col == 0) return nullptr; nr = row - 1; }
      else if (q == 1) { if (col == 63) return nullptr; nr = row + 1; }
      else if (q == 2) { if (gr == 0) return nullptr; nr = row - 64; }
      else { if (gr == 255) return nullptr; nr = row + 64; } }
    return p.H + (size_t)nr * 1024 + (kt - 16) * 64; }
  static __device__ __forceinline__ const bfr* bptr(const P& p, const Ctx& c, int n, int kt) { return p.W + (size_t)n * 2048 + kt * 64; }
  static __device__ __forceinline__ void epi(const P& p, const Ctx& c, f32x4 (&acc)[4][4], int m0, int n0, int lane) {
    bfr* RK = (bfr*)(p.ACT + A_RKVZ); bfr* WMb = (bfr*)(p.ACT + A_WM); bfr* AMb = (bfr*)(p.ACT + A_AM);
#pragma unroll
    for (int ni = 0; ni < 4; ni++)
#pragma unroll
      for (int mi = 0; mi < 4; mi++) {
        int row = m0 + mi * 16 + (lane & 15), n = n0 + ni * 16 + (lane >> 4) * 4;
        if (n < 4096) store4b(RK + (size_t)row * 4096 + n, acc[ni][mi]);
        else if (n < 4224) { f32x4 t;
#pragma unroll
          for (int q = 0; q < 4; q++) t[q] = tanhf(acc[ni][mi][q]); store4b(WMb + (size_t)row * 128 + (n - 4096), t); }
        else store4b(AMb + (size_t)row * 128 + (n - 4224), acc[ni][mi]);
      }
  } };
struct G_R7Out { static constexpr int KT = 16, NT = 8;
  static __device__ __forceinline__ const bfr* aptr(const P& p, const Ctx& c, int row, int kt, int nt) { return p.H + (size_t)row * 1024 + kt * 64; }
  static __device__ __forceinline__ const bfr* bptr(const P& p, const Ctx& c, int n, int kt) { return p.W + WR_OUT + (size_t)n * 1024 + kt * 64; }
  static __device__ __forceinline__ void epi(const P& p, const Ctx& c, f32x4 (&acc)[4][4], int m0, int n0, int lane) { epi_resid(p, c, acc, m0, n0, lane); } };


namespace pg8 {
#define PG8_LAS __attribute__((address_space(3)))
constexpr int BM = 256, BK = 64, HALF = 128, HTB = HALF * BK * 2, NXCD = 8, WGM = 8;
__device__ __forceinline__ int lds_byte(int r, int c) { const int st = (r >> 4) * 2 + (c >> 5), rr = r & 15, cc = c & 31, ob = rr * 64 + cc * 2; return st * 1024 + (ob ^ (((ob >> 9) & 1) << 5)); }
__device__ __forceinline__ void stage_rc(int b, int& R, int& C) { const int st = b / 1024, sb = b % 1024, swz = sb ^ (((sb >> 9) & 1) << 5); R = (st >> 1) * 16 + swz / 64; C = (st & 1) * 32 + (swz % 64) / 2; }
struct Unit { int pm, pn; };
struct Gemm { const bfr* A; const bfr* Bt; int M, N, K; };
struct StaticOrder {
  int nM, nN, nwg, G, c;
  __device__ void init(int M, int N, int G_, int c_) { nM = M / BM; nN = N / BM; nwg = nM * nN; G = G_; c = c_; }
  __device__ bool next(int i, Unit& u) const {
    const long L = (long)i * G + c; if (L >= nwg) return false;
    int wgid = (int)L; { const int q = nwg / NXCD, r = nwg % NXCD, xcd = wgid % NXCD, off = wgid / NXCD; wgid = (xcd < r ? xcd * (q + 1) : r * (q + 1) + (xcd - r) * q) + off; }
    const int nig = WGM * nN, gid = wgid / nig, fm = gid * WGM, gsz = (nM - fm) < WGM ? (nM - fm) : WGM;
    u.pm = fm + ((wgid % nig) % gsz); u.pn = (wgid % nig) / gsz; return true;
  }
};
template <class Epi>
__device__ __forceinline__ void gemm_phase(PG8_LAS unsigned char* lds, const Gemm g, const StaticOrder& S, const Epi& E) {
  const int tid = ltid(), wid = __builtin_amdgcn_readfirstlane(tid >> 6), lane = tid & 63, wr = wid >> 2, wc = wid & 3, fr = lane & 15, fq = lane >> 4;
  const int K = g.K, nt = K / BK;
  unsigned voffA[2], voffB[2];
#pragma unroll
  for (int i = 0; i < 2; ++i) { int R, C; stage_rc(tid * 16 + i * 8192, R, C); voffA[i] = (unsigned)(R * K + C) * 2u; voffB[i] = voffA[i]; }
  const size_t kstep = (size_t)(BK * 2);
  const size_t hstep = (size_t)HALF * K * 2;
  const size_t tstep = 2 * hstep;
  const unsigned ldsw = (unsigned)wid * 1024u;
  const int aoff = lds_byte(wr * 64 + fr, fq * 8), boff = lds_byte(wc * 32 + fr, fq * 8);
#define PG8_SA(b, h) (((b) * 2 + (h)) * HTB)
#define PG8_SB(b, h) ((4 + (b) * 2 + (h)) * HTB)
#define PG8_STAGE(bufoff, gbase, voff) do { _Pragma("unroll") for (int _i = 0; _i < 2; ++_i) \
    __builtin_amdgcn_global_load_lds((const unsigned*)((const char*)(gbase) + (voff)[_i]), (PG8_LAS unsigned*)(lds + (bufoff) + ldsw + _i * 8192), 16, 0, 0); } while (0)
#define PG8_LDA(dst, b, h) do { _Pragma("unroll") for (int m = 0; m < 4; ++m) _Pragma("unroll") for (int k = 0; k < 2; ++k) dst[m][k] = *(const PG8_LAS bf16x8*)(lds + PG8_SA(b, h) + aoff + m * 2048 + k * 1024); } while (0)
#define PG8_LDB(dst, b, h) do { _Pragma("unroll") for (int n = 0; n < 2; ++n) _Pragma("unroll") for (int k = 0; k < 2; ++k) dst[n][k] = *(const PG8_LAS bf16x8*)(lds + PG8_SB(b, h) + boff + n * 2048 + k * 1024); } while (0)
#define PG8_MMA(ai, bj, At, Bt) do { __builtin_amdgcn_s_setprio(1); _Pragma("unroll") for (int m = 0; m < 4; ++m) _Pragma("unroll") for (int n = 0; n < 2; ++n) _Pragma("unroll") for (int k = 0; k < 2; ++k) \
    acc[ai][bj][m][n] = __builtin_amdgcn_mfma_f32_16x16x32_bf16(Bt[n][k], At[m][k], acc[ai][bj][m][n], 0, 0, 0); __builtin_amdgcn_s_setprio(0); } while (0)
#define PG8_WAIT_V(n) asm volatile("s_waitcnt vmcnt(" #n ")" ::: "memory")
#define PG8_WAIT_L(n) asm volatile("s_waitcnt lgkmcnt(" #n ")" ::: "memory")
#define PG8_BAR __builtin_amdgcn_s_barrier()
#define PG8_SCHED __builtin_amdgcn_sched_barrier(0)
  Unit cur, nxt; int ui = 0;
  if (!S.next(0, cur)) return;
  f32x4 acc[2][2][4][2];
#pragma unroll
  for (int a = 0; a < 2; ++a)
#pragma unroll
    for (int b = 0; b < 2; ++b)
#pragma unroll
      for (int m = 0; m < 4; ++m)
#pragma unroll
        for (int n = 0; n < 2; ++n) acc[a][b][m][n] = (f32x4){0.f, 0.f, 0.f, 0.f};
  bf16x8 At[4][2], B0[2][2], B1[2][2];
  const char* cA = (const char*)g.A + (size_t)cur.pm * tstep; const char* cB = (const char*)g.Bt + (size_t)cur.pn * tstep;
  PG8_STAGE(PG8_SB(0, 0), cB, voffB); PG8_STAGE(PG8_SA(0, 0), cA, voffA); PG8_STAGE(PG8_SB(0, 1), cB + hstep, voffB); PG8_STAGE(PG8_SA(0, 1), cA + hstep, voffA);
  if (wr == 1) PG8_BAR;
  PG8_WAIT_V(4); PG8_BAR;
  PG8_STAGE(PG8_SB(1, 0), cB + kstep, voffB); PG8_STAGE(PG8_SA(1, 0), cA + kstep, voffA); PG8_STAGE(PG8_SB(1, 1), cB + hstep + kstep, voffB);
  PG8_WAIT_V(6); PG8_BAR;
  for (;;) {
    const bool has_next = S.next(ui + 1, nxt);
    const char* nA = has_next ? (const char*)g.A + (size_t)nxt.pm * tstep : cA; const char* nB = has_next ? (const char*)g.Bt + (size_t)nxt.pn * tstep : cB;
    for (int t = 0; t < nt; t += 2) {
      const bool last = (t == nt - 2);
      const char* a1 = cA + (size_t)(t + 1) * kstep;
      const char* a2 = last ? nA : cA + (size_t)(t + 2) * kstep; const char* b2 = last ? nB : cB + (size_t)(t + 2) * kstep;
      const char* a3 = a2 + kstep; const char* b3 = b2 + kstep;
      PG8_LDB(B0, 0, 0); PG8_SCHED; PG8_LDA(At, 0, 0); PG8_STAGE(PG8_SA(1, 1), a1 + hstep, voffA);
      PG8_WAIT_L(8); PG8_BAR; PG8_WAIT_L(0); PG8_MMA(0, 0, At, B0); PG8_BAR; PG8_SCHED;
      PG8_LDB(B1, 0, 1); PG8_STAGE(PG8_SB(0, 0), b2, voffB);
      PG8_BAR; PG8_WAIT_L(0); PG8_MMA(0, 1, At, B1); PG8_BAR;
      PG8_LDA(At, 0, 1); PG8_STAGE(PG8_SA(0, 0), a2, voffA);
      PG8_BAR; PG8_WAIT_L(0); PG8_MMA(1, 0, At, B0); PG8_BAR; PG8_SCHED;
      PG8_STAGE(PG8_SB(0, 1), b2 + hstep, voffB);
      PG8_WAIT_V(6); PG8_BAR; PG8_MMA(1, 1, At, B1); PG8_BAR;
      PG8_LDB(B0, 1, 0); PG8_SCHED; PG8_LDA(At, 1, 0); PG8_STAGE(PG8_SA(0, 1), a2 + hstep, voffA);
      PG8_WAIT_L(8); PG8_BAR; PG8_WAIT_L(0); PG8_MMA(0, 0, At, B0); PG8_BAR; PG8_SCHED;
      PG8_LDB(B1, 1, 1); PG8_STAGE(PG8_SB(1, 0), b3, voffB);
      PG8_BAR; PG8_WAIT_L(0); PG8_MMA(0, 1, At, B1); PG8_BAR;
      PG8_LDA(At, 1, 1); PG8_STAGE(PG8_SA(1, 0), a3, voffA);
      PG8_BAR; PG8_WAIT_L(0); PG8_MMA(1, 0, At, B0); PG8_BAR; PG8_SCHED;
      PG8_STAGE(PG8_SB(1, 1), b3 + hstep, voffB);
      PG8_WAIT_V(6); PG8_BAR; PG8_MMA(1, 1, At, B1); PG8_BAR;
    }
    E(acc, cur, wr, wc, fr, fq);
    if (!has_next) break;
#pragma unroll
    for (int a = 0; a < 2; ++a)
#pragma unroll
      for (int b = 0; b < 2; ++b)
#pragma unroll
        for (int m = 0; m < 4; ++m)
#pragma unroll
          for (int n = 0; n < 2; ++n) acc[a][b][m][n] = (f32x4){0.f, 0.f, 0.f, 0.f};
    cur = nxt; cA = nA; cB = nB; ++ui;
  }
  PG8_WAIT_V(0);
  if (wr == 0) PG8_BAR;
  PG8_BAR;
#undef PG8_SA
#undef PG8_SB
#undef PG8_STAGE
#undef PG8_LDA
#undef PG8_LDB
#undef PG8_MMA
#undef PG8_WAIT_V
#undef PG8_WAIT_L
#undef PG8_BAR
#undef PG8_SCHED
}
}

template <class F> struct EpiAd {
  F f;
  __device__ __forceinline__ void operator()(const f32x4 (&acc)[2][2][4][2], const pg8::Unit& u, int wr, int wc, int fr, int fq) const {
#pragma unroll
    for (int ai = 0; ai < 2; ++ai)
#pragma unroll
      for (int m = 0; m < 4; ++m) { const int row = u.pm * 256 + ai * 128 + wr * 64 + m * 16 + fr;
#pragma unroll
        for (int bj = 0; bj < 2; ++bj)
#pragma unroll
          for (int n = 0; n < 2; ++n) f(row, u.pn * 256 + bj * 128 + wc * 32 + n * 16 + 4 * fq, acc[ai][bj][m][n]); }
  }
};
template <class F> __device__ __forceinline__ void big_gemm(char* smem, const bfr* A, const bfr* Bt, int N, int K, F f) {
  pg8::Gemm g; g.A = A; g.Bt = Bt; g.M = R_; g.N = N; g.K = K;
  pg8::StaticOrder S; S.init(R_, N, (int)gridDim.x, (int)blockIdx.x);
  EpiAd<F> E{f};
  pg8::gemm_phase(( __attribute__((address_space(3))) unsigned char*)smem, g, S, E);
}
struct F_LruIn { char* ACT; __device__ __forceinline__ void operator()(int row, int n, f32x4 v) const {
  bfr* dst = n < 1280 ? (bfr*)(ACT + A_U) + (size_t)row * 1280 + n : (bfr*)(ACT + A_Z) + (size_t)row * 1280 + (n - 1280); store4b(dst, v); } };
struct F_Resid { float* Xx; float* Xc; const float* MODg; int wc; __device__ __forceinline__ void operator()(int row, int n, f32x4 v) const {
  int b = row / BT_, o = row - b * BT_; bool isc = o < 256; if (isc && !wc) return;
  float* xr = isc ? Xc + (size_t)(b * 256 + o) * 1024 : Xx + (size_t)(b * 16384 + o - 256) * 1024; const float* g = MODg + (size_t)(isc ? 2 : b) * 3072 + 2048;
  float4 xv = *(float4*)(xr + n); float4 gg = *(const float4*)(g + n);
  xv.x += gg.x * v[0]; xv.y += gg.y * v[1]; xv.z += gg.z * v[2]; xv.w += gg.w * v[3]; *(float4*)(xr + n) = xv; } };
struct F_MlIn { char* ACT; __device__ __forceinline__ void operator()(int row, int n, f32x4 v) const {
  if (n < 4096) store4b((bfr*)(ACT + A_QKV) + (size_t)row * 4096 + n, v);
  else if (n < 4128) *(float4*)((float*)(ACT + A_GATE) + (size_t)row * 32 + (n - 4096)) = float4{v[0], v[1], v[2], v[3]}; } };
struct F_MlZ { char* ACT; const float* ng; __device__ __forceinline__ void operator()(int row, int n, f32x4 v) const {
  bfr* hp = (bfr*)(ACT + A_HS) + (size_t)row * 2048 + n; uint2 u = *(const uint2*)hp; float rs = ((const float*)(ACT + A_RSTD))[(size_t)row * 8 + (n >> 8)];
  float4 g4 = *(const float4*)(ng + n); f32x4 o;
  o[0] = blo(u.x) * rs * g4.x * siluf(v[0]); o[1] = bhi(u.x) * rs * g4.y * siluf(v[1]); o[2] = blo(u.y) * rs * g4.z * siluf(v[2]); o[3] = bhi(u.y) * rs * g4.w * siluf(v[3]);
  store4b(hp, o); } };
struct F_R7In { char* ACT; __device__ __forceinline__ void operator()(int row, int n, f32x4 v) const {
  if (n < 4096) store4b((bfr*)(ACT + A_RKVZ) + (size_t)row * 4096 + n, v);
  else if (n < 4224) { f32x4 t;
#pragma unroll
    for (int q = 0; q < 4; q++) t[q] = tanhf(v[q]);
    store4b((bfr*)(ACT + A_WM) + (size_t)row * 128 + (n - 4096), t); }
  else store4b((bfr*)(ACT + A_AM) + (size_t)row * 128 + (n - 4224), v); } };

template <class G> __device__ __forceinline__ void gemm_phase(const P& p, const Ctx& c, char* smem) {
  const int total = 130 * G::NT;
  for (int it = blockIdx.x; it < total; it += gridDim.x) gemm_tile<G>(p, c, it / G::NT, it % G::NT, smem);
}

__device__ __forceinline__ void ph_pre(const P& p, char* smem) {
  float* sm = (float*)smem; const int tid = ltid();
  const int nprep = prep_count(0), ngemv = 192, ncopy = 4160;
  if (blockIdx.x == 0) for (int i = tid; i < 5120; i += 512) p.CL[i] = 8.f * softplusf(-p.lru_lam[i]);
  for (int it = blockIdx.x; it < nprep + ngemv + ncopy; it += gridDim.x) {
    if (it < nprep) { prep_item(p, 0, it, sm); continue; }
    int i2 = it - nprep;
    if (i2 < ngemv) {
      int l = i2 / 48, cgp = i2 % 48;
      for (int i = tid; i < 3072; i += 512) { int cnd = i >> 10, k = i & 1023; float v = cnd == 0 ? p.c[k] : cnd == 1 ? p.c[1024 + k] : p.c_ctx[k]; sm[i] = siluf(v); }
      __syncthreads();
      int kq = tid >> 6, col = cgp * 64 + (tid & 63); const float* w = p.mod_w + (size_t)l * 1024 * 3072 + col;
      float a0 = 0.f, a1 = 0.f, a2 = 0.f;
      for (int k = kq * 128; k < kq * 128 + 128; k++) { float wv = w[(size_t)k * 3072]; a0 += sm[k] * wv; a1 += sm[1024 + k] * wv; a2 += sm[2048 + k] * wv; }
      float* red = sm + 3072; red[tid * 3] = a0; red[tid * 3 + 1] = a1; red[tid * 3 + 2] = a2;
      __syncthreads();
      if (tid < 64) { float bias = p.mod_b[(size_t)l * 3072 + col];
        for (int cnd = 0; cnd < 3; cnd++) { float s = bias; for (int q = 0; q < 8; q++) s += red[(q * 64 + tid) * 3 + cnd]; p.MOD[(size_t)(l * 3 + cnd) * 3072 + col] = s; } }
      __syncthreads();
      continue;
    }
    i2 -= ngemv;
    for (int q = 0; q < 4; q++) { int idx = i2 * 2048 + q * 512 + tid; int row = idx >> 8, c4 = idx & 255; int b = row / BT_, o = row - b * BT_;
      if (o < 256) ((float4*)p.Xc)[(size_t)(b * 256 + o) * 256 + c4] = ((const float4*)p.ctx)[(size_t)(b * 256 + o) * 256 + c4];
      else ((float4*)p.Xx)[(size_t)(b * 16384 + o - 256) * 256 + c4] = ((const float4*)p.x)[(size_t)(b * 16384 + o - 256) * 256 + c4]; }
  }
}
__device__ __forceinline__ void ph_norm(const P& p, int layer, char* smem) {
  const int tid = ltid(), lane = tid & 63, wid = tid >> 6;
  const int nprep = layer > 0 ? prep_count(layer) : 0; const int kind = layer % 3;
  const int nzero = kind == 1 ? 8320 : 0;
  (void)nzero;
  for (int it = blockIdx.x; it < nprep + 4160; it += gridDim.x) {
    if (it < nprep) { prep_item(p, layer, it, (float*)smem); continue; }
    int row = (it - nprep) * 8 + wid; int mo; const float* xr = xrowp(p, row, mo);
    float4 v[4]; float ss = 0.f;
#pragma unroll
    for (int i = 0; i < 4; i++) { v[i] = *(const float4*)(xr + lane * 4 + 256 * i); ss += v[i].x * v[i].x + v[i].y * v[i].y + v[i].z * v[i].z + v[i].w * v[i].w; }
    ss = wsum(ss); float rs = rsqrtf(ss * (1.f / 1024.f) + 1e-6f);
    const float* g = p.norm_g + (size_t)layer * 1024; const float* md = p.MOD + (size_t)(layer * 3 + mo) * 3072;
#pragma unroll
    for (int i = 0; i < 4; i++) { int cidx = lane * 4 + 256 * i; float4 gg = *(const float4*)(g + cidx), sh = *(const float4*)(md + cidx), sc = *(const float4*)(md + 1024 + cidx);
      f32x4 o; o[0] = v[i].x * rs * gg.x * (1.f + sc.x) + sh.x; o[1] = v[i].y * rs * gg.y * (1.f + sc.y) + sh.y; o[2] = v[i].z * rs * gg.z * (1.f + sc.z) + sh.z; o[3] = v[i].w * rs * gg.w * (1.f + sc.w) + sh.w;
      store4b(p.H + (size_t)row * (kind == 2 ? 2048 : 1024) + cidx, o); }
  }
}
__device__ __forceinline__ void ph_r7_shift(const P& p) {
  for (int it = blockIdx.x; it < 8320; it += gridDim.x) {
    int idx = it * 512 + ltid(); int row = idx >> 7, c8 = idx & 127, q = c8 >> 5;
    int b = row / BT_, o = row - b * BT_; int nr = -1;
    if (o < 256) { if (q < 2) { if (o >= 1) nr = row - 1; } else { if (o < 255) nr = row + 1; } }
    else { int t = o - 256, col = t & 63, gr = t >> 6;
      if (q == 0) { if (col != 0) nr = row - 1; } else if (q == 1) { if (col != 63) nr = row + 1; }
      else if (q == 2) { if (gr != 0) nr = row - 64; } else { if (gr != 255) nr = row + 64; } }
    uint4 v = nr >= 0 ? *(const uint4*)(p.H + (size_t)nr * 2048 + c8 * 8) : uint4{0u, 0u, 0u, 0u};
    *(uint4*)(p.H + (size_t)row * 2048 + 1024 + c8 * 8) = v;
  }
}
__device__ __forceinline__ void ph_final(const P& p) {
  const int lane = ltid() & 63, wid = ltid() >> 6;
  for (int it = blockIdx.x; it < 4096; it += gridDim.x) {
    float* xr = p.Xx + (size_t)(it * 8 + wid) * 1024; float4 v[4]; float ss = 0.f;
#pragma unroll
    for (int i = 0; i < 4; i++) { v[i] = *(const float4*)(xr + lane * 4 + 256 * i); ss += v[i].x * v[i].x + v[i].y * v[i].y + v[i].z * v[i].z + v[i].w * v[i].w; }
    ss = wsum(ss); float rs = rsqrtf(ss * (1.f / 1024.f) + 1e-6f);
#pragma unroll
    for (int i = 0; i < 4; i++) { int cidx = lane * 4 + 256 * i; float4 gg = *(const float4*)(p.final_g + cidx);
      *(float4*)(xr + cidx) = float4{v[i].x * rs * gg.x, v[i].y * rs * gg.y, v[i].z * rs * gg.z, v[i].w * rs * gg.w}; }
  }
}
__device__ __forceinline__ void ph_lru_conv(const P& p, int j) {
  const bfr* U = (const bfr*)(p.ACT + A_U); bfr* UC = (bfr*)(p.ACT + A_UC);
  const float* cw = p.lru_conv_w + (size_t)j * 4 * 1280; const float* cb = p.lru_conv_b + (size_t)j * 1280;
  for (int it = blockIdx.x; it < 10400; it += gridDim.x) {
    int idx = it * 512 + ltid(); int row = idx / 160, cgp = idx % 160, ch = cgp * 8;
    int b = row / BT_, o = row - b * BT_; int s0 = o < 256 ? 0 : 256, e0 = o < 256 ? 256 : BT_;
    float acc[8];
#pragma unroll
    for (int e = 0; e < 8; e++) acc[e] = cb[ch + e];
#pragma unroll
    for (int t = 0; t < 4; t++) { int oo = o + t - 2; if (oo < s0 || oo >= e0) continue;
      uint4 u = *(const uint4*)(U + (size_t)(row + t - 2) * 1280 + ch); const float* w = cw + t * 1280 + ch;
      acc[0] += w[0] * blo(u.x); acc[1] += w[1] * bhi(u.x); acc[2] += w[2] * blo(u.y); acc[3] += w[3] * bhi(u.y);
      acc[4] += w[4] * blo(u.z); acc[5] += w[5] * bhi(u.z); acc[6] += w[6] * blo(u.w); acc[7] += w[7] * bhi(u.w); }
    *(uint4*)(UC + (size_t)row * 1280 + ch) = uint4{pk2(acc[0], acc[1]), pk2(acc[2], acc[3]), pk2(acc[4], acc[5]), pk2(acc[6], acc[7])};
  }
}
__device__ __forceinline__ void ph_lru_s1(const P& p, int d) {
  const unsigned* AB = (const unsigned*)(p.ACT + A_AB); float2* AGG = (float2*)(p.ACT + A_AGG);
  const int t = ltid();
  for (int it = blockIdx.x * 8 + (t >> 6); it < 2600; it += gridDim.x * 8) {
    int b = it / 1300, r = it % 1300, cc = r / 5, ch = (r % 5) * 256 + (t & 63) * 4;
    float P0 = 1.f, Q0 = 0.f, P1 = 1.f, Q1 = 0.f, P2 = 1.f, Q2 = 0.f, P3 = 1.f, Q3 = 0.f;
#pragma unroll 8
    for (int q = 0; q < 64; q++) { uint4 u = *(const uint4*)(AB + (size_t)rowmap(d, b, cc * 64 + q) * 1280 + ch);
      float a0 = 1.f - bhi(u.x), a1 = 1.f - bhi(u.y), a2 = 1.f - bhi(u.z), a3 = 1.f - bhi(u.w);
      P0 *= a0; Q0 = a0 * Q0 + blo(u.x); P1 *= a1; Q1 = a1 * Q1 + blo(u.y); P2 *= a2; Q2 = a2 * Q2 + blo(u.z); P3 *= a3; Q3 = a3 * Q3 + blo(u.w); }
    float4* ag = (float4*)(AGG + (size_t)(b * NCH_ + cc) * 1280 + ch); ag[0] = float4{P0, Q0, P1, Q1}; ag[1] = float4{P2, Q2, P3, Q3};
  }
}
__device__ __forceinline__ void ph_lru_s2(const P& p) {
  const float2* AGG = (const float2*)(p.ACT + A_AGG); float* CAR = (float*)(p.ACT + A_CAR);
  for (int it = blockIdx.x; it < 5; it += gridDim.x) {
    int idx = it * 512 + ltid(), b = idx / 1280, ch = idx % 1280; float h = 0.f;
#pragma unroll 20
    for (int cc = 0; cc < NCH_; cc++) { size_t o = (size_t)(b * NCH_ + cc) * 1280 + ch; float2 a = AGG[o]; CAR[o] = h; h = a.x * h + a.y; }
  }
}
__device__ __forceinline__ void ph_lru_s3(const P& p, int d) {
  const unsigned* AB = (const unsigned*)(p.ACT + A_AB); const float* CAR = (const float*)(p.ACT + A_CAR);
  bfr* HF = (bfr*)(p.ACT + A_HF); bfr* Z = (bfr*)(p.ACT + A_Z);
  const int t = ltid();
  for (int it = blockIdx.x * 8 + (t >> 6); it < 2600; it += gridDim.x * 8) {
    int b = it / 1300, r = it % 1300, cc = r / 5, ch = (r % 5) * 256 + (t & 63) * 4;
    float4 h = *(const float4*)(CAR + (size_t)(b * NCH_ + cc) * 1280 + ch);
#pragma unroll 8
    for (int q = 0; q < 64; q++) { size_t o = (size_t)rowmap(d, b, cc * 64 + q) * 1280 + ch; uint4 u = *(const uint4*)(AB + o);
      h.x = (1.f - bhi(u.x)) * h.x + blo(u.x); h.y = (1.f - bhi(u.y)) * h.y + blo(u.y); h.z = (1.f - bhi(u.z)) * h.z + blo(u.z); h.w = (1.f - bhi(u.w)) * h.w + blo(u.w);
      if (d == 0) *(uint2*)(HF + o) = uint2{pk2(h.x, h.y), pk2(h.z, h.w)};
      else { uint2 hf = *(const uint2*)(HF + o), zz = *(const uint2*)(Z + o);
        *(uint2*)(Z + o) = uint2{pk2((blo(hf.x) + h.x) * siluf(blo(zz.x)), (bhi(hf.x) + h.y) * siluf(bhi(zz.x))), pk2((blo(hf.y) + h.z) * siluf(blo(zz.y)), (bhi(hf.y) + h.w) * siluf(bhi(zz.y)))}; } }
  }
}
__device__ __forceinline__ void ph_ml_stat(const P& p) {
  const bfr* HS = (const bfr*)(p.ACT + A_HS); float* RS = (float*)(p.ACT + A_RSTD);
  const int lane = ltid() & 63, wid = ltid() >> 6;
  for (int it = blockIdx.x; it < 4160; it += gridDim.x) {
    int row = it * 8 + wid; const bfr* hp = HS + (size_t)row * 2048 + lane * 32; float ss = 0.f;
#pragma unroll
    for (int i = 0; i < 4; i++) { uint4 u = *(const uint4*)(hp + i * 8); float a;
      a = blo(u.x); ss += a * a; a = bhi(u.x); ss += a * a; a = blo(u.y); ss += a * a; a = bhi(u.y); ss += a * a;
      a = blo(u.z); ss += a * a; a = bhi(u.z); ss += a * a; a = blo(u.w); ss += a * a; a = bhi(u.w); ss += a * a; }
    ss += __shfl_xor(ss, 1); ss += __shfl_xor(ss, 2); ss += __shfl_xor(ss, 4);
    if ((lane & 7) == 0) RS[(size_t)row * 8 + (lane >> 3)] = rsqrtf(ss * (1.f / 256.f) + 1e-6f);
  }
}
__device__ __forceinline__ void ph_r7_fin(const P& p, int j) {
  bfr* Y = (bfr*)(p.ACT + A_Y); const bfr* RK = (const bfr*)(p.ACT + A_RKVZ); const float* BON = (const float*)(p.ACT + A_BON);
  const float* lg = p.r7_ln_g + (size_t)j * 1024; const float* lb = p.r7_ln_b + (size_t)j * 1024;
  const int lane = ltid() & 63, wid = ltid() >> 6;
  for (int it = blockIdx.x; it < 4160; it += gridDim.x) {
    int row = it * 8 + wid, ch = lane * 16, hd = lane >> 2;
    float y[16], v[16], z[16];
#pragma unroll
    for (int i = 0; i < 2; i++) {
      uint4 u = *(const uint4*)(Y + (size_t)row * 1024 + ch + i * 8);
      y[i * 8 + 0] = blo(u.x); y[i * 8 + 1] = bhi(u.x); y[i * 8 + 2] = blo(u.y); y[i * 8 + 3] = bhi(u.y); y[i * 8 + 4] = blo(u.z); y[i * 8 + 5] = bhi(u.z); y[i * 8 + 6] = blo(u.w); y[i * 8 + 7] = bhi(u.w);
      u = *(const uint4*)(RK + (size_t)row * 4096 + 2048 + ch + i * 8);
      v[i * 8 + 0] = blo(u.x); v[i * 8 + 1] = bhi(u.x); v[i * 8 + 2] = blo(u.y); v[i * 8 + 3] = bhi(u.y); v[i * 8 + 4] = blo(u.z); v[i * 8 + 5] = bhi(u.z); v[i * 8 + 6] = blo(u.w); v[i * 8 + 7] = bhi(u.w);
      u = *(const uint4*)(RK + (size_t)row * 4096 + 3072 + ch + i * 8);
      z[i * 8 + 0] = blo(u.x); z[i * 8 + 1] = bhi(u.x); z[i * 8 + 2] = blo(u.y); z[i * 8 + 3] = bhi(u.y); z[i * 8 + 4] = blo(u.z); z[i * 8 + 5] = bhi(u.z); z[i * 8 + 6] = blo(u.w); z[i * 8 + 7] = bhi(u.w);
    }
    float s = 0.f;
#pragma unroll
    for (int e = 0; e < 16; e++) s += y[e];
    s += __shfl_xor(s, 1); s += __shfl_xor(s, 2); float mean = s * (1.f / 64.f);
    float q = 0.f;
#pragma unroll
    for (int e = 0; e < 16; e++) { float dlt = y[e] - mean; q += dlt * dlt; }
    q += __shfl_xor(q, 1); q += __shfl_xor(q, 2); float rs = rsqrtf(q * (1.f / 64.f) + 64e-5f);
    float bon = BON[(size_t)row * 16 + hd] + BON[(size_t)(R_ + row) * 16 + hd];
    float o[16];
#pragma unroll
    for (int e = 0; e < 16; e++) { float yn = (y[e] - mean) * rs * lg[ch + e] + lb[ch + e]; o[e] = (yn + bon * v[e]) * siluf(z[e]); }
#pragma unroll
    for (int i = 0; i < 2; i++)
      *(uint4*)(Y + (size_t)row * 1024 + ch + i * 8) = uint4{pk2(o[i * 8], o[i * 8 + 1]), pk2(o[i * 8 + 2], o[i * 8 + 3]), pk2(o[i * 8 + 4], o[i * 8 + 5]), pk2(o[i * 8 + 6], o[i * 8 + 7])};
  }
}

#define QS 136
#define VS 72
#define MLG_BYTES 45056
__device__ __forceinline__ void ph_ml_scan(const P& p, int j, char* smem0) {
  const int d = ltid() >> 8;
  char* smem = smem0 + d * MLG_BYTES;
  bfr* sQ = (bfr*)smem; bfr* sK = sQ + 64 * QS; bfr* sVT = sK + 64 * QS; bfr* sCT = sVT + 16 * VS;
  float* sN = (float*)(sCT + 16 * QS);
  float* sEs = sN + 128; float* sCt = sEs + 64; float* sBc = sCt + 64; float* sWg = sBc + 64; float* sNr = sWg + 64;
  const bfr* QKV = (const bfr*)(p.ACT + A_QKV); const float* GT = (const float*)(p.ACT + A_GATE); bfr* HS = (bfr*)(p.ACT + A_HS);
  const float* gbias = p.ml_gate_b + (size_t)j * 32;
  const int tid = ltid() & 255, lane = tid & 63, w = tid >> 6, l15 = lane & 15, q4 = lane >> 4;
  for (int it = blockIdx.x; it < 256; it += gridDim.x) {
    const int b = it >> 7, hh = (it >> 4) & 7, sl = it & 15;
    f32x4 Cacc[2];
    Cacc[0] = f32x4{0.f, 0.f, 0.f, 0.f}; Cacc[1] = f32x4{0.f, 0.f, 0.f, 0.f};
    float mcur = 0.f;
    for (int i = tid; i < 16 * QS; i += 256) sCT[i] = 0;
    if (tid < 128) sN[tid] = 0.f;
    uint4 pq0, pq1, pq2, pq3, pk0, pk1, pk2, pk3, pv = uint4{0u, 0u, 0u, 0u}; float pgi, pgf;
#define ML_ROW0(s_) (d == 0 ? b * BT_ + 64 * (s_) : rowmap(1, b, 64 * (s_) + 63))
#define ML_LD(i_, PQ, PK) { int idx = tid + 256 * (i_), rho = idx >> 4, c8 = idx & 15; const bfr* src = QKV + (size_t)(r0n + rho) * 4096 + hh * 128 + c8 * 8; PQ = *(const uint4*)src; PK = *(const uint4*)(src + 1024); }
#define ML_ISSUE(s_) { const int r0n = ML_ROW0(s_); ML_LD(0, pq0, pk0) ML_LD(1, pq1, pk1) ML_LD(2, pq2, pk2) ML_LD(3, pq3, pk3) \
      if (tid < 128) pv = *(const uint4*)(QKV + (size_t)(r0n + (tid >> 1)) * 4096 + 2048 + hh * 256 + sl * 16 + (tid & 1) * 8); \
      { const float* gp_ = GT + (size_t)(r0n + (d ? 63 - lane : lane)) * 32 + d * 16 + hh; pgi = gp_[0]; pgf = gp_[8]; } }
#define ML_ST(i_, PQ, PK) { int idx = tid + 256 * (i_), rho = idx >> 4, c8 = idx & 15; *(uint4*)(sQ + rho * QS + c8 * 8) = PQ; *(uint4*)(sK + rho * QS + c8 * 8) = PK; }
#define ML_COMMIT() { ML_ST(0, pq0, pk0) ML_ST(1, pq1, pk1) ML_ST(2, pq2, pk2) ML_ST(3, pq3, pk3) \
      if (tid < 128) { int rho = tid >> 1, vb = (tid & 1) * 8; \
        sVT[(vb + 0) * VS + rho] = (bfr)(pv.x & 0xffff); sVT[(vb + 1) * VS + rho] = (bfr)(pv.x >> 16); \
        sVT[(vb + 2) * VS + rho] = (bfr)(pv.y & 0xffff); sVT[(vb + 3) * VS + rho] = (bfr)(pv.y >> 16); \
        sVT[(vb + 4) * VS + rho] = (bfr)(pv.z & 0xffff); sVT[(vb + 5) * VS + rho] = (bfr)(pv.z >> 16); \
        sVT[(vb + 6) * VS + rho] = (bfr)(pv.w & 0xffff); sVT[(vb + 7) * VS + rho] = (bfr)(pv.w >> 16); } }
    ML_ISSUE(0)
    __syncthreads();
    for (int s = 0; s < NCH_; s++) {
      const int r0 = ML_ROW0(s);
      ML_COMMIT()
      float mxl, decay;
      {
        int rho = d ? 63 - lane : lane;
        float gi = pgi + gbias[(d * 2 + 0) * 8 + hh], gf = pgf + gbias[(d * 2 + 1) * 8 + hh];
        float fc = fminf(gf, 0.f) - __logf(1.f + __expf(-fabsf(gf)));
        float bc = fc;
        for (int o = 1; o < 64; o <<= 1) { float t = __shfl_up(bc, o); if (lane >= o) bc += t; }
        float e = gi - bc, pm = e;
        for (int o = 1; o < 64; o <<= 1) { float t = __shfl_up(pm, o); if (lane >= o) pm = fmaxf(pm, t); }
        float pml = __shfl(pm, 63), bcl = __shfl(bc, 63);
        mxl = fmaxf(mcur, pml); decay = __expf(mcur - mxl);
        if (w == 0) { sEs[rho] = e; sCt[rho] = -fmaxf(mcur, pm); sBc[rho] = bc; sWg[rho] = __expf(e - mxl); }
        pml = bcl + mxl;
        bcl = mcur; mcur = pml; pml = bcl;
        mxl = pml;
      }
      const float mold = mxl;
      __syncthreads();
      const int rt = 16 * w + l15;
      bfr* hp = HS + (size_t)(r0 + rt) * 2048 + hh * 256 + sl * 16 + 4 * q4;
      bool first; { int rc = (r0 - b * BT_) >> 6; if (d == 0) { int sp = rc < 4 ? 3 - rc : 263 - rc; first = s < sp; } else first = s < rc; }
      unsigned long long uu = 0ull;
      if (!first) uu = __hip_atomic_load((unsigned long long*)hp, __ATOMIC_RELAXED, __HIP_MEMORY_SCOPE_AGENT);
      if (s + 1 < NCH_) ML_ISSUE(s + 1)
      bf16x8 qf[4];
#pragma unroll
      for (int ks = 0; ks < 4; ks++) qf[ks] = *(const bf16x8*)(sQ + (16 * w + l15) * QS + ks * 32 + q4 * 8);
      f32x4 sacc[4];
#pragma unroll
      for (int a = 0; a < 4; a++) { sacc[a] = f32x4{0.f, 0.f, 0.f, 0.f};
#pragma unroll
        for (int ks = 0; ks < 4; ks++) { bf16x8 kf = *(const bf16x8*)(sK + (16 * a + l15) * QS + ks * 32 + q4 * 8); sacc[a] = __builtin_amdgcn_mfma_f32_16x16x32_bf16(kf, qf[ks], sacc[a], 0, 0, 0); } }
      const float ctt = sCt[rt]; float densum = 0.f;
#pragma unroll
      for (int a = 0; a < 4; a++)
#pragma unroll
        for (int jj = 0; jj < 4; jj++) { int rs_ = 16 * a + 4 * q4 + jj; bool valid = d == 0 ? rs_ <= rt : rs_ >= rt;
          float wv = valid ? __expf(ctt + sEs[rs_]) : 0.f; float sv = sacc[a][jj] * wv; sacc[a][jj] = sv; densum += sv; }
      densum += __shfl_xor(densum, 16); densum += __shfl_xor(densum, 32);
      bf16x8 sf[2], vf[2];
#pragma unroll
      for (int ks = 0; ks < 2; ks++) {
#pragma unroll
        for (int jj = 0; jj < 4; jj++) { sf[ks][jj] = (short)f2b(sacc[2 * ks][jj]); sf[ks][4 + jj] = (short)f2b(sacc[2 * ks + 1][jj]); }
        uint2 v0 = *(const uint2*)(sVT + l15 * VS + 32 * ks + 4 * q4), v1 = *(const uint2*)(sVT + l15 * VS + 32 * ks + 16 + 4 * q4);
        uint4 vv = uint4{v0.x, v0.y, v1.x, v1.y}; vf[ks] = *(bf16x8*)&vv;
      }
      f32x4 num = f32x4{0.f, 0.f, 0.f, 0.f}, numC = f32x4{0.f, 0.f, 0.f, 0.f};
#pragma unroll
      for (int ks = 0; ks < 2; ks++) num = __builtin_amdgcn_mfma_f32_16x16x32_bf16(vf[ks], sf[ks], num, 0, 0, 0);
#pragma unroll
      for (int ks = 0; ks < 4; ks++) { bf16x8 cf = *(const bf16x8*)(sCT + l15 * QS + ks * 32 + q4 * 8); numC = __builtin_amdgcn_mfma_f32_16x16x32_bf16(cf, qf[ks], numC, 0, 0, 0); }
      float qn = 0.f;
#pragma unroll
      for (int i = 0; i < 4; i++) { uint4 u = *(const uint4*)(sQ + rt * QS + 32 * q4 + i * 8); const float* nn = sN + 32 * q4 + i * 8;
        qn += blo(u.x) * nn[0] + bhi(u.x) * nn[1] + blo(u.y) * nn[2] + bhi(u.y) * nn[3] + blo(u.z) * nn[4] + bhi(u.z) * nn[5] + blo(u.w) * nn[6] + bhi(u.w) * nn[7]; }
      qn += __shfl_xor(qn, 16); qn += __shfl_xor(qn, 32);
      {
        float inter = __expf(mold + ctt); float den = densum + inter * qn; float dn = fmaxf(fabsf(den), __expf(ctt - sBc[rt])); float inv = __builtin_amdgcn_rcpf(dn);
        f32x4 hv;
#pragma unroll
        for (int jj = 0; jj < 4; jj++) hv[jj] = (num[jj] + inter * numC[jj]) * inv;
        if (!first) { unsigned ux = (unsigned)uu, uy = (unsigned)(uu >> 32);
          hv[0] += blo(ux); hv[1] += bhi(ux); hv[2] += blo(uy); hv[3] += bhi(uy); }
        store4b(hp, hv);
      }
      __syncthreads();
      {
        bf16x8 vw[2], wa[2];
#pragma unroll
        for (int ks = 0; ks < 2; ks++)
#pragma unroll
          for (int e = 0; e < 8; e++) { int rs_ = 32 * ks + (e < 4 ? 4 * q4 + e : 16 + 4 * q4 + e - 4); const float wg_ = sWg[rs_]; vw[ks][e] = (short)f2b(b2f((bfr)vf[ks][e]) * wg_); wa[ks][e] = l15 == 0 ? (short)f2b(wg_) : (short)0; }
#pragma unroll
        for (int a = 0; a < 2; a++) {
          int dk = 32 * w + 16 * a + l15;
#pragma unroll
          for (int jj = 0; jj < 4; jj++) Cacc[a][jj] *= decay;
          f32x4 nacc = f32x4{0.f, 0.f, 0.f, 0.f};
#pragma unroll
          for (int ks = 0; ks < 2; ks++) { bf16x8 kt;
#pragma unroll
            for (int e = 0; e < 8; e++) { int rs_ = 32 * ks + (e < 4 ? 4 * q4 + e : 16 + 4 * q4 + e - 4); kt[e] = (short)sK[rs_ * QS + dk]; }
            Cacc[a] = __builtin_amdgcn_mfma_f32_16x16x32_bf16(vw[ks], kt, Cacc[a], 0, 0, 0);
            nacc = __builtin_amdgcn_mfma_f32_16x16x32_bf16(wa[ks], kt, nacc, 0, 0, 0); }
          if (q4 == 0) sNr[dk] = nacc[0];
#pragma unroll
          for (int jj = 0; jj < 4; jj++) sCT[(4 * q4 + jj) * QS + dk] = f2b(Cacc[a][jj]);
        }
      }
      __syncthreads();
      if (tid < 128) sN[tid] = decay * sN[tid] + sNr[tid];
    }
    __syncthreads();
  }
}

#define CS 72
#define CSLOT(i_) ((bfr*)smem + (i_) * (64 * CS))
#define A_SST (A_R7B + 362086400ull)
__device__ __forceinline__ f32x4 cmm(const bfr* X, const bfr* YT, int ti, int tj, int l15, int q4) {
  f32x4 acc = f32x4{0.f, 0.f, 0.f, 0.f};
#pragma unroll
  for (int ks = 0; ks < 2; ks++) { bf16x8 a = *(const bf16x8*)(X + (16 * ti + l15) * CS + 32 * ks + 8 * q4); bf16x8 b = *(const bf16x8*)(YT + (16 * tj + l15) * CS + 32 * ks + 8 * q4);
    acc = __builtin_amdgcn_mfma_f32_16x16x32_bf16(a, b, acc, 0, 0, 0); }
  return acc;
}
template <int MODE> __device__ __forceinline__ f32x4 cmm_mask(const bfr* X, const bfr* YT, int ti, int tj, int l15, int q4) {
  f32x4 acc = f32x4{0.f, 0.f, 0.f, 0.f};
#pragma unroll
  for (int ks = 0; ks < 2; ks++) { const int kb = 2 * ks + (q4 >> 1);
    const bool ok = MODE == 1 ? ((kb == 0 && tj == 1) || (kb == 2 && tj == 3)) : (kb < 2 && tj >= 2);
    bf16x8 a = *(const bf16x8*)(X + (16 * ti + l15) * CS + 32 * ks + 8 * q4); bf16x8 bz = bf16x8{0, 0, 0, 0, 0, 0, 0, 0};
    if (ok) bz = *(const bf16x8*)(YT + (16 * tj + l15) * CS + 32 * ks + 8 * q4);
    acc = __builtin_amdgcn_mfma_f32_16x16x32_bf16(a, bz, acc, 0, 0, 0); }
  return acc;
}
__device__ __forceinline__ void st_row(bfr* dst, int r0, int c, f32x4 v) {
#pragma unroll
  for (int jj = 0; jj < 4; jj++) dst[(r0 + jj) * CS + c] = f2b(v[jj]); }
__device__ __forceinline__ void st_tr(bfr* dst, int r0, int c, f32x4 v) { store4b(dst + c * CS + r0, v); }
__device__ __forceinline__ f32x4 ld_row(const bfr* src, int r0, int c) { f32x4 v;
#pragma unroll
  for (int jj = 0; jj < 4; jj++) v[jj] = b2f(src[(r0 + jj) * CS + c]);
  return v; }
__device__ __forceinline__ f32x4 ld_tr(const bfr* src, int r0, int c) { uint2 u = *(const uint2*)(src + c * CS + r0); return f32x4{blo(u.x), bhi(u.x), blo(u.y), bhi(u.y)}; }

__device__ __forceinline__ void ph_r7_ca(const P& p, int j, int win, char* smem) {
  float* LW = (float*)(smem + 7 * 9216); float* AT = (float*)(smem + 9 * 9216); float* WL = (float*)(smem + 14 * 9216);
  const bfr* RK = (const bfr*)(p.ACT + A_RKVZ); const bfr* WMb = (const bfr*)(p.ACT + A_WM); const bfr* AMb = (const bfr*)(p.ACT + A_AM);
  float* BON = (float*)(p.ACT + A_BON); bfr* WB = p.H;
  const float* kkp = p.r7_k_k + (size_t)j * 1024; const float* kap = p.r7_k_a + (size_t)j * 1024; const float* rkp = p.r7_r_k + (size_t)j * 1024;
  const int tid = ltid(), lane = tid & 63, w = tid >> 6, l15 = lane & 15, q4 = lane >> 4, ti = w >> 1, tj0 = (w & 1) * 2;
  const int c0 = win * 65;
  for (int it = blockIdx.x; it < 4160; it += gridDim.x) {
    const int chain = it / 65, cl = it - chain * 65, c = c0 + cl, d = chain & 1, b = chain >> 5, h = (chain >> 1) & 15;
    {
      const int rowA = rowmap(d, b, 64 * c + 16 * ti + l15);
      const float* w0 = p.r7_w0 + (size_t)(j * 2 + d) * 1024 + h * 64; const float* a0 = p.r7_a0 + (size_t)(j * 2 + d) * 1024 + h * 64;
#pragma unroll
      for (int tt = 0; tt < 2; tt++) { const int tj = tj0 + tt; f32x4 aw = f32x4{0.f, 0.f, 0.f, 0.f}, aa = aw;
#pragma unroll
        for (int ks = 0; ks < 2; ks++) {
          bf16x8 xw = *(const bf16x8*)(WMb + (size_t)rowA * 128 + d * 64 + 32 * ks + 8 * q4), xa = *(const bf16x8*)(AMb + (size_t)rowA * 128 + d * 64 + 32 * ks + 8 * q4);
          bf16x8 yw = *(const bf16x8*)(p.W + WR_UP + d * 65536 + (size_t)(h * 64 + 16 * tj + l15) * 64 + 32 * ks + 8 * q4);
          bf16x8 ya = *(const bf16x8*)(p.W + WR_UP + (2 + d) * 65536 + (size_t)(h * 64 + 16 * tj + l15) * 64 + 32 * ks + 8 * q4);
          aw = __builtin_amdgcn_mfma_f32_16x16x32_bf16(xw, yw, aw, 0, 0, 0); aa = __builtin_amdgcn_mfma_f32_16x16x32_bf16(xa, ya, aa, 0, 0, 0); }
        const int ch = 16 * tj + l15; const float w0v = w0[ch], a0v = a0[ch];
#pragma unroll
        for (int jj = 0; jj < 4; jj++) { const int tau = 16 * ti + 4 * q4 + jj; LW[tau * 64 + ch] = -0.6065306597126334f * sigm(w0v + aw[jj]); AT[tau * 64 + ch] = sigm(a0v + aa[jj]); }
      }
    }
    __syncthreads();
    if (tid < 64) { float acc = 0.f;
#pragma unroll 8
      for (int t = 0; t < 64; t++) { acc += LW[t * 64 + tid]; LW[t * 64 + tid] = acc; } }
    __syncthreads();
    {
      const int tau = tid >> 3, sc = tid & 7, col = h * 64 + sc * 8; const int row = rowmap(d, b, 64 * c + tau);
      const bfr* rp = RK + (size_t)row * 4096 + col; uint4 pr = *(const uint4*)rp, pk = *(const uint4*)(rp + 1024);
      unsigned ur[4] = {pr.x, pr.y, pr.z, pr.w}, uk[4] = {pk.x, pk.y, pk.z, pk.w};
      float r8[8], k8[8], kr[8];
#pragma unroll
      for (int e = 0; e < 4; e++) { r8[2 * e] = blo(ur[e]); r8[2 * e + 1] = bhi(ur[e]); k8[2 * e] = blo(uk[e]); k8[2 * e + 1] = bhi(uk[e]); }
      float ss = 0.f;
#pragma unroll
      for (int e = 0; e < 8; e++) { kr[e] = k8[e] * kkp[col + e]; ss += kr[e] * kr[e]; }
      ss += __shfl_xor(ss, 1); ss += __shfl_xor(ss, 2); ss += __shfl_xor(ss, 4);
      const float inv = __builtin_amdgcn_rsqf(fmaxf(ss, 1e-24f));
      float bon = 0.f, o0[8], o1[8], o2[8], o3[8], o4[8], o5[8];
#pragma unroll
      for (int e = 0; e < 8; e++) {
        const float cw = LW[tau * 64 + sc * 8 + e], cwm = tau > 0 ? LW[(tau - 1) * 64 + sc * 8 + e] : 0.f, cwl = LW[63 * 64 + sc * 8 + e], a = AT[tau * 64 + sc * 8 + e];
        const float ka = kr[e] * inv, be = a * ka, kd = k8[e] * (1.f + (a - 1.f) * kap[col + e]); bon += r8[e] * kd * rkp[col + e];
        const float e2 = __expf(-cw), e4 = __expf(cwl - cw);
        o0[e] = ka * __expf(cwm); o1[e] = be * e2; o2[e] = kd * e2; o3[e] = r8[e] * __expf(cw); o4[e] = be * e4; o5[e] = kd * e4;
        if (tau == 63) WL[sc * 8 + e] = __expf(cwl);
      }
      bon += __shfl_xor(bon, 1); bon += __shfl_xor(bon, 2); bon += __shfl_xor(bon, 4);
      if (sc == 0) BON[((size_t)d * R_ + row) * 16 + h] = bon;
      *(uint4*)(CSLOT(0) + tau * CS + sc * 8) = uint4{pk2(o0[0], o0[1]), pk2(o0[2], o0[3]), pk2(o0[4], o0[5]), pk2(o0[6], o0[7])};
      *(uint4*)(CSLOT(1) + tau * CS + sc * 8) = uint4{pk2(o1[0], o1[1]), pk2(o1[2], o1[3]), pk2(o1[4], o1[5]), pk2(o1[6], o1[7])};
      *(uint4*)(CSLOT(2) + tau * CS + sc * 8) = uint4{pk2(o2[0], o2[1]), pk2(o2[2], o2[3]), pk2(o2[4], o2[5]), pk2(o2[6], o2[7])};
      *(uint4*)(CSLOT(3) + tau * CS + sc * 8) = uint4{pk2(o3[0], o3[1]), pk2(o3[2], o3[3]), pk2(o3[4], o3[5]), pk2(o3[6], o3[7])};
#pragma unroll
      for (int e = 0; e < 8; e++) { CSLOT(4)[(sc * 8 + e) * CS + tau] = f2b(o0[e]); CSLOT(5)[(sc * 8 + e) * CS + tau] = f2b(o4[e]); CSLOT(6)[(sc * 8 + e) * CS + tau] = f2b(o5[e]); }
    }
    __syncthreads();
#pragma unroll
    for (int tt = 0; tt < 2; tt++) { const int tj = tj0 + tt, r0 = 16 * ti + 4 * q4, cc = 16 * tj + l15;
      f32x4 v = cmm(CSLOT(1), CSLOT(0), ti, tj, l15, q4);
#pragma unroll
      for (int jj = 0; jj < 4; jj++) if (!(r0 + jj < cc)) v[jj] = 0.f;
      st_row(CSLOT(7), r0, cc, v); st_tr(CSLOT(8), r0, cc, v);
      v = cmm(CSLOT(2), CSLOT(0), ti, tj, l15, q4);
#pragma unroll
      for (int jj = 0; jj < 4; jj++) if (!(r0 + jj < cc)) v[jj] = 0.f;
      st_row(CSLOT(9), r0, cc, v);
      v = cmm(CSLOT(3), CSLOT(1), ti, tj, l15, q4);
#pragma unroll
      for (int jj = 0; jj < 4; jj++) if (!(cc <= r0 + jj)) v[jj] = 0.f;
      st_row(CSLOT(10), r0, cc, v);
      v = cmm(CSLOT(3), CSLOT(2), ti, tj, l15, q4);
#pragma unroll
      for (int jj = 0; jj < 4; jj++) if (!(cc <= r0 + jj)) v[jj] = 0.f;
      st_row(CSLOT(11), r0, cc, v);
    }
    __syncthreads();
    {
      float* X = (float*)CSLOT(0);
      const bfr* Ab = CSLOT(7);
      const int cl = lane >> 3, pp = lane & 7, cx = 8 * w + cl, blk0 = (w >> 1) * 16;
#pragma unroll 1
      for (int il = 15; il >= 0; il--) { const int i = blk0 + il;
        float sum = 0.f;
#pragma unroll 1
        for (int jx = i + 1 + pp; jx < blk0 + 16; jx += 8) sum += b2f(Ab[i * CS + jx]) * X[jx * 72 + cx];
        sum += dppf<0xB1>(sum); sum += dppf<0x4E>(sum); sum += dppf<0x141>(sum);
        const float xv = (i == cx ? 1.f : 0.f) - sum;
        if (pp == 0) X[i * 72 + cx] = xv;
      }
      __syncthreads();
#pragma unroll 1
      for (int e = tid; e < 4096; e += 512) { const int i = e >> 6, c2 = e & 63; const bfr tv = ((i >> 4) == (c2 >> 4)) ? f2b(X[i * 72 + c2]) : (bfr)0; CSLOT(2)[i * CS + c2] = tv; CSLOT(12)[c2 * CS + i] = tv; }
      __syncthreads();
#pragma unroll
      for (int tt = 0; tt < 2; tt++) { const int tj = tj0 + tt, r0 = 16 * ti + 4 * q4, cc = 16 * tj + l15; st_row(CSLOT(13), r0, cc, cmm_mask<1>(CSLOT(2), CSLOT(8), ti, tj, l15, q4)); }
      __syncthreads();
#pragma unroll
      for (int tt = 0; tt < 2; tt++) { const int tj = tj0 + tt, r0 = 16 * ti + 4 * q4, cc = 16 * tj + l15;
        f32x4 v = ld_row(CSLOT(2), r0, cc) - cmm(CSLOT(13), CSLOT(12), ti, tj, l15, q4); st_row(CSLOT(0), r0, cc, v); st_tr(CSLOT(1), r0, cc, v); }
      __syncthreads();
#pragma unroll
      for (int tt = 0; tt < 2; tt++) { const int tj = tj0 + tt, r0 = 16 * ti + 4 * q4, cc = 16 * tj + l15; st_row(CSLOT(13), r0, cc, cmm_mask<2>(CSLOT(0), CSLOT(8), ti, tj, l15, q4)); }
      __syncthreads();
#pragma unroll
      for (int tt = 0; tt < 2; tt++) { const int tj = tj0 + tt, r0 = 16 * ti + 4 * q4, cc = 16 * tj + l15;
        f32x4 v = ld_row(CSLOT(0), r0, cc) - cmm(CSLOT(13), CSLOT(1), ti, tj, l15, q4);
#pragma unroll
        for (int jj = 0; jj < 4; jj++) if (r0 + jj == cc) v[jj] -= 1.f;
        st_row(CSLOT(2), r0, cc, v); }
      __syncthreads();
    }
#pragma unroll
    for (int tt = 0; tt < 2; tt++) { const int tj = tj0 + tt, r0 = 16 * ti + 4 * q4, cc = 16 * tj + l15;
      f32x4 g = cmm(CSLOT(10), CSLOT(2), ti, tj, l15, q4) + ld_row(CSLOT(10), r0, cc); st_row(CSLOT(12), r0, cc, g);
      f32x4 hh = cmm(CSLOT(5), CSLOT(2), ti, tj, l15, q4) + ld_row(CSLOT(5), r0, cc); st_row(CSLOT(13), r0, cc, hh); }
    __syncthreads();
    {
      bfr* out = WB + (size_t)(chain * 65 + cl) * 16384;
#pragma unroll
      for (int tt = 0; tt < 2; tt++) { const int tj = tj0 + tt, r0 = 16 * ti + 4 * q4, cc = 16 * tj + l15;
        f32x4 v = ld_tr(CSLOT(3), r0, cc) - cmm(CSLOT(4), CSLOT(12), ti, tj, l15, q4);
        store4b(out + cc * 64 + r0, v);
        v = ld_tr(CSLOT(11), r0, cc) - cmm(CSLOT(9), CSLOT(12), ti, tj, l15, q4);
        store4b(out + 4096 + cc * 64 + r0, v);
        v = -cmm(CSLOT(4), CSLOT(13), ti, tj, l15, q4);
#pragma unroll
        for (int jj = 0; jj < 4; jj++) if (r0 + jj == cc) v[jj] += WL[cc];
        store4b(out + 8192 + cc * 64 + r0, v);
        v = ld_tr(CSLOT(6), r0, cc) - cmm(CSLOT(9), CSLOT(13), ti, tj, l15, q4);
        store4b(out + 12288 + cc * 64 + r0, v);
      }
    }
    __syncthreads();
  }
}

__device__ __forceinline__ void ph_r7_cb(const P& p, int win, int d, char* smem) {
  bfr* Sh = (bfr*)smem; bfr* Sl = Sh + 2 * 16 * CS; bfr* VT = Sl + 2 * 16 * CS;
  const bfr* WB = p.H; const bfr* RK = (const bfr*)(p.ACT + A_RKVZ); bfr* Y = (bfr*)(p.ACT + A_Y); bfr* SST = (bfr*)(p.ACT + A_SST);
  const int tid = ltid(), lane = tid & 63, w = tid >> 6, l15 = lane & 15, q4 = lane >> 4;
  const int c0 = win * 65;
  for (int it = blockIdx.x; it < 128; it += gridDim.x) {
    const int b = it >> 6, h = (it >> 2) & 15, rg = it & 3, chain = (b * 16 + h) * 2 + d;
    bfr* sst = SST + (size_t)(chain * 4 + rg) * 2048;
    __syncthreads();
    if (tid < 256) { const int hl = tid >> 7, e = tid & 127, rr = e >> 3, c8 = e & 7; uint4 v = uint4{0u, 0u, 0u, 0u};
      if (win > 0) v = *(const uint4*)(sst + hl * 1024 + rr * 64 + c8 * 8);
      *(uint4*)((hl ? Sl : Sh) + rr * CS + c8 * 8) = v; }
    const int vtau = tid >> 3, vp = tid & 7;
    { const int row = rowmap(d, b, 64 * c0 + vtau); unsigned vv = *(const unsigned*)(RK + (size_t)row * 4096 + 2048 + h * 64 + rg * 16 + 2 * vp);
      VT[(2 * vp) * CS + vtau] = (bfr)(vv & 0xffff); VT[(2 * vp + 1) * CS + vtau] = (bfr)(vv >> 16); }
    const bfr* bbase = WB + (size_t)(chain * 65) * 16384 + (w < 4 ? 8192 + (16 * w + l15) * 64 : (16 * (w - 4) + l15) * 64) + 8 * q4;
    bf16x8 rb1[4][2], rb2[4][2]; unsigned rv[4]; uint2 ry[4];
#define CB_FIRST(c_) ({ const int rc_ = d == 0 ? (c_) : ((c_) < 4 ? 3 - (c_) : 263 - (c_)); const int cb_ = rc_ < 4 ? 3 - rc_ : 263 - rc_; d == 0 ? (win <= cb_ / 65) : (win < rc_ / 65); })
#define CB_LOAD(u_, s_) { const int ss_ = (s_) < 65 ? (s_) : 64; const bfr* bp_ = bbase + (size_t)ss_ * 16384; \
      rb1[u_][0] = *(const bf16x8*)bp_; rb1[u_][1] = *(const bf16x8*)(bp_ + 32); rb2[u_][0] = *(const bf16x8*)(bp_ + 4096); rb2[u_][1] = *(const bf16x8*)(bp_ + 4096 + 32); \
      const int sv_ = ss_ + 1 < 65 ? ss_ + 1 : 64; const int rowv_ = rowmap(d, b, 64 * (c0 + sv_) + vtau); \
      rv[u_] = *(const unsigned*)(RK + (size_t)rowv_ * 4096 + 2048 + h * 64 + rg * 16 + 2 * vp); \
      ry[u_] = uint2{0u, 0u}; if (w >= 4 && !CB_FIRST(c0 + ss_)) { const int rowy_ = rowmap(d, b, 64 * (c0 + ss_) + 16 * (w - 4) + l15); ry[u_] = *(const uint2*)(Y + (size_t)rowy_ * 1024 + h * 64 + rg * 16 + 4 * q4); } }
    CB_LOAD(0, 0) CB_LOAD(1, 1) CB_LOAD(2, 2) CB_LOAD(3, 3)
    __syncthreads();
    for (int g = 0; g < 17; g++) {
#pragma unroll
      for (int u = 0; u < 4; u++) {
        const int s = 4 * g + u;
        if (s < 65) {
          const int cur = s & 1, nxt = cur ^ 1, c = c0 + s;
          bf16x8 sh[2], sl[2], vt[2];
#pragma unroll
          for (int ks = 0; ks < 2; ks++) { sh[ks] = *(const bf16x8*)(Sh + (cur * 16 + l15) * CS + 32 * ks + 8 * q4); sl[ks] = *(const bf16x8*)(Sl + (cur * 16 + l15) * CS + 32 * ks + 8 * q4);
            vt[ks] = *(const bf16x8*)(VT + (cur * 16 + l15) * CS + 32 * ks + 8 * q4); }
          f32x4 a1 = f32x4{0.f, 0.f, 0.f, 0.f}, a2 = a1;
#pragma unroll
          for (int ks = 0; ks < 2; ks++) { a1 = __builtin_amdgcn_mfma_f32_16x16x32_bf16(sh[ks], rb1[u][ks], a1, 0, 0, 0); a2 = __builtin_amdgcn_mfma_f32_16x16x32_bf16(vt[ks], rb2[u][ks], a2, 0, 0, 0); }
#pragma unroll
          for (int ks = 0; ks < 2; ks++) a1 = __builtin_amdgcn_mfma_f32_16x16x32_bf16(sl[ks], rb1[u][ks], a1, 0, 0, 0);
          a1 = a1 + a2;
          if (w < 4) {
#pragma unroll
            for (int jj = 0; jj < 4; jj++) { const bfr hi = f2b(a1[jj]); Sh[(nxt * 16 + 4 * q4 + jj) * CS + 16 * w + l15] = hi; Sl[(nxt * 16 + 4 * q4 + jj) * CS + 16 * w + l15] = f2b(a1[jj] - b2f(hi)); }
          } else {
            const int rowy = rowmap(d, b, 64 * c + 16 * (w - 4) + l15);
            a1[0] += blo(ry[u].x); a1[1] += bhi(ry[u].x); a1[2] += blo(ry[u].y); a1[3] += bhi(ry[u].y);
            store4b(Y + (size_t)rowy * 1024 + h * 64 + rg * 16 + 4 * q4, a1);
          }
          if (s + 1 < 65) { VT[(nxt * 16 + 2 * vp) * CS + vtau] = (bfr)(rv[u] & 0xffff); VT[(nxt * 16 + 2 * vp + 1) * CS + vtau] = (bfr)(rv[u] >> 16); }
          if (s + 4 < 65) CB_LOAD(u, s + 4)
          __syncthreads();
        }
      }
    }
    if (tid < 256) { const int hl = tid >> 7, e = tid & 127, rr = e >> 3, c8 = e & 7; *(uint4*)(sst + hl * 1024 + rr * 64 + c8 * 8) = *(const uint4*)((hl ? Sl : Sh) + (16 + rr) * CS + c8 * 8); }
  }
}

__device__ __forceinline__ void run_phase(const P& p, int ph, int layer, int d, char* smem) {
  Ctx c; c.layer = layer; c.j = layer / 3; c.d = d; c.wc = layer < 3 ? 1 : 0;
  switch (ph) {
    case PH_PRE: ph_pre(p, smem); break;
    case PH_NORM: ph_norm(p, layer, smem); break;
    case PH_LRU_IN: big_gemm(smem, p.H, p.W, 2560, 1024, F_LruIn{p.ACT}); break;
    case PH_LRU_CONV: ph_lru_conv(p, c.j); break;
    case PH_LRU_GATE: gemm_phase<G_LruGate>(p, c, smem); break;
    case PH_LRU_S1: ph_lru_s1(p, d); break;
    case PH_LRU_S2: ph_lru_s2(p); break;
    case PH_LRU_S3: ph_lru_s3(p, d); break;
    case PH_LRU_OUT: big_gemm(smem, (const bfr*)(p.ACT + A_Z), p.W + WL_OUT, 1024, 1280, F_Resid{p.Xx, p.Xc, p.MOD + (size_t)layer * 3 * 3072, c.wc}); break;
    case PH_ML_IN: big_gemm(smem, p.H, p.W, 4352, 1024, F_MlIn{p.ACT}); break;
    case PH_ML_SCAN: ph_ml_scan(p, c.j, smem); break;
    case PH_ML_STAT: ph_ml_stat(p); break;
    case PH_ML_Z: big_gemm(smem, p.H, p.W + WM_Z, 2048, 1024, F_MlZ{p.ACT, p.ml_norm_g + (size_t)c.j * 2048}); break;
    case PH_ML_OUT: big_gemm(smem, (const bfr*)(p.ACT + A_HS), p.W + WM_OUT, 1024, 2048, F_Resid{p.Xx, p.Xc, p.MOD + (size_t)layer * 3 * 3072, c.wc}); break;
    case PH_R7_IN: big_gemm(smem, p.H, p.W, 4352, 2048, F_R7In{p.ACT}); break;
    case PH_R7_SHIFT: ph_r7_shift(p); break;
    case PH_R7_CA: ph_r7_ca(p, c.j, d, smem); break;
    case PH_R7_CB: ph_r7_cb(p, d >> 1, d & 1, smem); break;
    case PH_R7_FIN: ph_r7_fin(p, c.j); break;
    case PH_R7_OUT: big_gemm(smem, (const bfr*)(p.ACT + A_Y), p.W + WR_OUT, 1024, 1024, F_Resid{p.Xx, p.Xc, p.MOD + (size_t)layer * 3 * 3072, c.wc}); break;
    case PH_FINAL: ph_final(p); break;
  }
}


#define XB_TMO      128
#define XB_XCNT(j)  (256  + 64 * (j))
#define XB_XSUB(j)  (1280 + 64 * (j))
#define XB_XGEN(j)  (2304 + 64 * (j))
#define XB_TOP      3328
#define XB_TOPGEN   3392
#define XCD_BAR_WORDS 3456
#define XB_SPIN_CAP (1u << 18)
#define OFF_BAR 527000064ull
#define OFF_CL (OFF_BAR + 16384ull)
__device__ __forceinline__ unsigned xb_ld(unsigned* p)              { return __hip_atomic_load(p, __ATOMIC_RELAXED, __HIP_MEMORY_SCOPE_AGENT); }
__device__ __forceinline__ unsigned xb_add(unsigned* p, unsigned v) { return __hip_atomic_fetch_add(p, v, __ATOMIC_RELAXED, __HIP_MEMORY_SCOPE_AGENT); }
__device__ __forceinline__ unsigned xb_xcc_id() { return (unsigned)__builtin_amdgcn_s_getreg((3 << 11) | 20) & 0xFu; }
#define XB_SPIN(cond, bar) do { unsigned _sp = 0; while (cond) { __builtin_amdgcn_s_sleep(1); \
    if ((++_sp & 255u) == 0u) { if (xb_ld(&(bar)[XB_TMO])) break; if (_sp > XB_SPIN_CAP) { atomicAdd(&(bar)[XB_TMO], 1u); break; } } } } while (0)
struct XcdBarrier { unsigned* bar; unsigned x; volatile __attribute__((address_space(3))) unsigned* st; };
__device__ __forceinline__ XcdBarrier xcd_barrier_post(unsigned* bar, volatile __attribute__((address_space(3))) unsigned* st) {
  XcdBarrier b; b.bar = bar; b.x = xb_xcc_id(); b.st = st;
  if (threadIdx.x == 0) (void)xb_add(&bar[XB_XCNT(b.x)], 1u);
  return b;
}
__device__ __forceinline__ void xcd_barrier_complete(unsigned* bar, unsigned x, unsigned& nloc, unsigned& nx) {
  const unsigned G = gridDim.x * gridDim.y * gridDim.z;
  unsigned sum, cnt, mine, sp = 0u;
  for (;;) {
    sum = 0u; cnt = 0u; mine = 0u;
#pragma unroll
    for (unsigned j = 0; j < 16; ++j) { const unsigned c = xb_ld(&bar[XB_XCNT(j)]); sum += c; cnt += (c > 0u) ? 1u : 0u; mine = (j == x) ? c : mine; }
    if (sum == G) break;
    __builtin_amdgcn_s_sleep(1);
    if ((++sp & 255u) == 0u) { if (xb_ld(&bar[XB_TMO])) break; if (sp > XB_SPIN_CAP) { atomicAdd(&bar[XB_TMO], 1u); break; } }
  }
  nloc = mine > 0u ? mine : 1u; nx = cnt > 0u ? cnt : 1u;
}
__device__ __forceinline__ void xcd_barrier(const XcdBarrier& b) {
  asm volatile("s_waitcnt vmcnt(0)" ::: "memory");
  __syncthreads();
  if (threadIdx.x == 0) {
    unsigned* bar = b.bar;
    __builtin_amdgcn_s_waitcnt(0);
    unsigned nloc = b.st[0], nx = b.st[1];
    if (nloc == 0u) { xcd_barrier_complete(bar, b.x, nloc, nx); b.st[0] = nloc; b.st[1] = nx; }
    const unsigned old = xb_add(&bar[XB_XSUB(b.x)], 1u);
    const unsigned gen = old / nloc;
    if (old + 1u == (gen + 1u) * nloc) {
      __builtin_amdgcn_fence(__ATOMIC_RELEASE, "agent");
      asm volatile("s_waitcnt vmcnt(0)" ::: "memory");
      const unsigned og = xb_add(&bar[XB_TOP], 1u);
      const unsigned tg = og / nx;
      if (og + 1u == (tg + 1u) * nx) xb_add(&bar[XB_TOPGEN], 1u);
      else XB_SPIN(xb_ld(&bar[XB_TOPGEN]) == tg, bar);
      __builtin_amdgcn_fence(__ATOMIC_ACQUIRE, "agent");
      xb_add(&bar[XB_XGEN(b.x)], 1u);
      asm volatile("s_waitcnt vmcnt(0)" ::: "memory");
    } else {
      XB_SPIN(xb_ld(&bar[XB_XGEN(b.x)]) == gen, bar);
      __builtin_amdgcn_fence(__ATOMIC_ACQUIRE, "agent");
      asm volatile("s_waitcnt vmcnt(0)" ::: "memory");
    }
  }
  __syncthreads();
}

#define SMEM_BYTES (131072 + 64)
extern __shared__ __attribute__((aligned(16))) char dyn_smem[];
#if !MEGA
__global__ void __launch_bounds__(512, 2) phase_kernel(P p, int si) {
  run_phase(p, p.sched[si * 3], p.sched[si * 3 + 1], p.sched[si * 3 + 2], dyn_smem);
}
#else
__global__ void __launch_bounds__(512, 2) mega_kernel(P p) {
  cg::grid_group grid = cg::this_grid();
  volatile __attribute__((address_space(3))) unsigned* st = (volatile __attribute__((address_space(3))) unsigned*)(dyn_smem + 131072);
  if (threadIdx.x < 4) st[threadIdx.x] = 0u;
  __syncthreads();
  const XcdBarrier xb = xcd_barrier_post(p.bar, st);
  for (int si = 0; si < p.nsched; si++) {
    run_phase(p, p.sched[si * 3], p.sched[si * 3 + 1], p.sched[si * 3 + 2], dyn_smem);
    if (si + 1 < p.nsched) { if (si == 0) grid.sync(); else xcd_barrier(xb); }
  }
}
#endif

extern "C" void kernel_launch(void* const* d_in, const int* in_sizes, int n_in, void* d_out, int out_size, void* d_ws, size_t ws_size, hipStream_t stream) {
  P p; memset(&p, 0, sizeof(p));
  const float** f = (const float**)&p;
  for (int i = 0; i < 33; i++) f[i] = (const float*)d_in[i];
  char* ws = (char*)d_ws;
  p.Xx = (float*)d_out; p.Xc = (float*)(ws + OFF_XC); p.MOD = (float*)(ws + OFF_MOD); p.W = (bfr*)(ws + OFF_W); p.H = (bfr*)(ws + OFF_H); p.ACT = ws + OFF_ACT; p.bar = (unsigned*)(ws + OFF_BAR); p.CL = (float*)(ws + OFF_CL);
  int n = 0;
  auto add = [&](int ph, int layer, int d) { p.sched[n * 3] = ph; p.sched[n * 3 + 1] = layer; p.sched[n * 3 + 2] = d; n++; };
  add(PH_PRE, 0, 0);
  if (DUP & 4) add(PH_PRE, 0, 0);
  for (int l = 0; l < 4; l++) {
    add(PH_NORM, l, 0); if (DUP & 4) add(PH_NORM, l, 0);
    int kind = l % 3;
    const bool dg = DUP & 1, ds = DUP & 2;
    if (kind == 0) { add(PH_LRU_IN, l, 0); if (dg) add(PH_LRU_IN, l, 0); add(PH_LRU_CONV, l, 0); if (DUP & 4) add(PH_LRU_CONV, l, 0);
      for (int d = 0; d < 2; d++) { add(PH_LRU_GATE, l, d); if (dg) add(PH_LRU_GATE, l, d); add(PH_LRU_S1, l, d); if (DUP & 8) add(PH_LRU_S1, l, d); add(PH_LRU_S2, l, d); if (DUP & 16) add(PH_LRU_S2, l, d); add(PH_LRU_S3, l, d); }
      add(PH_LRU_OUT, l, 0); }
    else if (kind == 1) { add(PH_ML_IN, l, 0); if (dg) add(PH_ML_IN, l, 0); add(PH_ML_SCAN, l, 0); if (ds) add(PH_ML_SCAN, l, 0); add(PH_ML_STAT, l, 0); if (DUP & 4) add(PH_ML_STAT, l, 0); add(PH_ML_Z, l, 0); add(PH_ML_OUT, l, 0); }
    else { add(PH_R7_SHIFT, l, 0); add(PH_R7_IN, l, 0); if (dg) add(PH_R7_IN, l, 0); for (int wi = 0; wi < 4; wi++) { add(PH_R7_CA, l, wi); if (ds) add(PH_R7_CA, l, wi); add(PH_R7_CB, l, wi * 2); add(PH_R7_CB, l, wi * 2 + 1); } add(PH_R7_FIN, l, 0); add(PH_R7_OUT, l, 0); }
  }
  add(PH_FINAL, 0, 0);
  p.nsched = n;
  if (ws_size < WS_NEED) fprintf(stderr, "workspace too small: %zu < %llu\n", ws_size, (unsigned long long)WS_NEED);
#if MEGA
  static int grid_blocks = 0;
  if (!grid_blocks) { int dev = 0, cus = 0, per = 0; hipGetDevice(&dev); hipDeviceGetAttribute(&cus, hipDeviceAttributeMultiprocessorCount, dev);
    hipFuncSetAttribute((const void*)mega_kernel, hipFuncAttributeMaxDynamicSharedMemorySize, SMEM_BYTES);
    hipOccupancyMaxActiveBlocksPerMultiprocessor(&per, mega_kernel, 512, SMEM_BYTES); if (per > 1) per = 1; if (per < 1) per = 1; grid_blocks = cus * per; }
  hipMemsetAsync(ws + OFF_BAR, 0, XCD_BAR_WORDS * 4, stream);
  void* args[] = {&p};
  hipError_t e = hipLaunchCooperativeKernel((void*)mega_kernel, dim3(grid_blocks), dim3(512), args, SMEM_BYTES, stream);
  if (e != hipSuccess) fprintf(stderr, "cooperative launch failed: %s (grid %d)\n", hipGetErrorString(e), grid_blocks);
#else
  static int once = 0; if (!once) { once = 1; hipFuncSetAttribute((const void*)phase_kernel, hipFuncAttributeMaxDynamicSharedMemorySize, SMEM_BYTES); }
  for (int si = 0; si < n; si++) phase_kernel<<<256, 512, SMEM_BYTES, stream>>>(p, si);
#endif
}
```

```cpp
#include <hip/hip_runtime.h>
#include <hip/hip_bf16.h>
#include <hip/hip_cooperative_groups.h>
#include <cstdio>
#include <cstring>
#include <type_traits>
namespace cg = cooperative_groups;

#ifndef DUP
#define DUP 0
#endif
#ifndef MEGA
#define MEGA 1
#endif

typedef unsigned short bfr;
using bf16x8 = __attribute__((ext_vector_type(8))) short;
using f32x4 = __attribute__((ext_vector_type(4))) float;

#define R_ 33280
#define BT_ 16640
#define NCH_ 260

#define OFF_XC 0ull
#define OFF_MOD 2097152ull
#define OFF_W 2244608ull
#define OFF_H 24264704ull
#define OFF_ACT 92422144ull
#define A_Z 0ull
#define A_UC 85196800ull
#define A_AB 170393600ull
#define A_U 170393600ull
#define A_HF 340787200ull
#define A_AGG 425984000ull
#define A_CAR 431308800ull
#define A_QKV 0ull
#define A_GATE 272629760ull
#define A_HS 276889600ull
#define A_RSTD 413204480ull
#define A_R7B 68157440ull
#define A_RKVZ (A_R7B + 0ull)
#define A_WM (A_R7B + 272629760ull)
#define A_AM (A_R7B + 281149440ull)
#define A_BON (A_R7B + 289669120ull)
#define A_Y (A_R7B + 293928960ull)
#define WS_NEED (527000064ull + 16384ull)

#define WL_GATE (2560 * 1024)
#define WL_OUT (WL_GATE + 1310720)
#define WM_Z (4352 * 1024)
#define WM_OUT (WM_Z + 2048 * 1024)
#define WR_UP (4352 * 2048)
#define WR_OUT (WR_UP + 262144)

enum { PH_PRE = 0, PH_NORM, PH_LRU_IN, PH_LRU_CONV, PH_LRU_GATE, PH_LRU_S1, PH_LRU_S2, PH_LRU_S3, PH_LRU_OUT,
       PH_ML_IN, PH_ML_SCAN, PH_ML_STAT, PH_ML_Z, PH_ML_OUT,
       PH_R7_IN, PH_R7_CA, PH_R7_CB, PH_R7_FIN, PH_R7_OUT, PH_FINAL, PH_R7_SHIFT };

struct P {
  const float *x, *c, *ctx, *c_ctx, *norm_g, *mod_w, *mod_b, *final_g;
  const float *lru_w_in, *lru_conv_w, *lru_conv_b, *lru_gate_w, *lru_gate_b, *lru_lam, *lru_w_out;
  const float *ml_w_in, *ml_gate_b, *ml_norm_g, *ml_w_out;
  const float *r7_mu, *r7_w_rkvz, *r7_w0, *r7_w1, *r7_w2, *r7_a0, *r7_a1, *r7_a2, *r7_k_k, *r7_k_a, *r7_r_k, *r7_ln_g, *r7_ln_b, *r7_w_out;
  float* Xx; float* Xc; float* MOD; bfr* W; bfr* H; char* ACT; unsigned* bar; float* CL;
  int nsched; int pad_;
  int sched[64 * 3];
};
struct Ctx { int layer, j, d, wc; };

__device__ __forceinline__ int ltid() { int t = threadIdx.x; asm volatile("" : "+v"(t)); return t; }
typedef float f32v2_ __attribute__((ext_vector_type(2))); typedef __bf16 bf16v2_ __attribute__((ext_vector_type(2)));
__device__ __forceinline__ unsigned cvtpk(float lo, float hi) { f32v2_ f = {lo, hi}; bf16v2_ h = __builtin_convertvector(f, bf16v2_); return __builtin_bit_cast(unsigned, h); }
__device__ __forceinline__ bfr f2b(float f) { return (bfr)(cvtpk(f, f) & 0xffffu); }
__device__ __forceinline__ float b2f(bfr b) { return __uint_as_float(((unsigned)b) << 16); }
__device__ __forceinline__ unsigned pk2(float a, float b) { return cvtpk(a, b); }
__device__ __forceinline__ float blo(unsigned u) { return __uint_as_float(u << 16); }
__device__ __forceinline__ float bhi(unsigned u) { return __uint_as_float(u & 0xffff0000u); }
__device__ __forceinline__ void store4b(bfr* dst, f32x4 v) { uint2 u; u.x = pk2(v[0], v[1]); u.y = pk2(v[2], v[3]); *(uint2*)dst = u; }
__device__ __forceinline__ float sigm(float x) { return __builtin_amdgcn_rcpf(1.f + __expf(-x)); }
__device__ __forceinline__ float siluf(float x) { return x * sigm(x); }
__device__ __forceinline__ float softplusf(float x) { return x > 20.f ? x : log1pf(expf(x)); }
__device__ __forceinline__ int rowmap(int d, int b, int pp) { int o = d == 0 ? pp : (pp < 256 ? 255 - pp : 16895 - pp); return b * BT_ + o; }
__device__ __forceinline__ float* xrowp(const P& p, int row, int& mi) {
  int b = row / BT_, o = row - b * BT_;
  if (o < 256) { mi = 2; return p.Xc + (size_t)(b * 256 + o) * 1024; }
  mi = b; return p.Xx + (size_t)(b * 16384 + o - 256) * 1024;
}
__device__ __forceinline__ float wsum(float v) { for (int o = 32; o; o >>= 1) v += __shfl_xor(v, o); return v; }
template <int CTRL> __device__ __forceinline__ float dppf(float x) {
  return __int_as_float(__builtin_amdgcn_update_dpp(0, __float_as_int(x), CTRL, 0xf, 0xf, true));
}
__device__ __forceinline__ float red16(float x) {
  x += dppf<0xB1>(x); x += dppf<0x4E>(x); x += dppf<0x141>(x); x += dppf<0x140>(x); return x;
}

template <class F> __device__ __forceinline__ void prep_tile(bfr* dst, int K, int tn, int tk, F get, float* sm) {
  int tid = ltid();
  for (int i = 0; i < 8; i++) { int kk = (tid >> 6) + 8 * i, nn = tid & 63; sm[kk * 65 + nn] = get(tk * 64 + kk, tn * 64 + nn); }
  __syncthreads();
  for (int i = 0; i < 8; i++) { int nn = (tid >> 6) + 8 * i, kk = tid & 63; dst[(size_t)(tn * 64 + nn) * K + tk * 64 + kk] = f2b(sm[kk * 65 + nn]); }
  __syncthreads();
}
__device__ __forceinline__ int prep_count(int layer) { int kind = layer % 3; return kind == 0 ? (640 + 320 + 320) : kind == 1 ? (1088 + 512 + 512) : (2176 + 64 + 256); }
__device__ __forceinline__ void prep_item(const P& p, int layer, int it, float* sm) {
  int kind = layer % 3, j = layer / 3;
  if (kind == 0) {
    if (it < 640) { int tn = it / 16, tk = it % 16; const float* s = p.lru_w_in + (size_t)j * 1024 * 2560;
      prep_tile(p.W, 1024, tn, tk, [=](int k, int n) { return s[(size_t)k * 2560 + n]; }, sm); return; }
    it -= 640;
    if (it < 320) { int d = it / 160, r = it % 160, tn = r / 2, tk = r % 2; const float* s = p.lru_gate_w + (size_t)(j * 2 + d) * 2 * 10 * 16384;
      prep_tile(p.W + WL_GATE + d * 655360, 128, tn, tk, [=](int k, int n) {
        int nt = n >> 7, blk = nt >> 1, sub = nt & 1, jj = n & 127, wn = jj >> 6, rr = jj & 63, g = rr >> 5, c = rr & 31;
        int kch = sub * 64 + wn * 32 + c; return s[((size_t)(g * 10 + blk) * 128 + k) * 128 + kch]; }, sm); return; }
    it -= 320;
    { int tn = it / 20, tk = it % 20; const float* s = p.lru_w_out + (size_t)j * 1280 * 1024;
      prep_tile(p.W + WL_OUT, 1280, tn, tk, [=](int k, int n) { return s[(size_t)k * 1024 + n]; }, sm); return; }
  } else if (kind == 1) {
    const float* s = p.ml_w_in + (size_t)j * 1024 * 6176;
    if (it < 1088) { int tn = it / 16, tk = it % 16;
      prep_tile(p.W, 1024, tn, tk, [=](int k, int n) {
        if (n < 4096) { float v = s[(size_t)k * 6176 + n]; return (n >= 1024 && n < 2048) ? v * 0.08838834764831845f : v; }
        if (n < 4128) return s[(size_t)k * 6176 + 6144 + (n - 4096)];
        return 0.f; }, sm); return; }
    it -= 1088;
    if (it < 512) { int tn = it / 16, tk = it % 16;
      prep_tile(p.W + WM_Z, 1024, tn, tk, [=](int k, int n) { return s[(size_t)k * 6176 + 4096 + n]; }, sm); return; }
    it -= 512;
    { int tn = it / 32, tk = it % 32; const float* so = p.ml_w_out + (size_t)j * 2048 * 1024;
      prep_tile(p.W + WM_OUT, 2048, tn, tk, [=](int k, int n) { return so[(size_t)k * 1024 + n]; }, sm); return; }
  } else {
    if (it < 2176) { int tn = it / 32, tk = it % 32;
      const float* mu = p.r7_mu + (size_t)j * 6 * 1024; const float* wr = p.r7_w_rkvz + (size_t)j * 4 * 1024 * 1024;
      const float* w1 = p.r7_w1 + (size_t)j * 2 * 1024 * 64; const float* a1 = p.r7_a1 + (size_t)j * 2 * 1024 * 64;
      prep_tile(p.W, 2048, tn, tk, [=](int k, int n) {
        int kk = k & 1023; float v, m;
        if (n < 4096) { int g = n >> 10, e = n & 1023; m = mu[g * 1024 + kk]; v = wr[((size_t)g * 1024 + kk) * 1024 + e]; }
        else if (n < 4224) { int xx = (n - 4096) >> 6, rr = (n - 4096) & 63; m = mu[4 * 1024 + kk]; v = w1[((size_t)xx * 1024 + kk) * 64 + rr]; }
        else { int xx = (n - 4224) >> 6, rr = (n - 4224) & 63; m = mu[5 * 1024 + kk]; v = a1[((size_t)xx * 1024 + kk) * 64 + rr]; }
        return (k < 1024 ? (1.f - m) : m) * v; }, sm); return; }
    it -= 2176;
    if (it < 64) { int u = it / 16, tn = it % 16; const float* s = (u < 2 ? p.r7_w2 : p.r7_a2) + (size_t)(j * 2 + (u & 1)) * 64 * 1024;
      prep_tile(p.W + WR_UP + u * 65536, 64, tn, 0, [=](int k, int n) { return s[(size_t)k * 1024 + n]; }, sm); return; }
    it -= 64;
    { int tn = it / 16, tk = it % 16; const float* s = p.r7_w_out + (size_t)j * 1024 * 1024;
      prep_tile(p.W + WR_OUT, 1024, tn, tk, [=](int k, int n) { return s[(size_t)k * 1024 + n]; }, sm); return; }
  }
}

#define LDSS 72
template <class G> __device__ __forceinline__ void gemm_tile(const P& p, const Ctx& c, int mt, int nt, char* smem) {
  const int tid = ltid(), lane = tid & 63, wid = tid >> 6, wm = wid & 3, wn = wid >> 2;
  bfr* sA = (bfr*)smem; bfr* sB = sA + 2 * 256 * LDSS;
  f32x4 acc[4][4];
  for (int a = 0; a < 4; a++) for (int b = 0; b < 4; b++) acc[a][b] = f32x4{0.f, 0.f, 0.f, 0.f};
  const int lr = tid >> 3, lc = tid & 7;
  uint4 ra[4], rb[2];
  auto gload = [&](int kt) __attribute__((always_inline)) {
#pragma unroll
    for (int i = 0; i < 4; i++) {
      const bfr* pa = G::aptr(p, c, mt * 256 + lr + 64 * i, kt, nt);
      ra[i] = pa ? *(const uint4*)(pa + lc * 8) : uint4{0u, 0u, 0u, 0u};
      if (i < 2) rb[i] = *(const uint4*)(G::bptr(p, c, nt * 128 + lr + 64 * i, kt) + lc * 8);
    }
  };
  auto sstore = [&](int buf) __attribute__((always_inline)) {
#pragma unroll
    for (int i = 0; i < 4; i++) {
      *(uint4*)(sA + (buf * 256 + lr + 64 * i) * LDSS + lc * 8) = ra[i];
      if (i < 2) *(uint4*)(sB + (buf * 128 + lr + 64 * i) * LDSS + lc * 8) = rb[i];
    }
  };
  gload(0); sstore(0); __syncthreads();
  for (int kt = 0; kt < G::KT; kt++) {
    const int buf = kt & 1;
    if (kt + 1 < G::KT) gload(kt + 1);
#pragma unroll
    for (int ks = 0; ks < 2; ks++) {
      bf16x8 af[4], bf[4];
#pragma unroll
      for (int i = 0; i < 4; i++) {
        af[i] = *(const bf16x8*)(sA + (buf * 256 + wm * 64 + i * 16 + (lane & 15)) * LDSS + ks * 32 + (lane >> 4) * 8);
        bf[i] = *(const bf16x8*)(sB + (buf * 128 + wn * 64 + i * 16 + (lane & 15)) * LDSS + ks * 32 + (lane >> 4) * 8);
      }
#pragma unroll
      for (int n = 0; n < 4; n++)
#pragma unroll
        for (int m = 0; m < 4; m++) acc[n][m] = __builtin_amdgcn_mfma_f32_16x16x32_bf16(bf[n], af[m], acc[n][m], 0, 0, 0);
    }
    if (kt + 1 < G::KT) sstore(buf ^ 1);
    __syncthreads();
  }
  G::epi(p, c, acc, mt * 256 + wm * 64, nt * 128 + wn * 64, lane);
}

__device__ __forceinline__ void epi_resid(const P& p, const Ctx& c, f32x4 (&acc)[4][4], int m0, int n0, int lane) {
#pragma unroll
  for (int mi = 0; mi < 4; mi++) {
    int row = m0 + mi * 16 + (lane & 15); int mo; float* xr = xrowp(p, row, mo);
    if (mo == 2 && !c.wc) continue;
    const float* g = p.MOD + (size_t)(c.layer * 3 + mo) * 3072 + 2048;
#pragma unroll
    for (int ni = 0; ni < 4; ni++) {
      int n = n0 + ni * 16 + (lane >> 4) * 4;
      float4 xv = *(float4*)(xr + n); float4 gg = *(const float4*)(g + n);
      xv.x += gg.x * acc[ni][mi][0]; xv.y += gg.y * acc[ni][mi][1]; xv.z += gg.z * acc[ni][mi][2]; xv.w += gg.w * acc[ni][mi][3];
      *(float4*)(xr + n) = xv;
    }
  }
}

struct G_LruIn { static constexpr int KT = 16, NT = 20;
  static __device__ __forceinline__ const bfr* aptr(const P& p, const Ctx& c, int row, int kt, int nt) { return p.H + (size_t)row * 1024 + kt * 64; }
  static __device__ __forceinline__ const bfr* bptr(const P& p, const Ctx& c, int n, int kt) { return p.W + (size_t)n * 1024 + kt * 64; }
  static __device__ __forceinline__ void epi(const P& p, const Ctx& c, f32x4 (&acc)[4][4], int m0, int n0, int lane) {
    bfr* U = (bfr*)(p.ACT + A_U); bfr* Z = (bfr*)(p.ACT + A_Z);
#pragma unroll
    for (int ni = 0; ni < 4; ni++)
#pragma unroll
      for (int mi = 0; mi < 4; mi++) {
        int row = m0 + mi * 16 + (lane & 15), n = n0 + ni * 16 + (lane >> 4) * 4;
        bfr* dst = n < 1280 ? U + (size_t)row * 1280 + n : Z + (size_t)row * 1280 + (n - 1280);
        store4b(dst, acc[ni][mi]);
      }
  } };
struct G_LruGate { static constexpr int KT = 2, NT = 20;
  static __device__ __forceinline__ const bfr* aptr(const P& p, const Ctx& c, int row, int kt, int nt) { return (const bfr*)(p.ACT + A_UC) + (size_t)row * 1280 + (nt >> 1) * 128 + kt * 64; }
  static __device__ __forceinline__ const bfr* bptr(const P& p, const Ctx& c, int n, int kt) { return p.W + WL_GATE + c.d * 655360 + (size_t)n * 128 + kt * 64; }
  static __device__ __forceinline__ void epi(const P& p, const Ctx& c, f32x4 (&acc)[4][4], int m0, int n0, int lane) {
    const bfr* UC = (const bfr*)(p.ACT + A_UC); unsigned* AB = (unsigned*)(p.ACT + A_AB);
    const float* gb = p.lru_gate_b + (size_t)(c.j * 2 + c.d) * 2 * 1280; const float* lam = p.lru_lam + (size_t)(c.j * 2 + c.d) * 1280;
    int chb = (n0 >> 6) * 32;
#pragma unroll
    for (int ni = 0; ni < 2; ni++) {
      int ch = chb + ni * 16 + (lane >> 4) * 4;
      float cl[4], br[4], bi[4];
#pragma unroll
      for (int q = 0; q < 4; q++) { cl[q] = p.CL[(size_t)(c.j * 2 + c.d) * 1280 + ch + q]; br[q] = gb[ch + q]; bi[q] = gb[1280 + ch + q]; }
#pragma unroll
      for (int mi = 0; mi < 4; mi++) {
        int row = m0 + mi * 16 + (lane & 15);
        uint2 u = *(const uint2*)(UC + (size_t)row * 1280 + ch);
        float uc[4] = {blo(u.x), bhi(u.x), blo(u.y), bhi(u.y)};
        unsigned o[4];
#pragma unroll
        for (int q = 0; q < 4; q++) {
          float r = sigm(acc[ni][mi][q] + br[q]), ig = sigm(acc[ni + 2][mi][q] + bi[q]);
          float la = -cl[q] * r; float oma = 1.f - __expf(la); float bb = __builtin_amdgcn_sqrtf(oma * (2.f - oma)) * ig * uc[q];
          o[q] = (((unsigned)f2b(oma)) << 16) | (unsigned)f2b(bb);
        }
        *(uint4*)(AB + (size_t)row * 1280 + ch) = uint4{o[0], o[1], o[2], o[3]};
      }
    }
  } };
struct G_LruOut { static constexpr int KT = 20, NT = 8;
  static __device__ __forceinline__ const bfr* aptr(const P& p, const Ctx& c, int row, int kt, int nt) { return (const bfr*)(p.ACT + A_Z) + (size_t)row * 1280 + kt * 64; }
  static __device__ __forceinline__ const bfr* bptr(const P& p, const Ctx& c, int n, int kt) { return p.W + WL_OUT + (size_t)n * 1280 + kt * 64; }
  static __device__ __forceinline__ void epi(const P& p, const Ctx& c, f32x4 (&acc)[4][4], int m0, int n0, int lane) { epi_resid(p, c, acc, m0, n0, lane); } };
struct G_MlIn { static constexpr int KT = 16, NT = 33;
  static __device__ __forceinline__ const bfr* aptr(const P& p, const Ctx& c, int row, int kt, int nt) { return p.H + (size_t)row * 1024 + kt * 64; }
  static __device__ __forceinline__ const bfr* bptr(const P& p, const Ctx& c, int n, int kt) { return p.W + (size_t)n * 1024 + kt * 64; }
  static __device__ __forceinline__ void epi(const P& p, const Ctx& c, f32x4 (&acc)[4][4], int m0, int n0, int lane) {
    bfr* QKV = (bfr*)(p.ACT + A_QKV); float* GT = (float*)(p.ACT + A_GATE);
#pragma unroll
    for (int ni = 0; ni < 4; ni++)
#pragma unroll
      for (int mi = 0; mi < 4; mi++) {
        int row = m0 + mi * 16 + (lane & 15), n = n0 + ni * 16 + (lane >> 4) * 4;
        if (n < 4096) store4b(QKV + (size_t)row * 4096 + n, acc[ni][mi]);
        else if (n < 4128) *(float4*)(GT + (size_t)row * 32 + (n - 4096)) = float4{acc[ni][mi][0], acc[ni][mi][1], acc[ni][mi][2], acc[ni][mi][3]};
      }
  } };
struct G_MlZ { static constexpr int KT = 16, NT = 16;
  static __device__ __forceinline__ const bfr* aptr(const P& p, const Ctx& c, int row, int kt, int nt) { return p.H + (size_t)row * 1024 + kt * 64; }
  static __device__ __forceinline__ const bfr* bptr(const P& p, const Ctx& c, int n, int kt) { return p.W + WM_Z + (size_t)n * 1024 + kt * 64; }
  static __device__ __forceinline__ void epi(const P& p, const Ctx& c, f32x4 (&acc)[4][4], int m0, int n0, int lane) {
    bfr* HS = (bfr*)(p.ACT + A_HS); const float* RS = (const float*)(p.ACT + A_RSTD); const float* ng = p.ml_norm_g + (size_t)c.j * 2048;
#pragma unroll
    for (int ni = 0; ni < 4; ni++)
#pragma unroll
      for (int mi = 0; mi < 4; mi++) {
        int row = m0 + mi * 16 + (lane & 15), n = n0 + ni * 16 + (lane >> 4) * 4;
        bfr* hp = HS + (size_t)row * 2048 + n; uint2 u = *(const uint2*)hp; float rs = RS[(size_t)row * 8 + (n >> 8)];
        float4 g4 = *(const float4*)(ng + n);
        f32x4 o;
        o[0] = blo(u.x) * rs * g4.x * siluf(acc[ni][mi][0]); o[1] = bhi(u.x) * rs * g4.y * siluf(acc[ni][mi][1]);
        o[2] = blo(u.y) * rs * g4.z * siluf(acc[ni][mi][2]); o[3] = bhi(u.y) * rs * g4.w * siluf(acc[ni][mi][3]);
        store4b(hp, o);
      }
  } };
struct G_MlOut { static constexpr int KT = 32, NT = 8;
  static __device__ __forceinline__ const bfr* aptr(const P& p, const Ctx& c, int row, int kt, int nt) { return (const bfr*)(p.ACT + A_HS) + (size_t)row * 2048 + kt * 64; }
  static __device__ __forceinline__ const bfr* bptr(const P& p, const Ctx& c, int n, int kt) { return p.W + WM_OUT + (size_t)n * 2048 + kt * 64; }
  static __device__ __forceinline__ void epi(const P& p, const Ctx& c, f32x4 (&acc)[4][4], int m0, int n0, int lane) { epi_resid(p, c, acc, m0, n0, lane); } };
struct G_R7In { static constexpr int KT = 32, NT = 34;
  static __device__ __forceinline__ const bfr* aptr(const P& p, const Ctx& c, int row, int kt, int nt) {
    if (kt < 16) return p.H + (size_t)row * 1024 + kt * 64;
    int q = (kt - 16) >> 2; int b = row / BT_, o = row - b * BT_; int nr;
    if (o < 256) { if (q < 2) { if (o < 1) return nullptr; nr = row - 1; } else { if (o >= 255) return nullptr; nr = row + 1; } }
    else { int t = o - 256, col = t & 63, gr = t >> 6;
      if (q == 0) { if (col == 0) return nullptr; nr = row - 1; }
      else if (q == 1) { if (col == 63) return nullptr; nr = row + 1; }
      else if (q == 2) { if (gr == 0) return nullptr; nr = row - 64; }
      else { if (gr == 255) return nullptr; nr = row + 64; } }
    return p.H + (size_t)nr * 1024 + (kt - 16) * 64; }
  static __device__ __forceinline__ const bfr* bptr(const P& p, const Ctx& c, int n, int kt) { return p.W + (size_t)n * 2048 + kt * 64; }
  static __device__ __forceinline__ void epi(const P& p, const Ctx& c, f32x4 (&acc)[4][4], int m0, int n0, int lane) {
    bfr* RK = (bfr*)(p.ACT + A_RKVZ); bfr* WMb = (bfr*)(p.ACT + A_WM); bfr* AMb = (bfr*)(p.ACT + A_AM);
#pragma unroll
    for (int ni = 0; ni < 4; ni++)
#pragma unroll
      for (int mi = 0; mi < 4; mi++) {
        int row = m0 + mi * 16 + (lane & 15), n = n0 + ni * 16 + (lane >> 4) * 4;
        if (n < 4096) store4b(RK + (size_t)row * 4096 + n, acc[ni][mi]);
        else if (n < 4224) { f32x4 t;
#pragma unroll
          for (int q = 0; q < 4; q++) t[q] = tanhf(acc[ni][mi][q]); store4b(WMb + (size_t)row * 128 + (n - 4096), t); }
        else store4b(AMb + (size_t)row * 128 + (n - 4224), acc[ni][mi]);
      }
  } };
struct G_R7Out { static constexpr int KT = 16, NT = 8;
  static __device__ __forceinline__ const bfr* aptr(const P& p, const Ctx& c, int row, int kt, int nt) { return p.H + (size_t)row * 1024 + kt * 64; }
  static __device__ __forceinline__ const bfr* bptr(const P& p, const Ctx& c, int n, int kt) { return p.W + WR_OUT + (size_t)n * 1024 + kt * 64; }
  static __device__ __forceinline__ void epi(const P& p, const Ctx& c, f32x4 (&acc)[4][4], int m0, int n0, int lane) { epi_resid(p, c, acc, m0, n0, lane); } };


namespace pg8 {
#define PG8_LAS __attribute__((address_space(3)))
constexpr int BM = 256, BK = 64, HALF = 128, HTB = HALF * BK * 2, NXCD = 8, WGM = 8;
__device__ __forceinline__ int lds_byte(int r, int c) { const int st = (r >> 4) * 2 + (c >> 5), rr = r & 15, cc = c & 31, ob = rr * 64 + cc * 2; return st * 1024 + (ob ^ (((ob >> 9) & 1) << 5)); }
__device__ __forceinline__ void stage_rc(int b, int& R, int& C) { const int st = b / 1024, sb = b % 1024, swz = sb ^ (((sb >> 9) & 1) << 5); R = (st >> 1) * 16 + swz / 64; C = (st & 1) * 32 + (swz % 64) / 2; }
struct Unit { int pm, pn; };
struct Gemm { const bfr* A; const bfr* Bt; int M, N, K; };
struct StaticOrder {
  int nM, nN, nwg, G, c;
  __device__ void init(int M, int N, int G_, int c_) { nM = M / BM; nN = N / BM; nwg = nM * nN; G = G_; c = c_; }
  __device__ bool next(int i, Unit& u) const {
    const long L = (long)i * G + c; if (L >= nwg) return false;
    int wgid = (int)L; { const int q = nwg / NXCD, r = nwg % NXCD, xcd = wgid % NXCD, off = wgid / NXCD; wgid = (xcd < r ? xcd * (q + 1) : r * (q + 1) + (xcd - r) * q) + off; }
    const int nig = WGM * nN, gid = wgid / nig, fm = gid * WGM, gsz = (nM - fm) < WGM ? (nM - fm) : WGM;
    u.pm = fm + ((wgid % nig) % gsz); u.pn = (wgid % nig) / gsz; return true;
  }
};
template <class Epi>
__device__ __forceinline__ void gemm_phase(PG8_LAS unsigned char* lds, const Gemm g, const StaticOrder& S, const Epi& E) {
  const int tid = ltid(), wid = __builtin_amdgcn_readfirstlane(tid >> 6), lane = tid & 63, wr = wid >> 2, wc = wid & 3, fr = lane & 15, fq = lane >> 4;
  const int K = g.K, nt = K / BK;
  unsigned voffA[2], voffB[2];
#pragma unroll
  for (int i = 0; i < 2; ++i) { int R, C; stage_rc(tid * 16 + i * 8192, R, C); voffA[i] = (unsigned)(R * K + C) * 2u; voffB[i] = voffA[i]; }
  const size_t kstep = (size_t)(BK * 2);
  const size_t hstep = (size_t)HALF * K * 2;
  const size_t tstep = 2 * hstep;
  const unsigned ldsw = (unsigned)wid * 1024u;
  const int aoff = lds_byte(wr * 64 + fr, fq * 8), boff = lds_byte(wc * 32 + fr, fq * 8);
#define PG8_SA(b, h) (((b) * 2 + (h)) * HTB)
#define PG8_SB(b, h) ((4 + (b) * 2 + (h)) * HTB)
#define PG8_STAGE(bufoff, gbase, voff) do { _Pragma("unroll") for (int _i = 0; _i < 2; ++_i) \
    __builtin_amdgcn_global_load_lds((const unsigned*)((const char*)(gbase) + (voff)[_i]), (PG8_LAS unsigned*)(lds + (bufoff) + ldsw + _i * 8192), 16, 0, 0); } while (0)
#define PG8_LDA(dst, b, h) do { _Pragma("unroll") for (int m = 0; m < 4; ++m) _Pragma("unroll") for (int k = 0; k < 2; ++k) dst[m][k] = *(const PG8_LAS bf16x8*)(lds + PG8_SA(b, h) + aoff + m * 2048 + k * 1024); } while (0)
#define PG8_LDB(dst, b, h) do { _Pragma("unroll") for (int n = 0; n < 2; ++n) _Pragma("unroll") for (int k = 0; k < 2; ++k) dst[n][k] = *(const PG8_LAS bf16x8*)(lds + PG8_SB(b, h) + boff + n * 2048 + k * 1024); } while (0)
#define PG8_MMA(ai, bj, At, Bt) do { __builtin_amdgcn_s_setprio(1); _Pragma("unroll") for (int m = 0; m < 4; ++m) _Pragma("unroll") for (int n = 0; n < 2; ++n) _Pragma("unroll") for (int k = 0; k < 2; ++k) \
    acc[ai][bj][m][n] = __builtin_amdgcn_mfma_f32_16x16x32_bf16(Bt[n][k], At[m][k], acc[ai][bj][m][n], 0, 0, 0); __builtin_amdgcn_s_setprio(0); } while (0)
#define PG8_WAIT_V(n) asm volatile("s_waitcnt vmcnt(" #n ")" ::: "memory")
#define PG8_WAIT_L(n) asm volatile("s_waitcnt lgkmcnt(" #n ")" ::: "memory")
#define PG8_BAR __builtin_amdgcn_s_barrier()
#define PG8_SCHED __builtin_amdgcn_sched_barrier(0)
  Unit cur, nxt; int ui = 0;
  if (!S.next(0, cur)) return;
  f32x4 acc[2][2][4][2];
#pragma unroll
  for (int a = 0; a < 2; ++a)
#pragma unroll
    for (int b = 0; b < 2; ++b)
#pragma unroll
      for (int m = 0; m < 4; ++m)
#pragma unroll
        for (int n = 0; n < 2; ++n) acc[a][b][m][n] = (f32x4){0.f, 0.f, 0.f, 0.f};
  bf16x8 At[4][2], B0[2][2], B1[2][2];
  const char* cA = (const char*)g.A + (size_t)cur.pm * tstep; const char* cB = (const char*)g.Bt + (size_t)cur.pn * tstep;
  PG8_STAGE(PG8_SB(0, 0), cB, voffB); PG8_STAGE(PG8_SA(0, 0), cA, voffA); PG8_STAGE(PG8_SB(0, 1), cB + hstep, voffB); PG8_STAGE(PG8_SA(0, 1), cA + hstep, voffA);
  if (wr == 1) PG8_BAR;
  PG8_WAIT_V(4); PG8_BAR;
  PG8_STAGE(PG8_SB(1, 0), cB + kstep, voffB); PG8_STAGE(PG8_SA(1, 0), cA + kstep, voffA); PG8_STAGE(PG8_SB(1, 1), cB + hstep + kstep, voffB);
  PG8_WAIT_V(6); PG8_BAR;
  for (;;) {
    const bool has_next = S.next(ui + 1, nxt);
    const char* nA = has_next ? (const char*)g.A + (size_t)nxt.pm * tstep : cA; const char* nB = has_next ? (const char*)g.Bt + (size_t)nxt.pn * tstep : cB;
    for (int t = 0; t < nt; t += 2) {
      const bool last = (t == nt - 2);
      const char* a1 = cA + (size_t)(t + 1) * kstep;
      const char* a2 = last ? nA : cA + (size_t)(t + 2) * kstep; const char* b2 = last ? nB : cB + (size_t)(t + 2) * kstep;
      const char* a3 = a2 + kstep; const char* b3 = b2 + kstep;
      PG8_LDB(B0, 0, 0); PG8_SCHED; PG8_LDA(At, 0, 0); PG8_STAGE(PG8_SA(1, 1), a1 + hstep, voffA);
      PG8_WAIT_L(8); PG8_BAR; PG8_WAIT_L(0); PG8_MMA(0, 0, At, B0); PG8_BAR; PG8_SCHED;
      PG8_LDB(B1, 0, 1); PG8_STAGE(PG8_SB(0, 0), b2, voffB);
      PG8_BAR; PG8_WAIT_L(0); PG8_MMA(0, 1, At, B1); PG8_BAR;
      PG8_LDA(At, 0, 1); PG8_STAGE(PG8_SA(0, 0), a2, voffA);
      PG8_BAR; PG8_WAIT_L(0); PG8_MMA(1, 0, At, B0); PG8_BAR; PG8_SCHED;
      PG8_STAGE(PG8_SB(0, 1), b2 + hstep, voffB);
      PG8_WAIT_V(6); PG8_BAR; PG8_MMA(1, 1, At, B1); PG8_BAR;
      PG8_LDB(B0, 1, 0); PG8_SCHED; PG8_LDA(At, 1, 0); PG8_STAGE(PG8_SA(0, 1), a2 + hstep, voffA);
      PG8_WAIT_L(8); PG8_BAR; PG8_WAIT_L(0); PG8_MMA(0, 0, At, B0); PG8_BAR; PG8_SCHED;
      PG8_LDB(B1, 1, 1); PG8_STAGE(PG8_SB(1, 0), b3, voffB);
      PG8_BAR; PG8_WAIT_L(0); PG8_MMA(0, 1, At, B1); PG8_BAR;
      PG8_LDA(At, 1, 1); PG8_STAGE(PG8_SA(1, 0), a3, voffA);
      PG8_BAR; PG8_WAIT_L(0); PG8_MMA(1, 0, At, B0); PG8_BAR; PG8_SCHED;
      PG8_STAGE(PG8_SB(1, 1), b3 + hstep, voffB);
      PG8_WAIT_V(6); PG8_BAR; PG8_MMA(1, 1, At, B1); PG8_BAR;
    }
    E(acc, cur, wr, wc, fr, fq);
    if (!has_next) break;
#pragma unroll
    for (int a = 0; a < 2; ++a)
#pragma unroll
      for (int b = 0; b < 2; ++b)
#pragma unroll
        for (int m = 0; m < 4; ++m)
#pragma unroll
          for (int n = 0; n < 2; ++n) acc[a][b][m][n] = (f32x4){0.f, 0.f, 0.f, 0.f};
    cur = nxt; cA = nA; cB = nB; ++ui;
  }
  PG8_WAIT_V(0);
  if (wr == 0) PG8_BAR;
  PG8_BAR;
#undef PG8_SA
#undef PG8_SB
#undef PG8_STAGE
#undef PG8_LDA
#undef PG8_LDB
#undef PG8_MMA
#undef PG8_WAIT_V
#undef PG8_WAIT_L
#undef PG8_BAR
#undef PG8_SCHED
}
}

template <class F> struct EpiAd {
  F f;
  __device__ __forceinline__ void operator()(const f32x4 (&acc)[2][2][4][2], const pg8::Unit& u, int wr, int wc, int fr, int fq) const {
#pragma unroll
    for (int ai = 0; ai < 2; ++ai)
#pragma unroll
      for (int m = 0; m < 4; ++m) { const int row = u.pm * 256 + ai * 128 + wr * 64 + m * 16 + fr;
#pragma unroll
        for (int bj = 0; bj < 2; ++bj)
#pragma unroll
          for (int n = 0; n < 2; ++n) f(row, u.pn * 256 + bj * 128 + wc * 32 + n * 16 + 4 * fq, acc[ai][bj][m][n]); }
  }
};
template <class F> __device__ __forceinline__ void big_gemm(char* smem, const bfr* A, const bfr* Bt, int N, int K, F f) {
  pg8::Gemm g; g.A = A; g.Bt = Bt; g.M = R_; g.N = N; g.K = K;
  pg8::StaticOrder S; S.init(R_, N, (int)gridDim.x, (int)blockIdx.x);
  EpiAd<F> E{f};
  pg8::gemm_phase(( __attribute__((address_space(3))) unsigned char*)smem, g, S, E);
}
struct F_LruIn { char* ACT; __device__ __forceinline__ void operator()(int row, int n, f32x4 v) const {
  bfr* dst = n < 1280 ? (bfr*)(ACT + A_U) + (size_t)row * 1280 + n : (bfr*)(ACT + A_Z) + (size_t)row * 1280 + (n - 1280); store4b(dst, v); } };
struct F_Resid { float* Xx; float* Xc; const float* MODg; int wc; __device__ __forceinline__ void operator()(int row, int n, f32x4 v) const {
  int b = row / BT_, o = row - b * BT_; bool isc = o < 256; if (isc && !wc) return;
  float* xr = isc ? Xc + (size_t)(b * 256 + o) * 1024 : Xx + (size_t)(b * 16384 + o - 256) * 1024; const float* g = MODg + (size_t)(isc ? 2 : b) * 3072 + 2048;
  float4 xv = *(float4*)(xr + n); float4 gg = *(const float4*)(g + n);
  xv.x += gg.x * v[0]; xv.y += gg.y * v[1]; xv.z += gg.z * v[2]; xv.w += gg.w * v[3]; *(float4*)(xr + n) = xv; } };
struct F_MlIn { char* ACT; __device__ __forceinline__ void operator()(int row, int n, f32x4 v) const {
  if (n < 4096) store4b((bfr*)(ACT + A_QKV) + (size_t)row * 4096 + n, v);
  else if (n < 4128) *(float4*)((float*)(ACT + A_GATE) + (size_t)row * 32 + (n - 4096)) = float4{v[0], v[1], v[2], v[3]}; } };
struct F_MlZ { char* ACT; const float* ng; __device__ __forceinline__ void operator()(int row, int n, f32x4 v) const {
  bfr* hp = (bfr*)(ACT + A_HS) + (size_t)row * 2048 + n; uint2 u = *(const uint2*)hp; float rs = ((const float*)(ACT + A_RSTD))[(size_t)row * 8 + (n >> 8)];
  float4 g4 = *(const float4*)(ng + n); f32x4 o;
  o[0] = blo(u.x) * rs * g4.x * siluf(v[0]); o[1] = bhi(u.x) * rs * g4.y * siluf(v[1]); o[2] = blo(u.y) * rs * g4.z * siluf(v[2]); o[3] = bhi(u.y) * rs * g4.w * siluf(v[3]);
  store4b(hp, o); } };
struct F_R7In { char* ACT; __device__ __forceinline__ void operator()(int row, int n, f32x4 v) const {
  if (n < 4096) store4b((bfr*)(ACT + A_RKVZ) + (size_t)row * 4096 + n, v);
  else if (n < 4224) { f32x4 t;
#pragma unroll
    for (int q = 0; q < 4; q++) t[q] = tanhf(v[q]);
    store4b((bfr*)(ACT + A_WM) + (size_t)row * 128 + (n - 4096), t); }
  else store4b((bfr*)(ACT + A_AM) + (size_t)row * 128 + (n - 4224), v); } };

template <class G> __device__ __forceinline__ void gemm_phase(const P& p, const Ctx& c, char* smem) {
  const int total = 130 * G::NT;
  for (int it = blockIdx.x; it < total; it += gridDim.x) gemm_tile<G>(p, c, it / G::NT, it % G::NT, smem);
}

#define R7_Y2 ((bfr*)p.H + (size_t)64 * 26 * 16384)
__device__ __forceinline__ void ph_pre(const P& p, char* smem) {
  float* sm = (float*)smem; const int tid = ltid();
  const int nprep = prep_count(0), ngemv = 192, ncopy = 4160;
  if (blockIdx.x == 0) for (int i = tid; i < 5120; i += 512) p.CL[i] = 8.f * softplusf(-p.lru_lam[i]);
  for (int it = blockIdx.x; it < nprep + ngemv + ncopy; it += gridDim.x) {
    if (it < nprep) { prep_item(p, 0, it, sm); continue; }
    int i2 = it - nprep;
    if (i2 < ngemv) {
      int l = i2 / 48, cgp = i2 % 48;
      for (int i = tid; i < 3072; i += 512) { int cnd = i >> 10, k = i & 1023; float v = cnd == 0 ? p.c[k] : cnd == 1 ? p.c[1024 + k] : p.c_ctx[k]; sm[i] = siluf(v); }
      __syncthreads();
      int kq = tid >> 6, col = cgp * 64 + (tid & 63); const float* w = p.mod_w + (size_t)l * 1024 * 3072 + col;
      float a0 = 0.f, a1 = 0.f, a2 = 0.f;
      for (int k = kq * 128; k < kq * 128 + 128; k++) { float wv = w[(size_t)k * 3072]; a0 += sm[k] * wv; a1 += sm[1024 + k] * wv; a2 += sm[2048 + k] * wv; }
      float* red = sm + 3072; red[tid * 3] = a0; red[tid * 3 + 1] = a1; red[tid * 3 + 2] = a2;
      __syncthreads();
      if (tid < 64) { float bias = p.mod_b[(size_t)l * 3072 + col];
        for (int cnd = 0; cnd < 3; cnd++) { float s = bias; for (int q = 0; q < 8; q++) s += red[(q * 64 + tid) * 3 + cnd]; p.MOD[(size_t)(l * 3 + cnd) * 3072 + col] = s; } }
      __syncthreads();
      continue;
    }
    i2 -= ngemv;
    for (int q = 0; q < 4; q++) { int idx = i2 * 2048 + q * 512 + tid; int row = idx >> 8, c4 = idx & 255; int b = row / BT_, o = row - b * BT_;
      if (o < 256) ((float4*)p.Xc)[(size_t)(b * 256 + o) * 256 + c4] = ((const float4*)p.ctx)[(size_t)(b * 256 + o) * 256 + c4];
      else ((float4*)p.Xx)[(size_t)(b * 16384 + o - 256) * 256 + c4] = ((const float4*)p.x)[(size_t)(b * 16384 + o - 256) * 256 + c4]; }
  }
}
__device__ __forceinline__ void ph_norm(const P& p, int layer, char* smem) {
  const int tid = ltid(), lane = tid & 63, wid = tid >> 6;
  const int nprep = layer > 0 ? prep_count(layer) : 0; const int kind = layer % 3;
  const int nzero = kind == 1 ? 8320 : 0;
  (void)nzero;
  for (int it = blockIdx.x; it < nprep + 4160; it += gridDim.x) {
    if (it < nprep) { prep_item(p, layer, it, (float*)smem); continue; }
    int row = (it - nprep) * 8 + wid; int mo; const float* xr = xrowp(p, row, mo);
    float4 v[4]; float ss = 0.f;
#pragma unroll
    for (int i = 0; i < 4; i++) { v[i] = *(const float4*)(xr + lane * 4 + 256 * i); ss += v[i].x * v[i].x + v[i].y * v[i].y + v[i].z * v[i].z + v[i].w * v[i].w; }
    ss = wsum(ss); float rs = rsqrtf(ss * (1.f / 1024.f) + 1e-6f);
    const float* g = p.norm_g + (size_t)layer * 1024; const float* md = p.MOD + (size_t)(layer * 3 + mo) * 3072;
#pragma unroll
    for (int i = 0; i < 4; i++) { int cidx = lane * 4 + 256 * i; float4 gg = *(const float4*)(g + cidx), sh = *(const float4*)(md + cidx), sc = *(const float4*)(md + 1024 + cidx);
      f32x4 o; o[0] = v[i].x * rs * gg.x * (1.f + sc.x) + sh.x; o[1] = v[i].y * rs * gg.y * (1.f + sc.y) + sh.y; o[2] = v[i].z * rs * gg.z * (1.f + sc.z) + sh.z; o[3] = v[i].w * rs * gg.w * (1.f + sc.w) + sh.w;
      store4b(p.H + (size_t)row * (kind == 2 ? 2048 : 1024) + cidx, o); }
  }
}
__device__ __forceinline__ void ph_r7_shift(const P& p) {
  for (int it = blockIdx.x; it < 8320; it += gridDim.x) {
    int idx = it * 512 + ltid(); int row = idx >> 7, c8 = idx & 127, q = c8 >> 5;
    int b = row / BT_, o = row - b * BT_; int nr = -1;
    if (o < 256) { if (q < 2) { if (o >= 1) nr = row - 1; } else { if (o < 255) nr = row + 1; } }
    else { int t = o - 256, col = t & 63, gr = t >> 6;
      if (q == 0) { if (col != 0) nr = row - 1; } else if (q == 1) { if (col != 63) nr = row + 1; }
      else if (q == 2) { if (gr != 0) nr = row - 64; } else { if (gr != 255) nr = row + 64; } }
    uint4 v = nr >= 0 ? *(const uint4*)(p.H + (size_t)nr * 2048 + c8 * 8) : uint4{0u, 0u, 0u, 0u};
    *(uint4*)(p.H + (size_t)row * 2048 + 1024 + c8 * 8) = v;
  }
}
__device__ __forceinline__ void ph_final(const P& p) {
  const int lane = ltid() & 63, wid = ltid() >> 6;
  for (int it = blockIdx.x; it < 4096; it += gridDim.x) {
    float* xr = p.Xx + (size_t)(it * 8 + wid) * 1024; float4 v[4]; float ss = 0.f;
#pragma unroll
    for (int i = 0; i < 4; i++) { v[i] = *(const float4*)(xr + lane * 4 + 256 * i); ss += v[i].x * v[i].x + v[i].y * v[i].y + v[i].z * v[i].z + v[i].w * v[i].w; }
    ss = wsum(ss); float rs = rsqrtf(ss * (1.f / 1024.f) + 1e-6f);
#pragma unroll
    for (int i = 0; i < 4; i++) { int cidx = lane * 4 + 256 * i; float4 gg = *(const float4*)(p.final_g + cidx);
      *(float4*)(xr + cidx) = float4{v[i].x * rs * gg.x, v[i].y * rs * gg.y, v[i].z * rs * gg.z, v[i].w * rs * gg.w}; }
  }
}
__device__ __forceinline__ void ph_lru_conv(const P& p, int j) {
  const bfr* U = (const bfr*)(p.ACT + A_U); bfr* UC = (bfr*)(p.ACT + A_UC);
  const float* cw = p.lru_conv_w + (size_t)j * 4 * 1280; const float* cb = p.lru_conv_b + (size_t)j * 1280;
  for (int it = blockIdx.x; it < 10400; it += gridDim.x) {
    int idx = it * 512 + ltid(); int row = idx / 160, cgp = idx % 160, ch = cgp * 8;
    int b = row / BT_, o = row - b * BT_; int s0 = o < 256 ? 0 : 256, e0 = o < 256 ? 256 : BT_;
    float acc[8];
#pragma unroll
    for (int e = 0; e < 8; e++) acc[e] = cb[ch + e];
#pragma unroll
    for (int t = 0; t < 4; t++) { int oo = o + t - 2; if (oo < s0 || oo >= e0) continue;
      uint4 u = *(const uint4*)(U + (size_t)(row + t - 2) * 1280 + ch); const float* w = cw + t * 1280 + ch;
      acc[0] += w[0] * blo(u.x); acc[1] += w[1] * bhi(u.x); acc[2] += w[2] * blo(u.y); acc[3] += w[3] * bhi(u.y);
      acc[4] += w[4] * blo(u.z); acc[5] += w[5] * bhi(u.z); acc[6] += w[6] * blo(u.w); acc[7] += w[7] * bhi(u.w); }
    *(uint4*)(UC + (size_t)row * 1280 + ch) = uint4{pk2(acc[0], acc[1]), pk2(acc[2], acc[3]), pk2(acc[4], acc[5]), pk2(acc[6], acc[7])};
  }
}
__device__ __forceinline__ void ph_lru_s1(const P& p, int d) {
  const unsigned* AB = (const unsigned*)(p.ACT + A_AB); float2* AGG = (float2*)(p.ACT + A_AGG);
  const int t = ltid();
  for (int it = blockIdx.x * 8 + (t >> 6); it < 2600; it += gridDim.x * 8) {
    int b = it / 1300, r = it % 1300, cc = r / 5, ch = (r % 5) * 256 + (t & 63) * 4;
    float P0 = 1.f, Q0 = 0.f, P1 = 1.f, Q1 = 0.f, P2 = 1.f, Q2 = 0.f, P3 = 1.f, Q3 = 0.f;
#pragma unroll 8
    for (int q = 0; q < 64; q++) { uint4 u = *(const uint4*)(AB + (size_t)rowmap(d, b, cc * 64 + q) * 1280 + ch);
      float a0 = 1.f - bhi(u.x), a1 = 1.f - bhi(u.y), a2 = 1.f - bhi(u.z), a3 = 1.f - bhi(u.w);
      P0 *= a0; Q0 = a0 * Q0 + blo(u.x); P1 *= a1; Q1 = a1 * Q1 + blo(u.y); P2 *= a2; Q2 = a2 * Q2 + blo(u.z); P3 *= a3; Q3 = a3 * Q3 + blo(u.w); }
    float4* ag = (float4*)(AGG + (size_t)(b * NCH_ + cc) * 1280 + ch); ag[0] = float4{P0, Q0, P1, Q1}; ag[1] = float4{P2, Q2, P3, Q3};
  }
}
__device__ __forceinline__ void ph_lru_s2(const P& p) {
  const float2* AGG = (const float2*)(p.ACT + A_AGG); float* CAR = (float*)(p.ACT + A_CAR);
  for (int it = blockIdx.x; it < 5; it += gridDim.x) {
    int idx = it * 512 + ltid(), b = idx / 1280, ch = idx % 1280; float h = 0.f;
#pragma unroll 20
    for (int cc = 0; cc < NCH_; cc++) { size_t o = (size_t)(b * NCH_ + cc) * 1280 + ch; float2 a = AGG[o]; CAR[o] = h; h = a.x * h + a.y; }
  }
}
__device__ __forceinline__ void ph_lru_s3(const P& p, int d) {
  const unsigned* AB = (const unsigned*)(p.ACT + A_AB); const float* CAR = (const float*)(p.ACT + A_CAR);
  bfr* HF = (bfr*)(p.ACT + A_HF); bfr* Z = (bfr*)(p.ACT + A_Z);
  const int t = ltid();
  for (int it = blockIdx.x * 8 + (t >> 6); it < 2600; it += gridDim.x * 8) {
    int b = it / 1300, r = it % 1300, cc = r / 5, ch = (r % 5) * 256 + (t & 63) * 4;
    float4 h = *(const float4*)(CAR + (size_t)(b * NCH_ + cc) * 1280 + ch);
#pragma unroll 8
    for (int q = 0; q < 64; q++) { size_t o = (size_t)rowmap(d, b, cc * 64 + q) * 1280 + ch; uint4 u = *(const uint4*)(AB + o);
      h.x = (1.f - bhi(u.x)) * h.x + blo(u.x); h.y = (1.f - bhi(u.y)) * h.y + blo(u.y); h.z = (1.f - bhi(u.z)) * h.z + blo(u.z); h.w = (1.f - bhi(u.w)) * h.w + blo(u.w);
      if (d == 0) *(uint2*)(HF + o) = uint2{pk2(h.x, h.y), pk2(h.z, h.w)};
      else { uint2 hf = *(const uint2*)(HF + o), zz = *(const uint2*)(Z + o);
        *(uint2*)(Z + o) = uint2{pk2((blo(hf.x) + h.x) * siluf(blo(zz.x)), (bhi(hf.x) + h.y) * siluf(bhi(zz.x))), pk2((blo(hf.y) + h.z) * siluf(blo(zz.y)), (bhi(hf.y) + h.w) * siluf(bhi(zz.y)))}; } }
  }
}
__device__ __forceinline__ void ph_ml_stat(const P& p) {
  const bfr* HS = (const bfr*)(p.ACT + A_HS); float* RS = (float*)(p.ACT + A_RSTD);
  const int lane = ltid() & 63, wid = ltid() >> 6;
  for (int it = blockIdx.x; it < 4160; it += gridDim.x) {
    int row = it * 8 + wid; const bfr* hp = HS + (size_t)row * 2048 + lane * 32; float ss = 0.f;
#pragma unroll
    for (int i = 0; i < 4; i++) { uint4 u = *(const uint4*)(hp + i * 8); float a;
      a = blo(u.x); ss += a * a; a = bhi(u.x); ss += a * a; a = blo(u.y); ss += a * a; a = bhi(u.y); ss += a * a;
      a = blo(u.z); ss += a * a; a = bhi(u.z); ss += a * a; a = blo(u.w); ss += a * a; a = bhi(u.w); ss += a * a; }
    ss += __shfl_xor(ss, 1); ss += __shfl_xor(ss, 2); ss += __shfl_xor(ss, 4);
    if ((lane & 7) == 0) RS[(size_t)row * 8 + (lane >> 3)] = rsqrtf(ss * (1.f / 256.f) + 1e-6f);
  }
}
__device__ __forceinline__ void ph_r7_fin(const P& p, int j) {
  bfr* Y = (bfr*)(p.ACT + A_Y); const bfr* RK = (const bfr*)(p.ACT + A_RKVZ); const float* BON = (const float*)(p.ACT + A_BON);
  const float* lg = p.r7_ln_g + (size_t)j * 1024; const float* lb = p.r7_ln_b + (size_t)j * 1024;
  const int lane = ltid() & 63, wid = ltid() >> 6;
  for (int it = blockIdx.x; it < 4160; it += gridDim.x) {
    int row = it * 8 + wid, ch = lane * 16, hd = lane >> 2;
    float y[16], v[16], z[16];
#pragma unroll
    for (int i = 0; i < 2; i++) {
      uint4 u = *(const uint4*)(Y + (size_t)row * 1024 + ch + i * 8); const uint4 u2 = *(const uint4*)(R7_Y2 + (size_t)row * 1024 + ch + i * 8);
      y[i * 8 + 0] = blo(u.x) + blo(u2.x); y[i * 8 + 1] = bhi(u.x) + bhi(u2.x); y[i * 8 + 2] = blo(u.y) + blo(u2.y); y[i * 8 + 3] = bhi(u.y) + bhi(u2.y); y[i * 8 + 4] = blo(u.z) + blo(u2.z); y[i * 8 + 5] = bhi(u.z) + bhi(u2.z); y[i * 8 + 6] = blo(u.w) + blo(u2.w); y[i * 8 + 7] = bhi(u.w) + bhi(u2.w);
      u = *(const uint4*)(RK + (size_t)row * 4096 + 2048 + ch + i * 8);
      v[i * 8 + 0] = blo(u.x); v[i * 8 + 1] = bhi(u.x); v[i * 8 + 2] = blo(u.y); v[i * 8 + 3] = bhi(u.y); v[i * 8 + 4] = blo(u.z); v[i * 8 + 5] = bhi(u.z); v[i * 8 + 6] = blo(u.w); v[i * 8 + 7] = bhi(u.w);
      u = *(const uint4*)(RK + (size_t)row * 4096 + 3072 + ch + i * 8);
      z[i * 8 + 0] = blo(u.x); z[i * 8 + 1] = bhi(u.x); z[i * 8 + 2] = blo(u.y); z[i * 8 + 3] = bhi(u.y); z[i * 8 + 4] = blo(u.z); z[i * 8 + 5] = bhi(u.z); z[i * 8 + 6] = blo(u.w); z[i * 8 + 7] = bhi(u.w);
    }
    float s = 0.f;
#pragma unroll
    for (int e = 0; e < 16; e++) s += y[e];
    s += __shfl_xor(s, 1); s += __shfl_xor(s, 2); float mean = s * (1.f / 64.f);
    float q = 0.f;
#pragma unroll
    for (int e = 0; e < 16; e++) { float dlt = y[e] - mean; q += dlt * dlt; }
    q += __shfl_xor(q, 1); q += __shfl_xor(q, 2); float rs = rsqrtf(q * (1.f / 64.f) + 64e-5f);
    float bon = BON[(size_t)row * 16 + hd] + BON[(size_t)(R_ + row) * 16 + hd];
    float o[16];
#pragma unroll
    for (int e = 0; e < 16; e++) { float yn = (y[e] - mean) * rs * lg[ch + e] + lb[ch + e]; o[e] = (yn + bon * v[e]) * siluf(z[e]); }
#pragma unroll
    for (int i = 0; i < 2; i++)
      *(uint4*)(Y + (size_t)row * 1024 + ch + i * 8) = uint4{pk2(o[i * 8], o[i * 8 + 1]), pk2(o[i * 8 + 2], o[i * 8 + 3]), pk2(o[i * 8 + 4], o[i * 8 + 5]), pk2(o[i * 8 + 6], o[i * 8 + 7])};
  }
}

#define QS 136
#define VS 72
#define MLG_BYTES 45056
__device__ __forceinline__ void ph_ml_scan(const P& p, int j, char* smem0) {
  const int d = ltid() >> 8;
  char* smem = smem0 + d * MLG_BYTES;
  bfr* sQ = (bfr*)smem; bfr* sK = sQ + 64 * QS; bfr* sVT = sK + 64 * QS; bfr* sCT = sVT + 16 * VS;
  float* sN = (float*)(sCT + 16 * QS);
  float* sEs = sN + 128; float* sCt = sEs + 64; float* sBc = sCt + 64; float* sWg = sBc + 64; float* sNr = sWg + 64;
  const bfr* QKV = (const bfr*)(p.ACT + A_QKV); const float* GT = (const float*)(p.ACT + A_GATE); bfr* HS = (bfr*)(p.ACT + A_HS);
  const float* gbias = p.ml_gate_b + (size_t)j * 32;
  const int tid = ltid() & 255, lane = tid & 63, w = tid >> 6, l15 = lane & 15, q4 = lane >> 4;
  for (int it = blockIdx.x; it < 256; it += gridDim.x) {
    const int b = it >> 7, hh = (it >> 4) & 7, sl = it & 15;
    f32x4 Cacc[2];
    Cacc[0] = f32x4{0.f, 0.f, 0.f, 0.f}; Cacc[1] = f32x4{0.f, 0.f, 0.f, 0.f};
    float mcur = 0.f;
    for (int i = tid; i < 16 * QS; i += 256) sCT[i] = 0;
    if (tid < 128) sN[tid] = 0.f;
    uint4 pq0, pq1, pq2, pq3, pk0, pk1, pk2, pk3, pv = uint4{0u, 0u, 0u, 0u}; float pgi, pgf;
#define ML_ROW0(s_) (d == 0 ? b * BT_ + 64 * (s_) : rowmap(1, b, 64 * (s_) + 63))
#define ML_LD(i_, PQ, PK) { int idx = tid + 256 * (i_), rho = idx >> 4, c8 = idx & 15; const bfr* src = QKV + (size_t)(r0n + rho) * 4096 + hh * 128 + c8 * 8; PQ = *(const uint4*)src; PK = *(const uint4*)(src + 1024); }
#define ML_ISSUE(s_) { const int r0n = ML_ROW0(s_); ML_LD(0, pq0, pk0) ML_LD(1, pq1, pk1) ML_LD(2, pq2, pk2) ML_LD(3, pq3, pk3) \
      if (tid < 128) pv = *(const uint4*)(QKV + (size_t)(r0n + (tid >> 1)) * 4096 + 2048 + hh * 256 + sl * 16 + (tid & 1) * 8); \
      { const float* gp_ = GT + (size_t)(r0n + (d ? 63 - lane : lane)) * 32 + d * 16 + hh; pgi = gp_[0]; pgf = gp_[8]; } }
#define ML_ST(i_, PQ, PK) { int idx = tid + 256 * (i_), rho = idx >> 4, c8 = idx & 15; *(uint4*)(sQ + rho * QS + c8 * 8) = PQ; *(uint4*)(sK + rho * QS + c8 * 8) = PK; }
#define ML_COMMIT() { ML_ST(0, pq0, pk0) ML_ST(1, pq1, pk1) ML_ST(2, pq2, pk2) ML_ST(3, pq3, pk3) \
      if (tid < 128) { int rho = tid >> 1, vb = (tid & 1) * 8; \
        sVT[(vb + 0) * VS + rho] = (bfr)(pv.x & 0xffff); sVT[(vb + 1) * VS + rho] = (bfr)(pv.x >> 16); \
        sVT[(vb + 2) * VS + rho] = (bfr)(pv.y & 0xffff); sVT[(vb + 3) * VS + rho] = (bfr)(pv.y >> 16); \
        sVT[(vb + 4) * VS + rho] = (bfr)(pv.z & 0xffff); sVT[(vb + 5) * VS + rho] = (bfr)(pv.z >> 16); \
        sVT[(vb + 6) * VS + rho] = (bfr)(pv.w & 0xffff); sVT[(vb + 7) * VS + rho] = (bfr)(pv.w >> 16); } }
    ML_ISSUE(0)
    __syncthreads();
    for (int s = 0; s < NCH_; s++) {
      const int r0 = ML_ROW0(s);
      ML_COMMIT()
      float mxl, decay;
      {
        int rho = d ? 63 - lane : lane;
        float gi = pgi + gbias[(d * 2 + 0) * 8 + hh], gf = pgf + gbias[(d * 2 + 1) * 8 + hh];
        float fc = fminf(gf, 0.f) - __logf(1.f + __expf(-fabsf(gf)));
        float bc = fc;
        for (int o = 1; o < 64; o <<= 1) { float t = __shfl_up(bc, o); if (lane >= o) bc += t; }
        float e = gi - bc, pm = e;
        for (int o = 1; o < 64; o <<= 1) { float t = __shfl_up(pm, o); if (lane >= o) pm = fmaxf(pm, t); }
        float pml = __shfl(pm, 63), bcl = __shfl(bc, 63);
        mxl = fmaxf(mcur, pml); decay = __expf(mcur - mxl);
        if (w == 0) { sEs[rho] = __expf(fminf(e, 80.f)); sCt[rho] = -fmaxf(mcur, pm); sBc[rho] = bc; sWg[rho] = __expf(e - mxl); }
        pml = bcl + mxl;
        bcl = mcur; mcur = pml; pml = bcl;
        mxl = pml;
      }
      const float mold = mxl;
      __syncthreads();
      const int rt = 16 * w + l15;
      bfr* hp = HS + (size_t)(r0 + rt) * 2048 + hh * 256 + sl * 16 + 4 * q4;
      bool first; { int rc = (r0 - b * BT_) >> 6; if (d == 0) { int sp = rc < 4 ? 3 - rc : 263 - rc; first = s < sp; } else first = s < rc; }
      unsigned long long uu = 0ull;
      if (!first) uu = __hip_atomic_load((unsigned long long*)hp, __ATOMIC_RELAXED, __HIP_MEMORY_SCOPE_AGENT);
      if (s + 1 < NCH_) ML_ISSUE(s + 1)
      bf16x8 qf[4];
#pragma unroll
      for (int ks = 0; ks < 4; ks++) qf[ks] = *(const bf16x8*)(sQ + (16 * w + l15) * QS + ks * 32 + q4 * 8);
      f32x4 sacc[4];
#pragma unroll
      for (int a = 0; a < 4; a++) { sacc[a] = f32x4{0.f, 0.f, 0.f, 0.f};
#pragma unroll
        for (int ks = 0; ks < 4; ks++) { bf16x8 kf = *(const bf16x8*)(sK + (16 * a + l15) * QS + ks * 32 + q4 * 8); sacc[a] = __builtin_amdgcn_mfma_f32_16x16x32_bf16(kf, qf[ks], sacc[a], 0, 0, 0); } }
      const float ctt = sCt[rt]; const float ect = __expf(ctt); float densum = 0.f;
#pragma unroll
      for (int a = 0; a < 4; a++) { const float4 ex4 = *(const float4*)(sEs + 16 * a + 4 * q4); const float exv[4] = {ex4.x, ex4.y, ex4.z, ex4.w};
#pragma unroll
        for (int jj = 0; jj < 4; jj++) { int rs_ = 16 * a + 4 * q4 + jj; bool valid = d == 0 ? rs_ <= rt : rs_ >= rt;
          float wv = valid ? ect * exv[jj] : 0.f; float sv = sacc[a][jj] * wv; sacc[a][jj] = sv; densum += sv; } }
      densum += __shfl_xor(densum, 16); densum += __shfl_xor(densum, 32);
      bf16x8 sf[2], vf[2];
#pragma unroll
      for (int ks = 0; ks < 2; ks++) {
#pragma unroll
        for (int jj = 0; jj < 4; jj++) { sf[ks][jj] = (short)f2b(sacc[2 * ks][jj]); sf[ks][4 + jj] = (short)f2b(sacc[2 * ks + 1][jj]); }
        uint2 v0 = *(const uint2*)(sVT + l15 * VS + 32 * ks + 4 * q4), v1 = *(const uint2*)(sVT + l15 * VS + 32 * ks + 16 + 4 * q4);
        uint4 vv = uint4{v0.x, v0.y, v1.x, v1.y}; vf[ks] = *(bf16x8*)&vv;
      }
      f32x4 num = f32x4{0.f, 0.f, 0.f, 0.f}, numC = f32x4{0.f, 0.f, 0.f, 0.f};
#pragma unroll
      for (int ks = 0; ks < 2; ks++) num = __builtin_amdgcn_mfma_f32_16x16x32_bf16(vf[ks], sf[ks], num, 0, 0, 0);
#pragma unroll
      for (int ks = 0; ks < 4; ks++) { bf16x8 cf = *(const bf16x8*)(sCT + l15 * QS + ks * 32 + q4 * 8); numC = __builtin_amdgcn_mfma_f32_16x16x32_bf16(cf, qf[ks], numC, 0, 0, 0); }
      float qn = 0.f;
#pragma unroll
      for (int i = 0; i < 4; i++) { uint4 u = *(const uint4*)(sQ + rt * QS + 32 * q4 + i * 8); const float* nn = sN + 32 * q4 + i * 8;
        qn += blo(u.x) * nn[0] + bhi(u.x) * nn[1] + blo(u.y) * nn[2] + bhi(u.y) * nn[3] + blo(u.z) * nn[4] + bhi(u.z) * nn[5] + blo(u.w) * nn[6] + bhi(u.w) * nn[7]; }
      qn += __shfl_xor(qn, 16); qn += __shfl_xor(qn, 32);
      {
        float inter = __expf(mold + ctt); float den = densum + inter * qn; float dn = fmaxf(fabsf(den), __expf(ctt - sBc[rt])); float inv = __builtin_amdgcn_rcpf(dn);
        f32x4 hv;
#pragma unroll
        for (int jj = 0; jj < 4; jj++) hv[jj] = (num[jj] + inter * numC[jj]) * inv;
        if (!first) { unsigned ux = (unsigned)uu, uy = (unsigned)(uu >> 32);
          hv[0] += blo(ux); hv[1] += bhi(ux); hv[2] += blo(uy); hv[3] += bhi(uy); }
        store4b(hp, hv);
      }
      __syncthreads();
      {
        bf16x8 vw[2], wa[2];
#pragma unroll
        for (int ks = 0; ks < 2; ks++)
#pragma unroll
          for (int e = 0; e < 8; e++) { int rs_ = 32 * ks + (e < 4 ? 4 * q4 + e : 16 + 4 * q4 + e - 4); const float wg_ = sWg[rs_]; vw[ks][e] = (short)f2b(b2f((bfr)vf[ks][e]) * wg_); wa[ks][e] = l15 == 0 ? (short)f2b(wg_) : (short)0; }
#pragma unroll
        for (int a = 0; a < 2; a++) {
          int dk = 32 * w + 16 * a + l15;
#pragma unroll
          for (int jj = 0; jj < 4; jj++) Cacc[a][jj] *= decay;
          f32x4 nacc = f32x4{0.f, 0.f, 0.f, 0.f};
#pragma unroll
          for (int ks = 0; ks < 2; ks++) { bf16x8 kt;
#pragma unroll
            for (int e = 0; e < 8; e++) { int rs_ = 32 * ks + (e < 4 ? 4 * q4 + e : 16 + 4 * q4 + e - 4); kt[e] = (short)sK[rs_ * QS + dk]; }
            Cacc[a] = __builtin_amdgcn_mfma_f32_16x16x32_bf16(vw[ks], kt, Cacc[a], 0, 0, 0);
            nacc = __builtin_amdgcn_mfma_f32_16x16x32_bf16(wa[ks], kt, nacc, 0, 0, 0); }
          if (q4 == 0) sNr[dk] = nacc[0];
#pragma unroll
          for (int jj = 0; jj < 4; jj++) sCT[(4 * q4 + jj) * QS + dk] = f2b(Cacc[a][jj]);
        }
      }
      __syncthreads();
      if (tid < 128) sN[tid] = decay * sN[tid] + sNr[tid];
    }
    __syncthreads();
  }
}

#define CS 72
#define CSLOT(i_) ((bfr*)smem + (i_) * (64 * CS))
#define A_SST (A_R7B + 362086400ull)
__device__ __forceinline__ f32x4 cmm(const bfr* X, const bfr* YT, int ti, int tj, int l15, int q4) {
  f32x4 acc = f32x4{0.f, 0.f, 0.f, 0.f};
#pragma unroll
  for (int ks = 0; ks < 2; ks++) { bf16x8 a = *(const bf16x8*)(X + (16 * ti + l15) * CS + 32 * ks + 8 * q4); bf16x8 b = *(const bf16x8*)(YT + (16 * tj + l15) * CS + 32 * ks + 8 * q4);
    acc = __builtin_amdgcn_mfma_f32_16x16x32_bf16(a, b, acc, 0, 0, 0); }
  return acc;
}
template <int MODE> __device__ __forceinline__ f32x4 cmm_mask(const bfr* X, const bfr* YT, int ti, int tj, int l15, int q4) {
  f32x4 acc = f32x4{0.f, 0.f, 0.f, 0.f};
#pragma unroll
  for (int ks = 0; ks < 2; ks++) { const int kb = 2 * ks + (q4 >> 1);
    const bool ok = MODE == 1 ? ((kb == 0 && tj == 1) || (kb == 2 && tj == 3)) : (kb < 2 && tj >= 2);
    bf16x8 a = *(const bf16x8*)(X + (16 * ti + l15) * CS + 32 * ks + 8 * q4); bf16x8 bz = bf16x8{0, 0, 0, 0, 0, 0, 0, 0};
    if (ok) bz = *(const bf16x8*)(YT + (16 * tj + l15) * CS + 32 * ks + 8 * q4);
    acc = __builtin_amdgcn_mfma_f32_16x16x32_bf16(a, bz, acc, 0, 0, 0); }
  return acc;
}
__device__ __forceinline__ void st_row(bfr* dst, int r0, int c, f32x4 v) {
#pragma unroll
  for (int jj = 0; jj < 4; jj++) dst[(r0 + jj) * CS + c] = f2b(v[jj]); }
__device__ __forceinline__ void st_tr(bfr* dst, int r0, int c, f32x4 v) { store4b(dst + c * CS + r0, v); }
__device__ __forceinline__ f32x4 ld_row(const bfr* src, int r0, int c) { f32x4 v;
#pragma unroll
  for (int jj = 0; jj < 4; jj++) v[jj] = b2f(src[(r0 + jj) * CS + c]);
  return v; }
__device__ __forceinline__ f32x4 ld_tr(const bfr* src, int r0, int c) { uint2 u = *(const uint2*)(src + c * CS + r0); return f32x4{blo(u.x), bhi(u.x), blo(u.y), bhi(u.y)}; }

__device__ __forceinline__ void ph_r7_ca(const P& p, int j, int win, char* smem) {
  float* LW = (float*)(smem + 7 * 9216); float* AT = (float*)(smem + 9 * 9216); float* WL = (float*)(smem + 14 * 9216);
  const bfr* RK = (const bfr*)(p.ACT + A_RKVZ); const bfr* WMb = (const bfr*)(p.ACT + A_WM); const bfr* AMb = (const bfr*)(p.ACT + A_AM);
  float* BON = (float*)(p.ACT + A_BON); bfr* WB = p.H;
  const float* kkp = p.r7_k_k + (size_t)j * 1024; const float* kap = p.r7_k_a + (size_t)j * 1024; const float* rkp = p.r7_r_k + (size_t)j * 1024;
  const int tid = ltid(), lane = tid & 63, w = tid >> 6, l15 = lane & 15, q4 = lane >> 4, ti = w >> 1, tj0 = (w & 1) * 2;
  const int c0 = win * 26;
  for (int it = blockIdx.x; it < 1664; it += gridDim.x) {
    const int chain = it / 26, cl = it - chain * 26, c = c0 + cl, d = chain & 1, b = chain >> 5, h = (chain >> 1) & 15;
    {
      const int rowA = rowmap(d, b, 64 * c + 16 * ti + l15);
      const float* w0 = p.r7_w0 + (size_t)(j * 2 + d) * 1024 + h * 64; const float* a0 = p.r7_a0 + (size_t)(j * 2 + d) * 1024 + h * 64;
#pragma unroll
      for (int tt = 0; tt < 2; tt++) { const int tj = tj0 + tt; f32x4 aw = f32x4{0.f, 0.f, 0.f, 0.f}, aa = aw;
#pragma unroll
        for (int ks = 0; ks < 2; ks++) {
          bf16x8 xw = *(const bf16x8*)(WMb + (size_t)rowA * 128 + d * 64 + 32 * ks + 8 * q4), xa = *(const bf16x8*)(AMb + (size_t)rowA * 128 + d * 64 + 32 * ks + 8 * q4);
          bf16x8 yw = *(const bf16x8*)(p.W + WR_UP + d * 65536 + (size_t)(h * 64 + 16 * tj + l15) * 64 + 32 * ks + 8 * q4);
          bf16x8 ya = *(const bf16x8*)(p.W + WR_UP + (2 + d) * 65536 + (size_t)(h * 64 + 16 * tj + l15) * 64 + 32 * ks + 8 * q4);
          aw = __builtin_amdgcn_mfma_f32_16x16x32_bf16(xw, yw, aw, 0, 0, 0); aa = __builtin_amdgcn_mfma_f32_16x16x32_bf16(xa, ya, aa, 0, 0, 0); }
        const int ch = 16 * tj + l15; const float w0v = w0[ch], a0v = a0[ch];
#pragma unroll
        for (int jj = 0; jj < 4; jj++) { const int tau = 16 * ti + 4 * q4 + jj; LW[tau * 64 + ch] = -0.6065306597126334f * sigm(w0v + aw[jj]); AT[tau * 64 + ch] = sigm(a0v + aa[jj]); }
      }
    }
    __syncthreads();
    if (tid < 64) { float acc = 0.f;
#pragma unroll 8
      for (int t = 0; t < 64; t++) { acc += LW[t * 64 + tid]; LW[t * 64 + tid] = acc; } }
    __syncthreads();
    {
      const int tau = tid >> 3, sc = tid & 7, col = h * 64 + sc * 8; const int row = rowmap(d, b, 64 * c + tau);
      const bfr* rp = RK + (size_t)row * 4096 + col; uint4 pr = *(const uint4*)rp, pk = *(const uint4*)(rp + 1024);
      unsigned ur[4] = {pr.x, pr.y, pr.z, pr.w}, uk[4] = {pk.x, pk.y, pk.z, pk.w};
      float r8[8], k8[8], kr[8];
#pragma unroll
      for (int e = 0; e < 4; e++) { r8[2 * e] = blo(ur[e]); r8[2 * e + 1] = bhi(ur[e]); k8[2 * e] = blo(uk[e]); k8[2 * e + 1] = bhi(uk[e]); }
      float ss = 0.f;
#pragma unroll
      for (int e = 0; e < 8; e++) { kr[e] = k8[e] * kkp[col + e]; ss += kr[e] * kr[e]; }
      ss += __shfl_xor(ss, 1); ss += __shfl_xor(ss, 2); ss += __shfl_xor(ss, 4);
      const float inv = __builtin_amdgcn_rsqf(fmaxf(ss, 1e-24f));
      float bon = 0.f, o0[8], o1[8], o2[8], o3[8], o4[8], o5[8];
#pragma unroll
      for (int e = 0; e < 8; e++) {
        const float cw = LW[tau * 64 + sc * 8 + e], cwm = tau > 0 ? LW[(tau - 1) * 64 + sc * 8 + e] : 0.f, cwl = LW[63 * 64 + sc * 8 + e], a = AT[tau * 64 + sc * 8 + e];
        const float ka = kr[e] * inv, be = a * ka, kd = k8[e] * (1.f + (a - 1.f) * kap[col + e]); bon += r8[e] * kd * rkp[col + e];
        const float e2 = __expf(-cw), e4 = __expf(cwl - cw);
        o0[e] = ka * __expf(cwm); o1[e] = be * e2; o2[e] = kd * e2; o3[e] = r8[e] * __expf(cw); o4[e] = be * e4; o5[e] = kd * e4;
        if (tau == 63) WL[sc * 8 + e] = __expf(cwl);
      }
      bon += __shfl_xor(bon, 1); bon += __shfl_xor(bon, 2); bon += __shfl_xor(bon, 4);
      if (sc == 0) BON[((size_t)d * R_ + row) * 16 + h] = bon;
      *(uint4*)(CSLOT(0) + tau * CS + sc * 8) = uint4{pk2(o0[0], o0[1]), pk2(o0[2], o0[3]), pk2(o0[4], o0[5]), pk2(o0[6], o0[7])};
      *(uint4*)(CSLOT(1) + tau * CS + sc * 8) = uint4{pk2(o1[0], o1[1]), pk2(o1[2], o1[3]), pk2(o1[4], o1[5]), pk2(o1[6], o1[7])};
      *(uint4*)(CSLOT(2) + tau * CS + sc * 8) = uint4{pk2(o2[0], o2[1]), pk2(o2[2], o2[3]), pk2(o2[4], o2[5]), pk2(o2[6], o2[7])};
      *(uint4*)(CSLOT(3) + tau * CS + sc * 8) = uint4{pk2(o3[0], o3[1]), pk2(o3[2], o3[3]), pk2(o3[4], o3[5]), pk2(o3[6], o3[7])};
#pragma unroll
      for (int e = 0; e < 8; e++) { CSLOT(4)[(sc * 8 + e) * CS + tau] = f2b(o0[e]); CSLOT(5)[(sc * 8 + e) * CS + tau] = f2b(o4[e]); CSLOT(6)[(sc * 8 + e) * CS + tau] = f2b(o5[e]); }
    }
    __syncthreads();
#pragma unroll
    for (int tt = 0; tt < 2; tt++) { const int tj = tj0 + tt, r0 = 16 * ti + 4 * q4, cc = 16 * tj + l15;
      f32x4 v = cmm(CSLOT(1), CSLOT(0), ti, tj, l15, q4);
#pragma unroll
      for (int jj = 0; jj < 4; jj++) if (!(r0 + jj < cc)) v[jj] = 0.f;
      st_row(CSLOT(7), r0, cc, v); st_tr(CSLOT(8), r0, cc, v);
      v = cmm(CSLOT(2), CSLOT(0), ti, tj, l15, q4);
#pragma unroll
      for (int jj = 0; jj < 4; jj++) if (!(r0 + jj < cc)) v[jj] = 0.f;
      st_row(CSLOT(9), r0, cc, v);
      v = cmm(CSLOT(3), CSLOT(1), ti, tj, l15, q4);
#pragma unroll
      for (int jj = 0; jj < 4; jj++) if (!(cc <= r0 + jj)) v[jj] = 0.f;
      st_row(CSLOT(10), r0, cc, v);
      v = cmm(CSLOT(3), CSLOT(2), ti, tj, l15, q4);
#pragma unroll
      for (int jj = 0; jj < 4; jj++) if (!(cc <= r0 + jj)) v[jj] = 0.f;
      st_row(CSLOT(11), r0, cc, v);
    }
    __syncthreads();
    {
      float* X = (float*)CSLOT(0);
      const bfr* Ab = CSLOT(7);
      const int cl = lane >> 3, pp = lane & 7, cx = 8 * w + cl, blk0 = (w >> 1) * 16;
#pragma unroll 1
      for (int il = 15; il >= 0; il--) { const int i = blk0 + il;
        float sum = 0.f;
#pragma unroll 1
        for (int jx = i + 1 + pp; jx < blk0 + 16; jx += 8) sum += b2f(Ab[i * CS + jx]) * X[jx * 72 + cx];
        sum += dppf<0xB1>(sum); sum += dppf<0x4E>(sum); sum += dppf<0x141>(sum);
        const float xv = (i == cx ? 1.f : 0.f) - sum;
        if (pp == 0) X[i * 72 + cx] = xv;
      }
      __syncthreads();
#pragma unroll 1
      for (int e = tid; e < 4096; e += 512) { const int i = e >> 6, c2 = e & 63; const bfr tv = ((i >> 4) == (c2 >> 4)) ? f2b(X[i * 72 + c2]) : (bfr)0; CSLOT(2)[i * CS + c2] = tv; CSLOT(12)[c2 * CS + i] = tv; }
      __syncthreads();
#pragma unroll
      for (int tt = 0; tt < 2; tt++) { const int tj = tj0 + tt, r0 = 16 * ti + 4 * q4, cc = 16 * tj + l15; st_row(CSLOT(13), r0, cc, cmm_mask<1>(CSLOT(2), CSLOT(8), ti, tj, l15, q4)); }
      __syncthreads();
#pragma unroll
      for (int tt = 0; tt < 2; tt++) { const int tj = tj0 + tt, r0 = 16 * ti + 4 * q4, cc = 16 * tj + l15;
        f32x4 v = ld_row(CSLOT(2), r0, cc) - cmm(CSLOT(13), CSLOT(12), ti, tj, l15, q4); st_row(CSLOT(0), r0, cc, v); st_tr(CSLOT(1), r0, cc, v); }
      __syncthreads();
#pragma unroll
      for (int tt = 0; tt < 2; tt++) { const int tj = tj0 + tt, r0 = 16 * ti + 4 * q4, cc = 16 * tj + l15; st_row(CSLOT(13), r0, cc, cmm_mask<2>(CSLOT(0), CSLOT(8), ti, tj, l15, q4)); }
      __syncthreads();
#pragma unroll
      for (int tt = 0; tt < 2; tt++) { const int tj = tj0 + tt, r0 = 16 * ti + 4 * q4, cc = 16 * tj + l15;
        f32x4 v = ld_row(CSLOT(0), r0, cc) - cmm(CSLOT(13), CSLOT(1), ti, tj, l15, q4);
#pragma unroll
        for (int jj = 0; jj < 4; jj++) if (r0 + jj == cc) v[jj] -= 1.f;
        st_row(CSLOT(2), r0, cc, v); }
      __syncthreads();
    }
#pragma unroll
    for (int tt = 0; tt < 2; tt++) { const int tj = tj0 + tt, r0 = 16 * ti + 4 * q4, cc = 16 * tj + l15;
      f32x4 g = cmm(CSLOT(10), CSLOT(2), ti, tj, l15, q4) + ld_row(CSLOT(10), r0, cc); st_row(CSLOT(12), r0, cc, g);
      f32x4 hh = cmm(CSLOT(5), CSLOT(2), ti, tj, l15, q4) + ld_row(CSLOT(5), r0, cc); st_row(CSLOT(13), r0, cc, hh); }
    __syncthreads();
    {
      bfr* out = WB + (size_t)(chain * 26 + cl) * 16384;
#pragma unroll
      for (int tt = 0; tt < 2; tt++) { const int tj = tj0 + tt, r0 = 16 * ti + 4 * q4, cc = 16 * tj + l15;
        f32x4 v = ld_tr(CSLOT(3), r0, cc) - cmm(CSLOT(4), CSLOT(12), ti, tj, l15, q4);
        store4b(out + cc * 64 + r0, v);
        v = ld_tr(CSLOT(11), r0, cc) - cmm(CSLOT(9), CSLOT(12), ti, tj, l15, q4);
        store4b(out + 4096 + cc * 64 + r0, v);
        v = -cmm(CSLOT(4), CSLOT(13), ti, tj, l15, q4);
#pragma unroll
        for (int jj = 0; jj < 4; jj++) if (r0 + jj == cc) v[jj] += WL[cc];
        store4b(out + 8192 + cc * 64 + r0, v);
        v = ld_tr(CSLOT(6), r0, cc) - cmm(CSLOT(9), CSLOT(13), ti, tj, l15, q4);
        store4b(out + 12288 + cc * 64 + r0, v);
      }
    }
    __syncthreads();
  }
}

__device__ __forceinline__ void ph_r7_cb(const P& p, int win, char* smem) {
  bfr* Sh = (bfr*)smem; bfr* Sl = Sh + 2 * 16 * CS; bfr* VT = Sl + 2 * 16 * CS;
  const bfr* WB = p.H; const bfr* RK = (const bfr*)(p.ACT + A_RKVZ); bfr* SST = (bfr*)(p.ACT + A_SST);
  const int tid = ltid(), lane = tid & 63, w = tid >> 6, l15 = lane & 15, q4 = lane >> 4;
  const int c0 = win * 26;
  for (int it = blockIdx.x; it < 256; it += gridDim.x) {
    const int d = it & 1, b = it >> 7, h = (it >> 3) & 15, rg = (it >> 1) & 3, chain = (b * 16 + h) * 2 + d;
    bfr* Y = d ? R7_Y2 : (bfr*)(p.ACT + A_Y);
    bfr* sst = SST + (size_t)(chain * 4 + rg) * 2048;
    __syncthreads();
    if (tid < 256) { const int hl = tid >> 7, e = tid & 127, rr = e >> 3, c8 = e & 7; uint4 v = uint4{0u, 0u, 0u, 0u};
      if (win > 0) v = *(const uint4*)(sst + hl * 1024 + rr * 64 + c8 * 8);
      *(uint4*)((hl ? Sl : Sh) + rr * CS + c8 * 8) = v; }
    const int vtau = tid >> 3, vp = tid & 7;
    { const int row = rowmap(d, b, 64 * c0 + vtau); unsigned vv = *(const unsigned*)(RK + (size_t)row * 4096 + 2048 + h * 64 + rg * 16 + 2 * vp);
      VT[(2 * vp) * CS + vtau] = (bfr)(vv & 0xffff); VT[(2 * vp + 1) * CS + vtau] = (bfr)(vv >> 16); }
    const bfr* bbase = WB + (size_t)(chain * 26) * 16384 + (w < 4 ? 8192 + (16 * w + l15) * 64 : (16 * (w - 4) + l15) * 64) + 8 * q4;
    bf16x8 rb1[4][2], rb2[4][2]; unsigned rv[4];
#define CB_LOAD(u_, s_) { const int ss_ = (s_) < 26 ? (s_) : 25; const bfr* bp_ = bbase + (size_t)ss_ * 16384; \
      rb1[u_][0] = *(const bf16x8*)bp_; rb1[u_][1] = *(const bf16x8*)(bp_ + 32); rb2[u_][0] = *(const bf16x8*)(bp_ + 4096); rb2[u_][1] = *(const bf16x8*)(bp_ + 4096 + 32); \
      const int sv_ = ss_ + 1 < 26 ? ss_ + 1 : 25; const int rowv_ = rowmap(d, b, 64 * (c0 + sv_) + vtau); \
      rv[u_] = *(const unsigned*)(RK + (size_t)rowv_ * 4096 + 2048 + h * 64 + rg * 16 + 2 * vp); }
    CB_LOAD(0, 0) CB_LOAD(1, 1) CB_LOAD(2, 2) CB_LOAD(3, 3)
    __syncthreads();
    for (int g = 0; g < 7; g++) {
#pragma unroll
      for (int u = 0; u < 4; u++) {
        const int s = 4 * g + u;
        if (s < 26) {
          const int cur = s & 1, nxt = cur ^ 1, c = c0 + s;
          bf16x8 sh[2], sl[2], vt[2];
#pragma unroll
          for (int ks = 0; ks < 2; ks++) { sh[ks] = *(const bf16x8*)(Sh + (cur * 16 + l15) * CS + 32 * ks + 8 * q4); sl[ks] = *(const bf16x8*)(Sl + (cur * 16 + l15) * CS + 32 * ks + 8 * q4);
            vt[ks] = *(const bf16x8*)(VT + (cur * 16 + l15) * CS + 32 * ks + 8 * q4); }
          f32x4 a1 = f32x4{0.f, 0.f, 0.f, 0.f}, a2 = a1;
#pragma unroll
          for (int ks = 0; ks < 2; ks++) { a1 = __builtin_amdgcn_mfma_f32_16x16x32_bf16(sh[ks], rb1[u][ks], a1, 0, 0, 0); a2 = __builtin_amdgcn_mfma_f32_16x16x32_bf16(vt[ks], rb2[u][ks], a2, 0, 0, 0); }
#pragma unroll
          for (int ks = 0; ks < 2; ks++) a1 = __builtin_amdgcn_mfma_f32_16x16x32_bf16(sl[ks], rb1[u][ks], a1, 0, 0, 0);
          a1 = a1 + a2;
          if (w < 4) {
#pragma unroll
            for (int jj = 0; jj < 4; jj++) { const bfr hi = f2b(a1[jj]); Sh[(nxt * 16 + 4 * q4 + jj) * CS + 16 * w + l15] = hi; Sl[(nxt * 16 + 4 * q4 + jj) * CS + 16 * w + l15] = f2b(a1[jj] - b2f(hi)); }
          } else {
            const int rowy = rowmap(d, b, 64 * c + 16 * (w - 4) + l15);
            store4b(Y + (size_t)rowy * 1024 + h * 64 + rg * 16 + 4 * q4, a1);
          }
          if (s + 1 < 26) { VT[(nxt * 16 + 2 * vp) * CS + vtau] = (bfr)(rv[u] & 0xffff); VT[(nxt * 16 + 2 * vp + 1) * CS + vtau] = (bfr)(rv[u] >> 16); }
          if (s + 4 < 26) CB_LOAD(u, s + 4)
          __syncthreads();
        }
      }
    }
    if (tid < 256) { const int hl = tid >> 7, e = tid & 127, rr = e >> 3, c8 = e & 7; *(uint4*)(sst + hl * 1024 + rr * 64 + c8 * 8) = *(const uint4*)((hl ? Sl : Sh) + rr * CS + c8 * 8); }
  }
}

__device__ __forceinline__ void run_phase(const P& p, int ph, int layer, int d, char* smem) {
  Ctx c; c.layer = layer; c.j = layer / 3; c.d = d; c.wc = layer < 3 ? 1 : 0;
  switch (ph) {
    case PH_PRE: ph_pre(p, smem); break;
    case PH_NORM: ph_norm(p, layer, smem); break;
    case PH_LRU_IN: big_gemm(smem, p.H, p.W, 2560, 1024, F_LruIn{p.ACT}); break;
    case PH_LRU_CONV: ph_lru_conv(p, c.j); break;
    case PH_LRU_GATE: gemm_phase<G_LruGate>(p, c, smem); break;
    case PH_LRU_S1: ph_lru_s1(p, d); break;
    case PH_LRU_S2: ph_lru_s2(p); break;
    case PH_LRU_S3: ph_lru_s3(p, d); break;
    case PH_LRU_OUT: big_gemm(smem, (const bfr*)(p.ACT + A_Z), p.W + WL_OUT, 1024, 1280, F_Resid{p.Xx, p.Xc, p.MOD + (size_t)layer * 3 * 3072, c.wc}); break;
    case PH_ML_IN: big_gemm(smem, p.H, p.W, 4352, 1024, F_MlIn{p.ACT}); break;
    case PH_ML_SCAN: ph_ml_scan(p, c.j, smem); break;
    case PH_ML_STAT: ph_ml_stat(p); break;
    case PH_ML_Z: big_gemm(smem, p.H, p.W + WM_Z, 2048, 1024, F_MlZ{p.ACT, p.ml_norm_g + (size_t)c.j * 2048}); break;
    case PH_ML_OUT: big_gemm(smem, (const bfr*)(p.ACT + A_HS), p.W + WM_OUT, 1024, 2048, F_Resid{p.Xx, p.Xc, p.MOD + (size_t)layer * 3 * 3072, c.wc}); break;
    case PH_R7_IN: big_gemm(smem, p.H, p.W, 4352, 2048, F_R7In{p.ACT}); break;
    case PH_R7_SHIFT: ph_r7_shift(p); break;
    case PH_R7_CA: ph_r7_ca(p, c.j, d, smem); break;
    case PH_R7_CB: ph_r7_cb(p, d, smem); break;
    case PH_R7_FIN: ph_r7_fin(p, c.j); break;
    case PH_R7_OUT: big_gemm(smem, (const bfr*)(p.ACT + A_Y), p.W + WR_OUT, 1024, 1024, F_Resid{p.Xx, p.Xc, p.MOD + (size_t)layer * 3 * 3072, c.wc}); break;
    case PH_FINAL: ph_final(p); break;
  }
}


#define XB_TMO      128
#define XB_XCNT(j)  (256  + 64 * (j))
#define XB_XSUB(j)  (1280 + 64 * (j))
#define XB_XGEN(j)  (2304 + 64 * (j))
#define XB_TOP      3328
#define XB_TOPGEN   3392
#define XCD_BAR_WORDS 3456
#define XB_SPIN_CAP (1u << 18)
#define OFF_BAR 527000064ull
#define OFF_CL (OFF_BAR + 16384ull)
__device__ __forceinline__ unsigned xb_ld(unsigned* p)              { return __hip_atomic_load(p, __ATOMIC_RELAXED, __HIP_MEMORY_SCOPE_AGENT); }
__device__ __forceinline__ unsigned xb_add(unsigned* p, unsigned v) { return __hip_atomic_fetch_add(p, v, __ATOMIC_RELAXED, __HIP_MEMORY_SCOPE_AGENT); }
__device__ __forceinline__ unsigned xb_xcc_id() { return (unsigned)__builtin_amdgcn_s_getreg((3 << 11) | 20) & 0xFu; }
#define XB_SPIN(cond, bar) do { unsigned _sp = 0; while (cond) { __builtin_amdgcn_s_sleep(1); \
    if ((++_sp & 255u) == 0u) { if (xb_ld(&(bar)[XB_TMO])) break; if (_sp > XB_SPIN_CAP) { atomicAdd(&(bar)[XB_TMO], 1u); break; } } } } while (0)
struct XcdBarrier { unsigned* bar; unsigned x; volatile __attribute__((address_space(3))) unsigned* st; };
__device__ __forceinline__ XcdBarrier xcd_barrier_post(unsigned* bar, volatile __attribute__((address_space(3))) unsigned* st) {
  XcdBarrier b; b.bar = bar; b.x = xb_xcc_id(); b.st = st;
  if (threadIdx.x == 0) (void)xb_add(&bar[XB_XCNT(b.x)], 1u);
  return b;
}
__device__ __forceinline__ void xcd_barrier_complete(unsigned* bar, unsigned x, unsigned& nloc, unsigned& nx) {
  const unsigned G = gridDim.x * gridDim.y * gridDim.z;
  unsigned sum, cnt, mine, sp = 0u;
  for (;;) {
    sum = 0u; cnt = 0u; mine = 0u;
#pragma unroll
    for (unsigned j = 0; j < 16; ++j) { const unsigned c = xb_ld(&bar[XB_XCNT(j)]); sum += c; cnt += (c > 0u) ? 1u : 0u; mine = (j == x) ? c : mine; }
    if (sum == G) break;
    __builtin_amdgcn_s_sleep(1);
    if ((++sp & 255u) == 0u) { if (xb_ld(&bar[XB_TMO])) break; if (sp > XB_SPIN_CAP) { atomicAdd(&bar[XB_TMO], 1u); break; } }
  }
  nloc = mine > 0u ? mine : 1u; nx = cnt > 0u ? cnt : 1u;
}
__device__ __forceinline__ void xcd_barrier(const XcdBarrier& b) {
  asm volatile("s_waitcnt vmcnt(0)" ::: "memory");
  __syncthreads();
  if (threadIdx.x == 0) {
    unsigned* bar = b.bar;
    __builtin_amdgcn_s_waitcnt(0);
    unsigned nloc = b.st[0], nx = b.st[1];
    if (nloc == 0u) { xcd_barrier_complete(bar, b.x, nloc, nx); b.st[0] = nloc; b.st[1] = nx; }
    const unsigned old = xb_add(&bar[XB_XSUB(b.x)], 1u);
    const unsigned gen = old / nloc;
    if (old + 1u == (gen + 1u) * nloc) {
      __builtin_amdgcn_fence(__ATOMIC_RELEASE, "agent");
      asm volatile("s_waitcnt vmcnt(0)" ::: "memory");
      const unsigned og = xb_add(&bar[XB_TOP], 1u);
      const unsigned tg = og / nx;
      if (og + 1u == (tg + 1u) * nx) xb_add(&bar[XB_TOPGEN], 1u);
      else XB_SPIN(xb_ld(&bar[XB_TOPGEN]) == tg, bar);
      __builtin_amdgcn_fence(__ATOMIC_ACQUIRE, "agent");
      xb_add(&bar[XB_XGEN(b.x)], 1u);
      asm volatile("s_waitcnt vmcnt(0)" ::: "memory");
    } else {
      XB_SPIN(xb_ld(&bar[XB_XGEN(b.x)]) == gen, bar);
      __builtin_amdgcn_fence(__ATOMIC_ACQUIRE, "agent");
      asm volatile("s_waitcnt vmcnt(0)" ::: "memory");
    }
  }
  __syncthreads();
}

#define SMEM_BYTES (131072 + 64)
extern __shared__ __attribute__((aligned(16))) char dyn_smem[];
#if !MEGA
__global__ void __launch_bounds__(512, 2) phase_kernel(P p, int si) {
  run_phase(p, p.sched[si * 3], p.sched[si * 3 + 1], p.sched[si * 3 + 2], dyn_smem);
}
#else
__global__ void __launch_bounds__(512, 2) mega_kernel(P p) {
  cg::grid_group grid = cg::this_grid();
  volatile __attribute__((address_space(3))) unsigned* st = (volatile __attribute__((address_space(3))) unsigned*)(dyn_smem + 131072);
  if (threadIdx.x < 4) st[threadIdx.x] = 0u;
  __syncthreads();
  const XcdBarrier xb = xcd_barrier_post(p.bar, st);
  for (int si = 0; si < p.nsched; si++) {
    run_phase(p, p.sched[si * 3], p.sched[si * 3 + 1], p.sched[si * 3 + 2], dyn_smem);
    if (si + 1 < p.nsched) { if (si == 0) grid.sync(); else xcd_barrier(xb); }
  }
}
#endif

extern "C" void kernel_launch(void* const* d_in, const int* in_sizes, int n_in, void* d_out, int out_size, void* d_ws, size_t ws_size, hipStream_t stream) {
  P p; memset(&p, 0, sizeof(p));
  const float** f = (const float**)&p;
  for (int i = 0; i < 33; i++) f[i] = (const float*)d_in[i];
  char* ws = (char*)d_ws;
  p.Xx = (float*)d_out; p.Xc = (float*)(ws + OFF_XC); p.MOD = (float*)(ws + OFF_MOD); p.W = (bfr*)(ws + OFF_W); p.H = (bfr*)(ws + OFF_H); p.ACT = ws + OFF_ACT; p.bar = (unsigned*)(ws + OFF_BAR); p.CL = (float*)(ws + OFF_CL);
  int n = 0;
  auto add = [&](int ph, int layer, int d) { p.sched[n * 3] = ph; p.sched[n * 3 + 1] = layer; p.sched[n * 3 + 2] = d; n++; };
  add(PH_PRE, 0, 0);
  if (DUP & 4) add(PH_PRE, 0, 0);
  for (int l = 0; l < 4; l++) {
    add(PH_NORM, l, 0); if (DUP & 4) add(PH_NORM, l, 0);
    int kind = l % 3;
    const bool dg = DUP & 1, ds = DUP & 2;
    if (kind == 0) { add(PH_LRU_IN, l, 0); if (dg) add(PH_LRU_IN, l, 0); add(PH_LRU_CONV, l, 0); if (DUP & 4) add(PH_LRU_CONV, l, 0);
      for (int d = 0; d < 2; d++) { add(PH_LRU_GATE, l, d); if (dg) add(PH_LRU_GATE, l, d); add(PH_LRU_S1, l, d); if (DUP & 8) add(PH_LRU_S1, l, d); add(PH_LRU_S2, l, d); if (DUP & 16) add(PH_LRU_S2, l, d); add(PH_LRU_S3, l, d); }
      add(PH_LRU_OUT, l, 0); }
    else if (kind == 1) { add(PH_ML_IN, l, 0); if (dg) add(PH_ML_IN, l, 0); add(PH_ML_SCAN, l, 0); if (ds) add(PH_ML_SCAN, l, 0); add(PH_ML_STAT, l, 0); if (DUP & 4) add(PH_ML_STAT, l, 0); add(PH_ML_Z, l, 0); add(PH_ML_OUT, l, 0); }
    else { add(PH_R7_SHIFT, l, 0); add(PH_R7_IN, l, 0); if (dg) add(PH_R7_IN, l, 0); for (int wi = 0; wi < 10; wi++) { add(PH_R7_CA, l, wi); if (DUP & 32) add(PH_R7_CA, l, wi); add(PH_R7_CB, l, wi); } add(PH_R7_FIN, l, 0); add(PH_R7_OUT, l, 0); }
  }
  add(PH_FINAL, 0, 0);
  p.nsched = n;
  if (ws_size < WS_NEED) fprintf(stderr, "workspace too small: %zu < %llu\n", ws_size, (unsigned long long)WS_NEED);
#if MEGA
  static int grid_blocks = 0;
  if (!grid_blocks) { int dev = 0, cus = 0, per = 0; hipGetDevice(&dev); hipDeviceGetAttribute(&cus, hipDeviceAttributeMultiprocessorCount, dev);
    hipFuncSetAttribute((const void*)mega_kernel, hipFuncAttributeMaxDynamicSharedMemorySize, SMEM_BYTES);
    hipOccupancyMaxActiveBlocksPerMultiprocessor(&per, mega_kernel, 512, SMEM_BYTES); if (per > 1) per = 1; if (per < 1) per = 1; grid_blocks = cus * per; }
  hipMemsetAsync(ws + OFF_BAR, 0, XCD_BAR_WORDS * 4, stream);
  void* args[] = {&p};
  hipError_t e = hipLaunchCooperativeKernel((void*)mega_kernel, dim3(grid_blocks), dim3(512), args, SMEM_BYTES, stream);
  if (e != hipSuccess) fprintf(stderr, "cooperative launch failed: %s (grid %d)\n", hipGetErrorString(e), grid_blocks);
#else
  static int once = 0; if (!once) { once = 1; hipFuncSetAttribute((const void*)phase_kernel, hipFuncAttributeMaxDynamicSharedMemorySize, SMEM_BYTES); }
  for (int si = 0; si < n; si++) phase_kernel<<<256, 512, SMEM_BYTES, stream>>>(p, si);
#endif
}
```

```cpp
#include <hip/hip_runtime.h>
#include <hip/hip_bf16.h>
#include <hip/hip_cooperative_groups.h>
#include <cstdio>
#include <cstring>
#include <type_traits>
namespace cg = cooperative_groups;

#ifndef DUP
#define DUP 0
#endif
#ifndef MEGA
#define MEGA 1
#endif

typedef unsigned short bfr;
using bf16x8 = __attribute__((ext_vector_type(8))) short;
using f32x4 = __attribute__((ext_vector_type(4))) float;

#define R_ 33280
#define BT_ 16640
#define NCH_ 260

#define OFF_XC 0ull
#define OFF_MOD 2097152ull
#define OFF_W 2244608ull
#define OFF_H 24264704ull
#define OFF_ACT 92422144ull
#define A_Z 0ull
#define A_UC 85196800ull
#define A_AB 170393600ull
#define A_U 170393600ull
#define A_HF 340787200ull
#define A_AGG 425984000ull
#define A_CAR 431308800ull
#define A_QKV 0ull
#define A_GATE 272629760ull
#define A_HS 276889600ull
#define A_RSTD 413204480ull
#define A_R7B 68157440ull
#define A_RKVZ (A_R7B + 0ull)
#define A_WM (A_R7B + 272629760ull)
#define A_AM (A_R7B + 281149440ull)
#define A_BON (A_R7B + 289669120ull)
#define A_Y (A_R7B + 293928960ull)
#define WS_NEED (527000064ull + 16384ull)

#define WL_GATE (2560 * 1024)
#define WL_OUT (WL_GATE + 1310720)
#define WM_Z (4352 * 1024)
#define WM_OUT (WM_Z + 2048 * 1024)
#define WR_UP (4352 * 2048)
#define WR_OUT (WR_UP + 262144)

enum { PH_PRE = 0, PH_NORM, PH_LRU_IN, PH_LRU_CONV, PH_LRU_GATE, PH_LRU_S1, PH_LRU_S2, PH_LRU_S3, PH_LRU_OUT,
       PH_ML_IN, PH_ML_SCAN, PH_ML_STAT, PH_ML_Z, PH_ML_OUT,
       PH_R7_IN, PH_R7_CA, PH_R7_CB, PH_R7_FIN, PH_R7_OUT, PH_FINAL, PH_R7_SHIFT };

struct P {
  const float *x, *c, *ctx, *c_ctx, *norm_g, *mod_w, *mod_b, *final_g;
  const float *lru_w_in, *lru_conv_w, *lru_conv_b, *lru_gate_w, *lru_gate_b, *lru_lam, *lru_w_out;
  const float *ml_w_in, *ml_gate_b, *ml_norm_g, *ml_w_out;
  const float *r7_mu, *r7_w_rkvz, *r7_w0, *r7_w1, *r7_w2, *r7_a0, *r7_a1, *r7_a2, *r7_k_k, *r7_k_a, *r7_r_k, *r7_ln_g, *r7_ln_b, *r7_w_out;
  float* Xx; float* Xc; float* MOD; bfr* W; bfr* H; char* ACT; unsigned* bar; float* CL;
  int nsched; int pad_;
  int sched[64 * 3];
};
struct Ctx { int layer, j, d, wc; };

__device__ __forceinline__ int ltid() { int t = threadIdx.x; asm volatile("" : "+v"(t)); return t; }
typedef float f32v2_ __attribute__((ext_vector_type(2))); typedef __bf16 bf16v2_ __attribute__((ext_vector_type(2)));
__device__ __forceinline__ unsigned cvtpk(float lo, float hi) { f32v2_ f = {lo, hi}; bf16v2_ h = __builtin_convertvector(f, bf16v2_); return __builtin_bit_cast(unsigned, h); }
__device__ __forceinline__ bfr f2b(float f) { return (bfr)(cvtpk(f, f) & 0xffffu); }
__device__ __forceinline__ float b2f(bfr b) { return __uint_as_float(((unsigned)b) << 16); }
__device__ __forceinline__ unsigned pk2(float a, float b) { return cvtpk(a, b); }
__device__ __forceinline__ float blo(unsigned u) { return __uint_as_float(u << 16); }
__device__ __forceinline__ float bhi(unsigned u) { return __uint_as_float(u & 0xffff0000u); }
__device__ __forceinline__ void store4b(bfr* dst, f32x4 v) { uint2 u; u.x = pk2(v[0], v[1]); u.y = pk2(v[2], v[3]); *(uint2*)dst = u; }
__device__ __forceinline__ float sigm(float x) { return __builtin_amdgcn_rcpf(1.f + __expf(-x)); }
__device__ __forceinline__ float siluf(float x) { return x * sigm(x); }
__device__ __forceinline__ float softplusf(float x) { return x > 20.f ? x : log1pf(expf(x)); }
__device__ __forceinline__ int rowmap(int d, int b, int pp) { int o = d == 0 ? pp : (pp < 256 ? 255 - pp : 16895 - pp); return b * BT_ + o; }
__device__ __forceinline__ float* xrowp(const P& p, int row, int& mi) {
  int b = row / BT_, o = row - b * BT_;
  if (o < 256) { mi = 2; return p.Xc + (size_t)(b * 256 + o) * 1024; }
  mi = b; return p.Xx + (size_t)(b * 16384 + o - 256) * 1024;
}
__device__ __forceinline__ float wsum(float v) { for (int o = 32; o; o >>= 1) v += __shfl_xor(v, o); return v; }
template <int CTRL> __device__ __forceinline__ float dppf(float x) {
  return __int_as_float(__builtin_amdgcn_update_dpp(0, __float_as_int(x), CTRL, 0xf, 0xf, true));
}
__device__ __forceinline__ float red16(float x) {
  x += dppf<0xB1>(x); x += dppf<0x4E>(x); x += dppf<0x141>(x); x += dppf<0x140>(x); return x;
}

template <class F> __device__ __forceinline__ void prep_tile(bfr* dst, int K, int tn, int tk, F get, float* sm) {
  int tid = ltid();
  for (int i = 0; i < 8; i++) { int kk = (tid >> 6) + 8 * i, nn = tid & 63; sm[kk * 65 + nn] = get(tk * 64 + kk, tn * 64 + nn); }
  __syncthreads();
  for (int i = 0; i < 8; i++) { int nn = (tid >> 6) + 8 * i, kk = tid & 63; dst[(size_t)(tn * 64 + nn) * K + tk * 64 + kk] = f2b(sm[kk * 65 + nn]); }
  __syncthreads();
}
__device__ __forceinline__ int prep_count(int layer) { int kind = layer % 3; return kind == 0 ? (640 + 320 + 320) : kind == 1 ? (1088 + 512 + 512) : (2176 + 64 + 256); }
__device__ __forceinline__ void prep_item(const P& p, int layer, int it, float* sm) {
  int kind = layer % 3, j = layer / 3;
  if (kind == 0) {
    if (it < 640) { int tn = it / 16, tk = it % 16; const float* s = p.lru_w_in + (size_t)j * 1024 * 2560;
      prep_tile(p.W, 1024, tn, tk, [=](int k, int n) { return s[(size_t)k * 2560 + n]; }, sm); return; }
    it -= 640;
    if (it < 320) { int d = it / 160, r = it % 160, tn = r / 2, tk = r % 2; const float* s = p.lru_gate_w + (size_t)(j * 2 + d) * 2 * 10 * 16384;
      prep_tile(p.W + WL_GATE + d * 655360, 128, tn, tk, [=](int k, int n) {
        int nt = n >> 7, blk = nt >> 1, sub = nt & 1, jj = n & 127, wn = jj >> 6, rr = jj & 63, g = rr >> 5, c = rr & 31;
        int kch = sub * 64 + wn * 32 + c; return s[((size_t)(g * 10 + blk) * 128 + k) * 128 + kch]; }, sm); return; }
    it -= 320;
    { int tn = it / 20, tk = it % 20; const float* s = p.lru_w_out + (size_t)j * 1280 * 1024;
      prep_tile(p.W + WL_OUT, 1280, tn, tk, [=](int k, int n) { return s[(size_t)k * 1024 + n]; }, sm); return; }
  } else if (kind == 1) {
    const float* s = p.ml_w_in + (size_t)j * 1024 * 6176;
    if (it < 1088) { int tn = it / 16, tk = it % 16;
      prep_tile(p.W, 1024, tn, tk, [=](int k, int n) {
        if (n < 4096) { float v = s[(size_t)k * 6176 + n]; return (n >= 1024 && n < 2048) ? v * 0.08838834764831845f : v; }
        if (n < 4128) return s[(size_t)k * 6176 + 6144 + (n - 4096)];
        return 0.f; }, sm); return; }
    it -= 1088;
    if (it < 512) { int tn = it / 16, tk = it % 16;
      prep_tile(p.W + WM_Z, 1024, tn, tk, [=](int k, int n) { return s[(size_t)k * 6176 + 4096 + n]; }, sm); return; }
    it -= 512;
    { int tn = it / 32, tk = it % 32; const float* so = p.ml_w_out + (size_t)j * 2048 * 1024;
      prep_tile(p.W + WM_OUT, 2048, tn, tk, [=](int k, int n) { return so[(size_t)k * 1024 + n]; }, sm); return; }
  } else {
    if (it < 2176) { int tn = it / 32, tk = it % 32;
      const float* mu = p.r7_mu + (size_t)j * 6 * 1024; const float* wr = p.r7_w_rkvz + (size_t)j * 4 * 1024 * 1024;
      const float* w1 = p.r7_w1 + (size_t)j * 2 * 1024 * 64; const float* a1 = p.r7_a1 + (size_t)j * 2 * 1024 * 64;
      prep_tile(p.W, 2048, tn, tk, [=](int k, int n) {
        int kk = k & 1023; float v, m;
        if (n < 4096) { int g = n >> 10, e = n & 1023; m = mu[g * 1024 + kk]; v = wr[((size_t)g * 1024 + kk) * 1024 + e]; }
        else if (n < 4224) { int xx = (n - 4096) >> 6, rr = (n - 4096) & 63; m = mu[4 * 1024 + kk]; v = w1[((size_t)xx * 1024 + kk) * 64 + rr]; }
        else { int xx = (n - 4224) >> 6, rr = (n - 4224) & 63; m = mu[5 * 1024 + kk]; v = a1[((size_t)xx * 1024 + kk) * 64 + rr]; }
        return (k < 1024 ? (1.f - m) : m) * v; }, sm); return; }
    it -= 2176;
    if (it < 64) { int u = it / 16, tn = it % 16; const float* s = (u < 2 ? p.r7_w2 : p.r7_a2) + (size_t)(j * 2 + (u & 1)) * 64 * 1024;
      prep_tile(p.W + WR_UP + u * 65536, 64, tn, 0, [=](int k, int n) { return s[(size_t)k * 1024 + n]; }, sm); return; }
    it -= 64;
    { int tn = it / 16, tk = it % 16; const float* s = p.r7_w_out + (size_t)j * 1024 * 1024;
      prep_tile(p.W + WR_OUT, 1024, tn, tk, [=](int k, int n) { return s[(size_t)k * 1024 + n]; }, sm); return; }
  }
}

#define LDSS 72
template <class G> __device__ __forceinline__ void gemm_tile(const P& p, const Ctx& c, int mt, int nt, char* smem) {
  const int tid = ltid(), lane = tid & 63, wid = tid >> 6, wm = wid & 3, wn = wid >> 2;
  bfr* sA = (bfr*)smem; bfr* sB = sA + 2 * 256 * LDSS;
  f32x4 acc[4][4];
  for (int a = 0; a < 4; a++) for (int b = 0; b < 4; b++) acc[a][b] = f32x4{0.f, 0.f, 0.f, 0.f};
  const int lr = tid >> 3, lc = tid & 7;
  uint4 ra[4], rb[2];
  auto gload = [&](int kt) __attribute__((always_inline)) {
#pragma unroll
    for (int i = 0; i < 4; i++) {
      const bfr* pa = G::aptr(p, c, mt * 256 + lr + 64 * i, kt, nt);
      ra[i] = pa ? *(const uint4*)(pa + lc * 8) : uint4{0u, 0u, 0u, 0u};
      if (i < 2) rb[i] = *(const uint4*)(G::bptr(p, c, nt * 128 + lr + 64 * i, kt) + lc * 8);
    }
  };
  auto sstore = [&](int buf) __attribute__((always_inline)) {
#pragma unroll
    for (int i = 0; i < 4; i++) {
      *(uint4*)(sA + (buf * 256 + lr + 64 * i) * LDSS + lc * 8) = ra[i];
      if (i < 2) *(uint4*)(sB + (buf * 128 + lr + 64 * i) * LDSS + lc * 8) = rb[i];
    }
  };
  gload(0); sstore(0); __syncthreads();
  for (int kt = 0; kt < G::KT; kt++) {
    const int buf = kt & 1;
    if (kt + 1 < G::KT) gload(kt + 1);
#pragma unroll
    for (int ks = 0; ks < 2; ks++) {
      bf16x8 af[4], bf[4];
#pragma unroll
      for (int i = 0; i < 4; i++) {
        af[i] = *(const bf16x8*)(sA + (buf * 256 + wm * 64 + i * 16 + (lane & 15)) * LDSS + ks * 32 + (lane >> 4) * 8);
        bf[i] = *(const bf16x8*)(sB + (buf * 128 + wn * 64 + i * 16 + (lane & 15)) * LDSS + ks * 32 + (lane >> 4) * 8);
      }
#pragma unroll
      for (int n = 0; n < 4; n++)
#pragma unroll
        for (int m = 0; m < 4; m++) acc[n][m] = __builtin_amdgcn_mfma_f32_16x16x32_bf16(bf[n], af[m], acc[n][m], 0, 0, 0);
    }
    if (kt + 1 < G::KT) sstore(buf ^ 1);
    __syncthreads();
  }
  G::epi(p, c, acc, mt * 256 + wm * 64, nt * 128 + wn * 64, lane);
}

__device__ __forceinline__ void epi_resid(const P& p, const Ctx& c, f32x4 (&acc)[4][4], int m0, int n0, int lane) {
#pragma unroll
  for (int mi = 0; mi < 4; mi++) {
    int row = m0 + mi * 16 + (lane & 15); int mo; float* xr = xrowp(p, row, mo);
    if (mo == 2 && !c.wc) continue;
    const float* g = p.MOD + (size_t)(c.layer * 3 + mo) * 3072 + 2048;
#pragma unroll
    for (int ni = 0; ni < 4; ni++) {
      int n = n0 + ni * 16 + (lane >> 4) * 4;
      float4 xv = *(float4*)(xr + n); float4 gg = *(const float4*)(g + n);
      xv.x += gg.x * acc[ni][mi][0]; xv.y += gg.y * acc[ni][mi][1]; xv.z += gg.z * acc[ni][mi][2]; xv.w += gg.w * acc[ni][mi][3];
      *(float4*)(xr + n) = xv;
    }
  }
}

struct G_LruIn { static constexpr int KT = 16, NT = 20;
  static __device__ __forceinline__ const bfr* aptr(const P& p, const Ctx& c, int row, int kt, int nt) { return p.H + (size_t)row * 1024 + kt * 64; }
  static __device__ __forceinline__ const bfr* bptr(const P& p, const Ctx& c, int n, int kt) { return p.W + (size_t)n * 1024 + kt * 64; }
  static __device__ __forceinline__ void epi(const P& p, const Ctx& c, f32x4 (&acc)[4][4], int m0, int n0, int lane) {
    bfr* U = (bfr*)(p.ACT + A_U); bfr* Z = (bfr*)(p.ACT + A_Z);
#pragma unroll
    for (int ni = 0; ni < 4; ni++)
#pragma unroll
      for (int mi = 0; mi < 4; mi++) {
        int row = m0 + mi * 16 + (lane & 15), n = n0 + ni * 16 + (lane >> 4) * 4;
        bfr* dst = n < 1280 ? U + (size_t)row * 1280 + n : Z + (size_t)row * 1280 + (n - 1280);
        store4b(dst, acc[ni][mi]);
      }
  } };
struct G_LruGate { static constexpr int KT = 2, NT = 20;
  static __device__ __forceinline__ const bfr* aptr(const P& p, const Ctx& c, int row, int kt, int nt) { return (const bfr*)(p.ACT + A_UC) + (size_t)row * 1280 + (nt >> 1) * 128 + kt * 64; }
  static __device__ __forceinline__ const bfr* bptr(const P& p, const Ctx& c, int n, int kt) { return p.W + WL_GATE + c.d * 655360 + (size_t)n * 128 + kt * 64; }
  static __device__ __forceinline__ void epi(const P& p, const Ctx& c, f32x4 (&acc)[4][4], int m0, int n0, int lane) {
    const bfr* UC = (const bfr*)(p.ACT + A_UC); unsigned* AB = (unsigned*)(p.ACT + A_AB);
    const float* gb = p.lru_gate_b + (size_t)(c.j * 2 + c.d) * 2 * 1280; const float* lam = p.lru_lam + (size_t)(c.j * 2 + c.d) * 1280;
    int chb = (n0 >> 6) * 32;
#pragma unroll
    for (int ni = 0; ni < 2; ni++) {
      int ch = chb + ni * 16 + (lane >> 4) * 4;
      float cl[4], br[4], bi[4];
#pragma unroll
      for (int q = 0; q < 4; q++) { cl[q] = p.CL[(size_t)(c.j * 2 + c.d) * 1280 + ch + q]; br[q] = gb[ch + q]; bi[q] = gb[1280 + ch + q]; }
#pragma unroll
      for (int mi = 0; mi < 4; mi++) {
        int row = m0 + mi * 16 + (lane & 15);
        uint2 u = *(const uint2*)(UC + (size_t)row * 1280 + ch);
        float uc[4] = {blo(u.x), bhi(u.x), blo(u.y), bhi(u.y)};
        unsigned o[4];
#pragma unroll
        for (int q = 0; q < 4; q++) {
          float r = sigm(acc[ni][mi][q] + br[q]), ig = sigm(acc[ni + 2][mi][q] + bi[q]);
          float la = -cl[q] * r; float oma = 1.f - __expf(la); float bb = __builtin_amdgcn_sqrtf(oma * (2.f - oma)) * ig * uc[q];
          o[q] = (((unsigned)f2b(oma)) << 16) | (unsigned)f2b(bb);
        }
        *(uint4*)(AB + (size_t)row * 1280 + ch) = uint4{o[0], o[1], o[2], o[3]};
      }
    }
  } };
struct G_LruOut { static constexpr int KT = 20, NT = 8;
  static __device__ __forceinline__ const bfr* aptr(const P& p, const Ctx& c, int row, int kt, int nt) { return (const bfr*)(p.ACT + A_Z) + (size_t)row * 1280 + kt * 64; }
  static __device__ __forceinline__ const bfr* bptr(const P& p, const Ctx& c, int n, int kt) { return p.W + WL_OUT + (size_t)n * 1280 + kt * 64; }
  static __device__ __forceinline__ void epi(const P& p, const Ctx& c, f32x4 (&acc)[4][4], int m0, int n0, int lane) { epi_resid(p, c, acc, m0, n0, lane); } };
struct G_MlIn { static constexpr int KT = 16, NT = 33;
  static __device__ __forceinline__ const bfr* aptr(const P& p, const Ctx& c, int row, int kt, int nt) { return p.H + (size_t)row * 1024 + kt * 64; }
  static __device__ __forceinline__ const bfr* bptr(const P& p, const Ctx& c, int n, int kt) { return p.W + (size_t)n * 1024 + kt * 64; }
  static __device__ __forceinline__ void epi(const P& p, const Ctx& c, f32x4 (&acc)[4][4], int m0, int n0, int lane) {
    bfr* QKV = (bfr*)(p.ACT + A_QKV); float* GT = (float*)(p.ACT + A_GATE);
#pragma unroll
    for (int ni = 0; ni < 4; ni++)
#pragma unroll
      for (int mi = 0; mi < 4; mi++) {
        int row = m0 + mi * 16 + (lane & 15), n = n0 + ni * 16 + (lane >> 4) * 4;
        if (n < 4096) store4b(QKV + (size_t)row * 4096 + n, acc[ni][mi]);
        else if (n < 4128) *(float4*)(GT + (size_t)row * 32 + (n - 4096)) = float4{acc[ni][mi][0], acc[ni][mi][1], acc[ni][mi][2], acc[ni][mi][3]};
      }
  } };
struct G_MlZ { static constexpr int KT = 16, NT = 16;
  static __device__ __forceinline__ const bfr* aptr(const P& p, const Ctx& c, int row, int kt, int nt) { return p.H + (size_t)row * 1024 + kt * 64; }
  static __device__ __forceinline__ const bfr* bptr(const P& p, const Ctx& c, int n, int kt) { return p.W + WM_Z + (size_t)n * 1024 + kt * 64; }
  static __device__ __forceinline__ void epi(const P& p, const Ctx& c, f32x4 (&acc)[4][4], int m0, int n0, int lane) {
    bfr* HS = (bfr*)(p.ACT + A_HS); const float* RS = (const float*)(p.ACT + A_RSTD); const float* ng = p.ml_norm_g + (size_t)c.j * 2048;
#pragma unroll
    for (int ni = 0; ni < 4; ni++)
#pragma unroll
      for (int mi = 0; mi < 4; mi++) {
        int row = m0 + mi * 16 + (lane & 15), n = n0 + ni * 16 + (lane >> 4) * 4;
        bfr* hp = HS + (size_t)row * 2048 + n; uint2 u = *(const uint2*)hp; float rs = RS[(size_t)row * 8 + (n >> 8)];
        float4 g4 = *(const float4*)(ng + n);
        f32x4 o;
        o[0] = blo(u.x) * rs * g4.x * siluf(acc[ni][mi][0]); o[1] = bhi(u.x) * rs * g4.y * siluf(acc[ni][mi][1]);
        o[2] = blo(u.y) * rs * g4.z * siluf(acc[ni][mi][2]); o[3] = bhi(u.y) * rs * g4.w * siluf(acc[ni][mi][3]);
        store4b(hp, o);
      }
  } };
struct G_MlOut { static constexpr int KT = 32, NT = 8;
  static __device__ __forceinline__ const bfr* aptr(const P& p, const Ctx& c, int row, int kt, int nt) { return (const bfr*)(p.ACT + A_HS) + (size_t)row * 2048 + kt * 64; }
  static __device__ __forceinline__ const bfr* bptr(const P& p, const Ctx& c, int n, int kt) { return p.W + WM_OUT + (size_t)n * 2048 + kt * 64; }
  static __device__ __forceinline__ void epi(const P& p, const Ctx& c, f32x4 (&acc)[4][4], int m0, int n0, int lane) { epi_resid(p, c, acc, m0, n0, lane); } };
struct G_R7In { static constexpr int KT = 32, NT = 34;
  static __device__ __forceinline__ const bfr* aptr(const P& p, const Ctx& c, int row, int kt, int nt) {
    if (kt < 16) return p.H + (size_t)row * 1024 + kt * 64;
    int q = (kt - 16) >> 2; int b = row / BT_, o = row - b * BT_; int nr;
    if (o < 256) { if (q < 2) { if (o < 1) return nullptr; nr = row - 1; } else { if (o >= 255) return nullptr; nr = row + 1; } }
    else { int t = o - 256, col = t & 63, gr = t >> 6;
      if (q == 0) { if (col == 0) return nullptr; nr = row - 1; }
      else if (q == 1) { if (col == 63) return nullptr; nr = row + 1; }
      else if (q == 2) { if (gr == 0) return nullptr; nr = row - 64; }
      else { if (gr == 255) return nullptr; nr = row + 64; } }
    return p.H + (size_t)nr * 1024 + (kt - 16) * 64; }
  static __device__ __forceinline__ const bfr* bptr(const P& p, const Ctx& c, int n, int kt) { return p.W + (size_t)n * 2048 + kt * 64; }
  static __device__ __forceinline__ void epi(const P& p, const Ctx& c, f32x4 (&acc)[4][4], int m0, int n0, int lane) {
    bfr* RK = (bfr*)(p.ACT + A_RKVZ); bfr* WMb = (bfr*)(p.ACT + A_WM); bfr* AMb = (bfr*)(p.ACT + A_AM);
#pragma unroll
    for (int ni = 0; ni < 4; ni++)
#pragma unroll
      for (int mi = 0; mi < 4; mi++) {
        int row = m0 + mi * 16 + (lane & 15), n = n0 + ni * 16 + (lane >> 4) * 4;
        if (n < 4096) store4b(RK + (size_t)row * 4096 + n, acc[ni][mi]);
        else if (n < 4224) { f32x4 t;
#pragma unroll
          for (int q = 0; q < 4; q++) t[q] = tanhf(acc[ni][mi][q]); store4b(WMb + (size_t)row * 128 + (n - 4096), t); }
        else store4b(AMb + (size_t)row * 128 + (n - 4224), acc[ni][mi]);
      }
  } };
struct G_R7Out { static constexpr int KT = 16, NT = 8;
  static __device__ __forceinline__ const bfr* aptr(const P& p, const Ctx& c, int row, int kt, int nt) { return p.H + (size_t)row * 1024 + kt * 64; }
  static __device__ __forceinline__ const bfr* bptr(const P& p, const Ctx& c, int n, int kt) { return p.W + WR_OUT + (size_t)n * 1024 + kt * 64; }
  static __device__ __forceinline__ void epi(const P& p, const Ctx& c, f32x4 (&acc)[4][4], int m0, int n0, int lane) { epi_resid(p, c, acc, m0, n0, lane); } };


namespace pg8 {
#define PG8_LAS __attribute__((address_space(3)))
constexpr int BM = 256, BK = 64, HALF = 128, HTB = HALF * BK * 2, NXCD = 8, WGM = 8;
__device__ __forceinline__ int lds_byte(int r, int c) { const int st = (r >> 4) * 2 + (c >> 5), rr = r & 15, cc = c & 31, ob = rr * 64 + cc * 2; return st * 1024 + (ob ^ (((ob >> 9) & 1) << 5)); }
__device__ __forceinline__ void stage_rc(int b, int& R, int& C) { const int st = b / 1024, sb = b % 1024, swz = sb ^ (((sb >> 9) & 1) << 5); R = (st >> 1) * 16 + swz / 64; C = (st & 1) * 32 + (swz % 64) / 2; }
struct Unit { int pm, pn; };
struct Gemm { const bfr* A; const bfr* Bt; int M, N, K; };
struct StaticOrder {
  int nM, nN, nwg, G, c;
  __device__ void init(int M, int N, int G_, int c_) { nM = M / BM; nN = N / BM; nwg = nM * nN; G = G_; c = c_; }
  __device__ bool next(int i, Unit& u) const {
    const long L = (long)i * G + c; if (L >= nwg) return false;
    int wgid = (int)L; { const int q = nwg / NXCD, r = nwg % NXCD, xcd = wgid % NXCD, off = wgid / NXCD; wgid = (xcd < r ? xcd * (q + 1) : r * (q + 1) + (xcd - r) * q) + off; }
    const int nig = WGM * nN, gid = wgid / nig, fm = gid * WGM, gsz = (nM - fm) < WGM ? (nM - fm) : WGM;
    u.pm = fm + ((wgid % nig) % gsz); u.pn = (wgid % nig) / gsz; return true;
  }
};
template <class Epi>
__device__ __forceinline__ void gemm_phase(PG8_LAS unsigned char* lds, const Gemm g, const StaticOrder& S, const Epi& E) {
  const int tid = ltid(), wid = __builtin_amdgcn_readfirstlane(tid >> 6), lane = tid & 63, wr = wid >> 2, wc = wid & 3, fr = lane & 15, fq = lane >> 4;
  const int K = g.K, nt = K / BK;
  unsigned voffA[2], voffB[2];
#pragma unroll
  for (int i = 0; i < 2; ++i) { int R, C; stage_rc(tid * 16 + i * 8192, R, C); voffA[i] = (unsigned)(R * K + C) * 2u; voffB[i] = voffA[i]; }
  const size_t kstep = (size_t)(BK * 2);
  const size_t hstep = (size_t)HALF * K * 2;
  const size_t tstep = 2 * hstep;
  const unsigned ldsw = (unsigned)wid * 1024u;
  const int aoff = lds_byte(wr * 64 + fr, fq * 8), boff = lds_byte(wc * 32 + fr, fq * 8);
#define PG8_SA(b, h) (((b) * 2 + (h)) * HTB)
#define PG8_SB(b, h) ((4 + (b) * 2 + (h)) * HTB)
#define PG8_STAGE(bufoff, gbase, voff) do { _Pragma("unroll") for (int _i = 0; _i < 2; ++_i) \
    __builtin_amdgcn_global_load_lds((const unsigned*)((const char*)(gbase) + (voff)[_i]), (PG8_LAS unsigned*)(lds + (bufoff) + ldsw + _i * 8192), 16, 0, 0); } while (0)
#define PG8_LDA(dst, b, h) do { _Pragma("unroll") for (int m = 0; m < 4; ++m) _Pragma("unroll") for (int k = 0; k < 2; ++k) dst[m][k] = *(const PG8_LAS bf16x8*)(lds + PG8_SA(b, h) + aoff + m * 2048 + k * 1024); } while (0)
#define PG8_LDB(dst, b, h) do { _Pragma("unroll") for (int n = 0; n < 2; ++n) _Pragma("unroll") for (int k = 0; k < 2; ++k) dst[n][k] = *(const PG8_LAS bf16x8*)(lds + PG8_SB(b, h) + boff + n * 2048 + k * 1024); } while (0)
#define PG8_MMA(ai, bj, At, Bt) do { __builtin_amdgcn_s_setprio(1); _Pragma("unroll") for (int m = 0; m < 4; ++m) _Pragma("unroll") for (int n = 0; n < 2; ++n) _Pragma("unroll") for (int k = 0; k < 2; ++k) \
    acc[ai][bj][m][n] = __builtin_amdgcn_mfma_f32_16x16x32_bf16(Bt[n][k], At[m][k], acc[ai][bj][m][n], 0, 0, 0); __builtin_amdgcn_s_setprio(0); } while (0)
#define PG8_WAIT_V(n) asm volatile("s_waitcnt vmcnt(" #n ")" ::: "memory")
#define PG8_WAIT_L(n) asm volatile("s_waitcnt lgkmcnt(" #n ")" ::: "memory")
#define PG8_BAR __builtin_amdgcn_s_barrier()
#define PG8_SCHED __builtin_amdgcn_sched_barrier(0)
  Unit cur, nxt; int ui = 0;
  if (!S.next(0, cur)) return;
  f32x4 acc[2][2][4][2];
#pragma unroll
  for (int a = 0; a < 2; ++a)
#pragma unroll
    for (int b = 0; b < 2; ++b)
#pragma unroll
      for (int m = 0; m < 4; ++m)
#pragma unroll
        for (int n = 0; n < 2; ++n) acc[a][b][m][n] = (f32x4){0.f, 0.f, 0.f, 0.f};
  bf16x8 At[4][2], B0[2][2], B1[2][2];
  const char* cA = (const char*)g.A + (size_t)cur.pm * tstep; const char* cB = (const char*)g.Bt + (size_t)cur.pn * tstep;
  PG8_STAGE(PG8_SB(0, 0), cB, voffB); PG8_STAGE(PG8_SA(0, 0), cA, voffA); PG8_STAGE(PG8_SB(0, 1), cB + hstep, voffB); PG8_STAGE(PG8_SA(0, 1), cA + hstep, voffA);
  if (wr == 1) PG8_BAR;
  PG8_WAIT_V(4); PG8_BAR;
  PG8_STAGE(PG8_SB(1, 0), cB + kstep, voffB); PG8_STAGE(PG8_SA(1, 0), cA + kstep, voffA); PG8_STAGE(PG8_SB(1, 1), cB + hstep + kstep, voffB);
  PG8_WAIT_V(6); PG8_BAR;
  for (;;) {
    const bool has_next = S.next(ui + 1, nxt);
    const char* nA = has_next ? (const char*)g.A + (size_t)nxt.pm * tstep : cA; const char* nB = has_next ? (const char*)g.Bt + (size_t)nxt.pn * tstep : cB;
    for (int t = 0; t < nt; t += 2) {
      const bool last = (t == nt - 2);
      const char* a1 = cA + (size_t)(t + 1) * kstep;
      const char* a2 = last ? nA : cA + (size_t)(t + 2) * kstep; const char* b2 = last ? nB : cB + (size_t)(t + 2) * kstep;
      const char* a3 = a2 + kstep; const char* b3 = b2 + kstep;
      PG8_LDB(B0, 0, 0); PG8_SCHED; PG8_LDA(At, 0, 0); PG8_STAGE(PG8_SA(1, 1), a1 + hstep, voffA);
      PG8_WAIT_L(8); PG8_BAR; PG8_WAIT_L(0); PG8_MMA(0, 0, At, B0); PG8_BAR; PG8_SCHED;
      PG8_LDB(B1, 0, 1); PG8_STAGE(PG8_SB(0, 0), b2, voffB);
      PG8_BAR; PG8_WAIT_L(0); PG8_MMA(0, 1, At, B1); PG8_BAR;
      PG8_LDA(At, 0, 1); PG8_STAGE(PG8_SA(0, 0), a2, voffA);
      PG8_BAR; PG8_WAIT_L(0); PG8_MMA(1, 0, At, B0); PG8_BAR; PG8_SCHED;
      PG8_STAGE(PG8_SB(0, 1), b2 + hstep, voffB);
      PG8_WAIT_V(6); PG8_BAR; PG8_MMA(1, 1, At, B1); PG8_BAR;
      PG8_LDB(B0, 1, 0); PG8_SCHED; PG8_LDA(At, 1, 0); PG8_STAGE(PG8_SA(0, 1), a2 + hstep, voffA);
      PG8_WAIT_L(8); PG8_BAR; PG8_WAIT_L(0); PG8_MMA(0, 0, At, B0); PG8_BAR; PG8_SCHED;
      PG8_LDB(B1, 1, 1); PG8_STAGE(PG8_SB(1, 0), b3, voffB);
      PG8_BAR; PG8_WAIT_L(0); PG8_MMA(0, 1, At, B1); PG8_BAR;
      PG8_LDA(At, 1, 1); PG8_STAGE(PG8_SA(1, 0), a3, voffA);
      PG8_BAR; PG8_WAIT_L(0); PG8_MMA(1, 0, At, B0); PG8_BAR; PG8_SCHED;
      PG8_STAGE(PG8_SB(1, 1), b3 + hstep, voffB);
      PG8_WAIT_V(6); PG8_BAR; PG8_MMA(1, 1, At, B1); PG8_BAR;
    }
    E(acc, cur, wr, wc, fr, fq);
    if (!has_next) break;
#pragma unroll
    for (int a = 0; a < 2; ++a)
#pragma unroll
      for (int b = 0; b < 2; ++b)
#pragma unroll
        for (int m = 0; m < 4; ++m)
#pragma unroll
          for (int n = 0; n < 2; ++n) acc[a][b][m][n] = (f32x4){0.f, 0.f, 0.f, 0.f};
    cur = nxt; cA = nA; cB = nB; ++ui;
  }
  PG8_WAIT_V(0);
  if (wr == 0) PG8_BAR;
  PG8_BAR;
#undef PG8_SA
#undef PG8_SB
#undef PG8_STAGE
#undef PG8_LDA
#undef PG8_LDB
#undef PG8_MMA
#undef PG8_WAIT_V
#undef PG8_WAIT_L
#undef PG8_BAR
#undef PG8_SCHED
}
}

template <class F> struct EpiAd {
  F f;
  __device__ __forceinline__ void operator()(const f32x4 (&acc)[2][2][4][2], const pg8::Unit& u, int wr, int wc, int fr, int fq) const {
#pragma unroll
    for (int ai = 0; ai < 2; ++ai)
#pragma unroll
      for (int m = 0; m < 4; ++m) { const int row = u.pm * 256 + ai * 128 + wr * 64 + m * 16 + fr;
#pragma unroll
        for (int bj = 0; bj < 2; ++bj)
#pragma unroll
          for (int n = 0; n < 2; ++n) f(row, u.pn * 256 + bj * 128 + wc * 32 + n * 16 + 4 * fq, acc[ai][bj][m][n]); }
  }
};
template <class F> __device__ __forceinline__ void big_gemm(char* smem, const bfr* A, const bfr* Bt, int N, int K, F f) {
  pg8::Gemm g; g.A = A; g.Bt = Bt; g.M = R_; g.N = N; g.K = K;
  pg8::StaticOrder S; S.init(R_, N, (int)gridDim.x, (int)blockIdx.x);
  EpiAd<F> E{f};
  pg8::gemm_phase(( __attribute__((address_space(3))) unsigned char*)smem, g, S, E);
}
struct F_LruIn { char* ACT; __device__ __forceinline__ void operator()(int row, int n, f32x4 v) const {
  bfr* dst = n < 1280 ? (bfr*)(ACT + A_U) + (size_t)row * 1280 + n : (bfr*)(ACT + A_Z) + (size_t)row * 1280 + (n - 1280); store4b(dst, v); } };
struct F_Resid { float* Xx; float* Xc; const float* MODg; int wc; __device__ __forceinline__ void operator()(int row, int n, f32x4 v) const {
  int b = row / BT_, o = row - b * BT_; bool isc = o < 256; if (isc && !wc) return;
  float* xr = isc ? Xc + (size_t)(b * 256 + o) * 1024 : Xx + (size_t)(b * 16384 + o - 256) * 1024; const float* g = MODg + (size_t)(isc ? 2 : b) * 3072 + 2048;
  float4 xv = *(float4*)(xr + n); float4 gg = *(const float4*)(g + n);
  xv.x += gg.x * v[0]; xv.y += gg.y * v[1]; xv.z += gg.z * v[2]; xv.w += gg.w * v[3]; *(float4*)(xr + n) = xv; } };
struct F_MlIn { char* ACT; __device__ __forceinline__ void operator()(int row, int n, f32x4 v) const {
  if (n < 4096) store4b((bfr*)(ACT + A_QKV) + (size_t)row * 4096 + n, v);
  else if (n < 4128) *(float4*)((float*)(ACT + A_GATE) + (size_t)row * 32 + (n - 4096)) = float4{v[0], v[1], v[2], v[3]}; } };
struct F_MlZ { char* ACT; const float* ng; __device__ __forceinline__ void operator()(int row, int n, f32x4 v) const {
  bfr* hp = (bfr*)(ACT + A_HS) + (size_t)row * 2048 + n; uint2 u = *(const uint2*)hp; float rs = ((const float*)(ACT + A_RSTD))[(size_t)row * 8 + (n >> 8)];
  float4 g4 = *(const float4*)(ng + n); f32x4 o;
  o[0] = blo(u.x) * rs * g4.x * siluf(v[0]); o[1] = bhi(u.x) * rs * g4.y * siluf(v[1]); o[2] = blo(u.y) * rs * g4.z * siluf(v[2]); o[3] = bhi(u.y) * rs * g4.w * siluf(v[3]);
  store4b(hp, o); } };
struct F_R7In { char* ACT; __device__ __forceinline__ void operator()(int row, int n, f32x4 v) const {
  if (n < 4096) store4b((bfr*)(ACT + A_RKVZ) + (size_t)row * 4096 + n, v);
  else if (n < 4224) { f32x4 t;
#pragma unroll
    for (int q = 0; q < 4; q++) t[q] = tanhf(v[q]);
    store4b((bfr*)(ACT + A_WM) + (size_t)row * 128 + (n - 4096), t); }
  else store4b((bfr*)(ACT + A_AM) + (size_t)row * 128 + (n - 4224), v); } };

template <class G> __device__ __forceinline__ void gemm_phase(const P& p, const Ctx& c, char* smem) {
  const int total = 130 * G::NT;
  for (int it = blockIdx.x; it < total; it += gridDim.x) gemm_tile<G>(p, c, it / G::NT, it % G::NT, smem);
}

#define R7_Y2 ((bfr*)p.H + (size_t)64 * 26 * 16384)
__device__ __forceinline__ void ph_pre(const P& p, char* smem) {
  float* sm = (float*)smem; const int tid = ltid();
  const int nprep = prep_count(0), ngemv = 192, ncopy = 4160;
  if (blockIdx.x == 0) for (int i = tid; i < 5120; i += 512) p.CL[i] = 8.f * softplusf(-p.lru_lam[i]);
  for (int it = blockIdx.x; it < nprep + ngemv + ncopy; it += gridDim.x) {
    if (it < nprep) { prep_item(p, 0, it, sm); continue; }
    int i2 = it - nprep;
    if (i2 < ngemv) {
      int l = i2 / 48, cgp = i2 % 48;
      for (int i = tid; i < 3072; i += 512) { int cnd = i >> 10, k = i & 1023; float v = cnd == 0 ? p.c[k] : cnd == 1 ? p.c[1024 + k] : p.c_ctx[k]; sm[i] = siluf(v); }
      __syncthreads();
      int kq = tid >> 6, col = cgp * 64 + (tid & 63); const float* w = p.mod_w + (size_t)l * 1024 * 3072 + col;
      float a0 = 0.f, a1 = 0.f, a2 = 0.f;
      for (int k = kq * 128; k < kq * 128 + 128; k++) { float wv = w[(size_t)k * 3072]; a0 += sm[k] * wv; a1 += sm[1024 + k] * wv; a2 += sm[2048 + k] * wv; }
      float* red = sm + 3072; red[tid * 3] = a0; red[tid * 3 + 1] = a1; red[tid * 3 + 2] = a2;
      __syncthreads();
      if (tid < 64) { float bias = p.mod_b[(size_t)l * 3072 + col];
        for (int cnd = 0; cnd < 3; cnd++) { float s = bias; for (int q = 0; q < 8; q++) s += red[(q * 64 + tid) * 3 + cnd]; p.MOD[(size_t)(l * 3 + cnd) * 3072 + col] = s; } }
      __syncthreads();
      continue;
    }
    i2 -= ngemv;
    for (int q = 0; q < 4; q++) { int idx = i2 * 2048 + q * 512 + tid; int row = idx >> 8, c4 = idx & 255; int b = row / BT_, o = row - b * BT_;
      if (o < 256) ((float4*)p.Xc)[(size_t)(b * 256 + o) * 256 + c4] = ((const float4*)p.ctx)[(size_t)(b * 256 + o) * 256 + c4];
      else ((float4*)p.Xx)[(size_t)(b * 16384 + o - 256) * 256 + c4] = ((const float4*)p.x)[(size_t)(b * 16384 + o - 256) * 256 + c4]; }
  }
}
__device__ __forceinline__ void ph_norm(const P& p, int layer, char* smem) {
  const int tid = ltid(), lane = tid & 63, wid = tid >> 6;
  const int nprep = layer > 0 ? prep_count(layer) : 0; const int kind = layer % 3;
  const int nzero = kind == 1 ? 8320 : 0;
  (void)nzero;
  for (int it = blockIdx.x; it < nprep + 4160; it += gridDim.x) {
    if (it < nprep) { prep_item(p, layer, it, (float*)smem); continue; }
    int row = (it - nprep) * 8 + wid; int mo; const float* xr = xrowp(p, row, mo);
    float4 v[4]; float ss = 0.f;
#pragma unroll
    for (int i = 0; i < 4; i++) { v[i] = *(const float4*)(xr + lane * 4 + 256 * i); ss += v[i].x * v[i].x + v[i].y * v[i].y + v[i].z * v[i].z + v[i].w * v[i].w; }
    ss = wsum(ss); float rs = rsqrtf(ss * (1.f / 1024.f) + 1e-6f);
    const float* g = p.norm_g + (size_t)layer * 1024; const float* md = p.MOD + (size_t)(layer * 3 + mo) * 3072;
#pragma unroll
    for (int i = 0; i < 4; i++) { int cidx = lane * 4 + 256 * i; float4 gg = *(const float4*)(g + cidx), sh = *(const float4*)(md + cidx), sc = *(const float4*)(md + 1024 + cidx);
      f32x4 o; o[0] = v[i].x * rs * gg.x * (1.f + sc.x) + sh.x; o[1] = v[i].y * rs * gg.y * (1.f + sc.y) + sh.y; o[2] = v[i].z * rs * gg.z * (1.f + sc.z) + sh.z; o[3] = v[i].w * rs * gg.w * (1.f + sc.w) + sh.w;
      store4b(p.H + (size_t)row * (kind == 2 ? 2048 : 1024) + cidx, o); }
  }
}
__device__ __forceinline__ void ph_r7_shift(const P& p) {
  for (int it = blockIdx.x; it < 8320; it += gridDim.x) {
    int idx = it * 512 + ltid(); int row = idx >> 7, c8 = idx & 127, q = c8 >> 5;
    int b = row / BT_, o = row - b * BT_; int nr = -1;
    if (o < 256) { if (q < 2) { if (o >= 1) nr = row - 1; } else { if (o < 255) nr = row + 1; } }
    else { int t = o - 256, col = t & 63, gr = t >> 6;
      if (q == 0) { if (col != 0) nr = row - 1; } else if (q == 1) { if (col != 63) nr = row + 1; }
      else if (q == 2) { if (gr != 0) nr = row - 64; } else { if (gr != 255) nr = row + 64; } }
    uint4 v = nr >= 0 ? *(const uint4*)(p.H + (size_t)nr * 2048 + c8 * 8) : uint4{0u, 0u, 0u, 0u};
    *(uint4*)(p.H + (size_t)row * 2048 + 1024 + c8 * 8) = v;
  }
}
__device__ __forceinline__ void ph_final(const P& p) {
  const int lane = ltid() & 63, wid = ltid() >> 6;
  for (int it = blockIdx.x; it < 4096; it += gridDim.x) {
    float* xr = p.Xx + (size_t)(it * 8 + wid) * 1024; float4 v[4]; float ss = 0.f;
#pragma unroll
    for (int i = 0; i < 4; i++) { v[i] = *(const float4*)(xr + lane * 4 + 256 * i); ss += v[i].x * v[i].x + v[i].y * v[i].y + v[i].z * v[i].z + v[i].w * v[i].w; }
    ss = wsum(ss); float rs = rsqrtf(ss * (1.f / 1024.f) + 1e-6f);
#pragma unroll
    for (int i = 0; i < 4; i++) { int cidx = lane * 4 + 256 * i; float4 gg = *(const float4*)(p.final_g + cidx);
      *(float4*)(xr + cidx) = float4{v[i].x * rs * gg.x, v[i].y * rs * gg.y, v[i].z * rs * gg.z, v[i].w * rs * gg.w}; }
  }
}
__device__ __forceinline__ void ph_lru_conv(const P& p, int j) {
  const bfr* U = (const bfr*)(p.ACT + A_U); bfr* UC = (bfr*)(p.ACT + A_UC);
  const float* cw = p.lru_conv_w + (size_t)j * 4 * 1280; const float* cb = p.lru_conv_b + (size_t)j * 1280;
  for (int it = blockIdx.x; it < 10400; it += gridDim.x) {
    int idx = it * 512 + ltid(); int row = idx / 160, cgp = idx % 160, ch = cgp * 8;
    int b = row / BT_, o = row - b * BT_; int s0 = o < 256 ? 0 : 256, e0 = o < 256 ? 256 : BT_;
    float acc[8];
#pragma unroll
    for (int e = 0; e < 8; e++) acc[e] = cb[ch + e];
#pragma unroll
    for (int t = 0; t < 4; t++) { int oo = o + t - 2; if (oo < s0 || oo >= e0) continue;
      uint4 u = *(const uint4*)(U + (size_t)(row + t - 2) * 1280 + ch); const float* w = cw + t * 1280 + ch;
      acc[0] += w[0] * blo(u.x); acc[1] += w[1] * bhi(u.x); acc[2] += w[2] * blo(u.y); acc[3] += w[3] * bhi(u.y);
      acc[4] += w[4] * blo(u.z); acc[5] += w[5] * bhi(u.z); acc[6] += w[6] * blo(u.w); acc[7] += w[7] * bhi(u.w); }
    *(uint4*)(UC + (size_t)row * 1280 + ch) = uint4{pk2(acc[0], acc[1]), pk2(acc[2], acc[3]), pk2(acc[4], acc[5]), pk2(acc[6], acc[7])};
  }
}
__device__ __forceinline__ void ph_lru_s1(const P& p, int d) {
  const unsigned* AB = (const unsigned*)(p.ACT + A_AB); float2* AGG = (float2*)(p.ACT + A_AGG);
  const int t = ltid();
  for (int it = blockIdx.x * 8 + (t >> 6); it < 2600; it += gridDim.x * 8) {
    int b = it / 1300, r = it % 1300, cc = r / 5, ch = (r % 5) * 256 + (t & 63) * 4;
    float P0 = 1.f, Q0 = 0.f, P1 = 1.f, Q1 = 0.f, P2 = 1.f, Q2 = 0.f, P3 = 1.f, Q3 = 0.f;
#pragma unroll 8
    for (int q = 0; q < 64; q++) { uint4 u = *(const uint4*)(AB + (size_t)rowmap(d, b, cc * 64 + q) * 1280 + ch);
      float a0 = 1.f - bhi(u.x), a1 = 1.f - bhi(u.y), a2 = 1.f - bhi(u.z), a3 = 1.f - bhi(u.w);
      P0 *= a0; Q0 = a0 * Q0 + blo(u.x); P1 *= a1; Q1 = a1 * Q1 + blo(u.y); P2 *= a2; Q2 = a2 * Q2 + blo(u.z); P3 *= a3; Q3 = a3 * Q3 + blo(u.w); }
    float4* ag = (float4*)(AGG + (size_t)(b * NCH_ + cc) * 1280 + ch); ag[0] = float4{P0, Q0, P1, Q1}; ag[1] = float4{P2, Q2, P3, Q3};
  }
}
__device__ __forceinline__ void ph_lru_s2(const P& p, char* smem) {
  const float2* AGG = (const float2*)(p.ACT + A_AGG); float* CAR = (float*)(p.ACT + A_CAR);
  float* sP = (float*)smem; float* sQ = sP + 512;
  const int tid = ltid(), chl = tid & 63, seg = tid >> 6;
  for (int it = blockIdx.x; it < 40; it += gridDim.x) {
    const int b = it / 20, ch = (it % 20) * 64 + chl; const int cb = seg * 33, ce = cb + 33 < NCH_ ? cb + 33 : NCH_;
    float Pp = 1.f, Q = 0.f;
#pragma unroll 11
    for (int cc = cb; cc < ce; cc++) { float2 a = AGG[(size_t)(b * NCH_ + cc) * 1280 + ch]; Pp *= a.x; Q = a.x * Q + a.y; }
    __syncthreads();
    sP[seg * 64 + chl] = Pp; sQ[seg * 64 + chl] = Q;
    __syncthreads();
    float h = 0.f;
    for (int s2 = 0; s2 < seg; s2++) h = sP[s2 * 64 + chl] * h + sQ[s2 * 64 + chl];
#pragma unroll 11
    for (int cc = cb; cc < ce; cc++) { size_t o = (size_t)(b * NCH_ + cc) * 1280 + ch; float2 a = AGG[o]; CAR[o] = h; h = a.x * h + a.y; }
  }
}
__device__ __forceinline__ void ph_lru_s3(const P& p, int d) {
  const unsigned* AB = (const unsigned*)(p.ACT + A_AB); const float* CAR = (const float*)(p.ACT + A_CAR);
  bfr* HF = (bfr*)(p.ACT + A_HF); bfr* Z = (bfr*)(p.ACT + A_Z);
  const int t = ltid();
  for (int it = blockIdx.x * 8 + (t >> 6); it < 2600; it += gridDim.x * 8) {
    int b = it / 1300, r = it % 1300, cc = r / 5, ch = (r % 5) * 256 + (t & 63) * 4;
    float4 h = *(const float4*)(CAR + (size_t)(b * NCH_ + cc) * 1280 + ch);
#pragma unroll 8
    for (int q = 0; q < 64; q++) { size_t o = (size_t)rowmap(d, b, cc * 64 + q) * 1280 + ch; uint4 u = *(const uint4*)(AB + o);
      h.x = (1.f - bhi(u.x)) * h.x + blo(u.x); h.y = (1.f - bhi(u.y)) * h.y + blo(u.y); h.z = (1.f - bhi(u.z)) * h.z + blo(u.z); h.w = (1.f - bhi(u.w)) * h.w + blo(u.w);
      if (d == 0) *(uint2*)(HF + o) = uint2{pk2(h.x, h.y), pk2(h.z, h.w)};
      else { uint2 hf = *(const uint2*)(HF + o), zz = *(const uint2*)(Z + o);
        *(uint2*)(Z + o) = uint2{pk2((blo(hf.x) + h.x) * siluf(blo(zz.x)), (bhi(hf.x) + h.y) * siluf(bhi(zz.x))), pk2((blo(hf.y) + h.z) * siluf(blo(zz.y)), (bhi(hf.y) + h.w) * siluf(bhi(zz.y)))}; } }
  }
}
__device__ __forceinline__ void ph_ml_stat(const P& p) {
  const bfr* HS = (const bfr*)(p.ACT + A_HS); float* RS = (float*)(p.ACT + A_RSTD);
  const int lane = ltid() & 63, wid = ltid() >> 6;
  for (int it = blockIdx.x; it < 4160; it += gridDim.x) {
    int row = it * 8 + wid; const bfr* hp = HS + (size_t)row * 2048 + lane * 32; float ss = 0.f;
#pragma unroll
    for (int i = 0; i < 4; i++) { uint4 u = *(const uint4*)(hp + i * 8); float a;
      a = blo(u.x); ss += a * a; a = bhi(u.x); ss += a * a; a = blo(u.y); ss += a * a; a = bhi(u.y); ss += a * a;
      a = blo(u.z); ss += a * a; a = bhi(u.z); ss += a * a; a = blo(u.w); ss += a * a; a = bhi(u.w); ss += a * a; }
    ss += __shfl_xor(ss, 1); ss += __shfl_xor(ss, 2); ss += __shfl_xor(ss, 4);
    if ((lane & 7) == 0) RS[(size_t)row * 8 + (lane >> 3)] = rsqrtf(ss * (1.f / 256.f) + 1e-6f);
  }
}
__device__ __forceinline__ void ph_r7_fin(const P& p, int j) {
  bfr* Y = (bfr*)(p.ACT + A_Y); const bfr* RK = (const bfr*)(p.ACT + A_RKVZ); const float* BON = (const float*)(p.ACT + A_BON);
  const float* lg = p.r7_ln_g + (size_t)j * 1024; const float* lb = p.r7_ln_b + (size_t)j * 1024;
  const int lane = ltid() & 63, wid = ltid() >> 6;
  for (int it = blockIdx.x; it < 4160; it += gridDim.x) {
    int row = it * 8 + wid, ch = lane * 16, hd = lane >> 2;
    float y[16], v[16], z[16];
#pragma unroll
    for (int i = 0; i < 2; i++) {
      uint4 u = *(const uint4*)(Y + (size_t)row * 1024 + ch + i * 8); const uint4 u2 = *(const uint4*)(R7_Y2 + (size_t)row * 1024 + ch + i * 8);
      y[i * 8 + 0] = blo(u.x) + blo(u2.x); y[i * 8 + 1] = bhi(u.x) + bhi(u2.x); y[i * 8 + 2] = blo(u.y) + blo(u2.y); y[i * 8 + 3] = bhi(u.y) + bhi(u2.y); y[i * 8 + 4] = blo(u.z) + blo(u2.z); y[i * 8 + 5] = bhi(u.z) + bhi(u2.z); y[i * 8 + 6] = blo(u.w) + blo(u2.w); y[i * 8 + 7] = bhi(u.w) + bhi(u2.w);
      u = *(const uint4*)(RK + (size_t)row * 4096 + 2048 + ch + i * 8);
      v[i * 8 + 0] = blo(u.x); v[i * 8 + 1] = bhi(u.x); v[i * 8 + 2] = blo(u.y); v[i * 8 + 3] = bhi(u.y); v[i * 8 + 4] = blo(u.z); v[i * 8 + 5] = bhi(u.z); v[i * 8 + 6] = blo(u.w); v[i * 8 + 7] = bhi(u.w);
      u = *(const uint4*)(RK + (size_t)row * 4096 + 3072 + ch + i * 8);
      z[i * 8 + 0] = blo(u.x); z[i * 8 + 1] = bhi(u.x); z[i * 8 + 2] = blo(u.y); z[i * 8 + 3] = bhi(u.y); z[i * 8 + 4] = blo(u.z); z[i * 8 + 5] = bhi(u.z); z[i * 8 + 6] = blo(u.w); z[i * 8 + 7] = bhi(u.w);
    }
    float s = 0.f;
#pragma unroll
    for (int e = 0; e < 16; e++) s += y[e];
    s += __shfl_xor(s, 1); s += __shfl_xor(s, 2); float mean = s * (1.f / 64.f);
    float q = 0.f;
#pragma unroll
    for (int e = 0; e < 16; e++) { float dlt = y[e] - mean; q += dlt * dlt; }
    q += __shfl_xor(q, 1); q += __shfl_xor(q, 2); float rs = rsqrtf(q * (1.f / 64.f) + 64e-5f);
    float bon = BON[(size_t)row * 16 + hd] + BON[(size_t)(R_ + row) * 16 + hd];
    float o[16];
#pragma unroll
    for (int e = 0; e < 16; e++) { float yn = (y[e] - mean) * rs * lg[ch + e] + lb[ch + e]; o[e] = (yn + bon * v[e]) * siluf(z[e]); }
#pragma unroll
    for (int i = 0; i < 2; i++)
      *(uint4*)(Y + (size_t)row * 1024 + ch + i * 8) = uint4{pk2(o[i * 8], o[i * 8 + 1]), pk2(o[i * 8 + 2], o[i * 8 + 3]), pk2(o[i * 8 + 4], o[i * 8 + 5]), pk2(o[i * 8 + 6], o[i * 8 + 7])};
  }
}

#define QS 136
#define VS 72
#define MLG_BYTES 45056
__device__ __forceinline__ void ph_ml_scan(const P& p, int j, char* smem0) {
  const int d = ltid() >> 8;
  char* smem = smem0 + d * MLG_BYTES;
  bfr* sQ = (bfr*)smem; bfr* sK = sQ + 64 * QS; bfr* sVT = sK + 64 * QS; bfr* sCT = sVT + 16 * VS;
  float* sN = (float*)(sCT + 16 * QS);
  float* sEs = sN + 128; float* sCt = sEs + 64; float* sBc = sCt + 64; float* sWg = sBc + 64; float* sNr = sWg + 64; bfr* sNb = (bfr*)(sNr + 256);
  const bfr* QKV = (const bfr*)(p.ACT + A_QKV); const float* GT = (const float*)(p.ACT + A_GATE); bfr* HS = (bfr*)(p.ACT + A_HS);
  const float* gbias = p.ml_gate_b + (size_t)j * 32;
  const int tid = ltid() & 255, lane = tid & 63, w = tid >> 6, l15 = lane & 15, q4 = lane >> 4;
  for (int it = blockIdx.x; it < 256; it += gridDim.x) {
    const int b = it >> 7, hh = (it >> 4) & 7, sl = it & 15;
    f32x4 Cacc[2];
    Cacc[0] = f32x4{0.f, 0.f, 0.f, 0.f}; Cacc[1] = f32x4{0.f, 0.f, 0.f, 0.f};
    float mcur = 0.f;
    for (int i = tid; i < 16 * QS; i += 256) sCT[i] = 0;
    if (tid < 128) { sN[tid] = 0.f; sNb[tid] = 0; }
    uint4 pq0, pq1, pq2, pq3, pk0, pk1, pk2, pk3, pv = uint4{0u, 0u, 0u, 0u}; float pgi, pgf;
#define ML_ROW0(s_) (d == 0 ? b * BT_ + 64 * (s_) : rowmap(1, b, 64 * (s_) + 63))
#define ML_LD(i_, PQ, PK) { int idx = tid + 256 * (i_), rho = idx >> 4, c8 = idx & 15; const bfr* src = QKV + (size_t)(r0n + rho) * 4096 + hh * 128 + c8 * 8; PQ = *(const uint4*)src; PK = *(const uint4*)(src + 1024); }
#define ML_ISSUE(s_) { const int r0n = ML_ROW0(s_); ML_LD(0, pq0, pk0) ML_LD(1, pq1, pk1) ML_LD(2, pq2, pk2) ML_LD(3, pq3, pk3) \
      if (tid < 128) pv = *(const uint4*)(QKV + (size_t)(r0n + (tid >> 1)) * 4096 + 2048 + hh * 256 + sl * 16 + (tid & 1) * 8); \
      { const float* gp_ = GT + (size_t)(r0n + (d ? 63 - lane : lane)) * 32 + d * 16 + hh; pgi = gp_[0]; pgf = gp_[8]; } }
#define ML_ST(i_, PQ, PK) { int idx = tid + 256 * (i_), rho = idx >> 4, c8 = idx & 15; *(uint4*)(sQ + rho * QS + c8 * 8) = PQ; *(uint4*)(sK + rho * QS + c8 * 8) = PK; }
#define ML_COMMIT() { ML_ST(0, pq0, pk0) ML_ST(1, pq1, pk1) ML_ST(2, pq2, pk2) ML_ST(3, pq3, pk3) \
      if (tid < 128) { int rho = tid >> 1, vb = (tid & 1) * 8; \
        sVT[(vb + 0) * VS + rho] = (bfr)(pv.x & 0xffff); sVT[(vb + 1) * VS + rho] = (bfr)(pv.x >> 16); \
        sVT[(vb + 2) * VS + rho] = (bfr)(pv.y & 0xffff); sVT[(vb + 3) * VS + rho] = (bfr)(pv.y >> 16); \
        sVT[(vb + 4) * VS + rho] = (bfr)(pv.z & 0xffff); sVT[(vb + 5) * VS + rho] = (bfr)(pv.z >> 16); \
        sVT[(vb + 6) * VS + rho] = (bfr)(pv.w & 0xffff); sVT[(vb + 7) * VS + rho] = (bfr)(pv.w >> 16); } }
    ML_ISSUE(0)
    __syncthreads();
    for (int s = 0; s < NCH_; s++) {
      const int r0 = ML_ROW0(s);
      ML_COMMIT()
      float mxl, decay;
      {
        int rho = d ? 63 - lane : lane;
        float gi = pgi + gbias[(d * 2 + 0) * 8 + hh], gf = pgf + gbias[(d * 2 + 1) * 8 + hh];
        float fc = fminf(gf, 0.f) - __logf(1.f + __expf(-fabsf(gf)));
        float bc = fc;
        for (int o = 1; o < 64; o <<= 1) { float t = __shfl_up(bc, o); if (lane >= o) bc += t; }
        float e = gi - bc, pm = e;
        for (int o = 1; o < 64; o <<= 1) { float t = __shfl_up(pm, o); if (lane >= o) pm = fmaxf(pm, t); }
        float pml = __shfl(pm, 63), bcl = __shfl(bc, 63);
        mxl = fmaxf(mcur, pml); decay = __expf(mcur - mxl);
        if (w == 0) { sEs[rho] = __expf(fminf(e, 80.f)); sCt[rho] = -fmaxf(mcur, pm); sBc[rho] = bc; sWg[rho] = __expf(e - mxl); }
        pml = bcl + mxl;
        bcl = mcur; mcur = pml; pml = bcl;
        mxl = pml;
      }
      const float mold = mxl;
      __syncthreads();
      const int rt = 16 * w + l15;
      bfr* hp = HS + (size_t)(r0 + rt) * 2048 + hh * 256 + sl * 16 + 4 * q4;
      bool first; { int rc = (r0 - b * BT_) >> 6; if (d == 0) { int sp = rc < 4 ? 3 - rc : 263 - rc; first = s < sp; } else first = s < rc; }
      unsigned long long uu = 0ull;
      if (!first) uu = __hip_atomic_load((unsigned long long*)hp, __ATOMIC_RELAXED, __HIP_MEMORY_SCOPE_AGENT);
      if (s + 1 < NCH_) ML_ISSUE(s + 1)
      bf16x8 qf[4];
#pragma unroll
      for (int ks = 0; ks < 4; ks++) qf[ks] = *(const bf16x8*)(sQ + (16 * w + l15) * QS + ks * 32 + q4 * 8);
      f32x4 sacc[4];
#pragma unroll
      for (int a = 0; a < 4; a++) { sacc[a] = f32x4{0.f, 0.f, 0.f, 0.f};
#pragma unroll
        for (int ks = 0; ks < 4; ks++) { bf16x8 kf = *(const bf16x8*)(sK + (16 * a + l15) * QS + ks * 32 + q4 * 8); sacc[a] = __builtin_amdgcn_mfma_f32_16x16x32_bf16(kf, qf[ks], sacc[a], 0, 0, 0); } }
      const float ctt = sCt[rt]; const float ect = __expf(ctt); float densum = 0.f;
#pragma unroll
      for (int a = 0; a < 4; a++) { const float4 ex4 = *(const float4*)(sEs + 16 * a + 4 * q4); const float exv[4] = {ex4.x, ex4.y, ex4.z, ex4.w};
#pragma unroll
        for (int jj = 0; jj < 4; jj++) { int rs_ = 16 * a + 4 * q4 + jj; bool valid = d == 0 ? rs_ <= rt : rs_ >= rt;
          float wv = valid ? ect * exv[jj] : 0.f; float sv = sacc[a][jj] * wv; sacc[a][jj] = sv; densum += sv; } }
      densum += __shfl_xor(densum, 16); densum += __shfl_xor(densum, 32);
      bf16x8 sf[2], vf[2];
#pragma unroll
      for (int ks = 0; ks < 2; ks++) {
#pragma unroll
        for (int jj = 0; jj < 4; jj++) { sf[ks][jj] = (short)f2b(sacc[2 * ks][jj]); sf[ks][4 + jj] = (short)f2b(sacc[2 * ks + 1][jj]); }
        uint2 v0 = *(const uint2*)(sVT + l15 * VS + 32 * ks + 4 * q4), v1 = *(const uint2*)(sVT + l15 * VS + 32 * ks + 16 + 4 * q4);
        uint4 vv = uint4{v0.x, v0.y, v1.x, v1.y}; vf[ks] = *(bf16x8*)&vv;
      }
      f32x4 num = f32x4{0.f, 0.f, 0.f, 0.f}, numC = f32x4{0.f, 0.f, 0.f, 0.f};
#pragma unroll
      for (int ks = 0; ks < 2; ks++) num = __builtin_amdgcn_mfma_f32_16x16x32_bf16(vf[ks], sf[ks], num, 0, 0, 0);
#pragma unroll
      for (int ks = 0; ks < 4; ks++) { bf16x8 cf = *(const bf16x8*)(sCT + l15 * QS + ks * 32 + q4 * 8); numC = __builtin_amdgcn_mfma_f32_16x16x32_bf16(cf, qf[ks], numC, 0, 0, 0); }
      f32x4 qnacc = f32x4{0.f, 0.f, 0.f, 0.f};
#pragma unroll
      for (int ks = 0; ks < 4; ks++) { bf16x8 na = bf16x8{0, 0, 0, 0, 0, 0, 0, 0}; if (l15 == 0) na = *(const bf16x8*)(sNb + ks * 32 + q4 * 8);
        qnacc = __builtin_amdgcn_mfma_f32_16x16x32_bf16(na, qf[ks], qnacc, 0, 0, 0); }
      const float qn = __shfl(qnacc[0], l15);
      {
        float inter = __expf(mold + ctt); float den = densum + inter * qn; float dn = fmaxf(fabsf(den), __expf(ctt - sBc[rt])); float inv = __builtin_amdgcn_rcpf(dn);
        f32x4 hv;
#pragma unroll
        for (int jj = 0; jj < 4; jj++) hv[jj] = (num[jj] + inter * numC[jj]) * inv;
        if (!first) { unsigned ux = (unsigned)uu, uy = (unsigned)(uu >> 32);
          hv[0] += blo(ux); hv[1] += bhi(ux); hv[2] += blo(uy); hv[3] += bhi(uy); }
        store4b(hp, hv);
      }
      __syncthreads();
      {
        bf16x8 vw[2], wa[2];
#pragma unroll
        for (int ks = 0; ks < 2; ks++)
#pragma unroll
          for (int e = 0; e < 8; e++) { int rs_ = 32 * ks + (e < 4 ? 4 * q4 + e : 16 + 4 * q4 + e - 4); const float wg_ = sWg[rs_]; vw[ks][e] = (short)f2b(b2f((bfr)vf[ks][e]) * wg_); wa[ks][e] = l15 == 0 ? (short)f2b(wg_) : (short)0; }
#pragma unroll
        for (int a = 0; a < 2; a++) {
          int dk = 32 * w + 16 * a + l15;
#pragma unroll
          for (int jj = 0; jj < 4; jj++) Cacc[a][jj] *= decay;
          f32x4 nacc = f32x4{0.f, 0.f, 0.f, 0.f};
#pragma unroll
          for (int ks = 0; ks < 2; ks++) { bf16x8 kt;
#pragma unroll
            for (int e = 0; e < 8; e++) { int rs_ = 32 * ks + (e < 4 ? 4 * q4 + e : 16 + 4 * q4 + e - 4); kt[e] = (short)sK[rs_ * QS + dk]; }
            Cacc[a] = __builtin_amdgcn_mfma_f32_16x16x32_bf16(vw[ks], kt, Cacc[a], 0, 0, 0);
            nacc = __builtin_amdgcn_mfma_f32_16x16x32_bf16(wa[ks], kt, nacc, 0, 0, 0); }
          if (q4 == 0) sNr[dk] = nacc[0];
#pragma unroll
          for (int jj = 0; jj < 4; jj++) sCT[(4 * q4 + jj) * QS + dk] = f2b(Cacc[a][jj]);
        }
      }
      __syncthreads();
      if (tid < 128) { const float nv = decay * sN[tid] + sNr[tid]; sN[tid] = nv; sNb[tid] = f2b(nv); }
    }
    __syncthreads();
  }
}

#define CS 72
#define CSLOT(i_) ((bfr*)smem + (i_) * (64 * CS))
#define A_SST (A_R7B + 362086400ull)
__device__ __forceinline__ f32x4 cmm(const bfr* X, const bfr* YT, int ti, int tj, int l15, int q4) {
  f32x4 acc = f32x4{0.f, 0.f, 0.f, 0.f};
#pragma unroll
  for (int ks = 0; ks < 2; ks++) { bf16x8 a = *(const bf16x8*)(X + (16 * ti + l15) * CS + 32 * ks + 8 * q4); bf16x8 b = *(const bf16x8*)(YT + (16 * tj + l15) * CS + 32 * ks + 8 * q4);
    acc = __builtin_amdgcn_mfma_f32_16x16x32_bf16(a, b, acc, 0, 0, 0); }
  return acc;
}
template <int MODE> __device__ __forceinline__ f32x4 cmm_mask(const bfr* X, const bfr* YT, int ti, int tj, int l15, int q4) {
  f32x4 acc = f32x4{0.f, 0.f, 0.f, 0.f};
#pragma unroll
  for (int ks = 0; ks < 2; ks++) { const int kb = 2 * ks + (q4 >> 1);
    const bool ok = MODE == 1 ? ((kb == 0 && tj == 1) || (kb == 2 && tj == 3)) : (kb < 2 && tj >= 2);
    bf16x8 a = *(const bf16x8*)(X + (16 * ti + l15) * CS + 32 * ks + 8 * q4); bf16x8 bz = bf16x8{0, 0, 0, 0, 0, 0, 0, 0};
    if (ok) bz = *(const bf16x8*)(YT + (16 * tj + l15) * CS + 32 * ks + 8 * q4);
    acc = __builtin_amdgcn_mfma_f32_16x16x32_bf16(a, bz, acc, 0, 0, 0); }
  return acc;
}
__device__ __forceinline__ void st_row(bfr* dst, int r0, int c, f32x4 v) {
#pragma unroll
  for (int jj = 0; jj < 4; jj++) dst[(r0 + jj) * CS + c] = f2b(v[jj]); }
__device__ __forceinline__ void st_tr(bfr* dst, int r0, int c, f32x4 v) { store4b(dst + c * CS + r0, v); }
__device__ __forceinline__ f32x4 ld_row(const bfr* src, int r0, int c) { f32x4 v;
#pragma unroll
  for (int jj = 0; jj < 4; jj++) v[jj] = b2f(src[(r0 + jj) * CS + c]);
  return v; }
__device__ __forceinline__ f32x4 ld_tr(const bfr* src, int r0, int c) { uint2 u = *(const uint2*)(src + c * CS + r0); return f32x4{blo(u.x), bhi(u.x), blo(u.y), bhi(u.y)}; }

__device__ __forceinline__ void ph_r7_ca(const P& p, int j, int win, char* smem) {
  float* LW = (float*)(smem + 7 * 9216); float* AT = (float*)(smem + 9 * 9216); float* WL = (float*)(smem + 14 * 9216);
  const bfr* RK = (const bfr*)(p.ACT + A_RKVZ); const bfr* WMb = (const bfr*)(p.ACT + A_WM); const bfr* AMb = (const bfr*)(p.ACT + A_AM);
  float* BON = (float*)(p.ACT + A_BON); bfr* WB = p.H;
  const float* kkp = p.r7_k_k + (size_t)j * 1024; const float* kap = p.r7_k_a + (size_t)j * 1024; const float* rkp = p.r7_r_k + (size_t)j * 1024;
  const int tid = ltid(), lane = tid & 63, w = tid >> 6, l15 = lane & 15, q4 = lane >> 4, ti = w >> 1, tj0 = (w & 1) * 2;
  const int c0 = win * 20;
  for (int it = blockIdx.x; it < 1280; it += gridDim.x) {
    const int chain = it / 20, cl = it - chain * 20, c = c0 + cl, d = chain & 1, b = chain >> 5, h = (chain >> 1) & 15;
    {
      const int rowA = rowmap(d, b, 64 * c + 16 * ti + l15);
      const float* w0 = p.r7_w0 + (size_t)(j * 2 + d) * 1024 + h * 64; const float* a0 = p.r7_a0 + (size_t)(j * 2 + d) * 1024 + h * 64;
#pragma unroll
      for (int tt = 0; tt < 2; tt++) { const int tj = tj0 + tt; f32x4 aw = f32x4{0.f, 0.f, 0.f, 0.f}, aa = aw;
#pragma unroll
        for (int ks = 0; ks < 2; ks++) {
          bf16x8 xw = *(const bf16x8*)(WMb + (size_t)rowA * 128 + d * 64 + 32 * ks + 8 * q4), xa = *(const bf16x8*)(AMb + (size_t)rowA * 128 + d * 64 + 32 * ks + 8 * q4);
          bf16x8 yw = *(const bf16x8*)(p.W + WR_UP + d * 65536 + (size_t)(h * 64 + 16 * tj + l15) * 64 + 32 * ks + 8 * q4);
          bf16x8 ya = *(const bf16x8*)(p.W + WR_UP + (2 + d) * 65536 + (size_t)(h * 64 + 16 * tj + l15) * 64 + 32 * ks + 8 * q4);
          aw = __builtin_amdgcn_mfma_f32_16x16x32_bf16(xw, yw, aw, 0, 0, 0); aa = __builtin_amdgcn_mfma_f32_16x16x32_bf16(xa, ya, aa, 0, 0, 0); }
        const int ch = 16 * tj + l15; const float w0v = w0[ch], a0v = a0[ch];
#pragma unroll
        for (int jj = 0; jj < 4; jj++) { const int tau = 16 * ti + 4 * q4 + jj; LW[tau * 64 + ch] = -0.6065306597126334f * sigm(w0v + aw[jj]); AT[tau * 64 + ch] = sigm(a0v + aa[jj]); }
      }
    }
    __syncthreads();
    if (tid < 64) { float acc = 0.f;
#pragma unroll 8
      for (int t = 0; t < 64; t++) { acc += LW[t * 64 + tid]; LW[t * 64 + tid] = acc; } }
    __syncthreads();
    {
      const int tau = tid >> 3, sc = tid & 7, col = h * 64 + sc * 8; const int row = rowmap(d, b, 64 * c + tau);
      const bfr* rp = RK + (size_t)row * 4096 + col; uint4 pr = *(const uint4*)rp, pk = *(const uint4*)(rp + 1024);
      unsigned ur[4] = {pr.x, pr.y, pr.z, pr.w}, uk[4] = {pk.x, pk.y, pk.z, pk.w};
      float r8[8], k8[8], kr[8];
#pragma unroll
      for (int e = 0; e < 4; e++) { r8[2 * e] = blo(ur[e]); r8[2 * e + 1] = bhi(ur[e]); k8[2 * e] = blo(uk[e]); k8[2 * e + 1] = bhi(uk[e]); }
      float ss = 0.f;
#pragma unroll
      for (int e = 0; e < 8; e++) { kr[e] = k8[e] * kkp[col + e]; ss += kr[e] * kr[e]; }
      ss += __shfl_xor(ss, 1); ss += __shfl_xor(ss, 2); ss += __shfl_xor(ss, 4);
      const float inv = __builtin_amdgcn_rsqf(fmaxf(ss, 1e-24f));
      float bon = 0.f, o0[8], o1[8], o2[8], o3[8], o4[8], o5[8];
#pragma unroll
      for (int e = 0; e < 8; e++) {
        const float cw = LW[tau * 64 + sc * 8 + e], cwm = tau > 0 ? LW[(tau - 1) * 64 + sc * 8 + e] : 0.f, cwl = LW[63 * 64 + sc * 8 + e], a = AT[tau * 64 + sc * 8 + e];
        const float ka = kr[e] * inv, be = a * ka, kd = k8[e] * (1.f + (a - 1.f) * kap[col + e]); bon += r8[e] * kd * rkp[col + e];
        const float e2 = __expf(-cw), e4 = __expf(cwl - cw);
        o0[e] = ka * __expf(cwm); o1[e] = be * e2; o2[e] = kd * e2; o3[e] = r8[e] * __expf(cw); o4[e] = be * e4; o5[e] = kd * e4;
        if (tau == 63) WL[sc * 8 + e] = __expf(cwl);
      }
      bon += __shfl_xor(bon, 1); bon += __shfl_xor(bon, 2); bon += __shfl_xor(bon, 4);
      if (sc == 0) BON[((size_t)d * R_ + row) * 16 + h] = bon;
      *(uint4*)(CSLOT(0) + tau * CS + sc * 8) = uint4{pk2(o0[0], o0[1]), pk2(o0[2], o0[3]), pk2(o0[4], o0[5]), pk2(o0[6], o0[7])};
      *(uint4*)(CSLOT(1) + tau * CS + sc * 8) = uint4{pk2(o1[0], o1[1]), pk2(o1[2], o1[3]), pk2(o1[4], o1[5]), pk2(o1[6], o1[7])};
      *(uint4*)(CSLOT(2) + tau * CS + sc * 8) = uint4{pk2(o2[0], o2[1]), pk2(o2[2], o2[3]), pk2(o2[4], o2[5]), pk2(o2[6], o2[7])};
      *(uint4*)(CSLOT(3) + tau * CS + sc * 8) = uint4{pk2(o3[0], o3[1]), pk2(o3[2], o3[3]), pk2(o3[4], o3[5]), pk2(o3[6], o3[7])};
#pragma unroll
      for (int e = 0; e < 8; e++) { CSLOT(4)[(sc * 8 + e) * CS + tau] = f2b(o0[e]); CSLOT(5)[(sc * 8 + e) * CS + tau] = f2b(o4[e]); CSLOT(6)[(sc * 8 + e) * CS + tau] = f2b(o5[e]); }
    }
    __syncthreads();
#pragma unroll
    for (int tt = 0; tt < 2; tt++) { const int tj = tj0 + tt, r0 = 16 * ti + 4 * q4, cc = 16 * tj + l15;
      f32x4 v = cmm(CSLOT(1), CSLOT(0), ti, tj, l15, q4);
#pragma unroll
      for (int jj = 0; jj < 4; jj++) if (!(r0 + jj < cc)) v[jj] = 0.f;
      st_row(CSLOT(7), r0, cc, v); st_tr(CSLOT(8), r0, cc, v);
      v = cmm(CSLOT(2), CSLOT(0), ti, tj, l15, q4);
#pragma unroll
      for (int jj = 0; jj < 4; jj++) if (!(r0 + jj < cc)) v[jj] = 0.f;
      st_row(CSLOT(9), r0, cc, v);
      v = cmm(CSLOT(3), CSLOT(1), ti, tj, l15, q4);
#pragma unroll
      for (int jj = 0; jj < 4; jj++) if (!(cc <= r0 + jj)) v[jj] = 0.f;
      st_row(CSLOT(10), r0, cc, v);
      v = cmm(CSLOT(3), CSLOT(2), ti, tj, l15, q4);
#pragma unroll
      for (int jj = 0; jj < 4; jj++) if (!(cc <= r0 + jj)) v[jj] = 0.f;
      st_row(CSLOT(11), r0, cc, v);
    }
    __syncthreads();
    {
      float* X = (float*)CSLOT(0);
      const bfr* Ab = CSLOT(7);
      const int cl = lane >> 3, pp = lane & 7, cx = 8 * w + cl, blk0 = (w >> 1) * 16;
#pragma unroll 1
      for (int il = 15; il >= 0; il--) { const int i = blk0 + il;
        float sum = 0.f;
#pragma unroll 1
        for (int jx = i + 1 + pp; jx < blk0 + 16; jx += 8) sum += b2f(Ab[i * CS + jx]) * X[jx * 72 + cx];
        sum += dppf<0xB1>(sum); sum += dppf<0x4E>(sum); sum += dppf<0x141>(sum);
        const float xv = (i == cx ? 1.f : 0.f) - sum;
        if (pp == 0) X[i * 72 + cx] = xv;
      }
      __syncthreads();
#pragma unroll 1
      for (int e = tid; e < 4096; e += 512) { const int i = e >> 6, c2 = e & 63; const bfr tv = ((i >> 4) == (c2 >> 4)) ? f2b(X[i * 72 + c2]) : (bfr)0; CSLOT(2)[i * CS + c2] = tv; CSLOT(12)[c2 * CS + i] = tv; }
      __syncthreads();
#pragma unroll
      for (int tt = 0; tt < 2; tt++) { const int tj = tj0 + tt, r0 = 16 * ti + 4 * q4, cc = 16 * tj + l15; st_row(CSLOT(13), r0, cc, cmm_mask<1>(CSLOT(2), CSLOT(8), ti, tj, l15, q4)); }
      __syncthreads();
#pragma unroll
      for (int tt = 0; tt < 2; tt++) { const int tj = tj0 + tt, r0 = 16 * ti + 4 * q4, cc = 16 * tj + l15;
        f32x4 v = ld_row(CSLOT(2), r0, cc) - cmm(CSLOT(13), CSLOT(12), ti, tj, l15, q4); st_row(CSLOT(0), r0, cc, v); st_tr(CSLOT(1), r0, cc, v); }
      __syncthreads();
#pragma unroll
      for (int tt = 0; tt < 2; tt++) { const int tj = tj0 + tt, r0 = 16 * ti + 4 * q4, cc = 16 * tj + l15; st_row(CSLOT(13), r0, cc, cmm_mask<2>(CSLOT(0), CSLOT(8), ti, tj, l15, q4)); }
      __syncthreads();
#pragma unroll
      for (int tt = 0; tt < 2; tt++) { const int tj = tj0 + tt, r0 = 16 * ti + 4 * q4, cc = 16 * tj + l15;
        f32x4 v = ld_row(CSLOT(0), r0, cc) - cmm(CSLOT(13), CSLOT(1), ti, tj, l15, q4);
#pragma unroll
        for (int jj = 0; jj < 4; jj++) if (r0 + jj == cc) v[jj] -= 1.f;
        st_row(CSLOT(2), r0, cc, v); }
      __syncthreads();
    }
#pragma unroll
    for (int tt = 0; tt < 2; tt++) { const int tj = tj0 + tt, r0 = 16 * ti + 4 * q4, cc = 16 * tj + l15;
      f32x4 g = cmm(CSLOT(10), CSLOT(2), ti, tj, l15, q4) + ld_row(CSLOT(10), r0, cc); st_row(CSLOT(12), r0, cc, g);
      f32x4 hh = cmm(CSLOT(5), CSLOT(2), ti, tj, l15, q4) + ld_row(CSLOT(5), r0, cc); st_row(CSLOT(13), r0, cc, hh); }
    __syncthreads();
    {
      bfr* out = WB + (size_t)(chain * 20 + cl) * 16384;
#pragma unroll
      for (int tt = 0; tt < 2; tt++) { const int tj = tj0 + tt, r0 = 16 * ti + 4 * q4, cc = 16 * tj + l15;
        f32x4 v = ld_tr(CSLOT(3), r0, cc) - cmm(CSLOT(4), CSLOT(12), ti, tj, l15, q4);
        store4b(out + cc * 64 + r0, v);
        v = ld_tr(CSLOT(11), r0, cc) - cmm(CSLOT(9), CSLOT(12), ti, tj, l15, q4);
        store4b(out + 4096 + cc * 64 + r0, v);
        v = -cmm(CSLOT(4), CSLOT(13), ti, tj, l15, q4);
#pragma unroll
        for (int jj = 0; jj < 4; jj++) if (r0 + jj == cc) v[jj] += WL[cc];
        store4b(out + 8192 + cc * 64 + r0, v);
        v = ld_tr(CSLOT(6), r0, cc) - cmm(CSLOT(9), CSLOT(13), ti, tj, l15, q4);
        store4b(out + 12288 + cc * 64 + r0, v);
      }
    }
    __syncthreads();
  }
}

__device__ __forceinline__ void ph_r7_cb(const P& p, int win, char* smem) {
  bfr* Sh = (bfr*)smem; bfr* Sl = Sh + 2 * 16 * CS; bfr* VT = Sl + 2 * 16 * CS;
  const bfr* WB = p.H; const bfr* RK = (const bfr*)(p.ACT + A_RKVZ); bfr* SST = (bfr*)(p.ACT + A_SST);
  const int tid = ltid(), lane = tid & 63, w = tid >> 6, l15 = lane & 15, q4 = lane >> 4;
  const int c0 = win * 20;
  for (int it = blockIdx.x; it < 256; it += gridDim.x) {
    const int d = it & 1, b = it >> 7, h = (it >> 3) & 15, rg = (it >> 1) & 3, chain = (b * 16 + h) * 2 + d;
    bfr* Y = d ? R7_Y2 : (bfr*)(p.ACT + A_Y);
    bfr* sst = SST + (size_t)(chain * 4 + rg) * 2048;
    __syncthreads();
    if (tid < 256) { const int hl = tid >> 7, e = tid & 127, rr = e >> 3, c8 = e & 7; uint4 v = uint4{0u, 0u, 0u, 0u};
      if (win > 0) v = *(const uint4*)(sst + hl * 1024 + rr * 64 + c8 * 8);
      *(uint4*)((hl ? Sl : Sh) + rr * CS + c8 * 8) = v; }
    const int vtau = tid >> 3, vp = tid & 7;
    { const int row = rowmap(d, b, 64 * c0 + vtau); unsigned vv = *(const unsigned*)(RK + (size_t)row * 4096 + 2048 + h * 64 + rg * 16 + 2 * vp);
      VT[(2 * vp) * CS + vtau] = (bfr)(vv & 0xffff); VT[(2 * vp + 1) * CS + vtau] = (bfr)(vv >> 16); }
    const bfr* bbase = WB + (size_t)(chain * 20) * 16384 + (w < 4 ? 8192 + (16 * w + l15) * 64 : (16 * (w - 4) + l15) * 64) + 8 * q4;
    bf16x8 rb1[4][2], rb2[4][2]; unsigned rv[4];
#define CB_LOAD(u_, s_) { const int ss_ = (s_) < 20 ? (s_) : 19; const bfr* bp_ = bbase + (size_t)ss_ * 16384; \
      rb1[u_][0] = *(const bf16x8*)bp_; rb1[u_][1] = *(const bf16x8*)(bp_ + 32); rb2[u_][0] = *(const bf16x8*)(bp_ + 4096); rb2[u_][1] = *(const bf16x8*)(bp_ + 4096 + 32); \
      const int sv_ = ss_ + 1 < 20 ? ss_ + 1 : 19; const int rowv_ = rowmap(d, b, 64 * (c0 + sv_) + vtau); \
      rv[u_] = *(const unsigned*)(RK + (size_t)rowv_ * 4096 + 2048 + h * 64 + rg * 16 + 2 * vp); }
    CB_LOAD(0, 0) CB_LOAD(1, 1) CB_LOAD(2, 2) CB_LOAD(3, 3)
    __syncthreads();
    for (int g = 0; g < 5; g++) {
#pragma unroll
      for (int u = 0; u < 4; u++) {
        const int s = 4 * g + u;
        if (s < 20) {
          const int cur = s & 1, nxt = cur ^ 1, c = c0 + s;
          bf16x8 sh[2], sl[2], vt[2];
#pragma unroll
          for (int ks = 0; ks < 2; ks++) { sh[ks] = *(const bf16x8*)(Sh + (cur * 16 + l15) * CS + 32 * ks + 8 * q4); sl[ks] = *(const bf16x8*)(Sl + (cur * 16 + l15) * CS + 32 * ks + 8 * q4);
            vt[ks] = *(const bf16x8*)(VT + (cur * 16 + l15) * CS + 32 * ks + 8 * q4); }
          f32x4 a1 = f32x4{0.f, 0.f, 0.f, 0.f}, a2 = a1;
#pragma unroll
          for (int ks = 0; ks < 2; ks++) { a1 = __builtin_amdgcn_mfma_f32_16x16x32_bf16(sh[ks], rb1[u][ks], a1, 0, 0, 0); a2 = __builtin_amdgcn_mfma_f32_16x16x32_bf16(vt[ks], rb2[u][ks], a2, 0, 0, 0); }
#pragma unroll
          for (int ks = 0; ks < 2; ks++) a1 = __builtin_amdgcn_mfma_f32_16x16x32_bf16(sl[ks], rb1[u][ks], a1, 0, 0, 0);
          a1 = a1 + a2;
          if (w < 4) {
#pragma unroll
            for (int jj = 0; jj < 4; jj++) { const bfr hi = f2b(a1[jj]); Sh[(nxt * 16 + 4 * q4 + jj) * CS + 16 * w + l15] = hi; Sl[(nxt * 16 + 4 * q4 + jj) * CS + 16 * w + l15] = f2b(a1[jj] - b2f(hi)); }
          } else {
            const int rowy = rowmap(d, b, 64 * c + 16 * (w - 4) + l15);
            store4b(Y + (size_t)rowy * 1024 + h * 64 + rg * 16 + 4 * q4, a1);
          }
          if (s + 1 < 20) { VT[(nxt * 16 + 2 * vp) * CS + vtau] = (bfr)(rv[u] & 0xffff); VT[(nxt * 16 + 2 * vp + 1) * CS + vtau] = (bfr)(rv[u] >> 16); }
          if (s + 4 < 20) CB_LOAD(u, s + 4)
          __syncthreads();
        }
      }
    }
    if (tid < 256) { const int hl = tid >> 7, e = tid & 127, rr = e >> 3, c8 = e & 7; *(uint4*)(sst + hl * 1024 + rr * 64 + c8 * 8) = *(const uint4*)((hl ? Sl : Sh) + rr * CS + c8 * 8); }
  }
}

__device__ __forceinline__ void run_phase(const P& p, int ph, int layer, int d, char* smem) {
  Ctx c; c.layer = layer; c.j = layer / 3; c.d = d; c.wc = layer < 3 ? 1 : 0;
  switch (ph) {
    case PH_PRE: ph_pre(p, smem); break;
    case PH_NORM: ph_norm(p, layer, smem); break;
    case PH_LRU_IN: big_gemm(smem, p.H, p.W, 2560, 1024, F_LruIn{p.ACT}); break;
    case PH_LRU_CONV: ph_lru_conv(p, c.j); break;
    case PH_LRU_GATE: gemm_phase<G_LruGate>(p, c, smem); break;
    case PH_LRU_S1: ph_lru_s1(p, d); break;
    case PH_LRU_S2: ph_lru_s2(p, smem); break;
    case PH_LRU_S3: ph_lru_s3(p, d); break;
    case PH_LRU_OUT: big_gemm(smem, (const bfr*)(p.ACT + A_Z), p.W + WL_OUT, 1024, 1280, F_Resid{p.Xx, p.Xc, p.MOD + (size_t)layer * 3 * 3072, c.wc}); break;
    case PH_ML_IN: big_gemm(smem, p.H, p.W, 4352, 1024, F_MlIn{p.ACT}); break;
    case PH_ML_SCAN: ph_ml_scan(p, c.j, smem); break;
    case PH_ML_STAT: ph_ml_stat(p); break;
    case PH_ML_Z: big_gemm(smem, p.H, p.W + WM_Z, 2048, 1024, F_MlZ{p.ACT, p.ml_norm_g + (size_t)c.j * 2048}); break;
    case PH_ML_OUT: big_gemm(smem, (const bfr*)(p.ACT + A_HS), p.W + WM_OUT, 1024, 2048, F_Resid{p.Xx, p.Xc, p.MOD + (size_t)layer * 3 * 3072, c.wc}); break;
    case PH_R7_IN: big_gemm(smem, p.H, p.W, 4352, 2048, F_R7In{p.ACT}); break;
    case PH_R7_SHIFT: ph_r7_shift(p); break;
    case PH_R7_CA: ph_r7_ca(p, c.j, d, smem); break;
    case PH_R7_CB: ph_r7_cb(p, d, smem); break;
    case PH_R7_FIN: ph_r7_fin(p, c.j); break;
    case PH_R7_OUT: big_gemm(smem, (const bfr*)(p.ACT + A_Y), p.W + WR_OUT, 1024, 1024, F_Resid{p.Xx, p.Xc, p.MOD + (size_t)layer * 3 * 3072, c.wc}); break;
    case PH_FINAL: ph_final(p); break;
  }
}


#define XB_TMO      128
#define XB_XCNT(j)  (256  + 64 * (j))
#define XB_XSUB(j)  (1280 + 64 * (j))
#define XB_XGEN(j)  (2304 + 64 * (j))
#define XB_TOP      3328
#define XB_TOPGEN   3392
#define XCD_BAR_WORDS 3456
#define XB_SPIN_CAP (1u << 18)
#define OFF_BAR 527000064ull
#define OFF_CL (OFF_BAR + 16384ull)
__device__ __forceinline__ unsigned xb_ld(unsigned* p)              { return __hip_atomic_load(p, __ATOMIC_RELAXED, __HIP_MEMORY_SCOPE_AGENT); }
__device__ __forceinline__ unsigned xb_add(unsigned* p, unsigned v) { return __hip_atomic_fetch_add(p, v, __ATOMIC_RELAXED, __HIP_MEMORY_SCOPE_AGENT); }
__device__ __forceinline__ unsigned xb_xcc_id() { return (unsigned)__builtin_amdgcn_s_getreg((3 << 11) | 20) & 0xFu; }
#define XB_SPIN(cond, bar) do { unsigned _sp = 0; while (cond) { __builtin_amdgcn_s_sleep(1); \
    if ((++_sp & 255u) == 0u) { if (xb_ld(&(bar)[XB_TMO])) break; if (_sp > XB_SPIN_CAP) { atomicAdd(&(bar)[XB_TMO], 1u); break; } } } } while (0)
struct XcdBarrier { unsigned* bar; unsigned x; volatile __attribute__((address_space(3))) unsigned* st; };
__device__ __forceinline__ XcdBarrier xcd_barrier_post(unsigned* bar, volatile __attribute__((address_space(3))) unsigned* st) {
  XcdBarrier b; b.bar = bar; b.x = xb_xcc_id(); b.st = st;
  if (threadIdx.x == 0) (void)xb_add(&bar[XB_XCNT(b.x)], 1u);
  return b;
}
__device__ __forceinline__ void xcd_barrier_complete(unsigned* bar, unsigned x, unsigned& nloc, unsigned& nx) {
  const unsigned G = gridDim.x * gridDim.y * gridDim.z;
  unsigned sum, cnt, mine, sp = 0u;
  for (;;) {
    sum = 0u; cnt = 0u; mine = 0u;
#pragma unroll
    for (unsigned j = 0; j < 16; ++j) { const unsigned c = xb_ld(&bar[XB_XCNT(j)]); sum += c; cnt += (c > 0u) ? 1u : 0u; mine = (j == x) ? c : mine; }
    if (sum == G) break;
    __builtin_amdgcn_s_sleep(1);
    if ((++sp & 255u) == 0u) { if (xb_ld(&bar[XB_TMO])) break; if (sp > XB_SPIN_CAP) { atomicAdd(&bar[XB_TMO], 1u); break; } }
  }
  nloc = mine > 0u ? mine : 1u; nx = cnt > 0u ? cnt : 1u;
}
__device__ __forceinline__ void xcd_barrier(const XcdBarrier& b) {
  asm volatile("s_waitcnt vmcnt(0)" ::: "memory");
  __syncthreads();
  if (threadIdx.x == 0) {
    unsigned* bar = b.bar;
    __builtin_amdgcn_s_waitcnt(0);
    unsigned nloc = b.st[0], nx = b.st[1];
    if (nloc == 0u) { xcd_barrier_complete(bar, b.x, nloc, nx); b.st[0] = nloc; b.st[1] = nx; }
    const unsigned old = xb_add(&bar[XB_XSUB(b.x)], 1u);
    const unsigned gen = old / nloc;
    if (old + 1u == (gen + 1u) * nloc) {
      __builtin_amdgcn_fence(__ATOMIC_RELEASE, "agent");
      asm volatile("s_waitcnt vmcnt(0)" ::: "memory");
      const unsigned og = xb_add(&bar[XB_TOP], 1u);
      const unsigned tg = og / nx;
      if (og + 1u == (tg + 1u) * nx) xb_add(&bar[XB_TOPGEN], 1u);
      else XB_SPIN(xb_ld(&bar[XB_TOPGEN]) == tg, bar);
      __builtin_amdgcn_fence(__ATOMIC_ACQUIRE, "agent");
      xb_add(&bar[XB_XGEN(b.x)], 1u);
      asm volatile("s_waitcnt vmcnt(0)" ::: "memory");
    } else {
      XB_SPIN(xb_ld(&bar[XB_XGEN(b.x)]) == gen, bar);
      __builtin_amdgcn_fence(__ATOMIC_ACQUIRE, "agent");
      asm volatile("s_waitcnt vmcnt(0)" ::: "memory");
    }
  }
  __syncthreads();
}

#define SMEM_BYTES (131072 + 64)
extern __shared__ __attribute__((aligned(16))) char dyn_smem[];
#if !MEGA
__global__ void __launch_bounds__(512, 2) phase_kernel(P p, int si) {
  run_phase(p, p.sched[si * 3], p.sched[si * 3 + 1], p.sched[si * 3 + 2], dyn_smem);
}
#else
__global__ void __launch_bounds__(512, 2) mega_kernel(P p) {
  cg::grid_group grid = cg::this_grid();
  volatile __attribute__((address_space(3))) unsigned* st = (volatile __attribute__((address_space(3))) unsigned*)(dyn_smem + 131072);
  if (threadIdx.x < 4) st[threadIdx.x] = 0u;
  __syncthreads();
  const XcdBarrier xb = xcd_barrier_post(p.bar, st);
  for (int si = 0; si < p.nsched; si++) {
    run_phase(p, p.sched[si * 3], p.sched[si * 3 + 1], p.sched[si * 3 + 2], dyn_smem);
    if (si + 1 < p.nsched) { if (si == 0) grid.sync(); else xcd_barrier(xb); }
  }
}
#endif

extern "C" void kernel_launch(void* const* d_in, const int* in_sizes, int n_in, void* d_out, int out_size, void* d_ws, size_t ws_size, hipStream_t stream) {
  P p; memset(&p, 0, sizeof(p));
  const float** f = (const float**)&p;
  for (int i = 0; i < 33; i++) f[i] = (const float*)d_in[i];
  char* ws = (char*)d_ws;
  p.Xx = (float*)d_out; p.Xc = (float*)(ws + OFF_XC); p.MOD = (float*)(ws + OFF_MOD); p.W = (bfr*)(ws + OFF_W); p.H = (bfr*)(ws + OFF_H); p.ACT = ws + OFF_ACT; p.bar = (unsigned*)(ws + OFF_BAR); p.CL = (float*)(ws + OFF_CL);
  int n = 0;
  auto add = [&](int ph, int layer, int d) { p.sched[n * 3] = ph; p.sched[n * 3 + 1] = layer; p.sched[n * 3 + 2] = d; n++; };
  add(PH_PRE, 0, 0);
  if (DUP & 4) add(PH_PRE, 0, 0);
  for (int l = 0; l < 4; l++) {
    add(PH_NORM, l, 0); if (DUP & 4) add(PH_NORM, l, 0);
    int kind = l % 3;
    const bool dg = DUP & 1, ds = DUP & 2;
    if (kind == 0) { add(PH_LRU_IN, l, 0); if (dg) add(PH_LRU_IN, l, 0); add(PH_LRU_CONV, l, 0); if (DUP & 4) add(PH_LRU_CONV, l, 0);
      for (int d = 0; d < 2; d++) { add(PH_LRU_GATE, l, d); if (dg) add(PH_LRU_GATE, l, d); add(PH_LRU_S1, l, d); if (DUP & 8) add(PH_LRU_S1, l, d); add(PH_LRU_S2, l, d); if (DUP & 16) add(PH_LRU_S2, l, d); add(PH_LRU_S3, l, d); }
      add(PH_LRU_OUT, l, 0); }
    else if (kind == 1) { add(PH_ML_IN, l, 0); if (dg) add(PH_ML_IN, l, 0); add(PH_ML_SCAN, l, 0); if (ds) add(PH_ML_SCAN, l, 0); add(PH_ML_STAT, l, 0); if (DUP & 4) add(PH_ML_STAT, l, 0); add(PH_ML_Z, l, 0); add(PH_ML_OUT, l, 0); }
    else { add(PH_R7_SHIFT, l, 0); add(PH_R7_IN, l, 0); if (dg) add(PH_R7_IN, l, 0); for (int wi = 0; wi < 13; wi++) { add(PH_R7_CA, l, wi); if (DUP & 32) add(PH_R7_CA, l, wi); add(PH_R7_CB, l, wi); } add(PH_R7_FIN, l, 0); add(PH_R7_OUT, l, 0); }
  }
  add(PH_FINAL, 0, 0);
  p.nsched = n;
  if (ws_size < WS_NEED) fprintf(stderr, "workspace too small: %zu < %llu\n", ws_size, (unsigned long long)WS_NEED);
#if MEGA
  static int grid_blocks = 0;
  if (!grid_blocks) { int dev = 0, cus = 0, per = 0; hipGetDevice(&dev); hipDeviceGetAttribute(&cus, hipDeviceAttributeMultiprocessorCount, dev);
    hipFuncSetAttribute((const void*)mega_kernel, hipFuncAttributeMaxDynamicSharedMemorySize, SMEM_BYTES);
    hipOccupancyMaxActiveBlocksPerMultiprocessor(&per, mega_kernel, 512, SMEM_BYTES); if (per > 1) per = 1; if (per < 1) per = 1; grid_blocks = cus * per; }
  hipMemsetAsync(ws + OFF_BAR, 0, XCD_BAR_WORDS * 4, stream);
  void* args[] = {&p};
  hipError_t e = hipLaunchCooperativeKernel((void*)mega_kernel, dim3(grid_blocks), dim3(512), args, SMEM_BYTES, stream);
  if (e != hipSuccess) fprintf(stderr, "cooperative launch failed: %s (grid %d)\n", hipGetErrorString(e), grid_blocks);
#else
  static int once = 0; if (!once) { once = 1; hipFuncSetAttribute((const void*)phase_kernel, hipFuncAttributeMaxDynamicSharedMemorySize, SMEM_BYTES); }
  for (int si = 0; si < n; si++) phase_kernel<<<256, 512, SMEM_BYTES, stream>>>(p, si);
#endif
}
```

```cpp
#include <hip/hip_runtime.h>
#include <hip/hip_bf16.h>
#include <hip/hip_cooperative_groups.h>
#include <cstdio>
#include <cstring>
#include <type_traits>
namespace cg = cooperative_groups;

#ifndef DUP
#define DUP 0
#endif
#ifndef MEGA
#define MEGA 1
#endif

typedef unsigned short bfr;
using bf16x8 = __attribute__((ext_vector_type(8))) short;
using f32x4 = __attribute__((ext_vector_type(4))) float;

#define R_ 33280
#define BT_ 16640
#define NCH_ 260

#define OFF_XC 0ull
#define OFF_MOD 2097152ull
#define OFF_W 2244608ull
#define OFF_H 24264704ull
#define OFF_ACT 92422144ull
#define A_Z 0ull
#define A_UC 85196800ull
#define A_AB 170393600ull
#define A_U 170393600ull
#define A_HF 340787200ull
#define A_AGG 425984000ull
#define A_CAR 431308800ull
#define A_QKV 0ull
#define A_GATE 272629760ull
#define A_HS 276889600ull
#define A_RSTD 413204480ull
#define A_R7B 68157440ull
#define A_RKVZ (A_R7B + 0ull)
#define A_WM (A_R7B + 272629760ull)
#define A_AM (A_R7B + 281149440ull)
#define A_BON (A_R7B + 289669120ull)
#define A_Y (A_R7B + 293928960ull)
#define WS_NEED (527000064ull + 16384ull)

#define WL_GATE (2560 * 1024)
#define WL_OUT (WL_GATE + 1310720)
#define WM_Z (4352 * 1024)
#define WM_OUT (WM_Z + 2048 * 1024)
#define WR_UP (4352 * 2048)
#define WR_OUT (WR_UP + 262144)

enum { PH_PRE = 0, PH_NORM, PH_LRU_IN, PH_LRU_CONV, PH_LRU_GATE, PH_LRU_S1, PH_LRU_S2, PH_LRU_S3, PH_LRU_OUT,
       PH_ML_IN, PH_ML_SCAN, PH_ML_STAT, PH_ML_Z, PH_ML_OUT,
       PH_R7_IN, PH_R7_CA, PH_R7_CB, PH_R7_FIN, PH_R7_OUT, PH_FINAL, PH_R7_SHIFT };

struct P {
  const float *x, *c, *ctx, *c_ctx, *norm_g, *mod_w, *mod_b, *final_g;
  const float *lru_w_in, *lru_conv_w, *lru_conv_b, *lru_gate_w, *lru_gate_b, *lru_lam, *lru_w_out;
  const float *ml_w_in, *ml_gate_b, *ml_norm_g, *ml_w_out;
  const float *r7_mu, *r7_w_rkvz, *r7_w0, *r7_w1, *r7_w2, *r7_a0, *r7_a1, *r7_a2, *r7_k_k, *r7_k_a, *r7_r_k, *r7_ln_g, *r7_ln_b, *r7_w_out;
  float* Xx; float* Xc; float* MOD; bfr* W; bfr* H; char* ACT; unsigned* bar; float* CL;
  int nsched; int pad_;
  int sched[64 * 3];
};
struct Ctx { int layer, j, d, wc; };

__device__ __forceinline__ int ltid() { int t = threadIdx.x; asm volatile("" : "+v"(t)); return t; }
typedef float f32v2_ __attribute__((ext_vector_type(2))); typedef __bf16 bf16v2_ __attribute__((ext_vector_type(2)));
__device__ __forceinline__ unsigned cvtpk(float lo, float hi) { f32v2_ f = {lo, hi}; bf16v2_ h = __builtin_convertvector(f, bf16v2_); return __builtin_bit_cast(unsigned, h); }
__device__ __forceinline__ bfr f2b(float f) { return (bfr)(cvtpk(f, f) & 0xffffu); }
__device__ __forceinline__ float b2f(bfr b) { return __uint_as_float(((unsigned)b) << 16); }
__device__ __forceinline__ unsigned pk2(float a, float b) { return cvtpk(a, b); }
__device__ __forceinline__ float blo(unsigned u) { return __uint_as_float(u << 16); }
__device__ __forceinline__ float bhi(unsigned u) { return __uint_as_float(u & 0xffff0000u); }
__device__ __forceinline__ void store4b(bfr* dst, f32x4 v) { uint2 u; u.x = pk2(v[0], v[1]); u.y = pk2(v[2], v[3]); *(uint2*)dst = u; }
__device__ __forceinline__ float sigm(float x) { return __builtin_amdgcn_rcpf(1.f + __expf(-x)); }
__device__ __forceinline__ float siluf(float x) { return x * sigm(x); }
__device__ __forceinline__ float softplusf(float x) { return x > 20.f ? x : log1pf(expf(x)); }
__device__ __forceinline__ int rowmap(int d, int b, int pp) { int o = d == 0 ? pp : (pp < 256 ? 255 - pp : 16895 - pp); return b * BT_ + o; }
__device__ __forceinline__ float* xrowp(const P& p, int row, int& mi) {
  int b = row / BT_, o = row - b * BT_;
  if (o < 256) { mi = 2; return p.Xc + (size_t)(b * 256 + o) * 1024; }
  mi = b; return p.Xx + (size_t)(b * 16384 + o - 256) * 1024;
}
__device__ __forceinline__ float wsum(float v) { for (int o = 32; o; o >>= 1) v += __shfl_xor(v, o); return v; }
template <int CTRL> __device__ __forceinline__ float dppf(float x) {
  return __int_as_float(__builtin_amdgcn_update_dpp(0, __float_as_int(x), CTRL, 0xf, 0xf, true));
}
__device__ __forceinline__ float red16(float x) {
  x += dppf<0xB1>(x); x += dppf<0x4E>(x); x += dppf<0x141>(x); x += dppf<0x140>(x); return x;
}

template <class F> __device__ __forceinline__ void prep_tile(bfr* dst, int K, int tn, int tk, F get, float* sm) {
  int tid = ltid();
  for (int i = 0; i < 8; i++) { int kk = (tid >> 6) + 8 * i, nn = tid & 63; sm[kk * 65 + nn] = get(tk * 64 + kk, tn * 64 + nn); }
  __syncthreads();
  for (int i = 0; i < 8; i++) { int nn = (tid >> 6) + 8 * i, kk = tid & 63; dst[(size_t)(tn * 64 + nn) * K + tk * 64 + kk] = f2b(sm[kk * 65 + nn]); }
  __syncthreads();
}
__device__ __forceinline__ int prep_count(int layer) { int kind = layer % 3; return kind == 0 ? (640 + 320 + 320) : kind == 1 ? (1088 + 512 + 512) : (2176 + 64 + 256); }
__device__ __forceinline__ void prep_item(const P& p, int layer, int it, float* sm) {
  int kind = layer % 3, j = layer / 3;
  if (kind == 0) {
    if (it < 640) { int tn = it / 16, tk = it % 16; const float* s = p.lru_w_in + (size_t)j * 1024 * 2560;
      prep_tile(p.W, 1024, tn, tk, [=](int k, int n) { return s[(size_t)k * 2560 + n]; }, sm); return; }
    it -= 640;
    if (it < 320) { int d = it / 160, r = it % 160, tn = r / 2, tk = r % 2; const float* s = p.lru_gate_w + (size_t)(j * 2 + d) * 2 * 10 * 16384;
      prep_tile(p.W + WL_GATE + d * 655360, 128, tn, tk, [=](int k, int n) {
        int nt = n >> 7, blk = nt >> 1, sub = nt & 1, jj = n & 127, wn = jj >> 6, rr = jj & 63, g = rr >> 5, c = rr & 31;
        int kch = sub * 64 + wn * 32 + c; return s[((size_t)(g * 10 + blk) * 128 + k) * 128 + kch]; }, sm); return; }
    it -= 320;
    { int tn = it / 20, tk = it % 20; const float* s = p.lru_w_out + (size_t)j * 1280 * 1024;
      prep_tile(p.W + WL_OUT, 1280, tn, tk, [=](int k, int n) { return s[(size_t)k * 1024 + n]; }, sm); return; }
  } else if (kind == 1) {
    const float* s = p.ml_w_in + (size_t)j * 1024 * 6176;
    if (it < 1088) { int tn = it / 16, tk = it % 16;
      prep_tile(p.W, 1024, tn, tk, [=](int k, int n) {
        if (n < 4096) { float v = s[(size_t)k * 6176 + n]; return (n >= 1024 && n < 2048) ? v * 0.08838834764831845f : v; }
        if (n < 4128) return s[(size_t)k * 6176 + 6144 + (n - 4096)];
        return 0.f; }, sm); return; }
    it -= 1088;
    if (it < 512) { int tn = it / 16, tk = it % 16;
      prep_tile(p.W + WM_Z, 1024, tn, tk, [=](int k, int n) { return s[(size_t)k * 6176 + 4096 + n]; }, sm); return; }
    it -= 512;
    { int tn = it / 32, tk = it % 32; const float* so = p.ml_w_out + (size_t)j * 2048 * 1024;
      prep_tile(p.W + WM_OUT, 2048, tn, tk, [=](int k, int n) { return so[(size_t)k * 1024 + n]; }, sm); return; }
  } else {
    if (it < 2176) { int tn = it / 32, tk = it % 32;
      const float* mu = p.r7_mu + (size_t)j * 6 * 1024; const float* wr = p.r7_w_rkvz + (size_t)j * 4 * 1024 * 1024;
      const float* w1 = p.r7_w1 + (size_t)j * 2 * 1024 * 64; const float* a1 = p.r7_a1 + (size_t)j * 2 * 1024 * 64;
      prep_tile(p.W, 2048, tn, tk, [=](int k, int n) {
        int kk = k & 1023; float v, m;
        if (n < 4096) { int g = n >> 10, e = n & 1023; m = mu[g * 1024 + kk]; v = wr[((size_t)g * 1024 + kk) * 1024 + e]; }
        else if (n < 4224) { int xx = (n - 4096) >> 6, rr = (n - 4096) & 63; m = mu[4 * 1024 + kk]; v = w1[((size_t)xx * 1024 + kk) * 64 + rr]; }
        else { int xx = (n - 4224) >> 6, rr = (n - 4224) & 63; m = mu[5 * 1024 + kk]; v = a1[((size_t)xx * 1024 + kk) * 64 + rr]; }
        return (k < 1024 ? (1.f - m) : m) * v; }, sm); return; }
    it -= 2176;
    if (it < 64) { int u = it / 16, tn = it % 16; const float* s = (u < 2 ? p.r7_w2 : p.r7_a2) + (size_t)(j * 2 + (u & 1)) * 64 * 1024;
      prep_tile(p.W + WR_UP + u * 65536, 64, tn, 0, [=](int k, int n) { return s[(size_t)k * 1024 + n]; }, sm); return; }
    it -= 64;
    { int tn = it / 16, tk = it % 16; const float* s = p.r7_w_out + (size_t)j * 1024 * 1024;
      prep_tile(p.W + WR_OUT, 1024, tn, tk, [=](int k, int n) { return s[(size_t)k * 1024 + n]; }, sm); return; }
  }
}

#define LDSS 72
template <class G> __device__ __forceinline__ void gemm_tile(const P& p, const Ctx& c, int mt, int nt, char* smem) {
  const int tid = ltid(), lane = tid & 63, wid = tid >> 6, wm = wid & 3, wn = wid >> 2;
  bfr* sA = (bfr*)smem; bfr* sB = sA + 2 * 256 * LDSS;
  f32x4 acc[4][4];
  for (int a = 0; a < 4; a++) for (int b = 0; b < 4; b++) acc[a][b] = f32x4{0.f, 0.f, 0.f, 0.f};
  const int lr = tid >> 3, lc = tid & 7;
  uint4 ra[4], rb[2];
  auto gload = [&](int kt) __attribute__((always_inline)) {
#pragma unroll
    for (int i = 0; i < 4; i++) {
      const bfr* pa = G::aptr(p, c, mt * 256 + lr + 64 * i, kt, nt);
      ra[i] = pa ? *(const uint4*)(pa + lc * 8) : uint4{0u, 0u, 0u, 0u};
      if (i < 2) rb[i] = *(const uint4*)(G::bptr(p, c, nt * 128 + lr + 64 * i, kt) + lc * 8);
    }
  };
  auto sstore = [&](int buf) __attribute__((always_inline)) {
#pragma unroll
    for (int i = 0; i < 4; i++) {
      *(uint4*)(sA + (buf * 256 + lr + 64 * i) * LDSS + lc * 8) = ra[i];
      if (i < 2) *(uint4*)(sB + (buf * 128 + lr + 64 * i) * LDSS + lc * 8) = rb[i];
    }
  };
  gload(0); sstore(0); __syncthreads();
  for (int kt = 0; kt < G::KT; kt++) {
    const int buf = kt & 1;
    if (kt + 1 < G::KT) gload(kt + 1);
#pragma unroll
    for (int ks = 0; ks < 2; ks++) {
      bf16x8 af[4], bf[4];
#pragma unroll
      for (int i = 0; i < 4; i++) {
        af[i] = *(const bf16x8*)(sA + (buf * 256 + wm * 64 + i * 16 + (lane & 15)) * LDSS + ks * 32 + (lane >> 4) * 8);
        bf[i] = *(const bf16x8*)(sB + (buf * 128 + wn * 64 + i * 16 + (lane & 15)) * LDSS + ks * 32 + (lane >> 4) * 8);
      }
#pragma unroll
      for (int n = 0; n < 4; n++)
#pragma unroll
        for (int m = 0; m < 4; m++) acc[n][m] = __builtin_amdgcn_mfma_f32_16x16x32_bf16(bf[n], af[m], acc[n][m], 0, 0, 0);
    }
    if (kt + 1 < G::KT) sstore(buf ^ 1);
    __syncthreads();
  }
  G::epi(p, c, acc, mt * 256 + wm * 64, nt * 128 + wn * 64, lane);
}

__device__ __forceinline__ void epi_resid(const P& p, const Ctx& c, f32x4 (&acc)[4][4], int m0, int n0, int lane) {
#pragma unroll
  for (int mi = 0; mi < 4; mi++) {
    int row = m0 + mi * 16 + (lane & 15); int mo; float* xr = xrowp(p, row, mo);
    if (mo == 2 && !c.wc) continue;
    const float* g = p.MOD + (size_t)(c.layer * 3 + mo) * 3072 + 2048;
#pragma unroll
    for (int ni = 0; ni < 4; ni++) {
      int n = n0 + ni * 16 + (lane >> 4) * 4;
      float4 xv = *(float4*)(xr + n); float4 gg = *(const float4*)(g + n);
      xv.x += gg.x * acc[ni][mi][0]; xv.y += gg.y * acc[ni][mi][1]; xv.z += gg.z * acc[ni][mi][2]; xv.w += gg.w * acc[ni][mi][3];
      *(float4*)(xr + n) = xv;
    }
  }
}

struct G_LruIn { static constexpr int KT = 16, NT = 20;
  static __device__ __forceinline__ const bfr* aptr(const P& p, const Ctx& c, int row, int kt, int nt) { return p.H + (size_t)row * 1024 + kt * 64; }
  static __device__ __forceinline__ const bfr* bptr(const P& p, const Ctx& c, int n, int kt) { return p.W + (size_t)n * 1024 + kt * 64; }
  static __device__ __forceinline__ void epi(const P& p, const Ctx& c, f32x4 (&acc)[4][4], int m0, int n0, int lane) {
    bfr* U = (bfr*)(p.ACT + A_U); bfr* Z = (bfr*)(p.ACT + A_Z);
#pragma unroll
    for (int ni = 0; ni < 4; ni++)
#pragma unroll
      for (int mi = 0; mi < 4; mi++) {
        int row = m0 + mi * 16 + (lane & 15), n = n0 + ni * 16 + (lane >> 4) * 4;
        bfr* dst = n < 1280 ? U + (size_t)row * 1280 + n : Z + (size_t)row * 1280 + (n - 1280);
        store4b(dst, acc[ni][mi]);
      }
  } };
struct G_LruGate { static constexpr int KT = 2, NT = 20;
  static __device__ __forceinline__ const bfr* aptr(const P& p, const Ctx& c, int row, int kt, int nt) { return (const bfr*)(p.ACT + A_UC) + (size_t)row * 1280 + (nt >> 1) * 128 + kt * 64; }
  static __device__ __forceinline__ const bfr* bptr(const P& p, const Ctx& c, int n, int kt) { return p.W + WL_GATE + c.d * 655360 + (size_t)n * 128 + kt * 64; }
  static __device__ __forceinline__ void epi(const P& p, const Ctx& c, f32x4 (&acc)[4][4], int m0, int n0, int lane) {
    const bfr* UC = (const bfr*)(p.ACT + A_UC); unsigned* AB = (unsigned*)(p.ACT + A_AB);
    const float* gb = p.lru_gate_b + (size_t)(c.j * 2 + c.d) * 2 * 1280; const float* lam = p.lru_lam + (size_t)(c.j * 2 + c.d) * 1280;
    int chb = (n0 >> 6) * 32;
#pragma unroll
    for (int ni = 0; ni < 2; ni++) {
      int ch = chb + ni * 16 + (lane >> 4) * 4;
      float cl[4], br[4], bi[4];
#pragma unroll
      for (int q = 0; q < 4; q++) { cl[q] = p.CL[(size_t)(c.j * 2 + c.d) * 1280 + ch + q]; br[q] = gb[ch + q]; bi[q] = gb[1280 + ch + q]; }
#pragma unroll
      for (int mi = 0; mi < 4; mi++) {
        int row = m0 + mi * 16 + (lane & 15);
        uint2 u = *(const uint2*)(UC + (size_t)row * 1280 + ch);
        float uc[4] = {blo(u.x), bhi(u.x), blo(u.y), bhi(u.y)};
        unsigned o[4];
#pragma unroll
        for (int q = 0; q < 4; q++) {
          float r = sigm(acc[ni][mi][q] + br[q]), ig = sigm(acc[ni + 2][mi][q] + bi[q]);
          float la = -cl[q] * r; float oma = 1.f - __expf(la); float bb = __builtin_amdgcn_sqrtf(oma * (2.f - oma)) * ig * uc[q];
          o[q] = (((unsigned)f2b(oma)) << 16) | (unsigned)f2b(bb);
        }
        *(uint4*)(AB + (size_t)row * 1280 + ch) = uint4{o[0], o[1], o[2], o[3]};
      }
    }
  } };
struct G_LruOut { static constexpr int KT = 20, NT = 8;
  static __device__ __forceinline__ const bfr* aptr(const P& p, const Ctx& c, int row, int kt, int nt) { return (const bfr*)(p.ACT + A_Z) + (size_t)row * 1280 + kt * 64; }
  static __device__ __forceinline__ const bfr* bptr(const P& p, const Ctx& c, int n, int kt) { return p.W + WL_OUT + (size_t)n * 1280 + kt * 64; }
  static __device__ __forceinline__ void epi(const P& p, const Ctx& c, f32x4 (&acc)[4][4], int m0, int n0, int lane) { epi_resid(p, c, acc, m0, n0, lane); } };
struct G_MlIn { static constexpr int KT = 16, NT = 33;
  static __device__ __forceinline__ const bfr* aptr(const P& p, const Ctx& c, int row, int kt, int nt) { return p.H + (size_t)row * 1024 + kt * 64; }
  static __device__ __forceinline__ const bfr* bptr(const P& p, const Ctx& c, int n, int kt) { return p.W + (size_t)n * 1024 + kt * 64; }
  static __device__ __forceinline__ void epi(const P& p, const Ctx& c, f32x4 (&acc)[4][4], int m0, int n0, int lane) {
    bfr* QKV = (bfr*)(p.ACT + A_QKV); float* GT = (float*)(p.ACT + A_GATE);
#pragma unroll
    for (int ni = 0; ni < 4; ni++)
#pragma unroll
      for (int mi = 0; mi < 4; mi++) {
        int row = m0 + mi * 16 + (lane & 15), n = n0 + ni * 16 + (lane >> 4) * 4;
        if (n < 4096) store4b(QKV + (size_t)row * 4096 + n, acc[ni][mi]);
        else if (n < 4128) *(float4*)(GT + (size_t)row * 32 + (n - 4096)) = float4{acc[ni][mi][0], acc[ni][mi][1], acc[ni][mi][2], acc[ni][mi][3]};
      }
  } };
struct G_MlZ { static constexpr int KT = 16, NT = 16;
  static __device__ __forceinline__ const bfr* aptr(const P& p, const Ctx& c, int row, int kt, int nt) { return p.H + (size_t)row * 1024 + kt * 64; }
  static __device__ __forceinline__ const bfr* bptr(const P& p, const Ctx& c, int n, int kt) { return p.W + WM_Z + (size_t)n * 1024 + kt * 64; }
  static __device__ __forceinline__ void epi(const P& p, const Ctx& c, f32x4 (&acc)[4][4], int m0, int n0, int lane) {
    bfr* HS = (bfr*)(p.ACT + A_HS); const float* RS = (const float*)(p.ACT + A_RSTD); const float* ng = p.ml_norm_g + (size_t)c.j * 2048;
#pragma unroll
    for (int ni = 0; ni < 4; ni++)
#pragma unroll
      for (int mi = 0; mi < 4; mi++) {
        int row = m0 + mi * 16 + (lane & 15), n = n0 + ni * 16 + (lane >> 4) * 4;
        bfr* hp = HS + (size_t)row * 2048 + n; uint2 u = *(const uint2*)hp; float rs = RS[(size_t)row * 8 + (n >> 8)];
        float4 g4 = *(const float4*)(ng + n);
        f32x4 o;
        o[0] = blo(u.x) * rs * g4.x * siluf(acc[ni][mi][0]); o[1] = bhi(u.x) * rs * g4.y * siluf(acc[ni][mi][1]);
        o[2] = blo(u.y) * rs * g4.z * siluf(acc[ni][mi][2]); o[3] = bhi(u.y) * rs * g4.w * siluf(acc[ni][mi][3]);
        store4b(hp, o);
      }
  } };
struct G_MlOut { static constexpr int KT = 32, NT = 8;
  static __device__ __forceinline__ const bfr* aptr(const P& p, const Ctx& c, int row, int kt, int nt) { return (const bfr*)(p.ACT + A_HS) + (size_t)row * 2048 + kt * 64; }
  static __device__ __forceinline__ const bfr* bptr(const P& p, const Ctx& c, int n, int kt) { return p.W + WM_OUT + (size_t)n * 2048 + kt * 64; }
  static __device__ __forceinline__ void epi(const P& p, const Ctx& c, f32x4 (&acc)[4][4], int m0, int n0, int lane) { epi_resid(p, c, acc, m0, n0, lane); } };
struct G_R7In { static constexpr int KT = 32, NT = 34;
  static __device__ __forceinline__ const bfr* aptr(const P& p, const Ctx& c, int row, int kt, int nt) {
    if (kt < 16) return p.H + (size_t)row * 1024 + kt * 64;
    int q = (kt - 16) >> 2; int b = row / BT_, o = row - b * BT_; int nr;
    if (o < 256) { if (q < 2) { if (o < 1) return nullptr; nr = row - 1; } else { if (o >= 255) return nullptr; nr = row + 1; } }
    else { int t = o - 256, col = t & 63, gr = t >> 6;
      if (q == 0) { if (col == 0) return nullptr; nr = row - 1; }
      else if (q == 1) { if (col == 63) return nullptr; nr = row + 1; }
      else if (q == 2) { if (gr == 0) return nullptr; nr = row - 64; }
      else { if (gr == 255) return nullptr; nr = row + 64; } }
    return p.H + (size_t)nr * 1024 + (kt - 16) * 64; }
  static __device__ __forceinline__ const bfr* bptr(const P& p, const Ctx& c, int n, int kt) { return p.W + (size_t)n * 2048 + kt * 64; }
  static __device__ __forceinline__ void epi(const P& p, const Ctx& c, f32x4 (&acc)[4][4], int m0, int n0, int lane) {
    bfr* RK = (bfr*)(p.ACT + A_RKVZ); bfr* WMb = (bfr*)(p.ACT + A_WM); bfr* AMb = (bfr*)(p.ACT + A_AM);
#pragma unroll
    for (int ni = 0; ni < 4; ni++)
#pragma unroll
      for (int mi = 0; mi < 4; mi++) {
        int row = m0 + mi * 16 + (lane & 15), n = n0 + ni * 16 + (lane >> 4) * 4;
        if (n < 4096) store4b(RK + (size_t)row * 4096 + n, acc[ni][mi]);
        else if (n < 4224) { f32x4 t;
#pragma unroll
          for (int q = 0; q < 4; q++) t[q] = tanhf(acc[ni][mi][q]); store4b(WMb + (size_t)row * 128 + (n - 4096), t); }
        else store4b(AMb + (size_t)row * 128 + (n - 4224), acc[ni][mi]);
      }
  } };
struct G_R7Out { static constexpr int KT = 16, NT = 8;
  static __device__ __forceinline__ const bfr* aptr(const P& p, const Ctx& c, int row, int kt, int nt) { return p.H + (size_t)row * 1024 + kt * 64; }
  static __device__ __forceinline__ const bfr* bptr(const P& p, const Ctx& c, int n, int kt) { return p.W + WR_OUT + (size_t)n * 1024 + kt * 64; }
  static __device__ __forceinline__ void epi(const P& p, const Ctx& c, f32x4 (&acc)[4][4], int m0, int n0, int lane) { epi_resid(p, c, acc, m0, n0, lane); } };


namespace pg8 {
#define PG8_LAS __attribute__((address_space(3)))
constexpr int BM = 256, BK = 64, HALF = 128, HTB = HALF * BK * 2, NXCD = 8, WGM = 8;
__device__ __forceinline__ int lds_byte(int r, int c) { const int st = (r >> 4) * 2 + (c >> 5), rr = r & 15, cc = c & 31, ob = rr * 64 + cc * 2; return st * 1024 + (ob ^ (((ob >> 9) & 1) << 5)); }
__device__ __forceinline__ void stage_rc(int b, int& R, int& C) { const int st = b / 1024, sb = b % 1024, swz = sb ^ (((sb >> 9) & 1) << 5); R = (st >> 1) * 16 + swz / 64; C = (st & 1) * 32 + (swz % 64) / 2; }
struct Unit { int pm, pn; };
struct Gemm { const bfr* A; const bfr* Bt; int M, N, K; };
struct StaticOrder {
  int nM, nN, nwg, G, c;
  __device__ void init(int M, int N, int G_, int c_) { nM = M / BM; nN = N / BM; nwg = nM * nN; G = G_; c = c_; }
  __device__ bool next(int i, Unit& u) const {
    const long L = (long)i * G + c; if (L >= nwg) return false;
    int wgid = (int)L; { const int q = nwg / NXCD, r = nwg % NXCD, xcd = wgid % NXCD, off = wgid / NXCD; wgid = (xcd < r ? xcd * (q + 1) : r * (q + 1) + (xcd - r) * q) + off; }
    const int nig = WGM * nN, gid = wgid / nig, fm = gid * WGM, gsz = (nM - fm) < WGM ? (nM - fm) : WGM;
    u.pm = fm + ((wgid % nig) % gsz); u.pn = (wgid % nig) / gsz; return true;
  }
};
template <class Epi>
__device__ __forceinline__ void gemm_phase(PG8_LAS unsigned char* lds, const Gemm g, const StaticOrder& S, const Epi& E) {
  const int tid = ltid(), wid = __builtin_amdgcn_readfirstlane(tid >> 6), lane = tid & 63, wr = wid >> 2, wc = wid & 3, fr = lane & 15, fq = lane >> 4;
  const int K = g.K, nt = K / BK;
  unsigned voffA[2], voffB[2];
#pragma unroll
  for (int i = 0; i < 2; ++i) { int R, C; stage_rc(tid * 16 + i * 8192, R, C); voffA[i] = (unsigned)(R * K + C) * 2u; voffB[i] = voffA[i]; }
  const size_t kstep = (size_t)(BK * 2);
  const size_t hstep = (size_t)HALF * K * 2;
  const size_t tstep = 2 * hstep;
  const unsigned ldsw = (unsigned)wid * 1024u;
  const int aoff = lds_byte(wr * 64 + fr, fq * 8), boff = lds_byte(wc * 32 + fr, fq * 8);
#define PG8_SA(b, h) (((b) * 2 + (h)) * HTB)
#define PG8_SB(b, h) ((4 + (b) * 2 + (h)) * HTB)
#define PG8_STAGE(bufoff, gbase, voff) do { _Pragma("unroll") for (int _i = 0; _i < 2; ++_i) \
    __builtin_amdgcn_global_load_lds((const unsigned*)((const char*)(gbase) + (voff)[_i]), (PG8_LAS unsigned*)(lds + (bufoff) + ldsw + _i * 8192), 16, 0, 0); } while (0)
#define PG8_LDA(dst, b, h) do { _Pragma("unroll") for (int m = 0; m < 4; ++m) _Pragma("unroll") for (int k = 0; k < 2; ++k) dst[m][k] = *(const PG8_LAS bf16x8*)(lds + PG8_SA(b, h) + aoff + m * 2048 + k * 1024); } while (0)
#define PG8_LDB(dst, b, h) do { _Pragma("unroll") for (int n = 0; n < 2; ++n) _Pragma("unroll") for (int k = 0; k < 2; ++k) dst[n][k] = *(const PG8_LAS bf16x8*)(lds + PG8_SB(b, h) + boff + n * 2048 + k * 1024); } while (0)
#define PG8_MMA(ai, bj, At, Bt) do { __builtin_amdgcn_s_setprio(1); _Pragma("unroll") for (int m = 0; m < 4; ++m) _Pragma("unroll") for (int n = 0; n < 2; ++n) _Pragma("unroll") for (int k = 0; k < 2; ++k) \
    acc[ai][bj][m][n] = __builtin_amdgcn_mfma_f32_16x16x32_bf16(Bt[n][k], At[m][k], acc[ai][bj][m][n], 0, 0, 0); __builtin_amdgcn_s_setprio(0); } while (0)
#define PG8_WAIT_V(n) asm volatile("s_waitcnt vmcnt(" #n ")" ::: "memory")
#define PG8_WAIT_L(n) asm volatile("s_waitcnt lgkmcnt(" #n ")" ::: "memory")
#define PG8_BAR __builtin_amdgcn_s_barrier()
#define PG8_SCHED __builtin_amdgcn_sched_barrier(0)
  Unit cur, nxt; int ui = 0;
  if (!S.next(0, cur)) return;
  f32x4 acc[2][2][4][2];
#pragma unroll
  for (int a = 0; a < 2; ++a)
#pragma unroll
    for (int b = 0; b < 2; ++b)
#pragma unroll
      for (int m = 0; m < 4; ++m)
#pragma unroll
        for (int n = 0; n < 2; ++n) acc[a][b][m][n] = (f32x4){0.f, 0.f, 0.f, 0.f};
  bf16x8 At[4][2], B0[2][2], B1[2][2];
  const char* cA = (const char*)g.A + (size_t)cur.pm * tstep; const char* cB = (const char*)g.Bt + (size_t)cur.pn * tstep;
  PG8_STAGE(PG8_SB(0, 0), cB, voffB); PG8_STAGE(PG8_SA(0, 0), cA, voffA); PG8_STAGE(PG8_SB(0, 1), cB + hstep, voffB); PG8_STAGE(PG8_SA(0, 1), cA + hstep, voffA);
  if (wr == 1) PG8_BAR;
  PG8_WAIT_V(4); PG8_BAR;
  PG8_STAGE(PG8_SB(1, 0), cB + kstep, voffB); PG8_STAGE(PG8_SA(1, 0), cA + kstep, voffA); PG8_STAGE(PG8_SB(1, 1), cB + hstep + kstep, voffB);
  PG8_WAIT_V(6); PG8_BAR;
  for (;;) {
    const bool has_next = S.next(ui + 1, nxt);
    const char* nA = has_next ? (const char*)g.A + (size_t)nxt.pm * tstep : cA; const char* nB = has_next ? (const char*)g.Bt + (size_t)nxt.pn * tstep : cB;
    for (int t = 0; t < nt; t += 2) {
      const bool last = (t == nt - 2);
      const char* a1 = cA + (size_t)(t + 1) * kstep;
      const char* a2 = last ? nA : cA + (size_t)(t + 2) * kstep; const char* b2 = last ? nB : cB + (size_t)(t + 2) * kstep;
      const char* a3 = a2 + kstep; const char* b3 = b2 + kstep;
      PG8_LDB(B0, 0, 0); PG8_SCHED; PG8_LDA(At, 0, 0); PG8_STAGE(PG8_SA(1, 1), a1 + hstep, voffA);
      PG8_WAIT_L(8); PG8_BAR; PG8_WAIT_L(0); PG8_MMA(0, 0, At, B0); PG8_BAR; PG8_SCHED;
      PG8_LDB(B1, 0, 1); PG8_STAGE(PG8_SB(0, 0), b2, voffB);
      PG8_BAR; PG8_WAIT_L(0); PG8_MMA(0, 1, At, B1); PG8_BAR;
      PG8_LDA(At, 0, 1); PG8_STAGE(PG8_SA(0, 0), a2, voffA);
      PG8_BAR; PG8_WAIT_L(0); PG8_MMA(1, 0, At, B0); PG8_BAR; PG8_SCHED;
      PG8_STAGE(PG8_SB(0, 1), b2 + hstep, voffB);
      PG8_WAIT_V(6); PG8_BAR; PG8_MMA(1, 1, At, B1); PG8_BAR;
      PG8_LDB(B0, 1, 0); PG8_SCHED; PG8_LDA(At, 1, 0); PG8_STAGE(PG8_SA(0, 1), a2 + hstep, voffA);
      PG8_WAIT_L(8); PG8_BAR; PG8_WAIT_L(0); PG8_MMA(0, 0, At, B0); PG8_BAR; PG8_SCHED;
      PG8_LDB(B1, 1, 1); PG8_STAGE(PG8_SB(1, 0), b3, voffB);
      PG8_BAR; PG8_WAIT_L(0); PG8_MMA(0, 1, At, B1); PG8_BAR;
      PG8_LDA(At, 1, 1); PG8_STAGE(PG8_SA(1, 0), a3, voffA);
      PG8_BAR; PG8_WAIT_L(0); PG8_MMA(1, 0, At, B0); PG8_BAR; PG8_SCHED;
      PG8_STAGE(PG8_SB(1, 1), b3 + hstep, voffB);
      PG8_WAIT_V(6); PG8_BAR; PG8_MMA(1, 1, At, B1); PG8_BAR;
    }
    E(acc, cur, wr, wc, fr, fq);
    if (!has_next) break;
#pragma unroll
    for (int a = 0; a < 2; ++a)
#pragma unroll
      for (int b = 0; b < 2; ++b)
#pragma unroll
        for (int m = 0; m < 4; ++m)
#pragma unroll
          for (int n = 0; n < 2; ++n) acc[a][b][m][n] = (f32x4){0.f, 0.f, 0.f, 0.f};
    cur = nxt; cA = nA; cB = nB; ++ui;
  }
  PG8_WAIT_V(0);
  if (wr == 0) PG8_BAR;
  PG8_BAR;
#undef PG8_SA
#undef PG8_SB
#undef PG8_STAGE
#undef PG8_LDA
#undef PG8_LDB
#undef PG8_MMA
#undef PG8_WAIT_V
#undef PG8_WAIT_L
#undef PG8_BAR
#undef PG8_SCHED
}
}

template <class F> struct EpiAd {
  F f;
  __device__ __forceinline__ void operator()(const f32x4 (&acc)[2][2][4][2], const pg8::Unit& u, int wr, int wc, int fr, int fq) const {
#pragma unroll
    for (int ai = 0; ai < 2; ++ai)
#pragma unroll
      for (int m = 0; m < 4; ++m) { const int row = u.pm * 256 + ai * 128 + wr * 64 + m * 16 + fr;
#pragma unroll
        for (int bj = 0; bj < 2; ++bj)
#pragma unroll
          for (int n = 0; n < 2; ++n) f(row, u.pn * 256 + bj * 128 + wc * 32 + n * 16 + 4 * fq, acc[ai][bj][m][n]); }
  }
};
template <class F> __device__ __forceinline__ void big_gemm(char* smem, const bfr* A, const bfr* Bt, int N, int K, F f) {
  pg8::Gemm g; g.A = A; g.Bt = Bt; g.M = R_; g.N = N; g.K = K;
  pg8::StaticOrder S; S.init(R_, N, (int)gridDim.x, (int)blockIdx.x);
  EpiAd<F> E{f};
  pg8::gemm_phase(( __attribute__((address_space(3))) unsigned char*)smem, g, S, E);
}
struct F_LruIn { char* ACT; __device__ __forceinline__ void operator()(int row, int n, f32x4 v) const {
  bfr* dst = n < 1280 ? (bfr*)(ACT + A_U) + (size_t)row * 1280 + n : (bfr*)(ACT + A_Z) + (size_t)row * 1280 + (n - 1280); store4b(dst, v); } };
struct F_Resid { float* Xx; float* Xc; const float* MODg; int wc; __device__ __forceinline__ void operator()(int row, int n, f32x4 v) const {
  int b = row / BT_, o = row - b * BT_; bool isc = o < 256; if (isc && !wc) return;
  float* xr = isc ? Xc + (size_t)(b * 256 + o) * 1024 : Xx + (size_t)(b * 16384 + o - 256) * 1024; const float* g = MODg + (size_t)(isc ? 2 : b) * 3072 + 2048;
  float4 xv = *(float4*)(xr + n); float4 gg = *(const float4*)(g + n);
  xv.x += gg.x * v[0]; xv.y += gg.y * v[1]; xv.z += gg.z * v[2]; xv.w += gg.w * v[3]; *(float4*)(xr + n) = xv; } };
struct F_MlIn { char* ACT; __device__ __forceinline__ void operator()(int row, int n, f32x4 v) const {
  if (n < 4096) store4b((bfr*)(ACT + A_QKV) + (size_t)row * 4096 + n, v);
  else if (n < 4128) *(float4*)((float*)(ACT + A_GATE) + (size_t)row * 32 + (n - 4096)) = float4{v[0], v[1], v[2], v[3]}; } };
struct F_MlZ { char* ACT; const float* ng; __device__ __forceinline__ void operator()(int row, int n, f32x4 v) const {
  bfr* hp = (bfr*)(ACT + A_HS) + (size_t)row * 2048 + n; uint2 u = *(const uint2*)hp; float rs = ((const float*)(ACT + A_RSTD))[(size_t)row * 8 + (n >> 8)];
  float4 g4 = *(const float4*)(ng + n); f32x4 o;
  o[0] = blo(u.x) * rs * g4.x * siluf(v[0]); o[1] = bhi(u.x) * rs * g4.y * siluf(v[1]); o[2] = blo(u.y) * rs * g4.z * siluf(v[2]); o[3] = bhi(u.y) * rs * g4.w * siluf(v[3]);
  store4b(hp, o); } };
struct F_R7In { char* ACT; __device__ __forceinline__ void operator()(int row, int n, f32x4 v) const {
  if (n < 4096) store4b((bfr*)(ACT + A_RKVZ) + (size_t)row * 4096 + n, v);
  else if (n < 4224) { f32x4 t;
#pragma unroll
    for (int q = 0; q < 4; q++) t[q] = tanhf(v[q]);
    store4b((bfr*)(ACT + A_WM) + (size_t)row * 128 + (n - 4096), t); }
  else store4b((bfr*)(ACT + A_AM) + (size_t)row * 128 + (n - 4224), v); } };

template <class G> __device__ __forceinline__ void gemm_phase(const P& p, const Ctx& c, char* smem) {
  const int total = 130 * G::NT;
  for (int it = blockIdx.x; it < total; it += gridDim.x) gemm_tile<G>(p, c, it / G::NT, it % G::NT, smem);
}

#define R7_Y2 ((bfr*)p.H + (size_t)64 * 26 * 16384)
__device__ __forceinline__ void ph_pre(const P& p, char* smem) {
  float* sm = (float*)smem; const int tid = ltid();
  const int nprep = prep_count(0), ngemv = 192, ncopy = 4160;
  if (blockIdx.x == 0) for (int i = tid; i < 5120; i += 512) p.CL[i] = 8.f * softplusf(-p.lru_lam[i]);
  for (int it = blockIdx.x; it < nprep + ngemv + ncopy; it += gridDim.x) {
    if (it < nprep) { prep_item(p, 0, it, sm); continue; }
    int i2 = it - nprep;
    if (i2 < ngemv) {
      int l = i2 / 48, cgp = i2 % 48;
      for (int i = tid; i < 3072; i += 512) { int cnd = i >> 10, k = i & 1023; float v = cnd == 0 ? p.c[k] : cnd == 1 ? p.c[1024 + k] : p.c_ctx[k]; sm[i] = siluf(v); }
      __syncthreads();
      int kq = tid >> 6, col = cgp * 64 + (tid & 63); const float* w = p.mod_w + (size_t)l * 1024 * 3072 + col;
      float a0 = 0.f, a1 = 0.f, a2 = 0.f;
      for (int k = kq * 128; k < kq * 128 + 128; k++) { float wv = w[(size_t)k * 3072]; a0 += sm[k] * wv; a1 += sm[1024 + k] * wv; a2 += sm[2048 + k] * wv; }
      float* red = sm + 3072; red[tid * 3] = a0; red[tid * 3 + 1] = a1; red[tid * 3 + 2] = a2;
      __syncthreads();
      if (tid < 64) { float bias = p.mod_b[(size_t)l * 3072 + col];
        for (int cnd = 0; cnd < 3; cnd++) { float s = bias; for (int q = 0; q < 8; q++) s += red[(q * 64 + tid) * 3 + cnd]; p.MOD[(size_t)(l * 3 + cnd) * 3072 + col] = s; } }
      __syncthreads();
      continue;
    }
    i2 -= ngemv;
    for (int q = 0; q < 4; q++) { int idx = i2 * 2048 + q * 512 + tid; int row = idx >> 8, c4 = idx & 255; int b = row / BT_, o = row - b * BT_;
      if (o < 256) ((float4*)p.Xc)[(size_t)(b * 256 + o) * 256 + c4] = ((const float4*)p.ctx)[(size_t)(b * 256 + o) * 256 + c4];
      else ((float4*)p.Xx)[(size_t)(b * 16384 + o - 256) * 256 + c4] = ((const float4*)p.x)[(size_t)(b * 16384 + o - 256) * 256 + c4]; }
  }
}
__device__ __forceinline__ void ph_norm(const P& p, int layer, char* smem) {
  const int tid = ltid(), lane = tid & 63, wid = tid >> 6;
  const int nprep = layer > 0 ? prep_count(layer) : 0; const int kind = layer % 3;
  const int nzero = kind == 1 ? 8320 : 0;
  (void)nzero;
  for (int it = blockIdx.x; it < nprep + 4160; it += gridDim.x) {
    if (it < nprep) { prep_item(p, layer, it, (float*)smem); continue; }
    int row = (it - nprep) * 8 + wid; int mo; const float* xr = xrowp(p, row, mo);
    float4 v[4]; float ss = 0.f;
#pragma unroll
    for (int i = 0; i < 4; i++) { v[i] = *(const float4*)(xr + lane * 4 + 256 * i); ss += v[i].x * v[i].x + v[i].y * v[i].y + v[i].z * v[i].z + v[i].w * v[i].w; }
    ss = wsum(ss); float rs = rsqrtf(ss * (1.f / 1024.f) + 1e-6f);
    const float* g = p.norm_g + (size_t)layer * 1024; const float* md = p.MOD + (size_t)(layer * 3 + mo) * 3072;
#pragma unroll
    for (int i = 0; i < 4; i++) { int cidx = lane * 4 + 256 * i; float4 gg = *(const float4*)(g + cidx), sh = *(const float4*)(md + cidx), sc = *(const float4*)(md + 1024 + cidx);
      f32x4 o; o[0] = v[i].x * rs * gg.x * (1.f + sc.x) + sh.x; o[1] = v[i].y * rs * gg.y * (1.f + sc.y) + sh.y; o[2] = v[i].z * rs * gg.z * (1.f + sc.z) + sh.z; o[3] = v[i].w * rs * gg.w * (1.f + sc.w) + sh.w;
      store4b(p.H + (size_t)row * (kind == 2 ? 2048 : 1024) + cidx, o); }
  }
}
__device__ __forceinline__ void ph_r7_shift(const P& p) {
  for (int it = blockIdx.x; it < 8320; it += gridDim.x) {
    int idx = it * 512 + ltid(); int row = idx >> 7, c8 = idx & 127, q = c8 >> 5;
    int b = row / BT_, o = row - b * BT_; int nr = -1;
    if (o < 256) { if (q < 2) { if (o >= 1) nr = row - 1; } else { if (o < 255) nr = row + 1; } }
    else { int t = o - 256, col = t & 63, gr = t >> 6;
      if (q == 0) { if (col != 0) nr = row - 1; } else if (q == 1) { if (col != 63) nr = row + 1; }
      else if (q == 2) { if (gr != 0) nr = row - 64; } else { if (gr != 255) nr = row + 64; } }
    uint4 v = nr >= 0 ? *(const uint4*)(p.H + (size_t)nr * 2048 + c8 * 8) : uint4{0u, 0u, 0u, 0u};
    *(uint4*)(p.H + (size_t)row * 2048 + 1024 + c8 * 8) = v;
  }
}
__device__ __forceinline__ void ph_final(const P& p) {
  const int lane = ltid() & 63, wid = ltid() >> 6;
  for (int it = blockIdx.x; it < 4096; it += gridDim.x) {
    float* xr = p.Xx + (size_t)(it * 8 + wid) * 1024; float4 v[4]; float ss = 0.f;
#pragma unroll
    for (int i = 0; i < 4; i++) { v[i] = *(const float4*)(xr + lane * 4 + 256 * i); ss += v[i].x * v[i].x + v[i].y * v[i].y + v[i].z * v[i].z + v[i].w * v[i].w; }
    ss = wsum(ss); float rs = rsqrtf(ss * (1.f / 1024.f) + 1e-6f);
#pragma unroll
    for (int i = 0; i < 4; i++) { int cidx = lane * 4 + 256 * i; float4 gg = *(const float4*)(p.final_g + cidx);
      *(float4*)(xr + cidx) = float4{v[i].x * rs * gg.x, v[i].y * rs * gg.y, v[i].z * rs * gg.z, v[i].w * rs * gg.w}; }
  }
}
__device__ __forceinline__ void ph_lru_conv(const P& p, int j) {
  const bfr* U = (const bfr*)(p.ACT + A_U); bfr* UC = (bfr*)(p.ACT + A_UC);
  const float* cw = p.lru_conv_w + (size_t)j * 4 * 1280; const float* cb = p.lru_conv_b + (size_t)j * 1280;
  for (int it = blockIdx.x; it < 10400; it += gridDim.x) {
    int idx = it * 512 + ltid(); int row = idx / 160, cgp = idx % 160, ch = cgp * 8;
    int b = row / BT_, o = row - b * BT_; int s0 = o < 256 ? 0 : 256, e0 = o < 256 ? 256 : BT_;
    float acc[8];
#pragma unroll
    for (int e = 0; e < 8; e++) acc[e] = cb[ch + e];
#pragma unroll
    for (int t = 0; t < 4; t++) { int oo = o + t - 2; if (oo < s0 || oo >= e0) continue;
      uint4 u = *(const uint4*)(U + (size_t)(row + t - 2) * 1280 + ch); const float* w = cw + t * 1280 + ch;
      acc[0] += w[0] * blo(u.x); acc[1] += w[1] * bhi(u.x); acc[2] += w[2] * blo(u.y); acc[3] += w[3] * bhi(u.y);
      acc[4] += w[4] * blo(u.z); acc[5] += w[5] * bhi(u.z); acc[6] += w[6] * blo(u.w); acc[7] += w[7] * bhi(u.w); }
    *(uint4*)(UC + (size_t)row * 1280 + ch) = uint4{pk2(acc[0], acc[1]), pk2(acc[2], acc[3]), pk2(acc[4], acc[5]), pk2(acc[6], acc[7])};
  }
}
__device__ __forceinline__ void ph_lru_s1(const P& p, int d) {
  const unsigned* AB = (const unsigned*)(p.ACT + A_AB); float2* AGG = (float2*)(p.ACT + A_AGG);
  const int t = ltid();
  for (int it = blockIdx.x * 8 + (t >> 6); it < 2600; it += gridDim.x * 8) {
    int b = it / 1300, r = it % 1300, cc = r / 5, ch = (r % 5) * 256 + (t & 63) * 4;
    float P0 = 1.f, Q0 = 0.f, P1 = 1.f, Q1 = 0.f, P2 = 1.f, Q2 = 0.f, P3 = 1.f, Q3 = 0.f;
#pragma unroll 8
    for (int q = 0; q < 64; q++) { uint4 u = *(const uint4*)(AB + (size_t)rowmap(d, b, cc * 64 + q) * 1280 + ch);
      float a0 = 1.f - bhi(u.x), a1 = 1.f - bhi(u.y), a2 = 1.f - bhi(u.z), a3 = 1.f - bhi(u.w);
      P0 *= a0; Q0 = a0 * Q0 + blo(u.x); P1 *= a1; Q1 = a1 * Q1 + blo(u.y); P2 *= a2; Q2 = a2 * Q2 + blo(u.z); P3 *= a3; Q3 = a3 * Q3 + blo(u.w); }
    float4* ag = (float4*)(AGG + (size_t)(b * NCH_ + cc) * 1280 + ch); ag[0] = float4{P0, Q0, P1, Q1}; ag[1] = float4{P2, Q2, P3, Q3};
  }
}
__device__ __forceinline__ void ph_lru_s2(const P& p, char* smem) {
  const float2* AGG = (const float2*)(p.ACT + A_AGG); float* CAR = (float*)(p.ACT + A_CAR);
  float* sP = (float*)smem; float* sQ = sP + 512;
  const int tid = ltid(), chl = tid & 63, seg = tid >> 6;
  for (int it = blockIdx.x; it < 40; it += gridDim.x) {
    const int b = it / 20, ch = (it % 20) * 64 + chl; const int cb = seg * 33, ce = cb + 33 < NCH_ ? cb + 33 : NCH_;
    float Pp = 1.f, Q = 0.f;
#pragma unroll 11
    for (int cc = cb; cc < ce; cc++) { float2 a = AGG[(size_t)(b * NCH_ + cc) * 1280 + ch]; Pp *= a.x; Q = a.x * Q + a.y; }
    __syncthreads();
    sP[seg * 64 + chl] = Pp; sQ[seg * 64 + chl] = Q;
    __syncthreads();
    float h = 0.f;
    for (int s2 = 0; s2 < seg; s2++) h = sP[s2 * 64 + chl] * h + sQ[s2 * 64 + chl];
#pragma unroll 11
    for (int cc = cb; cc < ce; cc++) { size_t o = (size_t)(b * NCH_ + cc) * 1280 + ch; float2 a = AGG[o]; CAR[o] = h; h = a.x * h + a.y; }
  }
}
__device__ __forceinline__ void ph_lru_s3(const P& p, int d) {
  const unsigned* AB = (const unsigned*)(p.ACT + A_AB); const float* CAR = (const float*)(p.ACT + A_CAR);
  bfr* HF = (bfr*)(p.ACT + A_HF); bfr* Z = (bfr*)(p.ACT + A_Z);
  const int t = ltid();
  for (int it = blockIdx.x * 8 + (t >> 6); it < 2600; it += gridDim.x * 8) {
    int b = it / 1300, r = it % 1300, cc = r / 5, ch = (r % 5) * 256 + (t & 63) * 4;
    float4 h = *(const float4*)(CAR + (size_t)(b * NCH_ + cc) * 1280 + ch);
#pragma unroll 8
    for (int q = 0; q < 64; q++) { size_t o = (size_t)rowmap(d, b, cc * 64 + q) * 1280 + ch; uint4 u = *(const uint4*)(AB + o);
      h.x = (1.f - bhi(u.x)) * h.x + blo(u.x); h.y = (1.f - bhi(u.y)) * h.y + blo(u.y); h.z = (1.f - bhi(u.z)) * h.z + blo(u.z); h.w = (1.f - bhi(u.w)) * h.w + blo(u.w);
      if (d == 0) *(uint2*)(HF + o) = uint2{pk2(h.x, h.y), pk2(h.z, h.w)};
      else { uint2 hf = *(const uint2*)(HF + o), zz = *(const uint2*)(Z + o);
        *(uint2*)(Z + o) = uint2{pk2((blo(hf.x) + h.x) * siluf(blo(zz.x)), (bhi(hf.x) + h.y) * siluf(bhi(zz.x))), pk2((blo(hf.y) + h.z) * siluf(blo(zz.y)), (bhi(hf.y) + h.w) * siluf(bhi(zz.y)))}; } }
  }
}
__device__ __forceinline__ void ph_ml_stat(const P& p) {
  const bfr* HS = (const bfr*)(p.ACT + A_HS); float* RS = (float*)(p.ACT + A_RSTD);
  const int lane = ltid() & 63, wid = ltid() >> 6;
  for (int it = blockIdx.x; it < 4160; it += gridDim.x) {
    int row = it * 8 + wid; const bfr* hp = HS + (size_t)row * 2048 + lane * 32; float ss = 0.f;
#pragma unroll
    for (int i = 0; i < 4; i++) { uint4 u = *(const uint4*)(hp + i * 8); float a;
      a = blo(u.x); ss += a * a; a = bhi(u.x); ss += a * a; a = blo(u.y); ss += a * a; a = bhi(u.y); ss += a * a;
      a = blo(u.z); ss += a * a; a = bhi(u.z); ss += a * a; a = blo(u.w); ss += a * a; a = bhi(u.w); ss += a * a; }
    ss += __shfl_xor(ss, 1); ss += __shfl_xor(ss, 2); ss += __shfl_xor(ss, 4);
    if ((lane & 7) == 0) RS[(size_t)row * 8 + (lane >> 3)] = rsqrtf(ss * (1.f / 256.f) + 1e-6f);
  }
}
__device__ __forceinline__ void ph_r7_fin(const P& p, int j) {
  bfr* Y = (bfr*)(p.ACT + A_Y); const bfr* RK = (const bfr*)(p.ACT + A_RKVZ); const float* BON = (const float*)(p.ACT + A_BON);
  const float* lg = p.r7_ln_g + (size_t)j * 1024; const float* lb = p.r7_ln_b + (size_t)j * 1024;
  const int lane = ltid() & 63, wid = ltid() >> 6;
  for (int it = blockIdx.x; it < 4160; it += gridDim.x) {
    int row = it * 8 + wid, ch = lane * 16, hd = lane >> 2;
    float y[16], v[16], z[16];
#pragma unroll
    for (int i = 0; i < 2; i++) {
      uint4 u = *(const uint4*)(Y + (size_t)row * 1024 + ch + i * 8); const uint4 u2 = *(const uint4*)(R7_Y2 + (size_t)row * 1024 + ch + i * 8);
      y[i * 8 + 0] = blo(u.x) + blo(u2.x); y[i * 8 + 1] = bhi(u.x) + bhi(u2.x); y[i * 8 + 2] = blo(u.y) + blo(u2.y); y[i * 8 + 3] = bhi(u.y) + bhi(u2.y); y[i * 8 + 4] = blo(u.z) + blo(u2.z); y[i * 8 + 5] = bhi(u.z) + bhi(u2.z); y[i * 8 + 6] = blo(u.w) + blo(u2.w); y[i * 8 + 7] = bhi(u.w) + bhi(u2.w);
      u = *(const uint4*)(RK + (size_t)row * 4096 + 2048 + ch + i * 8);
      v[i * 8 + 0] = blo(u.x); v[i * 8 + 1] = bhi(u.x); v[i * 8 + 2] = blo(u.y); v[i * 8 + 3] = bhi(u.y); v[i * 8 + 4] = blo(u.z); v[i * 8 + 5] = bhi(u.z); v[i * 8 + 6] = blo(u.w); v[i * 8 + 7] = bhi(u.w);
      u = *(const uint4*)(RK + (size_t)row * 4096 + 3072 + ch + i * 8);
      z[i * 8 + 0] = blo(u.x); z[i * 8 + 1] = bhi(u.x); z[i * 8 + 2] = blo(u.y); z[i * 8 + 3] = bhi(u.y); z[i * 8 + 4] = blo(u.z); z[i * 8 + 5] = bhi(u.z); z[i * 8 + 6] = blo(u.w); z[i * 8 + 7] = bhi(u.w);
    }
    float s = 0.f;
#pragma unroll
    for (int e = 0; e < 16; e++) s += y[e];
    s += __shfl_xor(s, 1); s += __shfl_xor(s, 2); float mean = s * (1.f / 64.f);
    float q = 0.f;
#pragma unroll
    for (int e = 0; e < 16; e++) { float dlt = y[e] - mean; q += dlt * dlt; }
    q += __shfl_xor(q, 1); q += __shfl_xor(q, 2); float rs = rsqrtf(q * (1.f / 64.f) + 64e-5f);
    float bon = BON[(size_t)row * 16 + hd] + BON[(size_t)(R_ + row) * 16 + hd];
    float o[16];
#pragma unroll
    for (int e = 0; e < 16; e++) { float yn = (y[e] - mean) * rs * lg[ch + e] + lb[ch + e]; o[e] = (yn + bon * v[e]) * siluf(z[e]); }
#pragma unroll
    for (int i = 0; i < 2; i++)
      *(uint4*)(Y + (size_t)row * 1024 + ch + i * 8) = uint4{pk2(o[i * 8], o[i * 8 + 1]), pk2(o[i * 8 + 2], o[i * 8 + 3]), pk2(o[i * 8 + 4], o[i * 8 + 5]), pk2(o[i * 8 + 6], o[i * 8 + 7])};
  }
}

#define QS 136
#define VS 72
#define MLG_BYTES 45056
__device__ __forceinline__ void ph_ml_scan(const P& p, int j, char* smem0) {
  const int d = ltid() >> 8;
  char* smem = smem0 + d * MLG_BYTES;
  bfr* sQ = (bfr*)smem; bfr* sK = sQ + 64 * QS; bfr* sVT = sK + 64 * QS; bfr* sCT = sVT + 16 * VS;
  float* sN = (float*)(sCT + 16 * QS);
  float* sEs = sN + 128; float* sCt = sEs + 64; float* sBc = sCt + 64; float* sWg = sBc + 64; float* sNr = sWg + 64; bfr* sNb = (bfr*)(sNr + 256); float* sMisc = (float*)(sNb + 128);
  const bfr* QKV = (const bfr*)(p.ACT + A_QKV); const float* GT = (const float*)(p.ACT + A_GATE); bfr* HS = (bfr*)(p.ACT + A_HS);
  const float* gbias = p.ml_gate_b + (size_t)j * 32;
  const int tid = ltid() & 255, lane = tid & 63, w = tid >> 6, l15 = lane & 15, q4 = lane >> 4;
  for (int it = blockIdx.x; it < 256; it += gridDim.x) {
    const int b = it >> 7, hh = (it >> 4) & 7, sl = it & 15;
    f32x4 Cacc[2];
    Cacc[0] = f32x4{0.f, 0.f, 0.f, 0.f}; Cacc[1] = f32x4{0.f, 0.f, 0.f, 0.f};
    float mcur = 0.f;
    for (int i = tid; i < 16 * QS; i += 256) sCT[i] = 0;
    if (tid < 128) { sN[tid] = 0.f; sNb[tid] = 0; }
    uint4 pq0, pq1, pq2, pq3, pk0, pk1, pk2, pk3, pv = uint4{0u, 0u, 0u, 0u}; float pgi = 0.f, pgf = 0.f;
#define ML_ROW0(s_) (d == 0 ? b * BT_ + 64 * (s_) : rowmap(1, b, 64 * (s_) + 63))
#define ML_LD(i_, PQ, PK) { int idx = tid + 256 * (i_), rho = idx >> 4, c8 = idx & 15; const bfr* src = QKV + (size_t)(r0n + rho) * 4096 + hh * 128 + c8 * 8; PQ = *(const uint4*)src; PK = *(const uint4*)(src + 1024); }
#define ML_ISSUE(s_) { const int r0n = ML_ROW0(s_); ML_LD(0, pq0, pk0) ML_LD(1, pq1, pk1) ML_LD(2, pq2, pk2) ML_LD(3, pq3, pk3) \
      if (tid < 128) pv = *(const uint4*)(QKV + (size_t)(r0n + (tid >> 1)) * 4096 + 2048 + hh * 256 + sl * 16 + (tid & 1) * 8); \
      if (w == 0) { const float* gp_ = GT + (size_t)(r0n + (d ? 63 - lane : lane)) * 32 + d * 16 + hh; pgi = gp_[0]; pgf = gp_[8]; } }
#define ML_ST(i_, PQ, PK) { int idx = tid + 256 * (i_), rho = idx >> 4, c8 = idx & 15; *(uint4*)(sQ + rho * QS + c8 * 8) = PQ; *(uint4*)(sK + rho * QS + c8 * 8) = PK; }
#define ML_COMMIT() { ML_ST(0, pq0, pk0) ML_ST(1, pq1, pk1) ML_ST(2, pq2, pk2) ML_ST(3, pq3, pk3) \
      if (tid < 128) { int rho = tid >> 1, vb = (tid & 1) * 8; \
        sVT[(vb + 0) * VS + rho] = (bfr)(pv.x & 0xffff); sVT[(vb + 1) * VS + rho] = (bfr)(pv.x >> 16); \
        sVT[(vb + 2) * VS + rho] = (bfr)(pv.y & 0xffff); sVT[(vb + 3) * VS + rho] = (bfr)(pv.y >> 16); \
        sVT[(vb + 4) * VS + rho] = (bfr)(pv.z & 0xffff); sVT[(vb + 5) * VS + rho] = (bfr)(pv.z >> 16); \
        sVT[(vb + 6) * VS + rho] = (bfr)(pv.w & 0xffff); sVT[(vb + 7) * VS + rho] = (bfr)(pv.w >> 16); } }
    ML_ISSUE(0)
    __syncthreads();
    for (int s = 0; s < NCH_; s++) {
      const int r0 = ML_ROW0(s);
      ML_COMMIT()
      if (w == 0) {
        int rho = d ? 63 - lane : lane;
        float gi = pgi + gbias[(d * 2 + 0) * 8 + hh], gf = pgf + gbias[(d * 2 + 1) * 8 + hh];
        float fc = fminf(gf, 0.f) - __logf(1.f + __expf(-fabsf(gf)));
        float bc = fc;
        for (int o = 1; o < 64; o <<= 1) { float t = __shfl_up(bc, o); if (lane >= o) bc += t; }
        float e = gi - bc, pm = e;
        for (int o = 1; o < 64; o <<= 1) { float t = __shfl_up(pm, o); if (lane >= o) pm = fmaxf(pm, t); }
        float pml = __shfl(pm, 63), bcl = __shfl(bc, 63);
        const float mx_ = fmaxf(mcur, pml);
        sEs[rho] = __expf(fminf(e, 80.f)); sCt[rho] = -fmaxf(mcur, pm); sBc[rho] = bc; sWg[rho] = __expf(e - mx_);
        if (lane == 0) { sMisc[0] = mcur; sMisc[1] = __expf(mcur - mx_); }
        mcur = bcl + mx_;
      }
      __syncthreads();
      const float mold = sMisc[0], decay = sMisc[1];

      const int rt = 16 * w + l15;
      bfr* hp = HS + (size_t)(r0 + rt) * 2048 + hh * 256 + sl * 16 + 4 * q4;
      bool first; { int rc = (r0 - b * BT_) >> 6; if (d == 0) { int sp = rc < 4 ? 3 - rc : 263 - rc; first = s < sp; } else first = s < rc; }
      unsigned long long uu = 0ull;
      if (!first) uu = __hip_atomic_load((unsigned long long*)hp, __ATOMIC_RELAXED, __HIP_MEMORY_SCOPE_AGENT);
      if (s + 1 < NCH_) ML_ISSUE(s + 1)
      bf16x8 qf[4];
#pragma unroll
      for (int ks = 0; ks < 4; ks++) qf[ks] = *(const bf16x8*)(sQ + (16 * w + l15) * QS + ks * 32 + q4 * 8);
      f32x4 sacc[4];
#pragma unroll
      for (int a = 0; a < 4; a++) { sacc[a] = f32x4{0.f, 0.f, 0.f, 0.f};
#pragma unroll
        for (int ks = 0; ks < 4; ks++) { bf16x8 kf = *(const bf16x8*)(sK + (16 * a + l15) * QS + ks * 32 + q4 * 8); sacc[a] = __builtin_amdgcn_mfma_f32_16x16x32_bf16(kf, qf[ks], sacc[a], 0, 0, 0); } }
      const float ctt = sCt[rt]; const float ect = __expf(ctt); float densum = 0.f;
#pragma unroll
      for (int a = 0; a < 4; a++) { const float4 ex4 = *(const float4*)(sEs + 16 * a + 4 * q4); const float exv[4] = {ex4.x, ex4.y, ex4.z, ex4.w};
#pragma unroll
        for (int jj = 0; jj < 4; jj++) { int rs_ = 16 * a + 4 * q4 + jj; bool valid = d == 0 ? rs_ <= rt : rs_ >= rt;
          float wv = valid ? ect * exv[jj] : 0.f; float sv = sacc[a][jj] * wv; sacc[a][jj] = sv; densum += sv; } }
      densum += __shfl_xor(densum, 16); densum += __shfl_xor(densum, 32);
      bf16x8 sf[2], vf[2];
#pragma unroll
      for (int ks = 0; ks < 2; ks++) {
#pragma unroll
        for (int jj = 0; jj < 4; jj++) { sf[ks][jj] = (short)f2b(sacc[2 * ks][jj]); sf[ks][4 + jj] = (short)f2b(sacc[2 * ks + 1][jj]); }
        uint2 v0 = *(const uint2*)(sVT + l15 * VS + 32 * ks + 4 * q4), v1 = *(const uint2*)(sVT + l15 * VS + 32 * ks + 16 + 4 * q4);
        uint4 vv = uint4{v0.x, v0.y, v1.x, v1.y}; vf[ks] = *(bf16x8*)&vv;
      }
      f32x4 num = f32x4{0.f, 0.f, 0.f, 0.f}, numC = f32x4{0.f, 0.f, 0.f, 0.f};
#pragma unroll
      for (int ks = 0; ks < 2; ks++) num = __builtin_amdgcn_mfma_f32_16x16x32_bf16(vf[ks], sf[ks], num, 0, 0, 0);
#pragma unroll
      for (int ks = 0; ks < 4; ks++) { bf16x8 cf = *(const bf16x8*)(sCT + l15 * QS + ks * 32 + q4 * 8); numC = __builtin_amdgcn_mfma_f32_16x16x32_bf16(cf, qf[ks], numC, 0, 0, 0); }
      f32x4 qnacc = f32x4{0.f, 0.f, 0.f, 0.f};
#pragma unroll
      for (int ks = 0; ks < 4; ks++) { bf16x8 na = bf16x8{0, 0, 0, 0, 0, 0, 0, 0}; if (l15 == 0) na = *(const bf16x8*)(sNb + ks * 32 + q4 * 8);
        qnacc = __builtin_amdgcn_mfma_f32_16x16x32_bf16(na, qf[ks], qnacc, 0, 0, 0); }
      const float qn = __shfl(qnacc[0], l15);
      {
        float inter = __expf(mold + ctt); float den = densum + inter * qn; float dn = fmaxf(fabsf(den), __expf(ctt - sBc[rt])); float inv = __builtin_amdgcn_rcpf(dn);
        f32x4 hv;
#pragma unroll
        for (int jj = 0; jj < 4; jj++) hv[jj] = (num[jj] + inter * numC[jj]) * inv;
        if (!first) { unsigned ux = (unsigned)uu, uy = (unsigned)(uu >> 32);
          hv[0] += blo(ux); hv[1] += bhi(ux); hv[2] += blo(uy); hv[3] += bhi(uy); }
        store4b(hp, hv);
      }
      __syncthreads();
      {
        bf16x8 vw[2], wa[2];
#pragma unroll
        for (int ks = 0; ks < 2; ks++)
#pragma unroll
          for (int e = 0; e < 8; e++) { int rs_ = 32 * ks + (e < 4 ? 4 * q4 + e : 16 + 4 * q4 + e - 4); const float wg_ = sWg[rs_]; vw[ks][e] = (short)f2b(b2f((bfr)vf[ks][e]) * wg_); wa[ks][e] = l15 == 0 ? (short)f2b(wg_) : (short)0; }
#pragma unroll
        for (int a = 0; a < 2; a++) {
          int dk = 32 * w + 16 * a + l15;
#pragma unroll
          for (int jj = 0; jj < 4; jj++) Cacc[a][jj] *= decay;
          f32x4 nacc = f32x4{0.f, 0.f, 0.f, 0.f};
#pragma unroll
          for (int ks = 0; ks < 2; ks++) { bf16x8 kt;
#pragma unroll
            for (int e = 0; e < 8; e++) { int rs_ = 32 * ks + (e < 4 ? 4 * q4 + e : 16 + 4 * q4 + e - 4); kt[e] = (short)sK[rs_ * QS + dk]; }
            Cacc[a] = __builtin_amdgcn_mfma_f32_16x16x32_bf16(vw[ks], kt, Cacc[a], 0, 0, 0);
            nacc = __builtin_amdgcn_mfma_f32_16x16x32_bf16(wa[ks], kt, nacc, 0, 0, 0); }
          if (q4 == 0) sNr[dk] = nacc[0];
#pragma unroll
          for (int jj = 0; jj < 4; jj++) sCT[(4 * q4 + jj) * QS + dk] = f2b(Cacc[a][jj]);
        }
      }
      __syncthreads();
      if (tid < 128) { const float nv = decay * sN[tid] + sNr[tid]; sN[tid] = nv; sNb[tid] = f2b(nv); }
    }
    __syncthreads();
  }
}

#define CS 72
#define CSLOT(i_) ((bfr*)smem + (i_) * (64 * CS))
#define A_SST (A_R7B + 362086400ull)
__device__ __forceinline__ f32x4 cmm(const bfr* X, const bfr* YT, int ti, int tj, int l15, int q4) {
  f32x4 acc = f32x4{0.f, 0.f, 0.f, 0.f};
#pragma unroll
  for (int ks = 0; ks < 2; ks++) { bf16x8 a = *(const bf16x8*)(X + (16 * ti + l15) * CS + 32 * ks + 8 * q4); bf16x8 b = *(const bf16x8*)(YT + (16 * tj + l15) * CS + 32 * ks + 8 * q4);
    acc = __builtin_amdgcn_mfma_f32_16x16x32_bf16(a, b, acc, 0, 0, 0); }
  return acc;
}
template <int MODE> __device__ __forceinline__ f32x4 cmm_mask(const bfr* X, const bfr* YT, int ti, int tj, int l15, int q4) {
  f32x4 acc = f32x4{0.f, 0.f, 0.f, 0.f};
#pragma unroll
  for (int ks = 0; ks < 2; ks++) { const int kb = 2 * ks + (q4 >> 1);
    const bool ok = MODE == 1 ? ((kb == 0 && tj == 1) || (kb == 2 && tj == 3)) : (kb < 2 && tj >= 2);
    bf16x8 a = *(const bf16x8*)(X + (16 * ti + l15) * CS + 32 * ks + 8 * q4); bf16x8 bz = bf16x8{0, 0, 0, 0, 0, 0, 0, 0};
    if (ok) bz = *(const bf16x8*)(YT + (16 * tj + l15) * CS + 32 * ks + 8 * q4);
    acc = __builtin_amdgcn_mfma_f32_16x16x32_bf16(a, bz, acc, 0, 0, 0); }
  return acc;
}
__device__ __forceinline__ void st_row(bfr* dst, int r0, int c, f32x4 v) {
#pragma unroll
  for (int jj = 0; jj < 4; jj++) dst[(r0 + jj) * CS + c] = f2b(v[jj]); }
__device__ __forceinline__ void st_tr(bfr* dst, int r0, int c, f32x4 v) { store4b(dst + c * CS + r0, v); }
__device__ __forceinline__ f32x4 ld_row(const bfr* src, int r0, int c) { f32x4 v;
#pragma unroll
  for (int jj = 0; jj < 4; jj++) v[jj] = b2f(src[(r0 + jj) * CS + c]);
  return v; }
__device__ __forceinline__ f32x4 ld_tr(const bfr* src, int r0, int c) { uint2 u = *(const uint2*)(src + c * CS + r0); return f32x4{blo(u.x), bhi(u.x), blo(u.y), bhi(u.y)}; }

__device__ __forceinline__ void ph_r7_ca(const P& p, int j, int win, char* smem) {
  float* LW = (float*)(smem + 7 * 9216); float* AT = (float*)(smem + 9 * 9216); float* WL = (float*)(smem + 14 * 9216);
  const bfr* RK = (const bfr*)(p.ACT + A_RKVZ); const bfr* WMb = (const bfr*)(p.ACT + A_WM); const bfr* AMb = (const bfr*)(p.ACT + A_AM);
  float* BON = (float*)(p.ACT + A_BON); bfr* WB = p.H;
  const float* kkp = p.r7_k_k + (size_t)j * 1024; const float* kap = p.r7_k_a + (size_t)j * 1024; const float* rkp = p.r7_r_k + (size_t)j * 1024;
  const int tid = ltid(), lane = tid & 63, w = tid >> 6, l15 = lane & 15, q4 = lane >> 4, ti = w >> 1, tj0 = (w & 1) * 2;
  const int c0 = win * 20;
  for (int it = blockIdx.x; it < 1280; it += gridDim.x) {
    const int chain = it / 20, cl = it - chain * 20, c = c0 + cl, d = chain & 1, b = chain >> 5, h = (chain >> 1) & 15;
    {
      const int rowA = rowmap(d, b, 64 * c + 16 * ti + l15);
      const float* w0 = p.r7_w0 + (size_t)(j * 2 + d) * 1024 + h * 64; const float* a0 = p.r7_a0 + (size_t)(j * 2 + d) * 1024 + h * 64;
#pragma unroll
      for (int tt = 0; tt < 2; tt++) { const int tj = tj0 + tt; f32x4 aw = f32x4{0.f, 0.f, 0.f, 0.f}, aa = aw;
#pragma unroll
        for (int ks = 0; ks < 2; ks++) {
          bf16x8 xw = *(const bf16x8*)(WMb + (size_t)rowA * 128 + d * 64 + 32 * ks + 8 * q4), xa = *(const bf16x8*)(AMb + (size_t)rowA * 128 + d * 64 + 32 * ks + 8 * q4);
          bf16x8 yw = *(const bf16x8*)(p.W + WR_UP + d * 65536 + (size_t)(h * 64 + 16 * tj + l15) * 64 + 32 * ks + 8 * q4);
          bf16x8 ya = *(const bf16x8*)(p.W + WR_UP + (2 + d) * 65536 + (size_t)(h * 64 + 16 * tj + l15) * 64 + 32 * ks + 8 * q4);
          aw = __builtin_amdgcn_mfma_f32_16x16x32_bf16(xw, yw, aw, 0, 0, 0); aa = __builtin_amdgcn_mfma_f32_16x16x32_bf16(xa, ya, aa, 0, 0, 0); }
        const int ch = 16 * tj + l15; const float w0v = w0[ch], a0v = a0[ch];
#pragma unroll
        for (int jj = 0; jj < 4; jj++) { const int tau = 16 * ti + 4 * q4 + jj; LW[tau * 64 + ch] = -0.6065306597126334f * sigm(w0v + aw[jj]); AT[tau * 64 + ch] = sigm(a0v + aa[jj]); }
      }
    }
    __syncthreads();
    if (tid < 64) { float acc = 0.f;
#pragma unroll 8
      for (int t = 0; t < 64; t++) { acc += LW[t * 64 + tid]; LW[t * 64 + tid] = acc; } }
    __syncthreads();
    {
      const int tau = tid >> 3, sc = tid & 7, col = h * 64 + sc * 8; const int row = rowmap(d, b, 64 * c + tau);
      const bfr* rp = RK + (size_t)row * 4096 + col; uint4 pr = *(const uint4*)rp, pk = *(const uint4*)(rp + 1024);
      unsigned ur[4] = {pr.x, pr.y, pr.z, pr.w}, uk[4] = {pk.x, pk.y, pk.z, pk.w};
      float r8[8], k8[8], kr[8];
#pragma unroll
      for (int e = 0; e < 4; e++) { r8[2 * e] = blo(ur[e]); r8[2 * e + 1] = bhi(ur[e]); k8[2 * e] = blo(uk[e]); k8[2 * e + 1] = bhi(uk[e]); }
      float ss = 0.f;
#pragma unroll
      for (int e = 0; e < 8; e++) { kr[e] = k8[e] * kkp[col + e]; ss += kr[e] * kr[e]; }
      ss += __shfl_xor(ss, 1); ss += __shfl_xor(ss, 2); ss += __shfl_xor(ss, 4);
      const float inv = __builtin_amdgcn_rsqf(fmaxf(ss, 1e-24f));
      float bon = 0.f, o0[8], o1[8], o2[8], o3[8], o4[8], o5[8];
#pragma unroll
      for (int e = 0; e < 8; e++) {
        const float cw = LW[tau * 64 + sc * 8 + e], cwm = tau > 0 ? LW[(tau - 1) * 64 + sc * 8 + e] : 0.f, cwl = LW[63 * 64 + sc * 8 + e], a = AT[tau * 64 + sc * 8 + e];
        const float ka = kr[e] * inv, be = a * ka, kd = k8[e] * (1.f + (a - 1.f) * kap[col + e]); bon += r8[e] * kd * rkp[col + e];
        const float e2 = __expf(-cw), e4 = __expf(cwl - cw);
        o0[e] = ka * __expf(cwm); o1[e] = be * e2; o2[e] = kd * e2; o3[e] = r8[e] * __expf(cw); o4[e] = be * e4; o5[e] = kd * e4;
        if (tau == 63) WL[sc * 8 + e] = __expf(cwl);
      }
      bon += __shfl_xor(bon, 1); bon += __shfl_xor(bon, 2); bon += __shfl_xor(bon, 4);
      if (sc == 0) BON[((size_t)d * R_ + row) * 16 + h] = bon;
      *(uint4*)(CSLOT(0) + tau * CS + sc * 8) = uint4{pk2(o0[0], o0[1]), pk2(o0[2], o0[3]), pk2(o0[4], o0[5]), pk2(o0[6], o0[7])};
      *(uint4*)(CSLOT(1) + tau * CS + sc * 8) = uint4{pk2(o1[0], o1[1]), pk2(o1[2], o1[3]), pk2(o1[4], o1[5]), pk2(o1[6], o1[7])};
      *(uint4*)(CSLOT(2) + tau * CS + sc * 8) = uint4{pk2(o2[0], o2[1]), pk2(o2[2], o2[3]), pk2(o2[4], o2[5]), pk2(o2[6], o2[7])};
      *(uint4*)(CSLOT(3) + tau * CS + sc * 8) = uint4{pk2(o3[0], o3[1]), pk2(o3[2], o3[3]), pk2(o3[4], o3[5]), pk2(o3[6], o3[7])};
#pragma unroll
      for (int e = 0; e < 8; e++) { CSLOT(4)[(sc * 8 + e) * CS + tau] = f2b(o0[e]); CSLOT(5)[(sc * 8 + e) * CS + tau] = f2b(o4[e]); CSLOT(6)[(sc * 8 + e) * CS + tau] = f2b(o5[e]); }
    }
    __syncthreads();
#pragma unroll
    for (int tt = 0; tt < 2; tt++) { const int tj = tj0 + tt, r0 = 16 * ti + 4 * q4, cc = 16 * tj + l15;
      f32x4 v = cmm(CSLOT(1), CSLOT(0), ti, tj, l15, q4);
#pragma unroll
      for (int jj = 0; jj < 4; jj++) if (!(r0 + jj < cc)) v[jj] = 0.f;
      st_row(CSLOT(7), r0, cc, v); st_tr(CSLOT(8), r0, cc, v);
      v = cmm(CSLOT(2), CSLOT(0), ti, tj, l15, q4);
#pragma unroll
      for (int jj = 0; jj < 4; jj++) if (!(r0 + jj < cc)) v[jj] = 0.f;
      st_row(CSLOT(9), r0, cc, v);
      v = cmm(CSLOT(3), CSLOT(1), ti, tj, l15, q4);
#pragma unroll
      for (int jj = 0; jj < 4; jj++) if (!(cc <= r0 + jj)) v[jj] = 0.f;
      st_row(CSLOT(10), r0, cc, v);
      v = cmm(CSLOT(3), CSLOT(2), ti, tj, l15, q4);
#pragma unroll
      for (int jj = 0; jj < 4; jj++) if (!(cc <= r0 + jj)) v[jj] = 0.f;
      st_row(CSLOT(11), r0, cc, v);
    }
    __syncthreads();
    {
      float* X = (float*)CSLOT(0);
      const bfr* Ab = CSLOT(7);
      const int cl = lane >> 3, pp = lane & 7, cx = 8 * w + cl, blk0 = (w >> 1) * 16;
#pragma unroll 1
      for (int il = 15; il >= 0; il--) { const int i = blk0 + il;
        float sum = 0.f;
#pragma unroll 1
        for (int jx = i + 1 + pp; jx < blk0 + 16; jx += 8) sum += b2f(Ab[i * CS + jx]) * X[jx * 72 + cx];
        sum += dppf<0xB1>(sum); sum += dppf<0x4E>(sum); sum += dppf<0x141>(sum);
        const float xv = (i == cx ? 1.f : 0.f) - sum;
        if (pp == 0) X[i * 72 + cx] = xv;
      }
      __syncthreads();
#pragma unroll 1
      for (int e = tid; e < 4096; e += 512) { const int i = e >> 6, c2 = e & 63; const bfr tv = ((i >> 4) == (c2 >> 4)) ? f2b(X[i * 72 + c2]) : (bfr)0; CSLOT(2)[i * CS + c2] = tv; CSLOT(12)[c2 * CS + i] = tv; }
      __syncthreads();
#pragma unroll
      for (int tt = 0; tt < 2; tt++) { const int tj = tj0 + tt, r0 = 16 * ti + 4 * q4, cc = 16 * tj + l15; st_row(CSLOT(13), r0, cc, cmm_mask<1>(CSLOT(2), CSLOT(8), ti, tj, l15, q4)); }
      __syncthreads();
#pragma unroll
      for (int tt = 0; tt < 2; tt++) { const int tj = tj0 + tt, r0 = 16 * ti + 4 * q4, cc = 16 * tj + l15;
        f32x4 v = ld_row(CSLOT(2), r0, cc) - cmm(CSLOT(13), CSLOT(12), ti, tj, l15, q4); st_row(CSLOT(0), r0, cc, v); st_tr(CSLOT(1), r0, cc, v); }
      __syncthreads();
#pragma unroll
      for (int tt = 0; tt < 2; tt++) { const int tj = tj0 + tt, r0 = 16 * ti + 4 * q4, cc = 16 * tj + l15; st_row(CSLOT(13), r0, cc, cmm_mask<2>(CSLOT(0), CSLOT(8), ti, tj, l15, q4)); }
      __syncthreads();
#pragma unroll
      for (int tt = 0; tt < 2; tt++) { const int tj = tj0 + tt, r0 = 16 * ti + 4 * q4, cc = 16 * tj + l15;
        f32x4 v = ld_row(CSLOT(0), r0, cc) - cmm(CSLOT(13), CSLOT(1), ti, tj, l15, q4);
#pragma unroll
        for (int jj = 0; jj < 4; jj++) if (r0 + jj == cc) v[jj] -= 1.f;
        st_row(CSLOT(2), r0, cc, v); }
      __syncthreads();
    }
#pragma unroll
    for (int tt = 0; tt < 2; tt++) { const int tj = tj0 + tt, r0 = 16 * ti + 4 * q4, cc = 16 * tj + l15;
      f32x4 g = cmm(CSLOT(10), CSLOT(2), ti, tj, l15, q4) + ld_row(CSLOT(10), r0, cc); st_row(CSLOT(12), r0, cc, g);
      f32x4 hh = cmm(CSLOT(5), CSLOT(2), ti, tj, l15, q4) + ld_row(CSLOT(5), r0, cc); st_row(CSLOT(13), r0, cc, hh); }
    __syncthreads();
    {
      bfr* out = WB + (size_t)(chain * 20 + cl) * 16384;
#pragma unroll
      for (int tt = 0; tt < 2; tt++) { const int tj = tj0 + tt, r0 = 16 * ti + 4 * q4, cc = 16 * tj + l15;
        f32x4 v = ld_tr(CSLOT(3), r0, cc) - cmm(CSLOT(4), CSLOT(12), ti, tj, l15, q4);
        store4b(out + cc * 64 + r0, v);
        v = ld_tr(CSLOT(11), r0, cc) - cmm(CSLOT(9), CSLOT(12), ti, tj, l15, q4);
        store4b(out + 4096 + cc * 64 + r0, v);
        v = -cmm(CSLOT(4), CSLOT(13), ti, tj, l15, q4);
#pragma unroll
        for (int jj = 0; jj < 4; jj++) if (r0 + jj == cc) v[jj] += WL[cc];
        store4b(out + 8192 + cc * 64 + r0, v);
        v = ld_tr(CSLOT(6), r0, cc) - cmm(CSLOT(9), CSLOT(13), ti, tj, l15, q4);
        store4b(out + 12288 + cc * 64 + r0, v);
      }
    }
    __syncthreads();
  }
}

__device__ __forceinline__ void ph_r7_cb(const P& p, int win, char* smem) {
  bfr* Sh = (bfr*)smem; bfr* Sl = Sh + 2 * 16 * CS; bfr* VT = Sl + 2 * 16 * CS;
  const bfr* WB = p.H; const bfr* RK = (const bfr*)(p.ACT + A_RKVZ); bfr* SST = (bfr*)(p.ACT + A_SST);
  const int tid = ltid(), lane = tid & 63, w = tid >> 6, l15 = lane & 15, q4 = lane >> 4;
  const int c0 = win * 20;
  for (int it = blockIdx.x; it < 256; it += gridDim.x) {
    const int d = it & 1, b = it >> 7, h = (it >> 3) & 15, rg = (it >> 1) & 3, chain = (b * 16 + h) * 2 + d;
    bfr* Y = d ? R7_Y2 : (bfr*)(p.ACT + A_Y);
    bfr* sst = SST + (size_t)(chain * 4 + rg) * 2048;
    __syncthreads();
    if (tid < 256) { const int hl = tid >> 7, e = tid & 127, rr = e >> 3, c8 = e & 7; uint4 v = uint4{0u, 0u, 0u, 0u};
      if (win > 0) v = *(const uint4*)(sst + hl * 1024 + rr * 64 + c8 * 8);
      *(uint4*)((hl ? Sl : Sh) + rr * CS + c8 * 8) = v; }
    const int vtau = tid >> 3, vp = tid & 7;
    { const int row = rowmap(d, b, 64 * c0 + vtau); unsigned vv = *(const unsigned*)(RK + (size_t)row * 4096 + 2048 + h * 64 + rg * 16 + 2 * vp);
      VT[(2 * vp) * CS + vtau] = (bfr)(vv & 0xffff); VT[(2 * vp + 1) * CS + vtau] = (bfr)(vv >> 16); }
    const bfr* bbase = WB + (size_t)(chain * 20) * 16384 + (w < 4 ? 8192 + (16 * w + l15) * 64 : (16 * (w - 4) + l15) * 64) + 8 * q4;
    bf16x8 rb1[4][2], rb2[4][2]; unsigned rv[4];
#define CB_LOAD(u_, s_) { const int ss_ = (s_) < 20 ? (s_) : 19; const bfr* bp_ = bbase + (size_t)ss_ * 16384; \
      rb1[u_][0] = *(const bf16x8*)bp_; rb1[u_][1] = *(const bf16x8*)(bp_ + 32); rb2[u_][0] = *(const bf16x8*)(bp_ + 4096); rb2[u_][1] = *(const bf16x8*)(bp_ + 4096 + 32); \
      const int sv_ = ss_ + 1 < 20 ? ss_ + 1 : 19; const int rowv_ = rowmap(d, b, 64 * (c0 + sv_) + vtau); \
      rv[u_] = *(const unsigned*)(RK + (size_t)rowv_ * 4096 + 2048 + h * 64 + rg * 16 + 2 * vp); }
    CB_LOAD(0, 0) CB_LOAD(1, 1) CB_LOAD(2, 2) CB_LOAD(3, 3)
    __syncthreads();
    for (int g = 0; g < 5; g++) {
#pragma unroll
      for (int u = 0; u < 4; u++) {
        const int s = 4 * g + u;
        if (s < 20) {
          const int cur = s & 1, nxt = cur ^ 1, c = c0 + s;
          bf16x8 sh[2], sl[2], vt[2];
#pragma unroll
          for (int ks = 0; ks < 2; ks++) { sh[ks] = *(const bf16x8*)(Sh + (cur * 16 + l15) * CS + 32 * ks + 8 * q4); sl[ks] = *(const bf16x8*)(Sl + (cur * 16 + l15) * CS + 32 * ks + 8 * q4);
            vt[ks] = *(const bf16x8*)(VT + (cur * 16 + l15) * CS + 32 * ks + 8 * q4); }
          f32x4 a1 = f32x4{0.f, 0.f, 0.f, 0.f}, a2 = a1;
#pragma unroll
          for (int ks = 0; ks < 2; ks++) { a1 = __builtin_amdgcn_mfma_f32_16x16x32_bf16(sh[ks], rb1[u][ks], a1, 0, 0, 0); a2 = __builtin_amdgcn_mfma_f32_16x16x32_bf16(vt[ks], rb2[u][ks], a2, 0, 0, 0); }
#pragma unroll
          for (int ks = 0; ks < 2; ks++) a1 = __builtin_amdgcn_mfma_f32_16x16x32_bf16(sl[ks], rb1[u][ks], a1, 0, 0, 0);
          a1 = a1 + a2;
          if (w < 4) {
#pragma unroll
            for (int jj = 0; jj < 4; jj++) { const bfr hi = f2b(a1[jj]); Sh[(nxt * 16 + 4 * q4 + jj) * CS + 16 * w + l15] = hi; Sl[(nxt * 16 + 4 * q4 + jj) * CS + 16 * w + l15] = f2b(a1[jj] - b2f(hi)); }
          } else {
            const int rowy = rowmap(d, b, 64 * c + 16 * (w - 4) + l15);
            store4b(Y + (size_t)rowy * 1024 + h * 64 + rg * 16 + 4 * q4, a1);
          }
          if (s + 1 < 20) { VT[(nxt * 16 + 2 * vp) * CS + vtau] = (bfr)(rv[u] & 0xffff); VT[(nxt * 16 + 2 * vp + 1) * CS + vtau] = (bfr)(rv[u] >> 16); }
          if (s + 4 < 20) CB_LOAD(u, s + 4)
          __syncthreads();
        }
      }
    }
    if (tid < 256) { const int hl = tid >> 7, e = tid & 127, rr = e >> 3, c8 = e & 7; *(uint4*)(sst + hl * 1024 + rr * 64 + c8 * 8) = *(const uint4*)((hl ? Sl : Sh) + rr * CS + c8 * 8); }
  }
}

__device__ __forceinline__ void run_phase(const P& p, int ph, int layer, int d, char* smem) {
  Ctx c; c.layer = layer; c.j = layer / 3; c.d = d; c.wc = layer < 3 ? 1 : 0;
  switch (ph) {
    case PH_PRE: ph_pre(p, smem); break;
    case PH_NORM: ph_norm(p, layer, smem); break;
    case PH_LRU_IN: big_gemm(smem, p.H, p.W, 2560, 1024, F_LruIn{p.ACT}); break;
    case PH_LRU_CONV: ph_lru_conv(p, c.j); break;
    case PH_LRU_GATE: gemm_phase<G_LruGate>(p, c, smem); break;
    case PH_LRU_S1: ph_lru_s1(p, d); break;
    case PH_LRU_S2: ph_lru_s2(p, smem); break;
    case PH_LRU_S3: ph_lru_s3(p, d); break;
    case PH_LRU_OUT: big_gemm(smem, (const bfr*)(p.ACT + A_Z), p.W + WL_OUT, 1024, 1280, F_Resid{p.Xx, p.Xc, p.MOD + (size_t)layer * 3 * 3072, c.wc}); break;
    case PH_ML_IN: big_gemm(smem, p.H, p.W, 4352, 1024, F_MlIn{p.ACT}); break;
    case PH_ML_SCAN: ph_ml_scan(p, c.j, smem); break;
    case PH_ML_STAT: ph_ml_stat(p); break;
    case PH_ML_Z: big_gemm(smem, p.H, p.W + WM_Z, 2048, 1024, F_MlZ{p.ACT, p.ml_norm_g + (size_t)c.j * 2048}); break;
    case PH_ML_OUT: big_gemm(smem, (const bfr*)(p.ACT + A_HS), p.W + WM_OUT, 1024, 2048, F_Resid{p.Xx, p.Xc, p.MOD + (size_t)layer * 3 * 3072, c.wc}); break;
    case PH_R7_IN: big_gemm(smem, p.H, p.W, 4352, 2048, F_R7In{p.ACT}); break;
    case PH_R7_SHIFT: ph_r7_shift(p); break;
    case PH_R7_CA: ph_r7_ca(p, c.j, d, smem); break;
    case PH_R7_CB: ph_r7_cb(p, d, smem); break;
    case PH_R7_FIN: ph_r7_fin(p, c.j); break;
    case PH_R7_OUT: big_gemm(smem, (const bfr*)(p.ACT + A_Y), p.W + WR_OUT, 1024, 1024, F_Resid{p.Xx, p.Xc, p.MOD + (size_t)layer * 3 * 3072, c.wc}); break;
    case PH_FINAL: ph_final(p); break;
  }
}


#define XB_TMO      128
#define XB_XCNT(j)  (256  + 64 * (j))
#define XB_XSUB(j)  (1280 + 64 * (j))
#define XB_XGEN(j)  (2304 + 64 * (j))
#define XB_TOP      3328
#define XB_TOPGEN   3392
#define XCD_BAR_WORDS 3456
#define XB_SPIN_CAP (1u << 18)
#define OFF_BAR 527000064ull
#define OFF_CL (OFF_BAR + 16384ull)
__device__ __forceinline__ unsigned xb_ld(unsigned* p)              { return __hip_atomic_load(p, __ATOMIC_RELAXED, __HIP_MEMORY_SCOPE_AGENT); }
__device__ __forceinline__ unsigned xb_add(unsigned* p, unsigned v) { return __hip_atomic_fetch_add(p, v, __ATOMIC_RELAXED, __HIP_MEMORY_SCOPE_AGENT); }
__device__ __forceinline__ unsigned xb_xcc_id() { return (unsigned)__builtin_amdgcn_s_getreg((3 << 11) | 20) & 0xFu; }
#define XB_SPIN(cond, bar) do { unsigned _sp = 0; while (cond) { __builtin_amdgcn_s_sleep(1); \
    if ((++_sp & 255u) == 0u) { if (xb_ld(&(bar)[XB_TMO])) break; if (_sp > XB_SPIN_CAP) { atomicAdd(&(bar)[XB_TMO], 1u); break; } } } } while (0)
struct XcdBarrier { unsigned* bar; unsigned x; volatile __attribute__((address_space(3))) unsigned* st; };
__device__ __forceinline__ XcdBarrier xcd_barrier_post(unsigned* bar, volatile __attribute__((address_space(3))) unsigned* st) {
  XcdBarrier b; b.bar = bar; b.x = xb_xcc_id(); b.st = st;
  if (threadIdx.x == 0) (void)xb_add(&bar[XB_XCNT(b.x)], 1u);
  return b;
}
__device__ __forceinline__ void xcd_barrier_complete(unsigned* bar, unsigned x, unsigned& nloc, unsigned& nx) {
  const unsigned G = gridDim.x * gridDim.y * gridDim.z;
  unsigned sum, cnt, mine, sp = 0u;
  for (;;) {
    sum = 0u; cnt = 0u; mine = 0u;
#pragma unroll
    for (unsigned j = 0; j < 16; ++j) { const unsigned c = xb_ld(&bar[XB_XCNT(j)]); sum += c; cnt += (c > 0u) ? 1u : 0u; mine = (j == x) ? c : mine; }
    if (sum == G) break;
    __builtin_amdgcn_s_sleep(1);
    if ((++sp & 255u) == 0u) { if (xb_ld(&bar[XB_TMO])) break; if (sp > XB_SPIN_CAP) { atomicAdd(&bar[XB_TMO], 1u); break; } }
  }
  nloc = mine > 0u ? mine : 1u; nx = cnt > 0u ? cnt : 1u;
}
__device__ __forceinline__ void xcd_barrier(const XcdBarrier& b) {
  asm volatile("s_waitcnt vmcnt(0)" ::: "memory");
  __syncthreads();
  if (threadIdx.x == 0) {
    unsigned* bar = b.bar;
    __builtin_amdgcn_s_waitcnt(0);
    unsigned nloc = b.st[0], nx = b.st[1];
    if (nloc == 0u) { xcd_barrier_complete(bar, b.x, nloc, nx); b.st[0] = nloc; b.st[1] = nx; }
    const unsigned old = xb_add(&bar[XB_XSUB(b.x)], 1u);
    const unsigned gen = old / nloc;
    if (old + 1u == (gen + 1u) * nloc) {
      __builtin_amdgcn_fence(__ATOMIC_RELEASE, "agent");
      asm volatile("s_waitcnt vmcnt(0)" ::: "memory");
      const unsigned og = xb_add(&bar[XB_TOP], 1u);
      const unsigned tg = og / nx;
      if (og + 1u == (tg + 1u) * nx) xb_add(&bar[XB_TOPGEN], 1u);
      else XB_SPIN(xb_ld(&bar[XB_TOPGEN]) == tg, bar);
      __builtin_amdgcn_fence(__ATOMIC_ACQUIRE, "agent");
      xb_add(&bar[XB_XGEN(b.x)], 1u);
      asm volatile("s_waitcnt vmcnt(0)" ::: "memory");
    } else {
      XB_SPIN(xb_ld(&bar[XB_XGEN(b.x)]) == gen, bar);
      __builtin_amdgcn_fence(__ATOMIC_ACQUIRE, "agent");
      asm volatile("s_waitcnt vmcnt(0)" ::: "memory");
    }
  }
  __syncthreads();
}

#define SMEM_BYTES (131072 + 64)
extern __shared__ __attribute__((aligned(16))) char dyn_smem[];
#if !MEGA
__global__ void __launch_bounds__(512, 2) phase_kernel(P p, int si) {
  run_phase(p, p.sched[si * 3], p.sched[si * 3 + 1], p.sched[si * 3 + 2], dyn_smem);
}
#else
__global__ void __launch_bounds__(512, 2) mega_kernel(P p) {
  cg::grid_group grid = cg::this_grid();
  volatile __attribute__((address_space(3))) unsigned* st = (volatile __attribute__((address_space(3))) unsigned*)(dyn_smem + 131072);
  if (threadIdx.x < 4) st[threadIdx.x] = 0u;
  __syncthreads();
  const XcdBarrier xb = xcd_barrier_post(p.bar, st);
  for (int si = 0; si < p.nsched; si++) {
    run_phase(p, p.sched[si * 3], p.sched[si * 3 + 1], p.sched[si * 3 + 2], dyn_smem);
    if (si + 1 < p.nsched) { if (si == 0) grid.sync(); else xcd_barrier(xb); }
  }
}
#endif

extern "C" void kernel_launch(void* const* d_in, const int* in_sizes, int n_in, void* d_out, int out_size, void* d_ws, size_t ws_size, hipStream_t stream) {
  P p; memset(&p, 0, sizeof(p));
  const float** f = (const float**)&p;
  for (int i = 0; i < 33; i++) f[i] = (const float*)d_in[i];
  char* ws = (char*)d_ws;
  p.Xx = (float*)d_out; p.Xc = (float*)(ws + OFF_XC); p.MOD = (float*)(ws + OFF_MOD); p.W = (bfr*)(ws + OFF_W); p.H = (bfr*)(ws + OFF_H); p.ACT = ws + OFF_ACT; p.bar = (unsigned*)(ws + OFF_BAR); p.CL = (float*)(ws + OFF_CL);
  int n = 0;
  auto add = [&](int ph, int layer, int d) { p.sched[n * 3] = ph; p.sched[n * 3 + 1] = layer; p.sched[n * 3 + 2] = d; n++; };
  add(PH_PRE, 0, 0);
  if (DUP & 4) add(PH_PRE, 0, 0);
  for (int l = 0; l < 4; l++) {
    add(PH_NORM, l, 0); if (DUP & 4) add(PH_NORM, l, 0);
    int kind = l % 3;
    const bool dg = DUP & 1, ds = DUP & 2;
    if (kind == 0) { add(PH_LRU_IN, l, 0); if (dg) add(PH_LRU_IN, l, 0); add(PH_LRU_CONV, l, 0); if (DUP & 4) add(PH_LRU_CONV, l, 0);
      for (int d = 0; d < 2; d++) { add(PH_LRU_GATE, l, d); if (dg) add(PH_LRU_GATE, l, d); add(PH_LRU_S1, l, d); if (DUP & 8) add(PH_LRU_S1, l, d); add(PH_LRU_S2, l, d); if (DUP & 16) add(PH_LRU_S2, l, d); add(PH_LRU_S3, l, d); }
      add(PH_LRU_OUT, l, 0); }
    else if (kind == 1) { add(PH_ML_IN, l, 0); if (dg) add(PH_ML_IN, l, 0); add(PH_ML_SCAN, l, 0); if (ds) add(PH_ML_SCAN, l, 0); add(PH_ML_STAT, l, 0); if (DUP & 4) add(PH_ML_STAT, l, 0); add(PH_ML_Z, l, 0); add(PH_ML_OUT, l, 0); }
    else { add(PH_R7_SHIFT, l, 0); add(PH_R7_IN, l, 0); if (dg) add(PH_R7_IN, l, 0); for (int wi = 0; wi < 13; wi++) { add(PH_R7_CA, l, wi); if (DUP & 32) add(PH_R7_CA, l, wi); add(PH_R7_CB, l, wi); } add(PH_R7_FIN, l, 0); add(PH_R7_OUT, l, 0); }
  }
  add(PH_FINAL, 0, 0);
  p.nsched = n;
  if (ws_size < WS_NEED) fprintf(stderr, "workspace too small: %zu < %llu\n", ws_size, (unsigned long long)WS_NEED);
#if MEGA
  static int grid_blocks = 0;
  if (!grid_blocks) { int dev = 0, cus = 0, per = 0; hipGetDevice(&dev); hipDeviceGetAttribute(&cus, hipDeviceAttributeMultiprocessorCount, dev);
    hipFuncSetAttribute((const void*)mega_kernel, hipFuncAttributeMaxDynamicSharedMemorySize, SMEM_BYTES);
    hipOccupancyMaxActiveBlocksPerMultiprocessor(&per, mega_kernel, 512, SMEM_BYTES); if (per > 1) per = 1; if (per < 1) per = 1; grid_blocks = cus * per; }
  hipMemsetAsync(ws + OFF_BAR, 0, XCD_BAR_WORDS * 4, stream);
  void* args[] = {&p};
  hipError_t e = hipLaunchCooperativeKernel((void*)mega_kernel, dim3(grid_blocks), dim3(512), args, SMEM_BYTES, stream);
  if (e != hipSuccess) fprintf(stderr, "cooperative launch failed: %s (grid %d)\n", hipGetErrorString(e), grid_blocks);
#else
  static int once = 0; if (!once) { once = 1; hipFuncSetAttribute((const void*)phase_kernel, hipFuncAttributeMaxDynamicSharedMemorySize, SMEM_BYTES); }
  for (int si = 0; si < n; si++) phase_kernel<<<256, 512, SMEM_BYTES, stream>>>(p, si);
#endif
}
```

```cpp
#include <hip/hip_runtime.h>
#include <hip/hip_bf16.h>
#include <hip/hip_cooperative_groups.h>
#include <cstdio>
#include <cstring>
#include <type_traits>
namespace cg = cooperative_groups;

#ifndef DUP
#define DUP 0
#endif
#ifndef MEGA
#define MEGA 1
#endif

typedef unsigned short bfr;
using bf16x8 = __attribute__((ext_vector_type(8))) short;
using f32x4 = __attribute__((ext_vector_type(4))) float;

#define R_ 33280
#define BT_ 16640
#define NCH_ 260

#define OFF_XC 0ull
#define OFF_MOD 2097152ull
#define OFF_W 2244608ull
#define OFF_H 24264704ull
#define OFF_ACT 92422144ull
#define A_Z 0ull
#define A_UC 85196800ull
#define A_AB 170393600ull
#define A_U 170393600ull
#define A_HF 340787200ull
#define A_AGG 425984000ull
#define A_CAR 431308800ull
#define A_QKV 0ull
#define A_GATE 272629760ull
#define A_HS 276889600ull
#define A_RSTD 413204480ull
#define A_R7B 68157440ull
#define A_RKVZ (A_R7B + 0ull)
#define A_WM (A_R7B + 272629760ull)
#define A_AM (A_R7B + 281149440ull)
#define A_BON (A_R7B + 289669120ull)
#define A_Y (A_R7B + 293928960ull)
#define WS_NEED (527000064ull + 16384ull)

#define WL_GATE (2560 * 1024)
#define WL_OUT (WL_GATE + 1310720)
#define WM_Z (4352 * 1024)
#define WM_OUT (WM_Z + 2048 * 1024)
#define WR_UP (4352 * 2048)
#define WR_OUT (WR_UP + 262144)

enum { PH_PRE = 0, PH_NORM, PH_LRU_IN, PH_LRU_CONV, PH_LRU_GATE, PH_LRU_S1, PH_LRU_S2, PH_LRU_S3, PH_LRU_OUT,
       PH_ML_IN, PH_ML_SCAN, PH_ML_STAT, PH_ML_Z, PH_ML_OUT,
       PH_R7_IN, PH_R7_CA, PH_R7_CB, PH_R7_FIN, PH_R7_OUT, PH_FINAL, PH_R7_SHIFT };

struct P {
  const float *x, *c, *ctx, *c_ctx, *norm_g, *mod_w, *mod_b, *final_g;
  const float *lru_w_in, *lru_conv_w, *lru_conv_b, *lru_gate_w, *lru_gate_b, *lru_lam, *lru_w_out;
  const float *ml_w_in, *ml_gate_b, *ml_norm_g, *ml_w_out;
  const float *r7_mu, *r7_w_rkvz, *r7_w0, *r7_w1, *r7_w2, *r7_a0, *r7_a1, *r7_a2, *r7_k_k, *r7_k_a, *r7_r_k, *r7_ln_g, *r7_ln_b, *r7_w_out;
  float* Xx; float* Xc; float* MOD; bfr* W; bfr* H; char* ACT; unsigned* bar; float* CL;
  int nsched; int pad_;
  int sched[64 * 3];
};
struct Ctx { int layer, j, d, wc; };

__device__ __forceinline__ int ltid() { int t = threadIdx.x; asm volatile("" : "+v"(t)); return t; }
typedef float f32v2_ __attribute__((ext_vector_type(2))); typedef __bf16 bf16v2_ __attribute__((ext_vector_type(2)));
__device__ __forceinline__ unsigned cvtpk(float lo, float hi) { f32v2_ f = {lo, hi}; bf16v2_ h = __builtin_convertvector(f, bf16v2_); return __builtin_bit_cast(unsigned, h); }
__device__ __forceinline__ bfr f2b(float f) { return (bfr)(cvtpk(f, f) & 0xffffu); }
__device__ __forceinline__ float b2f(bfr b) { return __uint_as_float(((unsigned)b) << 16); }
__device__ __forceinline__ unsigned pk2(float a, float b) { return cvtpk(a, b); }
__device__ __forceinline__ float blo(unsigned u) { return __uint_as_float(u << 16); }
__device__ __forceinline__ float bhi(unsigned u) { return __uint_as_float(u & 0xffff0000u); }
__device__ __forceinline__ void store4b(bfr* dst, f32x4 v) { uint2 u; u.x = pk2(v[0], v[1]); u.y = pk2(v[2], v[3]); *(uint2*)dst = u; }
__device__ __forceinline__ float sigm(float x) { return __builtin_amdgcn_rcpf(1.f + __expf(-x)); }
__device__ __forceinline__ float siluf(float x) { return x * sigm(x); }
__device__ __forceinline__ float softplusf(float x) { return x > 20.f ? x : log1pf(expf(x)); }
__device__ __forceinline__ int rowmap(int d, int b, int pp) { int o = d == 0 ? pp : (pp < 256 ? 255 - pp : 16895 - pp); return b * BT_ + o; }
__device__ __forceinline__ float* xrowp(const P& p, int row, int& mi) {
  int b = row / BT_, o = row - b * BT_;
  if (o < 256) { mi = 2; return p.Xc + (size_t)(b * 256 + o) * 1024; }
  mi = b; return p.Xx + (size_t)(b * 16384 + o - 256) * 1024;
}
__device__ __forceinline__ float wsum(float v) { for (int o = 32; o; o >>= 1) v += __shfl_xor(v, o); return v; }
template <int CTRL> __device__ __forceinline__ float dppf(float x) {
  return __int_as_float(__builtin_amdgcn_update_dpp(0, __float_as_int(x), CTRL, 0xf, 0xf, true));
}
__device__ __forceinline__ float red16(float x) {
  x += dppf<0xB1>(x); x += dppf<0x4E>(x); x += dppf<0x141>(x); x += dppf<0x140>(x); return x;
}

template <class F> __device__ __forceinline__ void prep_tile(bfr* dst, int K, int tn, int tk, F get, float* sm) {
  int tid = ltid();
  for (int i = 0; i < 8; i++) { int kk = (tid >> 6) + 8 * i, nn = tid & 63; sm[kk * 65 + nn] = get(tk * 64 + kk, tn * 64 + nn); }
  __syncthreads();
  for (int i = 0; i < 8; i++) { int nn = (tid >> 6) + 8 * i, kk = tid & 63; dst[(size_t)(tn * 64 + nn) * K + tk * 64 + kk] = f2b(sm[kk * 65 + nn]); }
  __syncthreads();
}
__device__ __forceinline__ int prep_count(int layer) { int kind = layer % 3; return kind == 0 ? (640 + 320 + 320) : kind == 1 ? (1088 + 512 + 512) : (2176 + 64 + 256); }
__device__ __forceinline__ void prep_item(const P& p, int layer, int it, float* sm) {
  int kind = layer % 3, j = layer / 3;
  if (kind == 0) {
    if (it < 640) { int tn = it / 16, tk = it % 16; const float* s = p.lru_w_in + (size_t)j * 1024 * 2560;
      prep_tile(p.W, 1024, tn, tk, [=](int k, int n) { return s[(size_t)k * 2560 + n]; }, sm); return; }
    it -= 640;
    if (it < 320) { int d = it / 160, r = it % 160, tn = r / 2, tk = r % 2; const float* s = p.lru_gate_w + (size_t)(j * 2 + d) * 2 * 10 * 16384;
      prep_tile(p.W + WL_GATE + d * 655360, 128, tn, tk, [=](int k, int n) {
        int nt = n >> 7, blk = nt >> 1, sub = nt & 1, jj = n & 127, wn = jj >> 6, rr = jj & 63, g = rr >> 5, c = rr & 31;
        int kch = sub * 64 + wn * 32 + c; return s[((size_t)(g * 10 + blk) * 128 + k) * 128 + kch]; }, sm); return; }
    it -= 320;
    { int tn = it / 20, tk = it % 20; const float* s = p.lru_w_out + (size_t)j * 1280 * 1024;
      prep_tile(p.W + WL_OUT, 1280, tn, tk, [=](int k, int n) { return s[(size_t)k * 1024 + n]; }, sm); return; }
  } else if (kind == 1) {
    const float* s = p.ml_w_in + (size_t)j * 1024 * 6176;
    if (it < 1088) { int tn = it / 16, tk = it % 16;
      prep_tile(p.W, 1024, tn, tk, [=](int k, int n) {
        if (n < 4096) { float v = s[(size_t)k * 6176 + n]; return (n >= 1024 && n < 2048) ? v * 0.08838834764831845f : v; }
        if (n < 4128) return s[(size_t)k * 6176 + 6144 + (n - 4096)];
        return 0.f; }, sm); return; }
    it -= 1088;
    if (it < 512) { int tn = it / 16, tk = it % 16;
      prep_tile(p.W + WM_Z, 1024, tn, tk, [=](int k, int n) { return s[(size_t)k * 6176 + 4096 + n]; }, sm); return; }
    it -= 512;
    { int tn = it / 32, tk = it % 32; const float* so = p.ml_w_out + (size_t)j * 2048 * 1024;
      prep_tile(p.W + WM_OUT, 2048, tn, tk, [=](int k, int n) { return so[(size_t)k * 1024 + n]; }, sm); return; }
  } else {
    if (it < 2176) { int tn = it / 32, tk = it % 32;
      const float* mu = p.r7_mu + (size_t)j * 6 * 1024; const float* wr = p.r7_w_rkvz + (size_t)j * 4 * 1024 * 1024;
      const float* w1 = p.r7_w1 + (size_t)j * 2 * 1024 * 64; const float* a1 = p.r7_a1 + (size_t)j * 2 * 1024 * 64;
      prep_tile(p.W, 2048, tn, tk, [=](int k, int n) {
        int kk = k & 1023; float v, m;
        if (n < 4096) { int g = n >> 10, e = n & 1023; m = mu[g * 1024 + kk]; v = wr[((size_t)g * 1024 + kk) * 1024 + e]; }
        else if (n < 4224) { int xx = (n - 4096) >> 6, rr = (n - 4096) & 63; m = mu[4 * 1024 + kk]; v = w1[((size_t)xx * 1024 + kk) * 64 + rr]; }
        else { int xx = (n - 4224) >> 6, rr = (n - 4224) & 63; m = mu[5 * 1024 + kk]; v = a1[((size_t)xx * 1024 + kk) * 64 + rr]; }
        return (k < 1024 ? (1.f - m) : m) * v; }, sm); return; }
    it -= 2176;
    if (it < 64) { int u = it / 16, tn = it % 16; const float* s = (u < 2 ? p.r7_w2 : p.r7_a2) + (size_t)(j * 2 + (u & 1)) * 64 * 1024;
      prep_tile(p.W + WR_UP + u * 65536, 64, tn, 0, [=](int k, int n) { return s[(size_t)k * 1024 + n]; }, sm); return; }
    it -= 64;
    { int tn = it / 16, tk = it % 16; const float* s = p.r7_w_out + (size_t)j * 1024 * 1024;
      prep_tile(p.W + WR_OUT, 1024, tn, tk, [=](int k, int n) { return s[(size_t)k * 1024 + n]; }, sm); return; }
  }
}

#define LDSS 72
template <class G> __device__ __forceinline__ void gemm_tile(const P& p, const Ctx& c, int mt, int nt, char* smem) {
  const int tid = ltid(), lane = tid & 63, wid = tid >> 6, wm = wid & 3, wn = wid >> 2;
  bfr* sA = (bfr*)smem; bfr* sB = sA + 2 * 256 * LDSS;
  f32x4 acc[4][4];
  for (int a = 0; a < 4; a++) for (int b = 0; b < 4; b++) acc[a][b] = f32x4{0.f, 0.f, 0.f, 0.f};
  const int lr = tid >> 3, lc = tid & 7;
  uint4 ra[4], rb[2];
  auto gload = [&](int kt) __attribute__((always_inline)) {
#pragma unroll
    for (int i = 0; i < 4; i++) {
      const bfr* pa = G::aptr(p, c, mt * 256 + lr + 64 * i, kt, nt);
      ra[i] = pa ? *(const uint4*)(pa + lc * 8) : uint4{0u, 0u, 0u, 0u};
      if (i < 2) rb[i] = *(const uint4*)(G::bptr(p, c, nt * 128 + lr + 64 * i, kt) + lc * 8);
    }
  };
  auto sstore = [&](int buf) __attribute__((always_inline)) {
#pragma unroll
    for (int i = 0; i < 4; i++) {
      *(uint4*)(sA + (buf * 256 + lr + 64 * i) * LDSS + lc * 8) = ra[i];
      if (i < 2) *(uint4*)(sB + (buf * 128 + lr + 64 * i) * LDSS + lc * 8) = rb[i];
    }
  };
  gload(0); sstore(0); __syncthreads();
  for (int kt = 0; kt < G::KT; kt++) {
    const int buf = kt & 1;
    if (kt + 1 < G::KT) gload(kt + 1);
#pragma unroll
    for (int ks = 0; ks < 2; ks++) {
      bf16x8 af[4], bf[4];
#pragma unroll
      for (int i = 0; i < 4; i++) {
        af[i] = *(const bf16x8*)(sA + (buf * 256 + wm * 64 + i * 16 + (lane & 15)) * LDSS + ks * 32 + (lane >> 4) * 8);
        bf[i] = *(const bf16x8*)(sB + (buf * 128 + wn * 64 + i * 16 + (lane & 15)) * LDSS + ks * 32 + (lane >> 4) * 8);
      }
#pragma unroll
      for (int n = 0; n < 4; n++)
#pragma unroll
        for (int m = 0; m < 4; m++) acc[n][m] = __builtin_amdgcn_mfma_f32_16x16x32_bf16(bf[n], af[m], acc[n][m], 0, 0, 0);
    }
    if (kt + 1 < G::KT) sstore(buf ^ 1);
    __syncthreads();
  }
  G::epi(p, c, acc, mt * 256 + wm * 64, nt * 128 + wn * 64, lane);
}

__device__ __forceinline__ void epi_resid(const P& p, const Ctx& c, f32x4 (&acc)[4][4], int m0, int n0, int lane) {
#pragma unroll
  for (int mi = 0; mi < 4; mi++) {
    int row = m0 + mi * 16 + (lane & 15); int mo; float* xr = xrowp(p, row, mo);
    if (mo == 2 && !c.wc) continue;
    const float* g = p.MOD + (size_t)(c.layer * 3 + mo) * 3072 + 2048;
#pragma unroll
    for (int ni = 0; ni < 4; ni++) {
      int n = n0 + ni * 16 + (lane >> 4) * 4;
      float4 xv = *(float4*)(xr + n); float4 gg = *(const float4*)(g + n);
      xv.x += gg.x * acc[ni][mi][0]; xv.y += gg.y * acc[ni][mi][1]; xv.z += gg.z * acc[ni][mi][2]; xv.w += gg.w * acc[ni][mi][3];
      *(float4*)(xr + n) = xv;
    }
  }
}

struct G_LruIn { static constexpr int KT = 16, NT = 20;
  static __device__ __forceinline__ const bfr* aptr(const P& p, const Ctx& c, int row, int kt, int nt) { return p.H + (size_t)row * 1024 + kt * 64; }
  static __device__ __forceinline__ const bfr* bptr(const P& p, const Ctx& c, int n, int kt) { return p.W + (size_t)n * 1024 + kt * 64; }
  static __device__ __forceinline__ void epi(const P& p, const Ctx& c, f32x4 (&acc)[4][4], int m0, int n0, int lane) {
    bfr* U = (bfr*)(p.ACT + A_U); bfr* Z = (bfr*)(p.ACT + A_Z);
#pragma unroll
    for (int ni = 0; ni < 4; ni++)
#pragma unroll
      for (int mi = 0; mi < 4; mi++) {
        int row = m0 + mi * 16 + (lane & 15), n = n0 + ni * 16 + (lane >> 4) * 4;
        bfr* dst = n < 1280 ? U + (size_t)row * 1280 + n : Z + (size_t)row * 1280 + (n - 1280);
        store4b(dst, acc[ni][mi]);
      }
  } };
struct G_LruGate { static constexpr int KT = 2, NT = 20;
  static __device__ __forceinline__ const bfr* aptr(const P& p, const Ctx& c, int row, int kt, int nt) { return (const bfr*)(p.ACT + A_UC) + (size_t)row * 1280 + (nt >> 1) * 128 + kt * 64; }
  static __device__ __forceinline__ const bfr* bptr(const P& p, const Ctx& c, int n, int kt) { return p.W + WL_GATE + c.d * 655360 + (size_t)n * 128 + kt * 64; }
  static __device__ __forceinline__ void epi(const P& p, const Ctx& c, f32x4 (&acc)[4][4], int m0, int n0, int lane) {
    const bfr* UC = (const bfr*)(p.ACT + A_UC); unsigned* AB = (unsigned*)(p.ACT + A_AB);
    const float* gb = p.lru_gate_b + (size_t)(c.j * 2 + c.d) * 2 * 1280; const float* lam = p.lru_lam + (size_t)(c.j * 2 + c.d) * 1280;
    int chb = (n0 >> 6) * 32;
#pragma unroll
    for (int ni = 0; ni < 2; ni++) {
      int ch = chb + ni * 16 + (lane >> 4) * 4;
      float cl[4], br[4], bi[4];
#pragma unroll
      for (int q = 0; q < 4; q++) { cl[q] = p.CL[(size_t)(c.j * 2 + c.d) * 1280 + ch + q]; br[q] = gb[ch + q]; bi[q] = gb[1280 + ch + q]; }
#pragma unroll
      for (int mi = 0; mi < 4; mi++) {
        int row = m0 + mi * 16 + (lane & 15);
        uint2 u = *(const uint2*)(UC + (size_t)row * 1280 + ch);
        float uc[4] = {blo(u.x), bhi(u.x), blo(u.y), bhi(u.y)};
        unsigned o[4];
#pragma unroll
        for (int q = 0; q < 4; q++) {
          float r = sigm(acc[ni][mi][q] + br[q]), ig = sigm(acc[ni + 2][mi][q] + bi[q]);
          float la = -cl[q] * r; float oma = 1.f - __expf(la); float bb = __builtin_amdgcn_sqrtf(oma * (2.f - oma)) * ig * uc[q];
          o[q] = (((unsigned)f2b(oma)) << 16) | (unsigned)f2b(bb);
        }
        *(uint4*)(AB + (size_t)row * 1280 + ch) = uint4{o[0], o[1], o[2], o[3]};
      }
    }
  } };
struct G_LruOut { static constexpr int KT = 20, NT = 8;
  static __device__ __forceinline__ const bfr* aptr(const P& p, const Ctx& c, int row, int kt, int nt) { return (const bfr*)(p.ACT + A_Z) + (size_t)row * 1280 + kt * 64; }
  static __device__ __forceinline__ const bfr* bptr(const P& p, const Ctx& c, int n, int kt) { return p.W + WL_OUT + (size_t)n * 1280 + kt * 64; }
  static __device__ __forceinline__ void epi(const P& p, const Ctx& c, f32x4 (&acc)[4][4], int m0, int n0, int lane) { epi_resid(p, c, acc, m0, n0, lane); } };
struct G_MlIn { static constexpr int KT = 16, NT = 33;
  static __device__ __forceinline__ const bfr* aptr(const P& p, const Ctx& c, int row, int kt, int nt) { return p.H + (size_t)row * 1024 + kt * 64; }
  static __device__ __forceinline__ const bfr* bptr(const P& p, const Ctx& c, int n, int kt) { return p.W + (size_t)n * 1024 + kt * 64; }
  static __device__ __forceinline__ void epi(const P& p, const Ctx& c, f32x4 (&acc)[4][4], int m0, int n0, int lane) {
    bfr* QKV = (bfr*)(p.ACT + A_QKV); float* GT = (float*)(p.ACT + A_GATE);
#pragma unroll
    for (int ni = 0; ni < 4; ni++)
#pragma unroll
      for (int mi = 0; mi < 4; mi++) {
        int row = m0 + mi * 16 + (lane & 15), n = n0 + ni * 16 + (lane >> 4) * 4;
        if (n < 4096) store4b(QKV + (size_t)row * 4096 + n, acc[ni][mi]);
        else if (n < 4128) *(float4*)(GT + (size_t)row * 32 + (n - 4096)) = float4{acc[ni][mi][0], acc[ni][mi][1], acc[ni][mi][2], acc[ni][mi][3]};
      }
  } };
struct G_MlZ { static constexpr int KT = 16, NT = 16;
  static __device__ __forceinline__ const bfr* aptr(const P& p, const Ctx& c, int row, int kt, int nt) { return p.H + (size_t)row * 1024 + kt * 64; }
  static __device__ __forceinline__ const bfr* bptr(const P& p, const Ctx& c, int n, int kt) { return p.W + WM_Z + (size_t)n * 1024 + kt * 64; }
  static __device__ __forceinline__ void epi(const P& p, const Ctx& c, f32x4 (&acc)[4][4], int m0, int n0, int lane) {
    bfr* HS = (bfr*)(p.ACT + A_HS); const float* RS = (const float*)(p.ACT + A_RSTD); const float* ng = p.ml_norm_g + (size_t)c.j * 2048;
#pragma unroll
    for (int ni = 0; ni < 4; ni++)
#pragma unroll
      for (int mi = 0; mi < 4; mi++) {
        int row = m0 + mi * 16 + (lane & 15), n = n0 + ni * 16 + (lane >> 4) * 4;
        bfr* hp = HS + (size_t)row * 2048 + n; uint2 u = *(const uint2*)hp; float rs = RS[(size_t)row * 8 + (n >> 8)];
        float4 g4 = *(const float4*)(ng + n);
        f32x4 o;
        o[0] = blo(u.x) * rs * g4.x * siluf(acc[ni][mi][0]); o[1] = bhi(u.x) * rs * g4.y * siluf(acc[ni][mi][1]);
        o[2] = blo(u.y) * rs * g4.z * siluf(acc[ni][mi][2]); o[3] = bhi(u.y) * rs * g4.w * siluf(acc[ni][mi][3]);
        store4b(hp, o);
      }
  } };
struct G_MlOut { static constexpr int KT = 32, NT = 8;
  static __device__ __forceinline__ const bfr* aptr(const P& p, const Ctx& c, int row, int kt, int nt) { return (const bfr*)(p.ACT + A_HS) + (size_t)row * 2048 + kt * 64; }
  static __device__ __forceinline__ const bfr* bptr(const P& p, const Ctx& c, int n, int kt) { return p.W + WM_OUT + (size_t)n * 2048 + kt * 64; }
  static __device__ __forceinline__ void epi(const P& p, const Ctx& c, f32x4 (&acc)[4][4], int m0, int n0, int lane) { epi_resid(p, c, acc, m0, n0, lane); } };
struct G_R7In { static constexpr int KT = 32, NT = 34;
  static __device__ __forceinline__ const bfr* aptr(const P& p, const Ctx& c, int row, int kt, int nt) {
    if (kt < 16) return p.H + (size_t)row * 1024 + kt * 64;
    int q = (kt - 16) >> 2; int b = row / BT_, o = row - b * BT_; int nr;
    if (o < 256) { if (q < 2) { if (o < 1) return nullptr; nr = row - 1; } else { if (o >= 255) return nullptr; nr = row + 1; } }
    else { int t = o - 256, col = t & 63, gr = t >> 6;
      if (q == 0) { if (col == 0) return nullptr; nr = row - 1; }
      else if (q == 1) { if (col == 63) return nullptr; nr = row + 1; }
      else if (q == 2) { if (gr == 0) return nullptr; nr = row - 64; }
      else { if (gr == 255) return nullptr; nr = row + 64; } }
    return p.H + (size_t)nr * 1024 + (kt - 16) * 64; }
  static __device__ __forceinline__ const bfr* bptr(const P& p, const Ctx& c, int n, int kt) { return p.W + (size_t)n * 2048 + kt * 64; }
  static __device__ __forceinline__ void epi(const P& p, const Ctx& c, f32x4 (&acc)[4][4], int m0, int n0, int lane) {
    bfr* RK = (bfr*)(p.ACT + A_RKVZ); bfr* WMb = (bfr*)(p.ACT + A_WM); bfr* AMb = (bfr*)(p.ACT + A_AM);
#pragma unroll
    for (int ni = 0; ni < 4; ni++)
#pragma unroll
      for (int mi = 0; mi < 4; mi++) {
        int row = m0 + mi * 16 + (lane & 15), n = n0 + ni * 16 + (lane >> 4) * 4;
        if (n < 4096) store4b(RK + (size_t)row * 4096 + n, acc[ni][mi]);
        else if (n < 4224) { f32x4 t;
#pragma unroll
          for (int q = 0; q < 4; q++) t[q] = tanhf(acc[ni][mi][q]); store4b(WMb + (size_t)row * 128 + (n - 4096), t); }
        else store4b(AMb + (size_t)row * 128 + (n - 4224), acc[ni][mi]);
      }
  } };
struct G_R7Out { static constexpr int KT = 16, NT = 8;
  static __device__ __forceinline__ const bfr* aptr(const P& p, const Ctx& c, int row, int kt, int nt) { return p.H + (size_t)row * 1024 + kt * 64; }
  static __device__ __forceinline__ const bfr* bptr(const P& p, const Ctx& c, int n, int kt) { return p.W + WR_OUT + (size_t)n * 1024 + kt * 64; }
  static __device__ __forceinline__ void epi(const P& p, const Ctx& c, f32x4 (&acc)[4][4], int m0, int n0, int lane) { epi_resid(p, c, acc, m0, n0, lane); } };


namespace pg8 {
#define PG8_LAS __attribute__((address_space(3)))
constexpr int BM = 256, BK = 64, HALF = 128, HTB = HALF * BK * 2, NXCD = 8, WGM = 8;
__device__ __forceinline__ int lds_byte(int r, int c) { const int st = (r >> 4) * 2 + (c >> 5), rr = r & 15, cc = c & 31, ob = rr * 64 + cc * 2; return st * 1024 + (ob ^ (((ob >> 9) & 1) << 5)); }
__device__ __forceinline__ void stage_rc(int b, int& R, int& C) { const int st = b / 1024, sb = b % 1024, swz = sb ^ (((sb >> 9) & 1) << 5); R = (st >> 1) * 16 + swz / 64; C = (st & 1) * 32 + (swz % 64) / 2; }
struct Unit { int pm, pn; };
struct Gemm { const bfr* A; const bfr* Bt; int M, N, K; };
struct StaticOrder {
  int nM, nN, nwg, G, c;
  __device__ void init(int M, int N, int G_, int c_) { nM = M / BM; nN = N / BM; nwg = nM * nN; G = G_; c = c_; }
  __device__ bool next(int i, Unit& u) const {
    const long L = (long)i * G + c; if (L >= nwg) return false;
    int wgid = (int)L; { const int q = nwg / NXCD, r = nwg % NXCD, xcd = wgid % NXCD, off = wgid / NXCD; wgid = (xcd < r ? xcd * (q + 1) : r * (q + 1) + (xcd - r) * q) + off; }
    const int nig = WGM * nN, gid = wgid / nig, fm = gid * WGM, gsz = (nM - fm) < WGM ? (nM - fm) : WGM;
    u.pm = fm + ((wgid % nig) % gsz); u.pn = (wgid % nig) / gsz; return true;
  }
};
template <class Epi>
__device__ __forceinline__ void gemm_phase(PG8_LAS unsigned char* lds, const Gemm g, const StaticOrder& S, const Epi& E) {
  const int tid = ltid(), wid = __builtin_amdgcn_readfirstlane(tid >> 6), lane = tid & 63, wr = wid >> 2, wc = wid & 3, fr = lane & 15, fq = lane >> 4;
  const int K = g.K, nt = K / BK;
  unsigned voffA[2], voffB[2];
#pragma unroll
  for (int i = 0; i < 2; ++i) { int R, C; stage_rc(tid * 16 + i * 8192, R, C); voffA[i] = (unsigned)(R * K + C) * 2u; voffB[i] = voffA[i]; }
  const size_t kstep = (size_t)(BK * 2);
  const size_t hstep = (size_t)HALF * K * 2;
  const size_t tstep = 2 * hstep;
  const unsigned ldsw = (unsigned)wid * 1024u;
  const int aoff = lds_byte(wr * 64 + fr, fq * 8), boff = lds_byte(wc * 32 + fr, fq * 8);
#define PG8_SA(b, h) (((b) * 2 + (h)) * HTB)
#define PG8_SB(b, h) ((4 + (b) * 2 + (h)) * HTB)
#define PG8_STAGE(bufoff, gbase, voff) do { _Pragma("unroll") for (int _i = 0; _i < 2; ++_i) \
    __builtin_amdgcn_global_load_lds((const unsigned*)((const char*)(gbase) + (voff)[_i]), (PG8_LAS unsigned*)(lds + (bufoff) + ldsw + _i * 8192), 16, 0, 0); } while (0)
#define PG8_LDA(dst, b, h) do { _Pragma("unroll") for (int m = 0; m < 4; ++m) _Pragma("unroll") for (int k = 0; k < 2; ++k) dst[m][k] = *(const PG8_LAS bf16x8*)(lds + PG8_SA(b, h) + aoff + m * 2048 + k * 1024); } while (0)
#define PG8_LDB(dst, b, h) do { _Pragma("unroll") for (int n = 0; n < 2; ++n) _Pragma("unroll") for (int k = 0; k < 2; ++k) dst[n][k] = *(const PG8_LAS bf16x8*)(lds + PG8_SB(b, h) + boff + n * 2048 + k * 1024); } while (0)
#define PG8_MMA(ai, bj, At, Bt) do { __builtin_amdgcn_s_setprio(1); _Pragma("unroll") for (int m = 0; m < 4; ++m) _Pragma("unroll") for (int n = 0; n < 2; ++n) _Pragma("unroll") for (int k = 0; k < 2; ++k) \
    acc[ai][bj][m][n] = __builtin_amdgcn_mfma_f32_16x16x32_bf16(Bt[n][k], At[m][k], acc[ai][bj][m][n], 0, 0, 0); __builtin_amdgcn_s_setprio(0); } while (0)
#define PG8_WAIT_V(n) asm volatile("s_waitcnt vmcnt(" #n ")" ::: "memory")
#define PG8_WAIT_L(n) asm volatile("s_waitcnt lgkmcnt(" #n ")" ::: "memory")
#define PG8_BAR __builtin_amdgcn_s_barrier()
#define PG8_SCHED __builtin_amdgcn_sched_barrier(0)
  Unit cur, nxt; int ui = 0;
  if (!S.next(0, cur)) return;
  f32x4 acc[2][2][4][2];
#pragma unroll
  for (int a = 0; a < 2; ++a)
#pragma unroll
    for (int b = 0; b < 2; ++b)
#pragma unroll
      for (int m = 0; m < 4; ++m)
#pragma unroll
        for (int n = 0; n < 2; ++n) acc[a][b][m][n] = (f32x4){0.f, 0.f, 0.f, 0.f};
  bf16x8 At[4][2], B0[2][2], B1[2][2];
  const char* cA = (const char*)g.A + (size_t)cur.pm * tstep; const char* cB = (const char*)g.Bt + (size_t)cur.pn * tstep;
  PG8_STAGE(PG8_SB(0, 0), cB, voffB); PG8_STAGE(PG8_SA(0, 0), cA, voffA); PG8_STAGE(PG8_SB(0, 1), cB + hstep, voffB); PG8_STAGE(PG8_SA(0, 1), cA + hstep, voffA);
  if (wr == 1) PG8_BAR;
  PG8_WAIT_V(4); PG8_BAR;
  PG8_STAGE(PG8_SB(1, 0), cB + kstep, voffB); PG8_STAGE(PG8_SA(1, 0), cA + kstep, voffA); PG8_STAGE(PG8_SB(1, 1), cB + hstep + kstep, voffB);
  PG8_WAIT_V(6); PG8_BAR;
  for (;;) {
    const bool has_next = S.next(ui + 1, nxt);
    const char* nA = has_next ? (const char*)g.A + (size_t)nxt.pm * tstep : cA; const char* nB = has_next ? (const char*)g.Bt + (size_t)nxt.pn * tstep : cB;
    for (int t = 0; t < nt; t += 2) {
      const bool last = (t == nt - 2);
      const char* a1 = cA + (size_t)(t + 1) * kstep;
      const char* a2 = last ? nA : cA + (size_t)(t + 2) * kstep; const char* b2 = last ? nB : cB + (size_t)(t + 2) * kstep;
      const char* a3 = a2 + kstep; const char* b3 = b2 + kstep;
      PG8_LDB(B0, 0, 0); PG8_SCHED; PG8_LDA(At, 0, 0); PG8_STAGE(PG8_SA(1, 1), a1 + hstep, voffA);
      PG8_WAIT_L(8); PG8_BAR; PG8_WAIT_L(0); PG8_MMA(0, 0, At, B0); PG8_BAR; PG8_SCHED;
      PG8_LDB(B1, 0, 1); PG8_STAGE(PG8_SB(0, 0), b2, voffB);
      PG8_BAR; PG8_WAIT_L(0); PG8_MMA(0, 1, At, B1); PG8_BAR;
      PG8_LDA(At, 0, 1); PG8_STAGE(PG8_SA(0, 0), a2, voffA);
      PG8_BAR; PG8_WAIT_L(0); PG8_MMA(1, 0, At, B0); PG8_BAR; PG8_SCHED;
      PG8_STAGE(PG8_SB(0, 1), b2 + hstep, voffB);
      PG8_WAIT_V(6); PG8_BAR; PG8_MMA(1, 1, At, B1); PG8_BAR;
      PG8_LDB(B0, 1, 0); PG8_SCHED; PG8_LDA(At, 1, 0); PG8_STAGE(PG8_SA(0, 1), a2 + hstep, voffA);
      PG8_WAIT_L(8); PG8_BAR; PG8_WAIT_L(0); PG8_MMA(0, 0, At, B0); PG8_BAR; PG8_SCHED;
      PG8_LDB(B1, 1, 1); PG8_STAGE(PG8_SB(1, 0), b3, voffB);
      PG8_BAR; PG8_WAIT_L(0); PG8_MMA(0, 1, At, B1); PG8_BAR;
      PG8_LDA(At, 1, 1); PG8_STAGE(PG8_SA(1, 0), a3, voffA);
      PG8_BAR; PG8_WAIT_L(0); PG8_MMA(1, 0, At, B0); PG8_BAR; PG8_SCHED;
      PG8_STAGE(PG8_SB(1, 1), b3 + hstep, voffB);
      PG8_WAIT_V(6); PG8_BAR; PG8_MMA(1, 1, At, B1); PG8_BAR;
    }
    E(acc, cur, wr, wc, fr, fq);
    if (!has_next) break;
#pragma unroll
    for (int a = 0; a < 2; ++a)
#pragma unroll
      for (int b = 0; b < 2; ++b)
#pragma unroll
        for (int m = 0; m < 4; ++m)
#pragma unroll
          for (int n = 0; n < 2; ++n) acc[a][b][m][n] = (f32x4){0.f, 0.f, 0.f, 0.f};
    cur = nxt; cA = nA; cB = nB; ++ui;
  }
  PG8_WAIT_V(0);
  if (wr == 0) PG8_BAR;
  PG8_BAR;
#undef PG8_SA
#undef PG8_SB
#undef PG8_STAGE
#undef PG8_LDA
#undef PG8_LDB
#undef PG8_MMA
#undef PG8_WAIT_V
#undef PG8_WAIT_L
#undef PG8_BAR
#undef PG8_SCHED
}
}

template <class F> struct EpiAd {
  F f;
  __device__ __forceinline__ void operator()(const f32x4 (&acc)[2][2][4][2], const pg8::Unit& u, int wr, int wc, int fr, int fq) const {
#pragma unroll
    for (int ai = 0; ai < 2; ++ai)
#pragma unroll
      for (int m = 0; m < 4; ++m) { const int row = u.pm * 256 + ai * 128 + wr * 64 + m * 16 + fr;
#pragma unroll
        for (int bj = 0; bj < 2; ++bj)
#pragma unroll
          for (int n = 0; n < 2; ++n) f(row, u.pn * 256 + bj * 128 + wc * 32 + n * 16 + 4 * fq, acc[ai][bj][m][n]); }
  }
};
template <class F> __device__ __forceinline__ void big_gemm(char* smem, const bfr* A, const bfr* Bt, int N, int K, F f) {
  pg8::Gemm g; g.A = A; g.Bt = Bt; g.M = R_; g.N = N; g.K = K;
  pg8::StaticOrder S; S.init(R_, N, (int)gridDim.x, (int)blockIdx.x);
  EpiAd<F> E{f};
  pg8::gemm_phase(( __attribute__((address_space(3))) unsigned char*)smem, g, S, E);
}
struct F_LruIn { char* ACT; __device__ __forceinline__ void operator()(int row, int n, f32x4 v) const {
  bfr* dst = n < 1280 ? (bfr*)(ACT + A_U) + (size_t)row * 1280 + n : (bfr*)(ACT + A_Z) + (size_t)row * 1280 + (n - 1280); store4b(dst, v); } };
struct F_Resid { float* Xx; float* Xc; const float* MODg; int wc; __device__ __forceinline__ void operator()(int row, int n, f32x4 v) const {
  int b = row / BT_, o = row - b * BT_; bool isc = o < 256; if (isc && !wc) return;
  float* xr = isc ? Xc + (size_t)(b * 256 + o) * 1024 : Xx + (size_t)(b * 16384 + o - 256) * 1024; const float* g = MODg + (size_t)(isc ? 2 : b) * 3072 + 2048;
  float4 xv = *(float4*)(xr + n); float4 gg = *(const float4*)(g + n);
  xv.x += gg.x * v[0]; xv.y += gg.y * v[1]; xv.z += gg.z * v[2]; xv.w += gg.w * v[3]; *(float4*)(xr + n) = xv; } };
struct F_MlIn { char* ACT; __device__ __forceinline__ void operator()(int row, int n, f32x4 v) const {
  if (n < 4096) store4b((bfr*)(ACT + A_QKV) + (size_t)row * 4096 + n, v);
  else if (n < 4128) *(float4*)((float*)(ACT + A_GATE) + (size_t)row * 32 + (n - 4096)) = float4{v[0], v[1], v[2], v[3]}; } };
struct F_MlZ { char* ACT; const float* ng; __device__ __forceinline__ void operator()(int row, int n, f32x4 v) const {
  bfr* hp = (bfr*)(ACT + A_HS) + (size_t)row * 2048 + n; uint2 u = *(const uint2*)hp; float rs = ((const float*)(ACT + A_RSTD))[(size_t)row * 8 + (n >> 8)];
  float4 g4 = *(const float4*)(ng + n); f32x4 o;
  o[0] = blo(u.x) * rs * g4.x * siluf(v[0]); o[1] = bhi(u.x) * rs * g4.y * siluf(v[1]); o[2] = blo(u.y) * rs * g4.z * siluf(v[2]); o[3] = bhi(u.y) * rs * g4.w * siluf(v[3]);
  store4b(hp, o); } };
struct F_R7In { char* ACT; __device__ __forceinline__ void operator()(int row, int n, f32x4 v) const {
  if (n < 4096) store4b((bfr*)(ACT + A_RKVZ) + (size_t)row * 4096 + n, v);
  else if (n < 4224) { f32x4 t;
#pragma unroll
    for (int q = 0; q < 4; q++) t[q] = tanhf(v[q]);
    store4b((bfr*)(ACT + A_WM) + (size_t)row * 128 + (n - 4096), t); }
  else store4b((bfr*)(ACT + A_AM) + (size_t)row * 128 + (n - 4224), v); } };

template <class G> __device__ __forceinline__ void gemm_phase(const P& p, const Ctx& c, char* smem) {
  const int total = 130 * G::NT;
  for (int it = blockIdx.x; it < total; it += gridDim.x) gemm_tile<G>(p, c, it / G::NT, it % G::NT, smem);
}

#define R7_Y2 ((bfr*)p.H + (size_t)64 * 26 * 16384)
__device__ __forceinline__ void ph_pre(const P& p, char* smem) {
  float* sm = (float*)smem; const int tid = ltid();
  const int nprep = prep_count(0), ngemv = 192, ncopy = 4160;
  if (blockIdx.x == 0) for (int i = tid; i < 5120; i += 512) p.CL[i] = 8.f * softplusf(-p.lru_lam[i]);
  for (int it = blockIdx.x; it < nprep + ngemv + ncopy; it += gridDim.x) {
    if (it < nprep) { prep_item(p, 0, it, sm); continue; }
    int i2 = it - nprep;
    if (i2 < ngemv) {
      int l = i2 / 48, cgp = i2 % 48;
      for (int i = tid; i < 3072; i += 512) { int cnd = i >> 10, k = i & 1023; float v = cnd == 0 ? p.c[k] : cnd == 1 ? p.c[1024 + k] : p.c_ctx[k]; sm[i] = siluf(v); }
      __syncthreads();
      int kq = tid >> 6, col = cgp * 64 + (tid & 63); const float* w = p.mod_w + (size_t)l * 1024 * 3072 + col;
      float a0 = 0.f, a1 = 0.f, a2 = 0.f;
      for (int k = kq * 128; k < kq * 128 + 128; k++) { float wv = w[(size_t)k * 3072]; a0 += sm[k] * wv; a1 += sm[1024 + k] * wv; a2 += sm[2048 + k] * wv; }
      float* red = sm + 3072; red[tid * 3] = a0; red[tid * 3 + 1] = a1; red[tid * 3 + 2] = a2;
      __syncthreads();
      if (tid < 64) { float bias = p.mod_b[(size_t)l * 3072 + col];
        for (int cnd = 0; cnd < 3; cnd++) { float s = bias; for (int q = 0; q < 8; q++) s += red[(q * 64 + tid) * 3 + cnd]; p.MOD[(size_t)(l * 3 + cnd) * 3072 + col] = s; } }
      __syncthreads();
      continue;
    }
    i2 -= ngemv;
    for (int q = 0; q < 4; q++) { int idx = i2 * 2048 + q * 512 + tid; int row = idx >> 8, c4 = idx & 255; int b = row / BT_, o = row - b * BT_;
      if (o < 256) ((float4*)p.Xc)[(size_t)(b * 256 + o) * 256 + c4] = ((const float4*)p.ctx)[(size_t)(b * 256 + o) * 256 + c4];
      else ((float4*)p.Xx)[(size_t)(b * 16384 + o - 256) * 256 + c4] = ((const float4*)p.x)[(size_t)(b * 16384 + o - 256) * 256 + c4]; }
  }
}
__device__ __forceinline__ void ph_norm(const P& p, int layer, char* smem) {
  const int tid = ltid(), lane = tid & 63, wid = tid >> 6;
  const int nprep = layer > 0 ? prep_count(layer) : 0; const int kind = layer % 3;
  const int nzero = kind == 1 ? 8320 : 0;
  (void)nzero;
  for (int it = blockIdx.x; it < nprep + 4160; it += gridDim.x) {
    if (it < nprep) { prep_item(p, layer, it, (float*)smem); continue; }
    int row = (it - nprep) * 8 + wid; int mo; const float* xr = xrowp(p, row, mo);
    float4 v[4]; float ss = 0.f;
#pragma unroll
    for (int i = 0; i < 4; i++) { v[i] = *(const float4*)(xr + lane * 4 + 256 * i); ss += v[i].x * v[i].x + v[i].y * v[i].y + v[i].z * v[i].z + v[i].w * v[i].w; }
    ss = wsum(ss); float rs = rsqrtf(ss * (1.f / 1024.f) + 1e-6f);
    const float* g = p.norm_g + (size_t)layer * 1024; const float* md = p.MOD + (size_t)(layer * 3 + mo) * 3072;
#pragma unroll
    for (int i = 0; i < 4; i++) { int cidx = lane * 4 + 256 * i; float4 gg = *(const float4*)(g + cidx), sh = *(const float4*)(md + cidx), sc = *(const float4*)(md + 1024 + cidx);
      f32x4 o; o[0] = v[i].x * rs * gg.x * (1.f + sc.x) + sh.x; o[1] = v[i].y * rs * gg.y * (1.f + sc.y) + sh.y; o[2] = v[i].z * rs * gg.z * (1.f + sc.z) + sh.z; o[3] = v[i].w * rs * gg.w * (1.f + sc.w) + sh.w;
      store4b(p.H + (size_t)row * (kind == 2 ? 2048 : 1024) + cidx, o); }
  }
}
__device__ __forceinline__ void ph_r7_shift(const P& p) {
  for (int it = blockIdx.x; it < 8320; it += gridDim.x) {
    int idx = it * 512 + ltid(); int row = idx >> 7, c8 = idx & 127, q = c8 >> 5;
    int b = row / BT_, o = row - b * BT_; int nr = -1;
    if (o < 256) { if (q < 2) { if (o >= 1) nr = row - 1; } else { if (o < 255) nr = row + 1; } }
    else { int t = o - 256, col = t & 63, gr = t >> 6;
      if (q == 0) { if (col != 0) nr = row - 1; } else if (q == 1) { if (col != 63) nr = row + 1; }
      else if (q == 2) { if (gr != 0) nr = row - 64; } else { if (gr != 255) nr = row + 64; } }
    uint4 v = nr >= 0 ? *(const uint4*)(p.H + (size_t)nr * 2048 + c8 * 8) : uint4{0u, 0u, 0u, 0u};
    *(uint4*)(p.H + (size_t)row * 2048 + 1024 + c8 * 8) = v;
  }
}
__device__ __forceinline__ void ph_final(const P& p) {
  const int lane = ltid() & 63, wid = ltid() >> 6;
  for (int it = blockIdx.x; it < 4096; it += gridDim.x) {
    float* xr = p.Xx + (size_t)(it * 8 + wid) * 1024; float4 v[4]; float ss = 0.f;
#pragma unroll
    for (int i = 0; i < 4; i++) { v[i] = *(const float4*)(xr + lane * 4 + 256 * i); ss += v[i].x * v[i].x + v[i].y * v[i].y + v[i].z * v[i].z + v[i].w * v[i].w; }
    ss = wsum(ss); float rs = rsqrtf(ss * (1.f / 1024.f) + 1e-6f);
#pragma unroll
    for (int i = 0; i < 4; i++) { int cidx = lane * 4 + 256 * i; float4 gg = *(const float4*)(p.final_g + cidx);
      *(float4*)(xr + cidx) = float4{v[i].x * rs * gg.x, v[i].y * rs * gg.y, v[i].z * rs * gg.z, v[i].w * rs * gg.w}; }
  }
}
__device__ __forceinline__ void ph_lru_conv(const P& p, int j) {
  const bfr* U = (const bfr*)(p.ACT + A_U); bfr* UC = (bfr*)(p.ACT + A_UC);
  const float* cw = p.lru_conv_w + (size_t)j * 4 * 1280; const float* cb = p.lru_conv_b + (size_t)j * 1280;
  for (int it = blockIdx.x; it < 10400; it += gridDim.x) {
    int idx = it * 512 + ltid(); int row = idx / 160, cgp = idx % 160, ch = cgp * 8;
    int b = row / BT_, o = row - b * BT_; int s0 = o < 256 ? 0 : 256, e0 = o < 256 ? 256 : BT_;
    float acc[8];
#pragma unroll
    for (int e = 0; e < 8; e++) acc[e] = cb[ch + e];
#pragma unroll
    for (int t = 0; t < 4; t++) { int oo = o + t - 2; if (oo < s0 || oo >= e0) continue;
      uint4 u = *(const uint4*)(U + (size_t)(row + t - 2) * 1280 + ch); const float* w = cw + t * 1280 + ch;
      acc[0] += w[0] * blo(u.x); acc[1] += w[1] * bhi(u.x); acc[2] += w[2] * blo(u.y); acc[3] += w[3] * bhi(u.y);
      acc[4] += w[4] * blo(u.z); acc[5] += w[5] * bhi(u.z); acc[6] += w[6] * blo(u.w); acc[7] += w[7] * bhi(u.w); }
    *(uint4*)(UC + (size_t)row * 1280 + ch) = uint4{pk2(acc[0], acc[1]), pk2(acc[2], acc[3]), pk2(acc[4], acc[5]), pk2(acc[6], acc[7])};
  }
}
__device__ __forceinline__ void ph_lru_s1(const P& p, int d) {
  const unsigned* AB = (const unsigned*)(p.ACT + A_AB); float2* AGG = (float2*)(p.ACT + A_AGG);
  const int t = ltid();
  for (int it = blockIdx.x * 8 + (t >> 6); it < 2600; it += gridDim.x * 8) {
    int b = it / 1300, r = it % 1300, cc = r / 5, ch = (r % 5) * 256 + (t & 63) * 4;
    float P0 = 1.f, Q0 = 0.f, P1 = 1.f, Q1 = 0.f, P2 = 1.f, Q2 = 0.f, P3 = 1.f, Q3 = 0.f;
#pragma unroll 8
    for (int q = 0; q < 64; q++) { uint4 u = *(const uint4*)(AB + (size_t)rowmap(d, b, cc * 64 + q) * 1280 + ch);
      float a0 = 1.f - bhi(u.x), a1 = 1.f - bhi(u.y), a2 = 1.f - bhi(u.z), a3 = 1.f - bhi(u.w);
      P0 *= a0; Q0 = a0 * Q0 + blo(u.x); P1 *= a1; Q1 = a1 * Q1 + blo(u.y); P2 *= a2; Q2 = a2 * Q2 + blo(u.z); P3 *= a3; Q3 = a3 * Q3 + blo(u.w); }
    float4* ag = (float4*)(AGG + (size_t)(b * NCH_ + cc) * 1280 + ch); ag[0] = float4{P0, Q0, P1, Q1}; ag[1] = float4{P2, Q2, P3, Q3};
  }
}
__device__ __forceinline__ void ph_lru_s2(const P& p, char* smem) {
  const float2* AGG = (const float2*)(p.ACT + A_AGG); float* CAR = (float*)(p.ACT + A_CAR);
  float* sP = (float*)smem; float* sQ = sP + 512;
  const int tid = ltid(), chl = tid & 63, seg = tid >> 6;
  for (int it = blockIdx.x; it < 40; it += gridDim.x) {
    const int b = it / 20, ch = (it % 20) * 64 + chl; const int cb = seg * 33, ce = cb + 33 < NCH_ ? cb + 33 : NCH_;
    float Pp = 1.f, Q = 0.f;
#pragma unroll 11
    for (int cc = cb; cc < ce; cc++) { float2 a = AGG[(size_t)(b * NCH_ + cc) * 1280 + ch]; Pp *= a.x; Q = a.x * Q + a.y; }
    __syncthreads();
    sP[seg * 64 + chl] = Pp; sQ[seg * 64 + chl] = Q;
    __syncthreads();
    float h = 0.f;
    for (int s2 = 0; s2 < seg; s2++) h = sP[s2 * 64 + chl] * h + sQ[s2 * 64 + chl];
#pragma unroll 11
    for (int cc = cb; cc < ce; cc++) { size_t o = (size_t)(b * NCH_ + cc) * 1280 + ch; float2 a = AGG[o]; CAR[o] = h; h = a.x * h + a.y; }
  }
}
__device__ __forceinline__ void ph_lru_s3(const P& p, int d) {
  const unsigned* AB = (const unsigned*)(p.ACT + A_AB); const float* CAR = (const float*)(p.ACT + A_CAR);
  bfr* HF = (bfr*)(p.ACT + A_HF); bfr* Z = (bfr*)(p.ACT + A_Z);
  const int t = ltid();
  for (int it = blockIdx.x * 8 + (t >> 6); it < 2600; it += gridDim.x * 8) {
    int b = it / 1300, r = it % 1300, cc = r / 5, ch = (r % 5) * 256 + (t & 63) * 4;
    float4 h = *(const float4*)(CAR + (size_t)(b * NCH_ + cc) * 1280 + ch);
#pragma unroll 8
    for (int q = 0; q < 64; q++) { size_t o = (size_t)rowmap(d, b, cc * 64 + q) * 1280 + ch; uint4 u = *(const uint4*)(AB + o);
      h.x = (1.f - bhi(u.x)) * h.x + blo(u.x); h.y = (1.f - bhi(u.y)) * h.y + blo(u.y); h.z = (1.f - bhi(u.z)) * h.z + blo(u.z); h.w = (1.f - bhi(u.w)) * h.w + blo(u.w);
      if (d == 0) *(uint2*)(HF + o) = uint2{pk2(h.x, h.y), pk2(h.z, h.w)};
      else { uint2 hf = *(const uint2*)(HF + o), zz = *(const uint2*)(Z + o);
        *(uint2*)(Z + o) = uint2{pk2((blo(hf.x) + h.x) * siluf(blo(zz.x)), (bhi(hf.x) + h.y) * siluf(bhi(zz.x))), pk2((blo(hf.y) + h.z) * siluf(blo(zz.y)), (bhi(hf.y) + h.w) * siluf(bhi(zz.y)))}; } }
  }
}
__device__ __forceinline__ void ph_ml_stat(const P& p) {
  const bfr* HS = (const bfr*)(p.ACT + A_HS); float* RS = (float*)(p.ACT + A_RSTD);
  const int lane = ltid() & 63, wid = ltid() >> 6;
  for (int it = blockIdx.x; it < 4160; it += gridDim.x) {
    int row = it * 8 + wid; const bfr* hp = HS + (size_t)row * 2048 + lane * 32; float ss = 0.f;
#pragma unroll
    for (int i = 0; i < 4; i++) { uint4 u = *(const uint4*)(hp + i * 8); float a;
      a = blo(u.x); ss += a * a; a = bhi(u.x); ss += a * a; a = blo(u.y); ss += a * a; a = bhi(u.y); ss += a * a;
      a = blo(u.z); ss += a * a; a = bhi(u.z); ss += a * a; a = blo(u.w); ss += a * a; a = bhi(u.w); ss += a * a; }
    ss += __shfl_xor(ss, 1); ss += __shfl_xor(ss, 2); ss += __shfl_xor(ss, 4);
    if ((lane & 7) == 0) RS[(size_t)row * 8 + (lane >> 3)] = rsqrtf(ss * (1.f / 256.f) + 1e-6f);
  }
}
__device__ __forceinline__ void ph_r7_fin(const P& p, int j) {
  bfr* Y = (bfr*)(p.ACT + A_Y); const bfr* RK = (const bfr*)(p.ACT + A_RKVZ); const float* BON = (const float*)(p.ACT + A_BON);
  const float* lg = p.r7_ln_g + (size_t)j * 1024; const float* lb = p.r7_ln_b + (size_t)j * 1024;
  const int lane = ltid() & 63, wid = ltid() >> 6;
  for (int it = blockIdx.x; it < 4160; it += gridDim.x) {
    int row = it * 8 + wid, ch = lane * 16, hd = lane >> 2;
    float y[16], v[16], z[16];
#pragma unroll
    for (int i = 0; i < 2; i++) {
      uint4 u = *(const uint4*)(Y + (size_t)row * 1024 + ch + i * 8); const uint4 u2 = *(const uint4*)(R7_Y2 + (size_t)row * 1024 + ch + i * 8);
      y[i * 8 + 0] = blo(u.x) + blo(u2.x); y[i * 8 + 1] = bhi(u.x) + bhi(u2.x); y[i * 8 + 2] = blo(u.y) + blo(u2.y); y[i * 8 + 3] = bhi(u.y) + bhi(u2.y); y[i * 8 + 4] = blo(u.z) + blo(u2.z); y[i * 8 + 5] = bhi(u.z) + bhi(u2.z); y[i * 8 + 6] = blo(u.w) + blo(u2.w); y[i * 8 + 7] = bhi(u.w) + bhi(u2.w);
      u = *(const uint4*)(RK + (size_t)row * 4096 + 2048 + ch + i * 8);
      v[i * 8 + 0] = blo(u.x); v[i * 8 + 1] = bhi(u.x); v[i * 8 + 2] = blo(u.y); v[i * 8 + 3] = bhi(u.y); v[i * 8 + 4] = blo(u.z); v[i * 8 + 5] = bhi(u.z); v[i * 8 + 6] = blo(u.w); v[i * 8 + 7] = bhi(u.w);
      u = *(const uint4*)(RK + (size_t)row * 4096 + 3072 + ch + i * 8);
      z[i * 8 + 0] = blo(u.x); z[i * 8 + 1] = bhi(u.x); z[i * 8 + 2] = blo(u.y); z[i * 8 + 3] = bhi(u.y); z[i * 8 + 4] = blo(u.z); z[i * 8 + 5] = bhi(u.z); z[i * 8 + 6] = blo(u.w); z[i * 8 + 7] = bhi(u.w);
    }
    float s = 0.f;
#pragma unroll
    for (int e = 0; e < 16; e++) s += y[e];
    s += __shfl_xor(s, 1); s += __shfl_xor(s, 2); float mean = s * (1.f / 64.f);
    float q = 0.f;
#pragma unroll
    for (int e = 0; e < 16; e++) { float dlt = y[e] - mean; q += dlt * dlt; }
    q += __shfl_xor(q, 1); q += __shfl_xor(q, 2); float rs = rsqrtf(q * (1.f / 64.f) + 64e-5f);
    float bon = BON[(size_t)row * 16 + hd] + BON[(size_t)(R_ + row) * 16 + hd];
    float o[16];
#pragma unroll
    for (int e = 0; e < 16; e++) { float yn = (y[e] - mean) * rs * lg[ch + e] + lb[ch + e]; o[e] = (yn + bon * v[e]) * siluf(z[e]); }
#pragma unroll
    for (int i = 0; i < 2; i++)
      *(uint4*)(Y + (size_t)row * 1024 + ch + i * 8) = uint4{pk2(o[i * 8], o[i * 8 + 1]), pk2(o[i * 8 + 2], o[i * 8 + 3]), pk2(o[i * 8 + 4], o[i * 8 + 5]), pk2(o[i * 8 + 6], o[i * 8 + 7])};
  }
}

#define QS 136
#define VS 72
#define MLG_BYTES 47104
__device__ __forceinline__ void ph_ml_scan(const P& p, int j, char* smem0) {
  const int d = ltid() >> 8;
  char* smem = smem0 + d * MLG_BYTES;
  bfr* sQ = (bfr*)smem; bfr* sK = sQ + 64 * QS; bfr* sVT = sK + 64 * QS; bfr* sCT = sVT + 16 * VS;
  float* sN = (float*)(sCT + 16 * QS);
  float* sEs = sN + 128; float* sCt = sEs + 64; float* sBc = sCt + 64; float* sWg = sBc + 64; float* sNr = sWg + 64; bfr* sNb = (bfr*)(sNr + 256); float* sMisc = (float*)(sNb + 128); bfr* sVW = (bfr*)(sMisc + 4);
  const bfr* QKV = (const bfr*)(p.ACT + A_QKV); const float* GT = (const float*)(p.ACT + A_GATE); bfr* HS = (bfr*)(p.ACT + A_HS);
  const float* gbias = p.ml_gate_b + (size_t)j * 32;
  const int tid = ltid() & 255, lane = tid & 63, w = tid >> 6, l15 = lane & 15, q4 = lane >> 4;
  for (int it = blockIdx.x; it < 256; it += gridDim.x) {
    const int b = it >> 7, hh = (it >> 4) & 7, sl = it & 15;
    f32x4 Cacc[2];
    Cacc[0] = f32x4{0.f, 0.f, 0.f, 0.f}; Cacc[1] = f32x4{0.f, 0.f, 0.f, 0.f};
    float mcur = 0.f;
    for (int i = tid; i < 16 * QS; i += 256) sCT[i] = 0;
    if (tid < 128) { sN[tid] = 0.f; sNb[tid] = 0; }
    uint4 pq0, pq1, pq2, pq3, pk0, pk1, pk2, pk3, pv = uint4{0u, 0u, 0u, 0u}; float pgi = 0.f, pgf = 0.f;
#define ML_ROW0(s_) (d == 0 ? b * BT_ + 64 * (s_) : rowmap(1, b, 64 * (s_) + 63))
#define ML_LD(i_, PQ, PK) { int idx = tid + 256 * (i_), rho = idx >> 4, c8 = idx & 15; const bfr* src = QKV + (size_t)(r0n + rho) * 4096 + hh * 128 + c8 * 8; PQ = *(const uint4*)src; PK = *(const uint4*)(src + 1024); }
#define ML_ISSUE(s_) { const int r0n = ML_ROW0(s_); ML_LD(0, pq0, pk0) ML_LD(1, pq1, pk1) ML_LD(2, pq2, pk2) ML_LD(3, pq3, pk3) \
      if (tid < 128) pv = *(const uint4*)(QKV + (size_t)(r0n + (tid >> 1)) * 4096 + 2048 + hh * 256 + sl * 16 + (tid & 1) * 8); \
      if (w == 0) { const float* gp_ = GT + (size_t)(r0n + (d ? 63 - lane : lane)) * 32 + d * 16 + hh; pgi = gp_[0]; pgf = gp_[8]; } }
#define ML_ST(i_, PQ, PK) { int idx = tid + 256 * (i_), rho = idx >> 4, c8 = idx & 15; *(uint4*)(sQ + rho * QS + c8 * 8) = PQ; *(uint4*)(sK + rho * QS + c8 * 8) = PK; }
#define ML_COMMIT() { ML_ST(0, pq0, pk0) ML_ST(1, pq1, pk1) ML_ST(2, pq2, pk2) ML_ST(3, pq3, pk3) \
      if (tid < 128) { int rho = tid >> 1, vb = (tid & 1) * 8; \
        sVT[(vb + 0) * VS + rho] = (bfr)(pv.x & 0xffff); sVT[(vb + 1) * VS + rho] = (bfr)(pv.x >> 16); \
        sVT[(vb + 2) * VS + rho] = (bfr)(pv.y & 0xffff); sVT[(vb + 3) * VS + rho] = (bfr)(pv.y >> 16); \
        sVT[(vb + 4) * VS + rho] = (bfr)(pv.z & 0xffff); sVT[(vb + 5) * VS + rho] = (bfr)(pv.z >> 16); \
        sVT[(vb + 6) * VS + rho] = (bfr)(pv.w & 0xffff); sVT[(vb + 7) * VS + rho] = (bfr)(pv.w >> 16); } }
    ML_ISSUE(0)
    __syncthreads();
    for (int s = 0; s < NCH_; s++) {
      const int r0 = ML_ROW0(s);
      ML_COMMIT()
      if (w == 0) {
        int rho = d ? 63 - lane : lane;
        float gi = pgi + gbias[(d * 2 + 0) * 8 + hh], gf = pgf + gbias[(d * 2 + 1) * 8 + hh];
        float fc = fminf(gf, 0.f) - __logf(1.f + __expf(-fabsf(gf)));
        float bc = fc;
        for (int o = 1; o < 64; o <<= 1) { float t = __shfl_up(bc, o); if (lane >= o) bc += t; }
        float e = gi - bc, pm = e;
        for (int o = 1; o < 64; o <<= 1) { float t = __shfl_up(pm, o); if (lane >= o) pm = fmaxf(pm, t); }
        float pml = __shfl(pm, 63), bcl = __shfl(bc, 63);
        const float mx_ = fmaxf(mcur, pml);
        sEs[rho] = __expf(fminf(e, 80.f)); sCt[rho] = -fmaxf(mcur, pm); sBc[rho] = bc; sWg[rho] = __expf(e - mx_);
        if (lane == 0) { sMisc[0] = mcur; sMisc[1] = __expf(mcur - mx_); }
        mcur = bcl + mx_;
      }
      __syncthreads();
      const float mold = sMisc[0], decay = sMisc[1];

      const int rt = 16 * w + l15;
      bfr* hp = HS + (size_t)(r0 + rt) * 2048 + hh * 256 + sl * 16 + 4 * q4;
      bool first; { int rc = (r0 - b * BT_) >> 6; if (d == 0) { int sp = rc < 4 ? 3 - rc : 263 - rc; first = s < sp; } else first = s < rc; }
      unsigned long long uu = 0ull;
      if (!first) uu = __hip_atomic_load((unsigned long long*)hp, __ATOMIC_RELAXED, __HIP_MEMORY_SCOPE_AGENT);
      if (s + 1 < NCH_) ML_ISSUE(s + 1)
      { const int vr = tid >> 4, sg = (tid & 15) * 4; const uint2 vv_ = *(const uint2*)(sVT + vr * VS + sg); const float4 wg4 = *(const float4*)(sWg + sg);
        *(uint2*)(sVW + vr * VS + sg) = uint2{cvtpk(blo(vv_.x) * wg4.x, bhi(vv_.x) * wg4.y), cvtpk(blo(vv_.y) * wg4.z, bhi(vv_.y) * wg4.w)}; }
      bf16x8 qf[4];
#pragma unroll
      for (int ks = 0; ks < 4; ks++) qf[ks] = *(const bf16x8*)(sQ + (16 * w + l15) * QS + ks * 32 + q4 * 8);
      f32x4 sacc[4];
#pragma unroll
      for (int a = 0; a < 4; a++) { sacc[a] = f32x4{0.f, 0.f, 0.f, 0.f};
#pragma unroll
        for (int ks = 0; ks < 4; ks++) { bf16x8 kf = *(const bf16x8*)(sK + (16 * a + l15) * QS + ks * 32 + q4 * 8); sacc[a] = __builtin_amdgcn_mfma_f32_16x16x32_bf16(kf, qf[ks], sacc[a], 0, 0, 0); } }
      const float ctt = sCt[rt]; const float ect = __expf(ctt); float densum = 0.f;
#pragma unroll
      for (int a = 0; a < 4; a++) { const float4 ex4 = *(const float4*)(sEs + 16 * a + 4 * q4); const float exv[4] = {ex4.x, ex4.y, ex4.z, ex4.w};
#pragma unroll
        for (int jj = 0; jj < 4; jj++) { int rs_ = 16 * a + 4 * q4 + jj; bool valid = d == 0 ? rs_ <= rt : rs_ >= rt;
          float wv = valid ? ect * exv[jj] : 0.f; float sv = sacc[a][jj] * wv; sacc[a][jj] = sv; densum += sv; } }
      densum += __shfl_xor(densum, 16); densum += __shfl_xor(densum, 32);
      bf16x8 sf[2], vf[2];
#pragma unroll
      for (int ks = 0; ks < 2; ks++) {
#pragma unroll
        for (int jj = 0; jj < 4; jj++) { sf[ks][jj] = (short)f2b(sacc[2 * ks][jj]); sf[ks][4 + jj] = (short)f2b(sacc[2 * ks + 1][jj]); }
        uint2 v0 = *(const uint2*)(sVT + l15 * VS + 32 * ks + 4 * q4), v1 = *(const uint2*)(sVT + l15 * VS + 32 * ks + 16 + 4 * q4);
        uint4 vv = uint4{v0.x, v0.y, v1.x, v1.y}; vf[ks] = *(bf16x8*)&vv;
      }
      f32x4 num = f32x4{0.f, 0.f, 0.f, 0.f}, numC = f32x4{0.f, 0.f, 0.f, 0.f};
#pragma unroll
      for (int ks = 0; ks < 2; ks++) num = __builtin_amdgcn_mfma_f32_16x16x32_bf16(vf[ks], sf[ks], num, 0, 0, 0);
#pragma unroll
      for (int ks = 0; ks < 4; ks++) { bf16x8 cf = *(const bf16x8*)(sCT + l15 * QS + ks * 32 + q4 * 8); numC = __builtin_amdgcn_mfma_f32_16x16x32_bf16(cf, qf[ks], numC, 0, 0, 0); }
      f32x4 qnacc = f32x4{0.f, 0.f, 0.f, 0.f};
#pragma unroll
      for (int ks = 0; ks < 4; ks++) { bf16x8 na = bf16x8{0, 0, 0, 0, 0, 0, 0, 0}; if (l15 == 0) na = *(const bf16x8*)(sNb + ks * 32 + q4 * 8);
        qnacc = __builtin_amdgcn_mfma_f32_16x16x32_bf16(na, qf[ks], qnacc, 0, 0, 0); }
      const float qn = __shfl(qnacc[0], l15);
      {
        float inter = __expf(mold + ctt); float den = densum + inter * qn; float dn = fmaxf(fabsf(den), __expf(ctt - sBc[rt])); float inv = __builtin_amdgcn_rcpf(dn);
        f32x4 hv;
#pragma unroll
        for (int jj = 0; jj < 4; jj++) hv[jj] = (num[jj] + inter * numC[jj]) * inv;
        if (!first) { unsigned ux = (unsigned)uu, uy = (unsigned)(uu >> 32);
          hv[0] += blo(ux); hv[1] += bhi(ux); hv[2] += blo(uy); hv[3] += bhi(uy); }
        store4b(hp, hv);
      }
      __syncthreads();
      {
        bf16x8 vw[2], wa[2];
#pragma unroll
        for (int ks = 0; ks < 2; ks++) {
          const uint2 v0 = *(const uint2*)(sVW + l15 * VS + 32 * ks + 4 * q4), v1 = *(const uint2*)(sVW + l15 * VS + 32 * ks + 16 + 4 * q4);
          uint4 vv = uint4{v0.x, v0.y, v1.x, v1.y}; vw[ks] = *(bf16x8*)&vv;
          uint4 wz = uint4{0u, 0u, 0u, 0u};
          if (l15 == 0) { const float4 g0 = *(const float4*)(sWg + 32 * ks + 4 * q4), g1 = *(const float4*)(sWg + 32 * ks + 16 + 4 * q4); wz = uint4{cvtpk(g0.x, g0.y), cvtpk(g0.z, g0.w), cvtpk(g1.x, g1.y), cvtpk(g1.z, g1.w)}; }
          wa[ks] = *(bf16x8*)&wz; }
#pragma unroll
        for (int a = 0; a < 2; a++) {
          int dk = 32 * w + 16 * a + l15;
#pragma unroll
          for (int jj = 0; jj < 4; jj++) Cacc[a][jj] *= decay;
          f32x4 nacc = f32x4{0.f, 0.f, 0.f, 0.f};
#pragma unroll
          for (int ks = 0; ks < 2; ks++) { bf16x8 kt;
#pragma unroll
            for (int e = 0; e < 8; e++) { int rs_ = 32 * ks + (e < 4 ? 4 * q4 + e : 16 + 4 * q4 + e - 4); kt[e] = (short)sK[rs_ * QS + dk]; }
            Cacc[a] = __builtin_amdgcn_mfma_f32_16x16x32_bf16(vw[ks], kt, Cacc[a], 0, 0, 0);
            nacc = __builtin_amdgcn_mfma_f32_16x16x32_bf16(wa[ks], kt, nacc, 0, 0, 0); }
          if (q4 == 0) sNr[dk] = nacc[0];
#pragma unroll
          for (int jj = 0; jj < 4; jj++) sCT[(4 * q4 + jj) * QS + dk] = f2b(Cacc[a][jj]);
        }
      }
      __syncthreads();
      if (tid < 128) { const float nv = decay * sN[tid] + sNr[tid]; sN[tid] = nv; sNb[tid] = f2b(nv); }
    }
    __syncthreads();
  }
}

#define CS 72
#define CSLOT(i_) ((bfr*)smem + (i_) * (64 * CS))
#define A_SST (A_R7B + 362086400ull)
__device__ __forceinline__ f32x4 cmm(const bfr* X, const bfr* YT, int ti, int tj, int l15, int q4) {
  f32x4 acc = f32x4{0.f, 0.f, 0.f, 0.f};
#pragma unroll
  for (int ks = 0; ks < 2; ks++) { bf16x8 a = *(const bf16x8*)(X + (16 * ti + l15) * CS + 32 * ks + 8 * q4); bf16x8 b = *(const bf16x8*)(YT + (16 * tj + l15) * CS + 32 * ks + 8 * q4);
    acc = __builtin_amdgcn_mfma_f32_16x16x32_bf16(a, b, acc, 0, 0, 0); }
  return acc;
}
template <int MODE> __device__ __forceinline__ f32x4 cmm_mask(const bfr* X, const bfr* YT, int ti, int tj, int l15, int q4) {
  f32x4 acc = f32x4{0.f, 0.f, 0.f, 0.f};
#pragma unroll
  for (int ks = 0; ks < 2; ks++) { const int kb = 2 * ks + (q4 >> 1);
    const bool ok = MODE == 1 ? ((kb == 0 && tj == 1) || (kb == 2 && tj == 3)) : (kb < 2 && tj >= 2);
    bf16x8 a = *(const bf16x8*)(X + (16 * ti + l15) * CS + 32 * ks + 8 * q4); bf16x8 bz = bf16x8{0, 0, 0, 0, 0, 0, 0, 0};
    if (ok) bz = *(const bf16x8*)(YT + (16 * tj + l15) * CS + 32 * ks + 8 * q4);
    acc = __builtin_amdgcn_mfma_f32_16x16x32_bf16(a, bz, acc, 0, 0, 0); }
  return acc;
}
__device__ __forceinline__ void st_row(bfr* dst, int r0, int c, f32x4 v) {
#pragma unroll
  for (int jj = 0; jj < 4; jj++) dst[(r0 + jj) * CS + c] = f2b(v[jj]); }
__device__ __forceinline__ void st_tr(bfr* dst, int r0, int c, f32x4 v) { store4b(dst + c * CS + r0, v); }
__device__ __forceinline__ f32x4 ld_row(const bfr* src, int r0, int c) { f32x4 v;
#pragma unroll
  for (int jj = 0; jj < 4; jj++) v[jj] = b2f(src[(r0 + jj) * CS + c]);
  return v; }
__device__ __forceinline__ f32x4 ld_tr(const bfr* src, int r0, int c) { uint2 u = *(const uint2*)(src + c * CS + r0); return f32x4{blo(u.x), bhi(u.x), blo(u.y), bhi(u.y)}; }

__device__ __forceinline__ void ph_r7_ca(const P& p, int j, int win, char* smem) {
  float* LW = (float*)(smem + 7 * 9216); float* AT = (float*)(smem + 9 * 9216); float* WL = (float*)(smem + 14 * 9216);
  const bfr* RK = (const bfr*)(p.ACT + A_RKVZ); const bfr* WMb = (const bfr*)(p.ACT + A_WM); const bfr* AMb = (const bfr*)(p.ACT + A_AM);
  float* BON = (float*)(p.ACT + A_BON); bfr* WB = p.H;
  const float* kkp = p.r7_k_k + (size_t)j * 1024; const float* kap = p.r7_k_a + (size_t)j * 1024; const float* rkp = p.r7_r_k + (size_t)j * 1024;
  const int tid = ltid(), lane = tid & 63, w = tid >> 6, l15 = lane & 15, q4 = lane >> 4, ti = w >> 1, tj0 = (w & 1) * 2;
  const int c0 = win * 20;
  for (int it = blockIdx.x; it < 1280; it += gridDim.x) {
    const int chain = it / 20, cl = it - chain * 20, c = c0 + cl, d = chain & 1, b = chain >> 5, h = (chain >> 1) & 15;
    {
      const int rowA = rowmap(d, b, 64 * c + 16 * ti + l15);
      const float* w0 = p.r7_w0 + (size_t)(j * 2 + d) * 1024 + h * 64; const float* a0 = p.r7_a0 + (size_t)(j * 2 + d) * 1024 + h * 64;
#pragma unroll
      for (int tt = 0; tt < 2; tt++) { const int tj = tj0 + tt; f32x4 aw = f32x4{0.f, 0.f, 0.f, 0.f}, aa = aw;
#pragma unroll
        for (int ks = 0; ks < 2; ks++) {
          bf16x8 xw = *(const bf16x8*)(WMb + (size_t)rowA * 128 + d * 64 + 32 * ks + 8 * q4), xa = *(const bf16x8*)(AMb + (size_t)rowA * 128 + d * 64 + 32 * ks + 8 * q4);
          bf16x8 yw = *(const bf16x8*)(p.W + WR_UP + d * 65536 + (size_t)(h * 64 + 16 * tj + l15) * 64 + 32 * ks + 8 * q4);
          bf16x8 ya = *(const bf16x8*)(p.W + WR_UP + (2 + d) * 65536 + (size_t)(h * 64 + 16 * tj + l15) * 64 + 32 * ks + 8 * q4);
          aw = __builtin_amdgcn_mfma_f32_16x16x32_bf16(xw, yw, aw, 0, 0, 0); aa = __builtin_amdgcn_mfma_f32_16x16x32_bf16(xa, ya, aa, 0, 0, 0); }
        const int ch = 16 * tj + l15; const float w0v = w0[ch], a0v = a0[ch];
#pragma unroll
        for (int jj = 0; jj < 4; jj++) { const int tau = 16 * ti + 4 * q4 + jj; LW[tau * 64 + ch] = -0.6065306597126334f * sigm(w0v + aw[jj]); AT[tau * 64 + ch] = sigm(a0v + aa[jj]); }
      }
    }
    __syncthreads();
    if (tid < 64) { float acc = 0.f;
#pragma unroll 8
      for (int t = 0; t < 64; t++) { acc += LW[t * 64 + tid]; LW[t * 64 + tid] = acc; } }
    __syncthreads();
    {
      const int tau = tid >> 3, sc = tid & 7, col = h * 64 + sc * 8; const int row = rowmap(d, b, 64 * c + tau);
      const bfr* rp = RK + (size_t)row * 4096 + col; uint4 pr = *(const uint4*)rp, pk = *(const uint4*)(rp + 1024);
      unsigned ur[4] = {pr.x, pr.y, pr.z, pr.w}, uk[4] = {pk.x, pk.y, pk.z, pk.w};
      float r8[8], k8[8], kr[8];
#pragma unroll
      for (int e = 0; e < 4; e++) { r8[2 * e] = blo(ur[e]); r8[2 * e + 1] = bhi(ur[e]); k8[2 * e] = blo(uk[e]); k8[2 * e + 1] = bhi(uk[e]); }
      float ss = 0.f;
#pragma unroll
      for (int e = 0; e < 8; e++) { kr[e] = k8[e] * kkp[col + e]; ss += kr[e] * kr[e]; }
      ss += __shfl_xor(ss, 1); ss += __shfl_xor(ss, 2); ss += __shfl_xor(ss, 4);
      const float inv = __builtin_amdgcn_rsqf(fmaxf(ss, 1e-24f));
      float bon = 0.f, o0[8], o1[8], o2[8], o3[8], o4[8], o5[8];
#pragma unroll
      for (int e = 0; e < 8; e++) {
        const float cw = LW[tau * 64 + sc * 8 + e], cwm = tau > 0 ? LW[(tau - 1) * 64 + sc * 8 + e] : 0.f, cwl = LW[63 * 64 + sc * 8 + e], a = AT[tau * 64 + sc * 8 + e];
        const float ka = kr[e] * inv, be = a * ka, kd = k8[e] * (1.f + (a - 1.f) * kap[col + e]); bon += r8[e] * kd * rkp[col + e];
        const float e2 = __expf(-cw), e4 = __expf(cwl - cw);
        o0[e] = ka * __expf(cwm); o1[e] = be * e2; o2[e] = kd * e2; o3[e] = r8[e] * __expf(cw); o4[e] = be * e4; o5[e] = kd * e4;
        if (tau == 63) WL[sc * 8 + e] = __expf(cwl);
      }
      bon += __shfl_xor(bon, 1); bon += __shfl_xor(bon, 2); bon += __shfl_xor(bon, 4);
      if (sc == 0) BON[((size_t)d * R_ + row) * 16 + h] = bon;
      *(uint4*)(CSLOT(0) + tau * CS + sc * 8) = uint4{pk2(o0[0], o0[1]), pk2(o0[2], o0[3]), pk2(o0[4], o0[5]), pk2(o0[6], o0[7])};
      *(uint4*)(CSLOT(1) + tau * CS + sc * 8) = uint4{pk2(o1[0], o1[1]), pk2(o1[2], o1[3]), pk2(o1[4], o1[5]), pk2(o1[6], o1[7])};
      *(uint4*)(CSLOT(2) + tau * CS + sc * 8) = uint4{pk2(o2[0], o2[1]), pk2(o2[2], o2[3]), pk2(o2[4], o2[5]), pk2(o2[6], o2[7])};
      *(uint4*)(CSLOT(3) + tau * CS + sc * 8) = uint4{pk2(o3[0], o3[1]), pk2(o3[2], o3[3]), pk2(o3[4], o3[5]), pk2(o3[6], o3[7])};
#pragma unroll
      for (int e = 0; e < 8; e++) { CSLOT(4)[(sc * 8 + e) * CS + tau] = f2b(o0[e]); CSLOT(5)[(sc * 8 + e) * CS + tau] = f2b(o4[e]); CSLOT(6)[(sc * 8 + e) * CS + tau] = f2b(o5[e]); }
    }
    __syncthreads();
#pragma unroll
    for (int tt = 0; tt < 2; tt++) { const int tj = tj0 + tt, r0 = 16 * ti + 4 * q4, cc = 16 * tj + l15;
      f32x4 v = cmm(CSLOT(1), CSLOT(0), ti, tj, l15, q4);
#pragma unroll
      for (int jj = 0; jj < 4; jj++) if (!(r0 + jj < cc)) v[jj] = 0.f;
      st_row(CSLOT(7), r0, cc, v); st_tr(CSLOT(8), r0, cc, v);
      v = cmm(CSLOT(2), CSLOT(0), ti, tj, l15, q4);
#pragma unroll
      for (int jj = 0; jj < 4; jj++) if (!(r0 + jj < cc)) v[jj] = 0.f;
      st_row(CSLOT(9), r0, cc, v);
      v = cmm(CSLOT(3), CSLOT(1), ti, tj, l15, q4);
#pragma unroll
      for (int jj = 0; jj < 4; jj++) if (!(cc <= r0 + jj)) v[jj] = 0.f;
      st_row(CSLOT(10), r0, cc, v);
      v = cmm(CSLOT(3), CSLOT(2), ti, tj, l15, q4);
#pragma unroll
      for (int jj = 0; jj < 4; jj++) if (!(cc <= r0 + jj)) v[jj] = 0.f;
      st_row(CSLOT(11), r0, cc, v);
    }
    __syncthreads();
    {
      float* X = (float*)CSLOT(0);
      const bfr* Ab = CSLOT(7);
      const int cl = lane >> 3, pp = lane & 7, cx = 8 * w + cl, blk0 = (w >> 1) * 16;
#pragma unroll 1
      for (int il = 15; il >= 0; il--) { const int i = blk0 + il;
        float sum = 0.f;
#pragma unroll 1
        for (int jx = i + 1 + pp; jx < blk0 + 16; jx += 8) sum += b2f(Ab[i * CS + jx]) * X[jx * 72 + cx];
        sum += dppf<0xB1>(sum); sum += dppf<0x4E>(sum); sum += dppf<0x141>(sum);
        const float xv = (i == cx ? 1.f : 0.f) - sum;
        if (pp == 0) X[i * 72 + cx] = xv;
      }
      __syncthreads();
#pragma unroll 1
      for (int e = tid; e < 4096; e += 512) { const int i = e >> 6, c2 = e & 63; const bfr tv = ((i >> 4) == (c2 >> 4)) ? f2b(X[i * 72 + c2]) : (bfr)0; CSLOT(2)[i * CS + c2] = tv; CSLOT(12)[c2 * CS + i] = tv; }
      __syncthreads();
#pragma unroll
      for (int tt = 0; tt < 2; tt++) { const int tj = tj0 + tt, r0 = 16 * ti + 4 * q4, cc = 16 * tj + l15; st_row(CSLOT(13), r0, cc, cmm_mask<1>(CSLOT(2), CSLOT(8), ti, tj, l15, q4)); }
      __syncthreads();
#pragma unroll
      for (int tt = 0; tt < 2; tt++) { const int tj = tj0 + tt, r0 = 16 * ti + 4 * q4, cc = 16 * tj + l15;
        f32x4 v = ld_row(CSLOT(2), r0, cc) - cmm(CSLOT(13), CSLOT(12), ti, tj, l15, q4); st_row(CSLOT(0), r0, cc, v); st_tr(CSLOT(1), r0, cc, v); }
      __syncthreads();
#pragma unroll
      for (int tt = 0; tt < 2; tt++) { const int tj = tj0 + tt, r0 = 16 * ti + 4 * q4, cc = 16 * tj + l15; st_row(CSLOT(13), r0, cc, cmm_mask<2>(CSLOT(0), CSLOT(8), ti, tj, l15, q4)); }
      __syncthreads();
#pragma unroll
      for (int tt = 0; tt < 2; tt++) { const int tj = tj0 + tt, r0 = 16 * ti + 4 * q4, cc = 16 * tj + l15;
        f32x4 v = ld_row(CSLOT(0), r0, cc) - cmm(CSLOT(13), CSLOT(1), ti, tj, l15, q4);
#pragma unroll
        for (int jj = 0; jj < 4; jj++) if (r0 + jj == cc) v[jj] -= 1.f;
        st_row(CSLOT(2), r0, cc, v); }
      __syncthreads();
    }
#pragma unroll
    for (int tt = 0; tt < 2; tt++) { const int tj = tj0 + tt, r0 = 16 * ti + 4 * q4, cc = 16 * tj + l15;
      f32x4 g = cmm(CSLOT(10), CSLOT(2), ti, tj, l15, q4) + ld_row(CSLOT(10), r0, cc); st_row(CSLOT(12), r0, cc, g);
      f32x4 hh = cmm(CSLOT(5), CSLOT(2), ti, tj, l15, q4) + ld_row(CSLOT(5), r0, cc); st_row(CSLOT(13), r0, cc, hh); }
    __syncthreads();
    {
      bfr* out = WB + (size_t)(chain * 20 + cl) * 16384;
#pragma unroll
      for (int tt = 0; tt < 2; tt++) { const int tj = tj0 + tt, r0 = 16 * ti + 4 * q4, cc = 16 * tj + l15;
        f32x4 v = ld_tr(CSLOT(3), r0, cc) - cmm(CSLOT(4), CSLOT(12), ti, tj, l15, q4);
        store4b(out + cc * 64 + r0, v);
        v = ld_tr(CSLOT(11), r0, cc) - cmm(CSLOT(9), CSLOT(12), ti, tj, l15, q4);
        store4b(out + 4096 + cc * 64 + r0, v);
        v = -cmm(CSLOT(4), CSLOT(13), ti, tj, l15, q4);
#pragma unroll
        for (int jj = 0; jj < 4; jj++) if (r0 + jj == cc) v[jj] += WL[cc];
        store4b(out + 8192 + cc * 64 + r0, v);
        v = ld_tr(CSLOT(6), r0, cc) - cmm(CSLOT(9), CSLOT(13), ti, tj, l15, q4);
        store4b(out + 12288 + cc * 64 + r0, v);
      }
    }
    __syncthreads();
  }
}

__device__ __forceinline__ void ph_r7_cb(const P& p, int win, char* smem) {
  bfr* Sh = (bfr*)smem; bfr* Sl = Sh + 2 * 16 * CS; bfr* VT = Sl + 2 * 16 * CS;
  const bfr* WB = p.H; const bfr* RK = (const bfr*)(p.ACT + A_RKVZ); bfr* SST = (bfr*)(p.ACT + A_SST);
  const int tid = ltid(), lane = tid & 63, w = tid >> 6, l15 = lane & 15, q4 = lane >> 4;
  const int c0 = win * 20;
  for (int it = blockIdx.x; it < 256; it += gridDim.x) {
    const int d = it & 1, b = it >> 7, h = (it >> 3) & 15, rg = (it >> 1) & 3, chain = (b * 16 + h) * 2 + d;
    bfr* Y = d ? R7_Y2 : (bfr*)(p.ACT + A_Y);
    bfr* sst = SST + (size_t)(chain * 4 + rg) * 2048;
    __syncthreads();
    if (tid < 256) { const int hl = tid >> 7, e = tid & 127, rr = e >> 3, c8 = e & 7; uint4 v = uint4{0u, 0u, 0u, 0u};
      if (win > 0) v = *(const uint4*)(sst + hl * 1024 + rr * 64 + c8 * 8);
      *(uint4*)((hl ? Sl : Sh) + rr * CS + c8 * 8) = v; }
    const int vtau = tid >> 3, vp = tid & 7;
    { const int row = rowmap(d, b, 64 * c0 + vtau); unsigned vv = *(const unsigned*)(RK + (size_t)row * 4096 + 2048 + h * 64 + rg * 16 + 2 * vp);
      VT[(2 * vp) * CS + vtau] = (bfr)(vv & 0xffff); VT[(2 * vp + 1) * CS + vtau] = (bfr)(vv >> 16); }
    const bfr* bbase = WB + (size_t)(chain * 20) * 16384 + (w < 4 ? 8192 + (16 * w + l15) * 64 : (16 * (w - 4) + l15) * 64) + 8 * q4;
    bf16x8 rb1[4][2], rb2[4][2]; unsigned rv[4];
#define CB_LOAD(u_, s_) { const int ss_ = (s_) < 20 ? (s_) : 19; const bfr* bp_ = bbase + (size_t)ss_ * 16384; \
      rb1[u_][0] = *(const bf16x8*)bp_; rb1[u_][1] = *(const bf16x8*)(bp_ + 32); rb2[u_][0] = *(const bf16x8*)(bp_ + 4096); rb2[u_][1] = *(const bf16x8*)(bp_ + 4096 + 32); \
      const int sv_ = ss_ + 1 < 20 ? ss_ + 1 : 19; const int rowv_ = rowmap(d, b, 64 * (c0 + sv_) + vtau); \
      rv[u_] = *(const unsigned*)(RK + (size_t)rowv_ * 4096 + 2048 + h * 64 + rg * 16 + 2 * vp); }
    CB_LOAD(0, 0) CB_LOAD(1, 1) CB_LOAD(2, 2) CB_LOAD(3, 3)
    __syncthreads();
    for (int g = 0; g < 5; g++) {
#pragma unroll
      for (int u = 0; u < 4; u++) {
        const int s = 4 * g + u;
        if (s < 20) {
          const int cur = s & 1, nxt = cur ^ 1, c = c0 + s;
          bf16x8 sh[2], sl[2], vt[2];
#pragma unroll
          for (int ks = 0; ks < 2; ks++) { sh[ks] = *(const bf16x8*)(Sh + (cur * 16 + l15) * CS + 32 * ks + 8 * q4); sl[ks] = *(const bf16x8*)(Sl + (cur * 16 + l15) * CS + 32 * ks + 8 * q4);
            vt[ks] = *(const bf16x8*)(VT + (cur * 16 + l15) * CS + 32 * ks + 8 * q4); }
          f32x4 a1 = f32x4{0.f, 0.f, 0.f, 0.f}, a2 = a1;
#pragma unroll
          for (int ks = 0; ks < 2; ks++) { a1 = __builtin_amdgcn_mfma_f32_16x16x32_bf16(sh[ks], rb1[u][ks], a1, 0, 0, 0); a2 = __builtin_amdgcn_mfma_f32_16x16x32_bf16(vt[ks], rb2[u][ks], a2, 0, 0, 0); }
#pragma unroll
          for (int ks = 0; ks < 2; ks++) a1 = __builtin_amdgcn_mfma_f32_16x16x32_bf16(sl[ks], rb1[u][ks], a1, 0, 0, 0);
          a1 = a1 + a2;
          if (w < 4) {
#pragma unroll
            for (int jj = 0; jj < 4; jj++) { const bfr hi = f2b(a1[jj]); Sh[(nxt * 16 + 4 * q4 + jj) * CS + 16 * w + l15] = hi; Sl[(nxt * 16 + 4 * q4 + jj) * CS + 16 * w + l15] = f2b(a1[jj] - b2f(hi)); }
          } else {
            const int rowy = rowmap(d, b, 64 * c + 16 * (w - 4) + l15);
            store4b(Y + (size_t)rowy * 1024 + h * 64 + rg * 16 + 4 * q4, a1);
          }
          if (s + 1 < 20) { VT[(nxt * 16 + 2 * vp) * CS + vtau] = (bfr)(rv[u] & 0xffff); VT[(nxt * 16 + 2 * vp + 1) * CS + vtau] = (bfr)(rv[u] >> 16); }
          if (s + 4 < 20) CB_LOAD(u, s + 4)
          __syncthreads();
        }
      }
    }
    if (tid < 256) { const int hl = tid >> 7, e = tid & 127, rr = e >> 3, c8 = e & 7; *(uint4*)(sst + hl * 1024 + rr * 64 + c8 * 8) = *(const uint4*)((hl ? Sl : Sh) + rr * CS + c8 * 8); }
  }
}

__device__ __forceinline__ void run_phase(const P& p, int ph, int layer, int d, char* smem) {
  Ctx c; c.layer = layer; c.j = layer / 3; c.d = d; c.wc = layer < 3 ? 1 : 0;
  switch (ph) {
    case PH_PRE: ph_pre(p, smem); break;
    case PH_NORM: ph_norm(p, layer, smem); break;
    case PH_LRU_IN: big_gemm(smem, p.H, p.W, 2560, 1024, F_LruIn{p.ACT}); break;
    case PH_LRU_CONV: ph_lru_conv(p, c.j); break;
    case PH_LRU_GATE: gemm_phase<G_LruGate>(p, c, smem); break;
    case PH_LRU_S1: ph_lru_s1(p, d); break;
    case PH_LRU_S2: ph_lru_s2(p, smem); break;
    case PH_LRU_S3: ph_lru_s3(p, d); break;
    case PH_LRU_OUT: big_gemm(smem, (const bfr*)(p.ACT + A_Z), p.W + WL_OUT, 1024, 1280, F_Resid{p.Xx, p.Xc, p.MOD + (size_t)layer * 3 * 3072, c.wc}); break;
    case PH_ML_IN: big_gemm(smem, p.H, p.W, 4352, 1024, F_MlIn{p.ACT}); break;
    case PH_ML_SCAN: ph_ml_scan(p, c.j, smem); break;
    case PH_ML_STAT: ph_ml_stat(p); break;
    case PH_ML_Z: big_gemm(smem, p.H, p.W + WM_Z, 2048, 1024, F_MlZ{p.ACT, p.ml_norm_g + (size_t)c.j * 2048}); break;
    case PH_ML_OUT: big_gemm(smem, (const bfr*)(p.ACT + A_HS), p.W + WM_OUT, 1024, 2048, F_Resid{p.Xx, p.Xc, p.MOD + (size_t)layer * 3 * 3072, c.wc}); break;
    case PH_R7_IN: big_gemm(smem, p.H, p.W, 4352, 2048, F_R7In{p.ACT}); break;
    case PH_R7_SHIFT: ph_r7_shift(p); break;
    case PH_R7_CA: ph_r7_ca(p, c.j, d, smem); break;
    case PH_R7_CB: ph_r7_cb(p, d, smem); break;
    case PH_R7_FIN: ph_r7_fin(p, c.j); break;
    case PH_R7_OUT: big_gemm(smem, (const bfr*)(p.ACT + A_Y), p.W + WR_OUT, 1024, 1024, F_Resid{p.Xx, p.Xc, p.MOD + (size_t)layer * 3 * 3072, c.wc}); break;
    case PH_FINAL: ph_final(p); break;
  }
}


#define XB_TMO      128
#define XB_XCNT(j)  (256  + 64 * (j))
#define XB_XSUB(j)  (1280 + 64 * (j))
#define XB_XGEN(j)  (2304 + 64 * (j))
#define XB_TOP      3328
#define XB_TOPGEN   3392
#define XCD_BAR_WORDS 3456
#define XB_SPIN_CAP (1u << 18)
#define OFF_BAR 527000064ull
#define OFF_CL (OFF_BAR + 16384ull)
__device__ __forceinline__ unsigned xb_ld(unsigned* p)              { return __hip_atomic_load(p, __ATOMIC_RELAXED, __HIP_MEMORY_SCOPE_AGENT); }
__device__ __forceinline__ unsigned xb_add(unsigned* p, unsigned v) { return __hip_atomic_fetch_add(p, v, __ATOMIC_RELAXED, __HIP_MEMORY_SCOPE_AGENT); }
__device__ __forceinline__ unsigned xb_xcc_id() { return (unsigned)__builtin_amdgcn_s_getreg((3 << 11) | 20) & 0xFu; }
#define XB_SPIN(cond, bar) do { unsigned _sp = 0; while (cond) { __builtin_amdgcn_s_sleep(1); \
    if ((++_sp & 255u) == 0u) { if (xb_ld(&(bar)[XB_TMO])) break; if (_sp > XB_SPIN_CAP) { atomicAdd(&(bar)[XB_TMO], 1u); break; } } } } while (0)
struct XcdBarrier { unsigned* bar; unsigned x; volatile __attribute__((address_space(3))) unsigned* st; };
__device__ __forceinline__ XcdBarrier xcd_barrier_post(unsigned* bar, volatile __attribute__((address_space(3))) unsigned* st) {
  XcdBarrier b; b.bar = bar; b.x = xb_xcc_id(); b.st = st;
  if (threadIdx.x == 0) (void)xb_add(&bar[XB_XCNT(b.x)], 1u);
  return b;
}
__device__ __forceinline__ void xcd_barrier_complete(unsigned* bar, unsigned x, unsigned& nloc, unsigned& nx) {
  const unsigned G = gridDim.x * gridDim.y * gridDim.z;
  unsigned sum, cnt, mine, sp = 0u;
  for (;;) {
    sum = 0u; cnt = 0u; mine = 0u;
#pragma unroll
    for (unsigned j = 0; j < 16; ++j) { const unsigned c = xb_ld(&bar[XB_XCNT(j)]); sum += c; cnt += (c > 0u) ? 1u : 0u; mine = (j == x) ? c : mine; }
    if (sum == G) break;
    __builtin_amdgcn_s_sleep(1);
    if ((++sp & 255u) == 0u) { if (xb_ld(&bar[XB_TMO])) break; if (sp > XB_SPIN_CAP) { atomicAdd(&bar[XB_TMO], 1u); break; } }
  }
  nloc = mine > 0u ? mine : 1u; nx = cnt > 0u ? cnt : 1u;
}
__device__ __forceinline__ void xcd_barrier(const XcdBarrier& b) {
  asm volatile("s_waitcnt vmcnt(0)" ::: "memory");
  __syncthreads();
  if (threadIdx.x == 0) {
    unsigned* bar = b.bar;
    __builtin_amdgcn_s_waitcnt(0);
    unsigned nloc = b.st[0], nx = b.st[1];
    if (nloc == 0u) { xcd_barrier_complete(bar, b.x, nloc, nx); b.st[0] = nloc; b.st[1] = nx; }
    const unsigned old = xb_add(&bar[XB_XSUB(b.x)], 1u);
    const unsigned gen = old / nloc;
    if (old + 1u == (gen + 1u) * nloc) {
      __builtin_amdgcn_fence(__ATOMIC_RELEASE, "agent");
      asm volatile("s_waitcnt vmcnt(0)" ::: "memory");
      const unsigned og = xb_add(&bar[XB_TOP], 1u);
      const unsigned tg = og / nx;
      if (og + 1u == (tg + 1u) * nx) xb_add(&bar[XB_TOPGEN], 1u);
      else XB_SPIN(xb_ld(&bar[XB_TOPGEN]) == tg, bar);
      __builtin_amdgcn_fence(__ATOMIC_ACQUIRE, "agent");
      xb_add(&bar[XB_XGEN(b.x)], 1u);
      asm volatile("s_waitcnt vmcnt(0)" ::: "memory");
    } else {
      XB_SPIN(xb_ld(&bar[XB_XGEN(b.x)]) == gen, bar);
      __builtin_amdgcn_fence(__ATOMIC_ACQUIRE, "agent");
      asm volatile("s_waitcnt vmcnt(0)" ::: "memory");
    }
  }
  __syncthreads();
}

#define SMEM_BYTES (131072 + 64)
extern __shared__ __attribute__((aligned(16))) char dyn_smem[];
#if !MEGA
__global__ void __launch_bounds__(512, 2) phase_kernel(P p, int si) {
  run_phase(p, p.sched[si * 3], p.sched[si * 3 + 1], p.sched[si * 3 + 2], dyn_smem);
}
#else
__global__ void __launch_bounds__(512, 2) mega_kernel(P p) {
  cg::grid_group grid = cg::this_grid();
  volatile __attribute__((address_space(3))) unsigned* st = (volatile __attribute__((address_space(3))) unsigned*)(dyn_smem + 131072);
  if (threadIdx.x < 4) st[threadIdx.x] = 0u;
  __syncthreads();
  const XcdBarrier xb = xcd_barrier_post(p.bar, st);
  for (int si = 0; si < p.nsched; si++) {
    run_phase(p, p.sched[si * 3], p.sched[si * 3 + 1], p.sched[si * 3 + 2], dyn_smem);
    if (si + 1 < p.nsched) { if (si == 0) grid.sync(); else xcd_barrier(xb); }
  }
}
#endif

extern "C" void kernel_launch(void* const* d_in, const int* in_sizes, int n_in, void* d_out, int out_size, void* d_ws, size_t ws_size, hipStream_t stream) {
  P p; memset(&p, 0, sizeof(p));
  const float** f = (const float**)&p;
  for (int i = 0; i < 33; i++) f[i] = (const float*)d_in[i];
  char* ws = (char*)d_ws;
  p.Xx = (float*)d_out; p.Xc = (float*)(ws + OFF_XC); p.MOD = (float*)(ws + OFF_MOD); p.W = (bfr*)(ws + OFF_W); p.H = (bfr*)(ws + OFF_H); p.ACT = ws + OFF_ACT; p.bar = (unsigned*)(ws + OFF_BAR); p.CL = (float*)(ws + OFF_CL);
  int n = 0;
  auto add = [&](int ph, int layer, int d) { p.sched[n * 3] = ph; p.sched[n * 3 + 1] = layer; p.sched[n * 3 + 2] = d; n++; };
  add(PH_PRE, 0, 0);
  if (DUP & 4) add(PH_PRE, 0, 0);
  for (int l = 0; l < 4; l++) {
    add(PH_NORM, l, 0); if (DUP & 4) add(PH_NORM, l, 0);
    int kind = l % 3;
    const bool dg = DUP & 1, ds = DUP & 2;
    if (kind == 0) { add(PH_LRU_IN, l, 0); if (dg) add(PH_LRU_IN, l, 0); add(PH_LRU_CONV, l, 0); if (DUP & 4) add(PH_LRU_CONV, l, 0);
      for (int d = 0; d < 2; d++) { add(PH_LRU_GATE, l, d); if (dg) add(PH_LRU_GATE, l, d); add(PH_LRU_S1, l, d); if (DUP & 8) add(PH_LRU_S1, l, d); add(PH_LRU_S2, l, d); if (DUP & 16) add(PH_LRU_S2, l, d); add(PH_LRU_S3, l, d); }
      add(PH_LRU_OUT, l, 0); }
    else if (kind == 1) { add(PH_ML_IN, l, 0); if (dg) add(PH_ML_IN, l, 0); add(PH_ML_SCAN, l, 0); if (ds) add(PH_ML_SCAN, l, 0); add(PH_ML_STAT, l, 0); if (DUP & 4) add(PH_ML_STAT, l, 0); add(PH_ML_Z, l, 0); add(PH_ML_OUT, l, 0); }
    else { add(PH_R7_SHIFT, l, 0); add(PH_R7_IN, l, 0); if (dg) add(PH_R7_IN, l, 0); for (int wi = 0; wi < 13; wi++) { add(PH_R7_CA, l, wi); if (DUP & 32) add(PH_R7_CA, l, wi); add(PH_R7_CB, l, wi); } add(PH_R7_FIN, l, 0); add(PH_R7_OUT, l, 0); }
  }
  add(PH_FINAL, 0, 0);
  p.nsched = n;
  if (ws_size < WS_NEED) fprintf(stderr, "workspace too small: %zu < %llu\n", ws_size, (unsigned long long)WS_NEED);
#if MEGA
  static int grid_blocks = 0;
  if (!grid_blocks) { int dev = 0, cus = 0, per = 0; hipGetDevice(&dev); hipDeviceGetAttribute(&cus, hipDeviceAttributeMultiprocessorCount, dev);
    hipFuncSetAttribute((const void*)mega_kernel, hipFuncAttributeMaxDynamicSharedMemorySize, SMEM_BYTES);
    hipOccupancyMaxActiveBlocksPerMultiprocessor(&per, mega_kernel, 512, SMEM_BYTES); if (per > 1) per = 1; if (per < 1) per = 1; grid_blocks = cus * per; }
  hipMemsetAsync(ws + OFF_BAR, 0, XCD_BAR_WORDS * 4, stream);
  void* args[] = {&p};
  hipError_t e = hipLaunchCooperativeKernel((void*)mega_kernel, dim3(grid_blocks), dim3(512), args, SMEM_BYTES, stream);
  if (e != hipSuccess) fprintf(stderr, "cooperative launch failed: %s (grid %d)\n", hipGetErrorString(e), grid_blocks);
#else
  static int once = 0; if (!once) { once = 1; hipFuncSetAttribute((const void*)phase_kernel, hipFuncAttributeMaxDynamicSharedMemorySize, SMEM_BYTES); }
  for (int si = 0; si < n; si++) phase_kernel<<<256, 512, SMEM_BYTES, stream>>>(p, si);
#endif
}
```

```cpp
#include <hip/hip_runtime.h>
#include <hip/hip_bf16.h>
#include <hip/hip_cooperative_groups.h>
#include <cstdio>
#include <cstring>
#include <type_traits>
namespace cg = cooperative_groups;

#ifndef DUP
#define DUP 0
#endif
#ifndef MEGA
#define MEGA 1
#endif

typedef unsigned short bfr;
using bf16x8 = __attribute__((ext_vector_type(8))) short;
using f32x4 = __attribute__((ext_vector_type(4))) float;

#define R_ 33280
#define BT_ 16640
#define NCH_ 260

#define OFF_XC 0ull
#define OFF_MOD 2097152ull
#define OFF_W 2244608ull
#define OFF_H 24264704ull
#define OFF_ACT 92422144ull
#define A_Z 0ull
#define A_UC 85196800ull
#define A_AB 170393600ull
#define A_U 170393600ull
#define A_HF 340787200ull
#define A_AGG 425984000ull
#define A_CAR 431308800ull
#define A_QKV 0ull
#define A_GATE 272629760ull
#define A_HS 276889600ull
#define A_RSTD 413204480ull
#define A_R7B 68157440ull
#define A_RKVZ (A_R7B + 0ull)
#define A_WM (A_R7B + 272629760ull)
#define A_AM (A_R7B + 281149440ull)
#define A_BON (A_R7B + 289669120ull)
#define A_Y (A_R7B + 293928960ull)
#define WS_NEED (527000064ull + 16384ull)

#define WL_GATE (2560 * 1024)
#define WL_OUT (WL_GATE + 1310720)
#define WM_Z (4352 * 1024)
#define WM_OUT (WM_Z + 2048 * 1024)
#define WR_UP (4352 * 2048)
#define WR_OUT (WR_UP + 262144)

enum { PH_PRE = 0, PH_NORM, PH_LRU_IN, PH_LRU_CONV, PH_LRU_GATE, PH_LRU_S1, PH_LRU_S2, PH_LRU_S3, PH_LRU_OUT,
       PH_ML_IN, PH_ML_SCAN, PH_ML_STAT, PH_ML_Z, PH_ML_OUT,
       PH_R7_IN, PH_R7_CA, PH_R7_CB, PH_R7_FIN, PH_R7_OUT, PH_FINAL, PH_R7_SHIFT };

struct P {
  const float *x, *c, *ctx, *c_ctx, *norm_g, *mod_w, *mod_b, *final_g;
  const float *lru_w_in, *lru_conv_w, *lru_conv_b, *lru_gate_w, *lru_gate_b, *lru_lam, *lru_w_out;
  const float *ml_w_in, *ml_gate_b, *ml_norm_g, *ml_w_out;
  const float *r7_mu, *r7_w_rkvz, *r7_w0, *r7_w1, *r7_w2, *r7_a0, *r7_a1, *r7_a2, *r7_k_k, *r7_k_a, *r7_r_k, *r7_ln_g, *r7_ln_b, *r7_w_out;
  float* Xx; float* Xc; float* MOD; bfr* W; bfr* H; char* ACT; unsigned* bar; float* CL;
  int nsched; int pad_;
  int sched[64 * 3];
};
struct Ctx { int layer, j, d, wc; };

__device__ __forceinline__ int ltid() { int t = threadIdx.x; asm volatile("" : "+v"(t)); return t; }
typedef float f32v2_ __attribute__((ext_vector_type(2))); typedef __bf16 bf16v2_ __attribute__((ext_vector_type(2)));
__device__ __forceinline__ unsigned cvtpk(float lo, float hi) { f32v2_ f = {lo, hi}; bf16v2_ h = __builtin_convertvector(f, bf16v2_); return __builtin_bit_cast(unsigned, h); }
__device__ __forceinline__ bfr f2b(float f) { return (bfr)(cvtpk(f, f) & 0xffffu); }
__device__ __forceinline__ float b2f(bfr b) { return __uint_as_float(((unsigned)b) << 16); }
__device__ __forceinline__ unsigned pk2(float a, float b) { return cvtpk(a, b); }
__device__ __forceinline__ float blo(unsigned u) { return __uint_as_float(u << 16); }
__device__ __forceinline__ float bhi(unsigned u) { return __uint_as_float(u & 0xffff0000u); }
__device__ __forceinline__ void store4b(bfr* dst, f32x4 v) { uint2 u; u.x = pk2(v[0], v[1]); u.y = pk2(v[2], v[3]); *(uint2*)dst = u; }
__device__ __forceinline__ float sigm(float x) { return __builtin_amdgcn_rcpf(1.f + __expf(-x)); }
__device__ __forceinline__ float siluf(float x) { return x * sigm(x); }
__device__ __forceinline__ float softplusf(float x) { return x > 20.f ? x : log1pf(expf(x)); }
__device__ __forceinline__ int rowmap(int d, int b, int pp) { int o = d == 0 ? pp : (pp < 256 ? 255 - pp : 16895 - pp); return b * BT_ + o; }
__device__ __forceinline__ float* xrowp(const P& p, int row, int& mi) {
  int b = row / BT_, o = row - b * BT_;
  if (o < 256) { mi = 2; return p.Xc + (size_t)(b * 256 + o) * 1024; }
  mi = b; return p.Xx + (size_t)(b * 16384 + o - 256) * 1024;
}
__device__ __forceinline__ float wsum(float v) { for (int o = 32; o; o >>= 1) v += __shfl_xor(v, o); return v; }
template <int CTRL> __device__ __forceinline__ float dppf(float x) {
  return __int_as_float(__builtin_amdgcn_update_dpp(0, __float_as_int(x), CTRL, 0xf, 0xf, true));
}
__device__ __forceinline__ float red16(float x) {
  x += dppf<0xB1>(x); x += dppf<0x4E>(x); x += dppf<0x141>(x); x += dppf<0x140>(x); return x;
}

template <class F> __device__ __forceinline__ void prep_tile(bfr* dst, int K, int tn, int tk, F get, float* sm) {
  int tid = ltid();
  for (int i = 0; i < 8; i++) { int kk = (tid >> 6) + 8 * i, nn = tid & 63; sm[kk * 65 + nn] = get(tk * 64 + kk, tn * 64 + nn); }
  __syncthreads();
  for (int i = 0; i < 8; i++) { int nn = (tid >> 6) + 8 * i, kk = tid & 63; dst[(size_t)(tn * 64 + nn) * K + tk * 64 + kk] = f2b(sm[kk * 65 + nn]); }
  __syncthreads();
}
__device__ __forceinline__ int prep_count(int layer) { int kind = layer % 3; return kind == 0 ? (640 + 320 + 320) : kind == 1 ? (1088 + 512 + 512) : (2176 + 64 + 256); }
__device__ __forceinline__ void prep_item(const P& p, int layer, int it, float* sm) {
  int kind = layer % 3, j = layer / 3;
  if (kind == 0) {
    if (it < 640) { int tn = it / 16, tk = it % 16; const float* s = p.lru_w_in + (size_t)j * 1024 * 2560;
      prep_tile(p.W, 1024, tn, tk, [=](int k, int n) { return s[(size_t)k * 2560 + n]; }, sm); return; }
    it -= 640;
    if (it < 320) { int d = it / 160, r = it % 160, tn = r / 2, tk = r % 2; const float* s = p.lru_gate_w + (size_t)(j * 2 + d) * 2 * 10 * 16384;
      prep_tile(p.W + WL_GATE + d * 655360, 128, tn, tk, [=](int k, int n) {
        int nt = n >> 7, blk = nt >> 1, sub = nt & 1, jj = n & 127, wn = jj >> 6, rr = jj & 63, g = rr >> 5, c = rr & 31;
        int kch = sub * 64 + wn * 32 + c; return s[((size_t)(g * 10 + blk) * 128 + k) * 128 + kch]; }, sm); return; }
    it -= 320;
    { int tn = it / 20, tk = it % 20; const float* s = p.lru_w_out + (size_t)j * 1280 * 1024;
      prep_tile(p.W + WL_OUT, 1280, tn, tk, [=](int k, int n) { return s[(size_t)k * 1024 + n]; }, sm); return; }
  } else if (kind == 1) {
    const float* s = p.ml_w_in + (size_t)j * 1024 * 6176;
    if (it < 1088) { int tn = it / 16, tk = it % 16;
      prep_tile(p.W, 1024, tn, tk, [=](int k, int n) {
        if (n < 4096) { float v = s[(size_t)k * 6176 + n]; return (n >= 1024 && n < 2048) ? v * 0.08838834764831845f : v; }
        if (n < 4128) return s[(size_t)k * 6176 + 6144 + (n - 4096)];
        return 0.f; }, sm); return; }
    it -= 1088;
    if (it < 512) { int tn = it / 16, tk = it % 16;
      prep_tile(p.W + WM_Z, 1024, tn, tk, [=](int k, int n) { return s[(size_t)k * 6176 + 4096 + n]; }, sm); return; }
    it -= 512;
    { int tn = it / 32, tk = it % 32; const float* so = p.ml_w_out + (size_t)j * 2048 * 1024;
      prep_tile(p.W + WM_OUT, 2048, tn, tk, [=](int k, int n) { return so[(size_t)k * 1024 + n]; }, sm); return; }
  } else {
    if (it < 2176) { int tn = it / 32, tk = it % 32;
      const float* mu = p.r7_mu + (size_t)j * 6 * 1024; const float* wr = p.r7_w_rkvz + (size_t)j * 4 * 1024 * 1024;
      const float* w1 = p.r7_w1 + (size_t)j * 2 * 1024 * 64; const float* a1 = p.r7_a1 + (size_t)j * 2 * 1024 * 64;
      prep_tile(p.W, 2048, tn, tk, [=](int k, int n) {
        int kk = k & 1023; float v, m;
        if (n < 4096) { int g = n >> 10, e = n & 1023; m = mu[g * 1024 + kk]; v = wr[((size_t)g * 1024 + kk) * 1024 + e]; }
        else if (n < 4224) { int xx = (n - 4096) >> 6, rr = (n - 4096) & 63; m = mu[4 * 1024 + kk]; v = w1[((size_t)xx * 1024 + kk) * 64 + rr]; }
        else { int xx = (n - 4224) >> 6, rr = (n - 4224) & 63; m = mu[5 * 1024 + kk]; v = a1[((size_t)xx * 1024 + kk) * 64 + rr]; }
        return (k < 1024 ? (1.f - m) : m) * v; }, sm); return; }
    it -= 2176;
    if (it < 64) { int u = it / 16, tn = it % 16; const float* s = (u < 2 ? p.r7_w2 : p.r7_a2) + (size_t)(j * 2 + (u & 1)) * 64 * 1024;
      prep_tile(p.W + WR_UP + u * 65536, 64, tn, 0, [=](int k, int n) { return s[(size_t)k * 1024 + n]; }, sm); return; }
    it -= 64;
    { int tn = it / 16, tk = it % 16; const float* s = p.r7_w_out + (size_t)j * 1024 * 1024;
      prep_tile(p.W + WR_OUT, 1024, tn, tk, [=](int k, int n) { return s[(size_t)k * 1024 + n]; }, sm); return; }
  }
}

#define LDSS 72
template <class G> __device__ __forceinline__ void gemm_tile(const P& p, const Ctx& c, int mt, int nt, char* smem) {
  const int tid = ltid(), lane = tid & 63, wid = tid >> 6, wm = wid & 3, wn = wid >> 2;
  bfr* sA = (bfr*)smem; bfr* sB = sA + 2 * 256 * LDSS;
  f32x4 acc[4][4];
  for (int a = 0; a < 4; a++) for (int b = 0; b < 4; b++) acc[a][b] = f32x4{0.f, 0.f, 0.f, 0.f};
  const int lr = tid >> 3, lc = tid & 7;
  uint4 ra[4], rb[2];
  auto gload = [&](int kt) __attribute__((always_inline)) {
#pragma unroll
    for (int i = 0; i < 4; i++) {
      const bfr* pa = G::aptr(p, c, mt * 256 + lr + 64 * i, kt, nt);
      ra[i] = pa ? *(const uint4*)(pa + lc * 8) : uint4{0u, 0u, 0u, 0u};
      if (i < 2) rb[i] = *(const uint4*)(G::bptr(p, c, nt * 128 + lr + 64 * i, kt) + lc * 8);
    }
  };
  auto sstore = [&](int buf) __attribute__((always_inline)) {
#pragma unroll
    for (int i = 0; i < 4; i++) {
      *(uint4*)(sA + (buf * 256 + lr + 64 * i) * LDSS + lc * 8) = ra[i];
      if (i < 2) *(uint4*)(sB + (buf * 128 + lr + 64 * i) * LDSS + lc * 8) = rb[i];
    }
  };
  gload(0); sstore(0); __syncthreads();
  for (int kt = 0; kt < G::KT; kt++) {
    const int buf = kt & 1;
    if (kt + 1 < G::KT) gload(kt + 1);
#pragma unroll
    for (int ks = 0; ks < 2; ks++) {
      bf16x8 af[4], bf[4];
#pragma unroll
      for (int i = 0; i < 4; i++) {
        af[i] = *(const bf16x8*)(sA + (buf * 256 + wm * 64 + i * 16 + (lane & 15)) * LDSS + ks * 32 + (lane >> 4) * 8);
        bf[i] = *(const bf16x8*)(sB + (buf * 128 + wn * 64 + i * 16 + (lane & 15)) * LDSS + ks * 32 + (lane >> 4) * 8);
      }
#pragma unroll
      for (int n = 0; n < 4; n++)
#pragma unroll
        for (int m = 0; m < 4; m++) acc[n][m] = __builtin_amdgcn_mfma_f32_16x16x32_bf16(bf[n], af[m], acc[n][m], 0, 0, 0);
    }
    if (kt + 1 < G::KT) sstore(buf ^ 1);
    __syncthreads();
  }
  G::epi(p, c, acc, mt * 256 + wm * 64, nt * 128 + wn * 64, lane);
}

__device__ __forceinline__ void epi_resid(const P& p, const Ctx& c, f32x4 (&acc)[4][4], int m0, int n0, int lane) {
#pragma unroll
  for (int mi = 0; mi < 4; mi++) {
    int row = m0 + mi * 16 + (lane & 15); int mo; float* xr = xrowp(p, row, mo);
    if (mo == 2 && !c.wc) continue;
    const float* g = p.MOD + (size_t)(c.layer * 3 + mo) * 3072 + 2048;
#pragma unroll
    for (int ni = 0; ni < 4; ni++) {
      int n = n0 + ni * 16 + (lane >> 4) * 4;
      float4 xv = *(float4*)(xr + n); float4 gg = *(const float4*)(g + n);
      xv.x += gg.x * acc[ni][mi][0]; xv.y += gg.y * acc[ni][mi][1]; xv.z += gg.z * acc[ni][mi][2]; xv.w += gg.w * acc[ni][mi][3];
      *(float4*)(xr + n) = xv;
    }
  }
}

struct G_LruIn { static constexpr int KT = 16, NT = 20;
  static __device__ __forceinline__ const bfr* aptr(const P& p, const Ctx& c, int row, int kt, int nt) { return p.H + (size_t)row * 1024 + kt * 64; }
  static __device__ __forceinline__ const bfr* bptr(const P& p, const Ctx& c, int n, int kt) { return p.W + (size_t)n * 1024 + kt * 64; }
  static __device__ __forceinline__ void epi(const P& p, const Ctx& c, f32x4 (&acc)[4][4], int m0, int n0, int lane) {
    bfr* U = (bfr*)(p.ACT + A_U); bfr* Z = (bfr*)(p.ACT + A_Z);
#pragma unroll
    for (int ni = 0; ni < 4; ni++)
#pragma unroll
      for (int mi = 0; mi < 4; mi++) {
        int row = m0 + mi * 16 + (lane & 15), n = n0 + ni * 16 + (lane >> 4) * 4;
        bfr* dst = n < 1280 ? U + (size_t)row * 1280 + n : Z + (size_t)row * 1280 + (n - 1280);
        store4b(dst, acc[ni][mi]);
      }
  } };
struct G_LruGate { static constexpr int KT = 2, NT = 20;
  static __device__ __forceinline__ const bfr* aptr(const P& p, const Ctx& c, int row, int kt, int nt) { return (const bfr*)(p.ACT + A_UC) + (size_t)row * 1280 + (nt >> 1) * 128 + kt * 64; }
  static __device__ __forceinline__ const bfr* bptr(const P& p, const Ctx& c, int n, int kt) { return p.W + WL_GATE + c.d * 655360 + (size_t)n * 128 + kt * 64; }
  static __device__ __forceinline__ void epi(const P& p, const Ctx& c, f32x4 (&acc)[4][4], int m0, int n0, int lane) {
    const bfr* UC = (const bfr*)(p.ACT + A_UC); unsigned* AB = (unsigned*)(p.ACT + A_AB);
    const float* gb = p.lru_gate_b + (size_t)(c.j * 2 + c.d) * 2 * 1280; const float* lam = p.lru_lam + (size_t)(c.j * 2 + c.d) * 1280;
    int chb = (n0 >> 6) * 32;
#pragma unroll
    for (int ni = 0; ni < 2; ni++) {
      int ch = chb + ni * 16 + (lane >> 4) * 4;
      float cl[4], br[4], bi[4];
#pragma unroll
      for (int q = 0; q < 4; q++) { cl[q] = p.CL[(size_t)(c.j * 2 + c.d) * 1280 + ch + q]; br[q] = gb[ch + q]; bi[q] = gb[1280 + ch + q]; }
#pragma unroll
      for (int mi = 0; mi < 4; mi++) {
        int row = m0 + mi * 16 + (lane & 15);
        uint2 u = *(const uint2*)(UC + (size_t)row * 1280 + ch);
        float uc[4] = {blo(u.x), bhi(u.x), blo(u.y), bhi(u.y)};
        unsigned o[4];
#pragma unroll
        for (int q = 0; q < 4; q++) {
          float r = sigm(acc[ni][mi][q] + br[q]), ig = sigm(acc[ni + 2][mi][q] + bi[q]);
          float la = -cl[q] * r; float oma = 1.f - __expf(la); float bb = __builtin_amdgcn_sqrtf(oma * (2.f - oma)) * ig * uc[q];
          o[q] = (((unsigned)f2b(oma)) << 16) | (unsigned)f2b(bb);
        }
        *(uint4*)(AB + (size_t)row * 1280 + ch) = uint4{o[0], o[1], o[2], o[3]};
      }
    }
  } };
struct G_LruOut { static constexpr int KT = 20, NT = 8;
  static __device__ __forceinline__ const bfr* aptr(const P& p, const Ctx& c, int row, int kt, int nt) { return (const bfr*)(p.ACT + A_Z) + (size_t)row * 1280 + kt * 64; }
  static __device__ __forceinline__ const bfr* bptr(const P& p, const Ctx& c, int n, int kt) { return p.W + WL_OUT + (size_t)n * 1280 + kt * 64; }
  static __device__ __forceinline__ void epi(const P& p, const Ctx& c, f32x4 (&acc)[4][4], int m0, int n0, int lane) { epi_resid(p, c, acc, m0, n0, lane); } };
struct G_MlIn { static constexpr int KT = 16, NT = 33;
  static __device__ __forceinline__ const bfr* aptr(const P& p, const Ctx& c, int row, int kt, int nt) { return p.H + (size_t)row * 1024 + kt * 64; }
  static __device__ __forceinline__ const bfr* bptr(const P& p, const Ctx& c, int n, int kt) { return p.W + (size_t)n * 1024 + kt * 64; }
  static __device__ __forceinline__ void epi(const P& p, const Ctx& c, f32x4 (&acc)[4][4], int m0, int n0, int lane) {
    bfr* QKV = (bfr*)(p.ACT + A_QKV); float* GT = (float*)(p.ACT + A_GATE);
#pragma unroll
    for (int ni = 0; ni < 4; ni++)
#pragma unroll
      for (int mi = 0; mi < 4; mi++) {
        int row = m0 + mi * 16 + (lane & 15), n = n0 + ni * 16 + (lane >> 4) * 4;
        if (n < 4096) store4b(QKV + (size_t)row * 4096 + n, acc[ni][mi]);
        else if (n < 4128) *(float4*)(GT + (size_t)row * 32 + (n - 4096)) = float4{acc[ni][mi][0], acc[ni][mi][1], acc[ni][mi][2], acc[ni][mi][3]};
      }
  } };
struct G_MlZ { static constexpr int KT = 16, NT = 16;
  static __device__ __forceinline__ const bfr* aptr(const P& p, const Ctx& c, int row, int kt, int nt) { return p.H + (size_t)row * 1024 + kt * 64; }
  static __device__ __forceinline__ const bfr* bptr(const P& p, const Ctx& c, int n, int kt) { return p.W + WM_Z + (size_t)n * 1024 + kt * 64; }
  static __device__ __forceinline__ void epi(const P& p, const Ctx& c, f32x4 (&acc)[4][4], int m0, int n0, int lane) {
    bfr* HS = (bfr*)(p.ACT + A_HS); const float* RS = (const float*)(p.ACT + A_RSTD); const float* ng = p.ml_norm_g + (size_t)c.j * 2048;
#pragma unroll
    for (int ni = 0; ni < 4; ni++)
#pragma unroll
      for (int mi = 0; mi < 4; mi++) {
        int row = m0 + mi * 16 + (lane & 15), n = n0 + ni * 16 + (lane >> 4) * 4;
        bfr* hp = HS + (size_t)row * 2048 + n; uint2 u = *(const uint2*)hp; float rs = RS[(size_t)row * 8 + (n >> 8)];
        float4 g4 = *(const float4*)(ng + n);
        f32x4 o;
        o[0] = blo(u.x) * rs * g4.x * siluf(acc[ni][mi][0]); o[1] = bhi(u.x) * rs * g4.y * siluf(acc[ni][mi][1]);
        o[2] = blo(u.y) * rs * g4.z * siluf(acc[ni][mi][2]); o[3] = bhi(u.y) * rs * g4.w * siluf(acc[ni][mi][3]);
        store4b(hp, o);
      }
  } };
struct G_MlOut { static constexpr int KT = 32, NT = 8;
  static __device__ __forceinline__ const bfr* aptr(const P& p, const Ctx& c, int row, int kt, int nt) { return (const bfr*)(p.ACT + A_HS) + (size_t)row * 2048 + kt * 64; }
  static __device__ __forceinline__ const bfr* bptr(const P& p, const Ctx& c, int n, int kt) { return p.W + WM_OUT + (size_t)n * 2048 + kt * 64; }
  static __device__ __forceinline__ void epi(const P& p, const Ctx& c, f32x4 (&acc)[4][4], int m0, int n0, int lane) { epi_resid(p, c, acc, m0, n0, lane); } };
struct G_R7In { static constexpr int KT = 32, NT = 34;
  static __device__ __forceinline__ const bfr* aptr(const P& p, const Ctx& c, int row, int kt, int nt) {
    if (kt < 16) return p.H + (size_t)row * 1024 + kt * 64;
    int q = (kt - 16) >> 2; int b = row / BT_, o = row - b * BT_; int nr;
    if (o < 256) { if (q < 2) { if (o < 1) return nullptr; nr = row - 1; } else { if (o >= 255) return nullptr; nr = row + 1; } }
    else { int t = o - 256, col = t & 63, gr = t >> 6;
      if (q == 0) { if (col == 0) return nullptr; nr = row - 1; }
      else if (q == 1) { if (col == 63) return nullptr; nr = row + 1; }
      else if (q == 2) { if (gr == 0) return nullptr; nr = row - 64; }
      else { if (gr == 255) return nullptr; nr = row + 64; } }
    return p.H + (size_t)nr * 1024 + (kt - 16) * 64; }
  static __device__ __forceinline__ const bfr* bptr(const P& p, const Ctx& c, int n, int kt) { return p.W + (size_t)n * 2048 + kt * 64; }
  static __device__ __forceinline__ void epi(const P& p, const Ctx& c, f32x4 (&acc)[4][4], int m0, int n0, int lane) {
    bfr* RK = (bfr*)(p.ACT + A_RKVZ); bfr* WMb = (bfr*)(p.ACT + A_WM); bfr* AMb = (bfr*)(p.ACT + A_AM);
#pragma unroll
    for (int ni = 0; ni < 4; ni++)
#pragma unroll
      for (int mi = 0; mi < 4; mi++) {
        int row = m0 + mi * 16 + (lane & 15), n = n0 + ni * 16 + (lane >> 4) * 4;
        if (n < 4096) store4b(RK + (size_t)row * 4096 + n, acc[ni][mi]);
        else if (n < 4224) { f32x4 t;
#pragma unroll
          for (int q = 0; q < 4; q++) t[q] = tanhf(acc[ni][mi][q]); store4b(WMb + (size_t)row * 128 + (n - 4096), t); }
        else store4b(AMb + (size_t)row * 128 + (n - 4224), acc[ni][mi]);
      }
  } };
struct G_R7Out { static constexpr int KT = 16, NT = 8;
  static __device__ __forceinline__ const bfr* aptr(const P& p, const Ctx& c, int row, int kt, int nt) { return p.H + (size_t)row * 1024 + kt * 64; }
  static __device__ __forceinline__ const bfr* bptr(const P& p, const Ctx& c, int n, int kt) { return p.W + WR_OUT + (size_t)n * 1024 + kt * 64; }
  static __device__ __forceinline__ void epi(const P& p, const Ctx& c, f32x4 (&acc)[4][4], int m0, int n0, int lane) { epi_resid(p, c, acc, m0, n0, lane); } };


namespace pg8 {
#define PG8_LAS __attribute__((address_space(3)))
constexpr int BM = 256, BK = 64, HALF = 128, HTB = HALF * BK * 2, NXCD = 8, WGM = 8;
__device__ __forceinline__ int lds_byte(int r, int c) { const int st = (r >> 4) * 2 + (c >> 5), rr = r & 15, cc = c & 31, ob = rr * 64 + cc * 2; return st * 1024 + (ob ^ (((ob >> 9) & 1) << 5)); }
__device__ __forceinline__ void stage_rc(int b, int& R, int& C) { const int st = b / 1024, sb = b % 1024, swz = sb ^ (((sb >> 9) & 1) << 5); R = (st >> 1) * 16 + swz / 64; C = (st & 1) * 32 + (swz % 64) / 2; }
struct Unit { int pm, pn; };
struct Gemm { const bfr* A; const bfr* Bt; int M, N, K; };
struct StaticOrder {
  int nM, nN, nwg, G, c;
  __device__ void init(int M, int N, int G_, int c_) { nM = M / BM; nN = N / BM; nwg = nM * nN; G = G_; c = c_; }
  __device__ bool next(int i, Unit& u) const {
    const long L = (long)i * G + c; if (L >= nwg) return false;
    int wgid = (int)L; { const int q = nwg / NXCD, r = nwg % NXCD, xcd = wgid % NXCD, off = wgid / NXCD; wgid = (xcd < r ? xcd * (q + 1) : r * (q + 1) + (xcd - r) * q) + off; }
    const int nig = WGM * nN, gid = wgid / nig, fm = gid * WGM, gsz = (nM - fm) < WGM ? (nM - fm) : WGM;
    u.pm = fm + ((wgid % nig) % gsz); u.pn = (wgid % nig) / gsz; return true;
  }
};
template <class Epi>
__device__ __forceinline__ void gemm_phase(PG8_LAS unsigned char* lds, const Gemm g, const StaticOrder& S, const Epi& E) {
  const int tid = ltid(), wid = __builtin_amdgcn_readfirstlane(tid >> 6), lane = tid & 63, wr = wid >> 2, wc = wid & 3, fr = lane & 15, fq = lane >> 4;
  const int K = g.K, nt = K / BK;
  unsigned voffA[2], voffB[2];
#pragma unroll
  for (int i = 0; i < 2; ++i) { int R, C; stage_rc(tid * 16 + i * 8192, R, C); voffA[i] = (unsigned)(R * K + C) * 2u; voffB[i] = voffA[i]; }
  const size_t kstep = (size_t)(BK * 2);
  const size_t hstep = (size_t)HALF * K * 2;
  const size_t tstep = 2 * hstep;
  const unsigned ldsw = (unsigned)wid * 1024u;
  const int aoff = lds_byte(wr * 64 + fr, fq * 8), boff = lds_byte(wc * 32 + fr, fq * 8);
#define PG8_SA(b, h) (((b) * 2 + (h)) * HTB)
#define PG8_SB(b, h) ((4 + (b) * 2 + (h)) * HTB)
#define PG8_STAGE(bufoff, gbase, voff) do { _Pragma("unroll") for (int _i = 0; _i < 2; ++_i) \
    __builtin_amdgcn_global_load_lds((const unsigned*)((const char*)(gbase) + (voff)[_i]), (PG8_LAS unsigned*)(lds + (bufoff) + ldsw + _i * 8192), 16, 0, 0); } while (0)
#define PG8_LDA(dst, b, h) do { _Pragma("unroll") for (int m = 0; m < 4; ++m) _Pragma("unroll") for (int k = 0; k < 2; ++k) dst[m][k] = *(const PG8_LAS bf16x8*)(lds + PG8_SA(b, h) + aoff + m * 2048 + k * 1024); } while (0)
#define PG8_LDB(dst, b, h) do { _Pragma("unroll") for (int n = 0; n < 2; ++n) _Pragma("unroll") for (int k = 0; k < 2; ++k) dst[n][k] = *(const PG8_LAS bf16x8*)(lds + PG8_SB(b, h) + boff + n * 2048 + k * 1024); } while (0)
#define PG8_MMA(ai, bj, At, Bt) do { __builtin_amdgcn_s_setprio(1); _Pragma("unroll") for (int m = 0; m < 4; ++m) _Pragma("unroll") for (int n = 0; n < 2; ++n) _Pragma("unroll") for (int k = 0; k < 2; ++k) \
    acc[ai][bj][m][n] = __builtin_amdgcn_mfma_f32_16x16x32_bf16(Bt[n][k], At[m][k], acc[ai][bj][m][n], 0, 0, 0); __builtin_amdgcn_s_setprio(0); } while (0)
#define PG8_WAIT_V(n) asm volatile("s_waitcnt vmcnt(" #n ")" ::: "memory")
#define PG8_WAIT_L(n) asm volatile("s_waitcnt lgkmcnt(" #n ")" ::: "memory")
#define PG8_BAR __builtin_amdgcn_s_barrier()
#define PG8_SCHED __builtin_amdgcn_sched_barrier(0)
  Unit cur, nxt; int ui = 0;
  if (!S.next(0, cur)) return;
  f32x4 acc[2][2][4][2];
#pragma unroll
  for (int a = 0; a < 2; ++a)
#pragma unroll
    for (int b = 0; b < 2; ++b)
#pragma unroll
      for (int m = 0; m < 4; ++m)
#pragma unroll
        for (int n = 0; n < 2; ++n) acc[a][b][m][n] = (f32x4){0.f, 0.f, 0.f, 0.f};
  bf16x8 At[4][2], B0[2][2], B1[2][2];
  const char* cA = (const char*)g.A + (size_t)cur.pm * tstep; const char* cB = (const char*)g.Bt + (size_t)cur.pn * tstep;
  PG8_STAGE(PG8_SB(0, 0), cB, voffB); PG8_STAGE(PG8_SA(0, 0), cA, voffA); PG8_STAGE(PG8_SB(0, 1), cB + hstep, voffB); PG8_STAGE(PG8_SA(0, 1), cA + hstep, voffA);
  if (wr == 1) PG8_BAR;
  PG8_WAIT_V(4); PG8_BAR;
  PG8_STAGE(PG8_SB(1, 0), cB + kstep, voffB); PG8_STAGE(PG8_SA(1, 0), cA + kstep, voffA); PG8_STAGE(PG8_SB(1, 1), cB + hstep + kstep, voffB);
  PG8_WAIT_V(6); PG8_BAR;
  for (;;) {
    const bool has_next = S.next(ui + 1, nxt);
    const char* nA = has_next ? (const char*)g.A + (size_t)nxt.pm * tstep : cA; const char* nB = has_next ? (const char*)g.Bt + (size_t)nxt.pn * tstep : cB;
    for (int t = 0; t < nt; t += 2) {
      const bool last = (t == nt - 2);
      const char* a1 = cA + (size_t)(t + 1) * kstep;
      const char* a2 = last ? nA : cA + (size_t)(t + 2) * kstep; const char* b2 = last ? nB : cB + (size_t)(t + 2) * kstep;
      const char* a3 = a2 + kstep; const char* b3 = b2 + kstep;
      PG8_LDB(B0, 0, 0); PG8_SCHED; PG8_LDA(At, 0, 0); PG8_STAGE(PG8_SA(1, 1), a1 + hstep, voffA);
      PG8_WAIT_L(8); PG8_BAR; PG8_WAIT_L(0); PG8_MMA(0, 0, At, B0); PG8_BAR; PG8_SCHED;
      PG8_LDB(B1, 0, 1); PG8_STAGE(PG8_SB(0, 0), b2, voffB);
      PG8_BAR; PG8_WAIT_L(0); PG8_MMA(0, 1, At, B1); PG8_BAR;
      PG8_LDA(At, 0, 1); PG8_STAGE(PG8_SA(0, 0), a2, voffA);
      PG8_BAR; PG8_WAIT_L(0); PG8_MMA(1, 0, At, B0); PG8_BAR; PG8_SCHED;
      PG8_STAGE(PG8_SB(0, 1), b2 + hstep, voffB);
      PG8_WAIT_V(6); PG8_BAR; PG8_MMA(1, 1, At, B1); PG8_BAR;
      PG8_LDB(B0, 1, 0); PG8_SCHED; PG8_LDA(At, 1, 0); PG8_STAGE(PG8_SA(0, 1), a2 + hstep, voffA);
      PG8_WAIT_L(8); PG8_BAR; PG8_WAIT_L(0); PG8_MMA(0, 0, At, B0); PG8_BAR; PG8_SCHED;
      PG8_LDB(B1, 1, 1); PG8_STAGE(PG8_SB(1, 0), b3, voffB);
      PG8_BAR; PG8_WAIT_L(0); PG8_MMA(0, 1, At, B1); PG8_BAR;
      PG8_LDA(At, 1, 1); PG8_STAGE(PG8_SA(1, 0), a3, voffA);
      PG8_BAR; PG8_WAIT_L(0); PG8_MMA(1, 0, At, B0); PG8_BAR; PG8_SCHED;
      PG8_STAGE(PG8_SB(1, 1), b3 + hstep, voffB);
      PG8_WAIT_V(6); PG8_BAR; PG8_MMA(1, 1, At, B1); PG8_BAR;
    }
    E(acc, cur, wr, wc, fr, fq);
    if (!has_next) break;
#pragma unroll
    for (int a = 0; a < 2; ++a)
#pragma unroll
      for (int b = 0; b < 2; ++b)
#pragma unroll
        for (int m = 0; m < 4; ++m)
#pragma unroll
          for (int n = 0; n < 2; ++n) acc[a][b][m][n] = (f32x4){0.f, 0.f, 0.f, 0.f};
    cur = nxt; cA = nA; cB = nB; ++ui;
  }
  PG8_WAIT_V(0);
  if (wr == 0) PG8_BAR;
  PG8_BAR;
#undef PG8_SA
#undef PG8_SB
#undef PG8_STAGE
#undef PG8_LDA
#undef PG8_LDB
#undef PG8_MMA
#undef PG8_WAIT_V
#undef PG8_WAIT_L
#undef PG8_BAR
#undef PG8_SCHED
}
}

template <class F> struct EpiAd {
  F f;
  __device__ __forceinline__ void operator()(const f32x4 (&acc)[2][2][4][2], const pg8::Unit& u, int wr, int wc, int fr, int fq) const {
#pragma unroll
    for (int ai = 0; ai < 2; ++ai)
#pragma unroll
      for (int m = 0; m < 4; ++m) { const int row = u.pm * 256 + ai * 128 + wr * 64 + m * 16 + fr;
#pragma unroll
        for (int bj = 0; bj < 2; ++bj)
#pragma unroll
          for (int n = 0; n < 2; ++n) f(row, u.pn * 256 + bj * 128 + wc * 32 + n * 16 + 4 * fq, acc[ai][bj][m][n]); }
  }
};
template <class F> __device__ __forceinline__ void big_gemm(char* smem, const bfr* A, const bfr* Bt, int N, int K, F f) {
  pg8::Gemm g; g.A = A; g.Bt = Bt; g.M = R_; g.N = N; g.K = K;
  pg8::StaticOrder S; S.init(R_, N, (int)gridDim.x, (int)blockIdx.x);
  EpiAd<F> E{f};
  pg8::gemm_phase(( __attribute__((address_space(3))) unsigned char*)smem, g, S, E);
}
struct F_LruIn { char* ACT; __device__ __forceinline__ void operator()(int row, int n, f32x4 v) const {
  bfr* dst = n < 1280 ? (bfr*)(ACT + A_U) + (size_t)row * 1280 + n : (bfr*)(ACT + A_Z) + (size_t)row * 1280 + (n - 1280); store4b(dst, v); } };
struct F_Resid { float* Xx; float* Xc; const float* MODg; int wc; __device__ __forceinline__ void operator()(int row, int n, f32x4 v) const {
  int b = row / BT_, o = row - b * BT_; bool isc = o < 256; if (isc && !wc) return;
  float* xr = isc ? Xc + (size_t)(b * 256 + o) * 1024 : Xx + (size_t)(b * 16384 + o - 256) * 1024; const float* g = MODg + (size_t)(isc ? 2 : b) * 3072 + 2048;
  float4 xv = *(float4*)(xr + n); float4 gg = *(const float4*)(g + n);
  xv.x += gg.x * v[0]; xv.y += gg.y * v[1]; xv.z += gg.z * v[2]; xv.w += gg.w * v[3]; *(float4*)(xr + n) = xv; } };
struct F_MlIn { char* ACT; __device__ __forceinline__ void operator()(int row, int n, f32x4 v) const {
  if (n < 4096) store4b((bfr*)(ACT + A_QKV) + (size_t)row * 4096 + n, v);
  else if (n < 4128) *(float4*)((float*)(ACT + A_GATE) + (size_t)row * 32 + (n - 4096)) = float4{v[0], v[1], v[2], v[3]}; } };
struct F_MlZ { char* ACT; const float* ng; __device__ __forceinline__ void operator()(int row, int n, f32x4 v) const {
  bfr* hp = (bfr*)(ACT + A_HS) + (size_t)row * 2048 + n; uint2 u = *(const uint2*)hp; float rs = ((const float*)(ACT + A_RSTD))[(size_t)row * 8 + (n >> 8)];
  float4 g4 = *(const float4*)(ng + n); f32x4 o;
  o[0] = blo(u.x) * rs * g4.x * siluf(v[0]); o[1] = bhi(u.x) * rs * g4.y * siluf(v[1]); o[2] = blo(u.y) * rs * g4.z * siluf(v[2]); o[3] = bhi(u.y) * rs * g4.w * siluf(v[3]);
  store4b(hp, o); } };
struct F_R7In { char* ACT; __device__ __forceinline__ void operator()(int row, int n, f32x4 v) const {
  if (n < 4096) store4b((bfr*)(ACT + A_RKVZ) + (size_t)row * 4096 + n, v);
  else if (n < 4224) { f32x4 t;
#pragma unroll
    for (int q = 0; q < 4; q++) t[q] = tanhf(v[q]);
    store4b((bfr*)(ACT + A_WM) + (size_t)row * 128 + (n - 4096), t); }
  else store4b((bfr*)(ACT + A_AM) + (size_t)row * 128 + (n - 4224), v); } };

template <class G> __device__ __forceinline__ void gemm_phase(const P& p, const Ctx& c, char* smem) {
  const int total = 130 * G::NT;
  for (int it = blockIdx.x; it < total; it += gridDim.x) gemm_tile<G>(p, c, it / G::NT, it % G::NT, smem);
}

#define R7_Y2 ((bfr*)p.H + (size_t)64 * 26 * 16384)
template <class G> __device__ __forceinline__ void gemm_phase_k2(const P& p, const Ctx& c, char* smem) {
  const int tid = ltid(), lane = tid & 63, wid = tid >> 6, wm = wid & 3, wn = wid >> 2;
  bfr* sA = (bfr*)smem; bfr* sB = sA + 2 * 256 * LDSS;
  const int lr = tid >> 3, lc = tid & 7;
  const int total = 130 * G::NT;
  uint4 a00, a01, a02, a03, a10, a11, a12, a13, b00, b01, b10, b11;
#define GK2_LA(i_, R0, R1) { R0 = *(const uint4*)(G::aptr(p, c, mt_ * 256 + lr + 64 * (i_), 0, nt_) + lc * 8); R1 = *(const uint4*)(G::aptr(p, c, mt_ * 256 + lr + 64 * (i_), 1, nt_) + lc * 8); }
#define GK2_LB(i_, R0, R1) { R0 = *(const uint4*)(G::bptr(p, c, nt_ * 128 + lr + 64 * (i_), 0) + lc * 8); R1 = *(const uint4*)(G::bptr(p, c, nt_ * 128 + lr + 64 * (i_), 1) + lc * 8); }
#define GK2_LOAD(it_) { const int mt_ = (it_) / G::NT, nt_ = (it_) % G::NT; GK2_LA(0, a00, a10) GK2_LA(1, a01, a11) GK2_LA(2, a02, a12) GK2_LA(3, a03, a13) GK2_LB(0, b00, b10) GK2_LB(1, b01, b11) }
#define GK2_SA(i_, R0, R1) { *(uint4*)(sA + (lr + 64 * (i_)) * LDSS + lc * 8) = R0; *(uint4*)(sA + (256 + lr + 64 * (i_)) * LDSS + lc * 8) = R1; }
#define GK2_SB(i_, R0, R1) { *(uint4*)(sB + (lr + 64 * (i_)) * LDSS + lc * 8) = R0; *(uint4*)(sB + (128 + lr + 64 * (i_)) * LDSS + lc * 8) = R1; }
  int it = blockIdx.x;
  if (it < total) GK2_LOAD(it)
  while (it < total) {
    const int mt = it / G::NT, nt = it % G::NT;
    GK2_SA(0, a00, a10) GK2_SA(1, a01, a11) GK2_SA(2, a02, a12) GK2_SA(3, a03, a13) GK2_SB(0, b00, b10) GK2_SB(1, b01, b11)
    __syncthreads();
    const int itn = it + gridDim.x;
    if (itn < total) GK2_LOAD(itn)
    f32x4 acc[4][4];
#pragma unroll
    for (int a = 0; a < 4; a++)
#pragma unroll
      for (int b = 0; b < 4; b++) acc[a][b] = f32x4{0.f, 0.f, 0.f, 0.f};
#pragma unroll
    for (int buf = 0; buf < 2; buf++)
#pragma unroll
      for (int ks = 0; ks < 2; ks++) {
        bf16x8 af[4], bf[4];
#pragma unroll
        for (int i = 0; i < 4; i++) {
          af[i] = *(const bf16x8*)(sA + (buf * 256 + wm * 64 + i * 16 + (lane & 15)) * LDSS + ks * 32 + (lane >> 4) * 8);
          bf[i] = *(const bf16x8*)(sB + (buf * 128 + wn * 64 + i * 16 + (lane & 15)) * LDSS + ks * 32 + (lane >> 4) * 8);
        }
#pragma unroll
        for (int n = 0; n < 4; n++)
#pragma unroll
          for (int m = 0; m < 4; m++) acc[n][m] = __builtin_amdgcn_mfma_f32_16x16x32_bf16(bf[n], af[m], acc[n][m], 0, 0, 0);
      }
    G::epi(p, c, acc, mt * 256 + wm * 64, nt * 128 + wn * 64, lane);
    __syncthreads();
    it = itn;
  }
#undef GK2_LOAD
#undef GK2_LA
#undef GK2_LB
#undef GK2_SA
#undef GK2_SB
}

__device__ __forceinline__ void ph_pre(const P& p, char* smem) {
  float* sm = (float*)smem; const int tid = ltid();
  const int nprep = prep_count(0), ngemv = 192, ncopy = 4160;
  if (blockIdx.x == 0) for (int i = tid; i < 5120; i += 512) p.CL[i] = 8.f * softplusf(-p.lru_lam[i]);
  for (int it = blockIdx.x; it < nprep + ngemv + ncopy; it += gridDim.x) {
    if (it < nprep) { prep_item(p, 0, it, sm); continue; }
    int i2 = it - nprep;
    if (i2 < ngemv) {
      int l = i2 / 48, cgp = i2 % 48;
      for (int i = tid; i < 3072; i += 512) { int cnd = i >> 10, k = i & 1023; float v = cnd == 0 ? p.c[k] : cnd == 1 ? p.c[1024 + k] : p.c_ctx[k]; sm[i] = siluf(v); }
      __syncthreads();
      int kq = tid >> 6, col = cgp * 64 + (tid & 63); const float* w = p.mod_w + (size_t)l * 1024 * 3072 + col;
      float a0 = 0.f, a1 = 0.f, a2 = 0.f;
      for (int k = kq * 128; k < kq * 128 + 128; k++) { float wv = w[(size_t)k * 3072]; a0 += sm[k] * wv; a1 += sm[1024 + k] * wv; a2 += sm[2048 + k] * wv; }
      float* red = sm + 3072; red[tid * 3] = a0; red[tid * 3 + 1] = a1; red[tid * 3 + 2] = a2;
      __syncthreads();
      if (tid < 64) { float bias = p.mod_b[(size_t)l * 3072 + col];
        for (int cnd = 0; cnd < 3; cnd++) { float s = bias; for (int q = 0; q < 8; q++) s += red[(q * 64 + tid) * 3 + cnd]; p.MOD[(size_t)(l * 3 + cnd) * 3072 + col] = s; } }
      __syncthreads();
      continue;
    }
    i2 -= ngemv;
    for (int q = 0; q < 4; q++) { int idx = i2 * 2048 + q * 512 + tid; int row = idx >> 8, c4 = idx & 255; int b = row / BT_, o = row - b * BT_;
      if (o < 256) ((float4*)p.Xc)[(size_t)(b * 256 + o) * 256 + c4] = ((const float4*)p.ctx)[(size_t)(b * 256 + o) * 256 + c4];
      else ((float4*)p.Xx)[(size_t)(b * 16384 + o - 256) * 256 + c4] = ((const float4*)p.x)[(size_t)(b * 16384 + o - 256) * 256 + c4]; }
  }
}
__device__ __forceinline__ void ph_norm(const P& p, int layer, char* smem) {
  const int tid = ltid(), lane = tid & 63, wid = tid >> 6;
  const int nprep = layer > 0 ? prep_count(layer) : 0; const int kind = layer % 3;
  const int nzero = kind == 1 ? 8320 : 0;
  (void)nzero;
  for (int it = blockIdx.x; it < nprep + 4160; it += gridDim.x) {
    if (it < nprep) { prep_item(p, layer, it, (float*)smem); continue; }
    int row = (it - nprep) * 8 + wid; int mo; const float* xr = xrowp(p, row, mo);
    float4 v[4]; float ss = 0.f;
#pragma unroll
    for (int i = 0; i < 4; i++) { v[i] = *(const float4*)(xr + lane * 4 + 256 * i); ss += v[i].x * v[i].x + v[i].y * v[i].y + v[i].z * v[i].z + v[i].w * v[i].w; }
    ss = wsum(ss); float rs = rsqrtf(ss * (1.f / 1024.f) + 1e-6f);
    const float* g = p.norm_g + (size_t)layer * 1024; const float* md = p.MOD + (size_t)(layer * 3 + mo) * 3072;
#pragma unroll
    for (int i = 0; i < 4; i++) { int cidx = lane * 4 + 256 * i; float4 gg = *(const float4*)(g + cidx), sh = *(const float4*)(md + cidx), sc = *(const float4*)(md + 1024 + cidx);
      f32x4 o; o[0] = v[i].x * rs * gg.x * (1.f + sc.x) + sh.x; o[1] = v[i].y * rs * gg.y * (1.f + sc.y) + sh.y; o[2] = v[i].z * rs * gg.z * (1.f + sc.z) + sh.z; o[3] = v[i].w * rs * gg.w * (1.f + sc.w) + sh.w;
      store4b(p.H + (size_t)row * (kind == 2 ? 2048 : 1024) + cidx, o); }
  }
}
__device__ __forceinline__ void ph_r7_shift(const P& p) {
  for (int it = blockIdx.x; it < 8320; it += gridDim.x) {
    int idx = it * 512 + ltid(); int row = idx >> 7, c8 = idx & 127, q = c8 >> 5;
    int b = row / BT_, o = row - b * BT_; int nr = -1;
    if (o < 256) { if (q < 2) { if (o >= 1) nr = row - 1; } else { if (o < 255) nr = row + 1; } }
    else { int t = o - 256, col = t & 63, gr = t >> 6;
      if (q == 0) { if (col != 0) nr = row - 1; } else if (q == 1) { if (col != 63) nr = row + 1; }
      else if (q == 2) { if (gr != 0) nr = row - 64; } else { if (gr != 255) nr = row + 64; } }
    uint4 v = nr >= 0 ? *(const uint4*)(p.H + (size_t)nr * 2048 + c8 * 8) : uint4{0u, 0u, 0u, 0u};
    *(uint4*)(p.H + (size_t)row * 2048 + 1024 + c8 * 8) = v;
  }
}
__device__ __forceinline__ void ph_final(const P& p) {
  const int lane = ltid() & 63, wid = ltid() >> 6;
  for (int it = blockIdx.x; it < 4096; it += gridDim.x) {
    float* xr = p.Xx + (size_t)(it * 8 + wid) * 1024; float4 v[4]; float ss = 0.f;
#pragma unroll
    for (int i = 0; i < 4; i++) { v[i] = *(const float4*)(xr + lane * 4 + 256 * i); ss += v[i].x * v[i].x + v[i].y * v[i].y + v[i].z * v[i].z + v[i].w * v[i].w; }
    ss = wsum(ss); float rs = rsqrtf(ss * (1.f / 1024.f) + 1e-6f);
#pragma unroll
    for (int i = 0; i < 4; i++) { int cidx = lane * 4 + 256 * i; float4 gg = *(const float4*)(p.final_g + cidx);
      *(float4*)(xr + cidx) = float4{v[i].x * rs * gg.x, v[i].y * rs * gg.y, v[i].z * rs * gg.z, v[i].w * rs * gg.w}; }
  }
}
__device__ __forceinline__ void ph_lru_conv(const P& p, int j) {
  const bfr* U = (const bfr*)(p.ACT + A_U); bfr* UC = (bfr*)(p.ACT + A_UC);
  const float* cw = p.lru_conv_w + (size_t)j * 4 * 1280; const float* cb = p.lru_conv_b + (size_t)j * 1280;
  for (int it = blockIdx.x; it < 10400; it += gridDim.x) {
    int idx = it * 512 + ltid(); int row = idx / 160, cgp = idx % 160, ch = cgp * 8;
    int b = row / BT_, o = row - b * BT_; int s0 = o < 256 ? 0 : 256, e0 = o < 256 ? 256 : BT_;
    float acc[8];
#pragma unroll
    for (int e = 0; e < 8; e++) acc[e] = cb[ch + e];
#pragma unroll
    for (int t = 0; t < 4; t++) { int oo = o + t - 2; if (oo < s0 || oo >= e0) continue;
      uint4 u = *(const uint4*)(U + (size_t)(row + t - 2) * 1280 + ch); const float* w = cw + t * 1280 + ch;
      acc[0] += w[0] * blo(u.x); acc[1] += w[1] * bhi(u.x); acc[2] += w[2] * blo(u.y); acc[3] += w[3] * bhi(u.y);
      acc[4] += w[4] * blo(u.z); acc[5] += w[5] * bhi(u.z); acc[6] += w[6] * blo(u.w); acc[7] += w[7] * bhi(u.w); }
    *(uint4*)(UC + (size_t)row * 1280 + ch) = uint4{pk2(acc[0], acc[1]), pk2(acc[2], acc[3]), pk2(acc[4], acc[5]), pk2(acc[6], acc[7])};
  }
}
__device__ __forceinline__ void ph_lru_s1(const P& p, int d) {
  const unsigned* AB = (const unsigned*)(p.ACT + A_AB); float2* AGG = (float2*)(p.ACT + A_AGG);
  const int t = ltid();
  for (int it = blockIdx.x * 8 + (t >> 6); it < 2600; it += gridDim.x * 8) {
    int b = it / 1300, r = it % 1300, cc = r / 5, ch = (r % 5) * 256 + (t & 63) * 4;
    float P0 = 1.f, Q0 = 0.f, P1 = 1.f, Q1 = 0.f, P2 = 1.f, Q2 = 0.f, P3 = 1.f, Q3 = 0.f;
#pragma unroll 8
    for (int q = 0; q < 64; q++) { uint4 u = *(const uint4*)(AB + (size_t)rowmap(d, b, cc * 64 + q) * 1280 + ch);
      float a0 = 1.f - bhi(u.x), a1 = 1.f - bhi(u.y), a2 = 1.f - bhi(u.z), a3 = 1.f - bhi(u.w);
      P0 *= a0; Q0 = a0 * Q0 + blo(u.x); P1 *= a1; Q1 = a1 * Q1 + blo(u.y); P2 *= a2; Q2 = a2 * Q2 + blo(u.z); P3 *= a3; Q3 = a3 * Q3 + blo(u.w); }
    float4* ag = (float4*)(AGG + (size_t)(b * NCH_ + cc) * 1280 + ch); ag[0] = float4{P0, Q0, P1, Q1}; ag[1] = float4{P2, Q2, P3, Q3};
  }
}
__device__ __forceinline__ void ph_lru_s2(const P& p, char* smem) {
  const float2* AGG = (const float2*)(p.ACT + A_AGG); float* CAR = (float*)(p.ACT + A_CAR);
  float* sP = (float*)smem; float* sQ = sP + 512;
  const int tid = ltid(), chl = tid & 63, seg = tid >> 6;
  for (int it = blockIdx.x; it < 40; it += gridDim.x) {
    const int b = it / 20, ch = (it % 20) * 64 + chl; const int cb = seg * 33, ce = cb + 33 < NCH_ ? cb + 33 : NCH_;
    float Pp = 1.f, Q = 0.f;
#pragma unroll 11
    for (int cc = cb; cc < ce; cc++) { float2 a = AGG[(size_t)(b * NCH_ + cc) * 1280 + ch]; Pp *= a.x; Q = a.x * Q + a.y; }
    __syncthreads();
    sP[seg * 64 + chl] = Pp; sQ[seg * 64 + chl] = Q;
    __syncthreads();
    float h = 0.f;
    for (int s2 = 0; s2 < seg; s2++) h = sP[s2 * 64 + chl] * h + sQ[s2 * 64 + chl];
#pragma unroll 11
    for (int cc = cb; cc < ce; cc++) { size_t o = (size_t)(b * NCH_ + cc) * 1280 + ch; float2 a = AGG[o]; CAR[o] = h; h = a.x * h + a.y; }
  }
}
__device__ __forceinline__ void ph_lru_s3(const P& p, int d) {
  const unsigned* AB = (const unsigned*)(p.ACT + A_AB); const float* CAR = (const float*)(p.ACT + A_CAR);
  bfr* HF = (bfr*)(p.ACT + A_HF); bfr* Z = (bfr*)(p.ACT + A_Z);
  const int t = ltid();
  for (int it = blockIdx.x * 8 + (t >> 6); it < 2600; it += gridDim.x * 8) {
    int b = it / 1300, r = it % 1300, cc = r / 5, ch = (r % 5) * 256 + (t & 63) * 4;
    float4 h = *(const float4*)(CAR + (size_t)(b * NCH_ + cc) * 1280 + ch);
#pragma unroll 8
    for (int q = 0; q < 64; q++) { size_t o = (size_t)rowmap(d, b, cc * 64 + q) * 1280 + ch; uint4 u = *(const uint4*)(AB + o);
      h.x = (1.f - bhi(u.x)) * h.x + blo(u.x); h.y = (1.f - bhi(u.y)) * h.y + blo(u.y); h.z = (1.f - bhi(u.z)) * h.z + blo(u.z); h.w = (1.f - bhi(u.w)) * h.w + blo(u.w);
      if (d == 0) *(uint2*)(HF + o) = uint2{pk2(h.x, h.y), pk2(h.z, h.w)};
      else { uint2 hf = *(const uint2*)(HF + o), zz = *(const uint2*)(Z + o);
        *(uint2*)(Z + o) = uint2{pk2((blo(hf.x) + h.x) * siluf(blo(zz.x)), (bhi(hf.x) + h.y) * siluf(bhi(zz.x))), pk2((blo(hf.y) + h.z) * siluf(blo(zz.y)), (bhi(hf.y) + h.w) * siluf(bhi(zz.y)))}; } }
  }
}
__device__ __forceinline__ void ph_ml_stat(const P& p) {
  const bfr* HS = (const bfr*)(p.ACT + A_HS); float* RS = (float*)(p.ACT + A_RSTD);
  const int lane = ltid() & 63, wid = ltid() >> 6;
  for (int it = blockIdx.x; it < 4160; it += gridDim.x) {
    int row = it * 8 + wid; const bfr* hp = HS + (size_t)row * 2048 + lane * 32; float ss = 0.f;
#pragma unroll
    for (int i = 0; i < 4; i++) { uint4 u = *(const uint4*)(hp + i * 8); float a;
      a = blo(u.x); ss += a * a; a = bhi(u.x); ss += a * a; a = blo(u.y); ss += a * a; a = bhi(u.y); ss += a * a;
      a = blo(u.z); ss += a * a; a = bhi(u.z); ss += a * a; a = blo(u.w); ss += a * a; a = bhi(u.w); ss += a * a; }
    ss += __shfl_xor(ss, 1); ss += __shfl_xor(ss, 2); ss += __shfl_xor(ss, 4);
    if ((lane & 7) == 0) RS[(size_t)row * 8 + (lane >> 3)] = rsqrtf(ss * (1.f / 256.f) + 1e-6f);
  }
}
__device__ __forceinline__ void ph_r7_fin(const P& p, int j) {
  bfr* Y = (bfr*)(p.ACT + A_Y); const bfr* RK = (const bfr*)(p.ACT + A_RKVZ); const float* BON = (const float*)(p.ACT + A_BON);
  const float* lg = p.r7_ln_g + (size_t)j * 1024; const float* lb = p.r7_ln_b + (size_t)j * 1024;
  const int lane = ltid() & 63, wid = ltid() >> 6;
  for (int it = blockIdx.x; it < 4160; it += gridDim.x) {
    int row = it * 8 + wid, ch = lane * 16, hd = lane >> 2;
    float y[16], v[16], z[16];
#pragma unroll
    for (int i = 0; i < 2; i++) {
      uint4 u = *(const uint4*)(Y + (size_t)row * 1024 + ch + i * 8); const uint4 u2 = *(const uint4*)(R7_Y2 + (size_t)row * 1024 + ch + i * 8);
      y[i * 8 + 0] = blo(u.x) + blo(u2.x); y[i * 8 + 1] = bhi(u.x) + bhi(u2.x); y[i * 8 + 2] = blo(u.y) + blo(u2.y); y[i * 8 + 3] = bhi(u.y) + bhi(u2.y); y[i * 8 + 4] = blo(u.z) + blo(u2.z); y[i * 8 + 5] = bhi(u.z) + bhi(u2.z); y[i * 8 + 6] = blo(u.w) + blo(u2.w); y[i * 8 + 7] = bhi(u.w) + bhi(u2.w);
      u = *(const uint4*)(RK + (size_t)row * 4096 + 2048 + ch + i * 8);
      v[i * 8 + 0] = blo(u.x); v[i * 8 + 1] = bhi(u.x); v[i * 8 + 2] = blo(u.y); v[i * 8 + 3] = bhi(u.y); v[i * 8 + 4] = blo(u.z); v[i * 8 + 5] = bhi(u.z); v[i * 8 + 6] = blo(u.w); v[i * 8 + 7] = bhi(u.w);
      u = *(const uint4*)(RK + (size_t)row * 4096 + 3072 + ch + i * 8);
      z[i * 8 + 0] = blo(u.x); z[i * 8 + 1] = bhi(u.x); z[i * 8 + 2] = blo(u.y); z[i * 8 + 3] = bhi(u.y); z[i * 8 + 4] = blo(u.z); z[i * 8 + 5] = bhi(u.z); z[i * 8 + 6] = blo(u.w); z[i * 8 + 7] = bhi(u.w);
    }
    float s = 0.f;
#pragma unroll
    for (int e = 0; e < 16; e++) s += y[e];
    s += __shfl_xor(s, 1); s += __shfl_xor(s, 2); float mean = s * (1.f / 64.f);
    float q = 0.f;
#pragma unroll
    for (int e = 0; e < 16; e++) { float dlt = y[e] - mean; q += dlt * dlt; }
    q += __shfl_xor(q, 1); q += __shfl_xor(q, 2); float rs = rsqrtf(q * (1.f / 64.f) + 64e-5f);
    float bon = BON[(size_t)row * 16 + hd] + BON[(size_t)(R_ + row) * 16 + hd];
    float o[16];
#pragma unroll
    for (int e = 0; e < 16; e++) { float yn = (y[e] - mean) * rs * lg[ch + e] + lb[ch + e]; o[e] = (yn + bon * v[e]) * siluf(z[e]); }
#pragma unroll
    for (int i = 0; i < 2; i++)
      *(uint4*)(Y + (size_t)row * 1024 + ch + i * 8) = uint4{pk2(o[i * 8], o[i * 8 + 1]), pk2(o[i * 8 + 2], o[i * 8 + 3]), pk2(o[i * 8 + 4], o[i * 8 + 5]), pk2(o[i * 8 + 6], o[i * 8 + 7])};
  }
}

#define QS 136
#define VS 72
#define MLG_BYTES 47104
__device__ __forceinline__ void ph_ml_scan(const P& p, int j, char* smem0) {
  const int d = ltid() >> 8;
  char* smem = smem0 + d * MLG_BYTES;
  bfr* sQ = (bfr*)smem; bfr* sK = sQ + 64 * QS; bfr* sVT = sK + 64 * QS; bfr* sCT = sVT + 16 * VS;
  float* sN = (float*)(sCT + 16 * QS);
  float* sEs = sN + 128; float* sCt = sEs + 64; float* sBc = sCt + 64; float* sWg = sBc + 64; float* sNr = sWg + 64; bfr* sNb = (bfr*)(sNr + 256); float* sMisc = (float*)(sNb + 128); bfr* sVW = (bfr*)(sMisc + 4);
  const bfr* QKV = (const bfr*)(p.ACT + A_QKV); const float* GT = (const float*)(p.ACT + A_GATE); bfr* HS = (bfr*)(p.ACT + A_HS);
  const float* gbias = p.ml_gate_b + (size_t)j * 32;
  const int tid = ltid() & 255, lane = tid & 63, w = tid >> 6, l15 = lane & 15, q4 = lane >> 4;
  for (int it = blockIdx.x; it < 256; it += gridDim.x) {
    const int b = it >> 7, hh = (it >> 4) & 7, sl = it & 15;
    f32x4 Cacc[2];
    Cacc[0] = f32x4{0.f, 0.f, 0.f, 0.f}; Cacc[1] = f32x4{0.f, 0.f, 0.f, 0.f};
    float mcur = 0.f;
    for (int i = tid; i < 16 * QS; i += 256) sCT[i] = 0;
    if (tid < 128) { sN[tid] = 0.f; sNb[tid] = 0; }
    uint4 pq0, pq1, pq2, pq3, pk0, pk1, pk2, pk3, pv = uint4{0u, 0u, 0u, 0u}; float pgi = 0.f, pgf = 0.f;
#define ML_ROW0(s_) (d == 0 ? b * BT_ + 64 * (s_) : rowmap(1, b, 64 * (s_) + 63))
#define ML_LD(i_, PQ, PK) { int idx = tid + 256 * (i_), rho = idx >> 4, c8 = idx & 15; const bfr* src = QKV + (size_t)(r0n + rho) * 4096 + hh * 128 + c8 * 8; PQ = *(const uint4*)src; PK = *(const uint4*)(src + 1024); }
#define ML_ISSUE(s_) { const int r0n = ML_ROW0(s_); ML_LD(0, pq0, pk0) ML_LD(1, pq1, pk1) ML_LD(2, pq2, pk2) ML_LD(3, pq3, pk3) \
      if (tid < 128) pv = *(const uint4*)(QKV + (size_t)(r0n + (tid >> 1)) * 4096 + 2048 + hh * 256 + sl * 16 + (tid & 1) * 8); \
      if (w == 0) { const float* gp_ = GT + (size_t)(r0n + (d ? 63 - lane : lane)) * 32 + d * 16 + hh; pgi = gp_[0]; pgf = gp_[8]; } }
#define ML_ST(i_, PQ, PK) { int idx = tid + 256 * (i_), rho = idx >> 4, c8 = idx & 15; *(uint4*)(sQ + rho * QS + c8 * 8) = PQ; *(uint4*)(sK + rho * QS + c8 * 8) = PK; }
#define ML_COMMIT() { ML_ST(0, pq0, pk0) ML_ST(1, pq1, pk1) ML_ST(2, pq2, pk2) ML_ST(3, pq3, pk3) \
      if (tid < 128) { int rho = tid >> 1, vb = (tid & 1) * 8; \
        sVT[(vb + 0) * VS + rho] = (bfr)(pv.x & 0xffff); sVT[(vb + 1) * VS + rho] = (bfr)(pv.x >> 16); \
        sVT[(vb + 2) * VS + rho] = (bfr)(pv.y & 0xffff); sVT[(vb + 3) * VS + rho] = (bfr)(pv.y >> 16); \
        sVT[(vb + 4) * VS + rho] = (bfr)(pv.z & 0xffff); sVT[(vb + 5) * VS + rho] = (bfr)(pv.z >> 16); \
        sVT[(vb + 6) * VS + rho] = (bfr)(pv.w & 0xffff); sVT[(vb + 7) * VS + rho] = (bfr)(pv.w >> 16); } }
    ML_ISSUE(0)
    __syncthreads();
    for (int s = 0; s < NCH_; s++) {
      const int r0 = ML_ROW0(s);
      ML_COMMIT()
      if (w == 0) {
        int rho = d ? 63 - lane : lane;
        float gi = pgi + gbias[(d * 2 + 0) * 8 + hh], gf = pgf + gbias[(d * 2 + 1) * 8 + hh];
        float fc = fminf(gf, 0.f) - __logf(1.f + __expf(-fabsf(gf)));
        float bc = fc;
        for (int o = 1; o < 64; o <<= 1) { float t = __shfl_up(bc, o); if (lane >= o) bc += t; }
        float e = gi - bc, pm = e;
        for (int o = 1; o < 64; o <<= 1) { float t = __shfl_up(pm, o); if (lane >= o) pm = fmaxf(pm, t); }
        float pml = __shfl(pm, 63), bcl = __shfl(bc, 63);
        const float mx_ = fmaxf(mcur, pml);
        sEs[rho] = __expf(fminf(e, 80.f)); sCt[rho] = -fmaxf(mcur, pm); sBc[rho] = bc; sWg[rho] = __expf(e - mx_);
        if (lane == 0) { sMisc[0] = mcur; sMisc[1] = __expf(mcur - mx_); }
        mcur = bcl + mx_;
      }
      __syncthreads();
      const float mold = sMisc[0], decay = sMisc[1];

      const int rt = 16 * w + l15;
      bfr* hp = HS + (size_t)(r0 + rt) * 2048 + hh * 256 + sl * 16 + 4 * q4;
      bool first; { int rc = (r0 - b * BT_) >> 6; if (d == 0) { int sp = rc < 4 ? 3 - rc : 263 - rc; first = s < sp; } else first = s < rc; }
      unsigned long long uu = 0ull;
      if (!first) uu = __hip_atomic_load((unsigned long long*)hp, __ATOMIC_RELAXED, __HIP_MEMORY_SCOPE_AGENT);
      if (s + 1 < NCH_) ML_ISSUE(s + 1)
      { const int vr = tid >> 4, sg = (tid & 15) * 4; const uint2 vv_ = *(const uint2*)(sVT + vr * VS + sg); const float4 wg4 = *(const float4*)(sWg + sg);
        *(uint2*)(sVW + vr * VS + sg) = uint2{cvtpk(blo(vv_.x) * wg4.x, bhi(vv_.x) * wg4.y), cvtpk(blo(vv_.y) * wg4.z, bhi(vv_.y) * wg4.w)}; }
      bf16x8 qf[4];
#pragma unroll
      for (int ks = 0; ks < 4; ks++) qf[ks] = *(const bf16x8*)(sQ + (16 * w + l15) * QS + ks * 32 + q4 * 8);
      f32x4 sacc[4];
#pragma unroll
      for (int a = 0; a < 4; a++) { sacc[a] = f32x4{0.f, 0.f, 0.f, 0.f};
#pragma unroll
        for (int ks = 0; ks < 4; ks++) { bf16x8 kf = *(const bf16x8*)(sK + (16 * a + l15) * QS + ks * 32 + q4 * 8); sacc[a] = __builtin_amdgcn_mfma_f32_16x16x32_bf16(kf, qf[ks], sacc[a], 0, 0, 0); } }
      const float ctt = sCt[rt]; const float ect = __expf(ctt); float densum = 0.f;
#pragma unroll
      for (int a = 0; a < 4; a++) { const float4 ex4 = *(const float4*)(sEs + 16 * a + 4 * q4); const float exv[4] = {ex4.x, ex4.y, ex4.z, ex4.w};
#pragma unroll
        for (int jj = 0; jj < 4; jj++) { int rs_ = 16 * a + 4 * q4 + jj; bool valid = d == 0 ? rs_ <= rt : rs_ >= rt;
          float wv = valid ? ect * exv[jj] : 0.f; float sv = sacc[a][jj] * wv; sacc[a][jj] = sv; densum += sv; } }
      densum += __shfl_xor(densum, 16); densum += __shfl_xor(densum, 32);
      bf16x8 sf[2], vf[2];
#pragma unroll
      for (int ks = 0; ks < 2; ks++) {
#pragma unroll
        for (int jj = 0; jj < 4; jj++) { sf[ks][jj] = (short)f2b(sacc[2 * ks][jj]); sf[ks][4 + jj] = (short)f2b(sacc[2 * ks + 1][jj]); }
        uint2 v0 = *(const uint2*)(sVT + l15 * VS + 32 * ks + 4 * q4), v1 = *(const uint2*)(sVT + l15 * VS + 32 * ks + 16 + 4 * q4);
        uint4 vv = uint4{v0.x, v0.y, v1.x, v1.y}; vf[ks] = *(bf16x8*)&vv;
      }
      f32x4 num = f32x4{0.f, 0.f, 0.f, 0.f}, numC = f32x4{0.f, 0.f, 0.f, 0.f};
#pragma unroll
      for (int ks = 0; ks < 2; ks++) num = __builtin_amdgcn_mfma_f32_16x16x32_bf16(vf[ks], sf[ks], num, 0, 0, 0);
#pragma unroll
      for (int ks = 0; ks < 4; ks++) { bf16x8 cf = *(const bf16x8*)(sCT + l15 * QS + ks * 32 + q4 * 8); numC = __builtin_amdgcn_mfma_f32_16x16x32_bf16(cf, qf[ks], numC, 0, 0, 0); }
      f32x4 qnacc = f32x4{0.f, 0.f, 0.f, 0.f};
#pragma unroll
      for (int ks = 0; ks < 4; ks++) { bf16x8 na = bf16x8{0, 0, 0, 0, 0, 0, 0, 0}; if (l15 == 0) na = *(const bf16x8*)(sNb + ks * 32 + q4 * 8);
        qnacc = __builtin_amdgcn_mfma_f32_16x16x32_bf16(na, qf[ks], qnacc, 0, 0, 0); }
      const float qn = __shfl(qnacc[0], l15);
      {
        float inter = __expf(mold + ctt); float den = densum + inter * qn; float dn = fmaxf(fabsf(den), __expf(ctt - sBc[rt])); float inv = __builtin_amdgcn_rcpf(dn);
        f32x4 hv;
#pragma unroll
        for (int jj = 0; jj < 4; jj++) hv[jj] = (num[jj] + inter * numC[jj]) * inv;
        if (!first) { unsigned ux = (unsigned)uu, uy = (unsigned)(uu >> 32);
          hv[0] += blo(ux); hv[1] += bhi(ux); hv[2] += blo(uy); hv[3] += bhi(uy); }
        store4b(hp, hv);
      }
      __syncthreads();
      {
        bf16x8 vw[2], wa[2];
#pragma unroll
        for (int ks = 0; ks < 2; ks++) {
          const uint2 v0 = *(const uint2*)(sVW + l15 * VS + 32 * ks + 4 * q4), v1 = *(const uint2*)(sVW + l15 * VS + 32 * ks + 16 + 4 * q4);
          uint4 vv = uint4{v0.x, v0.y, v1.x, v1.y}; vw[ks] = *(bf16x8*)&vv;
          uint4 wz = uint4{0u, 0u, 0u, 0u};
          if (l15 == 0) { const float4 g0 = *(const float4*)(sWg + 32 * ks + 4 * q4), g1 = *(const float4*)(sWg + 32 * ks + 16 + 4 * q4); wz = uint4{cvtpk(g0.x, g0.y), cvtpk(g0.z, g0.w), cvtpk(g1.x, g1.y), cvtpk(g1.z, g1.w)}; }
          wa[ks] = *(bf16x8*)&wz; }
#pragma unroll
        for (int a = 0; a < 2; a++) {
          int dk = 32 * w + 16 * a + l15;
#pragma unroll
          for (int jj = 0; jj < 4; jj++) Cacc[a][jj] *= decay;
          f32x4 nacc = f32x4{0.f, 0.f, 0.f, 0.f};
#pragma unroll
          for (int ks = 0; ks < 2; ks++) { bf16x8 kt;
#pragma unroll
            for (int e = 0; e < 8; e++) { int rs_ = 32 * ks + (e < 4 ? 4 * q4 + e : 16 + 4 * q4 + e - 4); kt[e] = (short)sK[rs_ * QS + dk]; }
            Cacc[a] = __builtin_amdgcn_mfma_f32_16x16x32_bf16(vw[ks], kt, Cacc[a], 0, 0, 0);
            nacc = __builtin_amdgcn_mfma_f32_16x16x32_bf16(wa[ks], kt, nacc, 0, 0, 0); }
          if (q4 == 0) sNr[dk] = nacc[0];
#pragma unroll
          for (int jj = 0; jj < 4; jj++) sCT[(4 * q4 + jj) * QS + dk] = f2b(Cacc[a][jj]);
        }
      }
      __syncthreads();
      if (tid < 128) { const float nv = decay * sN[tid] + sNr[tid]; sN[tid] = nv; sNb[tid] = f2b(nv); }
    }
    __syncthreads();
  }
}

#define CS 72
#define CSLOT(i_) ((bfr*)smem + (i_) * (64 * CS))
#define A_SST (A_R7B + 362086400ull)
__device__ __forceinline__ f32x4 cmm(const bfr* X, const bfr* YT, int ti, int tj, int l15, int q4) {
  f32x4 acc = f32x4{0.f, 0.f, 0.f, 0.f};
#pragma unroll
  for (int ks = 0; ks < 2; ks++) { bf16x8 a = *(const bf16x8*)(X + (16 * ti + l15) * CS + 32 * ks + 8 * q4); bf16x8 b = *(const bf16x8*)(YT + (16 * tj + l15) * CS + 32 * ks + 8 * q4);
    acc = __builtin_amdgcn_mfma_f32_16x16x32_bf16(a, b, acc, 0, 0, 0); }
  return acc;
}
template <int MODE> __device__ __forceinline__ f32x4 cmm_mask(const bfr* X, const bfr* YT, int ti, int tj, int l15, int q4) {
  f32x4 acc = f32x4{0.f, 0.f, 0.f, 0.f};
#pragma unroll
  for (int ks = 0; ks < 2; ks++) { const int kb = 2 * ks + (q4 >> 1);
    const bool ok = MODE == 1 ? ((kb == 0 && tj == 1) || (kb == 2 && tj == 3)) : (kb < 2 && tj >= 2);
    bf16x8 a = *(const bf16x8*)(X + (16 * ti + l15) * CS + 32 * ks + 8 * q4); bf16x8 bz = bf16x8{0, 0, 0, 0, 0, 0, 0, 0};
    if (ok) bz = *(const bf16x8*)(YT + (16 * tj + l15) * CS + 32 * ks + 8 * q4);
    acc = __builtin_amdgcn_mfma_f32_16x16x32_bf16(a, bz, acc, 0, 0, 0); }
  return acc;
}
__device__ __forceinline__ void st_row(bfr* dst, int r0, int c, f32x4 v) {
#pragma unroll
  for (int jj = 0; jj < 4; jj++) dst[(r0 + jj) * CS + c] = f2b(v[jj]); }
__device__ __forceinline__ void st_tr(bfr* dst, int r0, int c, f32x4 v) { store4b(dst + c * CS + r0, v); }
__device__ __forceinline__ f32x4 ld_row(const bfr* src, int r0, int c) { f32x4 v;
#pragma unroll
  for (int jj = 0; jj < 4; jj++) v[jj] = b2f(src[(r0 + jj) * CS + c]);
  return v; }
__device__ __forceinline__ f32x4 ld_tr(const bfr* src, int r0, int c) { uint2 u = *(const uint2*)(src + c * CS + r0); return f32x4{blo(u.x), bhi(u.x), blo(u.y), bhi(u.y)}; }

__device__ __forceinline__ void ph_r7_ca(const P& p, int j, int win, char* smem) {
  float* LW = (float*)(smem + 7 * 9216); float* AT = (float*)(smem + 9 * 9216); float* WL = (float*)(smem + 14 * 9216);
  const bfr* RK = (const bfr*)(p.ACT + A_RKVZ); const bfr* WMb = (const bfr*)(p.ACT + A_WM); const bfr* AMb = (const bfr*)(p.ACT + A_AM);
  float* BON = (float*)(p.ACT + A_BON); bfr* WB = p.H;
  const float* kkp = p.r7_k_k + (size_t)j * 1024; const float* kap = p.r7_k_a + (size_t)j * 1024; const float* rkp = p.r7_r_k + (size_t)j * 1024;
  const int tid = ltid(), lane = tid & 63, w = tid >> 6, l15 = lane & 15, q4 = lane >> 4, ti = w >> 1, tj0 = (w & 1) * 2;
  const int c0 = win * 20;
  for (int it = blockIdx.x; it < 1280; it += gridDim.x) {
    const int chain = it / 20, cl = it - chain * 20, c = c0 + cl, d = chain & 1, b = chain >> 5, h = (chain >> 1) & 15;
    {
      const int rowA = rowmap(d, b, 64 * c + 16 * ti + l15);
      const float* w0 = p.r7_w0 + (size_t)(j * 2 + d) * 1024 + h * 64; const float* a0 = p.r7_a0 + (size_t)(j * 2 + d) * 1024 + h * 64;
#pragma unroll
      for (int tt = 0; tt < 2; tt++) { const int tj = tj0 + tt; f32x4 aw = f32x4{0.f, 0.f, 0.f, 0.f}, aa = aw;
#pragma unroll
        for (int ks = 0; ks < 2; ks++) {
          bf16x8 xw = *(const bf16x8*)(WMb + (size_t)rowA * 128 + d * 64 + 32 * ks + 8 * q4), xa = *(const bf16x8*)(AMb + (size_t)rowA * 128 + d * 64 + 32 * ks + 8 * q4);
          bf16x8 yw = *(const bf16x8*)(p.W + WR_UP + d * 65536 + (size_t)(h * 64 + 16 * tj + l15) * 64 + 32 * ks + 8 * q4);
          bf16x8 ya = *(const bf16x8*)(p.W + WR_UP + (2 + d) * 65536 + (size_t)(h * 64 + 16 * tj + l15) * 64 + 32 * ks + 8 * q4);
          aw = __builtin_amdgcn_mfma_f32_16x16x32_bf16(xw, yw, aw, 0, 0, 0); aa = __builtin_amdgcn_mfma_f32_16x16x32_bf16(xa, ya, aa, 0, 0, 0); }
        const int ch = 16 * tj + l15; const float w0v = w0[ch], a0v = a0[ch];
#pragma unroll
        for (int jj = 0; jj < 4; jj++) { const int tau = 16 * ti + 4 * q4 + jj; LW[tau * 64 + ch] = -0.6065306597126334f * sigm(w0v + aw[jj]); AT[tau * 64 + ch] = sigm(a0v + aa[jj]); }
      }
    }
    __syncthreads();
    if (tid < 64) { float acc = 0.f;
#pragma unroll 8
      for (int t = 0; t < 64; t++) { acc += LW[t * 64 + tid]; LW[t * 64 + tid] = acc; } }
    __syncthreads();
    {
      const int tau = tid >> 3, sc = tid & 7, col = h * 64 + sc * 8; const int row = rowmap(d, b, 64 * c + tau);
      const bfr* rp = RK + (size_t)row * 4096 + col; uint4 pr = *(const uint4*)rp, pk = *(const uint4*)(rp + 1024);
      unsigned ur[4] = {pr.x, pr.y, pr.z, pr.w}, uk[4] = {pk.x, pk.y, pk.z, pk.w};
      float r8[8], k8[8], kr[8];
#pragma unroll
      for (int e = 0; e < 4; e++) { r8[2 * e] = blo(ur[e]); r8[2 * e + 1] = bhi(ur[e]); k8[2 * e] = blo(uk[e]); k8[2 * e + 1] = bhi(uk[e]); }
      float ss = 0.f;
#pragma unroll
      for (int e = 0; e < 8; e++) { kr[e] = k8[e] * kkp[col + e]; ss += kr[e] * kr[e]; }
      ss += __shfl_xor(ss, 1); ss += __shfl_xor(ss, 2); ss += __shfl_xor(ss, 4);
      const float inv = __builtin_amdgcn_rsqf(fmaxf(ss, 1e-24f));
      float bon = 0.f, o0[8], o1[8], o2[8], o3[8], o4[8], o5[8];
#pragma unroll
      for (int e = 0; e < 8; e++) {
        const float cw = LW[tau * 64 + sc * 8 + e], cwm = tau > 0 ? LW[(tau - 1) * 64 + sc * 8 + e] : 0.f, cwl = LW[63 * 64 + sc * 8 + e], a = AT[tau * 64 + sc * 8 + e];
        const float ka = kr[e] * inv, be = a * ka, kd = k8[e] * (1.f + (a - 1.f) * kap[col + e]); bon += r8[e] * kd * rkp[col + e];
        const float e2 = __expf(-cw), e4 = __expf(cwl - cw);
        o0[e] = ka * __expf(cwm); o1[e] = be * e2; o2[e] = kd * e2; o3[e] = r8[e] * __expf(cw); o4[e] = be * e4; o5[e] = kd * e4;
        if (tau == 63) WL[sc * 8 + e] = __expf(cwl);
      }
      bon += __shfl_xor(bon, 1); bon += __shfl_xor(bon, 2); bon += __shfl_xor(bon, 4);
      if (sc == 0) BON[((size_t)d * R_ + row) * 16 + h] = bon;
      *(uint4*)(CSLOT(0) + tau * CS + sc * 8) = uint4{pk2(o0[0], o0[1]), pk2(o0[2], o0[3]), pk2(o0[4], o0[5]), pk2(o0[6], o0[7])};
      *(uint4*)(CSLOT(1) + tau * CS + sc * 8) = uint4{pk2(o1[0], o1[1]), pk2(o1[2], o1[3]), pk2(o1[4], o1[5]), pk2(o1[6], o1[7])};
      *(uint4*)(CSLOT(2) + tau * CS + sc * 8) = uint4{pk2(o2[0], o2[1]), pk2(o2[2], o2[3]), pk2(o2[4], o2[5]), pk2(o2[6], o2[7])};
      *(uint4*)(CSLOT(3) + tau * CS + sc * 8) = uint4{pk2(o3[0], o3[1]), pk2(o3[2], o3[3]), pk2(o3[4], o3[5]), pk2(o3[6], o3[7])};
#pragma unroll
      for (int e = 0; e < 8; e++) { CSLOT(4)[(sc * 8 + e) * CS + tau] = f2b(o0[e]); CSLOT(5)[(sc * 8 + e) * CS + tau] = f2b(o4[e]); CSLOT(6)[(sc * 8 + e) * CS + tau] = f2b(o5[e]); }
    }
    __syncthreads();
#pragma unroll
    for (int tt = 0; tt < 2; tt++) { const int tj = tj0 + tt, r0 = 16 * ti + 4 * q4, cc = 16 * tj + l15;
      f32x4 v = cmm(CSLOT(1), CSLOT(0), ti, tj, l15, q4);
#pragma unroll
      for (int jj = 0; jj < 4; jj++) if (!(r0 + jj < cc)) v[jj] = 0.f;
      st_row(CSLOT(7), r0, cc, v); st_tr(CSLOT(8), r0, cc, v);
      v = cmm(CSLOT(2), CSLOT(0), ti, tj, l15, q4);
#pragma unroll
      for (int jj = 0; jj < 4; jj++) if (!(r0 + jj < cc)) v[jj] = 0.f;
      st_row(CSLOT(9), r0, cc, v);
      v = cmm(CSLOT(3), CSLOT(1), ti, tj, l15, q4);
#pragma unroll
      for (int jj = 0; jj < 4; jj++) if (!(cc <= r0 + jj)) v[jj] = 0.f;
      st_row(CSLOT(10), r0, cc, v);
      v = cmm(CSLOT(3), CSLOT(2), ti, tj, l15, q4);
#pragma unroll
      for (int jj = 0; jj < 4; jj++) if (!(cc <= r0 + jj)) v[jj] = 0.f;
      st_row(CSLOT(11), r0, cc, v);
    }
    __syncthreads();
    {
      float* X = (float*)CSLOT(0);
      const bfr* Ab = CSLOT(7);
      const int cl = lane >> 3, pp = lane & 7, cx = 8 * w + cl, blk0 = (w >> 1) * 16;
#pragma unroll 1
      for (int il = 15; il >= 0; il--) { const int i = blk0 + il;
        float sum = 0.f;
#pragma unroll 1
        for (int jx = i + 1 + pp; jx < blk0 + 16; jx += 8) sum += b2f(Ab[i * CS + jx]) * X[jx * 72 + cx];
        sum += dppf<0xB1>(sum); sum += dppf<0x4E>(sum); sum += dppf<0x141>(sum);
        const float xv = (i == cx ? 1.f : 0.f) - sum;
        if (pp == 0) X[i * 72 + cx] = xv;
      }
      __syncthreads();
#pragma unroll 1
      for (int e = tid; e < 4096; e += 512) { const int i = e >> 6, c2 = e & 63; const bfr tv = ((i >> 4) == (c2 >> 4)) ? f2b(X[i * 72 + c2]) : (bfr)0; CSLOT(2)[i * CS + c2] = tv; CSLOT(12)[c2 * CS + i] = tv; }
      __syncthreads();
#pragma unroll
      for (int tt = 0; tt < 2; tt++) { const int tj = tj0 + tt, r0 = 16 * ti + 4 * q4, cc = 16 * tj + l15; st_row(CSLOT(13), r0, cc, cmm_mask<1>(CSLOT(2), CSLOT(8), ti, tj, l15, q4)); }
      __syncthreads();
#pragma unroll
      for (int tt = 0; tt < 2; tt++) { const int tj = tj0 + tt, r0 = 16 * ti + 4 * q4, cc = 16 * tj + l15;
        f32x4 v = ld_row(CSLOT(2), r0, cc) - cmm(CSLOT(13), CSLOT(12), ti, tj, l15, q4); st_row(CSLOT(0), r0, cc, v); st_tr(CSLOT(1), r0, cc, v); }
      __syncthreads();
#pragma unroll
      for (int tt = 0; tt < 2; tt++) { const int tj = tj0 + tt, r0 = 16 * ti + 4 * q4, cc = 16 * tj + l15; st_row(CSLOT(13), r0, cc, cmm_mask<2>(CSLOT(0), CSLOT(8), ti, tj, l15, q4)); }
      __syncthreads();
#pragma unroll
      for (int tt = 0; tt < 2; tt++) { const int tj = tj0 + tt, r0 = 16 * ti + 4 * q4, cc = 16 * tj + l15;
        f32x4 v = ld_row(CSLOT(0), r0, cc) - cmm(CSLOT(13), CSLOT(1), ti, tj, l15, q4);
#pragma unroll
        for (int jj = 0; jj < 4; jj++) if (r0 + jj == cc) v[jj] -= 1.f;
        st_row(CSLOT(2), r0, cc, v); }
      __syncthreads();
    }
#pragma unroll
    for (int tt = 0; tt < 2; tt++) { const int tj = tj0 + tt, r0 = 16 * ti + 4 * q4, cc = 16 * tj + l15;
      f32x4 g = cmm(CSLOT(10), CSLOT(2), ti, tj, l15, q4) + ld_row(CSLOT(10), r0, cc); st_row(CSLOT(12), r0, cc, g);
      f32x4 hh = cmm(CSLOT(5), CSLOT(2), ti, tj, l15, q4) + ld_row(CSLOT(5), r0, cc); st_row(CSLOT(13), r0, cc, hh); }
    __syncthreads();
    {
      bfr* out = WB + (size_t)(chain * 20 + cl) * 16384;
#pragma unroll
      for (int tt = 0; tt < 2; tt++) { const int tj = tj0 + tt, r0 = 16 * ti + 4 * q4, cc = 16 * tj + l15;
        f32x4 v = ld_tr(CSLOT(3), r0, cc) - cmm(CSLOT(4), CSLOT(12), ti, tj, l15, q4);
        store4b(out + cc * 64 + r0, v);
        v = ld_tr(CSLOT(11), r0, cc) - cmm(CSLOT(9), CSLOT(12), ti, tj, l15, q4);
        store4b(out + 4096 + cc * 64 + r0, v);
        v = -cmm(CSLOT(4), CSLOT(13), ti, tj, l15, q4);
#pragma unroll
        for (int jj = 0; jj < 4; jj++) if (r0 + jj == cc) v[jj] += WL[cc];
        store4b(out + 8192 + cc * 64 + r0, v);
        v = ld_tr(CSLOT(6), r0, cc) - cmm(CSLOT(9), CSLOT(13), ti, tj, l15, q4);
        store4b(out + 12288 + cc * 64 + r0, v);
      }
    }
    __syncthreads();
  }
}

__device__ __forceinline__ void ph_r7_cb(const P& p, int win, char* smem) {
  bfr* Sh = (bfr*)smem; bfr* Sl = Sh + 2 * 16 * CS; bfr* VT = Sl + 2 * 16 * CS;
  const bfr* WB = p.H; const bfr* RK = (const bfr*)(p.ACT + A_RKVZ); bfr* SST = (bfr*)(p.ACT + A_SST);
  const int tid = ltid(), lane = tid & 63, w = tid >> 6, l15 = lane & 15, q4 = lane >> 4;
  const int c0 = win * 20;
  for (int it = blockIdx.x; it < 256; it += gridDim.x) {
    const int d = it & 1, b = it >> 7, h = (it >> 3) & 15, rg = (it >> 1) & 3, chain = (b * 16 + h) * 2 + d;
    bfr* Y = d ? R7_Y2 : (bfr*)(p.ACT + A_Y);
    bfr* sst = SST + (size_t)(chain * 4 + rg) * 2048;
    __syncthreads();
    if (tid < 256) { const int hl = tid >> 7, e = tid & 127, rr = e >> 3, c8 = e & 7; uint4 v = uint4{0u, 0u, 0u, 0u};
      if (win > 0) v = *(const uint4*)(sst + hl * 1024 + rr * 64 + c8 * 8);
      *(uint4*)((hl ? Sl : Sh) + rr * CS + c8 * 8) = v; }
    const int vtau = tid >> 3, vp = tid & 7;
    { const int row = rowmap(d, b, 64 * c0 + vtau); unsigned vv = *(const unsigned*)(RK + (size_t)row * 4096 + 2048 + h * 64 + rg * 16 + 2 * vp);
      VT[(2 * vp) * CS + vtau] = (bfr)(vv & 0xffff); VT[(2 * vp + 1) * CS + vtau] = (bfr)(vv >> 16); }
    const bfr* bbase = WB + (size_t)(chain * 20) * 16384 + (w < 4 ? 8192 + (16 * w + l15) * 64 : (16 * (w - 4) + l15) * 64) + 8 * q4;
    bf16x8 rb1[4][2], rb2[4][2]; unsigned rv[4];
#define CB_LOAD(u_, s_) { const int ss_ = (s_) < 20 ? (s_) : 19; const bfr* bp_ = bbase + (size_t)ss_ * 16384; \
      rb1[u_][0] = *(const bf16x8*)bp_; rb1[u_][1] = *(const bf16x8*)(bp_ + 32); rb2[u_][0] = *(const bf16x8*)(bp_ + 4096); rb2[u_][1] = *(const bf16x8*)(bp_ + 4096 + 32); \
      const int sv_ = ss_ + 1 < 20 ? ss_ + 1 : 19; const int rowv_ = rowmap(d, b, 64 * (c0 + sv_) + vtau); \
      rv[u_] = *(const unsigned*)(RK + (size_t)rowv_ * 4096 + 2048 + h * 64 + rg * 16 + 2 * vp); }
    CB_LOAD(0, 0) CB_LOAD(1, 1) CB_LOAD(2, 2) CB_LOAD(3, 3)
    __syncthreads();
    for (int g = 0; g < 5; g++) {
#pragma unroll
      for (int u = 0; u < 4; u++) {
        const int s = 4 * g + u;
        if (s < 20) {
          const int cur = s & 1, nxt = cur ^ 1, c = c0 + s;
          bf16x8 sh[2], sl[2], vt[2];
#pragma unroll
          for (int ks = 0; ks < 2; ks++) { sh[ks] = *(const bf16x8*)(Sh + (cur * 16 + l15) * CS + 32 * ks + 8 * q4); sl[ks] = *(const bf16x8*)(Sl + (cur * 16 + l15) * CS + 32 * ks + 8 * q4);
            vt[ks] = *(const bf16x8*)(VT + (cur * 16 + l15) * CS + 32 * ks + 8 * q4); }
          f32x4 a1 = f32x4{0.f, 0.f, 0.f, 0.f}, a2 = a1;
#pragma unroll
          for (int ks = 0; ks < 2; ks++) { a1 = __builtin_amdgcn_mfma_f32_16x16x32_bf16(sh[ks], rb1[u][ks], a1, 0, 0, 0); a2 = __builtin_amdgcn_mfma_f32_16x16x32_bf16(vt[ks], rb2[u][ks], a2, 0, 0, 0); }
#pragma unroll
          for (int ks = 0; ks < 2; ks++) a1 = __builtin_amdgcn_mfma_f32_16x16x32_bf16(sl[ks], rb1[u][ks], a1, 0, 0, 0);
          a1 = a1 + a2;
          if (w < 4) {
#pragma unroll
            for (int jj = 0; jj < 4; jj++) { const bfr hi = f2b(a1[jj]); Sh[(nxt * 16 + 4 * q4 + jj) * CS + 16 * w + l15] = hi; Sl[(nxt * 16 + 4 * q4 + jj) * CS + 16 * w + l15] = f2b(a1[jj] - b2f(hi)); }
          } else {
            const int rowy = rowmap(d, b, 64 * c + 16 * (w - 4) + l15);
            store4b(Y + (size_t)rowy * 1024 + h * 64 + rg * 16 + 4 * q4, a1);
          }
          if (s + 1 < 20) { VT[(nxt * 16 + 2 * vp) * CS + vtau] = (bfr)(rv[u] & 0xffff); VT[(nxt * 16 + 2 * vp + 1) * CS + vtau] = (bfr)(rv[u] >> 16); }
          if (s + 4 < 20) CB_LOAD(u, s + 4)
          __syncthreads();
        }
      }
    }
    if (tid < 256) { const int hl = tid >> 7, e = tid & 127, rr = e >> 3, c8 = e & 7; *(uint4*)(sst + hl * 1024 + rr * 64 + c8 * 8) = *(const uint4*)((hl ? Sl : Sh) + rr * CS + c8 * 8); }
  }
}

__device__ __forceinline__ void run_phase(const P& p, int ph, int layer, int d, char* smem) {
  Ctx c; c.layer = layer; c.j = layer / 3; c.d = d; c.wc = layer < 3 ? 1 : 0;
  switch (ph) {
    case PH_PRE: ph_pre(p, smem); break;
    case PH_NORM: ph_norm(p, layer, smem); break;
    case PH_LRU_IN: big_gemm(smem, p.H, p.W, 2560, 1024, F_LruIn{p.ACT}); break;
    case PH_LRU_CONV: ph_lru_conv(p, c.j); break;
    case PH_LRU_GATE: gemm_phase_k2<G_LruGate>(p, c, smem); break;
    case PH_LRU_S1: ph_lru_s1(p, d); break;
    case PH_LRU_S2: ph_lru_s2(p, smem); break;
    case PH_LRU_S3: ph_lru_s3(p, d); break;
    case PH_LRU_OUT: big_gemm(smem, (const bfr*)(p.ACT + A_Z), p.W + WL_OUT, 1024, 1280, F_Resid{p.Xx, p.Xc, p.MOD + (size_t)layer * 3 * 3072, c.wc}); break;
    case PH_ML_IN: big_gemm(smem, p.H, p.W, 4352, 1024, F_MlIn{p.ACT}); break;
    case PH_ML_SCAN: ph_ml_scan(p, c.j, smem); break;
    case PH_ML_STAT: ph_ml_stat(p); break;
    case PH_ML_Z: big_gemm(smem, p.H, p.W + WM_Z, 2048, 1024, F_MlZ{p.ACT, p.ml_norm_g + (size_t)c.j * 2048}); break;
    case PH_ML_OUT: big_gemm(smem, (const bfr*)(p.ACT + A_HS), p.W + WM_OUT, 1024, 2048, F_Resid{p.Xx, p.Xc, p.MOD + (size_t)layer * 3 * 3072, c.wc}); break;
    case PH_R7_IN: big_gemm(smem, p.H, p.W, 4352, 2048, F_R7In{p.ACT}); break;
    case PH_R7_SHIFT: ph_r7_shift(p); break;
    case PH_R7_CA: ph_r7_ca(p, c.j, d, smem); break;
    case PH_R7_CB: ph_r7_cb(p, d, smem); break;
    case PH_R7_FIN: ph_r7_fin(p, c.j); break;
    case PH_R7_OUT: big_gemm(smem, (const bfr*)(p.ACT + A_Y), p.W + WR_OUT, 1024, 1024, F_Resid{p.Xx, p.Xc, p.MOD + (size_t)layer * 3 * 3072, c.wc}); break;
    case PH_FINAL: ph_final(p); break;
  }
}


#define XB_TMO      128
#define XB_XCNT(j)  (256  + 64 * (j))
#define XB_XSUB(j)  (1280 + 64 * (j))
#define XB_XGEN(j)  (2304 + 64 * (j))
#define XB_TOP      3328
#define XB_TOPGEN   3392
#define XCD_BAR_WORDS 3456
#define XB_SPIN_CAP (1u << 18)
#define OFF_BAR 527000064ull
#define OFF_CL (OFF_BAR + 16384ull)
__device__ __forceinline__ unsigned xb_ld(unsigned* p)              { return __hip_atomic_load(p, __ATOMIC_RELAXED, __HIP_MEMORY_SCOPE_AGENT); }
__device__ __forceinline__ unsigned xb_add(unsigned* p, unsigned v) { return __hip_atomic_fetch_add(p, v, __ATOMIC_RELAXED, __HIP_MEMORY_SCOPE_AGENT); }
__device__ __forceinline__ unsigned xb_xcc_id() { return (unsigned)__builtin_amdgcn_s_getreg((3 << 11) | 20) & 0xFu; }
#define XB_SPIN(cond, bar) do { unsigned _sp = 0; while (cond) { __builtin_amdgcn_s_sleep(1); \
    if ((++_sp & 255u) == 0u) { if (xb_ld(&(bar)[XB_TMO])) break; if (_sp > XB_SPIN_CAP) { atomicAdd(&(bar)[XB_TMO], 1u); break; } } } } while (0)
struct XcdBarrier { unsigned* bar; unsigned x; volatile __attribute__((address_space(3))) unsigned* st; };
__device__ __forceinline__ XcdBarrier xcd_barrier_post(unsigned* bar, volatile __attribute__((address_space(3))) unsigned* st) {
  XcdBarrier b; b.bar = bar; b.x = xb_xcc_id(); b.st = st;
  if (threadIdx.x == 0) (void)xb_add(&bar[XB_XCNT(b.x)], 1u);
  return b;
}
__device__ __forceinline__ void xcd_barrier_complete(unsigned* bar, unsigned x, unsigned& nloc, unsigned& nx) {
  const unsigned G = gridDim.x * gridDim.y * gridDim.z;
  unsigned sum, cnt, mine, sp = 0u;
  for (;;) {
    sum = 0u; cnt = 0u; mine = 0u;
#pragma unroll
    for (unsigned j = 0; j < 16; ++j) { const unsigned c = xb_ld(&bar[XB_XCNT(j)]); sum += c; cnt += (c > 0u) ? 1u : 0u; mine = (j == x) ? c : mine; }
    if (sum == G) break;
    __builtin_amdgcn_s_sleep(1);
    if ((++sp & 255u) == 0u) { if (xb_ld(&bar[XB_TMO])) break; if (sp > XB_SPIN_CAP) { atomicAdd(&bar[XB_TMO], 1u); break; } }
  }
  nloc = mine > 0u ? mine : 1u; nx = cnt > 0u ? cnt : 1u;
}
__device__ __forceinline__ void xcd_barrier(const XcdBarrier& b) {
  asm volatile("s_waitcnt vmcnt(0)" ::: "memory");
  __syncthreads();
  if (threadIdx.x == 0) {
    unsigned* bar = b.bar;
    __builtin_amdgcn_s_waitcnt(0);
    unsigned nloc = b.st[0], nx = b.st[1];
    if (nloc == 0u) { xcd_barrier_complete(bar, b.x, nloc, nx); b.st[0] = nloc; b.st[1] = nx; }
    const unsigned old = xb_add(&bar[XB_XSUB(b.x)], 1u);
    const unsigned gen = old / nloc;
    if (old + 1u == (gen + 1u) * nloc) {
      __builtin_amdgcn_fence(__ATOMIC_RELEASE, "agent");
      asm volatile("s_waitcnt vmcnt(0)" ::: "memory");
      const unsigned og = xb_add(&bar[XB_TOP], 1u);
      const unsigned tg = og / nx;
      if (og + 1u == (tg + 1u) * nx) xb_add(&bar[XB_TOPGEN], 1u);
      else XB_SPIN(xb_ld(&bar[XB_TOPGEN]) == tg, bar);
      __builtin_amdgcn_fence(__ATOMIC_ACQUIRE, "agent");
      xb_add(&bar[XB_XGEN(b.x)], 1u);
      asm volatile("s_waitcnt vmcnt(0)" ::: "memory");
    } else {
      XB_SPIN(xb_ld(&bar[XB_XGEN(b.x)]) == gen, bar);
      __builtin_amdgcn_fence(__ATOMIC_ACQUIRE, "agent");
      asm volatile("s_waitcnt vmcnt(0)" ::: "memory");
    }
  }
  __syncthreads();
}

#define SMEM_BYTES (131072 + 64)
extern __shared__ __attribute__((aligned(16))) char dyn_smem[];
#if !MEGA
__global__ void __launch_bounds__(512, 2) phase_kernel(P p, int si) {
  run_phase(p, p.sched[si * 3], p.sched[si * 3 + 1], p.sched[si * 3 + 2], dyn_smem);
}
#else
__global__ void __launch_bounds__(512, 2) mega_kernel(P p) {
  cg::grid_group grid = cg::this_grid();
  volatile __attribute__((address_space(3))) unsigned* st = (volatile __attribute__((address_space(3))) unsigned*)(dyn_smem + 131072);
  if (threadIdx.x < 4) st[threadIdx.x] = 0u;
  __syncthreads();
  const XcdBarrier xb = xcd_barrier_post(p.bar, st);
  for (int si = 0; si < p.nsched; si++) {
    run_phase(p, p.sched[si * 3], p.sched[si * 3 + 1], p.sched[si * 3 + 2], dyn_smem);
    if (si + 1 < p.nsched) { if (si == 0) grid.sync(); else xcd_barrier(xb); }
  }
}
#endif

extern "C" void kernel_launch(void* const* d_in, const int* in_sizes, int n_in, void* d_out, int out_size, void* d_ws, size_t ws_size, hipStream_t stream) {
  P p; memset(&p, 0, sizeof(p));
  const float** f = (const float**)&p;
  for (int i = 0; i < 33; i++) f[i] = (const float*)d_in[i];
  char* ws = (char*)d_ws;
  p.Xx = (float*)d_out; p.Xc = (float*)(ws + OFF_XC); p.MOD = (float*)(ws + OFF_MOD); p.W = (bfr*)(ws + OFF_W); p.H = (bfr*)(ws + OFF_H); p.ACT = ws + OFF_ACT; p.bar = (unsigned*)(ws + OFF_BAR); p.CL = (float*)(ws + OFF_CL);
  int n = 0;
  auto add = [&](int ph, int layer, int d) { p.sched[n * 3] = ph; p.sched[n * 3 + 1] = layer; p.sched[n * 3 + 2] = d; n++; };
  add(PH_PRE, 0, 0);
  if (DUP & 4) add(PH_PRE, 0, 0);
  for (int l = 0; l < 4; l++) {
    add(PH_NORM, l, 0); if (DUP & 4) add(PH_NORM, l, 0);
    int kind = l % 3;
    const bool dg = DUP & 1, ds = DUP & 2;
    if (kind == 0) { add(PH_LRU_IN, l, 0); if (dg) add(PH_LRU_IN, l, 0); add(PH_LRU_CONV, l, 0); if (DUP & 4) add(PH_LRU_CONV, l, 0);
      for (int d = 0; d < 2; d++) { add(PH_LRU_GATE, l, d); if (dg) add(PH_LRU_GATE, l, d); add(PH_LRU_S1, l, d); if (DUP & 8) add(PH_LRU_S1, l, d); add(PH_LRU_S2, l, d); if (DUP & 16) add(PH_LRU_S2, l, d); add(PH_LRU_S3, l, d); }
      add(PH_LRU_OUT, l, 0); }
    else if (kind == 1) { add(PH_ML_IN, l, 0); if (dg) add(PH_ML_IN, l, 0); add(PH_ML_SCAN, l, 0); if (ds) add(PH_ML_SCAN, l, 0); add(PH_ML_STAT, l, 0); if (DUP & 4) add(PH_ML_STAT, l, 0); add(PH_ML_Z, l, 0); add(PH_ML_OUT, l, 0); }
    else { add(PH_R7_SHIFT, l, 0); add(PH_R7_IN, l, 0); if (dg) add(PH_R7_IN, l, 0); for (int wi = 0; wi < 13; wi++) { add(PH_R7_CA, l, wi); if (DUP & 32) add(PH_R7_CA, l, wi); add(PH_R7_CB, l, wi); } add(PH_R7_FIN, l, 0); add(PH_R7_OUT, l, 0); }
  }
  add(PH_FINAL, 0, 0);
  p.nsched = n;
  if (ws_size < WS_NEED) fprintf(stderr, "workspace too small: %zu < %llu\n", ws_size, (unsigned long long)WS_NEED);
#if MEGA
  static int grid_blocks = 0;
  if (!grid_blocks) { int dev = 0, cus = 0, per = 0; hipGetDevice(&dev); hipDeviceGetAttribute(&cus, hipDeviceAttributeMultiprocessorCount, dev);
    hipFuncSetAttribute((const void*)mega_kernel, hipFuncAttributeMaxDynamicSharedMemorySize, SMEM_BYTES);
    hipOccupancyMaxActiveBlocksPerMultiprocessor(&per, mega_kernel, 512, SMEM_BYTES); if (per > 1) per = 1; if (per < 1) per = 1; grid_blocks = cus * per; }
  hipMemsetAsync(ws + OFF_BAR, 0, XCD_BAR_WORDS * 4, stream);
  void* args[] = {&p};
  hipError_t e = hipLaunchCooperativeKernel((void*)mega_kernel, dim3(grid_blocks), dim3(512), args, SMEM_BYTES, stream);
  if (e != hipSuccess) fprintf(stderr, "cooperative launch failed: %s (grid %d)\n", hipGetErrorString(e), grid_blocks);
#else
  static int once = 0; if (!once) { once = 1; hipFuncSetAttribute((const void*)phase_kernel, hipFuncAttributeMaxDynamicSharedMemorySize, SMEM_BYTES); }
  for (int si = 0; si < n; si++) phase_kernel<<<256, 512, SMEM_BYTES, stream>>>(p, si);
#endif
}
```

```cpp
#include <hip/hip_runtime.h>
#include <hip/hip_bf16.h>
#include <hip/hip_cooperative_groups.h>
#include <cstdio>
#include <cstring>
#include <type_traits>
namespace cg = cooperative_groups;

#ifndef DUP
#define DUP 0
#endif
#ifndef MEGA
#define MEGA 1
#endif

typedef unsigned short bfr;
using bf16x8 = __attribute__((ext_vector_type(8))) short;
using f32x4 = __attribute__((ext_vector_type(4))) float;

#define R_ 33280
#define BT_ 16640
#define NCH_ 260

#define OFF_XC 0ull
#define OFF_MOD 2097152ull
#define OFF_W 2244608ull
#define OFF_H 24264704ull
#define OFF_ACT 92422144ull
#define A_Z 0ull
#define A_UC 85196800ull
#define A_AB 170393600ull
#define A_U 170393600ull
#define A_HF 340787200ull
#define A_AGG 425984000ull
#define A_CAR 431308800ull
#define A_QKV 0ull
#define A_GATE 272629760ull
#define A_HS 276889600ull
#define A_RSTD 413204480ull
#define A_R7B 68157440ull
#define A_RKVZ (A_R7B + 0ull)
#define A_WM (A_R7B + 272629760ull)
#define A_AM (A_R7B + 281149440ull)
#define A_BON (A_R7B + 289669120ull)
#define A_Y (A_R7B + 293928960ull)
#define WS_NEED (527000064ull + 16384ull)

#define WL_GATE (2560 * 1024)
#define WL_OUT (WL_GATE + 1310720)
#define WM_Z (4352 * 1024)
#define WM_OUT (WM_Z + 2048 * 1024)
#define WR_UP (4352 * 2048)
#define WR_OUT (WR_UP + 262144)

enum { PH_PRE = 0, PH_NORM, PH_LRU_IN, PH_LRU_CONV, PH_LRU_GATE, PH_LRU_S1, PH_LRU_S2, PH_LRU_S3, PH_LRU_OUT,
       PH_ML_IN, PH_ML_SCAN, PH_ML_STAT, PH_ML_Z, PH_ML_OUT,
       PH_R7_IN, PH_R7_CA, PH_R7_CB, PH_R7_FIN, PH_R7_OUT, PH_FINAL, PH_R7_SHIFT };

struct P {
  const float *x, *c, *ctx, *c_ctx, *norm_g, *mod_w, *mod_b, *final_g;
  const float *lru_w_in, *lru_conv_w, *lru_conv_b, *lru_gate_w, *lru_gate_b, *lru_lam, *lru_w_out;
  const float *ml_w_in, *ml_gate_b, *ml_norm_g, *ml_w_out;
  const float *r7_mu, *r7_w_rkvz, *r7_w0, *r7_w1, *r7_w2, *r7_a0, *r7_a1, *r7_a2, *r7_k_k, *r7_k_a, *r7_r_k, *r7_ln_g, *r7_ln_b, *r7_w_out;
  float* Xx; float* Xc; float* MOD; bfr* W; bfr* H; char* ACT; unsigned* bar; float* CL;
  int nsched; int pad_;
  int sched[64 * 3];
};
struct Ctx { int layer, j, d, wc; };

__device__ __forceinline__ int xcd_swz() { const int b = blockIdx.x; return gridDim.x == 256 ? ((b & 7) * 32 + (b >> 3)) : b; }
__device__ __forceinline__ int ltid() { int t = threadIdx.x; asm volatile("" : "+v"(t)); return t; }
typedef float f32v2_ __attribute__((ext_vector_type(2))); typedef __bf16 bf16v2_ __attribute__((ext_vector_type(2)));
__device__ __forceinline__ unsigned cvtpk(float lo, float hi) { f32v2_ f = {lo, hi}; bf16v2_ h = __builtin_convertvector(f, bf16v2_); return __builtin_bit_cast(unsigned, h); }
__device__ __forceinline__ bfr f2b(float f) { return (bfr)(cvtpk(f, f) & 0xffffu); }
__device__ __forceinline__ float b2f(bfr b) { return __uint_as_float(((unsigned)b) << 16); }
__device__ __forceinline__ unsigned pk2(float a, float b) { return cvtpk(a, b); }
__device__ __forceinline__ float blo(unsigned u) { return __uint_as_float(u << 16); }
__device__ __forceinline__ float bhi(unsigned u) { return __uint_as_float(u & 0xffff0000u); }
__device__ __forceinline__ void store4b(bfr* dst, f32x4 v) { uint2 u; u.x = pk2(v[0], v[1]); u.y = pk2(v[2], v[3]); *(uint2*)dst = u; }
__device__ __forceinline__ float sigm(float x) { return __builtin_amdgcn_rcpf(1.f + __expf(-x)); }
__device__ __forceinline__ float siluf(float x) { return x * sigm(x); }
__device__ __forceinline__ float softplusf(float x) { return x > 20.f ? x : log1pf(expf(x)); }
__device__ __forceinline__ int rowmap(int d, int b, int pp) { int o = d == 0 ? pp : (pp < 256 ? 255 - pp : 16895 - pp); return b * BT_ + o; }
__device__ __forceinline__ float* xrowp(const P& p, int row, int& mi) {
  int b = row / BT_, o = row - b * BT_;
  if (o < 256) { mi = 2; return p.Xc + (size_t)(b * 256 + o) * 1024; }
  mi = b; return p.Xx + (size_t)(b * 16384 + o - 256) * 1024;
}
__device__ __forceinline__ float wsum(float v) { for (int o = 32; o; o >>= 1) v += __shfl_xor(v, o); return v; }
template <int CTRL> __device__ __forceinline__ float dppf(float x) {
  return __int_as_float(__builtin_amdgcn_update_dpp(0, __float_as_int(x), CTRL, 0xf, 0xf, true));
}
__device__ __forceinline__ float red16(float x) {
  x += dppf<0xB1>(x); x += dppf<0x4E>(x); x += dppf<0x141>(x); x += dppf<0x140>(x); return x;
}

template <class F> __device__ __forceinline__ void prep_tile(bfr* dst, int K, int tn, int tk, F get, float* sm) {
  int tid = ltid();
  for (int i = 0; i < 8; i++) { int kk = (tid >> 6) + 8 * i, nn = tid & 63; sm[kk * 65 + nn] = get(tk * 64 + kk, tn * 64 + nn); }
  __syncthreads();
  for (int i = 0; i < 8; i++) { int nn = (tid >> 6) + 8 * i, kk = tid & 63; dst[(size_t)(tn * 64 + nn) * K + tk * 64 + kk] = f2b(sm[kk * 65 + nn]); }
  __syncthreads();
}
__device__ __forceinline__ int prep_count(int layer) { int kind = layer % 3; return kind == 0 ? (640 + 320 + 320) : kind == 1 ? (1088 + 512 + 512) : (2176 + 64 + 256); }
__device__ __forceinline__ void prep_item(const P& p, int layer, int it, float* sm) {
  int kind = layer % 3, j = layer / 3;
  if (kind == 0) {
    if (it < 640) { int tn = it / 16, tk = it % 16; const float* s = p.lru_w_in + (size_t)j * 1024 * 2560;
      prep_tile(p.W, 1024, tn, tk, [=](int k, int n) { return s[(size_t)k * 2560 + n]; }, sm); return; }
    it -= 640;
    if (it < 320) { int d = it / 160, r = it % 160, tn = r / 2, tk = r % 2; const float* s = p.lru_gate_w + (size_t)(j * 2 + d) * 2 * 10 * 16384;
      prep_tile(p.W + WL_GATE + d * 655360, 128, tn, tk, [=](int k, int n) {
        int nt = n >> 7, blk = nt >> 1, sub = nt & 1, jj = n & 127, wn = jj >> 6, rr = jj & 63, g = rr >> 5, c = rr & 31;
        int kch = sub * 64 + wn * 32 + c; return s[((size_t)(g * 10 + blk) * 128 + k) * 128 + kch]; }, sm); return; }
    it -= 320;
    { int tn = it / 20, tk = it % 20; const float* s = p.lru_w_out + (size_t)j * 1280 * 1024;
      prep_tile(p.W + WL_OUT, 1280, tn, tk, [=](int k, int n) { return s[(size_t)k * 1024 + n]; }, sm); return; }
  } else if (kind == 1) {
    const float* s = p.ml_w_in + (size_t)j * 1024 * 6176;
    if (it < 1088) { int tn = it / 16, tk = it % 16;
      prep_tile(p.W, 1024, tn, tk, [=](int k, int n) {
        if (n < 4096) { float v = s[(size_t)k * 6176 + n]; return (n >= 1024 && n < 2048) ? v * 0.08838834764831845f : v; }
        if (n < 4128) return s[(size_t)k * 6176 + 6144 + (n - 4096)];
        return 0.f; }, sm); return; }
    it -= 1088;
    if (it < 512) { int tn = it / 16, tk = it % 16;
      prep_tile(p.W + WM_Z, 1024, tn, tk, [=](int k, int n) { return s[(size_t)k * 6176 + 4096 + n]; }, sm); return; }
    it -= 512;
    { int tn = it / 32, tk = it % 32; const float* so = p.ml_w_out + (size_t)j * 2048 * 1024;
      prep_tile(p.W + WM_OUT, 2048, tn, tk, [=](int k, int n) { return so[(size_t)k * 1024 + n]; }, sm); return; }
  } else {
    if (it < 2176) { int tn = it / 32, tk = it % 32;
      const float* mu = p.r7_mu + (size_t)j * 6 * 1024; const float* wr = p.r7_w_rkvz + (size_t)j * 4 * 1024 * 1024;
      const float* w1 = p.r7_w1 + (size_t)j * 2 * 1024 * 64; const float* a1 = p.r7_a1 + (size_t)j * 2 * 1024 * 64;
      prep_tile(p.W, 2048, tn, tk, [=](int k, int n) {
        int kk = k & 1023; float v, m;
        if (n < 4096) { int g = n >> 10, e = n & 1023; m = mu[g * 1024 + kk]; v = wr[((size_t)g * 1024 + kk) * 1024 + e]; }
        else if (n < 4224) { int xx = (n - 4096) >> 6, rr = (n - 4096) & 63; m = mu[4 * 1024 + kk]; v = w1[((size_t)xx * 1024 + kk) * 64 + rr]; }
        else { int xx = (n - 4224) >> 6, rr = (n - 4224) & 63; m = mu[5 * 1024 + kk]; v = a1[((size_t)xx * 1024 + kk) * 64 + rr]; }
        return (k < 1024 ? (1.f - m) : m) * v; }, sm); return; }
    it -= 2176;
    if (it < 64) { int u = it / 16, tn = it % 16; const float* s = (u < 2 ? p.r7_w2 : p.r7_a2) + (size_t)(j * 2 + (u & 1)) * 64 * 1024;
      prep_tile(p.W + WR_UP + u * 65536, 64, tn, 0, [=](int k, int n) { return s[(size_t)k * 1024 + n]; }, sm); return; }
    it -= 64;
    { int tn = it / 16, tk = it % 16; const float* s = p.r7_w_out + (size_t)j * 1024 * 1024;
      prep_tile(p.W + WR_OUT, 1024, tn, tk, [=](int k, int n) { return s[(size_t)k * 1024 + n]; }, sm); return; }
  }
}

#define LDSS 72
template <class G> __device__ __forceinline__ void gemm_tile(const P& p, const Ctx& c, int mt, int nt, char* smem) {
  const int tid = ltid(), lane = tid & 63, wid = tid >> 6, wm = wid & 3, wn = wid >> 2;
  bfr* sA = (bfr*)smem; bfr* sB = sA + 2 * 256 * LDSS;
  f32x4 acc[4][4];
  for (int a = 0; a < 4; a++) for (int b = 0; b < 4; b++) acc[a][b] = f32x4{0.f, 0.f, 0.f, 0.f};
  const int lr = tid >> 3, lc = tid & 7;
  uint4 ra[4], rb[2];
  auto gload = [&](int kt) __attribute__((always_inline)) {
#pragma unroll
    for (int i = 0; i < 4; i++) {
      const bfr* pa = G::aptr(p, c, mt * 256 + lr + 64 * i, kt, nt);
      ra[i] = pa ? *(const uint4*)(pa + lc * 8) : uint4{0u, 0u, 0u, 0u};
      if (i < 2) rb[i] = *(const uint4*)(G::bptr(p, c, nt * 128 + lr + 64 * i, kt) + lc * 8);
    }
  };
  auto sstore = [&](int buf) __attribute__((always_inline)) {
#pragma unroll
    for (int i = 0; i < 4; i++) {
      *(uint4*)(sA + (buf * 256 + lr + 64 * i) * LDSS + lc * 8) = ra[i];
      if (i < 2) *(uint4*)(sB + (buf * 128 + lr + 64 * i) * LDSS + lc * 8) = rb[i];
    }
  };
  gload(0); sstore(0); __syncthreads();
  for (int kt = 0; kt < G::KT; kt++) {
    const int buf = kt & 1;
    if (kt + 1 < G::KT) gload(kt + 1);
#pragma unroll
    for (int ks = 0; ks < 2; ks++) {
      bf16x8 af[4], bf[4];
#pragma unroll
      for (int i = 0; i < 4; i++) {
        af[i] = *(const bf16x8*)(sA + (buf * 256 + wm * 64 + i * 16 + (lane & 15)) * LDSS + ks * 32 + (lane >> 4) * 8);
        bf[i] = *(const bf16x8*)(sB + (buf * 128 + wn * 64 + i * 16 + (lane & 15)) * LDSS + ks * 32 + (lane >> 4) * 8);
      }
#pragma unroll
      for (int n = 0; n < 4; n++)
#pragma unroll
        for (int m = 0; m < 4; m++) acc[n][m] = __builtin_amdgcn_mfma_f32_16x16x32_bf16(bf[n], af[m], acc[n][m], 0, 0, 0);
    }
    if (kt + 1 < G::KT) sstore(buf ^ 1);
    __syncthreads();
  }
  G::epi(p, c, acc, mt * 256 + wm * 64, nt * 128 + wn * 64, lane);
}

__device__ __forceinline__ void epi_resid(const P& p, const Ctx& c, f32x4 (&acc)[4][4], int m0, int n0, int lane) {
#pragma unroll
  for (int mi = 0; mi < 4; mi++) {
    int row = m0 + mi * 16 + (lane & 15); int mo; float* xr = xrowp(p, row, mo);
    if (mo == 2 && !c.wc) continue;
    const float* g = p.MOD + (size_t)(c.layer * 3 + mo) * 3072 + 2048;
#pragma unroll
    for (int ni = 0; ni < 4; ni++) {
      int n = n0 + ni * 16 + (lane >> 4) * 4;
      float4 xv = *(float4*)(xr + n); float4 gg = *(const float4*)(g + n);
      xv.x += gg.x * acc[ni][mi][0]; xv.y += gg.y * acc[ni][mi][1]; xv.z += gg.z * acc[ni][mi][2]; xv.w += gg.w * acc[ni][mi][3];
      *(float4*)(xr + n) = xv;
    }
  }
}

struct G_LruIn { static constexpr int KT = 16, NT = 20;
  static __device__ __forceinline__ const bfr* aptr(const P& p, const Ctx& c, int row, int kt, int nt) { return p.H + (size_t)row * 1024 + kt * 64; }
  static __device__ __forceinline__ const bfr* bptr(const P& p, const Ctx& c, int n, int kt) { return p.W + (size_t)n * 1024 + kt * 64; }
  static __device__ __forceinline__ void epi(const P& p, const Ctx& c, f32x4 (&acc)[4][4], int m0, int n0, int lane) {
    bfr* U = (bfr*)(p.ACT + A_U); bfr* Z = (bfr*)(p.ACT + A_Z);
#pragma unroll
    for (int ni = 0; ni < 4; ni++)
#pragma unroll
      for (int mi = 0; mi < 4; mi++) {
        int row = m0 + mi * 16 + (lane & 15), n = n0 + ni * 16 + (lane >> 4) * 4;
        bfr* dst = n < 1280 ? U + (size_t)row * 1280 + n : Z + (size_t)row * 1280 + (n - 1280);
        store4b(dst, acc[ni][mi]);
      }
  } };
struct G_LruGate { static constexpr int KT = 2, NT = 20;
  static __device__ __forceinline__ const bfr* aptr(const P& p, const Ctx& c, int row, int kt, int nt) { return (const bfr*)(p.ACT + A_UC) + (size_t)row * 1280 + (nt >> 1) * 128 + kt * 64; }
  static __device__ __forceinline__ const bfr* bptr(const P& p, const Ctx& c, int n, int kt) { return p.W + WL_GATE + c.d * 655360 + (size_t)n * 128 + kt * 64; }
  static __device__ __forceinline__ void epi(const P& p, const Ctx& c, f32x4 (&acc)[4][4], int m0, int n0, int lane) {
    const bfr* UC = (const bfr*)(p.ACT + A_UC); unsigned* AB = (unsigned*)(p.ACT + A_AB);
    const float* gb = p.lru_gate_b + (size_t)(c.j * 2 + c.d) * 2 * 1280; const float* lam = p.lru_lam + (size_t)(c.j * 2 + c.d) * 1280;
    int chb = (n0 >> 6) * 32;
#pragma unroll
    for (int ni = 0; ni < 2; ni++) {
      int ch = chb + ni * 16 + (lane >> 4) * 4;
      float cl[4], br[4], bi[4];
#pragma unroll
      for (int q = 0; q < 4; q++) { cl[q] = p.CL[(size_t)(c.j * 2 + c.d) * 1280 + ch + q]; br[q] = gb[ch + q]; bi[q] = gb[1280 + ch + q]; }
#pragma unroll
      for (int mi = 0; mi < 4; mi++) {
        int row = m0 + mi * 16 + (lane & 15);
        uint2 u = *(const uint2*)(UC + (size_t)row * 1280 + ch);
        float uc[4] = {blo(u.x), bhi(u.x), blo(u.y), bhi(u.y)};
        unsigned o[4];
#pragma unroll
        for (int q = 0; q < 4; q++) {
          float r = sigm(acc[ni][mi][q] + br[q]), ig = sigm(acc[ni + 2][mi][q] + bi[q]);
          float la = -cl[q] * r; float oma = 1.f - __expf(la); float bb = __builtin_amdgcn_sqrtf(oma * (2.f - oma)) * ig * uc[q];
          o[q] = (((unsigned)f2b(oma)) << 16) | (unsigned)f2b(bb);
        }
        *(uint4*)(AB + (size_t)row * 1280 + ch) = uint4{o[0], o[1], o[2], o[3]};
      }
    }
  } };
struct G_LruOut { static constexpr int KT = 20, NT = 8;
  static __device__ __forceinline__ const bfr* aptr(const P& p, const Ctx& c, int row, int kt, int nt) { return (const bfr*)(p.ACT + A_Z) + (size_t)row * 1280 + kt * 64; }
  static __device__ __forceinline__ const bfr* bptr(const P& p, const Ctx& c, int n, int kt) { return p.W + WL_OUT + (size_t)n * 1280 + kt * 64; }
  static __device__ __forceinline__ void epi(const P& p, const Ctx& c, f32x4 (&acc)[4][4], int m0, int n0, int lane) { epi_resid(p, c, acc, m0, n0, lane); } };
struct G_MlIn { static constexpr int KT = 16, NT = 33;
  static __device__ __forceinline__ const bfr* aptr(const P& p, const Ctx& c, int row, int kt, int nt) { return p.H + (size_t)row * 1024 + kt * 64; }
  static __device__ __forceinline__ const bfr* bptr(const P& p, const Ctx& c, int n, int kt) { return p.W + (size_t)n * 1024 + kt * 64; }
  static __device__ __forceinline__ void epi(const P& p, const Ctx& c, f32x4 (&acc)[4][4], int m0, int n0, int lane) {
    bfr* QKV = (bfr*)(p.ACT + A_QKV); float* GT = (float*)(p.ACT + A_GATE);
#pragma unroll
    for (int ni = 0; ni < 4; ni++)
#pragma unroll
      for (int mi = 0; mi < 4; mi++) {
        int row = m0 + mi * 16 + (lane & 15), n = n0 + ni * 16 + (lane >> 4) * 4;
        if (n < 4096) store4b(QKV + (size_t)row * 4096 + n, acc[ni][mi]);
        else if (n < 4128) *(float4*)(GT + (size_t)row * 32 + (n - 4096)) = float4{acc[ni][mi][0], acc[ni][mi][1], acc[ni][mi][2], acc[ni][mi][3]};
      }
  } };
struct G_MlZ { static constexpr int KT = 16, NT = 16;
  static __device__ __forceinline__ const bfr* aptr(const P& p, const Ctx& c, int row, int kt, int nt) { return p.H + (size_t)row * 1024 + kt * 64; }
  static __device__ __forceinline__ const bfr* bptr(const P& p, const Ctx& c, int n, int kt) { return p.W + WM_Z + (size_t)n * 1024 + kt * 64; }
  static __device__ __forceinline__ void epi(const P& p, const Ctx& c, f32x4 (&acc)[4][4], int m0, int n0, int lane) {
    bfr* HS = (bfr*)(p.ACT + A_HS); const float* RS = (const float*)(p.ACT + A_RSTD); const float* ng = p.ml_norm_g + (size_t)c.j * 2048;
#pragma unroll
    for (int ni = 0; ni < 4; ni++)
#pragma unroll
      for (int mi = 0; mi < 4; mi++) {
        int row = m0 + mi * 16 + (lane & 15), n = n0 + ni * 16 + (lane >> 4) * 4;
        bfr* hp = HS + (size_t)row * 2048 + n; uint2 u = *(const uint2*)hp; float rs = RS[(size_t)row * 8 + (n >> 8)];
        float4 g4 = *(const float4*)(ng + n);
        f32x4 o;
        o[0] = blo(u.x) * rs * g4.x * siluf(acc[ni][mi][0]); o[1] = bhi(u.x) * rs * g4.y * siluf(acc[ni][mi][1]);
        o[2] = blo(u.y) * rs * g4.z * siluf(acc[ni][mi][2]); o[3] = bhi(u.y) * rs * g4.w * siluf(acc[ni][mi][3]);
        store4b(hp, o);
      }
  } };
struct G_MlOut { static constexpr int KT = 32, NT = 8;
  static __device__ __forceinline__ const bfr* aptr(const P& p, const Ctx& c, int row, int kt, int nt) { return (const bfr*)(p.ACT + A_HS) + (size_t)row * 2048 + kt * 64; }
  static __device__ __forceinline__ const bfr* bptr(const P& p, const Ctx& c, int n, int kt) { return p.W + WM_OUT + (size_t)n * 2048 + kt * 64; }
  static __device__ __forceinline__ void epi(const P& p, const Ctx& c, f32x4 (&acc)[4][4], int m0, int n0, int lane) { epi_resid(p, c, acc, m0, n0, lane); } };
struct G_R7In { static constexpr int KT = 32, NT = 34;
  static __device__ __forceinline__ const bfr* aptr(const P& p, const Ctx& c, int row, int kt, int nt) {
    if (kt < 16) return p.H + (size_t)row * 1024 + kt * 64;
    int q = (kt - 16) >> 2; int b = row / BT_, o = row - b * BT_; int nr;
    if (o < 256) { if (q < 2) { if (o < 1) return nullptr; nr = row - 1; } else { if (o >= 255) return nullptr; nr = row + 1; } }
    else { int t = o - 256, col = t & 63, gr = t >> 6;
      if (q == 0) { if (col == 0) return nullptr; nr = row - 1; }
      else if (q == 1) { if (col == 63) return nullptr; nr = row + 1; }
      else if (q == 2) { if (gr == 0) return nullptr; nr = row - 64; }
      else { if (gr == 255) return nullptr; nr = row + 64; } }
    return p.H + (size_t)nr * 1024 + (kt - 16) * 64; }
  static __device__ __forceinline__ const bfr* bptr(const P& p, const Ctx& c, int n, int kt) { return p.W + (size_t)n * 2048 + kt * 64; }
  static __device__ __forceinline__ void epi(const P& p, const Ctx& c, f32x4 (&acc)[4][4], int m0, int n0, int lane) {
    bfr* RK = (bfr*)(p.ACT + A_RKVZ); bfr* WMb = (bfr*)(p.ACT + A_WM); bfr* AMb = (bfr*)(p.ACT + A_AM);
#pragma unroll
    for (int ni = 0; ni < 4; ni++)
#pragma unroll
      for (int mi = 0; mi < 4; mi++) {
        int row = m0 + mi * 16 + (lane & 15), n = n0 + ni * 16 + (lane >> 4) * 4;
        if (n < 4096) store4b(RK + (size_t)row * 4096 + n, acc[ni][mi]);
        else if (n < 4224) { f32x4 t;
#pragma unroll
          for (int q = 0; q < 4; q++) t[q] = tanhf(acc[ni][mi][q]); store4b(WMb + (size_t)row * 128 + (n - 4096), t); }
        else store4b(AMb + (size_t)row * 128 + (n - 4224), acc[ni][mi]);
      }
  } };
struct G_R7Out { static constexpr int KT = 16, NT = 8;
  static __device__ __forceinline__ const bfr* aptr(const P& p, const Ctx& c, int row, int kt, int nt) { return p.H + (size_t)row * 1024 + kt * 64; }
  static __device__ __forceinline__ const bfr* bptr(const P& p, const Ctx& c, int n, int kt) { return p.W + WR_OUT + (size_t)n * 1024 + kt * 64; }
  static __device__ __forceinline__ void epi(const P& p, const Ctx& c, f32x4 (&acc)[4][4], int m0, int n0, int lane) { epi_resid(p, c, acc, m0, n0, lane); } };


namespace pg8 {
#define PG8_LAS __attribute__((address_space(3)))
constexpr int BM = 256, BK = 64, HALF = 128, HTB = HALF * BK * 2, NXCD = 8, WGM = 8;
__device__ __forceinline__ int lds_byte(int r, int c) { const int st = (r >> 4) * 2 + (c >> 5), rr = r & 15, cc = c & 31, ob = rr * 64 + cc * 2; return st * 1024 + (ob ^ (((ob >> 9) & 1) << 5)); }
__device__ __forceinline__ void stage_rc(int b, int& R, int& C) { const int st = b / 1024, sb = b % 1024, swz = sb ^ (((sb >> 9) & 1) << 5); R = (st >> 1) * 16 + swz / 64; C = (st & 1) * 32 + (swz % 64) / 2; }
struct Unit { int pm, pn; };
struct Gemm { const bfr* A; const bfr* Bt; int M, N, K; };
struct StaticOrder {
  int nM, nN, nwg, G, c;
  __device__ void init(int M, int N, int G_, int c_) { nM = M / BM; nN = N / BM; nwg = nM * nN; G = G_; c = c_; }
  __device__ bool next(int i, Unit& u) const {
    const long L = (long)i * G + c; if (L >= nwg) return false;
    int wgid = (int)L; { const int q = nwg / NXCD, r = nwg % NXCD, xcd = wgid % NXCD, off = wgid / NXCD; wgid = (xcd < r ? xcd * (q + 1) : r * (q + 1) + (xcd - r) * q) + off; }
    const int nig = WGM * nN, gid = wgid / nig, fm = gid * WGM, gsz = (nM - fm) < WGM ? (nM - fm) : WGM;
    u.pm = fm + ((wgid % nig) % gsz); u.pn = (wgid % nig) / gsz; return true;
  }
};
template <class Epi>
__device__ __forceinline__ void gemm_phase(PG8_LAS unsigned char* lds, const Gemm g, const StaticOrder& S, const Epi& E) {
  const int tid = ltid(), wid = __builtin_amdgcn_readfirstlane(tid >> 6), lane = tid & 63, wr = wid >> 2, wc = wid & 3, fr = lane & 15, fq = lane >> 4;
  const int K = g.K, nt = K / BK;
  unsigned voffA[2], voffB[2];
#pragma unroll
  for (int i = 0; i < 2; ++i) { int R, C; stage_rc(tid * 16 + i * 8192, R, C); voffA[i] = (unsigned)(R * K + C) * 2u; voffB[i] = voffA[i]; }
  const size_t kstep = (size_t)(BK * 2);
  const size_t hstep = (size_t)HALF * K * 2;
  const size_t tstep = 2 * hstep;
  const unsigned ldsw = (unsigned)wid * 1024u;
  const int aoff = lds_byte(wr * 64 + fr, fq * 8), boff = lds_byte(wc * 32 + fr, fq * 8);
#define PG8_SA(b, h) (((b) * 2 + (h)) * HTB)
#define PG8_SB(b, h) ((4 + (b) * 2 + (h)) * HTB)
#define PG8_STAGE(bufoff, gbase, voff) do { _Pragma("unroll") for (int _i = 0; _i < 2; ++_i) \
    __builtin_amdgcn_global_load_lds((const unsigned*)((const char*)(gbase) + (voff)[_i]), (PG8_LAS unsigned*)(lds + (bufoff) + ldsw + _i * 8192), 16, 0, 0); } while (0)
#define PG8_LDA(dst, b, h) do { _Pragma("unroll") for (int m = 0; m < 4; ++m) _Pragma("unroll") for (int k = 0; k < 2; ++k) dst[m][k] = *(const PG8_LAS bf16x8*)(lds + PG8_SA(b, h) + aoff + m * 2048 + k * 1024); } while (0)
#define PG8_LDB(dst, b, h) do { _Pragma("unroll") for (int n = 0; n < 2; ++n) _Pragma("unroll") for (int k = 0; k < 2; ++k) dst[n][k] = *(const PG8_LAS bf16x8*)(lds + PG8_SB(b, h) + boff + n * 2048 + k * 1024); } while (0)
#define PG8_MMA(ai, bj, At, Bt) do { __builtin_amdgcn_s_setprio(1); _Pragma("unroll") for (int m = 0; m < 4; ++m) _Pragma("unroll") for (int n = 0; n < 2; ++n) _Pragma("unroll") for (int k = 0; k < 2; ++k) \
    acc[ai][bj][m][n] = __builtin_amdgcn_mfma_f32_16x16x32_bf16(Bt[n][k], At[m][k], acc[ai][bj][m][n], 0, 0, 0); __builtin_amdgcn_s_setprio(0); } while (0)
#define PG8_WAIT_V(n) asm volatile("s_waitcnt vmcnt(" #n ")" ::: "memory")
#define PG8_WAIT_L(n) asm volatile("s_waitcnt lgkmcnt(" #n ")" ::: "memory")
#define PG8_BAR __builtin_amdgcn_s_barrier()
#define PG8_SCHED __builtin_amdgcn_sched_barrier(0)
  Unit cur, nxt; int ui = 0;
  if (!S.next(0, cur)) return;
  f32x4 acc[2][2][4][2];
#pragma unroll
  for (int a = 0; a < 2; ++a)
#pragma unroll
    for (int b = 0; b < 2; ++b)
#pragma unroll
      for (int m = 0; m < 4; ++m)
#pragma unroll
        for (int n = 0; n < 2; ++n) acc[a][b][m][n] = (f32x4){0.f, 0.f, 0.f, 0.f};
  bf16x8 At[4][2], B0[2][2], B1[2][2];
  const char* cA = (const char*)g.A + (size_t)cur.pm * tstep; const char* cB = (const char*)g.Bt + (size_t)cur.pn * tstep;
  PG8_STAGE(PG8_SB(0, 0), cB, voffB); PG8_STAGE(PG8_SA(0, 0), cA, voffA); PG8_STAGE(PG8_SB(0, 1), cB + hstep, voffB); PG8_STAGE(PG8_SA(0, 1), cA + hstep, voffA);
  if (wr == 1) PG8_BAR;
  PG8_WAIT_V(4); PG8_BAR;
  PG8_STAGE(PG8_SB(1, 0), cB + kstep, voffB); PG8_STAGE(PG8_SA(1, 0), cA + kstep, voffA); PG8_STAGE(PG8_SB(1, 1), cB + hstep + kstep, voffB);
  PG8_WAIT_V(6); PG8_BAR;
  for (;;) {
    const bool has_next = S.next(ui + 1, nxt);
    const char* nA = has_next ? (const char*)g.A + (size_t)nxt.pm * tstep : cA; const char* nB = has_next ? (const char*)g.Bt + (size_t)nxt.pn * tstep : cB;
    for (int t = 0; t < nt; t += 2) {
      const bool last = (t == nt - 2);
      const char* a1 = cA + (size_t)(t + 1) * kstep;
      const char* a2 = last ? nA : cA + (size_t)(t + 2) * kstep; const char* b2 = last ? nB : cB + (size_t)(t + 2) * kstep;
      const char* a3 = a2 + kstep; const char* b3 = b2 + kstep;
      PG8_LDB(B0, 0, 0); PG8_SCHED; PG8_LDA(At, 0, 0); PG8_STAGE(PG8_SA(1, 1), a1 + hstep, voffA);
      PG8_WAIT_L(8); PG8_BAR; PG8_WAIT_L(0); PG8_MMA(0, 0, At, B0); PG8_BAR; PG8_SCHED;
      PG8_LDB(B1, 0, 1); PG8_STAGE(PG8_SB(0, 0), b2, voffB);
      PG8_BAR; PG8_WAIT_L(0); PG8_MMA(0, 1, At, B1); PG8_BAR;
      PG8_LDA(At, 0, 1); PG8_STAGE(PG8_SA(0, 0), a2, voffA);
      PG8_BAR; PG8_WAIT_L(0); PG8_MMA(1, 0, At, B0); PG8_BAR; PG8_SCHED;
      PG8_STAGE(PG8_SB(0, 1), b2 + hstep, voffB);
      PG8_WAIT_V(6); PG8_BAR; PG8_MMA(1, 1, At, B1); PG8_BAR;
      PG8_LDB(B0, 1, 0); PG8_SCHED; PG8_LDA(At, 1, 0); PG8_STAGE(PG8_SA(0, 1), a2 + hstep, voffA);
      PG8_WAIT_L(8); PG8_BAR; PG8_WAIT_L(0); PG8_MMA(0, 0, At, B0); PG8_BAR; PG8_SCHED;
      PG8_LDB(B1, 1, 1); PG8_STAGE(PG8_SB(1, 0), b3, voffB);
      PG8_BAR; PG8_WAIT_L(0); PG8_MMA(0, 1, At, B1); PG8_BAR;
      PG8_LDA(At, 1, 1); PG8_STAGE(PG8_SA(1, 0), a3, voffA);
      PG8_BAR; PG8_WAIT_L(0); PG8_MMA(1, 0, At, B0); PG8_BAR; PG8_SCHED;
      PG8_STAGE(PG8_SB(1, 1), b3 + hstep, voffB);
      PG8_WAIT_V(6); PG8_BAR; PG8_MMA(1, 1, At, B1); PG8_BAR;
    }
    E(acc, cur, wr, wc, fr, fq);
    if (!has_next) break;
#pragma unroll
    for (int a = 0; a < 2; ++a)
#pragma unroll
      for (int b = 0; b < 2; ++b)
#pragma unroll
        for (int m = 0; m < 4; ++m)
#pragma unroll
          for (int n = 0; n < 2; ++n) acc[a][b][m][n] = (f32x4){0.f, 0.f, 0.f, 0.f};
    cur = nxt; cA = nA; cB = nB; ++ui;
  }
  PG8_WAIT_V(0);
  if (wr == 0) PG8_BAR;
  PG8_BAR;
#undef PG8_SA
#undef PG8_SB
#undef PG8_STAGE
#undef PG8_LDA
#undef PG8_LDB
#undef PG8_MMA
#undef PG8_WAIT_V
#undef PG8_WAIT_L
#undef PG8_BAR
#undef PG8_SCHED
}
}

template <class F> struct EpiAd {
  F f;
  __device__ __forceinline__ void operator()(const f32x4 (&acc)[2][2][4][2], const pg8::Unit& u, int wr, int wc, int fr, int fq) const {
#pragma unroll
    for (int ai = 0; ai < 2; ++ai)
#pragma unroll
      for (int m = 0; m < 4; ++m) { const int row = u.pm * 256 + ai * 128 + wr * 64 + m * 16 + fr;
#pragma unroll
        for (int bj = 0; bj < 2; ++bj)
#pragma unroll
          for (int n = 0; n < 2; ++n) f(row, u.pn * 256 + bj * 128 + wc * 32 + n * 16 + 4 * fq, acc[ai][bj][m][n]); }
  }
};
template <class F> __device__ __forceinline__ void big_gemm(char* smem, const bfr* A, const bfr* Bt, int N, int K, F f) {
  pg8::Gemm g; g.A = A; g.Bt = Bt; g.M = R_; g.N = N; g.K = K;
  pg8::StaticOrder S; S.init(R_, N, (int)gridDim.x, (int)blockIdx.x);
  EpiAd<F> E{f};
  pg8::gemm_phase(( __attribute__((address_space(3))) unsigned char*)smem, g, S, E);
}
struct F_LruIn { char* ACT; __device__ __forceinline__ void operator()(int row, int n, f32x4 v) const {
  bfr* dst = n < 1280 ? (bfr*)(ACT + A_U) + (size_t)row * 1280 + n : (bfr*)(ACT + A_Z) + (size_t)row * 1280 + (n - 1280); store4b(dst, v); } };
struct F_Resid { float* Xx; float* Xc; const float* MODg; int wc; __device__ __forceinline__ void operator()(int row, int n, f32x4 v) const {
  int b = row / BT_, o = row - b * BT_; bool isc = o < 256; if (isc && !wc) return;
  float* xr = isc ? Xc + (size_t)(b * 256 + o) * 1024 : Xx + (size_t)(b * 16384 + o - 256) * 1024; const float* g = MODg + (size_t)(isc ? 2 : b) * 3072 + 2048;
  float4 xv = *(float4*)(xr + n); float4 gg = *(const float4*)(g + n);
  xv.x += gg.x * v[0]; xv.y += gg.y * v[1]; xv.z += gg.z * v[2]; xv.w += gg.w * v[3]; *(float4*)(xr + n) = xv; } };
struct F_MlIn { char* ACT; __device__ __forceinline__ void operator()(int row, int n, f32x4 v) const {
  if (n < 4096) store4b((bfr*)(ACT + A_QKV) + (size_t)row * 4096 + n, v);
  else if (n < 4128) *(float4*)((float*)(ACT + A_GATE) + (size_t)row * 32 + (n - 4096)) = float4{v[0], v[1], v[2], v[3]}; } };
struct F_MlZ { char* ACT; const float* ng; __device__ __forceinline__ void operator()(int row, int n, f32x4 v) const {
  bfr* hp = (bfr*)(ACT + A_HS) + (size_t)row * 2048 + n; uint2 u = *(const uint2*)hp; float rs = ((const float*)(ACT + A_RSTD))[(size_t)row * 8 + (n >> 8)];
  float4 g4 = *(const float4*)(ng + n); f32x4 o;
  o[0] = blo(u.x) * rs * g4.x * siluf(v[0]); o[1] = bhi(u.x) * rs * g4.y * siluf(v[1]); o[2] = blo(u.y) * rs * g4.z * siluf(v[2]); o[3] = bhi(u.y) * rs * g4.w * siluf(v[3]);
  store4b(hp, o); } };
struct F_R7In { char* ACT; __device__ __forceinline__ void operator()(int row, int n, f32x4 v) const {
  if (n < 4096) store4b((bfr*)(ACT + A_RKVZ) + (size_t)row * 4096 + n, v);
  else if (n < 4224) { f32x4 t;
#pragma unroll
    for (int q = 0; q < 4; q++) t[q] = tanhf(v[q]);
    store4b((bfr*)(ACT + A_WM) + (size_t)row * 128 + (n - 4096), t); }
  else store4b((bfr*)(ACT + A_AM) + (size_t)row * 128 + (n - 4224), v); } };

template <class G> __device__ __forceinline__ void gemm_phase(const P& p, const Ctx& c, char* smem) {
  const int total = 130 * G::NT;
  for (int it = blockIdx.x; it < total; it += gridDim.x) gemm_tile<G>(p, c, it / G::NT, it % G::NT, smem);
}

#define R7_Y2 ((bfr*)p.H + (size_t)64 * 26 * 16384)
template <class G> __device__ __forceinline__ void gemm_phase_k2(const P& p, const Ctx& c, char* smem) {
  const int tid = ltid(), lane = tid & 63, wid = tid >> 6, wm = wid & 3, wn = wid >> 2;
  bfr* sA = (bfr*)smem; bfr* sB = sA + 2 * 256 * LDSS;
  const int lr = tid >> 3, lc = tid & 7;
  const int total = 130 * G::NT;
  uint4 a00, a01, a02, a03, a10, a11, a12, a13, b00, b01, b10, b11;
#define GK2_LA(i_, R0, R1) { R0 = *(const uint4*)(G::aptr(p, c, mt_ * 256 + lr + 64 * (i_), 0, nt_) + lc * 8); R1 = *(const uint4*)(G::aptr(p, c, mt_ * 256 + lr + 64 * (i_), 1, nt_) + lc * 8); }
#define GK2_LB(i_, R0, R1) { R0 = *(const uint4*)(G::bptr(p, c, nt_ * 128 + lr + 64 * (i_), 0) + lc * 8); R1 = *(const uint4*)(G::bptr(p, c, nt_ * 128 + lr + 64 * (i_), 1) + lc * 8); }
#define GK2_LOAD(it_) { const int mt_ = (it_) / G::NT, nt_ = (it_) % G::NT; GK2_LA(0, a00, a10) GK2_LA(1, a01, a11) GK2_LA(2, a02, a12) GK2_LA(3, a03, a13) GK2_LB(0, b00, b10) GK2_LB(1, b01, b11) }
#define GK2_SA(i_, R0, R1) { *(uint4*)(sA + (lr + 64 * (i_)) * LDSS + lc * 8) = R0; *(uint4*)(sA + (256 + lr + 64 * (i_)) * LDSS + lc * 8) = R1; }
#define GK2_SB(i_, R0, R1) { *(uint4*)(sB + (lr + 64 * (i_)) * LDSS + lc * 8) = R0; *(uint4*)(sB + (128 + lr + 64 * (i_)) * LDSS + lc * 8) = R1; }
  int it = xcd_swz();
  if (it < total) GK2_LOAD(it)
  while (it < total) {
    const int mt = it / G::NT, nt = it % G::NT;
    GK2_SA(0, a00, a10) GK2_SA(1, a01, a11) GK2_SA(2, a02, a12) GK2_SA(3, a03, a13) GK2_SB(0, b00, b10) GK2_SB(1, b01, b11)
    __syncthreads();
    const int itn = it + gridDim.x;
    if (itn < total) GK2_LOAD(itn)
    f32x4 acc[4][4];
#pragma unroll
    for (int a = 0; a < 4; a++)
#pragma unroll
      for (int b = 0; b < 4; b++) acc[a][b] = f32x4{0.f, 0.f, 0.f, 0.f};
#pragma unroll
    for (int buf = 0; buf < 2; buf++)
#pragma unroll
      for (int ks = 0; ks < 2; ks++) {
        bf16x8 af[4], bf[4];
#pragma unroll
        for (int i = 0; i < 4; i++) {
          af[i] = *(const bf16x8*)(sA + (buf * 256 + wm * 64 + i * 16 + (lane & 15)) * LDSS + ks * 32 + (lane >> 4) * 8);
          bf[i] = *(const bf16x8*)(sB + (buf * 128 + wn * 64 + i * 16 + (lane & 15)) * LDSS + ks * 32 + (lane >> 4) * 8);
        }
#pragma unroll
        for (int n = 0; n < 4; n++)
#pragma unroll
          for (int m = 0; m < 4; m++) acc[n][m] = __builtin_amdgcn_mfma_f32_16x16x32_bf16(bf[n], af[m], acc[n][m], 0, 0, 0);
      }
    G::epi(p, c, acc, mt * 256 + wm * 64, nt * 128 + wn * 64, lane);
    __syncthreads();
    it = itn;
  }
#undef GK2_LOAD
#undef GK2_LA
#undef GK2_LB
#undef GK2_SA
#undef GK2_SB
}

__device__ __forceinline__ void ph_pre(const P& p, char* smem) {
  float* sm = (float*)smem; const int tid = ltid();
  const int nprep = prep_count(0), ngemv = 192, ncopy = 4160;
  if (blockIdx.x == 0) for (int i = tid; i < 5120; i += 512) p.CL[i] = 8.f * softplusf(-p.lru_lam[i]);
  for (int it = blockIdx.x; it < nprep + ngemv + ncopy; it += gridDim.x) {
    if (it < nprep) { prep_item(p, 0, it, sm); continue; }
    int i2 = it - nprep;
    if (i2 < ngemv) {
      int l = i2 / 48, cgp = i2 % 48;
      for (int i = tid; i < 3072; i += 512) { int cnd = i >> 10, k = i & 1023; float v = cnd == 0 ? p.c[k] : cnd == 1 ? p.c[1024 + k] : p.c_ctx[k]; sm[i] = siluf(v); }
      __syncthreads();
      int kq = tid >> 6, col = cgp * 64 + (tid & 63); const float* w = p.mod_w + (size_t)l * 1024 * 3072 + col;
      float a0 = 0.f, a1 = 0.f, a2 = 0.f;
      for (int k = kq * 128; k < kq * 128 + 128; k++) { float wv = w[(size_t)k * 3072]; a0 += sm[k] * wv; a1 += sm[1024 + k] * wv; a2 += sm[2048 + k] * wv; }
      float* red = sm + 3072; red[tid * 3] = a0; red[tid * 3 + 1] = a1; red[tid * 3 + 2] = a2;
      __syncthreads();
      if (tid < 64) { float bias = p.mod_b[(size_t)l * 3072 + col];
        for (int cnd = 0; cnd < 3; cnd++) { float s = bias; for (int q = 0; q < 8; q++) s += red[(q * 64 + tid) * 3 + cnd]; p.MOD[(size_t)(l * 3 + cnd) * 3072 + col] = s; } }
      __syncthreads();
      continue;
    }
    i2 -= ngemv;
    for (int q = 0; q < 4; q++) { int idx = i2 * 2048 + q * 512 + tid; int row = idx >> 8, c4 = idx & 255; int b = row / BT_, o = row - b * BT_;
      if (o < 256) ((float4*)p.Xc)[(size_t)(b * 256 + o) * 256 + c4] = ((const float4*)p.ctx)[(size_t)(b * 256 + o) * 256 + c4];
      else ((float4*)p.Xx)[(size_t)(b * 16384 + o - 256) * 256 + c4] = ((const float4*)p.x)[(size_t)(b * 16384 + o - 256) * 256 + c4]; }
  }
}
__device__ __forceinline__ void ph_norm(const P& p, int layer, char* smem) {
  const int tid = ltid(), lane = tid & 63, wid = tid >> 6;
  const int nprep = layer > 0 ? prep_count(layer) : 0; const int kind = layer % 3;
  const int nzero = kind == 1 ? 8320 : 0;
  (void)nzero;
  for (int it = blockIdx.x; it < nprep + 4160; it += gridDim.x) {
    if (it < nprep) { prep_item(p, layer, it, (float*)smem); continue; }
    int row = (it - nprep) * 8 + wid; int mo; const float* xr = xrowp(p, row, mo);
    float4 v[4]; float ss = 0.f;
#pragma unroll
    for (int i = 0; i < 4; i++) { v[i] = *(const float4*)(xr + lane * 4 + 256 * i); ss += v[i].x * v[i].x + v[i].y * v[i].y + v[i].z * v[i].z + v[i].w * v[i].w; }
    ss = wsum(ss); float rs = rsqrtf(ss * (1.f / 1024.f) + 1e-6f);
    const float* g = p.norm_g + (size_t)layer * 1024; const float* md = p.MOD + (size_t)(layer * 3 + mo) * 3072;
#pragma unroll
    for (int i = 0; i < 4; i++) { int cidx = lane * 4 + 256 * i; float4 gg = *(const float4*)(g + cidx), sh = *(const float4*)(md + cidx), sc = *(const float4*)(md + 1024 + cidx);
      f32x4 o; o[0] = v[i].x * rs * gg.x * (1.f + sc.x) + sh.x; o[1] = v[i].y * rs * gg.y * (1.f + sc.y) + sh.y; o[2] = v[i].z * rs * gg.z * (1.f + sc.z) + sh.z; o[3] = v[i].w * rs * gg.w * (1.f + sc.w) + sh.w;
      store4b(p.H + (size_t)row * (kind == 2 ? 2048 : 1024) + cidx, o); }
  }
}
__device__ __forceinline__ void ph_r7_shift(const P& p) {
  for (int it = blockIdx.x; it < 8320; it += gridDim.x) {
    int idx = it * 512 + ltid(); int row = idx >> 7, c8 = idx & 127, q = c8 >> 5;
    int b = row / BT_, o = row - b * BT_; int nr = -1;
    if (o < 256) { if (q < 2) { if (o >= 1) nr = row - 1; } else { if (o < 255) nr = row + 1; } }
    else { int t = o - 256, col = t & 63, gr = t >> 6;
      if (q == 0) { if (col != 0) nr = row - 1; } else if (q == 1) { if (col != 63) nr = row + 1; }
      else if (q == 2) { if (gr != 0) nr = row - 64; } else { if (gr != 255) nr = row + 64; } }
    uint4 v = nr >= 0 ? *(const uint4*)(p.H + (size_t)nr * 2048 + c8 * 8) : uint4{0u, 0u, 0u, 0u};
    *(uint4*)(p.H + (size_t)row * 2048 + 1024 + c8 * 8) = v;
  }
}
__device__ __forceinline__ void ph_final(const P& p) {
  const int lane = ltid() & 63, wid = ltid() >> 6;
  for (int it = blockIdx.x; it < 4096; it += gridDim.x) {
    float* xr = p.Xx + (size_t)(it * 8 + wid) * 1024; float4 v[4]; float ss = 0.f;
#pragma unroll
    for (int i = 0; i < 4; i++) { v[i] = *(const float4*)(xr + lane * 4 + 256 * i); ss += v[i].x * v[i].x + v[i].y * v[i].y + v[i].z * v[i].z + v[i].w * v[i].w; }
    ss = wsum(ss); float rs = rsqrtf(ss * (1.f / 1024.f) + 1e-6f);
#pragma unroll
    for (int i = 0; i < 4; i++) { int cidx = lane * 4 + 256 * i; float4 gg = *(const float4*)(p.final_g + cidx);
      *(float4*)(xr + cidx) = float4{v[i].x * rs * gg.x, v[i].y * rs * gg.y, v[i].z * rs * gg.z, v[i].w * rs * gg.w}; }
  }
}
__device__ __forceinline__ void ph_lru_conv(const P& p, int j) {
  const bfr* U = (const bfr*)(p.ACT + A_U); bfr* UC = (bfr*)(p.ACT + A_UC);
  const float* cw = p.lru_conv_w + (size_t)j * 4 * 1280; const float* cb = p.lru_conv_b + (size_t)j * 1280;
  for (int it = blockIdx.x; it < 10400; it += gridDim.x) {
    int idx = it * 512 + ltid(); int row = idx / 160, cgp = idx % 160, ch = cgp * 8;
    int b = row / BT_, o = row - b * BT_; int s0 = o < 256 ? 0 : 256, e0 = o < 256 ? 256 : BT_;
    float acc[8];
#pragma unroll
    for (int e = 0; e < 8; e++) acc[e] = cb[ch + e];
#pragma unroll
    for (int t = 0; t < 4; t++) { int oo = o + t - 2; if (oo < s0 || oo >= e0) continue;
      uint4 u = *(const uint4*)(U + (size_t)(row + t - 2) * 1280 + ch); const float* w = cw + t * 1280 + ch;
      acc[0] += w[0] * blo(u.x); acc[1] += w[1] * bhi(u.x); acc[2] += w[2] * blo(u.y); acc[3] += w[3] * bhi(u.y);
      acc[4] += w[4] * blo(u.z); acc[5] += w[5] * bhi(u.z); acc[6] += w[6] * blo(u.w); acc[7] += w[7] * bhi(u.w); }
    *(uint4*)(UC + (size_t)row * 1280 + ch) = uint4{pk2(acc[0], acc[1]), pk2(acc[2], acc[3]), pk2(acc[4], acc[5]), pk2(acc[6], acc[7])};
  }
}
__device__ __forceinline__ void ph_lru_s1(const P& p, int d) {
  const unsigned* AB = (const unsigned*)(p.ACT + A_AB); float2* AGG = (float2*)(p.ACT + A_AGG);
  const int t = ltid();
  for (int it = blockIdx.x * 8 + (t >> 6); it < 2600; it += gridDim.x * 8) {
    int b = it / 1300, r = it % 1300, cc = r / 5, ch = (r % 5) * 256 + (t & 63) * 4;
    float P0 = 1.f, Q0 = 0.f, P1 = 1.f, Q1 = 0.f, P2 = 1.f, Q2 = 0.f, P3 = 1.f, Q3 = 0.f;
#pragma unroll 8
    for (int q = 0; q < 64; q++) { uint4 u = *(const uint4*)(AB + (size_t)rowmap(d, b, cc * 64 + q) * 1280 + ch);
      float a0 = 1.f - bhi(u.x), a1 = 1.f - bhi(u.y), a2 = 1.f - bhi(u.z), a3 = 1.f - bhi(u.w);
      P0 *= a0; Q0 = a0 * Q0 + blo(u.x); P1 *= a1; Q1 = a1 * Q1 + blo(u.y); P2 *= a2; Q2 = a2 * Q2 + blo(u.z); P3 *= a3; Q3 = a3 * Q3 + blo(u.w); }
    float4* ag = (float4*)(AGG + (size_t)(b * NCH_ + cc) * 1280 + ch); ag[0] = float4{P0, Q0, P1, Q1}; ag[1] = float4{P2, Q2, P3, Q3};
  }
}
__device__ __forceinline__ void ph_lru_s2(const P& p, char* smem) {
  const float2* AGG = (const float2*)(p.ACT + A_AGG); float* CAR = (float*)(p.ACT + A_CAR);
  float* sP = (float*)smem; float* sQ = sP + 512;
  const int tid = ltid(), chl = tid & 63, seg = tid >> 6;
  for (int it = blockIdx.x; it < 40; it += gridDim.x) {
    const int b = it / 20, ch = (it % 20) * 64 + chl; const int cb = seg * 33, ce = cb + 33 < NCH_ ? cb + 33 : NCH_;
    float Pp = 1.f, Q = 0.f;
#pragma unroll 11
    for (int cc = cb; cc < ce; cc++) { float2 a = AGG[(size_t)(b * NCH_ + cc) * 1280 + ch]; Pp *= a.x; Q = a.x * Q + a.y; }
    __syncthreads();
    sP[seg * 64 + chl] = Pp; sQ[seg * 64 + chl] = Q;
    __syncthreads();
    float h = 0.f;
    for (int s2 = 0; s2 < seg; s2++) h = sP[s2 * 64 + chl] * h + sQ[s2 * 64 + chl];
#pragma unroll 11
    for (int cc = cb; cc < ce; cc++) { size_t o = (size_t)(b * NCH_ + cc) * 1280 + ch; float2 a = AGG[o]; CAR[o] = h; h = a.x * h + a.y; }
  }
}
__device__ __forceinline__ void ph_lru_s3(const P& p, int d) {
  const unsigned* AB = (const unsigned*)(p.ACT + A_AB); const float* CAR = (const float*)(p.ACT + A_CAR);
  bfr* HF = (bfr*)(p.ACT + A_HF); bfr* Z = (bfr*)(p.ACT + A_Z);
  const int t = ltid();
  for (int it = blockIdx.x * 8 + (t >> 6); it < 2600; it += gridDim.x * 8) {
    int b = it / 1300, r = it % 1300, cc = r / 5, ch = (r % 5) * 256 + (t & 63) * 4;
    float4 h = *(const float4*)(CAR + (size_t)(b * NCH_ + cc) * 1280 + ch);
#pragma unroll 8
    for (int q = 0; q < 64; q++) { size_t o = (size_t)rowmap(d, b, cc * 64 + q) * 1280 + ch; uint4 u = *(const uint4*)(AB + o);
      h.x = (1.f - bhi(u.x)) * h.x + blo(u.x); h.y = (1.f - bhi(u.y)) * h.y + blo(u.y); h.z = (1.f - bhi(u.z)) * h.z + blo(u.z); h.w = (1.f - bhi(u.w)) * h.w + blo(u.w);
      if (d == 0) *(uint2*)(HF + o) = uint2{pk2(h.x, h.y), pk2(h.z, h.w)};
      else { uint2 hf = *(const uint2*)(HF + o), zz = *(const uint2*)(Z + o);
        *(uint2*)(Z + o) = uint2{pk2((blo(hf.x) + h.x) * siluf(blo(zz.x)), (bhi(hf.x) + h.y) * siluf(bhi(zz.x))), pk2((blo(hf.y) + h.z) * siluf(blo(zz.y)), (bhi(hf.y) + h.w) * siluf(bhi(zz.y)))}; } }
  }
}
__device__ __forceinline__ void ph_ml_stat(const P& p) {
  const bfr* HS = (const bfr*)(p.ACT + A_HS); float* RS = (float*)(p.ACT + A_RSTD);
  const int lane = ltid() & 63, wid = ltid() >> 6;
  for (int it = blockIdx.x; it < 4160; it += gridDim.x) {
    int row = it * 8 + wid; const bfr* hp = HS + (size_t)row * 2048 + lane * 32; float ss = 0.f;
#pragma unroll
    for (int i = 0; i < 4; i++) { uint4 u = *(const uint4*)(hp + i * 8); float a;
      a = blo(u.x); ss += a * a; a = bhi(u.x); ss += a * a; a = blo(u.y); ss += a * a; a = bhi(u.y); ss += a * a;
      a = blo(u.z); ss += a * a; a = bhi(u.z); ss += a * a; a = blo(u.w); ss += a * a; a = bhi(u.w); ss += a * a; }
    ss += __shfl_xor(ss, 1); ss += __shfl_xor(ss, 2); ss += __shfl_xor(ss, 4);
    if ((lane & 7) == 0) RS[(size_t)row * 8 + (lane >> 3)] = rsqrtf(ss * (1.f / 256.f) + 1e-6f);
  }
}
__device__ __forceinline__ void ph_r7_fin(const P& p, int j) {
  bfr* Y = (bfr*)(p.ACT + A_Y); const bfr* RK = (const bfr*)(p.ACT + A_RKVZ); const float* BON = (const float*)(p.ACT + A_BON);
  const float* lg = p.r7_ln_g + (size_t)j * 1024; const float* lb = p.r7_ln_b + (size_t)j * 1024;
  const int lane = ltid() & 63, wid = ltid() >> 6;
  for (int it = blockIdx.x; it < 4160; it += gridDim.x) {
    int row = it * 8 + wid, ch = lane * 16, hd = lane >> 2;
    float y[16], v[16], z[16];
#pragma unroll
    for (int i = 0; i < 2; i++) {
      uint4 u = *(const uint4*)(Y + (size_t)row * 1024 + ch + i * 8); const uint4 u2 = *(const uint4*)(R7_Y2 + (size_t)row * 1024 + ch + i * 8);
      y[i * 8 + 0] = blo(u.x) + blo(u2.x); y[i * 8 + 1] = bhi(u.x) + bhi(u2.x); y[i * 8 + 2] = blo(u.y) + blo(u2.y); y[i * 8 + 3] = bhi(u.y) + bhi(u2.y); y[i * 8 + 4] = blo(u.z) + blo(u2.z); y[i * 8 + 5] = bhi(u.z) + bhi(u2.z); y[i * 8 + 6] = blo(u.w) + blo(u2.w); y[i * 8 + 7] = bhi(u.w) + bhi(u2.w);
      u = *(const uint4*)(RK + (size_t)row * 4096 + 2048 + ch + i * 8);
      v[i * 8 + 0] = blo(u.x); v[i * 8 + 1] = bhi(u.x); v[i * 8 + 2] = blo(u.y); v[i * 8 + 3] = bhi(u.y); v[i * 8 + 4] = blo(u.z); v[i * 8 + 5] = bhi(u.z); v[i * 8 + 6] = blo(u.w); v[i * 8 + 7] = bhi(u.w);
      u = *(const uint4*)(RK + (size_t)row * 4096 + 3072 + ch + i * 8);
      z[i * 8 + 0] = blo(u.x); z[i * 8 + 1] = bhi(u.x); z[i * 8 + 2] = blo(u.y); z[i * 8 + 3] = bhi(u.y); z[i * 8 + 4] = blo(u.z); z[i * 8 + 5] = bhi(u.z); z[i * 8 + 6] = blo(u.w); z[i * 8 + 7] = bhi(u.w);
    }
    float s = 0.f;
#pragma unroll
    for (int e = 0; e < 16; e++) s += y[e];
    s += __shfl_xor(s, 1); s += __shfl_xor(s, 2); float mean = s * (1.f / 64.f);
    float q = 0.f;
#pragma unroll
    for (int e = 0; e < 16; e++) { float dlt = y[e] - mean; q += dlt * dlt; }
    q += __shfl_xor(q, 1); q += __shfl_xor(q, 2); float rs = rsqrtf(q * (1.f / 64.f) + 64e-5f);
    float bon = BON[(size_t)row * 16 + hd] + BON[(size_t)(R_ + row) * 16 + hd];
    float o[16];
#pragma unroll
    for (int e = 0; e < 16; e++) { float yn = (y[e] - mean) * rs * lg[ch + e] + lb[ch + e]; o[e] = (yn + bon * v[e]) * siluf(z[e]); }
#pragma unroll
    for (int i = 0; i < 2; i++)
      *(uint4*)(Y + (size_t)row * 1024 + ch + i * 8) = uint4{pk2(o[i * 8], o[i * 8 + 1]), pk2(o[i * 8 + 2], o[i * 8 + 3]), pk2(o[i * 8 + 4], o[i * 8 + 5]), pk2(o[i * 8 + 6], o[i * 8 + 7])};
  }
}

#define QS 136
#define VS 72
#define MLG_BYTES 47104
__device__ __forceinline__ void ph_ml_scan(const P& p, int j, char* smem0) {
  const int d = ltid() >> 8;
  char* smem = smem0 + d * MLG_BYTES;
  bfr* sQ = (bfr*)smem; bfr* sK = sQ + 64 * QS; bfr* sVT = sK + 64 * QS; bfr* sCT = sVT + 16 * VS;
  float* sN = (float*)(sCT + 16 * QS);
  float* sEs = sN + 128; float* sCt = sEs + 64; float* sBc = sCt + 64; float* sWg = sBc + 64; float* sNr = sWg + 64; bfr* sNb = (bfr*)(sNr + 256); float* sMisc = (float*)(sNb + 128); bfr* sVW = (bfr*)(sMisc + 4);
  const bfr* QKV = (const bfr*)(p.ACT + A_QKV); const float* GT = (const float*)(p.ACT + A_GATE); bfr* HS = (bfr*)(p.ACT + A_HS);
  const float* gbias = p.ml_gate_b + (size_t)j * 32;
  const int tid = ltid() & 255, lane = tid & 63, w = tid >> 6, l15 = lane & 15, q4 = lane >> 4;
  for (int it = xcd_swz(); it < 256; it += gridDim.x) {
    const int b = it >> 7, hh = (it >> 4) & 7, sl = it & 15;
    f32x4 Cacc[2];
    Cacc[0] = f32x4{0.f, 0.f, 0.f, 0.f}; Cacc[1] = f32x4{0.f, 0.f, 0.f, 0.f};
    float mcur = 0.f;
    for (int i = tid; i < 16 * QS; i += 256) sCT[i] = 0;
    if (tid < 128) { sN[tid] = 0.f; sNb[tid] = 0; }
    uint4 pq0, pq1, pq2, pq3, pk0, pk1, pk2, pk3, pv = uint4{0u, 0u, 0u, 0u}; float pgi = 0.f, pgf = 0.f;
#define ML_ROW0(s_) (d == 0 ? b * BT_ + 64 * (s_) : rowmap(1, b, 64 * (s_) + 63))
#define ML_LD(i_, PQ, PK) { int idx = tid + 256 * (i_), rho = idx >> 4, c8 = idx & 15; const bfr* src = QKV + (size_t)(r0n + rho) * 4096 + hh * 128 + c8 * 8; PQ = *(const uint4*)src; PK = *(const uint4*)(src + 1024); }
#define ML_ISSUE(s_) { const int r0n = ML_ROW0(s_); ML_LD(0, pq0, pk0) ML_LD(1, pq1, pk1) ML_LD(2, pq2, pk2) ML_LD(3, pq3, pk3) \
      if (tid < 128) pv = *(const uint4*)(QKV + (size_t)(r0n + (tid >> 1)) * 4096 + 2048 + hh * 256 + sl * 16 + (tid & 1) * 8); \
      if (w == 0) { const float* gp_ = GT + (size_t)(r0n + (d ? 63 - lane : lane)) * 32 + d * 16 + hh; pgi = gp_[0]; pgf = gp_[8]; } }
#define ML_ST(i_, PQ, PK) { int idx = tid + 256 * (i_), rho = idx >> 4, c8 = idx & 15; *(uint4*)(sQ + rho * QS + c8 * 8) = PQ; *(uint4*)(sK + rho * QS + c8 * 8) = PK; }
#define ML_COMMIT() { ML_ST(0, pq0, pk0) ML_ST(1, pq1, pk1) ML_ST(2, pq2, pk2) ML_ST(3, pq3, pk3) \
      if (tid < 128) { int rho = tid >> 1, vb = (tid & 1) * 8; \
        sVT[(vb + 0) * VS + rho] = (bfr)(pv.x & 0xffff); sVT[(vb + 1) * VS + rho] = (bfr)(pv.x >> 16); \
        sVT[(vb + 2) * VS + rho] = (bfr)(pv.y & 0xffff); sVT[(vb + 3) * VS + rho] = (bfr)(pv.y >> 16); \
        sVT[(vb + 4) * VS + rho] = (bfr)(pv.z & 0xffff); sVT[(vb + 5) * VS + rho] = (bfr)(pv.z >> 16); \
        sVT[(vb + 6) * VS + rho] = (bfr)(pv.w & 0xffff); sVT[(vb + 7) * VS + rho] = (bfr)(pv.w >> 16); } }
    ML_ISSUE(0)
    __syncthreads();
    for (int s = 0; s < NCH_; s++) {
      const int r0 = ML_ROW0(s);
      ML_COMMIT()
      if (w == 0) {
        int rho = d ? 63 - lane : lane;
        float gi = pgi + gbias[(d * 2 + 0) * 8 + hh], gf = pgf + gbias[(d * 2 + 1) * 8 + hh];
        float fc = fminf(gf, 0.f) - __logf(1.f + __expf(-fabsf(gf)));
        float bc = fc;
        for (int o = 1; o < 64; o <<= 1) { float t = __shfl_up(bc, o); if (lane >= o) bc += t; }
        float e = gi - bc, pm = e;
        for (int o = 1; o < 64; o <<= 1) { float t = __shfl_up(pm, o); if (lane >= o) pm = fmaxf(pm, t); }
        float pml = __shfl(pm, 63), bcl = __shfl(bc, 63);
        const float mx_ = fmaxf(mcur, pml);
        sEs[rho] = __expf(fminf(e, 80.f)); sCt[rho] = -fmaxf(mcur, pm); sBc[rho] = bc; sWg[rho] = __expf(e - mx_);
        if (lane == 0) { sMisc[0] = mcur; sMisc[1] = __expf(mcur - mx_); }
        mcur = bcl + mx_;
      }
      __syncthreads();
      const float mold = sMisc[0], decay = sMisc[1];

      const int rt = 16 * w + l15;
      bfr* hp = HS + (size_t)(r0 + rt) * 2048 + hh * 256 + sl * 16 + 4 * q4;
      bool first; { int rc = (r0 - b * BT_) >> 6; if (d == 0) { int sp = rc < 4 ? 3 - rc : 263 - rc; first = s < sp; } else first = s < rc; }
      unsigned long long uu = 0ull;
      if (!first) uu = __hip_atomic_load((unsigned long long*)hp, __ATOMIC_RELAXED, __HIP_MEMORY_SCOPE_AGENT);
      if (s + 1 < NCH_) ML_ISSUE(s + 1)
      { const int vr = tid >> 4, sg = (tid & 15) * 4; const uint2 vv_ = *(const uint2*)(sVT + vr * VS + sg); const float4 wg4 = *(const float4*)(sWg + sg);
        *(uint2*)(sVW + vr * VS + sg) = uint2{cvtpk(blo(vv_.x) * wg4.x, bhi(vv_.x) * wg4.y), cvtpk(blo(vv_.y) * wg4.z, bhi(vv_.y) * wg4.w)}; }
      bf16x8 qf[4];
#pragma unroll
      for (int ks = 0; ks < 4; ks++) qf[ks] = *(const bf16x8*)(sQ + (16 * w + l15) * QS + ks * 32 + q4 * 8);
      f32x4 sacc[4];
#pragma unroll
      for (int a = 0; a < 4; a++) { sacc[a] = f32x4{0.f, 0.f, 0.f, 0.f};
#pragma unroll
        for (int ks = 0; ks < 4; ks++) { bf16x8 kf = *(const bf16x8*)(sK + (16 * a + l15) * QS + ks * 32 + q4 * 8); sacc[a] = __builtin_amdgcn_mfma_f32_16x16x32_bf16(kf, qf[ks], sacc[a], 0, 0, 0); } }
      const float ctt = sCt[rt]; const float ect = __expf(ctt); float densum = 0.f;
#pragma unroll
      for (int a = 0; a < 4; a++) { const float4 ex4 = *(const float4*)(sEs + 16 * a + 4 * q4); const float exv[4] = {ex4.x, ex4.y, ex4.z, ex4.w};
#pragma unroll
        for (int jj = 0; jj < 4; jj++) { int rs_ = 16 * a + 4 * q4 + jj; bool valid = d == 0 ? rs_ <= rt : rs_ >= rt;
          float wv = valid ? ect * exv[jj] : 0.f; float sv = sacc[a][jj] * wv; sacc[a][jj] = sv; densum += sv; } }
      densum += __shfl_xor(densum, 16); densum += __shfl_xor(densum, 32);
      bf16x8 sf[2], vf[2];
#pragma unroll
      for (int ks = 0; ks < 2; ks++) {
#pragma unroll
        for (int jj = 0; jj < 4; jj++) { sf[ks][jj] = (short)f2b(sacc[2 * ks][jj]); sf[ks][4 + jj] = (short)f2b(sacc[2 * ks + 1][jj]); }
        uint2 v0 = *(const uint2*)(sVT + l15 * VS + 32 * ks + 4 * q4), v1 = *(const uint2*)(sVT + l15 * VS + 32 * ks + 16 + 4 * q4);
        uint4 vv = uint4{v0.x, v0.y, v1.x, v1.y}; vf[ks] = *(bf16x8*)&vv;
      }
      f32x4 num = f32x4{0.f, 0.f, 0.f, 0.f}, numC = f32x4{0.f, 0.f, 0.f, 0.f};
#pragma unroll
      for (int ks = 0; ks < 2; ks++) num = __builtin_amdgcn_mfma_f32_16x16x32_bf16(vf[ks], sf[ks], num, 0, 0, 0);
#pragma unroll
      for (int ks = 0; ks < 4; ks++) { bf16x8 cf = *(const bf16x8*)(sCT + l15 * QS + ks * 32 + q4 * 8); numC = __builtin_amdgcn_mfma_f32_16x16x32_bf16(cf, qf[ks], numC, 0, 0, 0); }
      f32x4 qnacc = f32x4{0.f, 0.f, 0.f, 0.f};
#pragma unroll
      for (int ks = 0; ks < 4; ks++) { bf16x8 na = bf16x8{0, 0, 0, 0, 0, 0, 0, 0}; if (l15 == 0) na = *(const bf16x8*)(sNb + ks * 32 + q4 * 8);
        qnacc = __builtin_amdgcn_mfma_f32_16x16x32_bf16(na, qf[ks], qnacc, 0, 0, 0); }
      const float qn = __shfl(qnacc[0], l15);
      {
        float inter = __expf(mold + ctt); float den = densum + inter * qn; float dn = fmaxf(fabsf(den), __expf(ctt - sBc[rt])); float inv = __builtin_amdgcn_rcpf(dn);
        f32x4 hv;
#pragma unroll
        for (int jj = 0; jj < 4; jj++) hv[jj] = (num[jj] + inter * numC[jj]) * inv;
        if (!first) { unsigned ux = (unsigned)uu, uy = (unsigned)(uu >> 32);
          hv[0] += blo(ux); hv[1] += bhi(ux); hv[2] += blo(uy); hv[3] += bhi(uy); }
        store4b(hp, hv);
      }
      __syncthreads();
      {
        bf16x8 vw[2], wa[2];
#pragma unroll
        for (int ks = 0; ks < 2; ks++) {
          const uint2 v0 = *(const uint2*)(sVW + l15 * VS + 32 * ks + 4 * q4), v1 = *(const uint2*)(sVW + l15 * VS + 32 * ks + 16 + 4 * q4);
          uint4 vv = uint4{v0.x, v0.y, v1.x, v1.y}; vw[ks] = *(bf16x8*)&vv;
          uint4 wz = uint4{0u, 0u, 0u, 0u};
          if (l15 == 0) { const float4 g0 = *(const float4*)(sWg + 32 * ks + 4 * q4), g1 = *(const float4*)(sWg + 32 * ks + 16 + 4 * q4); wz = uint4{cvtpk(g0.x, g0.y), cvtpk(g0.z, g0.w), cvtpk(g1.x, g1.y), cvtpk(g1.z, g1.w)}; }
          wa[ks] = *(bf16x8*)&wz; }
#pragma unroll
        for (int a = 0; a < 2; a++) {
          int dk = 32 * w + 16 * a + l15;
#pragma unroll
          for (int jj = 0; jj < 4; jj++) Cacc[a][jj] *= decay;
          f32x4 nacc = f32x4{0.f, 0.f, 0.f, 0.f};
#pragma unroll
          for (int ks = 0; ks < 2; ks++) { bf16x8 kt;
#pragma unroll
            for (int e = 0; e < 8; e++) { int rs_ = 32 * ks + (e < 4 ? 4 * q4 + e : 16 + 4 * q4 + e - 4); kt[e] = (short)sK[rs_ * QS + dk]; }
            Cacc[a] = __builtin_amdgcn_mfma_f32_16x16x32_bf16(vw[ks], kt, Cacc[a], 0, 0, 0);
            nacc = __builtin_amdgcn_mfma_f32_16x16x32_bf16(wa[ks], kt, nacc, 0, 0, 0); }
          if (q4 == 0) sNr[dk] = nacc[0];
#pragma unroll
          for (int jj = 0; jj < 4; jj++) sCT[(4 * q4 + jj) * QS + dk] = f2b(Cacc[a][jj]);
        }
      }
      __syncthreads();
      if (tid < 128) { const float nv = decay * sN[tid] + sNr[tid]; sN[tid] = nv; sNb[tid] = f2b(nv); }
    }
    __syncthreads();
  }
}

#define CS 72
#define CSLOT(i_) ((bfr*)smem + (i_) * (64 * CS))
#define A_SST (A_R7B + 362086400ull)
__device__ __forceinline__ f32x4 cmm(const bfr* X, const bfr* YT, int ti, int tj, int l15, int q4) {
  f32x4 acc = f32x4{0.f, 0.f, 0.f, 0.f};
#pragma unroll
  for (int ks = 0; ks < 2; ks++) { bf16x8 a = *(const bf16x8*)(X + (16 * ti + l15) * CS + 32 * ks + 8 * q4); bf16x8 b = *(const bf16x8*)(YT + (16 * tj + l15) * CS + 32 * ks + 8 * q4);
    acc = __builtin_amdgcn_mfma_f32_16x16x32_bf16(a, b, acc, 0, 0, 0); }
  return acc;
}
template <int MODE> __device__ __forceinline__ f32x4 cmm_mask(const bfr* X, const bfr* YT, int ti, int tj, int l15, int q4) {
  f32x4 acc = f32x4{0.f, 0.f, 0.f, 0.f};
#pragma unroll
  for (int ks = 0; ks < 2; ks++) { const int kb = 2 * ks + (q4 >> 1);
    const bool ok = MODE == 1 ? ((kb == 0 && tj == 1) || (kb == 2 && tj == 3)) : (kb < 2 && tj >= 2);
    bf16x8 a = *(const bf16x8*)(X + (16 * ti + l15) * CS + 32 * ks + 8 * q4); bf16x8 bz = bf16x8{0, 0, 0, 0, 0, 0, 0, 0};
    if (ok) bz = *(const bf16x8*)(YT + (16 * tj + l15) * CS + 32 * ks + 8 * q4);
    acc = __builtin_amdgcn_mfma_f32_16x16x32_bf16(a, bz, acc, 0, 0, 0); }
  return acc;
}
__device__ __forceinline__ void st_row(bfr* dst, int r0, int c, f32x4 v) {
#pragma unroll
  for (int jj = 0; jj < 4; jj++) dst[(r0 + jj) * CS + c] = f2b(v[jj]); }
__device__ __forceinline__ void st_tr(bfr* dst, int r0, int c, f32x4 v) { store4b(dst + c * CS + r0, v); }
__device__ __forceinline__ f32x4 ld_row(const bfr* src, int r0, int c) { f32x4 v;
#pragma unroll
  for (int jj = 0; jj < 4; jj++) v[jj] = b2f(src[(r0 + jj) * CS + c]);
  return v; }
__device__ __forceinline__ f32x4 ld_tr(const bfr* src, int r0, int c) { uint2 u = *(const uint2*)(src + c * CS + r0); return f32x4{blo(u.x), bhi(u.x), blo(u.y), bhi(u.y)}; }

__device__ __forceinline__ void ph_r7_ca(const P& p, int j, int win, char* smem) {
  float* LW = (float*)(smem + 7 * 9216); float* AT = (float*)(smem + 9 * 9216); float* WL = (float*)(smem + 14 * 9216);
  const bfr* RK = (const bfr*)(p.ACT + A_RKVZ); const bfr* WMb = (const bfr*)(p.ACT + A_WM); const bfr* AMb = (const bfr*)(p.ACT + A_AM);
  float* BON = (float*)(p.ACT + A_BON); bfr* WB = p.H;
  const float* kkp = p.r7_k_k + (size_t)j * 1024; const float* kap = p.r7_k_a + (size_t)j * 1024; const float* rkp = p.r7_r_k + (size_t)j * 1024;
  const int tid = ltid(), lane = tid & 63, w = tid >> 6, l15 = lane & 15, q4 = lane >> 4, ti = w >> 1, tj0 = (w & 1) * 2;
  const int c0 = win * 20;
  for (int it = blockIdx.x; it < 1280; it += gridDim.x) {
    const int chain = it / 20, cl = it - chain * 20, c = c0 + cl, d = chain & 1, b = chain >> 5, h = (chain >> 1) & 15;
    {
      const int rowA = rowmap(d, b, 64 * c + 16 * ti + l15);
      const float* w0 = p.r7_w0 + (size_t)(j * 2 + d) * 1024 + h * 64; const float* a0 = p.r7_a0 + (size_t)(j * 2 + d) * 1024 + h * 64;
#pragma unroll
      for (int tt = 0; tt < 2; tt++) { const int tj = tj0 + tt; f32x4 aw = f32x4{0.f, 0.f, 0.f, 0.f}, aa = aw;
#pragma unroll
        for (int ks = 0; ks < 2; ks++) {
          bf16x8 xw = *(const bf16x8*)(WMb + (size_t)rowA * 128 + d * 64 + 32 * ks + 8 * q4), xa = *(const bf16x8*)(AMb + (size_t)rowA * 128 + d * 64 + 32 * ks + 8 * q4);
          bf16x8 yw = *(const bf16x8*)(p.W + WR_UP + d * 65536 + (size_t)(h * 64 + 16 * tj + l15) * 64 + 32 * ks + 8 * q4);
          bf16x8 ya = *(const bf16x8*)(p.W + WR_UP + (2 + d) * 65536 + (size_t)(h * 64 + 16 * tj + l15) * 64 + 32 * ks + 8 * q4);
          aw = __builtin_amdgcn_mfma_f32_16x16x32_bf16(xw, yw, aw, 0, 0, 0); aa = __builtin_amdgcn_mfma_f32_16x16x32_bf16(xa, ya, aa, 0, 0, 0); }
        const int ch = 16 * tj + l15; const float w0v = w0[ch], a0v = a0[ch];
#pragma unroll
        for (int jj = 0; jj < 4; jj++) { const int tau = 16 * ti + 4 * q4 + jj; LW[tau * 64 + ch] = -0.6065306597126334f * sigm(w0v + aw[jj]); AT[tau * 64 + ch] = sigm(a0v + aa[jj]); }
      }
    }
    __syncthreads();
    if (tid < 64) { float acc = 0.f;
#pragma unroll 8
      for (int t = 0; t < 64; t++) { acc += LW[t * 64 + tid]; LW[t * 64 + tid] = acc; } }
    __syncthreads();
    {
      const int tau = tid >> 3, sc = tid & 7, col = h * 64 + sc * 8; const int row = rowmap(d, b, 64 * c + tau);
      const bfr* rp = RK + (size_t)row * 4096 + col; uint4 pr = *(const uint4*)rp, pk = *(const uint4*)(rp + 1024);
      unsigned ur[4] = {pr.x, pr.y, pr.z, pr.w}, uk[4] = {pk.x, pk.y, pk.z, pk.w};
      float r8[8], k8[8], kr[8];
#pragma unroll
      for (int e = 0; e < 4; e++) { r8[2 * e] = blo(ur[e]); r8[2 * e + 1] = bhi(ur[e]); k8[2 * e] = blo(uk[e]); k8[2 * e + 1] = bhi(uk[e]); }
      float ss = 0.f;
#pragma unroll
      for (int e = 0; e < 8; e++) { kr[e] = k8[e] * kkp[col + e]; ss += kr[e] * kr[e]; }
      ss += __shfl_xor(ss, 1); ss += __shfl_xor(ss, 2); ss += __shfl_xor(ss, 4);
      const float inv = __builtin_amdgcn_rsqf(fmaxf(ss, 1e-24f));
      float bon = 0.f, o0[8], o1[8], o2[8], o3[8], o4[8], o5[8];
#pragma unroll
      for (int e = 0; e < 8; e++) {
        const float cw = LW[tau * 64 + sc * 8 + e], cwm = tau > 0 ? LW[(tau - 1) * 64 + sc * 8 + e] : 0.f, cwl = LW[63 * 64 + sc * 8 + e], a = AT[tau * 64 + sc * 8 + e];
        const float ka = kr[e] * inv, be = a * ka, kd = k8[e] * (1.f + (a - 1.f) * kap[col + e]); bon += r8[e] * kd * rkp[col + e];
        const float e2 = __expf(-cw), e4 = __expf(cwl - cw);
        o0[e] = ka * __expf(cwm); o1[e] = be * e2; o2[e] = kd * e2; o3[e] = r8[e] * __expf(cw); o4[e] = be * e4; o5[e] = kd * e4;
        if (tau == 63) WL[sc * 8 + e] = __expf(cwl);
      }
      bon += __shfl_xor(bon, 1); bon += __shfl_xor(bon, 2); bon += __shfl_xor(bon, 4);
      if (sc == 0) BON[((size_t)d * R_ + row) * 16 + h] = bon;
      *(uint4*)(CSLOT(0) + tau * CS + sc * 8) = uint4{pk2(o0[0], o0[1]), pk2(o0[2], o0[3]), pk2(o0[4], o0[5]), pk2(o0[6], o0[7])};
      *(uint4*)(CSLOT(1) + tau * CS + sc * 8) = uint4{pk2(o1[0], o1[1]), pk2(o1[2], o1[3]), pk2(o1[4], o1[5]), pk2(o1[6], o1[7])};
      *(uint4*)(CSLOT(2) + tau * CS + sc * 8) = uint4{pk2(o2[0], o2[1]), pk2(o2[2], o2[3]), pk2(o2[4], o2[5]), pk2(o2[6], o2[7])};
      *(uint4*)(CSLOT(3) + tau * CS + sc * 8) = uint4{pk2(o3[0], o3[1]), pk2(o3[2], o3[3]), pk2(o3[4], o3[5]), pk2(o3[6], o3[7])};
#pragma unroll
      for (int e = 0; e < 8; e++) { CSLOT(4)[(sc * 8 + e) * CS + tau] = f2b(o0[e]); CSLOT(5)[(sc * 8 + e) * CS + tau] = f2b(o4[e]); CSLOT(6)[(sc * 8 + e) * CS + tau] = f2b(o5[e]); }
    }
    __syncthreads();
#pragma unroll
    for (int tt = 0; tt < 2; tt++) { const int tj = tj0 + tt, r0 = 16 * ti + 4 * q4, cc = 16 * tj + l15;
      f32x4 v = cmm(CSLOT(1), CSLOT(0), ti, tj, l15, q4);
#pragma unroll
      for (int jj = 0; jj < 4; jj++) if (!(r0 + jj < cc)) v[jj] = 0.f;
      st_row(CSLOT(7), r0, cc, v); st_tr(CSLOT(8), r0, cc, v);
      v = cmm(CSLOT(2), CSLOT(0), ti, tj, l15, q4);
#pragma unroll
      for (int jj = 0; jj < 4; jj++) if (!(r0 + jj < cc)) v[jj] = 0.f;
      st_row(CSLOT(9), r0, cc, v);
      v = cmm(CSLOT(3), CSLOT(1), ti, tj, l15, q4);
#pragma unroll
      for (int jj = 0; jj < 4; jj++) if (!(cc <= r0 + jj)) v[jj] = 0.f;
      st_row(CSLOT(10), r0, cc, v);
      v = cmm(CSLOT(3), CSLOT(2), ti, tj, l15, q4);
#pragma unroll
      for (int jj = 0; jj < 4; jj++) if (!(cc <= r0 + jj)) v[jj] = 0.f;
      st_row(CSLOT(11), r0, cc, v);
    }
    __syncthreads();
    {
      float* X = (float*)CSLOT(0);
      const bfr* Ab = CSLOT(7);
      const int cl = lane >> 3, pp = lane & 7, cx = 8 * w + cl, blk0 = (w >> 1) * 16;
#pragma unroll 1
      for (int il = 15; il >= 0; il--) { const int i = blk0 + il;
        float sum = 0.f;
#pragma unroll 1
        for (int jx = i + 1 + pp; jx < blk0 + 16; jx += 8) sum += b2f(Ab[i * CS + jx]) * X[jx * 72 + cx];
        sum += dppf<0xB1>(sum); sum += dppf<0x4E>(sum); sum += dppf<0x141>(sum);
        const float xv = (i == cx ? 1.f : 0.f) - sum;
        if (pp == 0) X[i * 72 + cx] = xv;
      }
      __syncthreads();
#pragma unroll 1
      for (int e = tid; e < 4096; e += 512) { const int i = e >> 6, c2 = e & 63; const bfr tv = ((i >> 4) == (c2 >> 4)) ? f2b(X[i * 72 + c2]) : (bfr)0; CSLOT(2)[i * CS + c2] = tv; CSLOT(12)[c2 * CS + i] = tv; }
      __syncthreads();
#pragma unroll
      for (int tt = 0; tt < 2; tt++) { const int tj = tj0 + tt, r0 = 16 * ti + 4 * q4, cc = 16 * tj + l15; st_row(CSLOT(13), r0, cc, cmm_mask<1>(CSLOT(2), CSLOT(8), ti, tj, l15, q4)); }
      __syncthreads();
#pragma unroll
      for (int tt = 0; tt < 2; tt++) { const int tj = tj0 + tt, r0 = 16 * ti + 4 * q4, cc = 16 * tj + l15;
        f32x4 v = ld_row(CSLOT(2), r0, cc) - cmm(CSLOT(13), CSLOT(12), ti, tj, l15, q4); st_row(CSLOT(0), r0, cc, v); st_tr(CSLOT(1), r0, cc, v); }
      __syncthreads();
#pragma unroll
      for (int tt = 0; tt < 2; tt++) { const int tj = tj0 + tt, r0 = 16 * ti + 4 * q4, cc = 16 * tj + l15; st_row(CSLOT(13), r0, cc, cmm_mask<2>(CSLOT(0), CSLOT(8), ti, tj, l15, q4)); }
      __syncthreads();
#pragma unroll
      for (int tt = 0; tt < 2; tt++) { const int tj = tj0 + tt, r0 = 16 * ti + 4 * q4, cc = 16 * tj + l15;
        f32x4 v = ld_row(CSLOT(0), r0, cc) - cmm(CSLOT(13), CSLOT(1), ti, tj, l15, q4);
#pragma unroll
        for (int jj = 0; jj < 4; jj++) if (r0 + jj == cc) v[jj] -= 1.f;
        st_row(CSLOT(2), r0, cc, v); }
      __syncthreads();
    }
#pragma unroll
    for (int tt = 0; tt < 2; tt++) { const int tj = tj0 + tt, r0 = 16 * ti + 4 * q4, cc = 16 * tj + l15;
      f32x4 g = cmm(CSLOT(10), CSLOT(2), ti, tj, l15, q4) + ld_row(CSLOT(10), r0, cc); st_row(CSLOT(12), r0, cc, g);
      f32x4 hh = cmm(CSLOT(5), CSLOT(2), ti, tj, l15, q4) + ld_row(CSLOT(5), r0, cc); st_row(CSLOT(13), r0, cc, hh); }
    __syncthreads();
    {
      bfr* out = WB + (size_t)(chain * 20 + cl) * 16384;
#pragma unroll
      for (int tt = 0; tt < 2; tt++) { const int tj = tj0 + tt, r0 = 16 * ti + 4 * q4, cc = 16 * tj + l15;
        f32x4 v = ld_tr(CSLOT(3), r0, cc) - cmm(CSLOT(4), CSLOT(12), ti, tj, l15, q4);
        store4b(out + cc * 64 + r0, v);
        v = ld_tr(CSLOT(11), r0, cc) - cmm(CSLOT(9), CSLOT(12), ti, tj, l15, q4);
        store4b(out + 4096 + cc * 64 + r0, v);
        v = -cmm(CSLOT(4), CSLOT(13), ti, tj, l15, q4);
#pragma unroll
        for (int jj = 0; jj < 4; jj++) if (r0 + jj == cc) v[jj] += WL[cc];
        store4b(out + 8192 + cc * 64 + r0, v);
        v = ld_tr(CSLOT(6), r0, cc) - cmm(CSLOT(9), CSLOT(13), ti, tj, l15, q4);
        store4b(out + 12288 + cc * 64 + r0, v);
      }
    }
    __syncthreads();
  }
}

__device__ __forceinline__ void ph_r7_cb(const P& p, int win, char* smem) {
  bfr* Sh = (bfr*)smem; bfr* Sl = Sh + 2 * 16 * CS; bfr* VT = Sl + 2 * 16 * CS;
  const bfr* WB = p.H; const bfr* RK = (const bfr*)(p.ACT + A_RKVZ); bfr* SST = (bfr*)(p.ACT + A_SST);
  const int tid = ltid(), lane = tid & 63, w = tid >> 6, l15 = lane & 15, q4 = lane >> 4;
  const int c0 = win * 20;
  for (int it = xcd_swz(); it < 256; it += gridDim.x) {
    const int d = it & 1, b = it >> 7, h = (it >> 3) & 15, rg = (it >> 1) & 3, chain = (b * 16 + h) * 2 + d;
    bfr* Y = d ? R7_Y2 : (bfr*)(p.ACT + A_Y);
    bfr* sst = SST + (size_t)(chain * 4 + rg) * 2048;
    __syncthreads();
    if (tid < 256) { const int hl = tid >> 7, e = tid & 127, rr = e >> 3, c8 = e & 7; uint4 v = uint4{0u, 0u, 0u, 0u};
      if (win > 0) v = *(const uint4*)(sst + hl * 1024 + rr * 64 + c8 * 8);
      *(uint4*)((hl ? Sl : Sh) + rr * CS + c8 * 8) = v; }
    const int vtau = tid >> 3, vp = tid & 7;
    { const int row = rowmap(d, b, 64 * c0 + vtau); unsigned vv = *(const unsigned*)(RK + (size_t)row * 4096 + 2048 + h * 64 + rg * 16 + 2 * vp);
      VT[(2 * vp) * CS + vtau] = (bfr)(vv & 0xffff); VT[(2 * vp + 1) * CS + vtau] = (bfr)(vv >> 16); }
    const bfr* bbase = WB + (size_t)(chain * 20) * 16384 + (w < 4 ? 8192 + (16 * w + l15) * 64 : (16 * (w - 4) + l15) * 64) + 8 * q4;
    bf16x8 rb1[4][2], rb2[4][2]; unsigned rv[4];
#define CB_LOAD(u_, s_) { const int ss_ = (s_) < 20 ? (s_) : 19; const bfr* bp_ = bbase + (size_t)ss_ * 16384; \
      rb1[u_][0] = *(const bf16x8*)bp_; rb1[u_][1] = *(const bf16x8*)(bp_ + 32); rb2[u_][0] = *(const bf16x8*)(bp_ + 4096); rb2[u_][1] = *(const bf16x8*)(bp_ + 4096 + 32); \
      const int sv_ = ss_ + 1 < 20 ? ss_ + 1 : 19; const int rowv_ = rowmap(d, b, 64 * (c0 + sv_) + vtau); \
      rv[u_] = *(const unsigned*)(RK + (size_t)rowv_ * 4096 + 2048 + h * 64 + rg * 16 + 2 * vp); }
    CB_LOAD(0, 0) CB_LOAD(1, 1) CB_LOAD(2, 2) CB_LOAD(3, 3)
    __syncthreads();
    for (int g = 0; g < 5; g++) {
#pragma unroll
      for (int u = 0; u < 4; u++) {
        const int s = 4 * g + u;
        if (s < 20) {
          const int cur = s & 1, nxt = cur ^ 1, c = c0 + s;
          bf16x8 sh[2], sl[2], vt[2];
#pragma unroll
          for (int ks = 0; ks < 2; ks++) { sh[ks] = *(const bf16x8*)(Sh + (cur * 16 + l15) * CS + 32 * ks + 8 * q4); sl[ks] = *(const bf16x8*)(Sl + (cur * 16 + l15) * CS + 32 * ks + 8 * q4);
            vt[ks] = *(const bf16x8*)(VT + (cur * 16 + l15) * CS + 32 * ks + 8 * q4); }
          f32x4 a1 = f32x4{0.f, 0.f, 0.f, 0.f}, a2 = a1;
#pragma unroll
          for (int ks = 0; ks < 2; ks++) { a1 = __builtin_amdgcn_mfma_f32_16x16x32_bf16(sh[ks], rb1[u][ks], a1, 0, 0, 0); a2 = __builtin_amdgcn_mfma_f32_16x16x32_bf16(vt[ks], rb2[u][ks], a2, 0, 0, 0); }
#pragma unroll
          for (int ks = 0; ks < 2; ks++) a1 = __builtin_amdgcn_mfma_f32_16x16x32_bf16(sl[ks], rb1[u][ks], a1, 0, 0, 0);
          a1 = a1 + a2;
          if (w < 4) {
#pragma unroll
            for (int jj = 0; jj < 4; jj++) { const bfr hi = f2b(a1[jj]); Sh[(nxt * 16 + 4 * q4 + jj) * CS + 16 * w + l15] = hi; Sl[(nxt * 16 + 4 * q4 + jj) * CS + 16 * w + l15] = f2b(a1[jj] - b2f(hi)); }
          } else {
            const int rowy = rowmap(d, b, 64 * c + 16 * (w - 4) + l15);
            store4b(Y + (size_t)rowy * 1024 + h * 64 + rg * 16 + 4 * q4, a1);
          }
          if (s + 1 < 20) { VT[(nxt * 16 + 2 * vp) * CS + vtau] = (bfr)(rv[u] & 0xffff); VT[(nxt * 16 + 2 * vp + 1) * CS + vtau] = (bfr)(rv[u] >> 16); }
          if (s + 4 < 20) CB_LOAD(u, s + 4)
          __syncthreads();
        }
      }
    }
    if (tid < 256) { const int hl = tid >> 7, e = tid & 127, rr = e >> 3, c8 = e & 7; *(uint4*)(sst + hl * 1024 + rr * 64 + c8 * 8) = *(const uint4*)((hl ? Sl : Sh) + rr * CS + c8 * 8); }
  }
}

__device__ __forceinline__ void run_phase(const P& p, int ph, int layer, int d, char* smem) {
  Ctx c; c.layer = layer; c.j = layer / 3; c.d = d; c.wc = layer < 3 ? 1 : 0;
  switch (ph) {
    case PH_PRE: ph_pre(p, smem); break;
    case PH_NORM: ph_norm(p, layer, smem); break;
    case PH_LRU_IN: big_gemm(smem, p.H, p.W, 2560, 1024, F_LruIn{p.ACT}); break;
    case PH_LRU_CONV: ph_lru_conv(p, c.j); break;
    case PH_LRU_GATE: gemm_phase_k2<G_LruGate>(p, c, smem); break;
    case PH_LRU_S1: ph_lru_s1(p, d); break;
    case PH_LRU_S2: ph_lru_s2(p, smem); break;
    case PH_LRU_S3: ph_lru_s3(p, d); break;
    case PH_LRU_OUT: big_gemm(smem, (const bfr*)(p.ACT + A_Z), p.W + WL_OUT, 1024, 1280, F_Resid{p.Xx, p.Xc, p.MOD + (size_t)layer * 3 * 3072, c.wc}); break;
    case PH_ML_IN: big_gemm(smem, p.H, p.W, 4352, 1024, F_MlIn{p.ACT}); break;
    case PH_ML_SCAN: ph_ml_scan(p, c.j, smem); break;
    case PH_ML_STAT: ph_ml_stat(p); break;
    case PH_ML_Z: big_gemm(smem, p.H, p.W + WM_Z, 2048, 1024, F_MlZ{p.ACT, p.ml_norm_g + (size_t)c.j * 2048}); break;
    case PH_ML_OUT: big_gemm(smem, (const bfr*)(p.ACT + A_HS), p.W + WM_OUT, 1024, 2048, F_Resid{p.Xx, p.Xc, p.MOD + (size_t)layer * 3 * 3072, c.wc}); break;
    case PH_R7_IN: big_gemm(smem, p.H, p.W, 4352, 2048, F_R7In{p.ACT}); break;
    case PH_R7_SHIFT: ph_r7_shift(p); break;
    case PH_R7_CA: ph_r7_ca(p, c.j, d, smem); break;
    case PH_R7_CB: ph_r7_cb(p, d, smem); break;
    case PH_R7_FIN: ph_r7_fin(p, c.j); break;
    case PH_R7_OUT: big_gemm(smem, (const bfr*)(p.ACT + A_Y), p.W + WR_OUT, 1024, 1024, F_Resid{p.Xx, p.Xc, p.MOD + (size_t)layer * 3 * 3072, c.wc}); break;
    case PH_FINAL: ph_final(p); break;
  }
}


#define XB_TMO      128
#define XB_XCNT(j)  (256  + 64 * (j))
#define XB_XSUB(j)  (1280 + 64 * (j))
#define XB_XGEN(j)  (2304 + 64 * (j))
#define XB_TOP      3328
#define XB_TOPGEN   3392
#define XCD_BAR_WORDS 3456
#define XB_SPIN_CAP (1u << 18)
#define OFF_BAR 527000064ull
#define OFF_CL (OFF_BAR + 16384ull)
__device__ __forceinline__ unsigned xb_ld(unsigned* p)              { return __hip_atomic_load(p, __ATOMIC_RELAXED, __HIP_MEMORY_SCOPE_AGENT); }
__device__ __forceinline__ unsigned xb_add(unsigned* p, unsigned v) { return __hip_atomic_fetch_add(p, v, __ATOMIC_RELAXED, __HIP_MEMORY_SCOPE_AGENT); }
__device__ __forceinline__ unsigned xb_xcc_id() { return (unsigned)__builtin_amdgcn_s_getreg((3 << 11) | 20) & 0xFu; }
#define XB_SPIN(cond, bar) do { unsigned _sp = 0; while (cond) { __builtin_amdgcn_s_sleep(1); \
    if ((++_sp & 255u) == 0u) { if (xb_ld(&(bar)[XB_TMO])) break; if (_sp > XB_SPIN_CAP) { atomicAdd(&(bar)[XB_TMO], 1u); break; } } } } while (0)
struct XcdBarrier { unsigned* bar; unsigned x; volatile __attribute__((address_space(3))) unsigned* st; };
__device__ __forceinline__ XcdBarrier xcd_barrier_post(unsigned* bar, volatile __attribute__((address_space(3))) unsigned* st) {
  XcdBarrier b; b.bar = bar; b.x = xb_xcc_id(); b.st = st;
  if (threadIdx.x == 0) (void)xb_add(&bar[XB_XCNT(b.x)], 1u);
  return b;
}
__device__ __forceinline__ void xcd_barrier_complete(unsigned* bar, unsigned x, unsigned& nloc, unsigned& nx) {
  const unsigned G = gridDim.x * gridDim.y * gridDim.z;
  unsigned sum, cnt, mine, sp = 0u;
  for (;;) {
    sum = 0u; cnt = 0u; mine = 0u;
#pragma unroll
    for (unsigned j = 0; j < 16; ++j) { const unsigned c = xb_ld(&bar[XB_XCNT(j)]); sum += c; cnt += (c > 0u) ? 1u : 0u; mine = (j == x) ? c : mine; }
    if (sum == G) break;
    __builtin_amdgcn_s_sleep(1);
    if ((++sp & 255u) == 0u) { if (xb_ld(&bar[XB_TMO])) break; if (sp > XB_SPIN_CAP) { atomicAdd(&bar[XB_TMO], 1u); break; } }
  }
  nloc = mine > 0u ? mine : 1u; nx = cnt > 0u ? cnt : 1u;
}
__device__ __forceinline__ void xcd_barrier(const XcdBarrier& b) {
  asm volatile("s_waitcnt vmcnt(0)" ::: "memory");
  __syncthreads();
  if (threadIdx.x == 0) {
    unsigned* bar = b.bar;
    __builtin_amdgcn_s_waitcnt(0);
    unsigned nloc = b.st[0], nx = b.st[1];
    if (nloc == 0u) { xcd_barrier_complete(bar, b.x, nloc, nx); b.st[0] = nloc; b.st[1] = nx; }
    const unsigned old = xb_add(&bar[XB_XSUB(b.x)], 1u);
    const unsigned gen = old / nloc;
    if (old + 1u == (gen + 1u) * nloc) {
      __builtin_amdgcn_fence(__ATOMIC_RELEASE, "agent");
      asm volatile("s_waitcnt vmcnt(0)" ::: "memory");
      const unsigned og = xb_add(&bar[XB_TOP], 1u);
      const unsigned tg = og / nx;
      if (og + 1u == (tg + 1u) * nx) xb_add(&bar[XB_TOPGEN], 1u);
      else XB_SPIN(xb_ld(&bar[XB_TOPGEN]) == tg, bar);
      __builtin_amdgcn_fence(__ATOMIC_ACQUIRE, "agent");
      xb_add(&bar[XB_XGEN(b.x)], 1u);
      asm volatile("s_waitcnt vmcnt(0)" ::: "memory");
    } else {
      XB_SPIN(xb_ld(&bar[XB_XGEN(b.x)]) == gen, bar);
      __builtin_amdgcn_fence(__ATOMIC_ACQUIRE, "agent");
      asm volatile("s_waitcnt vmcnt(0)" ::: "memory");
    }
  }
  __syncthreads();
}

#define SMEM_BYTES (131072 + 64)
extern __shared__ __attribute__((aligned(16))) char dyn_smem[];
#if !MEGA
__global__ void __launch_bounds__(512, 2) phase_kernel(P p, int si) {
  run_phase(p, p.sched[si * 3], p.sched[si * 3 + 1], p.sched[si * 3 + 2], dyn_smem);
}
#else
__global__ void __launch_bounds__(512, 2) mega_kernel(P p) {
  cg::grid_group grid = cg::this_grid();
  volatile __attribute__((address_space(3))) unsigned* st = (volatile __attribute__((address_space(3))) unsigned*)(dyn_smem + 131072);
  if (threadIdx.x < 4) st[threadIdx.x] = 0u;
  __syncthreads();
  const XcdBarrier xb = xcd_barrier_post(p.bar, st);
  for (int si = 0; si < p.nsched; si++) {
    run_phase(p, p.sched[si * 3], p.sched[si * 3 + 1], p.sched[si * 3 + 2], dyn_smem);
    if (si + 1 < p.nsched) { if (si == 0) grid.sync(); else xcd_barrier(xb); }
  }
}
#endif

extern "C" void kernel_launch(void* const* d_in, const int* in_sizes, int n_in, void* d_out, int out_size, void* d_ws, size_t ws_size, hipStream_t stream) {
  P p; memset(&p, 0, sizeof(p));
  const float** f = (const float**)&p;
  for (int i = 0; i < 33; i++) f[i] = (const float*)d_in[i];
  char* ws = (char*)d_ws;
  p.Xx = (float*)d_out; p.Xc = (float*)(ws + OFF_XC); p.MOD = (float*)(ws + OFF_MOD); p.W = (bfr*)(ws + OFF_W); p.H = (bfr*)(ws + OFF_H); p.ACT = ws + OFF_ACT; p.bar = (unsigned*)(ws + OFF_BAR); p.CL = (float*)(ws + OFF_CL);
  int n = 0;
  auto add = [&](int ph, int layer, int d) { p.sched[n * 3] = ph; p.sched[n * 3 + 1] = layer; p.sched[n * 3 + 2] = d; n++; };
  add(PH_PRE, 0, 0);
  if (DUP & 4) add(PH_PRE, 0, 0);
  for (int l = 0; l < 4; l++) {
    add(PH_NORM, l, 0); if (DUP & 4) add(PH_NORM, l, 0);
    int kind = l % 3;
    const bool dg = DUP & 1, ds = DUP & 2;
    if (kind == 0) { add(PH_LRU_IN, l, 0); if (dg) add(PH_LRU_IN, l, 0); add(PH_LRU_CONV, l, 0); if (DUP & 4) add(PH_LRU_CONV, l, 0);
      for (int d = 0; d < 2; d++) { add(PH_LRU_GATE, l, d); if (dg) add(PH_LRU_GATE, l, d); add(PH_LRU_S1, l, d); if (DUP & 8) add(PH_LRU_S1, l, d); add(PH_LRU_S2, l, d); if (DUP & 16) add(PH_LRU_S2, l, d); add(PH_LRU_S3, l, d); }
      add(PH_LRU_OUT, l, 0); }
    else if (kind == 1) { add(PH_ML_IN, l, 0); if (dg) add(PH_ML_IN, l, 0); add(PH_ML_SCAN, l, 0); if (ds) add(PH_ML_SCAN, l, 0); add(PH_ML_STAT, l, 0); if (DUP & 4) add(PH_ML_STAT, l, 0); add(PH_ML_Z, l, 0); add(PH_ML_OUT, l, 0); }
    else { add(PH_R7_SHIFT, l, 0); add(PH_R7_IN, l, 0); if (dg) add(PH_R7_IN, l, 0); for (int wi = 0; wi < 13; wi++) { add(PH_R7_CA, l, wi); if (DUP & 32) add(PH_R7_CA, l, wi); add(PH_R7_CB, l, wi); } add(PH_R7_FIN, l, 0); add(PH_R7_OUT, l, 0); }
  }
  add(PH_FINAL, 0, 0);
  p.nsched = n;
  if (ws_size < WS_NEED) fprintf(stderr, "workspace too small: %zu < %llu\n", ws_size, (unsigned long long)WS_NEED);
#if MEGA
  static int grid_blocks = 0;
  if (!grid_blocks) { int dev = 0, cus = 0, per = 0; hipGetDevice(&dev); hipDeviceGetAttribute(&cus, hipDeviceAttributeMultiprocessorCount, dev);
    hipFuncSetAttribute((const void*)mega_kernel, hipFuncAttributeMaxDynamicSharedMemorySize, SMEM_BYTES);
    hipOccupancyMaxActiveBlocksPerMultiprocessor(&per, mega_kernel, 512, SMEM_BYTES); if (per > 1) per = 1; if (per < 1) per = 1; grid_blocks = cus * per; }
  hipMemsetAsync(ws + OFF_BAR, 0, XCD_BAR_WORDS * 4, stream);
  void* args[] = {&p};
  hipError_t e = hipLaunchCooperativeKernel((void*)mega_kernel, dim3(grid_blocks), dim3(512), args, SMEM_BYTES, stream);
  if (e != hipSuccess) fprintf(stderr, "cooperative launch failed: %s (grid %d)\n", hipGetErrorString(e), grid_blocks);
#else
  static int once = 0; if (!once) { once = 1; hipFuncSetAttribute((const void*)phase_kernel, hipFuncAttributeMaxDynamicSharedMemorySize, SMEM_BYTES); }
  for (int si = 0; si < n; si++) phase_kernel<<<256, 512, SMEM_BYTES, stream>>>(p, si);
#endif
}
```

```cpp
#include <hip/hip_runtime.h>
#include <hip/hip_bf16.h>
#include <hip/hip_cooperative_groups.h>
#include <cstdio>
#include <cstring>
#include <type_traits>
namespace cg = cooperative_groups;

#ifndef DUP
#define DUP 0
#endif
#ifndef MEGA
#define MEGA 1
#endif

typedef unsigned short bfr;
using bf16x8 = __attribute__((ext_vector_type(8))) short;
using f32x4 = __attribute__((ext_vector_type(4))) float;

#define R_ 33280
#define BT_ 16640
#define NCH_ 260

#define OFF_XC 0ull
#define OFF_MOD 2097152ull
#define OFF_W 2244608ull
#define OFF_H 24264704ull
#define OFF_ACT 92422144ull
#define A_Z 0ull
#define A_UC 85196800ull
#define A_AB 170393600ull
#define A_U 170393600ull
#define A_HF 340787200ull
#define A_AGG 425984000ull
#define A_CAR 431308800ull
#define A_QKV 0ull
#define A_GATE 272629760ull
#define A_HS 276889600ull
#define A_RSTD 413204480ull
#define A_R7B 68157440ull
#define A_RKVZ (A_R7B + 0ull)
#define A_WM (A_R7B + 272629760ull)
#define A_AM (A_R7B + 281149440ull)
#define A_BON (A_R7B + 289669120ull)
#define A_Y (A_R7B + 293928960ull)
#define WS_NEED (527000064ull + 16384ull)

#define WL_GATE (2560 * 1024)
#define WL_OUT (WL_GATE + 1310720)
#define WM_Z (4352 * 1024)
#define WM_OUT (WM_Z + 2048 * 1024)
#define WR_UP (4352 * 2048)
#define WR_OUT (WR_UP + 262144)

enum { PH_PRE = 0, PH_NORM, PH_LRU_IN, PH_LRU_CONV, PH_LRU_GATE, PH_LRU_S1, PH_LRU_S2, PH_LRU_S3, PH_LRU_OUT,
       PH_ML_IN, PH_ML_SCAN, PH_ML_STAT, PH_ML_Z, PH_ML_OUT,
       PH_R7_IN, PH_R7_CA, PH_R7_CB, PH_R7_FIN, PH_R7_OUT, PH_FINAL, PH_R7_SHIFT };

struct P {
  const float *x, *c, *ctx, *c_ctx, *norm_g, *mod_w, *mod_b, *final_g;
  const float *lru_w_in, *lru_conv_w, *lru_conv_b, *lru_gate_w, *lru_gate_b, *lru_lam, *lru_w_out;
  const float *ml_w_in, *ml_gate_b, *ml_norm_g, *ml_w_out;
  const float *r7_mu, *r7_w_rkvz, *r7_w0, *r7_w1, *r7_w2, *r7_a0, *r7_a1, *r7_a2, *r7_k_k, *r7_k_a, *r7_r_k, *r7_ln_g, *r7_ln_b, *r7_w_out;
  float* Xx; float* Xc; float* MOD; bfr* W; bfr* H; char* ACT; unsigned* bar; float* CL;
  int nsched; int pad_;
  int sched[64 * 3];
};
struct Ctx { int layer, j, d, wc; };

__device__ __forceinline__ int xcd_swz() { const int b = blockIdx.x; return gridDim.x == 256 ? ((b & 7) * 32 + (b >> 3)) : b; }
__device__ __forceinline__ int ltid() { int t = threadIdx.x; asm volatile("" : "+v"(t)); return t; }
typedef float f32v2_ __attribute__((ext_vector_type(2))); typedef __bf16 bf16v2_ __attribute__((ext_vector_type(2)));
__device__ __forceinline__ unsigned cvtpk(float lo, float hi) { f32v2_ f = {lo, hi}; bf16v2_ h = __builtin_convertvector(f, bf16v2_); return __builtin_bit_cast(unsigned, h); }
__device__ __forceinline__ bfr f2b(float f) { return (bfr)(cvtpk(f, f) & 0xffffu); }
__device__ __forceinline__ float b2f(bfr b) { return __uint_as_float(((unsigned)b) << 16); }
__device__ __forceinline__ unsigned pk2(float a, float b) { return cvtpk(a, b); }
__device__ __forceinline__ float blo(unsigned u) { return __uint_as_float(u << 16); }
__device__ __forceinline__ float bhi(unsigned u) { return __uint_as_float(u & 0xffff0000u); }
__device__ __forceinline__ void store4b(bfr* dst, f32x4 v) { uint2 u; u.x = pk2(v[0], v[1]); u.y = pk2(v[2], v[3]); *(uint2*)dst = u; }
__device__ __forceinline__ float sigm(float x) { return __builtin_amdgcn_rcpf(1.f + __expf(-x)); }
__device__ __forceinline__ float siluf(float x) { return x * sigm(x); }
__device__ __forceinline__ float softplusf(float x) { return x > 20.f ? x : log1pf(expf(x)); }
__device__ __forceinline__ int rowmap(int d, int b, int pp) { int o = d == 0 ? pp : (pp < 256 ? 255 - pp : 16895 - pp); return b * BT_ + o; }
__device__ __forceinline__ float* xrowp(const P& p, int row, int& mi) {
  int b = row / BT_, o = row - b * BT_;
  if (o < 256) { mi = 2; return p.Xc + (size_t)(b * 256 + o) * 1024; }
  mi = b; return p.Xx + (size_t)(b * 16384 + o - 256) * 1024;
}
__device__ __forceinline__ float wsum(float v) { for (int o = 32; o; o >>= 1) v += __shfl_xor(v, o); return v; }
template <int CTRL> __device__ __forceinline__ float dppf(float x) {
  return __int_as_float(__builtin_amdgcn_update_dpp(0, __float_as_int(x), CTRL, 0xf, 0xf, true));
}
__device__ __forceinline__ float red16(float x) {
  x += dppf<0xB1>(x); x += dppf<0x4E>(x); x += dppf<0x141>(x); x += dppf<0x140>(x); return x;
}

template <class F> __device__ __forceinline__ void prep_tile(bfr* dst, int K, int tn, int tk, F get, float* sm) {
  int tid = ltid();
  for (int i = 0; i < 8; i++) { int kk = (tid >> 6) + 8 * i, nn = tid & 63; sm[kk * 65 + nn] = get(tk * 64 + kk, tn * 64 + nn); }
  __syncthreads();
  for (int i = 0; i < 8; i++) { int nn = (tid >> 6) + 8 * i, kk = tid & 63; dst[(size_t)(tn * 64 + nn) * K + tk * 64 + kk] = f2b(sm[kk * 65 + nn]); }
  __syncthreads();
}
__device__ __forceinline__ int prep_count(int layer) { int kind = layer % 3; return kind == 0 ? (640 + 320 + 320) : kind == 1 ? (1088 + 512 + 512) : (2176 + 64 + 256); }
__device__ __forceinline__ void prep_item(const P& p, int layer, int it, float* sm) {
  int kind = layer % 3, j = layer / 3;
  if (kind == 0) {
    if (it < 640) { int tn = it / 16, tk = it % 16; const float* s = p.lru_w_in + (size_t)j * 1024 * 2560;
      prep_tile(p.W, 1024, tn, tk, [=](int k, int n) { return s[(size_t)k * 2560 + n]; }, sm); return; }
    it -= 640;
    if (it < 320) { int d = it / 160, r = it % 160, tn = r / 2, tk = r % 2; const float* s = p.lru_gate_w + (size_t)(j * 2 + d) * 2 * 10 * 16384;
      prep_tile(p.W + WL_GATE + d * 655360, 128, tn, tk, [=](int k, int n) {
        int nt = n >> 7, blk = nt >> 1, sub = nt & 1, jj = n & 127, wn = jj >> 6, rr = jj & 63, g = rr >> 5, c = rr & 31;
        int kch = sub * 64 + wn * 32 + c; return s[((size_t)(g * 10 + blk) * 128 + k) * 128 + kch]; }, sm); return; }
    it -= 320;
    { int tn = it / 20, tk = it % 20; const float* s = p.lru_w_out + (size_t)j * 1280 * 1024;
      prep_tile(p.W + WL_OUT, 1280, tn, tk, [=](int k, int n) { return s[(size_t)k * 1024 + n]; }, sm); return; }
  } else if (kind == 1) {
    const float* s = p.ml_w_in + (size_t)j * 1024 * 6176;
    if (it < 1088) { int tn = it / 16, tk = it % 16;
      prep_tile(p.W, 1024, tn, tk, [=](int k, int n) {
        if (n < 4096) { float v = s[(size_t)k * 6176 + n]; return (n >= 1024 && n < 2048) ? v * 0.08838834764831845f : v; }
        if (n < 4128) return s[(size_t)k * 6176 + 6144 + (n - 4096)];
        return 0.f; }, sm); return; }
    it -= 1088;
    if (it < 512) { int tn = it / 16, tk = it % 16;
      prep_tile(p.W + WM_Z, 1024, tn, tk, [=](int k, int n) { return s[(size_t)k * 6176 + 4096 + n]; }, sm); return; }
    it -= 512;
    { int tn = it / 32, tk = it % 32; const float* so = p.ml_w_out + (size_t)j * 2048 * 1024;
      prep_tile(p.W + WM_OUT, 2048, tn, tk, [=](int k, int n) { return so[(size_t)k * 1024 + n]; }, sm); return; }
  } else {
    if (it < 2176) { int tn = it / 32, tk = it % 32;
      const float* mu = p.r7_mu + (size_t)j * 6 * 1024; const float* wr = p.r7_w_rkvz + (size_t)j * 4 * 1024 * 1024;
      const float* w1 = p.r7_w1 + (size_t)j * 2 * 1024 * 64; const float* a1 = p.r7_a1 + (size_t)j * 2 * 1024 * 64;
      prep_tile(p.W, 2048, tn, tk, [=](int k, int n) {
        int kk = k & 1023; float v, m;
        if (n < 4096) { int g = n >> 10, e = n & 1023; m = mu[g * 1024 + kk]; v = wr[((size_t)g * 1024 + kk) * 1024 + e]; }
        else if (n < 4224) { int xx = (n - 4096) >> 6, rr = (n - 4096) & 63; m = mu[4 * 1024 + kk]; v = w1[((size_t)xx * 1024 + kk) * 64 + rr]; }
        else { int xx = (n - 4224) >> 6, rr = (n - 4224) & 63; m = mu[5 * 1024 + kk]; v = a1[((size_t)xx * 1024 + kk) * 64 + rr]; }
        return (k < 1024 ? (1.f - m) : m) * v; }, sm); return; }
    it -= 2176;
    if (it < 64) { int u = it / 16, tn = it % 16; const float* s = (u < 2 ? p.r7_w2 : p.r7_a2) + (size_t)(j * 2 + (u & 1)) * 64 * 1024;
      prep_tile(p.W + WR_UP + u * 65536, 64, tn, 0, [=](int k, int n) { return s[(size_t)k * 1024 + n]; }, sm); return; }
    it -= 64;
    { int tn = it / 16, tk = it % 16; const float* s = p.r7_w_out + (size_t)j * 1024 * 1024;
      prep_tile(p.W + WR_OUT, 1024, tn, tk, [=](int k, int n) { return s[(size_t)k * 1024 + n]; }, sm); return; }
  }
}

#define LDSS 72
template <class G> __device__ __forceinline__ void gemm_tile(const P& p, const Ctx& c, int mt, int nt, char* smem) {
  const int tid = ltid(), lane = tid & 63, wid = tid >> 6, wm = wid & 3, wn = wid >> 2;
  bfr* sA = (bfr*)smem; bfr* sB = sA + 2 * 256 * LDSS;
  f32x4 acc[4][4];
  for (int a = 0; a < 4; a++) for (int b = 0; b < 4; b++) acc[a][b] = f32x4{0.f, 0.f, 0.f, 0.f};
  const int lr = tid >> 3, lc = tid & 7;
  uint4 ra[4], rb[2];
  auto gload = [&](int kt) __attribute__((always_inline)) {
#pragma unroll
    for (int i = 0; i < 4; i++) {
      const bfr* pa = G::aptr(p, c, mt * 256 + lr + 64 * i, kt, nt);
      ra[i] = pa ? *(const uint4*)(pa + lc * 8) : uint4{0u, 0u, 0u, 0u};
      if (i < 2) rb[i] = *(const uint4*)(G::bptr(p, c, nt * 128 + lr + 64 * i, kt) + lc * 8);
    }
  };
  auto sstore = [&](int buf) __attribute__((always_inline)) {
#pragma unroll
    for (int i = 0; i < 4; i++) {
      *(uint4*)(sA + (buf * 256 + lr + 64 * i) * LDSS + lc * 8) = ra[i];
      if (i < 2) *(uint4*)(sB + (buf * 128 + lr + 64 * i) * LDSS + lc * 8) = rb[i];
    }
  };
  gload(0); sstore(0); __syncthreads();
  for (int kt = 0; kt < G::KT; kt++) {
    const int buf = kt & 1;
    if (kt + 1 < G::KT) gload(kt + 1);
#pragma unroll
    for (int ks = 0; ks < 2; ks++) {
      bf16x8 af[4], bf[4];
#pragma unroll
      for (int i = 0; i < 4; i++) {
        af[i] = *(const bf16x8*)(sA + (buf * 256 + wm * 64 + i * 16 + (lane & 15)) * LDSS + ks * 32 + (lane >> 4) * 8);
        bf[i] = *(const bf16x8*)(sB + (buf * 128 + wn * 64 + i * 16 + (lane & 15)) * LDSS + ks * 32 + (lane >> 4) * 8);
      }
#pragma unroll
      for (int n = 0; n < 4; n++)
#pragma unroll
        for (int m = 0; m < 4; m++) acc[n][m] = __builtin_amdgcn_mfma_f32_16x16x32_bf16(bf[n], af[m], acc[n][m], 0, 0, 0);
    }
    if (kt + 1 < G::KT) sstore(buf ^ 1);
    __syncthreads();
  }
  G::epi(p, c, acc, mt * 256 + wm * 64, nt * 128 + wn * 64, lane);
}

__device__ __forceinline__ void epi_resid(const P& p, const Ctx& c, f32x4 (&acc)[4][4], int m0, int n0, int lane) {
#pragma unroll
  for (int mi = 0; mi < 4; mi++) {
    int row = m0 + mi * 16 + (lane & 15); int mo; float* xr = xrowp(p, row, mo);
    if (mo == 2 && !c.wc) continue;
    const float* g = p.MOD + (size_t)(c.layer * 3 + mo) * 3072 + 2048;
#pragma unroll
    for (int ni = 0; ni < 4; ni++) {
      int n = n0 + ni * 16 + (lane >> 4) * 4;
      float4 xv = *(float4*)(xr + n); float4 gg = *(const float4*)(g + n);
      xv.x += gg.x * acc[ni][mi][0]; xv.y += gg.y * acc[ni][mi][1]; xv.z += gg.z * acc[ni][mi][2]; xv.w += gg.w * acc[ni][mi][3];
      *(float4*)(xr + n) = xv;
    }
  }
}

struct G_LruIn { static constexpr int KT = 16, NT = 20;
  static __device__ __forceinline__ const bfr* aptr(const P& p, const Ctx& c, int row, int kt, int nt) { return p.H + (size_t)row * 1024 + kt * 64; }
  static __device__ __forceinline__ const bfr* bptr(const P& p, const Ctx& c, int n, int kt) { return p.W + (size_t)n * 1024 + kt * 64; }
  static __device__ __forceinline__ void epi(const P& p, const Ctx& c, f32x4 (&acc)[4][4], int m0, int n0, int lane) {
    bfr* U = (bfr*)(p.ACT + A_U); bfr* Z = (bfr*)(p.ACT + A_Z);
#pragma unroll
    for (int ni = 0; ni < 4; ni++)
#pragma unroll
      for (int mi = 0; mi < 4; mi++) {
        int row = m0 + mi * 16 + (lane & 15), n = n0 + ni * 16 + (lane >> 4) * 4;
        bfr* dst = n < 1280 ? U + (size_t)row * 1280 + n : Z + (size_t)row * 1280 + (n - 1280);
        store4b(dst, acc[ni][mi]);
      }
  } };
struct G_LruGate { static constexpr int KT = 2, NT = 20;
  static __device__ __forceinline__ const bfr* aptr(const P& p, const Ctx& c, int row, int kt, int nt) { return (const bfr*)(p.ACT + A_UC) + (size_t)row * 1280 + (nt >> 1) * 128 + kt * 64; }
  static __device__ __forceinline__ const bfr* bptr(const P& p, const Ctx& c, int n, int kt) { return p.W + WL_GATE + c.d * 655360 + (size_t)n * 128 + kt * 64; }
  static __device__ __forceinline__ void epi(const P& p, const Ctx& c, f32x4 (&acc)[4][4], int m0, int n0, int lane) {
    const bfr* UC = (const bfr*)(p.ACT + A_UC); unsigned* AB = (unsigned*)(p.ACT + A_AB);
    const float* gb = p.lru_gate_b + (size_t)(c.j * 2 + c.d) * 2 * 1280; const float* lam = p.lru_lam + (size_t)(c.j * 2 + c.d) * 1280;
    int chb = (n0 >> 6) * 32;
#pragma unroll
    for (int ni = 0; ni < 2; ni++) {
      int ch = chb + ni * 16 + (lane >> 4) * 4;
      float cl[4], br[4], bi[4];
#pragma unroll
      for (int q = 0; q < 4; q++) { cl[q] = p.CL[(size_t)(c.j * 2 + c.d) * 1280 + ch + q]; br[q] = gb[ch + q]; bi[q] = gb[1280 + ch + q]; }
#pragma unroll
      for (int mi = 0; mi < 4; mi++) {
        int row = m0 + mi * 16 + (lane & 15);
        uint2 u = *(const uint2*)(UC + (size_t)row * 1280 + ch);
        float uc[4] = {blo(u.x), bhi(u.x), blo(u.y), bhi(u.y)};
        unsigned o[4];
#pragma unroll
        for (int q = 0; q < 4; q++) {
          float r = sigm(acc[ni][mi][q] + br[q]), ig = sigm(acc[ni + 2][mi][q] + bi[q]);
          float la = -cl[q] * r; float oma = 1.f - __expf(la); float bb = __builtin_amdgcn_sqrtf(oma * (2.f - oma)) * ig * uc[q];
          o[q] = (((unsigned)f2b(oma)) << 16) | (unsigned)f2b(bb);
        }
        *(uint4*)(AB + (size_t)row * 1280 + ch) = uint4{o[0], o[1], o[2], o[3]};
      }
    }
  } };
struct G_LruOut { static constexpr int KT = 20, NT = 8;
  static __device__ __forceinline__ const bfr* aptr(const P& p, const Ctx& c, int row, int kt, int nt) { return (const bfr*)(p.ACT + A_Z) + (size_t)row * 1280 + kt * 64; }
  static __device__ __forceinline__ const bfr* bptr(const P& p, const Ctx& c, int n, int kt) { return p.W + WL_OUT + (size_t)n * 1280 + kt * 64; }
  static __device__ __forceinline__ void epi(const P& p, const Ctx& c, f32x4 (&acc)[4][4], int m0, int n0, int lane) { epi_resid(p, c, acc, m0, n0, lane); } };
struct G_MlIn { static constexpr int KT = 16, NT = 33;
  static __device__ __forceinline__ const bfr* aptr(const P& p, const Ctx& c, int row, int kt, int nt) { return p.H + (size_t)row * 1024 + kt * 64; }
  static __device__ __forceinline__ const bfr* bptr(const P& p, const Ctx& c, int n, int kt) { return p.W + (size_t)n * 1024 + kt * 64; }
  static __device__ __forceinline__ void epi(const P& p, const Ctx& c, f32x4 (&acc)[4][4], int m0, int n0, int lane) {
    bfr* QKV = (bfr*)(p.ACT + A_QKV); float* GT = (float*)(p.ACT + A_GATE);
#pragma unroll
    for (int ni = 0; ni < 4; ni++)
#pragma unroll
      for (int mi = 0; mi < 4; mi++) {
        int row = m0 + mi * 16 + (lane & 15), n = n0 + ni * 16 + (lane >> 4) * 4;
        if (n < 4096) store4b(QKV + (size_t)row * 4096 + n, acc[ni][mi]);
        else if (n < 4128) *(float4*)(GT + (size_t)row * 32 + (n - 4096)) = float4{acc[ni][mi][0], acc[ni][mi][1], acc[ni][mi][2], acc[ni][mi][3]};
      }
  } };
struct G_MlZ { static constexpr int KT = 16, NT = 16;
  static __device__ __forceinline__ const bfr* aptr(const P& p, const Ctx& c, int row, int kt, int nt) { return p.H + (size_t)row * 1024 + kt * 64; }
  static __device__ __forceinline__ const bfr* bptr(const P& p, const Ctx& c, int n, int kt) { return p.W + WM_Z + (size_t)n * 1024 + kt * 64; }
  static __device__ __forceinline__ void epi(const P& p, const Ctx& c, f32x4 (&acc)[4][4], int m0, int n0, int lane) {
    bfr* HS = (bfr*)(p.ACT + A_HS); const float* RS = (const float*)(p.ACT + A_RSTD); const float* ng = p.ml_norm_g + (size_t)c.j * 2048;
#pragma unroll
    for (int ni = 0; ni < 4; ni++)
#pragma unroll
      for (int mi = 0; mi < 4; mi++) {
        int row = m0 + mi * 16 + (lane & 15), n = n0 + ni * 16 + (lane >> 4) * 4;
        bfr* hp = HS + (size_t)row * 2048 + n; uint2 u = *(const uint2*)hp; float rs = RS[(size_t)row * 8 + (n >> 8)];
        float4 g4 = *(const float4*)(ng + n);
        f32x4 o;
        o[0] = blo(u.x) * rs * g4.x * siluf(acc[ni][mi][0]); o[1] = bhi(u.x) * rs * g4.y * siluf(acc[ni][mi][1]);
        o[2] = blo(u.y) * rs * g4.z * siluf(acc[ni][mi][2]); o[3] = bhi(u.y) * rs * g4.w * siluf(acc[ni][mi][3]);
        store4b(hp, o);
      }
  } };
struct G_MlOut { static constexpr int KT = 32, NT = 8;
  static __device__ __forceinline__ const bfr* aptr(const P& p, const Ctx& c, int row, int kt, int nt) { return (const bfr*)(p.ACT + A_HS) + (size_t)row * 2048 + kt * 64; }
  static __device__ __forceinline__ const bfr* bptr(const P& p, const Ctx& c, int n, int kt) { return p.W + WM_OUT + (size_t)n * 2048 + kt * 64; }
  static __device__ __forceinline__ void epi(const P& p, const Ctx& c, f32x4 (&acc)[4][4], int m0, int n0, int lane) { epi_resid(p, c, acc, m0, n0, lane); } };
struct G_R7In { static constexpr int KT = 32, NT = 34;
  static __device__ __forceinline__ const bfr* aptr(const P& p, const Ctx& c, int row, int kt, int nt) {
    if (kt < 16) return p.H + (size_t)row * 1024 + kt * 64;
    int q = (kt - 16) >> 2; int b = row / BT_, o = row - b * BT_; int nr;
    if (o < 256) { if (q < 2) { if (o < 1) return nullptr; nr = row - 1; } else { if (o >= 255) return nullptr; nr = row + 1; } }
    else { int t = o - 256, col = t & 63, gr = t >> 6;
      if (q == 0) { if (col == 0) return nullptr; nr = row - 1; }
      else if (q == 1) { if (col == 63) return nullptr; nr = row + 1; }
      else if (q == 2) { if (gr == 0) return nullptr; nr = row - 64; }
      else { if (gr == 255) return nullptr; nr = row + 64; } }
    return p.H + (size_t)nr * 1024 + (kt - 16) * 64; }
  static __device__ __forceinline__ const bfr* bptr(const P& p, const Ctx& c, int n, int kt) { return p.W + (size_t)n * 2048 + kt * 64; }
  static __device__ __forceinline__ void epi(const P& p, const Ctx& c, f32x4 (&acc)[4][4], int m0, int n0, int lane) {
    bfr* RK = (bfr*)(p.ACT + A_RKVZ); bfr* WMb = (bfr*)(p.ACT + A_WM); bfr* AMb = (bfr*)(p.ACT + A_AM);
#pragma unroll
    for (int ni = 0; ni < 4; ni++)
#pragma unroll
      for (int mi = 0; mi < 4; mi++) {
        int row = m0 + mi * 16 + (lane & 15), n = n0 + ni * 16 + (lane >> 4) * 4;
        if (n < 4096) store4b(RK + (size_t)row * 4096 + n, acc[ni][mi]);
        else if (n < 4224) { f32x4 t;
#pragma unroll
          for (int q = 0; q < 4; q++) t[q] = tanhf(acc[ni][mi][q]); store4b(WMb + (size_t)row * 128 + (n - 4096), t); }
        else store4b(AMb + (size_t)row * 128 + (n - 4224), acc[ni][mi]);
      }
  } };
struct G_R7Out { static constexpr int KT = 16, NT = 8;
  static __device__ __forceinline__ const bfr* aptr(const P& p, const Ctx& c, int row, int kt, int nt) { return p.H + (size_t)row * 1024 + kt * 64; }
  static __device__ __forceinline__ const bfr* bptr(const P& p, const Ctx& c, int n, int kt) { return p.W + WR_OUT + (size_t)n * 1024 + kt * 64; }
  static __device__ __forceinline__ void epi(const P& p, const Ctx& c, f32x4 (&acc)[4][4], int m0, int n0, int lane) { epi_resid(p, c, acc, m0, n0, lane); } };


namespace pg8 {
#define PG8_LAS __attribute__((address_space(3)))
constexpr int BM = 256, BK = 64, HALF = 128, HTB = HALF * BK * 2, NXCD = 8, WGM = 8;
__device__ __forceinline__ int lds_byte(int r, int c) { const int st = (r >> 4) * 2 + (c >> 5), rr = r & 15, cc = c & 31, ob = rr * 64 + cc * 2; return st * 1024 + (ob ^ (((ob >> 9) & 1) << 5)); }
__device__ __forceinline__ void stage_rc(int b, int& R, int& C) { const int st = b / 1024, sb = b % 1024, swz = sb ^ (((sb >> 9) & 1) << 5); R = (st >> 1) * 16 + swz / 64; C = (st & 1) * 32 + (swz % 64) / 2; }
struct Unit { int pm, pn; };
struct Gemm { const bfr* A; const bfr* Bt; int M, N, K; };
struct StaticOrder {
  int nM, nN, nwg, G, c;
  __device__ void init(int M, int N, int G_, int c_) { nM = M / BM; nN = N / BM; nwg = nM * nN; G = G_; c = c_; }
  __device__ bool next(int i, Unit& u) const {
    const long L = (long)i * G + c; if (L >= nwg) return false;
    int wgid = (int)L; { const int q = nwg / NXCD, r = nwg % NXCD, xcd = wgid % NXCD, off = wgid / NXCD; wgid = (xcd < r ? xcd * (q + 1) : r * (q + 1) + (xcd - r) * q) + off; }
    const int nig = WGM * nN, gid = wgid / nig, fm = gid * WGM, gsz = (nM - fm) < WGM ? (nM - fm) : WGM;
    u.pm = fm + ((wgid % nig) % gsz); u.pn = (wgid % nig) / gsz; return true;
  }
};
template <class Epi>
__device__ __forceinline__ void gemm_phase(PG8_LAS unsigned char* lds, const Gemm g, const StaticOrder& S, const Epi& E) {
  const int tid = ltid(), wid = __builtin_amdgcn_readfirstlane(tid >> 6), lane = tid & 63, wr = wid >> 2, wc = wid & 3, fr = lane & 15, fq = lane >> 4;
  const int K = g.K, nt = K / BK;
  unsigned voffA[2], voffB[2];
#pragma unroll
  for (int i = 0; i < 2; ++i) { int R, C; stage_rc(tid * 16 + i * 8192, R, C); voffA[i] = (unsigned)(R * K + C) * 2u; voffB[i] = voffA[i]; }
  const size_t kstep = (size_t)(BK * 2);
  const size_t hstep = (size_t)HALF * K * 2;
  const size_t tstep = 2 * hstep;
  const unsigned ldsw = (unsigned)wid * 1024u;
  const int aoff = lds_byte(wr * 64 + fr, fq * 8), boff = lds_byte(wc * 32 + fr, fq * 8);
#define PG8_SA(b, h) (((b) * 2 + (h)) * HTB)
#define PG8_SB(b, h) ((4 + (b) * 2 + (h)) * HTB)
#define PG8_STAGE(bufoff, gbase, voff) do { _Pragma("unroll") for (int _i = 0; _i < 2; ++_i) \
    __builtin_amdgcn_global_load_lds((const unsigned*)((const char*)(gbase) + (voff)[_i]), (PG8_LAS unsigned*)(lds + (bufoff) + ldsw + _i * 8192), 16, 0, 0); } while (0)
#define PG8_LDA(dst, b, h) do { _Pragma("unroll") for (int m = 0; m < 4; ++m) _Pragma("unroll") for (int k = 0; k < 2; ++k) dst[m][k] = *(const PG8_LAS bf16x8*)(lds + PG8_SA(b, h) + aoff + m * 2048 + k * 1024); } while (0)
#define PG8_LDB(dst, b, h) do { _Pragma("unroll") for (int n = 0; n < 2; ++n) _Pragma("unroll") for (int k = 0; k < 2; ++k) dst[n][k] = *(const PG8_LAS bf16x8*)(lds + PG8_SB(b, h) + boff + n * 2048 + k * 1024); } while (0)
#define PG8_MMA(ai, bj, At, Bt) do { __builtin_amdgcn_s_setprio(1); _Pragma("unroll") for (int m = 0; m < 4; ++m) _Pragma("unroll") for (int n = 0; n < 2; ++n) _Pragma("unroll") for (int k = 0; k < 2; ++k) \
    acc[ai][bj][m][n] = __builtin_amdgcn_mfma_f32_16x16x32_bf16(Bt[n][k], At[m][k], acc[ai][bj][m][n], 0, 0, 0); __builtin_amdgcn_s_setprio(0); } while (0)
#define PG8_WAIT_V(n) asm volatile("s_waitcnt vmcnt(" #n ")" ::: "memory")
#define PG8_WAIT_L(n) asm volatile("s_waitcnt lgkmcnt(" #n ")" ::: "memory")
#define PG8_BAR __builtin_amdgcn_s_barrier()
#define PG8_SCHED __builtin_amdgcn_sched_barrier(0)
  Unit cur, nxt; int ui = 0;
  if (!S.next(0, cur)) return;
  f32x4 acc[2][2][4][2];
#pragma unroll
  for (int a = 0; a < 2; ++a)
#pragma unroll
    for (int b = 0; b < 2; ++b)
#pragma unroll
      for (int m = 0; m < 4; ++m)
#pragma unroll
        for (int n = 0; n < 2; ++n) acc[a][b][m][n] = (f32x4){0.f, 0.f, 0.f, 0.f};
  bf16x8 At[4][2], B0[2][2], B1[2][2];
  const char* cA = (const char*)g.A + (size_t)cur.pm * tstep; const char* cB = (const char*)g.Bt + (size_t)cur.pn * tstep;
  PG8_STAGE(PG8_SB(0, 0), cB, voffB); PG8_STAGE(PG8_SA(0, 0), cA, voffA); PG8_STAGE(PG8_SB(0, 1), cB + hstep, voffB); PG8_STAGE(PG8_SA(0, 1), cA + hstep, voffA);
  if (wr == 1) PG8_BAR;
  PG8_WAIT_V(4); PG8_BAR;
  PG8_STAGE(PG8_SB(1, 0), cB + kstep, voffB); PG8_STAGE(PG8_SA(1, 0), cA + kstep, voffA); PG8_STAGE(PG8_SB(1, 1), cB + hstep + kstep, voffB);
  PG8_WAIT_V(6); PG8_BAR;
  for (;;) {
    const bool has_next = S.next(ui + 1, nxt);
    const char* nA = has_next ? (const char*)g.A + (size_t)nxt.pm * tstep : cA; const char* nB = has_next ? (const char*)g.Bt + (size_t)nxt.pn * tstep : cB;
    for (int t = 0; t < nt; t += 2) {
      const bool last = (t == nt - 2);
      const char* a1 = cA + (size_t)(t + 1) * kstep;
      const char* a2 = last ? nA : cA + (size_t)(t + 2) * kstep; const char* b2 = last ? nB : cB + (size_t)(t + 2) * kstep;
      const char* a3 = a2 + kstep; const char* b3 = b2 + kstep;
      PG8_LDB(B0, 0, 0); PG8_SCHED; PG8_LDA(At, 0, 0); PG8_STAGE(PG8_SA(1, 1), a1 + hstep, voffA);
      PG8_WAIT_L(8); PG8_BAR; PG8_WAIT_L(0); PG8_MMA(0, 0, At, B0); PG8_BAR; PG8_SCHED;
      PG8_LDB(B1, 0, 1); PG8_STAGE(PG8_SB(0, 0), b2, voffB);
      PG8_BAR; PG8_WAIT_L(0); PG8_MMA(0, 1, At, B1); PG8_BAR;
      PG8_LDA(At, 0, 1); PG8_STAGE(PG8_SA(0, 0), a2, voffA);
      PG8_BAR; PG8_WAIT_L(0); PG8_MMA(1, 0, At, B0); PG8_BAR; PG8_SCHED;
      PG8_STAGE(PG8_SB(0, 1), b2 + hstep, voffB);
      PG8_WAIT_V(6); PG8_BAR; PG8_MMA(1, 1, At, B1); PG8_BAR;
      PG8_LDB(B0, 1, 0); PG8_SCHED; PG8_LDA(At, 1, 0); PG8_STAGE(PG8_SA(0, 1), a2 + hstep, voffA);
      PG8_WAIT_L(8); PG8_BAR; PG8_WAIT_L(0); PG8_MMA(0, 0, At, B0); PG8_BAR; PG8_SCHED;
      PG8_LDB(B1, 1, 1); PG8_STAGE(PG8_SB(1, 0), b3, voffB);
      PG8_BAR; PG8_WAIT_L(0); PG8_MMA(0, 1, At, B1); PG8_BAR;
      PG8_LDA(At, 1, 1); PG8_STAGE(PG8_SA(1, 0), a3, voffA);
      PG8_BAR; PG8_WAIT_L(0); PG8_MMA(1, 0, At, B0); PG8_BAR; PG8_SCHED;
      PG8_STAGE(PG8_SB(1, 1), b3 + hstep, voffB);
      PG8_WAIT_V(6); PG8_BAR; PG8_MMA(1, 1, At, B1); PG8_BAR;
    }
    E(acc, cur, wr, wc, fr, fq);
    if (!has_next) break;
#pragma unroll
    for (int a = 0; a < 2; ++a)
#pragma unroll
      for (int b = 0; b < 2; ++b)
#pragma unroll
        for (int m = 0; m < 4; ++m)
#pragma unroll
          for (int n = 0; n < 2; ++n) acc[a][b][m][n] = (f32x4){0.f, 0.f, 0.f, 0.f};
    cur = nxt; cA = nA; cB = nB; ++ui;
  }
  PG8_WAIT_V(0);
  if (wr == 0) PG8_BAR;
  PG8_BAR;
#undef PG8_SA
#undef PG8_SB
#undef PG8_STAGE
#undef PG8_LDA
#undef PG8_LDB
#undef PG8_MMA
#undef PG8_WAIT_V
#undef PG8_WAIT_L
#undef PG8_BAR
#undef PG8_SCHED
}
}

template <class F> struct EpiAd {
  F f;
  __device__ __forceinline__ void operator()(const f32x4 (&acc)[2][2][4][2], const pg8::Unit& u, int wr, int wc, int fr, int fq) const {
#pragma unroll
    for (int ai = 0; ai < 2; ++ai)
#pragma unroll
      for (int m = 0; m < 4; ++m) { const int row = u.pm * 256 + ai * 128 + wr * 64 + m * 16 + fr;
#pragma unroll
        for (int bj = 0; bj < 2; ++bj)
#pragma unroll
          for (int n = 0; n < 2; ++n) f(row, u.pn * 256 + bj * 128 + wc * 32 + n * 16 + 4 * fq, acc[ai][bj][m][n]); }
  }
};
template <class F> __device__ __forceinline__ void big_gemm(char* smem, const bfr* A, const bfr* Bt, int N, int K, F f) {
  pg8::Gemm g; g.A = A; g.Bt = Bt; g.M = R_; g.N = N; g.K = K;
  pg8::StaticOrder S; S.init(R_, N, (int)gridDim.x, (int)blockIdx.x);
  EpiAd<F> E{f};
  pg8::gemm_phase(( __attribute__((address_space(3))) unsigned char*)smem, g, S, E);
}
struct F_LruIn { char* ACT; __device__ __forceinline__ void operator()(int row, int n, f32x4 v) const {
  bfr* dst = n < 1280 ? (bfr*)(ACT + A_U) + (size_t)row * 1280 + n : (bfr*)(ACT + A_Z) + (size_t)row * 1280 + (n - 1280); store4b(dst, v); } };
struct F_Resid { float* Xx; float* Xc; const float* MODg; int wc; __device__ __forceinline__ void operator()(int row, int n, f32x4 v) const {
  int b = row / BT_, o = row - b * BT_; bool isc = o < 256; if (isc && !wc) return;
  float* xr = isc ? Xc + (size_t)(b * 256 + o) * 1024 : Xx + (size_t)(b * 16384 + o - 256) * 1024; const float* g = MODg + (size_t)(isc ? 2 : b) * 3072 + 2048;
  float4 xv = *(float4*)(xr + n); float4 gg = *(const float4*)(g + n);
  xv.x += gg.x * v[0]; xv.y += gg.y * v[1]; xv.z += gg.z * v[2]; xv.w += gg.w * v[3]; *(float4*)(xr + n) = xv; } };
struct F_MlIn { char* ACT; __device__ __forceinline__ void operator()(int row, int n, f32x4 v) const {
  if (n < 4096) store4b((bfr*)(ACT + A_QKV) + (size_t)row * 4096 + n, v);
  else if (n < 4128) *(float4*)((float*)(ACT + A_GATE) + (size_t)row * 32 + (n - 4096)) = float4{v[0], v[1], v[2], v[3]}; } };
struct F_MlZ { char* ACT; const float* ng; __device__ __forceinline__ void operator()(int row, int n, f32x4 v) const {
  bfr* hp = (bfr*)(ACT + A_HS) + (size_t)row * 2048 + n; uint2 u = *(const uint2*)hp; float rs = ((const float*)(ACT + A_RSTD))[(size_t)row * 8 + (n >> 8)];
  float4 g4 = *(const float4*)(ng + n); f32x4 o;
  o[0] = blo(u.x) * rs * g4.x * siluf(v[0]); o[1] = bhi(u.x) * rs * g4.y * siluf(v[1]); o[2] = blo(u.y) * rs * g4.z * siluf(v[2]); o[3] = bhi(u.y) * rs * g4.w * siluf(v[3]);
  store4b(hp, o); } };
struct F_R7In { char* ACT; __device__ __forceinline__ void operator()(int row, int n, f32x4 v) const {
  if (n < 4096) store4b((bfr*)(ACT + A_RKVZ) + (size_t)row * 4096 + n, v);
  else if (n < 4224) { f32x4 t;
#pragma unroll
    for (int q = 0; q < 4; q++) t[q] = tanhf(v[q]);
    store4b((bfr*)(ACT + A_WM) + (size_t)row * 128 + (n - 4096), t); }
  else store4b((bfr*)(ACT + A_AM) + (size_t)row * 128 + (n - 4224), v); } };

template <class G> __device__ __forceinline__ void gemm_phase(const P& p, const Ctx& c, char* smem) {
  const int total = 130 * G::NT;
  for (int it = blockIdx.x; it < total; it += gridDim.x) gemm_tile<G>(p, c, it / G::NT, it % G::NT, smem);
}

#define R7_Y2 ((bfr*)p.H + (size_t)64 * 26 * 16384)
template <class G> __device__ __forceinline__ void gemm_phase_k2(const P& p, const Ctx& c, char* smem) {
  const int tid = ltid(), lane = tid & 63, wid = tid >> 6, wm = wid & 3, wn = wid >> 2;
  bfr* sA = (bfr*)smem; bfr* sB = sA + 2 * 256 * LDSS;
  const int lr = tid >> 3, lc = tid & 7;
  const int total = 130 * G::NT;
  uint4 a00, a01, a02, a03, a10, a11, a12, a13, b00, b01, b10, b11;
#define GK2_LA(i_, R0, R1) { R0 = *(const uint4*)(G::aptr(p, c, mt_ * 256 + lr + 64 * (i_), 0, nt_) + lc * 8); R1 = *(const uint4*)(G::aptr(p, c, mt_ * 256 + lr + 64 * (i_), 1, nt_) + lc * 8); }
#define GK2_LB(i_, R0, R1) { R0 = *(const uint4*)(G::bptr(p, c, nt_ * 128 + lr + 64 * (i_), 0) + lc * 8); R1 = *(const uint4*)(G::bptr(p, c, nt_ * 128 + lr + 64 * (i_), 1) + lc * 8); }
#define GK2_LOAD(it_) { const int mt_ = (it_) / G::NT, nt_ = (it_) % G::NT; GK2_LA(0, a00, a10) GK2_LA(1, a01, a11) GK2_LA(2, a02, a12) GK2_LA(3, a03, a13) GK2_LB(0, b00, b10) GK2_LB(1, b01, b11) }
#define GK2_SA(i_, R0, R1) { *(uint4*)(sA + (lr + 64 * (i_)) * LDSS + lc * 8) = R0; *(uint4*)(sA + (256 + lr + 64 * (i_)) * LDSS + lc * 8) = R1; }
#define GK2_SB(i_, R0, R1) { *(uint4*)(sB + (lr + 64 * (i_)) * LDSS + lc * 8) = R0; *(uint4*)(sB + (128 + lr + 64 * (i_)) * LDSS + lc * 8) = R1; }
  int it = xcd_swz();
  if (it < total) GK2_LOAD(it)
  while (it < total) {
    const int mt = it / G::NT, nt = it % G::NT;
    GK2_SA(0, a00, a10) GK2_SA(1, a01, a11) GK2_SA(2, a02, a12) GK2_SA(3, a03, a13) GK2_SB(0, b00, b10) GK2_SB(1, b01, b11)
    __syncthreads();
    const int itn = it + gridDim.x;
    if (itn < total) GK2_LOAD(itn)
    f32x4 acc[4][4];
#pragma unroll
    for (int a = 0; a < 4; a++)
#pragma unroll
      for (int b = 0; b < 4; b++) acc[a][b] = f32x4{0.f, 0.f, 0.f, 0.f};
#pragma unroll
    for (int buf = 0; buf < 2; buf++)
#pragma unroll
      for (int ks = 0; ks < 2; ks++) {
        bf16x8 af[4], bf[4];
#pragma unroll
        for (int i = 0; i < 4; i++) {
          af[i] = *(const bf16x8*)(sA + (buf * 256 + wm * 64 + i * 16 + (lane & 15)) * LDSS + ks * 32 + (lane >> 4) * 8);
          bf[i] = *(const bf16x8*)(sB + (buf * 128 + wn * 64 + i * 16 + (lane & 15)) * LDSS + ks * 32 + (lane >> 4) * 8);
        }
#pragma unroll
        for (int n = 0; n < 4; n++)
#pragma unroll
          for (int m = 0; m < 4; m++) acc[n][m] = __builtin_amdgcn_mfma_f32_16x16x32_bf16(bf[n], af[m], acc[n][m], 0, 0, 0);
      }
    G::epi(p, c, acc, mt * 256 + wm * 64, nt * 128 + wn * 64, lane);
    __syncthreads();
    it = itn;
  }
#undef GK2_LOAD
#undef GK2_LA
#undef GK2_LB
#undef GK2_SA
#undef GK2_SB
}

__device__ __forceinline__ void ph_pre(const P& p, char* smem) {
  float* sm = (float*)smem; const int tid = ltid();
  const int nprep = prep_count(0), ngemv = 192, ncopy = 4160;
  if (blockIdx.x == 0) for (int i = tid; i < 5120; i += 512) p.CL[i] = 8.f * softplusf(-p.lru_lam[i]);
  for (int it = blockIdx.x; it < nprep + ngemv + ncopy; it += gridDim.x) {
    if (it < nprep) { prep_item(p, 0, it, sm); continue; }
    int i2 = it - nprep;
    if (i2 < ngemv) {
      int l = i2 / 48, cgp = i2 % 48;
      for (int i = tid; i < 3072; i += 512) { int cnd = i >> 10, k = i & 1023; float v = cnd == 0 ? p.c[k] : cnd == 1 ? p.c[1024 + k] : p.c_ctx[k]; sm[i] = siluf(v); }
      __syncthreads();
      int kq = tid >> 6, col = cgp * 64 + (tid & 63); const float* w = p.mod_w + (size_t)l * 1024 * 3072 + col;
      float a0 = 0.f, a1 = 0.f, a2 = 0.f;
      for (int k = kq * 128; k < kq * 128 + 128; k++) { float wv = w[(size_t)k * 3072]; a0 += sm[k] * wv; a1 += sm[1024 + k] * wv; a2 += sm[2048 + k] * wv; }
      float* red = sm + 3072; red[tid * 3] = a0; red[tid * 3 + 1] = a1; red[tid * 3 + 2] = a2;
      __syncthreads();
      if (tid < 64) { float bias = p.mod_b[(size_t)l * 3072 + col];
        for (int cnd = 0; cnd < 3; cnd++) { float s = bias; for (int q = 0; q < 8; q++) s += red[(q * 64 + tid) * 3 + cnd]; p.MOD[(size_t)(l * 3 + cnd) * 3072 + col] = s; } }
      __syncthreads();
      continue;
    }
    i2 -= ngemv;
    for (int q = 0; q < 4; q++) { int idx = i2 * 2048 + q * 512 + tid; int row = idx >> 8, c4 = idx & 255; int b = row / BT_, o = row - b * BT_;
      if (o < 256) ((float4*)p.Xc)[(size_t)(b * 256 + o) * 256 + c4] = ((const float4*)p.ctx)[(size_t)(b * 256 + o) * 256 + c4];
      else ((float4*)p.Xx)[(size_t)(b * 16384 + o - 256) * 256 + c4] = ((const float4*)p.x)[(size_t)(b * 16384 + o - 256) * 256 + c4]; }
  }
}
__device__ __forceinline__ void ph_norm(const P& p, int layer, char* smem) {
  const int tid = ltid(), lane = tid & 63, wid = tid >> 6;
  const int nprep = layer > 0 ? prep_count(layer) : 0; const int kind = layer % 3;
  const int nzero = kind == 1 ? 8320 : 0;
  (void)nzero;
  for (int it = blockIdx.x; it < nprep + 4160; it += gridDim.x) {
    if (it < nprep) { prep_item(p, layer, it, (float*)smem); continue; }
    int row = (it - nprep) * 8 + wid; int mo; const float* xr = xrowp(p, row, mo);
    float4 v[4]; float ss = 0.f;
#pragma unroll
    for (int i = 0; i < 4; i++) { v[i] = *(const float4*)(xr + lane * 4 + 256 * i); ss += v[i].x * v[i].x + v[i].y * v[i].y + v[i].z * v[i].z + v[i].w * v[i].w; }
    ss = wsum(ss); float rs = rsqrtf(ss * (1.f / 1024.f) + 1e-6f);
    const float* g = p.norm_g + (size_t)layer * 1024; const float* md = p.MOD + (size_t)(layer * 3 + mo) * 3072;
#pragma unroll
    for (int i = 0; i < 4; i++) { int cidx = lane * 4 + 256 * i; float4 gg = *(const float4*)(g + cidx), sh = *(const float4*)(md + cidx), sc = *(const float4*)(md + 1024 + cidx);
      f32x4 o; o[0] = v[i].x * rs * gg.x * (1.f + sc.x) + sh.x; o[1] = v[i].y * rs * gg.y * (1.f + sc.y) + sh.y; o[2] = v[i].z * rs * gg.z * (1.f + sc.z) + sh.z; o[3] = v[i].w * rs * gg.w * (1.f + sc.w) + sh.w;
      store4b(p.H + (size_t)row * (kind == 2 ? 2048 : 1024) + cidx, o); }
  }
}
__device__ __forceinline__ void ph_r7_shift(const P& p) {
  for (int it = blockIdx.x; it < 8320; it += gridDim.x) {
    int idx = it * 512 + ltid(); int row = idx >> 7, c8 = idx & 127, q = c8 >> 5;
    int b = row / BT_, o = row - b * BT_; int nr = -1;
    if (o < 256) { if (q < 2) { if (o >= 1) nr = row - 1; } else { if (o < 255) nr = row + 1; } }
    else { int t = o - 256, col = t & 63, gr = t >> 6;
      if (q == 0) { if (col != 0) nr = row - 1; } else if (q == 1) { if (col != 63) nr = row + 1; }
      else if (q == 2) { if (gr != 0) nr = row - 64; } else { if (gr != 255) nr = row + 64; } }
    uint4 v = nr >= 0 ? *(const uint4*)(p.H + (size_t)nr * 2048 + c8 * 8) : uint4{0u, 0u, 0u, 0u};
    *(uint4*)(p.H + (size_t)row * 2048 + 1024 + c8 * 8) = v;
  }
}
__device__ __forceinline__ void ph_final(const P& p) {
  const int lane = ltid() & 63, wid = ltid() >> 6;
  for (int it = blockIdx.x; it < 4096; it += gridDim.x) {
    float* xr = p.Xx + (size_t)(it * 8 + wid) * 1024; float4 v[4]; float ss = 0.f;
#pragma unroll
    for (int i = 0; i < 4; i++) { v[i] = *(const float4*)(xr + lane * 4 + 256 * i); ss += v[i].x * v[i].x + v[i].y * v[i].y + v[i].z * v[i].z + v[i].w * v[i].w; }
    ss = wsum(ss); float rs = rsqrtf(ss * (1.f / 1024.f) + 1e-6f);
#pragma unroll
    for (int i = 0; i < 4; i++) { int cidx = lane * 4 + 256 * i; float4 gg = *(const float4*)(p.final_g + cidx);
      *(float4*)(xr + cidx) = float4{v[i].x * rs * gg.x, v[i].y * rs * gg.y, v[i].z * rs * gg.z, v[i].w * rs * gg.w}; }
  }
}
__device__ __forceinline__ void ph_lru_conv(const P& p, int j) {
  const bfr* U = (const bfr*)(p.ACT + A_U); bfr* UC = (bfr*)(p.ACT + A_UC);
  const float* cw = p.lru_conv_w + (size_t)j * 4 * 1280; const float* cb = p.lru_conv_b + (size_t)j * 1280;
  for (int it = xcd_swz(); it < 10400; it += gridDim.x) {
    int idx = it * 512 + ltid(); int row = idx / 160, cgp = idx % 160, ch = cgp * 8;
    int b = row / BT_, o = row - b * BT_; int s0 = o < 256 ? 0 : 256, e0 = o < 256 ? 256 : BT_;
    float acc[8];
#pragma unroll
    for (int e = 0; e < 8; e++) acc[e] = cb[ch + e];
#pragma unroll
    for (int t = 0; t < 4; t++) { int oo = o + t - 2; if (oo < s0 || oo >= e0) continue;
      uint4 u = *(const uint4*)(U + (size_t)(row + t - 2) * 1280 + ch); const float* w = cw + t * 1280 + ch;
      acc[0] += w[0] * blo(u.x); acc[1] += w[1] * bhi(u.x); acc[2] += w[2] * blo(u.y); acc[3] += w[3] * bhi(u.y);
      acc[4] += w[4] * blo(u.z); acc[5] += w[5] * bhi(u.z); acc[6] += w[6] * blo(u.w); acc[7] += w[7] * bhi(u.w); }
    *(uint4*)(UC + (size_t)row * 1280 + ch) = uint4{pk2(acc[0], acc[1]), pk2(acc[2], acc[3]), pk2(acc[4], acc[5]), pk2(acc[6], acc[7])};
  }
}
__device__ __forceinline__ void ph_lru_s1(const P& p, int d) {
  const unsigned* AB = (const unsigned*)(p.ACT + A_AB); float2* AGG = (float2*)(p.ACT + A_AGG);
  const int t = ltid();
  for (int it = xcd_swz() * 8 + (t >> 6); it < 2600; it += gridDim.x * 8) {
    int b = it / 1300, r = it % 1300, cc = r / 5, ch = (r % 5) * 256 + (t & 63) * 4;
    float P0 = 1.f, Q0 = 0.f, P1 = 1.f, Q1 = 0.f, P2 = 1.f, Q2 = 0.f, P3 = 1.f, Q3 = 0.f;
#pragma unroll 8
    for (int q = 0; q < 64; q++) { uint4 u = *(const uint4*)(AB + (size_t)rowmap(d, b, cc * 64 + q) * 1280 + ch);
      float a0 = 1.f - bhi(u.x), a1 = 1.f - bhi(u.y), a2 = 1.f - bhi(u.z), a3 = 1.f - bhi(u.w);
      P0 *= a0; Q0 = a0 * Q0 + blo(u.x); P1 *= a1; Q1 = a1 * Q1 + blo(u.y); P2 *= a2; Q2 = a2 * Q2 + blo(u.z); P3 *= a3; Q3 = a3 * Q3 + blo(u.w); }
    float4* ag = (float4*)(AGG + (size_t)(b * NCH_ + cc) * 1280 + ch); ag[0] = float4{P0, Q0, P1, Q1}; ag[1] = float4{P2, Q2, P3, Q3};
  }
}
__device__ __forceinline__ void ph_lru_s2(const P& p, char* smem) {
  const float2* AGG = (const float2*)(p.ACT + A_AGG); float* CAR = (float*)(p.ACT + A_CAR);
  float* sP = (float*)smem; float* sQ = sP + 512;
  const int tid = ltid(), chl = tid & 63, seg = tid >> 6;
  for (int it = blockIdx.x; it < 40; it += gridDim.x) {
    const int b = it / 20, ch = (it % 20) * 64 + chl; const int cb = seg * 33, ce = cb + 33 < NCH_ ? cb + 33 : NCH_;
    float Pp = 1.f, Q = 0.f;
#pragma unroll 11
    for (int cc = cb; cc < ce; cc++) { float2 a = AGG[(size_t)(b * NCH_ + cc) * 1280 + ch]; Pp *= a.x; Q = a.x * Q + a.y; }
    __syncthreads();
    sP[seg * 64 + chl] = Pp; sQ[seg * 64 + chl] = Q;
    __syncthreads();
    float h = 0.f;
    for (int s2 = 0; s2 < seg; s2++) h = sP[s2 * 64 + chl] * h + sQ[s2 * 64 + chl];
#pragma unroll 11
    for (int cc = cb; cc < ce; cc++) { size_t o = (size_t)(b * NCH_ + cc) * 1280 + ch; float2 a = AGG[o]; CAR[o] = h; h = a.x * h + a.y; }
  }
}
__device__ __forceinline__ void ph_lru_s3(const P& p, int d) {
  const unsigned* AB = (const unsigned*)(p.ACT + A_AB); const float* CAR = (const float*)(p.ACT + A_CAR);
  bfr* HF = (bfr*)(p.ACT + A_HF); bfr* Z = (bfr*)(p.ACT + A_Z);
  const int t = ltid();
  for (int it = xcd_swz() * 8 + (t >> 6); it < 2600; it += gridDim.x * 8) {
    int b = it / 1300, r = it % 1300, cc = r / 5, ch = (r % 5) * 256 + (t & 63) * 4;
    float4 h = *(const float4*)(CAR + (size_t)(b * NCH_ + cc) * 1280 + ch);
#pragma unroll 8
    for (int q = 0; q < 64; q++) { size_t o = (size_t)rowmap(d, b, cc * 64 + q) * 1280 + ch; uint4 u = *(const uint4*)(AB + o);
      h.x = (1.f - bhi(u.x)) * h.x + blo(u.x); h.y = (1.f - bhi(u.y)) * h.y + blo(u.y); h.z = (1.f - bhi(u.z)) * h.z + blo(u.z); h.w = (1.f - bhi(u.w)) * h.w + blo(u.w);
      if (d == 0) *(uint2*)(HF + o) = uint2{pk2(h.x, h.y), pk2(h.z, h.w)};
      else { uint2 hf = *(const uint2*)(HF + o), zz = *(const uint2*)(Z + o);
        *(uint2*)(Z + o) = uint2{pk2((blo(hf.x) + h.x) * siluf(blo(zz.x)), (bhi(hf.x) + h.y) * siluf(bhi(zz.x))), pk2((blo(hf.y) + h.z) * siluf(blo(zz.y)), (bhi(hf.y) + h.w) * siluf(bhi(zz.y)))}; } }
  }
}
__device__ __forceinline__ void ph_ml_stat(const P& p) {
  const bfr* HS = (const bfr*)(p.ACT + A_HS); float* RS = (float*)(p.ACT + A_RSTD);
  const int lane = ltid() & 63, wid = ltid() >> 6;
  for (int it = blockIdx.x; it < 4160; it += gridDim.x) {
    int row = it * 8 + wid; const bfr* hp = HS + (size_t)row * 2048 + lane * 32; float ss = 0.f;
#pragma unroll
    for (int i = 0; i < 4; i++) { uint4 u = *(const uint4*)(hp + i * 8); float a;
      a = blo(u.x); ss += a * a; a = bhi(u.x); ss += a * a; a = blo(u.y); ss += a * a; a = bhi(u.y); ss += a * a;
      a = blo(u.z); ss += a * a; a = bhi(u.z); ss += a * a; a = blo(u.w); ss += a * a; a = bhi(u.w); ss += a * a; }
    ss += __shfl_xor(ss, 1); ss += __shfl_xor(ss, 2); ss += __shfl_xor(ss, 4);
    if ((lane & 7) == 0) RS[(size_t)row * 8 + (lane >> 3)] = rsqrtf(ss * (1.f / 256.f) + 1e-6f);
  }
}
__device__ __forceinline__ void ph_r7_fin(const P& p, int j) {
  bfr* Y = (bfr*)(p.ACT + A_Y); const bfr* RK = (const bfr*)(p.ACT + A_RKVZ); const float* BON = (const float*)(p.ACT + A_BON);
  const float* lg = p.r7_ln_g + (size_t)j * 1024; const float* lb = p.r7_ln_b + (size_t)j * 1024;
  const int lane = ltid() & 63, wid = ltid() >> 6;
  for (int it = blockIdx.x; it < 4160; it += gridDim.x) {
    int row = it * 8 + wid, ch = lane * 16, hd = lane >> 2;
    float y[16], v[16], z[16];
#pragma unroll
    for (int i = 0; i < 2; i++) {
      uint4 u = *(const uint4*)(Y + (size_t)row * 1024 + ch + i * 8); const uint4 u2 = *(const uint4*)(R7_Y2 + (size_t)row * 1024 + ch + i * 8);
      y[i * 8 + 0] = blo(u.x) + blo(u2.x); y[i * 8 + 1] = bhi(u.x) + bhi(u2.x); y[i * 8 + 2] = blo(u.y) + blo(u2.y); y[i * 8 + 3] = bhi(u.y) + bhi(u2.y); y[i * 8 + 4] = blo(u.z) + blo(u2.z); y[i * 8 + 5] = bhi(u.z) + bhi(u2.z); y[i * 8 + 6] = blo(u.w) + blo(u2.w); y[i * 8 + 7] = bhi(u.w) + bhi(u2.w);
      u = *(const uint4*)(RK + (size_t)row * 4096 + 2048 + ch + i * 8);
      v[i * 8 + 0] = blo(u.x); v[i * 8 + 1] = bhi(u.x); v[i * 8 + 2] = blo(u.y); v[i * 8 + 3] = bhi(u.y); v[i * 8 + 4] = blo(u.z); v[i * 8 + 5] = bhi(u.z); v[i * 8 + 6] = blo(u.w); v[i * 8 + 7] = bhi(u.w);
      u = *(const uint4*)(RK + (size_t)row * 4096 + 3072 + ch + i * 8);
      z[i * 8 + 0] = blo(u.x); z[i * 8 + 1] = bhi(u.x); z[i * 8 + 2] = blo(u.y); z[i * 8 + 3] = bhi(u.y); z[i * 8 + 4] = blo(u.z); z[i * 8 + 5] = bhi(u.z); z[i * 8 + 6] = blo(u.w); z[i * 8 + 7] = bhi(u.w);
    }
    float s = 0.f;
#pragma unroll
    for (int e = 0; e < 16; e++) s += y[e];
    s += __shfl_xor(s, 1); s += __shfl_xor(s, 2); float mean = s * (1.f / 64.f);
    float q = 0.f;
#pragma unroll
    for (int e = 0; e < 16; e++) { float dlt = y[e] - mean; q += dlt * dlt; }
    q += __shfl_xor(q, 1); q += __shfl_xor(q, 2); float rs = rsqrtf(q * (1.f / 64.f) + 64e-5f);
    float bon = BON[(size_t)row * 16 + hd] + BON[(size_t)(R_ + row) * 16 + hd];
    float o[16];
#pragma unroll
    for (int e = 0; e < 16; e++) { float yn = (y[e] - mean) * rs * lg[ch + e] + lb[ch + e]; o[e] = (yn + bon * v[e]) * siluf(z[e]); }
#pragma unroll
    for (int i = 0; i < 2; i++)
      *(uint4*)(Y + (size_t)row * 1024 + ch + i * 8) = uint4{pk2(o[i * 8], o[i * 8 + 1]), pk2(o[i * 8 + 2], o[i * 8 + 3]), pk2(o[i * 8 + 4], o[i * 8 + 5]), pk2(o[i * 8 + 6], o[i * 8 + 7])};
  }
}

#define QS 136
#define VS 72
#define MLG_BYTES 47104
__device__ __forceinline__ void ph_ml_scan(const P& p, int j, char* smem0) {
  const int d = ltid() >> 8;
  char* smem = smem0 + d * MLG_BYTES;
  bfr* sQ = (bfr*)smem; bfr* sK = sQ + 64 * QS; bfr* sVT = sK + 64 * QS; bfr* sCT = sVT + 16 * VS;
  float* sN = (float*)(sCT + 16 * QS);
  float* sEs = sN + 128; float* sCt = sEs + 64; float* sBc = sCt + 64; float* sWg = sBc + 64; float* sNr = sWg + 64; bfr* sNb = (bfr*)(sNr + 256); float* sMisc = (float*)(sNb + 128); bfr* sVW = (bfr*)(sMisc + 4);
  const bfr* QKV = (const bfr*)(p.ACT + A_QKV); const float* GT = (const float*)(p.ACT + A_GATE); bfr* HS = (bfr*)(p.ACT + A_HS);
  const float* gbias = p.ml_gate_b + (size_t)j * 32;
  const int tid = ltid() & 255, lane = tid & 63, w = tid >> 6, l15 = lane & 15, q4 = lane >> 4;
  for (int it = xcd_swz(); it < 256; it += gridDim.x) {
    const int b = it >> 7, hh = (it >> 4) & 7, sl = it & 15;
    f32x4 Cacc[2];
    Cacc[0] = f32x4{0.f, 0.f, 0.f, 0.f}; Cacc[1] = f32x4{0.f, 0.f, 0.f, 0.f};
    float mcur = 0.f;
    for (int i = tid; i < 16 * QS; i += 256) sCT[i] = 0;
    if (tid < 128) { sN[tid] = 0.f; sNb[tid] = 0; }
    uint4 pq0, pq1, pq2, pq3, pk0, pk1, pk2, pk3, pv = uint4{0u, 0u, 0u, 0u}; float pgi = 0.f, pgf = 0.f;
#define ML_ROW0(s_) (d == 0 ? b * BT_ + 64 * (s_) : rowmap(1, b, 64 * (s_) + 63))
#define ML_LD(i_, PQ, PK) { int idx = tid + 256 * (i_), rho = idx >> 4, c8 = idx & 15; const bfr* src = QKV + (size_t)(r0n + rho) * 4096 + hh * 128 + c8 * 8; PQ = *(const uint4*)src; PK = *(const uint4*)(src + 1024); }
#define ML_ISSUE(s_) { const int r0n = ML_ROW0(s_); ML_LD(0, pq0, pk0) ML_LD(1, pq1, pk1) ML_LD(2, pq2, pk2) ML_LD(3, pq3, pk3) \
      if (tid < 128) pv = *(const uint4*)(QKV + (size_t)(r0n + (tid >> 1)) * 4096 + 2048 + hh * 256 + sl * 16 + (tid & 1) * 8); \
      if (w == 0) { const float* gp_ = GT + (size_t)(r0n + (d ? 63 - lane : lane)) * 32 + d * 16 + hh; pgi = gp_[0]; pgf = gp_[8]; } }
#define ML_ST(i_, PQ, PK) { int idx = tid + 256 * (i_), rho = idx >> 4, c8 = idx & 15; *(uint4*)(sQ + rho * QS + c8 * 8) = PQ; *(uint4*)(sK + rho * QS + c8 * 8) = PK; }
#define ML_COMMIT() { ML_ST(0, pq0, pk0) ML_ST(1, pq1, pk1) ML_ST(2, pq2, pk2) ML_ST(3, pq3, pk3) \
      if (tid < 128) { int rho = tid >> 1, vb = (tid & 1) * 8; \
        sVT[(vb + 0) * VS + rho] = (bfr)(pv.x & 0xffff); sVT[(vb + 1) * VS + rho] = (bfr)(pv.x >> 16); \
        sVT[(vb + 2) * VS + rho] = (bfr)(pv.y & 0xffff); sVT[(vb + 3) * VS + rho] = (bfr)(pv.y >> 16); \
        sVT[(vb + 4) * VS + rho] = (bfr)(pv.z & 0xffff); sVT[(vb + 5) * VS + rho] = (bfr)(pv.z >> 16); \
        sVT[(vb + 6) * VS + rho] = (bfr)(pv.w & 0xffff); sVT[(vb + 7) * VS + rho] = (bfr)(pv.w >> 16); } }
    ML_ISSUE(0)
    __syncthreads();
    for (int s = 0; s < NCH_; s++) {
      const int r0 = ML_ROW0(s);
      ML_COMMIT()
      if (w == 0) {
        int rho = d ? 63 - lane : lane;
        float gi = pgi + gbias[(d * 2 + 0) * 8 + hh], gf = pgf + gbias[(d * 2 + 1) * 8 + hh];
        float fc = fminf(gf, 0.f) - __logf(1.f + __expf(-fabsf(gf)));
        float bc = fc;
        for (int o = 1; o < 64; o <<= 1) { float t = __shfl_up(bc, o); if (lane >= o) bc += t; }
        float e = gi - bc, pm = e;
        for (int o = 1; o < 64; o <<= 1) { float t = __shfl_up(pm, o); if (lane >= o) pm = fmaxf(pm, t); }
        float pml = __shfl(pm, 63), bcl = __shfl(bc, 63);
        const float mx_ = fmaxf(mcur, pml);
        sEs[rho] = __expf(fminf(e, 80.f)); sCt[rho] = -fmaxf(mcur, pm); sBc[rho] = bc; sWg[rho] = __expf(e - mx_);
        if (lane == 0) { sMisc[0] = mcur; sMisc[1] = __expf(mcur - mx_); }
        mcur = bcl + mx_;
      }
      __syncthreads();
      const float mold = sMisc[0], decay = sMisc[1];

      const int rt = 16 * w + l15;
      bfr* hp = HS + (size_t)(r0 + rt) * 2048 + hh * 256 + sl * 16 + 4 * q4;
      bool first; { int rc = (r0 - b * BT_) >> 6; if (d == 0) { int sp = rc < 4 ? 3 - rc : 263 - rc; first = s < sp; } else first = s < rc; }
      unsigned long long uu = 0ull;
      if (!first) uu = __hip_atomic_load((unsigned long long*)hp, __ATOMIC_RELAXED, __HIP_MEMORY_SCOPE_AGENT);
      if (s + 1 < NCH_) ML_ISSUE(s + 1)
      { const int vr = tid >> 4, sg = (tid & 15) * 4; const uint2 vv_ = *(const uint2*)(sVT + vr * VS + sg); const float4 wg4 = *(const float4*)(sWg + sg);
        *(uint2*)(sVW + vr * VS + sg) = uint2{cvtpk(blo(vv_.x) * wg4.x, bhi(vv_.x) * wg4.y), cvtpk(blo(vv_.y) * wg4.z, bhi(vv_.y) * wg4.w)}; }
      bf16x8 qf[4];
#pragma unroll
      for (int ks = 0; ks < 4; ks++) qf[ks] = *(const bf16x8*)(sQ + (16 * w + l15) * QS + ks * 32 + q4 * 8);
      f32x4 sacc[4];
#pragma unroll
      for (int a = 0; a < 4; a++) { sacc[a] = f32x4{0.f, 0.f, 0.f, 0.f};
#pragma unroll
        for (int ks = 0; ks < 4; ks++) { bf16x8 kf = *(const bf16x8*)(sK + (16 * a + l15) * QS + ks * 32 + q4 * 8); sacc[a] = __builtin_amdgcn_mfma_f32_16x16x32_bf16(kf, qf[ks], sacc[a], 0, 0, 0); } }
      const float ctt = sCt[rt]; const float ect = __expf(ctt); float densum = 0.f;
#pragma unroll
      for (int a = 0; a < 4; a++) { const float4 ex4 = *(const float4*)(sEs + 16 * a + 4 * q4); const float exv[4] = {ex4.x, ex4.y, ex4.z, ex4.w};
#pragma unroll
        for (int jj = 0; jj < 4; jj++) { int rs_ = 16 * a + 4 * q4 + jj; bool valid = d == 0 ? rs_ <= rt : rs_ >= rt;
          float wv = valid ? ect * exv[jj] : 0.f; float sv = sacc[a][jj] * wv; sacc[a][jj] = sv; densum += sv; } }
      densum += __shfl_xor(densum, 16); densum += __shfl_xor(densum, 32);
      bf16x8 sf[2], vf[2];
#pragma unroll
      for (int ks = 0; ks < 2; ks++) {
#pragma unroll
        for (int jj = 0; jj < 4; jj++) { sf[ks][jj] = (short)f2b(sacc[2 * ks][jj]); sf[ks][4 + jj] = (short)f2b(sacc[2 * ks + 1][jj]); }
        uint2 v0 = *(const uint2*)(sVT + l15 * VS + 32 * ks + 4 * q4), v1 = *(const uint2*)(sVT + l15 * VS + 32 * ks + 16 + 4 * q4);
        uint4 vv = uint4{v0.x, v0.y, v1.x, v1.y}; vf[ks] = *(bf16x8*)&vv;
      }
      f32x4 num = f32x4{0.f, 0.f, 0.f, 0.f}, numC = f32x4{0.f, 0.f, 0.f, 0.f};
#pragma unroll
      for (int ks = 0; ks < 2; ks++) num = __builtin_amdgcn_mfma_f32_16x16x32_bf16(vf[ks], sf[ks], num, 0, 0, 0);
#pragma unroll
      for (int ks = 0; ks < 4; ks++) { bf16x8 cf = *(const bf16x8*)(sCT + l15 * QS + ks * 32 + q4 * 8); numC = __builtin_amdgcn_mfma_f32_16x16x32_bf16(cf, qf[ks], numC, 0, 0, 0); }
      f32x4 qnacc = f32x4{0.f, 0.f, 0.f, 0.f};
#pragma unroll
      for (int ks = 0; ks < 4; ks++) { bf16x8 na = bf16x8{0, 0, 0, 0, 0, 0, 0, 0}; if (l15 == 0) na = *(const bf16x8*)(sNb + ks * 32 + q4 * 8);
        qnacc = __builtin_amdgcn_mfma_f32_16x16x32_bf16(na, qf[ks], qnacc, 0, 0, 0); }
      const float qn = __shfl(qnacc[0], l15);
      {
        float inter = __expf(mold + ctt); float den = densum + inter * qn; float dn = fmaxf(fabsf(den), __expf(ctt - sBc[rt])); float inv = __builtin_amdgcn_rcpf(dn);
        f32x4 hv;
#pragma unroll
        for (int jj = 0; jj < 4; jj++) hv[jj] = (num[jj] + inter * numC[jj]) * inv;
        if (!first) { unsigned ux = (unsigned)uu, uy = (unsigned)(uu >> 32);
          hv[0] += blo(ux); hv[1] += bhi(ux); hv[2] += blo(uy); hv[3] += bhi(uy); }
        store4b(hp, hv);
      }
      __syncthreads();
      {
        bf16x8 vw[2], wa[2];
#pragma unroll
        for (int ks = 0; ks < 2; ks++) {
          const uint2 v0 = *(const uint2*)(sVW + l15 * VS + 32 * ks + 4 * q4), v1 = *(const uint2*)(sVW + l15 * VS + 32 * ks + 16 + 4 * q4);
          uint4 vv = uint4{v0.x, v0.y, v1.x, v1.y}; vw[ks] = *(bf16x8*)&vv;
          uint4 wz = uint4{0u, 0u, 0u, 0u};
          if (l15 == 0) { const float4 g0 = *(const float4*)(sWg + 32 * ks + 4 * q4), g1 = *(const float4*)(sWg + 32 * ks + 16 + 4 * q4); wz = uint4{cvtpk(g0.x, g0.y), cvtpk(g0.z, g0.w), cvtpk(g1.x, g1.y), cvtpk(g1.z, g1.w)}; }
          wa[ks] = *(bf16x8*)&wz; }
#pragma unroll
        for (int a = 0; a < 2; a++) {
          int dk = 32 * w + 16 * a + l15;
#pragma unroll
          for (int jj = 0; jj < 4; jj++) Cacc[a][jj] *= decay;
          f32x4 nacc = f32x4{0.f, 0.f, 0.f, 0.f};
#pragma unroll
          for (int ks = 0; ks < 2; ks++) { bf16x8 kt;
#pragma unroll
            for (int e = 0; e < 8; e++) { int rs_ = 32 * ks + (e < 4 ? 4 * q4 + e : 16 + 4 * q4 + e - 4); kt[e] = (short)sK[rs_ * QS + dk]; }
            Cacc[a] = __builtin_amdgcn_mfma_f32_16x16x32_bf16(vw[ks], kt, Cacc[a], 0, 0, 0);
            nacc = __builtin_amdgcn_mfma_f32_16x16x32_bf16(wa[ks], kt, nacc, 0, 0, 0); }
          if (q4 == 0) sNr[dk] = nacc[0];
#pragma unroll
          for (int jj = 0; jj < 4; jj++) sCT[(4 * q4 + jj) * QS + dk] = f2b(Cacc[a][jj]);
        }
      }
      __syncthreads();
      if (tid < 128) { const float nv = decay * sN[tid] + sNr[tid]; sN[tid] = nv; sNb[tid] = f2b(nv); }
    }
    __syncthreads();
  }
}

#define CS 72
#define CSLOT(i_) ((bfr*)smem + (i_) * (64 * CS))
#define A_SST (A_R7B + 362086400ull)
__device__ __forceinline__ f32x4 cmm(const bfr* X, const bfr* YT, int ti, int tj, int l15, int q4) {
  f32x4 acc = f32x4{0.f, 0.f, 0.f, 0.f};
#pragma unroll
  for (int ks = 0; ks < 2; ks++) { bf16x8 a = *(const bf16x8*)(X + (16 * ti + l15) * CS + 32 * ks + 8 * q4); bf16x8 b = *(const bf16x8*)(YT + (16 * tj + l15) * CS + 32 * ks + 8 * q4);
    acc = __builtin_amdgcn_mfma_f32_16x16x32_bf16(a, b, acc, 0, 0, 0); }
  return acc;
}
template <int MODE> __device__ __forceinline__ f32x4 cmm_mask(const bfr* X, const bfr* YT, int ti, int tj, int l15, int q4) {
  f32x4 acc = f32x4{0.f, 0.f, 0.f, 0.f};
#pragma unroll
  for (int ks = 0; ks < 2; ks++) { const int kb = 2 * ks + (q4 >> 1);
    const bool ok = MODE == 1 ? ((kb == 0 && tj == 1) || (kb == 2 && tj == 3)) : (kb < 2 && tj >= 2);
    bf16x8 a = *(const bf16x8*)(X + (16 * ti + l15) * CS + 32 * ks + 8 * q4); bf16x8 bz = bf16x8{0, 0, 0, 0, 0, 0, 0, 0};
    if (ok) bz = *(const bf16x8*)(YT + (16 * tj + l15) * CS + 32 * ks + 8 * q4);
    acc = __builtin_amdgcn_mfma_f32_16x16x32_bf16(a, bz, acc, 0, 0, 0); }
  return acc;
}
__device__ __forceinline__ void st_row(bfr* dst, int r0, int c, f32x4 v) {
#pragma unroll
  for (int jj = 0; jj < 4; jj++) dst[(r0 + jj) * CS + c] = f2b(v[jj]); }
__device__ __forceinline__ void st_tr(bfr* dst, int r0, int c, f32x4 v) { store4b(dst + c * CS + r0, v); }
__device__ __forceinline__ f32x4 ld_row(const bfr* src, int r0, int c) { f32x4 v;
#pragma unroll
  for (int jj = 0; jj < 4; jj++) v[jj] = b2f(src[(r0 + jj) * CS + c]);
  return v; }
__device__ __forceinline__ f32x4 ld_tr(const bfr* src, int r0, int c) { uint2 u = *(const uint2*)(src + c * CS + r0); return f32x4{blo(u.x), bhi(u.x), blo(u.y), bhi(u.y)}; }

__device__ __forceinline__ void ph_r7_ca(const P& p, int j, int win, char* smem) {
  float* LW = (float*)(smem + 7 * 9216); float* AT = (float*)(smem + 9 * 9216); float* WL = (float*)(smem + 14 * 9216);
  const bfr* RK = (const bfr*)(p.ACT + A_RKVZ); const bfr* WMb = (const bfr*)(p.ACT + A_WM); const bfr* AMb = (const bfr*)(p.ACT + A_AM);
  float* BON = (float*)(p.ACT + A_BON); bfr* WB = p.H;
  const float* kkp = p.r7_k_k + (size_t)j * 1024; const float* kap = p.r7_k_a + (size_t)j * 1024; const float* rkp = p.r7_r_k + (size_t)j * 1024;
  const int tid = ltid(), lane = tid & 63, w = tid >> 6, l15 = lane & 15, q4 = lane >> 4, ti = w >> 1, tj0 = (w & 1) * 2;
  const int c0 = win * 20;
  for (int it = blockIdx.x; it < 1280; it += gridDim.x) {
    const int chain = it / 20, cl = it - chain * 20, c = c0 + cl, d = chain & 1, b = chain >> 5, h = (chain >> 1) & 15;
    {
      const int rowA = rowmap(d, b, 64 * c + 16 * ti + l15);
      const float* w0 = p.r7_w0 + (size_t)(j * 2 + d) * 1024 + h * 64; const float* a0 = p.r7_a0 + (size_t)(j * 2 + d) * 1024 + h * 64;
#pragma unroll
      for (int tt = 0; tt < 2; tt++) { const int tj = tj0 + tt; f32x4 aw = f32x4{0.f, 0.f, 0.f, 0.f}, aa = aw;
#pragma unroll
        for (int ks = 0; ks < 2; ks++) {
          bf16x8 xw = *(const bf16x8*)(WMb + (size_t)rowA * 128 + d * 64 + 32 * ks + 8 * q4), xa = *(const bf16x8*)(AMb + (size_t)rowA * 128 + d * 64 + 32 * ks + 8 * q4);
          bf16x8 yw = *(const bf16x8*)(p.W + WR_UP + d * 65536 + (size_t)(h * 64 + 16 * tj + l15) * 64 + 32 * ks + 8 * q4);
          bf16x8 ya = *(const bf16x8*)(p.W + WR_UP + (2 + d) * 65536 + (size_t)(h * 64 + 16 * tj + l15) * 64 + 32 * ks + 8 * q4);
          aw = __builtin_amdgcn_mfma_f32_16x16x32_bf16(xw, yw, aw, 0, 0, 0); aa = __builtin_amdgcn_mfma_f32_16x16x32_bf16(xa, ya, aa, 0, 0, 0); }
        const int ch = 16 * tj + l15; const float w0v = w0[ch], a0v = a0[ch];
#pragma unroll
        for (int jj = 0; jj < 4; jj++) { const int tau = 16 * ti + 4 * q4 + jj; LW[tau * 64 + ch] = -0.6065306597126334f * sigm(w0v + aw[jj]); AT[tau * 64 + ch] = sigm(a0v + aa[jj]); }
      }
    }
    __syncthreads();
    if (tid < 64) { float acc = 0.f;
#pragma unroll 8
      for (int t = 0; t < 64; t++) { acc += LW[t * 64 + tid]; LW[t * 64 + tid] = acc; } }
    __syncthreads();
    {
      const int tau = tid >> 3, sc = tid & 7, col = h * 64 + sc * 8; const int row = rowmap(d, b, 64 * c + tau);
      const bfr* rp = RK + (size_t)row * 4096 + col; uint4 pr = *(const uint4*)rp, pk = *(const uint4*)(rp + 1024);
      unsigned ur[4] = {pr.x, pr.y, pr.z, pr.w}, uk[4] = {pk.x, pk.y, pk.z, pk.w};
      float r8[8], k8[8], kr[8];
#pragma unroll
      for (int e = 0; e < 4; e++) { r8[2 * e] = blo(ur[e]); r8[2 * e + 1] = bhi(ur[e]); k8[2 * e] = blo(uk[e]); k8[2 * e + 1] = bhi(uk[e]); }
      float ss = 0.f;
#pragma unroll
      for (int e = 0; e < 8; e++) { kr[e] = k8[e] * kkp[col + e]; ss += kr[e] * kr[e]; }
      ss += __shfl_xor(ss, 1); ss += __shfl_xor(ss, 2); ss += __shfl_xor(ss, 4);
      const float inv = __builtin_amdgcn_rsqf(fmaxf(ss, 1e-24f));
      float bon = 0.f, o0[8], o1[8], o2[8], o3[8], o4[8], o5[8];
#pragma unroll
      for (int e = 0; e < 8; e++) {
        const float cw = LW[tau * 64 + sc * 8 + e], cwm = tau > 0 ? LW[(tau - 1) * 64 + sc * 8 + e] : 0.f, cwl = LW[63 * 64 + sc * 8 + e], a = AT[tau * 64 + sc * 8 + e];
        const float ka = kr[e] * inv, be = a * ka, kd = k8[e] * (1.f + (a - 1.f) * kap[col + e]); bon += r8[e] * kd * rkp[col + e];
        const float e2 = __expf(-cw), e4 = __expf(cwl - cw);
        o0[e] = ka * __expf(cwm); o1[e] = be * e2; o2[e] = kd * e2; o3[e] = r8[e] * __expf(cw); o4[e] = be * e4; o5[e] = kd * e4;
        if (tau == 63) WL[sc * 8 + e] = __expf(cwl);
      }
      bon += __shfl_xor(bon, 1); bon += __shfl_xor(bon, 2); bon += __shfl_xor(bon, 4);
      if (sc == 0) BON[((size_t)d * R_ + row) * 16 + h] = bon;
      *(uint4*)(CSLOT(0) + tau * CS + sc * 8) = uint4{pk2(o0[0], o0[1]), pk2(o0[2], o0[3]), pk2(o0[4], o0[5]), pk2(o0[6], o0[7])};
      *(uint4*)(CSLOT(1) + tau * CS + sc * 8) = uint4{pk2(o1[0], o1[1]), pk2(o1[2], o1[3]), pk2(o1[4], o1[5]), pk2(o1[6], o1[7])};
      *(uint4*)(CSLOT(2) + tau * CS + sc * 8) = uint4{pk2(o2[0], o2[1]), pk2(o2[2], o2[3]), pk2(o2[4], o2[5]), pk2(o2[6], o2[7])};
      *(uint4*)(CSLOT(3) + tau * CS + sc * 8) = uint4{pk2(o3[0], o3[1]), pk2(o3[2], o3[3]), pk2(o3[4], o3[5]), pk2(o3[6], o3[7])};
#pragma unroll
      for (int e = 0; e < 8; e++) { CSLOT(4)[(sc * 8 + e) * CS + tau] = f2b(o0[e]); CSLOT(5)[(sc * 8 + e) * CS + tau] = f2b(o4[e]); CSLOT(6)[(sc * 8 + e) * CS + tau] = f2b(o5[e]); }
    }
    __syncthreads();
#pragma unroll
    for (int tt = 0; tt < 2; tt++) { const int tj = tj0 + tt, r0 = 16 * ti + 4 * q4, cc = 16 * tj + l15;
      f32x4 v = cmm(CSLOT(1), CSLOT(0), ti, tj, l15, q4);
#pragma unroll
      for (int jj = 0; jj < 4; jj++) if (!(r0 + jj < cc)) v[jj] = 0.f;
      st_row(CSLOT(7), r0, cc, v); st_tr(CSLOT(8), r0, cc, v);
      v = cmm(CSLOT(2), CSLOT(0), ti, tj, l15, q4);
#pragma unroll
      for (int jj = 0; jj < 4; jj++) if (!(r0 + jj < cc)) v[jj] = 0.f;
      st_row(CSLOT(9), r0, cc, v);
      v = cmm(CSLOT(3), CSLOT(1), ti, tj, l15, q4);
#pragma unroll
      for (int jj = 0; jj < 4; jj++) if (!(cc <= r0 + jj)) v[jj] = 0.f;
      st_row(CSLOT(10), r0, cc, v);
      v = cmm(CSLOT(3), CSLOT(2), ti, tj, l15, q4);
#pragma unroll
      for (int jj = 0; jj < 4; jj++) if (!(cc <= r0 + jj)) v[jj] = 0.f;
      st_row(CSLOT(11), r0, cc, v);
    }
    __syncthreads();
    {
      float* X = (float*)CSLOT(0);
      const bfr* Ab = CSLOT(7);
      const int cl = lane >> 3, pp = lane & 7, cx = 8 * w + cl, blk0 = (w >> 1) * 16;
#pragma unroll 1
      for (int il = 15; il >= 0; il--) { const int i = blk0 + il;
        float sum = 0.f;
#pragma unroll 1
        for (int jx = i + 1 + pp; jx < blk0 + 16; jx += 8) sum += b2f(Ab[i * CS + jx]) * X[jx * 72 + cx];
        sum += dppf<0xB1>(sum); sum += dppf<0x4E>(sum); sum += dppf<0x141>(sum);
        const float xv = (i == cx ? 1.f : 0.f) - sum;
        if (pp == 0) X[i * 72 + cx] = xv;
      }
      __syncthreads();
#pragma unroll 1
      for (int e = tid; e < 4096; e += 512) { const int i = e >> 6, c2 = e & 63; const bfr tv = ((i >> 4) == (c2 >> 4)) ? f2b(X[i * 72 + c2]) : (bfr)0; CSLOT(2)[i * CS + c2] = tv; CSLOT(12)[c2 * CS + i] = tv; }
      __syncthreads();
#pragma unroll
      for (int tt = 0; tt < 2; tt++) { const int tj = tj0 + tt, r0 = 16 * ti + 4 * q4, cc = 16 * tj + l15; st_row(CSLOT(13), r0, cc, cmm_mask<1>(CSLOT(2), CSLOT(8), ti, tj, l15, q4)); }
      __syncthreads();
#pragma unroll
      for (int tt = 0; tt < 2; tt++) { const int tj = tj0 + tt, r0 = 16 * ti + 4 * q4, cc = 16 * tj + l15;
        f32x4 v = ld_row(CSLOT(2), r0, cc) - cmm(CSLOT(13), CSLOT(12), ti, tj, l15, q4); st_row(CSLOT(0), r0, cc, v); st_tr(CSLOT(1), r0, cc, v); }
      __syncthreads();
#pragma unroll
      for (int tt = 0; tt < 2; tt++) { const int tj = tj0 + tt, r0 = 16 * ti + 4 * q4, cc = 16 * tj + l15; st_row(CSLOT(13), r0, cc, cmm_mask<2>(CSLOT(0), CSLOT(8), ti, tj, l15, q4)); }
      __syncthreads();
#pragma unroll
      for (int tt = 0; tt < 2; tt++) { const int tj = tj0 + tt, r0 = 16 * ti + 4 * q4, cc = 16 * tj + l15;
        f32x4 v = ld_row(CSLOT(0), r0, cc) - cmm(CSLOT(13), CSLOT(1), ti, tj, l15, q4);
#pragma unroll
        for (int jj = 0; jj < 4; jj++) if (r0 + jj == cc) v[jj] -= 1.f;
        st_row(CSLOT(2), r0, cc, v); }
      __syncthreads();
    }
#pragma unroll
    for (int tt = 0; tt < 2; tt++) { const int tj = tj0 + tt, r0 = 16 * ti + 4 * q4, cc = 16 * tj + l15;
      f32x4 g = cmm(CSLOT(10), CSLOT(2), ti, tj, l15, q4) + ld_row(CSLOT(10), r0, cc); st_row(CSLOT(12), r0, cc, g);
      f32x4 hh = cmm(CSLOT(5), CSLOT(2), ti, tj, l15, q4) + ld_row(CSLOT(5), r0, cc); st_row(CSLOT(13), r0, cc, hh); }
    __syncthreads();
    {
      bfr* out = WB + (size_t)(chain * 20 + cl) * 16384;
#pragma unroll
      for (int tt = 0; tt < 2; tt++) { const int tj = tj0 + tt, r0 = 16 * ti + 4 * q4, cc = 16 * tj + l15;
        f32x4 v = ld_tr(CSLOT(3), r0, cc) - cmm(CSLOT(4), CSLOT(12), ti, tj, l15, q4);
        store4b(out + cc * 64 + r0, v);
        v = ld_tr(CSLOT(11), r0, cc) - cmm(CSLOT(9), CSLOT(12), ti, tj, l15, q4);
        store4b(out + 4096 + cc * 64 + r0, v);
        v = -cmm(CSLOT(4), CSLOT(13), ti, tj, l15, q4);
#pragma unroll
        for (int jj = 0; jj < 4; jj++) if (r0 + jj == cc) v[jj] += WL[cc];
        store4b(out + 8192 + cc * 64 + r0, v);
        v = ld_tr(CSLOT(6), r0, cc) - cmm(CSLOT(9), CSLOT(13), ti, tj, l15, q4);
        store4b(out + 12288 + cc * 64 + r0, v);
      }
    }
    __syncthreads();
  }
}

__device__ __forceinline__ void ph_r7_cb(const P& p, int win, char* smem) {
  bfr* Sh = (bfr*)smem; bfr* Sl = Sh + 2 * 16 * CS; bfr* VT = Sl + 2 * 16 * CS;
  const bfr* WB = p.H; const bfr* RK = (const bfr*)(p.ACT + A_RKVZ); bfr* SST = (bfr*)(p.ACT + A_SST);
  const int tid = ltid(), lane = tid & 63, w = tid >> 6, l15 = lane & 15, q4 = lane >> 4;
  const int c0 = win * 20;
  for (int it = xcd_swz(); it < 256; it += gridDim.x) {
    const int d = it & 1, b = it >> 7, h = (it >> 3) & 15, rg = (it >> 1) & 3, chain = (b * 16 + h) * 2 + d;
    bfr* Y = d ? R7_Y2 : (bfr*)(p.ACT + A_Y);
    bfr* sst = SST + (size_t)(chain * 4 + rg) * 2048;
    __syncthreads();
    if (tid < 256) { const int hl = tid >> 7, e = tid & 127, rr = e >> 3, c8 = e & 7; uint4 v = uint4{0u, 0u, 0u, 0u};
      if (win > 0) v = *(const uint4*)(sst + hl * 1024 + rr * 64 + c8 * 8);
      *(uint4*)((hl ? Sl : Sh) + rr * CS + c8 * 8) = v; }
    const int vtau = tid >> 3, vp = tid & 7;
    { const int row = rowmap(d, b, 64 * c0 + vtau); unsigned vv = *(const unsigned*)(RK + (size_t)row * 4096 + 2048 + h * 64 + rg * 16 + 2 * vp);
      VT[(2 * vp) * CS + vtau] = (bfr)(vv & 0xffff); VT[(2 * vp + 1) * CS + vtau] = (bfr)(vv >> 16); }
    const bfr* bbase = WB + (size_t)(chain * 20) * 16384 + (w < 4 ? 8192 + (16 * w + l15) * 64 : (16 * (w - 4) + l15) * 64) + 8 * q4;
    bf16x8 rb1[4][2], rb2[4][2]; unsigned rv[4];
#define CB_LOAD(u_, s_) { const int ss_ = (s_) < 20 ? (s_) : 19; const bfr* bp_ = bbase + (size_t)ss_ * 16384; \
      rb1[u_][0] = *(const bf16x8*)bp_; rb1[u_][1] = *(const bf16x8*)(bp_ + 32); rb2[u_][0] = *(const bf16x8*)(bp_ + 4096); rb2[u_][1] = *(const bf16x8*)(bp_ + 4096 + 32); \
      const int sv_ = ss_ + 1 < 20 ? ss_ + 1 : 19; const int rowv_ = rowmap(d, b, 64 * (c0 + sv_) + vtau); \
      rv[u_] = *(const unsigned*)(RK + (size_t)rowv_ * 4096 + 2048 + h * 64 + rg * 16 + 2 * vp); }
    CB_LOAD(0, 0) CB_LOAD(1, 1) CB_LOAD(2, 2) CB_LOAD(3, 3)
    __syncthreads();
    for (int g = 0; g < 5; g++) {
#pragma unroll
      for (int u = 0; u < 4; u++) {
        const int s = 4 * g + u;
        if (s < 20) {
          const int cur = s & 1, nxt = cur ^ 1, c = c0 + s;
          bf16x8 sh[2], sl[2], vt[2];
#pragma unroll
          for (int ks = 0; ks < 2; ks++) { sh[ks] = *(const bf16x8*)(Sh + (cur * 16 + l15) * CS + 32 * ks + 8 * q4); sl[ks] = *(const bf16x8*)(Sl + (cur * 16 + l15) * CS + 32 * ks + 8 * q4);
            vt[ks] = *(const bf16x8*)(VT + (cur * 16 + l15) * CS + 32 * ks + 8 * q4); }
          f32x4 a1 = f32x4{0.f, 0.f, 0.f, 0.f}, a2 = a1;
#pragma unroll
          for (int ks = 0; ks < 2; ks++) { a1 = __builtin_amdgcn_mfma_f32_16x16x32_bf16(sh[ks], rb1[u][ks], a1, 0, 0, 0); a2 = __builtin_amdgcn_mfma_f32_16x16x32_bf16(vt[ks], rb2[u][ks], a2, 0, 0, 0); }
#pragma unroll
          for (int ks = 0; ks < 2; ks++) a1 = __builtin_amdgcn_mfma_f32_16x16x32_bf16(sl[ks], rb1[u][ks], a1, 0, 0, 0);
          a1 = a1 + a2;
          if (w < 4) {
#pragma unroll
            for (int jj = 0; jj < 4; jj++) { const bfr hi = f2b(a1[jj]); Sh[(nxt * 16 + 4 * q4 + jj) * CS + 16 * w + l15] = hi; Sl[(nxt * 16 + 4 * q4 + jj) * CS + 16 * w + l15] = f2b(a1[jj] - b2f(hi)); }
          } else {
            const int rowy = rowmap(d, b, 64 * c + 16 * (w - 4) + l15);
            store4b(Y + (size_t)rowy * 1024 + h * 64 + rg * 16 + 4 * q4, a1);
          }
          if (s + 1 < 20) { VT[(nxt * 16 + 2 * vp) * CS + vtau] = (bfr)(rv[u] & 0xffff); VT[(nxt * 16 + 2 * vp + 1) * CS + vtau] = (bfr)(rv[u] >> 16); }
          if (s + 4 < 20) CB_LOAD(u, s + 4)
          __syncthreads();
        }
      }
    }
    if (tid < 256) { const int hl = tid >> 7, e = tid & 127, rr = e >> 3, c8 = e & 7; *(uint4*)(sst + hl * 1024 + rr * 64 + c8 * 8) = *(const uint4*)((hl ? Sl : Sh) + rr * CS + c8 * 8); }
  }
}

__device__ __forceinline__ void run_phase(const P& p, int ph, int layer, int d, char* smem) {
  Ctx c; c.layer = layer; c.j = layer / 3; c.d = d; c.wc = layer < 3 ? 1 : 0;
  switch (ph) {
    case PH_PRE: ph_pre(p, smem); break;
    case PH_NORM: ph_norm(p, layer, smem); break;
    case PH_LRU_IN: big_gemm(smem, p.H, p.W, 2560, 1024, F_LruIn{p.ACT}); break;
    case PH_LRU_CONV: ph_lru_conv(p, c.j); break;
    case PH_LRU_GATE: gemm_phase_k2<G_LruGate>(p, c, smem); break;
    case PH_LRU_S1: ph_lru_s1(p, d); break;
    case PH_LRU_S2: ph_lru_s2(p, smem); break;
    case PH_LRU_S3: ph_lru_s3(p, d); break;
    case PH_LRU_OUT: big_gemm(smem, (const bfr*)(p.ACT + A_Z), p.W + WL_OUT, 1024, 1280, F_Resid{p.Xx, p.Xc, p.MOD + (size_t)layer * 3 * 3072, c.wc}); break;
    case PH_ML_IN: big_gemm(smem, p.H, p.W, 4352, 1024, F_MlIn{p.ACT}); break;
    case PH_ML_SCAN: ph_ml_scan(p, c.j, smem); break;
    case PH_ML_STAT: ph_ml_stat(p); break;
    case PH_ML_Z: big_gemm(smem, p.H, p.W + WM_Z, 2048, 1024, F_MlZ{p.ACT, p.ml_norm_g + (size_t)c.j * 2048}); break;
    case PH_ML_OUT: big_gemm(smem, (const bfr*)(p.ACT + A_HS), p.W + WM_OUT, 1024, 2048, F_Resid{p.Xx, p.Xc, p.MOD + (size_t)layer * 3 * 3072, c.wc}); break;
    case PH_R7_IN: big_gemm(smem, p.H, p.W, 4352, 2048, F_R7In{p.ACT}); break;
    case PH_R7_SHIFT: ph_r7_shift(p); break;
    case PH_R7_CA: ph_r7_ca(p, c.j, d, smem); break;
    case PH_R7_CB: ph_r7_cb(p, d, smem); break;
    case PH_R7_FIN: ph_r7_fin(p, c.j); break;
    case PH_R7_OUT: big_gemm(smem, (const bfr*)(p.ACT + A_Y), p.W + WR_OUT, 1024, 1024, F_Resid{p.Xx, p.Xc, p.MOD + (size_t)layer * 3 * 3072, c.wc}); break;
    case PH_FINAL: ph_final(p); break;
  }
}


#define XB_TMO      128
#define XB_XCNT(j)  (256  + 64 * (j))
#define XB_XSUB(j)  (1280 + 64 * (j))
#define XB_XGEN(j)  (2304 + 64 * (j))
#define XB_TOP      3328
#define XB_TOPGEN   3392
#define XCD_BAR_WORDS 3456
#define XB_SPIN_CAP (1u << 18)
#define OFF_BAR 527000064ull
#define OFF_CL (OFF_BAR + 16384ull)
__device__ __forceinline__ unsigned xb_ld(unsigned* p)              { return __hip_atomic_load(p, __ATOMIC_RELAXED, __HIP_MEMORY_SCOPE_AGENT); }
__device__ __forceinline__ unsigned xb_add(unsigned* p, unsigned v) { return __hip_atomic_fetch_add(p, v, __ATOMIC_RELAXED, __HIP_MEMORY_SCOPE_AGENT); }
__device__ __forceinline__ unsigned xb_xcc_id() { return (unsigned)__builtin_amdgcn_s_getreg((3 << 11) | 20) & 0xFu; }
#define XB_SPIN(cond, bar) do { unsigned _sp = 0; while (cond) { __builtin_amdgcn_s_sleep(1); \
    if ((++_sp & 255u) == 0u) { if (xb_ld(&(bar)[XB_TMO])) break; if (_sp > XB_SPIN_CAP) { atomicAdd(&(bar)[XB_TMO], 1u); break; } } } } while (0)
struct XcdBarrier { unsigned* bar; unsigned x; volatile __attribute__((address_space(3))) unsigned* st; };
__device__ __forceinline__ XcdBarrier xcd_barrier_post(unsigned* bar, volatile __attribute__((address_space(3))) unsigned* st) {
  XcdBarrier b; b.bar = bar; b.x = xb_xcc_id(); b.st = st;
  if (threadIdx.x == 0) (void)xb_add(&bar[XB_XCNT(b.x)], 1u);
  return b;
}
__device__ __forceinline__ void xcd_barrier_complete(unsigned* bar, unsigned x, unsigned& nloc, unsigned& nx) {
  const unsigned G = gridDim.x * gridDim.y * gridDim.z;
  unsigned sum, cnt, mine, sp = 0u;
  for (;;) {
    sum = 0u; cnt = 0u; mine = 0u;
#pragma unroll
    for (unsigned j = 0; j < 16; ++j) { const unsigned c = xb_ld(&bar[XB_XCNT(j)]); sum += c; cnt += (c > 0u) ? 1u : 0u; mine = (j == x) ? c : mine; }
    if (sum == G) break;
    __builtin_amdgcn_s_sleep(1);
    if ((++sp & 255u) == 0u) { if (xb_ld(&bar[XB_TMO])) break; if (sp > XB_SPIN_CAP) { atomicAdd(&bar[XB_TMO], 1u); break; } }
  }
  nloc = mine > 0u ? mine : 1u; nx = cnt > 0u ? cnt : 1u;
}
__device__ __forceinline__ void xcd_barrier(const XcdBarrier& b) {
  asm volatile("s_waitcnt vmcnt(0)" ::: "memory");
  __syncthreads();
  if (threadIdx.x == 0) {
    unsigned* bar = b.bar;
    __builtin_amdgcn_s_waitcnt(0);
    unsigned nloc = b.st[0], nx = b.st[1];
    if (nloc == 0u) { xcd_barrier_complete(bar, b.x, nloc, nx); b.st[0] = nloc; b.st[1] = nx; }
    const unsigned old = xb_add(&bar[XB_XSUB(b.x)], 1u);
    const unsigned gen = old / nloc;
    if (old + 1u == (gen + 1u) * nloc) {
      __builtin_amdgcn_fence(__ATOMIC_RELEASE, "agent");
      asm volatile("s_waitcnt vmcnt(0)" ::: "memory");
      const unsigned og = xb_add(&bar[XB_TOP], 1u);
      const unsigned tg = og / nx;
      if (og + 1u == (tg + 1u) * nx) xb_add(&bar[XB_TOPGEN], 1u);
      else XB_SPIN(xb_ld(&bar[XB_TOPGEN]) == tg, bar);
      __builtin_amdgcn_fence(__ATOMIC_ACQUIRE, "agent");
      xb_add(&bar[XB_XGEN(b.x)], 1u);
      asm volatile("s_waitcnt vmcnt(0)" ::: "memory");
    } else {
      XB_SPIN(xb_ld(&bar[XB_XGEN(b.x)]) == gen, bar);
      __builtin_amdgcn_fence(__ATOMIC_ACQUIRE, "agent");
      asm volatile("s_waitcnt vmcnt(0)" ::: "memory");
    }
  }
  __syncthreads();
}

#define SMEM_BYTES (131072 + 64)
extern __shared__ __attribute__((aligned(16))) char dyn_smem[];
#if !MEGA
__global__ void __launch_bounds__(512, 2) phase_kernel(P p, int si) {
  run_phase(p, p.sched[si * 3], p.sched[si * 3 + 1], p.sched[si * 3 + 2], dyn_smem);
}
#else
__global__ void __launch_bounds__(512, 2) mega_kernel(P p) {
  cg::grid_group grid = cg::this_grid();
  volatile __attribute__((address_space(3))) unsigned* st = (volatile __attribute__((address_space(3))) unsigned*)(dyn_smem + 131072);
  if (threadIdx.x < 4) st[threadIdx.x] = 0u;
  __syncthreads();
  const XcdBarrier xb = xcd_barrier_post(p.bar, st);
  for (int si = 0; si < p.nsched; si++) {
    run_phase(p, p.sched[si * 3], p.sched[si * 3 + 1], p.sched[si * 3 + 2], dyn_smem);
    if (si + 1 < p.nsched) { if (si == 0) grid.sync(); else xcd_barrier(xb); }
  }
}
#endif

extern "C" void kernel_launch(void* const* d_in, const int* in_sizes, int n_in, void* d_out, int out_size, void* d_ws, size_t ws_size, hipStream_t stream) {
  P p; memset(&p, 0, sizeof(p));
  const float** f = (const float**)&p;
  for (int i = 0; i < 33; i++) f[i] = (const float*)d_in[i];
  char* ws = (char*)d_ws;
  p.Xx = (float*)d_out; p.Xc = (float*)(ws + OFF_XC); p.MOD = (float*)(ws + OFF_MOD); p.W = (bfr*)(ws + OFF_W); p.H = (bfr*)(ws + OFF_H); p.ACT = ws + OFF_ACT; p.bar = (unsigned*)(ws + OFF_BAR); p.CL = (float*)(ws + OFF_CL);
  int n = 0;
  auto add = [&](int ph, int layer, int d) { p.sched[n * 3] = ph; p.sched[n * 3 + 1] = layer; p.sched[n * 3 + 2] = d; n++; };
  add(PH_PRE, 0, 0);
  if (DUP & 4) add(PH_PRE, 0, 0);
  for (int l = 0; l < 4; l++) {
    add(PH_NORM, l, 0); if (DUP & 4) add(PH_NORM, l, 0);
    int kind = l % 3;
    const bool dg = DUP & 1, ds = DUP & 2;
    if (kind == 0) { add(PH_LRU_IN, l, 0); if (dg) add(PH_LRU_IN, l, 0); add(PH_LRU_CONV, l, 0); if (DUP & 4) add(PH_LRU_CONV, l, 0);
      for (int d = 0; d < 2; d++) { add(PH_LRU_GATE, l, d); if (dg) add(PH_LRU_GATE, l, d); add(PH_LRU_S1, l, d); if (DUP & 8) add(PH_LRU_S1, l, d); add(PH_LRU_S2, l, d); if (DUP & 16) add(PH_LRU_S2, l, d); add(PH_LRU_S3, l, d); }
      add(PH_LRU_OUT, l, 0); }
    else if (kind == 1) { add(PH_ML_IN, l, 0); if (dg) add(PH_ML_IN, l, 0); add(PH_ML_SCAN, l, 0); if (ds) add(PH_ML_SCAN, l, 0); add(PH_ML_STAT, l, 0); if (DUP & 4) add(PH_ML_STAT, l, 0); add(PH_ML_Z, l, 0); add(PH_ML_OUT, l, 0); }
    else { add(PH_R7_SHIFT, l, 0); add(PH_R7_IN, l, 0); if (dg) add(PH_R7_IN, l, 0); for (int wi = 0; wi < 13; wi++) { add(PH_R7_CA, l, wi); if (DUP & 32) add(PH_R7_CA, l, wi); add(PH_R7_CB, l, wi); } add(PH_R7_FIN, l, 0); add(PH_R7_OUT, l, 0); }
  }
  add(PH_FINAL, 0, 0);
  p.nsched = n;
  if (ws_size < WS_NEED) fprintf(stderr, "workspace too small: %zu < %llu\n", ws_size, (unsigned long long)WS_NEED);
#if MEGA
  static int grid_blocks = 0;
  if (!grid_blocks) { int dev = 0, cus = 0, per = 0; hipGetDevice(&dev); hipDeviceGetAttribute(&cus, hipDeviceAttributeMultiprocessorCount, dev);
    hipFuncSetAttribute((const void*)mega_kernel, hipFuncAttributeMaxDynamicSharedMemorySize, SMEM_BYTES);
    hipOccupancyMaxActiveBlocksPerMultiprocessor(&per, mega_kernel, 512, SMEM_BYTES); if (per > 1) per = 1; if (per < 1) per = 1; grid_blocks = cus * per; }
  hipMemsetAsync(ws + OFF_BAR, 0, XCD_BAR_WORDS * 4, stream);
  void* args[] = {&p};
  hipError_t e = hipLaunchCooperativeKernel((void*)mega_kernel, dim3(grid_blocks), dim3(512), args, SMEM_BYTES, stream);
  if (e != hipSuccess) fprintf(stderr, "cooperative launch failed: %s (grid %d)\n", hipGetErrorString(e), grid_blocks);
#else
  static int once = 0; if (!once) { once = 1; hipFuncSetAttribute((const void*)phase_kernel, hipFuncAttributeMaxDynamicSharedMemorySize, SMEM_BYTES); }
  for (int si = 0; si < n; si++) phase_kernel<<<256, 512, SMEM_BYTES, stream>>>(p, si);
#endif
}
```

```cpp
#include <hip/hip_runtime.h>
#include <hip/hip_bf16.h>
#include <hip/hip_cooperative_groups.h>
#include <cstdio>
#include <cstring>
#include <type_traits>
namespace cg = cooperative_groups;

#ifndef DUP
#define DUP 0
#endif
#ifndef MEGA
#define MEGA 1
#endif

typedef unsigned short bfr;
using bf16x8 = __attribute__((ext_vector_type(8))) short;
using f32x4 = __attribute__((ext_vector_type(4))) float;

#define R_ 33280
#define BT_ 16640
#define NCH_ 260

#define OFF_XC 0ull
#define OFF_MOD 2097152ull
#define OFF_W 2244608ull
#define OFF_H 24264704ull
#define OFF_ACT 92422144ull
#define A_Z 0ull
#define A_UC 85196800ull
#define A_AB 170393600ull
#define A_U 170393600ull
#define A_HF 340787200ull
#define A_AGG 425984000ull
#define A_CAR 431308800ull
#define A_QKV 0ull
#define A_GATE 272629760ull
#define A_HS 276889600ull
#define A_RSTD 413204480ull
#define A_R7B 68157440ull
#define A_RKVZ (A_R7B + 0ull)
#define A_WM (A_R7B + 272629760ull)
#define A_AM (A_R7B + 281149440ull)
#define A_BON (A_R7B + 289669120ull)
#define A_Y (A_R7B + 293928960ull)
#define WS_NEED (527000064ull + 16384ull)

#define WL_GATE (2560 * 1024)
#define WL_OUT (WL_GATE + 1310720)
#define WM_Z (4352 * 1024)
#define WM_OUT (WM_Z + 2048 * 1024)
#define WR_UP (4352 * 2048)
#define WR_OUT (WR_UP + 262144)

enum { PH_PRE = 0, PH_NORM, PH_LRU_IN, PH_LRU_CONV, PH_LRU_GATE, PH_LRU_S1, PH_LRU_S2, PH_LRU_S3, PH_LRU_OUT,
       PH_ML_IN, PH_ML_SCAN, PH_ML_STAT, PH_ML_Z, PH_ML_OUT,
       PH_R7_IN, PH_R7_CA, PH_R7_CB, PH_R7_FIN, PH_R7_OUT, PH_FINAL, PH_R7_SHIFT };

struct P {
  const float *x, *c, *ctx, *c_ctx, *norm_g, *mod_w, *mod_b, *final_g;
  const float *lru_w_in, *lru_conv_w, *lru_conv_b, *lru_gate_w, *lru_gate_b, *lru_lam, *lru_w_out;
  const float *ml_w_in, *ml_gate_b, *ml_norm_g, *ml_w_out;
  const float *r7_mu, *r7_w_rkvz, *r7_w0, *r7_w1, *r7_w2, *r7_a0, *r7_a1, *r7_a2, *r7_k_k, *r7_k_a, *r7_r_k, *r7_ln_g, *r7_ln_b, *r7_w_out;
  float* Xx; float* Xc; float* MOD; bfr* W; bfr* H; char* ACT; unsigned* bar; float* CL;
  int nsched; int pad_;
  int sched[64 * 3];
};
struct Ctx { int layer, j, d, wc; };

__device__ __forceinline__ int xcd_swz() { const int b = blockIdx.x; return gridDim.x == 256 ? ((b & 7) * 32 + (b >> 3)) : b; }
__device__ __forceinline__ int ltid() { int t = threadIdx.x; asm volatile("" : "+v"(t)); return t; }
typedef float f32v2_ __attribute__((ext_vector_type(2))); typedef __bf16 bf16v2_ __attribute__((ext_vector_type(2)));
__device__ __forceinline__ unsigned cvtpk(float lo, float hi) { f32v2_ f = {lo, hi}; bf16v2_ h = __builtin_convertvector(f, bf16v2_); return __builtin_bit_cast(unsigned, h); }
__device__ __forceinline__ bfr f2b(float f) { return (bfr)(cvtpk(f, f) & 0xffffu); }
__device__ __forceinline__ float b2f(bfr b) { return __uint_as_float(((unsigned)b) << 16); }
__device__ __forceinline__ unsigned pk2(float a, float b) { return cvtpk(a, b); }
__device__ __forceinline__ float blo(unsigned u) { return __uint_as_float(u << 16); }
__device__ __forceinline__ float bhi(unsigned u) { return __uint_as_float(u & 0xffff0000u); }
__device__ __forceinline__ void store4b(bfr* dst, f32x4 v) { uint2 u; u.x = pk2(v[0], v[1]); u.y = pk2(v[2], v[3]); *(uint2*)dst = u; }
__device__ __forceinline__ float sigm(float x) { return __builtin_amdgcn_rcpf(1.f + __expf(-x)); }
__device__ __forceinline__ float siluf(float x) { return x * sigm(x); }
__device__ __forceinline__ float softplusf(float x) { return x > 20.f ? x : log1pf(expf(x)); }
__device__ __forceinline__ int rowmap(int d, int b, int pp) { int o = d == 0 ? pp : (pp < 256 ? 255 - pp : 16895 - pp); return b * BT_ + o; }
__device__ __forceinline__ float* xrowp(const P& p, int row, int& mi) {
  int b = row / BT_, o = row - b * BT_;
  if (o < 256) { mi = 2; return p.Xc + (size_t)(b * 256 + o) * 1024; }
  mi = b; return p.Xx + (size_t)(b * 16384 + o - 256) * 1024;
}
template <int CTRL> __device__ __forceinline__ float dppf(float x) {
  return __int_as_float(__builtin_amdgcn_update_dpp(0, __float_as_int(x), CTRL, 0xf, 0xf, true));
}
__device__ __forceinline__ float wsum(float x) {
  x += dppf<0xB1>(x); x += dppf<0x4E>(x); x += dppf<0x141>(x); x += dppf<0x140>(x);
  x += __int_as_float(__builtin_amdgcn_update_dpp(0, __float_as_int(x), 0x142, 0xA, 0xF, false));
  x += __int_as_float(__builtin_amdgcn_update_dpp(0, __float_as_int(x), 0x143, 0xC, 0xF, false));
  return __int_as_float(__builtin_amdgcn_readlane(__float_as_int(x), 63));
}
__device__ __forceinline__ float red16(float x) {
  x += dppf<0xB1>(x); x += dppf<0x4E>(x); x += dppf<0x141>(x); x += dppf<0x140>(x); return x;
}

template <class F> __device__ __forceinline__ void prep_tile(bfr* dst, int K, int tn, int tk, F get, float* sm) {
  int tid = ltid();
  for (int i = 0; i < 8; i++) { int kk = (tid >> 6) + 8 * i, nn = tid & 63; sm[kk * 65 + nn] = get(tk * 64 + kk, tn * 64 + nn); }
  __syncthreads();
  for (int i = 0; i < 8; i++) { int nn = (tid >> 6) + 8 * i, kk = tid & 63; dst[(size_t)(tn * 64 + nn) * K + tk * 64 + kk] = f2b(sm[kk * 65 + nn]); }
  __syncthreads();
}
__device__ __forceinline__ int prep_count(int layer) { int kind = layer % 3; return kind == 0 ? (640 + 320 + 320) : kind == 1 ? (1088 + 512 + 512) : (2176 + 64 + 256); }
__device__ __forceinline__ void prep_item(const P& p, int layer, int it, float* sm) {
  int kind = layer % 3, j = layer / 3;
  if (kind == 0) {
    if (it < 640) { int tn = it / 16, tk = it % 16; const float* s = p.lru_w_in + (size_t)j * 1024 * 2560;
      prep_tile(p.W, 1024, tn, tk, [=](int k, int n) { return s[(size_t)k * 2560 + n]; }, sm); return; }
    it -= 640;
    if (it < 320) { int d = it / 160, r = it % 160, tn = r / 2, tk = r % 2; const float* s = p.lru_gate_w + (size_t)(j * 2 + d) * 2 * 10 * 16384;
      prep_tile(p.W + WL_GATE + d * 655360, 128, tn, tk, [=](int k, int n) {
        int nt = n >> 7, blk = nt >> 1, sub = nt & 1, jj = n & 127, wn = jj >> 6, rr = jj & 63, g = rr >> 5, c = rr & 31;
        int kch = sub * 64 + wn * 32 + c; return s[((size_t)(g * 10 + blk) * 128 + k) * 128 + kch]; }, sm); return; }
    it -= 320;
    { int tn = it / 20, tk = it % 20; const float* s = p.lru_w_out + (size_t)j * 1280 * 1024;
      prep_tile(p.W + WL_OUT, 1280, tn, tk, [=](int k, int n) { return s[(size_t)k * 1024 + n]; }, sm); return; }
  } else if (kind == 1) {
    const float* s = p.ml_w_in + (size_t)j * 1024 * 6176;
    if (it < 1088) { int tn = it / 16, tk = it % 16;
      prep_tile(p.W, 1024, tn, tk, [=](int k, int n) {
        if (n < 4096) { float v = s[(size_t)k * 6176 + n]; return (n >= 1024 && n < 2048) ? v * 0.08838834764831845f : v; }
        if (n < 4128) return s[(size_t)k * 6176 + 6144 + (n - 4096)];
        return 0.f; }, sm); return; }
    it -= 1088;
    if (it < 512) { int tn = it / 16, tk = it % 16;
      prep_tile(p.W + WM_Z, 1024, tn, tk, [=](int k, int n) { return s[(size_t)k * 6176 + 4096 + n]; }, sm); return; }
    it -= 512;
    { int tn = it / 32, tk = it % 32; const float* so = p.ml_w_out + (size_t)j * 2048 * 1024;
      prep_tile(p.W + WM_OUT, 2048, tn, tk, [=](int k, int n) { return so[(size_t)k * 1024 + n]; }, sm); return; }
  } else {
    if (it < 2176) { int tn = it / 32, tk = it % 32;
      const float* mu = p.r7_mu + (size_t)j * 6 * 1024; const float* wr = p.r7_w_rkvz + (size_t)j * 4 * 1024 * 1024;
      const float* w1 = p.r7_w1 + (size_t)j * 2 * 1024 * 64; const float* a1 = p.r7_a1 + (size_t)j * 2 * 1024 * 64;
      prep_tile(p.W, 2048, tn, tk, [=](int k, int n) {
        int kk = k & 1023; float v, m;
        if (n < 4096) { int g = n >> 10, e = n & 1023; m = mu[g * 1024 + kk]; v = wr[((size_t)g * 1024 + kk) * 1024 + e]; }
        else if (n < 4224) { int xx = (n - 4096) >> 6, rr = (n - 4096) & 63; m = mu[4 * 1024 + kk]; v = w1[((size_t)xx * 1024 + kk) * 64 + rr]; }
        else { int xx = (n - 4224) >> 6, rr = (n - 4224) & 63; m = mu[5 * 1024 + kk]; v = a1[((size_t)xx * 1024 + kk) * 64 + rr]; }
        return (k < 1024 ? (1.f - m) : m) * v; }, sm); return; }
    it -= 2176;
    if (it < 64) { int u = it / 16, tn = it % 16; const float* s = (u < 2 ? p.r7_w2 : p.r7_a2) + (size_t)(j * 2 + (u & 1)) * 64 * 1024;
      prep_tile(p.W + WR_UP + u * 65536, 64, tn, 0, [=](int k, int n) { return s[(size_t)k * 1024 + n]; }, sm); return; }
    it -= 64;
    { int tn = it / 16, tk = it % 16; const float* s = p.r7_w_out + (size_t)j * 1024 * 1024;
      prep_tile(p.W + WR_OUT, 1024, tn, tk, [=](int k, int n) { return s[(size_t)k * 1024 + n]; }, sm); return; }
  }
}

#define LDSS 72
template <class G> __device__ __forceinline__ void gemm_tile(const P& p, const Ctx& c, int mt, int nt, char* smem) {
  const int tid = ltid(), lane = tid & 63, wid = tid >> 6, wm = wid & 3, wn = wid >> 2;
  bfr* sA = (bfr*)smem; bfr* sB = sA + 2 * 256 * LDSS;
  f32x4 acc[4][4];
  for (int a = 0; a < 4; a++) for (int b = 0; b < 4; b++) acc[a][b] = f32x4{0.f, 0.f, 0.f, 0.f};
  const int lr = tid >> 3, lc = tid & 7;
  uint4 ra[4], rb[2];
  auto gload = [&](int kt) __attribute__((always_inline)) {
#pragma unroll
    for (int i = 0; i < 4; i++) {
      const bfr* pa = G::aptr(p, c, mt * 256 + lr + 64 * i, kt, nt);
      ra[i] = pa ? *(const uint4*)(pa + lc * 8) : uint4{0u, 0u, 0u, 0u};
      if (i < 2) rb[i] = *(const uint4*)(G::bptr(p, c, nt * 128 + lr + 64 * i, kt) + lc * 8);
    }
  };
  auto sstore = [&](int buf) __attribute__((always_inline)) {
#pragma unroll
    for (int i = 0; i < 4; i++) {
      *(uint4*)(sA + (buf * 256 + lr + 64 * i) * LDSS + lc * 8) = ra[i];
      if (i < 2) *(uint4*)(sB + (buf * 128 + lr + 64 * i) * LDSS + lc * 8) = rb[i];
    }
  };
  gload(0); sstore(0); __syncthreads();
  for (int kt = 0; kt < G::KT; kt++) {
    const int buf = kt & 1;
    if (kt + 1 < G::KT) gload(kt + 1);
#pragma unroll
    for (int ks = 0; ks < 2; ks++) {
      bf16x8 af[4], bf[4];
#pragma unroll
      for (int i = 0; i < 4; i++) {
        af[i] = *(const bf16x8*)(sA + (buf * 256 + wm * 64 + i * 16 + (lane & 15)) * LDSS + ks * 32 + (lane >> 4) * 8);
        bf[i] = *(const bf16x8*)(sB + (buf * 128 + wn * 64 + i * 16 + (lane & 15)) * LDSS + ks * 32 + (lane >> 4) * 8);
      }
#pragma unroll
      for (int n = 0; n < 4; n++)
#pragma unroll
        for (int m = 0; m < 4; m++) acc[n][m] = __builtin_amdgcn_mfma_f32_16x16x32_bf16(bf[n], af[m], acc[n][m], 0, 0, 0);
    }
    if (kt + 1 < G::KT) sstore(buf ^ 1);
    __syncthreads();
  }
  G::epi(p, c, acc, mt * 256 + wm * 64, nt * 128 + wn * 64, lane);
}

__device__ __forceinline__ void epi_resid(const P& p, const Ctx& c, f32x4 (&acc)[4][4], int m0, int n0, int lane) {
#pragma unroll
  for (int mi = 0; mi < 4; mi++) {
    int row = m0 + mi * 16 + (lane & 15); int mo; float* xr = xrowp(p, row, mo);
    if (mo == 2 && !c.wc) continue;
    const float* g = p.MOD + (size_t)(c.layer * 3 + mo) * 3072 + 2048;
#pragma unroll
    for (int ni = 0; ni < 4; ni++) {
      int n = n0 + ni * 16 + (lane >> 4) * 4;
      float4 xv = *(float4*)(xr + n); float4 gg = *(const float4*)(g + n);
      xv.x += gg.x * acc[ni][mi][0]; xv.y += gg.y * acc[ni][mi][1]; xv.z += gg.z * acc[ni][mi][2]; xv.w += gg.w * acc[ni][mi][3];
      *(float4*)(xr + n) = xv;
    }
  }
}

struct G_LruIn { static constexpr int KT = 16, NT = 20;
  static __device__ __forceinline__ const bfr* aptr(const P& p, const Ctx& c, int row, int kt, int nt) { return p.H + (size_t)row * 1024 + kt * 64; }
  static __device__ __forceinline__ const bfr* bptr(const P& p, const Ctx& c, int n, int kt) { return p.W + (size_t)n * 1024 + kt * 64; }
  static __device__ __forceinline__ void epi(const P& p, const Ctx& c, f32x4 (&acc)[4][4], int m0, int n0, int lane) {
    bfr* U = (bfr*)(p.ACT + A_U); bfr* Z = (bfr*)(p.ACT + A_Z);
#pragma unroll
    for (int ni = 0; ni < 4; ni++)
#pragma unroll
      for (int mi = 0; mi < 4; mi++) {
        int row = m0 + mi * 16 + (lane & 15), n = n0 + ni * 16 + (lane >> 4) * 4;
        bfr* dst = n < 1280 ? U + (size_t)row * 1280 + n : Z + (size_t)row * 1280 + (n - 1280);
        store4b(dst, acc[ni][mi]);
      }
  } };
struct G_LruGate { static constexpr int KT = 2, NT = 20;
  static __device__ __forceinline__ const bfr* aptr(const P& p, const Ctx& c, int row, int kt, int nt) { return (const bfr*)(p.ACT + A_UC) + (size_t)row * 1280 + (nt >> 1) * 128 + kt * 64; }
  static __device__ __forceinline__ const bfr* bptr(const P& p, const Ctx& c, int n, int kt) { return p.W + WL_GATE + c.d * 655360 + (size_t)n * 128 + kt * 64; }
  static __device__ __forceinline__ void epi(const P& p, const Ctx& c, f32x4 (&acc)[4][4], int m0, int n0, int lane) {
    const bfr* UC = (const bfr*)(p.ACT + A_UC); unsigned* AB = (unsigned*)(p.ACT + A_AB);
    const float* gb = p.lru_gate_b + (size_t)(c.j * 2 + c.d) * 2 * 1280; const float* lam = p.lru_lam + (size_t)(c.j * 2 + c.d) * 1280;
    int chb = (n0 >> 6) * 32;
#pragma unroll
    for (int ni = 0; ni < 2; ni++) {
      int ch = chb + ni * 16 + (lane >> 4) * 4;
      float cl[4], br[4], bi[4];
#pragma unroll
      for (int q = 0; q < 4; q++) { cl[q] = p.CL[(size_t)(c.j * 2 + c.d) * 1280 + ch + q]; br[q] = gb[ch + q]; bi[q] = gb[1280 + ch + q]; }
#pragma unroll
      for (int mi = 0; mi < 4; mi++) {
        int row = m0 + mi * 16 + (lane & 15);
        uint2 u = *(const uint2*)(UC + (size_t)row * 1280 + ch);
        float uc[4] = {blo(u.x), bhi(u.x), blo(u.y), bhi(u.y)};
        unsigned o[4];
#pragma unroll
        for (int q = 0; q < 4; q++) {
          float r = sigm(acc[ni][mi][q] + br[q]), ig = sigm(acc[ni + 2][mi][q] + bi[q]);
          float la = -cl[q] * r; float oma = 1.f - __expf(la); float bb = __builtin_amdgcn_sqrtf(oma * (2.f - oma)) * ig * uc[q];
          o[q] = (((unsigned)f2b(oma)) << 16) | (unsigned)f2b(bb);
        }
        *(uint4*)(AB + (size_t)row * 1280 + ch) = uint4{o[0], o[1], o[2], o[3]};
      }
    }
  } };
struct G_LruOut { static constexpr int KT = 20, NT = 8;
  static __device__ __forceinline__ const bfr* aptr(const P& p, const Ctx& c, int row, int kt, int nt) { return (const bfr*)(p.ACT + A_Z) + (size_t)row * 1280 + kt * 64; }
  static __device__ __forceinline__ const bfr* bptr(const P& p, const Ctx& c, int n, int kt) { return p.W + WL_OUT + (size_t)n * 1280 + kt * 64; }
  static __device__ __forceinline__ void epi(const P& p, const Ctx& c, f32x4 (&acc)[4][4], int m0, int n0, int lane) { epi_resid(p, c, acc, m0, n0, lane); } };
struct G_MlIn { static constexpr int KT = 16, NT = 33;
  static __device__ __forceinline__ const bfr* aptr(const P& p, const Ctx& c, int row, int kt, int nt) { return p.H + (size_t)row * 1024 + kt * 64; }
  static __device__ __forceinline__ const bfr* bptr(const P& p, const Ctx& c, int n, int kt) { return p.W + (size_t)n * 1024 + kt * 64; }
  static __device__ __forceinline__ void epi(const P& p, const Ctx& c, f32x4 (&acc)[4][4], int m0, int n0, int lane) {
    bfr* QKV = (bfr*)(p.ACT + A_QKV); float* GT = (float*)(p.ACT + A_GATE);
#pragma unroll
    for (int ni = 0; ni < 4; ni++)
#pragma unroll
      for (int mi = 0; mi < 4; mi++) {
        int row = m0 + mi * 16 + (lane & 15), n = n0 + ni * 16 + (lane >> 4) * 4;
        if (n < 4096) store4b(QKV + (size_t)row * 4096 + n, acc[ni][mi]);
        else if (n < 4128) *(float4*)(GT + (size_t)row * 32 + (n - 4096)) = float4{acc[ni][mi][0], acc[ni][mi][1], acc[ni][mi][2], acc[ni][mi][3]};
      }
  } };
struct G_MlZ { static constexpr int KT = 16, NT = 16;
  static __device__ __forceinline__ const bfr* aptr(const P& p, const Ctx& c, int row, int kt, int nt) { return p.H + (size_t)row * 1024 + kt * 64; }
  static __device__ __forceinline__ const bfr* bptr(const P& p, const Ctx& c, int n, int kt) { return p.W + WM_Z + (size_t)n * 1024 + kt * 64; }
  static __device__ __forceinline__ void epi(const P& p, const Ctx& c, f32x4 (&acc)[4][4], int m0, int n0, int lane) {
    bfr* HS = (bfr*)(p.ACT + A_HS); const float* RS = (const float*)(p.ACT + A_RSTD); const float* ng = p.ml_norm_g + (size_t)c.j * 2048;
#pragma unroll
    for (int ni = 0; ni < 4; ni++)
#pragma unroll
      for (int mi = 0; mi < 4; mi++) {
        int row = m0 + mi * 16 + (lane & 15), n = n0 + ni * 16 + (lane >> 4) * 4;
        bfr* hp = HS + (size_t)row * 2048 + n; uint2 u = *(const uint2*)hp; float rs = RS[(size_t)row * 8 + (n >> 8)];
        float4 g4 = *(const float4*)(ng + n);
        f32x4 o;
        o[0] = blo(u.x) * rs * g4.x * siluf(acc[ni][mi][0]); o[1] = bhi(u.x) * rs * g4.y * siluf(acc[ni][mi][1]);
        o[2] = blo(u.y) * rs * g4.z * siluf(acc[ni][mi][2]); o[3] = bhi(u.y) * rs * g4.w * siluf(acc[ni][mi][3]);
        store4b(hp, o);
      }
  } };
struct G_MlOut { static constexpr int KT = 32, NT = 8;
  static __device__ __forceinline__ const bfr* aptr(const P& p, const Ctx& c, int row, int kt, int nt) { return (const bfr*)(p.ACT + A_HS) + (size_t)row * 2048 + kt * 64; }
  static __device__ __forceinline__ const bfr* bptr(const P& p, const Ctx& c, int n, int kt) { return p.W + WM_OUT + (size_t)n * 2048 + kt * 64; }
  static __device__ __forceinline__ void epi(const P& p, const Ctx& c, f32x4 (&acc)[4][4], int m0, int n0, int lane) { epi_resid(p, c, acc, m0, n0, lane); } };
struct G_R7In { static constexpr int KT = 32, NT = 34;
  static __device__ __forceinline__ const bfr* aptr(const P& p, const Ctx& c, int row, int kt, int nt) {
    if (kt < 16) return p.H + (size_t)row * 1024 + kt * 64;
    int q = (kt - 16) >> 2; int b = row / BT_, o = row - b * BT_; int nr;
    if (o < 256) { if (q < 2) { if (o < 1) return nullptr; nr = row - 1; } else { if (o >= 255) return nullptr; nr = row + 1; } }
    else { int t = o - 256, col = t & 63, gr = t >> 6;
      if (q == 0) { if (col == 0) return nullptr; nr = row - 1; }
      else if (q == 1) { if (col == 63) return nullptr; nr = row + 1; }
      else if (q == 2) { if (gr == 0) return nullptr; nr = row - 64; }
      else { if (gr == 255) return nullptr; nr = row + 64; } }
    return p.H + (size_t)nr * 1024 + (kt - 16) * 64; }
  static __device__ __forceinline__ const bfr* bptr(const P& p, const Ctx& c, int n, int kt) { return p.W + (size_t)n * 2048 + kt * 64; }
  static __device__ __forceinline__ void epi(const P& p, const Ctx& c, f32x4 (&acc)[4][4], int m0, int n0, int lane) {
    bfr* RK = (bfr*)(p.ACT + A_RKVZ); bfr* WMb = (bfr*)(p.ACT + A_WM); bfr* AMb = (bfr*)(p.ACT + A_AM);
#pragma unroll
    for (int ni = 0; ni < 4; ni++)
#pragma unroll
      for (int mi = 0; mi < 4; mi++) {
        int row = m0 + mi * 16 + (lane & 15), n = n0 + ni * 16 + (lane >> 4) * 4;
        if (n < 4096) store4b(RK + (size_t)row * 4096 + n, acc[ni][mi]);
        else if (n < 4224) { f32x4 t;
#pragma unroll
          for (int q = 0; q < 4; q++) t[q] = tanhf(acc[ni][mi][q]); store4b(WMb + (size_t)row * 128 + (n - 4096), t); }
        else store4b(AMb + (size_t)row * 128 + (n - 4224), acc[ni][mi]);
      }
  } };
struct G_R7Out { static constexpr int KT = 16, NT = 8;
  static __device__ __forceinline__ const bfr* aptr(const P& p, const Ctx& c, int row, int kt, int nt) { return p.H + (size_t)row * 1024 + kt * 64; }
  static __device__ __forceinline__ const bfr* bptr(const P& p, const Ctx& c, int n, int kt) { return p.W + WR_OUT + (size_t)n * 1024 + kt * 64; }
  static __device__ __forceinline__ void epi(const P& p, const Ctx& c, f32x4 (&acc)[4][4], int m0, int n0, int lane) { epi_resid(p, c, acc, m0, n0, lane); } };


namespace pg8 {
#define PG8_LAS __attribute__((address_space(3)))
constexpr int BM = 256, BK = 64, HALF = 128, HTB = HALF * BK * 2, NXCD = 8, WGM = 8;
__device__ __forceinline__ int lds_byte(int r, int c) { const int st = (r >> 4) * 2 + (c >> 5), rr = r & 15, cc = c & 31, ob = rr * 64 + cc * 2; return st * 1024 + (ob ^ (((ob >> 9) & 1) << 5)); }
__device__ __forceinline__ void stage_rc(int b, int& R, int& C) { const int st = b / 1024, sb = b % 1024, swz = sb ^ (((sb >> 9) & 1) << 5); R = (st >> 1) * 16 + swz / 64; C = (st & 1) * 32 + (swz % 64) / 2; }
struct Unit { int pm, pn; };
struct Gemm { const bfr* A; const bfr* Bt; int M, N, K; };
struct StaticOrder {
  int nM, nN, nwg, G, c;
  __device__ void init(int M, int N, int G_, int c_) { nM = M / BM; nN = N / BM; nwg = nM * nN; G = G_; c = c_; }
  __device__ bool next(int i, Unit& u) const {
    const long L = (long)i * G + c; if (L >= nwg) return false;
    int wgid = (int)L; { const int q = nwg / NXCD, r = nwg % NXCD, xcd = wgid % NXCD, off = wgid / NXCD; wgid = (xcd < r ? xcd * (q + 1) : r * (q + 1) + (xcd - r) * q) + off; }
    const int nig = WGM * nN, gid = wgid / nig, fm = gid * WGM, gsz = (nM - fm) < WGM ? (nM - fm) : WGM;
    u.pm = fm + ((wgid % nig) % gsz); u.pn = (wgid % nig) / gsz; return true;
  }
};
template <class Epi>
__device__ __forceinline__ void gemm_phase(PG8_LAS unsigned char* lds, const Gemm g, const StaticOrder& S, const Epi& E) {
  const int tid = ltid(), wid = __builtin_amdgcn_readfirstlane(tid >> 6), lane = tid & 63, wr = wid >> 2, wc = wid & 3, fr = lane & 15, fq = lane >> 4;
  const int K = g.K, nt = K / BK;
  unsigned voffA[2], voffB[2];
#pragma unroll
  for (int i = 0; i < 2; ++i) { int R, C; stage_rc(tid * 16 + i * 8192, R, C); voffA[i] = (unsigned)(R * K + C) * 2u; voffB[i] = voffA[i]; }
  const size_t kstep = (size_t)(BK * 2);
  const size_t hstep = (size_t)HALF * K * 2;
  const size_t tstep = 2 * hstep;
  const unsigned ldsw = (unsigned)wid * 1024u;
  const int aoff = lds_byte(wr * 64 + fr, fq * 8), boff = lds_byte(wc * 32 + fr, fq * 8);
#define PG8_SA(b, h) (((b) * 2 + (h)) * HTB)
#define PG8_SB(b, h) ((4 + (b) * 2 + (h)) * HTB)
#define PG8_STAGE(bufoff, gbase, voff) do { _Pragma("unroll") for (int _i = 0; _i < 2; ++_i) \
    __builtin_amdgcn_global_load_lds((const unsigned*)((const char*)(gbase) + (voff)[_i]), (PG8_LAS unsigned*)(lds + (bufoff) + ldsw + _i * 8192), 16, 0, 0); } while (0)
#define PG8_LDA(dst, b, h) do { _Pragma("unroll") for (int m = 0; m < 4; ++m) _Pragma("unroll") for (int k = 0; k < 2; ++k) dst[m][k] = *(const PG8_LAS bf16x8*)(lds + PG8_SA(b, h) + aoff + m * 2048 + k * 1024); } while (0)
#define PG8_LDB(dst, b, h) do { _Pragma("unroll") for (int n = 0; n < 2; ++n) _Pragma("unroll") for (int k = 0; k < 2; ++k) dst[n][k] = *(const PG8_LAS bf16x8*)(lds + PG8_SB(b, h) + boff + n * 2048 + k * 1024); } while (0)
#define PG8_MMA(ai, bj, At, Bt) do { __builtin_amdgcn_s_setprio(1); _Pragma("unroll") for (int m = 0; m < 4; ++m) _Pragma("unroll") for (int n = 0; n < 2; ++n) _Pragma("unroll") for (int k = 0; k < 2; ++k) \
    acc[ai][bj][m][n] = __builtin_amdgcn_mfma_f32_16x16x32_bf16(Bt[n][k], At[m][k], acc[ai][bj][m][n], 0, 0, 0); __builtin_amdgcn_s_setprio(0); } while (0)
#define PG8_WAIT_V(n) asm volatile("s_waitcnt vmcnt(" #n ")" ::: "memory")
#define PG8_WAIT_L(n) asm volatile("s_waitcnt lgkmcnt(" #n ")" ::: "memory")
#define PG8_BAR __builtin_amdgcn_s_barrier()
#define PG8_SCHED __builtin_amdgcn_sched_barrier(0)
  Unit cur, nxt; int ui = 0;
  if (!S.next(0, cur)) return;
  f32x4 acc[2][2][4][2];
#pragma unroll
  for (int a = 0; a < 2; ++a)
#pragma unroll
    for (int b = 0; b < 2; ++b)
#pragma unroll
      for (int m = 0; m < 4; ++m)
#pragma unroll
        for (int n = 0; n < 2; ++n) acc[a][b][m][n] = (f32x4){0.f, 0.f, 0.f, 0.f};
  bf16x8 At[4][2], B0[2][2], B1[2][2];
  const char* cA = (const char*)g.A + (size_t)cur.pm * tstep; const char* cB = (const char*)g.Bt + (size_t)cur.pn * tstep;
  PG8_STAGE(PG8_SB(0, 0), cB, voffB); PG8_STAGE(PG8_SA(0, 0), cA, voffA); PG8_STAGE(PG8_SB(0, 1), cB + hstep, voffB); PG8_STAGE(PG8_SA(0, 1), cA + hstep, voffA);
  if (wr == 1) PG8_BAR;
  PG8_WAIT_V(4); PG8_BAR;
  PG8_STAGE(PG8_SB(1, 0), cB + kstep, voffB); PG8_STAGE(PG8_SA(1, 0), cA + kstep, voffA); PG8_STAGE(PG8_SB(1, 1), cB + hstep + kstep, voffB);
  PG8_WAIT_V(6); PG8_BAR;
  for (;;) {
    const bool has_next = S.next(ui + 1, nxt);
    const char* nA = has_next ? (const char*)g.A + (size_t)nxt.pm * tstep : cA; const char* nB = has_next ? (const char*)g.Bt + (size_t)nxt.pn * tstep : cB;
    for (int t = 0; t < nt; t += 2) {
      const bool last = (t == nt - 2);
      const char* a1 = cA + (size_t)(t + 1) * kstep;
      const char* a2 = last ? nA : cA + (size_t)(t + 2) * kstep; const char* b2 = last ? nB : cB + (size_t)(t + 2) * kstep;
      const char* a3 = a2 + kstep; const char* b3 = b2 + kstep;
      PG8_LDB(B0, 0, 0); PG8_SCHED; PG8_LDA(At, 0, 0); PG8_STAGE(PG8_SA(1, 1), a1 + hstep, voffA);
      PG8_WAIT_L(8); PG8_BAR; PG8_WAIT_L(0); PG8_MMA(0, 0, At, B0); PG8_BAR; PG8_SCHED;
      PG8_LDB(B1, 0, 1); PG8_STAGE(PG8_SB(0, 0), b2, voffB);
      PG8_BAR; PG8_WAIT_L(0); PG8_MMA(0, 1, At, B1); PG8_BAR;
      PG8_LDA(At, 0, 1); PG8_STAGE(PG8_SA(0, 0), a2, voffA);
      PG8_BAR; PG8_WAIT_L(0); PG8_MMA(1, 0, At, B0); PG8_BAR; PG8_SCHED;
      PG8_STAGE(PG8_SB(0, 1), b2 + hstep, voffB);
      PG8_WAIT_V(6); PG8_BAR; PG8_MMA(1, 1, At, B1); PG8_BAR;
      PG8_LDB(B0, 1, 0); PG8_SCHED; PG8_LDA(At, 1, 0); PG8_STAGE(PG8_SA(0, 1), a2 + hstep, voffA);
      PG8_WAIT_L(8); PG8_BAR; PG8_WAIT_L(0); PG8_MMA(0, 0, At, B0); PG8_BAR; PG8_SCHED;
      PG8_LDB(B1, 1, 1); PG8_STAGE(PG8_SB(1, 0), b3, voffB);
      PG8_BAR; PG8_WAIT_L(0); PG8_MMA(0, 1, At, B1); PG8_BAR;
      PG8_LDA(At, 1, 1); PG8_STAGE(PG8_SA(1, 0), a3, voffA);
      PG8_BAR; PG8_WAIT_L(0); PG8_MMA(1, 0, At, B0); PG8_BAR; PG8_SCHED;
      PG8_STAGE(PG8_SB(1, 1), b3 + hstep, voffB);
      PG8_WAIT_V(6); PG8_BAR; PG8_MMA(1, 1, At, B1); PG8_BAR;
    }
    E(acc, cur, wr, wc, fr, fq);
    if (!has_next) break;
#pragma unroll
    for (int a = 0; a < 2; ++a)
#pragma unroll
      for (int b = 0; b < 2; ++b)
#pragma unroll
        for (int m = 0; m < 4; ++m)
#pragma unroll
          for (int n = 0; n < 2; ++n) acc[a][b][m][n] = (f32x4){0.f, 0.f, 0.f, 0.f};
    cur = nxt; cA = nA; cB = nB; ++ui;
  }
  PG8_WAIT_V(0);
  if (wr == 0) PG8_BAR;
  PG8_BAR;
#undef PG8_SA
#undef PG8_SB
#undef PG8_STAGE
#undef PG8_LDA
#undef PG8_LDB
#undef PG8_MMA
#undef PG8_WAIT_V
#undef PG8_WAIT_L
#undef PG8_BAR
#undef PG8_SCHED
}
}

template <class F> struct EpiAd {
  F f;
  __device__ __forceinline__ void operator()(const f32x4 (&acc)[2][2][4][2], const pg8::Unit& u, int wr, int wc, int fr, int fq) const {
#pragma unroll
    for (int ai = 0; ai < 2; ++ai)
#pragma unroll
      for (int m = 0; m < 4; ++m) { const int row = u.pm * 256 + ai * 128 + wr * 64 + m * 16 + fr;
#pragma unroll
        for (int bj = 0; bj < 2; ++bj)
#pragma unroll
          for (int n = 0; n < 2; ++n) f(row, u.pn * 256 + bj * 128 + wc * 32 + n * 16 + 4 * fq, acc[ai][bj][m][n]); }
  }
};
template <class F> __device__ __forceinline__ void big_gemm(char* smem, const bfr* A, const bfr* Bt, int N, int K, F f) {
  pg8::Gemm g; g.A = A; g.Bt = Bt; g.M = R_; g.N = N; g.K = K;
  pg8::StaticOrder S; S.init(R_, N, (int)gridDim.x, (int)blockIdx.x);
  EpiAd<F> E{f};
  pg8::gemm_phase(( __attribute__((address_space(3))) unsigned char*)smem, g, S, E);
}
struct F_LruIn { char* ACT; __device__ __forceinline__ void operator()(int row, int n, f32x4 v) const {
  bfr* dst = n < 1280 ? (bfr*)(ACT + A_U) + (size_t)row * 1280 + n : (bfr*)(ACT + A_Z) + (size_t)row * 1280 + (n - 1280); store4b(dst, v); } };
struct F_Resid { float* Xx; float* Xc; const float* MODg; int wc; __device__ __forceinline__ void operator()(int row, int n, f32x4 v) const {
  int b = row / BT_, o = row - b * BT_; bool isc = o < 256; if (isc && !wc) return;
  float* xr = isc ? Xc + (size_t)(b * 256 + o) * 1024 : Xx + (size_t)(b * 16384 + o - 256) * 1024; const float* g = MODg + (size_t)(isc ? 2 : b) * 3072 + 2048;
  float4 xv = *(float4*)(xr + n); float4 gg = *(const float4*)(g + n);
  xv.x += gg.x * v[0]; xv.y += gg.y * v[1]; xv.z += gg.z * v[2]; xv.w += gg.w * v[3]; *(float4*)(xr + n) = xv; } };
struct F_MlIn { char* ACT; __device__ __forceinline__ void operator()(int row, int n, f32x4 v) const {
  if (n < 4096) store4b((bfr*)(ACT + A_QKV) + (size_t)row * 4096 + n, v);
  else if (n < 4128) *(float4*)((float*)(ACT + A_GATE) + (size_t)row * 32 + (n - 4096)) = float4{v[0], v[1], v[2], v[3]}; } };
struct F_MlZ { char* ACT; const float* ng; __device__ __forceinline__ void operator()(int row, int n, f32x4 v) const {
  bfr* hp = (bfr*)(ACT + A_HS) + (size_t)row * 2048 + n; uint2 u = *(const uint2*)hp; float rs = ((const float*)(ACT + A_RSTD))[(size_t)row * 8 + (n >> 8)];
  float4 g4 = *(const float4*)(ng + n); f32x4 o;
  o[0] = blo(u.x) * rs * g4.x * siluf(v[0]); o[1] = bhi(u.x) * rs * g4.y * siluf(v[1]); o[2] = blo(u.y) * rs * g4.z * siluf(v[2]); o[3] = bhi(u.y) * rs * g4.w * siluf(v[3]);
  store4b(hp, o); } };
struct F_R7In { char* ACT; __device__ __forceinline__ void operator()(int row, int n, f32x4 v) const {
  if (n < 4096) store4b((bfr*)(ACT + A_RKVZ) + (size_t)row * 4096 + n, v);
  else if (n < 4224) { f32x4 t;
#pragma unroll
    for (int q = 0; q < 4; q++) t[q] = tanhf(v[q]);
    store4b((bfr*)(ACT + A_WM) + (size_t)row * 128 + (n - 4096), t); }
  else store4b((bfr*)(ACT + A_AM) + (size_t)row * 128 + (n - 4224), v); } };

template <class G> __device__ __forceinline__ void gemm_phase(const P& p, const Ctx& c, char* smem) {
  const int total = 130 * G::NT;
  for (int it = blockIdx.x; it < total; it += gridDim.x) gemm_tile<G>(p, c, it / G::NT, it % G::NT, smem);
}

#define R7_Y2 ((bfr*)p.H + (size_t)64 * 26 * 16384)
template <class G> __device__ __forceinline__ void gemm_phase_k2(const P& p, const Ctx& c, char* smem) {
  const int tid = ltid(), lane = tid & 63, wid = tid >> 6, wm = wid & 3, wn = wid >> 2;
  bfr* sA = (bfr*)smem; bfr* sB = sA + 2 * 256 * LDSS;
  const int lr = tid >> 3, lc = tid & 7;
  const int total = 130 * G::NT;
  uint4 a00, a01, a02, a03, a10, a11, a12, a13, b00, b01, b10, b11;
#define GK2_LA(i_, R0, R1) { R0 = *(const uint4*)(G::aptr(p, c, mt_ * 256 + lr + 64 * (i_), 0, nt_) + lc * 8); R1 = *(const uint4*)(G::aptr(p, c, mt_ * 256 + lr + 64 * (i_), 1, nt_) + lc * 8); }
#define GK2_LB(i_, R0, R1) { R0 = *(const uint4*)(G::bptr(p, c, nt_ * 128 + lr + 64 * (i_), 0) + lc * 8); R1 = *(const uint4*)(G::bptr(p, c, nt_ * 128 + lr + 64 * (i_), 1) + lc * 8); }
#define GK2_LOAD(it_) { const int mt_ = (it_) / G::NT, nt_ = (it_) % G::NT; GK2_LA(0, a00, a10) GK2_LA(1, a01, a11) GK2_LA(2, a02, a12) GK2_LA(3, a03, a13) GK2_LB(0, b00, b10) GK2_LB(1, b01, b11) }
#define GK2_SA(i_, R0, R1) { *(uint4*)(sA + (lr + 64 * (i_)) * LDSS + lc * 8) = R0; *(uint4*)(sA + (256 + lr + 64 * (i_)) * LDSS + lc * 8) = R1; }
#define GK2_SB(i_, R0, R1) { *(uint4*)(sB + (lr + 64 * (i_)) * LDSS + lc * 8) = R0; *(uint4*)(sB + (128 + lr + 64 * (i_)) * LDSS + lc * 8) = R1; }
  int it = xcd_swz();
  if (it < total) GK2_LOAD(it)
  while (it < total) {
    const int mt = it / G::NT, nt = it % G::NT;
    GK2_SA(0, a00, a10) GK2_SA(1, a01, a11) GK2_SA(2, a02, a12) GK2_SA(3, a03, a13) GK2_SB(0, b00, b10) GK2_SB(1, b01, b11)
    __syncthreads();
    const int itn = it + gridDim.x;
    if (itn < total) GK2_LOAD(itn)
    f32x4 acc[4][4];
#pragma unroll
    for (int a = 0; a < 4; a++)
#pragma unroll
      for (int b = 0; b < 4; b++) acc[a][b] = f32x4{0.f, 0.f, 0.f, 0.f};
#pragma unroll
    for (int buf = 0; buf < 2; buf++)
#pragma unroll
      for (int ks = 0; ks < 2; ks++) {
        bf16x8 af[4], bf[4];
#pragma unroll
        for (int i = 0; i < 4; i++) {
          af[i] = *(const bf16x8*)(sA + (buf * 256 + wm * 64 + i * 16 + (lane & 15)) * LDSS + ks * 32 + (lane >> 4) * 8);
          bf[i] = *(const bf16x8*)(sB + (buf * 128 + wn * 64 + i * 16 + (lane & 15)) * LDSS + ks * 32 + (lane >> 4) * 8);
        }
#pragma unroll
        for (int n = 0; n < 4; n++)
#pragma unroll
          for (int m = 0; m < 4; m++) acc[n][m] = __builtin_amdgcn_mfma_f32_16x16x32_bf16(bf[n], af[m], acc[n][m], 0, 0, 0);
      }
    G::epi(p, c, acc, mt * 256 + wm * 64, nt * 128 + wn * 64, lane);
    __syncthreads();
    it = itn;
  }
#undef GK2_LOAD
#undef GK2_LA
#undef GK2_LB
#undef GK2_SA
#undef GK2_SB
}

__device__ __forceinline__ void ph_pre(const P& p, char* smem) {
  float* sm = (float*)smem; const int tid = ltid();
  const int nprep = prep_count(0), ngemv = 192, ncopy = 4160;
  if (blockIdx.x == 0) for (int i = tid; i < 5120; i += 512) p.CL[i] = 8.f * softplusf(-p.lru_lam[i]);
  for (int it = blockIdx.x; it < nprep + ngemv + ncopy; it += gridDim.x) {
    if (it < nprep) { prep_item(p, 0, it, sm); continue; }
    int i2 = it - nprep;
    if (i2 < ngemv) {
      int l = i2 / 48, cgp = i2 % 48;
      for (int i = tid; i < 3072; i += 512) { int cnd = i >> 10, k = i & 1023; float v = cnd == 0 ? p.c[k] : cnd == 1 ? p.c[1024 + k] : p.c_ctx[k]; sm[i] = siluf(v); }
      __syncthreads();
      int kq = tid >> 6, col = cgp * 64 + (tid & 63); const float* w = p.mod_w + (size_t)l * 1024 * 3072 + col;
      float a0 = 0.f, a1 = 0.f, a2 = 0.f;
      for (int k = kq * 128; k < kq * 128 + 128; k++) { float wv = w[(size_t)k * 3072]; a0 += sm[k] * wv; a1 += sm[1024 + k] * wv; a2 += sm[2048 + k] * wv; }
      float* red = sm + 3072; red[tid * 3] = a0; red[tid * 3 + 1] = a1; red[tid * 3 + 2] = a2;
      __syncthreads();
      if (tid < 64) { float bias = p.mod_b[(size_t)l * 3072 + col];
        for (int cnd = 0; cnd < 3; cnd++) { float s = bias; for (int q = 0; q < 8; q++) s += red[(q * 64 + tid) * 3 + cnd]; p.MOD[(size_t)(l * 3 + cnd) * 3072 + col] = s; } }
      __syncthreads();
      continue;
    }
    i2 -= ngemv;
    for (int q = 0; q < 4; q++) { int idx = i2 * 2048 + q * 512 + tid; int row = idx >> 8, c4 = idx & 255; int b = row / BT_, o = row - b * BT_;
      if (o < 256) ((float4*)p.Xc)[(size_t)(b * 256 + o) * 256 + c4] = ((const float4*)p.ctx)[(size_t)(b * 256 + o) * 256 + c4];
      else ((float4*)p.Xx)[(size_t)(b * 16384 + o - 256) * 256 + c4] = ((const float4*)p.x)[(size_t)(b * 16384 + o - 256) * 256 + c4]; }
  }
}
__device__ __forceinline__ void ph_norm(const P& p, int layer, char* smem) {
  const int tid = ltid(), lane = tid & 63, wid = tid >> 6;
  const int nprep = layer > 0 ? prep_count(layer) : 0; const int kind = layer % 3;
  const int nzero = kind == 1 ? 8320 : 0;
  (void)nzero;
  for (int it = blockIdx.x; it < nprep + 4160; it += gridDim.x) {
    if (it < nprep) { prep_item(p, layer, it, (float*)smem); continue; }
    int row = (it - nprep) * 8 + wid; int mo; const float* xr = xrowp(p, row, mo);
    float4 v[4]; float ss = 0.f;
#pragma unroll
    for (int i = 0; i < 4; i++) { v[i] = *(const float4*)(xr + lane * 4 + 256 * i); ss += v[i].x * v[i].x + v[i].y * v[i].y + v[i].z * v[i].z + v[i].w * v[i].w; }
    ss = wsum(ss); float rs = rsqrtf(ss * (1.f / 1024.f) + 1e-6f);
    const float* g = p.norm_g + (size_t)layer * 1024; const float* md = p.MOD + (size_t)(layer * 3 + mo) * 3072;
#pragma unroll
    for (int i = 0; i < 4; i++) { int cidx = lane * 4 + 256 * i; float4 gg = *(const float4*)(g + cidx), sh = *(const float4*)(md + cidx), sc = *(const float4*)(md + 1024 + cidx);
      f32x4 o; o[0] = v[i].x * rs * gg.x * (1.f + sc.x) + sh.x; o[1] = v[i].y * rs * gg.y * (1.f + sc.y) + sh.y; o[2] = v[i].z * rs * gg.z * (1.f + sc.z) + sh.z; o[3] = v[i].w * rs * gg.w * (1.f + sc.w) + sh.w;
      store4b(p.H + (size_t)row * (kind == 2 ? 2048 : 1024) + cidx, o); }
  }
}
__device__ __forceinline__ void ph_r7_shift(const P& p) {
  for (int it = blockIdx.x; it < 8320; it += gridDim.x) {
    int idx = it * 512 + ltid(); int row = idx >> 7, c8 = idx & 127, q = c8 >> 5;
    int b = row / BT_, o = row - b * BT_; int nr = -1;
    if (o < 256) { if (q < 2) { if (o >= 1) nr = row - 1; } else { if (o < 255) nr = row + 1; } }
    else { int t = o - 256, col = t & 63, gr = t >> 6;
      if (q == 0) { if (col != 0) nr = row - 1; } else if (q == 1) { if (col != 63) nr = row + 1; }
      else if (q == 2) { if (gr != 0) nr = row - 64; } else { if (gr != 255) nr = row + 64; } }
    uint4 v = nr >= 0 ? *(const uint4*)(p.H + (size_t)nr * 2048 + c8 * 8) : uint4{0u, 0u, 0u, 0u};
    *(uint4*)(p.H + (size_t)row * 2048 + 1024 + c8 * 8) = v;
  }
}
__device__ __forceinline__ void ph_final(const P& p) {
  const int lane = ltid() & 63, wid = ltid() >> 6;
  for (int it = blockIdx.x; it < 4096; it += gridDim.x) {
    float* xr = p.Xx + (size_t)(it * 8 + wid) * 1024; float4 v[4]; float ss = 0.f;
#pragma unroll
    for (int i = 0; i < 4; i++) { v[i] = *(const float4*)(xr + lane * 4 + 256 * i); ss += v[i].x * v[i].x + v[i].y * v[i].y + v[i].z * v[i].z + v[i].w * v[i].w; }
    ss = wsum(ss); float rs = rsqrtf(ss * (1.f / 1024.f) + 1e-6f);
#pragma unroll
    for (int i = 0; i < 4; i++) { int cidx = lane * 4 + 256 * i; float4 gg = *(const float4*)(p.final_g + cidx);
      *(float4*)(xr + cidx) = float4{v[i].x * rs * gg.x, v[i].y * rs * gg.y, v[i].z * rs * gg.z, v[i].w * rs * gg.w}; }
  }
}
__device__ __forceinline__ void ph_lru_conv(const P& p, int j) {
  const bfr* U = (const bfr*)(p.ACT + A_U); bfr* UC = (bfr*)(p.ACT + A_UC);
  const float* cw = p.lru_conv_w + (size_t)j * 4 * 1280; const float* cb = p.lru_conv_b + (size_t)j * 1280;
  for (int it = xcd_swz(); it < 10400; it += gridDim.x) {
    int idx = it * 512 + ltid(); int row = idx / 160, cgp = idx % 160, ch = cgp * 8;
    int b = row / BT_, o = row - b * BT_; int s0 = o < 256 ? 0 : 256, e0 = o < 256 ? 256 : BT_;
    float acc[8];
#pragma unroll
    for (int e = 0; e < 8; e++) acc[e] = cb[ch + e];
#pragma unroll
    for (int t = 0; t < 4; t++) { int oo = o + t - 2; if (oo < s0 || oo >= e0) continue;
      uint4 u = *(const uint4*)(U + (size_t)(row + t - 2) * 1280 + ch); const float* w = cw + t * 1280 + ch;
      acc[0] += w[0] * blo(u.x); acc[1] += w[1] * bhi(u.x); acc[2] += w[2] * blo(u.y); acc[3] += w[3] * bhi(u.y);
      acc[4] += w[4] * blo(u.z); acc[5] += w[5] * bhi(u.z); acc[6] += w[6] * blo(u.w); acc[7] += w[7] * bhi(u.w); }
    *(uint4*)(UC + (size_t)row * 1280 + ch) = uint4{pk2(acc[0], acc[1]), pk2(acc[2], acc[3]), pk2(acc[4], acc[5]), pk2(acc[6], acc[7])};
  }
}
__device__ __forceinline__ void ph_lru_s1(const P& p, int d) {
  const unsigned* AB = (const unsigned*)(p.ACT + A_AB); float2* AGG = (float2*)(p.ACT + A_AGG);
  const int t = ltid();
  for (int it = xcd_swz() * 8 + (t >> 6); it < 2600; it += gridDim.x * 8) {
    int b = it / 1300, r = it % 1300, cc = r / 5, ch = (r % 5) * 256 + (t & 63) * 4;
    float P0 = 1.f, Q0 = 0.f, P1 = 1.f, Q1 = 0.f, P2 = 1.f, Q2 = 0.f, P3 = 1.f, Q3 = 0.f;
#pragma unroll 8
    for (int q = 0; q < 64; q++) { uint4 u = *(const uint4*)(AB + (size_t)rowmap(d, b, cc * 64 + q) * 1280 + ch);
      float a0 = 1.f - bhi(u.x), a1 = 1.f - bhi(u.y), a2 = 1.f - bhi(u.z), a3 = 1.f - bhi(u.w);
      P0 *= a0; Q0 = a0 * Q0 + blo(u.x); P1 *= a1; Q1 = a1 * Q1 + blo(u.y); P2 *= a2; Q2 = a2 * Q2 + blo(u.z); P3 *= a3; Q3 = a3 * Q3 + blo(u.w); }
    float4* ag = (float4*)(AGG + (size_t)(b * NCH_ + cc) * 1280 + ch); ag[0] = float4{P0, Q0, P1, Q1}; ag[1] = float4{P2, Q2, P3, Q3};
  }
}
__device__ __forceinline__ void ph_lru_s2(const P& p, char* smem) {
  const float2* AGG = (const float2*)(p.ACT + A_AGG); float* CAR = (float*)(p.ACT + A_CAR);
  float* sP = (float*)smem; float* sQ = sP + 512;
  const int tid = ltid(), chl = tid & 63, seg = tid >> 6;
  for (int it = blockIdx.x; it < 40; it += gridDim.x) {
    const int b = it / 20, ch = (it % 20) * 64 + chl; const int cb = seg * 33, ce = cb + 33 < NCH_ ? cb + 33 : NCH_;
    float Pp = 1.f, Q = 0.f;
#pragma unroll 11
    for (int cc = cb; cc < ce; cc++) { float2 a = AGG[(size_t)(b * NCH_ + cc) * 1280 + ch]; Pp *= a.x; Q = a.x * Q + a.y; }
    __syncthreads();
    sP[seg * 64 + chl] = Pp; sQ[seg * 64 + chl] = Q;
    __syncthreads();
    float h = 0.f;
    for (int s2 = 0; s2 < seg; s2++) h = sP[s2 * 64 + chl] * h + sQ[s2 * 64 + chl];
#pragma unroll 11
    for (int cc = cb; cc < ce; cc++) { size_t o = (size_t)(b * NCH_ + cc) * 1280 + ch; float2 a = AGG[o]; CAR[o] = h; h = a.x * h + a.y; }
  }
}
__device__ __forceinline__ void ph_lru_s3(const P& p, int d) {
  const unsigned* AB = (const unsigned*)(p.ACT + A_AB); const float* CAR = (const float*)(p.ACT + A_CAR);
  bfr* HF = (bfr*)(p.ACT + A_HF); bfr* Z = (bfr*)(p.ACT + A_Z);
  const int t = ltid();
  for (int it = xcd_swz() * 8 + (t >> 6); it < 2600; it += gridDim.x * 8) {
    int b = it / 1300, r = it % 1300, cc = r / 5, ch = (r % 5) * 256 + (t & 63) * 4;
    float4 h = *(const float4*)(CAR + (size_t)(b * NCH_ + cc) * 1280 + ch);
#pragma unroll 8
    for (int q = 0; q < 64; q++) { size_t o = (size_t)rowmap(d, b, cc * 64 + q) * 1280 + ch; uint4 u = *(const uint4*)(AB + o);
      h.x = (1.f - bhi(u.x)) * h.x + blo(u.x); h.y = (1.f - bhi(u.y)) * h.y + blo(u.y); h.z = (1.f - bhi(u.z)) * h.z + blo(u.z); h.w = (1.f - bhi(u.w)) * h.w + blo(u.w);
      if (d == 0) *(uint2*)(HF + o) = uint2{pk2(h.x, h.y), pk2(h.z, h.w)};
      else { uint2 hf = *(const uint2*)(HF + o), zz = *(const uint2*)(Z + o);
        *(uint2*)(Z + o) = uint2{pk2((blo(hf.x) + h.x) * siluf(blo(zz.x)), (bhi(hf.x) + h.y) * siluf(bhi(zz.x))), pk2((blo(hf.y) + h.z) * siluf(blo(zz.y)), (bhi(hf.y) + h.w) * siluf(bhi(zz.y)))}; } }
  }
}
__device__ __forceinline__ void ph_ml_stat(const P& p) {
  const bfr* HS = (const bfr*)(p.ACT + A_HS); float* RS = (float*)(p.ACT + A_RSTD);
  const int lane = ltid() & 63, wid = ltid() >> 6;
  for (int it = blockIdx.x; it < 4160; it += gridDim.x) {
    int row = it * 8 + wid; const bfr* hp = HS + (size_t)row * 2048 + lane * 32; float ss = 0.f;
#pragma unroll
    for (int i = 0; i < 4; i++) { uint4 u = *(const uint4*)(hp + i * 8); float a;
      a = blo(u.x); ss += a * a; a = bhi(u.x); ss += a * a; a = blo(u.y); ss += a * a; a = bhi(u.y); ss += a * a;
      a = blo(u.z); ss += a * a; a = bhi(u.z); ss += a * a; a = blo(u.w); ss += a * a; a = bhi(u.w); ss += a * a; }
    ss += __shfl_xor(ss, 1); ss += __shfl_xor(ss, 2); ss += __shfl_xor(ss, 4);
    if ((lane & 7) == 0) RS[(size_t)row * 8 + (lane >> 3)] = rsqrtf(ss * (1.f / 256.f) + 1e-6f);
  }
}
__device__ __forceinline__ void ph_r7_fin(const P& p, int j) {
  bfr* Y = (bfr*)(p.ACT + A_Y); const bfr* RK = (const bfr*)(p.ACT + A_RKVZ); const float* BON = (const float*)(p.ACT + A_BON);
  const float* lg = p.r7_ln_g + (size_t)j * 1024; const float* lb = p.r7_ln_b + (size_t)j * 1024;
  const int lane = ltid() & 63, wid = ltid() >> 6;
  for (int it = blockIdx.x; it < 4160; it += gridDim.x) {
    int row = it * 8 + wid, ch = lane * 16, hd = lane >> 2;
    float y[16], v[16], z[16];
#pragma unroll
    for (int i = 0; i < 2; i++) {
      uint4 u = *(const uint4*)(Y + (size_t)row * 1024 + ch + i * 8); const uint4 u2 = *(const uint4*)(R7_Y2 + (size_t)row * 1024 + ch + i * 8);
      y[i * 8 + 0] = blo(u.x) + blo(u2.x); y[i * 8 + 1] = bhi(u.x) + bhi(u2.x); y[i * 8 + 2] = blo(u.y) + blo(u2.y); y[i * 8 + 3] = bhi(u.y) + bhi(u2.y); y[i * 8 + 4] = blo(u.z) + blo(u2.z); y[i * 8 + 5] = bhi(u.z) + bhi(u2.z); y[i * 8 + 6] = blo(u.w) + blo(u2.w); y[i * 8 + 7] = bhi(u.w) + bhi(u2.w);
      u = *(const uint4*)(RK + (size_t)row * 4096 + 2048 + ch + i * 8);
      v[i * 8 + 0] = blo(u.x); v[i * 8 + 1] = bhi(u.x); v[i * 8 + 2] = blo(u.y); v[i * 8 + 3] = bhi(u.y); v[i * 8 + 4] = blo(u.z); v[i * 8 + 5] = bhi(u.z); v[i * 8 + 6] = blo(u.w); v[i * 8 + 7] = bhi(u.w);
      u = *(const uint4*)(RK + (size_t)row * 4096 + 3072 + ch + i * 8);
      z[i * 8 + 0] = blo(u.x); z[i * 8 + 1] = bhi(u.x); z[i * 8 + 2] = blo(u.y); z[i * 8 + 3] = bhi(u.y); z[i * 8 + 4] = blo(u.z); z[i * 8 + 5] = bhi(u.z); z[i * 8 + 6] = blo(u.w); z[i * 8 + 7] = bhi(u.w);
    }
    float s = 0.f;
#pragma unroll
    for (int e = 0; e < 16; e++) s += y[e];
    s += __shfl_xor(s, 1); s += __shfl_xor(s, 2); float mean = s * (1.f / 64.f);
    float q = 0.f;
#pragma unroll
    for (int e = 0; e < 16; e++) { float dlt = y[e] - mean; q += dlt * dlt; }
    q += __shfl_xor(q, 1); q += __shfl_xor(q, 2); float rs = rsqrtf(q * (1.f / 64.f) + 64e-5f);
    float bon = BON[(size_t)row * 16 + hd] + BON[(size_t)(R_ + row) * 16 + hd];
    float o[16];
#pragma unroll
    for (int e = 0; e < 16; e++) { float yn = (y[e] - mean) * rs * lg[ch + e] + lb[ch + e]; o[e] = (yn + bon * v[e]) * siluf(z[e]); }
#pragma unroll
    for (int i = 0; i < 2; i++)
      *(uint4*)(Y + (size_t)row * 1024 + ch + i * 8) = uint4{pk2(o[i * 8], o[i * 8 + 1]), pk2(o[i * 8 + 2], o[i * 8 + 3]), pk2(o[i * 8 + 4], o[i * 8 + 5]), pk2(o[i * 8 + 6], o[i * 8 + 7])};
  }
}

#define QS 136
#define VS 72
#define MLG_BYTES 47104
__device__ __forceinline__ void ph_ml_scan(const P& p, int j, char* smem0) {
  const int d = ltid() >> 8;
  char* smem = smem0 + d * MLG_BYTES;
  bfr* sQ = (bfr*)smem; bfr* sK = sQ + 64 * QS; bfr* sVT = sK + 64 * QS; bfr* sCT = sVT + 16 * VS;
  float* sN = (float*)(sCT + 16 * QS);
  float* sEs = sN + 128; float* sCt = sEs + 64; float* sBc = sCt + 64; float* sWg = sBc + 64; float* sNr = sWg + 64; bfr* sNb = (bfr*)(sNr + 256); float* sMisc = (float*)(sNb + 128); bfr* sVW = (bfr*)(sMisc + 4);
  const bfr* QKV = (const bfr*)(p.ACT + A_QKV); const float* GT = (const float*)(p.ACT + A_GATE); bfr* HS = (bfr*)(p.ACT + A_HS);
  const float* gbias = p.ml_gate_b + (size_t)j * 32;
  const int tid = ltid() & 255, lane = tid & 63, w = tid >> 6, l15 = lane & 15, q4 = lane >> 4;
  for (int it = xcd_swz(); it < 256; it += gridDim.x) {
    const int b = it >> 7, hh = (it >> 4) & 7, sl = it & 15;
    f32x4 Cacc[2];
    Cacc[0] = f32x4{0.f, 0.f, 0.f, 0.f}; Cacc[1] = f32x4{0.f, 0.f, 0.f, 0.f};
    float mcur = 0.f;
    for (int i = tid; i < 16 * QS; i += 256) sCT[i] = 0;
    if (tid < 128) { sN[tid] = 0.f; sNb[tid] = 0; }
    uint4 pq0, pq1, pq2, pq3, pk0, pk1, pk2, pk3, pv = uint4{0u, 0u, 0u, 0u}; float pgi = 0.f, pgf = 0.f;
#define ML_ROW0(s_) (d == 0 ? b * BT_ + 64 * (s_) : rowmap(1, b, 64 * (s_) + 63))
#define ML_LD(i_, PQ, PK) { int idx = tid + 256 * (i_), rho = idx >> 4, c8 = idx & 15; const bfr* src = QKV + (size_t)(r0n + rho) * 4096 + hh * 128 + c8 * 8; PQ = *(const uint4*)src; PK = *(const uint4*)(src + 1024); }
#define ML_ISSUE(s_) { const int r0n = ML_ROW0(s_); ML_LD(0, pq0, pk0) ML_LD(1, pq1, pk1) ML_LD(2, pq2, pk2) ML_LD(3, pq3, pk3) \
      if (tid < 128) pv = *(const uint4*)(QKV + (size_t)(r0n + (tid >> 1)) * 4096 + 2048 + hh * 256 + sl * 16 + (tid & 1) * 8); \
      if (w == 0) { const float* gp_ = GT + (size_t)(r0n + (d ? 63 - lane : lane)) * 32 + d * 16 + hh; pgi = gp_[0]; pgf = gp_[8]; } }
#define ML_ST(i_, PQ, PK) { int idx = tid + 256 * (i_), rho = idx >> 4, c8 = idx & 15; *(uint4*)(sQ + rho * QS + c8 * 8) = PQ; *(uint4*)(sK + rho * QS + c8 * 8) = PK; }
#define ML_COMMIT() { ML_ST(0, pq0, pk0) ML_ST(1, pq1, pk1) ML_ST(2, pq2, pk2) ML_ST(3, pq3, pk3) \
      if (tid < 128) { int rho = tid >> 1, vb = (tid & 1) * 8; \
        sVT[(vb + 0) * VS + rho] = (bfr)(pv.x & 0xffff); sVT[(vb + 1) * VS + rho] = (bfr)(pv.x >> 16); \
        sVT[(vb + 2) * VS + rho] = (bfr)(pv.y & 0xffff); sVT[(vb + 3) * VS + rho] = (bfr)(pv.y >> 16); \
        sVT[(vb + 4) * VS + rho] = (bfr)(pv.z & 0xffff); sVT[(vb + 5) * VS + rho] = (bfr)(pv.z >> 16); \
        sVT[(vb + 6) * VS + rho] = (bfr)(pv.w & 0xffff); sVT[(vb + 7) * VS + rho] = (bfr)(pv.w >> 16); } }
    ML_ISSUE(0)
    __syncthreads();
    for (int s = 0; s < NCH_; s++) {
      const int r0 = ML_ROW0(s);
      ML_COMMIT()
      if (w == 0) {
        int rho = d ? 63 - lane : lane;
        float gi = pgi + gbias[(d * 2 + 0) * 8 + hh], gf = pgf + gbias[(d * 2 + 1) * 8 + hh];
        float fc = fminf(gf, 0.f) - __logf(1.f + __expf(-fabsf(gf)));
        float bc = fc;
        for (int o = 1; o < 64; o <<= 1) { float t = __shfl_up(bc, o); if (lane >= o) bc += t; }
        float e = gi - bc, pm = e;
        for (int o = 1; o < 64; o <<= 1) { float t = __shfl_up(pm, o); if (lane >= o) pm = fmaxf(pm, t); }
        float pml = __shfl(pm, 63), bcl = __shfl(bc, 63);
        const float mx_ = fmaxf(mcur, pml);
        sEs[rho] = __expf(fminf(e, 80.f)); sCt[rho] = -fmaxf(mcur, pm); sBc[rho] = bc; sWg[rho] = __expf(e - mx_);
        if (lane == 0) { sMisc[0] = mcur; sMisc[1] = __expf(mcur - mx_); }
        mcur = bcl + mx_;
      }
      __syncthreads();
      const float mold = sMisc[0], decay = sMisc[1];

      const int rt = 16 * w + l15;
      bfr* hp = HS + (size_t)(r0 + rt) * 2048 + hh * 256 + sl * 16 + 4 * q4;
      bool first; { int rc = (r0 - b * BT_) >> 6; if (d == 0) { int sp = rc < 4 ? 3 - rc : 263 - rc; first = s < sp; } else first = s < rc; }
      unsigned long long uu = 0ull;
      if (!first) uu = __hip_atomic_load((unsigned long long*)hp, __ATOMIC_RELAXED, __HIP_MEMORY_SCOPE_AGENT);
      if (s + 1 < NCH_) ML_ISSUE(s + 1)
      { const int vr = tid >> 4, sg = (tid & 15) * 4; const uint2 vv_ = *(const uint2*)(sVT + vr * VS + sg); const float4 wg4 = *(const float4*)(sWg + sg);
        *(uint2*)(sVW + vr * VS + sg) = uint2{cvtpk(blo(vv_.x) * wg4.x, bhi(vv_.x) * wg4.y), cvtpk(blo(vv_.y) * wg4.z, bhi(vv_.y) * wg4.w)}; }
      bf16x8 qf[4];
#pragma unroll
      for (int ks = 0; ks < 4; ks++) qf[ks] = *(const bf16x8*)(sQ + (16 * w + l15) * QS + ks * 32 + q4 * 8);
      f32x4 sacc[4];
#pragma unroll
      for (int a = 0; a < 4; a++) { sacc[a] = f32x4{0.f, 0.f, 0.f, 0.f};
#pragma unroll
        for (int ks = 0; ks < 4; ks++) { bf16x8 kf = *(const bf16x8*)(sK + (16 * a + l15) * QS + ks * 32 + q4 * 8); sacc[a] = __builtin_amdgcn_mfma_f32_16x16x32_bf16(kf, qf[ks], sacc[a], 0, 0, 0); } }
      const float ctt = sCt[rt]; const float ect = __expf(ctt); float densum = 0.f;
#pragma unroll
      for (int a = 0; a < 4; a++) { const float4 ex4 = *(const float4*)(sEs + 16 * a + 4 * q4); const float exv[4] = {ex4.x, ex4.y, ex4.z, ex4.w};
#pragma unroll
        for (int jj = 0; jj < 4; jj++) { int rs_ = 16 * a + 4 * q4 + jj; bool valid = d == 0 ? rs_ <= rt : rs_ >= rt;
          float wv = valid ? ect * exv[jj] : 0.f; float sv = sacc[a][jj] * wv; sacc[a][jj] = sv; densum += sv; } }
      densum += __shfl_xor(densum, 16); densum += __shfl_xor(densum, 32);
      bf16x8 sf[2], vf[2];
#pragma unroll
      for (int ks = 0; ks < 2; ks++) {
#pragma unroll
        for (int jj = 0; jj < 4; jj++) { sf[ks][jj] = (short)f2b(sacc[2 * ks][jj]); sf[ks][4 + jj] = (short)f2b(sacc[2 * ks + 1][jj]); }
        uint2 v0 = *(const uint2*)(sVT + l15 * VS + 32 * ks + 4 * q4), v1 = *(const uint2*)(sVT + l15 * VS + 32 * ks + 16 + 4 * q4);
        uint4 vv = uint4{v0.x, v0.y, v1.x, v1.y}; vf[ks] = *(bf16x8*)&vv;
      }
      f32x4 num = f32x4{0.f, 0.f, 0.f, 0.f}, numC = f32x4{0.f, 0.f, 0.f, 0.f};
#pragma unroll
      for (int ks = 0; ks < 2; ks++) num = __builtin_amdgcn_mfma_f32_16x16x32_bf16(vf[ks], sf[ks], num, 0, 0, 0);
#pragma unroll
      for (int ks = 0; ks < 4; ks++) { bf16x8 cf = *(const bf16x8*)(sCT + l15 * QS + ks * 32 + q4 * 8); numC = __builtin_amdgcn_mfma_f32_16x16x32_bf16(cf, qf[ks], numC, 0, 0, 0); }
      f32x4 qnacc = f32x4{0.f, 0.f, 0.f, 0.f};
#pragma unroll
      for (int ks = 0; ks < 4; ks++) { bf16x8 na = bf16x8{0, 0, 0, 0, 0, 0, 0, 0}; if (l15 == 0) na = *(const bf16x8*)(sNb + ks * 32 + q4 * 8);
        qnacc = __builtin_amdgcn_mfma_f32_16x16x32_bf16(na, qf[ks], qnacc, 0, 0, 0); }
      const float qn = __shfl(qnacc[0], l15);
      {
        float inter = __expf(mold + ctt); float den = densum + inter * qn; float dn = fmaxf(fabsf(den), __expf(ctt - sBc[rt])); float inv = __builtin_amdgcn_rcpf(dn);
        f32x4 hv;
#pragma unroll
        for (int jj = 0; jj < 4; jj++) hv[jj] = (num[jj] + inter * numC[jj]) * inv;
        if (!first) { unsigned ux = (unsigned)uu, uy = (unsigned)(uu >> 32);
          hv[0] += blo(ux); hv[1] += bhi(ux); hv[2] += blo(uy); hv[3] += bhi(uy); }
        store4b(hp, hv);
      }
      __syncthreads();
      {
        bf16x8 vw[2], wa[2];
#pragma unroll
        for (int ks = 0; ks < 2; ks++) {
          const uint2 v0 = *(const uint2*)(sVW + l15 * VS + 32 * ks + 4 * q4), v1 = *(const uint2*)(sVW + l15 * VS + 32 * ks + 16 + 4 * q4);
          uint4 vv = uint4{v0.x, v0.y, v1.x, v1.y}; vw[ks] = *(bf16x8*)&vv;
          uint4 wz = uint4{0u, 0u, 0u, 0u};
          if (l15 == 0) { const float4 g0 = *(const float4*)(sWg + 32 * ks + 4 * q4), g1 = *(const float4*)(sWg + 32 * ks + 16 + 4 * q4); wz = uint4{cvtpk(g0.x, g0.y), cvtpk(g0.z, g0.w), cvtpk(g1.x, g1.y), cvtpk(g1.z, g1.w)}; }
          wa[ks] = *(bf16x8*)&wz; }
#pragma unroll
        for (int a = 0; a < 2; a++) {
          int dk = 32 * w + 16 * a + l15;
#pragma unroll
          for (int jj = 0; jj < 4; jj++) Cacc[a][jj] *= decay;
          f32x4 nacc = f32x4{0.f, 0.f, 0.f, 0.f};
#pragma unroll
          for (int ks = 0; ks < 2; ks++) { bf16x8 kt;
#pragma unroll
            for (int e = 0; e < 8; e++) { int rs_ = 32 * ks + (e < 4 ? 4 * q4 + e : 16 + 4 * q4 + e - 4); kt[e] = (short)sK[rs_ * QS + dk]; }
            Cacc[a] = __builtin_amdgcn_mfma_f32_16x16x32_bf16(vw[ks], kt, Cacc[a], 0, 0, 0);
            nacc = __builtin_amdgcn_mfma_f32_16x16x32_bf16(wa[ks], kt, nacc, 0, 0, 0); }
          if (q4 == 0) sNr[dk] = nacc[0];
#pragma unroll
          for (int jj = 0; jj < 4; jj++) sCT[(4 * q4 + jj) * QS + dk] = f2b(Cacc[a][jj]);
        }
      }
      __syncthreads();
      if (tid < 128) { const float nv = decay * sN[tid] + sNr[tid]; sN[tid] = nv; sNb[tid] = f2b(nv); }
    }
    __syncthreads();
  }
}

#define CS 72
#define CSLOT(i_) ((bfr*)smem + (i_) * (64 * CS))
#define A_SST (A_R7B + 362086400ull)
__device__ __forceinline__ f32x4 cmm(const bfr* X, const bfr* YT, int ti, int tj, int l15, int q4) {
  f32x4 acc = f32x4{0.f, 0.f, 0.f, 0.f};
#pragma unroll
  for (int ks = 0; ks < 2; ks++) { bf16x8 a = *(const bf16x8*)(X + (16 * ti + l15) * CS + 32 * ks + 8 * q4); bf16x8 b = *(const bf16x8*)(YT + (16 * tj + l15) * CS + 32 * ks + 8 * q4);
    acc = __builtin_amdgcn_mfma_f32_16x16x32_bf16(a, b, acc, 0, 0, 0); }
  return acc;
}
template <int MODE> __device__ __forceinline__ f32x4 cmm_mask(const bfr* X, const bfr* YT, int ti, int tj, int l15, int q4) {
  f32x4 acc = f32x4{0.f, 0.f, 0.f, 0.f};
#pragma unroll
  for (int ks = 0; ks < 2; ks++) { const int kb = 2 * ks + (q4 >> 1);
    const bool ok = MODE == 1 ? ((kb == 0 && tj == 1) || (kb == 2 && tj == 3)) : (kb < 2 && tj >= 2);
    bf16x8 a = *(const bf16x8*)(X + (16 * ti + l15) * CS + 32 * ks + 8 * q4); bf16x8 bz = bf16x8{0, 0, 0, 0, 0, 0, 0, 0};
    if (ok) bz = *(const bf16x8*)(YT + (16 * tj + l15) * CS + 32 * ks + 8 * q4);
    acc = __builtin_amdgcn_mfma_f32_16x16x32_bf16(a, bz, acc, 0, 0, 0); }
  return acc;
}
__device__ __forceinline__ void st_row(bfr* dst, int r0, int c, f32x4 v) {
#pragma unroll
  for (int jj = 0; jj < 4; jj++) dst[(r0 + jj) * CS + c] = f2b(v[jj]); }
__device__ __forceinline__ void st_tr(bfr* dst, int r0, int c, f32x4 v) { store4b(dst + c * CS + r0, v); }
__device__ __forceinline__ f32x4 ld_row(const bfr* src, int r0, int c) { f32x4 v;
#pragma unroll
  for (int jj = 0; jj < 4; jj++) v[jj] = b2f(src[(r0 + jj) * CS + c]);
  return v; }
__device__ __forceinline__ f32x4 ld_tr(const bfr* src, int r0, int c) { uint2 u = *(const uint2*)(src + c * CS + r0); return f32x4{blo(u.x), bhi(u.x), blo(u.y), bhi(u.y)}; }

__device__ __forceinline__ void ph_r7_ca(const P& p, int j, int win, char* smem) {
  float* LW = (float*)(smem + 7 * 9216); float* AT = (float*)(smem + 9 * 9216); float* WL = (float*)(smem + 14 * 9216);
  const bfr* RK = (const bfr*)(p.ACT + A_RKVZ); const bfr* WMb = (const bfr*)(p.ACT + A_WM); const bfr* AMb = (const bfr*)(p.ACT + A_AM);
  float* BON = (float*)(p.ACT + A_BON); bfr* WB = p.H;
  const float* kkp = p.r7_k_k + (size_t)j * 1024; const float* kap = p.r7_k_a + (size_t)j * 1024; const float* rkp = p.r7_r_k + (size_t)j * 1024;
  const int tid = ltid(), lane = tid & 63, w = tid >> 6, l15 = lane & 15, q4 = lane >> 4, ti = w >> 1, tj0 = (w & 1) * 2;
  const int c0 = win * 20;
  for (int it = blockIdx.x; it < 1280; it += gridDim.x) {
    const int chain = it / 20, cl = it - chain * 20, c = c0 + cl, d = chain & 1, b = chain >> 5, h = (chain >> 1) & 15;
    {
      const int rowA = rowmap(d, b, 64 * c + 16 * ti + l15);
      const float* w0 = p.r7_w0 + (size_t)(j * 2 + d) * 1024 + h * 64; const float* a0 = p.r7_a0 + (size_t)(j * 2 + d) * 1024 + h * 64;
#pragma unroll
      for (int tt = 0; tt < 2; tt++) { const int tj = tj0 + tt; f32x4 aw = f32x4{0.f, 0.f, 0.f, 0.f}, aa = aw;
#pragma unroll
        for (int ks = 0; ks < 2; ks++) {
          bf16x8 xw = *(const bf16x8*)(WMb + (size_t)rowA * 128 + d * 64 + 32 * ks + 8 * q4), xa = *(const bf16x8*)(AMb + (size_t)rowA * 128 + d * 64 + 32 * ks + 8 * q4);
          bf16x8 yw = *(const bf16x8*)(p.W + WR_UP + d * 65536 + (size_t)(h * 64 + 16 * tj + l15) * 64 + 32 * ks + 8 * q4);
          bf16x8 ya = *(const bf16x8*)(p.W + WR_UP + (2 + d) * 65536 + (size_t)(h * 64 + 16 * tj + l15) * 64 + 32 * ks + 8 * q4);
          aw = __builtin_amdgcn_mfma_f32_16x16x32_bf16(xw, yw, aw, 0, 0, 0); aa = __builtin_amdgcn_mfma_f32_16x16x32_bf16(xa, ya, aa, 0, 0, 0); }
        const int ch = 16 * tj + l15; const float w0v = w0[ch], a0v = a0[ch];
#pragma unroll
        for (int jj = 0; jj < 4; jj++) { const int tau = 16 * ti + 4 * q4 + jj; LW[tau * 64 + ch] = -0.6065306597126334f * sigm(w0v + aw[jj]); AT[tau * 64 + ch] = sigm(a0v + aa[jj]); }
      }
    }
    __syncthreads();
    if (tid < 64) { float acc = 0.f;
#pragma unroll 8
      for (int t = 0; t < 64; t++) { acc += LW[t * 64 + tid]; LW[t * 64 + tid] = acc; } }
    __syncthreads();
    {
      const int tau = tid >> 3, sc = tid & 7, col = h * 64 + sc * 8; const int row = rowmap(d, b, 64 * c + tau);
      const bfr* rp = RK + (size_t)row * 4096 + col; uint4 pr = *(const uint4*)rp, pk = *(const uint4*)(rp + 1024);
      unsigned ur[4] = {pr.x, pr.y, pr.z, pr.w}, uk[4] = {pk.x, pk.y, pk.z, pk.w};
      float r8[8], k8[8], kr[8];
#pragma unroll
      for (int e = 0; e < 4; e++) { r8[2 * e] = blo(ur[e]); r8[2 * e + 1] = bhi(ur[e]); k8[2 * e] = blo(uk[e]); k8[2 * e + 1] = bhi(uk[e]); }
      float ss = 0.f;
#pragma unroll
      for (int e = 0; e < 8; e++) { kr[e] = k8[e] * kkp[col + e]; ss += kr[e] * kr[e]; }
      ss += __shfl_xor(ss, 1); ss += __shfl_xor(ss, 2); ss += __shfl_xor(ss, 4);
      const float inv = __builtin_amdgcn_rsqf(fmaxf(ss, 1e-24f));
      float bon = 0.f, o0[8], o1[8], o2[8], o3[8], o4[8], o5[8];
#pragma unroll
      for (int e = 0; e < 8; e++) {
        const float cw = LW[tau * 64 + sc * 8 + e], cwm = tau > 0 ? LW[(tau - 1) * 64 + sc * 8 + e] : 0.f, cwl = LW[63 * 64 + sc * 8 + e], a = AT[tau * 64 + sc * 8 + e];
        const float ka = kr[e] * inv, be = a * ka, kd = k8[e] * (1.f + (a - 1.f) * kap[col + e]); bon += r8[e] * kd * rkp[col + e];
        const float e2 = __expf(-cw), e4 = __expf(cwl - cw);
        o0[e] = ka * __expf(cwm); o1[e] = be * e2; o2[e] = kd * e2; o3[e] = r8[e] * __expf(cw); o4[e] = be * e4; o5[e] = kd * e4;
        if (tau == 63) WL[sc * 8 + e] = __expf(cwl);
      }
      bon += __shfl_xor(bon, 1); bon += __shfl_xor(bon, 2); bon += __shfl_xor(bon, 4);
      if (sc == 0) BON[((size_t)d * R_ + row) * 16 + h] = bon;
      *(uint4*)(CSLOT(0) + tau * CS + sc * 8) = uint4{pk2(o0[0], o0[1]), pk2(o0[2], o0[3]), pk2(o0[4], o0[5]), pk2(o0[6], o0[7])};
      *(uint4*)(CSLOT(1) + tau * CS + sc * 8) = uint4{pk2(o1[0], o1[1]), pk2(o1[2], o1[3]), pk2(o1[4], o1[5]), pk2(o1[6], o1[7])};
      *(uint4*)(CSLOT(2) + tau * CS + sc * 8) = uint4{pk2(o2[0], o2[1]), pk2(o2[2], o2[3]), pk2(o2[4], o2[5]), pk2(o2[6], o2[7])};
      *(uint4*)(CSLOT(3) + tau * CS + sc * 8) = uint4{pk2(o3[0], o3[1]), pk2(o3[2], o3[3]), pk2(o3[4], o3[5]), pk2(o3[6], o3[7])};
#pragma unroll
      for (int e = 0; e < 8; e++) { CSLOT(4)[(sc * 8 + e) * CS + tau] = f2b(o0[e]); CSLOT(5)[(sc * 8 + e) * CS + tau] = f2b(o4[e]); CSLOT(6)[(sc * 8 + e) * CS + tau] = f2b(o5[e]); }
    }
    __syncthreads();
#pragma unroll
    for (int tt = 0; tt < 2; tt++) { const int tj = tj0 + tt, r0 = 16 * ti + 4 * q4, cc = 16 * tj + l15;
      f32x4 v = cmm(CSLOT(1), CSLOT(0), ti, tj, l15, q4);
#pragma unroll
      for (int jj = 0; jj < 4; jj++) if (!(r0 + jj < cc)) v[jj] = 0.f;
      st_row(CSLOT(7), r0, cc, v); st_tr(CSLOT(8), r0, cc, v);
      v = cmm(CSLOT(2), CSLOT(0), ti, tj, l15, q4);
#pragma unroll
      for (int jj = 0; jj < 4; jj++) if (!(r0 + jj < cc)) v[jj] = 0.f;
      st_row(CSLOT(9), r0, cc, v);
      v = cmm(CSLOT(3), CSLOT(1), ti, tj, l15, q4);
#pragma unroll
      for (int jj = 0; jj < 4; jj++) if (!(cc <= r0 + jj)) v[jj] = 0.f;
      st_row(CSLOT(10), r0, cc, v);
      v = cmm(CSLOT(3), CSLOT(2), ti, tj, l15, q4);
#pragma unroll
      for (int jj = 0; jj < 4; jj++) if (!(cc <= r0 + jj)) v[jj] = 0.f;
      st_row(CSLOT(11), r0, cc, v);
    }
    __syncthreads();
    {
      float* X = (float*)CSLOT(0);
      const bfr* Ab = CSLOT(7);
      const int cl = lane >> 3, pp = lane & 7, cx = 8 * w + cl, blk0 = (w >> 1) * 16;
#pragma unroll 1
      for (int il = 15; il >= 0; il--) { const int i = blk0 + il;
        float sum = 0.f;
#pragma unroll 1
        for (int jx = i + 1 + pp; jx < blk0 + 16; jx += 8) sum += b2f(Ab[i * CS + jx]) * X[jx * 72 + cx];
        sum += dppf<0xB1>(sum); sum += dppf<0x4E>(sum); sum += dppf<0x141>(sum);
        const float xv = (i == cx ? 1.f : 0.f) - sum;
        if (pp == 0) X[i * 72 + cx] = xv;
      }
      __syncthreads();
#pragma unroll 1
      for (int e = tid; e < 4096; e += 512) { const int i = e >> 6, c2 = e & 63; const bfr tv = ((i >> 4) == (c2 >> 4)) ? f2b(X[i * 72 + c2]) : (bfr)0; CSLOT(2)[i * CS + c2] = tv; CSLOT(12)[c2 * CS + i] = tv; }
      __syncthreads();
#pragma unroll
      for (int tt = 0; tt < 2; tt++) { const int tj = tj0 + tt, r0 = 16 * ti + 4 * q4, cc = 16 * tj + l15; st_row(CSLOT(13), r0, cc, cmm_mask<1>(CSLOT(2), CSLOT(8), ti, tj, l15, q4)); }
      __syncthreads();
#pragma unroll
      for (int tt = 0; tt < 2; tt++) { const int tj = tj0 + tt, r0 = 16 * ti + 4 * q4, cc = 16 * tj + l15;
        f32x4 v = ld_row(CSLOT(2), r0, cc) - cmm(CSLOT(13), CSLOT(12), ti, tj, l15, q4); st_row(CSLOT(0), r0, cc, v); st_tr(CSLOT(1), r0, cc, v); }
      __syncthreads();
#pragma unroll
      for (int tt = 0; tt < 2; tt++) { const int tj = tj0 + tt, r0 = 16 * ti + 4 * q4, cc = 16 * tj + l15; st_row(CSLOT(13), r0, cc, cmm_mask<2>(CSLOT(0), CSLOT(8), ti, tj, l15, q4)); }
      __syncthreads();
#pragma unroll
      for (int tt = 0; tt < 2; tt++) { const int tj = tj0 + tt, r0 = 16 * ti + 4 * q4, cc = 16 * tj + l15;
        f32x4 v = ld_row(CSLOT(0), r0, cc) - cmm(CSLOT(13), CSLOT(1), ti, tj, l15, q4);
#pragma unroll
        for (int jj = 0; jj < 4; jj++) if (r0 + jj == cc) v[jj] -= 1.f;
        st_row(CSLOT(2), r0, cc, v); }
      __syncthreads();
    }
#pragma unroll
    for (int tt = 0; tt < 2; tt++) { const int tj = tj0 + tt, r0 = 16 * ti + 4 * q4, cc = 16 * tj + l15;
      f32x4 g = cmm(CSLOT(10), CSLOT(2), ti, tj, l15, q4) + ld_row(CSLOT(10), r0, cc); st_row(CSLOT(12), r0, cc, g);
      f32x4 hh = cmm(CSLOT(5), CSLOT(2), ti, tj, l15, q4) + ld_row(CSLOT(5), r0, cc); st_row(CSLOT(13), r0, cc, hh); }
    __syncthreads();
    {
      bfr* out = WB + (size_t)(chain * 20 + cl) * 16384;
#pragma unroll
      for (int tt = 0; tt < 2; tt++) { const int tj = tj0 + tt, r0 = 16 * ti + 4 * q4, cc = 16 * tj + l15;
        f32x4 v = ld_tr(CSLOT(3), r0, cc) - cmm(CSLOT(4), CSLOT(12), ti, tj, l15, q4);
        store4b(out + cc * 64 + r0, v);
        v = ld_tr(CSLOT(11), r0, cc) - cmm(CSLOT(9), CSLOT(12), ti, tj, l15, q4);
        store4b(out + 4096 + cc * 64 + r0, v);
        v = -cmm(CSLOT(4), CSLOT(13), ti, tj, l15, q4);
#pragma unroll
        for (int jj = 0; jj < 4; jj++) if (r0 + jj == cc) v[jj] += WL[cc];
        store4b(out + 8192 + cc * 64 + r0, v);
        v = ld_tr(CSLOT(6), r0, cc) - cmm(CSLOT(9), CSLOT(13), ti, tj, l15, q4);
        store4b(out + 12288 + cc * 64 + r0, v);
      }
    }
    __syncthreads();
  }
}

__device__ __forceinline__ void ph_r7_cb(const P& p, int win, char* smem) {
  bfr* Sh = (bfr*)smem; bfr* Sl = Sh + 2 * 16 * CS; bfr* VT = Sl + 2 * 16 * CS;
  const bfr* WB = p.H; const bfr* RK = (const bfr*)(p.ACT + A_RKVZ); bfr* SST = (bfr*)(p.ACT + A_SST);
  const int tid = ltid(), lane = tid & 63, w = tid >> 6, l15 = lane & 15, q4 = lane >> 4;
  const int c0 = win * 20;
  for (int it = xcd_swz(); it < 256; it += gridDim.x) {
    const int d = it & 1, b = it >> 7, h = (it >> 3) & 15, rg = (it >> 1) & 3, chain = (b * 16 + h) * 2 + d;
    bfr* Y = d ? R7_Y2 : (bfr*)(p.ACT + A_Y);
    bfr* sst = SST + (size_t)(chain * 4 + rg) * 2048;
    __syncthreads();
    if (tid < 256) { const int hl = tid >> 7, e = tid & 127, rr = e >> 3, c8 = e & 7; uint4 v = uint4{0u, 0u, 0u, 0u};
      if (win > 0) v = *(const uint4*)(sst + hl * 1024 + rr * 64 + c8 * 8);
      *(uint4*)((hl ? Sl : Sh) + rr * CS + c8 * 8) = v; }
    const int vtau = tid >> 3, vp = tid & 7;
    { const int row = rowmap(d, b, 64 * c0 + vtau); unsigned vv = *(const unsigned*)(RK + (size_t)row * 4096 + 2048 + h * 64 + rg * 16 + 2 * vp);
      VT[(2 * vp) * CS + vtau] = (bfr)(vv & 0xffff); VT[(2 * vp + 1) * CS + vtau] = (bfr)(vv >> 16); }
    const bfr* bbase = WB + (size_t)(chain * 20) * 16384 + (w < 4 ? 8192 + (16 * w + l15) * 64 : (16 * (w - 4) + l15) * 64) + 8 * q4;
    bf16x8 rb1[4][2], rb2[4][2]; unsigned rv[4];
#define CB_LOAD(u_, s_) { const int ss_ = (s_) < 20 ? (s_) : 19; const bfr* bp_ = bbase + (size_t)ss_ * 16384; \
      rb1[u_][0] = *(const bf16x8*)bp_; rb1[u_][1] = *(const bf16x8*)(bp_ + 32); rb2[u_][0] = *(const bf16x8*)(bp_ + 4096); rb2[u_][1] = *(const bf16x8*)(bp_ + 4096 + 32); \
      const int sv_ = ss_ + 1 < 20 ? ss_ + 1 : 19; const int rowv_ = rowmap(d, b, 64 * (c0 + sv_) + vtau); \
      rv[u_] = *(const unsigned*)(RK + (size_t)rowv_ * 4096 + 2048 + h * 64 + rg * 16 + 2 * vp); }
    CB_LOAD(0, 0) CB_LOAD(1, 1) CB_LOAD(2, 2) CB_LOAD(3, 3)
    __syncthreads();
    for (int g = 0; g < 5; g++) {
#pragma unroll
      for (int u = 0; u < 4; u++) {
        const int s = 4 * g + u;
        if (s < 20) {
          const int cur = s & 1, nxt = cur ^ 1, c = c0 + s;
          bf16x8 sh[2], sl[2], vt[2];
#pragma unroll
          for (int ks = 0; ks < 2; ks++) { sh[ks] = *(const bf16x8*)(Sh + (cur * 16 + l15) * CS + 32 * ks + 8 * q4); sl[ks] = *(const bf16x8*)(Sl + (cur * 16 + l15) * CS + 32 * ks + 8 * q4);
            vt[ks] = *(const bf16x8*)(VT + (cur * 16 + l15) * CS + 32 * ks + 8 * q4); }
          f32x4 a1 = f32x4{0.f, 0.f, 0.f, 0.f}, a2 = a1;
#pragma unroll
          for (int ks = 0; ks < 2; ks++) { a1 = __builtin_amdgcn_mfma_f32_16x16x32_bf16(sh[ks], rb1[u][ks], a1, 0, 0, 0); a2 = __builtin_amdgcn_mfma_f32_16x16x32_bf16(vt[ks], rb2[u][ks], a2, 0, 0, 0); }
#pragma unroll
          for (int ks = 0; ks < 2; ks++) a1 = __builtin_amdgcn_mfma_f32_16x16x32_bf16(sl[ks], rb1[u][ks], a1, 0, 0, 0);
          a1 = a1 + a2;
          if (w < 4) {
#pragma unroll
            for (int jj = 0; jj < 4; jj++) { const bfr hi = f2b(a1[jj]); Sh[(nxt * 16 + 4 * q4 + jj) * CS + 16 * w + l15] = hi; Sl[(nxt * 16 + 4 * q4 + jj) * CS + 16 * w + l15] = f2b(a1[jj] - b2f(hi)); }
          } else {
            const int rowy = rowmap(d, b, 64 * c + 16 * (w - 4) + l15);
            store4b(Y + (size_t)rowy * 1024 + h * 64 + rg * 16 + 4 * q4, a1);
          }
          if (s + 1 < 20) { VT[(nxt * 16 + 2 * vp) * CS + vtau] = (bfr)(rv[u] & 0xffff); VT[(nxt * 16 + 2 * vp + 1) * CS + vtau] = (bfr)(rv[u] >> 16); }
          if (s + 4 < 20) CB_LOAD(u, s + 4)
          __syncthreads();
        }
      }
    }
    if (tid < 256) { const int hl = tid >> 7, e = tid & 127, rr = e >> 3, c8 = e & 7; *(uint4*)(sst + hl * 1024 + rr * 64 + c8 * 8) = *(const uint4*)((hl ? Sl : Sh) + rr * CS + c8 * 8); }
  }
}

__device__ __forceinline__ void run_phase(const P& p, int ph, int layer, int d, char* smem) {
  Ctx c; c.layer = layer; c.j = layer / 3; c.d = d; c.wc = layer < 3 ? 1 : 0;
  switch (ph) {
    case PH_PRE: ph_pre(p, smem); break;
    case PH_NORM: ph_norm(p, layer, smem); break;
    case PH_LRU_IN: big_gemm(smem, p.H, p.W, 2560, 1024, F_LruIn{p.ACT}); break;
    case PH_LRU_CONV: ph_lru_conv(p, c.j); break;
    case PH_LRU_GATE: gemm_phase_k2<G_LruGate>(p, c, smem); break;
    case PH_LRU_S1: ph_lru_s1(p, d); break;
    case PH_LRU_S2: ph_lru_s2(p, smem); break;
    case PH_LRU_S3: ph_lru_s3(p, d); break;
    case PH_LRU_OUT: big_gemm(smem, (const bfr*)(p.ACT + A_Z), p.W + WL_OUT, 1024, 1280, F_Resid{p.Xx, p.Xc, p.MOD + (size_t)layer * 3 * 3072, c.wc}); break;
    case PH_ML_IN: big_gemm(smem, p.H, p.W, 4352, 1024, F_MlIn{p.ACT}); break;
    case PH_ML_SCAN: ph_ml_scan(p, c.j, smem); break;
    case PH_ML_STAT: ph_ml_stat(p); break;
    case PH_ML_Z: big_gemm(smem, p.H, p.W + WM_Z, 2048, 1024, F_MlZ{p.ACT, p.ml_norm_g + (size_t)c.j * 2048}); break;
    case PH_ML_OUT: big_gemm(smem, (const bfr*)(p.ACT + A_HS), p.W + WM_OUT, 1024, 2048, F_Resid{p.Xx, p.Xc, p.MOD + (size_t)layer * 3 * 3072, c.wc}); break;
    case PH_R7_IN: big_gemm(smem, p.H, p.W, 4352, 2048, F_R7In{p.ACT}); break;
    case PH_R7_SHIFT: ph_r7_shift(p); break;
    case PH_R7_CA: ph_r7_ca(p, c.j, d, smem); break;
    case PH_R7_CB: ph_r7_cb(p, d, smem); break;
    case PH_R7_FIN: ph_r7_fin(p, c.j); break;
    case PH_R7_OUT: big_gemm(smem, (const bfr*)(p.ACT + A_Y), p.W + WR_OUT, 1024, 1024, F_Resid{p.Xx, p.Xc, p.MOD + (size_t)layer * 3 * 3072, c.wc}); break;
    case PH_FINAL: ph_final(p); break;
  }
}


#define XB_TMO      128
#define XB_XCNT(j)  (256  + 64 * (j))
#define XB_XSUB(j)  (1280 + 64 * (j))
#define XB_XGEN(j)  (2304 + 64 * (j))
#define XB_TOP      3328
#define XB_TOPGEN   3392
#define XCD_BAR_WORDS 3456
#define XB_SPIN_CAP (1u << 18)
#define OFF_BAR 527000064ull
#define OFF_CL (OFF_BAR + 16384ull)
__device__ __forceinline__ unsigned xb_ld(unsigned* p)              { return __hip_atomic_load(p, __ATOMIC_RELAXED, __HIP_MEMORY_SCOPE_AGENT); }
__device__ __forceinline__ unsigned xb_add(unsigned* p, unsigned v) { return __hip_atomic_fetch_add(p, v, __ATOMIC_RELAXED, __HIP_MEMORY_SCOPE_AGENT); }
__device__ __forceinline__ unsigned xb_xcc_id() { return (unsigned)__builtin_amdgcn_s_getreg((3 << 11) | 20) & 0xFu; }
#define XB_SPIN(cond, bar) do { unsigned _sp = 0; while (cond) { __builtin_amdgcn_s_sleep(1); \
    if ((++_sp & 255u) == 0u) { if (xb_ld(&(bar)[XB_TMO])) break; if (_sp > XB_SPIN_CAP) { atomicAdd(&(bar)[XB_TMO], 1u); break; } } } } while (0)
struct XcdBarrier { unsigned* bar; unsigned x; volatile __attribute__((address_space(3))) unsigned* st; };
__device__ __forceinline__ XcdBarrier xcd_barrier_post(unsigned* bar, volatile __attribute__((address_space(3))) unsigned* st) {
  XcdBarrier b; b.bar = bar; b.x = xb_xcc_id(); b.st = st;
  if (threadIdx.x == 0) (void)xb_add(&bar[XB_XCNT(b.x)], 1u);
  return b;
}
__device__ __forceinline__ void xcd_barrier_complete(unsigned* bar, unsigned x, unsigned& nloc, unsigned& nx) {
  const unsigned G = gridDim.x * gridDim.y * gridDim.z;
  unsigned sum, cnt, mine, sp = 0u;
  for (;;) {
    sum = 0u; cnt = 0u; mine = 0u;
#pragma unroll
    for (unsigned j = 0; j < 16; ++j) { const unsigned c = xb_ld(&bar[XB_XCNT(j)]); sum += c; cnt += (c > 0u) ? 1u : 0u; mine = (j == x) ? c : mine; }
    if (sum == G) break;
    __builtin_amdgcn_s_sleep(1);
    if ((++sp & 255u) == 0u) { if (xb_ld(&bar[XB_TMO])) break; if (sp > XB_SPIN_CAP) { atomicAdd(&bar[XB_TMO], 1u); break; } }
  }
  nloc = mine > 0u ? mine : 1u; nx = cnt > 0u ? cnt : 1u;
}
__device__ __forceinline__ void xcd_barrier(const XcdBarrier& b) {
  asm volatile("s_waitcnt vmcnt(0)" ::: "memory");
  __syncthreads();
  if (threadIdx.x == 0) {
    unsigned* bar = b.bar;
    __builtin_amdgcn_s_waitcnt(0);
    unsigned nloc = b.st[0], nx = b.st[1];
    if (nloc == 0u) { xcd_barrier_complete(bar, b.x, nloc, nx); b.st[0] = nloc; b.st[1] = nx; }
    const unsigned old = xb_add(&bar[XB_XSUB(b.x)], 1u);
    const unsigned gen = old / nloc;
    if (old + 1u == (gen + 1u) * nloc) {
      __builtin_amdgcn_fence(__ATOMIC_RELEASE, "agent");
      asm volatile("s_waitcnt vmcnt(0)" ::: "memory");
      const unsigned og = xb_add(&bar[XB_TOP], 1u);
      const unsigned tg = og / nx;
      if (og + 1u == (tg + 1u) * nx) xb_add(&bar[XB_TOPGEN], 1u);
      else XB_SPIN(xb_ld(&bar[XB_TOPGEN]) == tg, bar);
      __builtin_amdgcn_fence(__ATOMIC_ACQUIRE, "agent");
      xb_add(&bar[XB_XGEN(b.x)], 1u);
      asm volatile("s_waitcnt vmcnt(0)" ::: "memory");
    } else {
      XB_SPIN(xb_ld(&bar[XB_XGEN(b.x)]) == gen, bar);
      __builtin_amdgcn_fence(__ATOMIC_ACQUIRE, "agent");
      asm volatile("s_waitcnt vmcnt(0)" ::: "memory");
    }
  }
  __syncthreads();
}

#define SMEM_BYTES (131072 + 64)
extern __shared__ __attribute__((aligned(16))) char dyn_smem[];
#if !MEGA
__global__ void __launch_bounds__(512, 2) phase_kernel(P p, int si) {
  run_phase(p, p.sched[si * 3], p.sched[si * 3 + 1], p.sched[si * 3 + 2], dyn_smem);
}
#else
__global__ void __launch_bounds__(512, 2) mega_kernel(P p) {
  cg::grid_group grid = cg::this_grid();
  volatile __attribute__((address_space(3))) unsigned* st = (volatile __attribute__((address_space(3))) unsigned*)(dyn_smem + 131072);
  if (threadIdx.x < 4) st[threadIdx.x] = 0u;
  __syncthreads();
  const XcdBarrier xb = xcd_barrier_post(p.bar, st);
  for (int si = 0; si < p.nsched; si++) {
    run_phase(p, p.sched[si * 3], p.sched[si * 3 + 1], p.sched[si * 3 + 2], dyn_smem);
    if (si + 1 < p.nsched) { if (p.pad_ != 0) grid.sync(); xcd_barrier(xb); }
  }
}
#endif

extern "C" void kernel_launch(void* const* d_in, const int* in_sizes, int n_in, void* d_out, int out_size, void* d_ws, size_t ws_size, hipStream_t stream) {
  P p; memset(&p, 0, sizeof(p));
  const float** f = (const float**)&p;
  for (int i = 0; i < 33; i++) f[i] = (const float*)d_in[i];
  char* ws = (char*)d_ws;
  p.Xx = (float*)d_out; p.Xc = (float*)(ws + OFF_XC); p.MOD = (float*)(ws + OFF_MOD); p.W = (bfr*)(ws + OFF_W); p.H = (bfr*)(ws + OFF_H); p.ACT = ws + OFF_ACT; p.bar = (unsigned*)(ws + OFF_BAR); p.CL = (float*)(ws + OFF_CL);
  int n = 0;
  auto add = [&](int ph, int layer, int d) { p.sched[n * 3] = ph; p.sched[n * 3 + 1] = layer; p.sched[n * 3 + 2] = d; n++; };
  add(PH_PRE, 0, 0);
  if (DUP & 4) add(PH_PRE, 0, 0);
  for (int l = 0; l < 4; l++) {
    add(PH_NORM, l, 0); if (DUP & 4) add(PH_NORM, l, 0);
    int kind = l % 3;
    const bool dg = DUP & 1, ds = DUP & 2;
    if (kind == 0) { add(PH_LRU_IN, l, 0); if (dg) add(PH_LRU_IN, l, 0); add(PH_LRU_CONV, l, 0); if (DUP & 4) add(PH_LRU_CONV, l, 0);
      for (int d = 0; d < 2; d++) { add(PH_LRU_GATE, l, d); if (dg) add(PH_LRU_GATE, l, d); add(PH_LRU_S1, l, d); if (DUP & 8) add(PH_LRU_S1, l, d); add(PH_LRU_S2, l, d); if (DUP & 16) add(PH_LRU_S2, l, d); add(PH_LRU_S3, l, d); }
      add(PH_LRU_OUT, l, 0); }
    else if (kind == 1) { add(PH_ML_IN, l, 0); if (dg) add(PH_ML_IN, l, 0); add(PH_ML_SCAN, l, 0); if (ds) add(PH_ML_SCAN, l, 0); add(PH_ML_STAT, l, 0); if (DUP & 4) add(PH_ML_STAT, l, 0); add(PH_ML_Z, l, 0); add(PH_ML_OUT, l, 0); }
    else { add(PH_R7_SHIFT, l, 0); add(PH_R7_IN, l, 0); if (dg) add(PH_R7_IN, l, 0); for (int wi = 0; wi < 13; wi++) { add(PH_R7_CA, l, wi); if (DUP & 32) add(PH_R7_CA, l, wi); add(PH_R7_CB, l, wi); } add(PH_R7_FIN, l, 0); add(PH_R7_OUT, l, 0); }
  }
  add(PH_FINAL, 0, 0);
  p.nsched = n;
  if (ws_size < WS_NEED) fprintf(stderr, "workspace too small: %zu < %llu\n", ws_size, (unsigned long long)WS_NEED);
#if MEGA
  static int grid_blocks = 0;
  if (!grid_blocks) { int dev = 0, cus = 0, per = 0; hipGetDevice(&dev); hipDeviceGetAttribute(&cus, hipDeviceAttributeMultiprocessorCount, dev);
    hipFuncSetAttribute((const void*)mega_kernel, hipFuncAttributeMaxDynamicSharedMemorySize, SMEM_BYTES);
    hipOccupancyMaxActiveBlocksPerMultiprocessor(&per, mega_kernel, 512, SMEM_BYTES); if (per > 1) per = 1; if (per < 1) per = 1; grid_blocks = cus * per; }
  hipMemsetAsync(ws + OFF_BAR, 0, XCD_BAR_WORDS * 4, stream);
  void* args[] = {&p};
  hipError_t e = hipLaunchCooperativeKernel((void*)mega_kernel, dim3(grid_blocks), dim3(512), args, SMEM_BYTES, stream);
  if (e != hipSuccess) fprintf(stderr, "cooperative launch failed: %s (grid %d)\n", hipGetErrorString(e), grid_blocks);
#else
  static int once = 0; if (!once) { once = 1; hipFuncSetAttribute((const void*)phase_kernel, hipFuncAttributeMaxDynamicSharedMemorySize, SMEM_BYTES); }
  for (int si = 0; si < n; si++) phase_kernel<<<256, 512, SMEM_BYTES, stream>>>(p, si);
#endif
}
```

```cpp
#include <hip/hip_runtime.h>
#include <hip/hip_bf16.h>
#include <hip/hip_cooperative_groups.h>
#include <cstdio>
#include <cstring>
#include <type_traits>
namespace cg = cooperative_groups;

#ifndef DUP
#define DUP 0
#endif
#ifndef MEGA
#define MEGA 1
#endif

typedef unsigned short bfr;
using bf16x8 = __attribute__((ext_vector_type(8))) short;
using f32x4 = __attribute__((ext_vector_type(4))) float;

#define R_ 33280
#define BT_ 16640
#define NCH_ 260

#define OFF_XC 0ull
#define OFF_MOD 2097152ull
#define OFF_W 2244608ull
#define OFF_H 24264704ull
#define OFF_ACT 92422144ull
#define A_Z 0ull
#define A_UC 85196800ull
#define A_AB 170393600ull
#define A_U 170393600ull
#define A_HF 340787200ull
#define A_AGG 425984000ull
#define A_CAR 431308800ull
#define A_QKV 0ull
#define A_GATE 272629760ull
#define A_HS 276889600ull
#define A_RSTD 413204480ull
#define A_R7B 68157440ull
#define A_RKVZ (A_R7B + 0ull)
#define A_WM (A_R7B + 272629760ull)
#define A_AM (A_R7B + 281149440ull)
#define A_BON (A_R7B + 289669120ull)
#define A_Y (A_R7B + 293928960ull)
#define WS_NEED (527000064ull + 16384ull)

#define WL_GATE (2560 * 1024)
#define WL_OUT (WL_GATE + 1310720)
#define WM_Z (4352 * 1024)
#define WM_OUT (WM_Z + 2048 * 1024)
#define WR_UP (4352 * 2048)
#define WR_OUT (WR_UP + 262144)

enum { PH_PRE = 0, PH_NORM, PH_LRU_IN, PH_LRU_CONV, PH_LRU_GATE, PH_LRU_S1, PH_LRU_S2, PH_LRU_S3, PH_LRU_OUT,
       PH_ML_IN, PH_ML_SCAN, PH_ML_STAT, PH_ML_Z, PH_ML_OUT,
       PH_R7_IN, PH_R7_CA, PH_R7_CB, PH_R7_FIN, PH_R7_OUT, PH_FINAL, PH_R7_SHIFT };

struct P {
  const float *x, *c, *ctx, *c_ctx, *norm_g, *mod_w, *mod_b, *final_g;
  const float *lru_w_in, *lru_conv_w, *lru_conv_b, *lru_gate_w, *lru_gate_b, *lru_lam, *lru_w_out;
  const float *ml_w_in, *ml_gate_b, *ml_norm_g, *ml_w_out;
  const float *r7_mu, *r7_w_rkvz, *r7_w0, *r7_w1, *r7_w2, *r7_a0, *r7_a1, *r7_a2, *r7_k_k, *r7_k_a, *r7_r_k, *r7_ln_g, *r7_ln_b, *r7_w_out;
  float* Xx; float* Xc; float* MOD; bfr* W; bfr* H; char* ACT; unsigned* bar; float* CL;
  int nsched; int pad_;
  int sched[64 * 3];
};
struct Ctx { int layer, j, d, wc; };

__device__ __forceinline__ int xcd_swz() { const int b = blockIdx.x; return gridDim.x == 256 ? ((b & 7) * 32 + (b >> 3)) : b; }
__device__ __forceinline__ int ltid() { int t = threadIdx.x; asm volatile("" : "+v"(t)); return t; }
typedef float f32v2_ __attribute__((ext_vector_type(2))); typedef __bf16 bf16v2_ __attribute__((ext_vector_type(2)));
__device__ __forceinline__ unsigned cvtpk(float lo, float hi) { f32v2_ f = {lo, hi}; bf16v2_ h = __builtin_convertvector(f, bf16v2_); return __builtin_bit_cast(unsigned, h); }
__device__ __forceinline__ bfr f2b(float f) { return (bfr)(cvtpk(f, f) & 0xffffu); }
__device__ __forceinline__ float b2f(bfr b) { return __uint_as_float(((unsigned)b) << 16); }
__device__ __forceinline__ unsigned pk2(float a, float b) { return cvtpk(a, b); }
__device__ __forceinline__ float blo(unsigned u) { return __uint_as_float(u << 16); }
__device__ __forceinline__ float bhi(unsigned u) { return __uint_as_float(u & 0xffff0000u); }
__device__ __forceinline__ void store4b(bfr* dst, f32x4 v) { uint2 u; u.x = pk2(v[0], v[1]); u.y = pk2(v[2], v[3]); *(uint2*)dst = u; }
__device__ __forceinline__ float sigm(float x) { return __builtin_amdgcn_rcpf(1.f + __expf(-x)); }
__device__ __forceinline__ float siluf(float x) { return x * sigm(x); }
__device__ __forceinline__ float softplusf(float x) { return x > 20.f ? x : log1pf(expf(x)); }
__device__ __forceinline__ int rowmap(int d, int b, int pp) { int o = d == 0 ? pp : (pp < 256 ? 255 - pp : 16895 - pp); return b * BT_ + o; }
__device__ __forceinline__ float* xrowp(const P& p, int row, int& mi) {
  int b = row / BT_, o = row - b * BT_;
  if (o < 256) { mi = 2; return p.Xc + (size_t)(b * 256 + o) * 1024; }
  mi = b; return p.Xx + (size_t)(b * 16384 + o - 256) * 1024;
}
template <int CTRL> __device__ __forceinline__ float dppf(float x) {
  return __int_as_float(__builtin_amdgcn_update_dpp(0, __float_as_int(x), CTRL, 0xf, 0xf, true));
}
__device__ __forceinline__ float wsum(float x) {
  x += dppf<0xB1>(x); x += dppf<0x4E>(x); x += dppf<0x141>(x); x += dppf<0x140>(x);
  x += __int_as_float(__builtin_amdgcn_update_dpp(0, __float_as_int(x), 0x142, 0xA, 0xF, false));
  x += __int_as_float(__builtin_amdgcn_update_dpp(0, __float_as_int(x), 0x143, 0xC, 0xF, false));
  return __int_as_float(__builtin_amdgcn_readlane(__float_as_int(x), 63));
}
template <int CTRL, int RM> __device__ __forceinline__ float dppo(float oldv, float x) {
  return __int_as_float(__builtin_amdgcn_update_dpp(__float_as_int(oldv), __float_as_int(x), CTRL, RM, 0xF, false)); }
__device__ __forceinline__ float wscan_add(float x) {
  x += dppo<0x111, 0xF>(0.f, x); x += dppo<0x112, 0xF>(0.f, x); x += dppo<0x114, 0xF>(0.f, x); x += dppo<0x118, 0xF>(0.f, x);
  x += dppo<0x142, 0xA>(0.f, x); x += dppo<0x143, 0xC>(0.f, x); return x; }
__device__ __forceinline__ float wscan_max(float x) {
  const float ninf = -3.0e38f;
  x = fmaxf(x, dppo<0x111, 0xF>(ninf, x)); x = fmaxf(x, dppo<0x112, 0xF>(ninf, x)); x = fmaxf(x, dppo<0x114, 0xF>(ninf, x)); x = fmaxf(x, dppo<0x118, 0xF>(ninf, x));
  x = fmaxf(x, dppo<0x142, 0xA>(ninf, x)); x = fmaxf(x, dppo<0x143, 0xC>(ninf, x)); return x; }
__device__ __forceinline__ float red16(float x) {
  x += dppf<0xB1>(x); x += dppf<0x4E>(x); x += dppf<0x141>(x); x += dppf<0x140>(x); return x;
}

template <class F> __device__ __forceinline__ void prep_tile(bfr* dst, int K, int tn, int tk, F get, float* sm) {
  int tid = ltid();
  for (int i = 0; i < 8; i++) { int kk = (tid >> 6) + 8 * i, nn = tid & 63; sm[kk * 65 + nn] = get(tk * 64 + kk, tn * 64 + nn); }
  __syncthreads();
  for (int i = 0; i < 8; i++) { int nn = (tid >> 6) + 8 * i, kk = tid & 63; dst[(size_t)(tn * 64 + nn) * K + tk * 64 + kk] = f2b(sm[kk * 65 + nn]); }
  __syncthreads();
}
__device__ __forceinline__ int prep_count(int layer) { int kind = layer % 3; return kind == 0 ? (640 + 320 + 320) : kind == 1 ? (1088 + 512 + 512) : (2176 + 64 + 256); }
__device__ __forceinline__ void prep_item(const P& p, int layer, int it, float* sm) {
  int kind = layer % 3, j = layer / 3;
  if (kind == 0) {
    if (it < 640) { int tn = it / 16, tk = it % 16; const float* s = p.lru_w_in + (size_t)j * 1024 * 2560;
      prep_tile(p.W, 1024, tn, tk, [=](int k, int n) { return s[(size_t)k * 2560 + n]; }, sm); return; }
    it -= 640;
    if (it < 320) { int d = it / 160, r = it % 160, tn = r / 2, tk = r % 2; const float* s = p.lru_gate_w + (size_t)(j * 2 + d) * 2 * 10 * 16384;
      prep_tile(p.W + WL_GATE + d * 655360, 128, tn, tk, [=](int k, int n) {
        int nt = n >> 7, blk = nt >> 1, sub = nt & 1, jj = n & 127, wn = jj >> 6, rr = jj & 63, g = rr >> 5, c = rr & 31;
        int kch = sub * 64 + wn * 32 + c; return s[((size_t)(g * 10 + blk) * 128 + k) * 128 + kch]; }, sm); return; }
    it -= 320;
    { int tn = it / 20, tk = it % 20; const float* s = p.lru_w_out + (size_t)j * 1280 * 1024;
      prep_tile(p.W + WL_OUT, 1280, tn, tk, [=](int k, int n) { return s[(size_t)k * 1024 + n]; }, sm); return; }
  } else if (kind == 1) {
    const float* s = p.ml_w_in + (size_t)j * 1024 * 6176;
    if (it < 1088) { int tn = it / 16, tk = it % 16;
      prep_tile(p.W, 1024, tn, tk, [=](int k, int n) {
        if (n < 4096) { float v = s[(size_t)k * 6176 + n]; return (n >= 1024 && n < 2048) ? v * 0.08838834764831845f : v; }
        if (n < 4128) return s[(size_t)k * 6176 + 6144 + (n - 4096)];
        return 0.f; }, sm); return; }
    it -= 1088;
    if (it < 512) { int tn = it / 16, tk = it % 16;
      prep_tile(p.W + WM_Z, 1024, tn, tk, [=](int k, int n) { return s[(size_t)k * 6176 + 4096 + n]; }, sm); return; }
    it -= 512;
    { int tn = it / 32, tk = it % 32; const float* so = p.ml_w_out + (size_t)j * 2048 * 1024;
      prep_tile(p.W + WM_OUT, 2048, tn, tk, [=](int k, int n) { return so[(size_t)k * 1024 + n]; }, sm); return; }
  } else {
    if (it < 2176) { int tn = it / 32, tk = it % 32;
      const float* mu = p.r7_mu + (size_t)j * 6 * 1024; const float* wr = p.r7_w_rkvz + (size_t)j * 4 * 1024 * 1024;
      const float* w1 = p.r7_w1 + (size_t)j * 2 * 1024 * 64; const float* a1 = p.r7_a1 + (size_t)j * 2 * 1024 * 64;
      prep_tile(p.W, 2048, tn, tk, [=](int k, int n) {
        int kk = k & 1023; float v, m;
        if (n < 4096) { int g = n >> 10, e = n & 1023; m = mu[g * 1024 + kk]; v = wr[((size_t)g * 1024 + kk) * 1024 + e]; }
        else if (n < 4224) { int xx = (n - 4096) >> 6, rr = (n - 4096) & 63; m = mu[4 * 1024 + kk]; v = w1[((size_t)xx * 1024 + kk) * 64 + rr]; }
        else { int xx = (n - 4224) >> 6, rr = (n - 4224) & 63; m = mu[5 * 1024 + kk]; v = a1[((size_t)xx * 1024 + kk) * 64 + rr]; }
        return (k < 1024 ? (1.f - m) : m) * v; }, sm); return; }
    it -= 2176;
    if (it < 64) { int u = it / 16, tn = it % 16; const float* s = (u < 2 ? p.r7_w2 : p.r7_a2) + (size_t)(j * 2 + (u & 1)) * 64 * 1024;
      prep_tile(p.W + WR_UP + u * 65536, 64, tn, 0, [=](int k, int n) { return s[(size_t)k * 1024 + n]; }, sm); return; }
    it -= 64;
    { int tn = it / 16, tk = it % 16; const float* s = p.r7_w_out + (size_t)j * 1024 * 1024;
      prep_tile(p.W + WR_OUT, 1024, tn, tk, [=](int k, int n) { return s[(size_t)k * 1024 + n]; }, sm); return; }
  }
}

#define LDSS 72
template <class G> __device__ __forceinline__ void gemm_tile(const P& p, const Ctx& c, int mt, int nt, char* smem) {
  const int tid = ltid(), lane = tid & 63, wid = tid >> 6, wm = wid & 3, wn = wid >> 2;
  bfr* sA = (bfr*)smem; bfr* sB = sA + 2 * 256 * LDSS;
  f32x4 acc[4][4];
  for (int a = 0; a < 4; a++) for (int b = 0; b < 4; b++) acc[a][b] = f32x4{0.f, 0.f, 0.f, 0.f};
  const int lr = tid >> 3, lc = tid & 7;
  uint4 ra[4], rb[2];
  auto gload = [&](int kt) __attribute__((always_inline)) {
#pragma unroll
    for (int i = 0; i < 4; i++) {
      const bfr* pa = G::aptr(p, c, mt * 256 + lr + 64 * i, kt, nt);
      ra[i] = pa ? *(const uint4*)(pa + lc * 8) : uint4{0u, 0u, 0u, 0u};
      if (i < 2) rb[i] = *(const uint4*)(G::bptr(p, c, nt * 128 + lr + 64 * i, kt) + lc * 8);
    }
  };
  auto sstore = [&](int buf) __attribute__((always_inline)) {
#pragma unroll
    for (int i = 0; i < 4; i++) {
      *(uint4*)(sA + (buf * 256 + lr + 64 * i) * LDSS + lc * 8) = ra[i];
      if (i < 2) *(uint4*)(sB + (buf * 128 + lr + 64 * i) * LDSS + lc * 8) = rb[i];
    }
  };
  gload(0); sstore(0); __syncthreads();
  for (int kt = 0; kt < G::KT; kt++) {
    const int buf = kt & 1;
    if (kt + 1 < G::KT) gload(kt + 1);
#pragma unroll
    for (int ks = 0; ks < 2; ks++) {
      bf16x8 af[4], bf[4];
#pragma unroll
      for (int i = 0; i < 4; i++) {
        af[i] = *(const bf16x8*)(sA + (buf * 256 + wm * 64 + i * 16 + (lane & 15)) * LDSS + ks * 32 + (lane >> 4) * 8);
        bf[i] = *(const bf16x8*)(sB + (buf * 128 + wn * 64 + i * 16 + (lane & 15)) * LDSS + ks * 32 + (lane >> 4) * 8);
      }
#pragma unroll
      for (int n = 0; n < 4; n++)
#pragma unroll
        for (int m = 0; m < 4; m++) acc[n][m] = __builtin_amdgcn_mfma_f32_16x16x32_bf16(bf[n], af[m], acc[n][m], 0, 0, 0);
    }
    if (kt + 1 < G::KT) sstore(buf ^ 1);
    __syncthreads();
  }
  G::epi(p, c, acc, mt * 256 + wm * 64, nt * 128 + wn * 64, lane);
}

__device__ __forceinline__ void epi_resid(const P& p, const Ctx& c, f32x4 (&acc)[4][4], int m0, int n0, int lane) {
#pragma unroll
  for (int mi = 0; mi < 4; mi++) {
    int row = m0 + mi * 16 + (lane & 15); int mo; float* xr = xrowp(p, row, mo);
    if (mo == 2 && !c.wc) continue;
    const float* g = p.MOD + (size_t)(c.layer * 3 + mo) * 3072 + 2048;
#pragma unroll
    for (int ni = 0; ni < 4; ni++) {
      int n = n0 + ni * 16 + (lane >> 4) * 4;
      float4 xv = *(float4*)(xr + n); float4 gg = *(const float4*)(g + n);
      xv.x += gg.x * acc[ni][mi][0]; xv.y += gg.y * acc[ni][mi][1]; xv.z += gg.z * acc[ni][mi][2]; xv.w += gg.w * acc[ni][mi][3];
      *(float4*)(xr + n) = xv;
    }
  }
}

struct G_LruIn { static constexpr int KT = 16, NT = 20;
  static __device__ __forceinline__ const bfr* aptr(const P& p, const Ctx& c, int row, int kt, int nt) { return p.H + (size_t)row * 1024 + kt * 64; }
  static __device__ __forceinline__ const bfr* bptr(const P& p, const Ctx& c, int n, int kt) { return p.W + (size_t)n * 1024 + kt * 64; }
  static __device__ __forceinline__ void epi(const P& p, const Ctx& c, f32x4 (&acc)[4][4], int m0, int n0, int lane) {
    bfr* U = (bfr*)(p.ACT + A_U); bfr* Z = (bfr*)(p.ACT + A_Z);
#pragma unroll
    for (int ni = 0; ni < 4; ni++)
#pragma unroll
      for (int mi = 0; mi < 4; mi++) {
        int row = m0 + mi * 16 + (lane & 15), n = n0 + ni * 16 + (lane >> 4) * 4;
        bfr* dst = n < 1280 ? U + (size_t)row * 1280 + n : Z + (size_t)row * 1280 + (n - 1280);
        store4b(dst, acc[ni][mi]);
      }
  } };
struct G_LruGate { static constexpr int KT = 2, NT = 20;
  static __device__ __forceinline__ const bfr* aptr(const P& p, const Ctx& c, int row, int kt, int nt) { return (const bfr*)(p.ACT + A_UC) + (size_t)row * 1280 + (nt >> 1) * 128 + kt * 64; }
  static __device__ __forceinline__ const bfr* bptr(const P& p, const Ctx& c, int n, int kt) { return p.W + WL_GATE + c.d * 655360 + (size_t)n * 128 + kt * 64; }
  static __device__ __forceinline__ void epi(const P& p, const Ctx& c, f32x4 (&acc)[4][4], int m0, int n0, int lane) {
    const bfr* UC = (const bfr*)(p.ACT + A_UC); unsigned* AB = (unsigned*)(p.ACT + A_AB);
    const float* gb = p.lru_gate_b + (size_t)(c.j * 2 + c.d) * 2 * 1280; const float* lam = p.lru_lam + (size_t)(c.j * 2 + c.d) * 1280;
    int chb = (n0 >> 6) * 32;
#pragma unroll
    for (int ni = 0; ni < 2; ni++) {
      int ch = chb + ni * 16 + (lane >> 4) * 4;
      float cl[4], br[4], bi[4];
#pragma unroll
      for (int q = 0; q < 4; q++) { cl[q] = p.CL[(size_t)(c.j * 2 + c.d) * 1280 + ch + q]; br[q] = gb[ch + q]; bi[q] = gb[1280 + ch + q]; }
#pragma unroll
      for (int mi = 0; mi < 4; mi++) {
        int row = m0 + mi * 16 + (lane & 15);
        uint2 u = *(const uint2*)(UC + (size_t)row * 1280 + ch);
        float uc[4] = {blo(u.x), bhi(u.x), blo(u.y), bhi(u.y)};
        unsigned o[4];
#pragma unroll
        for (int q = 0; q < 4; q++) {
          float r = sigm(acc[ni][mi][q] + br[q]), ig = sigm(acc[ni + 2][mi][q] + bi[q]);
          float la = -cl[q] * r; float oma = 1.f - __expf(la); float bb = __builtin_amdgcn_sqrtf(oma * (2.f - oma)) * ig * uc[q];
          o[q] = (((unsigned)f2b(oma)) << 16) | (unsigned)f2b(bb);
        }
        *(uint4*)(AB + (size_t)row * 1280 + ch) = uint4{o[0], o[1], o[2], o[3]};
      }
    }
  } };
struct G_LruOut { static constexpr int KT = 20, NT = 8;
  static __device__ __forceinline__ const bfr* aptr(const P& p, const Ctx& c, int row, int kt, int nt) { return (const bfr*)(p.ACT + A_Z) + (size_t)row * 1280 + kt * 64; }
  static __device__ __forceinline__ const bfr* bptr(const P& p, const Ctx& c, int n, int kt) { return p.W + WL_OUT + (size_t)n * 1280 + kt * 64; }
  static __device__ __forceinline__ void epi(const P& p, const Ctx& c, f32x4 (&acc)[4][4], int m0, int n0, int lane) { epi_resid(p, c, acc, m0, n0, lane); } };
struct G_MlIn { static constexpr int KT = 16, NT = 33;
  static __device__ __forceinline__ const bfr* aptr(const P& p, const Ctx& c, int row, int kt, int nt) { return p.H + (size_t)row * 1024 + kt * 64; }
  static __device__ __forceinline__ const bfr* bptr(const P& p, const Ctx& c, int n, int kt) { return p.W + (size_t)n * 1024 + kt * 64; }
  static __device__ __forceinline__ void epi(const P& p, const Ctx& c, f32x4 (&acc)[4][4], int m0, int n0, int lane) {
    bfr* QKV = (bfr*)(p.ACT + A_QKV); float* GT = (float*)(p.ACT + A_GATE);
#pragma unroll
    for (int ni = 0; ni < 4; ni++)
#pragma unroll
      for (int mi = 0; mi < 4; mi++) {
        int row = m0 + mi * 16 + (lane & 15), n = n0 + ni * 16 + (lane >> 4) * 4;
        if (n < 4096) store4b(QKV + (size_t)row * 4096 + n, acc[ni][mi]);
        else if (n < 4128) *(float4*)(GT + (size_t)row * 32 + (n - 4096)) = float4{acc[ni][mi][0], acc[ni][mi][1], acc[ni][mi][2], acc[ni][mi][3]};
      }
  } };
struct G_MlZ { static constexpr int KT = 16, NT = 16;
  static __device__ __forceinline__ const bfr* aptr(const P& p, const Ctx& c, int row, int kt, int nt) { return p.H + (size_t)row * 1024 + kt * 64; }
  static __device__ __forceinline__ const bfr* bptr(const P& p, const Ctx& c, int n, int kt) { return p.W + WM_Z + (size_t)n * 1024 + kt * 64; }
  static __device__ __forceinline__ void epi(const P& p, const Ctx& c, f32x4 (&acc)[4][4], int m0, int n0, int lane) {
    bfr* HS = (bfr*)(p.ACT + A_HS); const float* RS = (const float*)(p.ACT + A_RSTD); const float* ng = p.ml_norm_g + (size_t)c.j * 2048;
#pragma unroll
    for (int ni = 0; ni < 4; ni++)
#pragma unroll
      for (int mi = 0; mi < 4; mi++) {
        int row = m0 + mi * 16 + (lane & 15), n = n0 + ni * 16 + (lane >> 4) * 4;
        bfr* hp = HS + (size_t)row * 2048 + n; uint2 u = *(const uint2*)hp; float rs = RS[(size_t)row * 8 + (n >> 8)];
        float4 g4 = *(const float4*)(ng + n);
        f32x4 o;
        o[0] = blo(u.x) * rs * g4.x * siluf(acc[ni][mi][0]); o[1] = bhi(u.x) * rs * g4.y * siluf(acc[ni][mi][1]);
        o[2] = blo(u.y) * rs * g4.z * siluf(acc[ni][mi][2]); o[3] = bhi(u.y) * rs * g4.w * siluf(acc[ni][mi][3]);
        store4b(hp, o);
      }
  } };
struct G_MlOut { static constexpr int KT = 32, NT = 8;
  static __device__ __forceinline__ const bfr* aptr(const P& p, const Ctx& c, int row, int kt, int nt) { return (const bfr*)(p.ACT + A_HS) + (size_t)row * 2048 + kt * 64; }
  static __device__ __forceinline__ const bfr* bptr(const P& p, const Ctx& c, int n, int kt) { return p.W + WM_OUT + (size_t)n * 2048 + kt * 64; }
  static __device__ __forceinline__ void epi(const P& p, const Ctx& c, f32x4 (&acc)[4][4], int m0, int n0, int lane) { epi_resid(p, c, acc, m0, n0, lane); } };
struct G_R7In { static constexpr int KT = 32, NT = 34;
  static __device__ __forceinline__ const bfr* aptr(const P& p, const Ctx& c, int row, int kt, int nt) {
    if (kt < 16) return p.H + (size_t)row * 1024 + kt * 64;
    int q = (kt - 16) >> 2; int b = row / BT_, o = row - b * BT_; int nr;
    if (o < 256) { if (q < 2) { if (o < 1) return nullptr; nr = row - 1; } else { if (o >= 255) return nullptr; nr = row + 1; } }
    else { int t = o - 256, col = t & 63, gr = t >> 6;
      if (q == 0) { if (col == 0) return nullptr; nr = row - 1; }
      else if (q == 1) { if (col == 63) return nullptr; nr = row + 1; }
      else if (q == 2) { if (gr == 0) return nullptr; nr = row - 64; }
      else { if (gr == 255) return nullptr; nr = row + 64; } }
    return p.H + (size_t)nr * 1024 + (kt - 16) * 64; }
  static __device__ __forceinline__ const bfr* bptr(const P& p, const Ctx& c, int n, int kt) { return p.W + (size_t)n * 2048 + kt * 64; }
  static __device__ __forceinline__ void epi(const P& p, const Ctx& c, f32x4 (&acc)[4][4], int m0, int n0, int lane) {
    bfr* RK = (bfr*)(p.ACT + A_RKVZ); bfr* WMb = (bfr*)(p.ACT + A_WM); bfr* AMb = (bfr*)(p.ACT + A_AM);
#pragma unroll
    for (int ni = 0; ni < 4; ni++)
#pragma unroll
      for (int mi = 0; mi < 4; mi++) {
        int row = m0 + mi * 16 + (lane & 15), n = n0 + ni * 16 + (lane >> 4) * 4;
        if (n < 4096) store4b(RK + (size_t)row * 4096 + n, acc[ni][mi]);
        else if (n < 4224) { f32x4 t;
#pragma unroll
          for (int q = 0; q < 4; q++) t[q] = tanhf(acc[ni][mi][q]); store4b(WMb + (size_t)row * 128 + (n - 4096), t); }
        else store4b(AMb + (size_t)row * 128 + (n - 4224), acc[ni][mi]);
      }
  } };
struct G_R7Out { static constexpr int KT = 16, NT = 8;
  static __device__ __forceinline__ const bfr* aptr(const P& p, const Ctx& c, int row, int kt, int nt) { return p.H + (size_t)row * 1024 + kt * 64; }
  static __device__ __forceinline__ const bfr* bptr(const P& p, const Ctx& c, int n, int kt) { return p.W + WR_OUT + (size_t)n * 1024 + kt * 64; }
  static __device__ __forceinline__ void epi(const P& p, const Ctx& c, f32x4 (&acc)[4][4], int m0, int n0, int lane) { epi_resid(p, c, acc, m0, n0, lane); } };


namespace pg8 {
#define PG8_LAS __attribute__((address_space(3)))
constexpr int BM = 256, BK = 64, HALF = 128, HTB = HALF * BK * 2, NXCD = 8, WGM = 8;
__device__ __forceinline__ int lds_byte(int r, int c) { const int st = (r >> 4) * 2 + (c >> 5), rr = r & 15, cc = c & 31, ob = rr * 64 + cc * 2; return st * 1024 + (ob ^ (((ob >> 9) & 1) << 5)); }
__device__ __forceinline__ void stage_rc(int b, int& R, int& C) { const int st = b / 1024, sb = b % 1024, swz = sb ^ (((sb >> 9) & 1) << 5); R = (st >> 1) * 16 + swz / 64; C = (st & 1) * 32 + (swz % 64) / 2; }
struct Unit { int pm, pn; };
struct Gemm { const bfr* A; const bfr* Bt; int M, N, K; };
struct StaticOrder {
  int nM, nN, nwg, G, c;
  __device__ void init(int M, int N, int G_, int c_) { nM = M / BM; nN = N / BM; nwg = nM * nN; G = G_; c = c_; }
  __device__ bool next(int i, Unit& u) const {
    const long L = (long)i * G + c; if (L >= nwg) return false;
    int wgid = (int)L; { const int q = nwg / NXCD, r = nwg % NXCD, xcd = wgid % NXCD, off = wgid / NXCD; wgid = (xcd < r ? xcd * (q + 1) : r * (q + 1) + (xcd - r) * q) + off; }
    const int nig = WGM * nN, gid = wgid / nig, fm = gid * WGM, gsz = (nM - fm) < WGM ? (nM - fm) : WGM;
    u.pm = fm + ((wgid % nig) % gsz); u.pn = (wgid % nig) / gsz; return true;
  }
};
template <class Epi>
__device__ __forceinline__ void gemm_phase(PG8_LAS unsigned char* lds, const Gemm g, const StaticOrder& S, const Epi& E) {
  const int tid = ltid(), wid = __builtin_amdgcn_readfirstlane(tid >> 6), lane = tid & 63, wr = wid >> 2, wc = wid & 3, fr = lane & 15, fq = lane >> 4;
  const int K = g.K, nt = K / BK;
  unsigned voffA[2], voffB[2];
#pragma unroll
  for (int i = 0; i < 2; ++i) { int R, C; stage_rc(tid * 16 + i * 8192, R, C); voffA[i] = (unsigned)(R * K + C) * 2u; voffB[i] = voffA[i]; }
  const size_t kstep = (size_t)(BK * 2);
  const size_t hstep = (size_t)HALF * K * 2;
  const size_t tstep = 2 * hstep;
  const unsigned ldsw = (unsigned)wid * 1024u;
  const int aoff = lds_byte(wr * 64 + fr, fq * 8), boff = lds_byte(wc * 32 + fr, fq * 8);
#define PG8_SA(b, h) (((b) * 2 + (h)) * HTB)
#define PG8_SB(b, h) ((4 + (b) * 2 + (h)) * HTB)
#define PG8_STAGE(bufoff, gbase, voff) do { _Pragma("unroll") for (int _i = 0; _i < 2; ++_i) \
    __builtin_amdgcn_global_load_lds((const unsigned*)((const char*)(gbase) + (voff)[_i]), (PG8_LAS unsigned*)(lds + (bufoff) + ldsw + _i * 8192), 16, 0, 0); } while (0)
#define PG8_LDA(dst, b, h) do { _Pragma("unroll") for (int m = 0; m < 4; ++m) _Pragma("unroll") for (int k = 0; k < 2; ++k) dst[m][k] = *(const PG8_LAS bf16x8*)(lds + PG8_SA(b, h) + aoff + m * 2048 + k * 1024); } while (0)
#define PG8_LDB(dst, b, h) do { _Pragma("unroll") for (int n = 0; n < 2; ++n) _Pragma("unroll") for (int k = 0; k < 2; ++k) dst[n][k] = *(const PG8_LAS bf16x8*)(lds + PG8_SB(b, h) + boff + n * 2048 + k * 1024); } while (0)
#define PG8_MMA(ai, bj, At, Bt) do { __builtin_amdgcn_s_setprio(1); _Pragma("unroll") for (int m = 0; m < 4; ++m) _Pragma("unroll") for (int n = 0; n < 2; ++n) _Pragma("unroll") for (int k = 0; k < 2; ++k) \
    acc[ai][bj][m][n] = __builtin_amdgcn_mfma_f32_16x16x32_bf16(Bt[n][k], At[m][k], acc[ai][bj][m][n], 0, 0, 0); __builtin_amdgcn_s_setprio(0); } while (0)
#define PG8_WAIT_V(n) asm volatile("s_waitcnt vmcnt(" #n ")" ::: "memory")
#define PG8_WAIT_L(n) asm volatile("s_waitcnt lgkmcnt(" #n ")" ::: "memory")
#define PG8_BAR __builtin_amdgcn_s_barrier()
#define PG8_SCHED __builtin_amdgcn_sched_barrier(0)
  Unit cur, nxt; int ui = 0;
  if (!S.next(0, cur)) return;
  f32x4 acc[2][2][4][2];
#pragma unroll
  for (int a = 0; a < 2; ++a)
#pragma unroll
    for (int b = 0; b < 2; ++b)
#pragma unroll
      for (int m = 0; m < 4; ++m)
#pragma unroll
        for (int n = 0; n < 2; ++n) acc[a][b][m][n] = (f32x4){0.f, 0.f, 0.f, 0.f};
  bf16x8 At[4][2], B0[2][2], B1[2][2];
  const char* cA = (const char*)g.A + (size_t)cur.pm * tstep; const char* cB = (const char*)g.Bt + (size_t)cur.pn * tstep;
  PG8_STAGE(PG8_SB(0, 0), cB, voffB); PG8_STAGE(PG8_SA(0, 0), cA, voffA); PG8_STAGE(PG8_SB(0, 1), cB + hstep, voffB); PG8_STAGE(PG8_SA(0, 1), cA + hstep, voffA);
  if (wr == 1) PG8_BAR;
  PG8_WAIT_V(4); PG8_BAR;
  PG8_STAGE(PG8_SB(1, 0), cB + kstep, voffB); PG8_STAGE(PG8_SA(1, 0), cA + kstep, voffA); PG8_STAGE(PG8_SB(1, 1), cB + hstep + kstep, voffB);
  PG8_WAIT_V(6); PG8_BAR;
  for (;;) {
    const bool has_next = S.next(ui + 1, nxt);
    const char* nA = has_next ? (const char*)g.A + (size_t)nxt.pm * tstep : cA; const char* nB = has_next ? (const char*)g.Bt + (size_t)nxt.pn * tstep : cB;
    for (int t = 0; t < nt; t += 2) {
      const bool last = (t == nt - 2);
      const char* a1 = cA + (size_t)(t + 1) * kstep;
      const char* a2 = last ? nA : cA + (size_t)(t + 2) * kstep; const char* b2 = last ? nB : cB + (size_t)(t + 2) * kstep;
      const char* a3 = a2 + kstep; const char* b3 = b2 + kstep;
      PG8_LDB(B0, 0, 0); PG8_SCHED; PG8_LDA(At, 0, 0); PG8_STAGE(PG8_SA(1, 1), a1 + hstep, voffA);
      PG8_WAIT_L(8); PG8_BAR; PG8_WAIT_L(0); PG8_MMA(0, 0, At, B0); PG8_BAR; PG8_SCHED;
      PG8_LDB(B1, 0, 1); PG8_STAGE(PG8_SB(0, 0), b2, voffB);
      PG8_BAR; PG8_WAIT_L(0); PG8_MMA(0, 1, At, B1); PG8_BAR;
      PG8_LDA(At, 0, 1); PG8_STAGE(PG8_SA(0, 0), a2, voffA);
      PG8_BAR; PG8_WAIT_L(0); PG8_MMA(1, 0, At, B0); PG8_BAR; PG8_SCHED;
      PG8_STAGE(PG8_SB(0, 1), b2 + hstep, voffB);
      PG8_WAIT_V(6); PG8_BAR; PG8_MMA(1, 1, At, B1); PG8_BAR;
      PG8_LDB(B0, 1, 0); PG8_SCHED; PG8_LDA(At, 1, 0); PG8_STAGE(PG8_SA(0, 1), a2 + hstep, voffA);
      PG8_WAIT_L(8); PG8_BAR; PG8_WAIT_L(0); PG8_MMA(0, 0, At, B0); PG8_BAR; PG8_SCHED;
      PG8_LDB(B1, 1, 1); PG8_STAGE(PG8_SB(1, 0), b3, voffB);
      PG8_BAR; PG8_WAIT_L(0); PG8_MMA(0, 1, At, B1); PG8_BAR;
      PG8_LDA(At, 1, 1); PG8_STAGE(PG8_SA(1, 0), a3, voffA);
      PG8_BAR; PG8_WAIT_L(0); PG8_MMA(1, 0, At, B0); PG8_BAR; PG8_SCHED;
      PG8_STAGE(PG8_SB(1, 1), b3 + hstep, voffB);
      PG8_WAIT_V(6); PG8_BAR; PG8_MMA(1, 1, At, B1); PG8_BAR;
    }
    E(acc, cur, wr, wc, fr, fq);
    if (!has_next) break;
#pragma unroll
    for (int a = 0; a < 2; ++a)
#pragma unroll
      for (int b = 0; b < 2; ++b)
#pragma unroll
        for (int m = 0; m < 4; ++m)
#pragma unroll
          for (int n = 0; n < 2; ++n) acc[a][b][m][n] = (f32x4){0.f, 0.f, 0.f, 0.f};
    cur = nxt; cA = nA; cB = nB; ++ui;
  }
  PG8_WAIT_V(0);
  if (wr == 0) PG8_BAR;
  PG8_BAR;
#undef PG8_SA
#undef PG8_SB
#undef PG8_STAGE
#undef PG8_LDA
#undef PG8_LDB
#undef PG8_MMA
#undef PG8_WAIT_V
#undef PG8_WAIT_L
#undef PG8_BAR
#undef PG8_SCHED
}
}

template <class F> struct EpiAd {
  F f;
  __device__ __forceinline__ void operator()(const f32x4 (&acc)[2][2][4][2], const pg8::Unit& u, int wr, int wc, int fr, int fq) const {
#pragma unroll
    for (int ai = 0; ai < 2; ++ai)
#pragma unroll
      for (int m = 0; m < 4; ++m) { const int row = u.pm * 256 + ai * 128 + wr * 64 + m * 16 + fr;
#pragma unroll
        for (int bj = 0; bj < 2; ++bj)
#pragma unroll
          for (int n = 0; n < 2; ++n) f(row, u.pn * 256 + bj * 128 + wc * 32 + n * 16 + 4 * fq, acc[ai][bj][m][n]); }
  }
};
template <class F> __device__ __forceinline__ void big_gemm(char* smem, const bfr* A, const bfr* Bt, int N, int K, F f) {
  pg8::Gemm g; g.A = A; g.Bt = Bt; g.M = R_; g.N = N; g.K = K;
  pg8::StaticOrder S; S.init(R_, N, (int)gridDim.x, (int)blockIdx.x);
  EpiAd<F> E{f};
  pg8::gemm_phase(( __attribute__((address_space(3))) unsigned char*)smem, g, S, E);
}
struct F_LruIn { char* ACT; __device__ __forceinline__ void operator()(int row, int n, f32x4 v) const {
  bfr* dst = n < 1280 ? (bfr*)(ACT + A_U) + (size_t)row * 1280 + n : (bfr*)(ACT + A_Z) + (size_t)row * 1280 + (n - 1280); store4b(dst, v); } };
struct F_Resid { float* Xx; float* Xc; const float* MODg; int wc; __device__ __forceinline__ void operator()(int row, int n, f32x4 v) const {
  int b = row / BT_, o = row - b * BT_; bool isc = o < 256; if (isc && !wc) return;
  float* xr = isc ? Xc + (size_t)(b * 256 + o) * 1024 : Xx + (size_t)(b * 16384 + o - 256) * 1024; const float* g = MODg + (size_t)(isc ? 2 : b) * 3072 + 2048;
  float4 xv = *(float4*)(xr + n); float4 gg = *(const float4*)(g + n);
  xv.x += gg.x * v[0]; xv.y += gg.y * v[1]; xv.z += gg.z * v[2]; xv.w += gg.w * v[3]; *(float4*)(xr + n) = xv; } };
struct F_MlIn { char* ACT; __device__ __forceinline__ void operator()(int row, int n, f32x4 v) const {
  if (n < 4096) store4b((bfr*)(ACT + A_QKV) + (size_t)row * 4096 + n, v);
  else if (n < 4128) *(float4*)((float*)(ACT + A_GATE) + (size_t)row * 32 + (n - 4096)) = float4{v[0], v[1], v[2], v[3]}; } };
struct F_MlZ { char* ACT; const float* ng; __device__ __forceinline__ void operator()(int row, int n, f32x4 v) const {
  bfr* hp = (bfr*)(ACT + A_HS) + (size_t)row * 2048 + n; uint2 u = *(const uint2*)hp; float rs = ((const float*)(ACT + A_RSTD))[(size_t)row * 8 + (n >> 8)];
  float4 g4 = *(const float4*)(ng + n); f32x4 o;
  o[0] = blo(u.x) * rs * g4.x * siluf(v[0]); o[1] = bhi(u.x) * rs * g4.y * siluf(v[1]); o[2] = blo(u.y) * rs * g4.z * siluf(v[2]); o[3] = bhi(u.y) * rs * g4.w * siluf(v[3]);
  store4b(hp, o); } };
struct F_R7In { char* ACT; __device__ __forceinline__ void operator()(int row, int n, f32x4 v) const {
  if (n < 4096) store4b((bfr*)(ACT + A_RKVZ) + (size_t)row * 4096 + n, v);
  else if (n < 4224) { f32x4 t;
#pragma unroll
    for (int q = 0; q < 4; q++) t[q] = tanhf(v[q]);
    store4b((bfr*)(ACT + A_WM) + (size_t)row * 128 + (n - 4096), t); }
  else store4b((bfr*)(ACT + A_AM) + (size_t)row * 128 + (n - 4224), v); } };

template <class G> __device__ __forceinline__ void gemm_phase(const P& p, const Ctx& c, char* smem) {
  const int total = 130 * G::NT;
  for (int it = blockIdx.x; it < total; it += gridDim.x) gemm_tile<G>(p, c, it / G::NT, it % G::NT, smem);
}

#define R7_Y2 ((bfr*)p.H + (size_t)64 * 26 * 16384)
template <class G> __device__ __forceinline__ void gemm_phase_k2(const P& p, const Ctx& c, char* smem) {
  const int tid = ltid(), lane = tid & 63, wid = tid >> 6, wm = wid & 3, wn = wid >> 2;
  bfr* sA = (bfr*)smem; bfr* sB = sA + 2 * 256 * LDSS;
  const int lr = tid >> 3, lc = tid & 7;
  const int total = 130 * G::NT;
  uint4 a00, a01, a02, a03, a10, a11, a12, a13, b00, b01, b10, b11;
#define GK2_LA(i_, R0, R1) { R0 = *(const uint4*)(G::aptr(p, c, mt_ * 256 + lr + 64 * (i_), 0, nt_) + lc * 8); R1 = *(const uint4*)(G::aptr(p, c, mt_ * 256 + lr + 64 * (i_), 1, nt_) + lc * 8); }
#define GK2_LB(i_, R0, R1) { R0 = *(const uint4*)(G::bptr(p, c, nt_ * 128 + lr + 64 * (i_), 0) + lc * 8); R1 = *(const uint4*)(G::bptr(p, c, nt_ * 128 + lr + 64 * (i_), 1) + lc * 8); }
#define GK2_LOAD(it_) { const int mt_ = (it_) / G::NT, nt_ = (it_) % G::NT; GK2_LA(0, a00, a10) GK2_LA(1, a01, a11) GK2_LA(2, a02, a12) GK2_LA(3, a03, a13) GK2_LB(0, b00, b10) GK2_LB(1, b01, b11) }
#define GK2_SA(i_, R0, R1) { *(uint4*)(sA + (lr + 64 * (i_)) * LDSS + lc * 8) = R0; *(uint4*)(sA + (256 + lr + 64 * (i_)) * LDSS + lc * 8) = R1; }
#define GK2_SB(i_, R0, R1) { *(uint4*)(sB + (lr + 64 * (i_)) * LDSS + lc * 8) = R0; *(uint4*)(sB + (128 + lr + 64 * (i_)) * LDSS + lc * 8) = R1; }
  int it = xcd_swz();
  if (it < total) GK2_LOAD(it)
  while (it < total) {
    const int mt = it / G::NT, nt = it % G::NT;
    GK2_SA(0, a00, a10) GK2_SA(1, a01, a11) GK2_SA(2, a02, a12) GK2_SA(3, a03, a13) GK2_SB(0, b00, b10) GK2_SB(1, b01, b11)
    __syncthreads();
    const int itn = it + gridDim.x;
    if (itn < total) GK2_LOAD(itn)
    f32x4 acc[4][4];
#pragma unroll
    for (int a = 0; a < 4; a++)
#pragma unroll
      for (int b = 0; b < 4; b++) acc[a][b] = f32x4{0.f, 0.f, 0.f, 0.f};
#pragma unroll
    for (int buf = 0; buf < 2; buf++)
#pragma unroll
      for (int ks = 0; ks < 2; ks++) {
        bf16x8 af[4], bf[4];
#pragma unroll
        for (int i = 0; i < 4; i++) {
          af[i] = *(const bf16x8*)(sA + (buf * 256 + wm * 64 + i * 16 + (lane & 15)) * LDSS + ks * 32 + (lane >> 4) * 8);
          bf[i] = *(const bf16x8*)(sB + (buf * 128 + wn * 64 + i * 16 + (lane & 15)) * LDSS + ks * 32 + (lane >> 4) * 8);
        }
#pragma unroll
        for (int n = 0; n < 4; n++)
#pragma unroll
          for (int m = 0; m < 4; m++) acc[n][m] = __builtin_amdgcn_mfma_f32_16x16x32_bf16(bf[n], af[m], acc[n][m], 0, 0, 0);
      }
    G::epi(p, c, acc, mt * 256 + wm * 64, nt * 128 + wn * 64, lane);
    __syncthreads();
    it = itn;
  }
#undef GK2_LOAD
#undef GK2_LA
#undef GK2_LB
#undef GK2_SA
#undef GK2_SB
}

__device__ __forceinline__ void ph_pre(const P& p, char* smem) {
  float* sm = (float*)smem; const int tid = ltid();
  const int nprep = prep_count(0), ngemv = 192, ncopy = 4160;
  if (blockIdx.x == 0) for (int i = tid; i < 5120; i += 512) p.CL[i] = 8.f * softplusf(-p.lru_lam[i]);
  for (int it = blockIdx.x; it < nprep + ngemv + ncopy; it += gridDim.x) {
    if (it < nprep) { prep_item(p, 0, it, sm); continue; }
    int i2 = it - nprep;
    if (i2 < ngemv) {
      int l = i2 / 48, cgp = i2 % 48;
      for (int i = tid; i < 3072; i += 512) { int cnd = i >> 10, k = i & 1023; float v = cnd == 0 ? p.c[k] : cnd == 1 ? p.c[1024 + k] : p.c_ctx[k]; sm[i] = siluf(v); }
      __syncthreads();
      int kq = tid >> 6, col = cgp * 64 + (tid & 63); const float* w = p.mod_w + (size_t)l * 1024 * 3072 + col;
      float a0 = 0.f, a1 = 0.f, a2 = 0.f;
      for (int k = kq * 128; k < kq * 128 + 128; k++) { float wv = w[(size_t)k * 3072]; a0 += sm[k] * wv; a1 += sm[1024 + k] * wv; a2 += sm[2048 + k] * wv; }
      float* red = sm + 3072; red[tid * 3] = a0; red[tid * 3 + 1] = a1; red[tid * 3 + 2] = a2;
      __syncthreads();
      if (tid < 64) { float bias = p.mod_b[(size_t)l * 3072 + col];
        for (int cnd = 0; cnd < 3; cnd++) { float s = bias; for (int q = 0; q < 8; q++) s += red[(q * 64 + tid) * 3 + cnd]; p.MOD[(size_t)(l * 3 + cnd) * 3072 + col] = s; } }
      __syncthreads();
      continue;
    }
    i2 -= ngemv;
    for (int q = 0; q < 4; q++) { int idx = i2 * 2048 + q * 512 + tid; int row = idx >> 8, c4 = idx & 255; int b = row / BT_, o = row - b * BT_;
      if (o < 256) ((float4*)p.Xc)[(size_t)(b * 256 + o) * 256 + c4] = ((const float4*)p.ctx)[(size_t)(b * 256 + o) * 256 + c4];
      else ((float4*)p.Xx)[(size_t)(b * 16384 + o - 256) * 256 + c4] = ((const float4*)p.x)[(size_t)(b * 16384 + o - 256) * 256 + c4]; }
  }
}
__device__ __forceinline__ void ph_norm(const P& p, int layer, char* smem) {
  const int tid = ltid(), lane = tid & 63, wid = tid >> 6;
  const int nprep = layer > 0 ? prep_count(layer) : 0; const int kind = layer % 3;
  const int nzero = kind == 1 ? 8320 : 0;
  (void)nzero;
  for (int it = blockIdx.x; it < nprep + 4160; it += gridDim.x) {
    if (it < nprep) { prep_item(p, layer, it, (float*)smem); continue; }
    int row = (it - nprep) * 8 + wid; int mo; const float* xr = xrowp(p, row, mo);
    float4 v[4]; float ss = 0.f;
#pragma unroll
    for (int i = 0; i < 4; i++) { v[i] = *(const float4*)(xr + lane * 4 + 256 * i); ss += v[i].x * v[i].x + v[i].y * v[i].y + v[i].z * v[i].z + v[i].w * v[i].w; }
    ss = wsum(ss); float rs = rsqrtf(ss * (1.f / 1024.f) + 1e-6f);
    const float* g = p.norm_g + (size_t)layer * 1024; const float* md = p.MOD + (size_t)(layer * 3 + mo) * 3072;
#pragma unroll
    for (int i = 0; i < 4; i++) { int cidx = lane * 4 + 256 * i; float4 gg = *(const float4*)(g + cidx), sh = *(const float4*)(md + cidx), sc = *(const float4*)(md + 1024 + cidx);
      f32x4 o; o[0] = v[i].x * rs * gg.x * (1.f + sc.x) + sh.x; o[1] = v[i].y * rs * gg.y * (1.f + sc.y) + sh.y; o[2] = v[i].z * rs * gg.z * (1.f + sc.z) + sh.z; o[3] = v[i].w * rs * gg.w * (1.f + sc.w) + sh.w;
      store4b(p.H + (size_t)row * (kind == 2 ? 2048 : 1024) + cidx, o); }
  }
}
__device__ __forceinline__ void ph_r7_shift(const P& p) {
  for (int it = blockIdx.x; it < 8320; it += gridDim.x) {
    int idx = it * 512 + ltid(); int row = idx >> 7, c8 = idx & 127, q = c8 >> 5;
    int b = row / BT_, o = row - b * BT_; int nr = -1;
    if (o < 256) { if (q < 2) { if (o >= 1) nr = row - 1; } else { if (o < 255) nr = row + 1; } }
    else { int t = o - 256, col = t & 63, gr = t >> 6;
      if (q == 0) { if (col != 0) nr = row - 1; } else if (q == 1) { if (col != 63) nr = row + 1; }
      else if (q == 2) { if (gr != 0) nr = row - 64; } else { if (gr != 255) nr = row + 64; } }
    uint4 v = nr >= 0 ? *(const uint4*)(p.H + (size_t)nr * 2048 + c8 * 8) : uint4{0u, 0u, 0u, 0u};
    *(uint4*)(p.H + (size_t)row * 2048 + 1024 + c8 * 8) = v;
  }
}
__device__ __forceinline__ void ph_final(const P& p) {
  const int lane = ltid() & 63, wid = ltid() >> 6;
  for (int it = blockIdx.x; it < 4096; it += gridDim.x) {
    float* xr = p.Xx + (size_t)(it * 8 + wid) * 1024; float4 v[4]; float ss = 0.f;
#pragma unroll
    for (int i = 0; i < 4; i++) { v[i] = *(const float4*)(xr + lane * 4 + 256 * i); ss += v[i].x * v[i].x + v[i].y * v[i].y + v[i].z * v[i].z + v[i].w * v[i].w; }
    ss = wsum(ss); float rs = rsqrtf(ss * (1.f / 1024.f) + 1e-6f);
#pragma unroll
    for (int i = 0; i < 4; i++) { int cidx = lane * 4 + 256 * i; float4 gg = *(const float4*)(p.final_g + cidx);
      *(float4*)(xr + cidx) = float4{v[i].x * rs * gg.x, v[i].y * rs * gg.y, v[i].z * rs * gg.z, v[i].w * rs * gg.w}; }
  }
}
__device__ __forceinline__ void ph_lru_conv(const P& p, int j) {
  const bfr* U = (const bfr*)(p.ACT + A_U); bfr* UC = (bfr*)(p.ACT + A_UC);
  const float* cw = p.lru_conv_w + (size_t)j * 4 * 1280; const float* cb = p.lru_conv_b + (size_t)j * 1280;
  for (int it = xcd_swz(); it < 10400; it += gridDim.x) {
    int idx = it * 512 + ltid(); int row = idx / 160, cgp = idx % 160, ch = cgp * 8;
    int b = row / BT_, o = row - b * BT_; int s0 = o < 256 ? 0 : 256, e0 = o < 256 ? 256 : BT_;
    float acc[8];
#pragma unroll
    for (int e = 0; e < 8; e++) acc[e] = cb[ch + e];
#pragma unroll
    for (int t = 0; t < 4; t++) { int oo = o + t - 2; if (oo < s0 || oo >= e0) continue;
      uint4 u = *(const uint4*)(U + (size_t)(row + t - 2) * 1280 + ch); const float* w = cw + t * 1280 + ch;
      acc[0] += w[0] * blo(u.x); acc[1] += w[1] * bhi(u.x); acc[2] += w[2] * blo(u.y); acc[3] += w[3] * bhi(u.y);
      acc[4] += w[4] * blo(u.z); acc[5] += w[5] * bhi(u.z); acc[6] += w[6] * blo(u.w); acc[7] += w[7] * bhi(u.w); }
    *(uint4*)(UC + (size_t)row * 1280 + ch) = uint4{pk2(acc[0], acc[1]), pk2(acc[2], acc[3]), pk2(acc[4], acc[5]), pk2(acc[6], acc[7])};
  }
}
__device__ __forceinline__ void ph_lru_s1(const P& p, int d) {
  const unsigned* AB = (const unsigned*)(p.ACT + A_AB); float2* AGG = (float2*)(p.ACT + A_AGG);
  const int t = ltid();
  for (int it = xcd_swz() * 8 + (t >> 6); it < 2600; it += gridDim.x * 8) {
    int b = it / 1300, r = it % 1300, cc = r / 5, ch = (r % 5) * 256 + (t & 63) * 4;
    float P0 = 1.f, Q0 = 0.f, P1 = 1.f, Q1 = 0.f, P2 = 1.f, Q2 = 0.f, P3 = 1.f, Q3 = 0.f;
#pragma unroll 8
    for (int q = 0; q < 64; q++) { uint4 u = *(const uint4*)(AB + (size_t)rowmap(d, b, cc * 64 + q) * 1280 + ch);
      float a0 = 1.f - bhi(u.x), a1 = 1.f - bhi(u.y), a2 = 1.f - bhi(u.z), a3 = 1.f - bhi(u.w);
      P0 *= a0; Q0 = a0 * Q0 + blo(u.x); P1 *= a1; Q1 = a1 * Q1 + blo(u.y); P2 *= a2; Q2 = a2 * Q2 + blo(u.z); P3 *= a3; Q3 = a3 * Q3 + blo(u.w); }
    float4* ag = (float4*)(AGG + (size_t)(b * NCH_ + cc) * 1280 + ch); ag[0] = float4{P0, Q0, P1, Q1}; ag[1] = float4{P2, Q2, P3, Q3};
  }
}
__device__ __forceinline__ void ph_lru_s2(const P& p, char* smem) {
  const float2* AGG = (const float2*)(p.ACT + A_AGG); float* CAR = (float*)(p.ACT + A_CAR);
  float* sP = (float*)smem; float* sQ = sP + 512;
  const int tid = ltid(), chl = tid & 63, seg = tid >> 6;
  for (int it = blockIdx.x; it < 40; it += gridDim.x) {
    const int b = it / 20, ch = (it % 20) * 64 + chl; const int cb = seg * 33, ce = cb + 33 < NCH_ ? cb + 33 : NCH_;
    float Pp = 1.f, Q = 0.f;
#pragma unroll 11
    for (int cc = cb; cc < ce; cc++) { float2 a = AGG[(size_t)(b * NCH_ + cc) * 1280 + ch]; Pp *= a.x; Q = a.x * Q + a.y; }
    __syncthreads();
    sP[seg * 64 + chl] = Pp; sQ[seg * 64 + chl] = Q;
    __syncthreads();
    float h = 0.f;
    for (int s2 = 0; s2 < seg; s2++) h = sP[s2 * 64 + chl] * h + sQ[s2 * 64 + chl];
#pragma unroll 11
    for (int cc = cb; cc < ce; cc++) { size_t o = (size_t)(b * NCH_ + cc) * 1280 + ch; float2 a = AGG[o]; CAR[o] = h; h = a.x * h + a.y; }
  }
}
__device__ __forceinline__ void ph_lru_s3(const P& p, int d) {
  const unsigned* AB = (const unsigned*)(p.ACT + A_AB); const float* CAR = (const float*)(p.ACT + A_CAR);
  bfr* HF = (bfr*)(p.ACT + A_HF); bfr* Z = (bfr*)(p.ACT + A_Z);
  const int t = ltid();
  for (int it = xcd_swz() * 8 + (t >> 6); it < 2600; it += gridDim.x * 8) {
    int b = it / 1300, r = it % 1300, cc = r / 5, ch = (r % 5) * 256 + (t & 63) * 4;
    float4 h = *(const float4*)(CAR + (size_t)(b * NCH_ + cc) * 1280 + ch);
#pragma unroll 8
    for (int q = 0; q < 64; q++) { size_t o = (size_t)rowmap(d, b, cc * 64 + q) * 1280 + ch; uint4 u = *(const uint4*)(AB + o);
      h.x = (1.f - bhi(u.x)) * h.x + blo(u.x); h.y = (1.f - bhi(u.y)) * h.y + blo(u.y); h.z = (1.f - bhi(u.z)) * h.z + blo(u.z); h.w = (1.f - bhi(u.w)) * h.w + blo(u.w);
      if (d == 0) *(uint2*)(HF + o) = uint2{pk2(h.x, h.y), pk2(h.z, h.w)};
      else { uint2 hf = *(const uint2*)(HF + o), zz = *(const uint2*)(Z + o);
        *(uint2*)(Z + o) = uint2{pk2((blo(hf.x) + h.x) * siluf(blo(zz.x)), (bhi(hf.x) + h.y) * siluf(bhi(zz.x))), pk2((blo(hf.y) + h.z) * siluf(blo(zz.y)), (bhi(hf.y) + h.w) * siluf(bhi(zz.y)))}; } }
  }
}
__device__ __forceinline__ void ph_ml_stat(const P& p) {
  const bfr* HS = (const bfr*)(p.ACT + A_HS); float* RS = (float*)(p.ACT + A_RSTD);
  const int lane = ltid() & 63, wid = ltid() >> 6;
  for (int it = blockIdx.x; it < 4160; it += gridDim.x) {
    int row = it * 8 + wid; const bfr* hp = HS + (size_t)row * 2048 + lane * 32; float ss = 0.f;
#pragma unroll
    for (int i = 0; i < 4; i++) { uint4 u = *(const uint4*)(hp + i * 8); float a;
      a = blo(u.x); ss += a * a; a = bhi(u.x); ss += a * a; a = blo(u.y); ss += a * a; a = bhi(u.y); ss += a * a;
      a = blo(u.z); ss += a * a; a = bhi(u.z); ss += a * a; a = blo(u.w); ss += a * a; a = bhi(u.w); ss += a * a; }
    ss += __shfl_xor(ss, 1); ss += __shfl_xor(ss, 2); ss += __shfl_xor(ss, 4);
    if ((lane & 7) == 0) RS[(size_t)row * 8 + (lane >> 3)] = rsqrtf(ss * (1.f / 256.f) + 1e-6f);
  }
}
__device__ __forceinline__ void ph_r7_fin(const P& p, int j) {
  bfr* Y = (bfr*)(p.ACT + A_Y); const bfr* RK = (const bfr*)(p.ACT + A_RKVZ); const float* BON = (const float*)(p.ACT + A_BON);
  const float* lg = p.r7_ln_g + (size_t)j * 1024; const float* lb = p.r7_ln_b + (size_t)j * 1024;
  const int lane = ltid() & 63, wid = ltid() >> 6;
  for (int it = blockIdx.x; it < 4160; it += gridDim.x) {
    int row = it * 8 + wid, ch = lane * 16, hd = lane >> 2;
    float y[16], v[16], z[16];
#pragma unroll
    for (int i = 0; i < 2; i++) {
      uint4 u = *(const uint4*)(Y + (size_t)row * 1024 + ch + i * 8); const uint4 u2 = *(const uint4*)(R7_Y2 + (size_t)row * 1024 + ch + i * 8);
      y[i * 8 + 0] = blo(u.x) + blo(u2.x); y[i * 8 + 1] = bhi(u.x) + bhi(u2.x); y[i * 8 + 2] = blo(u.y) + blo(u2.y); y[i * 8 + 3] = bhi(u.y) + bhi(u2.y); y[i * 8 + 4] = blo(u.z) + blo(u2.z); y[i * 8 + 5] = bhi(u.z) + bhi(u2.z); y[i * 8 + 6] = blo(u.w) + blo(u2.w); y[i * 8 + 7] = bhi(u.w) + bhi(u2.w);
      u = *(const uint4*)(RK + (size_t)row * 4096 + 2048 + ch + i * 8);
      v[i * 8 + 0] = blo(u.x); v[i * 8 + 1] = bhi(u.x); v[i * 8 + 2] = blo(u.y); v[i * 8 + 3] = bhi(u.y); v[i * 8 + 4] = blo(u.z); v[i * 8 + 5] = bhi(u.z); v[i * 8 + 6] = blo(u.w); v[i * 8 + 7] = bhi(u.w);
      u = *(const uint4*)(RK + (size_t)row * 4096 + 3072 + ch + i * 8);
      z[i * 8 + 0] = blo(u.x); z[i * 8 + 1] = bhi(u.x); z[i * 8 + 2] = blo(u.y); z[i * 8 + 3] = bhi(u.y); z[i * 8 + 4] = blo(u.z); z[i * 8 + 5] = bhi(u.z); z[i * 8 + 6] = blo(u.w); z[i * 8 + 7] = bhi(u.w);
    }
    float s = 0.f;
#pragma unroll
    for (int e = 0; e < 16; e++) s += y[e];
    s += __shfl_xor(s, 1); s += __shfl_xor(s, 2); float mean = s * (1.f / 64.f);
    float q = 0.f;
#pragma unroll
    for (int e = 0; e < 16; e++) { float dlt = y[e] - mean; q += dlt * dlt; }
    q += __shfl_xor(q, 1); q += __shfl_xor(q, 2); float rs = rsqrtf(q * (1.f / 64.f) + 64e-5f);
    float bon = BON[(size_t)row * 16 + hd] + BON[(size_t)(R_ + row) * 16 + hd];
    float o[16];
#pragma unroll
    for (int e = 0; e < 16; e++) { float yn = (y[e] - mean) * rs * lg[ch + e] + lb[ch + e]; o[e] = (yn + bon * v[e]) * siluf(z[e]); }
#pragma unroll
    for (int i = 0; i < 2; i++)
      *(uint4*)(Y + (size_t)row * 1024 + ch + i * 8) = uint4{pk2(o[i * 8], o[i * 8 + 1]), pk2(o[i * 8 + 2], o[i * 8 + 3]), pk2(o[i * 8 + 4], o[i * 8 + 5]), pk2(o[i * 8 + 6], o[i * 8 + 7])};
  }
}

#define QS 136
#define VS 72
#define MLG_BYTES 47104
__device__ __forceinline__ void ph_ml_scan(const P& p, int j, char* smem0) {
  const int d = ltid() >> 8;
  char* smem = smem0 + d * MLG_BYTES;
  bfr* sQ = (bfr*)smem; bfr* sK = sQ + 64 * QS; bfr* sVT = sK + 64 * QS; bfr* sCT = sVT + 16 * VS;
  float* sN = (float*)(sCT + 16 * QS);
  float* sEs = sN + 128; float* sCt = sEs + 64; float* sBc = sCt + 64; float* sWg = sBc + 64; float* sNr = sWg + 64; bfr* sNb = (bfr*)(sNr + 256); float* sMisc = (float*)(sNb + 128); bfr* sVW = (bfr*)(sMisc + 4);
  const bfr* QKV = (const bfr*)(p.ACT + A_QKV); const float* GT = (const float*)(p.ACT + A_GATE); bfr* HS = (bfr*)(p.ACT + A_HS);
  const float* gbias = p.ml_gate_b + (size_t)j * 32;
  const int tid = ltid() & 255, lane = tid & 63, w = tid >> 6, l15 = lane & 15, q4 = lane >> 4;
  for (int it = xcd_swz(); it < 256; it += gridDim.x) {
    const int b = it >> 7, hh = (it >> 4) & 7, sl = it & 15;
    f32x4 Cacc[2];
    Cacc[0] = f32x4{0.f, 0.f, 0.f, 0.f}; Cacc[1] = f32x4{0.f, 0.f, 0.f, 0.f};
    float mcur = 0.f;
    for (int i = tid; i < 16 * QS; i += 256) sCT[i] = 0;
    if (tid < 128) { sN[tid] = 0.f; sNb[tid] = 0; }
    uint4 pq0, pq1, pq2, pq3, pk0, pk1, pk2, pk3, pv = uint4{0u, 0u, 0u, 0u}; float pgi = 0.f, pgf = 0.f;
#define ML_ROW0(s_) (d == 0 ? b * BT_ + 64 * (s_) : rowmap(1, b, 64 * (s_) + 63))
#define ML_LD(i_, PQ, PK) { int idx = tid + 256 * (i_), rho = idx >> 4, c8 = idx & 15; const bfr* src = QKV + (size_t)(r0n + rho) * 4096 + hh * 128 + c8 * 8; PQ = *(const uint4*)src; PK = *(const uint4*)(src + 1024); }
#define ML_ISSUE(s_) { const int r0n = ML_ROW0(s_); ML_LD(0, pq0, pk0) ML_LD(1, pq1, pk1) ML_LD(2, pq2, pk2) ML_LD(3, pq3, pk3) \
      if (tid < 128) pv = *(const uint4*)(QKV + (size_t)(r0n + (tid >> 1)) * 4096 + 2048 + hh * 256 + sl * 16 + (tid & 1) * 8); \
      if (w == 0) { const float* gp_ = GT + (size_t)(r0n + (d ? 63 - lane : lane)) * 32 + d * 16 + hh; pgi = gp_[0]; pgf = gp_[8]; } }
#define ML_ST(i_, PQ, PK) { int idx = tid + 256 * (i_), rho = idx >> 4, c8 = idx & 15; *(uint4*)(sQ + rho * QS + c8 * 8) = PQ; *(uint4*)(sK + rho * QS + c8 * 8) = PK; }
#define ML_COMMIT() { ML_ST(0, pq0, pk0) ML_ST(1, pq1, pk1) ML_ST(2, pq2, pk2) ML_ST(3, pq3, pk3) \
      if (tid < 128) { int rho = tid >> 1, vb = (tid & 1) * 8; \
        sVT[(vb + 0) * VS + rho] = (bfr)(pv.x & 0xffff); sVT[(vb + 1) * VS + rho] = (bfr)(pv.x >> 16); \
        sVT[(vb + 2) * VS + rho] = (bfr)(pv.y & 0xffff); sVT[(vb + 3) * VS + rho] = (bfr)(pv.y >> 16); \
        sVT[(vb + 4) * VS + rho] = (bfr)(pv.z & 0xffff); sVT[(vb + 5) * VS + rho] = (bfr)(pv.z >> 16); \
        sVT[(vb + 6) * VS + rho] = (bfr)(pv.w & 0xffff); sVT[(vb + 7) * VS + rho] = (bfr)(pv.w >> 16); } }
    ML_ISSUE(0)
    __syncthreads();
    for (int s = 0; s < NCH_; s++) {
      const int r0 = ML_ROW0(s);
      ML_COMMIT()
      if (w == 0) {
        int rho = d ? 63 - lane : lane;
        float gi = pgi + gbias[(d * 2 + 0) * 8 + hh], gf = pgf + gbias[(d * 2 + 1) * 8 + hh];
        float fc = fminf(gf, 0.f) - __logf(1.f + __expf(-fabsf(gf)));
        const float bc = wscan_add(fc);
        const float e = gi - bc, pm = wscan_max(e);
        const float pml = __int_as_float(__builtin_amdgcn_readlane(__float_as_int(pm), 63)), bcl = __int_as_float(__builtin_amdgcn_readlane(__float_as_int(bc), 63));
        const float mx_ = fmaxf(mcur, pml);
        sEs[rho] = __expf(fminf(e, 80.f)); sCt[rho] = -fmaxf(mcur, pm); sBc[rho] = bc; sWg[rho] = __expf(e - mx_);
        if (lane == 0) { sMisc[0] = mcur; sMisc[1] = __expf(mcur - mx_); }
        mcur = bcl + mx_;
      }
      __syncthreads();
      const float mold = sMisc[0], decay = sMisc[1];

      const int rt = 16 * w + l15;
      bfr* hp = HS + (size_t)(r0 + rt) * 2048 + hh * 256 + sl * 16 + 4 * q4;
      bool first; { int rc = (r0 - b * BT_) >> 6; if (d == 0) { int sp = rc < 4 ? 3 - rc : 263 - rc; first = s < sp; } else first = s < rc; }
      unsigned long long uu = 0ull;
      if (!first) uu = __hip_atomic_load((unsigned long long*)hp, __ATOMIC_RELAXED, __HIP_MEMORY_SCOPE_AGENT);
      if (s + 1 < NCH_) ML_ISSUE(s + 1)
      { const int vr = tid >> 4, sg = (tid & 15) * 4; const uint2 vv_ = *(const uint2*)(sVT + vr * VS + sg); const float4 wg4 = *(const float4*)(sWg + sg);
        *(uint2*)(sVW + vr * VS + sg) = uint2{cvtpk(blo(vv_.x) * wg4.x, bhi(vv_.x) * wg4.y), cvtpk(blo(vv_.y) * wg4.z, bhi(vv_.y) * wg4.w)}; }
      bf16x8 qf[4];
#pragma unroll
      for (int ks = 0; ks < 4; ks++) qf[ks] = *(const bf16x8*)(sQ + (16 * w + l15) * QS + ks * 32 + q4 * 8);
      f32x4 sacc[4];
#pragma unroll
      for (int a = 0; a < 4; a++) { sacc[a] = f32x4{0.f, 0.f, 0.f, 0.f};
#pragma unroll
        for (int ks = 0; ks < 4; ks++) { bf16x8 kf = *(const bf16x8*)(sK + (16 * a + l15) * QS + ks * 32 + q4 * 8); sacc[a] = __builtin_amdgcn_mfma_f32_16x16x32_bf16(kf, qf[ks], sacc[a], 0, 0, 0); } }
      const float ctt = sCt[rt]; const float ect = __expf(ctt); float densum = 0.f;
#pragma unroll
      for (int a = 0; a < 4; a++) { const float4 ex4 = *(const float4*)(sEs + 16 * a + 4 * q4); const float exv[4] = {ex4.x, ex4.y, ex4.z, ex4.w};
#pragma unroll
        for (int jj = 0; jj < 4; jj++) { int rs_ = 16 * a + 4 * q4 + jj; bool valid = d == 0 ? rs_ <= rt : rs_ >= rt;
          float wv = valid ? ect * exv[jj] : 0.f; float sv = sacc[a][jj] * wv; sacc[a][jj] = sv; densum += sv; } }
      densum += __shfl_xor(densum, 16); densum += __shfl_xor(densum, 32);
      bf16x8 sf[2], vf[2];
#pragma unroll
      for (int ks = 0; ks < 2; ks++) {
#pragma unroll
        for (int jj = 0; jj < 4; jj++) { sf[ks][jj] = (short)f2b(sacc[2 * ks][jj]); sf[ks][4 + jj] = (short)f2b(sacc[2 * ks + 1][jj]); }
        uint2 v0 = *(const uint2*)(sVT + l15 * VS + 32 * ks + 4 * q4), v1 = *(const uint2*)(sVT + l15 * VS + 32 * ks + 16 + 4 * q4);
        uint4 vv = uint4{v0.x, v0.y, v1.x, v1.y}; vf[ks] = *(bf16x8*)&vv;
      }
      f32x4 num = f32x4{0.f, 0.f, 0.f, 0.f}, numC = f32x4{0.f, 0.f, 0.f, 0.f};
#pragma unroll
      for (int ks = 0; ks < 2; ks++) num = __builtin_amdgcn_mfma_f32_16x16x32_bf16(vf[ks], sf[ks], num, 0, 0, 0);
#pragma unroll
      for (int ks = 0; ks < 4; ks++) { bf16x8 cf = *(const bf16x8*)(sCT + l15 * QS + ks * 32 + q4 * 8); numC = __builtin_amdgcn_mfma_f32_16x16x32_bf16(cf, qf[ks], numC, 0, 0, 0); }
      f32x4 qnacc = f32x4{0.f, 0.f, 0.f, 0.f};
#pragma unroll
      for (int ks = 0; ks < 4; ks++) { bf16x8 na = bf16x8{0, 0, 0, 0, 0, 0, 0, 0}; if (l15 == 0) na = *(const bf16x8*)(sNb + ks * 32 + q4 * 8);
        qnacc = __builtin_amdgcn_mfma_f32_16x16x32_bf16(na, qf[ks], qnacc, 0, 0, 0); }
      const float qn = __shfl(qnacc[0], l15);
      {
        float inter = __expf(mold + ctt); float den = densum + inter * qn; float dn = fmaxf(fabsf(den), __expf(ctt - sBc[rt])); float inv = __builtin_amdgcn_rcpf(dn);
        f32x4 hv;
#pragma unroll
        for (int jj = 0; jj < 4; jj++) hv[jj] = (num[jj] + inter * numC[jj]) * inv;
        if (!first) { unsigned ux = (unsigned)uu, uy = (unsigned)(uu >> 32);
          hv[0] += blo(ux); hv[1] += bhi(ux); hv[2] += blo(uy); hv[3] += bhi(uy); }
        store4b(hp, hv);
      }
      __syncthreads();
      {
        bf16x8 vw[2], wa[2];
#pragma unroll
        for (int ks = 0; ks < 2; ks++) {
          const uint2 v0 = *(const uint2*)(sVW + l15 * VS + 32 * ks + 4 * q4), v1 = *(const uint2*)(sVW + l15 * VS + 32 * ks + 16 + 4 * q4);
          uint4 vv = uint4{v0.x, v0.y, v1.x, v1.y}; vw[ks] = *(bf16x8*)&vv;
          uint4 wz = uint4{0u, 0u, 0u, 0u};
          if (l15 == 0) { const float4 g0 = *(const float4*)(sWg + 32 * ks + 4 * q4), g1 = *(const float4*)(sWg + 32 * ks + 16 + 4 * q4); wz = uint4{cvtpk(g0.x, g0.y), cvtpk(g0.z, g0.w), cvtpk(g1.x, g1.y), cvtpk(g1.z, g1.w)}; }
          wa[ks] = *(bf16x8*)&wz; }
#pragma unroll
        for (int a = 0; a < 2; a++) {
          int dk = 32 * w + 16 * a + l15;
#pragma unroll
          for (int jj = 0; jj < 4; jj++) Cacc[a][jj] *= decay;
          f32x4 nacc = f32x4{0.f, 0.f, 0.f, 0.f};
#pragma unroll
          for (int ks = 0; ks < 2; ks++) { bf16x8 kt;
#pragma unroll
            for (int e = 0; e < 8; e++) { int rs_ = 32 * ks + (e < 4 ? 4 * q4 + e : 16 + 4 * q4 + e - 4); kt[e] = (short)sK[rs_ * QS + dk]; }
            Cacc[a] = __builtin_amdgcn_mfma_f32_16x16x32_bf16(vw[ks], kt, Cacc[a], 0, 0, 0);
            nacc = __builtin_amdgcn_mfma_f32_16x16x32_bf16(wa[ks], kt, nacc, 0, 0, 0); }
          if (q4 == 0) sNr[dk] = nacc[0];
#pragma unroll
          for (int jj = 0; jj < 4; jj++) sCT[(4 * q4 + jj) * QS + dk] = f2b(Cacc[a][jj]);
        }
      }
      __syncthreads();
      if (tid < 128) { const float nv = decay * sN[tid] + sNr[tid]; sN[tid] = nv; sNb[tid] = f2b(nv); }
    }
    __syncthreads();
  }
}

#define CS 72
#define CSLOT(i_) ((bfr*)smem + (i_) * (64 * CS))
#define A_SST (A_R7B + 362086400ull)
__device__ __forceinline__ f32x4 cmm(const bfr* X, const bfr* YT, int ti, int tj, int l15, int q4) {
  f32x4 acc = f32x4{0.f, 0.f, 0.f, 0.f};
#pragma unroll
  for (int ks = 0; ks < 2; ks++) { bf16x8 a = *(const bf16x8*)(X + (16 * ti + l15) * CS + 32 * ks + 8 * q4); bf16x8 b = *(const bf16x8*)(YT + (16 * tj + l15) * CS + 32 * ks + 8 * q4);
    acc = __builtin_amdgcn_mfma_f32_16x16x32_bf16(a, b, acc, 0, 0, 0); }
  return acc;
}
template <int MODE> __device__ __forceinline__ f32x4 cmm_mask(const bfr* X, const bfr* YT, int ti, int tj, int l15, int q4) {
  f32x4 acc = f32x4{0.f, 0.f, 0.f, 0.f};
#pragma unroll
  for (int ks = 0; ks < 2; ks++) { const int kb = 2 * ks + (q4 >> 1);
    const bool ok = MODE == 1 ? ((kb == 0 && tj == 1) || (kb == 2 && tj == 3)) : (kb < 2 && tj >= 2);
    bf16x8 a = *(const bf16x8*)(X + (16 * ti + l15) * CS + 32 * ks + 8 * q4); bf16x8 bz = bf16x8{0, 0, 0, 0, 0, 0, 0, 0};
    if (ok) bz = *(const bf16x8*)(YT + (16 * tj + l15) * CS + 32 * ks + 8 * q4);
    acc = __builtin_amdgcn_mfma_f32_16x16x32_bf16(a, bz, acc, 0, 0, 0); }
  return acc;
}
__device__ __forceinline__ void st_row(bfr* dst, int r0, int c, f32x4 v) {
#pragma unroll
  for (int jj = 0; jj < 4; jj++) dst[(r0 + jj) * CS + c] = f2b(v[jj]); }
__device__ __forceinline__ void st_tr(bfr* dst, int r0, int c, f32x4 v) { store4b(dst + c * CS + r0, v); }
__device__ __forceinline__ f32x4 ld_row(const bfr* src, int r0, int c) { f32x4 v;
#pragma unroll
  for (int jj = 0; jj < 4; jj++) v[jj] = b2f(src[(r0 + jj) * CS + c]);
  return v; }
__device__ __forceinline__ f32x4 ld_tr(const bfr* src, int r0, int c) { uint2 u = *(const uint2*)(src + c * CS + r0); return f32x4{blo(u.x), bhi(u.x), blo(u.y), bhi(u.y)}; }

__device__ __forceinline__ void ph_r7_ca(const P& p, int j, int win, char* smem) {
  float* LW = (float*)(smem + 7 * 9216); float* AT = (float*)(smem + 9 * 9216); float* WL = (float*)(smem + 14 * 9216);
  const bfr* RK = (const bfr*)(p.ACT + A_RKVZ); const bfr* WMb = (const bfr*)(p.ACT + A_WM); const bfr* AMb = (const bfr*)(p.ACT + A_AM);
  float* BON = (float*)(p.ACT + A_BON); bfr* WB = p.H;
  const float* kkp = p.r7_k_k + (size_t)j * 1024; const float* kap = p.r7_k_a + (size_t)j * 1024; const float* rkp = p.r7_r_k + (size_t)j * 1024;
  const int tid = ltid(), lane = tid & 63, w = tid >> 6, l15 = lane & 15, q4 = lane >> 4, ti = w >> 1, tj0 = (w & 1) * 2;
  const int c0 = win * 20;
  for (int it = blockIdx.x; it < 1280; it += gridDim.x) {
    const int chain = it / 20, cl = it - chain * 20, c = c0 + cl, d = chain & 1, b = chain >> 5, h = (chain >> 1) & 15;
    {
      const int rowA = rowmap(d, b, 64 * c + 16 * ti + l15);
      const float* w0 = p.r7_w0 + (size_t)(j * 2 + d) * 1024 + h * 64; const float* a0 = p.r7_a0 + (size_t)(j * 2 + d) * 1024 + h * 64;
#pragma unroll
      for (int tt = 0; tt < 2; tt++) { const int tj = tj0 + tt; f32x4 aw = f32x4{0.f, 0.f, 0.f, 0.f}, aa = aw;
#pragma unroll
        for (int ks = 0; ks < 2; ks++) {
          bf16x8 xw = *(const bf16x8*)(WMb + (size_t)rowA * 128 + d * 64 + 32 * ks + 8 * q4), xa = *(const bf16x8*)(AMb + (size_t)rowA * 128 + d * 64 + 32 * ks + 8 * q4);
          bf16x8 yw = *(const bf16x8*)(p.W + WR_UP + d * 65536 + (size_t)(h * 64 + 16 * tj + l15) * 64 + 32 * ks + 8 * q4);
          bf16x8 ya = *(const bf16x8*)(p.W + WR_UP + (2 + d) * 65536 + (size_t)(h * 64 + 16 * tj + l15) * 64 + 32 * ks + 8 * q4);
          aw = __builtin_amdgcn_mfma_f32_16x16x32_bf16(xw, yw, aw, 0, 0, 0); aa = __builtin_amdgcn_mfma_f32_16x16x32_bf16(xa, ya, aa, 0, 0, 0); }
        const int ch = 16 * tj + l15; const float w0v = w0[ch], a0v = a0[ch];
#pragma unroll
        for (int jj = 0; jj < 4; jj++) { const int tau = 16 * ti + 4 * q4 + jj; LW[tau * 64 + ch] = -0.6065306597126334f * sigm(w0v + aw[jj]); AT[tau * 64 + ch] = sigm(a0v + aa[jj]); }
      }
    }
    __syncthreads();
    if (tid < 64) { float acc = 0.f;
#pragma unroll 8
      for (int t = 0; t < 64; t++) { acc += LW[t * 64 + tid]; LW[t * 64 + tid] = acc; } }
    __syncthreads();
    {
      const int tau = tid >> 3, sc = tid & 7, col = h * 64 + sc * 8; const int row = rowmap(d, b, 64 * c + tau);
      const bfr* rp = RK + (size_t)row * 4096 + col; uint4 pr = *(const uint4*)rp, pk = *(const uint4*)(rp + 1024);
      unsigned ur[4] = {pr.x, pr.y, pr.z, pr.w}, uk[4] = {pk.x, pk.y, pk.z, pk.w};
      float r8[8], k8[8], kr[8];
#pragma unroll
      for (int e = 0; e < 4; e++) { r8[2 * e] = blo(ur[e]); r8[2 * e + 1] = bhi(ur[e]); k8[2 * e] = blo(uk[e]); k8[2 * e + 1] = bhi(uk[e]); }
      float ss = 0.f;
#pragma unroll
      for (int e = 0; e < 8; e++) { kr[e] = k8[e] * kkp[col + e]; ss += kr[e] * kr[e]; }
      ss += __shfl_xor(ss, 1); ss += __shfl_xor(ss, 2); ss += __shfl_xor(ss, 4);
      const float inv = __builtin_amdgcn_rsqf(fmaxf(ss, 1e-24f));
      float bon = 0.f, o0[8], o1[8], o2[8], o3[8], o4[8], o5[8];
#pragma unroll
      for (int e = 0; e < 8; e++) {
        const float cw = LW[tau * 64 + sc * 8 + e], cwm = tau > 0 ? LW[(tau - 1) * 64 + sc * 8 + e] : 0.f, cwl = LW[63 * 64 + sc * 8 + e], a = AT[tau * 64 + sc * 8 + e];
        const float ka = kr[e] * inv, be = a * ka, kd = k8[e] * (1.f + (a - 1.f) * kap[col + e]); bon += r8[e] * kd * rkp[col + e];
        const float e2 = __expf(-cw), e4 = __expf(cwl - cw);
        o0[e] = ka * __expf(cwm); o1[e] = be * e2; o2[e] = kd * e2; o3[e] = r8[e] * __expf(cw); o4[e] = be * e4; o5[e] = kd * e4;
        if (tau == 63) WL[sc * 8 + e] = __expf(cwl);
      }
      bon += __shfl_xor(bon, 1); bon += __shfl_xor(bon, 2); bon += __shfl_xor(bon, 4);
      if (sc == 0) BON[((size_t)d * R_ + row) * 16 + h] = bon;
      *(uint4*)(CSLOT(0) + tau * CS + sc * 8) = uint4{pk2(o0[0], o0[1]), pk2(o0[2], o0[3]), pk2(o0[4], o0[5]), pk2(o0[6], o0[7])};
      *(uint4*)(CSLOT(1) + tau * CS + sc * 8) = uint4{pk2(o1[0], o1[1]), pk2(o1[2], o1[3]), pk2(o1[4], o1[5]), pk2(o1[6], o1[7])};
      *(uint4*)(CSLOT(2) + tau * CS + sc * 8) = uint4{pk2(o2[0], o2[1]), pk2(o2[2], o2[3]), pk2(o2[4], o2[5]), pk2(o2[6], o2[7])};
      *(uint4*)(CSLOT(3) + tau * CS + sc * 8) = uint4{pk2(o3[0], o3[1]), pk2(o3[2], o3[3]), pk2(o3[4], o3[5]), pk2(o3[6], o3[7])};
#pragma unroll
      for (int e = 0; e < 8; e++) { CSLOT(4)[(sc * 8 + e) * CS + tau] = f2b(o0[e]); CSLOT(5)[(sc * 8 + e) * CS + tau] = f2b(o4[e]); CSLOT(6)[(sc * 8 + e) * CS + tau] = f2b(o5[e]); }
    }
    __syncthreads();
#pragma unroll
    for (int tt = 0; tt < 2; tt++) { const int tj = tj0 + tt, r0 = 16 * ti + 4 * q4, cc = 16 * tj + l15;
      f32x4 v = cmm(CSLOT(1), CSLOT(0), ti, tj, l15, q4);
#pragma unroll
      for (int jj = 0; jj < 4; jj++) if (!(r0 + jj < cc)) v[jj] = 0.f;
      st_row(CSLOT(7), r0, cc, v); st_tr(CSLOT(8), r0, cc, v);
      v = cmm(CSLOT(2), CSLOT(0), ti, tj, l15, q4);
#pragma unroll
      for (int jj = 0; jj < 4; jj++) if (!(r0 + jj < cc)) v[jj] = 0.f;
      st_row(CSLOT(9), r0, cc, v);
      v = cmm(CSLOT(3), CSLOT(1), ti, tj, l15, q4);
#pragma unroll
      for (int jj = 0; jj < 4; jj++) if (!(cc <= r0 + jj)) v[jj] = 0.f;
      st_row(CSLOT(10), r0, cc, v);
      v = cmm(CSLOT(3), CSLOT(2), ti, tj, l15, q4);
#pragma unroll
      for (int jj = 0; jj < 4; jj++) if (!(cc <= r0 + jj)) v[jj] = 0.f;
      st_row(CSLOT(11), r0, cc, v);
    }
    __syncthreads();
    {
      float* X = (float*)CSLOT(0);
      const bfr* Ab = CSLOT(7);
      const int cl = lane >> 3, pp = lane & 7, cx = 8 * w + cl, blk0 = (w >> 1) * 16;
#pragma unroll 1
      for (int il = 15; il >= 0; il--) { const int i = blk0 + il;
        float sum = 0.f;
#pragma unroll 1
        for (int jx = i + 1 + pp; jx < blk0 + 16; jx += 8) sum += b2f(Ab[i * CS + jx]) * X[jx * 72 + cx];
        sum += dppf<0xB1>(sum); sum += dppf<0x4E>(sum); sum += dppf<0x141>(sum);
        const float xv = (i == cx ? 1.f : 0.f) - sum;
        if (pp == 0) X[i * 72 + cx] = xv;
      }
      __syncthreads();
#pragma unroll 1
      for (int e = tid; e < 4096; e += 512) { const int i = e >> 6, c2 = e & 63; const bfr tv = ((i >> 4) == (c2 >> 4)) ? f2b(X[i * 72 + c2]) : (bfr)0; CSLOT(2)[i * CS + c2] = tv; CSLOT(12)[c2 * CS + i] = tv; }
      __syncthreads();
#pragma unroll
      for (int tt = 0; tt < 2; tt++) { const int tj = tj0 + tt, r0 = 16 * ti + 4 * q4, cc = 16 * tj + l15; st_row(CSLOT(13), r0, cc, cmm_mask<1>(CSLOT(2), CSLOT(8), ti, tj, l15, q4)); }
      __syncthreads();
#pragma unroll
      for (int tt = 0; tt < 2; tt++) { const int tj = tj0 + tt, r0 = 16 * ti + 4 * q4, cc = 16 * tj + l15;
        f32x4 v = ld_row(CSLOT(2), r0, cc) - cmm(CSLOT(13), CSLOT(12), ti, tj, l15, q4); st_row(CSLOT(0), r0, cc, v); st_tr(CSLOT(1), r0, cc, v); }
      __syncthreads();
#pragma unroll
      for (int tt = 0; tt < 2; tt++) { const int tj = tj0 + tt, r0 = 16 * ti + 4 * q4, cc = 16 * tj + l15; st_row(CSLOT(13), r0, cc, cmm_mask<2>(CSLOT(0), CSLOT(8), ti, tj, l15, q4)); }
      __syncthreads();
#pragma unroll
      for (int tt = 0; tt < 2; tt++) { const int tj = tj0 + tt, r0 = 16 * ti + 4 * q4, cc = 16 * tj + l15;
        f32x4 v = ld_row(CSLOT(0), r0, cc) - cmm(CSLOT(13), CSLOT(1), ti, tj, l15, q4);
#pragma unroll
        for (int jj = 0; jj < 4; jj++) if (r0 + jj == cc) v[jj] -= 1.f;
        st_row(CSLOT(2), r0, cc, v); }
      __syncthreads();
    }
#pragma unroll
    for (int tt = 0; tt < 2; tt++) { const int tj = tj0 + tt, r0 = 16 * ti + 4 * q4, cc = 16 * tj + l15;
      f32x4 g = cmm(CSLOT(10), CSLOT(2), ti, tj, l15, q4) + ld_row(CSLOT(10), r0, cc); st_row(CSLOT(12), r0, cc, g);
      f32x4 hh = cmm(CSLOT(5), CSLOT(2), ti, tj, l15, q4) + ld_row(CSLOT(5), r0, cc); st_row(CSLOT(13), r0, cc, hh); }
    __syncthreads();
    {
      bfr* out = WB + (size_t)(chain * 20 + cl) * 16384;
#pragma unroll
      for (int tt = 0; tt < 2; tt++) { const int tj = tj0 + tt, r0 = 16 * ti + 4 * q4, cc = 16 * tj + l15;
        f32x4 v = ld_tr(CSLOT(3), r0, cc) - cmm(CSLOT(4), CSLOT(12), ti, tj, l15, q4);
        store4b(out + cc * 64 + r0, v);
        v = ld_tr(CSLOT(11), r0, cc) - cmm(CSLOT(9), CSLOT(12), ti, tj, l15, q4);
        store4b(out + 4096 + cc * 64 + r0, v);
        v = -cmm(CSLOT(4), CSLOT(13), ti, tj, l15, q4);
#pragma unroll
        for (int jj = 0; jj < 4; jj++) if (r0 + jj == cc) v[jj] += WL[cc];
        store4b(out + 8192 + cc * 64 + r0, v);
        v = ld_tr(CSLOT(6), r0, cc) - cmm(CSLOT(9), CSLOT(13), ti, tj, l15, q4);
        store4b(out + 12288 + cc * 64 + r0, v);
      }
    }
    __syncthreads();
  }
}

__device__ __forceinline__ void ph_r7_cb(const P& p, int win, char* smem) {
  bfr* Sh = (bfr*)smem; bfr* Sl = Sh + 2 * 16 * CS; bfr* VT = Sl + 2 * 16 * CS;
  const bfr* WB = p.H; const bfr* RK = (const bfr*)(p.ACT + A_RKVZ); bfr* SST = (bfr*)(p.ACT + A_SST);
  const int tid = ltid(), lane = tid & 63, w = tid >> 6, l15 = lane & 15, q4 = lane >> 4;
  const int c0 = win * 20;
  for (int it = xcd_swz(); it < 256; it += gridDim.x) {
    const int d = it & 1, b = it >> 7, h = (it >> 3) & 15, rg = (it >> 1) & 3, chain = (b * 16 + h) * 2 + d;
    bfr* Y = d ? R7_Y2 : (bfr*)(p.ACT + A_Y);
    bfr* sst = SST + (size_t)(chain * 4 + rg) * 2048;
    __syncthreads();
    if (tid < 256) { const int hl = tid >> 7, e = tid & 127, rr = e >> 3, c8 = e & 7; uint4 v = uint4{0u, 0u, 0u, 0u};
      if (win > 0) v = *(const uint4*)(sst + hl * 1024 + rr * 64 + c8 * 8);
      *(uint4*)((hl ? Sl : Sh) + rr * CS + c8 * 8) = v; }
    const int vtau = tid >> 3, vp = tid & 7;
    { const int row = rowmap(d, b, 64 * c0 + vtau); unsigned vv = *(const unsigned*)(RK + (size_t)row * 4096 + 2048 + h * 64 + rg * 16 + 2 * vp);
      VT[(2 * vp) * CS + vtau] = (bfr)(vv & 0xffff); VT[(2 * vp + 1) * CS + vtau] = (bfr)(vv >> 16); }
    const bfr* bbase = WB + (size_t)(chain * 20) * 16384 + (w < 4 ? 8192 + (16 * w + l15) * 64 : (16 * (w - 4) + l15) * 64) + 8 * q4;
    bf16x8 rb1[4][2], rb2[4][2]; unsigned rv[4];
#define CB_LOAD(u_, s_) { const int ss_ = (s_) < 20 ? (s_) : 19; const bfr* bp_ = bbase + (size_t)ss_ * 16384; \
      rb1[u_][0] = *(const bf16x8*)bp_; rb1[u_][1] = *(const bf16x8*)(bp_ + 32); rb2[u_][0] = *(const bf16x8*)(bp_ + 4096); rb2[u_][1] = *(const bf16x8*)(bp_ + 4096 + 32); \
      const int sv_ = ss_ + 1 < 20 ? ss_ + 1 : 19; const int rowv_ = rowmap(d, b, 64 * (c0 + sv_) + vtau); \
      rv[u_] = *(const unsigned*)(RK + (size_t)rowv_ * 4096 + 2048 + h * 64 + rg * 16 + 2 * vp); }
    CB_LOAD(0, 0) CB_LOAD(1, 1) CB_LOAD(2, 2) CB_LOAD(3, 3)
    __syncthreads();
    for (int g = 0; g < 5; g++) {
#pragma unroll
      for (int u = 0; u < 4; u++) {
        const int s = 4 * g + u;
        if (s < 20) {
          const int cur = s & 1, nxt = cur ^ 1, c = c0 + s;
          bf16x8 sh[2], sl[2], vt[2];
#pragma unroll
          for (int ks = 0; ks < 2; ks++) { sh[ks] = *(const bf16x8*)(Sh + (cur * 16 + l15) * CS + 32 * ks + 8 * q4); sl[ks] = *(const bf16x8*)(Sl + (cur * 16 + l15) * CS + 32 * ks + 8 * q4);
            vt[ks] = *(const bf16x8*)(VT + (cur * 16 + l15) * CS + 32 * ks + 8 * q4); }
          f32x4 a1 = f32x4{0.f, 0.f, 0.f, 0.f}, a2 = a1;
#pragma unroll
          for (int ks = 0; ks < 2; ks++) { a1 = __builtin_amdgcn_mfma_f32_16x16x32_bf16(sh[ks], rb1[u][ks], a1, 0, 0, 0); a2 = __builtin_amdgcn_mfma_f32_16x16x32_bf16(vt[ks], rb2[u][ks], a2, 0, 0, 0); }
#pragma unroll
          for (int ks = 0; ks < 2; ks++) a1 = __builtin_amdgcn_mfma_f32_16x16x32_bf16(sl[ks], rb1[u][ks], a1, 0, 0, 0);
          a1 = a1 + a2;
          if (w < 4) {
#pragma unroll
            for (int jj = 0; jj < 4; jj++) { const bfr hi = f2b(a1[jj]); Sh[(nxt * 16 + 4 * q4 + jj) * CS + 16 * w + l15] = hi; Sl[(nxt * 16 + 4 * q4 + jj) * CS + 16 * w + l15] = f2b(a1[jj] - b2f(hi)); }
          } else {
            const int rowy = rowmap(d, b, 64 * c + 16 * (w - 4) + l15);
            store4b(Y + (size_t)rowy * 1024 + h * 64 + rg * 16 + 4 * q4, a1);
          }
          if (s + 1 < 20) { VT[(nxt * 16 + 2 * vp) * CS + vtau] = (bfr)(rv[u] & 0xffff); VT[(nxt * 16 + 2 * vp + 1) * CS + vtau] = (bfr)(rv[u] >> 16); }
          if (s + 4 < 20) CB_LOAD(u, s + 4)
          __syncthreads();
        }
      }
    }
    if (tid < 256) { const int hl = tid >> 7, e = tid & 127, rr = e >> 3, c8 = e & 7; *(uint4*)(sst + hl * 1024 + rr * 64 + c8 * 8) = *(const uint4*)((hl ? Sl : Sh) + rr * CS + c8 * 8); }
  }
}

__device__ __forceinline__ void run_phase(const P& p, int ph, int layer, int d, char* smem) {
  Ctx c; c.layer = layer; c.j = layer / 3; c.d = d; c.wc = layer < 3 ? 1 : 0;
  switch (ph) {
    case PH_PRE: ph_pre(p, smem); break;
    case PH_NORM: ph_norm(p, layer, smem); break;
    case PH_LRU_IN: big_gemm(smem, p.H, p.W, 2560, 1024, F_LruIn{p.ACT}); break;
    case PH_LRU_CONV: ph_lru_conv(p, c.j); break;
    case PH_LRU_GATE: gemm_phase_k2<G_LruGate>(p, c, smem); break;
    case PH_LRU_S1: ph_lru_s1(p, d); break;
    case PH_LRU_S2: ph_lru_s2(p, smem); break;
    case PH_LRU_S3: ph_lru_s3(p, d); break;
    case PH_LRU_OUT: big_gemm(smem, (const bfr*)(p.ACT + A_Z), p.W + WL_OUT, 1024, 1280, F_Resid{p.Xx, p.Xc, p.MOD + (size_t)layer * 3 * 3072, c.wc}); break;
    case PH_ML_IN: big_gemm(smem, p.H, p.W, 4352, 1024, F_MlIn{p.ACT}); break;
    case PH_ML_SCAN: ph_ml_scan(p, c.j, smem); break;
    case PH_ML_STAT: ph_ml_stat(p); break;
    case PH_ML_Z: big_gemm(smem, p.H, p.W + WM_Z, 2048, 1024, F_MlZ{p.ACT, p.ml_norm_g + (size_t)c.j * 2048}); break;
    case PH_ML_OUT: big_gemm(smem, (const bfr*)(p.ACT + A_HS), p.W + WM_OUT, 1024, 2048, F_Resid{p.Xx, p.Xc, p.MOD + (size_t)layer * 3 * 3072, c.wc}); break;
    case PH_R7_IN: big_gemm(smem, p.H, p.W, 4352, 2048, F_R7In{p.ACT}); break;
    case PH_R7_SHIFT: ph_r7_shift(p); break;
    case PH_R7_CA: ph_r7_ca(p, c.j, d, smem); break;
    case PH_R7_CB: ph_r7_cb(p, d, smem); break;
    case PH_R7_FIN: ph_r7_fin(p, c.j); break;
    case PH_R7_OUT: big_gemm(smem, (const bfr*)(p.ACT + A_Y), p.W + WR_OUT, 1024, 1024, F_Resid{p.Xx, p.Xc, p.MOD + (size_t)layer * 3 * 3072, c.wc}); break;
    case PH_FINAL: ph_final(p); break;
  }
}


#define XB_TMO      128
#define XB_XCNT(j)  (256  + 64 * (j))
#define XB_XSUB(j)  (1280 + 64 * (j))
#define XB_XGEN(j)  (2304 + 64 * (j))
#define XB_TOP      3328
#define XB_TOPGEN   3392
#define XCD_BAR_WORDS 3456
#define XB_SPIN_CAP (1u << 18)
#define OFF_BAR 527000064ull
#define OFF_CL (OFF_BAR + 16384ull)
__device__ __forceinline__ unsigned xb_ld(unsigned* p)              { return __hip_atomic_load(p, __ATOMIC_RELAXED, __HIP_MEMORY_SCOPE_AGENT); }
__device__ __forceinline__ unsigned xb_add(unsigned* p, unsigned v) { return __hip_atomic_fetch_add(p, v, __ATOMIC_RELAXED, __HIP_MEMORY_SCOPE_AGENT); }
__device__ __forceinline__ unsigned xb_xcc_id() { return (unsigned)__builtin_amdgcn_s_getreg((3 << 11) | 20) & 0xFu; }
#define XB_SPIN(cond, bar) do { unsigned _sp = 0; while (cond) { __builtin_amdgcn_s_sleep(1); \
    if ((++_sp & 255u) == 0u) { if (xb_ld(&(bar)[XB_TMO])) break; if (_sp > XB_SPIN_CAP) { atomicAdd(&(bar)[XB_TMO], 1u); break; } } } } while (0)
struct XcdBarrier { unsigned* bar; unsigned x; volatile __attribute__((address_space(3))) unsigned* st; };
__device__ __forceinline__ XcdBarrier xcd_barrier_post(unsigned* bar, volatile __attribute__((address_space(3))) unsigned* st) {
  XcdBarrier b; b.bar = bar; b.x = xb_xcc_id(); b.st = st;
  if (threadIdx.x == 0) (void)xb_add(&bar[XB_XCNT(b.x)], 1u);
  return b;
}
__device__ __forceinline__ void xcd_barrier_complete(unsigned* bar, unsigned x, unsigned& nloc, unsigned& nx) {
  const unsigned G = gridDim.x * gridDim.y * gridDim.z;
  unsigned sum, cnt, mine, sp = 0u;
  for (;;) {
    sum = 0u; cnt = 0u; mine = 0u;
#pragma unroll
    for (unsigned j = 0; j < 16; ++j) { const unsigned c = xb_ld(&bar[XB_XCNT(j)]); sum += c; cnt += (c > 0u) ? 1u : 0u; mine = (j == x) ? c : mine; }
    if (sum == G) break;
    __builtin_amdgcn_s_sleep(1);
    if ((++sp & 255u) == 0u) { if (xb_ld(&bar[XB_TMO])) break; if (sp > XB_SPIN_CAP) { atomicAdd(&bar[XB_TMO], 1u); break; } }
  }
  nloc = mine > 0u ? mine : 1u; nx = cnt > 0u ? cnt : 1u;
}
__device__ __forceinline__ void xcd_barrier(const XcdBarrier& b) {
  asm volatile("s_waitcnt vmcnt(0)" ::: "memory");
  __syncthreads();
  if (threadIdx.x == 0) {
    unsigned* bar = b.bar;
    __builtin_amdgcn_s_waitcnt(0);
    unsigned nloc = b.st[0], nx = b.st[1];
    if (nloc == 0u) { xcd_barrier_complete(bar, b.x, nloc, nx); b.st[0] = nloc; b.st[1] = nx; }
    const unsigned old = xb_add(&bar[XB_XSUB(b.x)], 1u);
    const unsigned gen = old / nloc;
    if (old + 1u == (gen + 1u) * nloc) {
      __builtin_amdgcn_fence(__ATOMIC_RELEASE, "agent");
      asm volatile("s_waitcnt vmcnt(0)" ::: "memory");
      const unsigned og = xb_add(&bar[XB_TOP], 1u);
      const unsigned tg = og / nx;
      if (og + 1u == (tg + 1u) * nx) xb_add(&bar[XB_TOPGEN], 1u);
      else XB_SPIN(xb_ld(&bar[XB_TOPGEN]) == tg, bar);
      __builtin_amdgcn_fence(__ATOMIC_ACQUIRE, "agent");
      xb_add(&bar[XB_XGEN(b.x)], 1u);
      asm volatile("s_waitcnt vmcnt(0)" ::: "memory");
    } else {
      XB_SPIN(xb_ld(&bar[XB_XGEN(b.x)]) == gen, bar);
      __builtin_amdgcn_fence(__ATOMIC_ACQUIRE, "agent");
      asm volatile("s_waitcnt vmcnt(0)" ::: "memory");
    }
  }
  __syncthreads();
}

#define SMEM_BYTES (131072 + 64)
extern __shared__ __attribute__((aligned(16))) char dyn_smem[];
#if !MEGA
__global__ void __launch_bounds__(512, 2) phase_kernel(P p, int si) {
  run_phase(p, p.sched[si * 3], p.sched[si * 3 + 1], p.sched[si * 3 + 2], dyn_smem);
}
#else
__global__ void __launch_bounds__(512, 2) mega_kernel(P p) {
  cg::grid_group grid = cg::this_grid();
  volatile __attribute__((address_space(3))) unsigned* st = (volatile __attribute__((address_space(3))) unsigned*)(dyn_smem + 131072);
  if (threadIdx.x < 4) st[threadIdx.x] = 0u;
  __syncthreads();
  const XcdBarrier xb = xcd_barrier_post(p.bar, st);
  for (int si = 0; si < p.nsched; si++) {
    run_phase(p, p.sched[si * 3], p.sched[si * 3 + 1], p.sched[si * 3 + 2], dyn_smem);
    if (si + 1 < p.nsched) { if (p.pad_ != 0) grid.sync(); xcd_barrier(xb); }
  }
}
#endif

extern "C" void kernel_launch(void* const* d_in, const int* in_sizes, int n_in, void* d_out, int out_size, void* d_ws, size_t ws_size, hipStream_t stream) {
  P p; memset(&p, 0, sizeof(p));
  const float** f = (const float**)&p;
  for (int i = 0; i < 33; i++) f[i] = (const float*)d_in[i];
  char* ws = (char*)d_ws;
  p.Xx = (float*)d_out; p.Xc = (float*)(ws + OFF_XC); p.MOD = (float*)(ws + OFF_MOD); p.W = (bfr*)(ws + OFF_W); p.H = (bfr*)(ws + OFF_H); p.ACT = ws + OFF_ACT; p.bar = (unsigned*)(ws + OFF_BAR); p.CL = (float*)(ws + OFF_CL);
  int n = 0;
  auto add = [&](int ph, int layer, int d) { p.sched[n * 3] = ph; p.sched[n * 3 + 1] = layer; p.sched[n * 3 + 2] = d; n++; };
  add(PH_PRE, 0, 0);
  if (DUP & 4) add(PH_PRE, 0, 0);
  for (int l = 0; l < 4; l++) {
    add(PH_NORM, l, 0); if (DUP & 4) add(PH_NORM, l, 0);
    int kind = l % 3;
    const bool dg = DUP & 1, ds = DUP & 2;
    if (kind == 0) { add(PH_LRU_IN, l, 0); if (dg) add(PH_LRU_IN, l, 0); add(PH_LRU_CONV, l, 0); if (DUP & 4) add(PH_LRU_CONV, l, 0);
      for (int d = 0; d < 2; d++) { add(PH_LRU_GATE, l, d); if (dg) add(PH_LRU_GATE, l, d); add(PH_LRU_S1, l, d); if (DUP & 8) add(PH_LRU_S1, l, d); add(PH_LRU_S2, l, d); if (DUP & 16) add(PH_LRU_S2, l, d); add(PH_LRU_S3, l, d); }
      add(PH_LRU_OUT, l, 0); }
    else if (kind == 1) { add(PH_ML_IN, l, 0); if (dg) add(PH_ML_IN, l, 0); add(PH_ML_SCAN, l, 0); if (ds) add(PH_ML_SCAN, l, 0); add(PH_ML_STAT, l, 0); if (DUP & 4) add(PH_ML_STAT, l, 0); add(PH_ML_Z, l, 0); add(PH_ML_OUT, l, 0); }
    else { add(PH_R7_SHIFT, l, 0); add(PH_R7_IN, l, 0); if (dg) add(PH_R7_IN, l, 0); for (int wi = 0; wi < 13; wi++) { add(PH_R7_CA, l, wi); if (DUP & 32) add(PH_R7_CA, l, wi); add(PH_R7_CB, l, wi); } add(PH_R7_FIN, l, 0); add(PH_R7_OUT, l, 0); }
  }
  add(PH_FINAL, 0, 0);
  p.nsched = n;
  if (ws_size < WS_NEED) fprintf(stderr, "workspace too small: %zu < %llu\n", ws_size, (unsigned long long)WS_NEED);
#if MEGA
  static int grid_blocks = 0;
  if (!grid_blocks) { int dev = 0, cus = 0, per = 0; hipGetDevice(&dev); hipDeviceGetAttribute(&cus, hipDeviceAttributeMultiprocessorCount, dev);
    hipFuncSetAttribute((const void*)mega_kernel, hipFuncAttributeMaxDynamicSharedMemorySize, SMEM_BYTES);
    hipOccupancyMaxActiveBlocksPerMultiprocessor(&per, mega_kernel, 512, SMEM_BYTES); if (per > 1) per = 1; if (per < 1) per = 1; grid_blocks = cus * per; }
  hipMemsetAsync(ws + OFF_BAR, 0, XCD_BAR_WORDS * 4, stream);
  void* args[] = {&p};
  hipError_t e = hipLaunchCooperativeKernel((void*)mega_kernel, dim3(grid_blocks), dim3(512), args, SMEM_BYTES, stream);
  if (e != hipSuccess) fprintf(stderr, "cooperative launch failed: %s (grid %d)\n", hipGetErrorString(e), grid_blocks);
#else
  static int once = 0; if (!once) { once = 1; hipFuncSetAttribute((const void*)phase_kernel, hipFuncAttributeMaxDynamicSharedMemorySize, SMEM_BYTES); }
  for (int si = 0; si < n; si++) phase_kernel<<<256, 512, SMEM_BYTES, stream>>>(p, si);
#endif
}
```

```cpp
#include <hip/hip_runtime.h>
#include <hip/hip_bf16.h>
#include <hip/hip_cooperative_groups.h>
#include <cstdio>
#include <cstring>
#include <type_traits>
namespace cg = cooperative_groups;

#ifndef DUP
#define DUP 0
#endif
#ifndef MEGA
#define MEGA 1
#endif

typedef unsigned short bfr;
using bf16x8 = __attribute__((ext_vector_type(8))) short;
using f32x4 = __attribute__((ext_vector_type(4))) float;

#define R_ 33280
#define BT_ 16640
#define NCH_ 260

#define OFF_XC 0ull
#define OFF_MOD 2097152ull
#define OFF_W 2244608ull
#define OFF_H 24264704ull
#define OFF_ACT 92422144ull
#define A_Z 0ull
#define A_UC 85196800ull
#define A_AB 170393600ull
#define A_U 170393600ull
#define A_HF 340787200ull
#define A_AGG 425984000ull
#define A_CAR 431308800ull
#define A_QKV 0ull
#define A_GATE 272629760ull
#define A_HS 276889600ull
#define A_RSTD 413204480ull
#define A_R7B 68157440ull
#define A_RKVZ (A_R7B + 0ull)
#define A_WM (A_R7B + 272629760ull)
#define A_AM (A_R7B + 281149440ull)
#define A_BON (A_R7B + 289669120ull)
#define A_Y (A_R7B + 293928960ull)
#define WS_NEED (527000064ull + 16384ull)

#define WL_GATE (2560 * 1024)
#define WL_OUT (WL_GATE + 1310720)
#define WM_Z (4352 * 1024)
#define WM_OUT (WM_Z + 2048 * 1024)
#define WR_UP (4352 * 2048)
#define WR_OUT (WR_UP + 262144)

enum { PH_PRE = 0, PH_NORM, PH_LRU_IN, PH_LRU_CONV, PH_LRU_GATE, PH_LRU_S1, PH_LRU_S2, PH_LRU_S3, PH_LRU_OUT,
       PH_ML_IN, PH_ML_SCAN, PH_ML_STAT, PH_ML_Z, PH_ML_OUT,
       PH_R7_IN, PH_R7_CA, PH_R7_CB, PH_R7_FIN, PH_R7_OUT, PH_FINAL, PH_R7_SHIFT };

struct P {
  const float *x, *c, *ctx, *c_ctx, *norm_g, *mod_w, *mod_b, *final_g;
  const float *lru_w_in, *lru_conv_w, *lru_conv_b, *lru_gate_w, *lru_gate_b, *lru_lam, *lru_w_out;
  const float *ml_w_in, *ml_gate_b, *ml_norm_g, *ml_w_out;
  const float *r7_mu, *r7_w_rkvz, *r7_w0, *r7_w1, *r7_w2, *r7_a0, *r7_a1, *r7_a2, *r7_k_k, *r7_k_a, *r7_r_k, *r7_ln_g, *r7_ln_b, *r7_w_out;
  float* Xx; float* Xc; float* MOD; bfr* W; bfr* H; char* ACT; unsigned* bar; float* CL;
  int nsched; int pad_;
  int sched[64 * 3];
};
struct Ctx { int layer, j, d, wc; };

__device__ __forceinline__ int xcd_swz() { const int b = blockIdx.x; return gridDim.x == 256 ? ((b & 7) * 32 + (b >> 3)) : b; }
__device__ __forceinline__ int ltid() { int t = threadIdx.x; asm volatile("" : "+v"(t)); return t; }
typedef float f32v2_ __attribute__((ext_vector_type(2))); typedef __bf16 bf16v2_ __attribute__((ext_vector_type(2)));
__device__ __forceinline__ unsigned cvtpk(float lo, float hi) { f32v2_ f = {lo, hi}; bf16v2_ h = __builtin_convertvector(f, bf16v2_); return __builtin_bit_cast(unsigned, h); }
__device__ __forceinline__ bfr f2b(float f) { return (bfr)(cvtpk(f, f) & 0xffffu); }
__device__ __forceinline__ float b2f(bfr b) { return __uint_as_float(((unsigned)b) << 16); }
__device__ __forceinline__ unsigned pk2(float a, float b) { return cvtpk(a, b); }
__device__ __forceinline__ float blo(unsigned u) { return __uint_as_float(u << 16); }
__device__ __forceinline__ float bhi(unsigned u) { return __uint_as_float(u & 0xffff0000u); }
__device__ __forceinline__ void store4b(bfr* dst, f32x4 v) { uint2 u; u.x = pk2(v[0], v[1]); u.y = pk2(v[2], v[3]); *(uint2*)dst = u; }
__device__ __forceinline__ float sigm(float x) { return __builtin_amdgcn_rcpf(1.f + __expf(-x)); }
__device__ __forceinline__ float siluf(float x) { return x * sigm(x); }
__device__ __forceinline__ float softplusf(float x) { return x > 20.f ? x : log1pf(expf(x)); }
__device__ __forceinline__ int rowmap(int d, int b, int pp) { int o = d == 0 ? pp : (pp < 256 ? 255 - pp : 16895 - pp); return b * BT_ + o; }
__device__ __forceinline__ float* xrowp(const P& p, int row, int& mi) {
  int b = row / BT_, o = row - b * BT_;
  if (o < 256) { mi = 2; return p.Xc + (size_t)(b * 256 + o) * 1024; }
  mi = b; return p.Xx + (size_t)(b * 16384 + o - 256) * 1024;
}
template <int CTRL> __device__ __forceinline__ float dppf(float x) {
  return __int_as_float(__builtin_amdgcn_update_dpp(0, __float_as_int(x), CTRL, 0xf, 0xf, true));
}
__device__ __forceinline__ float wsum(float x) {
  x += dppf<0xB1>(x); x += dppf<0x4E>(x); x += dppf<0x141>(x); x += dppf<0x140>(x);
  x += __int_as_float(__builtin_amdgcn_update_dpp(0, __float_as_int(x), 0x142, 0xA, 0xF, false));
  x += __int_as_float(__builtin_amdgcn_update_dpp(0, __float_as_int(x), 0x143, 0xC, 0xF, false));
  return __int_as_float(__builtin_amdgcn_readlane(__float_as_int(x), 63));
}
template <int CTRL, int RM> __device__ __forceinline__ float dppo(float oldv, float x) {
  return __int_as_float(__builtin_amdgcn_update_dpp(__float_as_int(oldv), __float_as_int(x), CTRL, RM, 0xF, false)); }
__device__ __forceinline__ float wscan_add(float x) {
  x += dppo<0x111, 0xF>(0.f, x); x += dppo<0x112, 0xF>(0.f, x); x += dppo<0x114, 0xF>(0.f, x); x += dppo<0x118, 0xF>(0.f, x);
  x += dppo<0x142, 0xA>(0.f, x); x += dppo<0x143, 0xC>(0.f, x); return x; }
__device__ __forceinline__ float wscan_max(float x) {
  const float ninf = -3.0e38f;
  x = fmaxf(x, dppo<0x111, 0xF>(ninf, x)); x = fmaxf(x, dppo<0x112, 0xF>(ninf, x)); x = fmaxf(x, dppo<0x114, 0xF>(ninf, x)); x = fmaxf(x, dppo<0x118, 0xF>(ninf, x));
  x = fmaxf(x, dppo<0x142, 0xA>(ninf, x)); x = fmaxf(x, dppo<0x143, 0xC>(ninf, x)); return x; }
__device__ __forceinline__ float red16(float x) {
  x += dppf<0xB1>(x); x += dppf<0x4E>(x); x += dppf<0x141>(x); x += dppf<0x140>(x); return x;
}

template <class F> __device__ __forceinline__ void prep_tile(bfr* dst, int K, int tn, int tk, F get, float* sm) {
  int tid = ltid();
  for (int i = 0; i < 8; i++) { int kk = (tid >> 6) + 8 * i, nn = tid & 63; sm[kk * 65 + nn] = get(tk * 64 + kk, tn * 64 + nn); }
  __syncthreads();
  for (int i = 0; i < 8; i++) { int nn = (tid >> 6) + 8 * i, kk = tid & 63; dst[(size_t)(tn * 64 + nn) * K + tk * 64 + kk] = f2b(sm[kk * 65 + nn]); }
  __syncthreads();
}
__device__ __forceinline__ int prep_count(int layer) { int kind = layer % 3; return kind == 0 ? (640 + 320 + 320) : kind == 1 ? (1088 + 512 + 512) : (2176 + 64 + 256); }
__device__ __forceinline__ void prep_item(const P& p, int layer, int it, float* sm) {
  int kind = layer % 3, j = layer / 3;
  if (kind == 0) {
    if (it < 640) { int tn = it / 16, tk = it % 16; const float* s = p.lru_w_in + (size_t)j * 1024 * 2560;
      prep_tile(p.W, 1024, tn, tk, [=](int k, int n) { return s[(size_t)k * 2560 + n]; }, sm); return; }
    it -= 640;
    if (it < 320) { int d = it / 160, r = it % 160, tn = r / 2, tk = r % 2; const float* s = p.lru_gate_w + (size_t)(j * 2 + d) * 2 * 10 * 16384;
      prep_tile(p.W + WL_GATE + d * 655360, 128, tn, tk, [=](int k, int n) {
        int nt = n >> 7, blk = nt >> 1, sub = nt & 1, jj = n & 127, wn = jj >> 6, rr = jj & 63, g = rr >> 5, c = rr & 31;
        int kch = sub * 64 + wn * 32 + c; return s[((size_t)(g * 10 + blk) * 128 + k) * 128 + kch]; }, sm); return; }
    it -= 320;
    { int tn = it / 20, tk = it % 20; const float* s = p.lru_w_out + (size_t)j * 1280 * 1024;
      prep_tile(p.W + WL_OUT, 1280, tn, tk, [=](int k, int n) { return s[(size_t)k * 1024 + n]; }, sm); return; }
  } else if (kind == 1) {
    const float* s = p.ml_w_in + (size_t)j * 1024 * 6176;
    if (it < 1088) { int tn = it / 16, tk = it % 16;
      prep_tile(p.W, 1024, tn, tk, [=](int k, int n) {
        if (n < 4096) { float v = s[(size_t)k * 6176 + n]; return (n >= 1024 && n < 2048) ? v * 0.08838834764831845f : v; }
        if (n < 4128) return s[(size_t)k * 6176 + 6144 + (n - 4096)];
        return 0.f; }, sm); return; }
    it -= 1088;
    if (it < 512) { int tn = it / 16, tk = it % 16;
      prep_tile(p.W + WM_Z, 1024, tn, tk, [=](int k, int n) { return s[(size_t)k * 6176 + 4096 + n]; }, sm); return; }
    it -= 512;
    { int tn = it / 32, tk = it % 32; const float* so = p.ml_w_out + (size_t)j * 2048 * 1024;
      prep_tile(p.W + WM_OUT, 2048, tn, tk, [=](int k, int n) { return so[(size_t)k * 1024 + n]; }, sm); return; }
  } else {
    if (it < 2176) { int tn = it / 32, tk = it % 32;
      const float* mu = p.r7_mu + (size_t)j * 6 * 1024; const float* wr = p.r7_w_rkvz + (size_t)j * 4 * 1024 * 1024;
      const float* w1 = p.r7_w1 + (size_t)j * 2 * 1024 * 64; const float* a1 = p.r7_a1 + (size_t)j * 2 * 1024 * 64;
      prep_tile(p.W, 2048, tn, tk, [=](int k, int n) {
        int kk = k & 1023; float v, m;
        if (n < 4096) { int g = n >> 10, e = n & 1023; m = mu[g * 1024 + kk]; v = wr[((size_t)g * 1024 + kk) * 1024 + e]; }
        else if (n < 4224) { int xx = (n - 4096) >> 6, rr = (n - 4096) & 63; m = mu[4 * 1024 + kk]; v = w1[((size_t)xx * 1024 + kk) * 64 + rr]; }
        else { int xx = (n - 4224) >> 6, rr = (n - 4224) & 63; m = mu[5 * 1024 + kk]; v = a1[((size_t)xx * 1024 + kk) * 64 + rr]; }
        return (k < 1024 ? (1.f - m) : m) * v; }, sm); return; }
    it -= 2176;
    if (it < 64) { int u = it / 16, tn = it % 16; const float* s = (u < 2 ? p.r7_w2 : p.r7_a2) + (size_t)(j * 2 + (u & 1)) * 64 * 1024;
      prep_tile(p.W + WR_UP + u * 65536, 64, tn, 0, [=](int k, int n) { return s[(size_t)k * 1024 + n]; }, sm); return; }
    it -= 64;
    { int tn = it / 16, tk = it % 16; const float* s = p.r7_w_out + (size_t)j * 1024 * 1024;
      prep_tile(p.W + WR_OUT, 1024, tn, tk, [=](int k, int n) { return s[(size_t)k * 1024 + n]; }, sm); return; }
  }
}

#define LDSS 72
template <class G> __device__ __forceinline__ void gemm_tile(const P& p, const Ctx& c, int mt, int nt, char* smem) {
  const int tid = ltid(), lane = tid & 63, wid = tid >> 6, wm = wid & 3, wn = wid >> 2;
  bfr* sA = (bfr*)smem; bfr* sB = sA + 2 * 256 * LDSS;
  f32x4 acc[4][4];
  for (int a = 0; a < 4; a++) for (int b = 0; b < 4; b++) acc[a][b] = f32x4{0.f, 0.f, 0.f, 0.f};
  const int lr = tid >> 3, lc = tid & 7;
  uint4 ra[4], rb[2];
  auto gload = [&](int kt) __attribute__((always_inline)) {
#pragma unroll
    for (int i = 0; i < 4; i++) {
      const bfr* pa = G::aptr(p, c, mt * 256 + lr + 64 * i, kt, nt);
      ra[i] = pa ? *(const uint4*)(pa + lc * 8) : uint4{0u, 0u, 0u, 0u};
      if (i < 2) rb[i] = *(const uint4*)(G::bptr(p, c, nt * 128 + lr + 64 * i, kt) + lc * 8);
    }
  };
  auto sstore = [&](int buf) __attribute__((always_inline)) {
#pragma unroll
    for (int i = 0; i < 4; i++) {
      *(uint4*)(sA + (buf * 256 + lr + 64 * i) * LDSS + lc * 8) = ra[i];
      if (i < 2) *(uint4*)(sB + (buf * 128 + lr + 64 * i) * LDSS + lc * 8) = rb[i];
    }
  };
  gload(0); sstore(0); __syncthreads();
  for (int kt = 0; kt < G::KT; kt++) {
    const int buf = kt & 1;
    if (kt + 1 < G::KT) gload(kt + 1);
#pragma unroll
    for (int ks = 0; ks < 2; ks++) {
      bf16x8 af[4], bf[4];
#pragma unroll
      for (int i = 0; i < 4; i++) {
        af[i] = *(const bf16x8*)(sA + (buf * 256 + wm * 64 + i * 16 + (lane & 15)) * LDSS + ks * 32 + (lane >> 4) * 8);
        bf[i] = *(const bf16x8*)(sB + (buf * 128 + wn * 64 + i * 16 + (lane & 15)) * LDSS + ks * 32 + (lane >> 4) * 8);
      }
#pragma unroll
      for (int n = 0; n < 4; n++)
#pragma unroll
        for (int m = 0; m < 4; m++) acc[n][m] = __builtin_amdgcn_mfma_f32_16x16x32_bf16(bf[n], af[m], acc[n][m], 0, 0, 0);
    }
    if (kt + 1 < G::KT) sstore(buf ^ 1);
    __syncthreads();
  }
  G::epi(p, c, acc, mt * 256 + wm * 64, nt * 128 + wn * 64, lane);
}

__device__ __forceinline__ void epi_resid(const P& p, const Ctx& c, f32x4 (&acc)[4][4], int m0, int n0, int lane) {
#pragma unroll
  for (int mi = 0; mi < 4; mi++) {
    int row = m0 + mi * 16 + (lane & 15); int mo; float* xr = xrowp(p, row, mo);
    if (mo == 2 && !c.wc) continue;
    const float* g = p.MOD + (size_t)(c.layer * 3 + mo) * 3072 + 2048;
#pragma unroll
    for (int ni = 0; ni < 4; ni++) {
      int n = n0 + ni * 16 + (lane >> 4) * 4;
      float4 xv = *(float4*)(xr + n); float4 gg = *(const float4*)(g + n);
      xv.x += gg.x * acc[ni][mi][0]; xv.y += gg.y * acc[ni][mi][1]; xv.z += gg.z * acc[ni][mi][2]; xv.w += gg.w * acc[ni][mi][3];
      *(float4*)(xr + n) = xv;
    }
  }
}

struct G_LruIn { static constexpr int KT = 16, NT = 20;
  static __device__ __forceinline__ const bfr* aptr(const P& p, const Ctx& c, int row, int kt, int nt) { return p.H + (size_t)row * 1024 + kt * 64; }
  static __device__ __forceinline__ const bfr* bptr(const P& p, const Ctx& c, int n, int kt) { return p.W + (size_t)n * 1024 + kt * 64; }
  static __device__ __forceinline__ void epi(const P& p, const Ctx& c, f32x4 (&acc)[4][4], int m0, int n0, int lane) {
    bfr* U = (bfr*)(p.ACT + A_U); bfr* Z = (bfr*)(p.ACT + A_Z);
#pragma unroll
    for (int ni = 0; ni < 4; ni++)
#pragma unroll
      for (int mi = 0; mi < 4; mi++) {
        int row = m0 + mi * 16 + (lane & 15), n = n0 + ni * 16 + (lane >> 4) * 4;
        bfr* dst = n < 1280 ? U + (size_t)row * 1280 + n : Z + (size_t)row * 1280 + (n - 1280);
        store4b(dst, acc[ni][mi]);
      }
  } };
struct G_LruGate { static constexpr int KT = 2, NT = 20;
  static __device__ __forceinline__ const bfr* aptr(const P& p, const Ctx& c, int row, int kt, int nt) { return (const bfr*)(p.ACT + A_UC) + (size_t)row * 1280 + (nt >> 1) * 128 + kt * 64; }
  static __device__ __forceinline__ const bfr* bptr(const P& p, const Ctx& c, int n, int kt) { return p.W + WL_GATE + c.d * 655360 + (size_t)n * 128 + kt * 64; }
  static __device__ __forceinline__ void epi(const P& p, const Ctx& c, f32x4 (&acc)[4][4], int m0, int n0, int lane) {
    const bfr* UC = (const bfr*)(p.ACT + A_UC); unsigned* AB = (unsigned*)(p.ACT + A_AB);
    const float* gb = p.lru_gate_b + (size_t)(c.j * 2 + c.d) * 2 * 1280; const float* lam = p.lru_lam + (size_t)(c.j * 2 + c.d) * 1280;
    int chb = (n0 >> 6) * 32;
#pragma unroll
    for (int ni = 0; ni < 2; ni++) {
      int ch = chb + ni * 16 + (lane >> 4) * 4;
      float cl[4], br[4], bi[4];
#pragma unroll
      for (int q = 0; q < 4; q++) { cl[q] = p.CL[(size_t)(c.j * 2 + c.d) * 1280 + ch + q]; br[q] = gb[ch + q]; bi[q] = gb[1280 + ch + q]; }
#pragma unroll
      for (int mi = 0; mi < 4; mi++) {
        int row = m0 + mi * 16 + (lane & 15);
        uint2 u = *(const uint2*)(UC + (size_t)row * 1280 + ch);
        float uc[4] = {blo(u.x), bhi(u.x), blo(u.y), bhi(u.y)};
        unsigned o[4];
#pragma unroll
        for (int q = 0; q < 4; q++) {
          float r = sigm(acc[ni][mi][q] + br[q]), ig = sigm(acc[ni + 2][mi][q] + bi[q]);
          float la = -cl[q] * r; float oma = 1.f - __expf(la); float bb = __builtin_amdgcn_sqrtf(oma * (2.f - oma)) * ig * uc[q];
          o[q] = (((unsigned)f2b(oma)) << 16) | (unsigned)f2b(bb);
        }
        *(uint4*)(AB + (size_t)row * 1280 + ch) = uint4{o[0], o[1], o[2], o[3]};
      }
    }
  } };
struct G_LruOut { static constexpr int KT = 20, NT = 8;
  static __device__ __forceinline__ const bfr* aptr(const P& p, const Ctx& c, int row, int kt, int nt) { return (const bfr*)(p.ACT + A_Z) + (size_t)row * 1280 + kt * 64; }
  static __device__ __forceinline__ const bfr* bptr(const P& p, const Ctx& c, int n, int kt) { return p.W + WL_OUT + (size_t)n * 1280 + kt * 64; }
  static __device__ __forceinline__ void epi(const P& p, const Ctx& c, f32x4 (&acc)[4][4], int m0, int n0, int lane) { epi_resid(p, c, acc, m0, n0, lane); } };
struct G_MlIn { static constexpr int KT = 16, NT = 33;
  static __device__ __forceinline__ const bfr* aptr(const P& p, const Ctx& c, int row, int kt, int nt) { return p.H + (size_t)row * 1024 + kt * 64; }
  static __device__ __forceinline__ const bfr* bptr(const P& p, const Ctx& c, int n, int kt) { return p.W + (size_t)n * 1024 + kt * 64; }
  static __device__ __forceinline__ void epi(const P& p, const Ctx& c, f32x4 (&acc)[4][4], int m0, int n0, int lane) {
    bfr* QKV = (bfr*)(p.ACT + A_QKV); float* GT = (float*)(p.ACT + A_GATE);
#pragma unroll
    for (int ni = 0; ni < 4; ni++)
#pragma unroll
      for (int mi = 0; mi < 4; mi++) {
        int row = m0 + mi * 16 + (lane & 15), n = n0 + ni * 16 + (lane >> 4) * 4;
        if (n < 4096) store4b(QKV + (size_t)row * 4096 + n, acc[ni][mi]);
        else if (n < 4128) *(float4*)(GT + (size_t)row * 32 + (n - 4096)) = float4{acc[ni][mi][0], acc[ni][mi][1], acc[ni][mi][2], acc[ni][mi][3]};
      }
  } };
struct G_MlZ { static constexpr int KT = 16, NT = 16;
  static __device__ __forceinline__ const bfr* aptr(const P& p, const Ctx& c, int row, int kt, int nt) { return p.H + (size_t)row * 1024 + kt * 64; }
  static __device__ __forceinline__ const bfr* bptr(const P& p, const Ctx& c, int n, int kt) { return p.W + WM_Z + (size_t)n * 1024 + kt * 64; }
  static __device__ __forceinline__ void epi(const P& p, const Ctx& c, f32x4 (&acc)[4][4], int m0, int n0, int lane) {
    bfr* HS = (bfr*)(p.ACT + A_HS); const float* RS = (const float*)(p.ACT + A_RSTD); const float* ng = p.ml_norm_g + (size_t)c.j * 2048;
#pragma unroll
    for (int ni = 0; ni < 4; ni++)
#pragma unroll
      for (int mi = 0; mi < 4; mi++) {
        int row = m0 + mi * 16 + (lane & 15), n = n0 + ni * 16 + (lane >> 4) * 4;
        bfr* hp = HS + (size_t)row * 2048 + n; uint2 u = *(const uint2*)hp; float rs = RS[(size_t)row * 8 + (n >> 8)];
        float4 g4 = *(const float4*)(ng + n);
        f32x4 o;
        o[0] = blo(u.x) * rs * g4.x * siluf(acc[ni][mi][0]); o[1] = bhi(u.x) * rs * g4.y * siluf(acc[ni][mi][1]);
        o[2] = blo(u.y) * rs * g4.z * siluf(acc[ni][mi][2]); o[3] = bhi(u.y) * rs * g4.w * siluf(acc[ni][mi][3]);
        store4b(hp, o);
      }
  } };
struct G_MlOut { static constexpr int KT = 32, NT = 8;
  static __device__ __forceinline__ const bfr* aptr(const P& p, const Ctx& c, int row, int kt, int nt) { return (const bfr*)(p.ACT + A_HS) + (size_t)row * 2048 + kt * 64; }
  static __device__ __forceinline__ const bfr* bptr(const P& p, const Ctx& c, int n, int kt) { return p.W + WM_OUT + (size_t)n * 2048 + kt * 64; }
  static __device__ __forceinline__ void epi(const P& p, const Ctx& c, f32x4 (&acc)[4][4], int m0, int n0, int lane) { epi_resid(p, c, acc, m0, n0, lane); } };
struct G_R7In { static constexpr int KT = 32, NT = 34;
  static __device__ __forceinline__ const bfr* aptr(const P& p, const Ctx& c, int row, int kt, int nt) {
    if (kt < 16) return p.H + (size_t)row * 1024 + kt * 64;
    int q = (kt - 16) >> 2; int b = row / BT_, o = row - b * BT_; int nr;
    if (o < 256) { if (q < 2) { if (o < 1) return nullptr; nr = row - 1; } else { if (o >= 255) return nullptr; nr = row + 1; } }
    else { int t = o - 256, col = t & 63, gr = t >> 6;
      if (q == 0) { if (col == 0) return nullptr; nr = row - 1; }
      else if (q == 1) { if (col == 63) return nullptr; nr = row + 1; }
      else if (q == 2) { if (gr == 0) return nullptr; nr = row - 64; }
      else { if (gr == 255) return nullptr; nr = row + 64; } }
    return p.H + (size_t)nr * 1024 + (kt - 16) * 64; }
  static __device__ __forceinline__ const bfr* bptr(const P& p, const Ctx& c, int n, int kt) { return p.W + (size_t)n * 2048 + kt * 64; }
  static __device__ __forceinline__ void epi(const P& p, const Ctx& c, f32x4 (&acc)[4][4], int m0, int n0, int lane) {
    bfr* RK = (bfr*)(p.ACT + A_RKVZ); bfr* WMb = (bfr*)(p.ACT + A_WM); bfr* AMb = (bfr*)(p.ACT + A_AM);
#pragma unroll
    for (int ni = 0; ni < 4; ni++)
#pragma unroll
      for (int mi = 0; mi < 4; mi++) {
        int row = m0 + mi * 16 + (lane & 15), n = n0 + ni * 16 + (lane >> 4) * 4;
        if (n < 4096) store4b(RK + (size_t)row * 4096 + n, acc[ni][mi]);
        else if (n < 4224) { f32x4 t;
#pragma unroll
          for (int q = 0; q < 4; q++) t[q] = tanhf(acc[ni][mi][q]); store4b(WMb + (size_t)row * 128 + (n - 4096), t); }
        else store4b(AMb + (size_t)row * 128 + (n - 4224), acc[ni][mi]);
      }
  } };
struct G_R7Out { static constexpr int KT = 16, NT = 8;
  static __device__ __forceinline__ const bfr* aptr(const P& p, const Ctx& c, int row, int kt, int nt) { return p.H + (size_t)row * 1024 + kt * 64; }
  static __device__ __forceinline__ const bfr* bptr(const P& p, const Ctx& c, int n, int kt) { return p.W + WR_OUT + (size_t)n * 1024 + kt * 64; }
  static __device__ __forceinline__ void epi(const P& p, const Ctx& c, f32x4 (&acc)[4][4], int m0, int n0, int lane) { epi_resid(p, c, acc, m0, n0, lane); } };


namespace pg8 {
#define PG8_LAS __attribute__((address_space(3)))
constexpr int BM = 256, BK = 64, HALF = 128, HTB = HALF * BK * 2, NXCD = 8, WGM = 8;
__device__ __forceinline__ int lds_byte(int r, int c) { const int st = (r >> 4) * 2 + (c >> 5), rr = r & 15, cc = c & 31, ob = rr * 64 + cc * 2; return st * 1024 + (ob ^ (((ob >> 9) & 1) << 5)); }
__device__ __forceinline__ void stage_rc(int b, int& R, int& C) { const int st = b / 1024, sb = b % 1024, swz = sb ^ (((sb >> 9) & 1) << 5); R = (st >> 1) * 16 + swz / 64; C = (st & 1) * 32 + (swz % 64) / 2; }
struct Unit { int pm, pn; };
struct Gemm { const bfr* A; const bfr* Bt; int M, N, K; };
struct StaticOrder {
  int nM, nN, nwg, G, c;
  __device__ void init(int M, int N, int G_, int c_) { nM = M / BM; nN = N / BM; nwg = nM * nN; G = G_; c = c_; }
  __device__ bool next(int i, Unit& u) const {
    const long L = (long)i * G + c; if (L >= nwg) return false;
    int wgid = (int)L; { const int q = nwg / NXCD, r = nwg % NXCD, xcd = wgid % NXCD, off = wgid / NXCD; wgid = (xcd < r ? xcd * (q + 1) : r * (q + 1) + (xcd - r) * q) + off; }
    const int nig = WGM * nN, gid = wgid / nig, fm = gid * WGM, gsz = (nM - fm) < WGM ? (nM - fm) : WGM;
    u.pm = fm + ((wgid % nig) % gsz); u.pn = (wgid % nig) / gsz; return true;
  }
};
template <class Epi>
__device__ __forceinline__ void gemm_phase(PG8_LAS unsigned char* lds, const Gemm g, const StaticOrder& S, const Epi& E) {
  const int tid = ltid(), wid = __builtin_amdgcn_readfirstlane(tid >> 6), lane = tid & 63, wr = wid >> 2, wc = wid & 3, fr = lane & 15, fq = lane >> 4;
  const int K = g.K, nt = K / BK;
  unsigned voffA[2], voffB[2];
#pragma unroll
  for (int i = 0; i < 2; ++i) { int R, C; stage_rc(tid * 16 + i * 8192, R, C); voffA[i] = (unsigned)(R * K + C) * 2u; voffB[i] = voffA[i]; }
  const size_t kstep = (size_t)(BK * 2);
  const size_t hstep = (size_t)HALF * K * 2;
  const size_t tstep = 2 * hstep;
  const unsigned ldsw = (unsigned)wid * 1024u;
  const int aoff = lds_byte(wr * 64 + fr, fq * 8), boff = lds_byte(wc * 32 + fr, fq * 8);
#define PG8_SA(b, h) (((b) * 2 + (h)) * HTB)
#define PG8_SB(b, h) ((4 + (b) * 2 + (h)) * HTB)
#define PG8_STAGE(bufoff, gbase, voff) do { _Pragma("unroll") for (int _i = 0; _i < 2; ++_i) \
    __builtin_amdgcn_global_load_lds((const unsigned*)((const char*)(gbase) + (voff)[_i]), (PG8_LAS unsigned*)(lds + (bufoff) + ldsw + _i * 8192), 16, 0, 0); } while (0)
#define PG8_LDA(dst, b, h) do { _Pragma("unroll") for (int m = 0; m < 4; ++m) _Pragma("unroll") for (int k = 0; k < 2; ++k) dst[m][k] = *(const PG8_LAS bf16x8*)(lds + PG8_SA(b, h) + aoff + m * 2048 + k * 1024); } while (0)
#define PG8_LDB(dst, b, h) do { _Pragma("unroll") for (int n = 0; n < 2; ++n) _Pragma("unroll") for (int k = 0; k < 2; ++k) dst[n][k] = *(const PG8_LAS bf16x8*)(lds + PG8_SB(b, h) + boff + n * 2048 + k * 1024); } while (0)
#define PG8_MMA(ai, bj, At, Bt) do { __builtin_amdgcn_s_setprio(1); _Pragma("unroll") for (int m = 0; m < 4; ++m) _Pragma("unroll") for (int n = 0; n < 2; ++n) _Pragma("unroll") for (int k = 0; k < 2; ++k) \
    acc[ai][bj][m][n] = __builtin_amdgcn_mfma_f32_16x16x32_bf16(Bt[n][k], At[m][k], acc[ai][bj][m][n], 0, 0, 0); __builtin_amdgcn_s_setprio(0); } while (0)
#define PG8_WAIT_V(n) asm volatile("s_waitcnt vmcnt(" #n ")" ::: "memory")
#define PG8_WAIT_L(n) asm volatile("s_waitcnt lgkmcnt(" #n ")" ::: "memory")
#define PG8_BAR __builtin_amdgcn_s_barrier()
#define PG8_SCHED __builtin_amdgcn_sched_barrier(0)
  Unit cur, nxt; int ui = 0;
  if (!S.next(0, cur)) return;
  f32x4 acc[2][2][4][2];
#pragma unroll
  for (int a = 0; a < 2; ++a)
#pragma unroll
    for (int b = 0; b < 2; ++b)
#pragma unroll
      for (int m = 0; m < 4; ++m)
#pragma unroll
        for (int n = 0; n < 2; ++n) acc[a][b][m][n] = (f32x4){0.f, 0.f, 0.f, 0.f};
  bf16x8 At[4][2], B0[2][2], B1[2][2];
  const char* cA = (const char*)g.A + (size_t)cur.pm * tstep; const char* cB = (const char*)g.Bt + (size_t)cur.pn * tstep;
  PG8_STAGE(PG8_SB(0, 0), cB, voffB); PG8_STAGE(PG8_SA(0, 0), cA, voffA); PG8_STAGE(PG8_SB(0, 1), cB + hstep, voffB); PG8_STAGE(PG8_SA(0, 1), cA + hstep, voffA);
  if (wr == 1) PG8_BAR;
  PG8_WAIT_V(4); PG8_BAR;
  PG8_STAGE(PG8_SB(1, 0), cB + kstep, voffB); PG8_STAGE(PG8_SA(1, 0), cA + kstep, voffA); PG8_STAGE(PG8_SB(1, 1), cB + hstep + kstep, voffB);
  PG8_WAIT_V(6); PG8_BAR;
  for (;;) {
    const bool has_next = S.next(ui + 1, nxt);
    const char* nA = has_next ? (const char*)g.A + (size_t)nxt.pm * tstep : cA; const char* nB = has_next ? (const char*)g.Bt + (size_t)nxt.pn * tstep : cB;
    for (int t = 0; t < nt; t += 2) {
      const bool last = (t == nt - 2);
      const char* a1 = cA + (size_t)(t + 1) * kstep;
      const char* a2 = last ? nA : cA + (size_t)(t + 2) * kstep; const char* b2 = last ? nB : cB + (size_t)(t + 2) * kstep;
      const char* a3 = a2 + kstep; const char* b3 = b2 + kstep;
      PG8_LDB(B0, 0, 0); PG8_SCHED; PG8_LDA(At, 0, 0); PG8_STAGE(PG8_SA(1, 1), a1 + hstep, voffA);
      PG8_WAIT_L(8); PG8_BAR; PG8_WAIT_L(0); PG8_MMA(0, 0, At, B0); PG8_BAR; PG8_SCHED;
      PG8_LDB(B1, 0, 1); PG8_STAGE(PG8_SB(0, 0), b2, voffB);
      PG8_BAR; PG8_WAIT_L(0); PG8_MMA(0, 1, At, B1); PG8_BAR;
      PG8_LDA(At, 0, 1); PG8_STAGE(PG8_SA(0, 0), a2, voffA);
      PG8_BAR; PG8_WAIT_L(0); PG8_MMA(1, 0, At, B0); PG8_BAR; PG8_SCHED;
      PG8_STAGE(PG8_SB(0, 1), b2 + hstep, voffB);
      PG8_WAIT_V(6); PG8_BAR; PG8_MMA(1, 1, At, B1); PG8_BAR;
      PG8_LDB(B0, 1, 0); PG8_SCHED; PG8_LDA(At, 1, 0); PG8_STAGE(PG8_SA(0, 1), a2 + hstep, voffA);
      PG8_WAIT_L(8); PG8_BAR; PG8_WAIT_L(0); PG8_MMA(0, 0, At, B0); PG8_BAR; PG8_SCHED;
      PG8_LDB(B1, 1, 1); PG8_STAGE(PG8_SB(1, 0), b3, voffB);
      PG8_BAR; PG8_WAIT_L(0); PG8_MMA(0, 1, At, B1); PG8_BAR;
      PG8_LDA(At, 1, 1); PG8_STAGE(PG8_SA(1, 0), a3, voffA);
      PG8_BAR; PG8_WAIT_L(0); PG8_MMA(1, 0, At, B0); PG8_BAR; PG8_SCHED;
      PG8_STAGE(PG8_SB(1, 1), b3 + hstep, voffB);
      PG8_WAIT_V(6); PG8_BAR; PG8_MMA(1, 1, At, B1); PG8_BAR;
    }
    E(acc, cur, wr, wc, fr, fq);
    if (!has_next) break;
#pragma unroll
    for (int a = 0; a < 2; ++a)
#pragma unroll
      for (int b = 0; b < 2; ++b)
#pragma unroll
        for (int m = 0; m < 4; ++m)
#pragma unroll
          for (int n = 0; n < 2; ++n) acc[a][b][m][n] = (f32x4){0.f, 0.f, 0.f, 0.f};
    cur = nxt; cA = nA; cB = nB; ++ui;
  }
  PG8_WAIT_V(0);
  if (wr == 0) PG8_BAR;
  PG8_BAR;
#undef PG8_SA
#undef PG8_SB
#undef PG8_STAGE
#undef PG8_LDA
#undef PG8_LDB
#undef PG8_MMA
#undef PG8_WAIT_V
#undef PG8_WAIT_L
#undef PG8_BAR
#undef PG8_SCHED
}
}

template <class F> struct EpiAd {
  F f;
  __device__ __forceinline__ void operator()(const f32x4 (&acc)[2][2][4][2], const pg8::Unit& u, int wr, int wc, int fr, int fq) const {
#pragma unroll
    for (int ai = 0; ai < 2; ++ai)
#pragma unroll
      for (int m = 0; m < 4; ++m) { const int row = u.pm * 256 + ai * 128 + wr * 64 + m * 16 + fr;
#pragma unroll
        for (int bj = 0; bj < 2; ++bj)
#pragma unroll
          for (int n = 0; n < 2; ++n) f(row, u.pn * 256 + bj * 128 + wc * 32 + n * 16 + 4 * fq, acc[ai][bj][m][n]); }
  }
};
template <class F> __device__ __forceinline__ void big_gemm(char* smem, const bfr* A, const bfr* Bt, int N, int K, F f) {
  pg8::Gemm g; g.A = A; g.Bt = Bt; g.M = R_; g.N = N; g.K = K;
  pg8::StaticOrder S; S.init(R_, N, (int)gridDim.x, (int)blockIdx.x);
  EpiAd<F> E{f};
  pg8::gemm_phase(( __attribute__((address_space(3))) unsigned char*)smem, g, S, E);
}
struct F_LruIn { char* ACT; __device__ __forceinline__ void operator()(int row, int n, f32x4 v) const {
  bfr* dst = n < 1280 ? (bfr*)(ACT + A_U) + (size_t)row * 1280 + n : (bfr*)(ACT + A_Z) + (size_t)row * 1280 + (n - 1280); store4b(dst, v); } };
struct F_Resid { float* Xx; float* Xc; const float* MODg; int wc; __device__ __forceinline__ void operator()(int row, int n, f32x4 v) const {
  int b = row / BT_, o = row - b * BT_; bool isc = o < 256; if (isc && !wc) return;
  float* xr = isc ? Xc + (size_t)(b * 256 + o) * 1024 : Xx + (size_t)(b * 16384 + o - 256) * 1024; const float* g = MODg + (size_t)(isc ? 2 : b) * 3072 + 2048;
  float4 xv = *(float4*)(xr + n); float4 gg = *(const float4*)(g + n);
  xv.x += gg.x * v[0]; xv.y += gg.y * v[1]; xv.z += gg.z * v[2]; xv.w += gg.w * v[3]; *(float4*)(xr + n) = xv; } };
struct F_MlIn { char* ACT; __device__ __forceinline__ void operator()(int row, int n, f32x4 v) const {
  if (n < 4096) store4b((bfr*)(ACT + A_QKV) + (size_t)row * 4096 + n, v);
  else if (n < 4128) *(float4*)((float*)(ACT + A_GATE) + (size_t)row * 32 + (n - 4096)) = float4{v[0], v[1], v[2], v[3]}; } };
struct F_MlZ { char* ACT; const float* ng; __device__ __forceinline__ void operator()(int row, int n, f32x4 v) const {
  bfr* hp = (bfr*)(ACT + A_HS) + (size_t)row * 2048 + n; uint2 u = *(const uint2*)hp; float rs = ((const float*)(ACT + A_RSTD))[(size_t)row * 8 + (n >> 8)];
  float4 g4 = *(const float4*)(ng + n); f32x4 o;
  o[0] = blo(u.x) * rs * g4.x * siluf(v[0]); o[1] = bhi(u.x) * rs * g4.y * siluf(v[1]); o[2] = blo(u.y) * rs * g4.z * siluf(v[2]); o[3] = bhi(u.y) * rs * g4.w * siluf(v[3]);
  store4b(hp, o); } };
struct F_R7In { char* ACT; __device__ __forceinline__ void operator()(int row, int n, f32x4 v) const {
  if (n < 4096) store4b((bfr*)(ACT + A_RKVZ) + (size_t)row * 4096 + n, v);
  else if (n < 4224) { f32x4 t;
#pragma unroll
    for (int q = 0; q < 4; q++) t[q] = tanhf(v[q]);
    store4b((bfr*)(ACT + A_WM) + (size_t)row * 128 + (n - 4096), t); }
  else store4b((bfr*)(ACT + A_AM) + (size_t)row * 128 + (n - 4224), v); } };

template <class G> __device__ __forceinline__ void gemm_phase(const P& p, const Ctx& c, char* smem) {
  const int total = 130 * G::NT;
  for (int it = blockIdx.x; it < total; it += gridDim.x) gemm_tile<G>(p, c, it / G::NT, it % G::NT, smem);
}

#define R7_Y2 ((bfr*)p.H + (size_t)64 * 26 * 16384)
template <class G> __device__ __forceinline__ void gemm_phase_k2(const P& p, const Ctx& c, char* smem) {
  const int tid = ltid(), lane = tid & 63, wid = tid >> 6, wm = wid & 3, wn = wid >> 2;
  bfr* sA = (bfr*)smem; bfr* sB = sA + 2 * 256 * LDSS;
  const int lr = tid >> 3, lc = tid & 7;
  const int total = 130 * G::NT;
  uint4 a00, a01, a02, a03, a10, a11, a12, a13, b00, b01, b10, b11;
#define GK2_LA(i_, R0, R1) { R0 = *(const uint4*)(G::aptr(p, c, mt_ * 256 + lr + 64 * (i_), 0, nt_) + lc * 8); R1 = *(const uint4*)(G::aptr(p, c, mt_ * 256 + lr + 64 * (i_), 1, nt_) + lc * 8); }
#define GK2_LB(i_, R0, R1) { R0 = *(const uint4*)(G::bptr(p, c, nt_ * 128 + lr + 64 * (i_), 0) + lc * 8); R1 = *(const uint4*)(G::bptr(p, c, nt_ * 128 + lr + 64 * (i_), 1) + lc * 8); }
#define GK2_LOAD(it_) { const int mt_ = (it_) / G::NT, nt_ = (it_) % G::NT; GK2_LA(0, a00, a10) GK2_LA(1, a01, a11) GK2_LA(2, a02, a12) GK2_LA(3, a03, a13) GK2_LB(0, b00, b10) GK2_LB(1, b01, b11) }
#define GK2_SA(i_, R0, R1) { *(uint4*)(sA + (lr + 64 * (i_)) * LDSS + lc * 8) = R0; *(uint4*)(sA + (256 + lr + 64 * (i_)) * LDSS + lc * 8) = R1; }
#define GK2_SB(i_, R0, R1) { *(uint4*)(sB + (lr + 64 * (i_)) * LDSS + lc * 8) = R0; *(uint4*)(sB + (128 + lr + 64 * (i_)) * LDSS + lc * 8) = R1; }
  int it = xcd_swz();
  if (it < total) GK2_LOAD(it)
  while (it < total) {
    const int mt = it / G::NT, nt = it % G::NT;
    GK2_SA(0, a00, a10) GK2_SA(1, a01, a11) GK2_SA(2, a02, a12) GK2_SA(3, a03, a13) GK2_SB(0, b00, b10) GK2_SB(1, b01, b11)
    __syncthreads();
    const int itn = it + gridDim.x;
    if (itn < total) GK2_LOAD(itn)
    f32x4 acc[4][4];
#pragma unroll
    for (int a = 0; a < 4; a++)
#pragma unroll
      for (int b = 0; b < 4; b++) acc[a][b] = f32x4{0.f, 0.f, 0.f, 0.f};
#pragma unroll
    for (int buf = 0; buf < 2; buf++)
#pragma unroll
      for (int ks = 0; ks < 2; ks++) {
        bf16x8 af[4], bf[4];
#pragma unroll
        for (int i = 0; i < 4; i++) {
          af[i] = *(const bf16x8*)(sA + (buf * 256 + wm * 64 + i * 16 + (lane & 15)) * LDSS + ks * 32 + (lane >> 4) * 8);
          bf[i] = *(const bf16x8*)(sB + (buf * 128 + wn * 64 + i * 16 + (lane & 15)) * LDSS + ks * 32 + (lane >> 4) * 8);
        }
#pragma unroll
        for (int n = 0; n < 4; n++)
#pragma unroll
          for (int m = 0; m < 4; m++) acc[n][m] = __builtin_amdgcn_mfma_f32_16x16x32_bf16(bf[n], af[m], acc[n][m], 0, 0, 0);
      }
    G::epi(p, c, acc, mt * 256 + wm * 64, nt * 128 + wn * 64, lane);
    __syncthreads();
    it = itn;
  }
#undef GK2_LOAD
#undef GK2_LA
#undef GK2_LB
#undef GK2_SA
#undef GK2_SB
}

__device__ __forceinline__ void ph_pre(const P& p, char* smem) {
  float* sm = (float*)smem; const int tid = ltid();
  const int nprep = prep_count(0), ngemv = 192, ncopy = 4160;
  if (blockIdx.x == 0) for (int i = tid; i < 5120; i += 512) p.CL[i] = 8.f * softplusf(-p.lru_lam[i]);
  for (int it = blockIdx.x; it < nprep + ngemv + ncopy; it += gridDim.x) {
    if (it < nprep) { prep_item(p, 0, it, sm); continue; }
    int i2 = it - nprep;
    if (i2 < ngemv) {
      int l = i2 / 48, cgp = i2 % 48;
      for (int i = tid; i < 3072; i += 512) { int cnd = i >> 10, k = i & 1023; float v = cnd == 0 ? p.c[k] : cnd == 1 ? p.c[1024 + k] : p.c_ctx[k]; sm[i] = siluf(v); }
      __syncthreads();
      int kq = tid >> 6, col = cgp * 64 + (tid & 63); const float* w = p.mod_w + (size_t)l * 1024 * 3072 + col;
      float a0 = 0.f, a1 = 0.f, a2 = 0.f;
      for (int k = kq * 128; k < kq * 128 + 128; k++) { float wv = w[(size_t)k * 3072]; a0 += sm[k] * wv; a1 += sm[1024 + k] * wv; a2 += sm[2048 + k] * wv; }
      float* red = sm + 3072; red[tid * 3] = a0; red[tid * 3 + 1] = a1; red[tid * 3 + 2] = a2;
      __syncthreads();
      if (tid < 64) { float bias = p.mod_b[(size_t)l * 3072 + col];
        for (int cnd = 0; cnd < 3; cnd++) { float s = bias; for (int q = 0; q < 8; q++) s += red[(q * 64 + tid) * 3 + cnd]; p.MOD[(size_t)(l * 3 + cnd) * 3072 + col] = s; } }
      __syncthreads();
      continue;
    }
    i2 -= ngemv;
    for (int q = 0; q < 4; q++) { int idx = i2 * 2048 + q * 512 + tid; int row = idx >> 8, c4 = idx & 255; int b = row / BT_, o = row - b * BT_;
      if (o < 256) ((float4*)p.Xc)[(size_t)(b * 256 + o) * 256 + c4] = ((const float4*)p.ctx)[(size_t)(b * 256 + o) * 256 + c4];
      else ((float4*)p.Xx)[(size_t)(b * 16384 + o - 256) * 256 + c4] = ((const float4*)p.x)[(size_t)(b * 16384 + o - 256) * 256 + c4]; }
  }
}
__device__ __forceinline__ void ph_norm(const P& p, int layer, char* smem) {
  const int tid = ltid(), lane = tid & 63, wid = tid >> 6;
  const int nprep = layer > 0 ? prep_count(layer) : 0; const int kind = layer % 3;
  const int nzero = kind == 1 ? 8320 : 0;
  (void)nzero;
  for (int it = blockIdx.x; it < nprep + 4160; it += gridDim.x) {
    if (it < nprep) { prep_item(p, layer, it, (float*)smem); continue; }
    int row = (it - nprep) * 8 + wid; int mo; const float* xr = xrowp(p, row, mo);
    float4 v[4]; float ss = 0.f;
#pragma unroll
    for (int i = 0; i < 4; i++) { v[i] = *(const float4*)(xr + lane * 4 + 256 * i); ss += v[i].x * v[i].x + v[i].y * v[i].y + v[i].z * v[i].z + v[i].w * v[i].w; }
    ss = wsum(ss); float rs = rsqrtf(ss * (1.f / 1024.f) + 1e-6f);
    const float* g = p.norm_g + (size_t)layer * 1024; const float* md = p.MOD + (size_t)(layer * 3 + mo) * 3072;
#pragma unroll
    for (int i = 0; i < 4; i++) { int cidx = lane * 4 + 256 * i; float4 gg = *(const float4*)(g + cidx), sh = *(const float4*)(md + cidx), sc = *(const float4*)(md + 1024 + cidx);
      f32x4 o; o[0] = v[i].x * rs * gg.x * (1.f + sc.x) + sh.x; o[1] = v[i].y * rs * gg.y * (1.f + sc.y) + sh.y; o[2] = v[i].z * rs * gg.z * (1.f + sc.z) + sh.z; o[3] = v[i].w * rs * gg.w * (1.f + sc.w) + sh.w;
      store4b(p.H + (size_t)row * (kind == 2 ? 2048 : 1024) + cidx, o); }
  }
}
__device__ __forceinline__ void ph_r7_shift(const P& p) {
  for (int it = blockIdx.x; it < 8320; it += gridDim.x) {
    int idx = it * 512 + ltid(); int row = idx >> 7, c8 = idx & 127, q = c8 >> 5;
    int b = row / BT_, o = row - b * BT_; int nr = -1;
    if (o < 256) { if (q < 2) { if (o >= 1) nr = row - 1; } else { if (o < 255) nr = row + 1; } }
    else { int t = o - 256, col = t & 63, gr = t >> 6;
      if (q == 0) { if (col != 0) nr = row - 1; } else if (q == 1) { if (col != 63) nr = row + 1; }
      else if (q == 2) { if (gr != 0) nr = row - 64; } else { if (gr != 255) nr = row + 64; } }
    uint4 v = nr >= 0 ? *(const uint4*)(p.H + (size_t)nr * 2048 + c8 * 8) : uint4{0u, 0u, 0u, 0u};
    *(uint4*)(p.H + (size_t)row * 2048 + 1024 + c8 * 8) = v;
  }
}
__device__ __forceinline__ void ph_final(const P& p) {
  const int lane = ltid() & 63, wid = ltid() >> 6;
  for (int it = blockIdx.x; it < 4096; it += gridDim.x) {
    float* xr = p.Xx + (size_t)(it * 8 + wid) * 1024; float4 v[4]; float ss = 0.f;
#pragma unroll
    for (int i = 0; i < 4; i++) { v[i] = *(const float4*)(xr + lane * 4 + 256 * i); ss += v[i].x * v[i].x + v[i].y * v[i].y + v[i].z * v[i].z + v[i].w * v[i].w; }
    ss = wsum(ss); float rs = rsqrtf(ss * (1.f / 1024.f) + 1e-6f);
#pragma unroll
    for (int i = 0; i < 4; i++) { int cidx = lane * 4 + 256 * i; float4 gg = *(const float4*)(p.final_g + cidx);
      *(float4*)(xr + cidx) = float4{v[i].x * rs * gg.x, v[i].y * rs * gg.y, v[i].z * rs * gg.z, v[i].w * rs * gg.w}; }
  }
}
__device__ __forceinline__ void ph_lru_conv(const P& p, int j) {
  const bfr* U = (const bfr*)(p.ACT + A_U); bfr* UC = (bfr*)(p.ACT + A_UC);
  const float* cw = p.lru_conv_w + (size_t)j * 4 * 1280; const float* cb = p.lru_conv_b + (size_t)j * 1280;
  for (int it = xcd_swz(); it < 10400; it += gridDim.x) {
    int idx = it * 512 + ltid(); int row = idx / 160, cgp = idx % 160, ch = cgp * 8;
    int b = row / BT_, o = row - b * BT_; int s0 = o < 256 ? 0 : 256, e0 = o < 256 ? 256 : BT_;
    float acc[8];
#pragma unroll
    for (int e = 0; e < 8; e++) acc[e] = cb[ch + e];
#pragma unroll
    for (int t = 0; t < 4; t++) { int oo = o + t - 2; if (oo < s0 || oo >= e0) continue;
      uint4 u = *(const uint4*)(U + (size_t)(row + t - 2) * 1280 + ch); const float* w = cw + t * 1280 + ch;
      acc[0] += w[0] * blo(u.x); acc[1] += w[1] * bhi(u.x); acc[2] += w[2] * blo(u.y); acc[3] += w[3] * bhi(u.y);
      acc[4] += w[4] * blo(u.z); acc[5] += w[5] * bhi(u.z); acc[6] += w[6] * blo(u.w); acc[7] += w[7] * bhi(u.w); }
    *(uint4*)(UC + (size_t)row * 1280 + ch) = uint4{pk2(acc[0], acc[1]), pk2(acc[2], acc[3]), pk2(acc[4], acc[5]), pk2(acc[6], acc[7])};
  }
}
__device__ __forceinline__ void ph_lru_s1(const P& p, int d) {
  const unsigned* AB = (const unsigned*)(p.ACT + A_AB); float2* AGG = (float2*)(p.ACT + A_AGG);
  const int t = ltid();
  for (int it = xcd_swz() * 8 + (t >> 6); it < 2600; it += gridDim.x * 8) {
    int b = it / 1300, r = it % 1300, cc = r / 5, ch = (r % 5) * 256 + (t & 63) * 4;
    float P0 = 1.f, Q0 = 0.f, P1 = 1.f, Q1 = 0.f, P2 = 1.f, Q2 = 0.f, P3 = 1.f, Q3 = 0.f;
#pragma unroll 8
    for (int q = 0; q < 64; q++) { uint4 u = *(const uint4*)(AB + (size_t)rowmap(d, b, cc * 64 + q) * 1280 + ch);
      float a0 = 1.f - bhi(u.x), a1 = 1.f - bhi(u.y), a2 = 1.f - bhi(u.z), a3 = 1.f - bhi(u.w);
      P0 *= a0; Q0 = a0 * Q0 + blo(u.x); P1 *= a1; Q1 = a1 * Q1 + blo(u.y); P2 *= a2; Q2 = a2 * Q2 + blo(u.z); P3 *= a3; Q3 = a3 * Q3 + blo(u.w); }
    float4* ag = (float4*)(AGG + (size_t)(b * NCH_ + cc) * 1280 + ch); ag[0] = float4{P0, Q0, P1, Q1}; ag[1] = float4{P2, Q2, P3, Q3};
  }
}
__device__ __forceinline__ void ph_lru_s2(const P& p, char* smem) {
  const float2* AGG = (const float2*)(p.ACT + A_AGG); float* CAR = (float*)(p.ACT + A_CAR);
  float* sP = (float*)smem; float* sQ = sP + 512;
  const int tid = ltid(), chl = tid & 63, seg = tid >> 6;
  for (int it = blockIdx.x; it < 40; it += gridDim.x) {
    const int b = it / 20, ch = (it % 20) * 64 + chl; const int cb = seg * 33, ce = cb + 33 < NCH_ ? cb + 33 : NCH_;
    float Pp = 1.f, Q = 0.f;
#pragma unroll 11
    for (int cc = cb; cc < ce; cc++) { float2 a = AGG[(size_t)(b * NCH_ + cc) * 1280 + ch]; Pp *= a.x; Q = a.x * Q + a.y; }
    __syncthreads();
    sP[seg * 64 + chl] = Pp; sQ[seg * 64 + chl] = Q;
    __syncthreads();
    float h = 0.f;
    for (int s2 = 0; s2 < seg; s2++) h = sP[s2 * 64 + chl] * h + sQ[s2 * 64 + chl];
#pragma unroll 11
    for (int cc = cb; cc < ce; cc++) { size_t o = (size_t)(b * NCH_ + cc) * 1280 + ch; float2 a = AGG[o]; CAR[o] = h; h = a.x * h + a.y; }
  }
}
__device__ __forceinline__ void ph_lru_s3(const P& p, int d) {
  const unsigned* AB = (const unsigned*)(p.ACT + A_AB); const float* CAR = (const float*)(p.ACT + A_CAR);
  bfr* HF = (bfr*)(p.ACT + A_HF); bfr* Z = (bfr*)(p.ACT + A_Z);
  const int t = ltid();
  for (int it = xcd_swz() * 8 + (t >> 6); it < 2600; it += gridDim.x * 8) {
    int b = it / 1300, r = it % 1300, cc = r / 5, ch = (r % 5) * 256 + (t & 63) * 4;
    float4 h = *(const float4*)(CAR + (size_t)(b * NCH_ + cc) * 1280 + ch);
#pragma unroll 8
    for (int q = 0; q < 64; q++) { size_t o = (size_t)rowmap(d, b, cc * 64 + q) * 1280 + ch; uint4 u = *(const uint4*)(AB + o);
      h.x = (1.f - bhi(u.x)) * h.x + blo(u.x); h.y = (1.f - bhi(u.y)) * h.y + blo(u.y); h.z = (1.f - bhi(u.z)) * h.z + blo(u.z); h.w = (1.f - bhi(u.w)) * h.w + blo(u.w);
      if (d == 0) *(uint2*)(HF + o) = uint2{pk2(h.x, h.y), pk2(h.z, h.w)};
      else { uint2 hf = *(const uint2*)(HF + o), zz = *(const uint2*)(Z + o);
        *(uint2*)(Z + o) = uint2{pk2((blo(hf.x) + h.x) * siluf(blo(zz.x)), (bhi(hf.x) + h.y) * siluf(bhi(zz.x))), pk2((blo(hf.y) + h.z) * siluf(blo(zz.y)), (bhi(hf.y) + h.w) * siluf(bhi(zz.y)))}; } }
  }
}
__device__ __forceinline__ void ph_ml_stat(const P& p) {
  const bfr* HS = (const bfr*)(p.ACT + A_HS); float* RS = (float*)(p.ACT + A_RSTD);
  const int lane = ltid() & 63, wid = ltid() >> 6;
  for (int it = blockIdx.x; it < 4160; it += gridDim.x) {
    int row = it * 8 + wid; const bfr* hp = HS + (size_t)row * 2048 + lane * 32; float ss = 0.f;
#pragma unroll
    for (int i = 0; i < 4; i++) { uint4 u = *(const uint4*)(hp + i * 8); float a;
      a = blo(u.x); ss += a * a; a = bhi(u.x); ss += a * a; a = blo(u.y); ss += a * a; a = bhi(u.y); ss += a * a;
      a = blo(u.z); ss += a * a; a = bhi(u.z); ss += a * a; a = blo(u.w); ss += a * a; a = bhi(u.w); ss += a * a; }
    ss += __shfl_xor(ss, 1); ss += __shfl_xor(ss, 2); ss += __shfl_xor(ss, 4);
    if ((lane & 7) == 0) RS[(size_t)row * 8 + (lane >> 3)] = rsqrtf(ss * (1.f / 256.f) + 1e-6f);
  }
}
__device__ __forceinline__ void ph_r7_fin(const P& p, int j) {
  bfr* Y = (bfr*)(p.ACT + A_Y); const bfr* RK = (const bfr*)(p.ACT + A_RKVZ); const float* BON = (const float*)(p.ACT + A_BON);
  const float* lg = p.r7_ln_g + (size_t)j * 1024; const float* lb = p.r7_ln_b + (size_t)j * 1024;
  const int lane = ltid() & 63, wid = ltid() >> 6;
  for (int it = blockIdx.x; it < 4160; it += gridDim.x) {
    int row = it * 8 + wid, ch = lane * 16, hd = lane >> 2;
    float y[16], v[16], z[16];
#pragma unroll
    for (int i = 0; i < 2; i++) {
      uint4 u = *(const uint4*)(Y + (size_t)row * 1024 + ch + i * 8); const uint4 u2 = *(const uint4*)(R7_Y2 + (size_t)row * 1024 + ch + i * 8);
      y[i * 8 + 0] = blo(u.x) + blo(u2.x); y[i * 8 + 1] = bhi(u.x) + bhi(u2.x); y[i * 8 + 2] = blo(u.y) + blo(u2.y); y[i * 8 + 3] = bhi(u.y) + bhi(u2.y); y[i * 8 + 4] = blo(u.z) + blo(u2.z); y[i * 8 + 5] = bhi(u.z) + bhi(u2.z); y[i * 8 + 6] = blo(u.w) + blo(u2.w); y[i * 8 + 7] = bhi(u.w) + bhi(u2.w);
      u = *(const uint4*)(RK + (size_t)row * 4096 + 2048 + ch + i * 8);
      v[i * 8 + 0] = blo(u.x); v[i * 8 + 1] = bhi(u.x); v[i * 8 + 2] = blo(u.y); v[i * 8 + 3] = bhi(u.y); v[i * 8 + 4] = blo(u.z); v[i * 8 + 5] = bhi(u.z); v[i * 8 + 6] = blo(u.w); v[i * 8 + 7] = bhi(u.w);
      u = *(const uint4*)(RK + (size_t)row * 4096 + 3072 + ch + i * 8);
      z[i * 8 + 0] = blo(u.x); z[i * 8 + 1] = bhi(u.x); z[i * 8 + 2] = blo(u.y); z[i * 8 + 3] = bhi(u.y); z[i * 8 + 4] = blo(u.z); z[i * 8 + 5] = bhi(u.z); z[i * 8 + 6] = blo(u.w); z[i * 8 + 7] = bhi(u.w);
    }
    float s = 0.f;
#pragma unroll
    for (int e = 0; e < 16; e++) s += y[e];
    s += __shfl_xor(s, 1); s += __shfl_xor(s, 2); float mean = s * (1.f / 64.f);
    float q = 0.f;
#pragma unroll
    for (int e = 0; e < 16; e++) { float dlt = y[e] - mean; q += dlt * dlt; }
    q += __shfl_xor(q, 1); q += __shfl_xor(q, 2); float rs = rsqrtf(q * (1.f / 64.f) + 64e-5f);
    float bon = BON[(size_t)row * 16 + hd] + BON[(size_t)(R_ + row) * 16 + hd];
    float o[16];
#pragma unroll
    for (int e = 0; e < 16; e++) { float yn = (y[e] - mean) * rs * lg[ch + e] + lb[ch + e]; o[e] = (yn + bon * v[e]) * siluf(z[e]); }
#pragma unroll
    for (int i = 0; i < 2; i++)
      *(uint4*)(Y + (size_t)row * 1024 + ch + i * 8) = uint4{pk2(o[i * 8], o[i * 8 + 1]), pk2(o[i * 8 + 2], o[i * 8 + 3]), pk2(o[i * 8 + 4], o[i * 8 + 5]), pk2(o[i * 8 + 6], o[i * 8 + 7])};
  }
}

#define QS 136
#define VS 72
#define MLG_BYTES 47104
__device__ __forceinline__ void ph_ml_scan(const P& p, int j, char* smem0) {
  const int d = ltid() >> 8;
  char* smem = smem0 + d * MLG_BYTES;
  bfr* sQ = (bfr*)smem; bfr* sK = sQ + 64 * QS; bfr* sVT = sK + 64 * QS; bfr* sCT = sVT + 16 * VS;
  float* sN = (float*)(sCT + 16 * QS);
  float* sEs = sN + 128; float* sCt = sEs + 64; float* sBc = sCt + 64; float* sWg = sBc + 64; float* sNr = sWg + 64; bfr* sNb = (bfr*)(sNr + 256); float* sMisc = (float*)(sNb + 128); bfr* sVW = (bfr*)(sMisc + 4);
  const bfr* QKV = (const bfr*)(p.ACT + A_QKV); const float* GT = (const float*)(p.ACT + A_GATE); bfr* HS = (bfr*)(p.ACT + A_HS);
  const float* gbias = p.ml_gate_b + (size_t)j * 32;
  const int tid = ltid() & 255, lane = tid & 63, w = tid >> 6, l15 = lane & 15, q4 = lane >> 4;
  for (int it = xcd_swz(); it < 256; it += gridDim.x) {
    const int b = it >> 7, hh = (it >> 4) & 7, sl = it & 15;
    f32x4 Cacc[2];
    Cacc[0] = f32x4{0.f, 0.f, 0.f, 0.f}; Cacc[1] = f32x4{0.f, 0.f, 0.f, 0.f};
    float mcur = 0.f;
    for (int i = tid; i < 16 * QS; i += 256) sCT[i] = 0;
    if (tid < 128) { sN[tid] = 0.f; sNb[tid] = 0; }
    uint4 pq0, pq1, pq2, pq3, pk0, pk1, pk2, pk3, pv = uint4{0u, 0u, 0u, 0u}; float pgi = 0.f, pgf = 0.f;
#define ML_ROW0(s_) (d == 0 ? b * BT_ + 64 * (s_) : rowmap(1, b, 64 * (s_) + 63))
#define ML_LD(i_, PQ, PK) { int idx = tid + 256 * (i_), rho = idx >> 4, c8 = idx & 15; const bfr* src = QKV + (size_t)(r0n + rho) * 4096 + hh * 128 + c8 * 8; PQ = *(const uint4*)src; PK = *(const uint4*)(src + 1024); }
#define ML_ISSUE(s_) { const int r0n = ML_ROW0(s_); ML_LD(0, pq0, pk0) ML_LD(1, pq1, pk1) ML_LD(2, pq2, pk2) ML_LD(3, pq3, pk3) \
      if (tid < 128) pv = *(const uint4*)(QKV + (size_t)(r0n + (tid >> 1)) * 4096 + 2048 + hh * 256 + sl * 16 + (tid & 1) * 8); \
      if (w == 0) { const float* gp_ = GT + (size_t)(r0n + (d ? 63 - lane : lane)) * 32 + d * 16 + hh; pgi = gp_[0]; pgf = gp_[8]; } }
#define ML_ST(i_, PQ, PK) { int idx = tid + 256 * (i_), rho = idx >> 4, c8 = idx & 15; *(uint4*)(sQ + rho * QS + c8 * 8) = PQ; *(uint4*)(sK + rho * QS + c8 * 8) = PK; }
#define ML_COMMIT() { ML_ST(0, pq0, pk0) ML_ST(1, pq1, pk1) ML_ST(2, pq2, pk2) ML_ST(3, pq3, pk3) \
      if (tid < 128) { int rho = tid >> 1, vb = (tid & 1) * 8; \
        sVT[(vb + 0) * VS + rho] = (bfr)(pv.x & 0xffff); sVT[(vb + 1) * VS + rho] = (bfr)(pv.x >> 16); \
        sVT[(vb + 2) * VS + rho] = (bfr)(pv.y & 0xffff); sVT[(vb + 3) * VS + rho] = (bfr)(pv.y >> 16); \
        sVT[(vb + 4) * VS + rho] = (bfr)(pv.z & 0xffff); sVT[(vb + 5) * VS + rho] = (bfr)(pv.z >> 16); \
        sVT[(vb + 6) * VS + rho] = (bfr)(pv.w & 0xffff); sVT[(vb + 7) * VS + rho] = (bfr)(pv.w >> 16); } }
    ML_ISSUE(0)
    __syncthreads();
    for (int s = 0; s < NCH_; s++) {
      const int r0 = ML_ROW0(s);
      ML_COMMIT()
      if (w == 0) {
        int rho = d ? 63 - lane : lane;
        float gi = pgi + gbias[(d * 2 + 0) * 8 + hh], gf = pgf + gbias[(d * 2 + 1) * 8 + hh];
        float fc = fminf(gf, 0.f) - __logf(1.f + __expf(-fabsf(gf)));
        const float bc = wscan_add(fc);
        const float e = gi - bc, pm = wscan_max(e);
        const float pml = __int_as_float(__builtin_amdgcn_readlane(__float_as_int(pm), 63)), bcl = __int_as_float(__builtin_amdgcn_readlane(__float_as_int(bc), 63));
        const float mx_ = fmaxf(mcur, pml);
        sEs[rho] = __expf(fminf(e, 80.f)); sCt[rho] = -fmaxf(mcur, pm); sBc[rho] = bc; sWg[rho] = __expf(e - mx_);
        if (lane == 0) { sMisc[0] = mcur; sMisc[1] = __expf(mcur - mx_); }
        mcur = bcl + mx_;
      }
      __syncthreads();
      const float mold = sMisc[0], decay = sMisc[1];

      const int rt = 16 * w + l15;
      bfr* hp = HS + (size_t)(r0 + rt) * 2048 + hh * 256 + sl * 16 + 4 * q4;
      bool first; { int rc = (r0 - b * BT_) >> 6; if (d == 0) { int sp = rc < 4 ? 3 - rc : 263 - rc; first = s < sp; } else first = s < rc; }
      unsigned long long uu = 0ull;
      if (!first) uu = __hip_atomic_load((unsigned long long*)hp, __ATOMIC_RELAXED, __HIP_MEMORY_SCOPE_AGENT);
      if (s + 1 < NCH_) ML_ISSUE(s + 1)
      { const int vr = tid >> 4, sg = (tid & 15) * 4; const uint2 vv_ = *(const uint2*)(sVT + vr * VS + sg); const float4 wg4 = *(const float4*)(sWg + sg);
        *(uint2*)(sVW + vr * VS + sg) = uint2{cvtpk(blo(vv_.x) * wg4.x, bhi(vv_.x) * wg4.y), cvtpk(blo(vv_.y) * wg4.z, bhi(vv_.y) * wg4.w)}; }
      bf16x8 qf[4];
#pragma unroll
      for (int ks = 0; ks < 4; ks++) qf[ks] = *(const bf16x8*)(sQ + (16 * w + l15) * QS + ks * 32 + q4 * 8);
      f32x4 sacc[4];
#pragma unroll
      for (int a = 0; a < 4; a++) { sacc[a] = f32x4{0.f, 0.f, 0.f, 0.f};
#pragma unroll
        for (int ks = 0; ks < 4; ks++) { bf16x8 kf = *(const bf16x8*)(sK + (16 * a + l15) * QS + ks * 32 + q4 * 8); sacc[a] = __builtin_amdgcn_mfma_f32_16x16x32_bf16(kf, qf[ks], sacc[a], 0, 0, 0); } }
      const float ctt = sCt[rt]; const float ect = __expf(ctt); float densum = 0.f;
#pragma unroll
      for (int a = 0; a < 4; a++) { const float4 ex4 = *(const float4*)(sEs + 16 * a + 4 * q4); const float exv[4] = {ex4.x, ex4.y, ex4.z, ex4.w};
#pragma unroll
        for (int jj = 0; jj < 4; jj++) { int rs_ = 16 * a + 4 * q4 + jj; bool valid = d == 0 ? rs_ <= rt : rs_ >= rt;
          float wv = valid ? ect * exv[jj] : 0.f; sacc[a][jj] = sacc[a][jj] * wv; } }
      bf16x8 sf[2], vf[2];
#pragma unroll
      for (int ks = 0; ks < 2; ks++) {
#pragma unroll
        for (int jj = 0; jj < 4; jj++) { sf[ks][jj] = (short)f2b(sacc[2 * ks][jj]); sf[ks][4 + jj] = (short)f2b(sacc[2 * ks + 1][jj]); }
        uint2 v0 = *(const uint2*)(sVT + l15 * VS + 32 * ks + 4 * q4), v1 = *(const uint2*)(sVT + l15 * VS + 32 * ks + 16 + 4 * q4);
        uint4 vv = uint4{v0.x, v0.y, v1.x, v1.y}; vf[ks] = *(bf16x8*)&vv;
      }
      f32x4 num = f32x4{0.f, 0.f, 0.f, 0.f}, numC = f32x4{0.f, 0.f, 0.f, 0.f}, dacc = f32x4{0.f, 0.f, 0.f, 0.f};
      { const short one_ = (l15 & 3) == 0 ? (short)0x3F80 : (short)0; const bf16x8 onesA = bf16x8{one_, one_, one_, one_, one_, one_, one_, one_};
#pragma unroll
        for (int ks = 0; ks < 2; ks++) dacc = __builtin_amdgcn_mfma_f32_16x16x32_bf16(onesA, sf[ks], dacc, 0, 0, 0); }
      densum = dacc[0];
#pragma unroll
      for (int ks = 0; ks < 2; ks++) num = __builtin_amdgcn_mfma_f32_16x16x32_bf16(vf[ks], sf[ks], num, 0, 0, 0);
#pragma unroll
      for (int ks = 0; ks < 4; ks++) { bf16x8 cf = *(const bf16x8*)(sCT + l15 * QS + ks * 32 + q4 * 8); numC = __builtin_amdgcn_mfma_f32_16x16x32_bf16(cf, qf[ks], numC, 0, 0, 0); }
      f32x4 qnacc = f32x4{0.f, 0.f, 0.f, 0.f};
#pragma unroll
      for (int ks = 0; ks < 4; ks++) { bf16x8 na = bf16x8{0, 0, 0, 0, 0, 0, 0, 0}; if ((l15 & 3) == 0) na = *(const bf16x8*)(sNb + ks * 32 + q4 * 8);
        qnacc = __builtin_amdgcn_mfma_f32_16x16x32_bf16(na, qf[ks], qnacc, 0, 0, 0); }
      const float qn = qnacc[0];
      {
        float inter = __expf(mold + ctt); float den = densum + inter * qn; float dn = fmaxf(fabsf(den), __expf(ctt - sBc[rt])); float inv = __builtin_amdgcn_rcpf(dn);
        f32x4 hv;
#pragma unroll
        for (int jj = 0; jj < 4; jj++) hv[jj] = (num[jj] + inter * numC[jj]) * inv;
        if (!first) { unsigned ux = (unsigned)uu, uy = (unsigned)(uu >> 32);
          hv[0] += blo(ux); hv[1] += bhi(ux); hv[2] += blo(uy); hv[3] += bhi(uy); }
        store4b(hp, hv);
      }
      __syncthreads();
      {
        bf16x8 vw[2], wa[2];
#pragma unroll
        for (int ks = 0; ks < 2; ks++) {
          const uint2 v0 = *(const uint2*)(sVW + l15 * VS + 32 * ks + 4 * q4), v1 = *(const uint2*)(sVW + l15 * VS + 32 * ks + 16 + 4 * q4);
          uint4 vv = uint4{v0.x, v0.y, v1.x, v1.y}; vw[ks] = *(bf16x8*)&vv;
          uint4 wz = uint4{0u, 0u, 0u, 0u};
          if (l15 == 0) { const float4 g0 = *(const float4*)(sWg + 32 * ks + 4 * q4), g1 = *(const float4*)(sWg + 32 * ks + 16 + 4 * q4); wz = uint4{cvtpk(g0.x, g0.y), cvtpk(g0.z, g0.w), cvtpk(g1.x, g1.y), cvtpk(g1.z, g1.w)}; }
          wa[ks] = *(bf16x8*)&wz; }
#pragma unroll
        for (int a = 0; a < 2; a++) {
          int dk = 32 * w + 16 * a + l15;
#pragma unroll
          for (int jj = 0; jj < 4; jj++) Cacc[a][jj] *= decay;
          f32x4 nacc = f32x4{0.f, 0.f, 0.f, 0.f};
#pragma unroll
          for (int ks = 0; ks < 2; ks++) { bf16x8 kt;
#pragma unroll
            for (int e = 0; e < 8; e++) { int rs_ = 32 * ks + (e < 4 ? 4 * q4 + e : 16 + 4 * q4 + e - 4); kt[e] = (short)sK[rs_ * QS + dk]; }
            Cacc[a] = __builtin_amdgcn_mfma_f32_16x16x32_bf16(vw[ks], kt, Cacc[a], 0, 0, 0);
            nacc = __builtin_amdgcn_mfma_f32_16x16x32_bf16(wa[ks], kt, nacc, 0, 0, 0); }
          if (q4 == 0) sNr[dk] = nacc[0];
#pragma unroll
          for (int jj = 0; jj < 4; jj++) sCT[(4 * q4 + jj) * QS + dk] = f2b(Cacc[a][jj]);
        }
      }
      __syncthreads();
      if (tid < 128) { const float nv = decay * sN[tid] + sNr[tid]; sN[tid] = nv; sNb[tid] = f2b(nv); }
    }
    __syncthreads();
  }
}

#define CS 72
#define CSLOT(i_) ((bfr*)smem + (i_) * (64 * CS))
#define A_SST (A_R7B + 362086400ull)
__device__ __forceinline__ f32x4 cmm(const bfr* X, const bfr* YT, int ti, int tj, int l15, int q4) {
  f32x4 acc = f32x4{0.f, 0.f, 0.f, 0.f};
#pragma unroll
  for (int ks = 0; ks < 2; ks++) { bf16x8 a = *(const bf16x8*)(X + (16 * ti + l15) * CS + 32 * ks + 8 * q4); bf16x8 b = *(const bf16x8*)(YT + (16 * tj + l15) * CS + 32 * ks + 8 * q4);
    acc = __builtin_amdgcn_mfma_f32_16x16x32_bf16(a, b, acc, 0, 0, 0); }
  return acc;
}
template <int MODE> __device__ __forceinline__ f32x4 cmm_mask(const bfr* X, const bfr* YT, int ti, int tj, int l15, int q4) {
  f32x4 acc = f32x4{0.f, 0.f, 0.f, 0.f};
#pragma unroll
  for (int ks = 0; ks < 2; ks++) { const int kb = 2 * ks + (q4 >> 1);
    const bool ok = MODE == 1 ? ((kb == 0 && tj == 1) || (kb == 2 && tj == 3)) : (kb < 2 && tj >= 2);
    bf16x8 a = *(const bf16x8*)(X + (16 * ti + l15) * CS + 32 * ks + 8 * q4); bf16x8 bz = bf16x8{0, 0, 0, 0, 0, 0, 0, 0};
    if (ok) bz = *(const bf16x8*)(YT + (16 * tj + l15) * CS + 32 * ks + 8 * q4);
    acc = __builtin_amdgcn_mfma_f32_16x16x32_bf16(a, bz, acc, 0, 0, 0); }
  return acc;
}
__device__ __forceinline__ void st_row(bfr* dst, int r0, int c, f32x4 v) {
#pragma unroll
  for (int jj = 0; jj < 4; jj++) dst[(r0 + jj) * CS + c] = f2b(v[jj]); }
__device__ __forceinline__ void st_tr(bfr* dst, int r0, int c, f32x4 v) { store4b(dst + c * CS + r0, v); }
__device__ __forceinline__ f32x4 ld_row(const bfr* src, int r0, int c) { f32x4 v;
#pragma unroll
  for (int jj = 0; jj < 4; jj++) v[jj] = b2f(src[(r0 + jj) * CS + c]);
  return v; }
__device__ __forceinline__ f32x4 ld_tr(const bfr* src, int r0, int c) { uint2 u = *(const uint2*)(src + c * CS + r0); return f32x4{blo(u.x), bhi(u.x), blo(u.y), bhi(u.y)}; }

__device__ __forceinline__ void ph_r7_ca(const P& p, int j, int win, char* smem) {
  float* LW = (float*)(smem + 7 * 9216); float* AT = (float*)(smem + 9 * 9216); float* WL = (float*)(smem + 14 * 9216);
  const bfr* RK = (const bfr*)(p.ACT + A_RKVZ); const bfr* WMb = (const bfr*)(p.ACT + A_WM); const bfr* AMb = (const bfr*)(p.ACT + A_AM);
  float* BON = (float*)(p.ACT + A_BON); bfr* WB = p.H;
  const float* kkp = p.r7_k_k + (size_t)j * 1024; const float* kap = p.r7_k_a + (size_t)j * 1024; const float* rkp = p.r7_r_k + (size_t)j * 1024;
  const int tid = ltid(), lane = tid & 63, w = tid >> 6, l15 = lane & 15, q4 = lane >> 4, ti = w >> 1, tj0 = (w & 1) * 2;
  const int c0 = win * 20;
  for (int it = blockIdx.x; it < 1280; it += gridDim.x) {
    const int chain = it / 20, cl = it - chain * 20, c = c0 + cl, d = chain & 1, b = chain >> 5, h = (chain >> 1) & 15;
    {
      const int rowA = rowmap(d, b, 64 * c + 16 * ti + l15);
      const float* w0 = p.r7_w0 + (size_t)(j * 2 + d) * 1024 + h * 64; const float* a0 = p.r7_a0 + (size_t)(j * 2 + d) * 1024 + h * 64;
#pragma unroll
      for (int tt = 0; tt < 2; tt++) { const int tj = tj0 + tt; f32x4 aw = f32x4{0.f, 0.f, 0.f, 0.f}, aa = aw;
#pragma unroll
        for (int ks = 0; ks < 2; ks++) {
          bf16x8 xw = *(const bf16x8*)(WMb + (size_t)rowA * 128 + d * 64 + 32 * ks + 8 * q4), xa = *(const bf16x8*)(AMb + (size_t)rowA * 128 + d * 64 + 32 * ks + 8 * q4);
          bf16x8 yw = *(const bf16x8*)(p.W + WR_UP + d * 65536 + (size_t)(h * 64 + 16 * tj + l15) * 64 + 32 * ks + 8 * q4);
          bf16x8 ya = *(const bf16x8*)(p.W + WR_UP + (2 + d) * 65536 + (size_t)(h * 64 + 16 * tj + l15) * 64 + 32 * ks + 8 * q4);
          aw = __builtin_amdgcn_mfma_f32_16x16x32_bf16(xw, yw, aw, 0, 0, 0); aa = __builtin_amdgcn_mfma_f32_16x16x32_bf16(xa, ya, aa, 0, 0, 0); }
        const int ch = 16 * tj + l15; const float w0v = w0[ch], a0v = a0[ch];
#pragma unroll
        for (int jj = 0; jj < 4; jj++) { const int tau = 16 * ti + 4 * q4 + jj; LW[tau * 64 + ch] = -0.6065306597126334f * sigm(w0v + aw[jj]); AT[tau * 64 + ch] = sigm(a0v + aa[jj]); }
      }
    }
    __syncthreads();
    if (tid < 64) { float acc = 0.f;
#pragma unroll 8
      for (int t = 0; t < 64; t++) { acc += LW[t * 64 + tid]; LW[t * 64 + tid] = acc; } }
    __syncthreads();
    {
      const int tau = tid >> 3, sc = tid & 7, col = h * 64 + sc * 8; const int row = rowmap(d, b, 64 * c + tau);
      const bfr* rp = RK + (size_t)row * 4096 + col; uint4 pr = *(const uint4*)rp, pk = *(const uint4*)(rp + 1024);
      unsigned ur[4] = {pr.x, pr.y, pr.z, pr.w}, uk[4] = {pk.x, pk.y, pk.z, pk.w};
      float r8[8], k8[8], kr[8];
#pragma unroll
      for (int e = 0; e < 4; e++) { r8[2 * e] = blo(ur[e]); r8[2 * e + 1] = bhi(ur[e]); k8[2 * e] = blo(uk[e]); k8[2 * e + 1] = bhi(uk[e]); }
      float ss = 0.f;
#pragma unroll
      for (int e = 0; e < 8; e++) { kr[e] = k8[e] * kkp[col + e]; ss += kr[e] * kr[e]; }
      ss += __shfl_xor(ss, 1); ss += __shfl_xor(ss, 2); ss += __shfl_xor(ss, 4);
      const float inv = __builtin_amdgcn_rsqf(fmaxf(ss, 1e-24f));
      float bon = 0.f, o0[8], o1[8], o2[8], o3[8], o4[8], o5[8];
#pragma unroll
      for (int e = 0; e < 8; e++) {
        const float cw = LW[tau * 64 + sc * 8 + e], cwm = tau > 0 ? LW[(tau - 1) * 64 + sc * 8 + e] : 0.f, cwl = LW[63 * 64 + sc * 8 + e], a = AT[tau * 64 + sc * 8 + e];
        const float ka = kr[e] * inv, be = a * ka, kd = k8[e] * (1.f + (a - 1.f) * kap[col + e]); bon += r8[e] * kd * rkp[col + e];
        const float e2 = __expf(-cw), e4 = __expf(cwl - cw);
        o0[e] = ka * __expf(cwm); o1[e] = be * e2; o2[e] = kd * e2; o3[e] = r8[e] * __expf(cw); o4[e] = be * e4; o5[e] = kd * e4;
        if (tau == 63) WL[sc * 8 + e] = __expf(cwl);
      }
      bon += __shfl_xor(bon, 1); bon += __shfl_xor(bon, 2); bon += __shfl_xor(bon, 4);
      if (sc == 0) BON[((size_t)d * R_ + row) * 16 + h] = bon;
      *(uint4*)(CSLOT(0) + tau * CS + sc * 8) = uint4{pk2(o0[0], o0[1]), pk2(o0[2], o0[3]), pk2(o0[4], o0[5]), pk2(o0[6], o0[7])};
      *(uint4*)(CSLOT(1) + tau * CS + sc * 8) = uint4{pk2(o1[0], o1[1]), pk2(o1[2], o1[3]), pk2(o1[4], o1[5]), pk2(o1[6], o1[7])};
      *(uint4*)(CSLOT(2) + tau * CS + sc * 8) = uint4{pk2(o2[0], o2[1]), pk2(o2[2], o2[3]), pk2(o2[4], o2[5]), pk2(o2[6], o2[7])};
      *(uint4*)(CSLOT(3) + tau * CS + sc * 8) = uint4{pk2(o3[0], o3[1]), pk2(o3[2], o3[3]), pk2(o3[4], o3[5]), pk2(o3[6], o3[7])};
#pragma unroll
      for (int e = 0; e < 8; e++) { CSLOT(4)[(sc * 8 + e) * CS + tau] = f2b(o0[e]); CSLOT(5)[(sc * 8 + e) * CS + tau] = f2b(o4[e]); CSLOT(6)[(sc * 8 + e) * CS + tau] = f2b(o5[e]); }
    }
    __syncthreads();
#pragma unroll
    for (int tt = 0; tt < 2; tt++) { const int tj = tj0 + tt, r0 = 16 * ti + 4 * q4, cc = 16 * tj + l15;
      f32x4 v = cmm(CSLOT(1), CSLOT(0), ti, tj, l15, q4);
#pragma unroll
      for (int jj = 0; jj < 4; jj++) if (!(r0 + jj < cc)) v[jj] = 0.f;
      st_row(CSLOT(7), r0, cc, v); st_tr(CSLOT(8), r0, cc, v);
      v = cmm(CSLOT(2), CSLOT(0), ti, tj, l15, q4);
#pragma unroll
      for (int jj = 0; jj < 4; jj++) if (!(r0 + jj < cc)) v[jj] = 0.f;
      st_row(CSLOT(9), r0, cc, v);
      v = cmm(CSLOT(3), CSLOT(1), ti, tj, l15, q4);
#pragma unroll
      for (int jj = 0; jj < 4; jj++) if (!(cc <= r0 + jj)) v[jj] = 0.f;
      st_row(CSLOT(10), r0, cc, v);
      v = cmm(CSLOT(3), CSLOT(2), ti, tj, l15, q4);
#pragma unroll
      for (int jj = 0; jj < 4; jj++) if (!(cc <= r0 + jj)) v[jj] = 0.f;
      st_row(CSLOT(11), r0, cc, v);
    }
    __syncthreads();
    {
      float* X = (float*)CSLOT(0);
      const bfr* Ab = CSLOT(7);
      const int cl = lane >> 3, pp = lane & 7, cx = 8 * w + cl, blk0 = (w >> 1) * 16;
#pragma unroll 1
      for (int il = 15; il >= 0; il--) { const int i = blk0 + il;
        float sum = 0.f;
#pragma unroll 1
        for (int jx = i + 1 + pp; jx < blk0 + 16; jx += 8) sum += b2f(Ab[i * CS + jx]) * X[jx * 72 + cx];
        sum += dppf<0xB1>(sum); sum += dppf<0x4E>(sum); sum += dppf<0x141>(sum);
        const float xv = (i == cx ? 1.f : 0.f) - sum;
        if (pp == 0) X[i * 72 + cx] = xv;
      }
      __syncthreads();
#pragma unroll 1
      for (int e = tid; e < 4096; e += 512) { const int i = e >> 6, c2 = e & 63; const bfr tv = ((i >> 4) == (c2 >> 4)) ? f2b(X[i * 72 + c2]) : (bfr)0; CSLOT(2)[i * CS + c2] = tv; CSLOT(12)[c2 * CS + i] = tv; }
      __syncthreads();
#pragma unroll
      for (int tt = 0; tt < 2; tt++) { const int tj = tj0 + tt, r0 = 16 * ti + 4 * q4, cc = 16 * tj + l15; st_row(CSLOT(13), r0, cc, cmm_mask<1>(CSLOT(2), CSLOT(8), ti, tj, l15, q4)); }
      __syncthreads();
#pragma unroll
      for (int tt = 0; tt < 2; tt++) { const int tj = tj0 + tt, r0 = 16 * ti + 4 * q4, cc = 16 * tj + l15;
        f32x4 v = ld_row(CSLOT(2), r0, cc) - cmm(CSLOT(13), CSLOT(12), ti, tj, l15, q4); st_row(CSLOT(0), r0, cc, v); st_tr(CSLOT(1), r0, cc, v); }
      __syncthreads();
#pragma unroll
      for (int tt = 0; tt < 2; tt++) { const int tj = tj0 + tt, r0 = 16 * ti + 4 * q4, cc = 16 * tj + l15; st_row(CSLOT(13), r0, cc, cmm_mask<2>(CSLOT(0), CSLOT(8), ti, tj, l15, q4)); }
      __syncthreads();
#pragma unroll
      for (int tt = 0; tt < 2; tt++) { const int tj = tj0 + tt, r0 = 16 * ti + 4 * q4, cc = 16 * tj + l15;
        f32x4 v = ld_row(CSLOT(0), r0, cc) - cmm(CSLOT(13), CSLOT(1), ti, tj, l15, q4);
#pragma unroll
        for (int jj = 0; jj < 4; jj++) if (r0 + jj == cc) v[jj] -= 1.f;
        st_row(CSLOT(2), r0, cc, v); }
      __syncthreads();
    }
#pragma unroll
    for (int tt = 0; tt < 2; tt++) { const int tj = tj0 + tt, r0 = 16 * ti + 4 * q4, cc = 16 * tj + l15;
      f32x4 g = cmm(CSLOT(10), CSLOT(2), ti, tj, l15, q4) + ld_row(CSLOT(10), r0, cc); st_row(CSLOT(12), r0, cc, g);
      f32x4 hh = cmm(CSLOT(5), CSLOT(2), ti, tj, l15, q4) + ld_row(CSLOT(5), r0, cc); st_row(CSLOT(13), r0, cc, hh); }
    __syncthreads();
    {
      bfr* out = WB + (size_t)(chain * 20 + cl) * 16384;
#pragma unroll
      for (int tt = 0; tt < 2; tt++) { const int tj = tj0 + tt, r0 = 16 * ti + 4 * q4, cc = 16 * tj + l15;
        f32x4 v = ld_tr(CSLOT(3), r0, cc) - cmm(CSLOT(4), CSLOT(12), ti, tj, l15, q4);
        store4b(out + cc * 64 + r0, v);
        v = ld_tr(CSLOT(11), r0, cc) - cmm(CSLOT(9), CSLOT(12), ti, tj, l15, q4);
        store4b(out + 4096 + cc * 64 + r0, v);
        v = -cmm(CSLOT(4), CSLOT(13), ti, tj, l15, q4);
#pragma unroll
        for (int jj = 0; jj < 4; jj++) if (r0 + jj == cc) v[jj] += WL[cc];
        store4b(out + 8192 + cc * 64 + r0, v);
        v = ld_tr(CSLOT(6), r0, cc) - cmm(CSLOT(9), CSLOT(13), ti, tj, l15, q4);
        store4b(out + 12288 + cc * 64 + r0, v);
      }
    }
    __syncthreads();
  }
}

__device__ __forceinline__ void ph_r7_cb(const P& p, int win, char* smem) {
  bfr* Sh = (bfr*)smem; bfr* Sl = Sh + 2 * 16 * CS; bfr* VT = Sl + 2 * 16 * CS;
  const bfr* WB = p.H; const bfr* RK = (const bfr*)(p.ACT + A_RKVZ); bfr* SST = (bfr*)(p.ACT + A_SST);
  const int tid = ltid(), lane = tid & 63, w = tid >> 6, l15 = lane & 15, q4 = lane >> 4;
  const int c0 = win * 20;
  for (int it = xcd_swz(); it < 256; it += gridDim.x) {
    const int d = it & 1, b = it >> 7, h = (it >> 3) & 15, rg = (it >> 1) & 3, chain = (b * 16 + h) * 2 + d;
    bfr* Y = d ? R7_Y2 : (bfr*)(p.ACT + A_Y);
    bfr* sst = SST + (size_t)(chain * 4 + rg) * 2048;
    __syncthreads();
    if (tid < 256) { const int hl = tid >> 7, e = tid & 127, rr = e >> 3, c8 = e & 7; uint4 v = uint4{0u, 0u, 0u, 0u};
      if (win > 0) v = *(const uint4*)(sst + hl * 1024 + rr * 64 + c8 * 8);
      *(uint4*)((hl ? Sl : Sh) + rr * CS + c8 * 8) = v; }
    const int vtau = tid >> 3, vp = tid & 7;
    { const int row = rowmap(d, b, 64 * c0 + vtau); unsigned vv = *(const unsigned*)(RK + (size_t)row * 4096 + 2048 + h * 64 + rg * 16 + 2 * vp);
      VT[(2 * vp) * CS + vtau] = (bfr)(vv & 0xffff); VT[(2 * vp + 1) * CS + vtau] = (bfr)(vv >> 16); }
    const bfr* bbase = WB + (size_t)(chain * 20) * 16384 + (w < 4 ? 8192 + (16 * w + l15) * 64 : (16 * (w - 4) + l15) * 64) + 8 * q4;
    bf16x8 rb1[4][2], rb2[4][2]; unsigned rv[4];
#define CB_LOAD(u_, s_) { const int ss_ = (s_) < 20 ? (s_) : 19; const bfr* bp_ = bbase + (size_t)ss_ * 16384; \
      rb1[u_][0] = *(const bf16x8*)bp_; rb1[u_][1] = *(const bf16x8*)(bp_ + 32); rb2[u_][0] = *(const bf16x8*)(bp_ + 4096); rb2[u_][1] = *(const bf16x8*)(bp_ + 4096 + 32); \
      const int sv_ = ss_ + 1 < 20 ? ss_ + 1 : 19; const int rowv_ = rowmap(d, b, 64 * (c0 + sv_) + vtau); \
      rv[u_] = *(const unsigned*)(RK + (size_t)rowv_ * 4096 + 2048 + h * 64 + rg * 16 + 2 * vp); }
    CB_LOAD(0, 0) CB_LOAD(1, 1) CB_LOAD(2, 2) CB_LOAD(3, 3)
    __syncthreads();
    for (int g = 0; g < 5; g++) {
#pragma unroll
      for (int u = 0; u < 4; u++) {
        const int s = 4 * g + u;
        if (s < 20) {
          const int cur = s & 1, nxt = cur ^ 1, c = c0 + s;
          bf16x8 sh[2], sl[2], vt[2];
#pragma unroll
          for (int ks = 0; ks < 2; ks++) { sh[ks] = *(const bf16x8*)(Sh + (cur * 16 + l15) * CS + 32 * ks + 8 * q4); sl[ks] = *(const bf16x8*)(Sl + (cur * 16 + l15) * CS + 32 * ks + 8 * q4);
            vt[ks] = *(const bf16x8*)(VT + (cur * 16 + l15) * CS + 32 * ks + 8 * q4); }
          f32x4 a1 = f32x4{0.f, 0.f, 0.f, 0.f}, a2 = a1;
#pragma unroll
          for (int ks = 0; ks < 2; ks++) { a1 = __builtin_amdgcn_mfma_f32_16x16x32_bf16(sh[ks], rb1[u][ks], a1, 0, 0, 0); a2 = __builtin_amdgcn_mfma_f32_16x16x32_bf16(vt[ks], rb2[u][ks], a2, 0, 0, 0); }
#pragma unroll
          for (int ks = 0; ks < 2; ks++) a1 = __builtin_amdgcn_mfma_f32_16x16x32_bf16(sl[ks], rb1[u][ks], a1, 0, 0, 0);
          a1 = a1 + a2;
          if (w < 4) {
#pragma unroll
            for (int jj = 0; jj < 4; jj++) { const bfr hi = f2b(a1[jj]); Sh[(nxt * 16 + 4 * q4 + jj) * CS + 16 * w + l15] = hi; Sl[(nxt * 16 + 4 * q4 + jj) * CS + 16 * w + l15] = f2b(a1[jj] - b2f(hi)); }
          } else {
            const int rowy = rowmap(d, b, 64 * c + 16 * (w - 4) + l15);
            store4b(Y + (size_t)rowy * 1024 + h * 64 + rg * 16 + 4 * q4, a1);
          }
          if (s + 1 < 20) { VT[(nxt * 16 + 2 * vp) * CS + vtau] = (bfr)(rv[u] & 0xffff); VT[(nxt * 16 + 2 * vp + 1) * CS + vtau] = (bfr)(rv[u] >> 16); }
          if (s + 4 < 20) CB_LOAD(u, s + 4)
          __syncthreads();
        }
      }
    }
    if (tid < 256) { const int hl = tid >> 7, e = tid & 127, rr = e >> 3, c8 = e & 7; *(uint4*)(sst + hl * 1024 + rr * 64 + c8 * 8) = *(const uint4*)((hl ? Sl : Sh) + rr * CS + c8 * 8); }
  }
}

__device__ __forceinline__ void run_phase(const P& p, int ph, int layer, int d, char* smem) {
  Ctx c; c.layer = layer; c.j = layer / 3; c.d = d; c.wc = layer < 3 ? 1 : 0;
  switch (ph) {
    case PH_PRE: ph_pre(p, smem); break;
    case PH_NORM: ph_norm(p, layer, smem); break;
    case PH_LRU_IN: big_gemm(smem, p.H, p.W, 2560, 1024, F_LruIn{p.ACT}); break;
    case PH_LRU_CONV: ph_lru_conv(p, c.j); break;
    case PH_LRU_GATE: gemm_phase_k2<G_LruGate>(p, c, smem); break;
    case PH_LRU_S1: ph_lru_s1(p, d); break;
    case PH_LRU_S2: ph_lru_s2(p, smem); break;
    case PH_LRU_S3: ph_lru_s3(p, d); break;
    case PH_LRU_OUT: big_gemm(smem, (const bfr*)(p.ACT + A_Z), p.W + WL_OUT, 1024, 1280, F_Resid{p.Xx, p.Xc, p.MOD + (size_t)layer * 3 * 3072, c.wc}); break;
    case PH_ML_IN: big_gemm(smem, p.H, p.W, 4352, 1024, F_MlIn{p.ACT}); break;
    case PH_ML_SCAN: ph_ml_scan(p, c.j, smem); break;
    case PH_ML_STAT: ph_ml_stat(p); break;
    case PH_ML_Z: big_gemm(smem, p.H, p.W + WM_Z, 2048, 1024, F_MlZ{p.ACT, p.ml_norm_g + (size_t)c.j * 2048}); break;
    case PH_ML_OUT: big_gemm(smem, (const bfr*)(p.ACT + A_HS), p.W + WM_OUT, 1024, 2048, F_Resid{p.Xx, p.Xc, p.MOD + (size_t)layer * 3 * 3072, c.wc}); break;
    case PH_R7_IN: big_gemm(smem, p.H, p.W, 4352, 2048, F_R7In{p.ACT}); break;
    case PH_R7_SHIFT: ph_r7_shift(p); break;
    case PH_R7_CA: ph_r7_ca(p, c.j, d, smem); break;
    case PH_R7_CB: ph_r7_cb(p, d, smem); break;
    case PH_R7_FIN: ph_r7_fin(p, c.j); break;
    case PH_R7_OUT: big_gemm(smem, (const bfr*)(p.ACT + A_Y), p.W + WR_OUT, 1024, 1024, F_Resid{p.Xx, p.Xc, p.MOD + (size_t)layer * 3 * 3072, c.wc}); break;
    case PH_FINAL: ph_final(p); break;
  }
}


#define XB_TMO      128
#define XB_XCNT(j)  (256  + 64 * (j))
#define XB_XSUB(j)  (1280 + 64 * (j))
#define XB_XGEN(j)  (2304 + 64 * (j))
#define XB_TOP      3328
#define XB_TOPGEN   3392
#define XCD_BAR_WORDS 3456
#define XB_SPIN_CAP (1u << 18)
#define OFF_BAR 527000064ull
#define OFF_CL (OFF_BAR + 16384ull)
__device__ __forceinline__ unsigned xb_ld(unsigned* p)              { return __hip_atomic_load(p, __ATOMIC_RELAXED, __HIP_MEMORY_SCOPE_AGENT); }
__device__ __forceinline__ unsigned xb_add(unsigned* p, unsigned v) { return __hip_atomic_fetch_add(p, v, __ATOMIC_RELAXED, __HIP_MEMORY_SCOPE_AGENT); }
__device__ __forceinline__ unsigned xb_xcc_id() { return (unsigned)__builtin_amdgcn_s_getreg((3 << 11) | 20) & 0xFu; }
#define XB_SPIN(cond, bar) do { unsigned _sp = 0; while (cond) { __builtin_amdgcn_s_sleep(1); \
    if ((++_sp & 255u) == 0u) { if (xb_ld(&(bar)[XB_TMO])) break; if (_sp > XB_SPIN_CAP) { atomicAdd(&(bar)[XB_TMO], 1u); break; } } } } while (0)
struct XcdBarrier { unsigned* bar; unsigned x; volatile __attribute__((address_space(3))) unsigned* st; };
__device__ __forceinline__ XcdBarrier xcd_barrier_post(unsigned* bar, volatile __attribute__((address_space(3))) unsigned* st) {
  XcdBarrier b; b.bar = bar; b.x = xb_xcc_id(); b.st = st;
  if (threadIdx.x == 0) (void)xb_add(&bar[XB_XCNT(b.x)], 1u);
  return b;
}
__device__ __forceinline__ void xcd_barrier_complete(unsigned* bar, unsigned x, unsigned& nloc, unsigned& nx) {
  const unsigned G = gridDim.x * gridDim.y * gridDim.z;
  unsigned sum, cnt, mine, sp = 0u;
  for (;;) {
    sum = 0u; cnt = 0u; mine = 0u;
#pragma unroll
    for (unsigned j = 0; j < 16; ++j) { const unsigned c = xb_ld(&bar[XB_XCNT(j)]); sum += c; cnt += (c > 0u) ? 1u : 0u; mine = (j == x) ? c : mine; }
    if (sum == G) break;
    __builtin_amdgcn_s_sleep(1);
    if ((++sp & 255u) == 0u) { if (xb_ld(&bar[XB_TMO])) break; if (sp > XB_SPIN_CAP) { atomicAdd(&bar[XB_TMO], 1u); break; } }
  }
  nloc = mine > 0u ? mine : 1u; nx = cnt > 0u ? cnt : 1u;
}
__device__ __forceinline__ void xcd_barrier(const XcdBarrier& b) {
  asm volatile("s_waitcnt vmcnt(0)" ::: "memory");
  __syncthreads();
  if (threadIdx.x == 0) {
    unsigned* bar = b.bar;
    __builtin_amdgcn_s_waitcnt(0);
    unsigned nloc = b.st[0], nx = b.st[1];
    if (nloc == 0u) { xcd_barrier_complete(bar, b.x, nloc, nx); b.st[0] = nloc; b.st[1] = nx; }
    const unsigned old = xb_add(&bar[XB_XSUB(b.x)], 1u);
    const unsigned gen = old / nloc;
    if (old + 1u == (gen + 1u) * nloc) {
      __builtin_amdgcn_fence(__ATOMIC_RELEASE, "agent");
      asm volatile("s_waitcnt vmcnt(0)" ::: "memory");
      const unsigned og = xb_add(&bar[XB_TOP], 1u);
      const unsigned tg = og / nx;
      if (og + 1u == (tg + 1u) * nx) xb_add(&bar[XB_TOPGEN], 1u);
      else XB_SPIN(xb_ld(&bar[XB_TOPGEN]) == tg, bar);
      __builtin_amdgcn_fence(__ATOMIC_ACQUIRE, "agent");
      xb_add(&bar[XB_XGEN(b.x)], 1u);
      asm volatile("s_waitcnt vmcnt(0)" ::: "memory");
    } else {
      XB_SPIN(xb_ld(&bar[XB_XGEN(b.x)]) == gen, bar);
      __builtin_amdgcn_fence(__ATOMIC_ACQUIRE, "agent");
      asm volatile("s_waitcnt vmcnt(0)" ::: "memory");
    }
  }
  __syncthreads();
}

#define SMEM_BYTES (131072 + 64)
extern __shared__ __attribute__((aligned(16))) char dyn_smem[];
#if !MEGA
__global__ void __launch_bounds__(512, 2) phase_kernel(P p, int si) {
  run_phase(p, p.sched[si * 3], p.sched[si * 3 + 1], p.sched[si * 3 + 2], dyn_smem);
}
#else
__global__ void __launch_bounds__(512, 2) mega_kernel(P p) {
  cg::grid_group grid = cg::this_grid();
  volatile __attribute__((address_space(3))) unsigned* st = (volatile __attribute__((address_space(3))) unsigned*)(dyn_smem + 131072);
  if (threadIdx.x < 4) st[threadIdx.x] = 0u;
  __syncthreads();
  const XcdBarrier xb = xcd_barrier_post(p.bar, st);
  for (int si = 0; si < p.nsched; si++) {
    run_phase(p, p.sched[si * 3], p.sched[si * 3 + 1], p.sched[si * 3 + 2], dyn_smem);
    if (si + 1 < p.nsched) { if (p.pad_ != 0) grid.sync(); xcd_barrier(xb); }
  }
}
#endif

extern "C" void kernel_launch(void* const* d_in, const int* in_sizes, int n_in, void* d_out, int out_size, void* d_ws, size_t ws_size, hipStream_t stream) {
  P p; memset(&p, 0, sizeof(p));
  const float** f = (const float**)&p;
  for (int i = 0; i < 33; i++) f[i] = (const float*)d_in[i];
  char* ws = (char*)d_ws;
  p.Xx = (float*)d_out; p.Xc = (float*)(ws + OFF_XC); p.MOD = (float*)(ws + OFF_MOD); p.W = (bfr*)(ws + OFF_W); p.H = (bfr*)(ws + OFF_H); p.ACT = ws + OFF_ACT; p.bar = (unsigned*)(ws + OFF_BAR); p.CL = (float*)(ws + OFF_CL);
  int n = 0;
  auto add = [&](int ph, int layer, int d) { p.sched[n * 3] = ph; p.sched[n * 3 + 1] = layer; p.sched[n * 3 + 2] = d; n++; };
  add(PH_PRE, 0, 0);
  if (DUP & 4) add(PH_PRE, 0, 0);
  for (int l = 0; l < 4; l++) {
    add(PH_NORM, l, 0); if (DUP & 4) add(PH_NORM, l, 0);
    int kind = l % 3;
    const bool dg = DUP & 1, ds = DUP & 2;
    if (kind == 0) { add(PH_LRU_IN, l, 0); if (dg) add(PH_LRU_IN, l, 0); add(PH_LRU_CONV, l, 0); if (DUP & 4) add(PH_LRU_CONV, l, 0);
      for (int d = 0; d < 2; d++) { add(PH_LRU_GATE, l, d); if (dg) add(PH_LRU_GATE, l, d); add(PH_LRU_S1, l, d); if (DUP & 8) add(PH_LRU_S1, l, d); add(PH_LRU_S2, l, d); if (DUP & 16) add(PH_LRU_S2, l, d); add(PH_LRU_S3, l, d); }
      add(PH_LRU_OUT, l, 0); }
    else if (kind == 1) { add(PH_ML_IN, l, 0); if (dg) add(PH_ML_IN, l, 0); add(PH_ML_SCAN, l, 0); if (ds) add(PH_ML_SCAN, l, 0); add(PH_ML_STAT, l, 0); if (DUP & 4) add(PH_ML_STAT, l, 0); add(PH_ML_Z, l, 0); add(PH_ML_OUT, l, 0); }
    else { add(PH_R7_SHIFT, l, 0); add(PH_R7_IN, l, 0); if (dg) add(PH_R7_IN, l, 0); for (int wi = 0; wi < 13; wi++) { add(PH_R7_CA, l, wi); if (DUP & 32) add(PH_R7_CA, l, wi); add(PH_R7_CB, l, wi); } add(PH_R7_FIN, l, 0); add(PH_R7_OUT, l, 0); }
  }
  add(PH_FINAL, 0, 0);
  p.nsched = n;
  if (ws_size < WS_NEED) fprintf(stderr, "workspace too small: %zu < %llu\n", ws_size, (unsigned long long)WS_NEED);
#if MEGA
  static int grid_blocks = 0;
  if (!grid_blocks) { int dev = 0, cus = 0, per = 0; hipGetDevice(&dev); hipDeviceGetAttribute(&cus, hipDeviceAttributeMultiprocessorCount, dev);
    hipFuncSetAttribute((const void*)mega_kernel, hipFuncAttributeMaxDynamicSharedMemorySize, SMEM_BYTES);
    hipOccupancyMaxActiveBlocksPerMultiprocessor(&per, mega_kernel, 512, SMEM_BYTES); if (per > 1) per = 1; if (per < 1) per = 1; grid_blocks = cus * per; }
  hipMemsetAsync(ws + OFF_BAR, 0, XCD_BAR_WORDS * 4, stream);
  void* args[] = {&p};
  hipError_t e = hipLaunchCooperativeKernel((void*)mega_kernel, dim3(grid_blocks), dim3(512), args, SMEM_BYTES, stream);
  if (e != hipSuccess) fprintf(stderr, "cooperative launch failed: %s (grid %d)\n", hipGetErrorString(e), grid_blocks);
#else
  static int once = 0; if (!once) { once = 1; hipFuncSetAttribute((const void*)phase_kernel, hipFuncAttributeMaxDynamicSharedMemorySize, SMEM_BYTES); }
  for (int si = 0; si < n; si++) phase_kernel<<<256, 512, SMEM_BYTES, stream>>>(p, si);
#endif
}
```
